# Optimizing an MI355X kernel written in HIP

```python
import math
import jax, jax.numpy as jnp
from jax import lax
import numpy as np

D_MODEL = 1024
BATCH = 4
SEQ = 8192
DEPTH = 4

CTX_LEN = 256
GRID_W = 64
HEAD_DIM = 64
SSM_WIDTH = 512
SSM_GROUP = 16
SSM_GROUPS = SSM_WIDTH // SSM_GROUP
SSM_STATE = 64
DT_MIN = 0.001
DT_MAX = 0.1
GQA_HEADS = 8
GQA_KV_HEADS = 2
GQA_WIDTH = GQA_HEADS * HEAD_DIM
GQA_KV_WIDTH = GQA_KV_HEADS * HEAD_DIM
NA_HEADS = 8
NA_WIDTH = NA_HEADS * HEAD_DIM
NA_WIN_H = 8
NA_WIN_W = 16
Q_BLOCK = 128
ROPE_BASE = 10000.0
N_BRANCH = 3
IN_WIDTHS = (SSM_WIDTH, GQA_WIDTH, GQA_KV_WIDTH, GQA_KV_WIDTH, NA_WIDTH, NA_WIDTH, NA_WIDTH, N_BRANCH * D_MODEL)
IN_WIDTH = sum(IN_WIDTHS)
N_EXPERTS = 16
N_EXPERT_GROUPS = 4
EXPERTS_PER_GROUP = N_EXPERTS // N_EXPERT_GROUPS
TOP_K = 2
EXPERT_FF = 512
NORM_EPS = 1e-6

kernel_name = "hybrid_s5_gqa_natten_moe_dit"


def rmsnorm(x, g):
    xf = x.astype(jnp.float32)
    y = xf * lax.rsqrt(jnp.mean(xf * xf, axis=-1, keepdims=True) + NORM_EPS)
    return (y * g.astype(jnp.float32)).astype(x.dtype)


def modulate(h, shift, scale):
    return h * (1.0 + scale) + shift


def axial_rope_tables(n_tokens):
    t = jnp.arange(n_tokens)
    row = (t // GRID_W).astype(jnp.float32)
    col = (t % GRID_W).astype(jnp.float32)
    n_freq = HEAD_DIM // 4
    inv = ROPE_BASE ** (-jnp.arange(n_freq, dtype=jnp.float32) / n_freq)
    ang = jnp.stack([row[:, None] * inv, col[:, None] * inv], axis=1)
    return jnp.cos(ang), jnp.sin(ang)


def apply_axial_rope(x, cos, sin):
    b, s, h, d = x.shape
    xr = x.astype(jnp.float32).reshape(b, s, h, 2, 2, d // 4)
    x1, x2 = xr[..., 0, :], xr[..., 1, :]
    cs, sn = cos[None, :, None], sin[None, :, None]
    out = jnp.stack([x1 * cs - x2 * sn, x2 * cs + x1 * sn], axis=-2)
    return out.reshape(b, s, h, d).astype(x.dtype)


def dense_attend(q, k, v):
    b, lq, hq, d = q.shape
    hk = k.shape[2]
    qg = q.reshape(b, lq, hk, hq // hk, d)
    s = jnp.einsum('bqkgd,bskd->bkgqs', qg, k).astype(jnp.float32) * (d ** -0.5)
    p = jax.nn.softmax(s, axis=-1).astype(v.dtype)
    return jnp.einsum('bkgqs,bskd->bqkgd', p, v).reshape(b, lq, hq * d)


def gqa_latent(q_lat, k_ctx, v_ctx, k_lat, v_lat):
    bsz, n_lat, hq, hd = q_lat.shape
    k_all = jnp.concatenate([k_ctx, k_lat], axis=1)
    v_all = jnp.concatenate([v_ctx, v_lat], axis=1)
    qb = q_lat.reshape(bsz, n_lat // Q_BLOCK, Q_BLOCK, hq, hd).transpose(1, 0, 2, 3, 4)
    out = lax.map(lambda qblk: dense_attend(qblk, k_all, v_all), qb)
    return out.transpose(1, 0, 2, 3).reshape(bsz, n_lat, hq * hd)


def neighborhood_attention(q_lat, k_lat, v_lat, k_ctx, v_ctx, rpb):
    bsz, n_lat, nh, hd = q_lat.shape
    rows = n_lat // GRID_W
    win_h = min(NA_WIN_H, rows)
    scale = hd ** -0.5
    qg = q_lat.reshape(bsz, rows, GRID_W, nh, hd)
    kg = k_lat.reshape(bsz, rows, GRID_W, nh, hd)
    vg = v_lat.reshape(bsz, rows, GRID_W, nh, hd)
    col = jnp.arange(GRID_W)
    col_start = jnp.clip(col - NA_WIN_W // 2, 0, GRID_W - NA_WIN_W)
    col_mask = (col[None, :] >= col_start[:, None]) & (col[None, :] < col_start[:, None] + NA_WIN_W)
    col_off = jnp.clip(col[None, :] - col[:, None], -(NA_WIN_W - 1), NA_WIN_W - 1) + (NA_WIN_W - 1)
    rpb_cols = rpb[:, :, col_off]

    def row_block(args):
        r, q_row = args
        r_start = jnp.clip(r - win_h // 2, 0, rows - win_h)
        kb = lax.dynamic_slice_in_dim(kg, r_start, win_h, axis=1)
        vb = lax.dynamic_slice_in_dim(vg, r_start, win_h, axis=1)
        row_off = r_start + jnp.arange(win_h) - r + (NA_WIN_H - 1)
        bias = rpb_cols[:, row_off].transpose(0, 2, 1, 3)
        s_loc = jnp.einsum('bqhd,bikhd->bhqik', q_row, kb).astype(jnp.float32) * scale + bias[None]
        s_loc = jnp.where(col_mask[None, None, :, None, :], s_loc, -jnp.inf)
        s_loc = s_loc.reshape(bsz, nh, GRID_W, win_h * GRID_W)
        s_ctx = jnp.einsum('bqhd,bchd->bhqc', q_row, k_ctx).astype(jnp.float32) * scale
        p = jax.nn.softmax(jnp.concatenate([s_loc, s_ctx], axis=-1), axis=-1).astype(vb.dtype)
        p_loc = p[..., :win_h * GRID_W].reshape(bsz, nh, GRID_W, win_h, GRID_W)
        p_ctx = p[..., win_h * GRID_W:]
        return (jnp.einsum('bhqik,bikhd->bqhd', p_loc, vb)
                + jnp.einsum('bhqc,bchd->bqhd', p_ctx, v_ctx))

    out = lax.map(row_block, (jnp.arange(rows), qg.transpose(1, 0, 2, 3, 4)))
    return out.transpose(1, 0, 2, 3, 4).reshape(bsz, n_lat, nh * hd)


def _recurrence_combine(left, right):
    a_l, b_l = left
    a_r, b_r = right
    return (a_l * a_r, a_r * b_l + b_r)


def s5_bidirectional(u_ctx, u_lat, lam_re, lam_im, log_dt, b_re, b_im, c_re, c_im, d_skip, need_ctx):
    f32 = jnp.float32
    n_ctx = u_ctx.shape[1]
    n_lat = u_lat.shape[1]

    def scan_direction(seq, d):
        lam = lax.complex(lam_re[d].astype(f32), lam_im[d].astype(f32))
        dt = jnp.exp(log_dt[d].astype(f32))[:, None]
        lam_bar = jnp.exp(lam * dt)
        b_bar = ((lam_bar - 1.0) / lam)[..., None] * lax.complex(b_re[d].astype(f32), b_im[d].astype(f32))
        bsz, length, _ = seq.shape
        ug = seq.astype(f32).reshape(bsz, length, SSM_GROUPS, SSM_GROUP)
        bu = jnp.einsum('blgh,gph->blgp', ug.astype(jnp.complex64), b_bar)
        a = jnp.broadcast_to(lam_bar, (1, length, SSM_GROUPS, SSM_STATE))
        _, states = lax.associative_scan(_recurrence_combine, (a, bu), axis=1)
        return states

    def readout(states, d):
        cm = lax.complex(c_re[d].astype(f32), c_im[d].astype(f32))
        y = jnp.einsum('blgp,ghp->blgh', states, cm).real
        return y.reshape(y.shape[0], y.shape[1], SSM_WIDTH)

    st_f = scan_direction(jnp.concatenate([u_ctx, u_lat], axis=1), 0)
    st_b = jnp.flip(scan_direction(jnp.flip(jnp.concatenate([u_lat, u_ctx], axis=1), axis=1), 1), axis=1)
    dsk = d_skip.astype(f32)
    y_lat = (readout(st_f[:, n_ctx:], 0) + readout(st_b[:, :n_lat], 1)
             + dsk * u_lat.astype(f32)).astype(u_lat.dtype)
    y_ctx = None
    if need_ctx:
        y_ctx = (readout(st_f[:, :n_ctx], 0) + readout(st_b[:, n_lat:], 1)
                 + dsk * u_ctx.astype(f32)).astype(u_ctx.dtype)
    return y_ctx, y_lat


def glu(y, w_glu):
    z = jax.nn.gelu(y)
    return z * jax.nn.sigmoid(z @ w_glu)


def gated_merge(branches, gates, w_branch, w_out):
    b, l, _ = gates.shape
    g = jax.nn.sigmoid(gates.reshape(b, l, N_BRANCH, D_MODEL))
    merged = g[:, :, 0] * (branches[0] @ w_branch[0])
    for i in range(1, N_BRANCH):
        merged = merged + g[:, :, i] * (branches[i] @ w_branch[i])
    return merged @ w_out


def hybrid_mixer(h_ctx, h_lat, cos, sin, w_in, lam_re, lam_im, log_dt, b_re, b_im, c_re, c_im,
                 d_skip, w_glu, q_norm_g, k_norm_g, rpb, w_branch, w_out, need_ctx):
    bsz, n_ctx, _ = h_ctx.shape
    proj = jnp.concatenate([h_ctx, h_lat], axis=1) @ w_in
    splits = [int(v) for v in np.cumsum(IN_WIDTHS)[:-1]]
    u, qa, ka, va, qn, kn, vn, gates = jnp.split(proj, splits, axis=-1)
    cpart = lambda t: t[:, :n_ctx]
    lpart = lambda t: t[:, n_ctx:]
    heads = lambda t, n: t.reshape(t.shape[0], t.shape[1], n, HEAD_DIM)

    ssm_ctx, ssm_lat = s5_bidirectional(cpart(u), lpart(u), lam_re, lam_im, log_dt, b_re, b_im,
                                        c_re, c_im, d_skip, need_ctx)
    qa_h = rmsnorm(heads(qa, GQA_HEADS), q_norm_g)
    ka_h = rmsnorm(heads(ka, GQA_KV_HEADS), k_norm_g)
    va_h = heads(va, GQA_KV_HEADS)
    gqa_lat = gqa_latent(apply_axial_rope(lpart(qa_h), cos, sin), cpart(ka_h), cpart(va_h),
                         apply_axial_rope(lpart(ka_h), cos, sin), lpart(va_h))
    qn_h, kn_h, vn_h = heads(qn, NA_HEADS), heads(kn, NA_HEADS), heads(vn, NA_HEADS)
    na_lat = neighborhood_attention(lpart(qn_h), lpart(kn_h), lpart(vn_h), cpart(kn_h), cpart(vn_h), rpb)

    y_lat = gated_merge([glu(ssm_lat, w_glu), gqa_lat, na_lat], lpart(gates), w_branch, w_out)
    y_ctx = None
    if need_ctx:
        gqa_ctx = dense_attend(cpart(qa_h), cpart(ka_h), cpart(va_h))
        na_ctx = dense_attend(cpart(qn_h), cpart(kn_h), cpart(vn_h))
        y_ctx = gated_merge([glu(ssm_ctx, w_glu), gqa_ctx, na_ctx], cpart(gates), w_branch, w_out)
    return y_ctx, y_lat


def moe_ffn(h, router_w, router_b, w_gate, w_up, w_down):
    probs = jax.nn.softmax((h @ router_w).astype(jnp.float32), axis=-1)
    sel = probs + router_b.astype(jnp.float32)
    grp = sel.reshape(-1, N_EXPERT_GROUPS, EXPERTS_PER_GROUP)
    grp_score = jnp.sum(lax.top_k(grp, TOP_K)[0], axis=-1)
    best = jnp.argmax(grp_score, axis=-1)
    in_grp = (jnp.arange(N_EXPERTS) // EXPERTS_PER_GROUP)[None, :] == best[:, None]
    _, idx = lax.top_k(jnp.where(in_grp, sel, -jnp.inf), TOP_K)
    w_sel = jnp.take_along_axis(probs, idx, axis=-1)
    w_sel = w_sel / jnp.sum(w_sel, axis=-1, keepdims=True)
    combine = jnp.sum(jax.nn.one_hot(idx, N_EXPERTS, dtype=jnp.float32) * w_sel[..., None], axis=1)
    combine = combine.astype(h.dtype)
    out = jnp.zeros_like(h)
    for e in range(N_EXPERTS):
        y_e = (jax.nn.silu(h @ w_gate[e]) * (h @ w_up[e])) @ w_down[e]
        out = out + combine[:, e:e + 1] * y_e
    return out


def setup_inputs(seed: int = 0) -> dict:
    key = jax.random.key(seed)
    ks = jax.random.split(key, 32)
    f32 = jnp.float32
    nrm = lambda k, shape, scale: jax.random.normal(k, shape, f32) * scale
    lam_shape = (DEPTH, 2, SSM_GROUPS, SSM_STATE)
    n_idx = jnp.arange(SSM_STATE, dtype=f32)
    return {
        "x": nrm(ks[0], (BATCH, SEQ, D_MODEL), 1.0),
        "c": nrm(ks[1], (BATCH, D_MODEL), 1.0),
        "ctx": nrm(ks[2], (BATCH, CTX_LEN, D_MODEL), 1.0),
        "c_ctx": nrm(ks[3], (D_MODEL,), 1.0),
        "w_mod": nrm(ks[4], (DEPTH, D_MODEL, 6 * D_MODEL), 0.5 * D_MODEL ** -0.5),
        "b_mod": nrm(ks[5], (DEPTH, 6 * D_MODEL), 0.02),
        "norm1_g": 1.0 + nrm(ks[6], (DEPTH, D_MODEL), 0.02),
        "norm2_g": 1.0 + nrm(ks[7], (DEPTH, D_MODEL), 0.02),
        "w_in": nrm(ks[8], (DEPTH, D_MODEL, IN_WIDTH), D_MODEL ** -0.5),
        "ssm_lam_re": -0.5 * jnp.exp(nrm(ks[9], lam_shape, 0.05)),
        "ssm_lam_im": math.pi * n_idx + nrm(ks[10], lam_shape, 0.01),
        "ssm_log_dt": jax.random.uniform(ks[11], (DEPTH, 2, SSM_GROUPS), f32, math.log(DT_MIN), math.log(DT_MAX)),
        "ssm_b_re": nrm(ks[12], (DEPTH, 2, SSM_GROUPS, SSM_STATE, SSM_GROUP), (2 * SSM_GROUP) ** -0.5),
        "ssm_b_im": nrm(ks[13], (DEPTH, 2, SSM_GROUPS, SSM_STATE, SSM_GROUP), (2 * SSM_GROUP) ** -0.5),
        "ssm_c_re": nrm(ks[14], (DEPTH, 2, SSM_GROUPS, SSM_GROUP, SSM_STATE), SSM_STATE ** -0.5),
        "ssm_c_im": nrm(ks[15], (DEPTH, 2, SSM_GROUPS, SSM_GROUP, SSM_STATE), SSM_STATE ** -0.5),
        "ssm_d": nrm(ks[16], (DEPTH, SSM_WIDTH), 1.0),
        "ssm_w_glu": nrm(ks[17], (DEPTH, SSM_WIDTH, SSM_WIDTH), SSM_WIDTH ** -0.5),
        "gqa_q_norm_g": 1.0 + nrm(ks[18], (DEPTH, HEAD_DIM), 0.02),
        "gqa_k_norm_g": 1.0 + nrm(ks[19], (DEPTH, HEAD_DIM), 0.02),
        "na_rpb": nrm(ks[20], (DEPTH, NA_HEADS, 2 * NA_WIN_H - 1, 2 * NA_WIN_W - 1), 0.1),
        "w_branch": nrm(ks[21], (DEPTH, N_BRANCH, SSM_WIDTH, D_MODEL), SSM_WIDTH ** -0.5),
        "w_out": nrm(ks[22], (DEPTH, D_MODEL, D_MODEL), D_MODEL ** -0.5),
        "router_w": nrm(ks[23], (D_MODEL, N_EXPERTS), D_MODEL ** -0.5),
        "router_b": nrm(ks[24], (N_EXPERTS,), 0.01),
        "moe_w_gate": nrm(ks[25], (DEPTH, N_EXPERTS, D_MODEL, EXPERT_FF), D_MODEL ** -0.5),
        "moe_w_up": nrm(ks[26], (DEPTH, N_EXPERTS, D_MODEL, EXPERT_FF), D_MODEL ** -0.5),
        "moe_w_down": nrm(ks[27], (DEPTH, N_EXPERTS, EXPERT_FF, D_MODEL), EXPERT_FF ** -0.5),
        "final_norm_g": 1.0 + nrm(ks[28], (D_MODEL,), 0.02),
    }


def reference(x, c, ctx, c_ctx, w_mod, b_mod, norm1_g, norm2_g, w_in,
              ssm_lam_re, ssm_lam_im, ssm_log_dt, ssm_b_re, ssm_b_im, ssm_c_re, ssm_c_im,
              ssm_d, ssm_w_glu, gqa_q_norm_g, gqa_k_norm_g, na_rpb, w_branch, w_out,
              router_w, router_b, moe_w_gate, moe_w_up, moe_w_down, final_norm_g):
    bsz, n_lat, d_model = x.shape
    n_ctx = ctx.shape[1]
    cos, sin = axial_rope_tables(n_lat)
    cond_lat = jax.nn.silu(c)
    cond_ctx = jax.nn.silu(c_ctx)
    for layer in range(DEPTH):
        need_ctx = layer < DEPTH - 1
        sh1, sc1, g1, sh2, sc2, g2 = jnp.split((cond_lat @ w_mod[layer] + b_mod[layer])[:, None, :], 6, axis=-1)
        csh1, csc1, cg1, csh2, csc2, cg2 = jnp.split(cond_ctx @ w_mod[layer] + b_mod[layer], 6, axis=-1)
        h_lat = modulate(rmsnorm(x, norm1_g[layer]), sh1, sc1)
        h_ctx = modulate(rmsnorm(ctx, norm1_g[layer]), csh1, csc1)
        y_ctx, y_lat = hybrid_mixer(h_ctx, h_lat, cos, sin, w_in[layer],
                                    ssm_lam_re[layer], ssm_lam_im[layer], ssm_log_dt[layer],
                                    ssm_b_re[layer], ssm_b_im[layer], ssm_c_re[layer], ssm_c_im[layer],
                                    ssm_d[layer], ssm_w_glu[layer], gqa_q_norm_g[layer], gqa_k_norm_g[layer],
                                    na_rpb[layer], w_branch[layer], w_out[layer], need_ctx)
        x = x + g1 * y_lat
        h_lat = modulate(rmsnorm(x, norm2_g[layer]), sh2, sc2).reshape(-1, d_model)
        if need_ctx:
            ctx = ctx + cg1 * y_ctx
            h_ctx = modulate(rmsnorm(ctx, norm2_g[layer]), csh2, csc2).reshape(-1, d_model)
            y = moe_ffn(jnp.concatenate([h_ctx, h_lat], axis=0), router_w, router_b,
                        moe_w_gate[layer], moe_w_up[layer], moe_w_down[layer])
            ctx = ctx + cg2 * y[:bsz * n_ctx].reshape(ctx.shape)
            y = y[bsz * n_ctx:]
        else:
            y = moe_ffn(h_lat, router_w, router_b, moe_w_gate[layer], moe_w_up[layer], moe_w_down[layer])
        x = x + g2 * y.reshape(x.shape)
    return rmsnorm(x, final_norm_g)
```

```cpp
#include <hip/hip_runtime.h>
#include <cstdio>
#include <cstdint>

#define GAS __attribute__((address_space(1)))
#define LAS __attribute__((address_space(3)))
typedef unsigned short bf16;
typedef unsigned v4u __attribute__((ext_vector_type(4)));
typedef unsigned v2u __attribute__((ext_vector_type(2)));
typedef float f32x4 __attribute__((ext_vector_type(4)));
typedef float f32x2 __attribute__((ext_vector_type(2)));
typedef float f32x16 __attribute__((ext_vector_type(16)));
typedef short bf16x8 __attribute__((ext_vector_type(8)));
typedef short s16x4 __attribute__((ext_vector_type(4)));
typedef GAS unsigned gu32;
#define RLX_AGENT __ATOMIC_RELAXED, __HIP_MEMORY_SCOPE_AGENT
#define LDS_WAIT() asm volatile("s_waitcnt lgkmcnt(0)" ::: "memory")
#define VM_WAIT() asm volatile("s_waitcnt vmcnt(0)" ::: "memory")

constexpr int NB = 4, SEQ = 8192, CTX = 256, LB = SEQ + CTX, T = NB * LB, D = 1024, NPAN = T / 256;
constexpr int NLAYER = 4, INW = 5888, NCH = LB / 32, NCR = NB * NCH;
constexpr int NEXP = 16, FF = 512;
constexpr float EPS = 1e-6f;
constexpr float LOG2E = 1.4426950408889634f;
constexpr float C2 = 0.125f * LOG2E;
constexpr int NWAVES = 8;

constexpr size_t MiB = 1u << 20;
constexpr size_t WS_CTL = 0, CTL_ZERO_BYTES = 1 * MiB;
constexpr size_t WS_MOD = 1 * MiB;
constexpr size_t WS_LIST = 2 * MiB;
constexpr size_t WS_RW = 5 * MiB;
constexpr size_t WS_CTXS = 6 * MiB;
constexpr size_t WS_SST = 10 * MiB;
constexpr size_t WS_XST = 44 * MiB;
constexpr size_t WS_BT1 = 61 * MiB;
constexpr size_t WS_BT2 = 85 * MiB;
constexpr size_t WS_WIN = 93 * MiB;
constexpr size_t WS_WGLU = 105 * MiB;
constexpr size_t WS_WBR = 106 * MiB;
constexpr size_t WS_WOUT = 109 * MiB;
constexpr size_t WS_MOE1 = 111 * MiB;
constexpr size_t WS_MOE2 = 143 * MiB;
constexpr size_t WS_HB = 159 * MiB;
constexpr size_t WS_U = 225 * MiB;
constexpr size_t WS_QA = 258 * MiB;
constexpr size_t WS_KA = 291 * MiB;
constexpr size_t WS_VA = 300 * MiB;
constexpr size_t WS_QN = 309 * MiB;
constexpr size_t WS_KN = 342 * MiB;
constexpr size_t WS_VN = 375 * MiB;
constexpr size_t WS_YS = 408 * MiB;
constexpr size_t WS_GATES = 441 * MiB;
constexpr size_t WS_ACT = WS_QN;
constexpr size_t WS_YSLOT = WS_GATES;
constexpr size_t WS_END = 640 * MiB;
static_assert(WS_GATES + (size_t)T * 3072 * 2 <= WS_END && WS_ACT + (size_t)(2 * T + 4096) * 512 * 2 <= WS_YS, "ws map");
constexpr int CW_FAIL = 8;
constexpr int CW_CNT = 64;
constexpr int CW_BAR = 8192;

constexpr int RING_BYTES = 131072, LDSCTL_OFF = RING_BYTES, MISC_OFF = LDSCTL_OFF + 320, LDS_BYTES = 147456;

__device__ __forceinline__ unsigned f2bf(float f) { unsigned u = __builtin_bit_cast(unsigned, f); return (u + 0x7fffu + ((u >> 16) & 1u)) >> 16; }
__device__ __forceinline__ unsigned pk2(float lo, float hi) { return f2bf(lo) | (f2bf(hi) << 16); }
__device__ __forceinline__ float bf2f(unsigned b) { return __builtin_bit_cast(float, b << 16); }
__device__ __forceinline__ float bflo(unsigned w) { return __builtin_bit_cast(float, w << 16); }
__device__ __forceinline__ float bfhi(unsigned w) { return __builtin_bit_cast(float, w & 0xffff0000u); }
__device__ __forceinline__ unsigned cvt_pk_bf16(float lo, float hi) { unsigned r; asm volatile("v_cvt_pk_bf16_f32 %0, %1, %2" : "=v"(r) : "v"(lo), "v"(hi)); return r; }
__device__ __forceinline__ float fsigmoid(float x) { return __builtin_amdgcn_rcpf(1.f + __builtin_amdgcn_exp2f(-LOG2E * x)); }
__device__ __forceinline__ float gelu_tanh(float x) { const float u = 0.7978845608f * (x + 0.044715f * x * x * x); return x * __builtin_amdgcn_rcpf(1.f + __builtin_amdgcn_exp2f(-2.f * LOG2E * u)); }
__device__ __forceinline__ float shflx(float v, int m, int lane) { return __builtin_bit_cast(float, __builtin_amdgcn_ds_bpermute((lane ^ m) << 2, __builtin_bit_cast(int, v))); }
__device__ __forceinline__ float wave_sum(float v, int lane) {
#pragma unroll
    for (int o = 1; o < 64; o <<= 1) v += shflx(v, o, lane);
    return v;
}
__device__ __forceinline__ float sin_rev(float r) { r = r - floorf(r); return __builtin_amdgcn_sinf(r); }
__device__ __forceinline__ float cos_rev(float r) { r = r - floorf(r); return __builtin_amdgcn_cosf(r); }

#define XB_TMO      128
#define XB_XCNT(j)  (256  + 64 * (j))
#define XB_XSUB(j)  (1280 + 64 * (j))
#define XB_XGEN(j)  (2304 + 64 * (j))
#define XB_TOP      3328
#define XB_TOPGEN   3392
#define XCD_BAR_WORDS 3456
#define XB_SPIN_CAP (1u << 22)

__device__ __forceinline__ unsigned xb_ld(unsigned* p)              { return __hip_atomic_load(p, __ATOMIC_RELAXED, __HIP_MEMORY_SCOPE_AGENT); }
__device__ __forceinline__ unsigned xb_add(unsigned* p, unsigned v) { return __hip_atomic_fetch_add(p, v, __ATOMIC_RELAXED, __HIP_MEMORY_SCOPE_AGENT); }
__device__ __forceinline__ unsigned xb_xcc_id() { return (unsigned)__builtin_amdgcn_s_getreg((3 << 11) | 20) & 0xFu; }
#define XB_SPIN(cond, bar) do { unsigned _sp = 0; while (cond) { __builtin_amdgcn_s_sleep(1); \
    if ((++_sp & 255u) == 0u) { if (xb_ld(&(bar)[XB_TMO])) break; if (_sp > XB_SPIN_CAP) { atomicAdd(&(bar)[XB_TMO], 1u); break; } } } } while (0)

struct XcdBarrier { unsigned* bar; unsigned x; volatile LAS unsigned* st; };

__device__ __forceinline__ XcdBarrier xcd_barrier_post(unsigned* bar, volatile LAS unsigned* st) {
    XcdBarrier b; b.bar = bar; b.x = xb_xcc_id(); b.st = st;
    if (threadIdx.x == 0) (void)xb_add(&bar[XB_XCNT(b.x)], 1u);
    return b;
}
__device__ __forceinline__ void xcd_barrier_complete(unsigned* bar, unsigned x, unsigned& nloc, unsigned& nx) {
    const unsigned G = gridDim.x * gridDim.y * gridDim.z;
    unsigned sum, cnt, mine, sp = 0u;
    for (;;) {
        sum = 0u; cnt = 0u; mine = 0u;
#pragma unroll
        for (unsigned j = 0; j < 16; ++j) { const unsigned c = xb_ld(&bar[XB_XCNT(j)]); sum += c; cnt += (c > 0u) ? 1u : 0u; mine = (j == x) ? c : mine; }
        if (sum == G) break;
        __builtin_amdgcn_s_sleep(1);
        if ((++sp & 255u) == 0u) { if (xb_ld(&bar[XB_TMO])) break; if (sp > XB_SPIN_CAP) { atomicAdd(&bar[XB_TMO], 1u); break; } }
    }
    nloc = mine > 0u ? mine : 1u; nx = cnt > 0u ? cnt : 1u;
}
__device__ __forceinline__ void xcd_barrier(const XcdBarrier& b) {
    asm volatile("s_waitcnt vmcnt(0)" ::: "memory");
    __syncthreads();
    if (threadIdx.x == 0) {
        unsigned* bar = b.bar;
        __builtin_amdgcn_s_waitcnt(0);
        unsigned nloc = b.st[0], nx = b.st[1];
        if (nloc == 0u) { xcd_barrier_complete(bar, b.x, nloc, nx); b.st[0] = nloc; b.st[1] = nx; }
        const unsigned old = xb_add(&bar[XB_XSUB(b.x)], 1u);
        const unsigned gen = old / nloc;
        if (old + 1u == (gen + 1u) * nloc) {
            __builtin_amdgcn_fence(__ATOMIC_RELEASE, "agent");
            asm volatile("s_waitcnt vmcnt(0)" ::: "memory");
            const unsigned og = xb_add(&bar[XB_TOP], 1u);
            const unsigned tg = og / nx;
            if (og + 1u == (tg + 1u) * nx) xb_add(&bar[XB_TOPGEN], 1u);
            else XB_SPIN(xb_ld(&bar[XB_TOPGEN]) == tg, bar);
            __builtin_amdgcn_fence(__ATOMIC_ACQUIRE, "agent");
            xb_add(&bar[XB_XGEN(b.x)], 1u);
            asm volatile("s_waitcnt vmcnt(0)" ::: "memory");
        } else {
            XB_SPIN(xb_ld(&bar[XB_XGEN(b.x)]) == gen, bar);
            __builtin_amdgcn_fence(__ATOMIC_ACQUIRE, "agent");
            asm volatile("s_waitcnt vmcnt(0)" ::: "memory");
        }
    }
    __syncthreads();
}

namespace pg8 {
constexpr int BM = 256, BK = 64, HALF = 128, HTB = HALF * BK * 2, STAGE_BYTES = 8 * HTB, NXCD = 8, WGM = 8;
__host__ __device__ __forceinline__ int lds_byte(int r, int c) { const int st = (r >> 4) * 2 + (c >> 5), rr = r & 15, cc = c & 31, ob = rr * 64 + cc * 2; return st * 1024 + (ob ^ (((ob >> 9) & 1) << 5)); }
__host__ __device__ __forceinline__ void stage_rc(int b, int& R, int& C) { const int st = b / 1024, sb = b % 1024, swz = sb ^ (((sb >> 9) & 1) << 5); R = (st >> 1) * 16 + swz / 64; C = (st & 1) * 32 + (swz % 64) / 2; }
__host__ __device__ __forceinline__ int perm32(int rho) { const int n = rho >> 4, i = rho & 15; return 8 * (i >> 2) + 4 * n + (i & 3); }

struct Unit { int pm, pn, z; };

__device__ __forceinline__ void static_decode(int L, int nM, int nN, int& pm, int& pn) {
    const int nwg = nM * nN; int wgid = L;
    { const int q = nwg / NXCD, r = nwg % NXCD, xcd = wgid % NXCD, off = wgid / NXCD; wgid = (xcd < r ? xcd * (q + 1) : r * (q + 1) + (xcd - r) * q) + off; }
    const int nig = WGM * nN, gid = wgid / nig, fm = gid * WGM, gsz = (nM - fm) < WGM ? (nM - fm) : WGM;
    pm = fm + ((wgid % nig) % gsz); pn = (wgid % nig) / gsz;
}

template <class P>
__device__ __forceinline__ void gemm_phase(LAS unsigned char* lds, const P& S) {
    int tid_ = threadIdx.x; asm volatile("" : "+v"(tid_));
    const int tid = tid_, wid = __builtin_amdgcn_readfirstlane(tid >> 6), lane = tid & 63, wr = wid >> 2, wc = wid & 3, fr = lane & 15, fq = lane >> 4;
    const int K = S.K, nt = K / BK;
    unsigned voffB[2];
#pragma unroll
    for (int i = 0; i < 2; ++i) { int R, C; stage_rc(tid * 16 + i * 8192, R, C); const int Rb = (R & ~31) + perm32(R & 31); voffB[i] = (unsigned)(Rb * K + C) * 2u; }
#define PG8_AOFF(dst0, dst1, u) do { _Pragma("unroll") for (int i = 0; i < 2; ++i) { int R, C; stage_rc(tid * 16 + i * 8192, R, C); dst0[i] = S.a_off(u, 0, R, C); dst1[i] = S.a_off(u, 1, R, C); } } while (0)
    const size_t kstepB = (size_t)(BK * 2), hstepB = (size_t)HALF * K * 2, kstepA = (size_t)S.kstepA;
    const unsigned ldsw = (unsigned)wid * 1024u;
    const int aoff = lds_byte(wr * 64 + fr, fq * 8), boff = lds_byte(wc * 32 + fr, fq * 8);
#define PG8_SA(b, h) (((b) * 2 + (h)) * HTB)
#define PG8_SB(b, h) ((4 + (b) * 2 + (h)) * HTB)
#define PG8_STAGE(bufoff, gbase, voff) do { _Pragma("unroll") for (int _i = 0; _i < 2; ++_i) \
        __builtin_amdgcn_global_load_lds((const unsigned*)((const char*)(gbase) + (voff)[_i]), (LAS unsigned*)(lds + (bufoff) + ldsw + _i * 8192), 16, 0, 0); } while (0)
#define PG8_LDA(dst, b, h) do { _Pragma("unroll") for (int m = 0; m < 4; ++m) _Pragma("unroll") for (int k = 0; k < 2; ++k) dst[m][k] = *(const LAS bf16x8*)(lds + PG8_SA(b, h) + aoff + m * 2048 + k * 1024); } while (0)
#define PG8_LDB(dst, b, h) do { _Pragma("unroll") for (int n = 0; n < 2; ++n) _Pragma("unroll") for (int k = 0; k < 2; ++k) dst[n][k] = *(const LAS bf16x8*)(lds + PG8_SB(b, h) + boff + n * 2048 + k * 1024); } while (0)
#define PG8_MMA(ai, bj, At, Bt) do { __builtin_amdgcn_s_setprio(1); _Pragma("unroll") for (int m = 0; m < 4; ++m) _Pragma("unroll") for (int n = 0; n < 2; ++n) _Pragma("unroll") for (int k = 0; k < 2; ++k) \
        acc[ai][bj][m][n] = __builtin_amdgcn_mfma_f32_16x16x32_bf16(Bt[n][k], At[m][k], acc[ai][bj][m][n], 0, 0, 0); __builtin_amdgcn_s_setprio(0); } while (0)
#define PG8_WAIT_V(n) asm volatile("s_waitcnt vmcnt(" #n ")" ::: "memory")
#define PG8_WAIT_L(n) asm volatile("s_waitcnt lgkmcnt(" #n ")" ::: "memory")
#define PG8_BAR __builtin_amdgcn_s_barrier()
#define PG8_SCHED __builtin_amdgcn_sched_barrier(0)
    Unit cur, nxt; int ui = 0;
    if (!S.next(0, cur)) return;
    f32x4 acc[2][2][4][2];
#pragma unroll
    for (int a = 0; a < 2; ++a)
#pragma unroll
        for (int b = 0; b < 2; ++b)
#pragma unroll
            for (int m = 0; m < 4; ++m)
#pragma unroll
                for (int n = 0; n < 2; ++n) acc[a][b][m][n] = (f32x4){0.f, 0.f, 0.f, 0.f};
    bf16x8 At[4][2], B0[2][2], B1[2][2];
    unsigned vA0[2], vA1[2], vN0[2], vN1[2];
    PG8_AOFF(vA0, vA1, cur);
    const char* cA = S.a_base(cur); const char* cB = S.b_base(cur);
    PG8_STAGE(PG8_SB(0, 0), cB, voffB); PG8_STAGE(PG8_SB(0, 1), cB + hstepB, voffB); PG8_STAGE(PG8_SA(0, 0), cA, vA0); PG8_STAGE(PG8_SA(0, 1), cA, vA1);
    if (wr == 1) PG8_BAR;
    PG8_WAIT_V(2); PG8_BAR;
    PG8_STAGE(PG8_SB(1, 0), cB + kstepB, voffB); PG8_STAGE(PG8_SA(1, 0), cA + kstepA, vA0); PG8_STAGE(PG8_SB(1, 1), cB + hstepB + kstepB, voffB);
    PG8_WAIT_V(6); PG8_BAR;
    for (;;) {
        const bool has_next = S.next(ui + 1, nxt);
        const char* nA = cA; const char* nB = cB;
#pragma unroll
        for (int i = 0; i < 2; ++i) { vN0[i] = vA0[i]; vN1[i] = vA1[i]; }
        if (has_next) { nA = S.a_base(nxt); nB = S.b_base(nxt); PG8_AOFF(vN0, vN1, nxt); }
        for (int t = 0; t < nt; t += 2) {
            const bool last = (t == nt - 2);
            const char* a1 = cA + (size_t)(t + 1) * kstepA;
            const char* a2 = last ? nA : cA + (size_t)(t + 2) * kstepA; const char* b2 = last ? nB : cB + (size_t)(t + 2) * kstepB;
            const char* a3 = a2 + kstepA; const char* b3 = b2 + kstepB;
            unsigned w0[2], w1[2];
#pragma unroll
            for (int i = 0; i < 2; ++i) { w0[i] = last ? vN0[i] : vA0[i]; w1[i] = last ? vN1[i] : vA1[i]; }
            PG8_LDB(B0, 0, 0); PG8_LDB(B1, 0, 1); PG8_SCHED; PG8_LDA(At, 0, 0); PG8_STAGE(PG8_SA(1, 1), a1, vA1);
            PG8_WAIT_V(8); PG8_WAIT_L(0); PG8_BAR; PG8_MMA(0, 0, At, B0); PG8_MMA(0, 1, At, B1); PG8_BAR; PG8_SCHED;
            PG8_LDA(At, 0, 1); PG8_STAGE(PG8_SB(0, 0), b2, voffB); PG8_STAGE(PG8_SB(0, 1), b2 + hstepB, voffB); PG8_STAGE(PG8_SA(0, 0), a2, w0);
            PG8_WAIT_V(8); PG8_WAIT_L(0); PG8_BAR; PG8_MMA(1, 0, At, B0); PG8_MMA(1, 1, At, B1); PG8_BAR; PG8_SCHED;
            PG8_LDB(B0, 1, 0); PG8_LDB(B1, 1, 1); PG8_SCHED; PG8_LDA(At, 1, 0); PG8_STAGE(PG8_SA(0, 1), a2, w1);
            PG8_WAIT_V(8); PG8_WAIT_L(0); PG8_BAR; PG8_MMA(0, 0, At, B0); PG8_MMA(0, 1, At, B1); PG8_BAR; PG8_SCHED;
            PG8_LDA(At, 1, 1); PG8_STAGE(PG8_SB(1, 0), b3, voffB); PG8_STAGE(PG8_SB(1, 1), b3 + hstepB, voffB); PG8_STAGE(PG8_SA(1, 0), a3, w0);
            PG8_WAIT_V(8); PG8_WAIT_L(0); PG8_BAR; PG8_MMA(1, 0, At, B0); PG8_MMA(1, 1, At, B1); PG8_BAR; PG8_SCHED;
        }
        if (wr == 0) PG8_BAR;
        S.epi(acc, cur, wr, wc, fr, fq);
        if (!has_next) break;
#pragma unroll
        for (int a = 0; a < 2; ++a)
#pragma unroll
            for (int b = 0; b < 2; ++b)
#pragma unroll
                for (int m = 0; m < 4; ++m)
#pragma unroll
                    for (int n = 0; n < 2; ++n) acc[a][b][m][n] = (f32x4){0.f, 0.f, 0.f, 0.f};
        cur = nxt; cA = nA; cB = nB; ++ui;
#pragma unroll
        for (int i = 0; i < 2; ++i) { vA0[i] = vN0[i]; vA1[i] = vN1[i]; }
        if (wr == 1) PG8_BAR;
    }
    PG8_WAIT_V(0);
    PG8_BAR;
#undef PG8_AOFF
#undef PG8_SA
#undef PG8_SB
#undef PG8_STAGE
#undef PG8_LDA
#undef PG8_LDB
#undef PG8_MMA
#undef PG8_WAIT_V
#undef PG8_WAIT_L
#undef PG8_BAR
#undef PG8_SCHED
}
}
namespace attn_body {
using bf16x8 = __attribute__((ext_vector_type(8))) short;
using u32x4 = __attribute__((ext_vector_type(4))) unsigned;
constexpr int NW = 8, QBLK = 32, QB = QBLK * NW, KVBLK = 64;
__device__ __forceinline__ int crow(int r, int hi) { return (r & 3) + 8 * (r >> 2) + 4 * hi; }
#define SBAR() __builtin_amdgcn_sched_barrier(0)
constexpr int NSLOT = 3, SLOTB = 8192;
constexpr int LDS_K = 0, LDS_V = NSLOT * SLOTB, LDS_WS = 2 * NSLOT * SLOTB, LDS_OST = LDS_WS + NW * 64 * 4, LDS_BYTES = LDS_OST + NW * 4096;
constexpr int LDS_BT = 86016 + 256;
__device__ __forceinline__ void glds16(const void* gsrc, unsigned lds_dst) { unsigned keep;
  asm volatile("s_mov_b32 %0, m0\n\ts_mov_b32 m0, %2\n\ts_nop 0\n\tglobal_load_lds_dwordx4 %1, off\n\ts_mov_b32 m0, %0" : "=&s"(keep) : "v"(gsrc), "s"(lds_dst) : "memory"); }
__device__ __forceinline__ float max3f(float a, float b, float c) { float r; asm("v_max3_f32 %0, %1, %2, %3" : "=v"(r) : "v"(a), "v"(b), "v"(c)); return r; }
__device__ __forceinline__ float max2f(float a, float b) { float r; asm("v_max_f32_e32 %0, %1, %2" : "=v"(r) : "v"(a), "v"(b)); return r; }
__device__ __forceinline__ float fadd_s(float a, float b) { float r; asm("v_add_f32_e32 %0, %1, %2" : "=v"(r) : "v"(a), "v"(b)); return r; }
__device__ __forceinline__ float fsub_s(float a, float b) { float r; asm("v_sub_f32_e32 %0, %1, %2" : "=v"(r) : "v"(a), "v"(b)); return r; }
typedef float f32x2_t __attribute__((ext_vector_type(2))); typedef __bf16 bf16x2_t __attribute__((ext_vector_type(2)));
__device__ __forceinline__ unsigned cvtpk_s(float lo, float hi) { f32x2_t v = {lo, hi}; bf16x2_t b = __builtin_convertvector(v, bf16x2_t); return __builtin_bit_cast(unsigned, b); }
#define WAIT_BAR(N) asm volatile("s_waitcnt vmcnt(" #N ") lgkmcnt(0)\n\ts_barrier" ::: "memory")

__device__ __forceinline__ void qkt(f32x16& p0, f32x16& p1, const char* Kslot, const bf16x8* qr, const f32x16& negm, int r32, int hi) {
  const char* kb = Kslot + hi * 1024 + r32 * 16;
  #pragma unroll
  for (int d0 = 0; d0 < 4; ++d0) {
    const bf16x8 b0 = *reinterpret_cast<const bf16x8*>(kb + d0 * 2048);
    const bf16x8 b1 = *reinterpret_cast<const bf16x8*>(kb + d0 * 2048 + 512);
    if (d0 == 0) { p0 = __builtin_amdgcn_mfma_f32_32x32x16_bf16(b0, qr[0], negm, 0, 0, 0); p1 = __builtin_amdgcn_mfma_f32_32x32x16_bf16(b1, qr[0], negm, 0, 0, 0); }
    else { p0 = __builtin_amdgcn_mfma_f32_32x32x16_bf16(b0, qr[d0], p0, 0, 0, 0); p1 = __builtin_amdgcn_mfma_f32_32x32x16_bf16(b1, qr[d0], p1, 0, 0, 0); } }
}
typedef __attribute__((address_space(3))) const char* lds_cptr;
typedef short v4i16_t __attribute__((ext_vector_type(4)));
__device__ __forceinline__ void kload8(bf16x8* kf, lds_cptr kp) {
  kf[0] = *(const __attribute__((address_space(3))) bf16x8*)(kp);        kf[1] = *(const __attribute__((address_space(3))) bf16x8*)(kp + 512);
  kf[2] = *(const __attribute__((address_space(3))) bf16x8*)(kp + 2048); kf[3] = *(const __attribute__((address_space(3))) bf16x8*)(kp + 2560);
  kf[4] = *(const __attribute__((address_space(3))) bf16x8*)(kp + 4096); kf[5] = *(const __attribute__((address_space(3))) bf16x8*)(kp + 4608);
  kf[6] = *(const __attribute__((address_space(3))) bf16x8*)(kp + 6144); kf[7] = *(const __attribute__((address_space(3))) bf16x8*)(kp + 6656);
}
__device__ __forceinline__ void kload2(bf16x8* kf, lds_cptr kp, int j) { kf[2 * j] = *(const __attribute__((address_space(3))) bf16x8*)(kp + j * 2048); kf[2 * j + 1] = *(const __attribute__((address_space(3))) bf16x8*)(kp + j * 2048 + 512); }
__device__ __forceinline__ s16x4 vtr(lds_cptr p) { return __builtin_bit_cast(s16x4, __builtin_amdgcn_ds_read_tr16_b64_v4i16((__attribute__((address_space(3))) v4i16_t*)p)); }
__device__ __forceinline__ float rowmax(const f32x16& p0, const f32x16& p1) {
  float a = max3f(p0[0], p0[1], p1[0]), b = max3f(p0[2], p0[3], p1[1]); a = max3f(a, p1[2], p1[3]);
  #pragma unroll
  for (int r = 4; r < 16; r += 4) { a = max3f(a, p0[r], p0[r + 1]); b = max3f(b, p0[r + 2], p0[r + 3]); a = max3f(a, p1[r], p1[r + 1]); b = max3f(b, p1[r + 2], p1[r + 3]); }
  const float m = max2f(a, b);
  auto rr = __builtin_amdgcn_permlane32_swap(__float_as_uint(m), __float_as_uint(m), false, false);
  return max2f(__uint_as_float(rr[0]), __uint_as_float(rr[1]));
}
__device__ __forceinline__ void pv(f32x16* o, int vb, bf16x8 pa0, bf16x8 pa1, bf16x8 pa2, bf16x8 pa3) {
  #pragma unroll
  for (int d0 = 0; d0 < 2; ++d0) { s16x4 lo[4], hi[4];
    #pragma unroll
    for (int ks = 0; ks < 4; ++ks) {
      asm volatile("ds_read_b64_tr_b16 %0,%1 offset:%c2" : "=&v"(lo[ks]) : "v"(vb), "i"(d0 * 4096 + ks * 1024) : "memory");
      asm volatile("ds_read_b64_tr_b16 %0,%1 offset:%c2" : "=&v"(hi[ks]) : "v"(vb), "i"(d0 * 4096 + ks * 1024 + 512) : "memory"); }
    asm volatile("s_waitcnt lgkmcnt(0)" ::: "memory"); SBAR();
    #define PK(k) (bf16x8){lo[k][0], lo[k][1], lo[k][2], lo[k][3], hi[k][0], hi[k][1], hi[k][2], hi[k][3]}
    o[d0] = __builtin_amdgcn_mfma_f32_32x32x16_bf16(pa0, PK(0), o[d0], 0, 0, 0);
    o[d0] = __builtin_amdgcn_mfma_f32_32x32x16_bf16(pa1, PK(1), o[d0], 0, 0, 0);
    o[d0] = __builtin_amdgcn_mfma_f32_32x32x16_bf16(pa2, PK(2), o[d0], 0, 0, 0);
    o[d0] = __builtin_amdgcn_mfma_f32_32x32x16_bf16(pa3, PK(3), o[d0], 0, 0, 0);
    #undef PK
  }
}
#define ATTN_STORE16(p, v) (*(u32x4*)(p) = (v))

template <int THRL, bool NA, int QP_, int KVP_>
__device__ __forceinline__ void attn_unit(const bf16* Qu, int qp_rt, const bf16* __restrict__ Kh, const bf16* __restrict__ Vh, int kvp_rt, bf16* Ou, int NT, int r0, int rlo, char* shm) {
  const int qp = QP_ ? QP_ : qp_rt, kvp = KVP_ ? KVP_ : kvp_rt, op = qp;
  int tid_ = threadIdx.x; asm volatile("" : "+v"(tid_));
  const int tid = tid_, lane = tid & 63, r32 = lane & 31, hi = lane >> 5; const int wid = __builtin_amdgcn_readfirstlane(tid >> 6);
  const bf16* Qw = Qu + (long)(wid * QBLK) * qp;
  const unsigned lds0 = (unsigned)(uintptr_t)shm;
  float* wsf = (float*)(shm + LDS_WS) + wid * 64;
  const bf16* ksrc = Kh + (long)lane * kvp + wid * 8;
  const bf16* vsrc = Vh + (long)(16 * (wid & 3) + (lane >> 2)) * kvp + (wid >> 2) * 32 + (lane & 3) * 8;
  const unsigned kdst = lds0 + LDS_K + wid * 1024, vdst = lds0 + LDS_V + wid * 1024;
  #define TROW(t) (NA ? ((t) < 4 ? 64 * (t) : CTX + 64 * ((rlo + (t) - 4) < 127 ? (rlo + (t) - 4) : 127)) : 64 * (t))
  #define DMA_K(t, slot) glds16(ksrc + (long)TROW(t) * kvp, (unsigned)__builtin_amdgcn_readfirstlane(kdst + (slot)))
  #define DMA_V(t, slot) glds16(vsrc + (long)TROW(t) * kvp, (unsigned)__builtin_amdgcn_readfirstlane(vdst + (slot)))
  const int vb0 = (int)(lds0 + LDS_V) + ((lane >> 4) & 1) * 32 + (lane & 3) * 8 + (4 * hi + ((lane & 15) >> 2)) * 64;
  const char* Kbase = shm + LDS_K; bf16x8 kf[8];
  const lds_cptr shm3 = (lds_cptr)shm; const lds_cptr kp0 = shm3 + LDS_K + hi * 1024 + r32 * 16; const lds_cptr vp0 = shm3 + LDS_V + ((lane >> 4) & 1) * 32 + (lane & 3) * 8 + (4 * hi + ((lane & 15) >> 2)) * 64;
  const int rq = r0 + (wid >> 1), qc = 32 * (wid & 1) + r32;
  const int rsw = rq - 4 < 0 ? 0 : (rq - 4 > 120 ? 120 : rq - 4);
  const int cs = qc - 8 < 0 ? 0 : (qc - 8 > 48 ? 48 : qc - 8);
  const __attribute__((address_space(3))) float* btl = (const __attribute__((address_space(3))) float*)(shm3 + LDS_BT) + (15 + 4 * hi - qc);
  DMA_K(0, 0); DMA_V(0, 0); DMA_K(1, SLOTB);
  bf16x8 qr[4];
  #pragma unroll
  for (int d0 = 0; d0 < 4; ++d0) qr[d0] = *reinterpret_cast<const bf16x8*>(&Qw[(long)r32 * qp + d0 * 16 + hi * 8]);
  float mhat = 0.f, l_reg = 0.f; f32x16 o[2]; o[0] = f32x16{}; o[1] = f32x16{}; f32x16 negm = f32x16{}; if (!NA) asm volatile("" : "+v"(negm));
  #define NEGM (NA ? f32x16{} : negm)
  #define CMASK(P0, P1, t) do { if (NA) { if ((t) >= 4) { const int kr_ = rlo + (t) - 4; const int dr_ = kr_ - rsw; \
      if (dr_ < 0 || dr_ >= 8) { _Pragma("unroll") for (int r = 0; r < 16; ++r) { P0[r] = (-__builtin_inff()); P1[r] = (-__builtin_inff()); } } \
      else { const __attribute__((address_space(3))) float* bp_ = btl + (kr_ - rq + 7) * 31; const int kl0_ = 4 * hi - cs; \
        _Pragma("unroll") for (int rg = 0; rg < 4; ++rg) { \
          _Pragma("unroll") for (int rr_ = 0; rr_ < 4; ++rr_) { const int r = rg * 4 + rr_; const int kc_ = (r & 3) + 8 * (r >> 2); const float b0_ = bp_[kc_], b1_ = bp_[kc_ + 32]; \
            const int kl_ = kc_ + kl0_; P0[r] = ((unsigned)kl_ < 16u) ? P0[r] + b0_ : (-__builtin_inff()); P1[r] = ((unsigned)(kl_ + 32) < 16u) ? P1[r] + b1_ : (-__builtin_inff()); } \
          SBAR(); } } } } } while (0)
  bool resc = false;
  #define START(P0, P1) do { const float rm = rowmax(P0, P1); resc = false; \
    { const float dl = rm; mhat = fadd_s(mhat, dl); \
      _Pragma("unroll") for (int r = 0; r < 16; ++r) { P0[r] = fsub_s(P0[r], dl); P1[r] = fsub_s(P1[r], dl); } \
      if (!NA) { _Pragma("unroll") for (int r = 0; r < 16; ++r) negm[r] = -mhat; asm volatile("" : "+v"(negm)); } } \
    _Pragma("unroll") for (int r = 0; r < 16; ++r) P0[r] = __builtin_amdgcn_exp2f(P0[r]); } while (0)
  #define RESC() do { if (resc) { asm volatile("s_waitcnt lgkmcnt(0)" ::: "memory"); \
      _Pragma("unroll") for (int d_ = 0; d_ < 2; ++d_) _Pragma("unroll") for (int r = 0; r < 16; ++r) o[d_][r] *= wsf[crow(r, hi)]; } } while (0)
  f32x16 pA0, pA1, pB0, pB1;
  int sl_prev = 0, sl_cur = 0, sl_next = SLOTB;
  #define ROT() do { sl_prev = sl_cur; sl_cur = sl_next; sl_next = (sl_next == (NSLOT - 1) * SLOTB) ? 0 : sl_next + SLOTB; } while (0)
  DMA_K(2, 2 * SLOTB);
  WAIT_BAR(3);
  qkt(pA0, pA1, Kbase, qr, NEGM, r32, hi); asm volatile("s_nop 15\n\ts_nop 7" : "+v"(pA0), "+v"(pA1));
  START(pA0, pA1);
  _Pragma("unroll") for (int r = 0; r < 16; ++r) pA1[r] = __builtin_amdgcn_exp2f(pA1[r]);
  WAIT_BAR(0);
  DMA_K(3, 0); DMA_V(1, SLOTB);
  ROT();
  kload8(kf, kp0 + sl_cur);
  WAIT_BAR(2);
  s16x4 vlo[8], vhi[8]; u32x4 pw0, pw1, pw2, pw3;
  #define PKW(P, B) cvtpk_s(P[B], P[B + 1])
  #define PAF(k) __builtin_bit_cast(bf16x8, pw##k)
  #define VFR(i) (bf16x8){vlo[i][0], vlo[i][1], vlo[i][2], vlo[i][3], vhi[i][0], vhi[i][1], vhi[i][2], vhi[i][3]}
  #define PIN(x) asm volatile("" : "+v"(x))
  #define MX3(a, b, c) __builtin_fmaxf(__builtin_fmaxf((a), (b)), (c))
  #define GAPA(MF, A0, A1, A2, A3, W0, W1, PW) do { MF; sacc += A0; sacc += A1; sacc += A2; sacc += A3; PIN(sacc); W0; W1; PIN(PW); SBAR(); } while (0)
  #define EX(v) __builtin_amdgcn_exp2f(v)
  #define GAPB(MF, X, B) do { MF; X[B] = EX(X[B]); X[B + 1] = EX(X[B + 1]); X[B + 2] = EX(X[B + 2]); X[B + 3] = EX(X[B + 3]); PIN(X); SBAR(); } while (0)
  #define VRD(i) do { vlo[i] = vtr(vp_ + (((i) >> 2) * 4096 + ((i) & 3) * 1024)); vhi[i] = vtr(vp_ + (((i) >> 2) * 4096 + ((i) & 3) * 1024 + 512)); } while (0)
  #define KRD(G, j) do { if (G) { kload2(kf, kp0 + sl_next, j); SBAR(); } } while (0)
  #define STEP(C0, C1, P0, P1, t, GK, GV, GL) do { SBAR(); \
    const lds_cptr vp_ = vp0 + sl_prev; \
    VRD(0); SBAR(); float sacc = (P0[0] + P0[1]); \
    GAPA(C0 = __builtin_amdgcn_mfma_f32_32x32x16_bf16(kf[0], qr[0], NEGM, 0, 0, 0), P0[2], P0[3], P0[4], P0[5],     pw0[0] = PKW(P0, 0), pw0[1] = PKW(P0, 2), pw0); \
    VRD(4); SBAR(); GAPA(C1 = __builtin_amdgcn_mfma_f32_32x32x16_bf16(kf[1], qr[0], NEGM, 0, 0, 0), P0[6], P0[7], P0[8], P0[9],     pw0[2] = PKW(P0, 4), pw0[3] = PKW(P0, 6), pw0); \
    VRD(1); SBAR(); GAPA(C0 = __builtin_amdgcn_mfma_f32_32x32x16_bf16(kf[2], qr[1], C0, 0, 0, 0),   P0[10], P0[11], P0[12], P0[13], pw1[0] = PKW(P0, 8), pw1[1] = PKW(P0, 10), pw1); \
    VRD(5); SBAR(); GAPA(C1 = __builtin_amdgcn_mfma_f32_32x32x16_bf16(kf[3], qr[1], C1, 0, 0, 0),   P0[14], P0[15], P1[0], P1[1],   pw1[2] = PKW(P0, 12), pw1[3] = PKW(P0, 14), pw1); \
    VRD(2); SBAR(); GAPA(C0 = __builtin_amdgcn_mfma_f32_32x32x16_bf16(kf[4], qr[2], C0, 0, 0, 0),   P1[2], P1[3], P1[4], P1[5],     pw2[0] = PKW(P1, 0), pw2[1] = PKW(P1, 2), pw2); \
    VRD(6); SBAR(); GAPA(C1 = __builtin_amdgcn_mfma_f32_32x32x16_bf16(kf[5], qr[2], C1, 0, 0, 0),   P1[6], P1[7], P1[8], P1[9],     pw2[2] = PKW(P1, 4), pw2[3] = PKW(P1, 6), pw2); \
    VRD(3); SBAR(); GAPA(C0 = __builtin_amdgcn_mfma_f32_32x32x16_bf16(kf[6], qr[3], C0, 0, 0, 0),   P1[10], P1[11], P1[12], P1[13], pw3[0] = PKW(P1, 8), pw3[1] = PKW(P1, 10), pw3); \
    VRD(7); SBAR(); GAPA(C1 = __builtin_amdgcn_mfma_f32_32x32x16_bf16(kf[7], qr[3], C1, 0, 0, 0),   P1[14], P1[15], 0.f, 0.f,       pw3[2] = PKW(P1, 12), pw3[3] = PKW(P1, 14), pw3); \
    l_reg += sacc; \
    if (GK) { DMA_K((t) + 3, sl_cur); } if (GV) { DMA_V((t) + 1, sl_next); } \
    if (NA) { _Pragma("unroll") for (int r = 0; r < 16; ++r) { C0[r] -= mhat; C1[r] -= mhat; } } \
    CMASK(C0, C1, t); \
    { float a = MX3(C0[0], C0[1], C1[0]), b = MX3(C0[2], C0[3], C1[1]); a = MX3(a, C1[2], C1[3]); \
      _Pragma("unroll") for (int r = 4; r < 16; r += 4) { a = MX3(a, C0[r], C0[r + 1]); b = MX3(b, C0[r + 2], C0[r + 3]); a = MX3(a, C1[r], C1[r + 1]); b = MX3(b, C1[r + 2], C1[r + 3]); } \
      float rm = __builtin_fmaxf(a, b); { auto rr = __builtin_amdgcn_permlane32_swap(__float_as_uint(rm), __float_as_uint(rm), false, false); rm = __builtin_fmaxf(__uint_as_float(rr[0]), __uint_as_float(rr[1])); } \
      resc = false; \
      if (__builtin_expect(__any(rm > (float)THRL), 0)) { const float dl = __builtin_fmaxf(rm, 0.f); mhat += dl; \
        _Pragma("unroll") for (int r = 0; r < 16; ++r) { C0[r] -= dl; C1[r] -= dl; } \
        if (!NA) { _Pragma("unroll") for (int r = 0; r < 16; ++r) negm[r] = -mhat; asm volatile("" : "+v"(negm)); } \
        const float f = __builtin_amdgcn_exp2f(-dl); l_reg *= f; if (hi == 0) wsf[r32] = f; resc = true; } } \
    SBAR(); \
    GAPB(o[0] = __builtin_amdgcn_mfma_f32_32x32x16_bf16(PAF(0), VFR(0), o[0], 0, 0, 0), C0, 0); \
    GAPB(o[1] = __builtin_amdgcn_mfma_f32_32x32x16_bf16(PAF(0), VFR(4), o[1], 0, 0, 0), C0, 4); \
    KRD(GL, 0); GAPB(o[0] = __builtin_amdgcn_mfma_f32_32x32x16_bf16(PAF(1), VFR(1), o[0], 0, 0, 0), C0, 8); \
    KRD(GL, 1); GAPB(o[1] = __builtin_amdgcn_mfma_f32_32x32x16_bf16(PAF(1), VFR(5), o[1], 0, 0, 0), C0, 12); \
    KRD(GL, 2); GAPB(o[0] = __builtin_amdgcn_mfma_f32_32x32x16_bf16(PAF(2), VFR(2), o[0], 0, 0, 0), C1, 0); \
    KRD(GL, 3); GAPB(o[1] = __builtin_amdgcn_mfma_f32_32x32x16_bf16(PAF(2), VFR(6), o[1], 0, 0, 0), C1, 4); \
    GAPB(o[0] = __builtin_amdgcn_mfma_f32_32x32x16_bf16(PAF(3), VFR(3), o[0], 0, 0, 0), C1, 8); \
    GAPB(o[1] = __builtin_amdgcn_mfma_f32_32x32x16_bf16(PAF(3), VFR(7), o[1], 0, 0, 0), C1, 12); \
    } while (0)
  int t = 1;
  for (; t + 5 < NT; t += 2) {
    STEP(pB0, pB1, pA0, pA1, t, true, true, true);     WAIT_BAR(2); RESC(); ROT();
    STEP(pA0, pA1, pB0, pB1, t + 1, true, true, true); WAIT_BAR(2); RESC(); ROT();
  }
  #define ENDW(tt) do { if ((tt) + 3 < NT) { WAIT_BAR(2); } else if ((tt) + 2 < NT) { WAIT_BAR(1); } else { WAIT_BAR(0); } } while (0)
  for (; t + 1 < NT; t += 2) {
    STEP(pB0, pB1, pA0, pA1, t, (t + 3 < NT), (t + 1 < NT), (t + 1 < NT));         ENDW(t);     RESC(); ROT();
    STEP(pA0, pA1, pB0, pB1, t + 1, (t + 4 < NT), (t + 2 < NT), (t + 2 < NT));     ENDW(t + 1); RESC(); ROT();
  }
  STEP(pB0, pB1, pA0, pA1, NT - 1, false, false, false); RESC();
  { float sacc = pB0[0] + pB0[1]; _Pragma("unroll") for (int r = 2; r < 16; ++r) sacc += pB0[r]; _Pragma("unroll") for (int r = 0; r < 16; ++r) sacc += pB1[r]; l_reg += sacc;
    pw0 = (u32x4){PKW(pB0, 0), PKW(pB0, 2), PKW(pB0, 4), PKW(pB0, 6)}; pw1 = (u32x4){PKW(pB0, 8), PKW(pB0, 10), PKW(pB0, 12), PKW(pB0, 14)}; pw2 = (u32x4){PKW(pB1, 0), PKW(pB1, 2), PKW(pB1, 4), PKW(pB1, 6)}; pw3 = (u32x4){PKW(pB1, 8), PKW(pB1, 10), PKW(pB1, 12), PKW(pB1, 14)};
    SBAR(); pv(o, vb0 + sl_cur, PAF(0), PAF(1), PAF(2), PAF(3)); }
  #undef PKW
  #undef PAF
  #undef VFR
  #undef PIN
  #undef MX3
  #undef GAPA
  #undef GAPB
  #undef EX
  #undef VRD
  #undef KRD
  #undef STEP
  #undef ENDW
  { auto rr = __builtin_amdgcn_permlane32_swap(__float_as_uint(l_reg), __float_as_uint(l_reg), false, false); l_reg = __uint_as_float(rr[0]) + __uint_as_float(rr[1]); }
  if (hi == 0) wsf[32 + r32] = l_reg; asm volatile("s_waitcnt lgkmcnt(0)" ::: "memory");
  float rli[16];
  #pragma unroll
  for (int r = 0; r < 16; ++r) rli[r] = __builtin_amdgcn_rcpf(wsf[32 + crow(r, hi)]);
  bf16* Ow = Ou + (long)(wid * QBLK) * op;
  { bf16* stg = (bf16*)(shm + LDS_OST) + wid * 2048;
    #pragma unroll
    for (int r = 0; r < 16; ++r) { const int orow = crow(r, hi);
      #pragma unroll
      for (int d0 = 0; d0 < 2; ++d0) stg[orow * 64 + d0 * 32 + r32] = (bf16)f2bf(o[d0][r] * rli[r]); }
    asm volatile("s_waitcnt lgkmcnt(0)" ::: "memory");
    #pragma unroll
    for (int i = 0; i < 4; ++i) { const int row = i * 8 + (lane >> 3), ch = lane & 7; const u32x4 v = *(const u32x4*)(stg + row * 64 + ch * 8); ATTN_STORE16(Ow + (long)row * op + ch * 8, v); } }
  asm volatile("s_waitcnt lgkmcnt(0)\n\ts_barrier" ::: "memory");
  #undef NEGM
  #undef DMA_K
  #undef DMA_V
  #undef TROW
  #undef CMASK
  #undef START
  #undef RESC
  #undef ROT
}
#undef SBAR
#undef WAIT_BAR
}
struct Args { const float* in[29]; float* out; unsigned char* ws; int ph_lo, ph_hi; };
enum { I_X = 0, I_C, I_CTX, I_CCTX, I_WMOD, I_BMOD, I_N1G, I_N2G, I_WIN, I_LRE, I_LIM, I_LDT, I_BRE, I_BIM, I_CRE, I_CIM, I_SSMD, I_WGLU, I_QNG, I_KNG, I_RPB, I_WBR, I_WOUT, I_RW, I_RB, I_MG, I_MU, I_MD, I_FNG };

typedef const float* CFP;
struct Ctx {
    const __attribute__((address_space(4))) CFP* in; float* out; unsigned char* ws; LAS unsigned char* lds; gu32* ctl;
    int tid, lane, wave, vcu, G;
};
#define WSP(T_, off) ((T_*)(C.ws + (off)))

__device__ __forceinline__ float* xs_row(const Ctx& C, int m) { const int b = m / LB, j = m - b * LB; return j < CTX ? WSP(float, WS_CTXS) + (size_t)(b * CTX + j) * D : C.out + (size_t)(b * SEQ + j - CTX) * D; }
__device__ __forceinline__ const float* in_row(const Ctx& C, int m) { const int b = m / LB, j = m - b * LB; return j < CTX ? C.in[I_CTX] + (size_t)(b * CTX + j) * D : C.in[I_X] + (size_t)(b * SEQ + j - CTX) * D; }
__device__ __forceinline__ int cond_of(int m) { const int b = m / LB, j = m - b * LB; return j < CTX ? 4 : b; }

__device__ __forceinline__ void transpose_item(const float* W, int N, int Kp, bf16* WT, int k0, int n0, int drow0, LAS float* scr, int lane) {
#pragma unroll 8
    for (int i = 0; i < 32; ++i) { const int kk = 2 * i + (lane >> 5); scr[kk * 33 + (lane & 31)] = W[(size_t)(k0 + kk) * N + n0 + (lane & 31)]; }
    LDS_WAIT(); asm volatile("" ::: "memory");
    const int c = lane & 7;
#pragma unroll
    for (int j = 0; j < 4; ++j) { const int n = (lane >> 3) + 8 * j; const LAS float* s = scr + (8 * c) * 33 + n;
        v4u o; o.x = pk2(s[0 * 33], s[1 * 33]); o.y = pk2(s[2 * 33], s[3 * 33]); o.z = pk2(s[4 * 33], s[5 * 33]); o.w = pk2(s[6 * 33], s[7 * 33]);
        *(GAS v4u*)(WT + (size_t)(drow0 + n) * Kp + k0 + 8 * c) = o; }
    LDS_WAIT(); asm volatile("" ::: "memory");
}
__device__ __forceinline__ void phase_weights(const Ctx& C, int l) {
    LAS float* scr = (LAS float*)(C.lds + C.wave * 8704);
    const int gw = C.vcu * NWAVES + C.wave, NGW = C.G * NWAVES;
    constexpr int I0 = 16 * 184, I1 = 8 * 16, I2 = 3 * 8 * 32, I3 = 16 * 32, I4 = 16 * 16 * 16, I5 = I4, I6 = 16 * 8 * 32;
    for (int it = gw; it < I0 + I1 + I2 + I3 + I4 + I5 + I6; it += NGW) {
        int r = it;
        if (r < I0) { const int kb = r / 184, nb = r % 184; transpose_item(C.in[I_WIN] + (size_t)l * 1024 * INW, INW, 1024, WSP(bf16, WS_WIN), 64 * kb, 32 * nb, 32 * nb, scr, C.lane); continue; } r -= I0;
        if (r < I1) { const int kb = r / 16, nb = r % 16; transpose_item(C.in[I_WGLU] + (size_t)l * 512 * 512, 512, 512, WSP(bf16, WS_WGLU), 64 * kb, 32 * nb, 32 * nb, scr, C.lane); continue; } r -= I1;
        if (r < I2) { const int i = r / 256, q = r % 256, kb = q / 32, nb = q % 32; transpose_item(C.in[I_WBR] + (size_t)(l * 3 + i) * 512 * 1024, 1024, 512, WSP(bf16, WS_WBR) + (size_t)i * 1024 * 512, 64 * kb, 32 * nb, 32 * nb, scr, C.lane); continue; } r -= I2;
        if (r < I3) { const int kb = r / 32, nb = r % 32; transpose_item(C.in[I_WOUT] + (size_t)l * 1024 * 1024, 1024, 1024, WSP(bf16, WS_WOUT), 64 * kb, 32 * nb, 32 * nb, scr, C.lane); continue; } r -= I3;
        if (r < I4 + I5) { const int up = r >= I4; if (up) r -= I4; const int e = r / 256, q = r % 256, kb = q / 16, nb = q % 16, n0 = 32 * nb;
            transpose_item(C.in[up ? I_MU : I_MG] + (size_t)(l * 16 + e) * 1024 * 512, 512, 1024, WSP(bf16, WS_MOE1) + (size_t)e * 1024 * 1024, 64 * kb, n0, (n0 / 128) * 256 + (n0 % 128) + (up ? 128 : 0), scr, C.lane); continue; } r -= I4 + I5;
        { const int e = r / 256, q = r % 256, kb = q / 32, nb = q % 32; transpose_item(C.in[I_MD] + (size_t)(l * 16 + e) * 512 * 1024, 1024, 512, WSP(bf16, WS_MOE2) + (size_t)e * 1024 * 512, 64 * kb, 32 * nb, 32 * nb, scr, C.lane); }
    }
}

__device__ __forceinline__ void phase_mod(const Ctx& C) {
    LAS float* sc = (LAS float*)(C.lds + 69632);
    LAS float* red = (LAS float*)(C.lds + 69632 + 20480);
    for (int i = C.tid; i < 5 * 1024; i += 512) { const int c = i >> 10, k = i & 1023; const float v = c < 4 ? C.in[I_C][c * 1024 + k] : C.in[I_CCTX][k]; sc[i] = v * fsigmoid(v); }
    __syncthreads();
    for (int it = C.vcu; it < NLAYER * 96; it += C.G) {
        const int l = it / 96, col = (it % 96) * 64 + C.lane, k0 = C.wave * 128;
        const float* W = C.in[I_WMOD] + (size_t)l * 1024 * 6144 + (size_t)k0 * 6144 + col;
        float a0 = 0.f, a1 = 0.f, a2 = 0.f, a3 = 0.f, a4 = 0.f;
#pragma unroll 16
        for (int k = 0; k < 128; ++k) { const float w = W[(size_t)k * 6144]; a0 += sc[k0 + k] * w; a1 += sc[1024 + k0 + k] * w; a2 += sc[2048 + k0 + k] * w; a3 += sc[3072 + k0 + k] * w; a4 += sc[4096 + k0 + k] * w; }
        LAS float* r = red + C.wave * 320 + C.lane; r[0] = a0; r[64] = a1; r[128] = a2; r[192] = a3; r[256] = a4;
        __syncthreads();
        if (C.tid < 320) { const int c = C.tid >> 6; float s = C.in[I_BMOD][l * 6144 + col];
#pragma unroll
            for (int w = 0; w < 8; ++w) s += red[w * 320 + C.tid];
            WSP(float, WS_MOD)[(size_t)(l * 5 + c) * 6144 + col] = s; }
        __syncthreads();
    }
}

__device__ __forceinline__ void phase_s5mats(const Ctx& C, int l) {
    if (C.vcu >= 32) return;
    const int g = C.vcu, tid = C.tid;
    LAS f32x2* POW = (LAS f32x2*)(C.lds);
    LAS f32x2* CC = (LAS f32x2*)(C.lds + 33792);
    LAS f32x2* BB = (LAS f32x2*)(C.lds + 50176);
    LAS f32x2* COEF = (LAS f32x2*)(C.lds + 66560);
    LAS bf16* KT = (LAS bf16*)(C.lds + 67584);
    __syncthreads();
    if (tid < 128) {
        const int d = tid >> 6, p = tid & 63; const int li = ((l * 2 + d) * 32 + g) * 64 + p;
        const float re = C.in[I_LRE][li], im = C.in[I_LIM][li], dt = __expf(C.in[I_LDT][(l * 2 + d) * 32 + g]);
        for (int tau = 0; tau <= 32; ++tau) { const float mag = __expf(re * dt * (float)tau), rev = im * dt * (float)tau * 0.15915494309189535f;
            POW[(d * 33 + tau) * 64 + p] = (f32x2){mag * cos_rev(rev), mag * sin_rev(rev)}; }
        const float mag = __expf(re * dt), rev = im * dt * 0.15915494309189535f; const float lr = mag * cos_rev(rev) - 1.f, lim = mag * sin_rev(rev);
        const float den = 1.f / (re * re + im * im);
        COEF[tid] = (f32x2){(lr * re + lim * im) * den, (lim * re - lr * im) * den};
    }
    __syncthreads();
    for (int i = tid; i < 2048; i += 512) {
        const int d = i >> 10, p = (i >> 4) & 63, h = i & 15; const size_t bi = (((size_t)(l * 2 + d) * 32 + g) * 64 + p) * 16 + h;
        const float br = C.in[I_BRE][bi], bi_ = C.in[I_BIM][bi]; const f32x2 cf = COEF[d * 64 + p];
        BB[i] = (f32x2){cf.x * br - cf.y * bi_, cf.x * bi_ + cf.y * br};
        const int h2 = (i >> 6) & 15, p2 = i & 63; const size_t ci = (((size_t)(l * 2 + d) * 32 + g) * 16 + h2) * 64 + p2;
        CC[i] = (f32x2){C.in[I_CRE][ci], C.in[I_CIM][ci]};
    }
    __syncthreads();
    for (int i = tid; i < 63 * 256; i += 512) {
        const int ti = i >> 8, h = (i >> 4) & 15, hp = i & 15, tau = ti - 31; float s = 0.f;
        if (tau >= 0) { for (int p = 0; p < 64; ++p) { const f32x2 c = CC[h * 64 + p], w = POW[tau * 64 + p], b = BB[p * 16 + hp];
                const float xr = c.x * w.x - c.y * w.y, xi = c.x * w.y + c.y * w.x; s += xr * b.x - xi * b.y; } }
        if (tau <= 0) { for (int p = 0; p < 64; ++p) { const f32x2 c = CC[1024 + h * 64 + p], w = POW[(33 - tau) * 64 + p], b = BB[1024 + p * 16 + hp];
                const float xr = c.x * w.x - c.y * w.y, xi = c.x * w.y + c.y * w.x; s += xr * b.x - xi * b.y; } }
        if (tau == 0 && h == hp) s += C.in[I_SSMD][l * 512 + g * 16 + h];
        KT[i] = (bf16)f2bf(s);
    }
    __syncthreads();
    bf16* B1 = WSP(bf16, WS_BT1) + (size_t)g * 768 * 512; bf16* B2 = WSP(bf16, WS_BT2) + (size_t)g * 512 * 256;
    for (int i = tid; i < 512 * 64; i += 512) {
        const int n = i >> 6, ch = i & 63, t = n >> 4, h = n & 15, s = ch >> 1, hp0 = (ch & 1) * 8;
        *(GAS v4u*)(B1 + (size_t)n * 512 + ch * 8) = *(const LAS v4u*)(KT + ((t - s + 31) * 16 + h) * 16 + hp0);
    }
    for (int i = tid; i < 256 * 64; i += 512) {
        const int nn = i >> 6, ch = i & 63, d = nn >> 7, p = (nn & 127) >> 1, ri = nn & 1, s = ch >> 1, hp0 = (ch & 1) * 8;
        const f32x2 w = POW[(d * 33 + (d == 0 ? 31 - s : s)) * 64 + p]; float v[8];
#pragma unroll
        for (int j = 0; j < 8; ++j) { const f32x2 b = BB[d * 1024 + p * 16 + hp0 + j]; v[j] = ri == 0 ? (w.x * b.x - w.y * b.y) : (w.x * b.y + w.y * b.x); }
        v4u o; o.x = pk2(v[0], v[1]); o.y = pk2(v[2], v[3]); o.z = pk2(v[4], v[5]); o.w = pk2(v[6], v[7]);
        *(GAS v4u*)(B1 + (size_t)(512 + nn) * 512 + ch * 8) = o;
    }
    for (int i = tid; i < 512 * 32; i += 512) {
        const int n = i >> 5, ch = i & 31, t = n >> 4, h = n & 15, d = ch >> 4, p0 = (ch & 15) * 4; float v[8];
#pragma unroll
        for (int j = 0; j < 4; ++j) { const f32x2 c = CC[d * 1024 + h * 64 + p0 + j], w = POW[(d * 33 + (d == 0 ? t + 1 : 32 - t)) * 64 + p0 + j];
            v[2 * j] = c.x * w.x - c.y * w.y; v[2 * j + 1] = -(c.x * w.y + c.y * w.x); }
        v4u o; o.x = pk2(v[0], v[1]); o.y = pk2(v[2], v[3]); o.z = pk2(v[4], v[5]); o.w = pk2(v[6], v[7]);
        *(GAS v4u*)(B2 + (size_t)n * 256 + ch * 8) = o;
    }
    __syncthreads();
}

template <int MODE>
__device__ __forceinline__ void phase_rows(const Ctx& C, int l) {
    const int gw = C.vcu * NWAVES + C.wave, NGW = C.G * NWAVES, lane = C.lane;
    const float* MODl = WSP(float, WS_MOD) + (size_t)(MODE == 2 ? 0 : l) * 5 * 6144;
    const float* MODp = WSP(float, WS_MOD) + (size_t)(l > 0 ? l - 1 : 0) * 5 * 6144;
    const bf16* YS = WSP(bf16, WS_YSLOT);
    for (int m = gw; m < T; m += NGW) {
        const int b = m / LB, j = m - b * LB, cond = j < CTX ? 4 : b;
        if (MODE == 2 && j < CTX) continue;
        f32x4 v[4];
        if (MODE == 0) { const GAS f32x4* xr = (const GAS f32x4*)in_row(C, m) + lane;
#pragma unroll
            for (int q = 0; q < 4; ++q) v[q] = xr[64 * q]; }
        else { const GAS f32x4* xr = (const GAS f32x4*)xs_row(C, m) + lane; const GAS v2u* y0 = (const GAS v2u*)(YS + (size_t)(2 * m) * D) + lane; const GAS v2u* y1 = (const GAS v2u*)(YS + (size_t)(2 * m + 1) * D) + lane;
            const GAS f32x4* g2 = (const GAS f32x4*)(MODp + cond * 6144 + 5 * 1024) + lane;
#pragma unroll
            for (int q = 0; q < 4; ++q) { const f32x4 x = xr[64 * q], g = g2[64 * q]; const v2u a = y0[64 * q], c = y1[64 * q];
                v[q] = x + g * (f32x4){bflo(a.x) + bflo(c.x), bfhi(a.x) + bfhi(c.x), bflo(a.y) + bflo(c.y), bfhi(a.y) + bfhi(c.y)}; } }
        float ss = 0.f;
#pragma unroll
        for (int q = 0; q < 4; ++q) ss += (v[q].x * v[q].x + v[q].y * v[q].y) + (v[q].z * v[q].z + v[q].w * v[q].w);
        const float rstd = 1.f / sqrtf(wave_sum(ss, lane) * (1.f / D) + EPS);
        if (MODE == 2) { GAS f32x4* o = (GAS f32x4*)(C.out + (size_t)(b * SEQ + j - CTX) * D) + lane; const GAS f32x4* fg = (const GAS f32x4*)C.in[I_FNG] + lane;
#pragma unroll
            for (int q = 0; q < 4; ++q) o[64 * q] = v[q] * rstd * fg[64 * q]; }
        else { GAS f32x4* xo = (GAS f32x4*)xs_row(C, m) + lane; GAS v2u* ho = (GAS v2u*)(WSP(bf16, WS_HB) + (size_t)m * D) + lane;
            const GAS f32x4* ng = (const GAS f32x4*)(C.in[I_N1G] + l * D) + lane; const GAS f32x4* sh = (const GAS f32x4*)(MODl + cond * 6144) + lane; const GAS f32x4* sc = (const GAS f32x4*)(MODl + cond * 6144 + 1024) + lane;
#pragma unroll
            for (int q = 0; q < 4; ++q) { xo[64 * q] = v[q]; const f32x4 h = v[q] * rstd * ng[64 * q] * (sc[64 * q] + 1.f) + sh[64 * q]; ho[64 * q] = (v2u){pk2(h.x, h.y), pk2(h.z, h.w)}; } }
    }
}

__device__ __forceinline__ void phase_qkprep(const Ctx& C, int l) {
    const int gw = C.vcu * NWAVES + C.wave, NGW = C.G * NWAVES, lane = C.lane, s8 = lane & 7;
    const float* qg = C.in[I_QNG] + l * 64 + 8 * s8; const float* kg = C.in[I_KNG] + l * 64 + 8 * s8;
    float gq[8], gk[8];
#pragma unroll
    for (int i = 0; i < 8; ++i) { gq[i] = qg[i]; gk[i] = kg[i]; }
    const int ax = s8 >> 2, f0 = 8 * (s8 & 1);
    float inv[8];
#pragma unroll
    for (int i = 0; i < 8; ++i) inv[i] = exp2f(-(float)(f0 + i) * 0.8304820237218406f) * 0.15915494309189535f;
    for (int m = gw; m < T; m += NGW) {
        const int b = m / LB, j = m - b * LB; const bool lat = j >= CTX; const int tt = j - CTX; const float pos = (float)(ax == 0 ? (tt >> 6) : (tt & 63));
#pragma unroll
        for (int which = 0; which < 2; ++which) {
            if (which == 1 && lane >= 16) break;
            GAS v4u* p = which == 0 ? (GAS v4u*)(WSP(bf16, WS_QA) + (size_t)m * 512) + lane : (GAS v4u*)(WSP(bf16, WS_KA) + (size_t)m * 128) + lane;
            const v4u w = *p; float x[8] = {bflo(w.x), bfhi(w.x), bflo(w.y), bfhi(w.y), bflo(w.z), bfhi(w.z), bflo(w.w), bfhi(w.w)};
            float ss = 0.f;
#pragma unroll
            for (int i = 0; i < 8; ++i) ss += x[i] * x[i];
            ss += shflx(ss, 1, lane); ss += shflx(ss, 2, lane); ss += shflx(ss, 4, lane);
            const float rstd = 1.f / sqrtf(ss * (1.f / 64.f) + EPS);
#pragma unroll
            for (int i = 0; i < 8; ++i) x[i] = x[i] * rstd * (which == 0 ? gq[i] : gk[i]);
            float y[8];
#pragma unroll
            for (int i = 0; i < 8; ++i) { const float other = shflx(x[i], 2, lane);
                if (lat) { const float cs = cos_rev(pos * inv[i]), sn = sin_rev(pos * inv[i]); y[i] = (s8 & 2) ? (x[i] * cs + other * sn) : (x[i] * cs - other * sn); } else y[i] = x[i]; }
            const float sc = which == 0 ? C2 : 1.f;
            v4u o; o.x = pk2(y[0] * sc, y[1] * sc); o.y = pk2(y[2] * sc, y[3] * sc); o.z = pk2(y[4] * sc, y[5] * sc); o.w = pk2(y[6] * sc, y[7] * sc);
            *p = o;
        }
    }
}

__device__ __forceinline__ void phase_carry(const Ctx& C, int l) {
    if (C.vcu >= 32) return;
    const int b = C.vcu >> 3, g = (C.vcu & 7) * 4 + (C.wave >> 1), d = C.wave & 1, p = C.lane;
    const int li = ((l * 2 + d) * 32 + g) * 64 + p;
    const float re = C.in[I_LRE][li], im = C.in[I_LIM][li], dt = __expf(C.in[I_LDT][(l * 2 + d) * 32 + g]);
    const float mag = __expf(re * dt * 32.f), rev = im * dt * 32.f * 0.15915494309189535f; const float Lr = mag * cos_rev(rev), Li = mag * sin_rev(rev);
    const GAS f32x2* S = (const GAS f32x2*)(WSP(float, WS_SST) + (size_t)(b * NCH) * 8192 + g * 256 + d * 128) + p;
    GAS unsigned* X = (GAS unsigned*)(WSP(bf16, WS_XST) + (size_t)(b * NCH) * 8192 + g * 256 + d * 128) + p;
    float sr = 0.f, si = 0.f;
    if (d == 0) {
        for (int c0 = 0; c0 < NCH; c0 += 8) { f32x2 s[8];
#pragma unroll
            for (int k = 0; k < 8; ++k) s[k] = S[(size_t)(c0 + k) * 4096];
#pragma unroll
            for (int k = 0; k < 8; ++k) { X[(size_t)(c0 + k) * 4096] = pk2(sr, si); const float nr = Lr * sr - Li * si + s[k].x, ni = Lr * si + Li * sr + s[k].y; sr = nr; si = ni; } }
    } else {
        for (int seg = 0; seg < 33; ++seg) { const int chi = seg == 0 ? 7 : NCH - 1 - (seg - 1) * 8; f32x2 s[8];
#pragma unroll
            for (int k = 0; k < 8; ++k) s[k] = S[(size_t)(chi - k) * 4096];
#pragma unroll
            for (int k = 0; k < 8; ++k) { X[(size_t)(chi - k) * 4096] = pk2(sr, si); const float nr = Lr * sr - Li * si + s[k].x, ni = Lr * si + Li * sr + s[k].y; sr = nr; si = ni; } }
    }
}

__device__ __forceinline__ void phase_norm2(const Ctx& C, int l) {
    LAS float* RWt = (LAS float*)C.lds;
    LAS unsigned* REC = (LAS unsigned*)(C.lds + 65536);
    LAS unsigned* LCNT = (LAS unsigned*)(C.lds + 65536 + 32768);
    const int lane = C.lane, tid = C.tid;
    for (int i = tid; i < 16384; i += 512) { const int k = i >> 4, e = i & 15; RWt[e * 1024 + k] = C.in[I_RW][i]; }
    if (tid < 32) LCNT[tid] = 0u;
    __syncthreads();
    const float* MODl = WSP(float, WS_MOD) + (size_t)l * 5 * 6144;
    float rb[16];
#pragma unroll
    for (int e = 0; e < 16; ++e) rb[e] = C.in[I_RB][e];
    int nrows = 0; for (int m = C.vcu; m < T; m += C.G) ++nrows;
    for (int i = C.wave; i < nrows; i += NWAVES) {
        const int m = C.vcu + C.G * i, cond = cond_of(m);
        const GAS f32x4* xr = (const GAS f32x4*)xs_row(C, m) + lane; GAS v2u* ho = (GAS v2u*)(WSP(bf16, WS_HB) + (size_t)m * D) + lane;
        const GAS f32x4* ng = (const GAS f32x4*)(C.in[I_N2G] + l * D) + lane; const GAS f32x4* sh = (const GAS f32x4*)(MODl + cond * 6144 + 3072) + lane; const GAS f32x4* sc = (const GAS f32x4*)(MODl + cond * 6144 + 4096) + lane;
        f32x4 v[4]; float ss = 0.f;
#pragma unroll
        for (int q = 0; q < 4; ++q) { v[q] = xr[64 * q]; ss += (v[q].x * v[q].x + v[q].y * v[q].y) + (v[q].z * v[q].z + v[q].w * v[q].w); }
        const float rstd = 1.f / sqrtf(wave_sum(ss, lane) * (1.f / D) + EPS);
        float lg[16];
#pragma unroll
        for (int e = 0; e < 16; ++e) lg[e] = 0.f;
#pragma unroll
        for (int q = 0; q < 4; ++q) { const f32x4 h = v[q] * rstd * ng[64 * q] * (sc[64 * q] + 1.f) + sh[64 * q]; ho[64 * q] = (v2u){pk2(h.x, h.y), pk2(h.z, h.w)};
#pragma unroll
            for (int e = 0; e < 16; ++e) { const f32x4 w = *(const LAS f32x4*)(RWt + e * 1024 + 256 * q + 4 * lane); lg[e] += (h.x * w.x + h.y * w.y) + (h.z * w.z + h.w * w.w); } }
#pragma unroll
        for (int e = 0; e < 16; ++e) lg[e] = wave_sum(lg[e], lane);
        float mx = lg[0];
#pragma unroll
        for (int e = 1; e < 16; ++e) mx = fmaxf(mx, lg[e]);
        float pr[16], sel[16], sum = 0.f;
#pragma unroll
        for (int e = 0; e < 16; ++e) { pr[e] = __expf(lg[e] - mx); sum += pr[e]; }
        const float rs = 1.f / sum;
#pragma unroll
        for (int e = 0; e < 16; ++e) { pr[e] *= rs; sel[e] = pr[e] + rb[e]; }
        float bestv = -1e30f; int best = 0;
#pragma unroll
        for (int gq = 0; gq < 4; ++gq) { float m1 = -1e30f, m2 = -1e30f;
#pragma unroll
            for (int k = 0; k < 4; ++k) { const float s = sel[4 * gq + k]; if (s > m1) { m2 = m1; m1 = s; } else if (s > m2) m2 = s; }
            const float gs = m1 + m2; if (gs > bestv) { bestv = gs; best = gq; } }
        float s4[4], p4[4];
#pragma unroll
        for (int k = 0; k < 4; ++k) { s4[k] = best == 0 ? sel[k] : best == 1 ? sel[4 + k] : best == 2 ? sel[8 + k] : sel[12 + k]; p4[k] = best == 0 ? pr[k] : best == 1 ? pr[4 + k] : best == 2 ? pr[8 + k] : pr[12 + k]; }
        int i0 = 0; float v0 = s4[0], q0 = p4[0];
#pragma unroll
        for (int k = 1; k < 4; ++k) if (s4[k] > v0) { v0 = s4[k]; i0 = k; q0 = p4[k]; }
        int i1 = -1; float v1 = -1e30f, q1 = 0.f;
#pragma unroll
        for (int k = 0; k < 4; ++k) if (k != i0 && s4[k] > v1) { v1 = s4[k]; i1 = k; q1 = p4[k]; }
        const int e0 = 4 * best + i0, e1 = 4 * best + i1; const float wn = 1.f / (q0 + q1);
        if (lane == 0) { const unsigned lp0 = atomicAdd((unsigned*)(LCNT + e0), 1u), lp1 = atomicAdd((unsigned*)(LCNT + e1), 1u);
            REC[i * 4 + 0] = (unsigned)e0 | ((unsigned)e1 << 8) | (lp0 << 16); REC[i * 4 + 1] = lp1; REC[i * 4 + 2] = __float_as_uint(q0 * wn); REC[i * 4 + 3] = __float_as_uint(q1 * wn); }
    }
    __syncthreads();
    if (tid < 16) LCNT[16 + tid] = __hip_atomic_fetch_add((unsigned*)(C.ctl + CW_CNT + l * 1024 + 64 * tid), LCNT[tid], RLX_AGENT);
    __syncthreads();
    int* LIST = WSP(int, WS_LIST); float* RWG = WSP(float, WS_RW);
    for (int i = tid; i < nrows; i += 512) { const int m = C.vcu + C.G * i; const unsigned r0 = REC[i * 4], r1 = REC[i * 4 + 1];
        const int e0 = r0 & 255, e1 = (r0 >> 8) & 255; const unsigned lp0 = r0 >> 16, lp1 = r1;
        LIST[(size_t)e0 * T + LCNT[16 + e0] + lp0] = 2 * m; LIST[(size_t)e1 * T + LCNT[16 + e1] + lp1] = 2 * m + 1;
        RWG[2 * m] = __uint_as_float(REC[i * 4 + 2]); RWG[2 * m + 1] = __uint_as_float(REC[i * 4 + 3]); }
    __syncthreads();
}
using pg8::Unit;
typedef f32x4 Acc[2][2][4][2];
__device__ __forceinline__ v4u pack8(const f32x4& a, const f32x4& b) { v4u w; w.x = cvt_pk_bf16(a[0], a[1]); w.y = cvt_pk_bf16(a[2], a[3]); w.z = cvt_pk_bf16(b[0], b[1]); w.w = cvt_pk_bf16(b[2], b[3]); return w; }
__device__ __forceinline__ void unpack8(const v4u& w, f32x4& a, f32x4& b) { a = (f32x4){bflo(w.x), bfhi(w.x), bflo(w.y), bfhi(w.y)}; b = (f32x4){bflo(w.z), bfhi(w.z), bflo(w.w), bfhi(w.w)}; }
__device__ __forceinline__ int chunk_m0(int cr) { return (cr / NCH) * LB + (cr % NCH) * 32; }

struct PWin {
    unsigned char* ws; int G, c; int K; unsigned kstepA;
    __device__ __forceinline__ bool next(int i, Unit& u) const { const long L = (long)i * G + c; if (L >= NPAN * 23) return false; pg8::static_decode((int)L, NPAN, 23, u.pm, u.pn); u.z = 0; return true; }
    __device__ __forceinline__ const char* a_base(const Unit& u) const { return (const char*)(ws + WS_HB) + (size_t)u.pm * 256 * 1024 * 2; }
    __device__ __forceinline__ unsigned a_off(const Unit&, int h, int R, int Cc) const { return (unsigned)((h * 128 + R) * 1024 + Cc) * 2u; }
    __device__ __forceinline__ const char* b_base(const Unit& u) const { return (const char*)(ws + WS_WIN) + (size_t)u.pn * 256 * 1024 * 2; }
    __device__ __forceinline__ void epi(const Acc& acc, const Unit& u, int wr, int wc, int fr, int fq) const {
        const int row0 = u.pm * 256 + wr * 64 + fr;
#pragma unroll
        for (int bj = 0; bj < 2; ++bj) {
            const int cb = u.pn * 256 + bj * 128; bf16* dst; int ld, col, mode = 0; float sc = 1.f;
            if (cb < 512) { dst = (bf16*)(ws + WS_U); ld = 512; col = cb; }
            else if (cb < 1024) { dst = (bf16*)(ws + WS_QA); ld = 512; col = cb - 512; }
            else if (cb == 1024) { dst = (bf16*)(ws + WS_KA); ld = 128; col = 0; }
            else if (cb == 1152) { dst = (bf16*)(ws + WS_VA); ld = 128; col = 0; }
            else if (cb < 1792) { dst = (bf16*)(ws + WS_QN); ld = 512; col = cb - 1280; sc = C2; }
            else if (cb < 2304) { dst = (bf16*)(ws + WS_KN); ld = 512; col = cb - 1792; }
            else if (cb < 2816) { dst = (bf16*)(ws + WS_VN); ld = 512; col = cb - 2304; }
            else { dst = (bf16*)(ws + WS_GATES); ld = 3072; col = cb - 2816; mode = 1; }
            const int c0 = col + wc * 32 + 8 * fq;
#pragma unroll
            for (int ai = 0; ai < 2; ++ai)
#pragma unroll
                for (int m = 0; m < 4; ++m) { f32x4 v0 = acc[ai][bj][m][0], v1 = acc[ai][bj][m][1];
                    if (mode) { v0 = (f32x4){fsigmoid(v0[0]), fsigmoid(v0[1]), fsigmoid(v0[2]), fsigmoid(v0[3])}; v1 = (f32x4){fsigmoid(v1[0]), fsigmoid(v1[1]), fsigmoid(v1[2]), fsigmoid(v1[3])}; }
                    else { v0 = v0 * sc; v1 = v1 * sc; }
                    *(GAS v4u*)(dst + (size_t)(row0 + ai * 128 + m * 16) * ld + c0) = pack8(v0, v1); __builtin_amdgcn_sched_barrier(0); }
        }
    }
};

struct PS5A {
    unsigned char* ws; int G, c; int K; unsigned kstepA;
    __device__ __forceinline__ bool next(int i, Unit& u) const { const long L = (long)i * G + c; if (L >= 32 * 15) return false; const int l = (int)L; u.z = l / 15; const int r = l % 15; u.pm = r / 3; u.pn = r % 3; return true; }
    __device__ __forceinline__ const char* a_base(const Unit& u) const { return (const char*)(ws + WS_U) + (size_t)u.z * 32; }
    __device__ __forceinline__ unsigned a_off(const Unit& u, int h, int R, int Cc) const { int cr = u.pm * 256 + h * 128 + R; cr = cr < NCR ? cr : NCR - 1; return (unsigned)((chunk_m0(cr) + (Cc >> 4)) * 512 + (Cc & 15)) * 2u; }
    __device__ __forceinline__ const char* b_base(const Unit& u) const { return (const char*)(ws + WS_BT1) + ((size_t)u.z * 768 + u.pn * 256) * 512 * 2; }
    __device__ __forceinline__ void epi(const Acc& acc, const Unit& u, int wr, int wc, int fr, int fq) const {
#pragma unroll
        for (int ai = 0; ai < 2; ++ai)
#pragma unroll
            for (int m = 0; m < 4; ++m) { const int cr = u.pm * 256 + ai * 128 + wr * 64 + m * 16 + fr; if (cr >= NCR) continue;
#pragma unroll
                for (int bj = 0; bj < 2; ++bj) { const int n = bj * 128 + wc * 32 + 8 * fq;
                    if (u.pn < 2) { const int nn = u.pn * 256 + n, t = nn >> 4, h0 = nn & 15;
                        *(GAS v4u*)((bf16*)(ws + WS_YS) + (size_t)(chunk_m0(cr) + t) * 512 + u.z * 16 + h0) = pack8(acc[ai][bj][m][0], acc[ai][bj][m][1]); }
                    else { GAS f32x4* o = (GAS f32x4*)((float*)(ws + WS_SST) + (size_t)cr * 8192 + u.z * 256 + n); o[0] = acc[ai][bj][m][0]; o[1] = acc[ai][bj][m][1]; } }
                __builtin_amdgcn_sched_barrier(0); }
    }
};

struct PS5B {
    unsigned char* ws; int G, c; int K; unsigned kstepA;
    __device__ __forceinline__ bool next(int i, Unit& u) const { const long L = (long)i * G + c; if (L >= 32 * 10) return false; const int l = (int)L; u.z = l / 10; const int r = l % 10; u.pm = r / 2; u.pn = r % 2; return true; }
    __device__ __forceinline__ const char* a_base(const Unit& u) const { return (const char*)(ws + WS_XST) + (size_t)u.z * 512; }
    __device__ __forceinline__ unsigned a_off(const Unit& u, int h, int R, int Cc) const { int cr = u.pm * 256 + h * 128 + R; cr = cr < NCR ? cr : NCR - 1; return (unsigned)(cr * 8192 + Cc) * 2u; }
    __device__ __forceinline__ const char* b_base(const Unit& u) const { return (const char*)(ws + WS_BT2) + ((size_t)u.z * 512 + u.pn * 256) * 256 * 2; }
    __device__ __forceinline__ void epi(const Acc& acc, const Unit& u, int wr, int wc, int fr, int fq) const {
#pragma unroll
        for (int ai = 0; ai < 2; ++ai)
#pragma unroll
            for (int m = 0; m < 4; ++m) { const int cr = u.pm * 256 + ai * 128 + wr * 64 + m * 16 + fr; if (cr >= NCR) continue;
#pragma unroll
                for (int bj = 0; bj < 2; ++bj) { const int nn = u.pn * 256 + bj * 128 + wc * 32 + 8 * fq, t = nn >> 4, h0 = nn & 15;
                    GAS v4u* p = (GAS v4u*)((bf16*)(ws + WS_YS) + (size_t)(chunk_m0(cr) + t) * 512 + u.z * 16 + h0);
                    f32x4 y0, y1; { const v4u w_ = *p; unpack8(w_, y0, y1); } y0 += acc[ai][bj][m][0]; y1 += acc[ai][bj][m][1];
                    y0 = (f32x4){gelu_tanh(y0[0]), gelu_tanh(y0[1]), gelu_tanh(y0[2]), gelu_tanh(y0[3])}; y1 = (f32x4){gelu_tanh(y1[0]), gelu_tanh(y1[1]), gelu_tanh(y1[2]), gelu_tanh(y1[3])};
                    *p = pack8(y0, y1); }
                __builtin_amdgcn_sched_barrier(0); }
    }
};

struct PGlu {
    unsigned char* ws; int G, c; int K; unsigned kstepA;
    __device__ __forceinline__ bool next(int i, Unit& u) const { const long L = (long)i * G + c; if (L >= NPAN * 2) return false; pg8::static_decode((int)L, NPAN, 2, u.pm, u.pn); u.z = 0; return true; }
    __device__ __forceinline__ const char* a_base(const Unit& u) const { return (const char*)(ws + WS_YS) + (size_t)u.pm * 256 * 512 * 2; }
    __device__ __forceinline__ unsigned a_off(const Unit&, int h, int R, int Cc) const { return (unsigned)((h * 128 + R) * 512 + Cc) * 2u; }
    __device__ __forceinline__ const char* b_base(const Unit& u) const { return (const char*)(ws + WS_WGLU) + (size_t)u.pn * 256 * 512 * 2; }
    __device__ __forceinline__ void epi(const Acc& acc, const Unit& u, int wr, int wc, int fr, int fq) const {
#pragma unroll
        for (int ai = 0; ai < 2; ++ai)
#pragma unroll
            for (int m = 0; m < 4; ++m) { const size_t r = (size_t)(u.pm * 256 + ai * 128 + wr * 64 + m * 16 + fr);
#pragma unroll
                for (int bj = 0; bj < 2; ++bj) { const int cc = u.pn * 256 + bj * 128 + wc * 32 + 8 * fq;
                    f32x4 z0, z1; { const v4u w_ = *(const GAS v4u*)((const bf16*)(ws + WS_YS) + r * 512 + cc); unpack8(w_, z0, z1); } const f32x4 a0 = acc[ai][bj][m][0], a1 = acc[ai][bj][m][1];
                    z0 = z0 * (f32x4){fsigmoid(a0[0]), fsigmoid(a0[1]), fsigmoid(a0[2]), fsigmoid(a0[3])}; z1 = z1 * (f32x4){fsigmoid(a1[0]), fsigmoid(a1[1]), fsigmoid(a1[2]), fsigmoid(a1[3])};
                    *(GAS v4u*)((bf16*)(ws + WS_U) + r * 512 + cc) = pack8(z0, z1); }
                __builtin_amdgcn_sched_barrier(0); }
    }
};

struct PMerge {
    unsigned char* ws; int G, c; int K; unsigned kstepA;
    __device__ __forceinline__ bool next(int i, Unit& u) const { const long tile = (long)(i / 3) * G + c; if (tile >= NPAN * 4) return false; pg8::static_decode((int)tile, NPAN, 4, u.pm, u.pn); u.z = i % 3; return true; }
    __device__ __forceinline__ const char* a_base(const Unit& u) const { const size_t off = u.z == 0 ? WS_U : (u.z == 1 ? WS_QA : WS_QN); return (const char*)(ws + off) + (size_t)u.pm * 256 * 512 * 2; }
    __device__ __forceinline__ unsigned a_off(const Unit&, int h, int R, int Cc) const { return (unsigned)((h * 128 + R) * 512 + Cc) * 2u; }
    __device__ __forceinline__ const char* b_base(const Unit& u) const { return (const char*)(ws + WS_WBR) + ((size_t)u.z * 1024 + u.pn * 256) * 512 * 2; }
    __device__ __forceinline__ void epi(const Acc& acc, const Unit& u, int wr, int wc, int fr, int fq) const {
#pragma unroll
        for (int ai = 0; ai < 2; ++ai)
#pragma unroll
            for (int m = 0; m < 4; ++m) { const size_t r = (size_t)(u.pm * 256 + ai * 128 + wr * 64 + m * 16 + fr);
#pragma unroll
                for (int bj = 0; bj < 2; ++bj) { const int cc = u.pn * 256 + bj * 128 + wc * 32 + 8 * fq;
                    f32x4 g0, g1; { const v4u w_ = *(const GAS v4u*)((const bf16*)(ws + WS_GATES) + r * 3072 + u.z * 1024 + cc); unpack8(w_, g0, g1); }
                    f32x4 v0 = g0 * acc[ai][bj][m][0], v1 = g1 * acc[ai][bj][m][1];
                    GAS v4u* p = (GAS v4u*)((bf16*)(ws + WS_HB) + r * 1024 + cc);
                    if (u.z != 0) { f32x4 o0, o1; const v4u w_ = *p; unpack8(w_, o0, o1); v0 += o0; v1 += o1; }
                    *p = pack8(v0, v1); }
                __builtin_amdgcn_sched_barrier(0); }
        asm volatile("s_waitcnt vmcnt(0)" ::: "memory");
    }
};

struct PWout {
    unsigned char* ws; float* out; const float* mod; int G, c; int K; unsigned kstepA;
    __device__ __forceinline__ bool next(int i, Unit& u) const { const long L = (long)i * G + c; if (L >= NPAN * 4) return false; pg8::static_decode((int)L, NPAN, 4, u.pm, u.pn); u.z = 0; return true; }
    __device__ __forceinline__ const char* a_base(const Unit& u) const { return (const char*)(ws + WS_HB) + (size_t)u.pm * 256 * 1024 * 2; }
    __device__ __forceinline__ unsigned a_off(const Unit&, int h, int R, int Cc) const { return (unsigned)((h * 128 + R) * 1024 + Cc) * 2u; }
    __device__ __forceinline__ const char* b_base(const Unit& u) const { return (const char*)(ws + WS_WOUT) + (size_t)u.pn * 256 * 1024 * 2; }
    __device__ __forceinline__ void epi(const Acc& acc, const Unit& u, int wr, int wc, int fr, int fq) const {
        const int b = u.pm / 33, pr = u.pm % 33, cond = pr == 0 ? 4 : b;
        float* xb = pr == 0 ? (float*)(ws + WS_CTXS) + (size_t)b * 256 * D : out + ((size_t)b * SEQ + (size_t)(pr - 1) * 256) * D;
        const float* g1 = mod + cond * 6144 + 2048;
#pragma unroll
        for (int bj = 0; bj < 2; ++bj) { const int cc = u.pn * 256 + bj * 128 + wc * 32 + 8 * fq; const f32x4 ga = *(const GAS f32x4*)(g1 + cc), gb = *(const GAS f32x4*)(g1 + cc + 4);
#pragma unroll
            for (int ai = 0; ai < 2; ++ai)
#pragma unroll
                for (int m = 0; m < 4; ++m) { GAS f32x4* p = (GAS f32x4*)(xb + (size_t)(ai * 128 + wr * 64 + m * 16 + fr) * D + cc);
                    p[0] = p[0] + ga * acc[ai][bj][m][0]; p[1] = p[1] + gb * acc[ai][bj][m][1]; __builtin_amdgcn_sched_barrier(0); } }
    }
};

struct ExpTab { int cnt[16], tile0[17]; };
__device__ __forceinline__ int exp_find(const int (&tile0)[17], int q) { int e = 0;
#pragma unroll
    for (int k = 1; k < 16; ++k) e += (q >= tile0[k]) ? 1 : 0;
    return e; }

struct PMoe1 {
    unsigned char* ws; const LAS int* tab; int G, c; int K; unsigned kstepA;
    __device__ __forceinline__ bool next(int i, Unit& u) const { const long L = (long)i * G + c; const int total = tab[32] * 4; if (L >= total) return false; const int q = (int)L >> 2; u.pn = (int)L & 3;
        int e = 0;
#pragma unroll
        for (int k = 1; k < 16; ++k) e += (q >= tab[16 + k]) ? 1 : 0;
        u.z = e; u.pm = q - tab[16 + e]; return true; }
    __device__ __forceinline__ const char* a_base(const Unit&) const { return (const char*)(ws + WS_HB); }
    __device__ __forceinline__ unsigned a_off(const Unit& u, int h, int R, int Cc) const { int r = u.pm * 256 + h * 128 + R; const int n = tab[u.z]; r = r < n ? r : n - 1;
        const int ent = ((const int*)(ws + WS_LIST))[(size_t)u.z * T + r]; return (unsigned)((ent >> 1) * 1024 + Cc) * 2u; }
    __device__ __forceinline__ const char* b_base(const Unit& u) const { return (const char*)(ws + WS_MOE1) + ((size_t)u.z * 1024 + u.pn * 256) * 1024 * 2; }
    __device__ __forceinline__ void epi(const Acc& acc, const Unit& u, int wr, int wc, int fr, int fq) const {
        const size_t arow0 = (size_t)(tab[16 + u.z] + u.pm) * 256;
#pragma unroll
        for (int ai = 0; ai < 2; ++ai)
#pragma unroll
            for (int m = 0; m < 4; ++m) { const f32x4 g0 = acc[ai][0][m][0], g1 = acc[ai][0][m][1], u0 = acc[ai][1][m][0], u1 = acc[ai][1][m][1];
                const f32x4 v0 = (f32x4){g0[0] * fsigmoid(g0[0]), g0[1] * fsigmoid(g0[1]), g0[2] * fsigmoid(g0[2]), g0[3] * fsigmoid(g0[3])} * u0;
                const f32x4 v1 = (f32x4){g1[0] * fsigmoid(g1[0]), g1[1] * fsigmoid(g1[1]), g1[2] * fsigmoid(g1[2]), g1[3] * fsigmoid(g1[3])} * u1;
                *(GAS v4u*)((bf16*)(ws + WS_ACT) + (arow0 + ai * 128 + wr * 64 + m * 16 + fr) * 512 + u.pn * 128 + wc * 32 + 8 * fq) = pack8(v0, v1); }
    }
};
struct PMoe2 {
    unsigned char* ws; const LAS int* tab; int G, c; int K; unsigned kstepA;
    __device__ __forceinline__ bool next(int i, Unit& u) const { const long L = (long)i * G + c; const int total = tab[32] * 4; if (L >= total) return false; const int q = (int)L >> 2; u.pn = (int)L & 3;
        int e = 0;
#pragma unroll
        for (int k = 1; k < 16; ++k) e += (q >= tab[16 + k]) ? 1 : 0;
        u.z = e; u.pm = q - tab[16 + e]; return true; }
    __device__ __forceinline__ const char* a_base(const Unit& u) const { return (const char*)(ws + WS_ACT) + (size_t)(tab[16 + u.z] + u.pm) * 256 * 512 * 2; }
    __device__ __forceinline__ unsigned a_off(const Unit&, int h, int R, int Cc) const { return (unsigned)((h * 128 + R) * 512 + Cc) * 2u; }
    __device__ __forceinline__ const char* b_base(const Unit& u) const { return (const char*)(ws + WS_MOE2) + ((size_t)u.z * 1024 + u.pn * 256) * 512 * 2; }
    __device__ __forceinline__ void epi(const Acc& acc, const Unit& u, int wr, int wc, int fr, int fq) const {
        const int n = tab[u.z];
#pragma unroll
        for (int ai = 0; ai < 2; ++ai)
#pragma unroll
            for (int m = 0; m < 4; ++m) { const int r = u.pm * 256 + ai * 128 + wr * 64 + m * 16 + fr; if (r >= n) continue;
                const int ent = ((const int*)(ws + WS_LIST))[(size_t)u.z * T + r]; const float w = ((const float*)(ws + WS_RW))[ent];
#pragma unroll
                for (int bj = 0; bj < 2; ++bj)
                    *(GAS v4u*)((bf16*)(ws + WS_YSLOT) + (size_t)ent * 1024 + u.pn * 256 + bj * 128 + wc * 32 + 8 * fq) = pack8(acc[ai][bj][m][0] * w, acc[ai][bj][m][1] * w); }
    }
};
__device__ __forceinline__ void build_exptab(const Ctx& C, LAS int* tab, int l) {
    __syncthreads();
    if (threadIdx.x == 0) { int t0 = 0;
        for (int e = 0; e < 16; ++e) { const int n = (int)__hip_atomic_load((unsigned*)(C.ctl + CW_CNT + l * 1024 + 64 * e), RLX_AGENT); tab[e] = n; tab[16 + e] = t0; t0 += (n + 255) >> 8; }
        tab[32] = t0; }
    __syncthreads();
}
__device__ __forceinline__ void phase_attn(const Ctx& C, int l, unsigned char* lds_gen) {
    phase_carry(C, l);
    char* shm = (char*)lds_gen;
    bf16* QA = WSP(bf16, WS_QA); bf16* KA = WSP(bf16, WS_KA); bf16* VA = WSP(bf16, WS_VA); bf16* QN = WSP(bf16, WS_QN); bf16* KN = WSP(bf16, WS_KN); bf16* VN = WSP(bf16, WS_VN);
#ifndef ATTN_SEL
#define ATTN_SEL 3
#endif
    const int per = (1024 + C.G - 1) / C.G;
    if (ATTN_SEL & 1) for (int i = 0; i < per; ++i) { const int id = C.vcu * per + i; if (id >= 1024) continue; const int bh = id >> 5, b = bh >> 3, h = bh & 7, qb = id & 31;
        const bf16* Qu = QA + (size_t)(b * LB + CTX + qb * 256) * 512 + h * 64;
        attn_body::attn_unit<8, false, 512, 128>(Qu, 512, KA + (size_t)(b * LB) * 128 + (h >> 2) * 64, VA + (size_t)(b * LB) * 128 + (h >> 2) * 64, 128, (bf16*)Qu, LB / 64, 0, 0, shm);
    }
    LAS float* bt = (LAS float*)(C.lds + attn_body::LDS_BT);
    const int nctx = (C.vcu >= 64 && C.vcu < 128) ? 1 : 0;
    if (ATTN_SEL & 2) for (int i = 0; i < per + nctx; ++i) {
        const bf16 *Qu, *Kh, *Vh; int kvp = 512, NT = 4, r0 = 0, rlo = 0;
        if (i < per) { const int id = C.vcu * per + i; if (id >= 1024) continue; const int bh = id >> 5, b = bh >> 3, h = bh & 7; r0 = (id & 31) * 4;
            const float* rp = C.in[I_RPB] + (size_t)(l * 8 + h) * 465;
            for (int k = C.tid; k < 465; k += 512) bt[k] = rp[k] * LOG2E;
            rlo = r0 - 4 < 0 ? 0 : (r0 - 4 > 120 ? 120 : r0 - 4); const int rh_ = r0 - 1 < 0 ? 0 : (r0 - 1 > 120 ? 120 : r0 - 1), nloc = rh_ + 8 - rlo; NT = (4 + nloc + 1) & ~1;
            Qu = QN + (size_t)(b * LB + CTX + r0 * 64) * 512 + h * 64; Kh = KN + (size_t)(b * LB) * 512 + h * 64; Vh = VN + (size_t)(b * LB) * 512 + h * 64; }
        else { int j = C.vcu - 64; if (j < 32) { const int b = j >> 3, h = j & 7; Qu = QA + (size_t)(b * LB) * 512 + h * 64; Kh = KA + (size_t)(b * LB) * 128 + (h >> 2) * 64; Vh = VA + (size_t)(b * LB) * 128 + (h >> 2) * 64; kvp = 128; }
            else { j -= 32; const int b = j >> 3, h = j & 7; Qu = QN + (size_t)(b * LB) * 512 + h * 64; Kh = KN + (size_t)(b * LB) * 512 + h * 64; Vh = VN + (size_t)(b * LB) * 512 + h * 64; } }
        attn_body::attn_unit<8, true, 512, 0>(Qu, 512, Kh, Vh, kvp, (bf16*)Qu, NT, r0, rlo, shm);
    }
}

constexpr int NPH = 46;
__global__ void __launch_bounds__(NWAVES * 64, 2) fwd(Args args) {
    extern __shared__ __attribute__((aligned(16))) unsigned char lds[];
    Ctx C; C.in = (const __attribute__((address_space(4))) CFP*)__builtin_amdgcn_kernarg_segment_ptr(); C.out = args.out; C.ws = args.ws; C.lds = (LAS unsigned char*)lds; C.ctl = (gu32*)(args.ws + WS_CTL);
    C.tid = 0; C.lane = 0; C.wave = __builtin_amdgcn_readfirstlane((int)threadIdx.x >> 6);
    C.G = gridDim.x; { const int bx = blockIdx.x; C.vcu = (C.G % 8 == 0) ? (bx % 8) * (C.G / 8) + bx / 8 : bx; }
    for (int u = threadIdx.x; u < (LDS_BYTES - LDSCTL_OFF) / 4; u += NWAVES * 64) ((LAS unsigned*)(C.lds + LDSCTL_OFF))[u] = 0u;
    __syncthreads();
    const int lo = args.ph_lo, hi = args.ph_hi;
    XcdBarrier bar; bar.bar = (unsigned*)(C.ctl + CW_BAR); bar.x = 0; bar.st = nullptr;
    if (hi - lo > 1) bar = xcd_barrier_post((unsigned*)(C.ctl + CW_BAR), (volatile LAS unsigned*)(C.lds + MISC_OFF) + 8);
    LAS int* tab = (LAS int*)(C.lds + LDSCTL_OFF);
    const int cg = (int)blockIdx.x;
#ifndef PHMASK
#define PHMASK 0xFFFF
#endif
#define IN(k) (lo <= (k) && (k) < hi)
#define EN(b) ((PHMASK >> (b)) & 1)
#define SEAM(k) do { if (IN(k) && IN((k) + 1)) xcd_barrier(bar); } while (0)
#define LWS() ({ const __attribute__((address_space(4))) CFP* k_ = C.in; asm volatile("" : "+s"(k_)); (unsigned char*)k_[30]; })
#define LC() ({ Ctx c_ = C; c_.tid = threadIdx.x; asm volatile("" : "+v"(c_.tid)); c_.lane = c_.tid & 63; asm volatile("" : "+s"(c_.in)); c_.ws = (unsigned char*)c_.in[30]; c_.out = (float*)c_.in[29]; c_.ctl = (gu32*)(c_.ws + WS_CTL); c_; })
    if (EN(11) && IN(0)) { const Ctx Cl = LC(); phase_mod(Cl); phase_s5mats(Cl, 0); phase_weights(Cl, 0); }
    SEAM(0);
    for (int l = 0; l < NLAYER; ++l) {
        const int pb = 1 + 11 * l;
        if (EN(0) && IN(pb)) { const Ctx Cl = LC(); if (l == 0) phase_rows<0>(Cl, 0); else { phase_s5mats(Cl, l); phase_weights(Cl, l); phase_rows<1>(Cl, l); } }
        SEAM(pb);
        if (EN(1) && IN(pb + 1)) { PWin P{LWS(), C.G, cg, 1024, 128u}; pg8::gemm_phase(C.lds, P); }
        SEAM(pb + 1);
        if (EN(2) && IN(pb + 2)) { { const Ctx Cl = LC(); phase_qkprep(Cl, l); } PS5A P{LWS(), C.G, cg, 512, 4096u}; pg8::gemm_phase(C.lds, P); }
        SEAM(pb + 2);
        if (EN(3) && IN(pb + 3)) { const Ctx Cl = LC(); phase_attn(Cl, l, lds); }
        SEAM(pb + 3);
        if (EN(4) && IN(pb + 4)) { PS5B P{LWS(), C.G, cg, 256, 128u}; pg8::gemm_phase(C.lds, P); }
        SEAM(pb + 4);
        if (EN(5) && IN(pb + 5)) { PGlu P{LWS(), C.G, cg, 512, 128u}; pg8::gemm_phase(C.lds, P); }
        SEAM(pb + 5);
        if (EN(6) && IN(pb + 6)) { PMerge P{LWS(), C.G, cg, 512, 128u}; pg8::gemm_phase(C.lds, P); }
        SEAM(pb + 6);
        if (EN(7) && IN(pb + 7)) { unsigned char* wl_ = LWS(); PWout P{wl_, (float*)C.in[29], (const float*)(wl_ + WS_MOD) + (size_t)l * 5 * 6144, C.G, cg, 1024, 128u}; pg8::gemm_phase(C.lds, P); }
        SEAM(pb + 7);
        if (EN(8) && IN(pb + 8)) { const Ctx Cl = LC(); phase_norm2(Cl, l); }
        SEAM(pb + 8);
        if (EN(9) && IN(pb + 9)) { build_exptab(C, tab, l); PMoe1 P{LWS(), tab, C.G, cg, 1024, 128u}; pg8::gemm_phase(C.lds, P); }
        SEAM(pb + 9);
        if (EN(10) && IN(pb + 10)) { build_exptab(C, tab, l); PMoe2 P{LWS(), tab, C.G, cg, 512, 128u}; pg8::gemm_phase(C.lds, P); }
        SEAM(pb + 10);
    }
    if (EN(12) && IN(NPH - 1)) { const Ctx Cl = LC(); phase_rows<2>(Cl, NLAYER); }
#undef IN
#undef SEAM
}

#ifndef MK_PER_PHASE
#define MK_PER_PHASE 1
#endif
extern "C" void kernel_launch(void* const* d_in, const int* in_sizes, int n_in, void* d_out, int out_size, void* d_ws, size_t ws_size, hipStream_t stream) {
    static int grid = 0;
    if (grid == 0) {
        if (n_in != 29 || out_size != NB * SEQ * D || ws_size < WS_END) { fprintf(stderr, "kernel_launch: unexpected shapes (n_in %d out %d ws %zu)\n", n_in, out_size, ws_size); grid = -1; return; }
        int dev = 0, cus = 0, per_cu = 0;
        if (hipGetDevice(&dev) != hipSuccess || hipDeviceGetAttribute(&cus, hipDeviceAttributeMultiprocessorCount, dev) != hipSuccess) { grid = -1; return; }
        if (hipFuncSetAttribute((const void*)fwd, hipFuncAttributeMaxDynamicSharedMemorySize, LDS_BYTES) != hipSuccess) { grid = -1; return; }
        if (hipOccupancyMaxActiveBlocksPerMultiprocessor(&per_cu, (const void*)fwd, NWAVES * 64, LDS_BYTES) != hipSuccess || per_cu < 1) fprintf(stderr, "kernel_launch: occupancy query says %d\n", per_cu);
        (void)hipGetLastError();
        grid = cus;
    }
    if (grid < 0) return;
    (void)hipMemsetAsync((char*)d_ws + WS_CTL, 0, CTL_ZERO_BYTES, stream);
    Args a{};
    for (int i = 0; i < 29; ++i) a.in[i] = (const float*)d_in[i];
    a.out = (float*)d_out; a.ws = (unsigned char*)d_ws;
#if MK_PER_PHASE
    for (int p = 0; p < NPH; ++p) { a.ph_lo = p; a.ph_hi = p + 1; hipLaunchKernelGGL(fwd, dim3(grid), dim3(NWAVES * 64), LDS_BYTES, stream, a); }
#else
    a.ph_lo = 0; a.ph_hi = NPH; hipLaunchKernelGGL(fwd, dim3(grid), dim3(NWAVES * 64), LDS_BYTES, stream, a);
#endif
}
```

```cpp
#include <hip/hip_runtime.h>
#include <cstdio>
#include <cstdint>

#define GAS __attribute__((address_space(1)))
#define LAS __attribute__((address_space(3)))
typedef unsigned short bf16;
typedef unsigned v4u __attribute__((ext_vector_type(4)));
typedef unsigned v2u __attribute__((ext_vector_type(2)));
typedef float f32x4 __attribute__((ext_vector_type(4)));
typedef float f32x2 __attribute__((ext_vector_type(2)));
typedef float f32x16 __attribute__((ext_vector_type(16)));
typedef short bf16x8 __attribute__((ext_vector_type(8)));
typedef short s16x4 __attribute__((ext_vector_type(4)));
typedef GAS unsigned gu32;
#define RLX_AGENT __ATOMIC_RELAXED, __HIP_MEMORY_SCOPE_AGENT
#define LDS_WAIT() asm volatile("s_waitcnt lgkmcnt(0)" ::: "memory")
#define VM_WAIT() asm volatile("s_waitcnt vmcnt(0)" ::: "memory")

constexpr int NB = 4, SEQ = 8192, CTX = 256, LB = SEQ + CTX, T = NB * LB, D = 1024, NPAN = T / 256;
constexpr int NLAYER = 4, INW = 5888, NCH = LB / 32, NCR = NB * NCH;
constexpr int NEXP = 16, FF = 512;
constexpr float EPS = 1e-6f;
constexpr float LOG2E = 1.4426950408889634f;
constexpr float C2 = 0.125f * LOG2E;
constexpr int NWAVES = 8;

constexpr size_t MiB = 1u << 20;
constexpr size_t WS_CTL = 0, CTL_ZERO_BYTES = 1 * MiB;
constexpr size_t WS_MOD = 1 * MiB;
constexpr size_t WS_LIST = 2 * MiB;
constexpr size_t WS_RW = 5 * MiB;
constexpr size_t WS_CTXS = 6 * MiB;
constexpr size_t WS_SST = 10 * MiB;
constexpr size_t WS_XST = 44 * MiB;
constexpr size_t WS_BT1 = 61 * MiB;
constexpr size_t WS_BT2 = 85 * MiB;
constexpr size_t WS_WIN = 93 * MiB;
constexpr size_t WS_WGLU = 105 * MiB;
constexpr size_t WS_WBR = 106 * MiB;
constexpr size_t WS_WOUT = 109 * MiB;
constexpr size_t WS_MOE1 = 111 * MiB;
constexpr size_t WS_MOE2 = 143 * MiB;
constexpr size_t WS_HB = 159 * MiB;
constexpr size_t WS_U = 225 * MiB;
constexpr size_t WS_QA = 258 * MiB;
constexpr size_t WS_KA = 291 * MiB;
constexpr size_t WS_VA = 300 * MiB;
constexpr size_t WS_QN = 309 * MiB;
constexpr size_t WS_KN = 342 * MiB;
constexpr size_t WS_VN = 375 * MiB;
constexpr size_t WS_YS = 408 * MiB;
constexpr size_t WS_GATES = 441 * MiB;
constexpr size_t WS_ACT = WS_QN;
constexpr size_t WS_YSLOT = WS_GATES;
constexpr size_t WS_END = 640 * MiB;
static_assert(WS_GATES + (size_t)T * 3072 * 2 <= WS_END && WS_ACT + (size_t)(2 * T + 4096) * 512 * 2 <= WS_YS, "ws map");
constexpr int CW_FAIL = 8;
constexpr int CW_CNT = 64;
constexpr int CW_BAR = 8192;

constexpr int RING_BYTES = 131072, LDSCTL_OFF = RING_BYTES, MISC_OFF = LDSCTL_OFF + 320, LDS_BYTES = 147456;

__device__ __forceinline__ unsigned f2bf(float f) { unsigned u = __builtin_bit_cast(unsigned, f); return (u + 0x7fffu + ((u >> 16) & 1u)) >> 16; }
__device__ __forceinline__ unsigned pk2(float lo, float hi) { return f2bf(lo) | (f2bf(hi) << 16); }
__device__ __forceinline__ float bf2f(unsigned b) { return __builtin_bit_cast(float, b << 16); }
__device__ __forceinline__ float bflo(unsigned w) { return __builtin_bit_cast(float, w << 16); }
__device__ __forceinline__ float bfhi(unsigned w) { return __builtin_bit_cast(float, w & 0xffff0000u); }
__device__ __forceinline__ unsigned cvt_pk_bf16(float lo, float hi) { unsigned r; asm volatile("v_cvt_pk_bf16_f32 %0, %1, %2" : "=v"(r) : "v"(lo), "v"(hi)); return r; }
__device__ __forceinline__ float fsigmoid(float x) { return __builtin_amdgcn_rcpf(1.f + __builtin_amdgcn_exp2f(-LOG2E * x)); }
__device__ __forceinline__ float gelu_tanh(float x) { const float u = 0.7978845608f * (x + 0.044715f * x * x * x); return x * __builtin_amdgcn_rcpf(1.f + __builtin_amdgcn_exp2f(-2.f * LOG2E * u)); }
__device__ __forceinline__ float shflx(float v, int m, int lane) { return __builtin_bit_cast(float, __builtin_amdgcn_ds_bpermute((lane ^ m) << 2, __builtin_bit_cast(int, v))); }
__device__ __forceinline__ float wave_sum(float v, int lane) {
#pragma unroll
    for (int o = 1; o < 64; o <<= 1) v += shflx(v, o, lane);
    return v;
}
__device__ __forceinline__ float sin_rev(float r) { r = r - floorf(r); return __builtin_amdgcn_sinf(r); }
__device__ __forceinline__ float cos_rev(float r) { r = r - floorf(r); return __builtin_amdgcn_cosf(r); }

#define XB_TMO      128
#define XB_XCNT(j)  (256  + 64 * (j))
#define XB_XSUB(j)  (1280 + 64 * (j))
#define XB_XGEN(j)  (2304 + 64 * (j))
#define XB_TOP      3328
#define XB_TOPGEN   3392
#define XCD_BAR_WORDS 3456
#define XB_SPIN_CAP (1u << 22)

__device__ __forceinline__ unsigned xb_ld(unsigned* p)              { return __hip_atomic_load(p, __ATOMIC_RELAXED, __HIP_MEMORY_SCOPE_AGENT); }
__device__ __forceinline__ unsigned xb_add(unsigned* p, unsigned v) { return __hip_atomic_fetch_add(p, v, __ATOMIC_RELAXED, __HIP_MEMORY_SCOPE_AGENT); }
__device__ __forceinline__ unsigned xb_xcc_id() { return (unsigned)__builtin_amdgcn_s_getreg((3 << 11) | 20) & 0xFu; }
#define XB_SPIN(cond, bar) do { unsigned _sp = 0; while (cond) { __builtin_amdgcn_s_sleep(1); \
    if ((++_sp & 255u) == 0u) { if (xb_ld(&(bar)[XB_TMO])) break; if (_sp > XB_SPIN_CAP) { atomicAdd(&(bar)[XB_TMO], 1u); break; } } } } while (0)

struct XcdBarrier { unsigned* bar; unsigned x; volatile LAS unsigned* st; };

__device__ __forceinline__ XcdBarrier xcd_barrier_post(unsigned* bar, volatile LAS unsigned* st) {
    XcdBarrier b; b.bar = bar; b.x = xb_xcc_id(); b.st = st;
    if (threadIdx.x == 0) (void)xb_add(&bar[XB_XCNT(b.x)], 1u);
    return b;
}
__device__ __forceinline__ void xcd_barrier_complete(unsigned* bar, unsigned x, unsigned& nloc, unsigned& nx) {
    const unsigned G = gridDim.x * gridDim.y * gridDim.z;
    unsigned sum, cnt, mine, sp = 0u;
    for (;;) {
        sum = 0u; cnt = 0u; mine = 0u;
#pragma unroll
        for (unsigned j = 0; j < 16; ++j) { const unsigned c = xb_ld(&bar[XB_XCNT(j)]); sum += c; cnt += (c > 0u) ? 1u : 0u; mine = (j == x) ? c : mine; }
        if (sum == G) break;
        __builtin_amdgcn_s_sleep(1);
        if ((++sp & 255u) == 0u) { if (xb_ld(&bar[XB_TMO])) break; if (sp > XB_SPIN_CAP) { atomicAdd(&bar[XB_TMO], 1u); break; } }
    }
    nloc = mine > 0u ? mine : 1u; nx = cnt > 0u ? cnt : 1u;
}
__device__ __forceinline__ void xcd_barrier(const XcdBarrier& b) {
    asm volatile("s_waitcnt vmcnt(0)" ::: "memory");
    __syncthreads();
    if (threadIdx.x == 0) {
        unsigned* bar = b.bar;
        __builtin_amdgcn_s_waitcnt(0);
        unsigned nloc = b.st[0], nx = b.st[1];
        if (nloc == 0u) { xcd_barrier_complete(bar, b.x, nloc, nx); b.st[0] = nloc; b.st[1] = nx; }
        const unsigned old = xb_add(&bar[XB_XSUB(b.x)], 1u);
        const unsigned gen = old / nloc;
        if (old + 1u == (gen + 1u) * nloc) {
            __builtin_amdgcn_fence(__ATOMIC_RELEASE, "agent");
            asm volatile("s_waitcnt vmcnt(0)" ::: "memory");
            const unsigned og = xb_add(&bar[XB_TOP], 1u);
            const unsigned tg = og / nx;
            if (og + 1u == (tg + 1u) * nx) xb_add(&bar[XB_TOPGEN], 1u);
            else XB_SPIN(xb_ld(&bar[XB_TOPGEN]) == tg, bar);
            __builtin_amdgcn_fence(__ATOMIC_ACQUIRE, "agent");
            xb_add(&bar[XB_XGEN(b.x)], 1u);
            asm volatile("s_waitcnt vmcnt(0)" ::: "memory");
        } else {
            XB_SPIN(xb_ld(&bar[XB_XGEN(b.x)]) == gen, bar);
            __builtin_amdgcn_fence(__ATOMIC_ACQUIRE, "agent");
            asm volatile("s_waitcnt vmcnt(0)" ::: "memory");
        }
    }
    __syncthreads();
}

namespace pg8 {
constexpr int BM = 256, BK = 64, HALF = 128, HTB = HALF * BK * 2, STAGE_BYTES = 8 * HTB, NXCD = 8, WGM = 8;
__host__ __device__ __forceinline__ int lds_byte(int r, int c) { const int st = (r >> 4) * 2 + (c >> 5), rr = r & 15, cc = c & 31, ob = rr * 64 + cc * 2; return st * 1024 + (ob ^ (((ob >> 9) & 1) << 5)); }
__host__ __device__ __forceinline__ void stage_rc(int b, int& R, int& C) { const int st = b / 1024, sb = b % 1024, swz = sb ^ (((sb >> 9) & 1) << 5); R = (st >> 1) * 16 + swz / 64; C = (st & 1) * 32 + (swz % 64) / 2; }
__host__ __device__ __forceinline__ int perm32(int rho) { const int n = rho >> 4, i = rho & 15; return 8 * (i >> 2) + 4 * n + (i & 3); }

struct Unit { int pm, pn, z; };

__device__ __forceinline__ void static_decode(int L, int nM, int nN, int& pm, int& pn) {
    const int nwg = nM * nN; int wgid = L;
    { const int q = nwg / NXCD, r = nwg % NXCD, xcd = wgid % NXCD, off = wgid / NXCD; wgid = (xcd < r ? xcd * (q + 1) : r * (q + 1) + (xcd - r) * q) + off; }
    const int nig = WGM * nN, gid = wgid / nig, fm = gid * WGM, gsz = (nM - fm) < WGM ? (nM - fm) : WGM;
    pm = fm + ((wgid % nig) % gsz); pn = (wgid % nig) / gsz;
}

template <class P>
__device__ __forceinline__ void gemm_phase(LAS unsigned char* lds, const P& S) {
    int tid_ = threadIdx.x; asm volatile("" : "+v"(tid_));
    const int tid = tid_, wid = __builtin_amdgcn_readfirstlane(tid >> 6), lane = tid & 63, wr = wid >> 2, wc = wid & 3, fr = lane & 15, fq = lane >> 4;
    const int K = S.K, nt = K / BK;
    unsigned voffB[2];
#pragma unroll
    for (int i = 0; i < 2; ++i) { int R, C; stage_rc(tid * 16 + i * 8192, R, C); const int Rb = (R & ~31) + perm32(R & 31); voffB[i] = (unsigned)(Rb * K + C) * 2u; }
#define PG8_AOFF(dst0, dst1, u) do { _Pragma("unroll") for (int i = 0; i < 2; ++i) { int R, C; stage_rc(tid * 16 + i * 8192, R, C); dst0[i] = S.a_off(u, 0, R, C); dst1[i] = S.a_off(u, 1, R, C); } } while (0)
    const size_t kstepB = (size_t)(BK * 2), hstepB = (size_t)HALF * K * 2, kstepA = (size_t)S.kstepA;
    const unsigned ldsw = (unsigned)wid * 1024u;
    const int aoff = lds_byte(wr * 64 + fr, fq * 8), boff = lds_byte(wc * 32 + fr, fq * 8);
#define PG8_SA(b, h) (((b) * 2 + (h)) * HTB)
#define PG8_SB(b, h) ((4 + (b) * 2 + (h)) * HTB)
#define PG8_STAGE(bufoff, gbase, voff) do { _Pragma("unroll") for (int _i = 0; _i < 2; ++_i) \
        __builtin_amdgcn_global_load_lds((const unsigned*)((const char*)(gbase) + (voff)[_i]), (LAS unsigned*)(lds + (bufoff) + ldsw + _i * 8192), 16, 0, 0); } while (0)
#define PG8_LDA(dst, b, h) do { _Pragma("unroll") for (int m = 0; m < 4; ++m) _Pragma("unroll") for (int k = 0; k < 2; ++k) dst[m][k] = *(const LAS bf16x8*)(lds + PG8_SA(b, h) + aoff + m * 2048 + k * 1024); } while (0)
#define PG8_LDB(dst, b, h) do { _Pragma("unroll") for (int n = 0; n < 2; ++n) _Pragma("unroll") for (int k = 0; k < 2; ++k) dst[n][k] = *(const LAS bf16x8*)(lds + PG8_SB(b, h) + boff + n * 2048 + k * 1024); } while (0)
#define PG8_MMA(ai, bj, At, Bt) do { __builtin_amdgcn_s_setprio(1); _Pragma("unroll") for (int m = 0; m < 4; ++m) _Pragma("unroll") for (int n = 0; n < 2; ++n) _Pragma("unroll") for (int k = 0; k < 2; ++k) \
        acc[ai][bj][m][n] = __builtin_amdgcn_mfma_f32_16x16x32_bf16(Bt[n][k], At[m][k], acc[ai][bj][m][n], 0, 0, 0); __builtin_amdgcn_s_setprio(0); } while (0)
#define PG8_WAIT_V(n) asm volatile("s_waitcnt vmcnt(" #n ")" ::: "memory")
#define PG8_WAIT_L(n) asm volatile("s_waitcnt lgkmcnt(" #n ")" ::: "memory")
#define PG8_BAR __builtin_amdgcn_s_barrier()
#define PG8_SCHED __builtin_amdgcn_sched_barrier(0)
    Unit cur, nxt; int ui = 0;
    if (!S.next(0, cur)) return;
    f32x4 acc[2][2][4][2];
#pragma unroll
    for (int a = 0; a < 2; ++a)
#pragma unroll
        for (int b = 0; b < 2; ++b)
#pragma unroll
            for (int m = 0; m < 4; ++m)
#pragma unroll
                for (int n = 0; n < 2; ++n) acc[a][b][m][n] = (f32x4){0.f, 0.f, 0.f, 0.f};
    bf16x8 At[4][2], B0[2][2], B1[2][2];
    unsigned vA0[2], vA1[2], vN0[2], vN1[2];
    PG8_AOFF(vA0, vA1, cur);
    const char* cA = S.a_base(cur); const char* cB = S.b_base(cur);
    PG8_STAGE(PG8_SB(0, 0), cB, voffB); PG8_STAGE(PG8_SB(0, 1), cB + hstepB, voffB); PG8_STAGE(PG8_SA(0, 0), cA, vA0); PG8_STAGE(PG8_SA(0, 1), cA, vA1);
    if (wr == 1) PG8_BAR;
    PG8_WAIT_V(2); PG8_BAR;
    PG8_STAGE(PG8_SB(1, 0), cB + kstepB, voffB); PG8_STAGE(PG8_SA(1, 0), cA + kstepA, vA0); PG8_STAGE(PG8_SB(1, 1), cB + hstepB + kstepB, voffB);
    PG8_WAIT_V(6); PG8_BAR;
    for (;;) {
        const bool has_next = S.next(ui + 1, nxt);
        const char* nA = cA; const char* nB = cB;
#pragma unroll
        for (int i = 0; i < 2; ++i) { vN0[i] = vA0[i]; vN1[i] = vA1[i]; }
        if (has_next) { nA = S.a_base(nxt); nB = S.b_base(nxt); PG8_AOFF(vN0, vN1, nxt); }
        for (int t = 0; t < nt; t += 2) {
            const bool last = (t == nt - 2);
            const char* a1 = cA + (size_t)(t + 1) * kstepA;
            const char* a2 = last ? nA : cA + (size_t)(t + 2) * kstepA; const char* b2 = last ? nB : cB + (size_t)(t + 2) * kstepB;
            const char* a3 = a2 + kstepA; const char* b3 = b2 + kstepB;
            unsigned w0[2], w1[2];
#pragma unroll
            for (int i = 0; i < 2; ++i) { w0[i] = last ? vN0[i] : vA0[i]; w1[i] = last ? vN1[i] : vA1[i]; }
            PG8_LDB(B0, 0, 0); PG8_LDB(B1, 0, 1); PG8_SCHED; PG8_LDA(At, 0, 0); PG8_STAGE(PG8_SA(1, 1), a1, vA1);
            PG8_WAIT_V(8); PG8_WAIT_L(0); PG8_BAR; PG8_MMA(0, 0, At, B0); PG8_MMA(0, 1, At, B1); PG8_BAR; PG8_SCHED;
            PG8_LDA(At, 0, 1); PG8_STAGE(PG8_SB(0, 0), b2, voffB); PG8_STAGE(PG8_SB(0, 1), b2 + hstepB, voffB); PG8_STAGE(PG8_SA(0, 0), a2, w0);
            PG8_WAIT_V(8); PG8_WAIT_L(0); PG8_BAR; PG8_MMA(1, 0, At, B0); PG8_MMA(1, 1, At, B1); PG8_BAR; PG8_SCHED;
            PG8_LDB(B0, 1, 0); PG8_LDB(B1, 1, 1); PG8_SCHED; PG8_LDA(At, 1, 0); PG8_STAGE(PG8_SA(0, 1), a2, w1);
            PG8_WAIT_V(8); PG8_WAIT_L(0); PG8_BAR; PG8_MMA(0, 0, At, B0); PG8_MMA(0, 1, At, B1); PG8_BAR; PG8_SCHED;
            PG8_LDA(At, 1, 1); PG8_STAGE(PG8_SB(1, 0), b3, voffB); PG8_STAGE(PG8_SB(1, 1), b3 + hstepB, voffB); PG8_STAGE(PG8_SA(1, 0), a3, w0);
            PG8_WAIT_V(8); PG8_WAIT_L(0); PG8_BAR; PG8_MMA(1, 0, At, B0); PG8_MMA(1, 1, At, B1); PG8_BAR; PG8_SCHED;
        }
        if (wr == 0) PG8_BAR;
        S.epi(acc, cur, wr, wc, fr, fq);
        if (!has_next) break;
#pragma unroll
        for (int a = 0; a < 2; ++a)
#pragma unroll
            for (int b = 0; b < 2; ++b)
#pragma unroll
                for (int m = 0; m < 4; ++m)
#pragma unroll
                    for (int n = 0; n < 2; ++n) acc[a][b][m][n] = (f32x4){0.f, 0.f, 0.f, 0.f};
        cur = nxt; cA = nA; cB = nB; ++ui;
#pragma unroll
        for (int i = 0; i < 2; ++i) { vA0[i] = vN0[i]; vA1[i] = vN1[i]; }
        if (wr == 1) PG8_BAR;
    }
    PG8_WAIT_V(0);
    PG8_BAR;
#undef PG8_AOFF
#undef PG8_SA
#undef PG8_SB
#undef PG8_STAGE
#undef PG8_LDA
#undef PG8_LDB
#undef PG8_MMA
#undef PG8_WAIT_V
#undef PG8_WAIT_L
#undef PG8_BAR
#undef PG8_SCHED
}
}
namespace attn_body {
using bf16x8 = __attribute__((ext_vector_type(8))) short;
using u32x4 = __attribute__((ext_vector_type(4))) unsigned;
constexpr int NW = 8, QBLK = 32, QB = QBLK * NW, KVBLK = 64;
__device__ __forceinline__ int crow(int r, int hi) { return (r & 3) + 8 * (r >> 2) + 4 * hi; }
#define SBAR() __builtin_amdgcn_sched_barrier(0)
constexpr int NSLOT = 3, SLOTB = 8192;
constexpr int LDS_K = 0, LDS_V = NSLOT * SLOTB, LDS_WS = 2 * NSLOT * SLOTB, LDS_OST = LDS_WS + NW * 64 * 4, LDS_BYTES = LDS_OST + NW * 4096;
constexpr int LDS_BT = 86016 + 256;
__device__ __forceinline__ void glds16(const void* gsrc, unsigned lds_dst) { unsigned keep;
  asm volatile("s_mov_b32 %0, m0\n\ts_mov_b32 m0, %2\n\ts_nop 0\n\tglobal_load_lds_dwordx4 %1, off\n\ts_mov_b32 m0, %0" : "=&s"(keep) : "v"(gsrc), "s"(lds_dst) : "memory"); }
__device__ __forceinline__ float max3f(float a, float b, float c) { float r; asm("v_max3_f32 %0, %1, %2, %3" : "=v"(r) : "v"(a), "v"(b), "v"(c)); return r; }
__device__ __forceinline__ float max2f(float a, float b) { float r; asm("v_max_f32_e32 %0, %1, %2" : "=v"(r) : "v"(a), "v"(b)); return r; }
__device__ __forceinline__ float fadd_s(float a, float b) { float r; asm("v_add_f32_e32 %0, %1, %2" : "=v"(r) : "v"(a), "v"(b)); return r; }
__device__ __forceinline__ float fsub_s(float a, float b) { float r; asm("v_sub_f32_e32 %0, %1, %2" : "=v"(r) : "v"(a), "v"(b)); return r; }
typedef float f32x2_t __attribute__((ext_vector_type(2))); typedef __bf16 bf16x2_t __attribute__((ext_vector_type(2)));
__device__ __forceinline__ unsigned cvtpk_s(float lo, float hi) { f32x2_t v = {lo, hi}; bf16x2_t b = __builtin_convertvector(v, bf16x2_t); return __builtin_bit_cast(unsigned, b); }
#define WAIT_BAR(N) asm volatile("s_waitcnt vmcnt(" #N ") lgkmcnt(0)\n\ts_barrier" ::: "memory")

__device__ __forceinline__ void qkt(f32x16& p0, f32x16& p1, const char* Kslot, const bf16x8* qr, const f32x16& negm, int r32, int hi) {
  const char* kb = Kslot + hi * 1024 + r32 * 16;
  #pragma unroll
  for (int d0 = 0; d0 < 4; ++d0) {
    const bf16x8 b0 = *reinterpret_cast<const bf16x8*>(kb + d0 * 2048);
    const bf16x8 b1 = *reinterpret_cast<const bf16x8*>(kb + d0 * 2048 + 512);
    if (d0 == 0) { p0 = __builtin_amdgcn_mfma_f32_32x32x16_bf16(b0, qr[0], negm, 0, 0, 0); p1 = __builtin_amdgcn_mfma_f32_32x32x16_bf16(b1, qr[0], negm, 0, 0, 0); }
    else { p0 = __builtin_amdgcn_mfma_f32_32x32x16_bf16(b0, qr[d0], p0, 0, 0, 0); p1 = __builtin_amdgcn_mfma_f32_32x32x16_bf16(b1, qr[d0], p1, 0, 0, 0); } }
}
typedef __attribute__((address_space(3))) const char* lds_cptr;
typedef short v4i16_t __attribute__((ext_vector_type(4)));
__device__ __forceinline__ void kload8(bf16x8* kf, lds_cptr kp) {
  kf[0] = *(const __attribute__((address_space(3))) bf16x8*)(kp);        kf[1] = *(const __attribute__((address_space(3))) bf16x8*)(kp + 512);
  kf[2] = *(const __attribute__((address_space(3))) bf16x8*)(kp + 2048); kf[3] = *(const __attribute__((address_space(3))) bf16x8*)(kp + 2560);
  kf[4] = *(const __attribute__((address_space(3))) bf16x8*)(kp + 4096); kf[5] = *(const __attribute__((address_space(3))) bf16x8*)(kp + 4608);
  kf[6] = *(const __attribute__((address_space(3))) bf16x8*)(kp + 6144); kf[7] = *(const __attribute__((address_space(3))) bf16x8*)(kp + 6656);
}
__device__ __forceinline__ void kload2(bf16x8* kf, lds_cptr kp, int j) { kf[2 * j] = *(const __attribute__((address_space(3))) bf16x8*)(kp + j * 2048); kf[2 * j + 1] = *(const __attribute__((address_space(3))) bf16x8*)(kp + j * 2048 + 512); }
__device__ __forceinline__ s16x4 vtr(lds_cptr p) { return __builtin_bit_cast(s16x4, __builtin_amdgcn_ds_read_tr16_b64_v4i16((__attribute__((address_space(3))) v4i16_t*)p)); }
__device__ __forceinline__ float rowmax(const f32x16& p0, const f32x16& p1) {
  float a = max3f(p0[0], p0[1], p1[0]), b = max3f(p0[2], p0[3], p1[1]); a = max3f(a, p1[2], p1[3]);
  #pragma unroll
  for (int r = 4; r < 16; r += 4) { a = max3f(a, p0[r], p0[r + 1]); b = max3f(b, p0[r + 2], p0[r + 3]); a = max3f(a, p1[r], p1[r + 1]); b = max3f(b, p1[r + 2], p1[r + 3]); }
  const float m = max2f(a, b);
  auto rr = __builtin_amdgcn_permlane32_swap(__float_as_uint(m), __float_as_uint(m), false, false);
  return max2f(__uint_as_float(rr[0]), __uint_as_float(rr[1]));
}
__device__ __forceinline__ void pv(f32x16* o, int vb, bf16x8 pa0, bf16x8 pa1, bf16x8 pa2, bf16x8 pa3) {
  #pragma unroll
  for (int d0 = 0; d0 < 2; ++d0) { s16x4 lo[4], hi[4];
    #pragma unroll
    for (int ks = 0; ks < 4; ++ks) {
      asm volatile("ds_read_b64_tr_b16 %0,%1 offset:%c2" : "=&v"(lo[ks]) : "v"(vb), "i"(d0 * 4096 + ks * 1024) : "memory");
      asm volatile("ds_read_b64_tr_b16 %0,%1 offset:%c2" : "=&v"(hi[ks]) : "v"(vb), "i"(d0 * 4096 + ks * 1024 + 512) : "memory"); }
    asm volatile("s_waitcnt lgkmcnt(0)" ::: "memory"); SBAR();
    #define PK(k) (bf16x8){lo[k][0], lo[k][1], lo[k][2], lo[k][3], hi[k][0], hi[k][1], hi[k][2], hi[k][3]}
    o[d0] = __builtin_amdgcn_mfma_f32_32x32x16_bf16(pa0, PK(0), o[d0], 0, 0, 0);
    o[d0] = __builtin_amdgcn_mfma_f32_32x32x16_bf16(pa1, PK(1), o[d0], 0, 0, 0);
    o[d0] = __builtin_amdgcn_mfma_f32_32x32x16_bf16(pa2, PK(2), o[d0], 0, 0, 0);
    o[d0] = __builtin_amdgcn_mfma_f32_32x32x16_bf16(pa3, PK(3), o[d0], 0, 0, 0);
    #undef PK
  }
}
#define ATTN_STORE16(p, v) (*(u32x4*)(p) = (v))

template <int THRL, bool NA, int QP_, int KVP_>
__device__ __forceinline__ void attn_unit(const bf16* Qu, int qp_rt, const bf16* __restrict__ Kh, const bf16* __restrict__ Vh, int kvp_rt, bf16* Ou, int NT, int r0, int rlo, char* shm) {
  const int qp = QP_ ? QP_ : qp_rt, kvp = KVP_ ? KVP_ : kvp_rt, op = qp;
  int tid_ = threadIdx.x; asm volatile("" : "+v"(tid_));
  const int tid = tid_, lane = tid & 63, r32 = lane & 31, hi = lane >> 5; const int wid = __builtin_amdgcn_readfirstlane(tid >> 6);
  const bf16* Qw = Qu + (long)(wid * QBLK) * qp;
  const unsigned lds0 = (unsigned)(uintptr_t)shm;
  float* wsf = (float*)(shm + LDS_WS) + wid * 64;
  const bf16* ksrc = Kh + (long)lane * kvp + wid * 8;
  const bf16* vsrc = Vh + (long)(16 * (wid & 3) + (lane >> 2)) * kvp + (wid >> 2) * 32 + (lane & 3) * 8;
  const unsigned kdst = lds0 + LDS_K + wid * 1024, vdst = lds0 + LDS_V + wid * 1024;
  #define TROW(t) (NA ? ((t) < 4 ? 64 * (t) : CTX + 64 * ((rlo + (t) - 4) < 127 ? (rlo + (t) - 4) : 127)) : 64 * (t))
  #define DMA_K(t, slot) glds16(ksrc + (long)TROW(t) * kvp, (unsigned)__builtin_amdgcn_readfirstlane(kdst + (slot)))
  #define DMA_V(t, slot) glds16(vsrc + (long)TROW(t) * kvp, (unsigned)__builtin_amdgcn_readfirstlane(vdst + (slot)))
  const int vb0 = (int)(lds0 + LDS_V) + ((lane >> 4) & 1) * 32 + (lane & 3) * 8 + (4 * hi + ((lane & 15) >> 2)) * 64;
  const char* Kbase = shm + LDS_K; bf16x8 kf[8];
  const lds_cptr shm3 = (lds_cptr)shm; const lds_cptr kp0 = shm3 + LDS_K + hi * 1024 + r32 * 16; const lds_cptr vp0 = shm3 + LDS_V + ((lane >> 4) & 1) * 32 + (lane & 3) * 8 + (4 * hi + ((lane & 15) >> 2)) * 64;
  const int rq = r0 + (wid >> 1), qc = 32 * (wid & 1) + r32;
  const int rsw = rq - 4 < 0 ? 0 : (rq - 4 > 120 ? 120 : rq - 4);
  const int cs = qc - 8 < 0 ? 0 : (qc - 8 > 48 ? 48 : qc - 8);
  const __attribute__((address_space(3))) float* btl = (const __attribute__((address_space(3))) float*)(shm3 + LDS_BT) + (15 + 4 * hi - qc);
  DMA_K(0, 0); DMA_V(0, 0); DMA_K(1, SLOTB);
  bf16x8 qr[4];
  #pragma unroll
  for (int d0 = 0; d0 < 4; ++d0) qr[d0] = *reinterpret_cast<const bf16x8*>(&Qw[(long)r32 * qp + d0 * 16 + hi * 8]);
  float mhat = 0.f, l_reg = 0.f; f32x16 o[2]; o[0] = f32x16{}; o[1] = f32x16{}; f32x16 negm = f32x16{}; if (!NA) asm volatile("" : "+v"(negm));
  #define NEGM (NA ? f32x16{} : negm)
  #define CMASK(P0, P1, t) do { if (NA) { if ((t) >= 4) { const int kr_ = rlo + (t) - 4; const int dr_ = kr_ - rsw; \
      if (dr_ < 0 || dr_ >= 8) { _Pragma("unroll") for (int r = 0; r < 16; ++r) { P0[r] = (-__builtin_inff()); P1[r] = (-__builtin_inff()); } } \
      else { const __attribute__((address_space(3))) float* bp_ = btl + (kr_ - rq + 7) * 31; const int kl0_ = 4 * hi - cs; \
        _Pragma("unroll") for (int rg = 0; rg < 4; ++rg) { \
          _Pragma("unroll") for (int rr_ = 0; rr_ < 4; ++rr_) { const int r = rg * 4 + rr_; const int kc_ = (r & 3) + 8 * (r >> 2); const float b0_ = bp_[kc_], b1_ = bp_[kc_ + 32]; \
            const int kl_ = kc_ + kl0_; P0[r] = ((unsigned)kl_ < 16u) ? P0[r] + b0_ : (-__builtin_inff()); P1[r] = ((unsigned)(kl_ + 32) < 16u) ? P1[r] + b1_ : (-__builtin_inff()); } \
          SBAR(); } } } } } while (0)
  bool resc = false;
  #define START(P0, P1) do { const float rm = rowmax(P0, P1); resc = false; \
    { const float dl = rm; mhat = fadd_s(mhat, dl); \
      _Pragma("unroll") for (int r = 0; r < 16; ++r) { P0[r] = fsub_s(P0[r], dl); P1[r] = fsub_s(P1[r], dl); } \
      if (!NA) { _Pragma("unroll") for (int r = 0; r < 16; ++r) negm[r] = -mhat; asm volatile("" : "+v"(negm)); } } \
    _Pragma("unroll") for (int r = 0; r < 16; ++r) P0[r] = __builtin_amdgcn_exp2f(P0[r]); } while (0)
  #define RESC() do { if (resc) { asm volatile("s_waitcnt lgkmcnt(0)" ::: "memory"); \
      _Pragma("unroll") for (int d_ = 0; d_ < 2; ++d_) _Pragma("unroll") for (int r = 0; r < 16; ++r) o[d_][r] *= wsf[crow(r, hi)]; } } while (0)
  f32x16 pA0, pA1, pB0, pB1;
  int sl_prev = 0, sl_cur = 0, sl_next = SLOTB;
  #define ROT() do { sl_prev = sl_cur; sl_cur = sl_next; sl_next = (sl_next == (NSLOT - 1) * SLOTB) ? 0 : sl_next + SLOTB; } while (0)
  DMA_K(2, 2 * SLOTB);
  WAIT_BAR(3);
  qkt(pA0, pA1, Kbase, qr, NEGM, r32, hi); asm volatile("s_nop 15\n\ts_nop 7" : "+v"(pA0), "+v"(pA1));
  START(pA0, pA1);
  _Pragma("unroll") for (int r = 0; r < 16; ++r) pA1[r] = __builtin_amdgcn_exp2f(pA1[r]);
  WAIT_BAR(0);
  DMA_K(3, 0); DMA_V(1, SLOTB);
  ROT();
  kload8(kf, kp0 + sl_cur);
  WAIT_BAR(2);
  s16x4 vlo[8], vhi[8]; u32x4 pw0, pw1, pw2, pw3;
  #define PKW(P, B) cvtpk_s(P[B], P[B + 1])
  #define PAF(k) __builtin_bit_cast(bf16x8, pw##k)
  #define VFR(i) (bf16x8){vlo[i][0], vlo[i][1], vlo[i][2], vlo[i][3], vhi[i][0], vhi[i][1], vhi[i][2], vhi[i][3]}
  #define PIN(x) asm volatile("" : "+v"(x))
  #define MX3(a, b, c) __builtin_fmaxf(__builtin_fmaxf((a), (b)), (c))
  #define GAPA(MF, A0, A1, A2, A3, W0, W1, PW) do { MF; sacc += A0; sacc += A1; sacc += A2; sacc += A3; PIN(sacc); W0; W1; PIN(PW); SBAR(); } while (0)
  #define EX(v) __builtin_amdgcn_exp2f(v)
  #define GAPB(MF, X, B) do { MF; X[B] = EX(X[B]); X[B + 1] = EX(X[B + 1]); X[B + 2] = EX(X[B + 2]); X[B + 3] = EX(X[B + 3]); PIN(X); SBAR(); } while (0)
  #define VRD(i) do { vlo[i] = vtr(vp_ + (((i) >> 2) * 4096 + ((i) & 3) * 1024)); vhi[i] = vtr(vp_ + (((i) >> 2) * 4096 + ((i) & 3) * 1024 + 512)); } while (0)
  #define KRD(G, j) do { if (G) { kload2(kf, kp0 + sl_next, j); SBAR(); } } while (0)
  #define STEP(C0, C1, P0, P1, t, GK, GV, GL) do { SBAR(); \
    const lds_cptr vp_ = vp0 + sl_prev; \
    VRD(0); SBAR(); float sacc = (P0[0] + P0[1]); \
    GAPA(C0 = __builtin_amdgcn_mfma_f32_32x32x16_bf16(kf[0], qr[0], NEGM, 0, 0, 0), P0[2], P0[3], P0[4], P0[5],     pw0[0] = PKW(P0, 0), pw0[1] = PKW(P0, 2), pw0); \
    VRD(4); SBAR(); GAPA(C1 = __builtin_amdgcn_mfma_f32_32x32x16_bf16(kf[1], qr[0], NEGM, 0, 0, 0), P0[6], P0[7], P0[8], P0[9],     pw0[2] = PKW(P0, 4), pw0[3] = PKW(P0, 6), pw0); \
    VRD(1); SBAR(); GAPA(C0 = __builtin_amdgcn_mfma_f32_32x32x16_bf16(kf[2], qr[1], C0, 0, 0, 0),   P0[10], P0[11], P0[12], P0[13], pw1[0] = PKW(P0, 8), pw1[1] = PKW(P0, 10), pw1); \
    VRD(5); SBAR(); GAPA(C1 = __builtin_amdgcn_mfma_f32_32x32x16_bf16(kf[3], qr[1], C1, 0, 0, 0),   P0[14], P0[15], P1[0], P1[1],   pw1[2] = PKW(P0, 12), pw1[3] = PKW(P0, 14), pw1); \
    VRD(2); SBAR(); GAPA(C0 = __builtin_amdgcn_mfma_f32_32x32x16_bf16(kf[4], qr[2], C0, 0, 0, 0),   P1[2], P1[3], P1[4], P1[5],     pw2[0] = PKW(P1, 0), pw2[1] = PKW(P1, 2), pw2); \
    VRD(6); SBAR(); GAPA(C1 = __builtin_amdgcn_mfma_f32_32x32x16_bf16(kf[5], qr[2], C1, 0, 0, 0),   P1[6], P1[7], P1[8], P1[9],     pw2[2] = PKW(P1, 4), pw2[3] = PKW(P1, 6), pw2); \
    VRD(3); SBAR(); GAPA(C0 = __builtin_amdgcn_mfma_f32_32x32x16_bf16(kf[6], qr[3], C0, 0, 0, 0),   P1[10], P1[11], P1[12], P1[13], pw3[0] = PKW(P1, 8), pw3[1] = PKW(P1, 10), pw3); \
    VRD(7); SBAR(); GAPA(C1 = __builtin_amdgcn_mfma_f32_32x32x16_bf16(kf[7], qr[3], C1, 0, 0, 0),   P1[14], P1[15], 0.f, 0.f,       pw3[2] = PKW(P1, 12), pw3[3] = PKW(P1, 14), pw3); \
    l_reg += sacc; \
    if (GK) { DMA_K((t) + 3, sl_cur); } if (GV) { DMA_V((t) + 1, sl_next); } \
    if (NA) { _Pragma("unroll") for (int r = 0; r < 16; ++r) { C0[r] -= mhat; C1[r] -= mhat; } } \
    CMASK(C0, C1, t); \
    { float a = MX3(C0[0], C0[1], C1[0]), b = MX3(C0[2], C0[3], C1[1]); a = MX3(a, C1[2], C1[3]); \
      _Pragma("unroll") for (int r = 4; r < 16; r += 4) { a = MX3(a, C0[r], C0[r + 1]); b = MX3(b, C0[r + 2], C0[r + 3]); a = MX3(a, C1[r], C1[r + 1]); b = MX3(b, C1[r + 2], C1[r + 3]); } \
      float rm = __builtin_fmaxf(a, b); { auto rr = __builtin_amdgcn_permlane32_swap(__float_as_uint(rm), __float_as_uint(rm), false, false); rm = __builtin_fmaxf(__uint_as_float(rr[0]), __uint_as_float(rr[1])); } \
      resc = false; \
      if (__builtin_expect(__any(rm > (float)THRL), 0)) { const float dl = __builtin_fmaxf(rm, 0.f); mhat += dl; \
        _Pragma("unroll") for (int r = 0; r < 16; ++r) { C0[r] -= dl; C1[r] -= dl; } \
        if (!NA) { _Pragma("unroll") for (int r = 0; r < 16; ++r) negm[r] = -mhat; asm volatile("" : "+v"(negm)); } \
        const float f = __builtin_amdgcn_exp2f(-dl); l_reg *= f; if (hi == 0) wsf[r32] = f; resc = true; } } \
    SBAR(); \
    GAPB(o[0] = __builtin_amdgcn_mfma_f32_32x32x16_bf16(PAF(0), VFR(0), o[0], 0, 0, 0), C0, 0); \
    GAPB(o[1] = __builtin_amdgcn_mfma_f32_32x32x16_bf16(PAF(0), VFR(4), o[1], 0, 0, 0), C0, 4); \
    KRD(GL, 0); GAPB(o[0] = __builtin_amdgcn_mfma_f32_32x32x16_bf16(PAF(1), VFR(1), o[0], 0, 0, 0), C0, 8); \
    KRD(GL, 1); GAPB(o[1] = __builtin_amdgcn_mfma_f32_32x32x16_bf16(PAF(1), VFR(5), o[1], 0, 0, 0), C0, 12); \
    KRD(GL, 2); GAPB(o[0] = __builtin_amdgcn_mfma_f32_32x32x16_bf16(PAF(2), VFR(2), o[0], 0, 0, 0), C1, 0); \
    KRD(GL, 3); GAPB(o[1] = __builtin_amdgcn_mfma_f32_32x32x16_bf16(PAF(2), VFR(6), o[1], 0, 0, 0), C1, 4); \
    GAPB(o[0] = __builtin_amdgcn_mfma_f32_32x32x16_bf16(PAF(3), VFR(3), o[0], 0, 0, 0), C1, 8); \
    GAPB(o[1] = __builtin_amdgcn_mfma_f32_32x32x16_bf16(PAF(3), VFR(7), o[1], 0, 0, 0), C1, 12); \
    } while (0)
  int t = 1;
  for (; t + 5 < NT; t += 2) {
    STEP(pB0, pB1, pA0, pA1, t, true, true, true);     WAIT_BAR(2); RESC(); ROT();
    STEP(pA0, pA1, pB0, pB1, t + 1, true, true, true); WAIT_BAR(2); RESC(); ROT();
  }
  #define ENDW(tt) do { if ((tt) + 3 < NT) { WAIT_BAR(2); } else if ((tt) + 2 < NT) { WAIT_BAR(1); } else { WAIT_BAR(0); } } while (0)
  for (; t + 1 < NT; t += 2) {
    STEP(pB0, pB1, pA0, pA1, t, (t + 3 < NT), (t + 1 < NT), (t + 1 < NT));         ENDW(t);     RESC(); ROT();
    STEP(pA0, pA1, pB0, pB1, t + 1, (t + 4 < NT), (t + 2 < NT), (t + 2 < NT));     ENDW(t + 1); RESC(); ROT();
  }
  STEP(pB0, pB1, pA0, pA1, NT - 1, false, false, false); RESC();
  { float sacc = pB0[0] + pB0[1]; _Pragma("unroll") for (int r = 2; r < 16; ++r) sacc += pB0[r]; _Pragma("unroll") for (int r = 0; r < 16; ++r) sacc += pB1[r]; l_reg += sacc;
    pw0 = (u32x4){PKW(pB0, 0), PKW(pB0, 2), PKW(pB0, 4), PKW(pB0, 6)}; pw1 = (u32x4){PKW(pB0, 8), PKW(pB0, 10), PKW(pB0, 12), PKW(pB0, 14)}; pw2 = (u32x4){PKW(pB1, 0), PKW(pB1, 2), PKW(pB1, 4), PKW(pB1, 6)}; pw3 = (u32x4){PKW(pB1, 8), PKW(pB1, 10), PKW(pB1, 12), PKW(pB1, 14)};
    SBAR(); pv(o, vb0 + sl_cur, PAF(0), PAF(1), PAF(2), PAF(3)); }
  #undef PKW
  #undef PAF
  #undef VFR
  #undef PIN
  #undef MX3
  #undef GAPA
  #undef GAPB
  #undef EX
  #undef VRD
  #undef KRD
  #undef STEP
  #undef ENDW
  { auto rr = __builtin_amdgcn_permlane32_swap(__float_as_uint(l_reg), __float_as_uint(l_reg), false, false); l_reg = __uint_as_float(rr[0]) + __uint_as_float(rr[1]); }
  if (hi == 0) wsf[32 + r32] = l_reg; asm volatile("s_waitcnt lgkmcnt(0)" ::: "memory");
  float rli[16];
  #pragma unroll
  for (int r = 0; r < 16; ++r) rli[r] = __builtin_amdgcn_rcpf(wsf[32 + crow(r, hi)]);
  bf16* Ow = Ou + (long)(wid * QBLK) * op;
  { bf16* stg = (bf16*)(shm + LDS_OST) + wid * 2048;
    #pragma unroll
    for (int r = 0; r < 16; ++r) { const int orow = crow(r, hi);
      #pragma unroll
      for (int d0 = 0; d0 < 2; ++d0) stg[orow * 64 + d0 * 32 + r32] = (bf16)f2bf(o[d0][r] * rli[r]); }
    asm volatile("s_waitcnt lgkmcnt(0)" ::: "memory");
    #pragma unroll
    for (int i = 0; i < 4; ++i) { const int row = i * 8 + (lane >> 3), ch = lane & 7; const u32x4 v = *(const u32x4*)(stg + row * 64 + ch * 8); ATTN_STORE16(Ow + (long)row * op + ch * 8, v); } }
  asm volatile("s_waitcnt lgkmcnt(0)\n\ts_barrier" ::: "memory");
  #undef NEGM
  #undef DMA_K
  #undef DMA_V
  #undef TROW
  #undef CMASK
  #undef START
  #undef RESC
  #undef ROT
}
#undef SBAR
#undef WAIT_BAR
}
struct Args { const float* in[29]; float* out; unsigned char* ws; int ph_lo, ph_hi; };
enum { I_X = 0, I_C, I_CTX, I_CCTX, I_WMOD, I_BMOD, I_N1G, I_N2G, I_WIN, I_LRE, I_LIM, I_LDT, I_BRE, I_BIM, I_CRE, I_CIM, I_SSMD, I_WGLU, I_QNG, I_KNG, I_RPB, I_WBR, I_WOUT, I_RW, I_RB, I_MG, I_MU, I_MD, I_FNG };

typedef const float* CFP;
struct Ctx {
    const __attribute__((address_space(4))) CFP* in; float* out; unsigned char* ws; LAS unsigned char* lds; gu32* ctl;
    int tid, lane, wave, vcu, G;
};
#define WSP(T_, off) ((T_*)(C.ws + (off)))

__device__ __forceinline__ float* xs_row(const Ctx& C, int m) { const int b = m / LB, j = m - b * LB; return j < CTX ? WSP(float, WS_CTXS) + (size_t)(b * CTX + j) * D : C.out + (size_t)(b * SEQ + j - CTX) * D; }
__device__ __forceinline__ const float* in_row(const Ctx& C, int m) { const int b = m / LB, j = m - b * LB; return j < CTX ? C.in[I_CTX] + (size_t)(b * CTX + j) * D : C.in[I_X] + (size_t)(b * SEQ + j - CTX) * D; }
__device__ __forceinline__ int cond_of(int m) { const int b = m / LB, j = m - b * LB; return j < CTX ? 4 : b; }

__device__ __forceinline__ void transpose_item(const float* W, int N, int Kp, bf16* WT, int k0, int n0, int drow0, LAS float* scr, int lane) {
#pragma unroll 8
    for (int i = 0; i < 32; ++i) { const int kk = 2 * i + (lane >> 5); scr[kk * 33 + (lane & 31)] = W[(size_t)(k0 + kk) * N + n0 + (lane & 31)]; }
    LDS_WAIT(); asm volatile("" ::: "memory");
    const int c = lane & 7;
#pragma unroll
    for (int j = 0; j < 4; ++j) { const int n = (lane >> 3) + 8 * j; const LAS float* s = scr + (8 * c) * 33 + n;
        v4u o; o.x = pk2(s[0 * 33], s[1 * 33]); o.y = pk2(s[2 * 33], s[3 * 33]); o.z = pk2(s[4 * 33], s[5 * 33]); o.w = pk2(s[6 * 33], s[7 * 33]);
        *(GAS v4u*)(WT + (size_t)(drow0 + n) * Kp + k0 + 8 * c) = o; }
    LDS_WAIT(); asm volatile("" ::: "memory");
}
__device__ __forceinline__ void phase_weights(const Ctx& C, int l) {
    LAS float* scr = (LAS float*)(C.lds + C.wave * 8704);
    const int gw = C.vcu * NWAVES + C.wave, NGW = C.G * NWAVES;
    constexpr int I0 = 16 * 184, I1 = 8 * 16, I2 = 3 * 8 * 32, I3 = 16 * 32, I4 = 16 * 16 * 16, I5 = I4, I6 = 16 * 8 * 32;
    for (int it = gw; it < I0 + I1 + I2 + I3 + I4 + I5 + I6; it += NGW) {
        int r = it;
        if (r < I0) { const int kb = r / 184, nb = r % 184; transpose_item(C.in[I_WIN] + (size_t)l * 1024 * INW, INW, 1024, WSP(bf16, WS_WIN), 64 * kb, 32 * nb, 32 * nb, scr, C.lane); continue; } r -= I0;
        if (r < I1) { const int kb = r / 16, nb = r % 16; transpose_item(C.in[I_WGLU] + (size_t)l * 512 * 512, 512, 512, WSP(bf16, WS_WGLU), 64 * kb, 32 * nb, 32 * nb, scr, C.lane); continue; } r -= I1;
        if (r < I2) { const int i = r / 256, q = r % 256, kb = q / 32, nb = q % 32; transpose_item(C.in[I_WBR] + (size_t)(l * 3 + i) * 512 * 1024, 1024, 512, WSP(bf16, WS_WBR) + (size_t)i * 1024 * 512, 64 * kb, 32 * nb, 32 * nb, scr, C.lane); continue; } r -= I2;
        if (r < I3) { const int kb = r / 32, nb = r % 32; transpose_item(C.in[I_WOUT] + (size_t)l * 1024 * 1024, 1024, 1024, WSP(bf16, WS_WOUT), 64 * kb, 32 * nb, 32 * nb, scr, C.lane); continue; } r -= I3;
        if (r < I4 + I5) { const int up = r >= I4; if (up) r -= I4; const int e = r / 256, q = r % 256, kb = q / 16, nb = q % 16, n0 = 32 * nb;
            transpose_item(C.in[up ? I_MU : I_MG] + (size_t)(l * 16 + e) * 1024 * 512, 512, 1024, WSP(bf16, WS_MOE1) + (size_t)e * 1024 * 1024, 64 * kb, n0, (n0 / 128) * 256 + (n0 % 128) + (up ? 128 : 0), scr, C.lane); continue; } r -= I4 + I5;
        { const int e = r / 256, q = r % 256, kb = q / 32, nb = q % 32; transpose_item(C.in[I_MD] + (size_t)(l * 16 + e) * 512 * 1024, 1024, 512, WSP(bf16, WS_MOE2) + (size_t)e * 1024 * 512, 64 * kb, 32 * nb, 32 * nb, scr, C.lane); }
    }
}

__device__ __forceinline__ void phase_mod(const Ctx& C) {
    LAS float* sc = (LAS float*)(C.lds + 69632);
    LAS float* red = (LAS float*)(C.lds + 69632 + 20480);
    for (int i = C.tid; i < 5 * 1024; i += 512) { const int c = i >> 10, k = i & 1023; const float v = c < 4 ? C.in[I_C][c * 1024 + k] : C.in[I_CCTX][k]; sc[i] = v * fsigmoid(v); }
    __syncthreads();
    for (int it = C.vcu; it < NLAYER * 96; it += C.G) {
        const int l = it / 96, col = (it % 96) * 64 + C.lane, k0 = C.wave * 128;
        const float* W = C.in[I_WMOD] + (size_t)l * 1024 * 6144 + (size_t)k0 * 6144 + col;
        float a0 = 0.f, a1 = 0.f, a2 = 0.f, a3 = 0.f, a4 = 0.f;
#pragma unroll 16
        for (int k = 0; k < 128; ++k) { const float w = W[(size_t)k * 6144]; a0 += sc[k0 + k] * w; a1 += sc[1024 + k0 + k] * w; a2 += sc[2048 + k0 + k] * w; a3 += sc[3072 + k0 + k] * w; a4 += sc[4096 + k0 + k] * w; }
        LAS float* r = red + C.wave * 320 + C.lane; r[0] = a0; r[64] = a1; r[128] = a2; r[192] = a3; r[256] = a4;
        __syncthreads();
        if (C.tid < 320) { const int c = C.tid >> 6; float s = C.in[I_BMOD][l * 6144 + col];
#pragma unroll
            for (int w = 0; w < 8; ++w) s += red[w * 320 + C.tid];
            WSP(float, WS_MOD)[(size_t)(l * 5 + c) * 6144 + col] = s; }
        __syncthreads();
    }
}

__device__ __forceinline__ void phase_s5mats(const Ctx& C, int l) {
    if (C.vcu >= 32) return;
    const int g = C.vcu, tid = C.tid;
    LAS f32x2* POW = (LAS f32x2*)(C.lds);
    LAS f32x2* CC = (LAS f32x2*)(C.lds + 33792);
    LAS f32x2* BB = (LAS f32x2*)(C.lds + 50176);
    LAS f32x2* COEF = (LAS f32x2*)(C.lds + 66560);
    LAS bf16* KT = (LAS bf16*)(C.lds + 67584);
    __syncthreads();
    if (tid < 128) {
        const int d = tid >> 6, p = tid & 63; const int li = ((l * 2 + d) * 32 + g) * 64 + p;
        const float re = C.in[I_LRE][li], im = C.in[I_LIM][li], dt = __expf(C.in[I_LDT][(l * 2 + d) * 32 + g]);
        for (int tau = 0; tau <= 32; ++tau) { const float mag = __expf(re * dt * (float)tau), rev = im * dt * (float)tau * 0.15915494309189535f;
            POW[(d * 33 + tau) * 64 + p] = (f32x2){mag * cos_rev(rev), mag * sin_rev(rev)}; }
        const float mag = __expf(re * dt), rev = im * dt * 0.15915494309189535f; const float lr = mag * cos_rev(rev) - 1.f, lim = mag * sin_rev(rev);
        const float den = 1.f / (re * re + im * im);
        COEF[tid] = (f32x2){(lr * re + lim * im) * den, (lim * re - lr * im) * den};
    }
    __syncthreads();
    for (int i = tid; i < 2048; i += 512) {
        const int d = i >> 10, p = (i >> 4) & 63, h = i & 15; const size_t bi = (((size_t)(l * 2 + d) * 32 + g) * 64 + p) * 16 + h;
        const float br = C.in[I_BRE][bi], bi_ = C.in[I_BIM][bi]; const f32x2 cf = COEF[d * 64 + p];
        BB[i] = (f32x2){cf.x * br - cf.y * bi_, cf.x * bi_ + cf.y * br};
        const int h2 = (i >> 6) & 15, p2 = i & 63; const size_t ci = (((size_t)(l * 2 + d) * 32 + g) * 16 + h2) * 64 + p2;
        CC[i] = (f32x2){C.in[I_CRE][ci], C.in[I_CIM][ci]};
    }
    __syncthreads();
    for (int i = tid; i < 63 * 256; i += 512) {
        const int ti = i >> 8, h = (i >> 4) & 15, hp = i & 15, tau = ti - 31; float s = 0.f;
        if (tau >= 0) { for (int p = 0; p < 64; ++p) { const f32x2 c = CC[h * 64 + p], w = POW[tau * 64 + p], b = BB[p * 16 + hp];
                const float xr = c.x * w.x - c.y * w.y, xi = c.x * w.y + c.y * w.x; s += xr * b.x - xi * b.y; } }
        if (tau <= 0) { for (int p = 0; p < 64; ++p) { const f32x2 c = CC[1024 + h * 64 + p], w = POW[(33 - tau) * 64 + p], b = BB[1024 + p * 16 + hp];
                const float xr = c.x * w.x - c.y * w.y, xi = c.x * w.y + c.y * w.x; s += xr * b.x - xi * b.y; } }
        if (tau == 0 && h == hp) s += C.in[I_SSMD][l * 512 + g * 16 + h];
        KT[i] = (bf16)f2bf(s);
    }
    __syncthreads();
    bf16* B1 = WSP(bf16, WS_BT1) + (size_t)g * 768 * 512; bf16* B2 = WSP(bf16, WS_BT2) + (size_t)g * 512 * 256;
    for (int i = tid; i < 512 * 64; i += 512) {
        const int n = i >> 6, ch = i & 63, t = n >> 4, h = n & 15, s = ch >> 1, hp0 = (ch & 1) * 8;
        *(GAS v4u*)(B1 + (size_t)n * 512 + ch * 8) = *(const LAS v4u*)(KT + ((t - s + 31) * 16 + h) * 16 + hp0);
    }
    for (int i = tid; i < 256 * 64; i += 512) {
        const int nn = i >> 6, ch = i & 63, d = nn >> 7, p = (nn & 127) >> 1, ri = nn & 1, s = ch >> 1, hp0 = (ch & 1) * 8;
        const f32x2 w = POW[(d * 33 + (d == 0 ? 31 - s : s)) * 64 + p]; float v[8];
#pragma unroll
        for (int j = 0; j < 8; ++j) { const f32x2 b = BB[d * 1024 + p * 16 + hp0 + j]; v[j] = ri == 0 ? (w.x * b.x - w.y * b.y) : (w.x * b.y + w.y * b.x); }
        v4u o; o.x = pk2(v[0], v[1]); o.y = pk2(v[2], v[3]); o.z = pk2(v[4], v[5]); o.w = pk2(v[6], v[7]);
        *(GAS v4u*)(B1 + (size_t)(512 + nn) * 512 + ch * 8) = o;
    }
    for (int i = tid; i < 512 * 32; i += 512) {
        const int n = i >> 5, ch = i & 31, t = n >> 4, h = n & 15, d = ch >> 4, p0 = (ch & 15) * 4; float v[8];
#pragma unroll
        for (int j = 0; j < 4; ++j) { const f32x2 c = CC[d * 1024 + h * 64 + p0 + j], w = POW[(d * 33 + (d == 0 ? t + 1 : 32 - t)) * 64 + p0 + j];
            v[2 * j] = c.x * w.x - c.y * w.y; v[2 * j + 1] = -(c.x * w.y + c.y * w.x); }
        v4u o; o.x = pk2(v[0], v[1]); o.y = pk2(v[2], v[3]); o.z = pk2(v[4], v[5]); o.w = pk2(v[6], v[7]);
        *(GAS v4u*)(B2 + (size_t)n * 256 + ch * 8) = o;
    }
    __syncthreads();
}

template <int MODE>
__device__ __forceinline__ void phase_rows(const Ctx& C, int l) {
    const int gw = C.vcu * NWAVES + C.wave, NGW = C.G * NWAVES, lane = C.lane;
    const float* MODl = WSP(float, WS_MOD) + (size_t)(MODE == 2 ? 0 : l) * 5 * 6144;
    const float* MODp = WSP(float, WS_MOD) + (size_t)(l > 0 ? l - 1 : 0) * 5 * 6144;
    const bf16* YS = WSP(bf16, WS_YSLOT);
    for (int m = gw; m < T; m += NGW) {
        const int b = m / LB, j = m - b * LB, cond = j < CTX ? 4 : b;
        if (MODE == 2 && j < CTX) continue;
        f32x4 v[4];
        if (MODE == 0) { const GAS f32x4* xr = (const GAS f32x4*)in_row(C, m) + lane;
#pragma unroll
            for (int q = 0; q < 4; ++q) v[q] = xr[64 * q]; }
        else { const GAS f32x4* xr = (const GAS f32x4*)xs_row(C, m) + lane; const GAS v2u* y0 = (const GAS v2u*)(YS + (size_t)(2 * m) * D) + lane; const GAS v2u* y1 = (const GAS v2u*)(YS + (size_t)(2 * m + 1) * D) + lane;
            const GAS f32x4* g2 = (const GAS f32x4*)(MODp + cond * 6144 + 5 * 1024) + lane;
#pragma unroll
            for (int q = 0; q < 4; ++q) { const f32x4 x = xr[64 * q], g = g2[64 * q]; const v2u a = y0[64 * q], c = y1[64 * q];
                v[q] = x + g * (f32x4){bflo(a.x) + bflo(c.x), bfhi(a.x) + bfhi(c.x), bflo(a.y) + bflo(c.y), bfhi(a.y) + bfhi(c.y)}; } }
        float ss = 0.f;
#pragma unroll
        for (int q = 0; q < 4; ++q) ss += (v[q].x * v[q].x + v[q].y * v[q].y) + (v[q].z * v[q].z + v[q].w * v[q].w);
        const float rstd = 1.f / sqrtf(wave_sum(ss, lane) * (1.f / D) + EPS);
        if (MODE == 2) { GAS f32x4* o = (GAS f32x4*)(C.out + (size_t)(b * SEQ + j - CTX) * D) + lane; const GAS f32x4* fg = (const GAS f32x4*)C.in[I_FNG] + lane;
#pragma unroll
            for (int q = 0; q < 4; ++q) o[64 * q] = v[q] * rstd * fg[64 * q]; }
        else { GAS f32x4* xo = (GAS f32x4*)xs_row(C, m) + lane; GAS v2u* ho = (GAS v2u*)(WSP(bf16, WS_HB) + (size_t)m * D) + lane;
            const GAS f32x4* ng = (const GAS f32x4*)(C.in[I_N1G] + l * D) + lane; const GAS f32x4* sh = (const GAS f32x4*)(MODl + cond * 6144) + lane; const GAS f32x4* sc = (const GAS f32x4*)(MODl + cond * 6144 + 1024) + lane;
#pragma unroll
            for (int q = 0; q < 4; ++q) { xo[64 * q] = v[q]; const f32x4 h = v[q] * rstd * ng[64 * q] * (sc[64 * q] + 1.f) + sh[64 * q]; ho[64 * q] = (v2u){pk2(h.x, h.y), pk2(h.z, h.w)}; } }
    }
}

__device__ __forceinline__ void phase_qkprep(const Ctx& C, int l) {
    const int gw = C.vcu * NWAVES + C.wave, NGW = C.G * NWAVES, lane = C.lane, s8 = lane & 7;
    const float* qg = C.in[I_QNG] + l * 64 + 8 * s8; const float* kg = C.in[I_KNG] + l * 64 + 8 * s8;
    float gq[8], gk[8];
#pragma unroll
    for (int i = 0; i < 8; ++i) { gq[i] = qg[i]; gk[i] = kg[i]; }
    const int ax = s8 >> 2, f0 = 8 * (s8 & 1);
    float inv[8];
#pragma unroll
    for (int i = 0; i < 8; ++i) inv[i] = exp2f(-(float)(f0 + i) * 0.8304820237218406f) * 0.15915494309189535f;
    for (int m = gw; m < T; m += NGW) {
        const int b = m / LB, j = m - b * LB; const bool lat = j >= CTX; const int tt = j - CTX; const float pos = (float)(ax == 0 ? (tt >> 6) : (tt & 63));
#pragma unroll
        for (int which = 0; which < 2; ++which) {
            if (which == 1 && lane >= 16) break;
            GAS v4u* p = which == 0 ? (GAS v4u*)(WSP(bf16, WS_QA) + (size_t)m * 512) + lane : (GAS v4u*)(WSP(bf16, WS_KA) + (size_t)m * 128) + lane;
            const v4u w = *p; float x[8] = {bflo(w.x), bfhi(w.x), bflo(w.y), bfhi(w.y), bflo(w.z), bfhi(w.z), bflo(w.w), bfhi(w.w)};
            float ss = 0.f;
#pragma unroll
            for (int i = 0; i < 8; ++i) ss += x[i] * x[i];
            ss += shflx(ss, 1, lane); ss += shflx(ss, 2, lane); ss += shflx(ss, 4, lane);
            const float rstd = 1.f / sqrtf(ss * (1.f / 64.f) + EPS);
#pragma unroll
            for (int i = 0; i < 8; ++i) x[i] = x[i] * rstd * (which == 0 ? gq[i] : gk[i]);
            float y[8];
#pragma unroll
            for (int i = 0; i < 8; ++i) { const float other = shflx(x[i], 2, lane);
                if (lat) { const float cs = cos_rev(pos * inv[i]), sn = sin_rev(pos * inv[i]); y[i] = (s8 & 2) ? (x[i] * cs + other * sn) : (x[i] * cs - other * sn); } else y[i] = x[i]; }
            const float sc = which == 0 ? C2 : 1.f;
            v4u o; o.x = pk2(y[0] * sc, y[1] * sc); o.y = pk2(y[2] * sc, y[3] * sc); o.z = pk2(y[4] * sc, y[5] * sc); o.w = pk2(y[6] * sc, y[7] * sc);
            *p = o;
        }
    }
}

__device__ __forceinline__ void phase_carry(const Ctx& C, int l) {
    if (C.vcu >= 32) return;
    const int b = C.vcu >> 3, g = (C.vcu & 7) * 4 + (C.wave >> 1), d = C.wave & 1, p = C.lane;
    const int li = ((l * 2 + d) * 32 + g) * 64 + p;
    const float re = C.in[I_LRE][li], im = C.in[I_LIM][li], dt = __expf(C.in[I_LDT][(l * 2 + d) * 32 + g]);
    const float mag = __expf(re * dt * 32.f), rev = im * dt * 32.f * 0.15915494309189535f; const float Lr = mag * cos_rev(rev), Li = mag * sin_rev(rev);
    const GAS f32x2* S = (const GAS f32x2*)(WSP(float, WS_SST) + (size_t)(b * NCH) * 8192 + g * 256 + d * 128) + p;
    GAS unsigned* X = (GAS unsigned*)(WSP(bf16, WS_XST) + (size_t)(b * NCH) * 8192 + g * 256 + d * 128) + p;
    float sr = 0.f, si = 0.f;
    if (d == 0) {
        for (int c0 = 0; c0 < NCH; c0 += 8) { f32x2 s[8];
#pragma unroll
            for (int k = 0; k < 8; ++k) s[k] = S[(size_t)(c0 + k) * 4096];
#pragma unroll
            for (int k = 0; k < 8; ++k) { X[(size_t)(c0 + k) * 4096] = pk2(sr, si); const float nr = Lr * sr - Li * si + s[k].x, ni = Lr * si + Li * sr + s[k].y; sr = nr; si = ni; } }
    } else {
        for (int seg = 0; seg < 33; ++seg) { const int chi = seg == 0 ? 7 : NCH - 1 - (seg - 1) * 8; f32x2 s[8];
#pragma unroll
            for (int k = 0; k < 8; ++k) s[k] = S[(size_t)(chi - k) * 4096];
#pragma unroll
            for (int k = 0; k < 8; ++k) { X[(size_t)(chi - k) * 4096] = pk2(sr, si); const float nr = Lr * sr - Li * si + s[k].x, ni = Lr * si + Li * sr + s[k].y; sr = nr; si = ni; } }
    }
}

__device__ __forceinline__ void phase_norm2(const Ctx& C, int l) {
    LAS float* RWt = (LAS float*)C.lds;
    LAS unsigned* REC = (LAS unsigned*)(C.lds + 65536);
    LAS unsigned* LCNT = (LAS unsigned*)(C.lds + 65536 + 32768);
    const int lane = C.lane, tid = C.tid;
    for (int i = tid; i < 16384; i += 512) { const int k = i >> 4, e = i & 15; RWt[e * 1024 + k] = C.in[I_RW][i]; }
    if (tid < 32) LCNT[tid] = 0u;
    __syncthreads();
    const float* MODl = WSP(float, WS_MOD) + (size_t)l * 5 * 6144;
    float rb[16];
#pragma unroll
    for (int e = 0; e < 16; ++e) rb[e] = C.in[I_RB][e];
    int nrows = 0; for (int m = C.vcu; m < T; m += C.G) ++nrows;
    for (int i = C.wave; i < nrows; i += NWAVES) {
        const int m = C.vcu + C.G * i, cond = cond_of(m);
        const GAS f32x4* xr = (const GAS f32x4*)xs_row(C, m) + lane; GAS v2u* ho = (GAS v2u*)(WSP(bf16, WS_HB) + (size_t)m * D) + lane;
        const GAS f32x4* ng = (const GAS f32x4*)(C.in[I_N2G] + l * D) + lane; const GAS f32x4* sh = (const GAS f32x4*)(MODl + cond * 6144 + 3072) + lane; const GAS f32x4* sc = (const GAS f32x4*)(MODl + cond * 6144 + 4096) + lane;
        f32x4 v[4]; float ss = 0.f;
#pragma unroll
        for (int q = 0; q < 4; ++q) { v[q] = xr[64 * q]; ss += (v[q].x * v[q].x + v[q].y * v[q].y) + (v[q].z * v[q].z + v[q].w * v[q].w); }
        const float rstd = 1.f / sqrtf(wave_sum(ss, lane) * (1.f / D) + EPS);
        float lg[16];
#pragma unroll
        for (int e = 0; e < 16; ++e) lg[e] = 0.f;
#pragma unroll
        for (int q = 0; q < 4; ++q) { const f32x4 h = v[q] * rstd * ng[64 * q] * (sc[64 * q] + 1.f) + sh[64 * q]; ho[64 * q] = (v2u){pk2(h.x, h.y), pk2(h.z, h.w)};
#pragma unroll
            for (int e = 0; e < 16; ++e) { const f32x4 w = *(const LAS f32x4*)(RWt + e * 1024 + 256 * q + 4 * lane); lg[e] += (h.x * w.x + h.y * w.y) + (h.z * w.z + h.w * w.w); } }
#pragma unroll
        for (int e = 0; e < 16; ++e) lg[e] = wave_sum(lg[e], lane);
        float mx = lg[0];
#pragma unroll
        for (int e = 1; e < 16; ++e) mx = fmaxf(mx, lg[e]);
        float pr[16], sel[16], sum = 0.f;
#pragma unroll
        for (int e = 0; e < 16; ++e) { pr[e] = __expf(lg[e] - mx); sum += pr[e]; }
        const float rs = 1.f / sum;
#pragma unroll
        for (int e = 0; e < 16; ++e) { pr[e] *= rs; sel[e] = pr[e] + rb[e]; }
        float bestv = -1e30f; int best = 0;
#pragma unroll
        for (int gq = 0; gq < 4; ++gq) { float m1 = -1e30f, m2 = -1e30f;
#pragma unroll
            for (int k = 0; k < 4; ++k) { const float s = sel[4 * gq + k]; if (s > m1) { m2 = m1; m1 = s; } else if (s > m2) m2 = s; }
            const float gs = m1 + m2; if (gs > bestv) { bestv = gs; best = gq; } }
        float s4[4], p4[4];
#pragma unroll
        for (int k = 0; k < 4; ++k) { s4[k] = best == 0 ? sel[k] : best == 1 ? sel[4 + k] : best == 2 ? sel[8 + k] : sel[12 + k]; p4[k] = best == 0 ? pr[k] : best == 1 ? pr[4 + k] : best == 2 ? pr[8 + k] : pr[12 + k]; }
        int i0 = 0; float v0 = s4[0], q0 = p4[0];
#pragma unroll
        for (int k = 1; k < 4; ++k) if (s4[k] > v0) { v0 = s4[k]; i0 = k; q0 = p4[k]; }
        int i1 = -1; float v1 = -1e30f, q1 = 0.f;
#pragma unroll
        for (int k = 0; k < 4; ++k) if (k != i0 && s4[k] > v1) { v1 = s4[k]; i1 = k; q1 = p4[k]; }
        const int e0 = 4 * best + i0, e1 = 4 * best + i1; const float wn = 1.f / (q0 + q1);
        if (lane == 0) { const unsigned lp0 = atomicAdd((unsigned*)(LCNT + e0), 1u), lp1 = atomicAdd((unsigned*)(LCNT + e1), 1u);
            REC[i * 4 + 0] = (unsigned)e0 | ((unsigned)e1 << 8) | (lp0 << 16); REC[i * 4 + 1] = lp1; REC[i * 4 + 2] = __float_as_uint(q0 * wn); REC[i * 4 + 3] = __float_as_uint(q1 * wn); }
    }
    __syncthreads();
    if (tid < 16) LCNT[16 + tid] = __hip_atomic_fetch_add((unsigned*)(C.ctl + CW_CNT + l * 1024 + 64 * tid), LCNT[tid], RLX_AGENT);
    __syncthreads();
    int* LIST = WSP(int, WS_LIST); float* RWG = WSP(float, WS_RW);
    for (int i = tid; i < nrows; i += 512) { const int m = C.vcu + C.G * i; const unsigned r0 = REC[i * 4], r1 = REC[i * 4 + 1];
        const int e0 = r0 & 255, e1 = (r0 >> 8) & 255; const unsigned lp0 = r0 >> 16, lp1 = r1;
        LIST[(size_t)e0 * T + LCNT[16 + e0] + lp0] = 2 * m; LIST[(size_t)e1 * T + LCNT[16 + e1] + lp1] = 2 * m + 1;
        RWG[2 * m] = __uint_as_float(REC[i * 4 + 2]); RWG[2 * m + 1] = __uint_as_float(REC[i * 4 + 3]); }
    __syncthreads();
}
using pg8::Unit;
typedef f32x4 Acc[2][2][4][2];
__device__ __forceinline__ v4u pack8(const f32x4& a, const f32x4& b) { v4u w; w.x = cvt_pk_bf16(a[0], a[1]); w.y = cvt_pk_bf16(a[2], a[3]); w.z = cvt_pk_bf16(b[0], b[1]); w.w = cvt_pk_bf16(b[2], b[3]); return w; }
__device__ __forceinline__ void unpack8(const v4u& w, f32x4& a, f32x4& b) { a = (f32x4){bflo(w.x), bfhi(w.x), bflo(w.y), bfhi(w.y)}; b = (f32x4){bflo(w.z), bfhi(w.z), bflo(w.w), bfhi(w.w)}; }
__device__ __forceinline__ int chunk_m0(int cr) { return (cr / NCH) * LB + (cr % NCH) * 32; }

struct PWin {
    unsigned char* ws; int G, c; int K; unsigned kstepA;
    __device__ __forceinline__ bool next(int i, Unit& u) const { const long L = (long)i * G + c; if (L >= NPAN * 23) return false; pg8::static_decode((int)L, NPAN, 23, u.pm, u.pn); u.z = 0; return true; }
    __device__ __forceinline__ const char* a_base(const Unit& u) const { return (const char*)(ws + WS_HB) + (size_t)u.pm * 256 * 1024 * 2; }
    __device__ __forceinline__ unsigned a_off(const Unit&, int h, int R, int Cc) const { return (unsigned)((h * 128 + R) * 1024 + Cc) * 2u; }
    __device__ __forceinline__ const char* b_base(const Unit& u) const { return (const char*)(ws + WS_WIN) + (size_t)u.pn * 256 * 1024 * 2; }
    __device__ __forceinline__ void epi(const Acc& acc, const Unit& u, int wr, int wc, int fr, int fq) const {
        const int row0 = u.pm * 256 + wr * 64 + fr;
#pragma unroll
        for (int bj = 0; bj < 2; ++bj) {
            const int cb = u.pn * 256 + bj * 128; bf16* dst; int ld, col, mode = 0; float sc = 1.f;
            if (cb < 512) { dst = (bf16*)(ws + WS_U); ld = 512; col = cb; }
            else if (cb < 1024) { dst = (bf16*)(ws + WS_QA); ld = 512; col = cb - 512; }
            else if (cb == 1024) { dst = (bf16*)(ws + WS_KA); ld = 128; col = 0; }
            else if (cb == 1152) { dst = (bf16*)(ws + WS_VA); ld = 128; col = 0; }
            else if (cb < 1792) { dst = (bf16*)(ws + WS_QN); ld = 512; col = cb - 1280; sc = C2; }
            else if (cb < 2304) { dst = (bf16*)(ws + WS_KN); ld = 512; col = cb - 1792; }
            else if (cb < 2816) { dst = (bf16*)(ws + WS_VN); ld = 512; col = cb - 2304; }
            else { dst = (bf16*)(ws + WS_GATES); ld = 3072; col = cb - 2816; mode = 1; }
            const int c0 = col + wc * 32 + 8 * fq;
#pragma unroll
            for (int ai = 0; ai < 2; ++ai)
#pragma unroll
                for (int m = 0; m < 4; ++m) { f32x4 v0 = acc[ai][bj][m][0], v1 = acc[ai][bj][m][1];
                    if (mode) { v0 = (f32x4){fsigmoid(v0[0]), fsigmoid(v0[1]), fsigmoid(v0[2]), fsigmoid(v0[3])}; v1 = (f32x4){fsigmoid(v1[0]), fsigmoid(v1[1]), fsigmoid(v1[2]), fsigmoid(v1[3])}; }
                    else { v0 = v0 * sc; v1 = v1 * sc; }
                    *(GAS v4u*)(dst + (size_t)(row0 + ai * 128 + m * 16) * ld + c0) = pack8(v0, v1); __builtin_amdgcn_sched_barrier(0); }
        }
    }
};

struct PS5A {
    unsigned char* ws; int G, c; int K; unsigned kstepA;
    __device__ __forceinline__ bool next(int i, Unit& u) const { const long L = (long)i * G + c; if (L >= 32 * 15) return false; const int l = (int)L; u.z = l / 15; const int r = l % 15; u.pm = r / 3; u.pn = r % 3; return true; }
    __device__ __forceinline__ const char* a_base(const Unit& u) const { return (const char*)(ws + WS_U) + (size_t)u.z * 32; }
    __device__ __forceinline__ unsigned a_off(const Unit& u, int h, int R, int Cc) const { int cr = u.pm * 256 + h * 128 + R; cr = cr < NCR ? cr : NCR - 1; return (unsigned)((chunk_m0(cr) + (Cc >> 4)) * 512 + (Cc & 15)) * 2u; }
    __device__ __forceinline__ const char* b_base(const Unit& u) const { return (const char*)(ws + WS_BT1) + ((size_t)u.z * 768 + u.pn * 256) * 512 * 2; }
    __device__ __forceinline__ void epi(const Acc& acc, const Unit& u, int wr, int wc, int fr, int fq) const {
#pragma unroll
        for (int ai = 0; ai < 2; ++ai)
#pragma unroll
            for (int m = 0; m < 4; ++m) { const int cr = u.pm * 256 + ai * 128 + wr * 64 + m * 16 + fr; if (cr >= NCR) continue;
#pragma unroll
                for (int bj = 0; bj < 2; ++bj) { const int n = bj * 128 + wc * 32 + 8 * fq;
                    if (u.pn < 2) { const int nn = u.pn * 256 + n, t = nn >> 4, h0 = nn & 15;
                        *(GAS v4u*)((bf16*)(ws + WS_YS) + (size_t)(chunk_m0(cr) + t) * 512 + u.z * 16 + h0) = pack8(acc[ai][bj][m][0], acc[ai][bj][m][1]); }
                    else { GAS f32x4* o = (GAS f32x4*)((float*)(ws + WS_SST) + (size_t)cr * 8192 + u.z * 256 + n); o[0] = acc[ai][bj][m][0]; o[1] = acc[ai][bj][m][1]; } }
                __builtin_amdgcn_sched_barrier(0); }
    }
};

struct PS5B {
    unsigned char* ws; int G, c; int K; unsigned kstepA;
    __device__ __forceinline__ bool next(int i, Unit& u) const { const long L = (long)i * G + c; if (L >= 32 * 10) return false; const int l = (int)L; u.z = l / 10; const int r = l % 10; u.pm = r / 2; u.pn = r % 2; return true; }
    __device__ __forceinline__ const char* a_base(const Unit& u) const { return (const char*)(ws + WS_XST) + (size_t)u.z * 512; }
    __device__ __forceinline__ unsigned a_off(const Unit& u, int h, int R, int Cc) const { int cr = u.pm * 256 + h * 128 + R; cr = cr < NCR ? cr : NCR - 1; return (unsigned)(cr * 8192 + Cc) * 2u; }
    __device__ __forceinline__ const char* b_base(const Unit& u) const { return (const char*)(ws + WS_BT2) + ((size_t)u.z * 512 + u.pn * 256) * 256 * 2; }
    __device__ __forceinline__ void epi(const Acc& acc, const Unit& u, int wr, int wc, int fr, int fq) const {
#pragma unroll
        for (int ai = 0; ai < 2; ++ai)
#pragma unroll
            for (int m = 0; m < 4; ++m) { const int cr = u.pm * 256 + ai * 128 + wr * 64 + m * 16 + fr; if (cr >= NCR) continue;
#pragma unroll
                for (int bj = 0; bj < 2; ++bj) { const int nn = u.pn * 256 + bj * 128 + wc * 32 + 8 * fq, t = nn >> 4, h0 = nn & 15;
                    GAS v4u* p = (GAS v4u*)((bf16*)(ws + WS_YS) + (size_t)(chunk_m0(cr) + t) * 512 + u.z * 16 + h0);
                    f32x4 y0, y1; { const v4u w_ = *p; unpack8(w_, y0, y1); } y0 += acc[ai][bj][m][0]; y1 += acc[ai][bj][m][1];
                    y0 = (f32x4){gelu_tanh(y0[0]), gelu_tanh(y0[1]), gelu_tanh(y0[2]), gelu_tanh(y0[3])}; y1 = (f32x4){gelu_tanh(y1[0]), gelu_tanh(y1[1]), gelu_tanh(y1[2]), gelu_tanh(y1[3])};
                    *p = pack8(y0, y1); }
                __builtin_amdgcn_sched_barrier(0); }
    }
};

struct PGlu {
    unsigned char* ws; int G, c; int K; unsigned kstepA;
    __device__ __forceinline__ bool next(int i, Unit& u) const { const long L = (long)i * G + c; if (L >= NPAN * 2) return false; pg8::static_decode((int)L, NPAN, 2, u.pm, u.pn); u.z = 0; return true; }
    __device__ __forceinline__ const char* a_base(const Unit& u) const { return (const char*)(ws + WS_YS) + (size_t)u.pm * 256 * 512 * 2; }
    __device__ __forceinline__ unsigned a_off(const Unit&, int h, int R, int Cc) const { return (unsigned)((h * 128 + R) * 512 + Cc) * 2u; }
    __device__ __forceinline__ const char* b_base(const Unit& u) const { return (const char*)(ws + WS_WGLU) + (size_t)u.pn * 256 * 512 * 2; }
    __device__ __forceinline__ void epi(const Acc& acc, const Unit& u, int wr, int wc, int fr, int fq) const {
#pragma unroll
        for (int ai = 0; ai < 2; ++ai)
#pragma unroll
            for (int m = 0; m < 4; ++m) { const size_t r = (size_t)(u.pm * 256 + ai * 128 + wr * 64 + m * 16 + fr);
#pragma unroll
                for (int bj = 0; bj < 2; ++bj) { const int cc = u.pn * 256 + bj * 128 + wc * 32 + 8 * fq;
                    f32x4 z0, z1; { const v4u w_ = *(const GAS v4u*)((const bf16*)(ws + WS_YS) + r * 512 + cc); unpack8(w_, z0, z1); } const f32x4 a0 = acc[ai][bj][m][0], a1 = acc[ai][bj][m][1];
                    z0 = z0 * (f32x4){fsigmoid(a0[0]), fsigmoid(a0[1]), fsigmoid(a0[2]), fsigmoid(a0[3])}; z1 = z1 * (f32x4){fsigmoid(a1[0]), fsigmoid(a1[1]), fsigmoid(a1[2]), fsigmoid(a1[3])};
                    *(GAS v4u*)((bf16*)(ws + WS_U) + r * 512 + cc) = pack8(z0, z1); }
                __builtin_amdgcn_sched_barrier(0); }
    }
};

struct PMerge {
    unsigned char* ws; int G, c; int K; unsigned kstepA;
    __device__ __forceinline__ bool next(int i, Unit& u) const { const long tile = (long)(i / 3) * G + c; if (tile >= NPAN * 4) return false; pg8::static_decode((int)tile, NPAN, 4, u.pm, u.pn); u.z = i % 3; return true; }
    __device__ __forceinline__ const char* a_base(const Unit& u) const { const size_t off = u.z == 0 ? WS_U : (u.z == 1 ? WS_QA : WS_QN); return (const char*)(ws + off) + (size_t)u.pm * 256 * 512 * 2; }
    __device__ __forceinline__ unsigned a_off(const Unit&, int h, int R, int Cc) const { return (unsigned)((h * 128 + R) * 512 + Cc) * 2u; }
    __device__ __forceinline__ const char* b_base(const Unit& u) const { return (const char*)(ws + WS_WBR) + ((size_t)u.z * 1024 + u.pn * 256) * 512 * 2; }
    __device__ __forceinline__ void epi(const Acc& acc, const Unit& u, int wr, int wc, int fr, int fq) const {
#pragma unroll
        for (int ai = 0; ai < 2; ++ai)
#pragma unroll
            for (int m = 0; m < 4; ++m) { const size_t r = (size_t)(u.pm * 256 + ai * 128 + wr * 64 + m * 16 + fr);
#pragma unroll
                for (int bj = 0; bj < 2; ++bj) { const int cc = u.pn * 256 + bj * 128 + wc * 32 + 8 * fq;
                    f32x4 g0, g1; { const v4u w_ = *(const GAS v4u*)((const bf16*)(ws + WS_GATES) + r * 3072 + u.z * 1024 + cc); unpack8(w_, g0, g1); }
                    f32x4 v0 = g0 * acc[ai][bj][m][0], v1 = g1 * acc[ai][bj][m][1];
                    GAS v4u* p = (GAS v4u*)((bf16*)(ws + WS_HB) + r * 1024 + cc);
                    if (u.z != 0) { f32x4 o0, o1; const v4u w_ = *p; unpack8(w_, o0, o1); v0 += o0; v1 += o1; }
                    *p = pack8(v0, v1); }
                __builtin_amdgcn_sched_barrier(0); }
        asm volatile("s_waitcnt vmcnt(0)" ::: "memory");
    }
};

struct PWout {
    unsigned char* ws; float* out; const float* mod; int G, c; int K; unsigned kstepA;
    __device__ __forceinline__ bool next(int i, Unit& u) const { const long L = (long)i * G + c; if (L >= NPAN * 4) return false; pg8::static_decode((int)L, NPAN, 4, u.pm, u.pn); u.z = 0; return true; }
    __device__ __forceinline__ const char* a_base(const Unit& u) const { return (const char*)(ws + WS_HB) + (size_t)u.pm * 256 * 1024 * 2; }
    __device__ __forceinline__ unsigned a_off(const Unit&, int h, int R, int Cc) const { return (unsigned)((h * 128 + R) * 1024 + Cc) * 2u; }
    __device__ __forceinline__ const char* b_base(const Unit& u) const { return (const char*)(ws + WS_WOUT) + (size_t)u.pn * 256 * 1024 * 2; }
    __device__ __forceinline__ void epi(const Acc& acc, const Unit& u, int wr, int wc, int fr, int fq) const {
        const int b = u.pm / 33, pr = u.pm % 33, cond = pr == 0 ? 4 : b;
        float* xb = pr == 0 ? (float*)(ws + WS_CTXS) + (size_t)b * 256 * D : out + ((size_t)b * SEQ + (size_t)(pr - 1) * 256) * D;
        const float* g1 = mod + cond * 6144 + 2048;
#pragma unroll
        for (int bj = 0; bj < 2; ++bj) { const int cc = u.pn * 256 + bj * 128 + wc * 32 + 8 * fq; const f32x4 ga = *(const GAS f32x4*)(g1 + cc), gb = *(const GAS f32x4*)(g1 + cc + 4);
#pragma unroll
            for (int ai = 0; ai < 2; ++ai)
#pragma unroll
                for (int m = 0; m < 4; ++m) { GAS f32x4* p = (GAS f32x4*)(xb + (size_t)(ai * 128 + wr * 64 + m * 16 + fr) * D + cc);
                    p[0] = p[0] + ga * acc[ai][bj][m][0]; p[1] = p[1] + gb * acc[ai][bj][m][1]; __builtin_amdgcn_sched_barrier(0); } }
    }
};

struct ExpTab { int cnt[16], tile0[17]; };
__device__ __forceinline__ int exp_find(const int (&tile0)[17], int q) { int e = 0;
#pragma unroll
    for (int k = 1; k < 16; ++k) e += (q >= tile0[k]) ? 1 : 0;
    return e; }

struct PMoe1 {
    unsigned char* ws; const LAS int* tab; int G, c; int K; unsigned kstepA;
    __device__ __forceinline__ bool next(int i, Unit& u) const { const long L = (long)i * G + c; const int total = tab[32] * 4; if (L >= total) return false; const int q = (int)L >> 2; u.pn = (int)L & 3;
        int e = 0;
#pragma unroll
        for (int k = 1; k < 16; ++k) e += (q >= tab[16 + k]) ? 1 : 0;
        u.z = e; u.pm = q - tab[16 + e]; return true; }
    __device__ __forceinline__ const char* a_base(const Unit&) const { return (const char*)(ws + WS_HB); }
    __device__ __forceinline__ unsigned a_off(const Unit& u, int h, int R, int Cc) const { int r = u.pm * 256 + h * 128 + R; const int n = tab[u.z]; r = r < n ? r : n - 1;
        const int ent = ((const int*)(ws + WS_LIST))[(size_t)u.z * T + r]; return (unsigned)((ent >> 1) * 1024 + Cc) * 2u; }
    __device__ __forceinline__ const char* b_base(const Unit& u) const { return (const char*)(ws + WS_MOE1) + ((size_t)u.z * 1024 + u.pn * 256) * 1024 * 2; }
    __device__ __forceinline__ void epi(const Acc& acc, const Unit& u, int wr, int wc, int fr, int fq) const {
        const size_t arow0 = (size_t)(tab[16 + u.z] + u.pm) * 256;
#pragma unroll
        for (int ai = 0; ai < 2; ++ai)
#pragma unroll
            for (int m = 0; m < 4; ++m) { const f32x4 g0 = acc[ai][0][m][0], g1 = acc[ai][0][m][1], u0 = acc[ai][1][m][0], u1 = acc[ai][1][m][1];
                const f32x4 v0 = (f32x4){g0[0] * fsigmoid(g0[0]), g0[1] * fsigmoid(g0[1]), g0[2] * fsigmoid(g0[2]), g0[3] * fsigmoid(g0[3])} * u0;
                const f32x4 v1 = (f32x4){g1[0] * fsigmoid(g1[0]), g1[1] * fsigmoid(g1[1]), g1[2] * fsigmoid(g1[2]), g1[3] * fsigmoid(g1[3])} * u1;
                *(GAS v4u*)((bf16*)(ws + WS_ACT) + (arow0 + ai * 128 + wr * 64 + m * 16 + fr) * 512 + u.pn * 128 + wc * 32 + 8 * fq) = pack8(v0, v1); }
    }
};
struct PMoe2 {
    unsigned char* ws; const LAS int* tab; int G, c; int K; unsigned kstepA;
    __device__ __forceinline__ bool next(int i, Unit& u) const { const long L = (long)i * G + c; const int total = tab[32] * 4; if (L >= total) return false; const int q = (int)L >> 2; u.pn = (int)L & 3;
        int e = 0;
#pragma unroll
        for (int k = 1; k < 16; ++k) e += (q >= tab[16 + k]) ? 1 : 0;
        u.z = e; u.pm = q - tab[16 + e]; return true; }
    __device__ __forceinline__ const char* a_base(const Unit& u) const { return (const char*)(ws + WS_ACT) + (size_t)(tab[16 + u.z] + u.pm) * 256 * 512 * 2; }
    __device__ __forceinline__ unsigned a_off(const Unit&, int h, int R, int Cc) const { return (unsigned)((h * 128 + R) * 512 + Cc) * 2u; }
    __device__ __forceinline__ const char* b_base(const Unit& u) const { return (const char*)(ws + WS_MOE2) + ((size_t)u.z * 1024 + u.pn * 256) * 512 * 2; }
    __device__ __forceinline__ void epi(const Acc& acc, const Unit& u, int wr, int wc, int fr, int fq) const {
        const int n = tab[u.z];
#pragma unroll
        for (int ai = 0; ai < 2; ++ai)
#pragma unroll
            for (int m = 0; m < 4; ++m) { const int r = u.pm * 256 + ai * 128 + wr * 64 + m * 16 + fr; if (r >= n) continue;
                const int ent = ((const int*)(ws + WS_LIST))[(size_t)u.z * T + r]; const float w = ((const float*)(ws + WS_RW))[ent];
#pragma unroll
                for (int bj = 0; bj < 2; ++bj)
                    *(GAS v4u*)((bf16*)(ws + WS_YSLOT) + (size_t)ent * 1024 + u.pn * 256 + bj * 128 + wc * 32 + 8 * fq) = pack8(acc[ai][bj][m][0] * w, acc[ai][bj][m][1] * w); }
    }
};
__device__ __forceinline__ void build_exptab(const Ctx& C, LAS int* tab, int l) {
    __syncthreads();
    if (threadIdx.x == 0) { int t0 = 0;
        for (int e = 0; e < 16; ++e) { const int n = (int)__hip_atomic_load((unsigned*)(C.ctl + CW_CNT + l * 1024 + 64 * e), RLX_AGENT); tab[e] = n; tab[16 + e] = t0; t0 += (n + 255) >> 8; }
        tab[32] = t0; }
    __syncthreads();
}
__device__ __forceinline__ void phase_attn(const Ctx& C, int l, unsigned char* lds_gen) {
    phase_carry(C, l);
    char* shm = (char*)lds_gen;
    bf16* QA = WSP(bf16, WS_QA); bf16* KA = WSP(bf16, WS_KA); bf16* VA = WSP(bf16, WS_VA); bf16* QN = WSP(bf16, WS_QN); bf16* KN = WSP(bf16, WS_KN); bf16* VN = WSP(bf16, WS_VN);
#ifndef ATTN_SEL
#define ATTN_SEL 3
#endif
    const int per = (1024 + C.G - 1) / C.G;
    if (ATTN_SEL & 1) for (int i = 0; i < per; ++i) { const int id = C.vcu * per + i; if (id >= 1024) continue; const int bh = id >> 5, b = bh >> 3, h = bh & 7, qb = id & 31;
        const bf16* Qu = QA + (size_t)(b * LB + CTX + qb * 256) * 512 + h * 64;
        attn_body::attn_unit<8, false, 512, 128>(Qu, 512, KA + (size_t)(b * LB) * 128 + (h >> 2) * 64, VA + (size_t)(b * LB) * 128 + (h >> 2) * 64, 128, (bf16*)Qu, LB / 64, 0, 0, shm);
    }
    LAS float* bt = (LAS float*)(C.lds + attn_body::LDS_BT);
    const int nctx = (C.vcu >= 64 && C.vcu < 128) ? 1 : 0;
    if (ATTN_SEL & 2) for (int i = 0; i < per + nctx; ++i) {
        const bf16 *Qu, *Kh, *Vh; int kvp = 512, NT = 4, r0 = 0, rlo = 0;
        if (i < per) { const int id = C.vcu * per + i; if (id >= 1024) continue; const int bh = id >> 5, b = bh >> 3, h = bh & 7; r0 = (id & 31) * 4;
            const float* rp = C.in[I_RPB] + (size_t)(l * 8 + h) * 465;
            for (int k = C.tid; k < 465; k += 512) bt[k] = rp[k] * LOG2E;
            rlo = r0 - 4 < 0 ? 0 : (r0 - 4 > 120 ? 120 : r0 - 4); const int rh_ = r0 - 1 < 0 ? 0 : (r0 - 1 > 120 ? 120 : r0 - 1), nloc = rh_ + 8 - rlo; NT = (4 + nloc + 1) & ~1;
            Qu = QN + (size_t)(b * LB + CTX + r0 * 64) * 512 + h * 64; Kh = KN + (size_t)(b * LB) * 512 + h * 64; Vh = VN + (size_t)(b * LB) * 512 + h * 64; }
        else { int j = C.vcu - 64; if (j < 32) { const int b = j >> 3, h = j & 7; Qu = QA + (size_t)(b * LB) * 512 + h * 64; Kh = KA + (size_t)(b * LB) * 128 + (h >> 2) * 64; Vh = VA + (size_t)(b * LB) * 128 + (h >> 2) * 64; kvp = 128; }
            else { j -= 32; const int b = j >> 3, h = j & 7; Qu = QN + (size_t)(b * LB) * 512 + h * 64; Kh = KN + (size_t)(b * LB) * 512 + h * 64; Vh = VN + (size_t)(b * LB) * 512 + h * 64; } }
        attn_body::attn_unit<8, true, 512, 0>(Qu, 512, Kh, Vh, kvp, (bf16*)Qu, NT, r0, rlo, shm);
    }
}

constexpr int NPH = 46;
__global__ void __launch_bounds__(NWAVES * 64, 2) fwd(Args args) {
    extern __shared__ __attribute__((aligned(16))) unsigned char lds[];
    Ctx C; C.in = (const __attribute__((address_space(4))) CFP*)__builtin_amdgcn_kernarg_segment_ptr(); C.out = args.out; C.ws = args.ws; C.lds = (LAS unsigned char*)lds; C.ctl = (gu32*)(args.ws + WS_CTL);
    C.tid = 0; C.lane = 0; C.wave = __builtin_amdgcn_readfirstlane((int)threadIdx.x >> 6);
    C.G = gridDim.x; { const int bx = blockIdx.x; C.vcu = (C.G % 8 == 0) ? (bx % 8) * (C.G / 8) + bx / 8 : bx; }
    for (int u = threadIdx.x; u < (LDS_BYTES - LDSCTL_OFF) / 4; u += NWAVES * 64) ((LAS unsigned*)(C.lds + LDSCTL_OFF))[u] = 0u;
    __syncthreads();
    const int lo = args.ph_lo, hi = args.ph_hi;
    XcdBarrier bar; bar.bar = (unsigned*)(C.ctl + CW_BAR); bar.x = 0; bar.st = nullptr;
    if (hi - lo > 1) bar = xcd_barrier_post((unsigned*)(C.ctl + CW_BAR), (volatile LAS unsigned*)(C.lds + MISC_OFF) + 8);
    LAS int* tab = (LAS int*)(C.lds + LDSCTL_OFF);
    const int cg = (int)blockIdx.x;
#ifndef PHMASK
#define PHMASK 0xFFFF
#endif
#define IN(k) (lo <= (k) && (k) < hi)
#define EN(b) ((PHMASK >> (b)) & 1)
#define SEAM(k) do { if (IN(k) && IN((k) + 1)) xcd_barrier(bar); } while (0)
#define LWS() ({ const __attribute__((address_space(4))) CFP* k_ = C.in; asm volatile("" : "+s"(k_)); (unsigned char*)k_[30]; })
#define LC() ({ Ctx c_ = C; c_.tid = threadIdx.x; asm volatile("" : "+v"(c_.tid)); c_.lane = c_.tid & 63; asm volatile("" : "+s"(c_.in)); c_.ws = (unsigned char*)c_.in[30]; c_.out = (float*)c_.in[29]; c_.ctl = (gu32*)(c_.ws + WS_CTL); c_; })
    if (EN(11) && IN(0)) { const Ctx Cl = LC(); phase_mod(Cl); phase_s5mats(Cl, 0); phase_weights(Cl, 0); }
    SEAM(0);
    for (int l = 0; l < NLAYER; ++l) {
        const int pb = 1 + 11 * l;
        if (EN(0) && IN(pb)) { const Ctx Cl = LC(); if (l == 0) phase_rows<0>(Cl, 0); else { phase_s5mats(Cl, l); phase_weights(Cl, l); phase_rows<1>(Cl, l); } }
        SEAM(pb);
        if (EN(1) && IN(pb + 1)) { PWin P{LWS(), C.G, cg, 1024, 128u}; pg8::gemm_phase(C.lds, P); }
        SEAM(pb + 1);
        if (EN(2) && IN(pb + 2)) { { const Ctx Cl = LC(); phase_qkprep(Cl, l); } PS5A P{LWS(), C.G, cg, 512, 4096u}; pg8::gemm_phase(C.lds, P); }
        SEAM(pb + 2);
        if (EN(3) && IN(pb + 3)) { const Ctx Cl = LC(); phase_attn(Cl, l, lds); }
        SEAM(pb + 3);
        if (EN(4) && IN(pb + 4)) { PS5B P{LWS(), C.G, cg, 256, 128u}; pg8::gemm_phase(C.lds, P); }
        SEAM(pb + 4);
        if (EN(5) && IN(pb + 5)) { PGlu P{LWS(), C.G, cg, 512, 128u}; pg8::gemm_phase(C.lds, P); }
        SEAM(pb + 5);
        if (EN(6) && IN(pb + 6)) { PMerge P{LWS(), C.G, cg, 512, 128u}; pg8::gemm_phase(C.lds, P); }
        SEAM(pb + 6);
        if (EN(7) && IN(pb + 7)) { unsigned char* wl_ = LWS(); PWout P{wl_, (float*)C.in[29], (const float*)(wl_ + WS_MOD) + (size_t)l * 5 * 6144, C.G, cg, 1024, 128u}; pg8::gemm_phase(C.lds, P); }
        SEAM(pb + 7);
        if (EN(8) && IN(pb + 8)) { const Ctx Cl = LC(); phase_norm2(Cl, l); }
        SEAM(pb + 8);
        if (EN(9) && IN(pb + 9)) { build_exptab(C, tab, l); PMoe1 P{LWS(), tab, C.G, cg, 1024, 128u}; pg8::gemm_phase(C.lds, P); }
        SEAM(pb + 9);
        if (EN(10) && IN(pb + 10)) { build_exptab(C, tab, l); PMoe2 P{LWS(), tab, C.G, cg, 512, 128u}; pg8::gemm_phase(C.lds, P); }
        SEAM(pb + 10);
    }
    if (EN(12) && IN(NPH - 1)) { const Ctx Cl = LC(); phase_rows<2>(Cl, NLAYER); }
#undef IN
#undef SEAM
}

#ifndef MK_PER_PHASE
#define MK_PER_PHASE 0
#endif
extern "C" void kernel_launch(void* const* d_in, const int* in_sizes, int n_in, void* d_out, int out_size, void* d_ws, size_t ws_size, hipStream_t stream) {
    static int grid = 0;
    if (grid == 0) {
        if (n_in != 29 || out_size != NB * SEQ * D || ws_size < WS_END) { fprintf(stderr, "kernel_launch: unexpected shapes (n_in %d out %d ws %zu)\n", n_in, out_size, ws_size); grid = -1; return; }
        int dev = 0, cus = 0, per_cu = 0;
        if (hipGetDevice(&dev) != hipSuccess || hipDeviceGetAttribute(&cus, hipDeviceAttributeMultiprocessorCount, dev) != hipSuccess) { grid = -1; return; }
        if (hipFuncSetAttribute((const void*)fwd, hipFuncAttributeMaxDynamicSharedMemorySize, LDS_BYTES) != hipSuccess) { grid = -1; return; }
        if (hipOccupancyMaxActiveBlocksPerMultiprocessor(&per_cu, (const void*)fwd, NWAVES * 64, LDS_BYTES) != hipSuccess || per_cu < 1) fprintf(stderr, "kernel_launch: occupancy query says %d\n", per_cu);
        (void)hipGetLastError();
        grid = cus;
    }
    if (grid < 0) return;
    (void)hipMemsetAsync((char*)d_ws + WS_CTL, 0, CTL_ZERO_BYTES, stream);
    Args a{};
    for (int i = 0; i < 29; ++i) a.in[i] = (const float*)d_in[i];
    a.out = (float*)d_out; a.ws = (unsigned char*)d_ws;
#if MK_PER_PHASE
    for (int p = 0; p < NPH; ++p) { a.ph_lo = p; a.ph_hi = p + 1; hipLaunchKernelGGL(fwd, dim3(grid), dim3(NWAVES * 64), LDS_BYTES, stream, a); }
#else
    a.ph_lo = 0; a.ph_hi = NPH; hipLaunchKernelGGL(fwd, dim3(grid), dim3(NWAVES * 64), LDS_BYTES, stream, a);
#endif
}
```

```cpp
#define FP8_MOE 1
#define GATE_BF16 0
#define H8_WRITE 1
#ifndef H8_WRITE
#define H8_WRITE 1
#endif
#ifndef GATE_BF16
#define GATE_BF16 0
#endif
#include <hip/hip_runtime.h>
#include <cstdio>
#include <cstdint>

#define GAS __attribute__((address_space(1)))
#define LAS __attribute__((address_space(3)))
typedef unsigned short bf16;
typedef unsigned v4u __attribute__((ext_vector_type(4)));
typedef unsigned v2u __attribute__((ext_vector_type(2)));
typedef float f32x4 __attribute__((ext_vector_type(4)));
typedef float f32x2 __attribute__((ext_vector_type(2)));
typedef float f32x16 __attribute__((ext_vector_type(16)));
typedef short bf16x8 __attribute__((ext_vector_type(8)));
typedef short s16x4 __attribute__((ext_vector_type(4)));
typedef GAS unsigned gu32;
#define RLX_AGENT __ATOMIC_RELAXED, __HIP_MEMORY_SCOPE_AGENT
#define LDS_WAIT() asm volatile("s_waitcnt lgkmcnt(0)" ::: "memory")
#define VM_WAIT() asm volatile("s_waitcnt vmcnt(0)" ::: "memory")

constexpr int NB = 4, SEQ = 8192, CTX = 256, LB = SEQ + CTX, T = NB * LB, D = 1024, NPAN = T / 256;
constexpr int NLAYER = 4, INW = 5888, NCH = LB / 32, NCR = NB * NCH;
constexpr int NEXP = 16, FF = 512;
constexpr float EPS = 1e-6f;
constexpr float LOG2E = 1.4426950408889634f;
constexpr float C2 = 0.125f * LOG2E;
constexpr int NWAVES = 8;

constexpr size_t MiB = 1u << 20;
constexpr size_t WS_CTL = 0, CTL_ZERO_BYTES = 1 * MiB;
constexpr size_t WS_MOD = 1 * MiB;
constexpr size_t WS_LIST = 2 * MiB;
constexpr size_t WS_RW = 5 * MiB;
constexpr size_t WS_CTXS = 6 * MiB;
constexpr size_t WS_SST = 10 * MiB;
constexpr size_t WS_HB8 = WS_SST;
constexpr size_t WS_XST = 44 * MiB;
constexpr size_t WS_BT1 = 61 * MiB;
constexpr size_t WS_BT2 = 85 * MiB;
constexpr size_t WS_WIN = 93 * MiB;
constexpr size_t WS_WIN8 = WS_WIN + (size_t)2816 * 1024 * 2;
constexpr size_t WS_WGLU = 105 * MiB;
constexpr size_t WS_WBR = 106 * MiB;
constexpr size_t WS_WOUT = 109 * MiB;
constexpr size_t WS_MOE1 = 111 * MiB;
constexpr size_t WS_MOE2 = 143 * MiB;
constexpr size_t WS_HB = 159 * MiB;
constexpr size_t WS_U = 225 * MiB;
constexpr size_t WS_QA = 258 * MiB;
constexpr size_t WS_KA = 291 * MiB;
constexpr size_t WS_VA = 300 * MiB;
constexpr size_t WS_QN = 309 * MiB;
constexpr size_t WS_KN = 342 * MiB;
constexpr size_t WS_VN = 375 * MiB;
constexpr size_t WS_YS = 408 * MiB;
constexpr size_t WS_GATES = 441 * MiB;
constexpr size_t WS_ACT = WS_QN;
constexpr size_t WS_ACTB = WS_QN;
constexpr size_t WS_YSLOT = WS_GATES;
constexpr size_t WS_AO = 640 * MiB;
constexpr size_t WS_NO = 673 * MiB;
constexpr size_t WS_YG = 706 * MiB;
constexpr size_t WS_END = 739 * MiB;
static_assert(WS_GATES + (size_t)T * 3072 * 2 <= WS_AO && WS_ACT + (size_t)(2 * T + 4096) * 512 * 2 <= WS_YS, "ws map");
constexpr int CW_FAIL = 8;
constexpr int CW_CNT = 64;
constexpr int CW_BAR = 8192;

constexpr int RING_BYTES = 131072, LDS_BYTES = 147456, LDSCTL_OFF = LDS_BYTES - 512, MISC_OFF = LDSCTL_OFF + 320;

__device__ __forceinline__ unsigned f2bf(float f) { unsigned u = __builtin_bit_cast(unsigned, f); return (u + 0x7fffu + ((u >> 16) & 1u)) >> 16; }
__device__ __forceinline__ unsigned pk2(float lo, float hi) { return f2bf(lo) | (f2bf(hi) << 16); }
__device__ __forceinline__ float bf2f(unsigned b) { return __builtin_bit_cast(float, b << 16); }
__device__ __forceinline__ float bflo(unsigned w) { return __builtin_bit_cast(float, w << 16); }
__device__ __forceinline__ float bfhi(unsigned w) { return __builtin_bit_cast(float, w & 0xffff0000u); }
typedef float f32x2_c __attribute__((ext_vector_type(2))); typedef __bf16 bf16x2_c __attribute__((ext_vector_type(2)));
__device__ __forceinline__ unsigned cvt_pk_bf16(float lo, float hi) { const f32x2_c v = {lo, hi}; return __builtin_bit_cast(unsigned, __builtin_convertvector(v, bf16x2_c)); }
typedef int v8i __attribute__((ext_vector_type(8)));
typedef int v4i __attribute__((ext_vector_type(4)));
__device__ __forceinline__ float clamp8(float x) { return __builtin_fminf(__builtin_fmaxf(x, -448.f), 448.f); }
__device__ __forceinline__ unsigned pk4_fp8(float a, float b, float c, float d) { int w = 0; w = __builtin_amdgcn_cvt_pk_fp8_f32(clamp8(a), clamp8(b), w, false); w = __builtin_amdgcn_cvt_pk_fp8_f32(clamp8(c), clamp8(d), w, true); return (unsigned)w; }
__device__ __forceinline__ float fsigmoid(float x) { return __builtin_amdgcn_rcpf(1.f + __builtin_amdgcn_exp2f(-LOG2E * x)); }
__device__ __forceinline__ float gelu_tanh(float x) { const float u = 0.7978845608f * (x + 0.044715f * x * x * x); return x * __builtin_amdgcn_rcpf(1.f + __builtin_amdgcn_exp2f(-2.f * LOG2E * u)); }
__device__ __forceinline__ float shflx(float v, int m, int lane) { return __builtin_bit_cast(float, __builtin_amdgcn_ds_bpermute((lane ^ m) << 2, __builtin_bit_cast(int, v))); }
__device__ __forceinline__ float wave_sum(float v, int lane) {
#pragma unroll
    for (int o = 1; o < 64; o <<= 1) v += shflx(v, o, lane);
    return v;
}
__device__ __forceinline__ float sin_rev(float r) { r = r - floorf(r); return __builtin_amdgcn_sinf(r); }
__device__ __forceinline__ float cos_rev(float r) { r = r - floorf(r); return __builtin_amdgcn_cosf(r); }

#define XB_TMO      128
#define XB_XCNT(j)  (256  + 64 * (j))
#define XB_XSUB(j)  (1280 + 64 * (j))
#define XB_XGEN(j)  (2304 + 64 * (j))
#define XB_TOP      3328
#define XB_TOPGEN   3392
#define XCD_BAR_WORDS 3456
#define XB_SPIN_CAP (1u << 22)

__device__ __forceinline__ unsigned xb_ld(unsigned* p)              { return __hip_atomic_load(p, __ATOMIC_RELAXED, __HIP_MEMORY_SCOPE_AGENT); }
__device__ __forceinline__ unsigned xb_add(unsigned* p, unsigned v) { return __hip_atomic_fetch_add(p, v, __ATOMIC_RELAXED, __HIP_MEMORY_SCOPE_AGENT); }
__device__ __forceinline__ unsigned xb_xcc_id() { return (unsigned)__builtin_amdgcn_s_getreg((3 << 11) | 20) & 0xFu; }
#define XB_SPIN(cond, bar) do { unsigned _sp = 0; while (cond) { __builtin_amdgcn_s_sleep(1); \
    if ((++_sp & 255u) == 0u) { if (xb_ld(&(bar)[XB_TMO])) break; if (_sp > XB_SPIN_CAP) { atomicAdd(&(bar)[XB_TMO], 1u); break; } } } } while (0)

struct XcdBarrier { unsigned* bar; unsigned x; volatile LAS unsigned* st; };

__device__ __forceinline__ XcdBarrier xcd_barrier_post(unsigned* bar, volatile LAS unsigned* st) {
    XcdBarrier b; b.bar = bar; b.x = xb_xcc_id(); b.st = st;
    if (threadIdx.x == 0) (void)xb_add(&bar[XB_XCNT(b.x)], 1u);
    return b;
}
__device__ __forceinline__ void xcd_barrier_complete(unsigned* bar, unsigned x, unsigned& nloc, unsigned& nx) {
    const unsigned G = gridDim.x * gridDim.y * gridDim.z;
    unsigned sum, cnt, mine, sp = 0u;
    for (;;) {
        sum = 0u; cnt = 0u; mine = 0u;
#pragma unroll
        for (unsigned j = 0; j < 16; ++j) { const unsigned c = xb_ld(&bar[XB_XCNT(j)]); sum += c; cnt += (c > 0u) ? 1u : 0u; mine = (j == x) ? c : mine; }
        if (sum == G) break;
        __builtin_amdgcn_s_sleep(1);
        if ((++sp & 255u) == 0u) { if (xb_ld(&bar[XB_TMO])) break; if (sp > XB_SPIN_CAP) { atomicAdd(&bar[XB_TMO], 1u); break; } }
    }
    nloc = mine > 0u ? mine : 1u; nx = cnt > 0u ? cnt : 1u;
}
__device__ __forceinline__ void xcd_barrier(const XcdBarrier& b) {
    asm volatile("s_waitcnt vmcnt(0)" ::: "memory");
    __syncthreads();
    if (threadIdx.x == 0) {
        unsigned* bar = b.bar;
        __builtin_amdgcn_s_waitcnt(0);
        unsigned nloc = b.st[0], nx = b.st[1];
        if (nloc == 0u) { xcd_barrier_complete(bar, b.x, nloc, nx); b.st[0] = nloc; b.st[1] = nx; }
        const unsigned old = xb_add(&bar[XB_XSUB(b.x)], 1u);
        const unsigned gen = old / nloc;
        if (old + 1u == (gen + 1u) * nloc) {
            __builtin_amdgcn_fence(__ATOMIC_RELEASE, "agent");
            asm volatile("s_waitcnt vmcnt(0)" ::: "memory");
            const unsigned og = xb_add(&bar[XB_TOP], 1u);
            const unsigned tg = og / nx;
            if (og + 1u == (tg + 1u) * nx) xb_add(&bar[XB_TOPGEN], 1u);
            else XB_SPIN(xb_ld(&bar[XB_TOPGEN]) == tg, bar);
            __builtin_amdgcn_fence(__ATOMIC_ACQUIRE, "agent");
            xb_add(&bar[XB_XGEN(b.x)], 1u);
            asm volatile("s_waitcnt vmcnt(0)" ::: "memory");
        } else {
            XB_SPIN(xb_ld(&bar[XB_XGEN(b.x)]) == gen, bar);
            __builtin_amdgcn_fence(__ATOMIC_ACQUIRE, "agent");
            asm volatile("s_waitcnt vmcnt(0)" ::: "memory");
        }
    }
    __syncthreads();
}

namespace pg8 {
constexpr int BM = 256, BK = 64, HALF = 128, HTB = HALF * BK * 2, STAGE_BYTES = 8 * HTB, NXCD = 8, WGM = 8;
__host__ __device__ __forceinline__ int lds_byte(int r, int c) { const int st = (r >> 4) * 2 + (c >> 5), rr = r & 15, cc = c & 31, ob = rr * 64 + cc * 2; return st * 1024 + (ob ^ (((ob >> 9) & 1) << 5)); }
__host__ __device__ __forceinline__ void stage_rc(int b, int& R, int& C) { const int st = b / 1024, sb = b % 1024, swz = sb ^ (((sb >> 9) & 1) << 5); R = (st >> 1) * 16 + swz / 64; C = (st & 1) * 32 + (swz % 64) / 2; }
__host__ __device__ __forceinline__ int perm32(int rho) { const int n = rho >> 4, i = rho & 15; return 8 * (i >> 2) + 4 * n + (i & 3); }

struct Unit { int pm, pn, z; };

__device__ __forceinline__ void static_decode(int L, int nM, int nN, int& pm, int& pn) {
    const int nwg = nM * nN; int wgid = L;
    { const int q = nwg / NXCD, r = nwg % NXCD, xcd = wgid % NXCD, off = wgid / NXCD; wgid = (xcd < r ? xcd * (q + 1) : r * (q + 1) + (xcd - r) * q) + off; }
    const int nig = WGM * nN, gid = wgid / nig, fm = gid * WGM, gsz = (nM - fm) < WGM ? (nM - fm) : WGM;
    pm = fm + ((wgid % nig) % gsz); pn = (wgid % nig) / gsz;
}

template <class P>
__device__ __forceinline__ void gemm_phase(LAS unsigned char* lds, const P& S) {
    int tid_ = threadIdx.x; asm volatile("" : "+v"(tid_));
    const int tid = tid_, wid = __builtin_amdgcn_readfirstlane(tid >> 6), lane = tid & 63, wr = wid >> 2, wc = wid & 3, fr = lane & 15, fq = lane >> 4;
    constexpr int ELB = P::FP8 ? 1 : 2;
    const int K = S.K; int nt = K * ELB / 128; asm volatile("" : "+s"(nt));
    unsigned voffB[2];
#pragma unroll
    for (int i = 0; i < 2; ++i) { int R, C; stage_rc(tid * 16 + i * 8192, R, C); const int Rb = (R & ~31) + perm32(R & 31); voffB[i] = (unsigned)(Rb * K * ELB + C * 2); }
#define PG8_AOFF(dst0, dst1, u) do { _Pragma("unroll") for (int i = 0; i < 2; ++i) { int R, C; stage_rc(tid * 16 + i * 8192, R, C); dst0[i] = S.a_off(u, 0, R, C); dst1[i] = S.a_off(u, 1, R, C); } } while (0)
    const size_t kstepB = (size_t)(BK * 2), hstepB = (size_t)HALF * K * ELB, kstepA = (size_t)S.kstepA;
    const unsigned ldsw = (unsigned)wid * 1024u;
    const int aoff = lds_byte(wr * 64 + fr, fq * 8), boff = lds_byte(wc * 32 + fr, fq * 8);
#define PG8_SA(b, h) (((b) * 2 + (h)) * HTB)
#define PG8_SB(b, h) ((4 + (b) * 2 + (h)) * HTB)
#define PG8_STAGE(bufoff, gbase, voff) do { _Pragma("unroll") for (int _i = 0; _i < 2; ++_i) \
        __builtin_amdgcn_global_load_lds((const unsigned*)((const char*)(gbase) + (voff)[_i]), (LAS unsigned*)(lds + (bufoff) + ldsw + _i * 8192), 16, 0, 0); } while (0)
#define PG8_LDA(dst, b, h) do { _Pragma("unroll") for (int m = 0; m < 4; ++m) _Pragma("unroll") for (int k = 0; k < 2; ++k) dst[m][k] = *(const LAS bf16x8*)(lds + PG8_SA(b, h) + aoff + m * 2048 + k * 1024); } while (0)
#define PG8_LDB(dst, b, h) do { _Pragma("unroll") for (int n = 0; n < 2; ++n) _Pragma("unroll") for (int k = 0; k < 2; ++k) dst[n][k] = *(const LAS bf16x8*)(lds + PG8_SB(b, h) + boff + n * 2048 + k * 1024); } while (0)
#define PG8_CAT(x0, x1) __builtin_shufflevector(__builtin_bit_cast(v4i, x0), __builtin_bit_cast(v4i, x1), 0, 1, 2, 3, 4, 5, 6, 7)
#define PG8_MMA(ai, bj, At, Bt) do { __builtin_amdgcn_s_setprio(1); _Pragma("unroll") for (int m = 0; m < 4; ++m) _Pragma("unroll") for (int n = 0; n < 2; ++n) { \
        if constexpr (P::FP8) acc[ai][bj][m][n] = __builtin_amdgcn_mfma_scale_f32_16x16x128_f8f6f4(PG8_CAT(Bt[n][0], Bt[n][1]), PG8_CAT(At[m][0], At[m][1]), acc[ai][bj][m][n], 0, 0, 0, 0x7f7f7f7f, 0, 0x7f7f7f7f); \
        else { _Pragma("unroll") for (int k = 0; k < 2; ++k) acc[ai][bj][m][n] = __builtin_amdgcn_mfma_f32_16x16x32_bf16(Bt[n][k], At[m][k], acc[ai][bj][m][n], 0, 0, 0); } } __builtin_amdgcn_s_setprio(0); } while (0)
#define PG8_WAIT_V(n) asm volatile("s_waitcnt vmcnt(" #n ")" ::: "memory")
#define PG8_WAIT_L(n) asm volatile("s_waitcnt lgkmcnt(" #n ")" ::: "memory")
#define PG8_BAR __builtin_amdgcn_s_barrier()
#define PG8_SCHED __builtin_amdgcn_sched_barrier(0)
    Unit cur, nxt; int ui = 0;
    if (!S.next(0, cur)) return;
    f32x4 acc[2][2][4][2];
#pragma unroll
    for (int a = 0; a < 2; ++a)
#pragma unroll
        for (int b = 0; b < 2; ++b)
#pragma unroll
            for (int m = 0; m < 4; ++m)
#pragma unroll
                for (int n = 0; n < 2; ++n) acc[a][b][m][n] = (f32x4){0.f, 0.f, 0.f, 0.f};
    bf16x8 At[4][2], B0[2][2], B1[2][2];
    unsigned vA0[2], vA1[2], vN0[2], vN1[2];
    PG8_AOFF(vA0, vA1, cur);
    const char* cA = S.a_base(cur); const char* cB = S.b_base(cur);
    PG8_STAGE(PG8_SB(0, 0), cB, voffB); PG8_STAGE(PG8_SB(0, 1), cB + hstepB, voffB); PG8_STAGE(PG8_SA(0, 0), cA, vA0); PG8_STAGE(PG8_SA(0, 1), cA, vA1);
    if (wr == 1) PG8_BAR;
    PG8_WAIT_V(2); PG8_BAR;
    PG8_STAGE(PG8_SB(1, 0), cB + kstepB, voffB); PG8_STAGE(PG8_SA(1, 0), cA + kstepA, vA0); PG8_STAGE(PG8_SB(1, 1), cB + hstepB + kstepB, voffB);
    PG8_WAIT_V(6); PG8_BAR;
    for (;;) {
        const bool has_next = S.next(ui + 1, nxt);
        const char* nA = cA; const char* nB = cB;
        if (has_next) { nA = S.a_base(nxt); nB = S.b_base(nxt); if (P::EARLY_AOFF) PG8_AOFF(vN0, vN1, nxt); }
        for (int t = 0; t < nt; t += 2) {
            const bool last = (t == nt - 2);
            const char* a1 = cA + (size_t)(t + 1) * kstepA;
            const char* a2 = last ? nA : cA + (size_t)(t + 2) * kstepA; const char* b2 = last ? nB : cB + (size_t)(t + 2) * kstepB;
            const char* a3 = a2 + kstepA; const char* b3 = b2 + kstepB;
            PG8_LDB(B0, 0, 0); PG8_LDB(B1, 0, 1); PG8_SCHED; PG8_LDA(At, 0, 0); PG8_STAGE(PG8_SA(1, 1), a1, vA1);
            if (last && has_next) {
                if (P::EARLY_AOFF) { _Pragma("unroll") for (int i = 0; i < 2; ++i) { vA0[i] = vN0[i]; vA1[i] = vN1[i]; } } else PG8_AOFF(vA0, vA1, nxt); }
            PG8_WAIT_V(8); PG8_WAIT_L(0); PG8_BAR; PG8_MMA(0, 0, At, B0); PG8_MMA(0, 1, At, B1); PG8_BAR; PG8_SCHED;
            PG8_LDA(At, 0, 1); PG8_STAGE(PG8_SB(0, 0), b2, voffB); PG8_STAGE(PG8_SB(0, 1), b2 + hstepB, voffB); PG8_STAGE(PG8_SA(0, 0), a2, vA0);
            PG8_WAIT_V(8); PG8_WAIT_L(0); PG8_BAR; PG8_MMA(1, 0, At, B0); PG8_MMA(1, 1, At, B1); PG8_BAR; PG8_SCHED;
            PG8_LDB(B0, 1, 0); PG8_LDB(B1, 1, 1); PG8_SCHED; PG8_LDA(At, 1, 0); PG8_STAGE(PG8_SA(0, 1), a2, vA1);
            PG8_WAIT_V(8); PG8_WAIT_L(0); PG8_BAR; PG8_MMA(0, 0, At, B0); PG8_MMA(0, 1, At, B1); PG8_BAR; PG8_SCHED;
            PG8_LDA(At, 1, 1); PG8_STAGE(PG8_SB(1, 0), b3, voffB); PG8_STAGE(PG8_SB(1, 1), b3 + hstepB, voffB); PG8_STAGE(PG8_SA(1, 0), a3, vA0);
            PG8_WAIT_V(8); PG8_WAIT_L(0); PG8_BAR; PG8_MMA(1, 0, At, B0); PG8_MMA(1, 1, At, B1); PG8_BAR; PG8_SCHED;
        }
        if (wr == 0) PG8_BAR;
        S.epi(acc, cur, wr, wc, fr, fq);
        if (!has_next) break;
#pragma unroll
        for (int a = 0; a < 2; ++a)
#pragma unroll
            for (int b = 0; b < 2; ++b)
#pragma unroll
                for (int m = 0; m < 4; ++m)
#pragma unroll
                    for (int n = 0; n < 2; ++n) acc[a][b][m][n] = (f32x4){0.f, 0.f, 0.f, 0.f};
        cur = nxt; cA = nA; cB = nB; ++ui;
        if (wr == 1) PG8_BAR;
    }
    PG8_WAIT_V(0);
    PG8_BAR;
#undef PG8_AOFF
#undef PG8_SA
#undef PG8_SB
#undef PG8_STAGE
#undef PG8_LDA
#undef PG8_LDB
#undef PG8_MMA
#undef PG8_CAT
#undef PG8_WAIT_V
#undef PG8_WAIT_L
#undef PG8_BAR
#undef PG8_SCHED
}

template <class P>
__device__ __forceinline__ void gemm_phase_m128(LAS unsigned char* lds, const P& S) {
    int tid_ = threadIdx.x; asm volatile("" : "+v"(tid_));
    const int tid = tid_, wid = __builtin_amdgcn_readfirstlane(tid >> 6), lane = tid & 63, wr = wid >> 2, wc = wid & 3, fr = lane & 15, fq = lane >> 4;
    constexpr int ELB = P::FP8 ? 1 : 2;
    const int K = S.K; int nt = K * ELB / 128; asm volatile("" : "+s"(nt));
    unsigned voffB[2];
#pragma unroll
    for (int i = 0; i < 2; ++i) { int R, C; stage_rc(tid * 16 + i * 8192, R, C); const int Rb = (R & ~31) + perm32(R & 31); voffB[i] = (unsigned)(Rb * K * ELB + C * 2); }
#define PG8_AOFF(dst0, u) do { _Pragma("unroll") for (int i = 0; i < 2; ++i) { int R, C; stage_rc(tid * 16 + i * 8192, R, C); dst0[i] = S.a_off(u, R, C); } } while (0)
    const size_t kstepB = (size_t)(BK * 2), hstepB = (size_t)HALF * K * ELB, kstepA = (size_t)S.kstepA;
    const unsigned ldsw = (unsigned)wid * 1024u;
    const int aoff = lds_byte(wr * 64 + fr, fq * 8), boff = lds_byte(wc * 32 + fr, fq * 8);
#define PG8_SA(b) (((b) * 2) * HTB)
#define PG8_SB(b, h) ((4 + (b) * 2 + (h)) * HTB)
#define PG8_STAGE(bufoff, gbase, voff) do { _Pragma("unroll") for (int _i = 0; _i < 2; ++_i) \
        __builtin_amdgcn_global_load_lds((const unsigned*)((const char*)(gbase) + (voff)[_i]), (LAS unsigned*)(lds + (bufoff) + ldsw + _i * 8192), 16, 0, 0); } while (0)
#define PG8_LDA(dst, b) do { _Pragma("unroll") for (int m = 0; m < 4; ++m) _Pragma("unroll") for (int k = 0; k < 2; ++k) dst[m][k] = *(const LAS bf16x8*)(lds + PG8_SA(b) + aoff + m * 2048 + k * 1024); } while (0)
#define PG8_LDB(dst, b, h) do { _Pragma("unroll") for (int n = 0; n < 2; ++n) _Pragma("unroll") for (int k = 0; k < 2; ++k) dst[n][k] = *(const LAS bf16x8*)(lds + PG8_SB(b, h) + boff + n * 2048 + k * 1024); } while (0)
#define PG8_CAT(x0, x1) __builtin_shufflevector(__builtin_bit_cast(v4i, x0), __builtin_bit_cast(v4i, x1), 0, 1, 2, 3, 4, 5, 6, 7)
#define PG8_MMA(bj, At, Bt) do { __builtin_amdgcn_s_setprio(1); _Pragma("unroll") for (int m = 0; m < 4; ++m) _Pragma("unroll") for (int n = 0; n < 2; ++n) { \
        if constexpr (P::FP8) acc[bj][m][n] = __builtin_amdgcn_mfma_scale_f32_16x16x128_f8f6f4(PG8_CAT(Bt[n][0], Bt[n][1]), PG8_CAT(At[m][0], At[m][1]), acc[bj][m][n], 0, 0, 0, 0x7f7f7f7f, 0, 0x7f7f7f7f); \
        else { _Pragma("unroll") for (int k = 0; k < 2; ++k) acc[bj][m][n] = __builtin_amdgcn_mfma_f32_16x16x32_bf16(Bt[n][k], At[m][k], acc[bj][m][n], 0, 0, 0); } } __builtin_amdgcn_s_setprio(0); } while (0)
#define PG8_WAIT_V(n) asm volatile("s_waitcnt vmcnt(" #n ")" ::: "memory")
#define PG8_WAIT_L(n) asm volatile("s_waitcnt lgkmcnt(" #n ")" ::: "memory")
#define PG8_BAR __builtin_amdgcn_s_barrier()
#define PG8_SCHED __builtin_amdgcn_sched_barrier(0)
    Unit cur, nxt; int ui = 0;
    if (!S.next(0, cur)) return;
    f32x4 acc[2][4][2], st[2][4][2];
#pragma unroll
    for (int a = 0; a < 2; ++a)
#pragma unroll
        for (int m = 0; m < 4; ++m)
#pragma unroll
            for (int n = 0; n < 2; ++n) { acc[a][m][n] = (f32x4){0.f, 0.f, 0.f, 0.f}; st[a][m][n] = (f32x4){0.f, 0.f, 0.f, 0.f}; }
    bf16x8 At[4][2], B0[2][2];
    unsigned vA[2], vN[2];
    PG8_AOFF(vA, cur);
    const char* cA = S.a_base(cur); const char* cB = S.b_base(cur);
    PG8_STAGE(PG8_SB(0, 0), cB, voffB); PG8_STAGE(PG8_SA(0), cA, vA); PG8_STAGE(PG8_SB(0, 1), cB + hstepB, voffB);
    if (wr == 1) PG8_BAR;
    PG8_WAIT_V(2); PG8_BAR;
    PG8_STAGE(PG8_SB(1, 0), cB + kstepB, voffB); PG8_STAGE(PG8_SA(1), cA + kstepA, vA);
    PG8_WAIT_V(4); PG8_BAR;
    for (;;) {
        const bool has_next = S.next(ui + 1, nxt);
        const char* nA = cA; const char* nB = cB;
        if (has_next) { nA = S.a_base(nxt); nB = S.b_base(nxt); if (P::EARLY_AOFF) PG8_AOFF(vN, nxt); }
        for (int t = 0; t < nt; t += 2) {
            const bool last = (t == nt - 2);
            const char* b1 = cB + (size_t)(t + 1) * kstepB;
            const char* a2 = last ? nA : cA + (size_t)(t + 2) * kstepA; const char* b2 = last ? nB : cB + (size_t)(t + 2) * kstepB;
            const char* a3 = a2 + kstepA; const char* b3 = b2 + kstepB;
            PG8_LDB(B0, 0, 0); PG8_SCHED; PG8_LDA(At, 0); PG8_STAGE(PG8_SB(1, 1), b1 + hstepB, voffB);
            if (last && has_next) { if (P::EARLY_AOFF) { vA[0] = vN[0]; vA[1] = vN[1]; } else PG8_AOFF(vA, nxt); }
            PG8_WAIT_V(6); PG8_WAIT_L(0); PG8_BAR; PG8_MMA(0, At, B0); PG8_BAR; PG8_SCHED;
            PG8_LDB(B0, 0, 1); PG8_STAGE(PG8_SB(0, 0), b2, voffB); PG8_STAGE(PG8_SA(0), a2, vA);
            PG8_WAIT_V(6); PG8_WAIT_L(0); PG8_BAR; PG8_MMA(1, At, B0); PG8_BAR; PG8_SCHED;
            PG8_LDB(B0, 1, 0); PG8_SCHED; PG8_LDA(At, 1); PG8_STAGE(PG8_SB(0, 1), b2 + hstepB, voffB);
            PG8_WAIT_V(6); PG8_WAIT_L(0); PG8_BAR; PG8_MMA(0, At, B0); PG8_BAR; PG8_SCHED;
            PG8_LDB(B0, 1, 1); PG8_STAGE(PG8_SB(1, 0), b3, voffB); PG8_STAGE(PG8_SA(1), a3, vA);
            PG8_WAIT_V(6); PG8_WAIT_L(0); PG8_BAR; PG8_MMA(1, At, B0); PG8_BAR; PG8_SCHED;
        }
        if (wr == 0) PG8_BAR;
        S.epi(acc, st, cur, wr, wc, fr, fq);
        if (!has_next) break;
#pragma unroll
        for (int a = 0; a < 2; ++a)
#pragma unroll
            for (int m = 0; m < 4; ++m)
#pragma unroll
                for (int n = 0; n < 2; ++n) acc[a][m][n] = (f32x4){0.f, 0.f, 0.f, 0.f};
        cur = nxt; cA = nA; cB = nB; ++ui;
        if (wr == 1) PG8_BAR;
    }
    PG8_WAIT_V(0);
    PG8_BAR;
#undef PG8_AOFF
#undef PG8_SA
#undef PG8_SB
#undef PG8_STAGE
#undef PG8_LDA
#undef PG8_LDB
#undef PG8_MMA
#undef PG8_CAT
#undef PG8_WAIT_V
#undef PG8_WAIT_L
#undef PG8_BAR
#undef PG8_SCHED
}
}
namespace attn_body {
using bf16x8 = __attribute__((ext_vector_type(8))) short;
using u32x4 = __attribute__((ext_vector_type(4))) unsigned;
constexpr int NW = 8, QBLK = 32, QB = QBLK * NW, KVBLK = 64;
__device__ __forceinline__ int crow(int r, int hi) { return (r & 3) + 8 * (r >> 2) + 4 * hi; }
#define SBAR() __builtin_amdgcn_sched_barrier(0)
constexpr int NSLOT = 3, SLOTB = 8192;
constexpr int LDS_K = 0, LDS_V = NSLOT * SLOTB, LDS_WS = 2 * NSLOT * SLOTB, LDS_OST = LDS_WS + NW * 64 * 4, LDS_BYTES = LDS_OST + NW * 4096;
constexpr int LDS_BT = 86016 + 256;
__device__ __forceinline__ void glds16(const void* gsrc, unsigned lds_dst) { unsigned keep;
  asm volatile("s_mov_b32 %0, m0\n\ts_mov_b32 m0, %2\n\ts_nop 0\n\tglobal_load_lds_dwordx4 %1, off\n\ts_mov_b32 m0, %0" : "=&s"(keep) : "v"(gsrc), "s"(lds_dst) : "memory"); }
__device__ __forceinline__ float max3f(float a, float b, float c) { float r; asm("v_max3_f32 %0, %1, %2, %3" : "=v"(r) : "v"(a), "v"(b), "v"(c)); return r; }
__device__ __forceinline__ float max2f(float a, float b) { float r; asm("v_max_f32_e32 %0, %1, %2" : "=v"(r) : "v"(a), "v"(b)); return r; }
__device__ __forceinline__ float fadd_s(float a, float b) { float r; asm("v_add_f32_e32 %0, %1, %2" : "=v"(r) : "v"(a), "v"(b)); return r; }
__device__ __forceinline__ float fsub_s(float a, float b) { float r; asm("v_sub_f32_e32 %0, %1, %2" : "=v"(r) : "v"(a), "v"(b)); return r; }
typedef float f32x2_t __attribute__((ext_vector_type(2))); typedef __bf16 bf16x2_t __attribute__((ext_vector_type(2)));
__device__ __forceinline__ unsigned cvtpk_s(float lo, float hi) { f32x2_t v = {lo, hi}; bf16x2_t b = __builtin_convertvector(v, bf16x2_t); return __builtin_bit_cast(unsigned, b); }
#define WAIT_BAR(N) asm volatile("s_waitcnt vmcnt(" #N ") lgkmcnt(0)\n\ts_barrier" ::: "memory")

__device__ __forceinline__ void qkt(f32x16& p0, f32x16& p1, const char* Kslot, const bf16x8* qr, const f32x16& negm, int r32, int hi) {
  const char* kb = Kslot + hi * 1024 + r32 * 16;
  #pragma unroll
  for (int d0 = 0; d0 < 4; ++d0) {
    const bf16x8 b0 = *reinterpret_cast<const bf16x8*>(kb + d0 * 2048);
    const bf16x8 b1 = *reinterpret_cast<const bf16x8*>(kb + d0 * 2048 + 512);
    if (d0 == 0) { p0 = __builtin_amdgcn_mfma_f32_32x32x16_bf16(b0, qr[0], negm, 0, 0, 0); p1 = __builtin_amdgcn_mfma_f32_32x32x16_bf16(b1, qr[0], negm, 0, 0, 0); }
    else { p0 = __builtin_amdgcn_mfma_f32_32x32x16_bf16(b0, qr[d0], p0, 0, 0, 0); p1 = __builtin_amdgcn_mfma_f32_32x32x16_bf16(b1, qr[d0], p1, 0, 0, 0); } }
}
typedef __attribute__((address_space(3))) const char* lds_cptr;
typedef short v4i16_t __attribute__((ext_vector_type(4)));
__device__ __forceinline__ void kload8(bf16x8* kf, lds_cptr kp) {
  kf[0] = *(const __attribute__((address_space(3))) bf16x8*)(kp);        kf[1] = *(const __attribute__((address_space(3))) bf16x8*)(kp + 512);
  kf[2] = *(const __attribute__((address_space(3))) bf16x8*)(kp + 2048); kf[3] = *(const __attribute__((address_space(3))) bf16x8*)(kp + 2560);
  kf[4] = *(const __attribute__((address_space(3))) bf16x8*)(kp + 4096); kf[5] = *(const __attribute__((address_space(3))) bf16x8*)(kp + 4608);
  kf[6] = *(const __attribute__((address_space(3))) bf16x8*)(kp + 6144); kf[7] = *(const __attribute__((address_space(3))) bf16x8*)(kp + 6656);
}
__device__ __forceinline__ void kload2(bf16x8* kf, lds_cptr kp, int j) { kf[2 * j] = *(const __attribute__((address_space(3))) bf16x8*)(kp + j * 2048); kf[2 * j + 1] = *(const __attribute__((address_space(3))) bf16x8*)(kp + j * 2048 + 512); }
__device__ __forceinline__ s16x4 vtr(lds_cptr p) { return __builtin_bit_cast(s16x4, __builtin_amdgcn_ds_read_tr16_b64_v4i16((__attribute__((address_space(3))) v4i16_t*)p)); }
__device__ __forceinline__ float rowmax(const f32x16& p0, const f32x16& p1) {
  float a = max3f(p0[0], p0[1], p1[0]), b = max3f(p0[2], p0[3], p1[1]); a = max3f(a, p1[2], p1[3]);
  #pragma unroll
  for (int r = 4; r < 16; r += 4) { a = max3f(a, p0[r], p0[r + 1]); b = max3f(b, p0[r + 2], p0[r + 3]); a = max3f(a, p1[r], p1[r + 1]); b = max3f(b, p1[r + 2], p1[r + 3]); }
  const float m = max2f(a, b);
  auto rr = __builtin_amdgcn_permlane32_swap(__float_as_uint(m), __float_as_uint(m), false, false);
  return max2f(__uint_as_float(rr[0]), __uint_as_float(rr[1]));
}
__device__ __forceinline__ void pv(f32x16* o, int vb, bf16x8 pa0, bf16x8 pa1, bf16x8 pa2, bf16x8 pa3) {
  #pragma unroll
  for (int d0 = 0; d0 < 2; ++d0) { s16x4 lo[4], hi[4];
    #pragma unroll
    for (int ks = 0; ks < 4; ++ks) {
      asm volatile("ds_read_b64_tr_b16 %0,%1 offset:%c2" : "=&v"(lo[ks]) : "v"(vb), "i"(d0 * 4096 + ks * 1024) : "memory");
      asm volatile("ds_read_b64_tr_b16 %0,%1 offset:%c2" : "=&v"(hi[ks]) : "v"(vb), "i"(d0 * 4096 + ks * 1024 + 512) : "memory"); }
    asm volatile("s_waitcnt lgkmcnt(0)" ::: "memory"); SBAR();
    #define PK(k) (bf16x8){lo[k][0], lo[k][1], lo[k][2], lo[k][3], hi[k][0], hi[k][1], hi[k][2], hi[k][3]}
    o[d0] = __builtin_amdgcn_mfma_f32_32x32x16_bf16(pa0, PK(0), o[d0], 0, 0, 0);
    o[d0] = __builtin_amdgcn_mfma_f32_32x32x16_bf16(pa1, PK(1), o[d0], 0, 0, 0);
    o[d0] = __builtin_amdgcn_mfma_f32_32x32x16_bf16(pa2, PK(2), o[d0], 0, 0, 0);
    o[d0] = __builtin_amdgcn_mfma_f32_32x32x16_bf16(pa3, PK(3), o[d0], 0, 0, 0);
    #undef PK
  }
}
#define ATTN_STORE16(p, v) (*(u32x4*)(p) = (v))

template <int THRL, bool NA, int QP_, int KVP_>
__device__ __forceinline__ void attn_unit(const bf16* Qu, int qp_rt, const bf16* __restrict__ Kh, const bf16* __restrict__ Vh, int kvp_rt, bf16* Ou, int NT, int r0, int rlo, char* shm) {
  const int qp = QP_ ? QP_ : qp_rt, kvp = KVP_ ? KVP_ : kvp_rt, op = qp;
  int tid_ = threadIdx.x; asm volatile("" : "+v"(tid_));
  const int tid = tid_, lane = tid & 63, r32 = lane & 31, hi = lane >> 5; const int wid = __builtin_amdgcn_readfirstlane(tid >> 6);
  const bf16* Qw = Qu + (long)(wid * QBLK) * qp;
  const unsigned lds0 = (unsigned)(uintptr_t)shm;
  float* wsf = (float*)(shm + LDS_WS) + wid * 64;
  const bf16* ksrc = Kh + (long)lane * kvp + wid * 8;
  const bf16* vsrc = Vh + (long)(16 * (wid & 3) + (lane >> 2)) * kvp + (wid >> 2) * 32 + (lane & 3) * 8;
  const unsigned kdst = lds0 + LDS_K + wid * 1024, vdst = lds0 + LDS_V + wid * 1024;
  #define TROW(t) (NA ? ((t) < 4 ? 64 * (t) : CTX + 64 * ((rlo + (t) - 4) < 127 ? (rlo + (t) - 4) : 127)) : 64 * (t))
  #define DMA_K(t, slot) glds16(ksrc + (long)TROW(t) * kvp, (unsigned)__builtin_amdgcn_readfirstlane(kdst + (slot)))
  #define DMA_V(t, slot) glds16(vsrc + (long)TROW(t) * kvp, (unsigned)__builtin_amdgcn_readfirstlane(vdst + (slot)))
  const int vb0 = (int)(lds0 + LDS_V) + ((lane >> 4) & 1) * 32 + (lane & 3) * 8 + (4 * hi + ((lane & 15) >> 2)) * 64;
  const char* Kbase = shm + LDS_K; bf16x8 kf[8];
  const lds_cptr shm3 = (lds_cptr)shm; const lds_cptr kp0 = shm3 + LDS_K + hi * 1024 + r32 * 16; const lds_cptr vp0 = shm3 + LDS_V + ((lane >> 4) & 1) * 32 + (lane & 3) * 8 + (4 * hi + ((lane & 15) >> 2)) * 64;
  const int rq = r0 + (wid >> 1), qc = 32 * (wid & 1) + r32;
  const int rsw = rq - 4 < 0 ? 0 : (rq - 4 > 120 ? 120 : rq - 4);
  const int cs = qc - 8 < 0 ? 0 : (qc - 8 > 48 ? 48 : qc - 8);
  const __attribute__((address_space(3))) float* btl = (const __attribute__((address_space(3))) float*)(shm3 + LDS_BT) + (15 + 4 * hi - qc);
  DMA_K(0, 0); DMA_V(0, 0); DMA_K(1, SLOTB);
  bf16x8 qr[4];
  #pragma unroll
  for (int d0 = 0; d0 < 4; ++d0) qr[d0] = *reinterpret_cast<const bf16x8*>(&Qw[(long)r32 * qp + d0 * 16 + hi * 8]);
  float mhat = 0.f, l_reg = 0.f; f32x16 o[2]; o[0] = f32x16{}; o[1] = f32x16{}; f32x16 negm = f32x16{}; if (!NA) asm volatile("" : "+v"(negm));
  #define NEGM (NA ? f32x16{} : negm)
  #define CMASK(P0, P1, t) do { if (NA) { if ((t) >= 4) { const int kr_ = rlo + (t) - 4; const int dr_ = kr_ - rsw; \
      if (dr_ < 0 || dr_ >= 8) { _Pragma("unroll") for (int r = 0; r < 16; ++r) { P0[r] = (-__builtin_inff()); P1[r] = (-__builtin_inff()); } } \
      else { const __attribute__((address_space(3))) float* bp_ = btl + (kr_ - rq + 7) * 31; const int kl0_ = 4 * hi - cs; \
        _Pragma("unroll") for (int rg = 0; rg < 4; ++rg) { \
          _Pragma("unroll") for (int rr_ = 0; rr_ < 4; ++rr_) { const int r = rg * 4 + rr_; const int kc_ = (r & 3) + 8 * (r >> 2); const float b0_ = bp_[kc_], b1_ = bp_[kc_ + 32]; \
            const int kl_ = kc_ + kl0_; P0[r] = ((unsigned)kl_ < 16u) ? P0[r] + b0_ : (-__builtin_inff()); P1[r] = ((unsigned)(kl_ + 32) < 16u) ? P1[r] + b1_ : (-__builtin_inff()); } \
          SBAR(); } } } } } while (0)
  bool resc = false;
  #define START(P0, P1) do { const float rm = rowmax(P0, P1); resc = false; \
    { const float dl = rm; mhat = fadd_s(mhat, dl); \
      _Pragma("unroll") for (int r = 0; r < 16; ++r) { P0[r] = fsub_s(P0[r], dl); P1[r] = fsub_s(P1[r], dl); } \
      if (!NA) { _Pragma("unroll") for (int r = 0; r < 16; ++r) negm[r] = -mhat; asm volatile("" : "+v"(negm)); } } \
    _Pragma("unroll") for (int r = 0; r < 16; ++r) P0[r] = __builtin_amdgcn_exp2f(P0[r]); } while (0)
  #define RESC() do { if (resc) { asm volatile("s_waitcnt lgkmcnt(0)" ::: "memory"); \
      _Pragma("unroll") for (int d_ = 0; d_ < 2; ++d_) _Pragma("unroll") for (int r = 0; r < 16; ++r) o[d_][r] *= wsf[crow(r, hi)]; } } while (0)
  f32x16 pA0, pA1, pB0, pB1;
  int sl_prev = 0, sl_cur = 0, sl_next = SLOTB;
  #define ROT() do { sl_prev = sl_cur; sl_cur = sl_next; sl_next = (sl_next == (NSLOT - 1) * SLOTB) ? 0 : sl_next + SLOTB; } while (0)
  DMA_K(2, 2 * SLOTB);
  WAIT_BAR(3);
  qkt(pA0, pA1, Kbase, qr, NEGM, r32, hi); asm volatile("s_nop 15\n\ts_nop 7" : "+v"(pA0), "+v"(pA1));
  START(pA0, pA1);
  _Pragma("unroll") for (int r = 0; r < 16; ++r) pA1[r] = __builtin_amdgcn_exp2f(pA1[r]);
  WAIT_BAR(0);
  DMA_K(3, 0); DMA_V(1, SLOTB);
  ROT();
  kload8(kf, kp0 + sl_cur);
  WAIT_BAR(2);
  s16x4 vlo[8], vhi[8]; u32x4 pw0, pw1, pw2, pw3;
  #define PKW(P, B) cvtpk_s(P[B], P[B + 1])
  #define PAF(k) __builtin_bit_cast(bf16x8, pw##k)
  #define VFR(i) (bf16x8){vlo[i][0], vlo[i][1], vlo[i][2], vlo[i][3], vhi[i][0], vhi[i][1], vhi[i][2], vhi[i][3]}
  #define PIN(x) asm volatile("" : "+v"(x))
  #define MX3(a, b, c) __builtin_fmaxf(__builtin_fmaxf((a), (b)), (c))
  #define GAPA(MF, A0, A1, A2, A3, W0, W1, PW) do { MF; sacc += A0; sacc += A1; sacc += A2; sacc += A3; PIN(sacc); W0; W1; PIN(PW); SBAR(); } while (0)
  #define EX(v) __builtin_amdgcn_exp2f(v)
  #define GAPB(MF, X, B) do { MF; X[B] = EX(X[B]); X[B + 1] = EX(X[B + 1]); X[B + 2] = EX(X[B + 2]); X[B + 3] = EX(X[B + 3]); PIN(X); SBAR(); } while (0)
  #define VRD(i) do { vlo[i] = vtr(vp_ + (((i) >> 2) * 4096 + ((i) & 3) * 1024)); vhi[i] = vtr(vp_ + (((i) >> 2) * 4096 + ((i) & 3) * 1024 + 512)); } while (0)
  #define KRD(G, j) do { if (G) { kload2(kf, kp0 + sl_next, j); SBAR(); } } while (0)
  #define STEP(C0, C1, P0, P1, t, GK, GV, GL) do { SBAR(); \
    const lds_cptr vp_ = vp0 + sl_prev; \
    VRD(0); SBAR(); float sacc = (P0[0] + P0[1]); \
    GAPA(C0 = __builtin_amdgcn_mfma_f32_32x32x16_bf16(kf[0], qr[0], NEGM, 0, 0, 0), P0[2], P0[3], P0[4], P0[5],     pw0[0] = PKW(P0, 0), pw0[1] = PKW(P0, 2), pw0); \
    VRD(4); SBAR(); GAPA(C1 = __builtin_amdgcn_mfma_f32_32x32x16_bf16(kf[1], qr[0], NEGM, 0, 0, 0), P0[6], P0[7], P0[8], P0[9],     pw0[2] = PKW(P0, 4), pw0[3] = PKW(P0, 6), pw0); \
    VRD(1); SBAR(); GAPA(C0 = __builtin_amdgcn_mfma_f32_32x32x16_bf16(kf[2], qr[1], C0, 0, 0, 0),   P0[10], P0[11], P0[12], P0[13], pw1[0] = PKW(P0, 8), pw1[1] = PKW(P0, 10), pw1); \
    VRD(5); SBAR(); GAPA(C1 = __builtin_amdgcn_mfma_f32_32x32x16_bf16(kf[3], qr[1], C1, 0, 0, 0),   P0[14], P0[15], P1[0], P1[1],   pw1[2] = PKW(P0, 12), pw1[3] = PKW(P0, 14), pw1); \
    VRD(2); SBAR(); GAPA(C0 = __builtin_amdgcn_mfma_f32_32x32x16_bf16(kf[4], qr[2], C0, 0, 0, 0),   P1[2], P1[3], P1[4], P1[5],     pw2[0] = PKW(P1, 0), pw2[1] = PKW(P1, 2), pw2); \
    VRD(6); SBAR(); GAPA(C1 = __builtin_amdgcn_mfma_f32_32x32x16_bf16(kf[5], qr[2], C1, 0, 0, 0),   P1[6], P1[7], P1[8], P1[9],     pw2[2] = PKW(P1, 4), pw2[3] = PKW(P1, 6), pw2); \
    VRD(3); SBAR(); GAPA(C0 = __builtin_amdgcn_mfma_f32_32x32x16_bf16(kf[6], qr[3], C0, 0, 0, 0),   P1[10], P1[11], P1[12], P1[13], pw3[0] = PKW(P1, 8), pw3[1] = PKW(P1, 10), pw3); \
    VRD(7); SBAR(); GAPA(C1 = __builtin_amdgcn_mfma_f32_32x32x16_bf16(kf[7], qr[3], C1, 0, 0, 0),   P1[14], P1[15], 0.f, 0.f,       pw3[2] = PKW(P1, 12), pw3[3] = PKW(P1, 14), pw3); \
    l_reg += sacc; \
    if (GK) { DMA_K((t) + 3, sl_cur); } if (GV) { DMA_V((t) + 1, sl_next); } \
    if (NA) { _Pragma("unroll") for (int r = 0; r < 16; ++r) { C0[r] -= mhat; C1[r] -= mhat; } } \
    CMASK(C0, C1, t); \
    { float a = MX3(C0[0], C0[1], C1[0]), b = MX3(C0[2], C0[3], C1[1]); a = MX3(a, C1[2], C1[3]); \
      _Pragma("unroll") for (int r = 4; r < 16; r += 4) { a = MX3(a, C0[r], C0[r + 1]); b = MX3(b, C0[r + 2], C0[r + 3]); a = MX3(a, C1[r], C1[r + 1]); b = MX3(b, C1[r + 2], C1[r + 3]); } \
      float rm = __builtin_fmaxf(a, b); { auto rr = __builtin_amdgcn_permlane32_swap(__float_as_uint(rm), __float_as_uint(rm), false, false); rm = __builtin_fmaxf(__uint_as_float(rr[0]), __uint_as_float(rr[1])); } \
      resc = false; \
      if (__builtin_expect(__any(rm > (float)THRL), 0)) { const float dl = __builtin_fmaxf(rm, 0.f); mhat += dl; \
        _Pragma("unroll") for (int r = 0; r < 16; ++r) { C0[r] -= dl; C1[r] -= dl; } \
        if (!NA) { _Pragma("unroll") for (int r = 0; r < 16; ++r) negm[r] = -mhat; asm volatile("" : "+v"(negm)); } \
        const float f = __builtin_amdgcn_exp2f(-dl); l_reg *= f; if (hi == 0) wsf[r32] = f; resc = true; } } \
    SBAR(); \
    GAPB(o[0] = __builtin_amdgcn_mfma_f32_32x32x16_bf16(PAF(0), VFR(0), o[0], 0, 0, 0), C0, 0); \
    GAPB(o[1] = __builtin_amdgcn_mfma_f32_32x32x16_bf16(PAF(0), VFR(4), o[1], 0, 0, 0), C0, 4); \
    KRD(GL, 0); GAPB(o[0] = __builtin_amdgcn_mfma_f32_32x32x16_bf16(PAF(1), VFR(1), o[0], 0, 0, 0), C0, 8); \
    KRD(GL, 1); GAPB(o[1] = __builtin_amdgcn_mfma_f32_32x32x16_bf16(PAF(1), VFR(5), o[1], 0, 0, 0), C0, 12); \
    KRD(GL, 2); GAPB(o[0] = __builtin_amdgcn_mfma_f32_32x32x16_bf16(PAF(2), VFR(2), o[0], 0, 0, 0), C1, 0); \
    KRD(GL, 3); GAPB(o[1] = __builtin_amdgcn_mfma_f32_32x32x16_bf16(PAF(2), VFR(6), o[1], 0, 0, 0), C1, 4); \
    GAPB(o[0] = __builtin_amdgcn_mfma_f32_32x32x16_bf16(PAF(3), VFR(3), o[0], 0, 0, 0), C1, 8); \
    GAPB(o[1] = __builtin_amdgcn_mfma_f32_32x32x16_bf16(PAF(3), VFR(7), o[1], 0, 0, 0), C1, 12); \
    } while (0)
  int t = 1;
  for (; t + 5 < NT; t += 2) {
    STEP(pB0, pB1, pA0, pA1, t, true, true, true);     WAIT_BAR(2); RESC(); ROT();
    STEP(pA0, pA1, pB0, pB1, t + 1, true, true, true); WAIT_BAR(2); RESC(); ROT();
  }
  #define ENDW(tt) do { if ((tt) + 3 < NT) { WAIT_BAR(2); } else if ((tt) + 2 < NT) { WAIT_BAR(1); } else { WAIT_BAR(0); } } while (0)
  for (; t + 1 < NT; t += 2) {
    STEP(pB0, pB1, pA0, pA1, t, (t + 3 < NT), (t + 1 < NT), (t + 1 < NT));         ENDW(t);     RESC(); ROT();
    STEP(pA0, pA1, pB0, pB1, t + 1, (t + 4 < NT), (t + 2 < NT), (t + 2 < NT));     ENDW(t + 1); RESC(); ROT();
  }
  STEP(pB0, pB1, pA0, pA1, NT - 1, false, false, false); RESC();
  { float sacc = pB0[0] + pB0[1]; _Pragma("unroll") for (int r = 2; r < 16; ++r) sacc += pB0[r]; _Pragma("unroll") for (int r = 0; r < 16; ++r) sacc += pB1[r]; l_reg += sacc;
    pw0 = (u32x4){PKW(pB0, 0), PKW(pB0, 2), PKW(pB0, 4), PKW(pB0, 6)}; pw1 = (u32x4){PKW(pB0, 8), PKW(pB0, 10), PKW(pB0, 12), PKW(pB0, 14)}; pw2 = (u32x4){PKW(pB1, 0), PKW(pB1, 2), PKW(pB1, 4), PKW(pB1, 6)}; pw3 = (u32x4){PKW(pB1, 8), PKW(pB1, 10), PKW(pB1, 12), PKW(pB1, 14)};
    SBAR(); pv(o, vb0 + sl_cur, PAF(0), PAF(1), PAF(2), PAF(3)); }
  #undef PKW
  #undef PAF
  #undef VFR
  #undef PIN
  #undef MX3
  #undef GAPA
  #undef GAPB
  #undef EX
  #undef VRD
  #undef KRD
  #undef STEP
  #undef ENDW
  { auto rr = __builtin_amdgcn_permlane32_swap(__float_as_uint(l_reg), __float_as_uint(l_reg), false, false); l_reg = __uint_as_float(rr[0]) + __uint_as_float(rr[1]); }
  if (hi == 0) wsf[32 + r32] = l_reg; asm volatile("s_waitcnt lgkmcnt(0)" ::: "memory");
  float rli[16];
  #pragma unroll
  for (int r = 0; r < 16; ++r) rli[r] = __builtin_amdgcn_rcpf(wsf[32 + crow(r, hi)]);
  bf16* Ow = Ou + (long)(wid * QBLK) * op;
  { bf16* stg = (bf16*)(shm + LDS_OST) + wid * 2048;
    #pragma unroll
    for (int r = 0; r < 16; ++r) { const int orow = crow(r, hi);
      #pragma unroll
      for (int d0 = 0; d0 < 2; ++d0) stg[orow * 64 + d0 * 32 + r32] = (bf16)f2bf(o[d0][r] * rli[r]); }
    asm volatile("s_waitcnt lgkmcnt(0)" ::: "memory");
    #pragma unroll
    for (int i = 0; i < 4; ++i) { const int row = i * 8 + (lane >> 3), ch = lane & 7; const u32x4 v = *(const u32x4*)(stg + row * 64 + ch * 8); ATTN_STORE16(Ow + (long)row * op + ch * 8, v); } }
  asm volatile("s_waitcnt lgkmcnt(0)\n\ts_barrier" ::: "memory");
  #undef NEGM
  #undef DMA_K
  #undef DMA_V
  #undef TROW
  #undef CMASK
  #undef START
  #undef RESC
  #undef ROT
}
#undef SBAR
#undef WAIT_BAR
}
#ifndef FP8_MOE
#define FP8_MOE 1
#endif
struct Args { const float* in[29]; float* out; unsigned char* ws; int ph_lo, ph_hi; };
enum { I_X = 0, I_C, I_CTX, I_CCTX, I_WMOD, I_BMOD, I_N1G, I_N2G, I_WIN, I_LRE, I_LIM, I_LDT, I_BRE, I_BIM, I_CRE, I_CIM, I_SSMD, I_WGLU, I_QNG, I_KNG, I_RPB, I_WBR, I_WOUT, I_RW, I_RB, I_MG, I_MU, I_MD, I_FNG };

typedef const float* CFP;
struct Ctx {
    const __attribute__((address_space(4))) CFP* in; float* out; unsigned char* ws; LAS unsigned char* lds; gu32* ctl;
    int tid, lane, wave, vcu, G;
};
#define WSP(T_, off) ((T_*)(C.ws + (off)))

__device__ __forceinline__ float* xs_row(const Ctx& C, int m) { const int b = m / LB, j = m - b * LB; return j < CTX ? WSP(float, WS_CTXS) + (size_t)(b * CTX + j) * D : C.out + (size_t)(b * SEQ + j - CTX) * D; }
__device__ __forceinline__ const float* in_row(const Ctx& C, int m) { const int b = m / LB, j = m - b * LB; return j < CTX ? C.in[I_CTX] + (size_t)(b * CTX + j) * D : C.in[I_X] + (size_t)(b * SEQ + j - CTX) * D; }
__device__ __forceinline__ int cond_of(int m) { const int b = m / LB, j = m - b * LB; return j < CTX ? 4 : b; }

__device__ __forceinline__ void transpose_item(const float* W, int N, int Kp, bf16* WT, int k0, int n0, int drow0, LAS float* scr, int lane) {
    const float* src = W + (size_t)k0 * N + n0 + lane;
    float tv[64];
#pragma unroll
    for (int i = 0; i < 64; ++i) tv[i] = src[(size_t)i * N];
#pragma unroll
    for (int i = 0; i < 64; ++i) scr[i * 65 + lane] = tv[i];
    LDS_WAIT(); asm volatile("" ::: "memory");
    const int c = lane & 7;
#pragma unroll
    for (int j = 0; j < 8; ++j) { const int n = (lane >> 3) + 8 * j; const LAS float* s = scr + (8 * c) * 65 + n;
        v4u o; o.x = pk2(s[0 * 65], s[1 * 65]); o.y = pk2(s[2 * 65], s[3 * 65]); o.z = pk2(s[4 * 65], s[5 * 65]); o.w = pk2(s[6 * 65], s[7 * 65]);
        *(GAS v4u*)(WT + (size_t)(drow0 + n) * Kp + k0 + 8 * c) = o; }
    LDS_WAIT(); asm volatile("" ::: "memory");
}
__device__ __forceinline__ void transpose_item8(const float* W, int N, int Kp, unsigned char* WT, int k0, int n0, int drow0, float scale, LAS float* scr, int lane) {
    const float* src = W + (size_t)k0 * N + n0 + lane;
    float tv[64];
#pragma unroll
    for (int i = 0; i < 64; ++i) tv[i] = src[(size_t)i * N];
#pragma unroll
    for (int i = 0; i < 64; ++i) scr[i * 65 + lane] = tv[i] * scale;
    LDS_WAIT(); asm volatile("" ::: "memory");
    const int c = lane & 3;
#pragma unroll
    for (int j = 0; j < 4; ++j) { const int n = (lane >> 2) + 16 * j; const LAS float* s = scr + (16 * c) * 65 + n;
        v4u o; o.x = pk4_fp8(s[0 * 65], s[1 * 65], s[2 * 65], s[3 * 65]); o.y = pk4_fp8(s[4 * 65], s[5 * 65], s[6 * 65], s[7 * 65]); o.z = pk4_fp8(s[8 * 65], s[9 * 65], s[10 * 65], s[11 * 65]); o.w = pk4_fp8(s[12 * 65], s[13 * 65], s[14 * 65], s[15 * 65]);
        *(GAS v4u*)(WT + (size_t)(drow0 + n) * Kp + k0 + 16 * c) = o; }
    LDS_WAIT(); asm volatile("" ::: "memory");
}
__device__ __forceinline__ void phase_weights(const Ctx& C, int l) {
    LAS float* scr = (LAS float*)(C.lds + C.wave * 16640);
    const int gw = C.vcu * NWAVES + C.wave, NGW = C.G * NWAVES;
    constexpr int I0 = 16 * 92, I1 = 8 * 8, I2 = 3 * 8 * 16, I3 = 16 * 16, I4 = 16 * 16 * 8, I5 = I4, I6 = 16 * 8 * 16;
    for (int it = gw; it < I0 + I1 + I2 + I3 + I4 + I5 + I6; it += NGW) {
        int r = it;
        if (r < I0) { const int kb = r / 92, nb = r % 92; if (nb < 44 || GATE_BF16) transpose_item(C.in[I_WIN] + (size_t)l * 1024 * INW, INW, 1024, WSP(bf16, WS_WIN), 64 * kb, 64 * nb, 64 * nb, scr, C.lane);
            else transpose_item8(C.in[I_WIN] + (size_t)l * 1024 * INW, INW, 1024, WSP(unsigned char, WS_WIN8), 64 * kb, 64 * nb, 64 * nb - 2816, 64.f, scr, C.lane); continue; } r -= I0;
        if (r < I1) { const int kb = r / 8, nb = r % 8; transpose_item(C.in[I_WGLU] + (size_t)l * 512 * 512, 512, 512, WSP(bf16, WS_WGLU), 64 * kb, 64 * nb, 64 * nb, scr, C.lane); continue; } r -= I1;
        if (r < I2) { const int i = r / 128, q = r % 128, kb = q / 16, nb = q % 16; transpose_item(C.in[I_WBR] + (size_t)(l * 3 + i) * 512 * 1024, 1024, 512, WSP(bf16, WS_WBR) + (size_t)i * 1024 * 512, 64 * kb, 64 * nb, 64 * nb, scr, C.lane); continue; } r -= I2;
        if (r < I3) { const int kb = r / 16, nb = r % 16; transpose_item(C.in[I_WOUT] + (size_t)l * 1024 * 1024, 1024, 1024, WSP(bf16, WS_WOUT), 64 * kb, 64 * nb, 64 * nb, scr, C.lane); continue; } r -= I3;
        if (r < I4 + I5) { const int up = r >= I4; if (up) r -= I4; const int e = r / 128, q = r % 128, kb = q / 8, nb = q % 8, n0 = 64 * nb;
            if (FP8_MOE) transpose_item8((up ? C.in[I_MU] : C.in[I_MG]) + (size_t)(l * 16 + e) * 1024 * 512, 512, 1024, WSP(unsigned char, WS_MOE1) + (size_t)e * 1024 * 1024, 64 * kb, n0, (n0 / 128) * 256 + (n0 % 128) + (up ? 128 : 0), 64.f, scr, C.lane);
            else transpose_item((up ? C.in[I_MU] : C.in[I_MG]) + (size_t)(l * 16 + e) * 1024 * 512, 512, 1024, WSP(bf16, WS_MOE1) + (size_t)e * 1024 * 1024, 64 * kb, n0, (n0 / 128) * 256 + (n0 % 128) + (up ? 128 : 0), scr, C.lane); continue; } r -= I4 + I5;
        { const int e = r / 128, q = r % 128, kb = q / 16, nb = q % 16; if (FP8_MOE) transpose_item8(C.in[I_MD] + (size_t)(l * 16 + e) * 512 * 1024, 1024, 512, WSP(unsigned char, WS_MOE2) + (size_t)e * 1024 * 512, 64 * kb, 64 * nb, 64 * nb, 32.f, scr, C.lane);
            else transpose_item(C.in[I_MD] + (size_t)(l * 16 + e) * 512 * 1024, 1024, 512, WSP(bf16, WS_MOE2) + (size_t)e * 1024 * 512, 64 * kb, 64 * nb, 64 * nb, scr, C.lane); }
    }
}

__device__ __forceinline__ void phase_mod(const Ctx& C) {
    LAS float* sc = (LAS float*)(C.lds);
    LAS float* red = (LAS float*)(C.lds + 20480);
    for (int i = C.tid; i < 5 * 1024; i += 512) { const int c = i >> 10, k = i & 1023; const float v = c < 4 ? C.in[I_C][c * 1024 + k] : C.in[I_CCTX][k]; sc[i] = v * fsigmoid(v); }
    __syncthreads();
    for (int it = C.vcu; it < NLAYER * 96; it += C.G) {
        const int l = it / 96, col = (it % 96) * 64 + C.lane, k0 = C.wave * 128;
        const float* W = C.in[I_WMOD] + (size_t)l * 1024 * 6144 + (size_t)k0 * 6144 + col;
        float a0 = 0.f, a1 = 0.f, a2 = 0.f, a3 = 0.f, a4 = 0.f;
#pragma unroll 16
        for (int k = 0; k < 128; ++k) { const float w = W[(size_t)k * 6144]; a0 += sc[k0 + k] * w; a1 += sc[1024 + k0 + k] * w; a2 += sc[2048 + k0 + k] * w; a3 += sc[3072 + k0 + k] * w; a4 += sc[4096 + k0 + k] * w; }
        LAS float* r = red + C.wave * 320 + C.lane; r[0] = a0; r[64] = a1; r[128] = a2; r[192] = a3; r[256] = a4;
        __syncthreads();
        if (C.tid < 320) { const int c = C.tid >> 6; float s = C.in[I_BMOD][l * 6144 + col];
#pragma unroll
            for (int w = 0; w < 8; ++w) s += red[w * 320 + C.tid];
            WSP(float, WS_MOD)[(size_t)(l * 5 + c) * 6144 + col] = s; }
        __syncthreads();
    }
}

__device__ __forceinline__ void phase_s5mats(const Ctx& C, int l) {
    if (C.vcu >= 128) return;
    const int g = C.vcu >> 2, part = C.vcu & 3, tid = C.tid;
    LAS f32x2* POW = (LAS f32x2*)(C.lds);
    LAS f32x2* CC = (LAS f32x2*)(C.lds + 33792);
    LAS f32x2* BB = (LAS f32x2*)(C.lds + 50176);
    LAS f32x2* COEF = (LAS f32x2*)(C.lds + 66560);
    LAS bf16* KT = (LAS bf16*)(C.lds + 67584);
    LAS float* K0 = (LAS float*)(C.lds + 99840);
    __syncthreads();
    if (tid < 128) {
        const int d = tid >> 6, p = tid & 63; const int li = ((l * 2 + d) * 32 + g) * 64 + p;
        const float re = C.in[I_LRE][li], im = C.in[I_LIM][li], dt = __expf(C.in[I_LDT][(l * 2 + d) * 32 + g]);
        for (int tau = 0; tau <= 32; ++tau) { const float mag = __expf(re * dt * (float)tau), rev = im * dt * (float)tau * 0.15915494309189535f;
            POW[(d * 33 + tau) * 64 + p] = (f32x2){mag * cos_rev(rev), mag * sin_rev(rev)}; }
        const float mag = __expf(re * dt), rev = im * dt * 0.15915494309189535f; const float lr = mag * cos_rev(rev) - 1.f, lim = mag * sin_rev(rev);
        const float den = 1.f / (re * re + im * im);
        COEF[tid] = (f32x2){(lr * re + lim * im) * den, (lim * re - lr * im) * den};
    }
    __syncthreads();
    for (int i = tid; i < 2048; i += 512) {
        const int d = i >> 10, p = (i >> 4) & 63, h = i & 15; const size_t bi = (((size_t)(l * 2 + d) * 32 + g) * 64 + p) * 16 + h;
        const float br = C.in[I_BRE][bi], bi_ = C.in[I_BIM][bi]; const f32x2 cf = COEF[d * 64 + p];
        BB[i] = (f32x2){cf.x * br - cf.y * bi_, cf.x * bi_ + cf.y * br};
        const int h2 = (i >> 6) & 15, p2 = i & 63; const size_t ci = (((size_t)(l * 2 + d) * 32 + g) * 16 + h2) * 64 + p2;
        CC[i] = (f32x2){C.in[I_CRE][ci], C.in[I_CIM][ci]};
    }
    __syncthreads();
    {
        const int d = tid >> 8, h = (tid >> 4) & 15, hp = tid & 15; float acc[32];
#pragma unroll
        for (int t = 0; t < 32; ++t) acc[t] = 0.f;
        for (int p = 0; p < 64; ++p) { const f32x2 c = CC[d * 1024 + h * 64 + p], b = BB[d * 1024 + p * 16 + hp], lam = POW[(d * 33 + 1) * 64 + p];
            float xr = c.x * b.x - c.y * b.y, xi = c.x * b.y + c.y * b.x;
#pragma unroll
            for (int t = 0; t < 32; ++t) { acc[t] += xr; const float nr = xr * lam.x - xi * lam.y, ni = xr * lam.y + xi * lam.x; xr = nr; xi = ni; } }
        if (d == 1) K0[tid & 255] = acc[0];
        __syncthreads();
        if (d == 0) { acc[0] += K0[tid] + (h == hp ? C.in[I_SSMD][l * 512 + g * 16 + h] : 0.f);
#pragma unroll
            for (int t = 0; t < 32; ++t) KT[((31 + t) * 16 + h) * 16 + hp] = (bf16)f2bf(acc[t]); }
        else {
#pragma unroll
            for (int t = 1; t < 32; ++t) KT[((31 - t) * 16 + h) * 16 + hp] = (bf16)f2bf(acc[t]); }
    }
    __syncthreads();
    bf16* B1 = WSP(bf16, WS_BT1) + (size_t)g * 768 * 512; bf16* B2 = WSP(bf16, WS_BT2) + (size_t)g * 512 * 256;
    for (int i = tid; i < 128 * 64; i += 512) {
        const int n = part * 128 + (i >> 6), ch = i & 63, t = n >> 4, h = n & 15, s = ch >> 1, hp0 = (ch & 1) * 8;
        *(GAS v4u*)(B1 + (size_t)n * 512 + ch * 8) = *(const LAS v4u*)(KT + ((t - s + 31) * 16 + h) * 16 + hp0);
    }
    for (int i = tid; i < 64 * 64; i += 512) {
        const int nn = part * 64 + (i >> 6), ch = i & 63, d = nn >> 7, p = (nn & 127) >> 1, ri = nn & 1, s = ch >> 1, hp0 = (ch & 1) * 8;
        const f32x2 w = POW[(d * 33 + (d == 0 ? 31 - s : s)) * 64 + p]; float v[8];
#pragma unroll
        for (int j = 0; j < 8; ++j) { const f32x2 b = BB[d * 1024 + p * 16 + hp0 + j]; v[j] = ri == 0 ? (w.x * b.x - w.y * b.y) : (w.x * b.y + w.y * b.x); }
        v4u o; o.x = pk2(v[0], v[1]); o.y = pk2(v[2], v[3]); o.z = pk2(v[4], v[5]); o.w = pk2(v[6], v[7]);
        *(GAS v4u*)(B1 + (size_t)(512 + nn) * 512 + ch * 8) = o;
    }
    for (int i = tid; i < 128 * 32; i += 512) {
        const int n = part * 128 + (i >> 5), ch = i & 31, t = n >> 4, h = n & 15, d = ch >> 4, p0 = (ch & 15) * 4; float v[8];
#pragma unroll
        for (int j = 0; j < 4; ++j) { const f32x2 c = CC[d * 1024 + h * 64 + p0 + j], w = POW[(d * 33 + (d == 0 ? t + 1 : 32 - t)) * 64 + p0 + j];
            v[2 * j] = c.x * w.x - c.y * w.y; v[2 * j + 1] = -(c.x * w.y + c.y * w.x); }
        v4u o; o.x = pk2(v[0], v[1]); o.y = pk2(v[2], v[3]); o.z = pk2(v[4], v[5]); o.w = pk2(v[6], v[7]);
        *(GAS v4u*)(B2 + (size_t)n * 256 + ch * 8) = o;
    }
    __syncthreads();
}

template <int MODE>
__device__ __forceinline__ void phase_rows(const Ctx& C, int l) {
    const int gw = C.vcu * NWAVES + C.wave, NGW = C.G * NWAVES, lane = C.lane;
    const float* MODl = WSP(float, WS_MOD) + (size_t)(MODE == 2 ? 0 : l) * 5 * 6144;
    const float* MODp = WSP(float, WS_MOD) + (size_t)(l > 0 ? l - 1 : 0) * 5 * 6144;
    const bf16* YS = WSP(bf16, WS_YSLOT);
    for (int m = gw; m < T; m += NGW) {
        const int b = m / LB, j = m - b * LB, cond = j < CTX ? 4 : b;
        if (MODE == 2 && j < CTX) continue;
        f32x4 v[4];
        if (MODE == 0) { const GAS f32x4* xr = (const GAS f32x4*)in_row(C, m) + lane;
#pragma unroll
            for (int q = 0; q < 4; ++q) v[q] = xr[64 * q]; }
        else { const GAS f32x4* xr = (const GAS f32x4*)xs_row(C, m) + lane; const GAS v2u* y0 = (const GAS v2u*)(YS + (size_t)(2 * m) * D) + lane; const GAS v2u* y1 = (const GAS v2u*)(YS + (size_t)(2 * m + 1) * D) + lane;
            const GAS f32x4* g2 = (const GAS f32x4*)(MODp + cond * 6144 + 5 * 1024) + lane;
#pragma unroll
            for (int q = 0; q < 4; ++q) { const f32x4 x = xr[64 * q], g = g2[64 * q]; const v2u a = y0[64 * q], c = y1[64 * q];
                v[q] = x + g * (f32x4){bflo(a.x) + bflo(c.x), bfhi(a.x) + bfhi(c.x), bflo(a.y) + bflo(c.y), bfhi(a.y) + bfhi(c.y)}; } }
        float ss = 0.f;
#pragma unroll
        for (int q = 0; q < 4; ++q) ss += (v[q].x * v[q].x + v[q].y * v[q].y) + (v[q].z * v[q].z + v[q].w * v[q].w);
        const float rstd = 1.f / sqrtf(wave_sum(ss, lane) * (1.f / D) + EPS);
        if (MODE == 2) { GAS f32x4* o = (GAS f32x4*)(C.out + (size_t)(b * SEQ + j - CTX) * D) + lane; const GAS f32x4* fg = (const GAS f32x4*)C.in[I_FNG] + lane;
#pragma unroll
            for (int q = 0; q < 4; ++q) o[64 * q] = v[q] * rstd * fg[64 * q]; }
        else { GAS f32x4* xo = (GAS f32x4*)xs_row(C, m) + lane; GAS v2u* ho = (GAS v2u*)(WSP(bf16, WS_HB) + (size_t)m * D) + lane; GAS unsigned* h8 = (GAS unsigned*)(WSP(unsigned char, WS_HB8) + (size_t)m * D) + lane;
            const GAS f32x4* ng = (const GAS f32x4*)(C.in[I_N1G] + l * D) + lane; const GAS f32x4* sh = (const GAS f32x4*)(MODl + cond * 6144) + lane; const GAS f32x4* sc = (const GAS f32x4*)(MODl + cond * 6144 + 1024) + lane;
#pragma unroll
            for (int q = 0; q < 4; ++q) { xo[64 * q] = v[q]; const f32x4 h = v[q] * rstd * ng[64 * q] * (sc[64 * q] + 1.f) + sh[64 * q]; ho[64 * q] = (v2u){pk2(h.x, h.y), pk2(h.z, h.w)}; if (H8_WRITE) h8[64 * q] = pk4_fp8(h.x, h.y, h.z, h.w); } }
    }
}

__device__ __forceinline__ void phase_qkprep(const Ctx& C, int l) {
    const int gw = C.vcu * NWAVES + C.wave, NGW = C.G * NWAVES, lane = C.lane, s8 = lane & 7;
    const float* qg = C.in[I_QNG] + l * 64 + 8 * s8; const float* kg = C.in[I_KNG] + l * 64 + 8 * s8;
    float gq[8], gk[8];
#pragma unroll
    for (int i = 0; i < 8; ++i) { gq[i] = qg[i]; gk[i] = kg[i]; }
    const int ax = s8 >> 2, f0 = 8 * (s8 & 1);
    float inv[8];
#pragma unroll
    for (int i = 0; i < 8; ++i) inv[i] = exp2f(-(float)(f0 + i) * 0.8304820237218406f) * 0.15915494309189535f;
    for (int m = gw; m < T; m += NGW) {
        const int b = m / LB, j = m - b * LB; const bool lat = j >= CTX; const int tt = j - CTX; const float pos = (float)(ax == 0 ? (tt >> 6) : (tt & 63));
#pragma unroll
        for (int which = 0; which < 2; ++which) {
            if (which == 1 && lane >= 16) break;
            GAS v4u* p = which == 0 ? (GAS v4u*)(WSP(bf16, WS_QA) + (size_t)m * 512) + lane : (GAS v4u*)(WSP(bf16, WS_KA) + (size_t)m * 128) + lane;
            const v4u w = *p; float x[8] = {bflo(w.x), bfhi(w.x), bflo(w.y), bfhi(w.y), bflo(w.z), bfhi(w.z), bflo(w.w), bfhi(w.w)};
            float ss = 0.f;
#pragma unroll
            for (int i = 0; i < 8; ++i) ss += x[i] * x[i];
            ss += shflx(ss, 1, lane); ss += shflx(ss, 2, lane); ss += shflx(ss, 4, lane);
            const float rstd = 1.f / sqrtf(ss * (1.f / 64.f) + EPS);
#pragma unroll
            for (int i = 0; i < 8; ++i) x[i] = x[i] * rstd * (which == 0 ? gq[i] : gk[i]);
            float y[8];
#pragma unroll
            for (int i = 0; i < 8; ++i) { const float other = shflx(x[i], 2, lane);
                if (lat) { const float cs = cos_rev(pos * inv[i]), sn = sin_rev(pos * inv[i]); y[i] = (s8 & 2) ? (x[i] * cs + other * sn) : (x[i] * cs - other * sn); } else y[i] = x[i]; }
            const float sc = which == 0 ? C2 : 1.f;
            v4u o; o.x = pk2(y[0] * sc, y[1] * sc); o.y = pk2(y[2] * sc, y[3] * sc); o.z = pk2(y[4] * sc, y[5] * sc); o.w = pk2(y[6] * sc, y[7] * sc);
            *p = o;
        }
    }
}

__device__ __forceinline__ void phase_carry(const Ctx& C, int l) {
    if (C.vcu >= 32) return;
    const int b = C.vcu >> 3, g = (C.vcu & 7) * 4 + (C.wave >> 1), d = C.wave & 1, p = C.lane;
    const int li = ((l * 2 + d) * 32 + g) * 64 + p;
    const float re = C.in[I_LRE][li], im = C.in[I_LIM][li], dt = __expf(C.in[I_LDT][(l * 2 + d) * 32 + g]);
    const float mag = __expf(re * dt * 32.f), rev = im * dt * 32.f * 0.15915494309189535f; const float Lr = mag * cos_rev(rev), Li = mag * sin_rev(rev);
    const GAS f32x2* S = (const GAS f32x2*)(WSP(float, WS_SST) + (size_t)(b * NCH) * 8192 + g * 256 + d * 128) + p;
    GAS unsigned* X = (GAS unsigned*)(WSP(bf16, WS_XST) + (size_t)(b * NCH) * 8192 + g * 256 + d * 128) + p;
    float sr = 0.f, si = 0.f;
    if (d == 0) {
        for (int c0 = 0; c0 < NCH; c0 += 8) { f32x2 s[8];
#pragma unroll
            for (int k = 0; k < 8; ++k) s[k] = S[(size_t)(c0 + k) * 4096];
#pragma unroll
            for (int k = 0; k < 8; ++k) { X[(size_t)(c0 + k) * 4096] = pk2(sr, si); const float nr = Lr * sr - Li * si + s[k].x, ni = Lr * si + Li * sr + s[k].y; sr = nr; si = ni; } }
    } else {
        for (int seg = 0; seg < 33; ++seg) { const int chi = seg == 0 ? 7 : NCH - 1 - (seg - 1) * 8; f32x2 s[8];
#pragma unroll
            for (int k = 0; k < 8; ++k) s[k] = S[(size_t)(chi - k) * 4096];
#pragma unroll
            for (int k = 0; k < 8; ++k) { X[(size_t)(chi - k) * 4096] = pk2(sr, si); const float nr = Lr * sr - Li * si + s[k].x, ni = Lr * si + Li * sr + s[k].y; sr = nr; si = ni; } }
    }
}

__device__ __forceinline__ void phase_norm2(const Ctx& C, int l) {
    LAS float* RWt = (LAS float*)C.lds;
    LAS unsigned* REC = (LAS unsigned*)(C.lds + 65536);
    LAS unsigned* LCNT = (LAS unsigned*)(C.lds + 65536 + 32768);
    const int lane = C.lane, tid = C.tid;
    for (int i = tid; i < 16384; i += 512) { const int k = i >> 4, e = i & 15; RWt[e * 1024 + k] = C.in[I_RW][i]; }
    if (tid < 32) LCNT[tid] = 0u;
    __syncthreads();
    const float* MODl = WSP(float, WS_MOD) + (size_t)l * 5 * 6144;
    float rb[16];
#pragma unroll
    for (int e = 0; e < 16; ++e) rb[e] = C.in[I_RB][e];
    int nrows = 0; for (int m = C.vcu; m < T; m += C.G) ++nrows;
    for (int i = C.wave; i < nrows; i += NWAVES) {
        const int m = C.vcu + C.G * i, cond = cond_of(m);
        const GAS f32x4* xr = (const GAS f32x4*)xs_row(C, m) + lane; GAS unsigned* h8 = (GAS unsigned*)(WSP(unsigned char, WS_HB8) + (size_t)m * D) + lane; GAS v2u* ho = (GAS v2u*)(WSP(bf16, WS_HB) + (size_t)m * D) + lane;
        const GAS f32x4* ng = (const GAS f32x4*)(C.in[I_N2G] + l * D) + lane; const GAS f32x4* sh = (const GAS f32x4*)(MODl + cond * 6144 + 3072) + lane; const GAS f32x4* sc = (const GAS f32x4*)(MODl + cond * 6144 + 4096) + lane;
        f32x4 v[4]; float ss = 0.f;
#pragma unroll
        for (int q = 0; q < 4; ++q) { v[q] = xr[64 * q]; ss += (v[q].x * v[q].x + v[q].y * v[q].y) + (v[q].z * v[q].z + v[q].w * v[q].w); }
        const float rstd = 1.f / sqrtf(wave_sum(ss, lane) * (1.f / D) + EPS);
        float lg[16];
#pragma unroll
        for (int e = 0; e < 16; ++e) lg[e] = 0.f;
#pragma unroll
        for (int q = 0; q < 4; ++q) { const f32x4 h = v[q] * rstd * ng[64 * q] * (sc[64 * q] + 1.f) + sh[64 * q]; if (FP8_MOE) h8[64 * q] = pk4_fp8(h.x, h.y, h.z, h.w); else ho[64 * q] = (v2u){pk2(h.x, h.y), pk2(h.z, h.w)};
#pragma unroll
            for (int e = 0; e < 16; ++e) { const f32x4 w = *(const LAS f32x4*)(RWt + e * 1024 + 256 * q + 4 * lane); lg[e] += (h.x * w.x + h.y * w.y) + (h.z * w.z + h.w * w.w); } }
        { float w8[8], w4[4], w2[2], w1;
          const bool b5 = lane & 32, b4 = lane & 16, b3 = lane & 8, b2 = lane & 4;
#pragma unroll
          for (int j = 0; j < 8; ++j) { const float mine = b5 ? lg[j + 8] : lg[j], oth = b5 ? lg[j] : lg[j + 8]; w8[j] = mine + shflx(oth, 32, lane); }
#pragma unroll
          for (int j = 0; j < 4; ++j) { const float mine = b4 ? w8[j + 4] : w8[j], oth = b4 ? w8[j] : w8[j + 4]; w4[j] = mine + shflx(oth, 16, lane); }
#pragma unroll
          for (int j = 0; j < 2; ++j) { const float mine = b3 ? w4[j + 2] : w4[j], oth = b3 ? w4[j] : w4[j + 2]; w2[j] = mine + shflx(oth, 8, lane); }
          { const float mine = b2 ? w2[1] : w2[0], oth = b2 ? w2[0] : w2[1]; w1 = mine + shflx(oth, 4, lane); }
          w1 += shflx(w1, 1, lane); w1 += shflx(w1, 2, lane);
#pragma unroll
          for (int e = 0; e < 16; ++e) lg[e] = __builtin_bit_cast(float, __builtin_amdgcn_readlane(__builtin_bit_cast(int, w1), 4 * e)); }
        float mx = lg[0];
#pragma unroll
        for (int e = 1; e < 16; ++e) mx = fmaxf(mx, lg[e]);
        float pr[16], sel[16], sum = 0.f;
#pragma unroll
        for (int e = 0; e < 16; ++e) { pr[e] = __expf(lg[e] - mx); sum += pr[e]; }
        const float rs = 1.f / sum;
#pragma unroll
        for (int e = 0; e < 16; ++e) { pr[e] *= rs; sel[e] = pr[e] + rb[e]; }
        float bestv = -1e30f; int best = 0;
#pragma unroll
        for (int gq = 0; gq < 4; ++gq) { float m1 = -1e30f, m2 = -1e30f;
#pragma unroll
            for (int k = 0; k < 4; ++k) { const float s = sel[4 * gq + k]; if (s > m1) { m2 = m1; m1 = s; } else if (s > m2) m2 = s; }
            const float gs = m1 + m2; if (gs > bestv) { bestv = gs; best = gq; } }
        float s4[4], p4[4];
#pragma unroll
        for (int k = 0; k < 4; ++k) { s4[k] = best == 0 ? sel[k] : best == 1 ? sel[4 + k] : best == 2 ? sel[8 + k] : sel[12 + k]; p4[k] = best == 0 ? pr[k] : best == 1 ? pr[4 + k] : best == 2 ? pr[8 + k] : pr[12 + k]; }
        int i0 = 0; float v0 = s4[0], q0 = p4[0];
#pragma unroll
        for (int k = 1; k < 4; ++k) if (s4[k] > v0) { v0 = s4[k]; i0 = k; q0 = p4[k]; }
        int i1 = -1; float v1 = -1e30f, q1 = 0.f;
#pragma unroll
        for (int k = 0; k < 4; ++k) if (k != i0 && s4[k] > v1) { v1 = s4[k]; i1 = k; q1 = p4[k]; }
        const int e0 = 4 * best + i0, e1 = 4 * best + i1; const float wn = 1.f / (q0 + q1);
        if (lane == 0) { const unsigned lp0 = atomicAdd((unsigned*)(LCNT + e0), 1u), lp1 = atomicAdd((unsigned*)(LCNT + e1), 1u);
            REC[i * 4 + 0] = (unsigned)e0 | ((unsigned)e1 << 8) | (lp0 << 16); REC[i * 4 + 1] = lp1; REC[i * 4 + 2] = __float_as_uint(q0 * wn); REC[i * 4 + 3] = __float_as_uint(q1 * wn); }
    }
    __syncthreads();
    if (tid < 16) LCNT[16 + tid] = __hip_atomic_fetch_add((unsigned*)(C.ctl + CW_CNT + l * 1024 + 64 * tid), LCNT[tid], RLX_AGENT);
    __syncthreads();
    int* LIST = WSP(int, WS_LIST); float* RWG = WSP(float, WS_RW);
    for (int i = tid; i < nrows; i += 512) { const int m = C.vcu + C.G * i; const unsigned r0 = REC[i * 4], r1 = REC[i * 4 + 1];
        const int e0 = r0 & 255, e1 = (r0 >> 8) & 255; const unsigned lp0 = r0 >> 16, lp1 = r1;
        LIST[(size_t)e0 * T + LCNT[16 + e0] + lp0] = 2 * m; LIST[(size_t)e1 * T + LCNT[16 + e1] + lp1] = 2 * m + 1;
        RWG[2 * m] = __uint_as_float(REC[i * 4 + 2]); RWG[2 * m + 1] = __uint_as_float(REC[i * 4 + 3]); }
    __syncthreads();
}
using pg8::Unit;
typedef f32x4 Acc[2][2][4][2];
__device__ __forceinline__ v4u pack8(const f32x4& a, const f32x4& b) { v4u w; w.x = cvt_pk_bf16(a[0], a[1]); w.y = cvt_pk_bf16(a[2], a[3]); w.z = cvt_pk_bf16(b[0], b[1]); w.w = cvt_pk_bf16(b[2], b[3]); return w; }
__device__ __forceinline__ void unpack8(const v4u& w, f32x4& a, f32x4& b) { a = (f32x4){bflo(w.x), bfhi(w.x), bflo(w.y), bfhi(w.y)}; b = (f32x4){bflo(w.z), bfhi(w.z), bflo(w.w), bfhi(w.w)}; }
#ifndef WT_MODE
#define WT_MODE 0
#endif
__device__ __forceinline__ void st16(void* p, const v4u& v) {
#if WT_MODE == 1
    asm volatile("global_store_dwordx4 %0, %1, off sc0 sc1" :: "v"(p), "v"(v) : "memory");
#elif WT_MODE == 2
    asm volatile("global_store_dwordx4 %0, %1, off nt" :: "v"(p), "v"(v) : "memory");
#else
    *(GAS v4u*)p = v;
#endif
}
__device__ __forceinline__ int chunk_m0(int cr) { return (cr / NCH) * LB + (cr % NCH) * 32; }

struct PWin {
    static constexpr bool EARLY_AOFF = false, FP8 = false; unsigned char* ws; int G, c; int K; unsigned kstepA;
    __device__ __forceinline__ bool next(int i, Unit& u) const { const long L = (long)i * G + c; if (L >= NPAN * 11) return false; pg8::static_decode((int)L, NPAN, 11, u.pm, u.pn); u.z = 0; return true; }
    __device__ __forceinline__ const char* a_base(const Unit& u) const { return (const char*)(ws + WS_HB) + (size_t)u.pm * 256 * 1024 * 2; }
    __device__ __forceinline__ unsigned a_off(const Unit&, int h, int R, int Cc) const { return (unsigned)((h * 128 + R) * 1024 + Cc) * 2u; }
    __device__ __forceinline__ const char* b_base(const Unit& u) const { return (const char*)(ws + WS_WIN) + (size_t)u.pn * 256 * 1024 * 2; }
    __device__ __forceinline__ void epi(const Acc& acc, const Unit& u, int wr, int wc, int fr, int fq) const {
        const int row0 = u.pm * 256 + wr * 64 + fr;
#pragma unroll
        for (int bj = 0; bj < 2; ++bj) {
            const int cb = u.pn * 256 + bj * 128; bf16* dst; int ld, col, mode = 0; float sc = 1.f;
            if (cb < 512) { dst = (bf16*)(ws + WS_U) + ((size_t)((cb + wc * 32 + 8 * fq) >> 4) * T) * 16 + ((8 * fq) & 15) - (wc * 32 + 8 * fq); ld = 16; col = 0; }
            else if (cb < 1024) { dst = (bf16*)(ws + WS_QA); ld = 512; col = cb - 512; }
            else if (cb == 1024) { dst = (bf16*)(ws + WS_KA); ld = 128; col = 0; }
            else if (cb == 1152) { dst = (bf16*)(ws + WS_VA); ld = 128; col = 0; }
            else if (cb < 1792) { dst = (bf16*)(ws + WS_QN); ld = 512; col = cb - 1280; sc = C2; }
            else if (cb < 2304) { dst = (bf16*)(ws + WS_KN); ld = 512; col = cb - 1792; }
            else { dst = (bf16*)(ws + WS_VN); ld = 512; col = cb - 2304; }
            const int c0 = col + wc * 32 + 8 * fq;
#pragma unroll
            for (int ai = 0; ai < 2; ++ai)
#pragma unroll
                for (int m = 0; m < 4; ++m) { f32x4 v0 = acc[ai][bj][m][0], v1 = acc[ai][bj][m][1];
                    if (mode) { v0 = (f32x4){fsigmoid(v0[0]), fsigmoid(v0[1]), fsigmoid(v0[2]), fsigmoid(v0[3])}; v1 = (f32x4){fsigmoid(v1[0]), fsigmoid(v1[1]), fsigmoid(v1[2]), fsigmoid(v1[3])}; }
                    else { v0 = v0 * sc; v1 = v1 * sc; }
                    st16(dst + (size_t)(row0 + ai * 128 + m * 16) * ld + c0, pack8(v0, v1)); __builtin_amdgcn_sched_barrier(0); }
        }
    }
};

struct PGate {
    static constexpr bool EARLY_AOFF = false, FP8 = !GATE_BF16; unsigned char* ws; int G, c; int K; unsigned kstepA;
    __device__ __forceinline__ bool next(int i, Unit& u) const { const long L = (long)i * G + c; if (L >= 2 * NPAN * 12) return false; pg8::static_decode((int)L, 2 * NPAN, 12, u.pm, u.pn); u.z = 0; return true; }
    __device__ __forceinline__ const char* a_base(const Unit& u) const { return GATE_BF16 ? (const char*)(ws + WS_HB) + (size_t)u.pm * 128 * 2048 : (const char*)(ws + WS_HB8) + (size_t)u.pm * 128 * 1024; }
    __device__ __forceinline__ unsigned a_off(const Unit&, int R, int Cc) const { return GATE_BF16 ? (unsigned)(R * 2048 + Cc * 2) : (unsigned)(R * 1024 + Cc * 2); }
    __device__ __forceinline__ const char* b_base(const Unit& u) const { return GATE_BF16 ? (const char*)(ws + WS_WIN) + (size_t)(2816 + u.pn * 256) * 2048 : (const char*)(ws + WS_WIN8) + (size_t)u.pn * 256 * 1024; }
    __device__ __forceinline__ void epi(const f32x4 (&acc)[2][4][2], f32x4 (&)[2][4][2], const Unit& u, int wr, int wc, int fr, int fq) const {
#pragma unroll
        for (int m = 0; m < 4; ++m) { const size_t r = (size_t)(u.pm * 128 + wr * 64 + m * 16 + fr);
#pragma unroll
            for (int bj = 0; bj < 2; ++bj) { const int c0 = u.pn * 256 + bj * 128 + wc * 32 + 8 * fq; f32x4 v0 = acc[bj][m][0] * (GATE_BF16 ? 1.f : 1.f / 64.f), v1 = acc[bj][m][1] * (GATE_BF16 ? 1.f : 1.f / 64.f);
                v0 = (f32x4){fsigmoid(v0[0]), fsigmoid(v0[1]), fsigmoid(v0[2]), fsigmoid(v0[3])}; v1 = (f32x4){fsigmoid(v1[0]), fsigmoid(v1[1]), fsigmoid(v1[2]), fsigmoid(v1[3])};
                if (GATE_BF16) *(GAS v4u*)((bf16*)(ws + WS_GATES) + r * 3072 + c0) = pack8(v0, v1);
                else *(GAS v2u*)((unsigned char*)(ws + WS_GATES) + r * 3072 + c0) = (v2u){pk4_fp8(v0[0], v0[1], v0[2], v0[3]), pk4_fp8(v1[0], v1[1], v1[2], v1[3])}; }
            __builtin_amdgcn_sched_barrier(0); }
    }
};

struct PS5A {
    static constexpr bool EARLY_AOFF = false, FP8 = false; unsigned char* ws; int G, c; int K; unsigned kstepA;
    __device__ __forceinline__ bool next(int i, Unit& u) const { const long L = (long)i * G + c; if (L >= 32 * 15) return false; const int l = (int)L; u.z = l / 15; const int r = l % 15; u.pm = r / 3; u.pn = r % 3; return true; }
    __device__ __forceinline__ const char* a_base(const Unit& u) const { return (const char*)(ws + WS_U) + (size_t)u.z * T * 32; }
    __device__ __forceinline__ unsigned a_off(const Unit& u, int h, int R, int Cc) const { int cr = u.pm * 256 + h * 128 + R; cr = cr < NCR ? cr : NCR - 1; return (unsigned)(cr * 512 + Cc) * 2u; }
    __device__ __forceinline__ const char* b_base(const Unit& u) const { return (const char*)(ws + WS_BT1) + ((size_t)u.z * 768 + u.pn * 256) * 512 * 2; }
    __device__ __forceinline__ void epi(const Acc& acc, const Unit& u, int wr, int wc, int fr, int fq) const {
#pragma unroll
        for (int ai = 0; ai < 2; ++ai)
#pragma unroll
            for (int m = 0; m < 4; ++m) { const int cr = u.pm * 256 + ai * 128 + wr * 64 + m * 16 + fr; if (cr >= NCR) continue;
#pragma unroll
                for (int bj = 0; bj < 2; ++bj) { const int n = bj * 128 + wc * 32 + 8 * fq;
                    if (u.pn < 2) *(GAS v4u*)((bf16*)(ws + WS_YG) + (size_t)u.z * T * 16 + (size_t)cr * 512 + u.pn * 256 + n) = pack8(acc[ai][bj][m][0], acc[ai][bj][m][1]);
                    else { GAS f32x4* o = (GAS f32x4*)((float*)(ws + WS_SST) + (size_t)cr * 8192 + u.z * 256 + n); o[0] = acc[ai][bj][m][0]; o[1] = acc[ai][bj][m][1]; } }
                __builtin_amdgcn_sched_barrier(0); }
    }
};

struct PS5B {
    static constexpr bool EARLY_AOFF = false, FP8 = false; unsigned char* ws; int G, c; int K; unsigned kstepA;
    __device__ __forceinline__ bool next(int i, Unit& u) const { const long L = (long)i * G + c; if (L >= 32 * 10) return false; const int l = (int)L; u.z = l / 10; const int r = l % 10; u.pm = r / 2; u.pn = r % 2; return true; }
    __device__ __forceinline__ const char* a_base(const Unit& u) const { return (const char*)(ws + WS_XST) + (size_t)u.z * 512; }
    __device__ __forceinline__ unsigned a_off(const Unit& u, int h, int R, int Cc) const { int cr = u.pm * 256 + h * 128 + R; cr = cr < NCR ? cr : NCR - 1; return (unsigned)(cr * 8192 + Cc) * 2u; }
    __device__ __forceinline__ const char* b_base(const Unit& u) const { return (const char*)(ws + WS_BT2) + ((size_t)u.z * 512 + u.pn * 256) * 256 * 2; }
    __device__ __forceinline__ void epi(const Acc& acc, const Unit& u, int wr, int wc, int fr, int fq) const {
#pragma unroll
        for (int ai = 0; ai < 2; ++ai)
#pragma unroll
            for (int m = 0; m < 4; ++m) { const int cr = u.pm * 256 + ai * 128 + wr * 64 + m * 16 + fr; if (cr >= NCR) continue;
#pragma unroll
                for (int bj = 0; bj < 2; ++bj) { const int nn = u.pn * 256 + bj * 128 + wc * 32 + 8 * fq, t = nn >> 4, h0 = nn & 15;
                    GAS v4u* p = (GAS v4u*)((bf16*)(ws + WS_YS) + (size_t)(chunk_m0(cr) + t) * 512 + u.z * 16 + h0);
                    f32x4 y0, y1; { const v4u w_ = *(const GAS v4u*)((const bf16*)(ws + WS_YG) + (size_t)u.z * T * 16 + (size_t)cr * 512 + nn); unpack8(w_, y0, y1); } y0 += acc[ai][bj][m][0]; y1 += acc[ai][bj][m][1];
                    y0 = (f32x4){gelu_tanh(y0[0]), gelu_tanh(y0[1]), gelu_tanh(y0[2]), gelu_tanh(y0[3])}; y1 = (f32x4){gelu_tanh(y1[0]), gelu_tanh(y1[1]), gelu_tanh(y1[2]), gelu_tanh(y1[3])};
                    *p = pack8(y0, y1); }
                __builtin_amdgcn_sched_barrier(0); }
    }
};

__device__ __forceinline__ int half_panel(int hl, bool lat_only) { if (!lat_only) return hl; const int pl = hl >> 1; return 2 * (pl + (pl >> 5) + 1) + (hl & 1); }
struct PGlu {
    static constexpr bool EARLY_AOFF = false, FP8 = false; unsigned char* ws; int G, c; int K; unsigned kstepA; bool lat_only;
    __device__ __forceinline__ bool next(int i, Unit& u) const { const int nH = lat_only ? 256 : 2 * NPAN; const long L = (long)i * G + c; if (L >= nH * 2) return false; pg8::static_decode((int)L, nH, 2, u.pm, u.pn); u.pm = half_panel(u.pm, lat_only); u.z = 0; return true; }
    __device__ __forceinline__ const char* a_base(const Unit& u) const { return (const char*)(ws + WS_YS) + (size_t)u.pm * 128 * 512 * 2; }
    __device__ __forceinline__ unsigned a_off(const Unit&, int R, int Cc) const { return (unsigned)(R * 512 + Cc) * 2u; }
    __device__ __forceinline__ const char* b_base(const Unit& u) const { return (const char*)(ws + WS_WGLU) + (size_t)u.pn * 256 * 512 * 2; }
    __device__ __forceinline__ void epi(const f32x4 (&acc)[2][4][2], f32x4 (&)[2][4][2], const Unit& u, int wr, int wc, int fr, int fq) const {
#pragma unroll
        for (int m = 0; m < 4; ++m) { const size_t r = (size_t)(u.pm * 128 + wr * 64 + m * 16 + fr);
#pragma unroll
            for (int bj = 0; bj < 2; ++bj) { const int cc = u.pn * 256 + bj * 128 + wc * 32 + 8 * fq;
                f32x4 z0, z1; { const v4u w_ = *(const GAS v4u*)((const bf16*)(ws + WS_YS) + r * 512 + cc); unpack8(w_, z0, z1); } const f32x4 a0 = acc[bj][m][0], a1 = acc[bj][m][1];
                z0 = z0 * (f32x4){fsigmoid(a0[0]), fsigmoid(a0[1]), fsigmoid(a0[2]), fsigmoid(a0[3])}; z1 = z1 * (f32x4){fsigmoid(a1[0]), fsigmoid(a1[1]), fsigmoid(a1[2]), fsigmoid(a1[3])};
                *(GAS v4u*)((bf16*)(ws + WS_U) + r * 512 + cc) = pack8(z0, z1); }
            __builtin_amdgcn_sched_barrier(0); }
    }
};

typedef f32x4 Acc128[2][4][2];
struct PMerge {
    static constexpr bool EARLY_AOFF = false, FP8 = false; unsigned char* ws; int G, c; int K; unsigned kstepA; bool lat_only;
    __device__ __forceinline__ bool next(int i, Unit& u) const { const int nH = lat_only ? 256 : 2 * NPAN; const long tile = (long)(i / 3) * G + c; if (tile >= nH * 4) return false; pg8::static_decode((int)tile, nH, 4, u.pm, u.pn); u.pm = half_panel(u.pm, lat_only); u.z = i % 3; return true; }
    __device__ __forceinline__ const char* a_base(const Unit& u) const { const size_t off = u.z == 0 ? WS_U : (u.z == 1 ? WS_AO : WS_NO); return (const char*)(ws + off) + (size_t)u.pm * 128 * 512 * 2; }
    __device__ __forceinline__ unsigned a_off(const Unit&, int R, int Cc) const { return (unsigned)(R * 512 + Cc) * 2u; }
    __device__ __forceinline__ const char* b_base(const Unit& u) const { return (const char*)(ws + WS_WBR) + ((size_t)u.z * 1024 + u.pn * 256) * 512 * 2; }
    __device__ __forceinline__ void epi(const Acc128& acc, Acc128& mrg, const Unit& u, int wr, int wc, int fr, int fq) const {
#pragma unroll
        for (int m = 0; m < 4; ++m) { const size_t r = (size_t)(u.pm * 128 + wr * 64 + m * 16 + fr);
#pragma unroll
            for (int bj = 0; bj < 2; ++bj) { const int cc = u.pn * 256 + bj * 128 + wc * 32 + 8 * fq;
                f32x4 g0, g1;
                if (GATE_BF16) { const v4u w_ = *(const GAS v4u*)((const bf16*)(ws + WS_GATES) + r * 3072 + u.z * 1024 + cc); unpack8(w_, g0, g1); }
                else { const v2u w_ = *(const GAS v2u*)((const unsigned char*)(ws + WS_GATES) + r * 3072 + u.z * 1024 + cc);
                    g0 = (f32x4){__builtin_amdgcn_cvt_f32_fp8((int)w_.x, 0), __builtin_amdgcn_cvt_f32_fp8((int)w_.x, 1), __builtin_amdgcn_cvt_f32_fp8((int)w_.x, 2), __builtin_amdgcn_cvt_f32_fp8((int)w_.x, 3)};
                    g1 = (f32x4){__builtin_amdgcn_cvt_f32_fp8((int)w_.y, 0), __builtin_amdgcn_cvt_f32_fp8((int)w_.y, 1), __builtin_amdgcn_cvt_f32_fp8((int)w_.y, 2), __builtin_amdgcn_cvt_f32_fp8((int)w_.y, 3)}; }
                if (u.z == 0) { mrg[bj][m][0] = g0 * acc[bj][m][0]; mrg[bj][m][1] = g1 * acc[bj][m][1]; }
                else { mrg[bj][m][0] += g0 * acc[bj][m][0]; mrg[bj][m][1] += g1 * acc[bj][m][1]; }
                if (u.z == 2) *(GAS v4u*)((bf16*)(ws + WS_HB) + r * 1024 + cc) = pack8(mrg[bj][m][0], mrg[bj][m][1]); } }
    }
};

struct PWout {
    static constexpr bool EARLY_AOFF = false, FP8 = false; unsigned char* ws; float* out; const float* mod; int G, c; int K; unsigned kstepA; bool lat_only;
    __device__ __forceinline__ bool next(int i, Unit& u) const { const int nH = lat_only ? 256 : 2 * NPAN; const long L = (long)i * G + c; if (L >= nH * 4) return false; pg8::static_decode((int)L, nH, 4, u.pm, u.pn); u.pm = half_panel(u.pm, lat_only); u.z = 0; return true; }
    __device__ __forceinline__ const char* a_base(const Unit& u) const { return (const char*)(ws + WS_HB) + (size_t)u.pm * 128 * 1024 * 2; }
    __device__ __forceinline__ unsigned a_off(const Unit&, int R, int Cc) const { return (unsigned)(R * 1024 + Cc) * 2u; }
    __device__ __forceinline__ const char* b_base(const Unit& u) const { return (const char*)(ws + WS_WOUT) + (size_t)u.pn * 256 * 1024 * 2; }
    __device__ __forceinline__ void epi(const f32x4 (&acc)[2][4][2], f32x4 (&)[2][4][2], const Unit& u, int wr, int wc, int fr, int fq) const {
        const int pm = u.pm >> 1, hh = u.pm & 1, b = pm / 33, pr = pm % 33, cond = pr == 0 ? 4 : b;
        float* xb = pr == 0 ? (float*)(ws + WS_CTXS) + ((size_t)b * 256 + hh * 128) * D : out + ((size_t)b * SEQ + (size_t)(pr - 1) * 256 + hh * 128) * D;
        const float* g1 = mod + cond * 6144 + 2048;
#pragma unroll
        for (int bj = 0; bj < 2; ++bj) { const int cc = u.pn * 256 + bj * 128 + wc * 32 + 8 * fq; const f32x4 ga = *(const GAS f32x4*)(g1 + cc), gb = *(const GAS f32x4*)(g1 + cc + 4);
#pragma unroll
            for (int m = 0; m < 4; ++m) { GAS f32x4* p = (GAS f32x4*)(xb + (size_t)(wr * 64 + m * 16 + fr) * D + cc);
                p[0] = p[0] + ga * acc[bj][m][0]; p[1] = p[1] + gb * acc[bj][m][1]; __builtin_amdgcn_sched_barrier(0); } }
    }
};

struct ExpTab { int cnt[16], tile0[17]; };
__device__ __forceinline__ int exp_find(const int (&tile0)[17], int q) { int e = 0;
#pragma unroll
    for (int k = 1; k < 16; ++k) e += (q >= tile0[k]) ? 1 : 0;
    return e; }

struct PMoe1 {
    static constexpr bool EARLY_AOFF = true, FP8 = true; unsigned char* ws; const LAS int* tab; int G, c; int K; unsigned kstepA;
    __device__ __forceinline__ bool next(int i, Unit& u) const { const long L = (long)i * G + c; const int total = __builtin_amdgcn_readfirstlane(tab[32]) * 4; if (L >= total) return false; const int q = (int)L >> 2; u.pn = (int)L & 3;
        int e = 0;
#pragma unroll
        for (int k = 1; k < 16; ++k) e += (q >= __builtin_amdgcn_readfirstlane(tab[16 + k])) ? 1 : 0;
        u.z = e; u.pm = q - __builtin_amdgcn_readfirstlane(tab[16 + e]); return true; }
    __device__ __forceinline__ const char* a_base(const Unit&) const { return (const char*)(ws + WS_HB8); }
    __device__ __forceinline__ unsigned a_off(const Unit& u, int R, int Cc) const { int r = u.pm * 128 + R; const int n = __builtin_amdgcn_readfirstlane(tab[u.z]); r = r < n ? r : n - 1;
        const int ent = ((const int*)(ws + WS_LIST))[(size_t)u.z * T + r]; return (unsigned)((ent >> 1) * 1024 + Cc * 2); }
    __device__ __forceinline__ const char* b_base(const Unit& u) const { return (const char*)(ws + WS_MOE1) + ((size_t)u.z * 1024 + u.pn * 256) * 1024; }
    __device__ __forceinline__ void epi(const f32x4 (&acc)[2][4][2], f32x4 (&)[2][4][2], const Unit& u, int wr, int wc, int fr, int fq) const {
        const size_t arow0 = (size_t)(__builtin_amdgcn_readfirstlane(tab[16 + u.z]) + u.pm) * 128;
#pragma unroll
        for (int m = 0; m < 4; ++m) { const f32x4 g0 = acc[0][m][0] * (1.f / 64.f), g1 = acc[0][m][1] * (1.f / 64.f), u0 = acc[1][m][0] * (8.f / 64.f), u1 = acc[1][m][1] * (8.f / 64.f);
            const f32x4 v0 = (f32x4){g0[0] * fsigmoid(g0[0]), g0[1] * fsigmoid(g0[1]), g0[2] * fsigmoid(g0[2]), g0[3] * fsigmoid(g0[3])} * u0;
            const f32x4 v1 = (f32x4){g1[0] * fsigmoid(g1[0]), g1[1] * fsigmoid(g1[1]), g1[2] * fsigmoid(g1[2]), g1[3] * fsigmoid(g1[3])} * u1;
            *(GAS v2u*)((unsigned char*)(ws + WS_ACT) + (arow0 + wr * 64 + m * 16 + fr) * 512 + u.pn * 128 + wc * 32 + 8 * fq) = (v2u){pk4_fp8(v0[0], v0[1], v0[2], v0[3]), pk4_fp8(v1[0], v1[1], v1[2], v1[3])}; }
    }
};
struct PMoe2 {
    static constexpr bool EARLY_AOFF = false, FP8 = true; unsigned char* ws; const LAS int* tab; int G, c; int K; unsigned kstepA;
    __device__ __forceinline__ bool next(int i, Unit& u) const { const long L = (long)i * G + c; const int total = __builtin_amdgcn_readfirstlane(tab[32]) * 4; if (L >= total) return false; const int q = (int)L >> 2; u.pn = (int)L & 3;
        int e = 0;
#pragma unroll
        for (int k = 1; k < 16; ++k) e += (q >= __builtin_amdgcn_readfirstlane(tab[16 + k])) ? 1 : 0;
        u.z = e; u.pm = q - __builtin_amdgcn_readfirstlane(tab[16 + e]); return true; }
    __device__ __forceinline__ const char* a_base(const Unit& u) const { return (const char*)(ws + WS_ACT) + (size_t)(__builtin_amdgcn_readfirstlane(tab[16 + u.z]) + u.pm) * 128 * 512; }
    __device__ __forceinline__ unsigned a_off(const Unit&, int R, int Cc) const { return (unsigned)(R * 512 + Cc * 2); }
    __device__ __forceinline__ const char* b_base(const Unit& u) const { return (const char*)(ws + WS_MOE2) + ((size_t)u.z * 1024 + u.pn * 256) * 512; }
    __device__ __forceinline__ void epi(const f32x4 (&acc)[2][4][2], f32x4 (&)[2][4][2], const Unit& u, int wr, int wc, int fr, int fq) const {
        const int n = __builtin_amdgcn_readfirstlane(tab[u.z]);
#pragma unroll
        for (int m = 0; m < 4; ++m) { const int r = u.pm * 128 + wr * 64 + m * 16 + fr; if (r >= n) continue;
            const int ent = ((const int*)(ws + WS_LIST))[(size_t)u.z * T + r]; const float w = ((const float*)(ws + WS_RW))[ent] * (1.f / 256.f);
#pragma unroll
            for (int bj = 0; bj < 2; ++bj)
                *(GAS v4u*)((bf16*)(ws + WS_YSLOT) + (size_t)ent * 1024 + u.pn * 256 + bj * 128 + wc * 32 + 8 * fq) = pack8(acc[bj][m][0] * w, acc[bj][m][1] * w); }
    }
};
struct PMoe1B {
    static constexpr bool EARLY_AOFF = true, FP8 = false; unsigned char* ws; const LAS int* tab; int G, c; int K; unsigned kstepA;
    __device__ __forceinline__ bool next(int i, Unit& u) const { const long L = (long)i * G + c; const int total = tab[32] * 4; if (L >= total) return false; const int q = (int)L >> 2; u.pn = (int)L & 3;
        int e = 0;
#pragma unroll
        for (int k = 1; k < 16; ++k) e += (q >= tab[16 + k]) ? 1 : 0;
        u.z = e; u.pm = q - tab[16 + e]; return true; }
    __device__ __forceinline__ const char* a_base(const Unit&) const { return (const char*)(ws + WS_HB); }
    __device__ __forceinline__ unsigned a_off(const Unit& u, int h, int R, int Cc) const { int r = u.pm * 256 + h * 128 + R; const int n = tab[u.z]; r = r < n ? r : n - 1;
        const int ent = ((const int*)(ws + WS_LIST))[(size_t)u.z * T + r]; return (unsigned)((ent >> 1) * 1024 + Cc) * 2u; }
    __device__ __forceinline__ const char* b_base(const Unit& u) const { return (const char*)(ws + WS_MOE1) + ((size_t)u.z * 1024 + u.pn * 256) * 1024 * 2; }
    __device__ __forceinline__ void epi(const Acc& acc, const Unit& u, int wr, int wc, int fr, int fq) const {
        const size_t arow0 = (size_t)(tab[16 + u.z] + u.pm) * 256;
#pragma unroll
        for (int ai = 0; ai < 2; ++ai)
#pragma unroll
            for (int m = 0; m < 4; ++m) { const f32x4 g0 = acc[ai][0][m][0], g1 = acc[ai][0][m][1], u0 = acc[ai][1][m][0], u1 = acc[ai][1][m][1];
                const f32x4 v0 = (f32x4){g0[0] * fsigmoid(g0[0]), g0[1] * fsigmoid(g0[1]), g0[2] * fsigmoid(g0[2]), g0[3] * fsigmoid(g0[3])} * u0;
                const f32x4 v1 = (f32x4){g1[0] * fsigmoid(g1[0]), g1[1] * fsigmoid(g1[1]), g1[2] * fsigmoid(g1[2]), g1[3] * fsigmoid(g1[3])} * u1;
                *(GAS v4u*)((bf16*)(ws + WS_ACTB) + (arow0 + ai * 128 + wr * 64 + m * 16 + fr) * 512 + u.pn * 128 + wc * 32 + 8 * fq) = pack8(v0, v1); }
    }
};
struct PMoe2B {
    static constexpr bool EARLY_AOFF = false, FP8 = false; unsigned char* ws; const LAS int* tab; int G, c; int K; unsigned kstepA;
    __device__ __forceinline__ bool next(int i, Unit& u) const { const long L = (long)i * G + c; const int total = tab[32] * 4; if (L >= total) return false; const int q = (int)L >> 2; u.pn = (int)L & 3;
        int e = 0;
#pragma unroll
        for (int k = 1; k < 16; ++k) e += (q >= tab[16 + k]) ? 1 : 0;
        u.z = e; u.pm = q - tab[16 + e]; return true; }
    __device__ __forceinline__ const char* a_base(const Unit& u) const { return (const char*)(ws + WS_ACTB) + (size_t)(tab[16 + u.z] + u.pm) * 256 * 512 * 2; }
    __device__ __forceinline__ unsigned a_off(const Unit&, int h, int R, int Cc) const { return (unsigned)((h * 128 + R) * 512 + Cc) * 2u; }
    __device__ __forceinline__ const char* b_base(const Unit& u) const { return (const char*)(ws + WS_MOE2) + ((size_t)u.z * 1024 + u.pn * 256) * 512 * 2; }
    __device__ __forceinline__ void epi(const Acc& acc, const Unit& u, int wr, int wc, int fr, int fq) const {
        const int n = tab[u.z];
#pragma unroll
        for (int ai = 0; ai < 2; ++ai)
#pragma unroll
            for (int m = 0; m < 4; ++m) { const int r = u.pm * 256 + ai * 128 + wr * 64 + m * 16 + fr; if (r >= n) continue;
                const int ent = ((const int*)(ws + WS_LIST))[(size_t)u.z * T + r]; const float w = ((const float*)(ws + WS_RW))[ent];
#pragma unroll
                for (int bj = 0; bj < 2; ++bj)
                    *(GAS v4u*)((bf16*)(ws + WS_YSLOT) + (size_t)ent * 1024 + u.pn * 256 + bj * 128 + wc * 32 + 8 * fq) = pack8(acc[ai][bj][m][0] * w, acc[ai][bj][m][1] * w); }
    }
};
__device__ __forceinline__ void build_exptab(const Ctx& C, LAS int* tab, int l, int tsh = 7) {
    __syncthreads();
    if (threadIdx.x == 0) { int t0 = 0;
        for (int e = 0; e < 16; ++e) { const int n = (int)__hip_atomic_load((unsigned*)(C.ctl + CW_CNT + l * 1024 + 64 * e), RLX_AGENT); tab[e] = n; tab[16 + e] = t0; t0 += (n + (1 << tsh) - 1) >> tsh; }
        tab[32] = t0; }
    __syncthreads();
}
__device__ __forceinline__ void phase_attn(const Ctx& C, int l, unsigned char* lds_gen) {
    phase_carry(C, l);
    char* shm = (char*)lds_gen;
    bf16* QA = WSP(bf16, WS_QA); bf16* KA = WSP(bf16, WS_KA); bf16* VA = WSP(bf16, WS_VA); bf16* QN = WSP(bf16, WS_QN); bf16* KN = WSP(bf16, WS_KN); bf16* VN = WSP(bf16, WS_VN);
#ifndef ATTN_SEL
#define ATTN_SEL 3
#endif
#ifdef REPMASK
#define REPMASK_ REPMASK
#else
#define REPMASK_ 0
#endif
    const int per = (1024 + C.G - 1) / C.G;
    if (ATTN_SEL & 1) for (int i = 0; i < per * (1 + ((REPMASK_ >> 13) & 1)); ++i) { const int id = C.vcu * per + (i % per); if (id >= 1024) continue; const int bh = id >> 5, b = bh >> 3, h = bh & 7, qb = id & 31;
        const bf16* Qu = QA + (size_t)(b * LB + CTX + qb * 256) * 512 + h * 64;
        attn_body::attn_unit<8, false, 512, 128>(Qu, 512, KA + (size_t)(b * LB) * 128 + (h >> 2) * 64, VA + (size_t)(b * LB) * 128 + (h >> 2) * 64, 128, WSP(bf16, WS_AO) + (Qu - QA), LB / 64, 0, 0, shm);
    }
    LAS float* bt = (LAS float*)(C.lds + attn_body::LDS_BT);
    const int nctx = (C.vcu >= 64 && C.vcu < 128) ? 1 : 0;
    if (ATTN_SEL & 2) for (int i0 = 0; i0 < (per + nctx) * (1 + ((REPMASK_ >> 14) & 1)); ++i0) { const int i = i0 % (per + nctx);
        const bf16 *Qu, *Kh, *Vh; bf16* Ou; int kvp = 512, NT = 4, r0 = 0, rlo = 0;
        if (i < per) { const int id = C.vcu * per + i; if (id >= 1024) continue; const int bh = id >> 5, b = bh >> 3, h = bh & 7; r0 = (id & 31) * 4;
            const float* rp = C.in[I_RPB] + (size_t)(l * 8 + h) * 465;
            for (int k = C.tid; k < 465; k += 512) bt[k] = rp[k] * LOG2E;
            rlo = r0 - 4 < 0 ? 0 : (r0 - 4 > 120 ? 120 : r0 - 4); const int rh_ = r0 - 1 < 0 ? 0 : (r0 - 1 > 120 ? 120 : r0 - 1), nloc = rh_ + 8 - rlo; NT = (4 + nloc + 1) & ~1;
            Qu = QN + (size_t)(b * LB + CTX + r0 * 64) * 512 + h * 64; Ou = WSP(bf16, WS_NO) + (Qu - QN); Kh = KN + (size_t)(b * LB) * 512 + h * 64; Vh = VN + (size_t)(b * LB) * 512 + h * 64; }
        else { int j = C.vcu - 64; if (j < 32) { const int b = j >> 3, h = j & 7; Qu = QA + (size_t)(b * LB) * 512 + h * 64; Ou = WSP(bf16, WS_AO) + (Qu - QA); Kh = KA + (size_t)(b * LB) * 128 + (h >> 2) * 64; Vh = VA + (size_t)(b * LB) * 128 + (h >> 2) * 64; kvp = 128; }
            else { j -= 32; const int b = j >> 3, h = j & 7; Qu = QN + (size_t)(b * LB) * 512 + h * 64; Ou = WSP(bf16, WS_NO) + (Qu - QN); Kh = KN + (size_t)(b * LB) * 512 + h * 64; Vh = VN + (size_t)(b * LB) * 512 + h * 64; } }
        attn_body::attn_unit<8, true, 512, 0>(Qu, 512, Kh, Vh, kvp, Ou, NT, r0, rlo, shm);
    }
}

constexpr int NPH = 46;
__global__ void __launch_bounds__(NWAVES * 64, 2) fwd(Args args) {
    extern __shared__ __attribute__((aligned(16))) unsigned char lds[];
    Ctx C; C.in = (const __attribute__((address_space(4))) CFP*)__builtin_amdgcn_kernarg_segment_ptr(); C.out = args.out; C.ws = args.ws; C.lds = (LAS unsigned char*)lds; C.ctl = (gu32*)(args.ws + WS_CTL);
    C.tid = 0; C.lane = 0; C.wave = __builtin_amdgcn_readfirstlane((int)threadIdx.x >> 6);
    C.G = gridDim.x; { const int bx = blockIdx.x; C.vcu = (C.G % 8 == 0) ? (bx % 8) * (C.G / 8) + bx / 8 : bx; }
    for (int u = threadIdx.x; u < (LDS_BYTES - LDSCTL_OFF) / 4; u += NWAVES * 64) ((LAS unsigned*)(C.lds + LDSCTL_OFF))[u] = 0u;
    __syncthreads();
    const int lo = args.ph_lo, hi = args.ph_hi;
    XcdBarrier bar; bar.bar = (unsigned*)(C.ctl + CW_BAR); bar.x = 0; bar.st = nullptr;
    if (hi - lo > 1) bar = xcd_barrier_post((unsigned*)(C.ctl + CW_BAR), (volatile LAS unsigned*)(C.lds + MISC_OFF) + 8);
    LAS int* tab = (LAS int*)(C.lds + LDSCTL_OFF);
    const int cg = (int)blockIdx.x;
#ifndef PHMASK
#define PHMASK 0xFFFF
#endif
#define IN(k) (lo <= (k) && (k) < hi)
#define EN(b) ((PHMASK >> (b)) & 1)
#ifndef REPMASK
#define REPMASK 0
#endif
#define RUN(b, stmt) do { stmt; if ((REPMASK >> (b)) & 1) { stmt; } } while (0)
#ifdef DIAG_SEL
#define DIAG_ACC(ty) do { if (blockIdx.x == 0 && threadIdx.x == 0) { volatile LAS unsigned* dg = (volatile LAS unsigned*)(C.lds + LDSCTL_OFF + 160); const unsigned now = (unsigned)__builtin_amdgcn_s_memrealtime(); dg[8 + (ty)] += now - dg[0]; dg[0] = now; } } while (0)
#else
#define DIAG_ACC(ty) do {} while (0)
#endif
#define SEAM(k) do { if (IN(k) && IN((k) + 1)) xcd_barrier(bar); DIAG_ACC((k) == 0 ? 11 : ((k) - 1) % 11); } while (0)
#define LWS() ({ const __attribute__((address_space(4))) CFP* k_ = C.in; asm volatile("" : "+s"(k_)); (unsigned char*)k_[30]; })
#define LC() ({ Ctx c_ = C; c_.tid = threadIdx.x; asm volatile("" : "+v"(c_.tid)); c_.lane = c_.tid & 63; asm volatile("" : "+s"(c_.in)); c_.ws = (unsigned char*)c_.in[30]; c_.out = (float*)c_.in[29]; c_.ctl = (gu32*)(c_.ws + WS_CTL); c_; })
#ifdef DIAG_SEL
    if (blockIdx.x == 0 && threadIdx.x == 0) { volatile LAS unsigned* dg = (volatile LAS unsigned*)(C.lds + LDSCTL_OFF + 160); dg[0] = (unsigned)__builtin_amdgcn_s_memrealtime(); dg[1] = dg[0]; }
#endif
    if (EN(11) && IN(0)) { const Ctx Cl = LC(); phase_mod(Cl); RUN(11, phase_s5mats(Cl, 0); phase_weights(Cl, 0)); }
    SEAM(0);
    for (int l = 0; l < NLAYER; ++l) {
        const int pb = 1 + 11 * l;
        if (EN(0) && IN(pb)) { const Ctx Cl = LC(); if (l == 0) phase_rows<0>(Cl, 0); else { phase_s5mats(Cl, l); phase_weights(Cl, l); phase_rows<1>(Cl, l); } }
        SEAM(pb);
        if (EN(1) && IN(pb + 1)) { { PWin P{LWS(), C.G, cg, 1024, 128u}; pg8::gemm_phase(C.lds, P); } { PGate P{LWS(), C.G, cg, 1024, 128u}; pg8::gemm_phase_m128(C.lds, P); } }
        SEAM(pb + 1);
        if (EN(2) && IN(pb + 2)) { { const Ctx Cl = LC(); phase_qkprep(Cl, l); } PS5A P{LWS(), C.G, cg, 512, 128u}; RUN(2, pg8::gemm_phase(C.lds, P)); }
        SEAM(pb + 2);
        if (EN(3) && IN(pb + 3)) { const Ctx Cl = LC(); RUN(3, phase_attn(Cl, l, lds)); }
        SEAM(pb + 3);
        if (EN(4) && IN(pb + 4)) { PS5B P{LWS(), C.G, cg, 256, 128u}; pg8::gemm_phase(C.lds, P); }
        SEAM(pb + 4);
        if (EN(5) && IN(pb + 5)) { PGlu P{LWS(), C.G, cg, 512, 128u, l == NLAYER - 1}; pg8::gemm_phase_m128(C.lds, P); }
        SEAM(pb + 5);
        if (EN(6) && IN(pb + 6)) { PMerge P{LWS(), C.G, cg, 512, 128u, l == NLAYER - 1}; pg8::gemm_phase_m128(C.lds, P); }
        SEAM(pb + 6);
        if (EN(7) && IN(pb + 7)) { unsigned char* wl_ = LWS(); PWout P{wl_, (float*)C.in[29], (const float*)(wl_ + WS_MOD) + (size_t)l * 5 * 6144, C.G, cg, 1024, 128u, l == NLAYER - 1}; pg8::gemm_phase_m128(C.lds, P); }
        SEAM(pb + 7);
        if (EN(8) && IN(pb + 8)) { const Ctx Cl = LC(); phase_norm2(Cl, l); }
        SEAM(pb + 8);
        if (EN(9) && IN(pb + 9)) { if (FP8_MOE) { build_exptab(C, tab, l); PMoe1 P{LWS(), tab, C.G, cg, 1024, 128u}; pg8::gemm_phase_m128(C.lds, P); } else { build_exptab(C, tab, l, 8); PMoe1B P{LWS(), tab, C.G, cg, 1024, 128u}; pg8::gemm_phase(C.lds, P); } }
        SEAM(pb + 9);
        if (EN(10) && IN(pb + 10)) { if (FP8_MOE) { build_exptab(C, tab, l); PMoe2 P{LWS(), tab, C.G, cg, 512, 128u}; pg8::gemm_phase_m128(C.lds, P); } else { build_exptab(C, tab, l, 8); PMoe2B P{LWS(), tab, C.G, cg, 512, 128u}; pg8::gemm_phase(C.lds, P); } }
        SEAM(pb + 10);
    }
    if (EN(12) && IN(NPH - 1)) { const Ctx Cl = LC(); phase_rows<2>(Cl, NLAYER); }
#ifdef DIAG_SEL
    xcd_barrier(bar); DIAG_ACC(12);
    if (blockIdx.x == 0 && threadIdx.x == 0) { volatile LAS unsigned* dg = (volatile LAS unsigned*)(C.lds + LDSCTL_OFF + 160); dg[8 + 13] = dg[0] - dg[1];
        for (int i = 0; i < 14; ++i) __hip_atomic_store(C.ctl + 2048 + i, dg[8 + i], RLX_AGENT); }
    xcd_barrier(bar);
    { const float d1 = (float)__hip_atomic_load(C.ctl + 2048 + (DIAG_SEL), RLX_AGENT) * 0.01f, d2 = (float)__hip_atomic_load(C.ctl + 2048 + (DIAG_SEL) + 1, RLX_AGENT) * 0.01f;
      const float c1 = sqrtf(d1); float* o = args.out;
      for (size_t i = (size_t)blockIdx.x * 512 + threadIdx.x; i < (size_t)NB * SEQ * D; i += (size_t)gridDim.x * 512) o[i] = (i == 12345) ? d2 : c1; }
#endif
#undef IN
#undef SEAM
}

#ifndef MK_PER_PHASE
#define MK_PER_PHASE 0
#endif
extern "C" void kernel_launch(void* const* d_in, const int* in_sizes, int n_in, void* d_out, int out_size, void* d_ws, size_t ws_size, hipStream_t stream) {
    static int grid = 0;
    if (grid == 0) {
        if (n_in != 29 || out_size != NB * SEQ * D || ws_size < WS_END) { fprintf(stderr, "kernel_launch: unexpected shapes (n_in %d out %d ws %zu)\n", n_in, out_size, ws_size); grid = -1; return; }
        int dev = 0, cus = 0, per_cu = 0;
        if (hipGetDevice(&dev) != hipSuccess || hipDeviceGetAttribute(&cus, hipDeviceAttributeMultiprocessorCount, dev) != hipSuccess) { grid = -1; return; }
        if (hipFuncSetAttribute((const void*)fwd, hipFuncAttributeMaxDynamicSharedMemorySize, LDS_BYTES) != hipSuccess) { grid = -1; return; }
        if (hipOccupancyMaxActiveBlocksPerMultiprocessor(&per_cu, (const void*)fwd, NWAVES * 64, LDS_BYTES) != hipSuccess || per_cu < 1) fprintf(stderr, "kernel_launch: occupancy query says %d\n", per_cu);
        (void)hipGetLastError();
        grid = cus;
    }
    if (grid < 0) return;
    (void)hipMemsetAsync((char*)d_ws + WS_CTL, 0, CTL_ZERO_BYTES, stream);
    Args a{};
    for (int i = 0; i < 29; ++i) a.in[i] = (const float*)d_in[i];
    a.out = (float*)d_out; a.ws = (unsigned char*)d_ws;
#if MK_PER_PHASE
    for (int p = 0; p < NPH; ++p) { a.ph_lo = p; a.ph_hi = p + 1; hipLaunchKernelGGL(fwd, dim3(grid), dim3(NWAVES * 64), LDS_BYTES, stream, a); }
#else
    a.ph_lo = 0; a.ph_hi = NPH; hipLaunchKernelGGL(fwd, dim3(grid), dim3(NWAVES * 64), LDS_BYTES, stream, a);
#endif
}
```

```cpp
#define FP8_MOE 1
#define GATE_BF16 0
#define H8_WRITE 1
#ifndef H8_WRITE
#define H8_WRITE 1
#endif
#ifndef GATE_BF16
#define GATE_BF16 0
#endif
#include <hip/hip_runtime.h>
#include <cstdio>
#include <cstdint>

#define GAS __attribute__((address_space(1)))
#define LAS __attribute__((address_space(3)))
typedef unsigned short bf16;
typedef unsigned v4u __attribute__((ext_vector_type(4)));
typedef unsigned v2u __attribute__((ext_vector_type(2)));
typedef float f32x4 __attribute__((ext_vector_type(4)));
typedef float f32x2 __attribute__((ext_vector_type(2)));
typedef float f32x16 __attribute__((ext_vector_type(16)));
typedef short bf16x8 __attribute__((ext_vector_type(8)));
typedef short s16x4 __attribute__((ext_vector_type(4)));
typedef GAS unsigned gu32;
#define RLX_AGENT __ATOMIC_RELAXED, __HIP_MEMORY_SCOPE_AGENT
#define LDS_WAIT() asm volatile("s_waitcnt lgkmcnt(0)" ::: "memory")
#define VM_WAIT() asm volatile("s_waitcnt vmcnt(0)" ::: "memory")

constexpr int NB = 4, SEQ = 8192, CTX = 256, LB = SEQ + CTX, T = NB * LB, D = 1024, NPAN = T / 256;
constexpr int NLAYER = 4, INW = 5888, NCH = LB / 32, NCR = NB * NCH;
constexpr int NEXP = 16, FF = 512;
constexpr float EPS = 1e-6f;
constexpr float LOG2E = 1.4426950408889634f;
constexpr float C2 = 0.125f * LOG2E;
constexpr int NWAVES = 8;

constexpr size_t MiB = 1u << 20;
constexpr size_t WS_CTL = 0, CTL_ZERO_BYTES = 1 * MiB;
constexpr size_t WS_MOD = 1 * MiB;
constexpr size_t WS_LIST = 2 * MiB;
constexpr size_t WS_RW = 5 * MiB;
constexpr size_t WS_CTXS = 6 * MiB;
constexpr size_t WS_SST = 10 * MiB;
constexpr size_t WS_HB8 = WS_SST;
constexpr size_t WS_XST = 44 * MiB;
constexpr size_t WS_BT1 = 61 * MiB;
constexpr size_t WS_BT2 = 85 * MiB;
constexpr size_t WS_WIN = 93 * MiB;
constexpr size_t WS_WIN8 = WS_WIN + (size_t)2816 * 1024 * 2;
constexpr size_t WS_WGLU = 105 * MiB;
constexpr size_t WS_WBR = 106 * MiB;
constexpr size_t WS_WOUT = 109 * MiB;
constexpr size_t WS_MOE1 = 111 * MiB;
constexpr size_t WS_MOE2 = 143 * MiB;
constexpr size_t WS_HB = 159 * MiB;
constexpr size_t WS_U = 225 * MiB;
constexpr size_t WS_QA = 258 * MiB;
constexpr size_t WS_KA = 291 * MiB;
constexpr size_t WS_VA = 300 * MiB;
constexpr size_t WS_QN = 309 * MiB;
constexpr size_t WS_KN = 342 * MiB;
constexpr size_t WS_VN = 375 * MiB;
constexpr size_t WS_YS = 408 * MiB;
constexpr size_t WS_GATES = 441 * MiB;
constexpr size_t WS_ACT = WS_QN;
constexpr size_t WS_ACTB = WS_QN;
constexpr size_t WS_YSLOT = WS_GATES;
constexpr size_t WS_AO = 640 * MiB;
constexpr size_t WS_NO = 673 * MiB;
constexpr size_t WS_YG = 706 * MiB;
constexpr size_t WS_END = 739 * MiB;
static_assert(WS_GATES + (size_t)T * 3072 * 2 <= WS_AO && WS_ACT + (size_t)(2 * T + 4096) * 512 * 2 <= WS_YS, "ws map");
constexpr int CW_FAIL = 8;
constexpr int CW_CNT = 64;
constexpr int CW_BAR = 8192;

constexpr int RING_BYTES = 131072, LDS_BYTES = 147456, LDSCTL_OFF = LDS_BYTES - 512, MISC_OFF = LDSCTL_OFF + 320;

__device__ __forceinline__ unsigned f2bf(float f) { unsigned u = __builtin_bit_cast(unsigned, f); return (u + 0x7fffu + ((u >> 16) & 1u)) >> 16; }
__device__ __forceinline__ unsigned pk2(float lo, float hi) { return f2bf(lo) | (f2bf(hi) << 16); }
__device__ __forceinline__ float bf2f(unsigned b) { return __builtin_bit_cast(float, b << 16); }
__device__ __forceinline__ float bflo(unsigned w) { return __builtin_bit_cast(float, w << 16); }
__device__ __forceinline__ float bfhi(unsigned w) { return __builtin_bit_cast(float, w & 0xffff0000u); }
typedef float f32x2_c __attribute__((ext_vector_type(2))); typedef __bf16 bf16x2_c __attribute__((ext_vector_type(2)));
__device__ __forceinline__ unsigned cvt_pk_bf16(float lo, float hi) { const f32x2_c v = {lo, hi}; return __builtin_bit_cast(unsigned, __builtin_convertvector(v, bf16x2_c)); }
typedef int v8i __attribute__((ext_vector_type(8)));
typedef int v4i __attribute__((ext_vector_type(4)));
__device__ __forceinline__ float clamp8(float x) { return __builtin_fminf(__builtin_fmaxf(x, -448.f), 448.f); }
__device__ __forceinline__ unsigned pk4_fp8(float a, float b, float c, float d) { int w = 0; w = __builtin_amdgcn_cvt_pk_fp8_f32(clamp8(a), clamp8(b), w, false); w = __builtin_amdgcn_cvt_pk_fp8_f32(clamp8(c), clamp8(d), w, true); return (unsigned)w; }
__device__ __forceinline__ float fsigmoid(float x) { return __builtin_amdgcn_rcpf(1.f + __builtin_amdgcn_exp2f(-LOG2E * x)); }
__device__ __forceinline__ float gelu_tanh(float x) { const float u = 0.7978845608f * (x + 0.044715f * x * x * x); return x * __builtin_amdgcn_rcpf(1.f + __builtin_amdgcn_exp2f(-2.f * LOG2E * u)); }
__device__ __forceinline__ float shflx(float v, int m, int lane) { return __builtin_bit_cast(float, __builtin_amdgcn_ds_bpermute((lane ^ m) << 2, __builtin_bit_cast(int, v))); }
template <int CTRL, int RM>
__device__ __forceinline__ float dpp_mov(float v) { return __builtin_bit_cast(float, __builtin_amdgcn_update_dpp(0, __builtin_bit_cast(int, v), CTRL, RM, 0xF, true)); }
__device__ __forceinline__ float wave_sum(float v, int) {
    v += dpp_mov<0xB1, 0xF>(v);
    v += dpp_mov<0x4E, 0xF>(v);
    v += dpp_mov<0x141, 0xF>(v);
    v += dpp_mov<0x140, 0xF>(v);
    v += dpp_mov<0x142, 0xA>(v);
    v += dpp_mov<0x143, 0xC>(v);
    return __builtin_bit_cast(float, __builtin_amdgcn_readlane(__builtin_bit_cast(int, v), 63));
}
__device__ __forceinline__ float sin_rev(float r) { r = r - floorf(r); return __builtin_amdgcn_sinf(r); }
__device__ __forceinline__ float cos_rev(float r) { r = r - floorf(r); return __builtin_amdgcn_cosf(r); }

#define XB_TMO      128
#define XB_XCNT(j)  (256  + 64 * (j))
#define XB_XSUB(j)  (1280 + 64 * (j))
#define XB_XGEN(j)  (2304 + 64 * (j))
#define XB_TOP      3328
#define XB_TOPGEN   3392
#define XCD_BAR_WORDS 3456
#define XB_SPIN_CAP (1u << 22)

__device__ __forceinline__ unsigned xb_ld(unsigned* p)              { return __hip_atomic_load(p, __ATOMIC_RELAXED, __HIP_MEMORY_SCOPE_AGENT); }
__device__ __forceinline__ unsigned xb_add(unsigned* p, unsigned v) { return __hip_atomic_fetch_add(p, v, __ATOMIC_RELAXED, __HIP_MEMORY_SCOPE_AGENT); }
__device__ __forceinline__ unsigned xb_xcc_id() { return (unsigned)__builtin_amdgcn_s_getreg((3 << 11) | 20) & 0xFu; }
#define XB_SPIN(cond, bar) do { unsigned _sp = 0; while (cond) { __builtin_amdgcn_s_sleep(1); \
    if ((++_sp & 255u) == 0u) { if (xb_ld(&(bar)[XB_TMO])) break; if (_sp > XB_SPIN_CAP) { atomicAdd(&(bar)[XB_TMO], 1u); break; } } } } while (0)

struct XcdBarrier { unsigned* bar; unsigned x; volatile LAS unsigned* st; };

__device__ __forceinline__ XcdBarrier xcd_barrier_post(unsigned* bar, volatile LAS unsigned* st) {
    XcdBarrier b; b.bar = bar; b.x = xb_xcc_id(); b.st = st;
    if (threadIdx.x == 0) (void)xb_add(&bar[XB_XCNT(b.x)], 1u);
    return b;
}
__device__ __forceinline__ void xcd_barrier_complete(unsigned* bar, unsigned x, unsigned& nloc, unsigned& nx) {
    const unsigned G = gridDim.x * gridDim.y * gridDim.z;
    unsigned sum, cnt, mine, sp = 0u;
    for (;;) {
        sum = 0u; cnt = 0u; mine = 0u;
#pragma unroll
        for (unsigned j = 0; j < 16; ++j) { const unsigned c = xb_ld(&bar[XB_XCNT(j)]); sum += c; cnt += (c > 0u) ? 1u : 0u; mine = (j == x) ? c : mine; }
        if (sum == G) break;
        __builtin_amdgcn_s_sleep(1);
        if ((++sp & 255u) == 0u) { if (xb_ld(&bar[XB_TMO])) break; if (sp > XB_SPIN_CAP) { atomicAdd(&bar[XB_TMO], 1u); break; } }
    }
    nloc = mine > 0u ? mine : 1u; nx = cnt > 0u ? cnt : 1u;
}
__device__ __forceinline__ void xcd_barrier(const XcdBarrier& b) {
    asm volatile("s_waitcnt vmcnt(0)" ::: "memory");
    __syncthreads();
    if (threadIdx.x == 0) {
        unsigned* bar = b.bar;
        __builtin_amdgcn_s_waitcnt(0);
        unsigned nloc = b.st[0], nx = b.st[1];
        if (nloc == 0u) { xcd_barrier_complete(bar, b.x, nloc, nx); b.st[0] = nloc; b.st[1] = nx; }
        const unsigned old = xb_add(&bar[XB_XSUB(b.x)], 1u);
        const unsigned gen = old / nloc;
        if (old + 1u == (gen + 1u) * nloc) {
            __builtin_amdgcn_fence(__ATOMIC_RELEASE, "agent");
            asm volatile("s_waitcnt vmcnt(0)" ::: "memory");
            const unsigned og = xb_add(&bar[XB_TOP], 1u);
            const unsigned tg = og / nx;
            if (og + 1u == (tg + 1u) * nx) xb_add(&bar[XB_TOPGEN], 1u);
            else XB_SPIN(xb_ld(&bar[XB_TOPGEN]) == tg, bar);
            __builtin_amdgcn_fence(__ATOMIC_ACQUIRE, "agent");
            xb_add(&bar[XB_XGEN(b.x)], 1u);
            asm volatile("s_waitcnt vmcnt(0)" ::: "memory");
        } else {
            XB_SPIN(xb_ld(&bar[XB_XGEN(b.x)]) == gen, bar);
            __builtin_amdgcn_fence(__ATOMIC_ACQUIRE, "agent");
            asm volatile("s_waitcnt vmcnt(0)" ::: "memory");
        }
    }
    __syncthreads();
}

namespace pg8 {
constexpr int BM = 256, BK = 64, HALF = 128, HTB = HALF * BK * 2, STAGE_BYTES = 8 * HTB, NXCD = 8, WGM = 8;
__host__ __device__ __forceinline__ int lds_byte(int r, int c) { const int st = (r >> 4) * 2 + (c >> 5), rr = r & 15, cc = c & 31, ob = rr * 64 + cc * 2; return st * 1024 + (ob ^ (((ob >> 9) & 1) << 5)); }
__host__ __device__ __forceinline__ void stage_rc(int b, int& R, int& C) { const int st = b / 1024, sb = b % 1024, swz = sb ^ (((sb >> 9) & 1) << 5); R = (st >> 1) * 16 + swz / 64; C = (st & 1) * 32 + (swz % 64) / 2; }
__host__ __device__ __forceinline__ int perm32(int rho) { const int n = rho >> 4, i = rho & 15; return 8 * (i >> 2) + 4 * n + (i & 3); }

struct Unit { int pm, pn, z; };

__device__ __forceinline__ void static_decode(int L, int nM, int nN, int& pm, int& pn) {
    const int nwg = nM * nN; int wgid = L;
    { const int q = nwg / NXCD, r = nwg % NXCD, xcd = wgid % NXCD, off = wgid / NXCD; wgid = (xcd < r ? xcd * (q + 1) : r * (q + 1) + (xcd - r) * q) + off; }
    const int nig = WGM * nN, gid = wgid / nig, fm = gid * WGM, gsz = (nM - fm) < WGM ? (nM - fm) : WGM;
    pm = fm + ((wgid % nig) % gsz); pn = (wgid % nig) / gsz;
}

template <class P>
__device__ __forceinline__ void gemm_phase(LAS unsigned char* lds, const P& S) {
    int tid_ = threadIdx.x; asm volatile("" : "+v"(tid_));
    const int tid = tid_, wid = __builtin_amdgcn_readfirstlane(tid >> 6), lane = tid & 63, wr = wid >> 2, wc = wid & 3, fr = lane & 15, fq = lane >> 4;
    constexpr int ELB = P::FP8 ? 1 : 2;
    const int K = S.K; int nt = K * ELB / 128; asm volatile("" : "+s"(nt));
    unsigned voffB[2];
#pragma unroll
    for (int i = 0; i < 2; ++i) { int R, C; stage_rc(tid * 16 + i * 8192, R, C); const int Rb = (R & ~31) + perm32(R & 31); voffB[i] = (unsigned)(Rb * K * ELB + C * 2); }
#define PG8_AOFF(dst0, dst1, u) do { _Pragma("unroll") for (int i = 0; i < 2; ++i) { int R, C; stage_rc(tid * 16 + i * 8192, R, C); dst0[i] = S.a_off(u, 0, R, C); dst1[i] = S.a_off(u, 1, R, C); } } while (0)
    const size_t kstepB = (size_t)(BK * 2), hstepB = (size_t)HALF * K * ELB, kstepA = (size_t)S.kstepA;
    const unsigned ldsw = (unsigned)wid * 1024u;
    const int aoff = lds_byte(wr * 64 + fr, fq * 8), boff = lds_byte(wc * 32 + fr, fq * 8);
#define PG8_SA(b, h) (((b) * 2 + (h)) * HTB)
#define PG8_SB(b, h) ((4 + (b) * 2 + (h)) * HTB)
#define PG8_STAGE(bufoff, gbase, voff) do { _Pragma("unroll") for (int _i = 0; _i < 2; ++_i) \
        __builtin_amdgcn_global_load_lds((const unsigned*)((const char*)(gbase) + (voff)[_i]), (LAS unsigned*)(lds + (bufoff) + ldsw + _i * 8192), 16, 0, 0); } while (0)
#define PG8_LDA(dst, b, h) do { _Pragma("unroll") for (int m = 0; m < 4; ++m) _Pragma("unroll") for (int k = 0; k < 2; ++k) dst[m][k] = *(const LAS bf16x8*)(lds + PG8_SA(b, h) + aoff + m * 2048 + k * 1024); } while (0)
#define PG8_LDB(dst, b, h) do { _Pragma("unroll") for (int n = 0; n < 2; ++n) _Pragma("unroll") for (int k = 0; k < 2; ++k) dst[n][k] = *(const LAS bf16x8*)(lds + PG8_SB(b, h) + boff + n * 2048 + k * 1024); } while (0)
#define PG8_CAT(x0, x1) __builtin_shufflevector(__builtin_bit_cast(v4i, x0), __builtin_bit_cast(v4i, x1), 0, 1, 2, 3, 4, 5, 6, 7)
#define PG8_MMA(ai, bj, At, Bt) do { __builtin_amdgcn_s_setprio(1); _Pragma("unroll") for (int m = 0; m < 4; ++m) _Pragma("unroll") for (int n = 0; n < 2; ++n) { \
        if constexpr (P::FP8) acc[ai][bj][m][n] = __builtin_amdgcn_mfma_scale_f32_16x16x128_f8f6f4(PG8_CAT(Bt[n][0], Bt[n][1]), PG8_CAT(At[m][0], At[m][1]), acc[ai][bj][m][n], 0, 0, 0, 0x7f7f7f7f, 0, 0x7f7f7f7f); \
        else { _Pragma("unroll") for (int k = 0; k < 2; ++k) acc[ai][bj][m][n] = __builtin_amdgcn_mfma_f32_16x16x32_bf16(Bt[n][k], At[m][k], acc[ai][bj][m][n], 0, 0, 0); } } __builtin_amdgcn_s_setprio(0); } while (0)
#define PG8_WAIT_V(n) asm volatile("s_waitcnt vmcnt(" #n ")" ::: "memory")
#define PG8_WAIT_L(n) asm volatile("s_waitcnt lgkmcnt(" #n ")" ::: "memory")
#define PG8_BAR __builtin_amdgcn_s_barrier()
#define PG8_SCHED __builtin_amdgcn_sched_barrier(0)
    Unit cur, nxt; int ui = 0;
    if (!S.next(0, cur)) return;
    f32x4 acc[2][2][4][2];
#pragma unroll
    for (int a = 0; a < 2; ++a)
#pragma unroll
        for (int b = 0; b < 2; ++b)
#pragma unroll
            for (int m = 0; m < 4; ++m)
#pragma unroll
                for (int n = 0; n < 2; ++n) acc[a][b][m][n] = (f32x4){0.f, 0.f, 0.f, 0.f};
    bf16x8 At[4][2], B0[2][2], B1[2][2];
    unsigned vA0[2], vA1[2], vN0[2], vN1[2];
    PG8_AOFF(vA0, vA1, cur);
    const char* cA = S.a_base(cur); const char* cB = S.b_base(cur);
    PG8_STAGE(PG8_SB(0, 0), cB, voffB); PG8_STAGE(PG8_SB(0, 1), cB + hstepB, voffB); PG8_STAGE(PG8_SA(0, 0), cA, vA0); PG8_STAGE(PG8_SA(0, 1), cA, vA1);
    if (wr == 1) PG8_BAR;
    PG8_WAIT_V(2); PG8_BAR;
    PG8_STAGE(PG8_SB(1, 0), cB + kstepB, voffB); PG8_STAGE(PG8_SA(1, 0), cA + kstepA, vA0); PG8_STAGE(PG8_SB(1, 1), cB + hstepB + kstepB, voffB);
    PG8_WAIT_V(6); PG8_BAR;
    for (;;) {
        const bool has_next = S.next(ui + 1, nxt);
        const char* nA = cA; const char* nB = cB;
        if (has_next) { nA = S.a_base(nxt); nB = S.b_base(nxt); if (P::EARLY_AOFF) PG8_AOFF(vN0, vN1, nxt); }
        for (int t = 0; t < nt; t += 2) {
            const bool last = (t == nt - 2);
            const char* a1 = cA + (size_t)(t + 1) * kstepA;
            const char* a2 = last ? nA : cA + (size_t)(t + 2) * kstepA; const char* b2 = last ? nB : cB + (size_t)(t + 2) * kstepB;
            const char* a3 = a2 + kstepA; const char* b3 = b2 + kstepB;
            PG8_LDB(B0, 0, 0); PG8_LDB(B1, 0, 1); PG8_SCHED; PG8_LDA(At, 0, 0); PG8_STAGE(PG8_SA(1, 1), a1, vA1);
            if (last && has_next) {
                if (P::EARLY_AOFF) { _Pragma("unroll") for (int i = 0; i < 2; ++i) { vA0[i] = vN0[i]; vA1[i] = vN1[i]; } } else PG8_AOFF(vA0, vA1, nxt); }
            PG8_WAIT_V(8); PG8_WAIT_L(0); PG8_BAR; PG8_MMA(0, 0, At, B0); PG8_MMA(0, 1, At, B1); PG8_BAR; PG8_SCHED;
            PG8_LDA(At, 0, 1); PG8_STAGE(PG8_SB(0, 0), b2, voffB); PG8_STAGE(PG8_SB(0, 1), b2 + hstepB, voffB); PG8_STAGE(PG8_SA(0, 0), a2, vA0);
            PG8_WAIT_V(8); PG8_WAIT_L(0); PG8_BAR; PG8_MMA(1, 0, At, B0); PG8_MMA(1, 1, At, B1); PG8_BAR; PG8_SCHED;
            PG8_LDB(B0, 1, 0); PG8_LDB(B1, 1, 1); PG8_SCHED; PG8_LDA(At, 1, 0); PG8_STAGE(PG8_SA(0, 1), a2, vA1);
            PG8_WAIT_V(8); PG8_WAIT_L(0); PG8_BAR; PG8_MMA(0, 0, At, B0); PG8_MMA(0, 1, At, B1); PG8_BAR; PG8_SCHED;
            PG8_LDA(At, 1, 1); PG8_STAGE(PG8_SB(1, 0), b3, voffB); PG8_STAGE(PG8_SB(1, 1), b3 + hstepB, voffB); PG8_STAGE(PG8_SA(1, 0), a3, vA0);
            PG8_WAIT_V(8); PG8_WAIT_L(0); PG8_BAR; PG8_MMA(1, 0, At, B0); PG8_MMA(1, 1, At, B1); PG8_BAR; PG8_SCHED;
        }
        if (wr == 0) PG8_BAR;
        S.epi(acc, cur, wr, wc, fr, fq);
        if (!has_next) break;
#pragma unroll
        for (int a = 0; a < 2; ++a)
#pragma unroll
            for (int b = 0; b < 2; ++b)
#pragma unroll
                for (int m = 0; m < 4; ++m)
#pragma unroll
                    for (int n = 0; n < 2; ++n) acc[a][b][m][n] = (f32x4){0.f, 0.f, 0.f, 0.f};
        cur = nxt; cA = nA; cB = nB; ++ui;
        if (wr == 1) PG8_BAR;
    }
    PG8_WAIT_V(0);
    PG8_BAR;
#undef PG8_AOFF
#undef PG8_SA
#undef PG8_SB
#undef PG8_STAGE
#undef PG8_LDA
#undef PG8_LDB
#undef PG8_MMA
#undef PG8_CAT
#undef PG8_WAIT_V
#undef PG8_WAIT_L
#undef PG8_BAR
#undef PG8_SCHED
}

template <class P>
__device__ __forceinline__ void gemm_phase_m128(LAS unsigned char* lds, const P& S) {
    int tid_ = threadIdx.x; asm volatile("" : "+v"(tid_));
    const int tid = tid_, wid = __builtin_amdgcn_readfirstlane(tid >> 6), lane = tid & 63, wr = wid >> 2, wc = wid & 3, fr = lane & 15, fq = lane >> 4;
    constexpr int ELB = P::FP8 ? 1 : 2;
    const int K = S.K; int nt = K * ELB / 128; asm volatile("" : "+s"(nt));
    unsigned voffB[2];
#pragma unroll
    for (int i = 0; i < 2; ++i) { int R, C; stage_rc(tid * 16 + i * 8192, R, C); const int Rb = (R & ~31) + perm32(R & 31); voffB[i] = (unsigned)(Rb * K * ELB + C * 2); }
#define PG8_AOFF(dst0, u) do { _Pragma("unroll") for (int i = 0; i < 2; ++i) { int R, C; stage_rc(tid * 16 + i * 8192, R, C); dst0[i] = S.a_off(u, R, C); } } while (0)
    const size_t kstepB = (size_t)(BK * 2), hstepB = (size_t)HALF * K * ELB, kstepA = (size_t)S.kstepA;
    const unsigned ldsw = (unsigned)wid * 1024u;
    const int aoff = lds_byte(wr * 64 + fr, fq * 8), boff = lds_byte(wc * 32 + fr, fq * 8);
#define PG8_SA(b) (((b) * 2) * HTB)
#define PG8_SB(b, h) ((4 + (b) * 2 + (h)) * HTB)
#define PG8_STAGE(bufoff, gbase, voff) do { _Pragma("unroll") for (int _i = 0; _i < 2; ++_i) \
        __builtin_amdgcn_global_load_lds((const unsigned*)((const char*)(gbase) + (voff)[_i]), (LAS unsigned*)(lds + (bufoff) + ldsw + _i * 8192), 16, 0, 0); } while (0)
#define PG8_LDA(dst, b) do { _Pragma("unroll") for (int m = 0; m < 4; ++m) _Pragma("unroll") for (int k = 0; k < 2; ++k) dst[m][k] = *(const LAS bf16x8*)(lds + PG8_SA(b) + aoff + m * 2048 + k * 1024); } while (0)
#define PG8_LDB(dst, b, h) do { _Pragma("unroll") for (int n = 0; n < 2; ++n) _Pragma("unroll") for (int k = 0; k < 2; ++k) dst[n][k] = *(const LAS bf16x8*)(lds + PG8_SB(b, h) + boff + n * 2048 + k * 1024); } while (0)
#define PG8_CAT(x0, x1) __builtin_shufflevector(__builtin_bit_cast(v4i, x0), __builtin_bit_cast(v4i, x1), 0, 1, 2, 3, 4, 5, 6, 7)
#define PG8_MMA(bj, At, Bt) do { __builtin_amdgcn_s_setprio(1); _Pragma("unroll") for (int m = 0; m < 4; ++m) _Pragma("unroll") for (int n = 0; n < 2; ++n) { \
        if constexpr (P::FP8) acc[bj][m][n] = __builtin_amdgcn_mfma_scale_f32_16x16x128_f8f6f4(PG8_CAT(Bt[n][0], Bt[n][1]), PG8_CAT(At[m][0], At[m][1]), acc[bj][m][n], 0, 0, 0, 0x7f7f7f7f, 0, 0x7f7f7f7f); \
        else { _Pragma("unroll") for (int k = 0; k < 2; ++k) acc[bj][m][n] = __builtin_amdgcn_mfma_f32_16x16x32_bf16(Bt[n][k], At[m][k], acc[bj][m][n], 0, 0, 0); } } __builtin_amdgcn_s_setprio(0); } while (0)
#define PG8_WAIT_V(n) asm volatile("s_waitcnt vmcnt(" #n ")" ::: "memory")
#define PG8_WAIT_L(n) asm volatile("s_waitcnt lgkmcnt(" #n ")" ::: "memory")
#define PG8_BAR __builtin_amdgcn_s_barrier()
#define PG8_SCHED __builtin_amdgcn_sched_barrier(0)
    Unit cur, nxt; int ui = 0;
    if (!S.next(0, cur)) return;
    f32x4 acc[2][4][2], st[2][4][2];
#pragma unroll
    for (int a = 0; a < 2; ++a)
#pragma unroll
        for (int m = 0; m < 4; ++m)
#pragma unroll
            for (int n = 0; n < 2; ++n) { acc[a][m][n] = (f32x4){0.f, 0.f, 0.f, 0.f}; st[a][m][n] = (f32x4){0.f, 0.f, 0.f, 0.f}; }
    bf16x8 At[4][2], B0[2][2];
    unsigned vA[2], vN[2];
    PG8_AOFF(vA, cur);
    const char* cA = S.a_base(cur); const char* cB = S.b_base(cur);
    PG8_STAGE(PG8_SB(0, 0), cB, voffB); PG8_STAGE(PG8_SA(0), cA, vA); PG8_STAGE(PG8_SB(0, 1), cB + hstepB, voffB);
    if (wr == 1) PG8_BAR;
    PG8_WAIT_V(2); PG8_BAR;
    PG8_STAGE(PG8_SB(1, 0), cB + kstepB, voffB); PG8_STAGE(PG8_SA(1), cA + kstepA, vA);
    PG8_WAIT_V(4); PG8_BAR;
    for (;;) {
        const bool has_next = S.next(ui + 1, nxt);
        const char* nA = cA; const char* nB = cB;
        if (has_next) { nA = S.a_base(nxt); nB = S.b_base(nxt); if (P::EARLY_AOFF) PG8_AOFF(vN, nxt); }
        for (int t = 0; t < nt; t += 2) {
            const bool last = (t == nt - 2);
            const char* b1 = cB + (size_t)(t + 1) * kstepB;
            const char* a2 = last ? nA : cA + (size_t)(t + 2) * kstepA; const char* b2 = last ? nB : cB + (size_t)(t + 2) * kstepB;
            const char* a3 = a2 + kstepA; const char* b3 = b2 + kstepB;
            PG8_LDB(B0, 0, 0); PG8_SCHED; PG8_LDA(At, 0); PG8_STAGE(PG8_SB(1, 1), b1 + hstepB, voffB);
            if (last && has_next) { if (P::EARLY_AOFF) { vA[0] = vN[0]; vA[1] = vN[1]; } else PG8_AOFF(vA, nxt); }
            PG8_WAIT_V(6); PG8_WAIT_L(0); PG8_BAR; PG8_MMA(0, At, B0); PG8_BAR; PG8_SCHED;
            PG8_LDB(B0, 0, 1); PG8_STAGE(PG8_SB(0, 0), b2, voffB); PG8_STAGE(PG8_SA(0), a2, vA);
            PG8_WAIT_V(6); PG8_WAIT_L(0); PG8_BAR; PG8_MMA(1, At, B0); PG8_BAR; PG8_SCHED;
            PG8_LDB(B0, 1, 0); PG8_SCHED; PG8_LDA(At, 1); PG8_STAGE(PG8_SB(0, 1), b2 + hstepB, voffB);
            PG8_WAIT_V(6); PG8_WAIT_L(0); PG8_BAR; PG8_MMA(0, At, B0); PG8_BAR; PG8_SCHED;
            PG8_LDB(B0, 1, 1); PG8_STAGE(PG8_SB(1, 0), b3, voffB); PG8_STAGE(PG8_SA(1), a3, vA);
            PG8_WAIT_V(6); PG8_WAIT_L(0); PG8_BAR; PG8_MMA(1, At, B0); PG8_BAR; PG8_SCHED;
        }
        if (wr == 0) PG8_BAR;
        S.epi(acc, st, cur, wr, wc, fr, fq);
        if (!has_next) break;
#pragma unroll
        for (int a = 0; a < 2; ++a)
#pragma unroll
            for (int m = 0; m < 4; ++m)
#pragma unroll
                for (int n = 0; n < 2; ++n) acc[a][m][n] = (f32x4){0.f, 0.f, 0.f, 0.f};
        cur = nxt; cA = nA; cB = nB; ++ui;
        if (wr == 1) PG8_BAR;
    }
    PG8_WAIT_V(0);
    PG8_BAR;
#undef PG8_AOFF
#undef PG8_SA
#undef PG8_SB
#undef PG8_STAGE
#undef PG8_LDA
#undef PG8_LDB
#undef PG8_MMA
#undef PG8_CAT
#undef PG8_WAIT_V
#undef PG8_WAIT_L
#undef PG8_BAR
#undef PG8_SCHED
}
}
namespace attn_body {
using bf16x8 = __attribute__((ext_vector_type(8))) short;
using u32x4 = __attribute__((ext_vector_type(4))) unsigned;
constexpr int NW = 8, QBLK = 32, QB = QBLK * NW, KVBLK = 64;
__device__ __forceinline__ int crow(int r, int hi) { return (r & 3) + 8 * (r >> 2) + 4 * hi; }
#define SBAR() __builtin_amdgcn_sched_barrier(0)
constexpr int NSLOT = 3, SLOTB = 8192;
constexpr int LDS_K = 0, LDS_V = NSLOT * SLOTB, LDS_WS = 2 * NSLOT * SLOTB, LDS_OST = LDS_WS + NW * 64 * 4, LDS_BYTES = LDS_OST + NW * 4096;
constexpr int LDS_BT = 86016 + 256;
__device__ __forceinline__ void glds16(const void* gsrc, unsigned lds_dst) { unsigned keep;
  asm volatile("s_mov_b32 %0, m0\n\ts_mov_b32 m0, %2\n\ts_nop 0\n\tglobal_load_lds_dwordx4 %1, off\n\ts_mov_b32 m0, %0" : "=&s"(keep) : "v"(gsrc), "s"(lds_dst) : "memory"); }
__device__ __forceinline__ float max3f(float a, float b, float c) { float r; asm("v_max3_f32 %0, %1, %2, %3" : "=v"(r) : "v"(a), "v"(b), "v"(c)); return r; }
__device__ __forceinline__ float max2f(float a, float b) { float r; asm("v_max_f32_e32 %0, %1, %2" : "=v"(r) : "v"(a), "v"(b)); return r; }
__device__ __forceinline__ float fadd_s(float a, float b) { float r; asm("v_add_f32_e32 %0, %1, %2" : "=v"(r) : "v"(a), "v"(b)); return r; }
__device__ __forceinline__ float fsub_s(float a, float b) { float r; asm("v_sub_f32_e32 %0, %1, %2" : "=v"(r) : "v"(a), "v"(b)); return r; }
typedef float f32x2_t __attribute__((ext_vector_type(2))); typedef __bf16 bf16x2_t __attribute__((ext_vector_type(2)));
__device__ __forceinline__ unsigned cvtpk_s(float lo, float hi) { f32x2_t v = {lo, hi}; bf16x2_t b = __builtin_convertvector(v, bf16x2_t); return __builtin_bit_cast(unsigned, b); }
#define WAIT_BAR(N) asm volatile("s_waitcnt vmcnt(" #N ") lgkmcnt(0)\n\ts_barrier" ::: "memory")

__device__ __forceinline__ void qkt(f32x16& p0, f32x16& p1, const char* Kslot, const bf16x8* qr, const f32x16& negm, int r32, int hi) {
  const char* kb = Kslot + hi * 1024 + r32 * 16;
  #pragma unroll
  for (int d0 = 0; d0 < 4; ++d0) {
    const bf16x8 b0 = *reinterpret_cast<const bf16x8*>(kb + d0 * 2048);
    const bf16x8 b1 = *reinterpret_cast<const bf16x8*>(kb + d0 * 2048 + 512);
    if (d0 == 0) { p0 = __builtin_amdgcn_mfma_f32_32x32x16_bf16(b0, qr[0], negm, 0, 0, 0); p1 = __builtin_amdgcn_mfma_f32_32x32x16_bf16(b1, qr[0], negm, 0, 0, 0); }
    else { p0 = __builtin_amdgcn_mfma_f32_32x32x16_bf16(b0, qr[d0], p0, 0, 0, 0); p1 = __builtin_amdgcn_mfma_f32_32x32x16_bf16(b1, qr[d0], p1, 0, 0, 0); } }
}
typedef __attribute__((address_space(3))) const char* lds_cptr;
typedef short v4i16_t __attribute__((ext_vector_type(4)));
__device__ __forceinline__ void kload8(bf16x8* kf, lds_cptr kp) {
  kf[0] = *(const __attribute__((address_space(3))) bf16x8*)(kp);        kf[1] = *(const __attribute__((address_space(3))) bf16x8*)(kp + 512);
  kf[2] = *(const __attribute__((address_space(3))) bf16x8*)(kp + 2048); kf[3] = *(const __attribute__((address_space(3))) bf16x8*)(kp + 2560);
  kf[4] = *(const __attribute__((address_space(3))) bf16x8*)(kp + 4096); kf[5] = *(const __attribute__((address_space(3))) bf16x8*)(kp + 4608);
  kf[6] = *(const __attribute__((address_space(3))) bf16x8*)(kp + 6144); kf[7] = *(const __attribute__((address_space(3))) bf16x8*)(kp + 6656);
}
__device__ __forceinline__ void kload2(bf16x8* kf, lds_cptr kp, int j) { kf[2 * j] = *(const __attribute__((address_space(3))) bf16x8*)(kp + j * 2048); kf[2 * j + 1] = *(const __attribute__((address_space(3))) bf16x8*)(kp + j * 2048 + 512); }
__device__ __forceinline__ s16x4 vtr(lds_cptr p) { return __builtin_bit_cast(s16x4, __builtin_amdgcn_ds_read_tr16_b64_v4i16((__attribute__((address_space(3))) v4i16_t*)p)); }
__device__ __forceinline__ float rowmax(const f32x16& p0, const f32x16& p1) {
  float a = max3f(p0[0], p0[1], p1[0]), b = max3f(p0[2], p0[3], p1[1]); a = max3f(a, p1[2], p1[3]);
  #pragma unroll
  for (int r = 4; r < 16; r += 4) { a = max3f(a, p0[r], p0[r + 1]); b = max3f(b, p0[r + 2], p0[r + 3]); a = max3f(a, p1[r], p1[r + 1]); b = max3f(b, p1[r + 2], p1[r + 3]); }
  const float m = max2f(a, b);
  auto rr = __builtin_amdgcn_permlane32_swap(__float_as_uint(m), __float_as_uint(m), false, false);
  return max2f(__uint_as_float(rr[0]), __uint_as_float(rr[1]));
}
__device__ __forceinline__ void pv(f32x16* o, int vb, bf16x8 pa0, bf16x8 pa1, bf16x8 pa2, bf16x8 pa3) {
  #pragma unroll
  for (int d0 = 0; d0 < 2; ++d0) { s16x4 lo[4], hi[4];
    #pragma unroll
    for (int ks = 0; ks < 4; ++ks) {
      asm volatile("ds_read_b64_tr_b16 %0,%1 offset:%c2" : "=&v"(lo[ks]) : "v"(vb), "i"(d0 * 4096 + ks * 1024) : "memory");
      asm volatile("ds_read_b64_tr_b16 %0,%1 offset:%c2" : "=&v"(hi[ks]) : "v"(vb), "i"(d0 * 4096 + ks * 1024 + 512) : "memory"); }
    asm volatile("s_waitcnt lgkmcnt(0)" ::: "memory"); SBAR();
    #define PK(k) (bf16x8){lo[k][0], lo[k][1], lo[k][2], lo[k][3], hi[k][0], hi[k][1], hi[k][2], hi[k][3]}
    o[d0] = __builtin_amdgcn_mfma_f32_32x32x16_bf16(pa0, PK(0), o[d0], 0, 0, 0);
    o[d0] = __builtin_amdgcn_mfma_f32_32x32x16_bf16(pa1, PK(1), o[d0], 0, 0, 0);
    o[d0] = __builtin_amdgcn_mfma_f32_32x32x16_bf16(pa2, PK(2), o[d0], 0, 0, 0);
    o[d0] = __builtin_amdgcn_mfma_f32_32x32x16_bf16(pa3, PK(3), o[d0], 0, 0, 0);
    #undef PK
  }
}
#define ATTN_STORE16(p, v) (*(u32x4*)(p) = (v))

template <int THRL, bool NA, int QP_, int KVP_>
__device__ __forceinline__ void attn_unit(const bf16* Qu, int qp_rt, const bf16* __restrict__ Kh, const bf16* __restrict__ Vh, int kvp_rt, bf16* Ou, int NT, int r0, int rlo, char* shm) {
  const int qp = QP_ ? QP_ : qp_rt, kvp = KVP_ ? KVP_ : kvp_rt, op = qp;
  int tid_ = threadIdx.x; asm volatile("" : "+v"(tid_));
  const int tid = tid_, lane = tid & 63, r32 = lane & 31, hi = lane >> 5; const int wid = __builtin_amdgcn_readfirstlane(tid >> 6);
  const bf16* Qw = Qu + (long)(wid * QBLK) * qp;
  const unsigned lds0 = (unsigned)(uintptr_t)shm;
  float* wsf = (float*)(shm + LDS_WS) + wid * 64;
  const bf16* ksrc = Kh + (long)lane * kvp + wid * 8;
  const bf16* vsrc = Vh + (long)(16 * (wid & 3) + (lane >> 2)) * kvp + (wid >> 2) * 32 + (lane & 3) * 8;
  const unsigned kdst = lds0 + LDS_K + wid * 1024, vdst = lds0 + LDS_V + wid * 1024;
  #define TROW(t) (NA ? ((t) < 4 ? 64 * (t) : CTX + 64 * ((rlo + (t) - 4) < 127 ? (rlo + (t) - 4) : 127)) : 64 * (t))
  #define DMA_K(t, slot) glds16(ksrc + (long)TROW(t) * kvp, (unsigned)__builtin_amdgcn_readfirstlane(kdst + (slot)))
  #define DMA_V(t, slot) glds16(vsrc + (long)TROW(t) * kvp, (unsigned)__builtin_amdgcn_readfirstlane(vdst + (slot)))
  const int vb0 = (int)(lds0 + LDS_V) + ((lane >> 4) & 1) * 32 + (lane & 3) * 8 + (4 * hi + ((lane & 15) >> 2)) * 64;
  const char* Kbase = shm + LDS_K; bf16x8 kf[8];
  const lds_cptr shm3 = (lds_cptr)shm; const lds_cptr kp0 = shm3 + LDS_K + hi * 1024 + r32 * 16; const lds_cptr vp0 = shm3 + LDS_V + ((lane >> 4) & 1) * 32 + (lane & 3) * 8 + (4 * hi + ((lane & 15) >> 2)) * 64;
  const int rq = r0 + (wid >> 1), qc = 32 * (wid & 1) + r32;
  const int rsw = rq - 4 < 0 ? 0 : (rq - 4 > 120 ? 120 : rq - 4);
  const int cs = qc - 8 < 0 ? 0 : (qc - 8 > 48 ? 48 : qc - 8);
  const __attribute__((address_space(3))) float* btl = (const __attribute__((address_space(3))) float*)(shm3 + LDS_BT) + (15 + 4 * hi - qc);
  DMA_K(0, 0); DMA_V(0, 0); DMA_K(1, SLOTB);
  bf16x8 qr[4];
  #pragma unroll
  for (int d0 = 0; d0 < 4; ++d0) qr[d0] = *reinterpret_cast<const bf16x8*>(&Qw[(long)r32 * qp + d0 * 16 + hi * 8]);
  float mhat = 0.f, l_reg = 0.f; f32x16 o[2]; o[0] = f32x16{}; o[1] = f32x16{}; f32x16 negm = f32x16{}; if (!NA) asm volatile("" : "+v"(negm));
  #define NEGM (NA ? f32x16{} : negm)
  #define CMASK(P0, P1, t) do { if (NA) { if ((t) >= 4) { const int kr_ = rlo + (t) - 4; const int dr_ = kr_ - rsw; \
      if (dr_ < 0 || dr_ >= 8) { _Pragma("unroll") for (int r = 0; r < 16; ++r) { P0[r] = (-__builtin_inff()); P1[r] = (-__builtin_inff()); } } \
      else { const __attribute__((address_space(3))) float* bp_ = btl + (kr_ - rq + 7) * 31; const int kl0_ = 4 * hi - cs; \
        _Pragma("unroll") for (int rg = 0; rg < 4; ++rg) { \
          _Pragma("unroll") for (int rr_ = 0; rr_ < 4; ++rr_) { const int r = rg * 4 + rr_; const int kc_ = (r & 3) + 8 * (r >> 2); const float b0_ = bp_[kc_], b1_ = bp_[kc_ + 32]; \
            const int kl_ = kc_ + kl0_; P0[r] = ((unsigned)kl_ < 16u) ? P0[r] + b0_ : (-__builtin_inff()); P1[r] = ((unsigned)(kl_ + 32) < 16u) ? P1[r] + b1_ : (-__builtin_inff()); } \
          SBAR(); } } } } } while (0)
  bool resc = false;
  #define START(P0, P1) do { const float rm = rowmax(P0, P1); resc = false; \
    { const float dl = rm; mhat = fadd_s(mhat, dl); \
      _Pragma("unroll") for (int r = 0; r < 16; ++r) { P0[r] = fsub_s(P0[r], dl); P1[r] = fsub_s(P1[r], dl); } \
      if (!NA) { _Pragma("unroll") for (int r = 0; r < 16; ++r) negm[r] = -mhat; asm volatile("" : "+v"(negm)); } } \
    _Pragma("unroll") for (int r = 0; r < 16; ++r) P0[r] = __builtin_amdgcn_exp2f(P0[r]); } while (0)
  #define RESC() do { if (resc) { asm volatile("s_waitcnt lgkmcnt(0)" ::: "memory"); \
      _Pragma("unroll") for (int d_ = 0; d_ < 2; ++d_) _Pragma("unroll") for (int r = 0; r < 16; ++r) o[d_][r] *= wsf[crow(r, hi)]; } } while (0)
  f32x16 pA0, pA1, pB0, pB1;
  int sl_prev = 0, sl_cur = 0, sl_next = SLOTB;
  #define ROT() do { sl_prev = sl_cur; sl_cur = sl_next; sl_next = (sl_next == (NSLOT - 1) * SLOTB) ? 0 : sl_next + SLOTB; } while (0)
  DMA_K(2, 2 * SLOTB);
  WAIT_BAR(3);
  qkt(pA0, pA1, Kbase, qr, NEGM, r32, hi); asm volatile("s_nop 15\n\ts_nop 7" : "+v"(pA0), "+v"(pA1));
  START(pA0, pA1);
  _Pragma("unroll") for (int r = 0; r < 16; ++r) pA1[r] = __builtin_amdgcn_exp2f(pA1[r]);
  WAIT_BAR(0);
  DMA_K(3, 0); DMA_V(1, SLOTB);
  ROT();
  kload8(kf, kp0 + sl_cur);
  WAIT_BAR(2);
  s16x4 vlo[8], vhi[8]; u32x4 pw0, pw1, pw2, pw3;
  #define PKW(P, B) cvtpk_s(P[B], P[B + 1])
  #define PAF(k) __builtin_bit_cast(bf16x8, pw##k)
  #define VFR(i) (bf16x8){vlo[i][0], vlo[i][1], vlo[i][2], vlo[i][3], vhi[i][0], vhi[i][1], vhi[i][2], vhi[i][3]}
  #define PIN(x) asm volatile("" : "+v"(x))
  #define MX3(a, b, c) __builtin_fmaxf(__builtin_fmaxf((a), (b)), (c))
  #define GAPA(MF, A0, A1, A2, A3, W0, W1, PW) do { MF; sacc += A0; sacc += A1; sacc += A2; sacc += A3; PIN(sacc); W0; W1; PIN(PW); SBAR(); } while (0)
  #define EX(v) __builtin_amdgcn_exp2f(v)
  #define GAPB(MF, X, B) do { MF; X[B] = EX(X[B]); X[B + 1] = EX(X[B + 1]); X[B + 2] = EX(X[B + 2]); X[B + 3] = EX(X[B + 3]); PIN(X); SBAR(); } while (0)
  #define VRD(i) do { vlo[i] = vtr(vp_ + (((i) >> 2) * 4096 + ((i) & 3) * 1024)); vhi[i] = vtr(vp_ + (((i) >> 2) * 4096 + ((i) & 3) * 1024 + 512)); } while (0)
  #define KRD(G, j) do { if (G) { kload2(kf, kp0 + sl_next, j); SBAR(); } } while (0)
  #define STEP(C0, C1, P0, P1, t, GK, GV, GL) do { SBAR(); \
    const lds_cptr vp_ = vp0 + sl_prev; \
    VRD(0); SBAR(); float sacc = (P0[0] + P0[1]); \
    GAPA(C0 = __builtin_amdgcn_mfma_f32_32x32x16_bf16(kf[0], qr[0], NEGM, 0, 0, 0), P0[2], P0[3], P0[4], P0[5],     pw0[0] = PKW(P0, 0), pw0[1] = PKW(P0, 2), pw0); \
    VRD(4); SBAR(); GAPA(C1 = __builtin_amdgcn_mfma_f32_32x32x16_bf16(kf[1], qr[0], NEGM, 0, 0, 0), P0[6], P0[7], P0[8], P0[9],     pw0[2] = PKW(P0, 4), pw0[3] = PKW(P0, 6), pw0); \
    VRD(1); SBAR(); GAPA(C0 = __builtin_amdgcn_mfma_f32_32x32x16_bf16(kf[2], qr[1], C0, 0, 0, 0),   P0[10], P0[11], P0[12], P0[13], pw1[0] = PKW(P0, 8), pw1[1] = PKW(P0, 10), pw1); \
    VRD(5); SBAR(); GAPA(C1 = __builtin_amdgcn_mfma_f32_32x32x16_bf16(kf[3], qr[1], C1, 0, 0, 0),   P0[14], P0[15], P1[0], P1[1],   pw1[2] = PKW(P0, 12), pw1[3] = PKW(P0, 14), pw1); \
    VRD(2); SBAR(); GAPA(C0 = __builtin_amdgcn_mfma_f32_32x32x16_bf16(kf[4], qr[2], C0, 0, 0, 0),   P1[2], P1[3], P1[4], P1[5],     pw2[0] = PKW(P1, 0), pw2[1] = PKW(P1, 2), pw2); \
    VRD(6); SBAR(); GAPA(C1 = __builtin_amdgcn_mfma_f32_32x32x16_bf16(kf[5], qr[2], C1, 0, 0, 0),   P1[6], P1[7], P1[8], P1[9],     pw2[2] = PKW(P1, 4), pw2[3] = PKW(P1, 6), pw2); \
    VRD(3); SBAR(); GAPA(C0 = __builtin_amdgcn_mfma_f32_32x32x16_bf16(kf[6], qr[3], C0, 0, 0, 0),   P1[10], P1[11], P1[12], P1[13], pw3[0] = PKW(P1, 8), pw3[1] = PKW(P1, 10), pw3); \
    VRD(7); SBAR(); GAPA(C1 = __builtin_amdgcn_mfma_f32_32x32x16_bf16(kf[7], qr[3], C1, 0, 0, 0),   P1[14], P1[15], 0.f, 0.f,       pw3[2] = PKW(P1, 12), pw3[3] = PKW(P1, 14), pw3); \
    l_reg += sacc; \
    if (GK) { DMA_K((t) + 3, sl_cur); } if (GV) { DMA_V((t) + 1, sl_next); } \
    if (NA) { _Pragma("unroll") for (int r = 0; r < 16; ++r) { C0[r] -= mhat; C1[r] -= mhat; } } \
    CMASK(C0, C1, t); \
    { float a = MX3(C0[0], C0[1], C1[0]), b = MX3(C0[2], C0[3], C1[1]); a = MX3(a, C1[2], C1[3]); \
      _Pragma("unroll") for (int r = 4; r < 16; r += 4) { a = MX3(a, C0[r], C0[r + 1]); b = MX3(b, C0[r + 2], C0[r + 3]); a = MX3(a, C1[r], C1[r + 1]); b = MX3(b, C1[r + 2], C1[r + 3]); } \
      float rm = __builtin_fmaxf(a, b); { auto rr = __builtin_amdgcn_permlane32_swap(__float_as_uint(rm), __float_as_uint(rm), false, false); rm = __builtin_fmaxf(__uint_as_float(rr[0]), __uint_as_float(rr[1])); } \
      resc = false; \
      if (__builtin_expect(__any(rm > (float)THRL), 0)) { const float dl = __builtin_fmaxf(rm, 0.f); mhat += dl; \
        _Pragma("unroll") for (int r = 0; r < 16; ++r) { C0[r] -= dl; C1[r] -= dl; } \
        if (!NA) { _Pragma("unroll") for (int r = 0; r < 16; ++r) negm[r] = -mhat; asm volatile("" : "+v"(negm)); } \
        const float f = __builtin_amdgcn_exp2f(-dl); l_reg *= f; if (hi == 0) wsf[r32] = f; resc = true; } } \
    SBAR(); \
    GAPB(o[0] = __builtin_amdgcn_mfma_f32_32x32x16_bf16(PAF(0), VFR(0), o[0], 0, 0, 0), C0, 0); \
    GAPB(o[1] = __builtin_amdgcn_mfma_f32_32x32x16_bf16(PAF(0), VFR(4), o[1], 0, 0, 0), C0, 4); \
    KRD(GL, 0); GAPB(o[0] = __builtin_amdgcn_mfma_f32_32x32x16_bf16(PAF(1), VFR(1), o[0], 0, 0, 0), C0, 8); \
    KRD(GL, 1); GAPB(o[1] = __builtin_amdgcn_mfma_f32_32x32x16_bf16(PAF(1), VFR(5), o[1], 0, 0, 0), C0, 12); \
    KRD(GL, 2); GAPB(o[0] = __builtin_amdgcn_mfma_f32_32x32x16_bf16(PAF(2), VFR(2), o[0], 0, 0, 0), C1, 0); \
    KRD(GL, 3); GAPB(o[1] = __builtin_amdgcn_mfma_f32_32x32x16_bf16(PAF(2), VFR(6), o[1], 0, 0, 0), C1, 4); \
    GAPB(o[0] = __builtin_amdgcn_mfma_f32_32x32x16_bf16(PAF(3), VFR(3), o[0], 0, 0, 0), C1, 8); \
    GAPB(o[1] = __builtin_amdgcn_mfma_f32_32x32x16_bf16(PAF(3), VFR(7), o[1], 0, 0, 0), C1, 12); \
    } while (0)
  int t = 1;
  for (; t + 5 < NT; t += 2) {
    STEP(pB0, pB1, pA0, pA1, t, true, true, true);     WAIT_BAR(2); RESC(); ROT();
    STEP(pA0, pA1, pB0, pB1, t + 1, true, true, true); WAIT_BAR(2); RESC(); ROT();
  }
  #define ENDW(tt) do { if ((tt) + 3 < NT) { WAIT_BAR(2); } else if ((tt) + 2 < NT) { WAIT_BAR(1); } else { WAIT_BAR(0); } } while (0)
  for (; t + 1 < NT; t += 2) {
    STEP(pB0, pB1, pA0, pA1, t, (t + 3 < NT), (t + 1 < NT), (t + 1 < NT));         ENDW(t);     RESC(); ROT();
    STEP(pA0, pA1, pB0, pB1, t + 1, (t + 4 < NT), (t + 2 < NT), (t + 2 < NT));     ENDW(t + 1); RESC(); ROT();
  }
  STEP(pB0, pB1, pA0, pA1, NT - 1, false, false, false); RESC();
  { float sacc = pB0[0] + pB0[1]; _Pragma("unroll") for (int r = 2; r < 16; ++r) sacc += pB0[r]; _Pragma("unroll") for (int r = 0; r < 16; ++r) sacc += pB1[r]; l_reg += sacc;
    pw0 = (u32x4){PKW(pB0, 0), PKW(pB0, 2), PKW(pB0, 4), PKW(pB0, 6)}; pw1 = (u32x4){PKW(pB0, 8), PKW(pB0, 10), PKW(pB0, 12), PKW(pB0, 14)}; pw2 = (u32x4){PKW(pB1, 0), PKW(pB1, 2), PKW(pB1, 4), PKW(pB1, 6)}; pw3 = (u32x4){PKW(pB1, 8), PKW(pB1, 10), PKW(pB1, 12), PKW(pB1, 14)};
    SBAR(); pv(o, vb0 + sl_cur, PAF(0), PAF(1), PAF(2), PAF(3)); }
  #undef PKW
  #undef PAF
  #undef VFR
  #undef PIN
  #undef MX3
  #undef GAPA
  #undef GAPB
  #undef EX
  #undef VRD
  #undef KRD
  #undef STEP
  #undef ENDW
  { auto rr = __builtin_amdgcn_permlane32_swap(__float_as_uint(l_reg), __float_as_uint(l_reg), false, false); l_reg = __uint_as_float(rr[0]) + __uint_as_float(rr[1]); }
  if (hi == 0) wsf[32 + r32] = l_reg; asm volatile("s_waitcnt lgkmcnt(0)" ::: "memory");
  float rli[16];
  #pragma unroll
  for (int r = 0; r < 16; ++r) rli[r] = __builtin_amdgcn_rcpf(wsf[32 + crow(r, hi)]);
  bf16* Ow = Ou + (long)(wid * QBLK) * op;
  { bf16* stg = (bf16*)(shm + LDS_OST) + wid * 2048;
    #pragma unroll
    for (int r = 0; r < 16; ++r) { const int orow = crow(r, hi);
      #pragma unroll
      for (int d0 = 0; d0 < 2; ++d0) stg[orow * 64 + d0 * 32 + r32] = (bf16)f2bf(o[d0][r] * rli[r]); }
    asm volatile("s_waitcnt lgkmcnt(0)" ::: "memory");
    #pragma unroll
    for (int i = 0; i < 4; ++i) { const int row = i * 8 + (lane >> 3), ch = lane & 7; const u32x4 v = *(const u32x4*)(stg + row * 64 + ch * 8); ATTN_STORE16(Ow + (long)row * op + ch * 8, v); } }
  asm volatile("s_waitcnt lgkmcnt(0)\n\ts_barrier" ::: "memory");
  #undef NEGM
  #undef DMA_K
  #undef DMA_V
  #undef TROW
  #undef CMASK
  #undef START
  #undef RESC
  #undef ROT
}
#undef SBAR
#undef WAIT_BAR
}
#ifndef FP8_MOE
#define FP8_MOE 1
#endif
struct Args { const float* in[29]; float* out; unsigned char* ws; int ph_lo, ph_hi; };
enum { I_X = 0, I_C, I_CTX, I_CCTX, I_WMOD, I_BMOD, I_N1G, I_N2G, I_WIN, I_LRE, I_LIM, I_LDT, I_BRE, I_BIM, I_CRE, I_CIM, I_SSMD, I_WGLU, I_QNG, I_KNG, I_RPB, I_WBR, I_WOUT, I_RW, I_RB, I_MG, I_MU, I_MD, I_FNG };

typedef const float* CFP;
struct Ctx {
    const __attribute__((address_space(4))) CFP* in; float* out; unsigned char* ws; LAS unsigned char* lds; gu32* ctl;
    int tid, lane, wave, vcu, G;
};
#define WSP(T_, off) ((T_*)(C.ws + (off)))

__device__ __forceinline__ float* xs_row(const Ctx& C, int m) { const int b = m / LB, j = m - b * LB; return j < CTX ? WSP(float, WS_CTXS) + (size_t)(b * CTX + j) * D : C.out + (size_t)(b * SEQ + j - CTX) * D; }
__device__ __forceinline__ const float* in_row(const Ctx& C, int m) { const int b = m / LB, j = m - b * LB; return j < CTX ? C.in[I_CTX] + (size_t)(b * CTX + j) * D : C.in[I_X] + (size_t)(b * SEQ + j - CTX) * D; }
__device__ __forceinline__ int cond_of(int m) { const int b = m / LB, j = m - b * LB; return j < CTX ? 4 : b; }

__device__ __forceinline__ void transpose_item(const float* W, int N, int Kp, bf16* WT, int k0, int n0, int drow0, LAS float* scr, int lane) {
    const float* src = W + (size_t)k0 * N + n0 + lane;
    float tv[64];
#pragma unroll
    for (int i = 0; i < 64; ++i) tv[i] = src[(size_t)i * N];
#pragma unroll
    for (int i = 0; i < 64; ++i) scr[i * 65 + lane] = tv[i];
    LDS_WAIT(); asm volatile("" ::: "memory");
    const int c = lane & 7;
#pragma unroll
    for (int j = 0; j < 8; ++j) { const int n = (lane >> 3) + 8 * j; const LAS float* s = scr + (8 * c) * 65 + n;
        v4u o; o.x = pk2(s[0 * 65], s[1 * 65]); o.y = pk2(s[2 * 65], s[3 * 65]); o.z = pk2(s[4 * 65], s[5 * 65]); o.w = pk2(s[6 * 65], s[7 * 65]);
        *(GAS v4u*)(WT + (size_t)(drow0 + n) * Kp + k0 + 8 * c) = o; }
    LDS_WAIT(); asm volatile("" ::: "memory");
}
__device__ __forceinline__ void transpose_item8(const float* W, int N, int Kp, unsigned char* WT, int k0, int n0, int drow0, float scale, LAS float* scr, int lane) {
    const float* src = W + (size_t)k0 * N + n0 + lane;
    float tv[64];
#pragma unroll
    for (int i = 0; i < 64; ++i) tv[i] = src[(size_t)i * N];
#pragma unroll
    for (int i = 0; i < 64; ++i) scr[i * 65 + lane] = tv[i] * scale;
    LDS_WAIT(); asm volatile("" ::: "memory");
    const int c = lane & 3;
#pragma unroll
    for (int j = 0; j < 4; ++j) { const int n = (lane >> 2) + 16 * j; const LAS float* s = scr + (16 * c) * 65 + n;
        v4u o; o.x = pk4_fp8(s[0 * 65], s[1 * 65], s[2 * 65], s[3 * 65]); o.y = pk4_fp8(s[4 * 65], s[5 * 65], s[6 * 65], s[7 * 65]); o.z = pk4_fp8(s[8 * 65], s[9 * 65], s[10 * 65], s[11 * 65]); o.w = pk4_fp8(s[12 * 65], s[13 * 65], s[14 * 65], s[15 * 65]);
        *(GAS v4u*)(WT + (size_t)(drow0 + n) * Kp + k0 + 16 * c) = o; }
    LDS_WAIT(); asm volatile("" ::: "memory");
}
__device__ __forceinline__ void phase_weights(const Ctx& C, int l) {
    LAS float* scr = (LAS float*)(C.lds + C.wave * 16640);
    const int gw = C.vcu * NWAVES + C.wave, NGW = C.G * NWAVES;
    constexpr int I0 = 16 * 92, I1 = 8 * 8, I2 = 3 * 8 * 16, I3 = 16 * 16, I4 = 16 * 16 * 8, I5 = I4, I6 = 16 * 8 * 16;
    for (int it = gw; it < I0 + I1 + I2 + I3 + I4 + I5 + I6; it += NGW) {
        int r = it;
        if (r < I0) { const int kb = r / 92, nb = r % 92; if (nb < 44 || GATE_BF16) transpose_item(C.in[I_WIN] + (size_t)l * 1024 * INW, INW, 1024, WSP(bf16, WS_WIN), 64 * kb, 64 * nb, 64 * nb, scr, C.lane);
            else transpose_item8(C.in[I_WIN] + (size_t)l * 1024 * INW, INW, 1024, WSP(unsigned char, WS_WIN8), 64 * kb, 64 * nb, 64 * nb - 2816, 64.f, scr, C.lane); continue; } r -= I0;
        if (r < I1) { const int kb = r / 8, nb = r % 8; transpose_item(C.in[I_WGLU] + (size_t)l * 512 * 512, 512, 512, WSP(bf16, WS_WGLU), 64 * kb, 64 * nb, 64 * nb, scr, C.lane); continue; } r -= I1;
        if (r < I2) { const int i = r / 128, q = r % 128, kb = q / 16, nb = q % 16; transpose_item(C.in[I_WBR] + (size_t)(l * 3 + i) * 512 * 1024, 1024, 512, WSP(bf16, WS_WBR) + (size_t)i * 1024 * 512, 64 * kb, 64 * nb, 64 * nb, scr, C.lane); continue; } r -= I2;
        if (r < I3) { const int kb = r / 16, nb = r % 16; transpose_item(C.in[I_WOUT] + (size_t)l * 1024 * 1024, 1024, 1024, WSP(bf16, WS_WOUT), 64 * kb, 64 * nb, 64 * nb, scr, C.lane); continue; } r -= I3;
        if (r < I4 + I5) { const int up = r >= I4; if (up) r -= I4; const int e = r / 128, q = r % 128, kb = q / 8, nb = q % 8, n0 = 64 * nb;
            if (FP8_MOE) transpose_item8((up ? C.in[I_MU] : C.in[I_MG]) + (size_t)(l * 16 + e) * 1024 * 512, 512, 1024, WSP(unsigned char, WS_MOE1) + (size_t)e * 1024 * 1024, 64 * kb, n0, (n0 / 128) * 256 + (n0 % 128) + (up ? 128 : 0), 64.f, scr, C.lane);
            else transpose_item((up ? C.in[I_MU] : C.in[I_MG]) + (size_t)(l * 16 + e) * 1024 * 512, 512, 1024, WSP(bf16, WS_MOE1) + (size_t)e * 1024 * 1024, 64 * kb, n0, (n0 / 128) * 256 + (n0 % 128) + (up ? 128 : 0), scr, C.lane); continue; } r -= I4 + I5;
        { const int e = r / 128, q = r % 128, kb = q / 16, nb = q % 16; if (FP8_MOE) transpose_item8(C.in[I_MD] + (size_t)(l * 16 + e) * 512 * 1024, 1024, 512, WSP(unsigned char, WS_MOE2) + (size_t)e * 1024 * 512, 64 * kb, 64 * nb, 64 * nb, 32.f, scr, C.lane);
            else transpose_item(C.in[I_MD] + (size_t)(l * 16 + e) * 512 * 1024, 1024, 512, WSP(bf16, WS_MOE2) + (size_t)e * 1024 * 512, 64 * kb, 64 * nb, 64 * nb, scr, C.lane); }
    }
}

__device__ __forceinline__ void phase_mod(const Ctx& C) {
    LAS float* sc = (LAS float*)(C.lds);
    LAS float* red = (LAS float*)(C.lds + 20480);
    for (int i = C.tid; i < 5 * 1024; i += 512) { const int c = i >> 10, k = i & 1023; const float v = c < 4 ? C.in[I_C][c * 1024 + k] : C.in[I_CCTX][k]; sc[i] = v * fsigmoid(v); }
    __syncthreads();
    for (int it = C.vcu; it < NLAYER * 96; it += C.G) {
        const int l = it / 96, col = (it % 96) * 64 + C.lane, k0 = C.wave * 128;
        const float* W = C.in[I_WMOD] + (size_t)l * 1024 * 6144 + (size_t)k0 * 6144 + col;
        float a0 = 0.f, a1 = 0.f, a2 = 0.f, a3 = 0.f, a4 = 0.f;
#pragma unroll 16
        for (int k = 0; k < 128; ++k) { const float w = W[(size_t)k * 6144]; a0 += sc[k0 + k] * w; a1 += sc[1024 + k0 + k] * w; a2 += sc[2048 + k0 + k] * w; a3 += sc[3072 + k0 + k] * w; a4 += sc[4096 + k0 + k] * w; }
        LAS float* r = red + C.wave * 320 + C.lane; r[0] = a0; r[64] = a1; r[128] = a2; r[192] = a3; r[256] = a4;
        __syncthreads();
        if (C.tid < 320) { const int c = C.tid >> 6; float s = C.in[I_BMOD][l * 6144 + col];
#pragma unroll
            for (int w = 0; w < 8; ++w) s += red[w * 320 + C.tid];
            WSP(float, WS_MOD)[(size_t)(l * 5 + c) * 6144 + col] = s; }
        __syncthreads();
    }
}

__device__ __forceinline__ void phase_s5mats(const Ctx& C, int l) {
    if (C.vcu >= 128) return;
    const int g = C.vcu >> 2, part = C.vcu & 3, tid = C.tid;
    LAS f32x2* POW = (LAS f32x2*)(C.lds);
    LAS f32x2* CC = (LAS f32x2*)(C.lds + 33792);
    LAS f32x2* BB = (LAS f32x2*)(C.lds + 50176);
    LAS f32x2* COEF = (LAS f32x2*)(C.lds + 66560);
    LAS bf16* KT = (LAS bf16*)(C.lds + 67584);
    LAS float* K0 = (LAS float*)(C.lds + 99840);
    __syncthreads();
    if (tid < 128) {
        const int d = tid >> 6, p = tid & 63; const int li = ((l * 2 + d) * 32 + g) * 64 + p;
        const float re = C.in[I_LRE][li], im = C.in[I_LIM][li], dt = __expf(C.in[I_LDT][(l * 2 + d) * 32 + g]);
        for (int tau = 0; tau <= 32; ++tau) { const float mag = __expf(re * dt * (float)tau), rev = im * dt * (float)tau * 0.15915494309189535f;
            POW[(d * 33 + tau) * 64 + p] = (f32x2){mag * cos_rev(rev), mag * sin_rev(rev)}; }
        const float mag = __expf(re * dt), rev = im * dt * 0.15915494309189535f; const float lr = mag * cos_rev(rev) - 1.f, lim = mag * sin_rev(rev);
        const float den = 1.f / (re * re + im * im);
        COEF[tid] = (f32x2){(lr * re + lim * im) * den, (lim * re - lr * im) * den};
    }
    __syncthreads();
    for (int i = tid; i < 2048; i += 512) {
        const int d = i >> 10, p = (i >> 4) & 63, h = i & 15; const size_t bi = (((size_t)(l * 2 + d) * 32 + g) * 64 + p) * 16 + h;
        const float br = C.in[I_BRE][bi], bi_ = C.in[I_BIM][bi]; const f32x2 cf = COEF[d * 64 + p];
        BB[i] = (f32x2){cf.x * br - cf.y * bi_, cf.x * bi_ + cf.y * br};
        const int h2 = (i >> 6) & 15, p2 = i & 63; const size_t ci = (((size_t)(l * 2 + d) * 32 + g) * 16 + h2) * 64 + p2;
        CC[i] = (f32x2){C.in[I_CRE][ci], C.in[I_CIM][ci]};
    }
    __syncthreads();
    {
        const int d = tid >> 8, h = (tid >> 4) & 15, hp = tid & 15; float acc[32];
#pragma unroll
        for (int t = 0; t < 32; ++t) acc[t] = 0.f;
        for (int p = 0; p < 64; ++p) { const f32x2 c = CC[d * 1024 + h * 64 + p], b = BB[d * 1024 + p * 16 + hp], lam = POW[(d * 33 + 1) * 64 + p];
            float xr = c.x * b.x - c.y * b.y, xi = c.x * b.y + c.y * b.x;
#pragma unroll
            for (int t = 0; t < 32; ++t) { acc[t] += xr; const float nr = xr * lam.x - xi * lam.y, ni = xr * lam.y + xi * lam.x; xr = nr; xi = ni; } }
        if (d == 1) K0[tid & 255] = acc[0];
        __syncthreads();
        if (d == 0) { acc[0] += K0[tid] + (h == hp ? C.in[I_SSMD][l * 512 + g * 16 + h] : 0.f);
#pragma unroll
            for (int t = 0; t < 32; ++t) KT[((31 + t) * 16 + h) * 16 + hp] = (bf16)f2bf(acc[t]); }
        else {
#pragma unroll
            for (int t = 1; t < 32; ++t) KT[((31 - t) * 16 + h) * 16 + hp] = (bf16)f2bf(acc[t]); }
    }
    __syncthreads();
    bf16* B1 = WSP(bf16, WS_BT1) + (size_t)g * 768 * 512; bf16* B2 = WSP(bf16, WS_BT2) + (size_t)g * 512 * 256;
    for (int i = tid; i < 128 * 64; i += 512) {
        const int n = part * 128 + (i >> 6), ch = i & 63, t = n >> 4, h = n & 15, s = ch >> 1, hp0 = (ch & 1) * 8;
        *(GAS v4u*)(B1 + (size_t)n * 512 + ch * 8) = *(const LAS v4u*)(KT + ((t - s + 31) * 16 + h) * 16 + hp0);
    }
    for (int i = tid; i < 64 * 64; i += 512) {
        const int nn = part * 64 + (i >> 6), ch = i & 63, d = nn >> 7, p = (nn & 127) >> 1, ri = nn & 1, s = ch >> 1, hp0 = (ch & 1) * 8;
        const f32x2 w = POW[(d * 33 + (d == 0 ? 31 - s : s)) * 64 + p]; float v[8];
#pragma unroll
        for (int j = 0; j < 8; ++j) { const f32x2 b = BB[d * 1024 + p * 16 + hp0 + j]; v[j] = ri == 0 ? (w.x * b.x - w.y * b.y) : (w.x * b.y + w.y * b.x); }
        v4u o; o.x = pk2(v[0], v[1]); o.y = pk2(v[2], v[3]); o.z = pk2(v[4], v[5]); o.w = pk2(v[6], v[7]);
        *(GAS v4u*)(B1 + (size_t)(512 + nn) * 512 + ch * 8) = o;
    }
    for (int i = tid; i < 128 * 32; i += 512) {
        const int n = part * 128 + (i >> 5), ch = i & 31, t = n >> 4, h = n & 15, d = ch >> 4, p0 = (ch & 15) * 4; float v[8];
#pragma unroll
        for (int j = 0; j < 4; ++j) { const f32x2 c = CC[d * 1024 + h * 64 + p0 + j], w = POW[(d * 33 + (d == 0 ? t + 1 : 32 - t)) * 64 + p0 + j];
            v[2 * j] = c.x * w.x - c.y * w.y; v[2 * j + 1] = -(c.x * w.y + c.y * w.x); }
        v4u o; o.x = pk2(v[0], v[1]); o.y = pk2(v[2], v[3]); o.z = pk2(v[4], v[5]); o.w = pk2(v[6], v[7]);
        *(GAS v4u*)(B2 + (size_t)n * 256 + ch * 8) = o;
    }
    __syncthreads();
}

template <int MODE>
__device__ __forceinline__ void phase_rows(const Ctx& C, int l) {
    const int gw = C.vcu * NWAVES + C.wave, NGW = C.G * NWAVES, lane = C.lane;
    const float* MODl = WSP(float, WS_MOD) + (size_t)(MODE == 2 ? 0 : l) * 5 * 6144;
    const float* MODp = WSP(float, WS_MOD) + (size_t)(l > 0 ? l - 1 : 0) * 5 * 6144;
    const bf16* YS = WSP(bf16, WS_YSLOT);
    f32x4 nx[4]; v2u na[4], nc[4];
#define ROWS_LOAD(mm) do { const int m_ = (mm); \
        if (MODE == 0) { const GAS f32x4* xr = (const GAS f32x4*)in_row(C, m_) + lane; _Pragma("unroll") for (int q = 0; q < 4; ++q) nx[q] = xr[64 * q]; } \
        else { const GAS f32x4* xr = (const GAS f32x4*)xs_row(C, m_) + lane; const GAS v2u* y0 = (const GAS v2u*)(YS + (size_t)(2 * m_) * D) + lane; const GAS v2u* y1 = (const GAS v2u*)(YS + (size_t)(2 * m_ + 1) * D) + lane; \
            _Pragma("unroll") for (int q = 0; q < 4; ++q) { nx[q] = xr[64 * q]; na[q] = y0[64 * q]; nc[q] = y1[64 * q]; } } } while (0)
    int m = gw; if (MODE == 2) { while (m < T && (m % LB) < CTX) m += NGW; }
    if (m < T) ROWS_LOAD(m);
    while (m < T) {
        const int b = m / LB, j = m - b * LB, cond = j < CTX ? 4 : b;
        f32x4 v[4];
        if (MODE == 0) {
#pragma unroll
            for (int q = 0; q < 4; ++q) v[q] = nx[q]; }
        else { const GAS f32x4* g2 = (const GAS f32x4*)(MODp + cond * 6144 + 5 * 1024) + lane;
#pragma unroll
            for (int q = 0; q < 4; ++q) { const f32x4 g = g2[64 * q]; const v2u a = na[q], c = nc[q];
                v[q] = nx[q] + g * (f32x4){bflo(a.x) + bflo(c.x), bfhi(a.x) + bfhi(c.x), bflo(a.y) + bflo(c.y), bfhi(a.y) + bfhi(c.y)}; } }
        int mn = m + NGW; if (MODE == 2) { while (mn < T && (mn % LB) < CTX) mn += NGW; }
        if (mn < T) ROWS_LOAD(mn);
        float ss = 0.f;
#pragma unroll
        for (int q = 0; q < 4; ++q) ss += (v[q].x * v[q].x + v[q].y * v[q].y) + (v[q].z * v[q].z + v[q].w * v[q].w);
        const float rstd = 1.f / sqrtf(wave_sum(ss, lane) * (1.f / D) + EPS);
        if (MODE == 2) { GAS f32x4* o = (GAS f32x4*)(C.out + (size_t)(b * SEQ + j - CTX) * D) + lane; const GAS f32x4* fg = (const GAS f32x4*)C.in[I_FNG] + lane;
#pragma unroll
            for (int q = 0; q < 4; ++q) o[64 * q] = v[q] * rstd * fg[64 * q]; }
        else { GAS f32x4* xo = (GAS f32x4*)xs_row(C, m) + lane; GAS v2u* ho = (GAS v2u*)(WSP(bf16, WS_HB) + (size_t)m * D) + lane; GAS unsigned* h8 = (GAS unsigned*)(WSP(unsigned char, WS_HB8) + (size_t)m * D) + lane;
            const GAS f32x4* ng = (const GAS f32x4*)(C.in[I_N1G] + l * D) + lane; const GAS f32x4* sh = (const GAS f32x4*)(MODl + cond * 6144) + lane; const GAS f32x4* sc = (const GAS f32x4*)(MODl + cond * 6144 + 1024) + lane;
#pragma unroll
            for (int q = 0; q < 4; ++q) { xo[64 * q] = v[q]; const f32x4 h = v[q] * rstd * ng[64 * q] * (sc[64 * q] + 1.f) + sh[64 * q]; ho[64 * q] = (v2u){pk2(h.x, h.y), pk2(h.z, h.w)}; if (H8_WRITE) h8[64 * q] = pk4_fp8(h.x, h.y, h.z, h.w); } }
        m = mn;
    }
#undef ROWS_LOAD
}

__device__ __forceinline__ void phase_qkprep(const Ctx& C, int l) {
    const int gw = C.vcu * NWAVES + C.wave, NGW = C.G * NWAVES, lane = C.lane, s8 = lane & 7;
    const float* qg = C.in[I_QNG] + l * 64 + 8 * s8; const float* kg = C.in[I_KNG] + l * 64 + 8 * s8;
    float gq[8], gk[8];
#pragma unroll
    for (int i = 0; i < 8; ++i) { gq[i] = qg[i]; gk[i] = kg[i]; }
    const int ax = s8 >> 2, f0 = 8 * (s8 & 1);
    float inv[8];
#pragma unroll
    for (int i = 0; i < 8; ++i) inv[i] = exp2f(-(float)(f0 + i) * 0.8304820237218406f) * 0.15915494309189535f;
    const int kl = lane & 15;
    v4u wq, wk;
    if (gw < T) { wq = *((const GAS v4u*)(WSP(bf16, WS_QA) + (size_t)gw * 512) + lane); wk = *((const GAS v4u*)(WSP(bf16, WS_KA) + (size_t)gw * 128) + kl); }
    for (int m = gw; m < T; m += NGW) {
        const int b = m / LB, j = m - b * LB; const bool lat = j >= CTX; const int tt = j - CTX; const float pos = (float)(ax == 0 ? (tt >> 6) : (tt & 63));
        const v4u cq = wq, ck = wk;
        if (m + NGW < T) { wq = *((const GAS v4u*)(WSP(bf16, WS_QA) + (size_t)(m + NGW) * 512) + lane); wk = *((const GAS v4u*)(WSP(bf16, WS_KA) + (size_t)(m + NGW) * 128) + kl); }
        float cs[8], sn[8];
#pragma unroll
        for (int i = 0; i < 8; ++i) { cs[i] = lat ? cos_rev(pos * inv[i]) : 1.f; sn[i] = lat ? sin_rev(pos * inv[i]) : 0.f; }
#pragma unroll
        for (int which = 0; which < 2; ++which) {
            const v4u w = which == 0 ? cq : ck; float x[8] = {bflo(w.x), bfhi(w.x), bflo(w.y), bfhi(w.y), bflo(w.z), bfhi(w.z), bflo(w.w), bfhi(w.w)};
            float ss = 0.f;
#pragma unroll
            for (int i = 0; i < 8; ++i) ss += x[i] * x[i];
            ss += dpp_mov<0xB1, 0xF>(ss); ss += dpp_mov<0x4E, 0xF>(ss); ss += dpp_mov<0x141, 0xF>(ss);
            const float rstd = 1.f / sqrtf(ss * (1.f / 64.f) + EPS);
            float y[8];
#pragma unroll
            for (int i = 0; i < 8; ++i) { const float xn = x[i] * rstd * (which == 0 ? gq[i] : gk[i]); const float other = dpp_mov<0x4E, 0xF>(xn);
                y[i] = (s8 & 2) ? (xn * cs[i] + other * sn[i]) : (xn * cs[i] - other * sn[i]); }
            const float sc = which == 0 ? C2 : 1.f;
            v4u o; o.x = pk2(y[0] * sc, y[1] * sc); o.y = pk2(y[2] * sc, y[3] * sc); o.z = pk2(y[4] * sc, y[5] * sc); o.w = pk2(y[6] * sc, y[7] * sc);
            if (which == 0) *((GAS v4u*)(WSP(bf16, WS_QA) + (size_t)m * 512) + lane) = o;
            else if (lane < 16) *((GAS v4u*)(WSP(bf16, WS_KA) + (size_t)m * 128) + lane) = o;
        }
    }
}

__device__ __forceinline__ void phase_carry(const Ctx& C, int l) {
    if (C.vcu >= 32) return;
    const int b = C.vcu >> 3, g = (C.vcu & 7) * 4 + (C.wave >> 1), d = C.wave & 1, p = C.lane;
    const int li = ((l * 2 + d) * 32 + g) * 64 + p;
    const float re = C.in[I_LRE][li], im = C.in[I_LIM][li], dt = __expf(C.in[I_LDT][(l * 2 + d) * 32 + g]);
    const float mag = __expf(re * dt * 32.f), rev = im * dt * 32.f * 0.15915494309189535f; const float Lr = mag * cos_rev(rev), Li = mag * sin_rev(rev);
    const GAS f32x2* S = (const GAS f32x2*)(WSP(float, WS_SST) + (size_t)(b * NCH) * 8192 + g * 256 + d * 128) + p;
    GAS unsigned* X = (GAS unsigned*)(WSP(bf16, WS_XST) + (size_t)(b * NCH) * 8192 + g * 256 + d * 128) + p;
    float sr = 0.f, si = 0.f;
    if (d == 0) {
        for (int c0 = 0; c0 < NCH; c0 += 8) { f32x2 s[8];
#pragma unroll
            for (int k = 0; k < 8; ++k) s[k] = S[(size_t)(c0 + k) * 4096];
#pragma unroll
            for (int k = 0; k < 8; ++k) { X[(size_t)(c0 + k) * 4096] = pk2(sr, si); const float nr = Lr * sr - Li * si + s[k].x, ni = Lr * si + Li * sr + s[k].y; sr = nr; si = ni; } }
    } else {
        for (int seg = 0; seg < 33; ++seg) { const int chi = seg == 0 ? 7 : NCH - 1 - (seg - 1) * 8; f32x2 s[8];
#pragma unroll
            for (int k = 0; k < 8; ++k) s[k] = S[(size_t)(chi - k) * 4096];
#pragma unroll
            for (int k = 0; k < 8; ++k) { X[(size_t)(chi - k) * 4096] = pk2(sr, si); const float nr = Lr * sr - Li * si + s[k].x, ni = Lr * si + Li * sr + s[k].y; sr = nr; si = ni; } }
    }
}

__device__ __forceinline__ void phase_norm2(const Ctx& C, int l) {
    LAS float* RWt = (LAS float*)C.lds;
    LAS unsigned* REC = (LAS unsigned*)(C.lds + 65536);
    LAS float* LG = (LAS float*)(C.lds + 65536 + 16384);
    LAS unsigned* LCNT = (LAS unsigned*)(C.lds + 65536 + 32768);
    const int lane = C.lane, tid = C.tid;
    for (int i = tid; i < 16384; i += 512) { const int k = i >> 4, e = i & 15; RWt[e * 1024 + k] = C.in[I_RW][i]; }
    if (tid < 32) LCNT[tid] = 0u;
    __syncthreads();
    const float* MODl = WSP(float, WS_MOD) + (size_t)l * 5 * 6144;
    int nrows = 0; for (int m = C.vcu; m < T; m += C.G) ++nrows;
    f32x4 nx[4];
    if (C.wave < nrows) { const GAS f32x4* xr = (const GAS f32x4*)xs_row(C, C.vcu + C.G * C.wave) + lane;
#pragma unroll
        for (int q = 0; q < 4; ++q) nx[q] = xr[64 * q]; }
    for (int i = C.wave; i < nrows; i += NWAVES) {
        const int m = C.vcu + C.G * i, cond = cond_of(m);
        GAS unsigned* h8 = (GAS unsigned*)(WSP(unsigned char, WS_HB8) + (size_t)m * D) + lane; GAS v2u* ho = (GAS v2u*)(WSP(bf16, WS_HB) + (size_t)m * D) + lane;
        const GAS f32x4* ng = (const GAS f32x4*)(C.in[I_N2G] + l * D) + lane; const GAS f32x4* sh = (const GAS f32x4*)(MODl + cond * 6144 + 3072) + lane; const GAS f32x4* sc = (const GAS f32x4*)(MODl + cond * 6144 + 4096) + lane;
        f32x4 v[4]; float ss = 0.f;
#pragma unroll
        for (int q = 0; q < 4; ++q) { v[q] = nx[q]; ss += (v[q].x * v[q].x + v[q].y * v[q].y) + (v[q].z * v[q].z + v[q].w * v[q].w); }
        if (i + NWAVES < nrows) { const GAS f32x4* xr = (const GAS f32x4*)xs_row(C, m + C.G * NWAVES) + lane;
#pragma unroll
            for (int q = 0; q < 4; ++q) nx[q] = xr[64 * q]; }
        const float rstd = 1.f / sqrtf(wave_sum(ss, lane) * (1.f / D) + EPS);
        float lg[16];
#pragma unroll
        for (int e = 0; e < 16; ++e) lg[e] = 0.f;
#pragma unroll
        for (int q = 0; q < 4; ++q) { const f32x4 h = v[q] * rstd * ng[64 * q] * (sc[64 * q] + 1.f) + sh[64 * q]; if (FP8_MOE) h8[64 * q] = pk4_fp8(h.x, h.y, h.z, h.w); else ho[64 * q] = (v2u){pk2(h.x, h.y), pk2(h.z, h.w)};
#pragma unroll
            for (int e = 0; e < 16; ++e) { const f32x4 w = *(const LAS f32x4*)(RWt + e * 1024 + 256 * q + 4 * lane); lg[e] += (h.x * w.x + h.y * w.y) + (h.z * w.z + h.w * w.w); } }
        float mine = 0.f;
#pragma unroll
        for (int e = 0; e < 16; ++e) { const float t = wave_sum(lg[e], lane); mine = lane == e ? t : mine; }
        if (lane < 16) LG[i * 16 + lane] = mine;
    }
    __syncthreads();
    float rb[16];
#pragma unroll
    for (int e = 0; e < 16; ++e) rb[e] = C.in[I_RB][e];
    for (int i = tid; i < nrows; i += 512) {
        float lg[16];
#pragma unroll
        for (int q = 0; q < 4; ++q) { const f32x4 t = *(const LAS f32x4*)(LG + i * 16 + 4 * q); lg[4 * q] = t.x; lg[4 * q + 1] = t.y; lg[4 * q + 2] = t.z; lg[4 * q + 3] = t.w; }
        float mx = lg[0];
#pragma unroll
        for (int e = 1; e < 16; ++e) mx = fmaxf(mx, lg[e]);
        float pr[16], sel[16], sum = 0.f;
#pragma unroll
        for (int e = 0; e < 16; ++e) { pr[e] = __expf(lg[e] - mx); sum += pr[e]; }
        const float rs = 1.f / sum;
#pragma unroll
        for (int e = 0; e < 16; ++e) { pr[e] *= rs; sel[e] = pr[e] + rb[e]; }
        float bestv = -1e30f; int best = 0;
#pragma unroll
        for (int gq = 0; gq < 4; ++gq) { float m1 = -1e30f, m2 = -1e30f;
#pragma unroll
            for (int k = 0; k < 4; ++k) { const float s_ = sel[4 * gq + k]; if (s_ > m1) { m2 = m1; m1 = s_; } else if (s_ > m2) m2 = s_; }
            const float gs = m1 + m2; if (gs > bestv) { bestv = gs; best = gq; } }
        float s4[4], p4[4];
#pragma unroll
        for (int k = 0; k < 4; ++k) { s4[k] = best == 0 ? sel[k] : best == 1 ? sel[4 + k] : best == 2 ? sel[8 + k] : sel[12 + k]; p4[k] = best == 0 ? pr[k] : best == 1 ? pr[4 + k] : best == 2 ? pr[8 + k] : pr[12 + k]; }
        int i0 = 0; float v0 = s4[0], q0 = p4[0];
#pragma unroll
        for (int k = 1; k < 4; ++k) if (s4[k] > v0) { v0 = s4[k]; i0 = k; q0 = p4[k]; }
        int i1 = -1; float v1 = -1e30f, q1 = 0.f;
#pragma unroll
        for (int k = 0; k < 4; ++k) if (k != i0 && s4[k] > v1) { v1 = s4[k]; i1 = k; q1 = p4[k]; }
        const int e0 = 4 * best + i0, e1 = 4 * best + i1; const float wn = 1.f / (q0 + q1);
        const unsigned lp0 = atomicAdd((unsigned*)(LCNT + e0), 1u), lp1 = atomicAdd((unsigned*)(LCNT + e1), 1u);
        REC[i * 4 + 0] = (unsigned)e0 | ((unsigned)e1 << 8) | (lp0 << 16); REC[i * 4 + 1] = lp1; REC[i * 4 + 2] = __float_as_uint(q0 * wn); REC[i * 4 + 3] = __float_as_uint(q1 * wn);
    }
    __syncthreads();
    if (tid < 16) LCNT[16 + tid] = __hip_atomic_fetch_add((unsigned*)(C.ctl + CW_CNT + l * 1024 + 64 * tid), LCNT[tid], RLX_AGENT);
    __syncthreads();
    int* LIST = WSP(int, WS_LIST); float* RWG = WSP(float, WS_RW);
    for (int i = tid; i < nrows; i += 512) { const int m = C.vcu + C.G * i; const unsigned r0 = REC[i * 4], r1 = REC[i * 4 + 1];
        const int e0 = r0 & 255, e1 = (r0 >> 8) & 255; const unsigned lp0 = r0 >> 16, lp1 = r1;
        LIST[(size_t)e0 * T + LCNT[16 + e0] + lp0] = 2 * m; LIST[(size_t)e1 * T + LCNT[16 + e1] + lp1] = 2 * m + 1;
        RWG[2 * m] = __uint_as_float(REC[i * 4 + 2]); RWG[2 * m + 1] = __uint_as_float(REC[i * 4 + 3]); }
    __syncthreads();
}
using pg8::Unit;
typedef f32x4 Acc[2][2][4][2];
__device__ __forceinline__ v4u pack8(const f32x4& a, const f32x4& b) { v4u w; w.x = cvt_pk_bf16(a[0], a[1]); w.y = cvt_pk_bf16(a[2], a[3]); w.z = cvt_pk_bf16(b[0], b[1]); w.w = cvt_pk_bf16(b[2], b[3]); return w; }
__device__ __forceinline__ void unpack8(const v4u& w, f32x4& a, f32x4& b) { a = (f32x4){bflo(w.x), bfhi(w.x), bflo(w.y), bfhi(w.y)}; b = (f32x4){bflo(w.z), bfhi(w.z), bflo(w.w), bfhi(w.w)}; }
#ifndef WT_MODE
#define WT_MODE 0
#endif
__device__ __forceinline__ void st16(void* p, const v4u& v) {
#if WT_MODE == 1
    asm volatile("global_store_dwordx4 %0, %1, off sc0 sc1" :: "v"(p), "v"(v) : "memory");
#elif WT_MODE == 2
    asm volatile("global_store_dwordx4 %0, %1, off nt" :: "v"(p), "v"(v) : "memory");
#else
    *(GAS v4u*)p = v;
#endif
}
__device__ __forceinline__ int chunk_m0(int cr) { return (cr / NCH) * LB + (cr % NCH) * 32; }

struct PWin {
    static constexpr bool EARLY_AOFF = false, FP8 = false; unsigned char* ws; int G, c; int K; unsigned kstepA;
    __device__ __forceinline__ bool next(int i, Unit& u) const { const long L = (long)i * G + c; if (L >= NPAN * 11) return false; pg8::static_decode((int)L, NPAN, 11, u.pm, u.pn); u.z = 0; return true; }
    __device__ __forceinline__ const char* a_base(const Unit& u) const { return (const char*)(ws + WS_HB) + (size_t)u.pm * 256 * 1024 * 2; }
    __device__ __forceinline__ unsigned a_off(const Unit&, int h, int R, int Cc) const { return (unsigned)((h * 128 + R) * 1024 + Cc) * 2u; }
    __device__ __forceinline__ const char* b_base(const Unit& u) const { return (const char*)(ws + WS_WIN) + (size_t)u.pn * 256 * 1024 * 2; }
    __device__ __forceinline__ void epi(const Acc& acc, const Unit& u, int wr, int wc, int fr, int fq) const {
        const int row0 = u.pm * 256 + wr * 64 + fr;
#pragma unroll
        for (int bj = 0; bj < 2; ++bj) {
            const int cb = u.pn * 256 + bj * 128; bf16* dst; int ld, col, mode = 0; float sc = 1.f;
            if (cb < 512) { dst = (bf16*)(ws + WS_U) + ((size_t)((cb + wc * 32 + 8 * fq) >> 4) * T) * 16 + ((8 * fq) & 15) - (wc * 32 + 8 * fq); ld = 16; col = 0; }
            else if (cb < 1024) { dst = (bf16*)(ws + WS_QA); ld = 512; col = cb - 512; }
            else if (cb == 1024) { dst = (bf16*)(ws + WS_KA); ld = 128; col = 0; }
            else if (cb == 1152) { dst = (bf16*)(ws + WS_VA); ld = 128; col = 0; }
            else if (cb < 1792) { dst = (bf16*)(ws + WS_QN); ld = 512; col = cb - 1280; sc = C2; }
            else if (cb < 2304) { dst = (bf16*)(ws + WS_KN); ld = 512; col = cb - 1792; }
            else { dst = (bf16*)(ws + WS_VN); ld = 512; col = cb - 2304; }
            const int c0 = col + wc * 32 + 8 * fq;
#pragma unroll
            for (int ai = 0; ai < 2; ++ai)
#pragma unroll
                for (int m = 0; m < 4; ++m) { f32x4 v0 = acc[ai][bj][m][0], v1 = acc[ai][bj][m][1];
                    if (mode) { v0 = (f32x4){fsigmoid(v0[0]), fsigmoid(v0[1]), fsigmoid(v0[2]), fsigmoid(v0[3])}; v1 = (f32x4){fsigmoid(v1[0]), fsigmoid(v1[1]), fsigmoid(v1[2]), fsigmoid(v1[3])}; }
                    else { v0 = v0 * sc; v1 = v1 * sc; }
                    st16(dst + (size_t)(row0 + ai * 128 + m * 16) * ld + c0, pack8(v0, v1)); __builtin_amdgcn_sched_barrier(0); }
        }
    }
};

struct PGate {
    static constexpr bool EARLY_AOFF = false, FP8 = !GATE_BF16; unsigned char* ws; int G, c; int K; unsigned kstepA;
    __device__ __forceinline__ bool next(int i, Unit& u) const { const long L = (long)i * G + c; if (L >= 2 * NPAN * 12) return false; pg8::static_decode((int)L, 2 * NPAN, 12, u.pm, u.pn); u.z = 0; return true; }
    __device__ __forceinline__ const char* a_base(const Unit& u) const { return GATE_BF16 ? (const char*)(ws + WS_HB) + (size_t)u.pm * 128 * 2048 : (const char*)(ws + WS_HB8) + (size_t)u.pm * 128 * 1024; }
    __device__ __forceinline__ unsigned a_off(const Unit&, int R, int Cc) const { return GATE_BF16 ? (unsigned)(R * 2048 + Cc * 2) : (unsigned)(R * 1024 + Cc * 2); }
    __device__ __forceinline__ const char* b_base(const Unit& u) const { return GATE_BF16 ? (const char*)(ws + WS_WIN) + (size_t)(2816 + u.pn * 256) * 2048 : (const char*)(ws + WS_WIN8) + (size_t)u.pn * 256 * 1024; }
    __device__ __forceinline__ void epi(const f32x4 (&acc)[2][4][2], f32x4 (&)[2][4][2], const Unit& u, int wr, int wc, int fr, int fq) const {
#pragma unroll
        for (int m = 0; m < 4; ++m) { const size_t r = (size_t)(u.pm * 128 + wr * 64 + m * 16 + fr);
#pragma unroll
            for (int bj = 0; bj < 2; ++bj) { const int c0 = u.pn * 256 + bj * 128 + wc * 32 + 8 * fq; f32x4 v0 = acc[bj][m][0] * (GATE_BF16 ? 1.f : 1.f / 64.f), v1 = acc[bj][m][1] * (GATE_BF16 ? 1.f : 1.f / 64.f);
                v0 = (f32x4){fsigmoid(v0[0]), fsigmoid(v0[1]), fsigmoid(v0[2]), fsigmoid(v0[3])}; v1 = (f32x4){fsigmoid(v1[0]), fsigmoid(v1[1]), fsigmoid(v1[2]), fsigmoid(v1[3])};
                *(GAS v4u*)((bf16*)(ws + WS_GATES) + r * 3072 + c0) = pack8(v0, v1); }
            __builtin_amdgcn_sched_barrier(0); }
    }
};

struct PS5A {
    static constexpr bool EARLY_AOFF = false, FP8 = false; unsigned char* ws; int G, c; int K; unsigned kstepA;
    __device__ __forceinline__ bool next(int i, Unit& u) const { const long L = (long)i * G + c; if (L >= 32 * 15) return false; const int l = (int)L; u.z = l / 15; const int r = l % 15; u.pm = r / 3; u.pn = r % 3; return true; }
    __device__ __forceinline__ const char* a_base(const Unit& u) const { return (const char*)(ws + WS_U) + (size_t)u.z * T * 32; }
    __device__ __forceinline__ unsigned a_off(const Unit& u, int h, int R, int Cc) const { int cr = u.pm * 256 + h * 128 + R; cr = cr < NCR ? cr : NCR - 1; return (unsigned)(cr * 512 + Cc) * 2u; }
    __device__ __forceinline__ const char* b_base(const Unit& u) const { return (const char*)(ws + WS_BT1) + ((size_t)u.z * 768 + u.pn * 256) * 512 * 2; }
    __device__ __forceinline__ void epi(const Acc& acc, const Unit& u, int wr, int wc, int fr, int fq) const {
#pragma unroll
        for (int ai = 0; ai < 2; ++ai)
#pragma unroll
            for (int m = 0; m < 4; ++m) { const int cr = u.pm * 256 + ai * 128 + wr * 64 + m * 16 + fr; if (cr >= NCR) continue;
#pragma unroll
                for (int bj = 0; bj < 2; ++bj) { const int n = bj * 128 + wc * 32 + 8 * fq;
                    if (u.pn < 2) *(GAS v4u*)((bf16*)(ws + WS_YG) + (size_t)u.z * T * 16 + (size_t)cr * 512 + u.pn * 256 + n) = pack8(acc[ai][bj][m][0], acc[ai][bj][m][1]);
                    else { GAS f32x4* o = (GAS f32x4*)((float*)(ws + WS_SST) + (size_t)cr * 8192 + u.z * 256 + n); o[0] = acc[ai][bj][m][0]; o[1] = acc[ai][bj][m][1]; } }
                __builtin_amdgcn_sched_barrier(0); }
    }
};

struct PS5B {
    static constexpr bool EARLY_AOFF = false, FP8 = false; unsigned char* ws; int G, c; int K; unsigned kstepA;
    __device__ __forceinline__ bool next(int i, Unit& u) const { const long L = (long)i * G + c; if (L >= 32 * 10) return false; const int l = (int)L; u.z = l / 10; const int r = l % 10; u.pm = r / 2; u.pn = r % 2; return true; }
    __device__ __forceinline__ const char* a_base(const Unit& u) const { return (const char*)(ws + WS_XST) + (size_t)u.z * 512; }
    __device__ __forceinline__ unsigned a_off(const Unit& u, int h, int R, int Cc) const { int cr = u.pm * 256 + h * 128 + R; cr = cr < NCR ? cr : NCR - 1; return (unsigned)(cr * 8192 + Cc) * 2u; }
    __device__ __forceinline__ const char* b_base(const Unit& u) const { return (const char*)(ws + WS_BT2) + ((size_t)u.z * 512 + u.pn * 256) * 256 * 2; }
    __device__ __forceinline__ void epi(const Acc& acc, const Unit& u, int wr, int wc, int fr, int fq) const {
#pragma unroll
        for (int ai = 0; ai < 2; ++ai)
#pragma unroll
            for (int m = 0; m < 4; ++m) { const int cr = u.pm * 256 + ai * 128 + wr * 64 + m * 16 + fr; if (cr >= NCR) continue;
#pragma unroll
                for (int bj = 0; bj < 2; ++bj) { const int nn = u.pn * 256 + bj * 128 + wc * 32 + 8 * fq, t = nn >> 4, h0 = nn & 15;
                    GAS v4u* p = (GAS v4u*)((bf16*)(ws + WS_YS) + (size_t)(chunk_m0(cr) + t) * 512 + u.z * 16 + h0);
                    f32x4 y0, y1; { const v4u w_ = *(const GAS v4u*)((const bf16*)(ws + WS_YG) + (size_t)u.z * T * 16 + (size_t)cr * 512 + nn); unpack8(w_, y0, y1); } y0 += acc[ai][bj][m][0]; y1 += acc[ai][bj][m][1];
                    y0 = (f32x4){gelu_tanh(y0[0]), gelu_tanh(y0[1]), gelu_tanh(y0[2]), gelu_tanh(y0[3])}; y1 = (f32x4){gelu_tanh(y1[0]), gelu_tanh(y1[1]), gelu_tanh(y1[2]), gelu_tanh(y1[3])};
                    *p = pack8(y0, y1); }
                __builtin_amdgcn_sched_barrier(0); }
    }
};

__device__ __forceinline__ int half_panel(int hl, bool lat_only) { if (!lat_only) return hl; const int pl = hl >> 1; return 2 * (pl + (pl >> 5) + 1) + (hl & 1); }
struct PGlu {
    static constexpr bool EARLY_AOFF = false, FP8 = false; unsigned char* ws; int G, c; int K; unsigned kstepA; bool lat_only;
    __device__ __forceinline__ bool next(int i, Unit& u) const { const int nH = lat_only ? 256 : 2 * NPAN; const long L = (long)i * G + c; if (L >= nH * 2) return false; pg8::static_decode((int)L, nH, 2, u.pm, u.pn); u.pm = half_panel(u.pm, lat_only); u.z = 0; return true; }
    __device__ __forceinline__ const char* a_base(const Unit& u) const { return (const char*)(ws + WS_YS) + (size_t)u.pm * 128 * 512 * 2; }
    __device__ __forceinline__ unsigned a_off(const Unit&, int R, int Cc) const { return (unsigned)(R * 512 + Cc) * 2u; }
    __device__ __forceinline__ const char* b_base(const Unit& u) const { return (const char*)(ws + WS_WGLU) + (size_t)u.pn * 256 * 512 * 2; }
    __device__ __forceinline__ void epi(const f32x4 (&acc)[2][4][2], f32x4 (&)[2][4][2], const Unit& u, int wr, int wc, int fr, int fq) const {
#pragma unroll
        for (int m = 0; m < 4; ++m) { const size_t r = (size_t)(u.pm * 128 + wr * 64 + m * 16 + fr);
#pragma unroll
            for (int bj = 0; bj < 2; ++bj) { const int cc = u.pn * 256 + bj * 128 + wc * 32 + 8 * fq;
                f32x4 z0, z1; { const v4u w_ = *(const GAS v4u*)((const bf16*)(ws + WS_YS) + r * 512 + cc); unpack8(w_, z0, z1); } const f32x4 a0 = acc[bj][m][0], a1 = acc[bj][m][1];
                z0 = z0 * (f32x4){fsigmoid(a0[0]), fsigmoid(a0[1]), fsigmoid(a0[2]), fsigmoid(a0[3])}; z1 = z1 * (f32x4){fsigmoid(a1[0]), fsigmoid(a1[1]), fsigmoid(a1[2]), fsigmoid(a1[3])};
                *(GAS v4u*)((bf16*)(ws + WS_U) + r * 512 + cc) = pack8(z0, z1); }
            __builtin_amdgcn_sched_barrier(0); }
    }
};

typedef f32x4 Acc128[2][4][2];
struct PMerge {
    static constexpr bool EARLY_AOFF = false, FP8 = false; unsigned char* ws; int G, c; int K; unsigned kstepA; bool lat_only;
    __device__ __forceinline__ bool next(int i, Unit& u) const { const int nH = lat_only ? 256 : 2 * NPAN; const long tile = (long)(i / 3) * G + c; if (tile >= nH * 4) return false; pg8::static_decode((int)tile, nH, 4, u.pm, u.pn); u.pm = half_panel(u.pm, lat_only); u.z = i % 3; return true; }
    __device__ __forceinline__ const char* a_base(const Unit& u) const { const size_t off = u.z == 0 ? WS_U : (u.z == 1 ? WS_AO : WS_NO); return (const char*)(ws + off) + (size_t)u.pm * 128 * 512 * 2; }
    __device__ __forceinline__ unsigned a_off(const Unit&, int R, int Cc) const { return (unsigned)(R * 512 + Cc) * 2u; }
    __device__ __forceinline__ const char* b_base(const Unit& u) const { return (const char*)(ws + WS_WBR) + ((size_t)u.z * 1024 + u.pn * 256) * 512 * 2; }
    __device__ __forceinline__ void epi(const Acc128& acc, Acc128& mrg, const Unit& u, int wr, int wc, int fr, int fq) const {
#pragma unroll
        for (int m = 0; m < 4; ++m) { const size_t r = (size_t)(u.pm * 128 + wr * 64 + m * 16 + fr);
#pragma unroll
            for (int bj = 0; bj < 2; ++bj) { const int cc = u.pn * 256 + bj * 128 + wc * 32 + 8 * fq;
                f32x4 g0, g1; { const v4u w_ = *(const GAS v4u*)((const bf16*)(ws + WS_GATES) + r * 3072 + u.z * 1024 + cc); unpack8(w_, g0, g1); }
                if (u.z == 0) { mrg[bj][m][0] = g0 * acc[bj][m][0]; mrg[bj][m][1] = g1 * acc[bj][m][1]; }
                else { mrg[bj][m][0] += g0 * acc[bj][m][0]; mrg[bj][m][1] += g1 * acc[bj][m][1]; }
                if (u.z == 2) *(GAS v4u*)((bf16*)(ws + WS_HB) + r * 1024 + cc) = pack8(mrg[bj][m][0], mrg[bj][m][1]); } }
    }
};

struct PWout {
    static constexpr bool EARLY_AOFF = false, FP8 = false; unsigned char* ws; float* out; const float* mod; int G, c; int K; unsigned kstepA; bool lat_only;
    __device__ __forceinline__ bool next(int i, Unit& u) const { const int nH = lat_only ? 256 : 2 * NPAN; const long L = (long)i * G + c; if (L >= nH * 4) return false; pg8::static_decode((int)L, nH, 4, u.pm, u.pn); u.pm = half_panel(u.pm, lat_only); u.z = 0; return true; }
    __device__ __forceinline__ const char* a_base(const Unit& u) const { return (const char*)(ws + WS_HB) + (size_t)u.pm * 128 * 1024 * 2; }
    __device__ __forceinline__ unsigned a_off(const Unit&, int R, int Cc) const { return (unsigned)(R * 1024 + Cc) * 2u; }
    __device__ __forceinline__ const char* b_base(const Unit& u) const { return (const char*)(ws + WS_WOUT) + (size_t)u.pn * 256 * 1024 * 2; }
    __device__ __forceinline__ void epi(const f32x4 (&acc)[2][4][2], f32x4 (&)[2][4][2], const Unit& u, int wr, int wc, int fr, int fq) const {
        const int pm = u.pm >> 1, hh = u.pm & 1, b = pm / 33, pr = pm % 33, cond = pr == 0 ? 4 : b;
        float* xb = pr == 0 ? (float*)(ws + WS_CTXS) + ((size_t)b * 256 + hh * 128) * D : out + ((size_t)b * SEQ + (size_t)(pr - 1) * 256 + hh * 128) * D;
        const float* g1 = mod + cond * 6144 + 2048;
#pragma unroll
        for (int bj = 0; bj < 2; ++bj) { const int cc = u.pn * 256 + bj * 128 + wc * 32 + 8 * fq; const f32x4 ga = *(const GAS f32x4*)(g1 + cc), gb = *(const GAS f32x4*)(g1 + cc + 4);
#pragma unroll
            for (int m = 0; m < 4; ++m) { GAS f32x4* p = (GAS f32x4*)(xb + (size_t)(wr * 64 + m * 16 + fr) * D + cc);
                p[0] = p[0] + ga * acc[bj][m][0]; p[1] = p[1] + gb * acc[bj][m][1]; __builtin_amdgcn_sched_barrier(0); } }
    }
};

struct ExpTab { int cnt[16], tile0[17]; };
__device__ __forceinline__ int exp_find(const int (&tile0)[17], int q) { int e = 0;
#pragma unroll
    for (int k = 1; k < 16; ++k) e += (q >= tile0[k]) ? 1 : 0;
    return e; }

struct PMoe1 {
    static constexpr bool EARLY_AOFF = true, FP8 = true; unsigned char* ws; const LAS int* tab; int G, c; int K; unsigned kstepA;
    __device__ __forceinline__ bool next(int i, Unit& u) const { const long L = (long)i * G + c; const int total = __builtin_amdgcn_readfirstlane(tab[32]) * 4; if (L >= total) return false; const int q = (int)L >> 2; u.pn = (int)L & 3;
        int e = 0;
#pragma unroll
        for (int k = 1; k < 16; ++k) e += (q >= __builtin_amdgcn_readfirstlane(tab[16 + k])) ? 1 : 0;
        u.z = e; u.pm = q - __builtin_amdgcn_readfirstlane(tab[16 + e]); return true; }
    __device__ __forceinline__ const char* a_base(const Unit&) const { return (const char*)(ws + WS_HB8); }
    __device__ __forceinline__ unsigned a_off(const Unit& u, int R, int Cc) const { int r = u.pm * 128 + R; const int n = __builtin_amdgcn_readfirstlane(tab[u.z]); r = r < n ? r : n - 1;
        const int ent = ((const int*)(ws + WS_LIST))[(size_t)u.z * T + r]; return (unsigned)((ent >> 1) * 1024 + Cc * 2); }
    __device__ __forceinline__ const char* b_base(const Unit& u) const { return (const char*)(ws + WS_MOE1) + ((size_t)u.z * 1024 + u.pn * 256) * 1024; }
    __device__ __forceinline__ void epi(const f32x4 (&acc)[2][4][2], f32x4 (&)[2][4][2], const Unit& u, int wr, int wc, int fr, int fq) const {
        const size_t arow0 = (size_t)(__builtin_amdgcn_readfirstlane(tab[16 + u.z]) + u.pm) * 128;
#pragma unroll
        for (int m = 0; m < 4; ++m) { const f32x4 g0 = acc[0][m][0] * (1.f / 64.f), g1 = acc[0][m][1] * (1.f / 64.f), u0 = acc[1][m][0] * (8.f / 64.f), u1 = acc[1][m][1] * (8.f / 64.f);
            const f32x4 v0 = (f32x4){g0[0] * fsigmoid(g0[0]), g0[1] * fsigmoid(g0[1]), g0[2] * fsigmoid(g0[2]), g0[3] * fsigmoid(g0[3])} * u0;
            const f32x4 v1 = (f32x4){g1[0] * fsigmoid(g1[0]), g1[1] * fsigmoid(g1[1]), g1[2] * fsigmoid(g1[2]), g1[3] * fsigmoid(g1[3])} * u1;
            *(GAS v2u*)((unsigned char*)(ws + WS_ACT) + (arow0 + wr * 64 + m * 16 + fr) * 512 + u.pn * 128 + wc * 32 + 8 * fq) = (v2u){pk4_fp8(v0[0], v0[1], v0[2], v0[3]), pk4_fp8(v1[0], v1[1], v1[2], v1[3])}; }
    }
};
struct PMoe2 {
    static constexpr bool EARLY_AOFF = false, FP8 = true; unsigned char* ws; const LAS int* tab; int G, c; int K; unsigned kstepA;
    __device__ __forceinline__ bool next(int i, Unit& u) const { const long L = (long)i * G + c; const int total = __builtin_amdgcn_readfirstlane(tab[32]) * 4; if (L >= total) return false; const int q = (int)L >> 2; u.pn = (int)L & 3;
        int e = 0;
#pragma unroll
        for (int k = 1; k < 16; ++k) e += (q >= __builtin_amdgcn_readfirstlane(tab[16 + k])) ? 1 : 0;
        u.z = e; u.pm = q - __builtin_amdgcn_readfirstlane(tab[16 + e]); return true; }
    __device__ __forceinline__ const char* a_base(const Unit& u) const { return (const char*)(ws + WS_ACT) + (size_t)(__builtin_amdgcn_readfirstlane(tab[16 + u.z]) + u.pm) * 128 * 512; }
    __device__ __forceinline__ unsigned a_off(const Unit&, int R, int Cc) const { return (unsigned)(R * 512 + Cc * 2); }
    __device__ __forceinline__ const char* b_base(const Unit& u) const { return (const char*)(ws + WS_MOE2) + ((size_t)u.z * 1024 + u.pn * 256) * 512; }
    __device__ __forceinline__ void epi(const f32x4 (&acc)[2][4][2], f32x4 (&)[2][4][2], const Unit& u, int wr, int wc, int fr, int fq) const {
        const int n = __builtin_amdgcn_readfirstlane(tab[u.z]);
#pragma unroll
        for (int m = 0; m < 4; ++m) { const int r = u.pm * 128 + wr * 64 + m * 16 + fr; if (r >= n) continue;
            const int ent = ((const int*)(ws + WS_LIST))[(size_t)u.z * T + r]; const float w = ((const float*)(ws + WS_RW))[ent] * (1.f / 256.f);
#pragma unroll
            for (int bj = 0; bj < 2; ++bj)
                *(GAS v4u*)((bf16*)(ws + WS_YSLOT) + (size_t)ent * 1024 + u.pn * 256 + bj * 128 + wc * 32 + 8 * fq) = pack8(acc[bj][m][0] * w, acc[bj][m][1] * w); }
    }
};
struct PMoe1B {
    static constexpr bool EARLY_AOFF = true, FP8 = false; unsigned char* ws; const LAS int* tab; int G, c; int K; unsigned kstepA;
    __device__ __forceinline__ bool next(int i, Unit& u) const { const long L = (long)i * G + c; const int total = tab[32] * 4; if (L >= total) return false; const int q = (int)L >> 2; u.pn = (int)L & 3;
        int e = 0;
#pragma unroll
        for (int k = 1; k < 16; ++k) e += (q >= tab[16 + k]) ? 1 : 0;
        u.z = e; u.pm = q - tab[16 + e]; return true; }
    __device__ __forceinline__ const char* a_base(const Unit&) const { return (const char*)(ws + WS_HB); }
    __device__ __forceinline__ unsigned a_off(const Unit& u, int h, int R, int Cc) const { int r = u.pm * 256 + h * 128 + R; const int n = tab[u.z]; r = r < n ? r : n - 1;
        const int ent = ((const int*)(ws + WS_LIST))[(size_t)u.z * T + r]; return (unsigned)((ent >> 1) * 1024 + Cc) * 2u; }
    __device__ __forceinline__ const char* b_base(const Unit& u) const { return (const char*)(ws + WS_MOE1) + ((size_t)u.z * 1024 + u.pn * 256) * 1024 * 2; }
    __device__ __forceinline__ void epi(const Acc& acc, const Unit& u, int wr, int wc, int fr, int fq) const {
        const size_t arow0 = (size_t)(tab[16 + u.z] + u.pm) * 256;
#pragma unroll
        for (int ai = 0; ai < 2; ++ai)
#pragma unroll
            for (int m = 0; m < 4; ++m) { const f32x4 g0 = acc[ai][0][m][0], g1 = acc[ai][0][m][1], u0 = acc[ai][1][m][0], u1 = acc[ai][1][m][1];
                const f32x4 v0 = (f32x4){g0[0] * fsigmoid(g0[0]), g0[1] * fsigmoid(g0[1]), g0[2] * fsigmoid(g0[2]), g0[3] * fsigmoid(g0[3])} * u0;
                const f32x4 v1 = (f32x4){g1[0] * fsigmoid(g1[0]), g1[1] * fsigmoid(g1[1]), g1[2] * fsigmoid(g1[2]), g1[3] * fsigmoid(g1[3])} * u1;
                *(GAS v4u*)((bf16*)(ws + WS_ACTB) + (arow0 + ai * 128 + wr * 64 + m * 16 + fr) * 512 + u.pn * 128 + wc * 32 + 8 * fq) = pack8(v0, v1); }
    }
};
struct PMoe2B {
    static constexpr bool EARLY_AOFF = false, FP8 = false; unsigned char* ws; const LAS int* tab; int G, c; int K; unsigned kstepA;
    __device__ __forceinline__ bool next(int i, Unit& u) const { const long L = (long)i * G + c; const int total = tab[32] * 4; if (L >= total) return false; const int q = (int)L >> 2; u.pn = (int)L & 3;
        int e = 0;
#pragma unroll
        for (int k = 1; k < 16; ++k) e += (q >= tab[16 + k]) ? 1 : 0;
        u.z = e; u.pm = q - tab[16 + e]; return true; }
    __device__ __forceinline__ const char* a_base(const Unit& u) const { return (const char*)(ws + WS_ACTB) + (size_t)(tab[16 + u.z] + u.pm) * 256 * 512 * 2; }
    __device__ __forceinline__ unsigned a_off(const Unit&, int h, int R, int Cc) const { return (unsigned)((h * 128 + R) * 512 + Cc) * 2u; }
    __device__ __forceinline__ const char* b_base(const Unit& u) const { return (const char*)(ws + WS_MOE2) + ((size_t)u.z * 1024 + u.pn * 256) * 512 * 2; }
    __device__ __forceinline__ void epi(const Acc& acc, const Unit& u, int wr, int wc, int fr, int fq) const {
        const int n = tab[u.z];
#pragma unroll
        for (int ai = 0; ai < 2; ++ai)
#pragma unroll
            for (int m = 0; m < 4; ++m) { const int r = u.pm * 256 + ai * 128 + wr * 64 + m * 16 + fr; if (r >= n) continue;
                const int ent = ((const int*)(ws + WS_LIST))[(size_t)u.z * T + r]; const float w = ((const float*)(ws + WS_RW))[ent];
#pragma unroll
                for (int bj = 0; bj < 2; ++bj)
                    *(GAS v4u*)((bf16*)(ws + WS_YSLOT) + (size_t)ent * 1024 + u.pn * 256 + bj * 128 + wc * 32 + 8 * fq) = pack8(acc[ai][bj][m][0] * w, acc[ai][bj][m][1] * w); }
    }
};
__device__ __forceinline__ void build_exptab(const Ctx& C, LAS int* tab, int l, int tsh = 7) {
    __syncthreads();
    if (threadIdx.x == 0) { int t0 = 0;
        for (int e = 0; e < 16; ++e) { const int n = (int)__hip_atomic_load((unsigned*)(C.ctl + CW_CNT + l * 1024 + 64 * e), RLX_AGENT); tab[e] = n; tab[16 + e] = t0; t0 += (n + (1 << tsh) - 1) >> tsh; }
        tab[32] = t0; }
    __syncthreads();
}
__device__ __forceinline__ void phase_attn(const Ctx& C, int l, unsigned char* lds_gen) {
    phase_carry(C, l);
    char* shm = (char*)lds_gen;
    bf16* QA = WSP(bf16, WS_QA); bf16* KA = WSP(bf16, WS_KA); bf16* VA = WSP(bf16, WS_VA); bf16* QN = WSP(bf16, WS_QN); bf16* KN = WSP(bf16, WS_KN); bf16* VN = WSP(bf16, WS_VN);
#ifndef ATTN_SEL
#define ATTN_SEL 3
#endif
#ifdef REPMASK
#define REPMASK_ REPMASK
#else
#define REPMASK_ 0
#endif
    const int per = (1024 + C.G - 1) / C.G;
    if (ATTN_SEL & 1) for (int i = 0; i < per * (1 + ((REPMASK_ >> 13) & 1)); ++i) { const int id = C.vcu * per + (i % per); if (id >= 1024) continue; const int bh = id >> 5, b = bh >> 3, h = bh & 7, qb = id & 31;
        const bf16* Qu = QA + (size_t)(b * LB + CTX + qb * 256) * 512 + h * 64;
        attn_body::attn_unit<8, false, 512, 128>(Qu, 512, KA + (size_t)(b * LB) * 128 + (h >> 2) * 64, VA + (size_t)(b * LB) * 128 + (h >> 2) * 64, 128, WSP(bf16, WS_AO) + (Qu - QA), LB / 64, 0, 0, shm);
    }
    LAS float* bt = (LAS float*)(C.lds + attn_body::LDS_BT);
    const int nctx = (C.vcu >= 64 && C.vcu < 128) ? 1 : 0;
    if (ATTN_SEL & 2) for (int i0 = 0; i0 < (per + nctx) * (1 + ((REPMASK_ >> 14) & 1)); ++i0) { const int i = i0 % (per + nctx);
        const bf16 *Qu, *Kh, *Vh; bf16* Ou; int kvp = 512, NT = 4, r0 = 0, rlo = 0;
        if (i < per) { const int id = C.vcu * per + i; if (id >= 1024) continue; const int bh = id >> 5, b = bh >> 3, h = bh & 7; r0 = (id & 31) * 4;
            const float* rp = C.in[I_RPB] + (size_t)(l * 8 + h) * 465;
            for (int k = C.tid; k < 465; k += 512) bt[k] = rp[k] * LOG2E;
            rlo = r0 - 4 < 0 ? 0 : (r0 - 4 > 120 ? 120 : r0 - 4); const int rh_ = r0 - 1 < 0 ? 0 : (r0 - 1 > 120 ? 120 : r0 - 1), nloc = rh_ + 8 - rlo; NT = (4 + nloc + 1) & ~1;
            Qu = QN + (size_t)(b * LB + CTX + r0 * 64) * 512 + h * 64; Ou = WSP(bf16, WS_NO) + (Qu - QN); Kh = KN + (size_t)(b * LB) * 512 + h * 64; Vh = VN + (size_t)(b * LB) * 512 + h * 64; }
        else { int j = C.vcu - 64; if (j < 32) { const int b = j >> 3, h = j & 7; Qu = QA + (size_t)(b * LB) * 512 + h * 64; Ou = WSP(bf16, WS_AO) + (Qu - QA); Kh = KA + (size_t)(b * LB) * 128 + (h >> 2) * 64; Vh = VA + (size_t)(b * LB) * 128 + (h >> 2) * 64; kvp = 128; }
            else { j -= 32; const int b = j >> 3, h = j & 7; Qu = QN + (size_t)(b * LB) * 512 + h * 64; Ou = WSP(bf16, WS_NO) + (Qu - QN); Kh = KN + (size_t)(b * LB) * 512 + h * 64; Vh = VN + (size_t)(b * LB) * 512 + h * 64; } }
        attn_body::attn_unit<8, true, 512, 0>(Qu, 512, Kh, Vh, kvp, Ou, NT, r0, rlo, shm);
    }
}

constexpr int NPH = 46;
__global__ void __launch_bounds__(NWAVES * 64, 2) fwd(Args args) {
    extern __shared__ __attribute__((aligned(16))) unsigned char lds[];
    Ctx C; C.in = (const __attribute__((address_space(4))) CFP*)__builtin_amdgcn_kernarg_segment_ptr(); C.out = args.out; C.ws = args.ws; C.lds = (LAS unsigned char*)lds; C.ctl = (gu32*)(args.ws + WS_CTL);
    C.tid = 0; C.lane = 0; C.wave = __builtin_amdgcn_readfirstlane((int)threadIdx.x >> 6);
    C.G = gridDim.x; { const int bx = blockIdx.x; C.vcu = (C.G % 8 == 0) ? (bx % 8) * (C.G / 8) + bx / 8 : bx; }
    for (int u = threadIdx.x; u < (LDS_BYTES - LDSCTL_OFF) / 4; u += NWAVES * 64) ((LAS unsigned*)(C.lds + LDSCTL_OFF))[u] = 0u;
    __syncthreads();
    const int lo = args.ph_lo, hi = args.ph_hi;
    XcdBarrier bar; bar.bar = (unsigned*)(C.ctl + CW_BAR); bar.x = 0; bar.st = nullptr;
    if (hi - lo > 1) bar = xcd_barrier_post((unsigned*)(C.ctl + CW_BAR), (volatile LAS unsigned*)(C.lds + MISC_OFF) + 8);
    LAS int* tab = (LAS int*)(C.lds + LDSCTL_OFF);
    const int cg = (int)blockIdx.x;
#ifndef PHMASK
#define PHMASK 0xFFFF
#endif
#define IN(k) (lo <= (k) && (k) < hi)
#define EN(b) ((PHMASK >> (b)) & 1)
#ifndef REPMASK
#define REPMASK 0
#endif
#define RUN(b, stmt) do { stmt; if ((REPMASK >> (b)) & 1) { stmt; } } while (0)
#ifdef DIAG_SEL
#define DIAG_ACC(ty) do { if (blockIdx.x == 0 && threadIdx.x == 0) { volatile LAS unsigned* dg = (volatile LAS unsigned*)(C.lds + LDSCTL_OFF + 160); const unsigned now = (unsigned)__builtin_amdgcn_s_memrealtime(); dg[8 + (ty)] += now - dg[0]; dg[0] = now; } } while (0)
#else
#define DIAG_ACC(ty) do {} while (0)
#endif
#define SEAM(k) do { if (IN(k) && IN((k) + 1)) xcd_barrier(bar); DIAG_ACC((k) == 0 ? 11 : ((k) - 1) % 11); } while (0)
#define LWS() ({ const __attribute__((address_space(4))) CFP* k_ = C.in; asm volatile("" : "+s"(k_)); (unsigned char*)k_[30]; })
#define LC() ({ Ctx c_ = C; c_.tid = threadIdx.x; asm volatile("" : "+v"(c_.tid)); c_.lane = c_.tid & 63; asm volatile("" : "+s"(c_.in)); c_.ws = (unsigned char*)c_.in[30]; c_.out = (float*)c_.in[29]; c_.ctl = (gu32*)(c_.ws + WS_CTL); c_; })
#ifdef DIAG_SEL
    if (blockIdx.x == 0 && threadIdx.x == 0) { volatile LAS unsigned* dg = (volatile LAS unsigned*)(C.lds + LDSCTL_OFF + 160); dg[0] = (unsigned)__builtin_amdgcn_s_memrealtime(); dg[1] = dg[0]; }
#endif
    if (EN(11) && IN(0)) { const Ctx Cl = LC(); phase_mod(Cl); RUN(11, phase_s5mats(Cl, 0); phase_weights(Cl, 0)); }
    SEAM(0);
    for (int l = 0; l < NLAYER; ++l) {
        const int pb = 1 + 11 * l;
        if (EN(0) && IN(pb)) { const Ctx Cl = LC(); if (l == 0) phase_rows<0>(Cl, 0); else { phase_s5mats(Cl, l); phase_weights(Cl, l); phase_rows<1>(Cl, l); } }
        SEAM(pb);
        if (EN(1) && IN(pb + 1)) { { PWin P{LWS(), C.G, cg, 1024, 128u}; pg8::gemm_phase(C.lds, P); } { PGate P{LWS(), C.G, cg, 1024, 128u}; pg8::gemm_phase_m128(C.lds, P); } }
        SEAM(pb + 1);
        if (EN(2) && IN(pb + 2)) { { const Ctx Cl = LC(); phase_qkprep(Cl, l); } PS5A P{LWS(), C.G, cg, 512, 128u}; RUN(2, pg8::gemm_phase(C.lds, P)); }
        SEAM(pb + 2);
        if (EN(3) && IN(pb + 3)) { const Ctx Cl = LC(); RUN(3, phase_attn(Cl, l, lds)); }
        SEAM(pb + 3);
        if (EN(4) && IN(pb + 4)) { PS5B P{LWS(), C.G, cg, 256, 128u}; pg8::gemm_phase(C.lds, P); }
        SEAM(pb + 4);
        if (EN(5) && IN(pb + 5)) { PGlu P{LWS(), C.G, cg, 512, 128u, l == NLAYER - 1}; pg8::gemm_phase_m128(C.lds, P); }
        SEAM(pb + 5);
        if (EN(6) && IN(pb + 6)) { PMerge P{LWS(), C.G, cg, 512, 128u, l == NLAYER - 1}; pg8::gemm_phase_m128(C.lds, P); }
        SEAM(pb + 6);
        if (EN(7) && IN(pb + 7)) { unsigned char* wl_ = LWS(); PWout P{wl_, (float*)C.in[29], (const float*)(wl_ + WS_MOD) + (size_t)l * 5 * 6144, C.G, cg, 1024, 128u, l == NLAYER - 1}; pg8::gemm_phase_m128(C.lds, P); }
        SEAM(pb + 7);
        if (EN(8) && IN(pb + 8)) { const Ctx Cl = LC(); phase_norm2(Cl, l); }
        SEAM(pb + 8);
        if (EN(9) && IN(pb + 9)) { if (FP8_MOE) { build_exptab(C, tab, l); PMoe1 P{LWS(), tab, C.G, cg, 1024, 128u}; pg8::gemm_phase_m128(C.lds, P); } else { build_exptab(C, tab, l, 8); PMoe1B P{LWS(), tab, C.G, cg, 1024, 128u}; pg8::gemm_phase(C.lds, P); } }
        SEAM(pb + 9);
        if (EN(10) && IN(pb + 10)) { if (FP8_MOE) { build_exptab(C, tab, l); PMoe2 P{LWS(), tab, C.G, cg, 512, 128u}; pg8::gemm_phase_m128(C.lds, P); } else { build_exptab(C, tab, l, 8); PMoe2B P{LWS(), tab, C.G, cg, 512, 128u}; pg8::gemm_phase(C.lds, P); } }
        SEAM(pb + 10);
    }
    if (EN(12) && IN(NPH - 1)) { const Ctx Cl = LC(); phase_rows<2>(Cl, NLAYER); }
#ifdef DIAG_SEL
    xcd_barrier(bar); DIAG_ACC(12);
    if (blockIdx.x == 0 && threadIdx.x == 0) { volatile LAS unsigned* dg = (volatile LAS unsigned*)(C.lds + LDSCTL_OFF + 160); dg[8 + 13] = dg[0] - dg[1];
        for (int i = 0; i < 14; ++i) __hip_atomic_store(C.ctl + 2048 + i, dg[8 + i], RLX_AGENT); }
    xcd_barrier(bar);
    { const float d1 = (float)__hip_atomic_load(C.ctl + 2048 + (DIAG_SEL), RLX_AGENT) * 0.01f, d2 = (float)__hip_atomic_load(C.ctl + 2048 + (DIAG_SEL) + 1, RLX_AGENT) * 0.01f;
      const float c1 = sqrtf(d1); float* o = args.out;
      for (size_t i = (size_t)blockIdx.x * 512 + threadIdx.x; i < (size_t)NB * SEQ * D; i += (size_t)gridDim.x * 512) o[i] = (i == 12345) ? d2 : c1; }
#endif
#undef IN
#undef SEAM
}

#ifndef MK_PER_PHASE
#define MK_PER_PHASE 0
#endif
extern "C" void kernel_launch(void* const* d_in, const int* in_sizes, int n_in, void* d_out, int out_size, void* d_ws, size_t ws_size, hipStream_t stream) {
    static int grid = 0;
    if (grid == 0) {
        if (n_in != 29 || out_size != NB * SEQ * D || ws_size < WS_END) { fprintf(stderr, "kernel_launch: unexpected shapes (n_in %d out %d ws %zu)\n", n_in, out_size, ws_size); grid = -1; return; }
        int dev = 0, cus = 0, per_cu = 0;
        if (hipGetDevice(&dev) != hipSuccess || hipDeviceGetAttribute(&cus, hipDeviceAttributeMultiprocessorCount, dev) != hipSuccess) { grid = -1; return; }
        if (hipFuncSetAttribute((const void*)fwd, hipFuncAttributeMaxDynamicSharedMemorySize, LDS_BYTES) != hipSuccess) { grid = -1; return; }
        if (hipOccupancyMaxActiveBlocksPerMultiprocessor(&per_cu, (const void*)fwd, NWAVES * 64, LDS_BYTES) != hipSuccess || per_cu < 1) fprintf(stderr, "kernel_launch: occupancy query says %d\n", per_cu);
        (void)hipGetLastError();
        grid = cus;
    }
    if (grid < 0) return;
    (void)hipMemsetAsync((char*)d_ws + WS_CTL, 0, CTL_ZERO_BYTES, stream);
    Args a{};
    for (int i = 0; i < 29; ++i) a.in[i] = (const float*)d_in[i];
    a.out = (float*)d_out; a.ws = (unsigned char*)d_ws;
#if MK_PER_PHASE
    for (int p = 0; p < NPH; ++p) { a.ph_lo = p; a.ph_hi = p + 1; hipLaunchKernelGGL(fwd, dim3(grid), dim3(NWAVES * 64), LDS_BYTES, stream, a); }
#else
    a.ph_lo = 0; a.ph_hi = NPH; hipLaunchKernelGGL(fwd, dim3(grid), dim3(NWAVES * 64), LDS_BYTES, stream, a);
#endif
}
```

```cpp
#define FP8_MOE 1
#define GATE_BF16 0
#define H8_WRITE 1
#ifndef H8_WRITE
#define H8_WRITE 1
#endif
#ifndef GATE_BF16
#define GATE_BF16 0
#endif
#include <hip/hip_runtime.h>
#include <cstdio>
#include <cstdint>

#define GAS __attribute__((address_space(1)))
#define LAS __attribute__((address_space(3)))
typedef unsigned short bf16;
typedef unsigned v4u __attribute__((ext_vector_type(4)));
typedef unsigned v2u __attribute__((ext_vector_type(2)));
typedef float f32x4 __attribute__((ext_vector_type(4)));
typedef float f32x2 __attribute__((ext_vector_type(2)));
typedef float f32x16 __attribute__((ext_vector_type(16)));
typedef short bf16x8 __attribute__((ext_vector_type(8)));
typedef short s16x4 __attribute__((ext_vector_type(4)));
typedef GAS unsigned gu32;
#define RLX_AGENT __ATOMIC_RELAXED, __HIP_MEMORY_SCOPE_AGENT
#define LDS_WAIT() asm volatile("s_waitcnt lgkmcnt(0)" ::: "memory")
#define VM_WAIT() asm volatile("s_waitcnt vmcnt(0)" ::: "memory")

constexpr int NB = 4, SEQ = 8192, CTX = 256, LB = SEQ + CTX, T = NB * LB, D = 1024, NPAN = T / 256;
constexpr int NLAYER = 4, INW = 5888, NCH = LB / 32, NCR = NB * NCH;
constexpr int NEXP = 16, FF = 512;
constexpr float EPS = 1e-6f;
constexpr float LOG2E = 1.4426950408889634f;
constexpr float C2 = 0.125f * LOG2E;
constexpr int NWAVES = 8;

constexpr size_t MiB = 1u << 20;
constexpr size_t WS_CTL = 0, CTL_ZERO_BYTES = 1 * MiB;
constexpr size_t WS_MOD = 1 * MiB;
constexpr size_t WS_LIST = 2 * MiB;
constexpr size_t WS_RW = 5 * MiB;
constexpr size_t WS_CTXS = 6 * MiB;
constexpr size_t WS_SST = 10 * MiB;
constexpr size_t WS_HB8 = WS_SST;
constexpr size_t WS_XST = 44 * MiB;
constexpr size_t WS_BT1 = 61 * MiB;
constexpr size_t WS_BT2 = 85 * MiB;
constexpr size_t WS_WIN = 93 * MiB;
constexpr size_t WS_WIN8 = WS_WIN + (size_t)2816 * 1024 * 2;
constexpr size_t WS_WGLU = 105 * MiB;
constexpr size_t WS_WBR = 106 * MiB;
constexpr size_t WS_WOUT = 109 * MiB;
constexpr size_t WS_MOE1 = 111 * MiB;
constexpr size_t WS_MOE2 = 143 * MiB;
constexpr size_t WS_HB = 159 * MiB;
constexpr size_t WS_U = 225 * MiB;
constexpr size_t WS_QA = 258 * MiB;
constexpr size_t WS_KA = 291 * MiB;
constexpr size_t WS_VA = 300 * MiB;
constexpr size_t WS_QN = 309 * MiB;
constexpr size_t WS_KN = 342 * MiB;
constexpr size_t WS_VN = 375 * MiB;
constexpr size_t WS_YS = 408 * MiB;
constexpr size_t WS_GATES = 441 * MiB;
constexpr size_t WS_ACT = WS_QN;
constexpr size_t WS_ACTB = WS_QN;
constexpr size_t WS_YSLOT = WS_GATES;
constexpr size_t WS_AO = 640 * MiB;
constexpr size_t WS_NO = 673 * MiB;
constexpr size_t WS_YG = 706 * MiB;
constexpr size_t WS_END = 739 * MiB;
static_assert(WS_GATES + (size_t)T * 3072 * 2 <= WS_AO && WS_ACT + (size_t)(2 * T + 4096) * 512 * 2 <= WS_YS, "ws map");
constexpr int CW_FAIL = 8;
constexpr int CW_CNT = 64;
constexpr int CW_BAR = 8192;

constexpr int RING_BYTES = 131072, LDS_BYTES = 147456, LDSCTL_OFF = LDS_BYTES - 512, MISC_OFF = LDSCTL_OFF + 320;

__device__ __forceinline__ unsigned f2bf(float f) { unsigned u = __builtin_bit_cast(unsigned, f); return (u + 0x7fffu + ((u >> 16) & 1u)) >> 16; }
__device__ __forceinline__ unsigned pk2(float lo, float hi) { return f2bf(lo) | (f2bf(hi) << 16); }
__device__ __forceinline__ float bf2f(unsigned b) { return __builtin_bit_cast(float, b << 16); }
__device__ __forceinline__ float bflo(unsigned w) { return __builtin_bit_cast(float, w << 16); }
__device__ __forceinline__ float bfhi(unsigned w) { return __builtin_bit_cast(float, w & 0xffff0000u); }
typedef float f32x2_c __attribute__((ext_vector_type(2))); typedef __bf16 bf16x2_c __attribute__((ext_vector_type(2)));
__device__ __forceinline__ unsigned cvt_pk_bf16(float lo, float hi) { const f32x2_c v = {lo, hi}; return __builtin_bit_cast(unsigned, __builtin_convertvector(v, bf16x2_c)); }
typedef int v8i __attribute__((ext_vector_type(8)));
typedef int v4i __attribute__((ext_vector_type(4)));
__device__ __forceinline__ float clamp8(float x) { return __builtin_fminf(__builtin_fmaxf(x, -448.f), 448.f); }
__device__ __forceinline__ unsigned pk4_fp8(float a, float b, float c, float d) { int w = 0; w = __builtin_amdgcn_cvt_pk_fp8_f32(clamp8(a), clamp8(b), w, false); w = __builtin_amdgcn_cvt_pk_fp8_f32(clamp8(c), clamp8(d), w, true); return (unsigned)w; }
__device__ __forceinline__ float fsigmoid(float x) { return __builtin_amdgcn_rcpf(1.f + __builtin_amdgcn_exp2f(-LOG2E * x)); }
__device__ __forceinline__ float gelu_tanh(float x) { const float u = 0.7978845608f * (x + 0.044715f * x * x * x); return x * __builtin_amdgcn_rcpf(1.f + __builtin_amdgcn_exp2f(-2.f * LOG2E * u)); }
__device__ __forceinline__ float shflx(float v, int m, int lane) { return __builtin_bit_cast(float, __builtin_amdgcn_ds_bpermute((lane ^ m) << 2, __builtin_bit_cast(int, v))); }
template <int CTRL, int RM>
__device__ __forceinline__ float dpp_mov(float v) { return __builtin_bit_cast(float, __builtin_amdgcn_update_dpp(0, __builtin_bit_cast(int, v), CTRL, RM, 0xF, true)); }
__device__ __forceinline__ float wave_sum(float v, int) {
    v += dpp_mov<0xB1, 0xF>(v);
    v += dpp_mov<0x4E, 0xF>(v);
    v += dpp_mov<0x141, 0xF>(v);
    v += dpp_mov<0x140, 0xF>(v);
    v += dpp_mov<0x142, 0xA>(v);
    v += dpp_mov<0x143, 0xC>(v);
    return __builtin_bit_cast(float, __builtin_amdgcn_readlane(__builtin_bit_cast(int, v), 63));
}
__device__ __forceinline__ float sin_rev(float r) { r = r - floorf(r); return __builtin_amdgcn_sinf(r); }
__device__ __forceinline__ float cos_rev(float r) { r = r - floorf(r); return __builtin_amdgcn_cosf(r); }

#define XB_TMO      128
#define XB_XCNT(j)  (256  + 64 * (j))
#define XB_XSUB(j)  (1280 + 64 * (j))
#define XB_XGEN(j)  (2304 + 64 * (j))
#define XB_TOP      3328
#define XB_TOPGEN   3392
#define XCD_BAR_WORDS 3456
#define XB_SPIN_CAP (1u << 22)

__device__ __forceinline__ unsigned xb_ld(unsigned* p)              { return __hip_atomic_load(p, __ATOMIC_RELAXED, __HIP_MEMORY_SCOPE_AGENT); }
__device__ __forceinline__ unsigned xb_add(unsigned* p, unsigned v) { return __hip_atomic_fetch_add(p, v, __ATOMIC_RELAXED, __HIP_MEMORY_SCOPE_AGENT); }
__device__ __forceinline__ unsigned xb_xcc_id() { return (unsigned)__builtin_amdgcn_s_getreg((3 << 11) | 20) & 0xFu; }
#define XB_SPIN(cond, bar) do { unsigned _sp = 0; while (cond) { __builtin_amdgcn_s_sleep(1); \
    if ((++_sp & 255u) == 0u) { if (xb_ld(&(bar)[XB_TMO])) break; if (_sp > XB_SPIN_CAP) { atomicAdd(&(bar)[XB_TMO], 1u); break; } } } } while (0)

struct XcdBarrier { unsigned* bar; unsigned x; volatile LAS unsigned* st; };

__device__ __forceinline__ XcdBarrier xcd_barrier_post(unsigned* bar, volatile LAS unsigned* st) {
    XcdBarrier b; b.bar = bar; b.x = xb_xcc_id(); b.st = st;
    if (threadIdx.x == 0) (void)xb_add(&bar[XB_XCNT(b.x)], 1u);
    return b;
}
__device__ __forceinline__ void xcd_barrier_complete(unsigned* bar, unsigned x, unsigned& nloc, unsigned& nx) {
    const unsigned G = gridDim.x * gridDim.y * gridDim.z;
    unsigned sum, cnt, mine, sp = 0u;
    for (;;) {
        sum = 0u; cnt = 0u; mine = 0u;
#pragma unroll
        for (unsigned j = 0; j < 16; ++j) { const unsigned c = xb_ld(&bar[XB_XCNT(j)]); sum += c; cnt += (c > 0u) ? 1u : 0u; mine = (j == x) ? c : mine; }
        if (sum == G) break;
        __builtin_amdgcn_s_sleep(1);
        if ((++sp & 255u) == 0u) { if (xb_ld(&bar[XB_TMO])) break; if (sp > XB_SPIN_CAP) { atomicAdd(&bar[XB_TMO], 1u); break; } }
    }
    nloc = mine > 0u ? mine : 1u; nx = cnt > 0u ? cnt : 1u;
}
__device__ __forceinline__ void xcd_barrier(const XcdBarrier& b) {
    asm volatile("s_waitcnt vmcnt(0)" ::: "memory");
    __syncthreads();
    if (threadIdx.x == 0) {
        unsigned* bar = b.bar;
        __builtin_amdgcn_s_waitcnt(0);
        unsigned nloc = b.st[0], nx = b.st[1];
        if (nloc == 0u) { xcd_barrier_complete(bar, b.x, nloc, nx); b.st[0] = nloc; b.st[1] = nx; }
        const unsigned old = xb_add(&bar[XB_XSUB(b.x)], 1u);
        const unsigned gen = old / nloc;
        if (old + 1u == (gen + 1u) * nloc) {
            __builtin_amdgcn_fence(__ATOMIC_RELEASE, "agent");
            asm volatile("s_waitcnt vmcnt(0)" ::: "memory");
            const unsigned og = xb_add(&bar[XB_TOP], 1u);
            const unsigned tg = og / nx;
            if (og + 1u == (tg + 1u) * nx) xb_add(&bar[XB_TOPGEN], 1u);
            else XB_SPIN(xb_ld(&bar[XB_TOPGEN]) == tg, bar);
            __builtin_amdgcn_fence(__ATOMIC_ACQUIRE, "agent");
            xb_add(&bar[XB_XGEN(b.x)], 1u);
            asm volatile("s_waitcnt vmcnt(0)" ::: "memory");
        } else {
            XB_SPIN(xb_ld(&bar[XB_XGEN(b.x)]) == gen, bar);
            __builtin_amdgcn_fence(__ATOMIC_ACQUIRE, "agent");
            asm volatile("s_waitcnt vmcnt(0)" ::: "memory");
        }
    }
    __syncthreads();
}

namespace pg8 {
constexpr int BM = 256, BK = 64, HALF = 128, HTB = HALF * BK * 2, STAGE_BYTES = 8 * HTB, NXCD = 8, WGM = 8;
__host__ __device__ __forceinline__ int lds_byte(int r, int c) { const int st = (r >> 4) * 2 + (c >> 5), rr = r & 15, cc = c & 31, ob = rr * 64 + cc * 2; return st * 1024 + (ob ^ (((ob >> 9) & 1) << 5)); }
__host__ __device__ __forceinline__ void stage_rc(int b, int& R, int& C) { const int st = b / 1024, sb = b % 1024, swz = sb ^ (((sb >> 9) & 1) << 5); R = (st >> 1) * 16 + swz / 64; C = (st & 1) * 32 + (swz % 64) / 2; }
__host__ __device__ __forceinline__ int perm32(int rho) { const int n = rho >> 4, i = rho & 15; return 8 * (i >> 2) + 4 * n + (i & 3); }

struct Unit { int pm, pn, z; };

__device__ __forceinline__ void static_decode(int L, int nM, int nN, int& pm, int& pn) {
    const int nwg = nM * nN; int wgid = L;
    { const int q = nwg / NXCD, r = nwg % NXCD, xcd = wgid % NXCD, off = wgid / NXCD; wgid = (xcd < r ? xcd * (q + 1) : r * (q + 1) + (xcd - r) * q) + off; }
    const int nig = WGM * nN, gid = wgid / nig, fm = gid * WGM, gsz = (nM - fm) < WGM ? (nM - fm) : WGM;
    pm = fm + ((wgid % nig) % gsz); pn = (wgid % nig) / gsz;
}

template <class P>
__device__ __forceinline__ void gemm_phase(LAS unsigned char* lds, const P& S) {
    int tid_ = threadIdx.x; asm volatile("" : "+v"(tid_));
    const int tid = tid_, wid = __builtin_amdgcn_readfirstlane(tid >> 6), lane = tid & 63, wr = wid >> 2, wc = wid & 3, fr = lane & 15, fq = lane >> 4;
    constexpr int ELB = P::FP8 ? 1 : 2;
    const int K = S.K; int nt = K * ELB / 128; asm volatile("" : "+s"(nt));
    unsigned voffB[2];
#pragma unroll
    for (int i = 0; i < 2; ++i) { int R, C; stage_rc(tid * 16 + i * 8192, R, C); const int Rb = (R & ~31) + perm32(R & 31); voffB[i] = (unsigned)(Rb * K * ELB + C * 2); }
#define PG8_AOFF(dst0, dst1, u) do { _Pragma("unroll") for (int i = 0; i < 2; ++i) { int R, C; stage_rc(tid * 16 + i * 8192, R, C); dst0[i] = S.a_off(u, 0, R, C); dst1[i] = S.a_off(u, 1, R, C); } } while (0)
    const size_t kstepB = (size_t)(BK * 2), hstepB = (size_t)HALF * K * ELB, kstepA = (size_t)S.kstepA;
    const unsigned ldsw = (unsigned)wid * 1024u;
    const int aoff = lds_byte(wr * 64 + fr, fq * 8), boff = lds_byte(wc * 32 + fr, fq * 8);
#define PG8_SA(b, h) (((b) * 2 + (h)) * HTB)
#define PG8_SB(b, h) ((4 + (b) * 2 + (h)) * HTB)
#define PG8_STAGE(bufoff, gbase, voff) do { _Pragma("unroll") for (int _i = 0; _i < 2; ++_i) \
        __builtin_amdgcn_global_load_lds((const unsigned*)((const char*)(gbase) + (voff)[_i]), (LAS unsigned*)(lds + (bufoff) + ldsw + _i * 8192), 16, 0, 0); } while (0)
#define PG8_LDA(dst, b, h) do { _Pragma("unroll") for (int m = 0; m < 4; ++m) _Pragma("unroll") for (int k = 0; k < 2; ++k) dst[m][k] = *(const LAS bf16x8*)(lds + PG8_SA(b, h) + aoff + m * 2048 + k * 1024); } while (0)
#define PG8_LDB(dst, b, h) do { _Pragma("unroll") for (int n = 0; n < 2; ++n) _Pragma("unroll") for (int k = 0; k < 2; ++k) dst[n][k] = *(const LAS bf16x8*)(lds + PG8_SB(b, h) + boff + n * 2048 + k * 1024); } while (0)
#define PG8_CAT(x0, x1) __builtin_shufflevector(__builtin_bit_cast(v4i, x0), __builtin_bit_cast(v4i, x1), 0, 1, 2, 3, 4, 5, 6, 7)
#define PG8_MMA(ai, bj, At, Bt) do { __builtin_amdgcn_s_setprio(1); _Pragma("unroll") for (int m = 0; m < 4; ++m) _Pragma("unroll") for (int n = 0; n < 2; ++n) { \
        if constexpr (P::FP8) acc[ai][bj][m][n] = __builtin_amdgcn_mfma_scale_f32_16x16x128_f8f6f4(PG8_CAT(Bt[n][0], Bt[n][1]), PG8_CAT(At[m][0], At[m][1]), acc[ai][bj][m][n], 0, 0, 0, 0x7f7f7f7f, 0, 0x7f7f7f7f); \
        else { _Pragma("unroll") for (int k = 0; k < 2; ++k) acc[ai][bj][m][n] = __builtin_amdgcn_mfma_f32_16x16x32_bf16(Bt[n][k], At[m][k], acc[ai][bj][m][n], 0, 0, 0); } } __builtin_amdgcn_s_setprio(0); } while (0)
#define PG8_WAIT_V(n) asm volatile("s_waitcnt vmcnt(" #n ")" ::: "memory")
#define PG8_WAIT_L(n) asm volatile("s_waitcnt lgkmcnt(" #n ")" ::: "memory")
#define PG8_BAR __builtin_amdgcn_s_barrier()
#define PG8_SCHED __builtin_amdgcn_sched_barrier(0)
    Unit cur, nxt; int ui = 0;
    if (!S.next(0, cur)) return;
    f32x4 acc[2][2][4][2];
#pragma unroll
    for (int a = 0; a < 2; ++a)
#pragma unroll
        for (int b = 0; b < 2; ++b)
#pragma unroll
            for (int m = 0; m < 4; ++m)
#pragma unroll
                for (int n = 0; n < 2; ++n) acc[a][b][m][n] = (f32x4){0.f, 0.f, 0.f, 0.f};
    bf16x8 At[4][2], B0[2][2], B1[2][2];
    unsigned vA0[2], vA1[2], vN0[2], vN1[2];
    PG8_AOFF(vA0, vA1, cur);
    const char* cA = S.a_base(cur); const char* cB = S.b_base(cur);
    PG8_STAGE(PG8_SB(0, 0), cB, voffB); PG8_STAGE(PG8_SB(0, 1), cB + hstepB, voffB); PG8_STAGE(PG8_SA(0, 0), cA, vA0); PG8_STAGE(PG8_SA(0, 1), cA, vA1);
    if (wr == 1) PG8_BAR;
    PG8_WAIT_V(2); PG8_BAR;
    PG8_STAGE(PG8_SB(1, 0), cB + kstepB, voffB); PG8_STAGE(PG8_SA(1, 0), cA + kstepA, vA0); PG8_STAGE(PG8_SB(1, 1), cB + hstepB + kstepB, voffB);
    PG8_WAIT_V(6); PG8_BAR;
    for (;;) {
        const bool has_next = S.next(ui + 1, nxt);
        const char* nA = cA; const char* nB = cB;
        if (has_next) { nA = S.a_base(nxt); nB = S.b_base(nxt); if (P::EARLY_AOFF) PG8_AOFF(vN0, vN1, nxt); }
        for (int t = 0; t < nt; t += 2) {
            const bool last = (t == nt - 2);
            const char* a1 = cA + (size_t)(t + 1) * kstepA;
            const char* a2 = last ? nA : cA + (size_t)(t + 2) * kstepA; const char* b2 = last ? nB : cB + (size_t)(t + 2) * kstepB;
            const char* a3 = a2 + kstepA; const char* b3 = b2 + kstepB;
            PG8_LDB(B0, 0, 0); PG8_LDB(B1, 0, 1); PG8_SCHED; PG8_LDA(At, 0, 0); PG8_STAGE(PG8_SA(1, 1), a1, vA1);
            if (last && has_next) {
                if (P::EARLY_AOFF) { _Pragma("unroll") for (int i = 0; i < 2; ++i) { vA0[i] = vN0[i]; vA1[i] = vN1[i]; } } else PG8_AOFF(vA0, vA1, nxt); }
            PG8_WAIT_V(8); PG8_WAIT_L(0); PG8_BAR; PG8_MMA(0, 0, At, B0); PG8_MMA(0, 1, At, B1); PG8_BAR; PG8_SCHED;
            PG8_LDA(At, 0, 1); PG8_STAGE(PG8_SB(0, 0), b2, voffB); PG8_STAGE(PG8_SB(0, 1), b2 + hstepB, voffB); PG8_STAGE(PG8_SA(0, 0), a2, vA0);
            PG8_WAIT_V(8); PG8_WAIT_L(0); PG8_BAR; PG8_MMA(1, 0, At, B0); PG8_MMA(1, 1, At, B1); PG8_BAR; PG8_SCHED;
            PG8_LDB(B0, 1, 0); PG8_LDB(B1, 1, 1); PG8_SCHED; PG8_LDA(At, 1, 0); PG8_STAGE(PG8_SA(0, 1), a2, vA1);
            PG8_WAIT_V(8); PG8_WAIT_L(0); PG8_BAR; PG8_MMA(0, 0, At, B0); PG8_MMA(0, 1, At, B1); PG8_BAR; PG8_SCHED;
            PG8_LDA(At, 1, 1); PG8_STAGE(PG8_SB(1, 0), b3, voffB); PG8_STAGE(PG8_SB(1, 1), b3 + hstepB, voffB); PG8_STAGE(PG8_SA(1, 0), a3, vA0);
            PG8_WAIT_V(8); PG8_WAIT_L(0); PG8_BAR; PG8_MMA(1, 0, At, B0); PG8_MMA(1, 1, At, B1); PG8_BAR; PG8_SCHED;
        }
        if (wr == 0) PG8_BAR;
        S.epi(acc, cur, wr, wc, fr, fq);
        if (!has_next) break;
#pragma unroll
        for (int a = 0; a < 2; ++a)
#pragma unroll
            for (int b = 0; b < 2; ++b)
#pragma unroll
                for (int m = 0; m < 4; ++m)
#pragma unroll
                    for (int n = 0; n < 2; ++n) acc[a][b][m][n] = (f32x4){0.f, 0.f, 0.f, 0.f};
        cur = nxt; cA = nA; cB = nB; ++ui;
        if (wr == 1) PG8_BAR;
    }
    PG8_WAIT_V(0);
    PG8_BAR;
#undef PG8_AOFF
#undef PG8_SA
#undef PG8_SB
#undef PG8_STAGE
#undef PG8_LDA
#undef PG8_LDB
#undef PG8_MMA
#undef PG8_CAT
#undef PG8_WAIT_V
#undef PG8_WAIT_L
#undef PG8_BAR
#undef PG8_SCHED
}

template <class P>
__device__ __forceinline__ void gemm_phase_m128(LAS unsigned char* lds, const P& S) {
    int tid_ = threadIdx.x; asm volatile("" : "+v"(tid_));
    const int tid = tid_, wid = __builtin_amdgcn_readfirstlane(tid >> 6), lane = tid & 63, wr = wid >> 2, wc = wid & 3, fr = lane & 15, fq = lane >> 4;
    constexpr int ELB = P::FP8 ? 1 : 2;
    const int K = S.K; int nt = K * ELB / 128; asm volatile("" : "+s"(nt));
    unsigned voffB[2];
#pragma unroll
    for (int i = 0; i < 2; ++i) { int R, C; stage_rc(tid * 16 + i * 8192, R, C); const int Rb = (R & ~31) + perm32(R & 31); voffB[i] = (unsigned)(Rb * K * ELB + C * 2); }
#define PG8_AOFF(dst0, u) do { _Pragma("unroll") for (int i = 0; i < 2; ++i) { int R, C; stage_rc(tid * 16 + i * 8192, R, C); dst0[i] = S.a_off(u, R, C); } } while (0)
    const size_t kstepB = (size_t)(BK * 2), hstepB = (size_t)HALF * K * ELB, kstepA = (size_t)S.kstepA;
    const unsigned ldsw = (unsigned)wid * 1024u;
    const int aoff = lds_byte(wr * 64 + fr, fq * 8), boff = lds_byte(wc * 32 + fr, fq * 8);
#define PG8_SA(b) (((b) * 2) * HTB)
#define PG8_SB(b, h) ((4 + (b) * 2 + (h)) * HTB)
#define PG8_STAGE(bufoff, gbase, voff) do { _Pragma("unroll") for (int _i = 0; _i < 2; ++_i) \
        __builtin_amdgcn_global_load_lds((const unsigned*)((const char*)(gbase) + (voff)[_i]), (LAS unsigned*)(lds + (bufoff) + ldsw + _i * 8192), 16, 0, 0); } while (0)
#define PG8_LDA(dst, b) do { _Pragma("unroll") for (int m = 0; m < 4; ++m) _Pragma("unroll") for (int k = 0; k < 2; ++k) dst[m][k] = *(const LAS bf16x8*)(lds + PG8_SA(b) + aoff + m * 2048 + k * 1024); } while (0)
#define PG8_LDB(dst, b, h) do { _Pragma("unroll") for (int n = 0; n < 2; ++n) _Pragma("unroll") for (int k = 0; k < 2; ++k) dst[n][k] = *(const LAS bf16x8*)(lds + PG8_SB(b, h) + boff + n * 2048 + k * 1024); } while (0)
#define PG8_CAT(x0, x1) __builtin_shufflevector(__builtin_bit_cast(v4i, x0), __builtin_bit_cast(v4i, x1), 0, 1, 2, 3, 4, 5, 6, 7)
#define PG8_MMA(bj, At, Bt) do { __builtin_amdgcn_s_setprio(1); _Pragma("unroll") for (int m = 0; m < 4; ++m) _Pragma("unroll") for (int n = 0; n < 2; ++n) { \
        if constexpr (P::FP8) acc[bj][m][n] = __builtin_amdgcn_mfma_scale_f32_16x16x128_f8f6f4(PG8_CAT(Bt[n][0], Bt[n][1]), PG8_CAT(At[m][0], At[m][1]), acc[bj][m][n], 0, 0, 0, 0x7f7f7f7f, 0, 0x7f7f7f7f); \
        else { _Pragma("unroll") for (int k = 0; k < 2; ++k) acc[bj][m][n] = __builtin_amdgcn_mfma_f32_16x16x32_bf16(Bt[n][k], At[m][k], acc[bj][m][n], 0, 0, 0); } } __builtin_amdgcn_s_setprio(0); } while (0)
#define PG8_WAIT_V(n) asm volatile("s_waitcnt vmcnt(" #n ")" ::: "memory")
#define PG8_WAIT_L(n) asm volatile("s_waitcnt lgkmcnt(" #n ")" ::: "memory")
#define PG8_BAR __builtin_amdgcn_s_barrier()
#define PG8_SCHED __builtin_amdgcn_sched_barrier(0)
    Unit cur, nxt; int ui = 0;
    if (!S.next(0, cur)) return;
    f32x4 acc[2][4][2], st[2][4][2];
#pragma unroll
    for (int a = 0; a < 2; ++a)
#pragma unroll
        for (int m = 0; m < 4; ++m)
#pragma unroll
            for (int n = 0; n < 2; ++n) { acc[a][m][n] = (f32x4){0.f, 0.f, 0.f, 0.f}; st[a][m][n] = (f32x4){0.f, 0.f, 0.f, 0.f}; }
    bf16x8 At[4][2], B0[2][2];
    unsigned vA[2], vN[2];
    PG8_AOFF(vA, cur);
    const char* cA = S.a_base(cur); const char* cB = S.b_base(cur);
    PG8_STAGE(PG8_SB(0, 0), cB, voffB); PG8_STAGE(PG8_SA(0), cA, vA); PG8_STAGE(PG8_SB(0, 1), cB + hstepB, voffB);
    if (wr == 1) PG8_BAR;
    PG8_WAIT_V(2); PG8_BAR;
    PG8_STAGE(PG8_SB(1, 0), cB + kstepB, voffB); PG8_STAGE(PG8_SA(1), cA + kstepA, vA);
    PG8_WAIT_V(4); PG8_BAR;
    for (;;) {
        const bool has_next = S.next(ui + 1, nxt);
        const char* nA = cA; const char* nB = cB;
        if (has_next) { nA = S.a_base(nxt); nB = S.b_base(nxt); if (P::EARLY_AOFF) PG8_AOFF(vN, nxt); }
        for (int t = 0; t < nt; t += 2) {
            const bool last = (t == nt - 2);
            const char* b1 = cB + (size_t)(t + 1) * kstepB;
            const char* a2 = last ? nA : cA + (size_t)(t + 2) * kstepA; const char* b2 = last ? nB : cB + (size_t)(t + 2) * kstepB;
            const char* a3 = a2 + kstepA; const char* b3 = b2 + kstepB;
            PG8_LDB(B0, 0, 0); PG8_SCHED; PG8_LDA(At, 0); PG8_STAGE(PG8_SB(1, 1), b1 + hstepB, voffB);
            if (last && has_next) { if (P::EARLY_AOFF) { vA[0] = vN[0]; vA[1] = vN[1]; } else PG8_AOFF(vA, nxt); }
            PG8_WAIT_V(6); PG8_WAIT_L(0); PG8_BAR; PG8_MMA(0, At, B0); PG8_BAR; PG8_SCHED;
            PG8_LDB(B0, 0, 1); PG8_STAGE(PG8_SB(0, 0), b2, voffB); PG8_STAGE(PG8_SA(0), a2, vA);
            PG8_WAIT_V(6); PG8_WAIT_L(0); PG8_BAR; PG8_MMA(1, At, B0); PG8_BAR; PG8_SCHED;
            PG8_LDB(B0, 1, 0); PG8_SCHED; PG8_LDA(At, 1); PG8_STAGE(PG8_SB(0, 1), b2 + hstepB, voffB);
            PG8_WAIT_V(6); PG8_WAIT_L(0); PG8_BAR; PG8_MMA(0, At, B0); PG8_BAR; PG8_SCHED;
            PG8_LDB(B0, 1, 1); PG8_STAGE(PG8_SB(1, 0), b3, voffB); PG8_STAGE(PG8_SA(1), a3, vA);
            PG8_WAIT_V(6); PG8_WAIT_L(0); PG8_BAR; PG8_MMA(1, At, B0); PG8_BAR; PG8_SCHED;
        }
        if (wr == 0) PG8_BAR;
        S.epi(acc, st, cur, wr, wc, fr, fq);
        if (!has_next) break;
#pragma unroll
        for (int a = 0; a < 2; ++a)
#pragma unroll
            for (int m = 0; m < 4; ++m)
#pragma unroll
                for (int n = 0; n < 2; ++n) acc[a][m][n] = (f32x4){0.f, 0.f, 0.f, 0.f};
        cur = nxt; cA = nA; cB = nB; ++ui;
        if (wr == 1) PG8_BAR;
    }
    PG8_WAIT_V(0);
    PG8_BAR;
#undef PG8_AOFF
#undef PG8_SA
#undef PG8_SB
#undef PG8_STAGE
#undef PG8_LDA
#undef PG8_LDB
#undef PG8_MMA
#undef PG8_CAT
#undef PG8_WAIT_V
#undef PG8_WAIT_L
#undef PG8_BAR
#undef PG8_SCHED
}
}
namespace attn_body {
using bf16x8 = __attribute__((ext_vector_type(8))) short;
using u32x4 = __attribute__((ext_vector_type(4))) unsigned;
constexpr int NW = 8, QBLK = 32, QB = QBLK * NW, KVBLK = 64;
__device__ __forceinline__ int crow(int r, int hi) { return (r & 3) + 8 * (r >> 2) + 4 * hi; }
#define SBAR() __builtin_amdgcn_sched_barrier(0)
constexpr int NSLOT = 3, SLOTB = 8192;
constexpr int LDS_K = 0, LDS_V = NSLOT * SLOTB, LDS_WS = 2 * NSLOT * SLOTB, LDS_OST = LDS_WS + NW * 64 * 4, LDS_BYTES = LDS_OST + NW * 4096;
constexpr int LDS_BT = 86016 + 256;
__device__ __forceinline__ void glds16(const void* gsrc, unsigned lds_dst) { unsigned keep;
  asm volatile("s_mov_b32 %0, m0\n\ts_mov_b32 m0, %2\n\ts_nop 0\n\tglobal_load_lds_dwordx4 %1, off\n\ts_mov_b32 m0, %0" : "=&s"(keep) : "v"(gsrc), "s"(lds_dst) : "memory"); }
__device__ __forceinline__ float max3f(float a, float b, float c) { float r; asm("v_max3_f32 %0, %1, %2, %3" : "=v"(r) : "v"(a), "v"(b), "v"(c)); return r; }
__device__ __forceinline__ float max2f(float a, float b) { float r; asm("v_max_f32_e32 %0, %1, %2" : "=v"(r) : "v"(a), "v"(b)); return r; }
__device__ __forceinline__ float fadd_s(float a, float b) { float r; asm("v_add_f32_e32 %0, %1, %2" : "=v"(r) : "v"(a), "v"(b)); return r; }
__device__ __forceinline__ float fsub_s(float a, float b) { float r; asm("v_sub_f32_e32 %0, %1, %2" : "=v"(r) : "v"(a), "v"(b)); return r; }
typedef float f32x2_t __attribute__((ext_vector_type(2))); typedef __bf16 bf16x2_t __attribute__((ext_vector_type(2)));
__device__ __forceinline__ unsigned cvtpk_s(float lo, float hi) { f32x2_t v = {lo, hi}; bf16x2_t b = __builtin_convertvector(v, bf16x2_t); return __builtin_bit_cast(unsigned, b); }
#define WAIT_BAR(N) asm volatile("s_waitcnt vmcnt(" #N ") lgkmcnt(0)\n\ts_barrier" ::: "memory")

__device__ __forceinline__ void qkt(f32x16& p0, f32x16& p1, const char* Kslot, const bf16x8* qr, const f32x16& negm, int r32, int hi) {
  const char* kb = Kslot + hi * 1024 + r32 * 16;
  #pragma unroll
  for (int d0 = 0; d0 < 4; ++d0) {
    const bf16x8 b0 = *reinterpret_cast<const bf16x8*>(kb + d0 * 2048);
    const bf16x8 b1 = *reinterpret_cast<const bf16x8*>(kb + d0 * 2048 + 512);
    if (d0 == 0) { p0 = __builtin_amdgcn_mfma_f32_32x32x16_bf16(b0, qr[0], negm, 0, 0, 0); p1 = __builtin_amdgcn_mfma_f32_32x32x16_bf16(b1, qr[0], negm, 0, 0, 0); }
    else { p0 = __builtin_amdgcn_mfma_f32_32x32x16_bf16(b0, qr[d0], p0, 0, 0, 0); p1 = __builtin_amdgcn_mfma_f32_32x32x16_bf16(b1, qr[d0], p1, 0, 0, 0); } }
}
typedef __attribute__((address_space(3))) const char* lds_cptr;
typedef short v4i16_t __attribute__((ext_vector_type(4)));
__device__ __forceinline__ void kload8(bf16x8* kf, lds_cptr kp) {
  kf[0] = *(const __attribute__((address_space(3))) bf16x8*)(kp);        kf[1] = *(const __attribute__((address_space(3))) bf16x8*)(kp + 512);
  kf[2] = *(const __attribute__((address_space(3))) bf16x8*)(kp + 2048); kf[3] = *(const __attribute__((address_space(3))) bf16x8*)(kp + 2560);
  kf[4] = *(const __attribute__((address_space(3))) bf16x8*)(kp + 4096); kf[5] = *(const __attribute__((address_space(3))) bf16x8*)(kp + 4608);
  kf[6] = *(const __attribute__((address_space(3))) bf16x8*)(kp + 6144); kf[7] = *(const __attribute__((address_space(3))) bf16x8*)(kp + 6656);
}
__device__ __forceinline__ void kload2(bf16x8* kf, lds_cptr kp, int j) { kf[2 * j] = *(const __attribute__((address_space(3))) bf16x8*)(kp + j * 2048); kf[2 * j + 1] = *(const __attribute__((address_space(3))) bf16x8*)(kp + j * 2048 + 512); }
__device__ __forceinline__ s16x4 vtr(lds_cptr p) { return __builtin_bit_cast(s16x4, __builtin_amdgcn_ds_read_tr16_b64_v4i16((__attribute__((address_space(3))) v4i16_t*)p)); }
__device__ __forceinline__ float rowmax(const f32x16& p0, const f32x16& p1) {
  float a = max3f(p0[0], p0[1], p1[0]), b = max3f(p0[2], p0[3], p1[1]); a = max3f(a, p1[2], p1[3]);
  #pragma unroll
  for (int r = 4; r < 16; r += 4) { a = max3f(a, p0[r], p0[r + 1]); b = max3f(b, p0[r + 2], p0[r + 3]); a = max3f(a, p1[r], p1[r + 1]); b = max3f(b, p1[r + 2], p1[r + 3]); }
  const float m = max2f(a, b);
  auto rr = __builtin_amdgcn_permlane32_swap(__float_as_uint(m), __float_as_uint(m), false, false);
  return max2f(__uint_as_float(rr[0]), __uint_as_float(rr[1]));
}
__device__ __forceinline__ void pv(f32x16* o, int vb, bf16x8 pa0, bf16x8 pa1, bf16x8 pa2, bf16x8 pa3) {
  #pragma unroll
  for (int d0 = 0; d0 < 2; ++d0) { s16x4 lo[4], hi[4];
    #pragma unroll
    for (int ks = 0; ks < 4; ++ks) {
      asm volatile("ds_read_b64_tr_b16 %0,%1 offset:%c2" : "=&v"(lo[ks]) : "v"(vb), "i"(d0 * 4096 + ks * 1024) : "memory");
      asm volatile("ds_read_b64_tr_b16 %0,%1 offset:%c2" : "=&v"(hi[ks]) : "v"(vb), "i"(d0 * 4096 + ks * 1024 + 512) : "memory"); }
    asm volatile("s_waitcnt lgkmcnt(0)" ::: "memory"); SBAR();
    #define PK(k) (bf16x8){lo[k][0], lo[k][1], lo[k][2], lo[k][3], hi[k][0], hi[k][1], hi[k][2], hi[k][3]}
    o[d0] = __builtin_amdgcn_mfma_f32_32x32x16_bf16(pa0, PK(0), o[d0], 0, 0, 0);
    o[d0] = __builtin_amdgcn_mfma_f32_32x32x16_bf16(pa1, PK(1), o[d0], 0, 0, 0);
    o[d0] = __builtin_amdgcn_mfma_f32_32x32x16_bf16(pa2, PK(2), o[d0], 0, 0, 0);
    o[d0] = __builtin_amdgcn_mfma_f32_32x32x16_bf16(pa3, PK(3), o[d0], 0, 0, 0);
    #undef PK
  }
}
#define ATTN_STORE16(p, v) (*(u32x4*)(p) = (v))

template <int THRL, bool NA, int QP_, int KVP_>
__device__ __forceinline__ void attn_unit(const bf16* Qu, int qp_rt, const bf16* __restrict__ Kh, const bf16* __restrict__ Vh, int kvp_rt, bf16* Ou, int NT, int r0, int rlo, char* shm) {
  const int qp = QP_ ? QP_ : qp_rt, kvp = KVP_ ? KVP_ : kvp_rt, op = qp;
  int tid_ = threadIdx.x; asm volatile("" : "+v"(tid_));
  const int tid = tid_, lane = tid & 63, r32 = lane & 31, hi = lane >> 5; const int wid = __builtin_amdgcn_readfirstlane(tid >> 6);
  const bf16* Qw = Qu + (long)(wid * QBLK) * qp;
  const unsigned lds0 = (unsigned)(uintptr_t)shm;
  float* wsf = (float*)(shm + LDS_WS) + wid * 64;
  const bf16* ksrc = Kh + (long)lane * kvp + wid * 8;
  const bf16* vsrc = Vh + (long)(16 * (wid & 3) + (lane >> 2)) * kvp + (wid >> 2) * 32 + (lane & 3) * 8;
  const unsigned kdst = lds0 + LDS_K + wid * 1024, vdst = lds0 + LDS_V + wid * 1024;
  #define TROW(t) (NA ? ((t) < 4 ? 64 * (t) : CTX + 64 * ((rlo + (t) - 4) < 127 ? (rlo + (t) - 4) : 127)) : 64 * (t))
  #define DMA_K(t, slot) glds16(ksrc + (long)TROW(t) * kvp, (unsigned)__builtin_amdgcn_readfirstlane(kdst + (slot)))
  #define DMA_V(t, slot) glds16(vsrc + (long)TROW(t) * kvp, (unsigned)__builtin_amdgcn_readfirstlane(vdst + (slot)))
  const int vb0 = (int)(lds0 + LDS_V) + ((lane >> 4) & 1) * 32 + (lane & 3) * 8 + (4 * hi + ((lane & 15) >> 2)) * 64;
  const char* Kbase = shm + LDS_K; bf16x8 kf[8];
  const lds_cptr shm3 = (lds_cptr)shm; const lds_cptr kp0 = shm3 + LDS_K + hi * 1024 + r32 * 16; const lds_cptr vp0 = shm3 + LDS_V + ((lane >> 4) & 1) * 32 + (lane & 3) * 8 + (4 * hi + ((lane & 15) >> 2)) * 64;
  const int rq = r0 + (wid >> 1), qc = 32 * (wid & 1) + r32;
  const int rsw = rq - 4 < 0 ? 0 : (rq - 4 > 120 ? 120 : rq - 4);
  const int cs = qc - 8 < 0 ? 0 : (qc - 8 > 48 ? 48 : qc - 8);
  const __attribute__((address_space(3))) float* btl = (const __attribute__((address_space(3))) float*)(shm3 + LDS_BT) + (15 + 4 * hi - qc);
  DMA_K(0, 0); DMA_V(0, 0); DMA_K(1, SLOTB);
  bf16x8 qr[4];
  #pragma unroll
  for (int d0 = 0; d0 < 4; ++d0) qr[d0] = *reinterpret_cast<const bf16x8*>(&Qw[(long)r32 * qp + d0 * 16 + hi * 8]);
  float mhat = 0.f, l_reg = 0.f; f32x16 o[2]; o[0] = f32x16{}; o[1] = f32x16{}; f32x16 negm = f32x16{}; if (!NA) asm volatile("" : "+v"(negm));
  #define NEGM (NA ? f32x16{} : negm)
  #define CMASK(P0, P1, t) do { if (NA) { if ((t) >= 4) { const int kr_ = rlo + (t) - 4; const int dr_ = kr_ - rsw; \
      if (dr_ < 0 || dr_ >= 8) { _Pragma("unroll") for (int r = 0; r < 16; ++r) { P0[r] = (-__builtin_inff()); P1[r] = (-__builtin_inff()); } } \
      else { const __attribute__((address_space(3))) float* bp_ = btl + (kr_ - rq + 7) * 31; const int kl0_ = 4 * hi - cs; \
        _Pragma("unroll") for (int rg = 0; rg < 4; ++rg) { \
          _Pragma("unroll") for (int rr_ = 0; rr_ < 4; ++rr_) { const int r = rg * 4 + rr_; const int kc_ = (r & 3) + 8 * (r >> 2); const float b0_ = bp_[kc_], b1_ = bp_[kc_ + 32]; \
            const int kl_ = kc_ + kl0_; P0[r] = ((unsigned)kl_ < 16u) ? P0[r] + b0_ : (-__builtin_inff()); P1[r] = ((unsigned)(kl_ + 32) < 16u) ? P1[r] + b1_ : (-__builtin_inff()); } \
          SBAR(); } } } } } while (0)
  bool resc = false;
  #define START(P0, P1) do { const float rm = rowmax(P0, P1); resc = false; \
    { const float dl = rm; mhat = fadd_s(mhat, dl); \
      _Pragma("unroll") for (int r = 0; r < 16; ++r) { P0[r] = fsub_s(P0[r], dl); P1[r] = fsub_s(P1[r], dl); } \
      if (!NA) { _Pragma("unroll") for (int r = 0; r < 16; ++r) negm[r] = -mhat; asm volatile("" : "+v"(negm)); } } \
    _Pragma("unroll") for (int r = 0; r < 16; ++r) P0[r] = __builtin_amdgcn_exp2f(P0[r]); } while (0)
  #define RESC() do { if (resc) { asm volatile("s_waitcnt lgkmcnt(0)" ::: "memory"); \
      _Pragma("unroll") for (int d_ = 0; d_ < 2; ++d_) _Pragma("unroll") for (int r = 0; r < 16; ++r) o[d_][r] *= wsf[crow(r, hi)]; } } while (0)
  f32x16 pA0, pA1, pB0, pB1;
  int sl_prev = 0, sl_cur = 0, sl_next = SLOTB;
  #define ROT() do { sl_prev = sl_cur; sl_cur = sl_next; sl_next = (sl_next == (NSLOT - 1) * SLOTB) ? 0 : sl_next + SLOTB; } while (0)
  DMA_K(2, 2 * SLOTB);
  WAIT_BAR(3);
  qkt(pA0, pA1, Kbase, qr, NEGM, r32, hi); asm volatile("s_nop 15\n\ts_nop 7" : "+v"(pA0), "+v"(pA1));
  START(pA0, pA1);
  _Pragma("unroll") for (int r = 0; r < 16; ++r) pA1[r] = __builtin_amdgcn_exp2f(pA1[r]);
  WAIT_BAR(0);
  DMA_K(3, 0); DMA_V(1, SLOTB);
  ROT();
  kload8(kf, kp0 + sl_cur);
  WAIT_BAR(2);
  s16x4 vlo[8], vhi[8]; u32x4 pw0, pw1, pw2, pw3;
  #define PKW(P, B) cvtpk_s(P[B], P[B + 1])
  #define PAF(k) __builtin_bit_cast(bf16x8, pw##k)
  #define VFR(i) (bf16x8){vlo[i][0], vlo[i][1], vlo[i][2], vlo[i][3], vhi[i][0], vhi[i][1], vhi[i][2], vhi[i][3]}
  #define PIN(x) asm volatile("" : "+v"(x))
  #define MX3(a, b, c) __builtin_fmaxf(__builtin_fmaxf((a), (b)), (c))
  #define GAPA(MF, A0, A1, A2, A3, W0, W1, PW) do { MF; sacc += A0; sacc += A1; sacc += A2; sacc += A3; PIN(sacc); W0; W1; PIN(PW); SBAR(); } while (0)
  #define EX(v) __builtin_amdgcn_exp2f(v)
  #define GAPB(MF, X, B) do { MF; X[B] = EX(X[B]); X[B + 1] = EX(X[B + 1]); X[B + 2] = EX(X[B + 2]); X[B + 3] = EX(X[B + 3]); PIN(X); SBAR(); } while (0)
  #define VRD(i) do { vlo[i] = vtr(vp_ + (((i) >> 2) * 4096 + ((i) & 3) * 1024)); vhi[i] = vtr(vp_ + (((i) >> 2) * 4096 + ((i) & 3) * 1024 + 512)); } while (0)
  #define KRD(G, j) do { if (G) { kload2(kf, kp0 + sl_next, j); SBAR(); } } while (0)
  #define STEP(C0, C1, P0, P1, t, GK, GV, GL) do { SBAR(); \
    const lds_cptr vp_ = vp0 + sl_prev; \
    VRD(0); SBAR(); float sacc = (P0[0] + P0[1]); \
    GAPA(C0 = __builtin_amdgcn_mfma_f32_32x32x16_bf16(kf[0], qr[0], NEGM, 0, 0, 0), P0[2], P0[3], P0[4], P0[5],     pw0[0] = PKW(P0, 0), pw0[1] = PKW(P0, 2), pw0); \
    VRD(4); SBAR(); GAPA(C1 = __builtin_amdgcn_mfma_f32_32x32x16_bf16(kf[1], qr[0], NEGM, 0, 0, 0), P0[6], P0[7], P0[8], P0[9],     pw0[2] = PKW(P0, 4), pw0[3] = PKW(P0, 6), pw0); \
    VRD(1); SBAR(); GAPA(C0 = __builtin_amdgcn_mfma_f32_32x32x16_bf16(kf[2], qr[1], C0, 0, 0, 0),   P0[10], P0[11], P0[12], P0[13], pw1[0] = PKW(P0, 8), pw1[1] = PKW(P0, 10), pw1); \
    VRD(5); SBAR(); GAPA(C1 = __builtin_amdgcn_mfma_f32_32x32x16_bf16(kf[3], qr[1], C1, 0, 0, 0),   P0[14], P0[15], P1[0], P1[1],   pw1[2] = PKW(P0, 12), pw1[3] = PKW(P0, 14), pw1); \
    VRD(2); SBAR(); GAPA(C0 = __builtin_amdgcn_mfma_f32_32x32x16_bf16(kf[4], qr[2], C0, 0, 0, 0),   P1[2], P1[3], P1[4], P1[5],     pw2[0] = PKW(P1, 0), pw2[1] = PKW(P1, 2), pw2); \
    VRD(6); SBAR(); GAPA(C1 = __builtin_amdgcn_mfma_f32_32x32x16_bf16(kf[5], qr[2], C1, 0, 0, 0),   P1[6], P1[7], P1[8], P1[9],     pw2[2] = PKW(P1, 4), pw2[3] = PKW(P1, 6), pw2); \
    VRD(3); SBAR(); GAPA(C0 = __builtin_amdgcn_mfma_f32_32x32x16_bf16(kf[6], qr[3], C0, 0, 0, 0),   P1[10], P1[11], P1[12], P1[13], pw3[0] = PKW(P1, 8), pw3[1] = PKW(P1, 10), pw3); \
    VRD(7); SBAR(); GAPA(C1 = __builtin_amdgcn_mfma_f32_32x32x16_bf16(kf[7], qr[3], C1, 0, 0, 0),   P1[14], P1[15], 0.f, 0.f,       pw3[2] = PKW(P1, 12), pw3[3] = PKW(P1, 14), pw3); \
    l_reg += sacc; \
    if (GK) { DMA_K((t) + 3, sl_cur); } if (GV) { DMA_V((t) + 1, sl_next); } \
    if (NA) { _Pragma("unroll") for (int r = 0; r < 16; ++r) { C0[r] -= mhat; C1[r] -= mhat; } } \
    CMASK(C0, C1, t); \
    { float a = MX3(C0[0], C0[1], C1[0]), b = MX3(C0[2], C0[3], C1[1]); a = MX3(a, C1[2], C1[3]); \
      _Pragma("unroll") for (int r = 4; r < 16; r += 4) { a = MX3(a, C0[r], C0[r + 1]); b = MX3(b, C0[r + 2], C0[r + 3]); a = MX3(a, C1[r], C1[r + 1]); b = MX3(b, C1[r + 2], C1[r + 3]); } \
      float rm = __builtin_fmaxf(a, b); { auto rr = __builtin_amdgcn_permlane32_swap(__float_as_uint(rm), __float_as_uint(rm), false, false); rm = __builtin_fmaxf(__uint_as_float(rr[0]), __uint_as_float(rr[1])); } \
      resc = false; \
      if (__builtin_expect(__any(rm > (float)THRL), 0)) { const float dl = __builtin_fmaxf(rm, 0.f); mhat += dl; \
        _Pragma("unroll") for (int r = 0; r < 16; ++r) { C0[r] -= dl; C1[r] -= dl; } \
        if (!NA) { _Pragma("unroll") for (int r = 0; r < 16; ++r) negm[r] = -mhat; asm volatile("" : "+v"(negm)); } \
        const float f = __builtin_amdgcn_exp2f(-dl); l_reg *= f; if (hi == 0) wsf[r32] = f; resc = true; } } \
    SBAR(); \
    GAPB(o[0] = __builtin_amdgcn_mfma_f32_32x32x16_bf16(PAF(0), VFR(0), o[0], 0, 0, 0), C0, 0); \
    GAPB(o[1] = __builtin_amdgcn_mfma_f32_32x32x16_bf16(PAF(0), VFR(4), o[1], 0, 0, 0), C0, 4); \
    KRD(GL, 0); GAPB(o[0] = __builtin_amdgcn_mfma_f32_32x32x16_bf16(PAF(1), VFR(1), o[0], 0, 0, 0), C0, 8); \
    KRD(GL, 1); GAPB(o[1] = __builtin_amdgcn_mfma_f32_32x32x16_bf16(PAF(1), VFR(5), o[1], 0, 0, 0), C0, 12); \
    KRD(GL, 2); GAPB(o[0] = __builtin_amdgcn_mfma_f32_32x32x16_bf16(PAF(2), VFR(2), o[0], 0, 0, 0), C1, 0); \
    KRD(GL, 3); GAPB(o[1] = __builtin_amdgcn_mfma_f32_32x32x16_bf16(PAF(2), VFR(6), o[1], 0, 0, 0), C1, 4); \
    GAPB(o[0] = __builtin_amdgcn_mfma_f32_32x32x16_bf16(PAF(3), VFR(3), o[0], 0, 0, 0), C1, 8); \
    GAPB(o[1] = __builtin_amdgcn_mfma_f32_32x32x16_bf16(PAF(3), VFR(7), o[1], 0, 0, 0), C1, 12); \
    } while (0)
  int t = 1;
  for (; t + 5 < NT; t += 2) {
    STEP(pB0, pB1, pA0, pA1, t, true, true, true);     WAIT_BAR(2); RESC(); ROT();
    STEP(pA0, pA1, pB0, pB1, t + 1, true, true, true); WAIT_BAR(2); RESC(); ROT();
  }
  #define ENDW(tt) do { if ((tt) + 3 < NT) { WAIT_BAR(2); } else if ((tt) + 2 < NT) { WAIT_BAR(1); } else { WAIT_BAR(0); } } while (0)
  for (; t + 1 < NT; t += 2) {
    STEP(pB0, pB1, pA0, pA1, t, (t + 3 < NT), (t + 1 < NT), (t + 1 < NT));         ENDW(t);     RESC(); ROT();
    STEP(pA0, pA1, pB0, pB1, t + 1, (t + 4 < NT), (t + 2 < NT), (t + 2 < NT));     ENDW(t + 1); RESC(); ROT();
  }
  STEP(pB0, pB1, pA0, pA1, NT - 1, false, false, false); RESC();
  { float sacc = pB0[0] + pB0[1]; _Pragma("unroll") for (int r = 2; r < 16; ++r) sacc += pB0[r]; _Pragma("unroll") for (int r = 0; r < 16; ++r) sacc += pB1[r]; l_reg += sacc;
    pw0 = (u32x4){PKW(pB0, 0), PKW(pB0, 2), PKW(pB0, 4), PKW(pB0, 6)}; pw1 = (u32x4){PKW(pB0, 8), PKW(pB0, 10), PKW(pB0, 12), PKW(pB0, 14)}; pw2 = (u32x4){PKW(pB1, 0), PKW(pB1, 2), PKW(pB1, 4), PKW(pB1, 6)}; pw3 = (u32x4){PKW(pB1, 8), PKW(pB1, 10), PKW(pB1, 12), PKW(pB1, 14)};
    SBAR(); pv(o, vb0 + sl_cur, PAF(0), PAF(1), PAF(2), PAF(3)); }
  #undef PKW
  #undef PAF
  #undef VFR
  #undef PIN
  #undef MX3
  #undef GAPA
  #undef GAPB
  #undef EX
  #undef VRD
  #undef KRD
  #undef STEP
  #undef ENDW
  { auto rr = __builtin_amdgcn_permlane32_swap(__float_as_uint(l_reg), __float_as_uint(l_reg), false, false); l_reg = __uint_as_float(rr[0]) + __uint_as_float(rr[1]); }
  if (hi == 0) wsf[32 + r32] = l_reg; asm volatile("s_waitcnt lgkmcnt(0)" ::: "memory");
  float rli[16];
  #pragma unroll
  for (int r = 0; r < 16; ++r) rli[r] = __builtin_amdgcn_rcpf(wsf[32 + crow(r, hi)]);
  bf16* Ow = Ou + (long)(wid * QBLK) * op;
  { bf16* stg = (bf16*)(shm + LDS_OST) + wid * 2048;
    #pragma unroll
    for (int r = 0; r < 16; ++r) { const int orow = crow(r, hi);
      #pragma unroll
      for (int d0 = 0; d0 < 2; ++d0) stg[orow * 64 + d0 * 32 + r32] = (bf16)f2bf(o[d0][r] * rli[r]); }
    asm volatile("s_waitcnt lgkmcnt(0)" ::: "memory");
    #pragma unroll
    for (int i = 0; i < 4; ++i) { const int row = i * 8 + (lane >> 3), ch = lane & 7; const u32x4 v = *(const u32x4*)(stg + row * 64 + ch * 8); ATTN_STORE16(Ow + (long)row * op + ch * 8, v); } }
  asm volatile("s_waitcnt lgkmcnt(0)\n\ts_barrier" ::: "memory");
  #undef NEGM
  #undef DMA_K
  #undef DMA_V
  #undef TROW
  #undef CMASK
  #undef START
  #undef RESC
  #undef ROT
}
#undef SBAR
#undef WAIT_BAR
}
#ifndef FP8_MOE
#define FP8_MOE 1
#endif
struct Args { const float* in[29]; float* out; unsigned char* ws; int ph_lo, ph_hi; };
enum { I_X = 0, I_C, I_CTX, I_CCTX, I_WMOD, I_BMOD, I_N1G, I_N2G, I_WIN, I_LRE, I_LIM, I_LDT, I_BRE, I_BIM, I_CRE, I_CIM, I_SSMD, I_WGLU, I_QNG, I_KNG, I_RPB, I_WBR, I_WOUT, I_RW, I_RB, I_MG, I_MU, I_MD, I_FNG };

typedef const float* CFP;
struct Ctx {
    const __attribute__((address_space(4))) CFP* in; float* out; unsigned char* ws; LAS unsigned char* lds; gu32* ctl;
    int tid, lane, wave, vcu, G;
};
#define WSP(T_, off) ((T_*)(C.ws + (off)))

__device__ __forceinline__ float* xs_row(const Ctx& C, int m) { const int b = m / LB, j = m - b * LB; return j < CTX ? WSP(float, WS_CTXS) + (size_t)(b * CTX + j) * D : C.out + (size_t)(b * SEQ + j - CTX) * D; }
__device__ __forceinline__ const float* in_row(const Ctx& C, int m) { const int b = m / LB, j = m - b * LB; return j < CTX ? C.in[I_CTX] + (size_t)(b * CTX + j) * D : C.in[I_X] + (size_t)(b * SEQ + j - CTX) * D; }
__device__ __forceinline__ int cond_of(int m) { const int b = m / LB, j = m - b * LB; return j < CTX ? 4 : b; }

__device__ __forceinline__ void transpose_item(const float* W, int N, int Kp, bf16* WT, int k0, int n0, int drow0, LAS float* scr, int lane) {
    const float* src = W + (size_t)k0 * N + n0 + lane;
    float tv[64];
#pragma unroll
    for (int i = 0; i < 64; ++i) tv[i] = src[(size_t)i * N];
#pragma unroll
    for (int i = 0; i < 64; ++i) scr[i * 65 + lane] = tv[i];
    LDS_WAIT(); asm volatile("" ::: "memory");
    const int c = lane & 7;
#pragma unroll
    for (int j = 0; j < 8; ++j) { const int n = (lane >> 3) + 8 * j; const LAS float* s = scr + (8 * c) * 65 + n;
        v4u o; o.x = pk2(s[0 * 65], s[1 * 65]); o.y = pk2(s[2 * 65], s[3 * 65]); o.z = pk2(s[4 * 65], s[5 * 65]); o.w = pk2(s[6 * 65], s[7 * 65]);
        *(GAS v4u*)(WT + (size_t)(drow0 + n) * Kp + k0 + 8 * c) = o; }
    LDS_WAIT(); asm volatile("" ::: "memory");
}
__device__ __forceinline__ void transpose_item8(const float* W, int N, int Kp, unsigned char* WT, int k0, int n0, int drow0, float scale, LAS float* scr, int lane) {
    const float* src = W + (size_t)k0 * N + n0 + lane;
    float tv[64];
#pragma unroll
    for (int i = 0; i < 64; ++i) tv[i] = src[(size_t)i * N];
#pragma unroll
    for (int i = 0; i < 64; ++i) scr[i * 65 + lane] = tv[i] * scale;
    LDS_WAIT(); asm volatile("" ::: "memory");
    const int c = lane & 3;
#pragma unroll
    for (int j = 0; j < 4; ++j) { const int n = (lane >> 2) + 16 * j; const LAS float* s = scr + (16 * c) * 65 + n;
        v4u o; o.x = pk4_fp8(s[0 * 65], s[1 * 65], s[2 * 65], s[3 * 65]); o.y = pk4_fp8(s[4 * 65], s[5 * 65], s[6 * 65], s[7 * 65]); o.z = pk4_fp8(s[8 * 65], s[9 * 65], s[10 * 65], s[11 * 65]); o.w = pk4_fp8(s[12 * 65], s[13 * 65], s[14 * 65], s[15 * 65]);
        *(GAS v4u*)(WT + (size_t)(drow0 + n) * Kp + k0 + 16 * c) = o; }
    LDS_WAIT(); asm volatile("" ::: "memory");
}
__device__ __forceinline__ void phase_weights(const Ctx& C, int l) {
    LAS float* scr = (LAS float*)(C.lds + C.wave * 16640);
    const int gw = C.vcu * NWAVES + C.wave, NGW = C.G * NWAVES;
    constexpr int I0 = 16 * 92, I1 = 8 * 8, I2 = 3 * 8 * 16, I3 = 16 * 16, I4 = 16 * 16 * 8, I5 = I4, I6 = 16 * 8 * 16;
    for (int it = gw; it < I0 + I1 + I2 + I3 + I4 + I5 + I6; it += NGW) {
        int r = it;
        if (r < I0) { const int kb = r / 92, nb = r % 92; if (nb < 44 || GATE_BF16) transpose_item(C.in[I_WIN] + (size_t)l * 1024 * INW, INW, 1024, WSP(bf16, WS_WIN), 64 * kb, 64 * nb, 64 * nb, scr, C.lane);
            else transpose_item8(C.in[I_WIN] + (size_t)l * 1024 * INW, INW, 1024, WSP(unsigned char, WS_WIN8), 64 * kb, 64 * nb, 64 * nb - 2816, 64.f, scr, C.lane); continue; } r -= I0;
        if (r < I1) { const int kb = r / 8, nb = r % 8; transpose_item(C.in[I_WGLU] + (size_t)l * 512 * 512, 512, 512, WSP(bf16, WS_WGLU), 64 * kb, 64 * nb, 64 * nb, scr, C.lane); continue; } r -= I1;
        if (r < I2) { const int i = r / 128, q = r % 128, kb = q / 16, nb = q % 16; transpose_item(C.in[I_WBR] + (size_t)(l * 3 + i) * 512 * 1024, 1024, 512, WSP(bf16, WS_WBR) + (size_t)i * 1024 * 512, 64 * kb, 64 * nb, 64 * nb, scr, C.lane); continue; } r -= I2;
        if (r < I3) { const int kb = r / 16, nb = r % 16; transpose_item(C.in[I_WOUT] + (size_t)l * 1024 * 1024, 1024, 1024, WSP(bf16, WS_WOUT), 64 * kb, 64 * nb, 64 * nb, scr, C.lane); continue; } r -= I3;
        if (r < I4 + I5) { const int up = r >= I4; if (up) r -= I4; const int e = r / 128, q = r % 128, kb = q / 8, nb = q % 8, n0 = 64 * nb;
            if (FP8_MOE) transpose_item8((up ? C.in[I_MU] : C.in[I_MG]) + (size_t)(l * 16 + e) * 1024 * 512, 512, 1024, WSP(unsigned char, WS_MOE1) + (size_t)e * 1024 * 1024, 64 * kb, n0, (n0 / 128) * 256 + (n0 % 128) + (up ? 128 : 0), 64.f, scr, C.lane);
            else transpose_item((up ? C.in[I_MU] : C.in[I_MG]) + (size_t)(l * 16 + e) * 1024 * 512, 512, 1024, WSP(bf16, WS_MOE1) + (size_t)e * 1024 * 1024, 64 * kb, n0, (n0 / 128) * 256 + (n0 % 128) + (up ? 128 : 0), scr, C.lane); continue; } r -= I4 + I5;
        { const int e = r / 128, q = r % 128, kb = q / 16, nb = q % 16; if (FP8_MOE) transpose_item8(C.in[I_MD] + (size_t)(l * 16 + e) * 512 * 1024, 1024, 512, WSP(unsigned char, WS_MOE2) + (size_t)e * 1024 * 512, 64 * kb, 64 * nb, 64 * nb, 32.f, scr, C.lane);
            else transpose_item(C.in[I_MD] + (size_t)(l * 16 + e) * 512 * 1024, 1024, 512, WSP(bf16, WS_MOE2) + (size_t)e * 1024 * 512, 64 * kb, 64 * nb, 64 * nb, scr, C.lane); }
    }
}

__device__ __forceinline__ void phase_mod(const Ctx& C) {
    LAS float* sc = (LAS float*)(C.lds);
    LAS float* red = (LAS float*)(C.lds + 20480);
    for (int i = C.tid; i < 5 * 1024; i += 512) { const int c = i >> 10, k = i & 1023; const float v = c < 4 ? C.in[I_C][c * 1024 + k] : C.in[I_CCTX][k]; sc[i] = v * fsigmoid(v); }
    __syncthreads();
    for (int it = C.vcu; it < NLAYER * 96; it += C.G) {
        const int l = it / 96, col = (it % 96) * 64 + C.lane, k0 = C.wave * 128;
        const float* W = C.in[I_WMOD] + (size_t)l * 1024 * 6144 + (size_t)k0 * 6144 + col;
        float a0 = 0.f, a1 = 0.f, a2 = 0.f, a3 = 0.f, a4 = 0.f;
#pragma unroll 16
        for (int k = 0; k < 128; ++k) { const float w = W[(size_t)k * 6144]; a0 += sc[k0 + k] * w; a1 += sc[1024 + k0 + k] * w; a2 += sc[2048 + k0 + k] * w; a3 += sc[3072 + k0 + k] * w; a4 += sc[4096 + k0 + k] * w; }
        LAS float* r = red + C.wave * 320 + C.lane; r[0] = a0; r[64] = a1; r[128] = a2; r[192] = a3; r[256] = a4;
        __syncthreads();
        if (C.tid < 320) { const int c = C.tid >> 6; float s = C.in[I_BMOD][l * 6144 + col];
#pragma unroll
            for (int w = 0; w < 8; ++w) s += red[w * 320 + C.tid];
            WSP(float, WS_MOD)[(size_t)(l * 5 + c) * 6144 + col] = s; }
        __syncthreads();
    }
}

__device__ __forceinline__ void phase_s5mats(const Ctx& C, int l) {
    if (C.vcu >= 128) return;
    const int g = C.vcu >> 2, part = C.vcu & 3, tid = C.tid;
    LAS f32x2* POW = (LAS f32x2*)(C.lds);
    LAS f32x2* CC = (LAS f32x2*)(C.lds + 33792);
    LAS f32x2* BB = (LAS f32x2*)(C.lds + 50176);
    LAS f32x2* COEF = (LAS f32x2*)(C.lds + 66560);
    LAS bf16* KT = (LAS bf16*)(C.lds + 67584);
    LAS float* K0 = (LAS float*)(C.lds + 99840);
    __syncthreads();
    if (tid < 128) {
        const int d = tid >> 6, p = tid & 63; const int li = ((l * 2 + d) * 32 + g) * 64 + p;
        const float re = C.in[I_LRE][li], im = C.in[I_LIM][li], dt = __expf(C.in[I_LDT][(l * 2 + d) * 32 + g]);
        for (int tau = 0; tau <= 32; ++tau) { const float mag = __expf(re * dt * (float)tau), rev = im * dt * (float)tau * 0.15915494309189535f;
            POW[(d * 33 + tau) * 64 + p] = (f32x2){mag * cos_rev(rev), mag * sin_rev(rev)}; }
        const float mag = __expf(re * dt), rev = im * dt * 0.15915494309189535f; const float lr = mag * cos_rev(rev) - 1.f, lim = mag * sin_rev(rev);
        const float den = 1.f / (re * re + im * im);
        COEF[tid] = (f32x2){(lr * re + lim * im) * den, (lim * re - lr * im) * den};
    }
    __syncthreads();
    for (int i = tid; i < 2048; i += 512) {
        const int d = i >> 10, p = (i >> 4) & 63, h = i & 15; const size_t bi = (((size_t)(l * 2 + d) * 32 + g) * 64 + p) * 16 + h;
        const float br = C.in[I_BRE][bi], bi_ = C.in[I_BIM][bi]; const f32x2 cf = COEF[d * 64 + p];
        BB[i] = (f32x2){cf.x * br - cf.y * bi_, cf.x * bi_ + cf.y * br};
        const int h2 = (i >> 6) & 15, p2 = i & 63; const size_t ci = (((size_t)(l * 2 + d) * 32 + g) * 16 + h2) * 64 + p2;
        CC[i] = (f32x2){C.in[I_CRE][ci], C.in[I_CIM][ci]};
    }
    __syncthreads();
    {
        const int d = tid >> 8, h = (tid >> 4) & 15, hp = tid & 15; float acc[32];
#pragma unroll
        for (int t = 0; t < 32; ++t) acc[t] = 0.f;
        for (int p = 0; p < 64; ++p) { const f32x2 c = CC[d * 1024 + h * 64 + p], b = BB[d * 1024 + p * 16 + hp], lam = POW[(d * 33 + 1) * 64 + p];
            float xr = c.x * b.x - c.y * b.y, xi = c.x * b.y + c.y * b.x;
#pragma unroll
            for (int t = 0; t < 32; ++t) { acc[t] += xr; const float nr = xr * lam.x - xi * lam.y, ni = xr * lam.y + xi * lam.x; xr = nr; xi = ni; } }
        if (d == 1) K0[tid & 255] = acc[0];
        __syncthreads();
        if (d == 0) { acc[0] += K0[tid] + (h == hp ? C.in[I_SSMD][l * 512 + g * 16 + h] : 0.f);
#pragma unroll
            for (int t = 0; t < 32; ++t) KT[((31 + t) * 16 + h) * 16 + hp] = (bf16)f2bf(acc[t]); }
        else {
#pragma unroll
            for (int t = 1; t < 32; ++t) KT[((31 - t) * 16 + h) * 16 + hp] = (bf16)f2bf(acc[t]); }
    }
    __syncthreads();
    bf16* B1 = WSP(bf16, WS_BT1) + (size_t)g * 768 * 512; bf16* B2 = WSP(bf16, WS_BT2) + (size_t)g * 512 * 256;
    for (int i = tid; i < 128 * 64; i += 512) {
        const int n = part * 128 + (i >> 6), ch = i & 63, t = n >> 4, h = n & 15, s = ch >> 1, hp0 = (ch & 1) * 8;
        *(GAS v4u*)(B1 + (size_t)n * 512 + ch * 8) = *(const LAS v4u*)(KT + ((t - s + 31) * 16 + h) * 16 + hp0);
    }
    for (int i = tid; i < 64 * 64; i += 512) {
        const int nn = part * 64 + (i >> 6), ch = i & 63, d = nn >> 7, p = (nn & 127) >> 1, ri = nn & 1, s = ch >> 1, hp0 = (ch & 1) * 8;
        const f32x2 w = POW[(d * 33 + (d == 0 ? 31 - s : s)) * 64 + p]; float v[8];
#pragma unroll
        for (int j = 0; j < 8; ++j) { const f32x2 b = BB[d * 1024 + p * 16 + hp0 + j]; v[j] = ri == 0 ? (w.x * b.x - w.y * b.y) : (w.x * b.y + w.y * b.x); }
        v4u o; o.x = pk2(v[0], v[1]); o.y = pk2(v[2], v[3]); o.z = pk2(v[4], v[5]); o.w = pk2(v[6], v[7]);
        *(GAS v4u*)(B1 + (size_t)(512 + nn) * 512 + ch * 8) = o;
    }
    for (int i = tid; i < 128 * 32; i += 512) {
        const int n = part * 128 + (i >> 5), ch = i & 31, t = n >> 4, h = n & 15, d = ch >> 4, p0 = (ch & 15) * 4; float v[8];
#pragma unroll
        for (int j = 0; j < 4; ++j) { const f32x2 c = CC[d * 1024 + h * 64 + p0 + j], w = POW[(d * 33 + (d == 0 ? t + 1 : 32 - t)) * 64 + p0 + j];
            v[2 * j] = c.x * w.x - c.y * w.y; v[2 * j + 1] = -(c.x * w.y + c.y * w.x); }
        v4u o; o.x = pk2(v[0], v[1]); o.y = pk2(v[2], v[3]); o.z = pk2(v[4], v[5]); o.w = pk2(v[6], v[7]);
        *(GAS v4u*)(B2 + (size_t)n * 256 + ch * 8) = o;
    }
    __syncthreads();
}

template <int MODE>
__device__ __forceinline__ void phase_rows(const Ctx& C, int l) {
    const int gw = C.vcu * NWAVES + C.wave, NGW = C.G * NWAVES, lane = C.lane;
    const float* MODl = WSP(float, WS_MOD) + (size_t)(MODE == 2 ? 0 : l) * 5 * 6144;
    const float* MODp = WSP(float, WS_MOD) + (size_t)(l > 0 ? l - 1 : 0) * 5 * 6144;
    const bf16* YS = WSP(bf16, WS_YSLOT);
    f32x4 nx[4]; v2u na[4], nc[4];
#define ROWS_LOAD(mm) do { const int m_ = (mm); \
        if (MODE == 0) { const GAS f32x4* xr = (const GAS f32x4*)in_row(C, m_) + lane; _Pragma("unroll") for (int q = 0; q < 4; ++q) nx[q] = xr[64 * q]; } \
        else { const GAS f32x4* xr = (const GAS f32x4*)xs_row(C, m_) + lane; const GAS v2u* y0 = (const GAS v2u*)(YS + (size_t)(2 * m_) * D) + lane; const GAS v2u* y1 = (const GAS v2u*)(YS + (size_t)(2 * m_ + 1) * D) + lane; \
            _Pragma("unroll") for (int q = 0; q < 4; ++q) { nx[q] = xr[64 * q]; na[q] = y0[64 * q]; nc[q] = y1[64 * q]; } } } while (0)
    int m = gw; if (MODE == 2) { while (m < T && (m % LB) < CTX) m += NGW; }
    if (m < T) ROWS_LOAD(m);
    while (m < T) {
        const int b = m / LB, j = m - b * LB, cond = j < CTX ? 4 : b;
        f32x4 v[4];
        if (MODE == 0) {
#pragma unroll
            for (int q = 0; q < 4; ++q) v[q] = nx[q]; }
        else { const GAS f32x4* g2 = (const GAS f32x4*)(MODp + cond * 6144 + 5 * 1024) + lane;
#pragma unroll
            for (int q = 0; q < 4; ++q) { const f32x4 g = g2[64 * q]; const v2u a = na[q], c = nc[q];
                v[q] = nx[q] + g * (f32x4){bflo(a.x) + bflo(c.x), bfhi(a.x) + bfhi(c.x), bflo(a.y) + bflo(c.y), bfhi(a.y) + bfhi(c.y)}; } }
        int mn = m + NGW; if (MODE == 2) { while (mn < T && (mn % LB) < CTX) mn += NGW; }
        if (mn < T) ROWS_LOAD(mn);
        float ss = 0.f;
#pragma unroll
        for (int q = 0; q < 4; ++q) ss += (v[q].x * v[q].x + v[q].y * v[q].y) + (v[q].z * v[q].z + v[q].w * v[q].w);
        const float rstd = 1.f / sqrtf(wave_sum(ss, lane) * (1.f / D) + EPS);
        if (MODE == 2) { GAS f32x4* o = (GAS f32x4*)(C.out + (size_t)(b * SEQ + j - CTX) * D) + lane; const GAS f32x4* fg = (const GAS f32x4*)C.in[I_FNG] + lane;
#pragma unroll
            for (int q = 0; q < 4; ++q) o[64 * q] = v[q] * rstd * fg[64 * q]; }
        else { GAS f32x4* xo = (GAS f32x4*)xs_row(C, m) + lane; GAS v2u* ho = (GAS v2u*)(WSP(bf16, WS_HB) + (size_t)m * D) + lane; GAS unsigned* h8 = (GAS unsigned*)(WSP(unsigned char, WS_HB8) + (size_t)m * D) + lane;
            const GAS f32x4* ng = (const GAS f32x4*)(C.in[I_N1G] + l * D) + lane; const GAS f32x4* sh = (const GAS f32x4*)(MODl + cond * 6144) + lane; const GAS f32x4* sc = (const GAS f32x4*)(MODl + cond * 6144 + 1024) + lane;
#pragma unroll
            for (int q = 0; q < 4; ++q) { xo[64 * q] = v[q]; const f32x4 h = v[q] * rstd * ng[64 * q] * (sc[64 * q] + 1.f) + sh[64 * q]; ho[64 * q] = (v2u){pk2(h.x, h.y), pk2(h.z, h.w)}; if (H8_WRITE) h8[64 * q] = pk4_fp8(h.x, h.y, h.z, h.w); } }
        m = mn;
    }
#undef ROWS_LOAD
}

__device__ __forceinline__ void phase_qkprep(const Ctx& C, int l) {
    const int gw = C.vcu * NWAVES + C.wave, NGW = C.G * NWAVES, lane = C.lane, s8 = lane & 7;
    const float* qg = C.in[I_QNG] + l * 64 + 8 * s8; const float* kg = C.in[I_KNG] + l * 64 + 8 * s8;
    float gq[8], gk[8];
#pragma unroll
    for (int i = 0; i < 8; ++i) { gq[i] = qg[i]; gk[i] = kg[i]; }
    const int ax = s8 >> 2, f0 = 8 * (s8 & 1);
    float inv[8];
#pragma unroll
    for (int i = 0; i < 8; ++i) inv[i] = exp2f(-(float)(f0 + i) * 0.8304820237218406f) * 0.15915494309189535f;
    const int kl = lane & 15;
    v4u wq, wk;
    if (gw < T) { wq = *((const GAS v4u*)(WSP(bf16, WS_QA) + (size_t)gw * 512) + lane); wk = *((const GAS v4u*)(WSP(bf16, WS_KA) + (size_t)gw * 128) + kl); }
    for (int m = gw; m < T; m += NGW) {
        const int b = m / LB, j = m - b * LB; const bool lat = j >= CTX; const int tt = j - CTX; const float pos = (float)(ax == 0 ? (tt >> 6) : (tt & 63));
        const v4u cq = wq, ck = wk;
        if (m + NGW < T) { wq = *((const GAS v4u*)(WSP(bf16, WS_QA) + (size_t)(m + NGW) * 512) + lane); wk = *((const GAS v4u*)(WSP(bf16, WS_KA) + (size_t)(m + NGW) * 128) + kl); }
        float cs[8], sn[8];
#pragma unroll
        for (int i = 0; i < 8; ++i) { cs[i] = lat ? cos_rev(pos * inv[i]) : 1.f; sn[i] = lat ? sin_rev(pos * inv[i]) : 0.f; }
#pragma unroll
        for (int which = 0; which < 2; ++which) {
            const v4u w = which == 0 ? cq : ck; float x[8] = {bflo(w.x), bfhi(w.x), bflo(w.y), bfhi(w.y), bflo(w.z), bfhi(w.z), bflo(w.w), bfhi(w.w)};
            float ss = 0.f;
#pragma unroll
            for (int i = 0; i < 8; ++i) ss += x[i] * x[i];
            ss += dpp_mov<0xB1, 0xF>(ss); ss += dpp_mov<0x4E, 0xF>(ss); ss += dpp_mov<0x141, 0xF>(ss);
            const float rstd = 1.f / sqrtf(ss * (1.f / 64.f) + EPS);
            float y[8];
#pragma unroll
            for (int i = 0; i < 8; ++i) { const float xn = x[i] * rstd * (which == 0 ? gq[i] : gk[i]); const float other = dpp_mov<0x4E, 0xF>(xn);
                y[i] = (s8 & 2) ? (xn * cs[i] + other * sn[i]) : (xn * cs[i] - other * sn[i]); }
            const float sc = which == 0 ? C2 : 1.f;
            v4u o; o.x = pk2(y[0] * sc, y[1] * sc); o.y = pk2(y[2] * sc, y[3] * sc); o.z = pk2(y[4] * sc, y[5] * sc); o.w = pk2(y[6] * sc, y[7] * sc);
            if (which == 0) *((GAS v4u*)(WSP(bf16, WS_QA) + (size_t)m * 512) + lane) = o;
            else if (lane < 16) *((GAS v4u*)(WSP(bf16, WS_KA) + (size_t)m * 128) + lane) = o;
        }
    }
}

__device__ __forceinline__ void phase_carry(const Ctx& C, int l) {
    if (C.vcu >= 32) return;
    const int b = C.vcu >> 3, g = (C.vcu & 7) * 4 + (C.wave >> 1), d = C.wave & 1, p = C.lane;
    const int li = ((l * 2 + d) * 32 + g) * 64 + p;
    const float re = C.in[I_LRE][li], im = C.in[I_LIM][li], dt = __expf(C.in[I_LDT][(l * 2 + d) * 32 + g]);
    const float mag = __expf(re * dt * 32.f), rev = im * dt * 32.f * 0.15915494309189535f; const float Lr = mag * cos_rev(rev), Li = mag * sin_rev(rev);
    const GAS f32x2* S = (const GAS f32x2*)(WSP(float, WS_SST) + (size_t)(b * NCH) * 8192 + g * 256 + d * 128) + p;
    GAS unsigned* X = (GAS unsigned*)(WSP(bf16, WS_XST) + (size_t)(b * NCH) * 8192 + g * 256 + d * 128) + p;
    float sr = 0.f, si = 0.f;
    if (d == 0) {
        for (int c0 = 0; c0 < NCH; c0 += 8) { f32x2 s[8];
#pragma unroll
            for (int k = 0; k < 8; ++k) s[k] = S[(size_t)(c0 + k) * 4096];
#pragma unroll
            for (int k = 0; k < 8; ++k) { X[(size_t)(c0 + k) * 4096] = pk2(sr, si); const float nr = Lr * sr - Li * si + s[k].x, ni = Lr * si + Li * sr + s[k].y; sr = nr; si = ni; } }
    } else {
        for (int seg = 0; seg < 33; ++seg) { const int chi = seg == 0 ? 7 : NCH - 1 - (seg - 1) * 8; f32x2 s[8];
#pragma unroll
            for (int k = 0; k < 8; ++k) s[k] = S[(size_t)(chi - k) * 4096];
#pragma unroll
            for (int k = 0; k < 8; ++k) { X[(size_t)(chi - k) * 4096] = pk2(sr, si); const float nr = Lr * sr - Li * si + s[k].x, ni = Lr * si + Li * sr + s[k].y; sr = nr; si = ni; } }
    }
}

__device__ __forceinline__ void phase_norm2(const Ctx& C, int l) {
    LAS float* RWt = (LAS float*)C.lds;
    LAS unsigned* REC = (LAS unsigned*)(C.lds + 65536);
    LAS float* LG = (LAS float*)(C.lds + 65536 + 16384);
    LAS unsigned* LCNT = (LAS unsigned*)(C.lds + 65536 + 32768);
    const int lane = C.lane, tid = C.tid;
    for (int i = tid; i < 16384; i += 512) { const int k = i >> 4, e = i & 15; RWt[e * 1024 + k] = C.in[I_RW][i]; }
    if (tid < 32) LCNT[tid] = 0u;
    __syncthreads();
    const float* MODl = WSP(float, WS_MOD) + (size_t)l * 5 * 6144;
    int nrows = 0; for (int m = C.vcu; m < T; m += C.G) ++nrows;
    f32x4 nx[4];
    if (C.wave < nrows) { const GAS f32x4* xr = (const GAS f32x4*)xs_row(C, C.vcu + C.G * C.wave) + lane;
#pragma unroll
        for (int q = 0; q < 4; ++q) nx[q] = xr[64 * q]; }
    for (int i = C.wave; i < nrows; i += NWAVES) {
        const int m = C.vcu + C.G * i, cond = cond_of(m);
        GAS unsigned* h8 = (GAS unsigned*)(WSP(unsigned char, WS_HB8) + (size_t)m * D) + lane; GAS v2u* ho = (GAS v2u*)(WSP(bf16, WS_HB) + (size_t)m * D) + lane;
        const GAS f32x4* ng = (const GAS f32x4*)(C.in[I_N2G] + l * D) + lane; const GAS f32x4* sh = (const GAS f32x4*)(MODl + cond * 6144 + 3072) + lane; const GAS f32x4* sc = (const GAS f32x4*)(MODl + cond * 6144 + 4096) + lane;
        f32x4 v[4]; float ss = 0.f;
#pragma unroll
        for (int q = 0; q < 4; ++q) { v[q] = nx[q]; ss += (v[q].x * v[q].x + v[q].y * v[q].y) + (v[q].z * v[q].z + v[q].w * v[q].w); }
        if (i + NWAVES < nrows) { const GAS f32x4* xr = (const GAS f32x4*)xs_row(C, m + C.G * NWAVES) + lane;
#pragma unroll
            for (int q = 0; q < 4; ++q) nx[q] = xr[64 * q]; }
        const float rstd = 1.f / sqrtf(wave_sum(ss, lane) * (1.f / D) + EPS);
        float lg[16];
#pragma unroll
        for (int e = 0; e < 16; ++e) lg[e] = 0.f;
#pragma unroll
        for (int q = 0; q < 4; ++q) { const f32x4 h = v[q] * rstd * ng[64 * q] * (sc[64 * q] + 1.f) + sh[64 * q]; if (FP8_MOE) h8[64 * q] = pk4_fp8(h.x, h.y, h.z, h.w); else ho[64 * q] = (v2u){pk2(h.x, h.y), pk2(h.z, h.w)};
#pragma unroll
            for (int e = 0; e < 16; ++e) { const f32x4 w = *(const LAS f32x4*)(RWt + e * 1024 + 256 * q + 4 * lane); lg[e] += (h.x * w.x + h.y * w.y) + (h.z * w.z + h.w * w.w); } }
        float mine = 0.f;
#pragma unroll
        for (int e = 0; e < 16; ++e) { const float t = wave_sum(lg[e], lane); mine = lane == e ? t : mine; }
        if (lane < 16) LG[i * 16 + lane] = mine;
    }
    __syncthreads();
    float rb[16];
#pragma unroll
    for (int e = 0; e < 16; ++e) rb[e] = C.in[I_RB][e];
    for (int i = tid; i < nrows; i += 512) {
        float lg[16];
#pragma unroll
        for (int q = 0; q < 4; ++q) { const f32x4 t = *(const LAS f32x4*)(LG + i * 16 + 4 * q); lg[4 * q] = t.x; lg[4 * q + 1] = t.y; lg[4 * q + 2] = t.z; lg[4 * q + 3] = t.w; }
        float mx = lg[0];
#pragma unroll
        for (int e = 1; e < 16; ++e) mx = fmaxf(mx, lg[e]);
        float pr[16], sel[16], sum = 0.f;
#pragma unroll
        for (int e = 0; e < 16; ++e) { pr[e] = __expf(lg[e] - mx); sum += pr[e]; }
        const float rs = 1.f / sum;
#pragma unroll
        for (int e = 0; e < 16; ++e) { pr[e] *= rs; sel[e] = pr[e] + rb[e]; }
        float bestv = -1e30f; int best = 0;
#pragma unroll
        for (int gq = 0; gq < 4; ++gq) { float m1 = -1e30f, m2 = -1e30f;
#pragma unroll
            for (int k = 0; k < 4; ++k) { const float s_ = sel[4 * gq + k]; if (s_ > m1) { m2 = m1; m1 = s_; } else if (s_ > m2) m2 = s_; }
            const float gs = m1 + m2; if (gs > bestv) { bestv = gs; best = gq; } }
        float s4[4], p4[4];
#pragma unroll
        for (int k = 0; k < 4; ++k) { s4[k] = best == 0 ? sel[k] : best == 1 ? sel[4 + k] : best == 2 ? sel[8 + k] : sel[12 + k]; p4[k] = best == 0 ? pr[k] : best == 1 ? pr[4 + k] : best == 2 ? pr[8 + k] : pr[12 + k]; }
        int i0 = 0; float v0 = s4[0], q0 = p4[0];
#pragma unroll
        for (int k = 1; k < 4; ++k) if (s4[k] > v0) { v0 = s4[k]; i0 = k; q0 = p4[k]; }
        int i1 = -1; float v1 = -1e30f, q1 = 0.f;
#pragma unroll
        for (int k = 0; k < 4; ++k) if (k != i0 && s4[k] > v1) { v1 = s4[k]; i1 = k; q1 = p4[k]; }
        const int e0 = 4 * best + i0, e1 = 4 * best + i1; const float wn = 1.f / (q0 + q1);
        const unsigned lp0 = atomicAdd((unsigned*)(LCNT + e0), 1u), lp1 = atomicAdd((unsigned*)(LCNT + e1), 1u);
        REC[i * 4 + 0] = (unsigned)e0 | ((unsigned)e1 << 8) | (lp0 << 16); REC[i * 4 + 1] = lp1; REC[i * 4 + 2] = __float_as_uint(q0 * wn); REC[i * 4 + 3] = __float_as_uint(q1 * wn);
    }
    __syncthreads();
    if (tid < 16) LCNT[16 + tid] = __hip_atomic_fetch_add((unsigned*)(C.ctl + CW_CNT + l * 1024 + 64 * tid), LCNT[tid], RLX_AGENT);
    __syncthreads();
    int* LIST = WSP(int, WS_LIST); float* RWG = WSP(float, WS_RW);
    for (int i = tid; i < nrows; i += 512) { const int m = C.vcu + C.G * i; const unsigned r0 = REC[i * 4], r1 = REC[i * 4 + 1];
        const int e0 = r0 & 255, e1 = (r0 >> 8) & 255; const unsigned lp0 = r0 >> 16, lp1 = r1;
        LIST[(size_t)e0 * T + LCNT[16 + e0] + lp0] = 2 * m; LIST[(size_t)e1 * T + LCNT[16 + e1] + lp1] = 2 * m + 1;
        RWG[2 * m] = __uint_as_float(REC[i * 4 + 2]); RWG[2 * m + 1] = __uint_as_float(REC[i * 4 + 3]); }
    __syncthreads();
}
using pg8::Unit;
typedef f32x4 Acc[2][2][4][2];
__device__ __forceinline__ v4u pack8(const f32x4& a, const f32x4& b) { v4u w; w.x = cvt_pk_bf16(a[0], a[1]); w.y = cvt_pk_bf16(a[2], a[3]); w.z = cvt_pk_bf16(b[0], b[1]); w.w = cvt_pk_bf16(b[2], b[3]); return w; }
__device__ __forceinline__ void unpack8(const v4u& w, f32x4& a, f32x4& b) { a = (f32x4){bflo(w.x), bfhi(w.x), bflo(w.y), bfhi(w.y)}; b = (f32x4){bflo(w.z), bfhi(w.z), bflo(w.w), bfhi(w.w)}; }
#ifndef WT_MODE
#define WT_MODE 0
#endif
__device__ __forceinline__ void st16(void* p, const v4u& v) {
#if WT_MODE == 1
    asm volatile("global_store_dwordx4 %0, %1, off sc0 sc1" :: "v"(p), "v"(v) : "memory");
#elif WT_MODE == 2
    asm volatile("global_store_dwordx4 %0, %1, off nt" :: "v"(p), "v"(v) : "memory");
#else
    *(GAS v4u*)p = v;
#endif
}
__device__ __forceinline__ int chunk_m0(int cr) { return (cr / NCH) * LB + (cr % NCH) * 32; }

struct PWin {
    static constexpr bool EARLY_AOFF = false, FP8 = false; unsigned char* ws; int G, c; int K; unsigned kstepA;
    __device__ __forceinline__ bool next(int i, Unit& u) const { const long L = (long)i * G + c; if (L >= NPAN * 11) return false; pg8::static_decode((int)L, NPAN, 11, u.pm, u.pn); u.z = 0; return true; }
    __device__ __forceinline__ const char* a_base(const Unit& u) const { return (const char*)(ws + WS_HB) + (size_t)u.pm * 256 * 1024 * 2; }
    __device__ __forceinline__ unsigned a_off(const Unit&, int h, int R, int Cc) const { return (unsigned)((h * 128 + R) * 1024 + Cc) * 2u; }
    __device__ __forceinline__ const char* b_base(const Unit& u) const { return (const char*)(ws + WS_WIN) + (size_t)u.pn * 256 * 1024 * 2; }
    __device__ __forceinline__ void epi(const Acc& acc, const Unit& u, int wr, int wc, int fr, int fq) const {
        const int row0 = u.pm * 256 + wr * 64 + fr;
#pragma unroll
        for (int bj = 0; bj < 2; ++bj) {
            const int cb = u.pn * 256 + bj * 128; bf16* dst; int ld, col, mode = 0; float sc = 1.f;
            if (cb < 512) { dst = (bf16*)(ws + WS_U) + ((size_t)((cb + wc * 32 + 8 * fq) >> 4) * T) * 16 + ((8 * fq) & 15) - (wc * 32 + 8 * fq); ld = 16; col = 0; }
            else if (cb < 1024) { dst = (bf16*)(ws + WS_QA); ld = 512; col = cb - 512; }
            else if (cb == 1024) { dst = (bf16*)(ws + WS_KA); ld = 128; col = 0; }
            else if (cb == 1152) { dst = (bf16*)(ws + WS_VA); ld = 128; col = 0; }
            else if (cb < 1792) { dst = (bf16*)(ws + WS_QN); ld = 512; col = cb - 1280; sc = C2; }
            else if (cb < 2304) { dst = (bf16*)(ws + WS_KN); ld = 512; col = cb - 1792; }
            else { dst = (bf16*)(ws + WS_VN); ld = 512; col = cb - 2304; }
            const int c0 = col + wc * 32 + 8 * fq;
#pragma unroll
            for (int ai = 0; ai < 2; ++ai)
#pragma unroll
                for (int m = 0; m < 4; ++m) { f32x4 v0 = acc[ai][bj][m][0], v1 = acc[ai][bj][m][1];
                    if (mode) { v0 = (f32x4){fsigmoid(v0[0]), fsigmoid(v0[1]), fsigmoid(v0[2]), fsigmoid(v0[3])}; v1 = (f32x4){fsigmoid(v1[0]), fsigmoid(v1[1]), fsigmoid(v1[2]), fsigmoid(v1[3])}; }
                    else { v0 = v0 * sc; v1 = v1 * sc; }
                    st16(dst + (size_t)(row0 + ai * 128 + m * 16) * ld + c0, pack8(v0, v1)); __builtin_amdgcn_sched_barrier(0); }
        }
    }
};

struct PGate {
    static constexpr bool EARLY_AOFF = false, FP8 = !GATE_BF16; unsigned char* ws; int G, c; int K; unsigned kstepA;
    __device__ __forceinline__ bool next(int i, Unit& u) const { const long L = (long)i * G + c; if (L >= 2 * NPAN * 12) return false; pg8::static_decode((int)L, 2 * NPAN, 12, u.pm, u.pn); u.z = 0; return true; }
    __device__ __forceinline__ const char* a_base(const Unit& u) const { return GATE_BF16 ? (const char*)(ws + WS_HB) + (size_t)u.pm * 128 * 2048 : (const char*)(ws + WS_HB8) + (size_t)u.pm * 128 * 1024; }
    __device__ __forceinline__ unsigned a_off(const Unit&, int R, int Cc) const { return GATE_BF16 ? (unsigned)(R * 2048 + Cc * 2) : (unsigned)(R * 1024 + Cc * 2); }
    __device__ __forceinline__ const char* b_base(const Unit& u) const { return GATE_BF16 ? (const char*)(ws + WS_WIN) + (size_t)(2816 + u.pn * 256) * 2048 : (const char*)(ws + WS_WIN8) + (size_t)u.pn * 256 * 1024; }
    __device__ __forceinline__ void epi(const f32x4 (&acc)[2][4][2], f32x4 (&)[2][4][2], const Unit& u, int wr, int wc, int fr, int fq) const {
#pragma unroll
        for (int m = 0; m < 4; ++m) { const size_t r = (size_t)(u.pm * 128 + wr * 64 + m * 16 + fr);
#pragma unroll
            for (int bj = 0; bj < 2; ++bj) { const int c0 = u.pn * 256 + bj * 128 + wc * 32 + 8 * fq; f32x4 v0 = acc[bj][m][0] * (GATE_BF16 ? 1.f : 1.f / 64.f), v1 = acc[bj][m][1] * (GATE_BF16 ? 1.f : 1.f / 64.f);
                v0 = (f32x4){fsigmoid(v0[0]), fsigmoid(v0[1]), fsigmoid(v0[2]), fsigmoid(v0[3])}; v1 = (f32x4){fsigmoid(v1[0]), fsigmoid(v1[1]), fsigmoid(v1[2]), fsigmoid(v1[3])};
                if (GATE_BF16) *(GAS v4u*)((bf16*)(ws + WS_GATES) + r * 3072 + c0) = pack8(v0, v1);
                else *(GAS v2u*)((unsigned char*)(ws + WS_GATES) + r * 3072 + c0) = (v2u){pk4_fp8(v0[0], v0[1], v0[2], v0[3]), pk4_fp8(v1[0], v1[1], v1[2], v1[3])}; }
            __builtin_amdgcn_sched_barrier(0); }
    }
};

struct PS5A {
    static constexpr bool EARLY_AOFF = false, FP8 = false; unsigned char* ws; int G, c; int K; unsigned kstepA;
    __device__ __forceinline__ bool next(int i, Unit& u) const { const long L = (long)i * G + c; if (L >= 32 * 15) return false; const int l = (int)L; u.z = l / 15; const int r = l % 15; u.pm = r / 3; u.pn = r % 3; return true; }
    __device__ __forceinline__ const char* a_base(const Unit& u) const { return (const char*)(ws + WS_U) + (size_t)u.z * T * 32; }
    __device__ __forceinline__ unsigned a_off(const Unit& u, int h, int R, int Cc) const { int cr = u.pm * 256 + h * 128 + R; cr = cr < NCR ? cr : NCR - 1; return (unsigned)(cr * 512 + Cc) * 2u; }
    __device__ __forceinline__ const char* b_base(const Unit& u) const { return (const char*)(ws + WS_BT1) + ((size_t)u.z * 768 + u.pn * 256) * 512 * 2; }
    __device__ __forceinline__ void epi(const Acc& acc, const Unit& u, int wr, int wc, int fr, int fq) const {
#pragma unroll
        for (int ai = 0; ai < 2; ++ai)
#pragma unroll
            for (int m = 0; m < 4; ++m) { const int cr = u.pm * 256 + ai * 128 + wr * 64 + m * 16 + fr; if (cr >= NCR) continue;
#pragma unroll
                for (int bj = 0; bj < 2; ++bj) { const int n = bj * 128 + wc * 32 + 8 * fq;
                    if (u.pn < 2) *(GAS v4u*)((bf16*)(ws + WS_YG) + (size_t)u.z * T * 16 + (size_t)cr * 512 + u.pn * 256 + n) = pack8(acc[ai][bj][m][0], acc[ai][bj][m][1]);
                    else { GAS f32x4* o = (GAS f32x4*)((float*)(ws + WS_SST) + (size_t)cr * 8192 + u.z * 256 + n); o[0] = acc[ai][bj][m][0]; o[1] = acc[ai][bj][m][1]; } }
                __builtin_amdgcn_sched_barrier(0); }
    }
};

struct PS5B {
    static constexpr bool EARLY_AOFF = false, FP8 = false; unsigned char* ws; int G, c; int K; unsigned kstepA;
    __device__ __forceinline__ bool next(int i, Unit& u) const { const long L = (long)i * G + c; if (L >= 32 * 10) return false; const int l = (int)L; u.z = l / 10; const int r = l % 10; u.pm = r / 2; u.pn = r % 2; return true; }
    __device__ __forceinline__ const char* a_base(const Unit& u) const { return (const char*)(ws + WS_XST) + (size_t)u.z * 512; }
    __device__ __forceinline__ unsigned a_off(const Unit& u, int h, int R, int Cc) const { int cr = u.pm * 256 + h * 128 + R; cr = cr < NCR ? cr : NCR - 1; return (unsigned)(cr * 8192 + Cc) * 2u; }
    __device__ __forceinline__ const char* b_base(const Unit& u) const { return (const char*)(ws + WS_BT2) + ((size_t)u.z * 512 + u.pn * 256) * 256 * 2; }
    __device__ __forceinline__ void epi(const Acc& acc, const Unit& u, int wr, int wc, int fr, int fq) const {
#pragma unroll
        for (int ai = 0; ai < 2; ++ai)
#pragma unroll
            for (int m = 0; m < 4; ++m) { const int cr = u.pm * 256 + ai * 128 + wr * 64 + m * 16 + fr; if (cr >= NCR) continue;
#pragma unroll
                for (int bj = 0; bj < 2; ++bj) { const int nn = u.pn * 256 + bj * 128 + wc * 32 + 8 * fq, t = nn >> 4, h0 = nn & 15;
                    GAS v4u* p = (GAS v4u*)((bf16*)(ws + WS_YS) + (size_t)(chunk_m0(cr) + t) * 512 + u.z * 16 + h0);
                    f32x4 y0, y1; { const v4u w_ = *(const GAS v4u*)((const bf16*)(ws + WS_YG) + (size_t)u.z * T * 16 + (size_t)cr * 512 + nn); unpack8(w_, y0, y1); } y0 += acc[ai][bj][m][0]; y1 += acc[ai][bj][m][1];
                    y0 = (f32x4){gelu_tanh(y0[0]), gelu_tanh(y0[1]), gelu_tanh(y0[2]), gelu_tanh(y0[3])}; y1 = (f32x4){gelu_tanh(y1[0]), gelu_tanh(y1[1]), gelu_tanh(y1[2]), gelu_tanh(y1[3])};
                    *p = pack8(y0, y1); }
                __builtin_amdgcn_sched_barrier(0); }
    }
};

__device__ __forceinline__ int half_panel(int hl, bool lat_only) { if (!lat_only) return hl; const int pl = hl >> 1; return 2 * (pl + (pl >> 5) + 1) + (hl & 1); }
struct PGlu {
    static constexpr bool EARLY_AOFF = false, FP8 = false; unsigned char* ws; int G, c; int K; unsigned kstepA; bool lat_only;
    __device__ __forceinline__ bool next(int i, Unit& u) const { const int nH = lat_only ? 256 : 2 * NPAN; const long L = (long)i * G + c; if (L >= nH * 2) return false; pg8::static_decode((int)L, nH, 2, u.pm, u.pn); u.pm = half_panel(u.pm, lat_only); u.z = 0; return true; }
    __device__ __forceinline__ const char* a_base(const Unit& u) const { return (const char*)(ws + WS_YS) + (size_t)u.pm * 128 * 512 * 2; }
    __device__ __forceinline__ unsigned a_off(const Unit&, int R, int Cc) const { return (unsigned)(R * 512 + Cc) * 2u; }
    __device__ __forceinline__ const char* b_base(const Unit& u) const { return (const char*)(ws + WS_WGLU) + (size_t)u.pn * 256 * 512 * 2; }
    __device__ __forceinline__ void epi(const f32x4 (&acc)[2][4][2], f32x4 (&)[2][4][2], const Unit& u, int wr, int wc, int fr, int fq) const {
#pragma unroll
        for (int m = 0; m < 4; ++m) { const size_t r = (size_t)(u.pm * 128 + wr * 64 + m * 16 + fr);
#pragma unroll
            for (int bj = 0; bj < 2; ++bj) { const int cc = u.pn * 256 + bj * 128 + wc * 32 + 8 * fq;
                f32x4 z0, z1; { const v4u w_ = *(const GAS v4u*)((const bf16*)(ws + WS_YS) + r * 512 + cc); unpack8(w_, z0, z1); } const f32x4 a0 = acc[bj][m][0], a1 = acc[bj][m][1];
                z0 = z0 * (f32x4){fsigmoid(a0[0]), fsigmoid(a0[1]), fsigmoid(a0[2]), fsigmoid(a0[3])}; z1 = z1 * (f32x4){fsigmoid(a1[0]), fsigmoid(a1[1]), fsigmoid(a1[2]), fsigmoid(a1[3])};
                *(GAS v4u*)((bf16*)(ws + WS_U) + r * 512 + cc) = pack8(z0, z1); }
            __builtin_amdgcn_sched_barrier(0); }
    }
};

typedef f32x4 Acc128[2][4][2];
struct PMerge {
    static constexpr bool EARLY_AOFF = false, FP8 = false; unsigned char* ws; int G, c; int K; unsigned kstepA; bool lat_only;
    __device__ __forceinline__ bool next(int i, Unit& u) const { const int nH = lat_only ? 256 : 2 * NPAN; const long tile = (long)(i / 3) * G + c; if (tile >= nH * 4) return false; pg8::static_decode((int)tile, nH, 4, u.pm, u.pn); u.pm = half_panel(u.pm, lat_only); u.z = i % 3; return true; }
    __device__ __forceinline__ const char* a_base(const Unit& u) const { const size_t off = u.z == 0 ? WS_U : (u.z == 1 ? WS_AO : WS_NO); return (const char*)(ws + off) + (size_t)u.pm * 128 * 512 * 2; }
    __device__ __forceinline__ unsigned a_off(const Unit&, int R, int Cc) const { return (unsigned)(R * 512 + Cc) * 2u; }
    __device__ __forceinline__ const char* b_base(const Unit& u) const { return (const char*)(ws + WS_WBR) + ((size_t)u.z * 1024 + u.pn * 256) * 512 * 2; }
    __device__ __forceinline__ void epi(const Acc128& acc, Acc128& mrg, const Unit& u, int wr, int wc, int fr, int fq) const {
#pragma unroll
        for (int m = 0; m < 4; ++m) { const size_t r = (size_t)(u.pm * 128 + wr * 64 + m * 16 + fr);
#pragma unroll
            for (int bj = 0; bj < 2; ++bj) { const int cc = u.pn * 256 + bj * 128 + wc * 32 + 8 * fq;
                f32x4 g0, g1;
                if (GATE_BF16) { const v4u w_ = *(const GAS v4u*)((const bf16*)(ws + WS_GATES) + r * 3072 + u.z * 1024 + cc); unpack8(w_, g0, g1); }
                else { const v2u w_ = *(const GAS v2u*)((const unsigned char*)(ws + WS_GATES) + r * 3072 + u.z * 1024 + cc);
                    g0 = (f32x4){__builtin_amdgcn_cvt_f32_fp8((int)w_.x, 0), __builtin_amdgcn_cvt_f32_fp8((int)w_.x, 1), __builtin_amdgcn_cvt_f32_fp8((int)w_.x, 2), __builtin_amdgcn_cvt_f32_fp8((int)w_.x, 3)};
                    g1 = (f32x4){__builtin_amdgcn_cvt_f32_fp8((int)w_.y, 0), __builtin_amdgcn_cvt_f32_fp8((int)w_.y, 1), __builtin_amdgcn_cvt_f32_fp8((int)w_.y, 2), __builtin_amdgcn_cvt_f32_fp8((int)w_.y, 3)}; }
                if (u.z == 0) { mrg[bj][m][0] = g0 * acc[bj][m][0]; mrg[bj][m][1] = g1 * acc[bj][m][1]; }
                else { mrg[bj][m][0] += g0 * acc[bj][m][0]; mrg[bj][m][1] += g1 * acc[bj][m][1]; }
                if (u.z == 2) *(GAS v4u*)((bf16*)(ws + WS_HB) + r * 1024 + cc) = pack8(mrg[bj][m][0], mrg[bj][m][1]); } }
    }
};

struct PWout {
    static constexpr bool EARLY_AOFF = false, FP8 = false; unsigned char* ws; float* out; const float* mod; int G, c; int K; unsigned kstepA; bool lat_only;
    __device__ __forceinline__ bool next(int i, Unit& u) const { const int nH = lat_only ? 256 : 2 * NPAN; const long L = (long)i * G + c; if (L >= nH * 4) return false; pg8::static_decode((int)L, nH, 4, u.pm, u.pn); u.pm = half_panel(u.pm, lat_only); u.z = 0; return true; }
    __device__ __forceinline__ const char* a_base(const Unit& u) const { return (const char*)(ws + WS_HB) + (size_t)u.pm * 128 * 1024 * 2; }
    __device__ __forceinline__ unsigned a_off(const Unit&, int R, int Cc) const { return (unsigned)(R * 1024 + Cc) * 2u; }
    __device__ __forceinline__ const char* b_base(const Unit& u) const { return (const char*)(ws + WS_WOUT) + (size_t)u.pn * 256 * 1024 * 2; }
    __device__ __forceinline__ void epi(const f32x4 (&acc)[2][4][2], f32x4 (&)[2][4][2], const Unit& u, int wr, int wc, int fr, int fq) const {
        const int pm = u.pm >> 1, hh = u.pm & 1, b = pm / 33, pr = pm % 33, cond = pr == 0 ? 4 : b;
        float* xb = pr == 0 ? (float*)(ws + WS_CTXS) + ((size_t)b * 256 + hh * 128) * D : out + ((size_t)b * SEQ + (size_t)(pr - 1) * 256 + hh * 128) * D;
        const float* g1 = mod + cond * 6144 + 2048;
#pragma unroll
        for (int bj = 0; bj < 2; ++bj) { const int cc = u.pn * 256 + bj * 128 + wc * 32 + 8 * fq; const f32x4 ga = *(const GAS f32x4*)(g1 + cc), gb = *(const GAS f32x4*)(g1 + cc + 4);
#pragma unroll
            for (int m = 0; m < 4; ++m) { GAS f32x4* p = (GAS f32x4*)(xb + (size_t)(wr * 64 + m * 16 + fr) * D + cc);
                p[0] = p[0] + ga * acc[bj][m][0]; p[1] = p[1] + gb * acc[bj][m][1]; __builtin_amdgcn_sched_barrier(0); } }
    }
};

struct ExpTab { int cnt[16], tile0[17]; };
__device__ __forceinline__ int exp_find(const int (&tile0)[17], int q) { int e = 0;
#pragma unroll
    for (int k = 1; k < 16; ++k) e += (q >= tile0[k]) ? 1 : 0;
    return e; }

struct PMoe1 {
    static constexpr bool EARLY_AOFF = true, FP8 = true; unsigned char* ws; const LAS int* tab; int G, c; int K; unsigned kstepA;
    __device__ __forceinline__ bool next(int i, Unit& u) const { const long L = (long)i * G + c; const int total = __builtin_amdgcn_readfirstlane(tab[32]) * 4; if (L >= total) return false; const int q = (int)L >> 2; u.pn = (int)L & 3;
        int e = 0;
#pragma unroll
        for (int k = 1; k < 16; ++k) e += (q >= __builtin_amdgcn_readfirstlane(tab[16 + k])) ? 1 : 0;
        u.z = e; u.pm = q - __builtin_amdgcn_readfirstlane(tab[16 + e]); return true; }
    __device__ __forceinline__ const char* a_base(const Unit&) const { return (const char*)(ws + WS_HB8); }
    __device__ __forceinline__ unsigned a_off(const Unit& u, int R, int Cc) const { int r = u.pm * 128 + R; const int n = __builtin_amdgcn_readfirstlane(tab[u.z]); r = r < n ? r : n - 1;
        const int ent = ((const int*)(ws + WS_LIST))[(size_t)u.z * T + r]; return (unsigned)((ent >> 1) * 1024 + Cc * 2); }
    __device__ __forceinline__ const char* b_base(const Unit& u) const { return (const char*)(ws + WS_MOE1) + ((size_t)u.z * 1024 + u.pn * 256) * 1024; }
    __device__ __forceinline__ void epi(const f32x4 (&acc)[2][4][2], f32x4 (&)[2][4][2], const Unit& u, int wr, int wc, int fr, int fq) const {
        const size_t arow0 = (size_t)(__builtin_amdgcn_readfirstlane(tab[16 + u.z]) + u.pm) * 128;
#pragma unroll
        for (int m = 0; m < 4; ++m) { const f32x4 g0 = acc[0][m][0] * (1.f / 64.f), g1 = acc[0][m][1] * (1.f / 64.f), u0 = acc[1][m][0] * (8.f / 64.f), u1 = acc[1][m][1] * (8.f / 64.f);
            const f32x4 v0 = (f32x4){g0[0] * fsigmoid(g0[0]), g0[1] * fsigmoid(g0[1]), g0[2] * fsigmoid(g0[2]), g0[3] * fsigmoid(g0[3])} * u0;
            const f32x4 v1 = (f32x4){g1[0] * fsigmoid(g1[0]), g1[1] * fsigmoid(g1[1]), g1[2] * fsigmoid(g1[2]), g1[3] * fsigmoid(g1[3])} * u1;
            *(GAS v2u*)((unsigned char*)(ws + WS_ACT) + (arow0 + wr * 64 + m * 16 + fr) * 512 + u.pn * 128 + wc * 32 + 8 * fq) = (v2u){pk4_fp8(v0[0], v0[1], v0[2], v0[3]), pk4_fp8(v1[0], v1[1], v1[2], v1[3])}; }
    }
};
struct PMoe2 {
    static constexpr bool EARLY_AOFF = false, FP8 = true; unsigned char* ws; const LAS int* tab; int G, c; int K; unsigned kstepA;
    __device__ __forceinline__ bool next(int i, Unit& u) const { const long L = (long)i * G + c; const int total = __builtin_amdgcn_readfirstlane(tab[32]) * 4; if (L >= total) return false; const int q = (int)L >> 2; u.pn = (int)L & 3;
        int e = 0;
#pragma unroll
        for (int k = 1; k < 16; ++k) e += (q >= __builtin_amdgcn_readfirstlane(tab[16 + k])) ? 1 : 0;
        u.z = e; u.pm = q - __builtin_amdgcn_readfirstlane(tab[16 + e]); return true; }
    __device__ __forceinline__ const char* a_base(const Unit& u) const { return (const char*)(ws + WS_ACT) + (size_t)(__builtin_amdgcn_readfirstlane(tab[16 + u.z]) + u.pm) * 128 * 512; }
    __device__ __forceinline__ unsigned a_off(const Unit&, int R, int Cc) const { return (unsigned)(R * 512 + Cc * 2); }
    __device__ __forceinline__ const char* b_base(const Unit& u) const { return (const char*)(ws + WS_MOE2) + ((size_t)u.z * 1024 + u.pn * 256) * 512; }
    __device__ __forceinline__ void epi(const f32x4 (&acc)[2][4][2], f32x4 (&)[2][4][2], const Unit& u, int wr, int wc, int fr, int fq) const {
        const int n = __builtin_amdgcn_readfirstlane(tab[u.z]);
#pragma unroll
        for (int m = 0; m < 4; ++m) { const int r = u.pm * 128 + wr * 64 + m * 16 + fr; if (r >= n) continue;
            const int ent = ((const int*)(ws + WS_LIST))[(size_t)u.z * T + r]; const float w = ((const float*)(ws + WS_RW))[ent] * (1.f / 256.f);
#pragma unroll
            for (int bj = 0; bj < 2; ++bj)
                *(GAS v4u*)((bf16*)(ws + WS_YSLOT) + (size_t)ent * 1024 + u.pn * 256 + bj * 128 + wc * 32 + 8 * fq) = pack8(acc[bj][m][0] * w, acc[bj][m][1] * w); }
    }
};
struct PMoe1B {
    static constexpr bool EARLY_AOFF = true, FP8 = false; unsigned char* ws; const LAS int* tab; int G, c; int K; unsigned kstepA;
    __device__ __forceinline__ bool next(int i, Unit& u) const { const long L = (long)i * G + c; const int total = tab[32] * 4; if (L >= total) return false; const int q = (int)L >> 2; u.pn = (int)L & 3;
        int e = 0;
#pragma unroll
        for (int k = 1; k < 16; ++k) e += (q >= tab[16 + k]) ? 1 : 0;
        u.z = e; u.pm = q - tab[16 + e]; return true; }
    __device__ __forceinline__ const char* a_base(const Unit&) const { return (const char*)(ws + WS_HB); }
    __device__ __forceinline__ unsigned a_off(const Unit& u, int h, int R, int Cc) const { int r = u.pm * 256 + h * 128 + R; const int n = tab[u.z]; r = r < n ? r : n - 1;
        const int ent = ((const int*)(ws + WS_LIST))[(size_t)u.z * T + r]; return (unsigned)((ent >> 1) * 1024 + Cc) * 2u; }
    __device__ __forceinline__ const char* b_base(const Unit& u) const { return (const char*)(ws + WS_MOE1) + ((size_t)u.z * 1024 + u.pn * 256) * 1024 * 2; }
    __device__ __forceinline__ void epi(const Acc& acc, const Unit& u, int wr, int wc, int fr, int fq) const {
        const size_t arow0 = (size_t)(tab[16 + u.z] + u.pm) * 256;
#pragma unroll
        for (int ai = 0; ai < 2; ++ai)
#pragma unroll
            for (int m = 0; m < 4; ++m) { const f32x4 g0 = acc[ai][0][m][0], g1 = acc[ai][0][m][1], u0 = acc[ai][1][m][0], u1 = acc[ai][1][m][1];
                const f32x4 v0 = (f32x4){g0[0] * fsigmoid(g0[0]), g0[1] * fsigmoid(g0[1]), g0[2] * fsigmoid(g0[2]), g0[3] * fsigmoid(g0[3])} * u0;
                const f32x4 v1 = (f32x4){g1[0] * fsigmoid(g1[0]), g1[1] * fsigmoid(g1[1]), g1[2] * fsigmoid(g1[2]), g1[3] * fsigmoid(g1[3])} * u1;
                *(GAS v4u*)((bf16*)(ws + WS_ACTB) + (arow0 + ai * 128 + wr * 64 + m * 16 + fr) * 512 + u.pn * 128 + wc * 32 + 8 * fq) = pack8(v0, v1); }
    }
};
struct PMoe2B {
    static constexpr bool EARLY_AOFF = false, FP8 = false; unsigned char* ws; const LAS int* tab; int G, c; int K; unsigned kstepA;
    __device__ __forceinline__ bool next(int i, Unit& u) const { const long L = (long)i * G + c; const int total = tab[32] * 4; if (L >= total) return false; const int q = (int)L >> 2; u.pn = (int)L & 3;
        int e = 0;
#pragma unroll
        for (int k = 1; k < 16; ++k) e += (q >= tab[16 + k]) ? 1 : 0;
        u.z = e; u.pm = q - tab[16 + e]; return true; }
    __device__ __forceinline__ const char* a_base(const Unit& u) const { return (const char*)(ws + WS_ACTB) + (size_t)(tab[16 + u.z] + u.pm) * 256 * 512 * 2; }
    __device__ __forceinline__ unsigned a_off(const Unit&, int h, int R, int Cc) const { return (unsigned)((h * 128 + R) * 512 + Cc) * 2u; }
    __device__ __forceinline__ const char* b_base(const Unit& u) const { return (const char*)(ws + WS_MOE2) + ((size_t)u.z * 1024 + u.pn * 256) * 512 * 2; }
    __device__ __forceinline__ void epi(const Acc& acc, const Unit& u, int wr, int wc, int fr, int fq) const {
        const int n = tab[u.z];
#pragma unroll
        for (int ai = 0; ai < 2; ++ai)
#pragma unroll
            for (int m = 0; m < 4; ++m) { const int r = u.pm * 256 + ai * 128 + wr * 64 + m * 16 + fr; if (r >= n) continue;
                const int ent = ((const int*)(ws + WS_LIST))[(size_t)u.z * T + r]; const float w = ((const float*)(ws + WS_RW))[ent];
#pragma unroll
                for (int bj = 0; bj < 2; ++bj)
                    *(GAS v4u*)((bf16*)(ws + WS_YSLOT) + (size_t)ent * 1024 + u.pn * 256 + bj * 128 + wc * 32 + 8 * fq) = pack8(acc[ai][bj][m][0] * w, acc[ai][bj][m][1] * w); }
    }
};
__device__ __forceinline__ void build_exptab(const Ctx& C, LAS int* tab, int l, int tsh = 7) {
    __syncthreads();
    if (threadIdx.x == 0) { int t0 = 0;
        for (int e = 0; e < 16; ++e) { const int n = (int)__hip_atomic_load((unsigned*)(C.ctl + CW_CNT + l * 1024 + 64 * e), RLX_AGENT); tab[e] = n; tab[16 + e] = t0; t0 += (n + (1 << tsh) - 1) >> tsh; }
        tab[32] = t0; }
    __syncthreads();
}
__device__ __forceinline__ void phase_attn(const Ctx& C, int l, unsigned char* lds_gen) {
    phase_carry(C, l);
    char* shm = (char*)lds_gen;
    bf16* QA = WSP(bf16, WS_QA); bf16* KA = WSP(bf16, WS_KA); bf16* VA = WSP(bf16, WS_VA); bf16* QN = WSP(bf16, WS_QN); bf16* KN = WSP(bf16, WS_KN); bf16* VN = WSP(bf16, WS_VN);
#ifndef ATTN_SEL
#define ATTN_SEL 3
#endif
#ifdef REPMASK
#define REPMASK_ REPMASK
#else
#define REPMASK_ 0
#endif
    const int per = (1024 + C.G - 1) / C.G;
    if (ATTN_SEL & 1) for (int i = 0; i < per * (1 + ((REPMASK_ >> 13) & 1)); ++i) { const int id = C.vcu * per + (i % per); if (id >= 1024) continue; const int bh = id >> 5, b = bh >> 3, h = bh & 7, qb = id & 31;
        const bf16* Qu = QA + (size_t)(b * LB + CTX + qb * 256) * 512 + h * 64;
        attn_body::attn_unit<8, false, 512, 128>(Qu, 512, KA + (size_t)(b * LB) * 128 + (h >> 2) * 64, VA + (size_t)(b * LB) * 128 + (h >> 2) * 64, 128, WSP(bf16, WS_AO) + (Qu - QA), LB / 64, 0, 0, shm);
    }
    LAS float* bt = (LAS float*)(C.lds + attn_body::LDS_BT);
    const int nctx = (C.vcu >= 64 && C.vcu < 128) ? 1 : 0;
    if (ATTN_SEL & 2) for (int i0 = 0; i0 < (per + nctx) * (1 + ((REPMASK_ >> 14) & 1)); ++i0) { const int i = i0 % (per + nctx);
        const bf16 *Qu, *Kh, *Vh; bf16* Ou; int kvp = 512, NT = 4, r0 = 0, rlo = 0;
        if (i < per) { const int id = C.vcu * per + i; if (id >= 1024) continue; const int bh = id >> 5, b = bh >> 3, h = bh & 7; r0 = (id & 31) * 4;
            const float* rp = C.in[I_RPB] + (size_t)(l * 8 + h) * 465;
            for (int k = C.tid; k < 465; k += 512) bt[k] = rp[k] * LOG2E;
            rlo = r0 - 4 < 0 ? 0 : (r0 - 4 > 120 ? 120 : r0 - 4); const int rh_ = r0 - 1 < 0 ? 0 : (r0 - 1 > 120 ? 120 : r0 - 1), nloc = rh_ + 8 - rlo; NT = (4 + nloc + 1) & ~1;
            Qu = QN + (size_t)(b * LB + CTX + r0 * 64) * 512 + h * 64; Ou = WSP(bf16, WS_NO) + (Qu - QN); Kh = KN + (size_t)(b * LB) * 512 + h * 64; Vh = VN + (size_t)(b * LB) * 512 + h * 64; }
        else { int j = C.vcu - 64; if (j < 32) { const int b = j >> 3, h = j & 7; Qu = QA + (size_t)(b * LB) * 512 + h * 64; Ou = WSP(bf16, WS_AO) + (Qu - QA); Kh = KA + (size_t)(b * LB) * 128 + (h >> 2) * 64; Vh = VA + (size_t)(b * LB) * 128 + (h >> 2) * 64; kvp = 128; }
            else { j -= 32; const int b = j >> 3, h = j & 7; Qu = QN + (size_t)(b * LB) * 512 + h * 64; Ou = WSP(bf16, WS_NO) + (Qu - QN); Kh = KN + (size_t)(b * LB) * 512 + h * 64; Vh = VN + (size_t)(b * LB) * 512 + h * 64; } }
        attn_body::attn_unit<8, true, 512, 0>(Qu, 512, Kh, Vh, kvp, Ou, NT, r0, rlo, shm);
    }
}

constexpr int NPH = 46;
__global__ void __launch_bounds__(NWAVES * 64, 2) fwd(Args args) {
    extern __shared__ __attribute__((aligned(16))) unsigned char lds[];
    Ctx C; C.in = (const __attribute__((address_space(4))) CFP*)__builtin_amdgcn_kernarg_segment_ptr(); C.out = args.out; C.ws = args.ws; C.lds = (LAS unsigned char*)lds; C.ctl = (gu32*)(args.ws + WS_CTL);
    C.tid = 0; C.lane = 0; C.wave = __builtin_amdgcn_readfirstlane((int)threadIdx.x >> 6);
    C.G = gridDim.x; { const int bx = blockIdx.x; C.vcu = (C.G % 8 == 0) ? (bx % 8) * (C.G / 8) + bx / 8 : bx; }
    for (int u = threadIdx.x; u < (LDS_BYTES - LDSCTL_OFF) / 4; u += NWAVES * 64) ((LAS unsigned*)(C.lds + LDSCTL_OFF))[u] = 0u;
    __syncthreads();
    const int lo = args.ph_lo, hi = args.ph_hi;
    XcdBarrier bar; bar.bar = (unsigned*)(C.ctl + CW_BAR); bar.x = 0; bar.st = nullptr;
    if (hi - lo > 1) bar = xcd_barrier_post((unsigned*)(C.ctl + CW_BAR), (volatile LAS unsigned*)(C.lds + MISC_OFF) + 8);
    LAS int* tab = (LAS int*)(C.lds + LDSCTL_OFF);
    const int cg = (int)blockIdx.x;
#ifndef PHMASK
#define PHMASK 0xFFFF
#endif
#define IN(k) (lo <= (k) && (k) < hi)
#define EN(b) ((PHMASK >> (b)) & 1)
#ifndef REPMASK
#define REPMASK 0
#endif
#define RUN(b, stmt) do { stmt; if ((REPMASK >> (b)) & 1) { stmt; } } while (0)
#ifdef DIAG_SEL
#define DIAG_ACC(ty) do { if (blockIdx.x == 0 && threadIdx.x == 0) { volatile LAS unsigned* dg = (volatile LAS unsigned*)(C.lds + LDSCTL_OFF + 160); const unsigned now = (unsigned)__builtin_amdgcn_s_memrealtime(); dg[8 + (ty)] += now - dg[0]; dg[0] = now; } } while (0)
#else
#define DIAG_ACC(ty) do {} while (0)
#endif
#define SEAM(k) do { if (IN(k) && IN((k) + 1)) xcd_barrier(bar); DIAG_ACC((k) == 0 ? 11 : ((k) - 1) % 11); } while (0)
#define LWS() ({ const __attribute__((address_space(4))) CFP* k_ = C.in; asm volatile("" : "+s"(k_)); (unsigned char*)k_[30]; })
#define LC() ({ Ctx c_ = C; c_.tid = threadIdx.x; asm volatile("" : "+v"(c_.tid)); c_.lane = c_.tid & 63; asm volatile("" : "+s"(c_.in)); c_.ws = (unsigned char*)c_.in[30]; c_.out = (float*)c_.in[29]; c_.ctl = (gu32*)(c_.ws + WS_CTL); c_; })
#ifdef DIAG_SEL
    if (blockIdx.x == 0 && threadIdx.x == 0) { volatile LAS unsigned* dg = (volatile LAS unsigned*)(C.lds + LDSCTL_OFF + 160); dg[0] = (unsigned)__builtin_amdgcn_s_memrealtime(); dg[1] = dg[0]; }
#endif
    if (EN(11) && IN(0)) { const Ctx Cl = LC(); phase_mod(Cl); RUN(11, phase_s5mats(Cl, 0); phase_weights(Cl, 0)); }
    SEAM(0);
    for (int l = 0; l < NLAYER; ++l) {
        const int pb = 1 + 11 * l;
        if (EN(0) && IN(pb)) { const Ctx Cl = LC(); if (l == 0) phase_rows<0>(Cl, 0); else { phase_s5mats(Cl, l); phase_weights(Cl, l); phase_rows<1>(Cl, l); } }
        SEAM(pb);
        if (EN(1) && IN(pb + 1)) { { PWin P{LWS(), C.G, cg, 1024, 128u}; pg8::gemm_phase(C.lds, P); } { PGate P{LWS(), C.G, cg, 1024, 128u}; pg8::gemm_phase_m128(C.lds, P); } }
        SEAM(pb + 1);
        if (EN(2) && IN(pb + 2)) { { const Ctx Cl = LC(); phase_qkprep(Cl, l); } PS5A P{LWS(), C.G, cg, 512, 128u}; RUN(2, pg8::gemm_phase(C.lds, P)); }
        SEAM(pb + 2);
        if (EN(3) && IN(pb + 3)) { const Ctx Cl = LC(); RUN(3, phase_attn(Cl, l, lds)); }
        SEAM(pb + 3);
        if (EN(4) && IN(pb + 4)) { PS5B P{LWS(), C.G, cg, 256, 128u}; pg8::gemm_phase(C.lds, P); }
        SEAM(pb + 4);
        if (EN(5) && IN(pb + 5)) { PGlu P{LWS(), C.G, cg, 512, 128u, l == NLAYER - 1}; pg8::gemm_phase_m128(C.lds, P); }
        SEAM(pb + 5);
        if (EN(6) && IN(pb + 6)) { PMerge P{LWS(), C.G, cg, 512, 128u, l == NLAYER - 1}; pg8::gemm_phase_m128(C.lds, P); }
        SEAM(pb + 6);
        if (EN(7) && IN(pb + 7)) { unsigned char* wl_ = LWS(); PWout P{wl_, (float*)C.in[29], (const float*)(wl_ + WS_MOD) + (size_t)l * 5 * 6144, C.G, cg, 1024, 128u, l == NLAYER - 1}; pg8::gemm_phase_m128(C.lds, P); }
        SEAM(pb + 7);
        if (EN(8) && IN(pb + 8)) { const Ctx Cl = LC(); phase_norm2(Cl, l); }
        SEAM(pb + 8);
        if (EN(9) && IN(pb + 9)) { if (FP8_MOE) { build_exptab(C, tab, l); PMoe1 P{LWS(), tab, C.G, cg, 1024, 128u}; pg8::gemm_phase_m128(C.lds, P); } else { build_exptab(C, tab, l, 8); PMoe1B P{LWS(), tab, C.G, cg, 1024, 128u}; pg8::gemm_phase(C.lds, P); } }
        SEAM(pb + 9);
        if (EN(10) && IN(pb + 10)) { if (FP8_MOE) { build_exptab(C, tab, l); PMoe2 P{LWS(), tab, C.G, cg, 512, 128u}; pg8::gemm_phase_m128(C.lds, P); } else { build_exptab(C, tab, l, 8); PMoe2B P{LWS(), tab, C.G, cg, 512, 128u}; pg8::gemm_phase(C.lds, P); } }
        SEAM(pb + 10);
    }
    if (EN(12) && IN(NPH - 1)) { const Ctx Cl = LC(); phase_rows<2>(Cl, NLAYER); }
#ifdef DIAG_SEL
    xcd_barrier(bar); DIAG_ACC(12);
    if (blockIdx.x == 0 && threadIdx.x == 0) { volatile LAS unsigned* dg = (volatile LAS unsigned*)(C.lds + LDSCTL_OFF + 160); dg[8 + 13] = dg[0] - dg[1];
        for (int i = 0; i < 14; ++i) __hip_atomic_store(C.ctl + 2048 + i, dg[8 + i], RLX_AGENT); }
    xcd_barrier(bar);
    { const float d1 = (float)__hip_atomic_load(C.ctl + 2048 + (DIAG_SEL), RLX_AGENT) * 0.01f, d2 = (float)__hip_atomic_load(C.ctl + 2048 + (DIAG_SEL) + 1, RLX_AGENT) * 0.01f;
      const float c1 = sqrtf(d1); float* o = args.out;
      for (size_t i = (size_t)blockIdx.x * 512 + threadIdx.x; i < (size_t)NB * SEQ * D; i += (size_t)gridDim.x * 512) o[i] = (i == 12345) ? d2 : c1; }
#endif
#undef IN
#undef SEAM
}

#ifndef MK_PER_PHASE
#define MK_PER_PHASE 0
#endif
extern "C" void kernel_launch(void* const* d_in, const int* in_sizes, int n_in, void* d_out, int out_size, void* d_ws, size_t ws_size, hipStream_t stream) {
    static int grid = 0;
    if (grid == 0) {
        if (n_in != 29 || out_size != NB * SEQ * D || ws_size < WS_END) { fprintf(stderr, "kernel_launch: unexpected shapes (n_in %d out %d ws %zu)\n", n_in, out_size, ws_size); grid = -1; return; }
        int dev = 0, cus = 0, per_cu = 0;
        if (hipGetDevice(&dev) != hipSuccess || hipDeviceGetAttribute(&cus, hipDeviceAttributeMultiprocessorCount, dev) != hipSuccess) { grid = -1; return; }
        if (hipFuncSetAttribute((const void*)fwd, hipFuncAttributeMaxDynamicSharedMemorySize, LDS_BYTES) != hipSuccess) { grid = -1; return; }
        if (hipOccupancyMaxActiveBlocksPerMultiprocessor(&per_cu, (const void*)fwd, NWAVES * 64, LDS_BYTES) != hipSuccess || per_cu < 1) fprintf(stderr, "kernel_launch: occupancy query says %d\n", per_cu);
        (void)hipGetLastError();
        grid = cus;
    }
    if (grid < 0) return;
    (void)hipMemsetAsync((char*)d_ws + WS_CTL, 0, CTL_ZERO_BYTES, stream);
    Args a{};
    for (int i = 0; i < 29; ++i) a.in[i] = (const float*)d_in[i];
    a.out = (float*)d_out; a.ws = (unsigned char*)d_ws;
#if MK_PER_PHASE
    for (int p = 0; p < NPH; ++p) { a.ph_lo = p; a.ph_hi = p + 1; hipLaunchKernelGGL(fwd, dim3(grid), dim3(NWAVES * 64), LDS_BYTES, stream, a); }
#else
    a.ph_lo = 0; a.ph_hi = NPH; hipLaunchKernelGGL(fwd, dim3(grid), dim3(NWAVES * 64), LDS_BYTES, stream, a);
#endif
}
```

```cpp
#define FP8_MOE 1
#define GATE_BF16 0
#define H8_WRITE 1
#ifndef H8_WRITE
#define H8_WRITE 1
#endif
#ifndef GATE_BF16
#define GATE_BF16 0
#endif
#include <hip/hip_runtime.h>
#include <cstdio>
#include <cstdint>

#define GAS __attribute__((address_space(1)))
#define LAS __attribute__((address_space(3)))
typedef unsigned short bf16;
typedef unsigned v4u __attribute__((ext_vector_type(4)));
typedef unsigned v2u __attribute__((ext_vector_type(2)));
typedef float f32x4 __attribute__((ext_vector_type(4)));
typedef float f32x2 __attribute__((ext_vector_type(2)));
typedef float f32x16 __attribute__((ext_vector_type(16)));
typedef short bf16x8 __attribute__((ext_vector_type(8)));
typedef short s16x4 __attribute__((ext_vector_type(4)));
typedef GAS unsigned gu32;
#define RLX_AGENT __ATOMIC_RELAXED, __HIP_MEMORY_SCOPE_AGENT
#define LDS_WAIT() asm volatile("s_waitcnt lgkmcnt(0)" ::: "memory")
#define VM_WAIT() asm volatile("s_waitcnt vmcnt(0)" ::: "memory")

constexpr int NB = 4, SEQ = 8192, CTX = 256, LB = SEQ + CTX, T = NB * LB, D = 1024, NPAN = T / 256;
constexpr int NLAYER = 4, INW = 5888, NCH = LB / 32, NCR = NB * NCH;
constexpr int NEXP = 16, FF = 512;
constexpr float EPS = 1e-6f;
constexpr float LOG2E = 1.4426950408889634f;
constexpr float C2 = 0.125f * LOG2E;
constexpr int NWAVES = 8;

constexpr size_t MiB = 1u << 20;
constexpr size_t WS_CTL = 0, CTL_ZERO_BYTES = 1 * MiB;
constexpr size_t WS_MOD = 1 * MiB;
constexpr size_t WS_LIST = 2 * MiB;
constexpr size_t WS_RW = 5 * MiB;
constexpr size_t WS_CTXS = 6 * MiB;
constexpr size_t WS_SST = 10 * MiB;
constexpr size_t WS_HB8 = WS_SST;
constexpr size_t WS_XST = 44 * MiB;
constexpr size_t WS_BT1 = 61 * MiB;
constexpr size_t WS_BT2 = 85 * MiB;
constexpr size_t WS_WIN = 93 * MiB;
constexpr size_t WS_WIN8 = WS_WIN + (size_t)2816 * 1024 * 2;
constexpr size_t WS_WGLU = 105 * MiB;
constexpr size_t WS_WBR = 106 * MiB;
constexpr size_t WS_WOUT = 109 * MiB;
constexpr size_t WS_MOE1 = 111 * MiB;
constexpr size_t WS_MOE2 = 143 * MiB;
constexpr size_t WS_HB = 159 * MiB;
constexpr size_t WS_U = 225 * MiB;
constexpr size_t WS_QA = 258 * MiB;
constexpr size_t WS_KA = 291 * MiB;
constexpr size_t WS_VA = 300 * MiB;
constexpr size_t WS_QN = 309 * MiB;
constexpr size_t WS_KN = 342 * MiB;
constexpr size_t WS_VN = 375 * MiB;
constexpr size_t WS_YS = 408 * MiB;
constexpr size_t WS_GATES = 441 * MiB;
constexpr size_t WS_ACT = WS_QN;
constexpr size_t WS_ACTB = WS_QN;
constexpr size_t WS_YSLOT = WS_GATES;
constexpr size_t WS_AO = 640 * MiB;
constexpr size_t WS_NO = 673 * MiB;
constexpr size_t WS_YG = 706 * MiB;
constexpr size_t WS_END = 739 * MiB;
static_assert(WS_GATES + (size_t)T * 3072 * 2 <= WS_AO && WS_ACT + (size_t)(2 * T + 4096) * 512 * 2 <= WS_YS, "ws map");
constexpr int CW_FAIL = 8;
constexpr int CW_CNT = 64;
constexpr int CW_BAR = 8192;

constexpr int RING_BYTES = 131072, LDS_BYTES = 147456, LDSCTL_OFF = LDS_BYTES - 512, MISC_OFF = LDSCTL_OFF + 320;

__device__ __forceinline__ unsigned f2bf(float f) { unsigned u = __builtin_bit_cast(unsigned, f); return (u + 0x7fffu + ((u >> 16) & 1u)) >> 16; }
__device__ __forceinline__ unsigned pk2(float lo, float hi) { return f2bf(lo) | (f2bf(hi) << 16); }
__device__ __forceinline__ float bf2f(unsigned b) { return __builtin_bit_cast(float, b << 16); }
__device__ __forceinline__ float bflo(unsigned w) { return __builtin_bit_cast(float, w << 16); }
__device__ __forceinline__ float bfhi(unsigned w) { return __builtin_bit_cast(float, w & 0xffff0000u); }
typedef float f32x2_c __attribute__((ext_vector_type(2))); typedef __bf16 bf16x2_c __attribute__((ext_vector_type(2)));
__device__ __forceinline__ unsigned cvt_pk_bf16(float lo, float hi) { const f32x2_c v = {lo, hi}; return __builtin_bit_cast(unsigned, __builtin_convertvector(v, bf16x2_c)); }
typedef int v8i __attribute__((ext_vector_type(8)));
typedef int v4i __attribute__((ext_vector_type(4)));
__device__ __forceinline__ float clamp8(float x) { return __builtin_fminf(__builtin_fmaxf(x, -448.f), 448.f); }
__device__ __forceinline__ unsigned pk4_fp8(float a, float b, float c, float d) { int w = 0; w = __builtin_amdgcn_cvt_pk_fp8_f32(clamp8(a), clamp8(b), w, false); w = __builtin_amdgcn_cvt_pk_fp8_f32(clamp8(c), clamp8(d), w, true); return (unsigned)w; }
__device__ __forceinline__ float fsigmoid(float x) { return __builtin_amdgcn_rcpf(1.f + __builtin_amdgcn_exp2f(-LOG2E * x)); }
__device__ __forceinline__ float gelu_tanh(float x) { const float u = 0.7978845608f * (x + 0.044715f * x * x * x); return x * __builtin_amdgcn_rcpf(1.f + __builtin_amdgcn_exp2f(-2.f * LOG2E * u)); }
__device__ __forceinline__ float shflx(float v, int m, int lane) { return __builtin_bit_cast(float, __builtin_amdgcn_ds_bpermute((lane ^ m) << 2, __builtin_bit_cast(int, v))); }
template <int CTRL, int RM>
__device__ __forceinline__ float dpp_mov(float v) { return __builtin_bit_cast(float, __builtin_amdgcn_update_dpp(0, __builtin_bit_cast(int, v), CTRL, RM, 0xF, true)); }
__device__ __forceinline__ float wave_sum(float v, int) {
    v += dpp_mov<0xB1, 0xF>(v);
    v += dpp_mov<0x4E, 0xF>(v);
    v += dpp_mov<0x141, 0xF>(v);
    v += dpp_mov<0x140, 0xF>(v);
    v += dpp_mov<0x142, 0xA>(v);
    v += dpp_mov<0x143, 0xC>(v);
    return __builtin_bit_cast(float, __builtin_amdgcn_readlane(__builtin_bit_cast(int, v), 63));
}
__device__ __forceinline__ float sin_rev(float r) { r = r - floorf(r); return __builtin_amdgcn_sinf(r); }
__device__ __forceinline__ float cos_rev(float r) { r = r - floorf(r); return __builtin_amdgcn_cosf(r); }

#define XB_TMO      128
#define XB_XCNT(j)  (256  + 64 * (j))
#define XB_XSUB(j)  (1280 + 64 * (j))
#define XB_XGEN(j)  (2304 + 64 * (j))
#define XB_TOP      3328
#define XB_TOPGEN   3392
#define XCD_BAR_WORDS 3456
#define XB_SPIN_CAP (1u << 22)

__device__ __forceinline__ unsigned xb_ld(unsigned* p)              { return __hip_atomic_load(p, __ATOMIC_RELAXED, __HIP_MEMORY_SCOPE_AGENT); }
__device__ __forceinline__ unsigned xb_add(unsigned* p, unsigned v) { return __hip_atomic_fetch_add(p, v, __ATOMIC_RELAXED, __HIP_MEMORY_SCOPE_AGENT); }
__device__ __forceinline__ unsigned xb_xcc_id() { return (unsigned)__builtin_amdgcn_s_getreg((3 << 11) | 20) & 0xFu; }
#define XB_SPIN(cond, bar) do { unsigned _sp = 0; while (cond) { __builtin_amdgcn_s_sleep(1); \
    if ((++_sp & 255u) == 0u) { if (xb_ld(&(bar)[XB_TMO])) break; if (_sp > XB_SPIN_CAP) { atomicAdd(&(bar)[XB_TMO], 1u); break; } } } } while (0)

struct XcdBarrier { unsigned* bar; unsigned x; volatile LAS unsigned* st; };

__device__ __forceinline__ XcdBarrier xcd_barrier_post(unsigned* bar, volatile LAS unsigned* st) {
    XcdBarrier b; b.bar = bar; b.x = xb_xcc_id(); b.st = st;
    if (threadIdx.x == 0) (void)xb_add(&bar[XB_XCNT(b.x)], 1u);
    return b;
}
__device__ __forceinline__ void xcd_barrier_complete(unsigned* bar, unsigned x, unsigned& nloc, unsigned& nx) {
    const unsigned G = gridDim.x * gridDim.y * gridDim.z;
    unsigned sum, cnt, mine, sp = 0u;
    for (;;) {
        sum = 0u; cnt = 0u; mine = 0u;
#pragma unroll
        for (unsigned j = 0; j < 16; ++j) { const unsigned c = xb_ld(&bar[XB_XCNT(j)]); sum += c; cnt += (c > 0u) ? 1u : 0u; mine = (j == x) ? c : mine; }
        if (sum == G) break;
        __builtin_amdgcn_s_sleep(1);
        if ((++sp & 255u) == 0u) { if (xb_ld(&bar[XB_TMO])) break; if (sp > XB_SPIN_CAP) { atomicAdd(&bar[XB_TMO], 1u); break; } }
    }
    nloc = mine > 0u ? mine : 1u; nx = cnt > 0u ? cnt : 1u;
}
__device__ __forceinline__ void xcd_barrier(const XcdBarrier& b) {
    asm volatile("s_waitcnt vmcnt(0)" ::: "memory");
    __syncthreads();
    if (threadIdx.x == 0) {
        unsigned* bar = b.bar;
        __builtin_amdgcn_s_waitcnt(0);
        unsigned nloc = b.st[0], nx = b.st[1];
        if (nloc == 0u) { xcd_barrier_complete(bar, b.x, nloc, nx); b.st[0] = nloc; b.st[1] = nx; }
        const unsigned old = xb_add(&bar[XB_XSUB(b.x)], 1u);
        const unsigned gen = old / nloc;
        if (old + 1u == (gen + 1u) * nloc) {
            __builtin_amdgcn_fence(__ATOMIC_RELEASE, "agent");
            asm volatile("s_waitcnt vmcnt(0)" ::: "memory");
            const unsigned og = xb_add(&bar[XB_TOP], 1u);
            const unsigned tg = og / nx;
            if (og + 1u == (tg + 1u) * nx) xb_add(&bar[XB_TOPGEN], 1u);
            else XB_SPIN(xb_ld(&bar[XB_TOPGEN]) == tg, bar);
            __builtin_amdgcn_fence(__ATOMIC_ACQUIRE, "agent");
            xb_add(&bar[XB_XGEN(b.x)], 1u);
            asm volatile("s_waitcnt vmcnt(0)" ::: "memory");
        } else {
            XB_SPIN(xb_ld(&bar[XB_XGEN(b.x)]) == gen, bar);
            __builtin_amdgcn_fence(__ATOMIC_ACQUIRE, "agent");
            asm volatile("s_waitcnt vmcnt(0)" ::: "memory");
        }
    }
    __syncthreads();
}

namespace pg8 {
constexpr int BM = 256, BK = 64, HALF = 128, HTB = HALF * BK * 2, STAGE_BYTES = 8 * HTB, NXCD = 8, WGM = 8;
__host__ __device__ __forceinline__ int lds_byte(int r, int c) { const int st = (r >> 4) * 2 + (c >> 5), rr = r & 15, cc = c & 31, ob = rr * 64 + cc * 2; return st * 1024 + (ob ^ (((ob >> 9) & 1) << 5)); }
__host__ __device__ __forceinline__ void stage_rc(int b, int& R, int& C) { const int st = b / 1024, sb = b % 1024, swz = sb ^ (((sb >> 9) & 1) << 5); R = (st >> 1) * 16 + swz / 64; C = (st & 1) * 32 + (swz % 64) / 2; }
__host__ __device__ __forceinline__ int perm32(int rho) { const int n = rho >> 4, i = rho & 15; return 8 * (i >> 2) + 4 * n + (i & 3); }

struct Unit { int pm, pn, z; };

__device__ __forceinline__ void static_decode(int L, int nM, int nN, int& pm, int& pn) {
    const int nwg = nM * nN; int wgid = L;
    { const int q = nwg / NXCD, r = nwg % NXCD, xcd = wgid % NXCD, off = wgid / NXCD; wgid = (xcd < r ? xcd * (q + 1) : r * (q + 1) + (xcd - r) * q) + off; }
    const int nig = WGM * nN, gid = wgid / nig, fm = gid * WGM, gsz = (nM - fm) < WGM ? (nM - fm) : WGM;
    pm = fm + ((wgid % nig) % gsz); pn = (wgid % nig) / gsz;
}

template <class P>
__device__ __forceinline__ void gemm_phase(LAS unsigned char* lds, const P& S) {
    int tid_ = threadIdx.x; asm volatile("" : "+v"(tid_));
    const int tid = tid_, wid = __builtin_amdgcn_readfirstlane(tid >> 6), lane = tid & 63, wr = wid >> 2, wc = wid & 3, fr = lane & 15, fq = lane >> 4;
    constexpr int ELB = P::FP8 ? 1 : 2;
    const int K = S.K; int nt = K * ELB / 128; asm volatile("" : "+s"(nt));
    unsigned voffB[2];
#pragma unroll
    for (int i = 0; i < 2; ++i) { int R, C; stage_rc(tid * 16 + i * 8192, R, C); const int Rb = (R & ~31) + perm32(R & 31); voffB[i] = (unsigned)(Rb * K * ELB + C * 2); }
#define PG8_AOFF(dst0, dst1, u) do { _Pragma("unroll") for (int i = 0; i < 2; ++i) { int R, C; stage_rc(tid * 16 + i * 8192, R, C); dst0[i] = S.a_off(u, 0, R, C); dst1[i] = S.a_off(u, 1, R, C); } } while (0)
    const size_t kstepB = (size_t)(BK * 2), hstepB = (size_t)HALF * K * ELB, kstepA = (size_t)S.kstepA;
    const unsigned ldsw = (unsigned)wid * 1024u;
    const int aoff = lds_byte(wr * 64 + fr, fq * 8), boff = lds_byte(wc * 32 + fr, fq * 8);
#define PG8_SA(b, h) (((b) * 2 + (h)) * HTB)
#define PG8_SB(b, h) ((4 + (b) * 2 + (h)) * HTB)
#define PG8_STAGE(bufoff, gbase, voff) do { _Pragma("unroll") for (int _i = 0; _i < 2; ++_i) \
        __builtin_amdgcn_global_load_lds((const unsigned*)((const char*)(gbase) + (voff)[_i]), (LAS unsigned*)(lds + (bufoff) + ldsw + _i * 8192), 16, 0, 0); } while (0)
#define PG8_LDA(dst, b, h) do { _Pragma("unroll") for (int m = 0; m < 4; ++m) _Pragma("unroll") for (int k = 0; k < 2; ++k) dst[m][k] = *(const LAS bf16x8*)(lds + PG8_SA(b, h) + aoff + m * 2048 + k * 1024); } while (0)
#define PG8_LDB(dst, b, h) do { _Pragma("unroll") for (int n = 0; n < 2; ++n) _Pragma("unroll") for (int k = 0; k < 2; ++k) dst[n][k] = *(const LAS bf16x8*)(lds + PG8_SB(b, h) + boff + n * 2048 + k * 1024); } while (0)
#define PG8_CAT(x0, x1) __builtin_shufflevector(__builtin_bit_cast(v4i, x0), __builtin_bit_cast(v4i, x1), 0, 1, 2, 3, 4, 5, 6, 7)
#define PG8_MMA(ai, bj, At, Bt) do { __builtin_amdgcn_s_setprio(1); _Pragma("unroll") for (int m = 0; m < 4; ++m) _Pragma("unroll") for (int n = 0; n < 2; ++n) { \
        if constexpr (P::FP8) acc[ai][bj][m][n] = __builtin_amdgcn_mfma_scale_f32_16x16x128_f8f6f4(PG8_CAT(Bt[n][0], Bt[n][1]), PG8_CAT(At[m][0], At[m][1]), acc[ai][bj][m][n], 0, 0, 0, 0x7f7f7f7f, 0, 0x7f7f7f7f); \
        else { _Pragma("unroll") for (int k = 0; k < 2; ++k) acc[ai][bj][m][n] = __builtin_amdgcn_mfma_f32_16x16x32_bf16(Bt[n][k], At[m][k], acc[ai][bj][m][n], 0, 0, 0); } } __builtin_amdgcn_s_setprio(0); } while (0)
#define PG8_WAIT_V(n) asm volatile("s_waitcnt vmcnt(" #n ")" ::: "memory")
#define PG8_WAIT_L(n) asm volatile("s_waitcnt lgkmcnt(" #n ")" ::: "memory")
#define PG8_BAR __builtin_amdgcn_s_barrier()
#define PG8_SCHED __builtin_amdgcn_sched_barrier(0)
    Unit cur, nxt; int ui = 0;
    if (!S.next(0, cur)) return;
    f32x4 acc[2][2][4][2];
#pragma unroll
    for (int a = 0; a < 2; ++a)
#pragma unroll
        for (int b = 0; b < 2; ++b)
#pragma unroll
            for (int m = 0; m < 4; ++m)
#pragma unroll
                for (int n = 0; n < 2; ++n) acc[a][b][m][n] = (f32x4){0.f, 0.f, 0.f, 0.f};
    bf16x8 At[4][2], B0[2][2], B1[2][2];
    unsigned vA0[2], vA1[2], vN0[2], vN1[2];
    PG8_AOFF(vA0, vA1, cur);
    const char* cA = S.a_base(cur); const char* cB = S.b_base(cur);
    PG8_STAGE(PG8_SB(0, 0), cB, voffB); PG8_STAGE(PG8_SB(0, 1), cB + hstepB, voffB); PG8_STAGE(PG8_SA(0, 0), cA, vA0); PG8_STAGE(PG8_SA(0, 1), cA, vA1);
    if (wr == 1) PG8_BAR;
    PG8_WAIT_V(2); PG8_BAR;
    PG8_STAGE(PG8_SB(1, 0), cB + kstepB, voffB); PG8_STAGE(PG8_SA(1, 0), cA + kstepA, vA0); PG8_STAGE(PG8_SB(1, 1), cB + hstepB + kstepB, voffB);
    PG8_WAIT_V(6); PG8_BAR;
    for (;;) {
        const bool has_next = S.next(ui + 1, nxt);
        const char* nA = cA; const char* nB = cB;
        if (has_next) { nA = S.a_base(nxt); nB = S.b_base(nxt); if (P::EARLY_AOFF) PG8_AOFF(vN0, vN1, nxt); }
        for (int t = 0; t < nt; t += 2) {
            const bool last = (t == nt - 2);
            const char* a1 = cA + (size_t)(t + 1) * kstepA;
            const char* a2 = last ? nA : cA + (size_t)(t + 2) * kstepA; const char* b2 = last ? nB : cB + (size_t)(t + 2) * kstepB;
            const char* a3 = a2 + kstepA; const char* b3 = b2 + kstepB;
            PG8_LDB(B0, 0, 0); PG8_LDB(B1, 0, 1); PG8_SCHED; PG8_LDA(At, 0, 0); PG8_STAGE(PG8_SA(1, 1), a1, vA1);
            if (last && has_next) {
                if (P::EARLY_AOFF) { _Pragma("unroll") for (int i = 0; i < 2; ++i) { vA0[i] = vN0[i]; vA1[i] = vN1[i]; } } else PG8_AOFF(vA0, vA1, nxt); }
            PG8_WAIT_V(8); PG8_WAIT_L(0); PG8_BAR; PG8_MMA(0, 0, At, B0); PG8_MMA(0, 1, At, B1); PG8_BAR; PG8_SCHED;
            PG8_LDA(At, 0, 1); PG8_STAGE(PG8_SB(0, 0), b2, voffB); PG8_STAGE(PG8_SB(0, 1), b2 + hstepB, voffB); PG8_STAGE(PG8_SA(0, 0), a2, vA0);
            PG8_WAIT_V(8); PG8_WAIT_L(0); PG8_BAR; PG8_MMA(1, 0, At, B0); PG8_MMA(1, 1, At, B1); PG8_BAR; PG8_SCHED;
            PG8_LDB(B0, 1, 0); PG8_LDB(B1, 1, 1); PG8_SCHED; PG8_LDA(At, 1, 0); PG8_STAGE(PG8_SA(0, 1), a2, vA1);
            PG8_WAIT_V(8); PG8_WAIT_L(0); PG8_BAR; PG8_MMA(0, 0, At, B0); PG8_MMA(0, 1, At, B1); PG8_BAR; PG8_SCHED;
            PG8_LDA(At, 1, 1); PG8_STAGE(PG8_SB(1, 0), b3, voffB); PG8_STAGE(PG8_SB(1, 1), b3 + hstepB, voffB); PG8_STAGE(PG8_SA(1, 0), a3, vA0);
            PG8_WAIT_V(8); PG8_WAIT_L(0); PG8_BAR; PG8_MMA(1, 0, At, B0); PG8_MMA(1, 1, At, B1); PG8_BAR; PG8_SCHED;
        }
        if (wr == 0) PG8_BAR;
        S.epi(acc, cur, wr, wc, fr, fq);
        if (!has_next) break;
#pragma unroll
        for (int a = 0; a < 2; ++a)
#pragma unroll
            for (int b = 0; b < 2; ++b)
#pragma unroll
                for (int m = 0; m < 4; ++m)
#pragma unroll
                    for (int n = 0; n < 2; ++n) acc[a][b][m][n] = (f32x4){0.f, 0.f, 0.f, 0.f};
        cur = nxt; cA = nA; cB = nB; ++ui;
        if (wr == 1) PG8_BAR;
    }
    PG8_WAIT_V(0);
    PG8_BAR;
#undef PG8_AOFF
#undef PG8_SA
#undef PG8_SB
#undef PG8_STAGE
#undef PG8_LDA
#undef PG8_LDB
#undef PG8_MMA
#undef PG8_CAT
#undef PG8_WAIT_V
#undef PG8_WAIT_L
#undef PG8_BAR
#undef PG8_SCHED
}

template <class P>
__device__ __forceinline__ void gemm_phase_m128(LAS unsigned char* lds, const P& S) {
    int tid_ = threadIdx.x; asm volatile("" : "+v"(tid_));
    const int tid = tid_, wid = __builtin_amdgcn_readfirstlane(tid >> 6), lane = tid & 63, wr = wid >> 2, wc = wid & 3, fr = lane & 15, fq = lane >> 4;
    constexpr int ELB = P::FP8 ? 1 : 2;
    const int K = S.K; int nt = K * ELB / 128; asm volatile("" : "+s"(nt));
    unsigned voffB[2];
#pragma unroll
    for (int i = 0; i < 2; ++i) { int R, C; stage_rc(tid * 16 + i * 8192, R, C); const int Rb = (R & ~31) + perm32(R & 31); voffB[i] = (unsigned)(Rb * K * ELB + C * 2); }
#define PG8_AOFF(dst0, u) do { _Pragma("unroll") for (int i = 0; i < 2; ++i) { int R, C; stage_rc(tid * 16 + i * 8192, R, C); dst0[i] = S.a_off(u, R, C); } } while (0)
    const size_t kstepB = (size_t)(BK * 2), hstepB = (size_t)HALF * K * ELB, kstepA = (size_t)S.kstepA;
    const unsigned ldsw = (unsigned)wid * 1024u;
    const int aoff = lds_byte(wr * 64 + fr, fq * 8), boff = lds_byte(wc * 32 + fr, fq * 8);
#define PG8_SA(b) (((b) * 2) * HTB)
#define PG8_SB(b, h) ((4 + (b) * 2 + (h)) * HTB)
#define PG8_STAGE(bufoff, gbase, voff) do { _Pragma("unroll") for (int _i = 0; _i < 2; ++_i) \
        __builtin_amdgcn_global_load_lds((const unsigned*)((const char*)(gbase) + (voff)[_i]), (LAS unsigned*)(lds + (bufoff) + ldsw + _i * 8192), 16, 0, 0); } while (0)
#define PG8_LDA(dst, b) do { _Pragma("unroll") for (int m = 0; m < 4; ++m) _Pragma("unroll") for (int k = 0; k < 2; ++k) dst[m][k] = *(const LAS bf16x8*)(lds + PG8_SA(b) + aoff + m * 2048 + k * 1024); } while (0)
#define PG8_LDB(dst, b, h) do { _Pragma("unroll") for (int n = 0; n < 2; ++n) _Pragma("unroll") for (int k = 0; k < 2; ++k) dst[n][k] = *(const LAS bf16x8*)(lds + PG8_SB(b, h) + boff + n * 2048 + k * 1024); } while (0)
#define PG8_CAT(x0, x1) __builtin_shufflevector(__builtin_bit_cast(v4i, x0), __builtin_bit_cast(v4i, x1), 0, 1, 2, 3, 4, 5, 6, 7)
#define PG8_MMA(bj, At, Bt) do { __builtin_amdgcn_s_setprio(1); _Pragma("unroll") for (int m = 0; m < 4; ++m) _Pragma("unroll") for (int n = 0; n < 2; ++n) { \
        if constexpr (P::FP8) acc[bj][m][n] = __builtin_amdgcn_mfma_scale_f32_16x16x128_f8f6f4(PG8_CAT(Bt[n][0], Bt[n][1]), PG8_CAT(At[m][0], At[m][1]), acc[bj][m][n], 0, 0, 0, 0x7f7f7f7f, 0, 0x7f7f7f7f); \
        else { _Pragma("unroll") for (int k = 0; k < 2; ++k) acc[bj][m][n] = __builtin_amdgcn_mfma_f32_16x16x32_bf16(Bt[n][k], At[m][k], acc[bj][m][n], 0, 0, 0); } } __builtin_amdgcn_s_setprio(0); } while (0)
#define PG8_WAIT_V(n) asm volatile("s_waitcnt vmcnt(" #n ")" ::: "memory")
#define PG8_WAIT_L(n) asm volatile("s_waitcnt lgkmcnt(" #n ")" ::: "memory")
#define PG8_BAR __builtin_amdgcn_s_barrier()
#define PG8_SCHED __builtin_amdgcn_sched_barrier(0)
    Unit cur, nxt; int ui = 0;
    if (!S.next(0, cur)) return;
    f32x4 acc[2][4][2], st[2][4][2];
#pragma unroll
    for (int a = 0; a < 2; ++a)
#pragma unroll
        for (int m = 0; m < 4; ++m)
#pragma unroll
            for (int n = 0; n < 2; ++n) { acc[a][m][n] = (f32x4){0.f, 0.f, 0.f, 0.f}; st[a][m][n] = (f32x4){0.f, 0.f, 0.f, 0.f}; }
    bf16x8 At[4][2], B0[2][2];
    unsigned vA[2], vN[2];
    PG8_AOFF(vA, cur);
    const char* cA = S.a_base(cur); const char* cB = S.b_base(cur);
    PG8_STAGE(PG8_SB(0, 0), cB, voffB); PG8_STAGE(PG8_SA(0), cA, vA); PG8_STAGE(PG8_SB(0, 1), cB + hstepB, voffB);
    if (wr == 1) PG8_BAR;
    PG8_WAIT_V(2); PG8_BAR;
    PG8_STAGE(PG8_SB(1, 0), cB + kstepB, voffB); PG8_STAGE(PG8_SA(1), cA + kstepA, vA);
    PG8_WAIT_V(4); PG8_BAR;
    for (;;) {
        const bool has_next = S.next(ui + 1, nxt);
        const char* nA = cA; const char* nB = cB;
        if (has_next) { nA = S.a_base(nxt); nB = S.b_base(nxt); if (P::EARLY_AOFF) PG8_AOFF(vN, nxt); }
        for (int t = 0; t < nt; t += 2) {
            const bool last = (t == nt - 2);
            const char* b1 = cB + (size_t)(t + 1) * kstepB;
            const char* a2 = last ? nA : cA + (size_t)(t + 2) * kstepA; const char* b2 = last ? nB : cB + (size_t)(t + 2) * kstepB;
            const char* a3 = a2 + kstepA; const char* b3 = b2 + kstepB;
            PG8_LDB(B0, 0, 0); PG8_SCHED; PG8_LDA(At, 0); PG8_STAGE(PG8_SB(1, 1), b1 + hstepB, voffB);
            if (last && has_next) { if (P::EARLY_AOFF) { vA[0] = vN[0]; vA[1] = vN[1]; } else PG8_AOFF(vA, nxt); }
            PG8_WAIT_V(6); PG8_WAIT_L(0); PG8_BAR; PG8_MMA(0, At, B0); PG8_BAR; PG8_SCHED;
            PG8_LDB(B0, 0, 1); PG8_STAGE(PG8_SB(0, 0), b2, voffB); PG8_STAGE(PG8_SA(0), a2, vA);
            PG8_WAIT_V(6); PG8_WAIT_L(0); PG8_BAR; PG8_MMA(1, At, B0); PG8_BAR; PG8_SCHED;
            PG8_LDB(B0, 1, 0); PG8_SCHED; PG8_LDA(At, 1); PG8_STAGE(PG8_SB(0, 1), b2 + hstepB, voffB);
            PG8_WAIT_V(6); PG8_WAIT_L(0); PG8_BAR; PG8_MMA(0, At, B0); PG8_BAR; PG8_SCHED;
            PG8_LDB(B0, 1, 1); PG8_STAGE(PG8_SB(1, 0), b3, voffB); PG8_STAGE(PG8_SA(1), a3, vA);
            PG8_WAIT_V(6); PG8_WAIT_L(0); PG8_BAR; PG8_MMA(1, At, B0); PG8_BAR; PG8_SCHED;
        }
        if (wr == 0) PG8_BAR;
        S.epi(acc, st, cur, wr, wc, fr, fq);
        if (!has_next) break;
#pragma unroll
        for (int a = 0; a < 2; ++a)
#pragma unroll
            for (int m = 0; m < 4; ++m)
#pragma unroll
                for (int n = 0; n < 2; ++n) acc[a][m][n] = (f32x4){0.f, 0.f, 0.f, 0.f};
        cur = nxt; cA = nA; cB = nB; ++ui;
        if (wr == 1) PG8_BAR;
    }
    PG8_WAIT_V(0);
    PG8_BAR;
#undef PG8_AOFF
#undef PG8_SA
#undef PG8_SB
#undef PG8_STAGE
#undef PG8_LDA
#undef PG8_LDB
#undef PG8_MMA
#undef PG8_CAT
#undef PG8_WAIT_V
#undef PG8_WAIT_L
#undef PG8_BAR
#undef PG8_SCHED
}
}
namespace attn_body {
using bf16x8 = __attribute__((ext_vector_type(8))) short;
using u32x4 = __attribute__((ext_vector_type(4))) unsigned;
constexpr int NW = 8, QBLK = 32, QB = QBLK * NW, KVBLK = 64;
__device__ __forceinline__ int crow(int r, int hi) { return (r & 3) + 8 * (r >> 2) + 4 * hi; }
#define SBAR() __builtin_amdgcn_sched_barrier(0)
constexpr int NSLOT = 3, SLOTB = 8192;
constexpr int LDS_K = 0, LDS_V = NSLOT * SLOTB, LDS_WS = 2 * NSLOT * SLOTB, LDS_OST = LDS_WS + NW * 64 * 4, LDS_BYTES = LDS_OST + NW * 4096;
constexpr int LDS_BT = 86016 + 256;
__device__ __forceinline__ void glds16(const void* gsrc, unsigned lds_dst) { unsigned keep;
  asm volatile("s_mov_b32 %0, m0\n\ts_mov_b32 m0, %2\n\ts_nop 0\n\tglobal_load_lds_dwordx4 %1, off\n\ts_mov_b32 m0, %0" : "=&s"(keep) : "v"(gsrc), "s"(lds_dst) : "memory"); }
__device__ __forceinline__ float max3f(float a, float b, float c) { float r; asm("v_max3_f32 %0, %1, %2, %3" : "=v"(r) : "v"(a), "v"(b), "v"(c)); return r; }
__device__ __forceinline__ float max2f(float a, float b) { float r; asm("v_max_f32_e32 %0, %1, %2" : "=v"(r) : "v"(a), "v"(b)); return r; }
__device__ __forceinline__ float fadd_s(float a, float b) { float r; asm("v_add_f32_e32 %0, %1, %2" : "=v"(r) : "v"(a), "v"(b)); return r; }
__device__ __forceinline__ float fsub_s(float a, float b) { float r; asm("v_sub_f32_e32 %0, %1, %2" : "=v"(r) : "v"(a), "v"(b)); return r; }
typedef float f32x2_t __attribute__((ext_vector_type(2))); typedef __bf16 bf16x2_t __attribute__((ext_vector_type(2)));
__device__ __forceinline__ unsigned cvtpk_s(float lo, float hi) { f32x2_t v = {lo, hi}; bf16x2_t b = __builtin_convertvector(v, bf16x2_t); return __builtin_bit_cast(unsigned, b); }
#define WAIT_BAR(N) asm volatile("s_waitcnt vmcnt(" #N ") lgkmcnt(0)\n\ts_barrier" ::: "memory")

__device__ __forceinline__ void qkt(f32x16& p0, f32x16& p1, const char* Kslot, const bf16x8* qr, const f32x16& negm, int r32, int hi) {
  const char* kb = Kslot + hi * 1024 + r32 * 16;
  #pragma unroll
  for (int d0 = 0; d0 < 4; ++d0) {
    const bf16x8 b0 = *reinterpret_cast<const bf16x8*>(kb + d0 * 2048);
    const bf16x8 b1 = *reinterpret_cast<const bf16x8*>(kb + d0 * 2048 + 512);
    if (d0 == 0) { p0 = __builtin_amdgcn_mfma_f32_32x32x16_bf16(b0, qr[0], negm, 0, 0, 0); p1 = __builtin_amdgcn_mfma_f32_32x32x16_bf16(b1, qr[0], negm, 0, 0, 0); }
    else { p0 = __builtin_amdgcn_mfma_f32_32x32x16_bf16(b0, qr[d0], p0, 0, 0, 0); p1 = __builtin_amdgcn_mfma_f32_32x32x16_bf16(b1, qr[d0], p1, 0, 0, 0); } }
}
typedef __attribute__((address_space(3))) const char* lds_cptr;
typedef short v4i16_t __attribute__((ext_vector_type(4)));
__device__ __forceinline__ void kload8(bf16x8* kf, lds_cptr kp) {
  kf[0] = *(const __attribute__((address_space(3))) bf16x8*)(kp);        kf[1] = *(const __attribute__((address_space(3))) bf16x8*)(kp + 512);
  kf[2] = *(const __attribute__((address_space(3))) bf16x8*)(kp + 2048); kf[3] = *(const __attribute__((address_space(3))) bf16x8*)(kp + 2560);
  kf[4] = *(const __attribute__((address_space(3))) bf16x8*)(kp + 4096); kf[5] = *(const __attribute__((address_space(3))) bf16x8*)(kp + 4608);
  kf[6] = *(const __attribute__((address_space(3))) bf16x8*)(kp + 6144); kf[7] = *(const __attribute__((address_space(3))) bf16x8*)(kp + 6656);
}
__device__ __forceinline__ void kload2(bf16x8* kf, lds_cptr kp, int j) { kf[2 * j] = *(const __attribute__((address_space(3))) bf16x8*)(kp + j * 2048); kf[2 * j + 1] = *(const __attribute__((address_space(3))) bf16x8*)(kp + j * 2048 + 512); }
__device__ __forceinline__ s16x4 vtr(lds_cptr p) { return __builtin_bit_cast(s16x4, __builtin_amdgcn_ds_read_tr16_b64_v4i16((__attribute__((address_space(3))) v4i16_t*)p)); }
__device__ __forceinline__ float rowmax(const f32x16& p0, const f32x16& p1) {
  float a = max3f(p0[0], p0[1], p1[0]), b = max3f(p0[2], p0[3], p1[1]); a = max3f(a, p1[2], p1[3]);
  #pragma unroll
  for (int r = 4; r < 16; r += 4) { a = max3f(a, p0[r], p0[r + 1]); b = max3f(b, p0[r + 2], p0[r + 3]); a = max3f(a, p1[r], p1[r + 1]); b = max3f(b, p1[r + 2], p1[r + 3]); }
  const float m = max2f(a, b);
  auto rr = __builtin_amdgcn_permlane32_swap(__float_as_uint(m), __float_as_uint(m), false, false);
  return max2f(__uint_as_float(rr[0]), __uint_as_float(rr[1]));
}
__device__ __forceinline__ void pv(f32x16* o, int vb, bf16x8 pa0, bf16x8 pa1, bf16x8 pa2, bf16x8 pa3) {
  #pragma unroll
  for (int d0 = 0; d0 < 2; ++d0) { s16x4 lo[4], hi[4];
    #pragma unroll
    for (int ks = 0; ks < 4; ++ks) {
      asm volatile("ds_read_b64_tr_b16 %0,%1 offset:%c2" : "=&v"(lo[ks]) : "v"(vb), "i"(d0 * 4096 + ks * 1024) : "memory");
      asm volatile("ds_read_b64_tr_b16 %0,%1 offset:%c2" : "=&v"(hi[ks]) : "v"(vb), "i"(d0 * 4096 + ks * 1024 + 512) : "memory"); }
    asm volatile("s_waitcnt lgkmcnt(0)" ::: "memory"); SBAR();
    #define PK(k) (bf16x8){lo[k][0], lo[k][1], lo[k][2], lo[k][3], hi[k][0], hi[k][1], hi[k][2], hi[k][3]}
    o[d0] = __builtin_amdgcn_mfma_f32_32x32x16_bf16(pa0, PK(0), o[d0], 0, 0, 0);
    o[d0] = __builtin_amdgcn_mfma_f32_32x32x16_bf16(pa1, PK(1), o[d0], 0, 0, 0);
    o[d0] = __builtin_amdgcn_mfma_f32_32x32x16_bf16(pa2, PK(2), o[d0], 0, 0, 0);
    o[d0] = __builtin_amdgcn_mfma_f32_32x32x16_bf16(pa3, PK(3), o[d0], 0, 0, 0);
    #undef PK
  }
}
#define ATTN_STORE16(p, v) (*(u32x4*)(p) = (v))

template <int THRL, bool NA, int QP_, int KVP_, bool NOMAX = false>
__device__ __forceinline__ void attn_unit(const bf16* Qu, int qp_rt, const bf16* __restrict__ Kh, const bf16* __restrict__ Vh, int kvp_rt, bf16* Ou, int NT, int r0, int rlo, char* shm) {
  const int qp = QP_ ? QP_ : qp_rt, kvp = KVP_ ? KVP_ : kvp_rt, op = qp;
  int tid_ = threadIdx.x; asm volatile("" : "+v"(tid_));
  const int tid = tid_, lane = tid & 63, r32 = lane & 31, hi = lane >> 5; const int wid = __builtin_amdgcn_readfirstlane(tid >> 6);
  const bf16* Qw = Qu + (long)(wid * QBLK) * qp;
  const unsigned lds0 = (unsigned)(uintptr_t)shm;
  float* wsf = (float*)(shm + LDS_WS) + wid * 64;
  const bf16* ksrc = Kh + (long)lane * kvp + wid * 8;
  const bf16* vsrc = Vh + (long)(16 * (wid & 3) + (lane >> 2)) * kvp + (wid >> 2) * 32 + (lane & 3) * 8;
  const unsigned kdst = lds0 + LDS_K + wid * 1024, vdst = lds0 + LDS_V + wid * 1024;
  #define TROW(t) (NA ? ((t) < 4 ? 64 * (t) : CTX + 64 * ((rlo + (t) - 4) < 127 ? (rlo + (t) - 4) : 127)) : 64 * (t))
  #define DMA_K(t, slot) glds16(ksrc + (long)TROW(t) * kvp, (unsigned)__builtin_amdgcn_readfirstlane(kdst + (slot)))
  #define DMA_V(t, slot) glds16(vsrc + (long)TROW(t) * kvp, (unsigned)__builtin_amdgcn_readfirstlane(vdst + (slot)))
  const int vb0 = (int)(lds0 + LDS_V) + ((lane >> 4) & 1) * 32 + (lane & 3) * 8 + (4 * hi + ((lane & 15) >> 2)) * 64;
  const char* Kbase = shm + LDS_K; bf16x8 kf[8];
  const lds_cptr shm3 = (lds_cptr)shm; const lds_cptr kp0 = shm3 + LDS_K + hi * 1024 + r32 * 16; const lds_cptr vp0 = shm3 + LDS_V + ((lane >> 4) & 1) * 32 + (lane & 3) * 8 + (4 * hi + ((lane & 15) >> 2)) * 64;
  const int rq = r0 + (wid >> 1), qc = 32 * (wid & 1) + r32;
  const int rsw = rq - 4 < 0 ? 0 : (rq - 4 > 120 ? 120 : rq - 4);
  const int cs = qc - 8 < 0 ? 0 : (qc - 8 > 48 ? 48 : qc - 8);
  const __attribute__((address_space(3))) float* btl = (const __attribute__((address_space(3))) float*)(shm3 + LDS_BT) + (15 + 4 * hi - qc);
  DMA_K(0, 0); DMA_V(0, 0); DMA_K(1, SLOTB);
  bf16x8 qr[4];
  #pragma unroll
  for (int d0 = 0; d0 < 4; ++d0) qr[d0] = *reinterpret_cast<const bf16x8*>(&Qw[(long)r32 * qp + d0 * 16 + hi * 8]);
  float mhat = 0.f, l_reg = 0.f; f32x16 o[2]; o[0] = f32x16{}; o[1] = f32x16{}; f32x16 negm = f32x16{}; if (!NA) asm volatile("" : "+v"(negm));
  #define NEGM (NA ? f32x16{} : negm)
  #define CMASK(P0, P1, t) do { if (NA) { if ((t) >= 4) { const int kr_ = rlo + (t) - 4; const int dr_ = kr_ - rsw; \
      if (dr_ < 0 || dr_ >= 8) { _Pragma("unroll") for (int r = 0; r < 16; ++r) { P0[r] = (-__builtin_inff()); P1[r] = (-__builtin_inff()); } } \
      else { const __attribute__((address_space(3))) float* bp_ = btl + (kr_ - rq + 7) * 31; const int kl0_ = 4 * hi - cs; \
        _Pragma("unroll") for (int rg = 0; rg < 4; ++rg) { \
          _Pragma("unroll") for (int rr_ = 0; rr_ < 4; ++rr_) { const int r = rg * 4 + rr_; const int kc_ = (r & 3) + 8 * (r >> 2); const float b0_ = bp_[kc_], b1_ = bp_[kc_ + 32]; \
            const int kl_ = kc_ + kl0_; P0[r] = ((unsigned)kl_ < 16u) ? P0[r] + b0_ : (-__builtin_inff()); P1[r] = ((unsigned)(kl_ + 32) < 16u) ? P1[r] + b1_ : (-__builtin_inff()); } \
          SBAR(); } } } } } while (0)
  bool resc = false;
  #define START(P0, P1) do { const float rm = NOMAX ? 0.f : rowmax(P0, P1); resc = false; \
    { const float dl = rm; mhat = fadd_s(mhat, dl); \
      _Pragma("unroll") for (int r = 0; r < 16; ++r) { P0[r] = fsub_s(P0[r], dl); P1[r] = fsub_s(P1[r], dl); } \
      if (!NA) { _Pragma("unroll") for (int r = 0; r < 16; ++r) negm[r] = -mhat; asm volatile("" : "+v"(negm)); } } \
    _Pragma("unroll") for (int r = 0; r < 16; ++r) P0[r] = __builtin_amdgcn_exp2f(P0[r]); } while (0)
  #define RESC() do { if (resc) { asm volatile("s_waitcnt lgkmcnt(0)" ::: "memory"); \
      _Pragma("unroll") for (int d_ = 0; d_ < 2; ++d_) _Pragma("unroll") for (int r = 0; r < 16; ++r) o[d_][r] *= wsf[crow(r, hi)]; } } while (0)
  f32x16 pA0, pA1, pB0, pB1;
  int sl_prev = 0, sl_cur = 0, sl_next = SLOTB;
  #define ROT() do { sl_prev = sl_cur; sl_cur = sl_next; sl_next = (sl_next == (NSLOT - 1) * SLOTB) ? 0 : sl_next + SLOTB; } while (0)
  DMA_K(2, 2 * SLOTB);
  WAIT_BAR(3);
  qkt(pA0, pA1, Kbase, qr, NEGM, r32, hi); asm volatile("s_nop 15\n\ts_nop 7" : "+v"(pA0), "+v"(pA1));
  START(pA0, pA1);
  _Pragma("unroll") for (int r = 0; r < 16; ++r) pA1[r] = __builtin_amdgcn_exp2f(pA1[r]);
  WAIT_BAR(0);
  DMA_K(3, 0); DMA_V(1, SLOTB);
  ROT();
  kload8(kf, kp0 + sl_cur);
  WAIT_BAR(2);
  s16x4 vlo[8], vhi[8]; u32x4 pw0, pw1, pw2, pw3;
  #define PKW(P, B) cvtpk_s(P[B], P[B + 1])
  #define PAF(k) __builtin_bit_cast(bf16x8, pw##k)
  #define VFR(i) (bf16x8){vlo[i][0], vlo[i][1], vlo[i][2], vlo[i][3], vhi[i][0], vhi[i][1], vhi[i][2], vhi[i][3]}
  #define PIN(x) asm volatile("" : "+v"(x))
  #define MX3(a, b, c) __builtin_fmaxf(__builtin_fmaxf((a), (b)), (c))
  #define GAPA(MF, A0, A1, A2, A3, W0, W1, PW) do { MF; sacc2 += (f32x2_t){A0, A1}; sacc2 += (f32x2_t){A2, A3}; PIN(sacc2); W0; W1; PIN(PW); SBAR(); } while (0)
  #define EX(v) __builtin_amdgcn_exp2f(v)
  #define GAPB(MF, X, B) do { MF; X[B] = EX(X[B]); X[B + 1] = EX(X[B + 1]); X[B + 2] = EX(X[B + 2]); X[B + 3] = EX(X[B + 3]); PIN(X); SBAR(); } while (0)
  #define VRD(i) do { vlo[i] = vtr(vp_ + (((i) >> 2) * 4096 + ((i) & 3) * 1024)); vhi[i] = vtr(vp_ + (((i) >> 2) * 4096 + ((i) & 3) * 1024 + 512)); } while (0)
  #define KRD(G, j) do { if (G) { kload2(kf, kp0 + sl_next, j); SBAR(); } } while (0)
  #define STEP(C0, C1, P0, P1, t, GK, GV, GL) do { SBAR(); \
    const lds_cptr vp_ = vp0 + sl_prev; \
    VRD(0); SBAR(); f32x2_t sacc2 = (f32x2_t){P0[0], P0[1]}; \
    GAPA(C0 = __builtin_amdgcn_mfma_f32_32x32x16_bf16(kf[0], qr[0], NEGM, 0, 0, 0), P0[2], P0[3], P0[4], P0[5],     pw0[0] = PKW(P0, 0), pw0[1] = PKW(P0, 2), pw0); \
    VRD(4); SBAR(); GAPA(C1 = __builtin_amdgcn_mfma_f32_32x32x16_bf16(kf[1], qr[0], NEGM, 0, 0, 0), P0[6], P0[7], P0[8], P0[9],     pw0[2] = PKW(P0, 4), pw0[3] = PKW(P0, 6), pw0); \
    VRD(1); SBAR(); GAPA(C0 = __builtin_amdgcn_mfma_f32_32x32x16_bf16(kf[2], qr[1], C0, 0, 0, 0),   P0[10], P0[11], P0[12], P0[13], pw1[0] = PKW(P0, 8), pw1[1] = PKW(P0, 10), pw1); \
    VRD(5); SBAR(); GAPA(C1 = __builtin_amdgcn_mfma_f32_32x32x16_bf16(kf[3], qr[1], C1, 0, 0, 0),   P0[14], P0[15], P1[0], P1[1],   pw1[2] = PKW(P0, 12), pw1[3] = PKW(P0, 14), pw1); \
    VRD(2); SBAR(); GAPA(C0 = __builtin_amdgcn_mfma_f32_32x32x16_bf16(kf[4], qr[2], C0, 0, 0, 0),   P1[2], P1[3], P1[4], P1[5],     pw2[0] = PKW(P1, 0), pw2[1] = PKW(P1, 2), pw2); \
    VRD(6); SBAR(); GAPA(C1 = __builtin_amdgcn_mfma_f32_32x32x16_bf16(kf[5], qr[2], C1, 0, 0, 0),   P1[6], P1[7], P1[8], P1[9],     pw2[2] = PKW(P1, 4), pw2[3] = PKW(P1, 6), pw2); \
    VRD(3); SBAR(); GAPA(C0 = __builtin_amdgcn_mfma_f32_32x32x16_bf16(kf[6], qr[3], C0, 0, 0, 0),   P1[10], P1[11], P1[12], P1[13], pw3[0] = PKW(P1, 8), pw3[1] = PKW(P1, 10), pw3); \
    VRD(7); SBAR(); GAPA(C1 = __builtin_amdgcn_mfma_f32_32x32x16_bf16(kf[7], qr[3], C1, 0, 0, 0),   P1[14], P1[15], 0.f, 0.f,       pw3[2] = PKW(P1, 12), pw3[3] = PKW(P1, 14), pw3); \
    l_reg += sacc2.x + sacc2.y; \
    if (GK) { DMA_K((t) + 3, sl_cur); } if (GV) { DMA_V((t) + 1, sl_next); } \
    resc = false; \
    if (NA) { _Pragma("unroll") for (int r = 0; r < 16; ++r) { C0[r] -= mhat; C1[r] -= mhat; } } \
    CMASK(C0, C1, t); \
    if (!NOMAX) { float a = MX3(C0[0], C0[1], C1[0]), b = MX3(C0[2], C0[3], C1[1]); a = MX3(a, C1[2], C1[3]); \
      _Pragma("unroll") for (int r = 4; r < 16; r += 4) { a = MX3(a, C0[r], C0[r + 1]); b = MX3(b, C0[r + 2], C0[r + 3]); a = MX3(a, C1[r], C1[r + 1]); b = MX3(b, C1[r + 2], C1[r + 3]); } \
      float rm = __builtin_fmaxf(a, b); { auto rr = __builtin_amdgcn_permlane32_swap(__float_as_uint(rm), __float_as_uint(rm), false, false); rm = __builtin_fmaxf(__uint_as_float(rr[0]), __uint_as_float(rr[1])); } \
      if (__builtin_expect(__any(rm > (float)THRL), 0)) { const float dl = __builtin_fmaxf(rm, 0.f); mhat += dl; \
        _Pragma("unroll") for (int r = 0; r < 16; ++r) { C0[r] -= dl; C1[r] -= dl; } \
        if (!NA) { _Pragma("unroll") for (int r = 0; r < 16; ++r) negm[r] = -mhat; asm volatile("" : "+v"(negm)); } \
        const float f = __builtin_amdgcn_exp2f(-dl); l_reg *= f; if (hi == 0) wsf[r32] = f; resc = true; } } \
    SBAR(); \
    GAPB(o[0] = __builtin_amdgcn_mfma_f32_32x32x16_bf16(PAF(0), VFR(0), o[0], 0, 0, 0), C0, 0); \
    GAPB(o[1] = __builtin_amdgcn_mfma_f32_32x32x16_bf16(PAF(0), VFR(4), o[1], 0, 0, 0), C0, 4); \
    KRD(GL, 0); GAPB(o[0] = __builtin_amdgcn_mfma_f32_32x32x16_bf16(PAF(1), VFR(1), o[0], 0, 0, 0), C0, 8); \
    KRD(GL, 1); GAPB(o[1] = __builtin_amdgcn_mfma_f32_32x32x16_bf16(PAF(1), VFR(5), o[1], 0, 0, 0), C0, 12); \
    KRD(GL, 2); GAPB(o[0] = __builtin_amdgcn_mfma_f32_32x32x16_bf16(PAF(2), VFR(2), o[0], 0, 0, 0), C1, 0); \
    KRD(GL, 3); GAPB(o[1] = __builtin_amdgcn_mfma_f32_32x32x16_bf16(PAF(2), VFR(6), o[1], 0, 0, 0), C1, 4); \
    GAPB(o[0] = __builtin_amdgcn_mfma_f32_32x32x16_bf16(PAF(3), VFR(3), o[0], 0, 0, 0), C1, 8); \
    GAPB(o[1] = __builtin_amdgcn_mfma_f32_32x32x16_bf16(PAF(3), VFR(7), o[1], 0, 0, 0), C1, 12); \
    } while (0)
  int t = 1;
  for (; t + 5 < NT; t += 2) {
    STEP(pB0, pB1, pA0, pA1, t, true, true, true);     WAIT_BAR(2); RESC(); ROT();
    STEP(pA0, pA1, pB0, pB1, t + 1, true, true, true); WAIT_BAR(2); RESC(); ROT();
  }
  #define ENDW(tt) do { if ((tt) + 3 < NT) { WAIT_BAR(2); } else if ((tt) + 2 < NT) { WAIT_BAR(1); } else { WAIT_BAR(0); } } while (0)
  for (; t + 1 < NT; t += 2) {
    STEP(pB0, pB1, pA0, pA1, t, (t + 3 < NT), (t + 1 < NT), (t + 1 < NT));         ENDW(t);     RESC(); ROT();
    STEP(pA0, pA1, pB0, pB1, t + 1, (t + 4 < NT), (t + 2 < NT), (t + 2 < NT));     ENDW(t + 1); RESC(); ROT();
  }
  STEP(pB0, pB1, pA0, pA1, NT - 1, false, false, false); RESC();
  { float sacc = pB0[0] + pB0[1]; _Pragma("unroll") for (int r = 2; r < 16; ++r) sacc += pB0[r]; _Pragma("unroll") for (int r = 0; r < 16; ++r) sacc += pB1[r]; l_reg += sacc;
    pw0 = (u32x4){PKW(pB0, 0), PKW(pB0, 2), PKW(pB0, 4), PKW(pB0, 6)}; pw1 = (u32x4){PKW(pB0, 8), PKW(pB0, 10), PKW(pB0, 12), PKW(pB0, 14)}; pw2 = (u32x4){PKW(pB1, 0), PKW(pB1, 2), PKW(pB1, 4), PKW(pB1, 6)}; pw3 = (u32x4){PKW(pB1, 8), PKW(pB1, 10), PKW(pB1, 12), PKW(pB1, 14)};
    SBAR(); pv(o, vb0 + sl_cur, PAF(0), PAF(1), PAF(2), PAF(3)); }
  #undef PKW
  #undef PAF
  #undef VFR
  #undef PIN
  #undef MX3
  #undef GAPA
  #undef GAPB
  #undef EX
  #undef VRD
  #undef KRD
  #undef STEP
  #undef ENDW
  { auto rr = __builtin_amdgcn_permlane32_swap(__float_as_uint(l_reg), __float_as_uint(l_reg), false, false); l_reg = __uint_as_float(rr[0]) + __uint_as_float(rr[1]); }
  if (hi == 0) wsf[32 + r32] = l_reg; asm volatile("s_waitcnt lgkmcnt(0)" ::: "memory");
  float rli[16];
  #pragma unroll
  for (int r = 0; r < 16; ++r) rli[r] = __builtin_amdgcn_rcpf(wsf[32 + crow(r, hi)]);
  bf16* Ow = Ou + (long)(wid * QBLK) * op;
  { bf16* stg = (bf16*)(shm + LDS_OST) + wid * 2048;
    #pragma unroll
    for (int r = 0; r < 16; ++r) { const int orow = crow(r, hi);
      #pragma unroll
      for (int d0 = 0; d0 < 2; ++d0) stg[orow * 64 + d0 * 32 + r32] = (bf16)f2bf(o[d0][r] * rli[r]); }
    asm volatile("s_waitcnt lgkmcnt(0)" ::: "memory");
    #pragma unroll
    for (int i = 0; i < 4; ++i) { const int row = i * 8 + (lane >> 3), ch = lane & 7; const u32x4 v = *(const u32x4*)(stg + row * 64 + ch * 8); ATTN_STORE16(Ow + (long)row * op + ch * 8, v); } }
  asm volatile("s_waitcnt lgkmcnt(0)\n\ts_barrier" ::: "memory");
  #undef NEGM
  #undef DMA_K
  #undef DMA_V
  #undef TROW
  #undef CMASK
  #undef START
  #undef RESC
  #undef ROT
}
#undef SBAR
#undef WAIT_BAR
}
#ifndef FP8_MOE
#define FP8_MOE 1
#endif
struct Args { const float* in[29]; float* out; unsigned char* ws; int ph_lo, ph_hi; };
enum { I_X = 0, I_C, I_CTX, I_CCTX, I_WMOD, I_BMOD, I_N1G, I_N2G, I_WIN, I_LRE, I_LIM, I_LDT, I_BRE, I_BIM, I_CRE, I_CIM, I_SSMD, I_WGLU, I_QNG, I_KNG, I_RPB, I_WBR, I_WOUT, I_RW, I_RB, I_MG, I_MU, I_MD, I_FNG };

typedef const float* CFP;
struct Ctx {
    const __attribute__((address_space(4))) CFP* in; float* out; unsigned char* ws; LAS unsigned char* lds; gu32* ctl;
    int tid, lane, wave, vcu, G;
};
#define WSP(T_, off) ((T_*)(C.ws + (off)))

__device__ __forceinline__ float* xs_row(const Ctx& C, int m) { const int b = m / LB, j = m - b * LB; return j < CTX ? WSP(float, WS_CTXS) + (size_t)(b * CTX + j) * D : C.out + (size_t)(b * SEQ + j - CTX) * D; }
__device__ __forceinline__ const float* in_row(const Ctx& C, int m) { const int b = m / LB, j = m - b * LB; return j < CTX ? C.in[I_CTX] + (size_t)(b * CTX + j) * D : C.in[I_X] + (size_t)(b * SEQ + j - CTX) * D; }
__device__ __forceinline__ int cond_of(int m) { const int b = m / LB, j = m - b * LB; return j < CTX ? 4 : b; }

__device__ __forceinline__ void transpose_item(const float* W, int N, int Kp, bf16* WT, int k0, int n0, int drow0, LAS float* scr, int lane) {
    const float* src = W + (size_t)k0 * N + n0 + lane;
    float tv[64];
#pragma unroll
    for (int i = 0; i < 64; ++i) tv[i] = src[(size_t)i * N];
#pragma unroll
    for (int i = 0; i < 64; ++i) scr[i * 65 + lane] = tv[i];
    LDS_WAIT(); asm volatile("" ::: "memory");
    const int c = lane & 7;
#pragma unroll
    for (int j = 0; j < 8; ++j) { const int n = (lane >> 3) + 8 * j; const LAS float* s = scr + (8 * c) * 65 + n;
        v4u o; o.x = pk2(s[0 * 65], s[1 * 65]); o.y = pk2(s[2 * 65], s[3 * 65]); o.z = pk2(s[4 * 65], s[5 * 65]); o.w = pk2(s[6 * 65], s[7 * 65]);
        *(GAS v4u*)(WT + (size_t)(drow0 + n) * Kp + k0 + 8 * c) = o; }
    LDS_WAIT(); asm volatile("" ::: "memory");
}
__device__ __forceinline__ void transpose_item8(const float* W, int N, int Kp, unsigned char* WT, int k0, int n0, int drow0, float scale, LAS float* scr, int lane) {
    const float* src = W + (size_t)k0 * N + n0 + lane;
    float tv[64];
#pragma unroll
    for (int i = 0; i < 64; ++i) tv[i] = src[(size_t)i * N];
#pragma unroll
    for (int i = 0; i < 64; ++i) scr[i * 65 + lane] = tv[i] * scale;
    LDS_WAIT(); asm volatile("" ::: "memory");
    const int c = lane & 3;
#pragma unroll
    for (int j = 0; j < 4; ++j) { const int n = (lane >> 2) + 16 * j; const LAS float* s = scr + (16 * c) * 65 + n;
        v4u o; o.x = pk4_fp8(s[0 * 65], s[1 * 65], s[2 * 65], s[3 * 65]); o.y = pk4_fp8(s[4 * 65], s[5 * 65], s[6 * 65], s[7 * 65]); o.z = pk4_fp8(s[8 * 65], s[9 * 65], s[10 * 65], s[11 * 65]); o.w = pk4_fp8(s[12 * 65], s[13 * 65], s[14 * 65], s[15 * 65]);
        *(GAS v4u*)(WT + (size_t)(drow0 + n) * Kp + k0 + 16 * c) = o; }
    LDS_WAIT(); asm volatile("" ::: "memory");
}
__device__ __forceinline__ void phase_weights(const Ctx& C, int l) {
    LAS float* scr = (LAS float*)(C.lds + C.wave * 16640);
    const int gw = C.vcu * NWAVES + C.wave, NGW = C.G * NWAVES;
    constexpr int I0 = 16 * 92, I1 = 8 * 8, I2 = 3 * 8 * 16, I3 = 16 * 16, I4 = 16 * 16 * 8, I5 = I4, I6 = 16 * 8 * 16;
    for (int it = gw; it < I0 + I1 + I2 + I3 + I4 + I5 + I6; it += NGW) {
        int r = it;
        if (r < I0) { const int kb = r / 92, nb = r % 92; if (nb < 44 || GATE_BF16) transpose_item(C.in[I_WIN] + (size_t)l * 1024 * INW, INW, 1024, WSP(bf16, WS_WIN), 64 * kb, 64 * nb, 64 * nb, scr, C.lane);
            else transpose_item8(C.in[I_WIN] + (size_t)l * 1024 * INW, INW, 1024, WSP(unsigned char, WS_WIN8), 64 * kb, 64 * nb, 64 * nb - 2816, 64.f, scr, C.lane); continue; } r -= I0;
        if (r < I1) { const int kb = r / 8, nb = r % 8; transpose_item(C.in[I_WGLU] + (size_t)l * 512 * 512, 512, 512, WSP(bf16, WS_WGLU), 64 * kb, 64 * nb, 64 * nb, scr, C.lane); continue; } r -= I1;
        if (r < I2) { const int i = r / 128, q = r % 128, kb = q / 16, nb = q % 16; transpose_item(C.in[I_WBR] + (size_t)(l * 3 + i) * 512 * 1024, 1024, 512, WSP(bf16, WS_WBR) + (size_t)i * 1024 * 512, 64 * kb, 64 * nb, 64 * nb, scr, C.lane); continue; } r -= I2;
        if (r < I3) { const int kb = r / 16, nb = r % 16; transpose_item(C.in[I_WOUT] + (size_t)l * 1024 * 1024, 1024, 1024, WSP(bf16, WS_WOUT), 64 * kb, 64 * nb, 64 * nb, scr, C.lane); continue; } r -= I3;
        if (r < I4 + I5) { const int up = r >= I4; if (up) r -= I4; const int e = r / 128, q = r % 128, kb = q / 8, nb = q % 8, n0 = 64 * nb;
            if (FP8_MOE) transpose_item8((up ? C.in[I_MU] : C.in[I_MG]) + (size_t)(l * 16 + e) * 1024 * 512, 512, 1024, WSP(unsigned char, WS_MOE1) + (size_t)e * 1024 * 1024, 64 * kb, n0, (n0 / 128) * 256 + (n0 % 128) + (up ? 128 : 0), 64.f, scr, C.lane);
            else transpose_item((up ? C.in[I_MU] : C.in[I_MG]) + (size_t)(l * 16 + e) * 1024 * 512, 512, 1024, WSP(bf16, WS_MOE1) + (size_t)e * 1024 * 1024, 64 * kb, n0, (n0 / 128) * 256 + (n0 % 128) + (up ? 128 : 0), scr, C.lane); continue; } r -= I4 + I5;
        { const int e = r / 128, q = r % 128, kb = q / 16, nb = q % 16; if (FP8_MOE) transpose_item8(C.in[I_MD] + (size_t)(l * 16 + e) * 512 * 1024, 1024, 512, WSP(unsigned char, WS_MOE2) + (size_t)e * 1024 * 512, 64 * kb, 64 * nb, 64 * nb, 32.f, scr, C.lane);
            else transpose_item(C.in[I_MD] + (size_t)(l * 16 + e) * 512 * 1024, 1024, 512, WSP(bf16, WS_MOE2) + (size_t)e * 1024 * 512, 64 * kb, 64 * nb, 64 * nb, scr, C.lane); }
    }
}

__device__ __forceinline__ void phase_mod(const Ctx& C) {
    LAS float* sc = (LAS float*)(C.lds);
    LAS float* red = (LAS float*)(C.lds + 20480);
    for (int i = C.tid; i < 5 * 1024; i += 512) { const int c = i >> 10, k = i & 1023; const float v = c < 4 ? C.in[I_C][c * 1024 + k] : C.in[I_CCTX][k]; sc[i] = v * fsigmoid(v); }
    __syncthreads();
    for (int it = C.vcu; it < NLAYER * 96; it += C.G) {
        const int l = it / 96, col = (it % 96) * 64 + C.lane, k0 = C.wave * 128;
        const float* W = C.in[I_WMOD] + (size_t)l * 1024 * 6144 + (size_t)k0 * 6144 + col;
        float a0 = 0.f, a1 = 0.f, a2 = 0.f, a3 = 0.f, a4 = 0.f;
#pragma unroll 16
        for (int k = 0; k < 128; ++k) { const float w = W[(size_t)k * 6144]; a0 += sc[k0 + k] * w; a1 += sc[1024 + k0 + k] * w; a2 += sc[2048 + k0 + k] * w; a3 += sc[3072 + k0 + k] * w; a4 += sc[4096 + k0 + k] * w; }
        LAS float* r = red + C.wave * 320 + C.lane; r[0] = a0; r[64] = a1; r[128] = a2; r[192] = a3; r[256] = a4;
        __syncthreads();
        if (C.tid < 320) { const int c = C.tid >> 6; float s = C.in[I_BMOD][l * 6144 + col];
#pragma unroll
            for (int w = 0; w < 8; ++w) s += red[w * 320 + C.tid];
            WSP(float, WS_MOD)[(size_t)(l * 5 + c) * 6144 + col] = s; }
        __syncthreads();
    }
}

__device__ __forceinline__ void phase_s5mats(const Ctx& C, int l) {
    if (C.vcu >= 128) return;
    const int g = C.vcu >> 2, part = C.vcu & 3, tid = C.tid;
    LAS f32x2* POW = (LAS f32x2*)(C.lds);
    LAS f32x2* CC = (LAS f32x2*)(C.lds + 33792);
    LAS f32x2* BB = (LAS f32x2*)(C.lds + 50176);
    LAS f32x2* COEF = (LAS f32x2*)(C.lds + 66560);
    LAS bf16* KT = (LAS bf16*)(C.lds + 67584);
    LAS float* K0 = (LAS float*)(C.lds + 99840);
    __syncthreads();
    if (tid < 128) {
        const int d = tid >> 6, p = tid & 63; const int li = ((l * 2 + d) * 32 + g) * 64 + p;
        const float re = C.in[I_LRE][li], im = C.in[I_LIM][li], dt = __expf(C.in[I_LDT][(l * 2 + d) * 32 + g]);
        for (int tau = 0; tau <= 32; ++tau) { const float mag = __expf(re * dt * (float)tau), rev = im * dt * (float)tau * 0.15915494309189535f;
            POW[(d * 33 + tau) * 64 + p] = (f32x2){mag * cos_rev(rev), mag * sin_rev(rev)}; }
        const float mag = __expf(re * dt), rev = im * dt * 0.15915494309189535f; const float lr = mag * cos_rev(rev) - 1.f, lim = mag * sin_rev(rev);
        const float den = 1.f / (re * re + im * im);
        COEF[tid] = (f32x2){(lr * re + lim * im) * den, (lim * re - lr * im) * den};
    }
    __syncthreads();
    for (int i = tid; i < 2048; i += 512) {
        const int d = i >> 10, p = (i >> 4) & 63, h = i & 15; const size_t bi = (((size_t)(l * 2 + d) * 32 + g) * 64 + p) * 16 + h;
        const float br = C.in[I_BRE][bi], bi_ = C.in[I_BIM][bi]; const f32x2 cf = COEF[d * 64 + p];
        BB[i] = (f32x2){cf.x * br - cf.y * bi_, cf.x * bi_ + cf.y * br};
        const int h2 = (i >> 6) & 15, p2 = i & 63; const size_t ci = (((size_t)(l * 2 + d) * 32 + g) * 16 + h2) * 64 + p2;
        CC[i] = (f32x2){C.in[I_CRE][ci], C.in[I_CIM][ci]};
    }
    __syncthreads();
    {
        const int d = tid >> 8, h = (tid >> 4) & 15, hp = tid & 15; float acc[32];
#pragma unroll
        for (int t = 0; t < 32; ++t) acc[t] = 0.f;
        for (int p = 0; p < 64; ++p) { const f32x2 c = CC[d * 1024 + h * 64 + p], b = BB[d * 1024 + p * 16 + hp], lam = POW[(d * 33 + 1) * 64 + p];
            float xr = c.x * b.x - c.y * b.y, xi = c.x * b.y + c.y * b.x;
#pragma unroll
            for (int t = 0; t < 32; ++t) { acc[t] += xr; const float nr = xr * lam.x - xi * lam.y, ni = xr * lam.y + xi * lam.x; xr = nr; xi = ni; } }
        if (d == 1) K0[tid & 255] = acc[0];
        __syncthreads();
        if (d == 0) { acc[0] += K0[tid] + (h == hp ? C.in[I_SSMD][l * 512 + g * 16 + h] : 0.f);
#pragma unroll
            for (int t = 0; t < 32; ++t) KT[((31 + t) * 16 + h) * 16 + hp] = (bf16)f2bf(acc[t]); }
        else {
#pragma unroll
            for (int t = 1; t < 32; ++t) KT[((31 - t) * 16 + h) * 16 + hp] = (bf16)f2bf(acc[t]); }
    }
    __syncthreads();
    bf16* B1 = WSP(bf16, WS_BT1) + (size_t)g * 768 * 512; bf16* B2 = WSP(bf16, WS_BT2) + (size_t)g * 512 * 256;
    for (int i = tid; i < 128 * 64; i += 512) {
        const int n = part * 128 + (i >> 6), ch = i & 63, t = n >> 4, h = n & 15, s = ch >> 1, hp0 = (ch & 1) * 8;
        *(GAS v4u*)(B1 + (size_t)n * 512 + ch * 8) = *(const LAS v4u*)(KT + ((t - s + 31) * 16 + h) * 16 + hp0);
    }
    for (int i = tid; i < 64 * 64; i += 512) {
        const int nn = part * 64 + (i >> 6), ch = i & 63, d = nn >> 7, p = (nn & 127) >> 1, ri = nn & 1, s = ch >> 1, hp0 = (ch & 1) * 8;
        const f32x2 w = POW[(d * 33 + (d == 0 ? 31 - s : s)) * 64 + p]; float v[8];
#pragma unroll
        for (int j = 0; j < 8; ++j) { const f32x2 b = BB[d * 1024 + p * 16 + hp0 + j]; v[j] = ri == 0 ? (w.x * b.x - w.y * b.y) : (w.x * b.y + w.y * b.x); }
        v4u o; o.x = pk2(v[0], v[1]); o.y = pk2(v[2], v[3]); o.z = pk2(v[4], v[5]); o.w = pk2(v[6], v[7]);
        *(GAS v4u*)(B1 + (size_t)(512 + nn) * 512 + ch * 8) = o;
    }
    for (int i = tid; i < 128 * 32; i += 512) {
        const int n = part * 128 + (i >> 5), ch = i & 31, t = n >> 4, h = n & 15, d = ch >> 4, p0 = (ch & 15) * 4; float v[8];
#pragma unroll
        for (int j = 0; j < 4; ++j) { const f32x2 c = CC[d * 1024 + h * 64 + p0 + j], w = POW[(d * 33 + (d == 0 ? t + 1 : 32 - t)) * 64 + p0 + j];
            v[2 * j] = c.x * w.x - c.y * w.y; v[2 * j + 1] = -(c.x * w.y + c.y * w.x); }
        v4u o; o.x = pk2(v[0], v[1]); o.y = pk2(v[2], v[3]); o.z = pk2(v[4], v[5]); o.w = pk2(v[6], v[7]);
        *(GAS v4u*)(B2 + (size_t)n * 256 + ch * 8) = o;
    }
    __syncthreads();
}

template <int MODE>
__device__ __forceinline__ void phase_rows(const Ctx& C, int l) {
    const int gw = C.vcu * NWAVES + C.wave, NGW = C.G * NWAVES, lane = C.lane;
    const float* MODl = WSP(float, WS_MOD) + (size_t)(MODE == 2 ? 0 : l) * 5 * 6144;
    const float* MODp = WSP(float, WS_MOD) + (size_t)(l > 0 ? l - 1 : 0) * 5 * 6144;
    const bf16* YS = WSP(bf16, WS_YSLOT);
    f32x4 nx[4]; v2u na[4], nc[4];
#define ROWS_LOAD(mm) do { const int m_ = (mm); \
        if (MODE == 0) { const GAS f32x4* xr = (const GAS f32x4*)in_row(C, m_) + lane; _Pragma("unroll") for (int q = 0; q < 4; ++q) nx[q] = xr[64 * q]; } \
        else { const GAS f32x4* xr = (const GAS f32x4*)xs_row(C, m_) + lane; const GAS v2u* y0 = (const GAS v2u*)(YS + (size_t)(2 * m_) * D) + lane; const GAS v2u* y1 = (const GAS v2u*)(YS + (size_t)(2 * m_ + 1) * D) + lane; \
            _Pragma("unroll") for (int q = 0; q < 4; ++q) { nx[q] = xr[64 * q]; na[q] = y0[64 * q]; nc[q] = y1[64 * q]; } } } while (0)
    int m = gw; if (MODE == 2) { while (m < T && (m % LB) < CTX) m += NGW; }
    if (m < T) ROWS_LOAD(m);
    while (m < T) {
        const int b = m / LB, j = m - b * LB, cond = j < CTX ? 4 : b;
        f32x4 v[4];
        if (MODE == 0) {
#pragma unroll
            for (int q = 0; q < 4; ++q) v[q] = nx[q]; }
        else { const GAS f32x4* g2 = (const GAS f32x4*)(MODp + cond * 6144 + 5 * 1024) + lane;
#pragma unroll
            for (int q = 0; q < 4; ++q) { const f32x4 g = g2[64 * q]; const v2u a = na[q], c = nc[q];
                v[q] = nx[q] + g * (f32x4){bflo(a.x) + bflo(c.x), bfhi(a.x) + bfhi(c.x), bflo(a.y) + bflo(c.y), bfhi(a.y) + bfhi(c.y)}; } }
        int mn = m + NGW; if (MODE == 2) { while (mn < T && (mn % LB) < CTX) mn += NGW; }
        if (mn < T) ROWS_LOAD(mn);
        float ss = 0.f;
#pragma unroll
        for (int q = 0; q < 4; ++q) ss += (v[q].x * v[q].x + v[q].y * v[q].y) + (v[q].z * v[q].z + v[q].w * v[q].w);
        const float rstd = 1.f / sqrtf(wave_sum(ss, lane) * (1.f / D) + EPS);
        if (MODE == 2) { GAS f32x4* o = (GAS f32x4*)(C.out + (size_t)(b * SEQ + j - CTX) * D) + lane; const GAS f32x4* fg = (const GAS f32x4*)C.in[I_FNG] + lane;
#pragma unroll
            for (int q = 0; q < 4; ++q) o[64 * q] = v[q] * rstd * fg[64 * q]; }
        else { GAS f32x4* xo = (GAS f32x4*)xs_row(C, m) + lane; GAS v2u* ho = (GAS v2u*)(WSP(bf16, WS_HB) + (size_t)m * D) + lane; GAS unsigned* h8 = (GAS unsigned*)(WSP(unsigned char, WS_HB8) + (size_t)m * D) + lane;
            const GAS f32x4* ng = (const GAS f32x4*)(C.in[I_N1G] + l * D) + lane; const GAS f32x4* sh = (const GAS f32x4*)(MODl + cond * 6144) + lane; const GAS f32x4* sc = (const GAS f32x4*)(MODl + cond * 6144 + 1024) + lane;
#pragma unroll
            for (int q = 0; q < 4; ++q) { xo[64 * q] = v[q]; const f32x4 h = v[q] * rstd * ng[64 * q] * (sc[64 * q] + 1.f) + sh[64 * q]; ho[64 * q] = (v2u){pk2(h.x, h.y), pk2(h.z, h.w)}; if (H8_WRITE) h8[64 * q] = pk4_fp8(h.x, h.y, h.z, h.w); } }
        m = mn;
    }
#undef ROWS_LOAD
}

__device__ __forceinline__ void phase_qkprep(const Ctx& C, int l) {
    const int gw = C.vcu * NWAVES + C.wave, NGW = C.G * NWAVES, lane = C.lane, s8 = lane & 7;
    const float* qg = C.in[I_QNG] + l * 64 + 8 * s8; const float* kg = C.in[I_KNG] + l * 64 + 8 * s8;
    float gq[8], gk[8];
#pragma unroll
    for (int i = 0; i < 8; ++i) { gq[i] = qg[i]; gk[i] = kg[i]; }
    const int ax = s8 >> 2, f0 = 8 * (s8 & 1);
    float inv[8];
#pragma unroll
    for (int i = 0; i < 8; ++i) inv[i] = exp2f(-(float)(f0 + i) * 0.8304820237218406f) * 0.15915494309189535f;
    const int kl = lane & 15;
    v4u wq, wk;
    if (gw < T) { wq = *((const GAS v4u*)(WSP(bf16, WS_QA) + (size_t)gw * 512) + lane); wk = *((const GAS v4u*)(WSP(bf16, WS_KA) + (size_t)gw * 128) + kl); }
    for (int m = gw; m < T; m += NGW) {
        const int b = m / LB, j = m - b * LB; const bool lat = j >= CTX; const int tt = j - CTX; const float pos = (float)(ax == 0 ? (tt >> 6) : (tt & 63));
        const v4u cq = wq, ck = wk;
        if (m + NGW < T) { wq = *((const GAS v4u*)(WSP(bf16, WS_QA) + (size_t)(m + NGW) * 512) + lane); wk = *((const GAS v4u*)(WSP(bf16, WS_KA) + (size_t)(m + NGW) * 128) + kl); }
        float cs[8], sn[8];
#pragma unroll
        for (int i = 0; i < 8; ++i) { cs[i] = lat ? cos_rev(pos * inv[i]) : 1.f; sn[i] = lat ? sin_rev(pos * inv[i]) : 0.f; }
#pragma unroll
        for (int which = 0; which < 2; ++which) {
            const v4u w = which == 0 ? cq : ck; float x[8] = {bflo(w.x), bfhi(w.x), bflo(w.y), bfhi(w.y), bflo(w.z), bfhi(w.z), bflo(w.w), bfhi(w.w)};
            float ss = 0.f;
#pragma unroll
            for (int i = 0; i < 8; ++i) ss += x[i] * x[i];
            ss += dpp_mov<0xB1, 0xF>(ss); ss += dpp_mov<0x4E, 0xF>(ss); ss += dpp_mov<0x141, 0xF>(ss);
            const float rstd = 1.f / sqrtf(ss * (1.f / 64.f) + EPS);
            float y[8];
#pragma unroll
            for (int i = 0; i < 8; ++i) { const float xn = x[i] * rstd * (which == 0 ? gq[i] : gk[i]); const float other = dpp_mov<0x4E, 0xF>(xn);
                y[i] = (s8 & 2) ? (xn * cs[i] + other * sn[i]) : (xn * cs[i] - other * sn[i]); }
            const float sc = which == 0 ? C2 : 1.f;
            v4u o; o.x = pk2(y[0] * sc, y[1] * sc); o.y = pk2(y[2] * sc, y[3] * sc); o.z = pk2(y[4] * sc, y[5] * sc); o.w = pk2(y[6] * sc, y[7] * sc);
            if (which == 0) *((GAS v4u*)(WSP(bf16, WS_QA) + (size_t)m * 512) + lane) = o;
            else if (lane < 16) *((GAS v4u*)(WSP(bf16, WS_KA) + (size_t)m * 128) + lane) = o;
        }
    }
}

__device__ __forceinline__ void phase_carry(const Ctx& C, int l) {
    if (C.vcu >= 32) return;
    const int b = C.vcu >> 3, g = (C.vcu & 7) * 4 + (C.wave >> 1), d = C.wave & 1, p = C.lane;
    const int li = ((l * 2 + d) * 32 + g) * 64 + p;
    const float re = C.in[I_LRE][li], im = C.in[I_LIM][li], dt = __expf(C.in[I_LDT][(l * 2 + d) * 32 + g]);
    const float mag = __expf(re * dt * 32.f), rev = im * dt * 32.f * 0.15915494309189535f; const float Lr = mag * cos_rev(rev), Li = mag * sin_rev(rev);
    const GAS f32x2* S = (const GAS f32x2*)(WSP(float, WS_SST) + (size_t)(b * NCH) * 8192 + g * 256 + d * 128) + p;
    GAS unsigned* X = (GAS unsigned*)(WSP(bf16, WS_XST) + (size_t)(b * NCH) * 8192 + g * 256 + d * 128) + p;
    float sr = 0.f, si = 0.f;
    if (d == 0) {
        for (int c0 = 0; c0 < NCH; c0 += 8) { f32x2 s[8];
#pragma unroll
            for (int k = 0; k < 8; ++k) s[k] = S[(size_t)(c0 + k) * 4096];
#pragma unroll
            for (int k = 0; k < 8; ++k) { X[(size_t)(c0 + k) * 4096] = pk2(sr, si); const float nr = Lr * sr - Li * si + s[k].x, ni = Lr * si + Li * sr + s[k].y; sr = nr; si = ni; } }
    } else {
        for (int seg = 0; seg < 33; ++seg) { const int chi = seg == 0 ? 7 : NCH - 1 - (seg - 1) * 8; f32x2 s[8];
#pragma unroll
            for (int k = 0; k < 8; ++k) s[k] = S[(size_t)(chi - k) * 4096];
#pragma unroll
            for (int k = 0; k < 8; ++k) { X[(size_t)(chi - k) * 4096] = pk2(sr, si); const float nr = Lr * sr - Li * si + s[k].x, ni = Lr * si + Li * sr + s[k].y; sr = nr; si = ni; } }
    }
}

__device__ __forceinline__ void phase_norm2(const Ctx& C, int l) {
    LAS float* RWt = (LAS float*)C.lds;
    LAS unsigned* REC = (LAS unsigned*)(C.lds + 65536);
    LAS float* LG = (LAS float*)(C.lds + 65536 + 16384);
    LAS unsigned* LCNT = (LAS unsigned*)(C.lds + 65536 + 32768);
    const int lane = C.lane, tid = C.tid;
    for (int i = tid; i < 16384; i += 512) { const int k = i >> 4, e = i & 15; RWt[e * 1024 + k] = C.in[I_RW][i]; }
    if (tid < 32) LCNT[tid] = 0u;
    __syncthreads();
    const float* MODl = WSP(float, WS_MOD) + (size_t)l * 5 * 6144;
    int nrows = 0; for (int m = C.vcu; m < T; m += C.G) ++nrows;
    f32x4 nx[4];
    if (C.wave < nrows) { const GAS f32x4* xr = (const GAS f32x4*)xs_row(C, C.vcu + C.G * C.wave) + lane;
#pragma unroll
        for (int q = 0; q < 4; ++q) nx[q] = xr[64 * q]; }
    for (int i = C.wave; i < nrows; i += NWAVES) {
        const int m = C.vcu + C.G * i, cond = cond_of(m);
        GAS unsigned* h8 = (GAS unsigned*)(WSP(unsigned char, WS_HB8) + (size_t)m * D) + lane; GAS v2u* ho = (GAS v2u*)(WSP(bf16, WS_HB) + (size_t)m * D) + lane;
        const GAS f32x4* ng = (const GAS f32x4*)(C.in[I_N2G] + l * D) + lane; const GAS f32x4* sh = (const GAS f32x4*)(MODl + cond * 6144 + 3072) + lane; const GAS f32x4* sc = (const GAS f32x4*)(MODl + cond * 6144 + 4096) + lane;
        f32x4 v[4]; float ss = 0.f;
#pragma unroll
        for (int q = 0; q < 4; ++q) { v[q] = nx[q]; ss += (v[q].x * v[q].x + v[q].y * v[q].y) + (v[q].z * v[q].z + v[q].w * v[q].w); }
        if (i + NWAVES < nrows) { const GAS f32x4* xr = (const GAS f32x4*)xs_row(C, m + C.G * NWAVES) + lane;
#pragma unroll
            for (int q = 0; q < 4; ++q) nx[q] = xr[64 * q]; }
        const float rstd = 1.f / sqrtf(wave_sum(ss, lane) * (1.f / D) + EPS);
        float lg[16];
#pragma unroll
        for (int e = 0; e < 16; ++e) lg[e] = 0.f;
#pragma unroll
        for (int q = 0; q < 4; ++q) { const f32x4 h = v[q] * rstd * ng[64 * q] * (sc[64 * q] + 1.f) + sh[64 * q]; if (FP8_MOE) h8[64 * q] = pk4_fp8(h.x, h.y, h.z, h.w); else ho[64 * q] = (v2u){pk2(h.x, h.y), pk2(h.z, h.w)};
#pragma unroll
            for (int e = 0; e < 16; ++e) { const f32x4 w = *(const LAS f32x4*)(RWt + e * 1024 + 256 * q + 4 * lane); lg[e] += (h.x * w.x + h.y * w.y) + (h.z * w.z + h.w * w.w); } }
        float mine = 0.f;
#pragma unroll
        for (int e = 0; e < 16; ++e) { const float t = wave_sum(lg[e], lane); mine = lane == e ? t : mine; }
        if (lane < 16) LG[i * 16 + lane] = mine;
    }
    __syncthreads();
    float rb[16];
#pragma unroll
    for (int e = 0; e < 16; ++e) rb[e] = C.in[I_RB][e];
    for (int i = tid; i < nrows; i += 512) {
        float lg[16];
#pragma unroll
        for (int q = 0; q < 4; ++q) { const f32x4 t = *(const LAS f32x4*)(LG + i * 16 + 4 * q); lg[4 * q] = t.x; lg[4 * q + 1] = t.y; lg[4 * q + 2] = t.z; lg[4 * q + 3] = t.w; }
        float mx = lg[0];
#pragma unroll
        for (int e = 1; e < 16; ++e) mx = fmaxf(mx, lg[e]);
        float pr[16], sel[16], sum = 0.f;
#pragma unroll
        for (int e = 0; e < 16; ++e) { pr[e] = __expf(lg[e] - mx); sum += pr[e]; }
        const float rs = 1.f / sum;
#pragma unroll
        for (int e = 0; e < 16; ++e) { pr[e] *= rs; sel[e] = pr[e] + rb[e]; }
        float bestv = -1e30f; int best = 0;
#pragma unroll
        for (int gq = 0; gq < 4; ++gq) { float m1 = -1e30f, m2 = -1e30f;
#pragma unroll
            for (int k = 0; k < 4; ++k) { const float s_ = sel[4 * gq + k]; if (s_ > m1) { m2 = m1; m1 = s_; } else if (s_ > m2) m2 = s_; }
            const float gs = m1 + m2; if (gs > bestv) { bestv = gs; best = gq; } }
        float s4[4], p4[4];
#pragma unroll
        for (int k = 0; k < 4; ++k) { s4[k] = best == 0 ? sel[k] : best == 1 ? sel[4 + k] : best == 2 ? sel[8 + k] : sel[12 + k]; p4[k] = best == 0 ? pr[k] : best == 1 ? pr[4 + k] : best == 2 ? pr[8 + k] : pr[12 + k]; }
        int i0 = 0; float v0 = s4[0], q0 = p4[0];
#pragma unroll
        for (int k = 1; k < 4; ++k) if (s4[k] > v0) { v0 = s4[k]; i0 = k; q0 = p4[k]; }
        int i1 = i0 == 0 ? 1 : 0; float v1 = -1e30f, q1 = p4[i0 == 0 ? 1 : 0];
#pragma unroll
        for (int k = 0; k < 4; ++k) if (k != i0 && s4[k] > v1) { v1 = s4[k]; i1 = k; q1 = p4[k]; }
        const int e0 = 4 * best + i0, e1 = 4 * best + i1; const float wn = 1.f / (q0 + q1);
        const unsigned lp0 = atomicAdd((unsigned*)(LCNT + e0), 1u), lp1 = atomicAdd((unsigned*)(LCNT + e1), 1u);
        REC[i * 4 + 0] = (unsigned)e0 | ((unsigned)e1 << 8) | (lp0 << 16); REC[i * 4 + 1] = lp1; REC[i * 4 + 2] = __float_as_uint(q0 * wn); REC[i * 4 + 3] = __float_as_uint(q1 * wn);
    }
    __syncthreads();
    if (tid < 16) LCNT[16 + tid] = __hip_atomic_fetch_add((unsigned*)(C.ctl + CW_CNT + l * 1024 + 64 * tid), LCNT[tid], RLX_AGENT);
    __syncthreads();
    int* LIST = WSP(int, WS_LIST); float* RWG = WSP(float, WS_RW);
    for (int i = tid; i < nrows; i += 512) { const int m = C.vcu + C.G * i; const unsigned r0 = REC[i * 4], r1 = REC[i * 4 + 1];
        const int e0 = r0 & 255, e1 = (r0 >> 8) & 255; const unsigned lp0 = r0 >> 16, lp1 = r1;
        LIST[(size_t)e0 * T + LCNT[16 + e0] + lp0] = 2 * m; LIST[(size_t)e1 * T + LCNT[16 + e1] + lp1] = 2 * m + 1;
        RWG[2 * m] = __uint_as_float(REC[i * 4 + 2]); RWG[2 * m + 1] = __uint_as_float(REC[i * 4 + 3]); }
    __syncthreads();
}
using pg8::Unit;
typedef f32x4 Acc[2][2][4][2];
__device__ __forceinline__ v4u pack8(const f32x4& a, const f32x4& b) { v4u w; w.x = cvt_pk_bf16(a[0], a[1]); w.y = cvt_pk_bf16(a[2], a[3]); w.z = cvt_pk_bf16(b[0], b[1]); w.w = cvt_pk_bf16(b[2], b[3]); return w; }
__device__ __forceinline__ void unpack8(const v4u& w, f32x4& a, f32x4& b) { a = (f32x4){bflo(w.x), bfhi(w.x), bflo(w.y), bfhi(w.y)}; b = (f32x4){bflo(w.z), bfhi(w.z), bflo(w.w), bfhi(w.w)}; }
#ifndef WT_MODE
#define WT_MODE 0
#endif
__device__ __forceinline__ void st16(void* p, const v4u& v) {
#if WT_MODE == 1
    asm volatile("global_store_dwordx4 %0, %1, off sc0 sc1" :: "v"(p), "v"(v) : "memory");
#elif WT_MODE == 2
    asm volatile("global_store_dwordx4 %0, %1, off nt" :: "v"(p), "v"(v) : "memory");
#else
    *(GAS v4u*)p = v;
#endif
}
__device__ __forceinline__ int chunk_m0(int cr) { return (cr / NCH) * LB + (cr % NCH) * 32; }

struct PWin {
    static constexpr bool EARLY_AOFF = false, FP8 = false; unsigned char* ws; int G, c; int K; unsigned kstepA;
    __device__ __forceinline__ bool next(int i, Unit& u) const { const long L = (long)i * G + c; if (L >= NPAN * 11) return false; pg8::static_decode((int)L, NPAN, 11, u.pm, u.pn); u.z = 0; return true; }
    __device__ __forceinline__ const char* a_base(const Unit& u) const { return (const char*)(ws + WS_HB) + (size_t)u.pm * 256 * 1024 * 2; }
    __device__ __forceinline__ unsigned a_off(const Unit&, int h, int R, int Cc) const { return (unsigned)((h * 128 + R) * 1024 + Cc) * 2u; }
    __device__ __forceinline__ const char* b_base(const Unit& u) const { return (const char*)(ws + WS_WIN) + (size_t)u.pn * 256 * 1024 * 2; }
    __device__ __forceinline__ void epi(const Acc& acc, const Unit& u, int wr, int wc, int fr, int fq) const {
        const int row0 = u.pm * 256 + wr * 64 + fr;
#pragma unroll
        for (int bj = 0; bj < 2; ++bj) {
            const int cb = u.pn * 256 + bj * 128; bf16* dst; int ld, col, mode = 0; float sc = 1.f;
            if (cb < 512) { dst = (bf16*)(ws + WS_U) + ((size_t)((cb + wc * 32 + 8 * fq) >> 4) * T) * 16 + ((8 * fq) & 15) - (wc * 32 + 8 * fq); ld = 16; col = 0; }
            else if (cb < 1024) { dst = (bf16*)(ws + WS_QA); ld = 512; col = cb - 512; }
            else if (cb == 1024) { dst = (bf16*)(ws + WS_KA); ld = 128; col = 0; }
            else if (cb == 1152) { dst = (bf16*)(ws + WS_VA); ld = 128; col = 0; }
            else if (cb < 1792) { dst = (bf16*)(ws + WS_QN); ld = 512; col = cb - 1280; sc = C2; }
            else if (cb < 2304) { dst = (bf16*)(ws + WS_KN); ld = 512; col = cb - 1792; }
            else { dst = (bf16*)(ws + WS_VN); ld = 512; col = cb - 2304; }
            const int c0 = col + wc * 32 + 8 * fq;
#pragma unroll
            for (int ai = 0; ai < 2; ++ai)
#pragma unroll
                for (int m = 0; m < 4; ++m) { f32x4 v0 = acc[ai][bj][m][0], v1 = acc[ai][bj][m][1];
                    if (mode) { v0 = (f32x4){fsigmoid(v0[0]), fsigmoid(v0[1]), fsigmoid(v0[2]), fsigmoid(v0[3])}; v1 = (f32x4){fsigmoid(v1[0]), fsigmoid(v1[1]), fsigmoid(v1[2]), fsigmoid(v1[3])}; }
                    else { v0 = v0 * sc; v1 = v1 * sc; }
                    st16(dst + (size_t)(row0 + ai * 128 + m * 16) * ld + c0, pack8(v0, v1)); __builtin_amdgcn_sched_barrier(0); }
        }
    }
};

struct PGate {
    static constexpr bool EARLY_AOFF = false, FP8 = !GATE_BF16; unsigned char* ws; int G, c; int K; unsigned kstepA;
    __device__ __forceinline__ bool next(int i, Unit& u) const { const long L = (long)i * G + c; if (L >= 2 * NPAN * 12) return false; pg8::static_decode((int)L, 2 * NPAN, 12, u.pm, u.pn); u.z = 0; return true; }
    __device__ __forceinline__ const char* a_base(const Unit& u) const { return GATE_BF16 ? (const char*)(ws + WS_HB) + (size_t)u.pm * 128 * 2048 : (const char*)(ws + WS_HB8) + (size_t)u.pm * 128 * 1024; }
    __device__ __forceinline__ unsigned a_off(const Unit&, int R, int Cc) const { return GATE_BF16 ? (unsigned)(R * 2048 + Cc * 2) : (unsigned)(R * 1024 + Cc * 2); }
    __device__ __forceinline__ const char* b_base(const Unit& u) const { return GATE_BF16 ? (const char*)(ws + WS_WIN) + (size_t)(2816 + u.pn * 256) * 2048 : (const char*)(ws + WS_WIN8) + (size_t)u.pn * 256 * 1024; }
    __device__ __forceinline__ void epi(const f32x4 (&acc)[2][4][2], f32x4 (&)[2][4][2], const Unit& u, int wr, int wc, int fr, int fq) const {
#pragma unroll
        for (int m = 0; m < 4; ++m) { const size_t r = (size_t)(u.pm * 128 + wr * 64 + m * 16 + fr);
#pragma unroll
            for (int bj = 0; bj < 2; ++bj) { const int c0 = u.pn * 256 + bj * 128 + wc * 32 + 8 * fq; f32x4 v0 = acc[bj][m][0] * (GATE_BF16 ? 1.f : 1.f / 64.f), v1 = acc[bj][m][1] * (GATE_BF16 ? 1.f : 1.f / 64.f);
                v0 = (f32x4){fsigmoid(v0[0]), fsigmoid(v0[1]), fsigmoid(v0[2]), fsigmoid(v0[3])}; v1 = (f32x4){fsigmoid(v1[0]), fsigmoid(v1[1]), fsigmoid(v1[2]), fsigmoid(v1[3])};
                if (GATE_BF16) *(GAS v4u*)((bf16*)(ws + WS_GATES) + r * 3072 + c0) = pack8(v0, v1);
                else *(GAS v2u*)((unsigned char*)(ws + WS_GATES) + r * 3072 + c0) = (v2u){pk4_fp8(v0[0], v0[1], v0[2], v0[3]), pk4_fp8(v1[0], v1[1], v1[2], v1[3])}; }
            __builtin_amdgcn_sched_barrier(0); }
    }
};

struct PS5A {
    static constexpr bool EARLY_AOFF = false, FP8 = false; unsigned char* ws; int G, c; int K; unsigned kstepA;
    __device__ __forceinline__ bool next(int i, Unit& u) const { const long L = (long)i * G + c; if (L >= 32 * 15) return false; const int l = (int)L; u.z = l / 15; const int r = l % 15; u.pm = r / 3; u.pn = r % 3; return true; }
    __device__ __forceinline__ const char* a_base(const Unit& u) const { return (const char*)(ws + WS_U) + (size_t)u.z * T * 32; }
    __device__ __forceinline__ unsigned a_off(const Unit& u, int h, int R, int Cc) const { int cr = u.pm * 256 + h * 128 + R; cr = cr < NCR ? cr : NCR - 1; return (unsigned)(cr * 512 + Cc) * 2u; }
    __device__ __forceinline__ const char* b_base(const Unit& u) const { return (const char*)(ws + WS_BT1) + ((size_t)u.z * 768 + u.pn * 256) * 512 * 2; }
    __device__ __forceinline__ void epi(const Acc& acc, const Unit& u, int wr, int wc, int fr, int fq) const {
#pragma unroll
        for (int ai = 0; ai < 2; ++ai)
#pragma unroll
            for (int m = 0; m < 4; ++m) { const int cr = u.pm * 256 + ai * 128 + wr * 64 + m * 16 + fr; if (cr >= NCR) continue;
#pragma unroll
                for (int bj = 0; bj < 2; ++bj) { const int n = bj * 128 + wc * 32 + 8 * fq;
                    if (u.pn < 2) *(GAS v4u*)((bf16*)(ws + WS_YG) + (size_t)u.z * T * 16 + (size_t)cr * 512 + u.pn * 256 + n) = pack8(acc[ai][bj][m][0], acc[ai][bj][m][1]);
                    else { GAS f32x4* o = (GAS f32x4*)((float*)(ws + WS_SST) + (size_t)cr * 8192 + u.z * 256 + n); o[0] = acc[ai][bj][m][0]; o[1] = acc[ai][bj][m][1]; } }
                __builtin_amdgcn_sched_barrier(0); }
    }
};

struct PS5B {
    static constexpr bool EARLY_AOFF = false, FP8 = false; unsigned char* ws; int G, c; int K; unsigned kstepA;
    __device__ __forceinline__ bool next(int i, Unit& u) const { const long L = (long)i * G + c; if (L >= 32 * 10) return false; const int l = (int)L; u.z = l / 10; const int r = l % 10; u.pm = r / 2; u.pn = r % 2; return true; }
    __device__ __forceinline__ const char* a_base(const Unit& u) const { return (const char*)(ws + WS_XST) + (size_t)u.z * 512; }
    __device__ __forceinline__ unsigned a_off(const Unit& u, int h, int R, int Cc) const { int cr = u.pm * 256 + h * 128 + R; cr = cr < NCR ? cr : NCR - 1; return (unsigned)(cr * 8192 + Cc) * 2u; }
    __device__ __forceinline__ const char* b_base(const Unit& u) const { return (const char*)(ws + WS_BT2) + ((size_t)u.z * 512 + u.pn * 256) * 256 * 2; }
    __device__ __forceinline__ void epi(const Acc& acc, const Unit& u, int wr, int wc, int fr, int fq) const {
#pragma unroll
        for (int ai = 0; ai < 2; ++ai)
#pragma unroll
            for (int m = 0; m < 4; ++m) { const int cr = u.pm * 256 + ai * 128 + wr * 64 + m * 16 + fr; if (cr >= NCR) continue;
#pragma unroll
                for (int bj = 0; bj < 2; ++bj) { const int nn = u.pn * 256 + bj * 128 + wc * 32 + 8 * fq, t = nn >> 4, h0 = nn & 15;
                    GAS v4u* p = (GAS v4u*)((bf16*)(ws + WS_YS) + (size_t)(chunk_m0(cr) + t) * 512 + u.z * 16 + h0);
                    f32x4 y0, y1; { const v4u w_ = *(const GAS v4u*)((const bf16*)(ws + WS_YG) + (size_t)u.z * T * 16 + (size_t)cr * 512 + nn); unpack8(w_, y0, y1); } y0 += acc[ai][bj][m][0]; y1 += acc[ai][bj][m][1];
                    y0 = (f32x4){gelu_tanh(y0[0]), gelu_tanh(y0[1]), gelu_tanh(y0[2]), gelu_tanh(y0[3])}; y1 = (f32x4){gelu_tanh(y1[0]), gelu_tanh(y1[1]), gelu_tanh(y1[2]), gelu_tanh(y1[3])};
                    *p = pack8(y0, y1); }
                __builtin_amdgcn_sched_barrier(0); }
    }
};

__device__ __forceinline__ int half_panel(int hl, bool lat_only) { if (!lat_only) return hl; const int pl = hl >> 1; return 2 * (pl + (pl >> 5) + 1) + (hl & 1); }
struct PGlu {
    static constexpr bool EARLY_AOFF = false, FP8 = false; unsigned char* ws; int G, c; int K; unsigned kstepA; bool lat_only;
    __device__ __forceinline__ bool next(int i, Unit& u) const { const int nH = lat_only ? 256 : 2 * NPAN; const long L = (long)i * G + c; if (L >= nH * 2) return false; pg8::static_decode((int)L, nH, 2, u.pm, u.pn); u.pm = half_panel(u.pm, lat_only); u.z = 0; return true; }
    __device__ __forceinline__ const char* a_base(const Unit& u) const { return (const char*)(ws + WS_YS) + (size_t)u.pm * 128 * 512 * 2; }
    __device__ __forceinline__ unsigned a_off(const Unit&, int R, int Cc) const { return (unsigned)(R * 512 + Cc) * 2u; }
    __device__ __forceinline__ const char* b_base(const Unit& u) const { return (const char*)(ws + WS_WGLU) + (size_t)u.pn * 256 * 512 * 2; }
    __device__ __forceinline__ void epi(const f32x4 (&acc)[2][4][2], f32x4 (&)[2][4][2], const Unit& u, int wr, int wc, int fr, int fq) const {
#pragma unroll
        for (int m = 0; m < 4; ++m) { const size_t r = (size_t)(u.pm * 128 + wr * 64 + m * 16 + fr);
#pragma unroll
            for (int bj = 0; bj < 2; ++bj) { const int cc = u.pn * 256 + bj * 128 + wc * 32 + 8 * fq;
                f32x4 z0, z1; { const v4u w_ = *(const GAS v4u*)((const bf16*)(ws + WS_YS) + r * 512 + cc); unpack8(w_, z0, z1); } const f32x4 a0 = acc[bj][m][0], a1 = acc[bj][m][1];
                z0 = z0 * (f32x4){fsigmoid(a0[0]), fsigmoid(a0[1]), fsigmoid(a0[2]), fsigmoid(a0[3])}; z1 = z1 * (f32x4){fsigmoid(a1[0]), fsigmoid(a1[1]), fsigmoid(a1[2]), fsigmoid(a1[3])};
                *(GAS v4u*)((bf16*)(ws + WS_U) + r * 512 + cc) = pack8(z0, z1); }
            __builtin_amdgcn_sched_barrier(0); }
    }
};

typedef f32x4 Acc128[2][4][2];
struct PMerge {
    static constexpr bool EARLY_AOFF = false, FP8 = false; unsigned char* ws; int G, c; int K; unsigned kstepA; bool lat_only;
    __device__ __forceinline__ bool next(int i, Unit& u) const { const int nH = lat_only ? 256 : 2 * NPAN; const long tile = (long)(i / 3) * G + c; if (tile >= nH * 4) return false; pg8::static_decode((int)tile, nH, 4, u.pm, u.pn); u.pm = half_panel(u.pm, lat_only); u.z = i % 3; return true; }
    __device__ __forceinline__ const char* a_base(const Unit& u) const { const size_t off = u.z == 0 ? WS_U : (u.z == 1 ? WS_AO : WS_NO); return (const char*)(ws + off) + (size_t)u.pm * 128 * 512 * 2; }
    __device__ __forceinline__ unsigned a_off(const Unit&, int R, int Cc) const { return (unsigned)(R * 512 + Cc) * 2u; }
    __device__ __forceinline__ const char* b_base(const Unit& u) const { return (const char*)(ws + WS_WBR) + ((size_t)u.z * 1024 + u.pn * 256) * 512 * 2; }
    __device__ __forceinline__ void epi(const Acc128& acc, Acc128& mrg, const Unit& u, int wr, int wc, int fr, int fq) const {
#pragma unroll
        for (int m = 0; m < 4; ++m) { const size_t r = (size_t)(u.pm * 128 + wr * 64 + m * 16 + fr);
#pragma unroll
            for (int bj = 0; bj < 2; ++bj) { const int cc = u.pn * 256 + bj * 128 + wc * 32 + 8 * fq;
                f32x4 g0, g1;
                if (GATE_BF16) { const v4u w_ = *(const GAS v4u*)((const bf16*)(ws + WS_GATES) + r * 3072 + u.z * 1024 + cc); unpack8(w_, g0, g1); }
                else { const v2u w_ = *(const GAS v2u*)((const unsigned char*)(ws + WS_GATES) + r * 3072 + u.z * 1024 + cc);
                    g0 = (f32x4){__builtin_amdgcn_cvt_f32_fp8((int)w_.x, 0), __builtin_amdgcn_cvt_f32_fp8((int)w_.x, 1), __builtin_amdgcn_cvt_f32_fp8((int)w_.x, 2), __builtin_amdgcn_cvt_f32_fp8((int)w_.x, 3)};
                    g1 = (f32x4){__builtin_amdgcn_cvt_f32_fp8((int)w_.y, 0), __builtin_amdgcn_cvt_f32_fp8((int)w_.y, 1), __builtin_amdgcn_cvt_f32_fp8((int)w_.y, 2), __builtin_amdgcn_cvt_f32_fp8((int)w_.y, 3)}; }
                if (u.z == 0) { mrg[bj][m][0] = g0 * acc[bj][m][0]; mrg[bj][m][1] = g1 * acc[bj][m][1]; }
                else { mrg[bj][m][0] += g0 * acc[bj][m][0]; mrg[bj][m][1] += g1 * acc[bj][m][1]; }
                if (u.z == 2) *(GAS v4u*)((bf16*)(ws + WS_HB) + r * 1024 + cc) = pack8(mrg[bj][m][0], mrg[bj][m][1]); } }
    }
};

struct PWout {
    static constexpr bool EARLY_AOFF = false, FP8 = false; unsigned char* ws; float* out; const float* mod; int G, c; int K; unsigned kstepA; bool lat_only;
    __device__ __forceinline__ bool next(int i, Unit& u) const { const int nH = lat_only ? 256 : 2 * NPAN; const long L = (long)i * G + c; if (L >= nH * 4) return false; pg8::static_decode((int)L, nH, 4, u.pm, u.pn); u.pm = half_panel(u.pm, lat_only); u.z = 0; return true; }
    __device__ __forceinline__ const char* a_base(const Unit& u) const { return (const char*)(ws + WS_HB) + (size_t)u.pm * 128 * 1024 * 2; }
    __device__ __forceinline__ unsigned a_off(const Unit&, int R, int Cc) const { return (unsigned)(R * 1024 + Cc) * 2u; }
    __device__ __forceinline__ const char* b_base(const Unit& u) const { return (const char*)(ws + WS_WOUT) + (size_t)u.pn * 256 * 1024 * 2; }
    __device__ __forceinline__ void epi(const f32x4 (&acc)[2][4][2], f32x4 (&)[2][4][2], const Unit& u, int wr, int wc, int fr, int fq) const {
        const int pm = u.pm >> 1, hh = u.pm & 1, b = pm / 33, pr = pm % 33, cond = pr == 0 ? 4 : b;
        float* xb = pr == 0 ? (float*)(ws + WS_CTXS) + ((size_t)b * 256 + hh * 128) * D : out + ((size_t)b * SEQ + (size_t)(pr - 1) * 256 + hh * 128) * D;
        const float* g1 = mod + cond * 6144 + 2048;
#pragma unroll
        for (int bj = 0; bj < 2; ++bj) { const int cc = u.pn * 256 + bj * 128 + wc * 32 + 8 * fq; const f32x4 ga = *(const GAS f32x4*)(g1 + cc), gb = *(const GAS f32x4*)(g1 + cc + 4);
#pragma unroll
            for (int m = 0; m < 4; ++m) { GAS f32x4* p = (GAS f32x4*)(xb + (size_t)(wr * 64 + m * 16 + fr) * D + cc);
                p[0] = p[0] + ga * acc[bj][m][0]; p[1] = p[1] + gb * acc[bj][m][1]; __builtin_amdgcn_sched_barrier(0); } }
    }
};

struct ExpTab { int cnt[16], tile0[17]; };
__device__ __forceinline__ int exp_find(const int (&tile0)[17], int q) { int e = 0;
#pragma unroll
    for (int k = 1; k < 16; ++k) e += (q >= tile0[k]) ? 1 : 0;
    return e; }

struct PMoe1 {
    static constexpr bool EARLY_AOFF = true, FP8 = true; unsigned char* ws; const LAS int* tab; int G, c; int K; unsigned kstepA;
    __device__ __forceinline__ bool next(int i, Unit& u) const { const long L = (long)i * G + c; const int total = __builtin_amdgcn_readfirstlane(tab[32]) * 4; if (L >= total) return false; const int q = (int)L >> 2; u.pn = (int)L & 3;
        int e = 0;
#pragma unroll
        for (int k = 1; k < 16; ++k) e += (q >= __builtin_amdgcn_readfirstlane(tab[16 + k])) ? 1 : 0;
        u.z = e; u.pm = q - __builtin_amdgcn_readfirstlane(tab[16 + e]); return true; }
    __device__ __forceinline__ const char* a_base(const Unit&) const { return (const char*)(ws + WS_HB8); }
    __device__ __forceinline__ unsigned a_off(const Unit& u, int R, int Cc) const { int r = u.pm * 128 + R; const int n = __builtin_amdgcn_readfirstlane(tab[u.z]); r = r < n ? r : n - 1;
        const int ent = ((const int*)(ws + WS_LIST))[(size_t)u.z * T + r]; return (unsigned)((ent >> 1) * 1024 + Cc * 2); }
    __device__ __forceinline__ const char* b_base(const Unit& u) const { return (const char*)(ws + WS_MOE1) + ((size_t)u.z * 1024 + u.pn * 256) * 1024; }
    __device__ __forceinline__ void epi(const f32x4 (&acc)[2][4][2], f32x4 (&)[2][4][2], const Unit& u, int wr, int wc, int fr, int fq) const {
        const size_t arow0 = (size_t)(__builtin_amdgcn_readfirstlane(tab[16 + u.z]) + u.pm) * 128;
#pragma unroll
        for (int m = 0; m < 4; ++m) { const f32x4 g0 = acc[0][m][0] * (1.f / 64.f), g1 = acc[0][m][1] * (1.f / 64.f), u0 = acc[1][m][0] * (8.f / 64.f), u1 = acc[1][m][1] * (8.f / 64.f);
            const f32x4 v0 = (f32x4){g0[0] * fsigmoid(g0[0]), g0[1] * fsigmoid(g0[1]), g0[2] * fsigmoid(g0[2]), g0[3] * fsigmoid(g0[3])} * u0;
            const f32x4 v1 = (f32x4){g1[0] * fsigmoid(g1[0]), g1[1] * fsigmoid(g1[1]), g1[2] * fsigmoid(g1[2]), g1[3] * fsigmoid(g1[3])} * u1;
            *(GAS v2u*)((unsigned char*)(ws + WS_ACT) + (arow0 + wr * 64 + m * 16 + fr) * 512 + u.pn * 128 + wc * 32 + 8 * fq) = (v2u){pk4_fp8(v0[0], v0[1], v0[2], v0[3]), pk4_fp8(v1[0], v1[1], v1[2], v1[3])}; }
    }
};
struct PMoe2 {
    static constexpr bool EARLY_AOFF = false, FP8 = true; unsigned char* ws; const LAS int* tab; int G, c; int K; unsigned kstepA;
    __device__ __forceinline__ bool next(int i, Unit& u) const { const long L = (long)i * G + c; const int total = __builtin_amdgcn_readfirstlane(tab[32]) * 4; if (L >= total) return false; const int q = (int)L >> 2; u.pn = (int)L & 3;
        int e = 0;
#pragma unroll
        for (int k = 1; k < 16; ++k) e += (q >= __builtin_amdgcn_readfirstlane(tab[16 + k])) ? 1 : 0;
        u.z = e; u.pm = q - __builtin_amdgcn_readfirstlane(tab[16 + e]); return true; }
    __device__ __forceinline__ const char* a_base(const Unit& u) const { return (const char*)(ws + WS_ACT) + (size_t)(__builtin_amdgcn_readfirstlane(tab[16 + u.z]) + u.pm) * 128 * 512; }
    __device__ __forceinline__ unsigned a_off(const Unit&, int R, int Cc) const { return (unsigned)(R * 512 + Cc * 2); }
    __device__ __forceinline__ const char* b_base(const Unit& u) const { return (const char*)(ws + WS_MOE2) + ((size_t)u.z * 1024 + u.pn * 256) * 512; }
    __device__ __forceinline__ void epi(const f32x4 (&acc)[2][4][2], f32x4 (&)[2][4][2], const Unit& u, int wr, int wc, int fr, int fq) const {
        const int n = __builtin_amdgcn_readfirstlane(tab[u.z]);
#pragma unroll
        for (int m = 0; m < 4; ++m) { const int r = u.pm * 128 + wr * 64 + m * 16 + fr; if (r >= n) continue;
            const int ent = ((const int*)(ws + WS_LIST))[(size_t)u.z * T + r]; const float w = ((const float*)(ws + WS_RW))[ent] * (1.f / 256.f);
#pragma unroll
            for (int bj = 0; bj < 2; ++bj)
                *(GAS v4u*)((bf16*)(ws + WS_YSLOT) + (size_t)ent * 1024 + u.pn * 256 + bj * 128 + wc * 32 + 8 * fq) = pack8(acc[bj][m][0] * w, acc[bj][m][1] * w); }
    }
};
struct PMoe1B {
    static constexpr bool EARLY_AOFF = true, FP8 = false; unsigned char* ws; const LAS int* tab; int G, c; int K; unsigned kstepA;
    __device__ __forceinline__ bool next(int i, Unit& u) const { const long L = (long)i * G + c; const int total = tab[32] * 4; if (L >= total) return false; const int q = (int)L >> 2; u.pn = (int)L & 3;
        int e = 0;
#pragma unroll
        for (int k = 1; k < 16; ++k) e += (q >= tab[16 + k]) ? 1 : 0;
        u.z = e; u.pm = q - tab[16 + e]; return true; }
    __device__ __forceinline__ const char* a_base(const Unit&) const { return (const char*)(ws + WS_HB); }
    __device__ __forceinline__ unsigned a_off(const Unit& u, int h, int R, int Cc) const { int r = u.pm * 256 + h * 128 + R; const int n = tab[u.z]; r = r < n ? r : n - 1;
        const int ent = ((const int*)(ws + WS_LIST))[(size_t)u.z * T + r]; return (unsigned)((ent >> 1) * 1024 + Cc) * 2u; }
    __device__ __forceinline__ const char* b_base(const Unit& u) const { return (const char*)(ws + WS_MOE1) + ((size_t)u.z * 1024 + u.pn * 256) * 1024 * 2; }
    __device__ __forceinline__ void epi(const Acc& acc, const Unit& u, int wr, int wc, int fr, int fq) const {
        const size_t arow0 = (size_t)(tab[16 + u.z] + u.pm) * 256;
#pragma unroll
        for (int ai = 0; ai < 2; ++ai)
#pragma unroll
            for (int m = 0; m < 4; ++m) { const f32x4 g0 = acc[ai][0][m][0], g1 = acc[ai][0][m][1], u0 = acc[ai][1][m][0], u1 = acc[ai][1][m][1];
                const f32x4 v0 = (f32x4){g0[0] * fsigmoid(g0[0]), g0[1] * fsigmoid(g0[1]), g0[2] * fsigmoid(g0[2]), g0[3] * fsigmoid(g0[3])} * u0;
                const f32x4 v1 = (f32x4){g1[0] * fsigmoid(g1[0]), g1[1] * fsigmoid(g1[1]), g1[2] * fsigmoid(g1[2]), g1[3] * fsigmoid(g1[3])} * u1;
                *(GAS v4u*)((bf16*)(ws + WS_ACTB) + (arow0 + ai * 128 + wr * 64 + m * 16 + fr) * 512 + u.pn * 128 + wc * 32 + 8 * fq) = pack8(v0, v1); }
    }
};
struct PMoe2B {
    static constexpr bool EARLY_AOFF = false, FP8 = false; unsigned char* ws; const LAS int* tab; int G, c; int K; unsigned kstepA;
    __device__ __forceinline__ bool next(int i, Unit& u) const { const long L = (long)i * G + c; const int total = tab[32] * 4; if (L >= total) return false; const int q = (int)L >> 2; u.pn = (int)L & 3;
        int e = 0;
#pragma unroll
        for (int k = 1; k < 16; ++k) e += (q >= tab[16 + k]) ? 1 : 0;
        u.z = e; u.pm = q - tab[16 + e]; return true; }
    __device__ __forceinline__ const char* a_base(const Unit& u) const { return (const char*)(ws + WS_ACTB) + (size_t)(tab[16 + u.z] + u.pm) * 256 * 512 * 2; }
    __device__ __forceinline__ unsigned a_off(const Unit&, int h, int R, int Cc) const { return (unsigned)((h * 128 + R) * 512 + Cc) * 2u; }
    __device__ __forceinline__ const char* b_base(const Unit& u) const { return (const char*)(ws + WS_MOE2) + ((size_t)u.z * 1024 + u.pn * 256) * 512 * 2; }
    __device__ __forceinline__ void epi(const Acc& acc, const Unit& u, int wr, int wc, int fr, int fq) const {
        const int n = tab[u.z];
#pragma unroll
        for (int ai = 0; ai < 2; ++ai)
#pragma unroll
            for (int m = 0; m < 4; ++m) { const int r = u.pm * 256 + ai * 128 + wr * 64 + m * 16 + fr; if (r >= n) continue;
                const int ent = ((const int*)(ws + WS_LIST))[(size_t)u.z * T + r]; const float w = ((const float*)(ws + WS_RW))[ent];
#pragma unroll
                for (int bj = 0; bj < 2; ++bj)
                    *(GAS v4u*)((bf16*)(ws + WS_YSLOT) + (size_t)ent * 1024 + u.pn * 256 + bj * 128 + wc * 32 + 8 * fq) = pack8(acc[ai][bj][m][0] * w, acc[ai][bj][m][1] * w); }
    }
};
__device__ __forceinline__ void build_exptab(const Ctx& C, LAS int* tab, int l, int tsh = 7) {
    __syncthreads();
    if (threadIdx.x == 0) { int t0 = 0;
        for (int e = 0; e < 16; ++e) { const int n = (int)__hip_atomic_load((unsigned*)(C.ctl + CW_CNT + l * 1024 + 64 * e), RLX_AGENT); tab[e] = n; tab[16 + e] = t0; t0 += (n + (1 << tsh) - 1) >> tsh; }
        tab[32] = t0; }
    __syncthreads();
}
__device__ __forceinline__ void phase_attn(const Ctx& C, int l, unsigned char* lds_gen) {
    phase_carry(C, l);
    char* shm = (char*)lds_gen;
    bf16* QA = WSP(bf16, WS_QA); bf16* KA = WSP(bf16, WS_KA); bf16* VA = WSP(bf16, WS_VA); bf16* QN = WSP(bf16, WS_QN); bf16* KN = WSP(bf16, WS_KN); bf16* VN = WSP(bf16, WS_VN);
#ifndef ATTN_SEL
#define ATTN_SEL 3
#endif
#ifdef REPMASK
#define REPMASK_ REPMASK
#else
#define REPMASK_ 0
#endif
    const int per = (1024 + C.G - 1) / C.G;
    bool nomax; { float gq = 0.f, gk = 0.f; for (int i = 0; i < 64; ++i) { gq = fmaxf(gq, fabsf(C.in[I_QNG][l * 64 + i])); gk = fmaxf(gk, fabsf(C.in[I_KNG][l * 64 + i])); } nomax = 64.f * gq * gk * C2 <= 60.f; }
    if (ATTN_SEL & 1) for (int i = 0; i < per * (1 + ((REPMASK_ >> 13) & 1)); ++i) { const int id = C.vcu * per + (i % per); if (id >= 1024) continue; const int bh = id >> 5, b = bh >> 3, h = bh & 7, qb = id & 31;
        const bf16* Qu = QA + (size_t)(b * LB + CTX + qb * 256) * 512 + h * 64;
        if (nomax) attn_body::attn_unit<8, false, 512, 128, true>(Qu, 512, KA + (size_t)(b * LB) * 128 + (h >> 2) * 64, VA + (size_t)(b * LB) * 128 + (h >> 2) * 64, 128, WSP(bf16, WS_AO) + (Qu - QA), LB / 64, 0, 0, shm);
        else attn_body::attn_unit<8, false, 512, 128, false>(Qu, 512, KA + (size_t)(b * LB) * 128 + (h >> 2) * 64, VA + (size_t)(b * LB) * 128 + (h >> 2) * 64, 128, WSP(bf16, WS_AO) + (Qu - QA), LB / 64, 0, 0, shm);
    }
    LAS float* bt = (LAS float*)(C.lds + attn_body::LDS_BT);
    const int nctx = (C.vcu >= 64 && C.vcu < 128) ? 1 : 0;
    if (ATTN_SEL & 2) for (int i0 = 0; i0 < (per + nctx) * (1 + ((REPMASK_ >> 14) & 1)); ++i0) { const int i = i0 % (per + nctx);
        const bf16 *Qu, *Kh, *Vh; bf16* Ou; int kvp = 512, NT = 4, r0 = 0, rlo = 0;
        if (i < per) { const int id = C.vcu * per + i; if (id >= 1024) continue; const int bh = id >> 5, b = bh >> 3, h = bh & 7; r0 = (id & 31) * 4;
            const float* rp = C.in[I_RPB] + (size_t)(l * 8 + h) * 465;
            for (int k = C.tid; k < 465; k += 512) bt[k] = rp[k] * LOG2E;
            rlo = r0 - 4 < 0 ? 0 : (r0 - 4 > 120 ? 120 : r0 - 4); const int rh_ = r0 - 1 < 0 ? 0 : (r0 - 1 > 120 ? 120 : r0 - 1), nloc = rh_ + 8 - rlo; NT = (4 + nloc + 1) & ~1;
            Qu = QN + (size_t)(b * LB + CTX + r0 * 64) * 512 + h * 64; Ou = WSP(bf16, WS_NO) + (Qu - QN); Kh = KN + (size_t)(b * LB) * 512 + h * 64; Vh = VN + (size_t)(b * LB) * 512 + h * 64; }
        else { int j = C.vcu - 64; if (j < 32) { const int b = j >> 3, h = j & 7; Qu = QA + (size_t)(b * LB) * 512 + h * 64; Ou = WSP(bf16, WS_AO) + (Qu - QA); Kh = KA + (size_t)(b * LB) * 128 + (h >> 2) * 64; Vh = VA + (size_t)(b * LB) * 128 + (h >> 2) * 64; kvp = 128; }
            else { j -= 32; const int b = j >> 3, h = j & 7; Qu = QN + (size_t)(b * LB) * 512 + h * 64; Ou = WSP(bf16, WS_NO) + (Qu - QN); Kh = KN + (size_t)(b * LB) * 512 + h * 64; Vh = VN + (size_t)(b * LB) * 512 + h * 64; } }
        attn_body::attn_unit<8, true, 512, 0>(Qu, 512, Kh, Vh, kvp, Ou, NT, r0, rlo, shm);
    }
}

constexpr int NPH = 46;
__global__ void __launch_bounds__(NWAVES * 64, 2) fwd(Args args) {
    extern __shared__ __attribute__((aligned(16))) unsigned char lds[];
    Ctx C; C.in = (const __attribute__((address_space(4))) CFP*)__builtin_amdgcn_kernarg_segment_ptr(); C.out = args.out; C.ws = args.ws; C.lds = (LAS unsigned char*)lds; C.ctl = (gu32*)(args.ws + WS_CTL);
    C.tid = 0; C.lane = 0; C.wave = __builtin_amdgcn_readfirstlane((int)threadIdx.x >> 6);
    C.G = gridDim.x; { const int bx = blockIdx.x; C.vcu = (C.G % 8 == 0) ? (bx % 8) * (C.G / 8) + bx / 8 : bx; }
    for (int u = threadIdx.x; u < (LDS_BYTES - LDSCTL_OFF) / 4; u += NWAVES * 64) ((LAS unsigned*)(C.lds + LDSCTL_OFF))[u] = 0u;
    __syncthreads();
    const int lo = args.ph_lo, hi = args.ph_hi;
    XcdBarrier bar; bar.bar = (unsigned*)(C.ctl + CW_BAR); bar.x = 0; bar.st = nullptr;
    if (hi - lo > 1) bar = xcd_barrier_post((unsigned*)(C.ctl + CW_BAR), (volatile LAS unsigned*)(C.lds + MISC_OFF) + 8);
    LAS int* tab = (LAS int*)(C.lds + LDSCTL_OFF);
    const int cg = (int)blockIdx.x;
#ifndef PHMASK
#define PHMASK 0xFFFF
#endif
#define IN(k) (lo <= (k) && (k) < hi)
#define EN(b) ((PHMASK >> (b)) & 1)
#ifndef REPMASK
#define REPMASK 0
#endif
#define RUN(b, stmt) do { stmt; if ((REPMASK >> (b)) & 1) { stmt; } } while (0)
#ifdef DIAG_SEL
#define DIAG_ACC(ty) do { if (blockIdx.x == 0 && threadIdx.x == 0) { volatile LAS unsigned* dg = (volatile LAS unsigned*)(C.lds + LDSCTL_OFF + 160); const unsigned now = (unsigned)__builtin_amdgcn_s_memrealtime(); dg[8 + (ty)] += now - dg[0]; dg[0] = now; } } while (0)
#else
#define DIAG_ACC(ty) do {} while (0)
#endif
#define SEAM(k) do { if (IN(k) && IN((k) + 1)) xcd_barrier(bar); DIAG_ACC((k) == 0 ? 11 : ((k) - 1) % 11); } while (0)
#define LWS() ({ const __attribute__((address_space(4))) CFP* k_ = C.in; asm volatile("" : "+s"(k_)); (unsigned char*)k_[30]; })
#define LC() ({ Ctx c_ = C; c_.tid = threadIdx.x; asm volatile("" : "+v"(c_.tid)); c_.lane = c_.tid & 63; asm volatile("" : "+s"(c_.in)); c_.ws = (unsigned char*)c_.in[30]; c_.out = (float*)c_.in[29]; c_.ctl = (gu32*)(c_.ws + WS_CTL); c_; })
#ifdef DIAG_SEL
    if (blockIdx.x == 0 && threadIdx.x == 0) { volatile LAS unsigned* dg = (volatile LAS unsigned*)(C.lds + LDSCTL_OFF + 160); dg[0] = (unsigned)__builtin_amdgcn_s_memrealtime(); dg[1] = dg[0]; }
#endif
    if (EN(11) && IN(0)) { const Ctx Cl = LC(); phase_mod(Cl); RUN(11, phase_s5mats(Cl, 0); phase_weights(Cl, 0)); }
    SEAM(0);
    for (int l = 0; l < NLAYER; ++l) {
        const int pb = 1 + 11 * l;
        if (EN(0) && IN(pb)) { const Ctx Cl = LC(); if (l == 0) phase_rows<0>(Cl, 0); else { phase_s5mats(Cl, l); phase_weights(Cl, l); phase_rows<1>(Cl, l); } }
        SEAM(pb);
        if (EN(1) && IN(pb + 1)) { { PWin P{LWS(), C.G, cg, 1024, 128u}; pg8::gemm_phase(C.lds, P); } { PGate P{LWS(), C.G, cg, 1024, 128u}; pg8::gemm_phase_m128(C.lds, P); } }
        SEAM(pb + 1);
        if (EN(2) && IN(pb + 2)) { { const Ctx Cl = LC(); phase_qkprep(Cl, l); } PS5A P{LWS(), C.G, cg, 512, 128u}; RUN(2, pg8::gemm_phase(C.lds, P)); }
        SEAM(pb + 2);
        if (EN(3) && IN(pb + 3)) { const Ctx Cl = LC(); RUN(3, phase_attn(Cl, l, lds)); }
        SEAM(pb + 3);
        if (EN(4) && IN(pb + 4)) { PS5B P{LWS(), C.G, cg, 256, 128u}; pg8::gemm_phase(C.lds, P); }
        SEAM(pb + 4);
        if (EN(5) && IN(pb + 5)) { PGlu P{LWS(), C.G, cg, 512, 128u, l == NLAYER - 1}; pg8::gemm_phase_m128(C.lds, P); }
        SEAM(pb + 5);
        if (EN(6) && IN(pb + 6)) { PMerge P{LWS(), C.G, cg, 512, 128u, l == NLAYER - 1}; pg8::gemm_phase_m128(C.lds, P); }
        SEAM(pb + 6);
        if (EN(7) && IN(pb + 7)) { unsigned char* wl_ = LWS(); PWout P{wl_, (float*)C.in[29], (const float*)(wl_ + WS_MOD) + (size_t)l * 5 * 6144, C.G, cg, 1024, 128u, l == NLAYER - 1}; pg8::gemm_phase_m128(C.lds, P); }
        SEAM(pb + 7);
        if (EN(8) && IN(pb + 8)) { const Ctx Cl = LC(); phase_norm2(Cl, l); }
        SEAM(pb + 8);
        if (EN(9) && IN(pb + 9)) { if (FP8_MOE) { build_exptab(C, tab, l); PMoe1 P{LWS(), tab, C.G, cg, 1024, 128u}; pg8::gemm_phase_m128(C.lds, P); } else { build_exptab(C, tab, l, 8); PMoe1B P{LWS(), tab, C.G, cg, 1024, 128u}; pg8::gemm_phase(C.lds, P); } }
        SEAM(pb + 9);
        if (EN(10) && IN(pb + 10)) { if (FP8_MOE) { build_exptab(C, tab, l); PMoe2 P{LWS(), tab, C.G, cg, 512, 128u}; pg8::gemm_phase_m128(C.lds, P); } else { build_exptab(C, tab, l, 8); PMoe2B P{LWS(), tab, C.G, cg, 512, 128u}; pg8::gemm_phase(C.lds, P); } }
        SEAM(pb + 10);
    }
    if (EN(12) && IN(NPH - 1)) { const Ctx Cl = LC(); phase_rows<2>(Cl, NLAYER); }
#ifdef DIAG_SEL
    xcd_barrier(bar); DIAG_ACC(12);
    if (blockIdx.x == 0 && threadIdx.x == 0) { volatile LAS unsigned* dg = (volatile LAS unsigned*)(C.lds + LDSCTL_OFF + 160); dg[8 + 13] = dg[0] - dg[1];
        for (int i = 0; i < 14; ++i) __hip_atomic_store(C.ctl + 2048 + i, dg[8 + i], RLX_AGENT); }
    xcd_barrier(bar);
    { const float d1 = (float)__hip_atomic_load(C.ctl + 2048 + (DIAG_SEL), RLX_AGENT) * 0.01f, d2 = (float)__hip_atomic_load(C.ctl + 2048 + (DIAG_SEL) + 1, RLX_AGENT) * 0.01f;
      const float c1 = sqrtf(d1); float* o = args.out;
      for (size_t i = (size_t)blockIdx.x * 512 + threadIdx.x; i < (size_t)NB * SEQ * D; i += (size_t)gridDim.x * 512) o[i] = (i == 12345) ? d2 : c1; }
#endif
#undef IN
#undef SEAM
}

#ifndef MK_PER_PHASE
#define MK_PER_PHASE 0
#endif
extern "C" void kernel_launch(void* const* d_in, const int* in_sizes, int n_in, void* d_out, int out_size, void* d_ws, size_t ws_size, hipStream_t stream) {
    static int grid = 0;
    if (grid == 0) {
        if (n_in != 29 || out_size != NB * SEQ * D || ws_size < WS_END) { fprintf(stderr, "kernel_launch: unexpected shapes (n_in %d out %d ws %zu)\n", n_in, out_size, ws_size); grid = -1; return; }
        int dev = 0, cus = 0, per_cu = 0;
        if (hipGetDevice(&dev) != hipSuccess || hipDeviceGetAttribute(&cus, hipDeviceAttributeMultiprocessorCount, dev) != hipSuccess) { grid = -1; return; }
        if (hipFuncSetAttribute((const void*)fwd, hipFuncAttributeMaxDynamicSharedMemorySize, LDS_BYTES) != hipSuccess) { grid = -1; return; }
        if (hipOccupancyMaxActiveBlocksPerMultiprocessor(&per_cu, (const void*)fwd, NWAVES * 64, LDS_BYTES) != hipSuccess || per_cu < 1) fprintf(stderr, "kernel_launch: occupancy query says %d\n", per_cu);
        (void)hipGetLastError();
        grid = cus;
    }
    if (grid < 0) return;
    (void)hipMemsetAsync((char*)d_ws + WS_CTL, 0, CTL_ZERO_BYTES, stream);
    Args a{};
    for (int i = 0; i < 29; ++i) a.in[i] = (const float*)d_in[i];
    a.out = (float*)d_out; a.ws = (unsigned char*)d_ws;
#if MK_PER_PHASE
    for (int p = 0; p < NPH; ++p) { a.ph_lo = p; a.ph_hi = p + 1; hipLaunchKernelGGL(fwd, dim3(grid), dim3(NWAVES * 64), LDS_BYTES, stream, a); }
#else
    a.ph_lo = 0; a.ph_hi = NPH; hipLaunchKernelGGL(fwd, dim3(grid), dim3(NWAVES * 64), LDS_BYTES, stream, a);
#endif
}
```

```cpp
#define FP8_MOE 1
#define GATE_BF16 0
#define H8_WRITE 1
#ifndef H8_WRITE
#define H8_WRITE 1
#endif
#ifndef GATE_BF16
#define GATE_BF16 0
#endif
#include <hip/hip_runtime.h>
#include <cstdio>
#include <cstdint>

#define GAS __attribute__((address_space(1)))
#define LAS __attribute__((address_space(3)))
typedef unsigned short bf16;
typedef unsigned v4u __attribute__((ext_vector_type(4)));
typedef unsigned v2u __attribute__((ext_vector_type(2)));
typedef float f32x4 __attribute__((ext_vector_type(4)));
typedef float f32x2 __attribute__((ext_vector_type(2)));
typedef float f32x16 __attribute__((ext_vector_type(16)));
typedef short bf16x8 __attribute__((ext_vector_type(8)));
typedef short s16x4 __attribute__((ext_vector_type(4)));
typedef GAS unsigned gu32;
#define RLX_AGENT __ATOMIC_RELAXED, __HIP_MEMORY_SCOPE_AGENT
#define LDS_WAIT() asm volatile("s_waitcnt lgkmcnt(0)" ::: "memory")
#define VM_WAIT() asm volatile("s_waitcnt vmcnt(0)" ::: "memory")

constexpr int NB = 4, SEQ = 8192, CTX = 256, LB = SEQ + CTX, T = NB * LB, D = 1024, NPAN = T / 256;
constexpr int NLAYER = 4, INW = 5888, NCH = LB / 32, NCR = NB * NCH;
constexpr int NEXP = 16, FF = 512;
constexpr float EPS = 1e-6f;
constexpr float LOG2E = 1.4426950408889634f;
constexpr float C2 = 0.125f * LOG2E;
constexpr int NWAVES = 8;

constexpr size_t MiB = 1u << 20;
constexpr size_t WS_CTL = 0, CTL_ZERO_BYTES = 1 * MiB;
constexpr size_t WS_MOD = 1 * MiB;
constexpr size_t WS_LIST = 2 * MiB;
constexpr size_t WS_RW = 5 * MiB;
constexpr size_t WS_CTXS = 6 * MiB;
constexpr size_t WS_SST = 10 * MiB;
constexpr size_t WS_HB8 = WS_SST;
constexpr size_t WS_XST = 44 * MiB;
constexpr size_t WS_BT1 = 61 * MiB;
constexpr size_t WS_BT2 = 85 * MiB;
constexpr size_t WS_WIN = 93 * MiB;
constexpr size_t WS_WIN8 = WS_WIN + (size_t)2816 * 1024 * 2;
constexpr size_t WS_WGLU = 105 * MiB;
constexpr size_t WS_WBR = 106 * MiB;
constexpr size_t WS_WOUT = 109 * MiB;
constexpr size_t WS_MOE1 = 111 * MiB;
constexpr size_t WS_MOE2 = 143 * MiB;
constexpr size_t WS_HB = 159 * MiB;
constexpr size_t WS_U = 225 * MiB;
constexpr size_t WS_QA = 258 * MiB;
constexpr size_t WS_KA = 291 * MiB;
constexpr size_t WS_VA = 300 * MiB;
constexpr size_t WS_QN = 309 * MiB;
constexpr size_t WS_KN = 342 * MiB;
constexpr size_t WS_VN = 375 * MiB;
constexpr size_t WS_YS = 408 * MiB;
constexpr size_t WS_GATES = 441 * MiB;
constexpr size_t WS_ACT = WS_QN;
constexpr size_t WS_ACTB = WS_QN;
constexpr size_t WS_YSLOT = WS_GATES;
constexpr size_t WS_AO = 640 * MiB;
constexpr size_t WS_NO = 673 * MiB;
constexpr size_t WS_YG = 706 * MiB;
constexpr size_t WS_END = 739 * MiB;
static_assert(WS_GATES + (size_t)T * 3072 * 2 <= WS_AO && WS_ACT + (size_t)(2 * T + 4096) * 512 * 2 <= WS_YS, "ws map");
constexpr int CW_FAIL = 8;
constexpr int CW_CNT = 64;
constexpr int CW_BAR = 8192;

constexpr int RING_BYTES = 131072, LDS_BYTES = 147456, LDSCTL_OFF = LDS_BYTES - 512, MISC_OFF = LDSCTL_OFF + 320;

__device__ __forceinline__ unsigned f2bf(float f) { unsigned u = __builtin_bit_cast(unsigned, f); return (u + 0x7fffu + ((u >> 16) & 1u)) >> 16; }
__device__ __forceinline__ unsigned pk2(float lo, float hi) { return f2bf(lo) | (f2bf(hi) << 16); }
__device__ __forceinline__ float bf2f(unsigned b) { return __builtin_bit_cast(float, b << 16); }
__device__ __forceinline__ float bflo(unsigned w) { return __builtin_bit_cast(float, w << 16); }
__device__ __forceinline__ float bfhi(unsigned w) { return __builtin_bit_cast(float, w & 0xffff0000u); }
typedef float f32x2_c __attribute__((ext_vector_type(2))); typedef __bf16 bf16x2_c __attribute__((ext_vector_type(2)));
__device__ __forceinline__ unsigned cvt_pk_bf16(float lo, float hi) { const f32x2_c v = {lo, hi}; return __builtin_bit_cast(unsigned, __builtin_convertvector(v, bf16x2_c)); }
typedef int v8i __attribute__((ext_vector_type(8)));
typedef int v4i __attribute__((ext_vector_type(4)));
__device__ __forceinline__ float clamp8(float x) { return __builtin_fminf(__builtin_fmaxf(x, -448.f), 448.f); }
__device__ __forceinline__ unsigned pk4_fp8(float a, float b, float c, float d) { int w = 0; w = __builtin_amdgcn_cvt_pk_fp8_f32(clamp8(a), clamp8(b), w, false); w = __builtin_amdgcn_cvt_pk_fp8_f32(clamp8(c), clamp8(d), w, true); return (unsigned)w; }
__device__ __forceinline__ float fsigmoid(float x) { return __builtin_amdgcn_rcpf(1.f + __builtin_amdgcn_exp2f(-LOG2E * x)); }
__device__ __forceinline__ float gelu_tanh(float x) { const float u = 0.7978845608f * (x + 0.044715f * x * x * x); return x * __builtin_amdgcn_rcpf(1.f + __builtin_amdgcn_exp2f(-2.f * LOG2E * u)); }
__device__ __forceinline__ float shflx(float v, int m, int lane) { return __builtin_bit_cast(float, __builtin_amdgcn_ds_bpermute((lane ^ m) << 2, __builtin_bit_cast(int, v))); }
template <int CTRL, int RM>
__device__ __forceinline__ float dpp_mov(float v) { return __builtin_bit_cast(float, __builtin_amdgcn_update_dpp(0, __builtin_bit_cast(int, v), CTRL, RM, 0xF, true)); }
__device__ __forceinline__ float wave_sum(float v, int) {
    v += dpp_mov<0xB1, 0xF>(v);
    v += dpp_mov<0x4E, 0xF>(v);
    v += dpp_mov<0x141, 0xF>(v);
    v += dpp_mov<0x140, 0xF>(v);
    v += dpp_mov<0x142, 0xA>(v);
    v += dpp_mov<0x143, 0xC>(v);
    return __builtin_bit_cast(float, __builtin_amdgcn_readlane(__builtin_bit_cast(int, v), 63));
}
__device__ __forceinline__ float sin_rev(float r) { r = r - floorf(r); return __builtin_amdgcn_sinf(r); }
__device__ __forceinline__ float cos_rev(float r) { r = r - floorf(r); return __builtin_amdgcn_cosf(r); }

#define XB_TMO      128
#define XB_XCNT(j)  (256  + 64 * (j))
#define XB_XSUB(j)  (1280 + 64 * (j))
#define XB_XGEN(j)  (2304 + 64 * (j))
#define XB_TOP      3328
#define XB_TOPGEN   3392
#define XCD_BAR_WORDS 3456
#define XB_SPIN_CAP (1u << 22)

__device__ __forceinline__ unsigned xb_ld(unsigned* p)              { return __hip_atomic_load(p, __ATOMIC_RELAXED, __HIP_MEMORY_SCOPE_AGENT); }
__device__ __forceinline__ unsigned xb_add(unsigned* p, unsigned v) { return __hip_atomic_fetch_add(p, v, __ATOMIC_RELAXED, __HIP_MEMORY_SCOPE_AGENT); }
__device__ __forceinline__ unsigned xb_xcc_id() { return (unsigned)__builtin_amdgcn_s_getreg((3 << 11) | 20) & 0xFu; }
#define XB_SPIN(cond, bar) do { unsigned _sp = 0; while (cond) { __builtin_amdgcn_s_sleep(1); \
    if ((++_sp & 255u) == 0u) { if (xb_ld(&(bar)[XB_TMO])) break; if (_sp > XB_SPIN_CAP) { atomicAdd(&(bar)[XB_TMO], 1u); break; } } } } while (0)

struct XcdBarrier { unsigned* bar; unsigned x; volatile LAS unsigned* st; };

__device__ __forceinline__ XcdBarrier xcd_barrier_post(unsigned* bar, volatile LAS unsigned* st) {
    XcdBarrier b; b.bar = bar; b.x = xb_xcc_id(); b.st = st;
    if (threadIdx.x == 0) (void)xb_add(&bar[XB_XCNT(b.x)], 1u);
    return b;
}
__device__ __forceinline__ void xcd_barrier_complete(unsigned* bar, unsigned x, unsigned& nloc, unsigned& nx) {
    const unsigned G = gridDim.x * gridDim.y * gridDim.z;
    unsigned sum, cnt, mine, sp = 0u;
    for (;;) {
        sum = 0u; cnt = 0u; mine = 0u;
#pragma unroll
        for (unsigned j = 0; j < 16; ++j) { const unsigned c = xb_ld(&bar[XB_XCNT(j)]); sum += c; cnt += (c > 0u) ? 1u : 0u; mine = (j == x) ? c : mine; }
        if (sum == G) break;
        __builtin_amdgcn_s_sleep(1);
        if ((++sp & 255u) == 0u) { if (xb_ld(&bar[XB_TMO])) break; if (sp > XB_SPIN_CAP) { atomicAdd(&bar[XB_TMO], 1u); break; } }
    }
    nloc = mine > 0u ? mine : 1u; nx = cnt > 0u ? cnt : 1u;
}
__device__ __forceinline__ void xcd_barrier(const XcdBarrier& b) {
    asm volatile("s_waitcnt vmcnt(0)" ::: "memory");
    __syncthreads();
    if (threadIdx.x == 0) {
        unsigned* bar = b.bar;
        __builtin_amdgcn_s_waitcnt(0);
        unsigned nloc = b.st[0], nx = b.st[1];
        if (nloc == 0u) { xcd_barrier_complete(bar, b.x, nloc, nx); b.st[0] = nloc; b.st[1] = nx; }
        const unsigned old = xb_add(&bar[XB_XSUB(b.x)], 1u);
        const unsigned gen = old / nloc;
        if (old + 1u == (gen + 1u) * nloc) {
            __builtin_amdgcn_fence(__ATOMIC_RELEASE, "agent");
            asm volatile("s_waitcnt vmcnt(0)" ::: "memory");
            const unsigned og = xb_add(&bar[XB_TOP], 1u);
            const unsigned tg = og / nx;
            if (og + 1u == (tg + 1u) * nx) xb_add(&bar[XB_TOPGEN], 1u);
            else XB_SPIN(xb_ld(&bar[XB_TOPGEN]) == tg, bar);
            __builtin_amdgcn_fence(__ATOMIC_ACQUIRE, "agent");
            xb_add(&bar[XB_XGEN(b.x)], 1u);
            asm volatile("s_waitcnt vmcnt(0)" ::: "memory");
        } else {
            XB_SPIN(xb_ld(&bar[XB_XGEN(b.x)]) == gen, bar);
            __builtin_amdgcn_fence(__ATOMIC_ACQUIRE, "agent");
            asm volatile("s_waitcnt vmcnt(0)" ::: "memory");
        }
    }
    __syncthreads();
}

namespace pg8 {
constexpr int BM = 256, BK = 64, HALF = 128, HTB = HALF * BK * 2, STAGE_BYTES = 8 * HTB, NXCD = 8, WGM = 8;
__host__ __device__ __forceinline__ int lds_byte(int r, int c) { const int st = (r >> 4) * 2 + (c >> 5), rr = r & 15, cc = c & 31, ob = rr * 64 + cc * 2; return st * 1024 + (ob ^ (((ob >> 9) & 1) << 5)); }
__host__ __device__ __forceinline__ void stage_rc(int b, int& R, int& C) { const int st = b / 1024, sb = b % 1024, swz = sb ^ (((sb >> 9) & 1) << 5); R = (st >> 1) * 16 + swz / 64; C = (st & 1) * 32 + (swz % 64) / 2; }
__host__ __device__ __forceinline__ int perm32(int rho) { const int n = rho >> 4, i = rho & 15; return 8 * (i >> 2) + 4 * n + (i & 3); }

struct Unit { int pm, pn, z; };

__device__ __forceinline__ void static_decode(int L, int nM, int nN, int& pm, int& pn) {
    const int nwg = nM * nN; int wgid = L;
    { const int q = nwg / NXCD, r = nwg % NXCD, xcd = wgid % NXCD, off = wgid / NXCD; wgid = (xcd < r ? xcd * (q + 1) : r * (q + 1) + (xcd - r) * q) + off; }
    const int nig = WGM * nN, gid = wgid / nig, fm = gid * WGM, gsz = (nM - fm) < WGM ? (nM - fm) : WGM;
    pm = fm + ((wgid % nig) % gsz); pn = (wgid % nig) / gsz;
}

template <class P>
__device__ __forceinline__ void gemm_phase(LAS unsigned char* lds, const P& S) {
    int tid_ = threadIdx.x; asm volatile("" : "+v"(tid_));
    const int tid = tid_, wid = __builtin_amdgcn_readfirstlane(tid >> 6), lane = tid & 63, wr = wid >> 2, wc = wid & 3, fr = lane & 15, fq = lane >> 4;
    constexpr int ELB = P::FP8 ? 1 : 2;
    const int K = S.K; int nt = K * ELB / 128; asm volatile("" : "+s"(nt));
    unsigned voffB[2];
#pragma unroll
    for (int i = 0; i < 2; ++i) { int R, C; stage_rc(tid * 16 + i * 8192, R, C); const int Rb = (R & ~31) + perm32(R & 31); voffB[i] = (unsigned)(Rb * K * ELB + C * 2); }
#define PG8_AOFF(dst0, dst1, u) do { _Pragma("unroll") for (int i = 0; i < 2; ++i) { int R, C; stage_rc(tid * 16 + i * 8192, R, C); dst0[i] = S.a_off(u, 0, R, C); dst1[i] = S.a_off(u, 1, R, C); } } while (0)
    const size_t kstepB = (size_t)(BK * 2), hstepB = (size_t)HALF * K * ELB, kstepA = (size_t)S.kstepA;
    const unsigned ldsw = (unsigned)wid * 1024u;
    const int aoff = lds_byte(wr * 64 + fr, fq * 8), boff = lds_byte(wc * 32 + fr, fq * 8);
#define PG8_SA(b, h) (((b) * 2 + (h)) * HTB)
#define PG8_SB(b, h) ((4 + (b) * 2 + (h)) * HTB)
#define PG8_STAGE(bufoff, gbase, voff) do { _Pragma("unroll") for (int _i = 0; _i < 2; ++_i) \
        __builtin_amdgcn_global_load_lds((const unsigned*)((const char*)(gbase) + (voff)[_i]), (LAS unsigned*)(lds + (bufoff) + ldsw + _i * 8192), 16, 0, 0); } while (0)
#define PG8_LDA(dst, b, h) do { _Pragma("unroll") for (int m = 0; m < 4; ++m) _Pragma("unroll") for (int k = 0; k < 2; ++k) dst[m][k] = *(const LAS bf16x8*)(lds + PG8_SA(b, h) + aoff + m * 2048 + k * 1024); } while (0)
#define PG8_LDB(dst, b, h) do { _Pragma("unroll") for (int n = 0; n < 2; ++n) _Pragma("unroll") for (int k = 0; k < 2; ++k) dst[n][k] = *(const LAS bf16x8*)(lds + PG8_SB(b, h) + boff + n * 2048 + k * 1024); } while (0)
#define PG8_CAT(x0, x1) __builtin_shufflevector(__builtin_bit_cast(v4i, x0), __builtin_bit_cast(v4i, x1), 0, 1, 2, 3, 4, 5, 6, 7)
#define PG8_MMA(ai, bj, At, Bt) do { __builtin_amdgcn_s_setprio(1); _Pragma("unroll") for (int m = 0; m < 4; ++m) _Pragma("unroll") for (int n = 0; n < 2; ++n) { \
        if constexpr (P::FP8) acc[ai][bj][m][n] = __builtin_amdgcn_mfma_scale_f32_16x16x128_f8f6f4(PG8_CAT(Bt[n][0], Bt[n][1]), PG8_CAT(At[m][0], At[m][1]), acc[ai][bj][m][n], 0, 0, 0, 0x7f7f7f7f, 0, 0x7f7f7f7f); \
        else { _Pragma("unroll") for (int k = 0; k < 2; ++k) acc[ai][bj][m][n] = __builtin_amdgcn_mfma_f32_16x16x32_bf16(Bt[n][k], At[m][k], acc[ai][bj][m][n], 0, 0, 0); } } __builtin_amdgcn_s_setprio(0); } while (0)
#define PG8_WAIT_V(n) asm volatile("s_waitcnt vmcnt(" #n ")" ::: "memory")
#define PG8_WAIT_L(n) asm volatile("s_waitcnt lgkmcnt(" #n ")" ::: "memory")
#define PG8_BAR __builtin_amdgcn_s_barrier()
#define PG8_SCHED __builtin_amdgcn_sched_barrier(0)
    Unit cur, nxt; int ui = 0;
    if (!S.next(0, cur)) return;
    f32x4 acc[2][2][4][2];
#pragma unroll
    for (int a = 0; a < 2; ++a)
#pragma unroll
        for (int b = 0; b < 2; ++b)
#pragma unroll
            for (int m = 0; m < 4; ++m)
#pragma unroll
                for (int n = 0; n < 2; ++n) acc[a][b][m][n] = (f32x4){0.f, 0.f, 0.f, 0.f};
    bf16x8 At[4][2], B0[2][2], B1[2][2];
    unsigned vA0[2], vA1[2], vN0[2], vN1[2];
    PG8_AOFF(vA0, vA1, cur);
    const char* cA = S.a_base(cur); const char* cB = S.b_base(cur);
    PG8_STAGE(PG8_SB(0, 0), cB, voffB); PG8_STAGE(PG8_SB(0, 1), cB + hstepB, voffB); PG8_STAGE(PG8_SA(0, 0), cA, vA0); PG8_STAGE(PG8_SA(0, 1), cA, vA1);
    if (wr == 1) PG8_BAR;
    PG8_WAIT_V(2); PG8_BAR;
    PG8_STAGE(PG8_SB(1, 0), cB + kstepB, voffB); PG8_STAGE(PG8_SA(1, 0), cA + kstepA, vA0); PG8_STAGE(PG8_SB(1, 1), cB + hstepB + kstepB, voffB);
    PG8_WAIT_V(6); PG8_BAR;
    for (;;) {
        const bool has_next = S.next(ui + 1, nxt);
        const char* nA = cA; const char* nB = cB;
        if (has_next) { nA = S.a_base(nxt); nB = S.b_base(nxt); if (P::EARLY_AOFF) PG8_AOFF(vN0, vN1, nxt); }
        for (int t = 0; t < nt; t += 2) {
            const bool last = (t == nt - 2);
            const char* a1 = cA + (size_t)(t + 1) * kstepA;
            const char* a2 = last ? nA : cA + (size_t)(t + 2) * kstepA; const char* b2 = last ? nB : cB + (size_t)(t + 2) * kstepB;
            const char* a3 = a2 + kstepA; const char* b3 = b2 + kstepB;
            PG8_LDB(B0, 0, 0); PG8_LDB(B1, 0, 1); PG8_SCHED; PG8_LDA(At, 0, 0); PG8_STAGE(PG8_SA(1, 1), a1, vA1);
            if (last && has_next) {
                if (P::EARLY_AOFF) { _Pragma("unroll") for (int i = 0; i < 2; ++i) { vA0[i] = vN0[i]; vA1[i] = vN1[i]; } } else PG8_AOFF(vA0, vA1, nxt); }
            PG8_WAIT_V(8); PG8_WAIT_L(0); PG8_BAR; PG8_MMA(0, 0, At, B0); PG8_MMA(0, 1, At, B1); PG8_BAR; PG8_SCHED;
            PG8_LDA(At, 0, 1); PG8_STAGE(PG8_SB(0, 0), b2, voffB); PG8_STAGE(PG8_SB(0, 1), b2 + hstepB, voffB); PG8_STAGE(PG8_SA(0, 0), a2, vA0);
            PG8_WAIT_V(8); PG8_WAIT_L(0); PG8_BAR; PG8_MMA(1, 0, At, B0); PG8_MMA(1, 1, At, B1); PG8_BAR; PG8_SCHED;
            PG8_LDB(B0, 1, 0); PG8_LDB(B1, 1, 1); PG8_SCHED; PG8_LDA(At, 1, 0); PG8_STAGE(PG8_SA(0, 1), a2, vA1);
            PG8_WAIT_V(8); PG8_WAIT_L(0); PG8_BAR; PG8_MMA(0, 0, At, B0); PG8_MMA(0, 1, At, B1); PG8_BAR; PG8_SCHED;
            PG8_LDA(At, 1, 1); PG8_STAGE(PG8_SB(1, 0), b3, voffB); PG8_STAGE(PG8_SB(1, 1), b3 + hstepB, voffB); PG8_STAGE(PG8_SA(1, 0), a3, vA0);
            PG8_WAIT_V(8); PG8_WAIT_L(0); PG8_BAR; PG8_MMA(1, 0, At, B0); PG8_MMA(1, 1, At, B1); PG8_BAR; PG8_SCHED;
        }
        if (wr == 0) PG8_BAR;
        S.epi(acc, cur, wr, wc, fr, fq);
        if (!has_next) break;
#pragma unroll
        for (int a = 0; a < 2; ++a)
#pragma unroll
            for (int b = 0; b < 2; ++b)
#pragma unroll
                for (int m = 0; m < 4; ++m)
#pragma unroll
                    for (int n = 0; n < 2; ++n) acc[a][b][m][n] = (f32x4){0.f, 0.f, 0.f, 0.f};
        cur = nxt; cA = nA; cB = nB; ++ui;
        if (wr == 1) PG8_BAR;
    }
    PG8_WAIT_V(0);
    PG8_BAR;
#undef PG8_AOFF
#undef PG8_SA
#undef PG8_SB
#undef PG8_STAGE
#undef PG8_LDA
#undef PG8_LDB
#undef PG8_MMA
#undef PG8_CAT
#undef PG8_WAIT_V
#undef PG8_WAIT_L
#undef PG8_BAR
#undef PG8_SCHED
}

template <class P>
__device__ __forceinline__ void gemm_phase_m128(LAS unsigned char* lds, const P& S) {
    int tid_ = threadIdx.x; asm volatile("" : "+v"(tid_));
    const int tid = tid_, wid = __builtin_amdgcn_readfirstlane(tid >> 6), lane = tid & 63, wr = wid >> 2, wc = wid & 3, fr = lane & 15, fq = lane >> 4;
    constexpr int ELB = P::FP8 ? 1 : 2;
    const int K = S.K; int nt = K * ELB / 128; asm volatile("" : "+s"(nt));
    unsigned voffB[2];
#pragma unroll
    for (int i = 0; i < 2; ++i) { int R, C; stage_rc(tid * 16 + i * 8192, R, C); const int Rb = (R & ~31) + perm32(R & 31); voffB[i] = (unsigned)(Rb * K * ELB + C * 2); }
#define PG8_AOFF(dst0, u) do { _Pragma("unroll") for (int i = 0; i < 2; ++i) { int R, C; stage_rc(tid * 16 + i * 8192, R, C); dst0[i] = S.a_off(u, R, C); } } while (0)
    const size_t kstepB = (size_t)(BK * 2), hstepB = (size_t)HALF * K * ELB, kstepA = (size_t)S.kstepA;
    const unsigned ldsw = (unsigned)wid * 1024u;
    const int aoff = lds_byte(wr * 64 + fr, fq * 8), boff = lds_byte(wc * 32 + fr, fq * 8);
#define PG8_SA(b) (((b) * 2) * HTB)
#define PG8_SB(b, h) ((4 + (b) * 2 + (h)) * HTB)
#define PG8_STAGE(bufoff, gbase, voff) do { _Pragma("unroll") for (int _i = 0; _i < 2; ++_i) \
        __builtin_amdgcn_global_load_lds((const unsigned*)((const char*)(gbase) + (voff)[_i]), (LAS unsigned*)(lds + (bufoff) + ldsw + _i * 8192), 16, 0, 0); } while (0)
#define PG8_LDA(dst, b) do { _Pragma("unroll") for (int m = 0; m < 4; ++m) _Pragma("unroll") for (int k = 0; k < 2; ++k) dst[m][k] = *(const LAS bf16x8*)(lds + PG8_SA(b) + aoff + m * 2048 + k * 1024); } while (0)
#define PG8_LDB(dst, b, h) do { _Pragma("unroll") for (int n = 0; n < 2; ++n) _Pragma("unroll") for (int k = 0; k < 2; ++k) dst[n][k] = *(const LAS bf16x8*)(lds + PG8_SB(b, h) + boff + n * 2048 + k * 1024); } while (0)
#define PG8_CAT(x0, x1) __builtin_shufflevector(__builtin_bit_cast(v4i, x0), __builtin_bit_cast(v4i, x1), 0, 1, 2, 3, 4, 5, 6, 7)
#define PG8_MMA(bj, At, Bt) do { __builtin_amdgcn_s_setprio(1); _Pragma("unroll") for (int m = 0; m < 4; ++m) _Pragma("unroll") for (int n = 0; n < 2; ++n) { \
        if constexpr (P::FP8) acc[bj][m][n] = __builtin_amdgcn_mfma_scale_f32_16x16x128_f8f6f4(PG8_CAT(Bt[n][0], Bt[n][1]), PG8_CAT(At[m][0], At[m][1]), acc[bj][m][n], 0, 0, 0, 0x7f7f7f7f, 0, 0x7f7f7f7f); \
        else { _Pragma("unroll") for (int k = 0; k < 2; ++k) acc[bj][m][n] = __builtin_amdgcn_mfma_f32_16x16x32_bf16(Bt[n][k], At[m][k], acc[bj][m][n], 0, 0, 0); } } __builtin_amdgcn_s_setprio(0); } while (0)
#define PG8_WAIT_V(n) asm volatile("s_waitcnt vmcnt(" #n ")" ::: "memory")
#define PG8_WAIT_L(n) asm volatile("s_waitcnt lgkmcnt(" #n ")" ::: "memory")
#define PG8_BAR __builtin_amdgcn_s_barrier()
#define PG8_SCHED __builtin_amdgcn_sched_barrier(0)
    Unit cur, nxt; int ui = 0;
    if (!S.next(0, cur)) return;
    f32x4 acc[2][4][2], st[2][4][2];
#pragma unroll
    for (int a = 0; a < 2; ++a)
#pragma unroll
        for (int m = 0; m < 4; ++m)
#pragma unroll
            for (int n = 0; n < 2; ++n) { acc[a][m][n] = (f32x4){0.f, 0.f, 0.f, 0.f}; st[a][m][n] = (f32x4){0.f, 0.f, 0.f, 0.f}; }
    bf16x8 At[4][2], B0[2][2];
    unsigned vA[2], vN[2];
    PG8_AOFF(vA, cur);
    const char* cA = S.a_base(cur); const char* cB = S.b_base(cur);
    PG8_STAGE(PG8_SB(0, 0), cB, voffB); PG8_STAGE(PG8_SA(0), cA, vA); PG8_STAGE(PG8_SB(0, 1), cB + hstepB, voffB);
    if (wr == 1) PG8_BAR;
    PG8_WAIT_V(2); PG8_BAR;
    PG8_STAGE(PG8_SB(1, 0), cB + kstepB, voffB); PG8_STAGE(PG8_SA(1), cA + kstepA, vA);
    PG8_WAIT_V(4); PG8_BAR;
    for (;;) {
        const bool has_next = S.next(ui + 1, nxt);
        const char* nA = cA; const char* nB = cB;
        if (has_next) { nA = S.a_base(nxt); nB = S.b_base(nxt); if (P::EARLY_AOFF) PG8_AOFF(vN, nxt); }
        for (int t = 0; t < nt; t += 2) {
            const bool last = (t == nt - 2);
            const char* b1 = cB + (size_t)(t + 1) * kstepB;
            const char* a2 = last ? nA : cA + (size_t)(t + 2) * kstepA; const char* b2 = last ? nB : cB + (size_t)(t + 2) * kstepB;
            const char* a3 = a2 + kstepA; const char* b3 = b2 + kstepB;
            PG8_LDB(B0, 0, 0); PG8_SCHED; PG8_LDA(At, 0); PG8_STAGE(PG8_SB(1, 1), b1 + hstepB, voffB);
            if (last && has_next) { if (P::EARLY_AOFF) { vA[0] = vN[0]; vA[1] = vN[1]; } else PG8_AOFF(vA, nxt); }
            PG8_WAIT_V(6); PG8_WAIT_L(0); PG8_BAR; PG8_MMA(0, At, B0); PG8_BAR; PG8_SCHED;
            PG8_LDB(B0, 0, 1); PG8_STAGE(PG8_SB(0, 0), b2, voffB); PG8_STAGE(PG8_SA(0), a2, vA);
            PG8_WAIT_V(6); PG8_WAIT_L(0); PG8_BAR; PG8_MMA(1, At, B0); PG8_BAR; PG8_SCHED;
            PG8_LDB(B0, 1, 0); PG8_SCHED; PG8_LDA(At, 1); PG8_STAGE(PG8_SB(0, 1), b2 + hstepB, voffB);
            PG8_WAIT_V(6); PG8_WAIT_L(0); PG8_BAR; PG8_MMA(0, At, B0); PG8_BAR; PG8_SCHED;
            PG8_LDB(B0, 1, 1); PG8_STAGE(PG8_SB(1, 0), b3, voffB); PG8_STAGE(PG8_SA(1), a3, vA);
            PG8_WAIT_V(6); PG8_WAIT_L(0); PG8_BAR; PG8_MMA(1, At, B0); PG8_BAR; PG8_SCHED;
        }
        if (wr == 0) PG8_BAR;
        S.epi(acc, st, cur, wr, wc, fr, fq);
        if (!has_next) break;
#pragma unroll
        for (int a = 0; a < 2; ++a)
#pragma unroll
            for (int m = 0; m < 4; ++m)
#pragma unroll
                for (int n = 0; n < 2; ++n) acc[a][m][n] = (f32x4){0.f, 0.f, 0.f, 0.f};
        cur = nxt; cA = nA; cB = nB; ++ui;
        if (wr == 1) PG8_BAR;
    }
    PG8_WAIT_V(0);
    PG8_BAR;
#undef PG8_AOFF
#undef PG8_SA
#undef PG8_SB
#undef PG8_STAGE
#undef PG8_LDA
#undef PG8_LDB
#undef PG8_MMA
#undef PG8_CAT
#undef PG8_WAIT_V
#undef PG8_WAIT_L
#undef PG8_BAR
#undef PG8_SCHED
}
}
namespace attn_body {
using bf16x8 = __attribute__((ext_vector_type(8))) short;
using u32x4 = __attribute__((ext_vector_type(4))) unsigned;
constexpr int NW = 8, QBLK = 32, QB = QBLK * NW, KVBLK = 64;
__device__ __forceinline__ int crow(int r, int hi) { return (r & 3) + 8 * (r >> 2) + 4 * hi; }
#define SBAR() __builtin_amdgcn_sched_barrier(0)
constexpr int NSLOT = 3, SLOTB = 8192;
constexpr int LDS_K = 0, LDS_V = NSLOT * SLOTB, LDS_WS = 2 * NSLOT * SLOTB, LDS_OST = LDS_WS + NW * 64 * 4, LDS_BYTES = LDS_OST + NW * 4096;
constexpr int LDS_BT = 86016 + 256;
__device__ __forceinline__ void glds16(const void* gsrc, unsigned lds_dst) { unsigned keep;
  asm volatile("s_mov_b32 %0, m0\n\ts_mov_b32 m0, %2\n\ts_nop 0\n\tglobal_load_lds_dwordx4 %1, off\n\ts_mov_b32 m0, %0" : "=&s"(keep) : "v"(gsrc), "s"(lds_dst) : "memory"); }
__device__ __forceinline__ float max3f(float a, float b, float c) { float r; asm("v_max3_f32 %0, %1, %2, %3" : "=v"(r) : "v"(a), "v"(b), "v"(c)); return r; }
__device__ __forceinline__ float max2f(float a, float b) { float r; asm("v_max_f32_e32 %0, %1, %2" : "=v"(r) : "v"(a), "v"(b)); return r; }
__device__ __forceinline__ float fadd_s(float a, float b) { float r; asm("v_add_f32_e32 %0, %1, %2" : "=v"(r) : "v"(a), "v"(b)); return r; }
__device__ __forceinline__ float fsub_s(float a, float b) { float r; asm("v_sub_f32_e32 %0, %1, %2" : "=v"(r) : "v"(a), "v"(b)); return r; }
typedef float f32x2_t __attribute__((ext_vector_type(2))); typedef __bf16 bf16x2_t __attribute__((ext_vector_type(2)));
__device__ __forceinline__ unsigned cvtpk_s(float lo, float hi) { f32x2_t v = {lo, hi}; bf16x2_t b = __builtin_convertvector(v, bf16x2_t); return __builtin_bit_cast(unsigned, b); }
#define WAIT_BAR(N) asm volatile("s_waitcnt vmcnt(" #N ") lgkmcnt(0)\n\ts_barrier" ::: "memory")

__device__ __forceinline__ void qkt(f32x16& p0, f32x16& p1, const char* Kslot, const bf16x8* qr, const f32x16& negm, int r32, int hi) {
  const char* kb = Kslot + hi * 1024 + r32 * 16;
  #pragma unroll
  for (int d0 = 0; d0 < 4; ++d0) {
    const bf16x8 b0 = *reinterpret_cast<const bf16x8*>(kb + d0 * 2048);
    const bf16x8 b1 = *reinterpret_cast<const bf16x8*>(kb + d0 * 2048 + 512);
    if (d0 == 0) { p0 = __builtin_amdgcn_mfma_f32_32x32x16_bf16(b0, qr[0], negm, 0, 0, 0); p1 = __builtin_amdgcn_mfma_f32_32x32x16_bf16(b1, qr[0], negm, 0, 0, 0); }
    else { p0 = __builtin_amdgcn_mfma_f32_32x32x16_bf16(b0, qr[d0], p0, 0, 0, 0); p1 = __builtin_amdgcn_mfma_f32_32x32x16_bf16(b1, qr[d0], p1, 0, 0, 0); } }
}
typedef __attribute__((address_space(3))) const char* lds_cptr;
typedef short v4i16_t __attribute__((ext_vector_type(4)));
__device__ __forceinline__ void kload8(bf16x8* kf, lds_cptr kp) {
  kf[0] = *(const __attribute__((address_space(3))) bf16x8*)(kp);        kf[1] = *(const __attribute__((address_space(3))) bf16x8*)(kp + 512);
  kf[2] = *(const __attribute__((address_space(3))) bf16x8*)(kp + 2048); kf[3] = *(const __attribute__((address_space(3))) bf16x8*)(kp + 2560);
  kf[4] = *(const __attribute__((address_space(3))) bf16x8*)(kp + 4096); kf[5] = *(const __attribute__((address_space(3))) bf16x8*)(kp + 4608);
  kf[6] = *(const __attribute__((address_space(3))) bf16x8*)(kp + 6144); kf[7] = *(const __attribute__((address_space(3))) bf16x8*)(kp + 6656);
}
__device__ __forceinline__ void kload2(bf16x8* kf, lds_cptr kp, int j) { kf[2 * j] = *(const __attribute__((address_space(3))) bf16x8*)(kp + j * 2048); kf[2 * j + 1] = *(const __attribute__((address_space(3))) bf16x8*)(kp + j * 2048 + 512); }
__device__ __forceinline__ s16x4 vtr(lds_cptr p) { return __builtin_bit_cast(s16x4, __builtin_amdgcn_ds_read_tr16_b64_v4i16((__attribute__((address_space(3))) v4i16_t*)p)); }
__device__ __forceinline__ float rowmax(const f32x16& p0, const f32x16& p1) {
  float a = max3f(p0[0], p0[1], p1[0]), b = max3f(p0[2], p0[3], p1[1]); a = max3f(a, p1[2], p1[3]);
  #pragma unroll
  for (int r = 4; r < 16; r += 4) { a = max3f(a, p0[r], p0[r + 1]); b = max3f(b, p0[r + 2], p0[r + 3]); a = max3f(a, p1[r], p1[r + 1]); b = max3f(b, p1[r + 2], p1[r + 3]); }
  const float m = max2f(a, b);
  auto rr = __builtin_amdgcn_permlane32_swap(__float_as_uint(m), __float_as_uint(m), false, false);
  return max2f(__uint_as_float(rr[0]), __uint_as_float(rr[1]));
}
__device__ __forceinline__ void pv(f32x16* o, int vb, bf16x8 pa0, bf16x8 pa1, bf16x8 pa2, bf16x8 pa3) {
  #pragma unroll
  for (int d0 = 0; d0 < 2; ++d0) { s16x4 lo[4], hi[4];
    #pragma unroll
    for (int ks = 0; ks < 4; ++ks) {
      asm volatile("ds_read_b64_tr_b16 %0,%1 offset:%c2" : "=&v"(lo[ks]) : "v"(vb), "i"(d0 * 4096 + ks * 1024) : "memory");
      asm volatile("ds_read_b64_tr_b16 %0,%1 offset:%c2" : "=&v"(hi[ks]) : "v"(vb), "i"(d0 * 4096 + ks * 1024 + 512) : "memory"); }
    asm volatile("s_waitcnt lgkmcnt(0)" ::: "memory"); SBAR();
    #define PK(k) (bf16x8){lo[k][0], lo[k][1], lo[k][2], lo[k][3], hi[k][0], hi[k][1], hi[k][2], hi[k][3]}
    o[d0] = __builtin_amdgcn_mfma_f32_32x32x16_bf16(pa0, PK(0), o[d0], 0, 0, 0);
    o[d0] = __builtin_amdgcn_mfma_f32_32x32x16_bf16(pa1, PK(1), o[d0], 0, 0, 0);
    o[d0] = __builtin_amdgcn_mfma_f32_32x32x16_bf16(pa2, PK(2), o[d0], 0, 0, 0);
    o[d0] = __builtin_amdgcn_mfma_f32_32x32x16_bf16(pa3, PK(3), o[d0], 0, 0, 0);
    #undef PK
  }
}
#define ATTN_STORE16(p, v) (*(u32x4*)(p) = (v))

template <int THRL, bool NA, int QP_, int KVP_, bool NOMAX = false>
__device__ __forceinline__ void attn_unit(const bf16* Qu, int qp_rt, const bf16* __restrict__ Kh, const bf16* __restrict__ Vh, int kvp_rt, bf16* Ou, int NT, int r0, int rlo, char* shm) {
  const int qp = QP_ ? QP_ : qp_rt, kvp = KVP_ ? KVP_ : kvp_rt, op = qp;
  int tid_ = threadIdx.x; asm volatile("" : "+v"(tid_));
  const int tid = tid_, lane = tid & 63, r32 = lane & 31, hi = lane >> 5; const int wid = __builtin_amdgcn_readfirstlane(tid >> 6);
  const bf16* Qw = Qu + (long)(wid * QBLK) * qp;
  const unsigned lds0 = (unsigned)(uintptr_t)shm;
  float* wsf = (float*)(shm + LDS_WS) + wid * 64;
  const bf16* ksrc = Kh + (long)lane * kvp + wid * 8;
  const bf16* vsrc = Vh + (long)(16 * (wid & 3) + (lane >> 2)) * kvp + (wid >> 2) * 32 + (lane & 3) * 8;
  const unsigned kdst = lds0 + LDS_K + wid * 1024, vdst = lds0 + LDS_V + wid * 1024;
  #define TROW(t) (NA ? ((t) < 4 ? 64 * (t) : CTX + 64 * ((rlo + (t) - 4) < 127 ? (rlo + (t) - 4) : 127)) : 64 * (t))
  #define DMA_K(t, slot) glds16(ksrc + (long)TROW(t) * kvp, (unsigned)__builtin_amdgcn_readfirstlane(kdst + (slot)))
  #define DMA_V(t, slot) glds16(vsrc + (long)TROW(t) * kvp, (unsigned)__builtin_amdgcn_readfirstlane(vdst + (slot)))
  const int vb0 = (int)(lds0 + LDS_V) + ((lane >> 4) & 1) * 32 + (lane & 3) * 8 + (4 * hi + ((lane & 15) >> 2)) * 64;
  const char* Kbase = shm + LDS_K; bf16x8 kf[8];
  const lds_cptr shm3 = (lds_cptr)shm; const lds_cptr kp0 = shm3 + LDS_K + hi * 1024 + r32 * 16; const lds_cptr vp0 = shm3 + LDS_V + ((lane >> 4) & 1) * 32 + (lane & 3) * 8 + (4 * hi + ((lane & 15) >> 2)) * 64;
  const int rq = r0 + (wid >> 1), qc = 32 * (wid & 1) + r32;
  const int rsw = rq - 4 < 0 ? 0 : (rq - 4 > 120 ? 120 : rq - 4);
  const int cs = qc - 8 < 0 ? 0 : (qc - 8 > 48 ? 48 : qc - 8);
  const __attribute__((address_space(3))) float* btl = (const __attribute__((address_space(3))) float*)(shm3 + LDS_BT) + (15 + 4 * hi - qc);
  DMA_K(0, 0); DMA_V(0, 0); DMA_K(1, SLOTB);
  bf16x8 qr[4];
  #pragma unroll
  for (int d0 = 0; d0 < 4; ++d0) qr[d0] = *reinterpret_cast<const bf16x8*>(&Qw[(long)r32 * qp + d0 * 16 + hi * 8]);
  float mhat = 0.f, l_reg = 0.f; f32x16 o[2]; o[0] = f32x16{}; o[1] = f32x16{}; f32x16 negm = f32x16{}; if (!NA) asm volatile("" : "+v"(negm));
  #define NEGM (NA ? f32x16{} : negm)
  #define CMASK(P0, P1, t) do { if (NA) { if ((t) >= 4) { const int kr_ = rlo + (t) - 4; const int dr_ = kr_ - rsw; \
      if (dr_ < 0 || dr_ >= 8) { _Pragma("unroll") for (int r = 0; r < 16; ++r) { P0[r] = (-__builtin_inff()); P1[r] = (-__builtin_inff()); } } \
      else { const __attribute__((address_space(3))) float* bp_ = btl + (kr_ - rq + 7) * 31; const int kl0_ = 4 * hi - cs; \
        _Pragma("unroll") for (int rg = 0; rg < 4; ++rg) { \
          _Pragma("unroll") for (int rr_ = 0; rr_ < 4; ++rr_) { const int r = rg * 4 + rr_; const int kc_ = (r & 3) + 8 * (r >> 2); const float b0_ = bp_[kc_], b1_ = bp_[kc_ + 32]; \
            const int kl_ = kc_ + kl0_; P0[r] = ((unsigned)kl_ < 16u) ? P0[r] + b0_ : (-__builtin_inff()); P1[r] = ((unsigned)(kl_ + 32) < 16u) ? P1[r] + b1_ : (-__builtin_inff()); } \
          SBAR(); } } } } } while (0)
  bool resc = false;
  #define START(P0, P1) do { const float rm = NOMAX ? 0.f : rowmax(P0, P1); resc = false; \
    { const float dl = rm; mhat = fadd_s(mhat, dl); \
      _Pragma("unroll") for (int r = 0; r < 16; ++r) { P0[r] = fsub_s(P0[r], dl); P1[r] = fsub_s(P1[r], dl); } \
      if (!NA) { _Pragma("unroll") for (int r = 0; r < 16; ++r) negm[r] = -mhat; asm volatile("" : "+v"(negm)); } } \
    _Pragma("unroll") for (int r = 0; r < 16; ++r) P0[r] = __builtin_amdgcn_exp2f(P0[r]); } while (0)
  #define RESC() do { if (resc) { asm volatile("s_waitcnt lgkmcnt(0)" ::: "memory"); \
      _Pragma("unroll") for (int d_ = 0; d_ < 2; ++d_) _Pragma("unroll") for (int r = 0; r < 16; ++r) o[d_][r] *= wsf[crow(r, hi)]; } } while (0)
  f32x16 pA0, pA1, pB0, pB1;
  int sl_prev = 0, sl_cur = 0, sl_next = SLOTB;
  #define ROT() do { sl_prev = sl_cur; sl_cur = sl_next; sl_next = (sl_next == (NSLOT - 1) * SLOTB) ? 0 : sl_next + SLOTB; } while (0)
  DMA_K(2, 2 * SLOTB);
  WAIT_BAR(3);
  qkt(pA0, pA1, Kbase, qr, NEGM, r32, hi); asm volatile("s_nop 15\n\ts_nop 7" : "+v"(pA0), "+v"(pA1));
  START(pA0, pA1);
  _Pragma("unroll") for (int r = 0; r < 16; ++r) pA1[r] = __builtin_amdgcn_exp2f(pA1[r]);
  WAIT_BAR(0);
  DMA_K(3, 0); DMA_V(1, SLOTB);
  ROT();
  kload8(kf, kp0 + sl_cur);
  WAIT_BAR(2);
  s16x4 vlo[8], vhi[8]; u32x4 pw0, pw1, pw2, pw3;
  #define PKW(P, B) cvtpk_s(P[B], P[B + 1])
  #define PAF(k) __builtin_bit_cast(bf16x8, pw##k)
  #define VFR(i) (bf16x8){vlo[i][0], vlo[i][1], vlo[i][2], vlo[i][3], vhi[i][0], vhi[i][1], vhi[i][2], vhi[i][3]}
  #define PIN(x) asm volatile("" : "+v"(x))
  #define MX3(a, b, c) __builtin_fmaxf(__builtin_fmaxf((a), (b)), (c))
  #define GAPA(MF, A0, A1, A2, A3, W0, W1, PW) do { MF; sacc2 += (f32x2_t){A0, A1}; sacc2 += (f32x2_t){A2, A3}; PIN(sacc2); W0; W1; PIN(PW); SBAR(); } while (0)
  #define EX(v) __builtin_amdgcn_exp2f(v)
  #define GAPB(MF, X, B) do { MF; X[B] = EX(X[B]); X[B + 1] = EX(X[B + 1]); X[B + 2] = EX(X[B + 2]); X[B + 3] = EX(X[B + 3]); PIN(X); SBAR(); } while (0)
  #define VRD(i) do { vlo[i] = vtr(vp_ + (((i) >> 2) * 4096 + ((i) & 3) * 1024)); vhi[i] = vtr(vp_ + (((i) >> 2) * 4096 + ((i) & 3) * 1024 + 512)); } while (0)
  #define KRD(G, j) do { if (G) { kload2(kf, kp0 + sl_next, j); SBAR(); } } while (0)
  #define STEP(C0, C1, P0, P1, t, GK, GV, GL) do { SBAR(); \
    const lds_cptr vp_ = vp0 + sl_prev; \
    VRD(0); SBAR(); f32x2_t sacc2 = (f32x2_t){P0[0], P0[1]}; \
    GAPA(C0 = __builtin_amdgcn_mfma_f32_32x32x16_bf16(kf[0], qr[0], NEGM, 0, 0, 0), P0[2], P0[3], P0[4], P0[5],     pw0[0] = PKW(P0, 0), pw0[1] = PKW(P0, 2), pw0); \
    VRD(4); SBAR(); GAPA(C1 = __builtin_amdgcn_mfma_f32_32x32x16_bf16(kf[1], qr[0], NEGM, 0, 0, 0), P0[6], P0[7], P0[8], P0[9],     pw0[2] = PKW(P0, 4), pw0[3] = PKW(P0, 6), pw0); \
    VRD(1); SBAR(); GAPA(C0 = __builtin_amdgcn_mfma_f32_32x32x16_bf16(kf[2], qr[1], C0, 0, 0, 0),   P0[10], P0[11], P0[12], P0[13], pw1[0] = PKW(P0, 8), pw1[1] = PKW(P0, 10), pw1); \
    VRD(5); SBAR(); GAPA(C1 = __builtin_amdgcn_mfma_f32_32x32x16_bf16(kf[3], qr[1], C1, 0, 0, 0),   P0[14], P0[15], P1[0], P1[1],   pw1[2] = PKW(P0, 12), pw1[3] = PKW(P0, 14), pw1); \
    VRD(2); SBAR(); GAPA(C0 = __builtin_amdgcn_mfma_f32_32x32x16_bf16(kf[4], qr[2], C0, 0, 0, 0),   P1[2], P1[3], P1[4], P1[5],     pw2[0] = PKW(P1, 0), pw2[1] = PKW(P1, 2), pw2); \
    VRD(6); SBAR(); GAPA(C1 = __builtin_amdgcn_mfma_f32_32x32x16_bf16(kf[5], qr[2], C1, 0, 0, 0),   P1[6], P1[7], P1[8], P1[9],     pw2[2] = PKW(P1, 4), pw2[3] = PKW(P1, 6), pw2); \
    VRD(3); SBAR(); GAPA(C0 = __builtin_amdgcn_mfma_f32_32x32x16_bf16(kf[6], qr[3], C0, 0, 0, 0),   P1[10], P1[11], P1[12], P1[13], pw3[0] = PKW(P1, 8), pw3[1] = PKW(P1, 10), pw3); \
    VRD(7); SBAR(); GAPA(C1 = __builtin_amdgcn_mfma_f32_32x32x16_bf16(kf[7], qr[3], C1, 0, 0, 0),   P1[14], P1[15], 0.f, 0.f,       pw3[2] = PKW(P1, 12), pw3[3] = PKW(P1, 14), pw3); \
    l_reg += sacc2.x + sacc2.y; \
    if (GK) { DMA_K((t) + 3, sl_cur); } if (GV) { DMA_V((t) + 1, sl_next); } \
    resc = false; \
    if (NA) { _Pragma("unroll") for (int r = 0; r < 16; ++r) { C0[r] -= mhat; C1[r] -= mhat; } } \
    CMASK(C0, C1, t); \
    if (!NOMAX) { float a = MX3(C0[0], C0[1], C1[0]), b = MX3(C0[2], C0[3], C1[1]); a = MX3(a, C1[2], C1[3]); \
      _Pragma("unroll") for (int r = 4; r < 16; r += 4) { a = MX3(a, C0[r], C0[r + 1]); b = MX3(b, C0[r + 2], C0[r + 3]); a = MX3(a, C1[r], C1[r + 1]); b = MX3(b, C1[r + 2], C1[r + 3]); } \
      float rm = __builtin_fmaxf(a, b); { auto rr = __builtin_amdgcn_permlane32_swap(__float_as_uint(rm), __float_as_uint(rm), false, false); rm = __builtin_fmaxf(__uint_as_float(rr[0]), __uint_as_float(rr[1])); } \
      if (__builtin_expect(__any(rm > (float)THRL), 0)) { const float dl = __builtin_fmaxf(rm, 0.f); mhat += dl; \
        _Pragma("unroll") for (int r = 0; r < 16; ++r) { C0[r] -= dl; C1[r] -= dl; } \
        if (!NA) { _Pragma("unroll") for (int r = 0; r < 16; ++r) negm[r] = -mhat; asm volatile("" : "+v"(negm)); } \
        const float f = __builtin_amdgcn_exp2f(-dl); l_reg *= f; if (hi == 0) wsf[r32] = f; resc = true; } } \
    SBAR(); \
    GAPB(o[0] = __builtin_amdgcn_mfma_f32_32x32x16_bf16(PAF(0), VFR(0), o[0], 0, 0, 0), C0, 0); \
    GAPB(o[1] = __builtin_amdgcn_mfma_f32_32x32x16_bf16(PAF(0), VFR(4), o[1], 0, 0, 0), C0, 4); \
    KRD(GL, 0); GAPB(o[0] = __builtin_amdgcn_mfma_f32_32x32x16_bf16(PAF(1), VFR(1), o[0], 0, 0, 0), C0, 8); \
    KRD(GL, 1); GAPB(o[1] = __builtin_amdgcn_mfma_f32_32x32x16_bf16(PAF(1), VFR(5), o[1], 0, 0, 0), C0, 12); \
    KRD(GL, 2); GAPB(o[0] = __builtin_amdgcn_mfma_f32_32x32x16_bf16(PAF(2), VFR(2), o[0], 0, 0, 0), C1, 0); \
    KRD(GL, 3); GAPB(o[1] = __builtin_amdgcn_mfma_f32_32x32x16_bf16(PAF(2), VFR(6), o[1], 0, 0, 0), C1, 4); \
    GAPB(o[0] = __builtin_amdgcn_mfma_f32_32x32x16_bf16(PAF(3), VFR(3), o[0], 0, 0, 0), C1, 8); \
    GAPB(o[1] = __builtin_amdgcn_mfma_f32_32x32x16_bf16(PAF(3), VFR(7), o[1], 0, 0, 0), C1, 12); \
    } while (0)
  int t = 1;
  for (; t + 5 < NT; t += 2) {
    STEP(pB0, pB1, pA0, pA1, t, true, true, true);     WAIT_BAR(2); RESC(); ROT();
    STEP(pA0, pA1, pB0, pB1, t + 1, true, true, true); WAIT_BAR(2); RESC(); ROT();
  }
  #define ENDW(tt) do { if ((tt) + 3 < NT) { WAIT_BAR(2); } else if ((tt) + 2 < NT) { WAIT_BAR(1); } else { WAIT_BAR(0); } } while (0)
  for (; t + 1 < NT; t += 2) {
    STEP(pB0, pB1, pA0, pA1, t, (t + 3 < NT), (t + 1 < NT), (t + 1 < NT));         ENDW(t);     RESC(); ROT();
    STEP(pA0, pA1, pB0, pB1, t + 1, (t + 4 < NT), (t + 2 < NT), (t + 2 < NT));     ENDW(t + 1); RESC(); ROT();
  }
  STEP(pB0, pB1, pA0, pA1, NT - 1, false, false, false); RESC();
  { float sacc = pB0[0] + pB0[1]; _Pragma("unroll") for (int r = 2; r < 16; ++r) sacc += pB0[r]; _Pragma("unroll") for (int r = 0; r < 16; ++r) sacc += pB1[r]; l_reg += sacc;
    pw0 = (u32x4){PKW(pB0, 0), PKW(pB0, 2), PKW(pB0, 4), PKW(pB0, 6)}; pw1 = (u32x4){PKW(pB0, 8), PKW(pB0, 10), PKW(pB0, 12), PKW(pB0, 14)}; pw2 = (u32x4){PKW(pB1, 0), PKW(pB1, 2), PKW(pB1, 4), PKW(pB1, 6)}; pw3 = (u32x4){PKW(pB1, 8), PKW(pB1, 10), PKW(pB1, 12), PKW(pB1, 14)};
    SBAR(); pv(o, vb0 + sl_cur, PAF(0), PAF(1), PAF(2), PAF(3)); }
  #undef PKW
  #undef PAF
  #undef VFR
  #undef PIN
  #undef MX3
  #undef GAPA
  #undef GAPB
  #undef EX
  #undef VRD
  #undef KRD
  #undef STEP
  #undef ENDW
  { auto rr = __builtin_amdgcn_permlane32_swap(__float_as_uint(l_reg), __float_as_uint(l_reg), false, false); l_reg = __uint_as_float(rr[0]) + __uint_as_float(rr[1]); }
  if (hi == 0) wsf[32 + r32] = l_reg; asm volatile("s_waitcnt lgkmcnt(0)" ::: "memory");
  float rli[16];
  #pragma unroll
  for (int r = 0; r < 16; ++r) rli[r] = __builtin_amdgcn_rcpf(wsf[32 + crow(r, hi)]);
  bf16* Ow = Ou + (long)(wid * QBLK) * op;
  { bf16* stg = (bf16*)(shm + LDS_OST) + wid * 2048;
    #pragma unroll
    for (int r = 0; r < 16; ++r) { const int orow = crow(r, hi);
      #pragma unroll
      for (int d0 = 0; d0 < 2; ++d0) stg[orow * 64 + d0 * 32 + r32] = (bf16)f2bf(o[d0][r] * rli[r]); }
    asm volatile("s_waitcnt lgkmcnt(0)" ::: "memory");
    #pragma unroll
    for (int i = 0; i < 4; ++i) { const int row = i * 8 + (lane >> 3), ch = lane & 7; const u32x4 v = *(const u32x4*)(stg + row * 64 + ch * 8); ATTN_STORE16(Ow + (long)row * op + ch * 8, v); } }
  asm volatile("s_waitcnt lgkmcnt(0)\n\ts_barrier" ::: "memory");
  #undef NEGM
  #undef DMA_K
  #undef DMA_V
  #undef TROW
  #undef CMASK
  #undef START
  #undef RESC
  #undef ROT
}
#undef SBAR
#undef WAIT_BAR
}
#ifndef FP8_MOE
#define FP8_MOE 1
#endif
struct Args { const float* in[29]; float* out; unsigned char* ws; int ph_lo, ph_hi; };
enum { I_X = 0, I_C, I_CTX, I_CCTX, I_WMOD, I_BMOD, I_N1G, I_N2G, I_WIN, I_LRE, I_LIM, I_LDT, I_BRE, I_BIM, I_CRE, I_CIM, I_SSMD, I_WGLU, I_QNG, I_KNG, I_RPB, I_WBR, I_WOUT, I_RW, I_RB, I_MG, I_MU, I_MD, I_FNG };

typedef const float* CFP;
struct Ctx {
    const __attribute__((address_space(4))) CFP* in; float* out; unsigned char* ws; LAS unsigned char* lds; gu32* ctl;
    int tid, lane, wave, vcu, G;
};
#define WSP(T_, off) ((T_*)(C.ws + (off)))

__device__ __forceinline__ float* xs_row(const Ctx& C, int m) { const int b = m / LB, j = m - b * LB; return j < CTX ? WSP(float, WS_CTXS) + (size_t)(b * CTX + j) * D : C.out + (size_t)(b * SEQ + j - CTX) * D; }
__device__ __forceinline__ const float* in_row(const Ctx& C, int m) { const int b = m / LB, j = m - b * LB; return j < CTX ? C.in[I_CTX] + (size_t)(b * CTX + j) * D : C.in[I_X] + (size_t)(b * SEQ + j - CTX) * D; }
__device__ __forceinline__ int cond_of(int m) { const int b = m / LB, j = m - b * LB; return j < CTX ? 4 : b; }

__device__ __forceinline__ void transpose_item(const float* W, int N, int Kp, bf16* WT, int k0, int n0, int drow0, LAS float* scr, int lane) {
    const float* src = W + (size_t)k0 * N + n0 + lane;
    float tv[64];
#pragma unroll
    for (int i = 0; i < 64; ++i) tv[i] = src[(size_t)i * N];
#pragma unroll
    for (int i = 0; i < 64; ++i) scr[i * 65 + lane] = tv[i];
    LDS_WAIT(); asm volatile("" ::: "memory");
    const int c = lane & 7;
#pragma unroll
    for (int j = 0; j < 8; ++j) { const int n = (lane >> 3) + 8 * j; const LAS float* s = scr + (8 * c) * 65 + n;
        v4u o; o.x = pk2(s[0 * 65], s[1 * 65]); o.y = pk2(s[2 * 65], s[3 * 65]); o.z = pk2(s[4 * 65], s[5 * 65]); o.w = pk2(s[6 * 65], s[7 * 65]);
        *(GAS v4u*)(WT + (size_t)(drow0 + n) * Kp + k0 + 8 * c) = o; }
    LDS_WAIT(); asm volatile("" ::: "memory");
}
__device__ __forceinline__ void transpose_item8(const float* W, int N, int Kp, unsigned char* WT, int k0, int n0, int drow0, float scale, LAS float* scr, int lane) {
    const float* src = W + (size_t)k0 * N + n0 + lane;
    float tv[64];
#pragma unroll
    for (int i = 0; i < 64; ++i) tv[i] = src[(size_t)i * N];
#pragma unroll
    for (int i = 0; i < 64; ++i) scr[i * 65 + lane] = tv[i] * scale;
    LDS_WAIT(); asm volatile("" ::: "memory");
    const int c = lane & 3;
#pragma unroll
    for (int j = 0; j < 4; ++j) { const int n = (lane >> 2) + 16 * j; const LAS float* s = scr + (16 * c) * 65 + n;
        v4u o; o.x = pk4_fp8(s[0 * 65], s[1 * 65], s[2 * 65], s[3 * 65]); o.y = pk4_fp8(s[4 * 65], s[5 * 65], s[6 * 65], s[7 * 65]); o.z = pk4_fp8(s[8 * 65], s[9 * 65], s[10 * 65], s[11 * 65]); o.w = pk4_fp8(s[12 * 65], s[13 * 65], s[14 * 65], s[15 * 65]);
        *(GAS v4u*)(WT + (size_t)(drow0 + n) * Kp + k0 + 16 * c) = o; }
    LDS_WAIT(); asm volatile("" ::: "memory");
}
__device__ __forceinline__ void phase_weights(const Ctx& C, int l) {
    LAS float* scr = (LAS float*)(C.lds + C.wave * 16640);
    const int gw = C.vcu * NWAVES + C.wave, NGW = C.G * NWAVES;
    constexpr int I0 = 16 * 92, I1 = 8 * 8, I2 = 3 * 8 * 16, I3 = 16 * 16, I4 = 16 * 16 * 8, I5 = I4, I6 = 16 * 8 * 16;
    for (int it = gw; it < I0 + I1 + I2 + I3 + I4 + I5 + I6; it += NGW) {
        int r = it;
        if (r < I0) { const int kb = r / 92, nb = r % 92; if (nb < 44 || GATE_BF16) transpose_item(C.in[I_WIN] + (size_t)l * 1024 * INW, INW, 1024, WSP(bf16, WS_WIN), 64 * kb, 64 * nb, 64 * nb, scr, C.lane);
            else transpose_item8(C.in[I_WIN] + (size_t)l * 1024 * INW, INW, 1024, WSP(unsigned char, WS_WIN8), 64 * kb, 64 * nb, 64 * nb - 2816, 64.f, scr, C.lane); continue; } r -= I0;
        if (r < I1) { const int kb = r / 8, nb = r % 8; transpose_item(C.in[I_WGLU] + (size_t)l * 512 * 512, 512, 512, WSP(bf16, WS_WGLU), 64 * kb, 64 * nb, 64 * nb, scr, C.lane); continue; } r -= I1;
        if (r < I2) { const int i = r / 128, q = r % 128, kb = q / 16, nb = q % 16; transpose_item(C.in[I_WBR] + (size_t)(l * 3 + i) * 512 * 1024, 1024, 512, WSP(bf16, WS_WBR) + (size_t)i * 1024 * 512, 64 * kb, 64 * nb, 64 * nb, scr, C.lane); continue; } r -= I2;
        if (r < I3) { const int kb = r / 16, nb = r % 16; transpose_item(C.in[I_WOUT] + (size_t)l * 1024 * 1024, 1024, 1024, WSP(bf16, WS_WOUT), 64 * kb, 64 * nb, 64 * nb, scr, C.lane); continue; } r -= I3;
        if (r < I4 + I5) { const int up = r >= I4; if (up) r -= I4; const int e = r / 128, q = r % 128, kb = q / 8, nb = q % 8, n0 = 64 * nb;
            if (FP8_MOE) transpose_item8((up ? C.in[I_MU] : C.in[I_MG]) + (size_t)(l * 16 + e) * 1024 * 512, 512, 1024, WSP(unsigned char, WS_MOE1) + (size_t)e * 1024 * 1024, 64 * kb, n0, (n0 / 128) * 256 + (n0 % 128) + (up ? 128 : 0), 64.f, scr, C.lane);
            else transpose_item((up ? C.in[I_MU] : C.in[I_MG]) + (size_t)(l * 16 + e) * 1024 * 512, 512, 1024, WSP(bf16, WS_MOE1) + (size_t)e * 1024 * 1024, 64 * kb, n0, (n0 / 128) * 256 + (n0 % 128) + (up ? 128 : 0), scr, C.lane); continue; } r -= I4 + I5;
        { const int e = r / 128, q = r % 128, kb = q / 16, nb = q % 16; if (FP8_MOE) transpose_item8(C.in[I_MD] + (size_t)(l * 16 + e) * 512 * 1024, 1024, 512, WSP(unsigned char, WS_MOE2) + (size_t)e * 1024 * 512, 64 * kb, 64 * nb, 64 * nb, 32.f, scr, C.lane);
            else transpose_item(C.in[I_MD] + (size_t)(l * 16 + e) * 512 * 1024, 1024, 512, WSP(bf16, WS_MOE2) + (size_t)e * 1024 * 512, 64 * kb, 64 * nb, 64 * nb, scr, C.lane); }
    }
}

__device__ __forceinline__ void phase_mod(const Ctx& C) {
    LAS float* sc = (LAS float*)(C.lds);
    LAS float* red = (LAS float*)(C.lds + 20480);
    for (int i = C.tid; i < 5 * 1024; i += 512) { const int c = i >> 10, k = i & 1023; const float v = c < 4 ? C.in[I_C][c * 1024 + k] : C.in[I_CCTX][k]; sc[i] = v * fsigmoid(v); }
    __syncthreads();
    for (int it = C.vcu; it < NLAYER * 96; it += C.G) {
        const int l = it / 96, col = (it % 96) * 64 + C.lane, k0 = C.wave * 128;
        const float* W = C.in[I_WMOD] + (size_t)l * 1024 * 6144 + (size_t)k0 * 6144 + col;
        float a0 = 0.f, a1 = 0.f, a2 = 0.f, a3 = 0.f, a4 = 0.f;
#pragma unroll 16
        for (int k = 0; k < 128; ++k) { const float w = W[(size_t)k * 6144]; a0 += sc[k0 + k] * w; a1 += sc[1024 + k0 + k] * w; a2 += sc[2048 + k0 + k] * w; a3 += sc[3072 + k0 + k] * w; a4 += sc[4096 + k0 + k] * w; }
        LAS float* r = red + C.wave * 320 + C.lane; r[0] = a0; r[64] = a1; r[128] = a2; r[192] = a3; r[256] = a4;
        __syncthreads();
        if (C.tid < 320) { const int c = C.tid >> 6; float s = C.in[I_BMOD][l * 6144 + col];
#pragma unroll
            for (int w = 0; w < 8; ++w) s += red[w * 320 + C.tid];
            WSP(float, WS_MOD)[(size_t)(l * 5 + c) * 6144 + col] = s; }
        __syncthreads();
    }
}

__device__ __forceinline__ void phase_s5mats(const Ctx& C, int l) {
    if (C.vcu >= 128) return;
    const int g = C.vcu >> 2, part = C.vcu & 3, tid = C.tid;
    LAS f32x2* POW = (LAS f32x2*)(C.lds);
    LAS f32x2* CC = (LAS f32x2*)(C.lds + 33792);
    LAS f32x2* BB = (LAS f32x2*)(C.lds + 50176);
    LAS f32x2* COEF = (LAS f32x2*)(C.lds + 66560);
    LAS bf16* KT = (LAS bf16*)(C.lds + 67584);
    LAS float* K0 = (LAS float*)(C.lds + 99840);
    __syncthreads();
    if (tid < 128) {
        const int d = tid >> 6, p = tid & 63; const int li = ((l * 2 + d) * 32 + g) * 64 + p;
        const float re = C.in[I_LRE][li], im = C.in[I_LIM][li], dt = __expf(C.in[I_LDT][(l * 2 + d) * 32 + g]);
        for (int tau = 0; tau <= 32; ++tau) { const float mag = __expf(re * dt * (float)tau), rev = im * dt * (float)tau * 0.15915494309189535f;
            POW[(d * 33 + tau) * 64 + p] = (f32x2){mag * cos_rev(rev), mag * sin_rev(rev)}; }
        const float mag = __expf(re * dt), rev = im * dt * 0.15915494309189535f; const float lr = mag * cos_rev(rev) - 1.f, lim = mag * sin_rev(rev);
        const float den = 1.f / (re * re + im * im);
        COEF[tid] = (f32x2){(lr * re + lim * im) * den, (lim * re - lr * im) * den};
    }
    __syncthreads();
    for (int i = tid; i < 2048; i += 512) {
        const int d = i >> 10, p = (i >> 4) & 63, h = i & 15; const size_t bi = (((size_t)(l * 2 + d) * 32 + g) * 64 + p) * 16 + h;
        const float br = C.in[I_BRE][bi], bi_ = C.in[I_BIM][bi]; const f32x2 cf = COEF[d * 64 + p];
        BB[i] = (f32x2){cf.x * br - cf.y * bi_, cf.x * bi_ + cf.y * br};
        const int h2 = (i >> 6) & 15, p2 = i & 63; const size_t ci = (((size_t)(l * 2 + d) * 32 + g) * 16 + h2) * 64 + p2;
        CC[i] = (f32x2){C.in[I_CRE][ci], C.in[I_CIM][ci]};
    }
    __syncthreads();
    {
        const int d = tid >> 8, h = (tid >> 4) & 15, hp = tid & 15; float acc[32];
#pragma unroll
        for (int t = 0; t < 32; ++t) acc[t] = 0.f;
        for (int p = 0; p < 64; ++p) { const f32x2 c = CC[d * 1024 + h * 64 + p], b = BB[d * 1024 + p * 16 + hp], lam = POW[(d * 33 + 1) * 64 + p];
            float xr = c.x * b.x - c.y * b.y, xi = c.x * b.y + c.y * b.x;
#pragma unroll
            for (int t = 0; t < 32; ++t) { acc[t] += xr; const float nr = xr * lam.x - xi * lam.y, ni = xr * lam.y + xi * lam.x; xr = nr; xi = ni; } }
        if (d == 1) K0[tid & 255] = acc[0];
        __syncthreads();
        if (d == 0) { acc[0] += K0[tid] + (h == hp ? C.in[I_SSMD][l * 512 + g * 16 + h] : 0.f);
#pragma unroll
            for (int t = 0; t < 32; ++t) KT[((31 + t) * 16 + h) * 16 + hp] = (bf16)f2bf(acc[t]); }
        else {
#pragma unroll
            for (int t = 1; t < 32; ++t) KT[((31 - t) * 16 + h) * 16 + hp] = (bf16)f2bf(acc[t]); }
    }
    __syncthreads();
    bf16* B1 = WSP(bf16, WS_BT1) + (size_t)g * 768 * 512; bf16* B2 = WSP(bf16, WS_BT2) + (size_t)g * 512 * 256;
    for (int i = tid; i < 128 * 64; i += 512) {
        const int n = part * 128 + (i >> 6), ch = i & 63, t = n >> 4, h = n & 15, s = ch >> 1, hp0 = (ch & 1) * 8;
        *(GAS v4u*)(B1 + (size_t)n * 512 + ch * 8) = *(const LAS v4u*)(KT + ((t - s + 31) * 16 + h) * 16 + hp0);
    }
    for (int i = tid; i < 64 * 64; i += 512) {
        const int nn = part * 64 + (i >> 6), ch = i & 63, d = nn >> 7, p = (nn & 127) >> 1, ri = nn & 1, s = ch >> 1, hp0 = (ch & 1) * 8;
        const f32x2 w = POW[(d * 33 + (d == 0 ? 31 - s : s)) * 64 + p]; float v[8];
#pragma unroll
        for (int j = 0; j < 8; ++j) { const f32x2 b = BB[d * 1024 + p * 16 + hp0 + j]; v[j] = ri == 0 ? (w.x * b.x - w.y * b.y) : (w.x * b.y + w.y * b.x); }
        v4u o; o.x = pk2(v[0], v[1]); o.y = pk2(v[2], v[3]); o.z = pk2(v[4], v[5]); o.w = pk2(v[6], v[7]);
        *(GAS v4u*)(B1 + (size_t)(512 + nn) * 512 + ch * 8) = o;
    }
    for (int i = tid; i < 128 * 32; i += 512) {
        const int n = part * 128 + (i >> 5), ch = i & 31, t = n >> 4, h = n & 15, d = ch >> 4, p0 = (ch & 15) * 4; float v[8];
#pragma unroll
        for (int j = 0; j < 4; ++j) { const f32x2 c = CC[d * 1024 + h * 64 + p0 + j], w = POW[(d * 33 + (d == 0 ? t + 1 : 32 - t)) * 64 + p0 + j];
            v[2 * j] = c.x * w.x - c.y * w.y; v[2 * j + 1] = -(c.x * w.y + c.y * w.x); }
        v4u o; o.x = pk2(v[0], v[1]); o.y = pk2(v[2], v[3]); o.z = pk2(v[4], v[5]); o.w = pk2(v[6], v[7]);
        *(GAS v4u*)(B2 + (size_t)n * 256 + ch * 8) = o;
    }
    __syncthreads();
}

template <int MODE>
__device__ __forceinline__ void phase_rows(const Ctx& C, int l) {
    const int gw = C.vcu * NWAVES + C.wave, NGW = C.G * NWAVES, lane = C.lane;
    const float* MODl = WSP(float, WS_MOD) + (size_t)(MODE == 2 ? 0 : l) * 5 * 6144;
    const float* MODp = WSP(float, WS_MOD) + (size_t)(l > 0 ? l - 1 : 0) * 5 * 6144;
    const bf16* YS = WSP(bf16, WS_YSLOT);
    f32x4 nx[4]; v2u na[4], nc[4];
#define ROWS_LOAD(mm) do { const int m_ = (mm); \
        if (MODE == 0) { const GAS f32x4* xr = (const GAS f32x4*)in_row(C, m_) + lane; _Pragma("unroll") for (int q = 0; q < 4; ++q) nx[q] = xr[64 * q]; } \
        else { const GAS f32x4* xr = (const GAS f32x4*)xs_row(C, m_) + lane; const GAS v2u* y0 = (const GAS v2u*)(YS + (size_t)(2 * m_) * D) + lane; const GAS v2u* y1 = (const GAS v2u*)(YS + (size_t)(2 * m_ + 1) * D) + lane; \
            _Pragma("unroll") for (int q = 0; q < 4; ++q) { nx[q] = xr[64 * q]; na[q] = y0[64 * q]; nc[q] = y1[64 * q]; } } } while (0)
    int m = gw; if (MODE == 2) { while (m < T && (m % LB) < CTX) m += NGW; }
    if (m < T) ROWS_LOAD(m);
    while (m < T) {
        const int b = m / LB, j = m - b * LB, cond = j < CTX ? 4 : b;
        f32x4 v[4];
        if (MODE == 0) {
#pragma unroll
            for (int q = 0; q < 4; ++q) v[q] = nx[q]; }
        else { const GAS f32x4* g2 = (const GAS f32x4*)(MODp + cond * 6144 + 5 * 1024) + lane;
#pragma unroll
            for (int q = 0; q < 4; ++q) { const f32x4 g = g2[64 * q]; const v2u a = na[q], c = nc[q];
                v[q] = nx[q] + g * (f32x4){bflo(a.x) + bflo(c.x), bfhi(a.x) + bfhi(c.x), bflo(a.y) + bflo(c.y), bfhi(a.y) + bfhi(c.y)}; } }
        int mn = m + NGW; if (MODE == 2) { while (mn < T && (mn % LB) < CTX) mn += NGW; }
        if (mn < T) ROWS_LOAD(mn);
        float ss = 0.f;
#pragma unroll
        for (int q = 0; q < 4; ++q) ss += (v[q].x * v[q].x + v[q].y * v[q].y) + (v[q].z * v[q].z + v[q].w * v[q].w);
        const float rstd = 1.f / sqrtf(wave_sum(ss, lane) * (1.f / D) + EPS);
        if (MODE == 2) { GAS f32x4* o = (GAS f32x4*)(C.out + (size_t)(b * SEQ + j - CTX) * D) + lane; const GAS f32x4* fg = (const GAS f32x4*)C.in[I_FNG] + lane;
#pragma unroll
            for (int q = 0; q < 4; ++q) o[64 * q] = v[q] * rstd * fg[64 * q]; }
        else { GAS f32x4* xo = (GAS f32x4*)xs_row(C, m) + lane; GAS v2u* ho = (GAS v2u*)(WSP(bf16, WS_HB) + (size_t)m * D) + lane; GAS unsigned* h8 = (GAS unsigned*)(WSP(unsigned char, WS_HB8) + (size_t)m * D) + lane;
            const GAS f32x4* ng = (const GAS f32x4*)(C.in[I_N1G] + l * D) + lane; const GAS f32x4* sh = (const GAS f32x4*)(MODl + cond * 6144) + lane; const GAS f32x4* sc = (const GAS f32x4*)(MODl + cond * 6144 + 1024) + lane;
#pragma unroll
            for (int q = 0; q < 4; ++q) { xo[64 * q] = v[q]; const f32x4 h = v[q] * rstd * ng[64 * q] * (sc[64 * q] + 1.f) + sh[64 * q]; ho[64 * q] = (v2u){pk2(h.x, h.y), pk2(h.z, h.w)}; if (H8_WRITE) h8[64 * q] = pk4_fp8(h.x, h.y, h.z, h.w); } }
        m = mn;
    }
#undef ROWS_LOAD
}

__device__ __forceinline__ void phase_qkprep(const Ctx& C, int l) {
    const int gw = C.vcu * NWAVES + C.wave, NGW = C.G * NWAVES, lane = C.lane, s8 = lane & 7;
    const float* qg = C.in[I_QNG] + l * 64 + 8 * s8; const float* kg = C.in[I_KNG] + l * 64 + 8 * s8;
    float gq[8], gk[8];
#pragma unroll
    for (int i = 0; i < 8; ++i) { gq[i] = qg[i]; gk[i] = kg[i]; }
    const int ax = s8 >> 2, f0 = 8 * (s8 & 1);
    float inv[8];
#pragma unroll
    for (int i = 0; i < 8; ++i) inv[i] = exp2f(-(float)(f0 + i) * 0.8304820237218406f) * 0.15915494309189535f;
    const int kl = lane & 15;
    v4u wq, wk;
    if (gw < T) { wq = *((const GAS v4u*)(WSP(bf16, WS_QA) + (size_t)gw * 512) + lane); wk = *((const GAS v4u*)(WSP(bf16, WS_KA) + (size_t)gw * 128) + kl); }
    for (int m = gw; m < T; m += NGW) {
        const int b = m / LB, j = m - b * LB; const bool lat = j >= CTX; const int tt = j - CTX; const float pos = (float)(ax == 0 ? (tt >> 6) : (tt & 63));
        const v4u cq = wq, ck = wk;
        if (m + NGW < T) { wq = *((const GAS v4u*)(WSP(bf16, WS_QA) + (size_t)(m + NGW) * 512) + lane); wk = *((const GAS v4u*)(WSP(bf16, WS_KA) + (size_t)(m + NGW) * 128) + kl); }
        float cs[8], sn[8];
#pragma unroll
        for (int i = 0; i < 8; ++i) { cs[i] = lat ? cos_rev(pos * inv[i]) : 1.f; sn[i] = lat ? sin_rev(pos * inv[i]) : 0.f; }
#pragma unroll
        for (int which = 0; which < 2; ++which) {
            const v4u w = which == 0 ? cq : ck; float x[8] = {bflo(w.x), bfhi(w.x), bflo(w.y), bfhi(w.y), bflo(w.z), bfhi(w.z), bflo(w.w), bfhi(w.w)};
            float ss = 0.f;
#pragma unroll
            for (int i = 0; i < 8; ++i) ss += x[i] * x[i];
            ss += dpp_mov<0xB1, 0xF>(ss); ss += dpp_mov<0x4E, 0xF>(ss); ss += dpp_mov<0x141, 0xF>(ss);
            const float rstd = 1.f / sqrtf(ss * (1.f / 64.f) + EPS);
            float y[8];
#pragma unroll
            for (int i = 0; i < 8; ++i) { const float xn = x[i] * rstd * (which == 0 ? gq[i] : gk[i]); const float other = dpp_mov<0x4E, 0xF>(xn);
                y[i] = (s8 & 2) ? (xn * cs[i] + other * sn[i]) : (xn * cs[i] - other * sn[i]); }
            const float sc = which == 0 ? C2 : 1.f;
            v4u o; o.x = pk2(y[0] * sc, y[1] * sc); o.y = pk2(y[2] * sc, y[3] * sc); o.z = pk2(y[4] * sc, y[5] * sc); o.w = pk2(y[6] * sc, y[7] * sc);
            if (which == 0) *((GAS v4u*)(WSP(bf16, WS_QA) + (size_t)m * 512) + lane) = o;
            else if (lane < 16) *((GAS v4u*)(WSP(bf16, WS_KA) + (size_t)m * 128) + lane) = o;
        }
    }
}

__device__ __forceinline__ void phase_carry(const Ctx& C, int l) {
    if (C.vcu >= 32) return;
    const int b = C.vcu >> 3, g = (C.vcu & 7) * 4 + (C.wave >> 1), d = C.wave & 1, p = C.lane;
    const int li = ((l * 2 + d) * 32 + g) * 64 + p;
    const float re = C.in[I_LRE][li], im = C.in[I_LIM][li], dt = __expf(C.in[I_LDT][(l * 2 + d) * 32 + g]);
    const float mag = __expf(re * dt * 32.f), rev = im * dt * 32.f * 0.15915494309189535f; const float Lr = mag * cos_rev(rev), Li = mag * sin_rev(rev);
    const GAS f32x2* S = (const GAS f32x2*)(WSP(float, WS_SST) + (size_t)(b * NCH) * 8192 + g * 256 + d * 128) + p;
    GAS unsigned* X = (GAS unsigned*)(WSP(bf16, WS_XST) + (size_t)(b * NCH) * 8192 + g * 256 + d * 128) + p;
    float sr = 0.f, si = 0.f;
    if (d == 0) {
        for (int c0 = 0; c0 < NCH; c0 += 8) { f32x2 s[8];
#pragma unroll
            for (int k = 0; k < 8; ++k) s[k] = S[(size_t)(c0 + k) * 4096];
#pragma unroll
            for (int k = 0; k < 8; ++k) { X[(size_t)(c0 + k) * 4096] = pk2(sr, si); const float nr = Lr * sr - Li * si + s[k].x, ni = Lr * si + Li * sr + s[k].y; sr = nr; si = ni; } }
    } else {
        for (int seg = 0; seg < 33; ++seg) { const int chi = seg == 0 ? 7 : NCH - 1 - (seg - 1) * 8; f32x2 s[8];
#pragma unroll
            for (int k = 0; k < 8; ++k) s[k] = S[(size_t)(chi - k) * 4096];
#pragma unroll
            for (int k = 0; k < 8; ++k) { X[(size_t)(chi - k) * 4096] = pk2(sr, si); const float nr = Lr * sr - Li * si + s[k].x, ni = Lr * si + Li * sr + s[k].y; sr = nr; si = ni; } }
    }
}

__device__ __forceinline__ void phase_norm2(const Ctx& C, int l) {
    LAS float* RWt = (LAS float*)C.lds;
    LAS unsigned* REC = (LAS unsigned*)(C.lds + 65536);
    LAS float* LG = (LAS float*)(C.lds + 65536 + 16384);
    LAS unsigned* LCNT = (LAS unsigned*)(C.lds + 65536 + 32768);
    const int lane = C.lane, tid = C.tid;
    for (int i = tid; i < 16384; i += 512) { const int k = i >> 4, e = i & 15; RWt[e * 1024 + k] = C.in[I_RW][i]; }
    if (tid < 32) LCNT[tid] = 0u;
    __syncthreads();
    const float* MODl = WSP(float, WS_MOD) + (size_t)l * 5 * 6144;
    int nrows = 0; for (int m = C.vcu; m < T; m += C.G) ++nrows;
    f32x4 nx[4];
    if (C.wave < nrows) { const GAS f32x4* xr = (const GAS f32x4*)xs_row(C, C.vcu + C.G * C.wave) + lane;
#pragma unroll
        for (int q = 0; q < 4; ++q) nx[q] = xr[64 * q]; }
    for (int i = C.wave; i < nrows; i += NWAVES) {
        const int m = C.vcu + C.G * i, cond = cond_of(m);
        GAS unsigned* h8 = (GAS unsigned*)(WSP(unsigned char, WS_HB8) + (size_t)m * D) + lane; GAS v2u* ho = (GAS v2u*)(WSP(bf16, WS_HB) + (size_t)m * D) + lane;
        const GAS f32x4* ng = (const GAS f32x4*)(C.in[I_N2G] + l * D) + lane; const GAS f32x4* sh = (const GAS f32x4*)(MODl + cond * 6144 + 3072) + lane; const GAS f32x4* sc = (const GAS f32x4*)(MODl + cond * 6144 + 4096) + lane;
        f32x4 v[4]; float ss = 0.f;
#pragma unroll
        for (int q = 0; q < 4; ++q) { v[q] = nx[q]; ss += (v[q].x * v[q].x + v[q].y * v[q].y) + (v[q].z * v[q].z + v[q].w * v[q].w); }
        if (i + NWAVES < nrows) { const GAS f32x4* xr = (const GAS f32x4*)xs_row(C, m + C.G * NWAVES) + lane;
#pragma unroll
            for (int q = 0; q < 4; ++q) nx[q] = xr[64 * q]; }
        const float rstd = 1.f / sqrtf(wave_sum(ss, lane) * (1.f / D) + EPS);
        float lg[16];
#pragma unroll
        for (int e = 0; e < 16; ++e) lg[e] = 0.f;
#pragma unroll
        for (int q = 0; q < 4; ++q) { const f32x4 h = v[q] * rstd * ng[64 * q] * (sc[64 * q] + 1.f) + sh[64 * q]; if (FP8_MOE) h8[64 * q] = pk4_fp8(h.x, h.y, h.z, h.w); else ho[64 * q] = (v2u){pk2(h.x, h.y), pk2(h.z, h.w)};
#pragma unroll
            for (int e = 0; e < 16; ++e) { const f32x4 w = *(const LAS f32x4*)(RWt + e * 1024 + 256 * q + 4 * lane); lg[e] += (h.x * w.x + h.y * w.y) + (h.z * w.z + h.w * w.w); } }
        float mine = 0.f;
#pragma unroll
        for (int e = 0; e < 16; ++e) { const float t = wave_sum(lg[e], lane); mine = lane == e ? t : mine; }
        if (lane < 16) LG[i * 16 + lane] = mine;
    }
    __syncthreads();
    float rb[16];
#pragma unroll
    for (int e = 0; e < 16; ++e) rb[e] = C.in[I_RB][e];
    for (int i = tid; i < nrows; i += 512) {
        float lg[16];
#pragma unroll
        for (int q = 0; q < 4; ++q) { const f32x4 t = *(const LAS f32x4*)(LG + i * 16 + 4 * q); lg[4 * q] = t.x; lg[4 * q + 1] = t.y; lg[4 * q + 2] = t.z; lg[4 * q + 3] = t.w; }
        float mx = lg[0];
#pragma unroll
        for (int e = 1; e < 16; ++e) mx = fmaxf(mx, lg[e]);
        float pr[16], sel[16], sum = 0.f;
#pragma unroll
        for (int e = 0; e < 16; ++e) { pr[e] = __expf(lg[e] - mx); sum += pr[e]; }
        const float rs = 1.f / sum;
#pragma unroll
        for (int e = 0; e < 16; ++e) { pr[e] *= rs; sel[e] = pr[e] + rb[e]; }
        float bestv = -1e30f; int best = 0;
#pragma unroll
        for (int gq = 0; gq < 4; ++gq) { float m1 = -1e30f, m2 = -1e30f;
#pragma unroll
            for (int k = 0; k < 4; ++k) { const float s_ = sel[4 * gq + k]; if (s_ > m1) { m2 = m1; m1 = s_; } else if (s_ > m2) m2 = s_; }
            const float gs = m1 + m2; if (gs > bestv) { bestv = gs; best = gq; } }
        float s4[4], p4[4];
#pragma unroll
        for (int k = 0; k < 4; ++k) { s4[k] = best == 0 ? sel[k] : best == 1 ? sel[4 + k] : best == 2 ? sel[8 + k] : sel[12 + k]; p4[k] = best == 0 ? pr[k] : best == 1 ? pr[4 + k] : best == 2 ? pr[8 + k] : pr[12 + k]; }
        int i0 = 0; float v0 = s4[0], q0 = p4[0];
#pragma unroll
        for (int k = 1; k < 4; ++k) if (s4[k] > v0) { v0 = s4[k]; i0 = k; q0 = p4[k]; }
        int i1 = i0 == 0 ? 1 : 0; float v1 = -1e30f, q1 = p4[i0 == 0 ? 1 : 0];
#pragma unroll
        for (int k = 0; k < 4; ++k) if (k != i0 && s4[k] > v1) { v1 = s4[k]; i1 = k; q1 = p4[k]; }
        const int e0 = 4 * best + i0, e1 = 4 * best + i1; const float wn = 1.f / (q0 + q1);
        const unsigned lp0 = atomicAdd((unsigned*)(LCNT + e0), 1u), lp1 = atomicAdd((unsigned*)(LCNT + e1), 1u);
        REC[i * 4 + 0] = (unsigned)e0 | ((unsigned)e1 << 8) | (lp0 << 16); REC[i * 4 + 1] = lp1; REC[i * 4 + 2] = __float_as_uint(q0 * wn); REC[i * 4 + 3] = __float_as_uint(q1 * wn);
    }
    __syncthreads();
    if (tid < 16) LCNT[16 + tid] = __hip_atomic_fetch_add((unsigned*)(C.ctl + CW_CNT + l * 1024 + 64 * tid), LCNT[tid], RLX_AGENT);
    __syncthreads();
    int* LIST = WSP(int, WS_LIST); float* RWG = WSP(float, WS_RW);
    for (int i = tid; i < nrows; i += 512) { const int m = C.vcu + C.G * i; const unsigned r0 = REC[i * 4], r1 = REC[i * 4 + 1];
        const int e0 = r0 & 255, e1 = (r0 >> 8) & 255; const unsigned lp0 = r0 >> 16, lp1 = r1;
        LIST[(size_t)e0 * T + LCNT[16 + e0] + lp0] = 2 * m; LIST[(size_t)e1 * T + LCNT[16 + e1] + lp1] = 2 * m + 1;
        RWG[2 * m] = __uint_as_float(REC[i * 4 + 2]); RWG[2 * m + 1] = __uint_as_float(REC[i * 4 + 3]); }
    __syncthreads();
}
using pg8::Unit;
typedef f32x4 Acc[2][2][4][2];
__device__ __forceinline__ v4u pack8(const f32x4& a, const f32x4& b) { v4u w; w.x = cvt_pk_bf16(a[0], a[1]); w.y = cvt_pk_bf16(a[2], a[3]); w.z = cvt_pk_bf16(b[0], b[1]); w.w = cvt_pk_bf16(b[2], b[3]); return w; }
__device__ __forceinline__ void unpack8(const v4u& w, f32x4& a, f32x4& b) { a = (f32x4){bflo(w.x), bfhi(w.x), bflo(w.y), bfhi(w.y)}; b = (f32x4){bflo(w.z), bfhi(w.z), bflo(w.w), bfhi(w.w)}; }
#ifndef WT_MODE
#define WT_MODE 0
#endif
__device__ __forceinline__ void st16(void* p, const v4u& v) {
#if WT_MODE == 1
    asm volatile("global_store_dwordx4 %0, %1, off sc0 sc1" :: "v"(p), "v"(v) : "memory");
#elif WT_MODE == 2
    asm volatile("global_store_dwordx4 %0, %1, off nt" :: "v"(p), "v"(v) : "memory");
#else
    *(GAS v4u*)p = v;
#endif
}
__device__ __forceinline__ int chunk_m0(int cr) { return (cr / NCH) * LB + (cr % NCH) * 32; }

struct PWin {
    static constexpr bool EARLY_AOFF = false, FP8 = false; unsigned char* ws; int G, c; int K; unsigned kstepA;
    __device__ __forceinline__ bool next(int i, Unit& u) const { const long L = (long)i * G + c; if (L >= NPAN * 11) return false; pg8::static_decode((int)L, NPAN, 11, u.pm, u.pn); u.z = 0; return true; }
    __device__ __forceinline__ const char* a_base(const Unit& u) const { return (const char*)(ws + WS_HB) + (size_t)u.pm * 256 * 1024 * 2; }
    __device__ __forceinline__ unsigned a_off(const Unit&, int h, int R, int Cc) const { return (unsigned)((h * 128 + R) * 1024 + Cc) * 2u; }
    __device__ __forceinline__ const char* b_base(const Unit& u) const { return (const char*)(ws + WS_WIN) + (size_t)u.pn * 256 * 1024 * 2; }
    __device__ __forceinline__ void epi(const Acc& acc, const Unit& u, int wr, int wc, int fr, int fq) const {
        const int row0 = u.pm * 256 + wr * 64 + fr;
#pragma unroll
        for (int bj = 0; bj < 2; ++bj) {
            const int cb = u.pn * 256 + bj * 128; bf16* dst; int ld, col, mode = 0; float sc = 1.f;
            if (cb < 512) { dst = (bf16*)(ws + WS_U) + ((size_t)((cb + wc * 32 + 8 * fq) >> 4) * T) * 16 + ((8 * fq) & 15) - (wc * 32 + 8 * fq); ld = 16; col = 0; }
            else if (cb < 1024) { dst = (bf16*)(ws + WS_QA); ld = 512; col = cb - 512; }
            else if (cb == 1024) { dst = (bf16*)(ws + WS_KA); ld = 128; col = 0; }
            else if (cb == 1152) { dst = (bf16*)(ws + WS_VA); ld = 128; col = 0; }
            else if (cb < 1792) { dst = (bf16*)(ws + WS_QN); ld = 512; col = cb - 1280; sc = C2; }
            else if (cb < 2304) { dst = (bf16*)(ws + WS_KN); ld = 512; col = cb - 1792; }
            else { dst = (bf16*)(ws + WS_VN); ld = 512; col = cb - 2304; }
            const int c0 = col + wc * 32 + 8 * fq;
#pragma unroll
            for (int ai = 0; ai < 2; ++ai)
#pragma unroll
                for (int m = 0; m < 4; ++m) { f32x4 v0 = acc[ai][bj][m][0], v1 = acc[ai][bj][m][1];
                    if (mode) { v0 = (f32x4){fsigmoid(v0[0]), fsigmoid(v0[1]), fsigmoid(v0[2]), fsigmoid(v0[3])}; v1 = (f32x4){fsigmoid(v1[0]), fsigmoid(v1[1]), fsigmoid(v1[2]), fsigmoid(v1[3])}; }
                    else { v0 = v0 * sc; v1 = v1 * sc; }
                    st16(dst + (size_t)(row0 + ai * 128 + m * 16) * ld + c0, pack8(v0, v1)); __builtin_amdgcn_sched_barrier(0); }
        }
    }
};

struct PGate {
    static constexpr bool EARLY_AOFF = false, FP8 = !GATE_BF16; unsigned char* ws; int G, c; int K; unsigned kstepA;
    __device__ __forceinline__ bool next(int i, Unit& u) const { const long L = (long)i * G + c; if (L >= 2 * NPAN * 12) return false; pg8::static_decode((int)L, 2 * NPAN, 12, u.pm, u.pn); u.z = 0; return true; }
    __device__ __forceinline__ const char* a_base(const Unit& u) const { return GATE_BF16 ? (const char*)(ws + WS_HB) + (size_t)u.pm * 128 * 2048 : (const char*)(ws + WS_HB8) + (size_t)u.pm * 128 * 1024; }
    __device__ __forceinline__ unsigned a_off(const Unit&, int R, int Cc) const { return GATE_BF16 ? (unsigned)(R * 2048 + Cc * 2) : (unsigned)(R * 1024 + Cc * 2); }
    __device__ __forceinline__ const char* b_base(const Unit& u) const { return GATE_BF16 ? (const char*)(ws + WS_WIN) + (size_t)(2816 + u.pn * 256) * 2048 : (const char*)(ws + WS_WIN8) + (size_t)u.pn * 256 * 1024; }
    __device__ __forceinline__ void epi(const f32x4 (&acc)[2][4][2], f32x4 (&)[2][4][2], const Unit& u, int wr, int wc, int fr, int fq) const {
#pragma unroll
        for (int m = 0; m < 4; ++m) { const size_t r = (size_t)(u.pm * 128 + wr * 64 + m * 16 + fr);
#pragma unroll
            for (int bj = 0; bj < 2; ++bj) { const int c0 = u.pn * 256 + bj * 128 + wc * 32 + 8 * fq; f32x4 v0 = acc[bj][m][0] * (GATE_BF16 ? 1.f : 1.f / 64.f), v1 = acc[bj][m][1] * (GATE_BF16 ? 1.f : 1.f / 64.f);
                v0 = (f32x4){fsigmoid(v0[0]), fsigmoid(v0[1]), fsigmoid(v0[2]), fsigmoid(v0[3])}; v1 = (f32x4){fsigmoid(v1[0]), fsigmoid(v1[1]), fsigmoid(v1[2]), fsigmoid(v1[3])};
                if (GATE_BF16) *(GAS v4u*)((bf16*)(ws + WS_GATES) + r * 3072 + c0) = pack8(v0, v1);
                else *(GAS v2u*)((unsigned char*)(ws + WS_GATES) + r * 3072 + c0) = (v2u){pk4_fp8(v0[0], v0[1], v0[2], v0[3]), pk4_fp8(v1[0], v1[1], v1[2], v1[3])}; }
            __builtin_amdgcn_sched_barrier(0); }
    }
};

struct PS5A {
    static constexpr bool EARLY_AOFF = false, FP8 = false; unsigned char* ws; int G, c; int K; unsigned kstepA;
    __device__ __forceinline__ bool next(int i, Unit& u) const { const long L = (long)i * G + c; if (L >= 32 * 15) return false; const int l = (int)L; u.z = l / 15; const int r = l % 15; u.pm = r / 3; u.pn = r % 3; return true; }
    __device__ __forceinline__ const char* a_base(const Unit& u) const { return (const char*)(ws + WS_U) + (size_t)u.z * T * 32; }
    __device__ __forceinline__ unsigned a_off(const Unit& u, int h, int R, int Cc) const { int cr = u.pm * 256 + h * 128 + R; cr = cr < NCR ? cr : NCR - 1; return (unsigned)(cr * 512 + Cc) * 2u; }
    __device__ __forceinline__ const char* b_base(const Unit& u) const { return (const char*)(ws + WS_BT1) + ((size_t)u.z * 768 + u.pn * 256) * 512 * 2; }
    __device__ __forceinline__ void epi(const Acc& acc, const Unit& u, int wr, int wc, int fr, int fq) const {
#pragma unroll
        for (int ai = 0; ai < 2; ++ai)
#pragma unroll
            for (int m = 0; m < 4; ++m) { const int cr = u.pm * 256 + ai * 128 + wr * 64 + m * 16 + fr; if (cr >= NCR) continue;
#pragma unroll
                for (int bj = 0; bj < 2; ++bj) { const int n = bj * 128 + wc * 32 + 8 * fq;
                    if (u.pn < 2) *(GAS v4u*)((bf16*)(ws + WS_YG) + (size_t)u.z * T * 16 + (size_t)cr * 512 + u.pn * 256 + n) = pack8(acc[ai][bj][m][0], acc[ai][bj][m][1]);
                    else { GAS f32x4* o = (GAS f32x4*)((float*)(ws + WS_SST) + (size_t)cr * 8192 + u.z * 256 + n); o[0] = acc[ai][bj][m][0]; o[1] = acc[ai][bj][m][1]; } }
                __builtin_amdgcn_sched_barrier(0); }
    }
};

struct PS5B {
    static constexpr bool EARLY_AOFF = false, FP8 = false; unsigned char* ws; int G, c; int K; unsigned kstepA;
    __device__ __forceinline__ bool next(int i, Unit& u) const { const long L = (long)i * G + c; if (L >= 32 * 10) return false; const int l = (int)L; u.z = l / 10; const int r = l % 10; u.pm = r / 2; u.pn = r % 2; return true; }
    __device__ __forceinline__ const char* a_base(const Unit& u) const { return (const char*)(ws + WS_XST) + (size_t)u.z * 512; }
    __device__ __forceinline__ unsigned a_off(const Unit& u, int h, int R, int Cc) const { int cr = u.pm * 256 + h * 128 + R; cr = cr < NCR ? cr : NCR - 1; return (unsigned)(cr * 8192 + Cc) * 2u; }
    __device__ __forceinline__ const char* b_base(const Unit& u) const { return (const char*)(ws + WS_BT2) + ((size_t)u.z * 512 + u.pn * 256) * 256 * 2; }
    __device__ __forceinline__ void epi(const Acc& acc, const Unit& u, int wr, int wc, int fr, int fq) const {
#pragma unroll
        for (int ai = 0; ai < 2; ++ai) {
            v4u yw[4][2];
#pragma unroll
            for (int m = 0; m < 4; ++m) { int cr = u.pm * 256 + ai * 128 + wr * 64 + m * 16 + fr; cr = cr < NCR ? cr : NCR - 1;
#pragma unroll
                for (int bj = 0; bj < 2; ++bj) yw[m][bj] = *(const GAS v4u*)((const bf16*)(ws + WS_YG) + (size_t)u.z * T * 16 + (size_t)cr * 512 + u.pn * 256 + bj * 128 + wc * 32 + 8 * fq); }
#pragma unroll
            for (int m = 0; m < 4; ++m) { const int cr = u.pm * 256 + ai * 128 + wr * 64 + m * 16 + fr; if (cr >= NCR) continue;
#pragma unroll
                for (int bj = 0; bj < 2; ++bj) { const int nn = u.pn * 256 + bj * 128 + wc * 32 + 8 * fq, t = nn >> 4, h0 = nn & 15;
                    GAS v4u* p = (GAS v4u*)((bf16*)(ws + WS_YS) + (size_t)(chunk_m0(cr) + t) * 512 + u.z * 16 + h0);
                    f32x4 y0, y1; { const v4u w_ = yw[m][bj]; unpack8(w_, y0, y1); } y0 += acc[ai][bj][m][0]; y1 += acc[ai][bj][m][1];
                    y0 = (f32x4){gelu_tanh(y0[0]), gelu_tanh(y0[1]), gelu_tanh(y0[2]), gelu_tanh(y0[3])}; y1 = (f32x4){gelu_tanh(y1[0]), gelu_tanh(y1[1]), gelu_tanh(y1[2]), gelu_tanh(y1[3])};
                    *p = pack8(y0, y1); } } }
    }
};

__device__ __forceinline__ int half_panel(int hl, bool lat_only) { if (!lat_only) return hl; const int pl = hl >> 1; return 2 * (pl + (pl >> 5) + 1) + (hl & 1); }
struct PGlu {
    static constexpr bool EARLY_AOFF = false, FP8 = false; unsigned char* ws; int G, c; int K; unsigned kstepA; bool lat_only;
    __device__ __forceinline__ bool next(int i, Unit& u) const { const int nH = lat_only ? 256 : 2 * NPAN; const long L = (long)i * G + c; if (L >= nH * 2) return false; pg8::static_decode((int)L, nH, 2, u.pm, u.pn); u.pm = half_panel(u.pm, lat_only); u.z = 0; return true; }
    __device__ __forceinline__ const char* a_base(const Unit& u) const { return (const char*)(ws + WS_YS) + (size_t)u.pm * 128 * 512 * 2; }
    __device__ __forceinline__ unsigned a_off(const Unit&, int R, int Cc) const { return (unsigned)(R * 512 + Cc) * 2u; }
    __device__ __forceinline__ const char* b_base(const Unit& u) const { return (const char*)(ws + WS_WGLU) + (size_t)u.pn * 256 * 512 * 2; }
    __device__ __forceinline__ void epi(const f32x4 (&acc)[2][4][2], f32x4 (&)[2][4][2], const Unit& u, int wr, int wc, int fr, int fq) const {
        v4u zw[4][2];
#pragma unroll
        for (int m = 0; m < 4; ++m)
#pragma unroll
            for (int bj = 0; bj < 2; ++bj) zw[m][bj] = *(const GAS v4u*)((const bf16*)(ws + WS_YS) + (size_t)(u.pm * 128 + wr * 64 + m * 16 + fr) * 512 + u.pn * 256 + bj * 128 + wc * 32 + 8 * fq);
#pragma unroll
        for (int m = 0; m < 4; ++m) { const size_t r = (size_t)(u.pm * 128 + wr * 64 + m * 16 + fr);
#pragma unroll
            for (int bj = 0; bj < 2; ++bj) { const int cc = u.pn * 256 + bj * 128 + wc * 32 + 8 * fq;
                f32x4 z0, z1; { const v4u w_ = zw[m][bj]; unpack8(w_, z0, z1); } const f32x4 a0 = acc[bj][m][0], a1 = acc[bj][m][1];
                z0 = z0 * (f32x4){fsigmoid(a0[0]), fsigmoid(a0[1]), fsigmoid(a0[2]), fsigmoid(a0[3])}; z1 = z1 * (f32x4){fsigmoid(a1[0]), fsigmoid(a1[1]), fsigmoid(a1[2]), fsigmoid(a1[3])};
                *(GAS v4u*)((bf16*)(ws + WS_U) + r * 512 + cc) = pack8(z0, z1); } }
    }
};

typedef f32x4 Acc128[2][4][2];
struct PMerge {
    static constexpr bool EARLY_AOFF = false, FP8 = false; unsigned char* ws; int G, c; int K; unsigned kstepA; bool lat_only;
    __device__ __forceinline__ bool next(int i, Unit& u) const { const int nH = lat_only ? 256 : 2 * NPAN; const long tile = (long)(i / 3) * G + c; if (tile >= nH * 4) return false; pg8::static_decode((int)tile, nH, 4, u.pm, u.pn); u.pm = half_panel(u.pm, lat_only); u.z = i % 3; return true; }
    __device__ __forceinline__ const char* a_base(const Unit& u) const { const size_t off = u.z == 0 ? WS_U : (u.z == 1 ? WS_AO : WS_NO); return (const char*)(ws + off) + (size_t)u.pm * 128 * 512 * 2; }
    __device__ __forceinline__ unsigned a_off(const Unit&, int R, int Cc) const { return (unsigned)(R * 512 + Cc) * 2u; }
    __device__ __forceinline__ const char* b_base(const Unit& u) const { return (const char*)(ws + WS_WBR) + ((size_t)u.z * 1024 + u.pn * 256) * 512 * 2; }
    __device__ __forceinline__ void epi(const Acc128& acc, Acc128& mrg, const Unit& u, int wr, int wc, int fr, int fq) const {
        v2u gw[4][2];
#pragma unroll
        for (int m = 0; m < 4; ++m)
#pragma unroll
            for (int bj = 0; bj < 2; ++bj) gw[m][bj] = *(const GAS v2u*)((const unsigned char*)(ws + WS_GATES) + (size_t)(u.pm * 128 + wr * 64 + m * 16 + fr) * 3072 + u.z * 1024 + u.pn * 256 + bj * 128 + wc * 32 + 8 * fq);
#pragma unroll
        for (int m = 0; m < 4; ++m) { const size_t r = (size_t)(u.pm * 128 + wr * 64 + m * 16 + fr);
#pragma unroll
            for (int bj = 0; bj < 2; ++bj) { const int cc = u.pn * 256 + bj * 128 + wc * 32 + 8 * fq; const v2u w_ = gw[m][bj];
                const f32x4 g0 = (f32x4){__builtin_amdgcn_cvt_f32_fp8((int)w_.x, 0), __builtin_amdgcn_cvt_f32_fp8((int)w_.x, 1), __builtin_amdgcn_cvt_f32_fp8((int)w_.x, 2), __builtin_amdgcn_cvt_f32_fp8((int)w_.x, 3)};
                const f32x4 g1 = (f32x4){__builtin_amdgcn_cvt_f32_fp8((int)w_.y, 0), __builtin_amdgcn_cvt_f32_fp8((int)w_.y, 1), __builtin_amdgcn_cvt_f32_fp8((int)w_.y, 2), __builtin_amdgcn_cvt_f32_fp8((int)w_.y, 3)};
                if (u.z == 0) { mrg[bj][m][0] = g0 * acc[bj][m][0]; mrg[bj][m][1] = g1 * acc[bj][m][1]; }
                else { mrg[bj][m][0] += g0 * acc[bj][m][0]; mrg[bj][m][1] += g1 * acc[bj][m][1]; }
                if (u.z == 2) *(GAS v4u*)((bf16*)(ws + WS_HB) + r * 1024 + cc) = pack8(mrg[bj][m][0], mrg[bj][m][1]); } }
    }
};

struct PWout {
    static constexpr bool EARLY_AOFF = false, FP8 = false; unsigned char* ws; float* out; const float* mod; int G, c; int K; unsigned kstepA; bool lat_only;
    __device__ __forceinline__ bool next(int i, Unit& u) const { const int nH = lat_only ? 256 : 2 * NPAN; const long L = (long)i * G + c; if (L >= nH * 4) return false; pg8::static_decode((int)L, nH, 4, u.pm, u.pn); u.pm = half_panel(u.pm, lat_only); u.z = 0; return true; }
    __device__ __forceinline__ const char* a_base(const Unit& u) const { return (const char*)(ws + WS_HB) + (size_t)u.pm * 128 * 1024 * 2; }
    __device__ __forceinline__ unsigned a_off(const Unit&, int R, int Cc) const { return (unsigned)(R * 1024 + Cc) * 2u; }
    __device__ __forceinline__ const char* b_base(const Unit& u) const { return (const char*)(ws + WS_WOUT) + (size_t)u.pn * 256 * 1024 * 2; }
    __device__ __forceinline__ void epi(const f32x4 (&acc)[2][4][2], f32x4 (&)[2][4][2], const Unit& u, int wr, int wc, int fr, int fq) const {
        const int pm = u.pm >> 1, hh = u.pm & 1, b = pm / 33, pr = pm % 33, cond = pr == 0 ? 4 : b;
        float* xb = pr == 0 ? (float*)(ws + WS_CTXS) + ((size_t)b * 256 + hh * 128) * D : out + ((size_t)b * SEQ + (size_t)(pr - 1) * 256 + hh * 128) * D;
        const float* g1 = mod + cond * 6144 + 2048;
        f32x4 xv[2][4][2];
#pragma unroll
        for (int bj = 0; bj < 2; ++bj)
#pragma unroll
            for (int m = 0; m < 4; ++m) { const GAS f32x4* p = (const GAS f32x4*)(xb + (size_t)(wr * 64 + m * 16 + fr) * D + u.pn * 256 + bj * 128 + wc * 32 + 8 * fq); xv[bj][m][0] = p[0]; xv[bj][m][1] = p[1]; }
#pragma unroll
        for (int bj = 0; bj < 2; ++bj) { const int cc = u.pn * 256 + bj * 128 + wc * 32 + 8 * fq; const f32x4 ga = *(const GAS f32x4*)(g1 + cc), gb = *(const GAS f32x4*)(g1 + cc + 4);
#pragma unroll
            for (int m = 0; m < 4; ++m) { GAS f32x4* p = (GAS f32x4*)(xb + (size_t)(wr * 64 + m * 16 + fr) * D + cc);
                p[0] = xv[bj][m][0] + ga * acc[bj][m][0]; p[1] = xv[bj][m][1] + gb * acc[bj][m][1]; } }
    }
};

struct ExpTab { int cnt[16], tile0[17]; };
__device__ __forceinline__ int exp_find(const int (&tile0)[17], int q) { int e = 0;
#pragma unroll
    for (int k = 1; k < 16; ++k) e += (q >= tile0[k]) ? 1 : 0;
    return e; }

struct PMoe1 {
    static constexpr bool EARLY_AOFF = true, FP8 = true; unsigned char* ws; const LAS int* tab; int G, c; int K; unsigned kstepA;
    __device__ __forceinline__ bool next(int i, Unit& u) const { const long L = (long)i * G + c; const int total = __builtin_amdgcn_readfirstlane(tab[32]) * 4; if (L >= total) return false; const int q = (int)L >> 2; u.pn = (int)L & 3;
        int e = 0;
#pragma unroll
        for (int k = 1; k < 16; ++k) e += (q >= __builtin_amdgcn_readfirstlane(tab[16 + k])) ? 1 : 0;
        u.z = e; u.pm = q - __builtin_amdgcn_readfirstlane(tab[16 + e]); return true; }
    __device__ __forceinline__ const char* a_base(const Unit&) const { return (const char*)(ws + WS_HB8); }
    __device__ __forceinline__ unsigned a_off(const Unit& u, int R, int Cc) const { int r = u.pm * 128 + R; const int n = __builtin_amdgcn_readfirstlane(tab[u.z]); r = r < n ? r : n - 1;
        const int ent = ((const int*)(ws + WS_LIST))[(size_t)u.z * T + r]; return (unsigned)((ent >> 1) * 1024 + Cc * 2); }
    __device__ __forceinline__ const char* b_base(const Unit& u) const { return (const char*)(ws + WS_MOE1) + ((size_t)u.z * 1024 + u.pn * 256) * 1024; }
    __device__ __forceinline__ void epi(const f32x4 (&acc)[2][4][2], f32x4 (&)[2][4][2], const Unit& u, int wr, int wc, int fr, int fq) const {
        const size_t arow0 = (size_t)(__builtin_amdgcn_readfirstlane(tab[16 + u.z]) + u.pm) * 128;
#pragma unroll
        for (int m = 0; m < 4; ++m) { const f32x4 g0 = acc[0][m][0] * (1.f / 64.f), g1 = acc[0][m][1] * (1.f / 64.f), u0 = acc[1][m][0] * (8.f / 64.f), u1 = acc[1][m][1] * (8.f / 64.f);
            const f32x4 v0 = (f32x4){g0[0] * fsigmoid(g0[0]), g0[1] * fsigmoid(g0[1]), g0[2] * fsigmoid(g0[2]), g0[3] * fsigmoid(g0[3])} * u0;
            const f32x4 v1 = (f32x4){g1[0] * fsigmoid(g1[0]), g1[1] * fsigmoid(g1[1]), g1[2] * fsigmoid(g1[2]), g1[3] * fsigmoid(g1[3])} * u1;
            *(GAS v2u*)((unsigned char*)(ws + WS_ACT) + (arow0 + wr * 64 + m * 16 + fr) * 512 + u.pn * 128 + wc * 32 + 8 * fq) = (v2u){pk4_fp8(v0[0], v0[1], v0[2], v0[3]), pk4_fp8(v1[0], v1[1], v1[2], v1[3])}; }
    }
};
struct PMoe2 {
    static constexpr bool EARLY_AOFF = false, FP8 = true; unsigned char* ws; const LAS int* tab; int G, c; int K; unsigned kstepA;
    __device__ __forceinline__ bool next(int i, Unit& u) const { const long L = (long)i * G + c; const int total = __builtin_amdgcn_readfirstlane(tab[32]) * 4; if (L >= total) return false; const int q = (int)L >> 2; u.pn = (int)L & 3;
        int e = 0;
#pragma unroll
        for (int k = 1; k < 16; ++k) e += (q >= __builtin_amdgcn_readfirstlane(tab[16 + k])) ? 1 : 0;
        u.z = e; u.pm = q - __builtin_amdgcn_readfirstlane(tab[16 + e]); return true; }
    __device__ __forceinline__ const char* a_base(const Unit& u) const { return (const char*)(ws + WS_ACT) + (size_t)(__builtin_amdgcn_readfirstlane(tab[16 + u.z]) + u.pm) * 128 * 512; }
    __device__ __forceinline__ unsigned a_off(const Unit&, int R, int Cc) const { return (unsigned)(R * 512 + Cc * 2); }
    __device__ __forceinline__ const char* b_base(const Unit& u) const { return (const char*)(ws + WS_MOE2) + ((size_t)u.z * 1024 + u.pn * 256) * 512; }
    __device__ __forceinline__ void epi(const f32x4 (&acc)[2][4][2], f32x4 (&)[2][4][2], const Unit& u, int wr, int wc, int fr, int fq) const {
        const int n = __builtin_amdgcn_readfirstlane(tab[u.z]);
        int entv[4]; float wv[4];
#pragma unroll
        for (int m = 0; m < 4; ++m) { int r = u.pm * 128 + wr * 64 + m * 16 + fr; r = r < n ? r : n - 1; entv[m] = ((const int*)(ws + WS_LIST))[(size_t)u.z * T + r]; }
#pragma unroll
        for (int m = 0; m < 4; ++m) wv[m] = ((const float*)(ws + WS_RW))[entv[m]] * (1.f / 256.f);
#pragma unroll
        for (int m = 0; m < 4; ++m) { const int r = u.pm * 128 + wr * 64 + m * 16 + fr; if (r >= n) continue;
            const int ent = entv[m]; const float w = wv[m];
#pragma unroll
            for (int bj = 0; bj < 2; ++bj)
                *(GAS v4u*)((bf16*)(ws + WS_YSLOT) + (size_t)ent * 1024 + u.pn * 256 + bj * 128 + wc * 32 + 8 * fq) = pack8(acc[bj][m][0] * w, acc[bj][m][1] * w); }
    }
};
struct PMoe1B {
    static constexpr bool EARLY_AOFF = true, FP8 = false; unsigned char* ws; const LAS int* tab; int G, c; int K; unsigned kstepA;
    __device__ __forceinline__ bool next(int i, Unit& u) const { const long L = (long)i * G + c; const int total = tab[32] * 4; if (L >= total) return false; const int q = (int)L >> 2; u.pn = (int)L & 3;
        int e = 0;
#pragma unroll
        for (int k = 1; k < 16; ++k) e += (q >= tab[16 + k]) ? 1 : 0;
        u.z = e; u.pm = q - tab[16 + e]; return true; }
    __device__ __forceinline__ const char* a_base(const Unit&) const { return (const char*)(ws + WS_HB); }
    __device__ __forceinline__ unsigned a_off(const Unit& u, int h, int R, int Cc) const { int r = u.pm * 256 + h * 128 + R; const int n = tab[u.z]; r = r < n ? r : n - 1;
        const int ent = ((const int*)(ws + WS_LIST))[(size_t)u.z * T + r]; return (unsigned)((ent >> 1) * 1024 + Cc) * 2u; }
    __device__ __forceinline__ const char* b_base(const Unit& u) const { return (const char*)(ws + WS_MOE1) + ((size_t)u.z * 1024 + u.pn * 256) * 1024 * 2; }
    __device__ __forceinline__ void epi(const Acc& acc, const Unit& u, int wr, int wc, int fr, int fq) const {
        const size_t arow0 = (size_t)(tab[16 + u.z] + u.pm) * 256;
#pragma unroll
        for (int ai = 0; ai < 2; ++ai)
#pragma unroll
            for (int m = 0; m < 4; ++m) { const f32x4 g0 = acc[ai][0][m][0], g1 = acc[ai][0][m][1], u0 = acc[ai][1][m][0], u1 = acc[ai][1][m][1];
                const f32x4 v0 = (f32x4){g0[0] * fsigmoid(g0[0]), g0[1] * fsigmoid(g0[1]), g0[2] * fsigmoid(g0[2]), g0[3] * fsigmoid(g0[3])} * u0;
                const f32x4 v1 = (f32x4){g1[0] * fsigmoid(g1[0]), g1[1] * fsigmoid(g1[1]), g1[2] * fsigmoid(g1[2]), g1[3] * fsigmoid(g1[3])} * u1;
                *(GAS v4u*)((bf16*)(ws + WS_ACTB) + (arow0 + ai * 128 + wr * 64 + m * 16 + fr) * 512 + u.pn * 128 + wc * 32 + 8 * fq) = pack8(v0, v1); }
    }
};
struct PMoe2B {
    static constexpr bool EARLY_AOFF = false, FP8 = false; unsigned char* ws; const LAS int* tab; int G, c; int K; unsigned kstepA;
    __device__ __forceinline__ bool next(int i, Unit& u) const { const long L = (long)i * G + c; const int total = tab[32] * 4; if (L >= total) return false; const int q = (int)L >> 2; u.pn = (int)L & 3;
        int e = 0;
#pragma unroll
        for (int k = 1; k < 16; ++k) e += (q >= tab[16 + k]) ? 1 : 0;
        u.z = e; u.pm = q - tab[16 + e]; return true; }
    __device__ __forceinline__ const char* a_base(const Unit& u) const { return (const char*)(ws + WS_ACTB) + (size_t)(tab[16 + u.z] + u.pm) * 256 * 512 * 2; }
    __device__ __forceinline__ unsigned a_off(const Unit&, int h, int R, int Cc) const { return (unsigned)((h * 128 + R) * 512 + Cc) * 2u; }
    __device__ __forceinline__ const char* b_base(const Unit& u) const { return (const char*)(ws + WS_MOE2) + ((size_t)u.z * 1024 + u.pn * 256) * 512 * 2; }
    __device__ __forceinline__ void epi(const Acc& acc, const Unit& u, int wr, int wc, int fr, int fq) const {
        const int n = tab[u.z];
#pragma unroll
        for (int ai = 0; ai < 2; ++ai)
#pragma unroll
            for (int m = 0; m < 4; ++m) { const int r = u.pm * 256 + ai * 128 + wr * 64 + m * 16 + fr; if (r >= n) continue;
                const int ent = ((const int*)(ws + WS_LIST))[(size_t)u.z * T + r]; const float w = ((const float*)(ws + WS_RW))[ent];
#pragma unroll
                for (int bj = 0; bj < 2; ++bj)
                    *(GAS v4u*)((bf16*)(ws + WS_YSLOT) + (size_t)ent * 1024 + u.pn * 256 + bj * 128 + wc * 32 + 8 * fq) = pack8(acc[ai][bj][m][0] * w, acc[ai][bj][m][1] * w); }
    }
};
__device__ __forceinline__ void build_exptab(const Ctx& C, LAS int* tab, int l, int tsh = 7) {
    __syncthreads();
    if (threadIdx.x == 0) { int t0 = 0;
        for (int e = 0; e < 16; ++e) { const int n = (int)__hip_atomic_load((unsigned*)(C.ctl + CW_CNT + l * 1024 + 64 * e), RLX_AGENT); tab[e] = n; tab[16 + e] = t0; t0 += (n + (1 << tsh) - 1) >> tsh; }
        tab[32] = t0; }
    __syncthreads();
}
__device__ __forceinline__ void phase_attn(const Ctx& C, int l, unsigned char* lds_gen) {
    phase_carry(C, l);
    char* shm = (char*)lds_gen;
    bf16* QA = WSP(bf16, WS_QA); bf16* KA = WSP(bf16, WS_KA); bf16* VA = WSP(bf16, WS_VA); bf16* QN = WSP(bf16, WS_QN); bf16* KN = WSP(bf16, WS_KN); bf16* VN = WSP(bf16, WS_VN);
#ifndef ATTN_SEL
#define ATTN_SEL 3
#endif
#ifdef REPMASK
#define REPMASK_ REPMASK
#else
#define REPMASK_ 0
#endif
    const int per = (1024 + C.G - 1) / C.G;
    bool nomax; { float gq = 0.f, gk = 0.f; for (int i = 0; i < 64; ++i) { gq = fmaxf(gq, fabsf(C.in[I_QNG][l * 64 + i])); gk = fmaxf(gk, fabsf(C.in[I_KNG][l * 64 + i])); } nomax = 64.f * gq * gk * C2 <= 60.f; }
    if (ATTN_SEL & 1) for (int i = 0; i < per * (1 + ((REPMASK_ >> 13) & 1)); ++i) { const int id = C.vcu * per + (i % per); if (id >= 1024) continue; const int bh = id >> 5, b = bh >> 3, h = bh & 7, qb = id & 31;
        const bf16* Qu = QA + (size_t)(b * LB + CTX + qb * 256) * 512 + h * 64;
        if (nomax) attn_body::attn_unit<8, false, 512, 128, true>(Qu, 512, KA + (size_t)(b * LB) * 128 + (h >> 2) * 64, VA + (size_t)(b * LB) * 128 + (h >> 2) * 64, 128, WSP(bf16, WS_AO) + (Qu - QA), LB / 64, 0, 0, shm);
        else attn_body::attn_unit<8, false, 512, 128, false>(Qu, 512, KA + (size_t)(b * LB) * 128 + (h >> 2) * 64, VA + (size_t)(b * LB) * 128 + (h >> 2) * 64, 128, WSP(bf16, WS_AO) + (Qu - QA), LB / 64, 0, 0, shm);
    }
    LAS float* bt = (LAS float*)(C.lds + attn_body::LDS_BT);
    const int nctx = (C.vcu >= 64 && C.vcu < 128) ? 1 : 0;
    if (ATTN_SEL & 2) for (int i0 = 0; i0 < (per + nctx) * (1 + ((REPMASK_ >> 14) & 1)); ++i0) { const int i = i0 % (per + nctx);
        const bf16 *Qu, *Kh, *Vh; bf16* Ou; int kvp = 512, NT = 4, r0 = 0, rlo = 0;
        if (i < per) { const int id = C.vcu * per + i; if (id >= 1024) continue; const int bh = id >> 5, b = bh >> 3, h = bh & 7; r0 = (id & 31) * 4;
            const float* rp = C.in[I_RPB] + (size_t)(l * 8 + h) * 465;
            for (int k = C.tid; k < 465; k += 512) bt[k] = rp[k] * LOG2E;
            rlo = r0 - 4 < 0 ? 0 : (r0 - 4 > 120 ? 120 : r0 - 4); const int rh_ = r0 - 1 < 0 ? 0 : (r0 - 1 > 120 ? 120 : r0 - 1), nloc = rh_ + 8 - rlo; NT = (4 + nloc + 1) & ~1;
            Qu = QN + (size_t)(b * LB + CTX + r0 * 64) * 512 + h * 64; Ou = WSP(bf16, WS_NO) + (Qu - QN); Kh = KN + (size_t)(b * LB) * 512 + h * 64; Vh = VN + (size_t)(b * LB) * 512 + h * 64; }
        else { int j = C.vcu - 64; if (j < 32) { const int b = j >> 3, h = j & 7; Qu = QA + (size_t)(b * LB) * 512 + h * 64; Ou = WSP(bf16, WS_AO) + (Qu - QA); Kh = KA + (size_t)(b * LB) * 128 + (h >> 2) * 64; Vh = VA + (size_t)(b * LB) * 128 + (h >> 2) * 64; kvp = 128; }
            else { j -= 32; const int b = j >> 3, h = j & 7; Qu = QN + (size_t)(b * LB) * 512 + h * 64; Ou = WSP(bf16, WS_NO) + (Qu - QN); Kh = KN + (size_t)(b * LB) * 512 + h * 64; Vh = VN + (size_t)(b * LB) * 512 + h * 64; } }
        attn_body::attn_unit<8, true, 512, 0>(Qu, 512, Kh, Vh, kvp, Ou, NT, r0, rlo, shm);
    }
}

constexpr int NPH = 46;
__global__ void __launch_bounds__(NWAVES * 64, 2) fwd(Args args) {
    extern __shared__ __attribute__((aligned(16))) unsigned char lds[];
    Ctx C; C.in = (const __attribute__((address_space(4))) CFP*)__builtin_amdgcn_kernarg_segment_ptr(); C.out = args.out; C.ws = args.ws; C.lds = (LAS unsigned char*)lds; C.ctl = (gu32*)(args.ws + WS_CTL);
    C.tid = 0; C.lane = 0; C.wave = __builtin_amdgcn_readfirstlane((int)threadIdx.x >> 6);
    C.G = gridDim.x; { const int bx = blockIdx.x; C.vcu = (C.G % 8 == 0) ? (bx % 8) * (C.G / 8) + bx / 8 : bx; }
    for (int u = threadIdx.x; u < (LDS_BYTES - LDSCTL_OFF) / 4; u += NWAVES * 64) ((LAS unsigned*)(C.lds + LDSCTL_OFF))[u] = 0u;
    __syncthreads();
    const int lo = args.ph_lo, hi = args.ph_hi;
    XcdBarrier bar; bar.bar = (unsigned*)(C.ctl + CW_BAR); bar.x = 0; bar.st = nullptr;
    if (hi - lo > 1) bar = xcd_barrier_post((unsigned*)(C.ctl + CW_BAR), (volatile LAS unsigned*)(C.lds + MISC_OFF) + 8);
    LAS int* tab = (LAS int*)(C.lds + LDSCTL_OFF);
    const int cg = (int)blockIdx.x;
#ifndef PHMASK
#define PHMASK 0xFFFF
#endif
#define IN(k) (lo <= (k) && (k) < hi)
#define EN(b) ((PHMASK >> (b)) & 1)
#ifndef REPMASK
#define REPMASK 0
#endif
#define RUN(b, stmt) do { stmt; if ((REPMASK >> (b)) & 1) { stmt; } } while (0)
#ifdef DIAG_SEL
#define DIAG_ACC(ty) do { if (blockIdx.x == 0 && threadIdx.x == 0) { volatile LAS unsigned* dg = (volatile LAS unsigned*)(C.lds + LDSCTL_OFF + 160); const unsigned now = (unsigned)__builtin_amdgcn_s_memrealtime(); dg[8 + (ty)] += now - dg[0]; dg[0] = now; } } while (0)
#else
#define DIAG_ACC(ty) do {} while (0)
#endif
#define SEAM(k) do { if (IN(k) && IN((k) + 1)) xcd_barrier(bar); DIAG_ACC((k) == 0 ? 11 : ((k) - 1) % 11); } while (0)
#define LWS() ({ const __attribute__((address_space(4))) CFP* k_ = C.in; asm volatile("" : "+s"(k_)); (unsigned char*)k_[30]; })
#define LC() ({ Ctx c_ = C; c_.tid = threadIdx.x; asm volatile("" : "+v"(c_.tid)); c_.lane = c_.tid & 63; asm volatile("" : "+s"(c_.in)); c_.ws = (unsigned char*)c_.in[30]; c_.out = (float*)c_.in[29]; c_.ctl = (gu32*)(c_.ws + WS_CTL); c_; })
#ifdef DIAG_SEL
    if (blockIdx.x == 0 && threadIdx.x == 0) { volatile LAS unsigned* dg = (volatile LAS unsigned*)(C.lds + LDSCTL_OFF + 160); dg[0] = (unsigned)__builtin_amdgcn_s_memrealtime(); dg[1] = dg[0]; }
#endif
    if (EN(11) && IN(0)) { const Ctx Cl = LC(); phase_mod(Cl); RUN(11, phase_s5mats(Cl, 0); phase_weights(Cl, 0)); }
    SEAM(0);
    for (int l = 0; l < NLAYER; ++l) {
        const int pb = 1 + 11 * l;
        if (EN(0) && IN(pb)) { const Ctx Cl = LC(); if (l == 0) phase_rows<0>(Cl, 0); else { phase_s5mats(Cl, l); phase_weights(Cl, l); phase_rows<1>(Cl, l); } }
        SEAM(pb);
        if (EN(1) && IN(pb + 1)) { { PWin P{LWS(), C.G, cg, 1024, 128u}; pg8::gemm_phase(C.lds, P); } { PGate P{LWS(), C.G, cg, 1024, 128u}; pg8::gemm_phase_m128(C.lds, P); } }
        SEAM(pb + 1);
        if (EN(2) && IN(pb + 2)) { { const Ctx Cl = LC(); phase_qkprep(Cl, l); } PS5A P{LWS(), C.G, cg, 512, 128u}; RUN(2, pg8::gemm_phase(C.lds, P)); }
        SEAM(pb + 2);
        if (EN(3) && IN(pb + 3)) { const Ctx Cl = LC(); RUN(3, phase_attn(Cl, l, lds)); }
        SEAM(pb + 3);
        if (EN(4) && IN(pb + 4)) { PS5B P{LWS(), C.G, cg, 256, 128u}; pg8::gemm_phase(C.lds, P); }
        SEAM(pb + 4);
        if (EN(5) && IN(pb + 5)) { PGlu P{LWS(), C.G, cg, 512, 128u, l == NLAYER - 1}; pg8::gemm_phase_m128(C.lds, P); }
        SEAM(pb + 5);
        if (EN(6) && IN(pb + 6)) { PMerge P{LWS(), C.G, cg, 512, 128u, l == NLAYER - 1}; pg8::gemm_phase_m128(C.lds, P); }
        SEAM(pb + 6);
        if (EN(7) && IN(pb + 7)) { unsigned char* wl_ = LWS(); PWout P{wl_, (float*)C.in[29], (const float*)(wl_ + WS_MOD) + (size_t)l * 5 * 6144, C.G, cg, 1024, 128u, l == NLAYER - 1}; pg8::gemm_phase_m128(C.lds, P); }
        SEAM(pb + 7);
        if (EN(8) && IN(pb + 8)) { const Ctx Cl = LC(); phase_norm2(Cl, l); }
        SEAM(pb + 8);
        if (EN(9) && IN(pb + 9)) { if (FP8_MOE) { build_exptab(C, tab, l); PMoe1 P{LWS(), tab, C.G, cg, 1024, 128u}; pg8::gemm_phase_m128(C.lds, P); } else { build_exptab(C, tab, l, 8); PMoe1B P{LWS(), tab, C.G, cg, 1024, 128u}; pg8::gemm_phase(C.lds, P); } }
        SEAM(pb + 9);
        if (EN(10) && IN(pb + 10)) { if (FP8_MOE) { build_exptab(C, tab, l); PMoe2 P{LWS(), tab, C.G, cg, 512, 128u}; pg8::gemm_phase_m128(C.lds, P); } else { build_exptab(C, tab, l, 8); PMoe2B P{LWS(), tab, C.G, cg, 512, 128u}; pg8::gemm_phase(C.lds, P); } }
        SEAM(pb + 10);
    }
    if (EN(12) && IN(NPH - 1)) { const Ctx Cl = LC(); phase_rows<2>(Cl, NLAYER); }
#ifdef DIAG_SEL
    xcd_barrier(bar); DIAG_ACC(12);
    if (blockIdx.x == 0 && threadIdx.x == 0) { volatile LAS unsigned* dg = (volatile LAS unsigned*)(C.lds + LDSCTL_OFF + 160); dg[8 + 13] = dg[0] - dg[1];
        for (int i = 0; i < 14; ++i) __hip_atomic_store(C.ctl + 2048 + i, dg[8 + i], RLX_AGENT); }
    xcd_barrier(bar);
    { const float d1 = (float)__hip_atomic_load(C.ctl + 2048 + (DIAG_SEL), RLX_AGENT) * 0.01f, d2 = (float)__hip_atomic_load(C.ctl + 2048 + (DIAG_SEL) + 1, RLX_AGENT) * 0.01f;
      const float c1 = sqrtf(d1); float* o = args.out;
      for (size_t i = (size_t)blockIdx.x * 512 + threadIdx.x; i < (size_t)NB * SEQ * D; i += (size_t)gridDim.x * 512) o[i] = (i == 12345) ? d2 : c1; }
#endif
#undef IN
#undef SEAM
}

#ifndef MK_PER_PHASE
#define MK_PER_PHASE 0
#endif
extern "C" void kernel_launch(void* const* d_in, const int* in_sizes, int n_in, void* d_out, int out_size, void* d_ws, size_t ws_size, hipStream_t stream) {
    static int grid = 0;
    if (grid == 0) {
        if (n_in != 29 || out_size != NB * SEQ * D || ws_size < WS_END) { fprintf(stderr, "kernel_launch: unexpected shapes (n_in %d out %d ws %zu)\n", n_in, out_size, ws_size); grid = -1; return; }
        int dev = 0, cus = 0, per_cu = 0;
        if (hipGetDevice(&dev) != hipSuccess || hipDeviceGetAttribute(&cus, hipDeviceAttributeMultiprocessorCount, dev) != hipSuccess) { grid = -1; return; }
        if (hipFuncSetAttribute((const void*)fwd, hipFuncAttributeMaxDynamicSharedMemorySize, LDS_BYTES) != hipSuccess) { grid = -1; return; }
        if (hipOccupancyMaxActiveBlocksPerMultiprocessor(&per_cu, (const void*)fwd, NWAVES * 64, LDS_BYTES) != hipSuccess || per_cu < 1) fprintf(stderr, "kernel_launch: occupancy query says %d\n", per_cu);
        (void)hipGetLastError();
        grid = cus;
    }
    if (grid < 0) return;
    (void)hipMemsetAsync((char*)d_ws + WS_CTL, 0, CTL_ZERO_BYTES, stream);
    Args a{};
    for (int i = 0; i < 29; ++i) a.in[i] = (const float*)d_in[i];
    a.out = (float*)d_out; a.ws = (unsigned char*)d_ws;
#if MK_PER_PHASE
    for (int p = 0; p < NPH; ++p) { a.ph_lo = p; a.ph_hi = p + 1; hipLaunchKernelGGL(fwd, dim3(grid), dim3(NWAVES * 64), LDS_BYTES, stream, a); }
#else
    a.ph_lo = 0; a.ph_hi = NPH; hipLaunchKernelGGL(fwd, dim3(grid), dim3(NWAVES * 64), LDS_BYTES, stream, a);
#endif
}
```

```cpp
#define FP8_MOE 1
#define GATE_BF16 0
#define W8_ALL 1
#define H8_WRITE 1
#ifndef H8_WRITE
#define H8_WRITE 1
#endif
#ifndef GATE_BF16
#define GATE_BF16 0
#endif
#include <hip/hip_runtime.h>
#include <cstdio>
#include <cstdint>

#define GAS __attribute__((address_space(1)))
#define LAS __attribute__((address_space(3)))
typedef unsigned short bf16;
typedef unsigned v4u __attribute__((ext_vector_type(4)));
typedef unsigned v2u __attribute__((ext_vector_type(2)));
typedef float f32x4 __attribute__((ext_vector_type(4)));
typedef float f32x2 __attribute__((ext_vector_type(2)));
typedef float f32x16 __attribute__((ext_vector_type(16)));
typedef short bf16x8 __attribute__((ext_vector_type(8)));
typedef short s16x4 __attribute__((ext_vector_type(4)));
typedef GAS unsigned gu32;
#define RLX_AGENT __ATOMIC_RELAXED, __HIP_MEMORY_SCOPE_AGENT
#define LDS_WAIT() asm volatile("s_waitcnt lgkmcnt(0)" ::: "memory")
#define VM_WAIT() asm volatile("s_waitcnt vmcnt(0)" ::: "memory")

constexpr int NB = 4, SEQ = 8192, CTX = 256, LB = SEQ + CTX, T = NB * LB, D = 1024, NPAN = T / 256;
constexpr int NLAYER = 4, INW = 5888, NCH = LB / 32, NCR = NB * NCH;
constexpr int NEXP = 16, FF = 512;
constexpr float EPS = 1e-6f;
constexpr float LOG2E = 1.4426950408889634f;
constexpr float C2 = 0.125f * LOG2E;
constexpr int NWAVES = 8;

constexpr size_t MiB = 1u << 20;
constexpr size_t WS_CTL = 0, CTL_ZERO_BYTES = 1 * MiB;
constexpr size_t WS_MOD = 1 * MiB;
constexpr size_t WS_LIST = 2 * MiB;
constexpr size_t WS_RW = 5 * MiB;
constexpr size_t WS_CTXS = 6 * MiB;
constexpr size_t WS_SST = 10 * MiB;
constexpr size_t WS_HB8 = WS_SST;
constexpr size_t WS_XST = 44 * MiB;
constexpr size_t WS_BT1 = 61 * MiB;
constexpr size_t WS_BT2 = 85 * MiB;
constexpr size_t WS_WIN = 93 * MiB;
constexpr size_t WS_WIN8 = WS_WIN + (size_t)2816 * 1024 * 2;
constexpr size_t WS_WGLU = 105 * MiB;
constexpr size_t WS_WBR = 106 * MiB;
constexpr size_t WS_WOUT = 109 * MiB;
constexpr size_t WS_MOE1 = 111 * MiB;
constexpr size_t WS_MOE2 = 143 * MiB;
constexpr size_t WS_HB = 159 * MiB;
constexpr size_t WS_U = 225 * MiB;
constexpr size_t WS_QA = 258 * MiB;
constexpr size_t WS_KA = 291 * MiB;
constexpr size_t WS_VA = 300 * MiB;
constexpr size_t WS_QN = 309 * MiB;
constexpr size_t WS_KN = 342 * MiB;
constexpr size_t WS_VN = 375 * MiB;
constexpr size_t WS_YS = 408 * MiB;
constexpr size_t WS_GATES = 441 * MiB;
constexpr size_t WS_ACT = WS_QN;
constexpr size_t WS_ACTB = WS_QN;
constexpr size_t WS_YSLOT = WS_GATES;
constexpr size_t WS_AO = 574 * MiB;
constexpr size_t WS_NO = 607 * MiB;
constexpr size_t WS_YG = 640 * MiB;
constexpr size_t WS_END = 673 * MiB;
static_assert(WS_GATES + (size_t)T * 3072 * (GATE_BF16 ? 2 : 1) <= WS_AO && WS_YSLOT + (size_t)2 * T * 1024 * 2 <= WS_AO && WS_ACT + (size_t)(2 * T + 4096) * 512 * 2 <= WS_YS, "ws map");
constexpr int CW_FAIL = 8;
constexpr int CW_CNT = 64;
constexpr int CW_BAR = 8192;

constexpr int RING_BYTES = 131072, LDS_BYTES = 147456, LDSCTL_OFF = LDS_BYTES - 512, MISC_OFF = LDSCTL_OFF + 320;

__device__ __forceinline__ unsigned f2bf(float f) { unsigned u = __builtin_bit_cast(unsigned, f); return (u + 0x7fffu + ((u >> 16) & 1u)) >> 16; }
__device__ __forceinline__ unsigned pk2(float lo, float hi) { return f2bf(lo) | (f2bf(hi) << 16); }
__device__ __forceinline__ float bf2f(unsigned b) { return __builtin_bit_cast(float, b << 16); }
__device__ __forceinline__ float bflo(unsigned w) { return __builtin_bit_cast(float, w << 16); }
__device__ __forceinline__ float bfhi(unsigned w) { return __builtin_bit_cast(float, w & 0xffff0000u); }
typedef float f32x2_c __attribute__((ext_vector_type(2))); typedef __bf16 bf16x2_c __attribute__((ext_vector_type(2)));
__device__ __forceinline__ unsigned cvt_pk_bf16(float lo, float hi) { const f32x2_c v = {lo, hi}; return __builtin_bit_cast(unsigned, __builtin_convertvector(v, bf16x2_c)); }
typedef int v8i __attribute__((ext_vector_type(8)));
typedef int v4i __attribute__((ext_vector_type(4)));
__device__ __forceinline__ float clamp8(float x) { return __builtin_fminf(__builtin_fmaxf(x, -448.f), 448.f); }
__device__ __forceinline__ unsigned pk4_fp8(float a, float b, float c, float d) { int w = 0; w = __builtin_amdgcn_cvt_pk_fp8_f32(clamp8(a), clamp8(b), w, false); w = __builtin_amdgcn_cvt_pk_fp8_f32(clamp8(c), clamp8(d), w, true); return (unsigned)w; }
__device__ __forceinline__ float fsigmoid(float x) { return __builtin_amdgcn_rcpf(1.f + __builtin_amdgcn_exp2f(-LOG2E * x)); }
__device__ __forceinline__ float gelu_tanh(float x) { const float u = 0.7978845608f * (x + 0.044715f * x * x * x); return x * __builtin_amdgcn_rcpf(1.f + __builtin_amdgcn_exp2f(-2.f * LOG2E * u)); }
__device__ __forceinline__ float shflx(float v, int m, int lane) { return __builtin_bit_cast(float, __builtin_amdgcn_ds_bpermute((lane ^ m) << 2, __builtin_bit_cast(int, v))); }
template <int CTRL, int RM>
__device__ __forceinline__ float dpp_mov(float v) { return __builtin_bit_cast(float, __builtin_amdgcn_update_dpp(0, __builtin_bit_cast(int, v), CTRL, RM, 0xF, true)); }
__device__ __forceinline__ float wave_sum(float v, int) {
    v += dpp_mov<0xB1, 0xF>(v);
    v += dpp_mov<0x4E, 0xF>(v);
    v += dpp_mov<0x141, 0xF>(v);
    v += dpp_mov<0x140, 0xF>(v);
    v += dpp_mov<0x142, 0xA>(v);
    v += dpp_mov<0x143, 0xC>(v);
    return __builtin_bit_cast(float, __builtin_amdgcn_readlane(__builtin_bit_cast(int, v), 63));
}
__device__ __forceinline__ float sin_rev(float r) { r = r - floorf(r); return __builtin_amdgcn_sinf(r); }
__device__ __forceinline__ float cos_rev(float r) { r = r - floorf(r); return __builtin_amdgcn_cosf(r); }

#define XB_TMO      128
#define XB_XCNT(j)  (256  + 64 * (j))
#define XB_XSUB(j)  (1280 + 64 * (j))
#define XB_XGEN(j)  (2304 + 64 * (j))
#define XB_TOP      3328
#define XB_TOPGEN   3392
#define XCD_BAR_WORDS 3456
#define XB_SPIN_CAP (1u << 22)

__device__ __forceinline__ unsigned xb_ld(unsigned* p)              { return __hip_atomic_load(p, __ATOMIC_RELAXED, __HIP_MEMORY_SCOPE_AGENT); }
__device__ __forceinline__ unsigned xb_add(unsigned* p, unsigned v) { return __hip_atomic_fetch_add(p, v, __ATOMIC_RELAXED, __HIP_MEMORY_SCOPE_AGENT); }
__device__ __forceinline__ unsigned xb_xcc_id() { return (unsigned)__builtin_amdgcn_s_getreg((3 << 11) | 20) & 0xFu; }
#define XB_SPIN(cond, bar) do { unsigned _sp = 0; while (cond) { __builtin_amdgcn_s_sleep(1); \
    if ((++_sp & 255u) == 0u) { if (xb_ld(&(bar)[XB_TMO])) break; if (_sp > XB_SPIN_CAP) { atomicAdd(&(bar)[XB_TMO], 1u); break; } } } } while (0)

struct XcdBarrier { unsigned* bar; unsigned x; volatile LAS unsigned* st; };

__device__ __forceinline__ XcdBarrier xcd_barrier_post(unsigned* bar, volatile LAS unsigned* st) {
    XcdBarrier b; b.bar = bar; b.x = xb_xcc_id(); b.st = st;
    if (threadIdx.x == 0) (void)xb_add(&bar[XB_XCNT(b.x)], 1u);
    return b;
}
__device__ __forceinline__ void xcd_barrier_complete(unsigned* bar, unsigned x, unsigned& nloc, unsigned& nx) {
    const unsigned G = gridDim.x * gridDim.y * gridDim.z;
    unsigned sum, cnt, mine, sp = 0u;
    for (;;) {
        sum = 0u; cnt = 0u; mine = 0u;
#pragma unroll
        for (unsigned j = 0; j < 16; ++j) { const unsigned c = xb_ld(&bar[XB_XCNT(j)]); sum += c; cnt += (c > 0u) ? 1u : 0u; mine = (j == x) ? c : mine; }
        if (sum == G) break;
        __builtin_amdgcn_s_sleep(1);
        if ((++sp & 255u) == 0u) { if (xb_ld(&bar[XB_TMO])) break; if (sp > XB_SPIN_CAP) { atomicAdd(&bar[XB_TMO], 1u); break; } }
    }
    nloc = mine > 0u ? mine : 1u; nx = cnt > 0u ? cnt : 1u;
}
__device__ __forceinline__ void xcd_barrier(const XcdBarrier& b) {
    asm volatile("s_waitcnt vmcnt(0)" ::: "memory");
    __syncthreads();
    if (threadIdx.x == 0) {
        unsigned* bar = b.bar;
        __builtin_amdgcn_s_waitcnt(0);
        unsigned nloc = b.st[0], nx = b.st[1];
        if (nloc == 0u) { xcd_barrier_complete(bar, b.x, nloc, nx); b.st[0] = nloc; b.st[1] = nx; }
        const unsigned old = xb_add(&bar[XB_XSUB(b.x)], 1u);
        const unsigned gen = old / nloc;
        if (old + 1u == (gen + 1u) * nloc) {
            __builtin_amdgcn_fence(__ATOMIC_RELEASE, "agent");
            asm volatile("s_waitcnt vmcnt(0)" ::: "memory");
            const unsigned og = xb_add(&bar[XB_TOP], 1u);
            const unsigned tg = og / nx;
            if (og + 1u == (tg + 1u) * nx) xb_add(&bar[XB_TOPGEN], 1u);
            else XB_SPIN(xb_ld(&bar[XB_TOPGEN]) == tg, bar);
            __builtin_amdgcn_fence(__ATOMIC_ACQUIRE, "agent");
            xb_add(&bar[XB_XGEN(b.x)], 1u);
            asm volatile("s_waitcnt vmcnt(0)" ::: "memory");
        } else {
            XB_SPIN(xb_ld(&bar[XB_XGEN(b.x)]) == gen, bar);
            __builtin_amdgcn_fence(__ATOMIC_ACQUIRE, "agent");
            asm volatile("s_waitcnt vmcnt(0)" ::: "memory");
        }
    }
    __syncthreads();
}

namespace pg8 {
constexpr int BM = 256, BK = 64, HALF = 128, HTB = HALF * BK * 2, STAGE_BYTES = 8 * HTB, NXCD = 8, WGM = 8;
__host__ __device__ __forceinline__ int lds_byte(int r, int c) { const int st = (r >> 4) * 2 + (c >> 5), rr = r & 15, cc = c & 31, ob = rr * 64 + cc * 2; return st * 1024 + (ob ^ (((ob >> 9) & 1) << 5)); }
__host__ __device__ __forceinline__ void stage_rc(int b, int& R, int& C) { const int st = b / 1024, sb = b % 1024, swz = sb ^ (((sb >> 9) & 1) << 5); R = (st >> 1) * 16 + swz / 64; C = (st & 1) * 32 + (swz % 64) / 2; }
__host__ __device__ __forceinline__ int perm32(int rho) { const int n = rho >> 4, i = rho & 15; return 8 * (i >> 2) + 4 * n + (i & 3); }

struct Unit { int pm, pn, z; };

__device__ __forceinline__ void static_decode(int L, int nM, int nN, int& pm, int& pn) {
    const int nwg = nM * nN; int wgid = L;
    { const int q = nwg / NXCD, r = nwg % NXCD, xcd = wgid % NXCD, off = wgid / NXCD; wgid = (xcd < r ? xcd * (q + 1) : r * (q + 1) + (xcd - r) * q) + off; }
    const int nig = WGM * nN, gid = wgid / nig, fm = gid * WGM, gsz = (nM - fm) < WGM ? (nM - fm) : WGM;
    pm = fm + ((wgid % nig) % gsz); pn = (wgid % nig) / gsz;
}

template <class P>
__device__ __forceinline__ void gemm_phase(LAS unsigned char* lds, const P& S) {
    int tid_ = threadIdx.x; asm volatile("" : "+v"(tid_));
    const int tid = tid_, wid = __builtin_amdgcn_readfirstlane(tid >> 6), lane = tid & 63, wr = wid >> 2, wc = wid & 3, fr = lane & 15, fq = lane >> 4;
    constexpr int ELB = P::FP8 ? 1 : 2;
    const int K = S.K; int nt = K * ELB / 128; asm volatile("" : "+s"(nt));
    unsigned voffB[2];
#pragma unroll
    for (int i = 0; i < 2; ++i) { int R, C; stage_rc(tid * 16 + i * 8192, R, C); const int Rb = (R & ~31) + perm32(R & 31); voffB[i] = (unsigned)(Rb * K * ELB + C * 2); }
#define PG8_AOFF(dst0, dst1, u) do { _Pragma("unroll") for (int i = 0; i < 2; ++i) { int R, C; stage_rc(tid * 16 + i * 8192, R, C); dst0[i] = S.a_off(u, 0, R, C); dst1[i] = S.a_off(u, 1, R, C); } } while (0)
    const size_t kstepB = (size_t)(BK * 2), hstepB = (size_t)HALF * K * ELB, kstepA = (size_t)S.kstepA;
    const unsigned ldsw = (unsigned)wid * 1024u;
    const int aoff = lds_byte(wr * 64 + fr, fq * 8), boff = lds_byte(wc * 32 + fr, fq * 8);
#define PG8_SA(b, h) (((b) * 2 + (h)) * HTB)
#define PG8_SB(b, h) ((4 + (b) * 2 + (h)) * HTB)
#define PG8_STAGE(bufoff, gbase, voff) do { _Pragma("unroll") for (int _i = 0; _i < 2; ++_i) \
        __builtin_amdgcn_global_load_lds((const unsigned*)((const char*)(gbase) + (voff)[_i]), (LAS unsigned*)(lds + (bufoff) + ldsw + _i * 8192), 16, 0, 0); } while (0)
#define PG8_LDA(dst, b, h) do { _Pragma("unroll") for (int m = 0; m < 4; ++m) _Pragma("unroll") for (int k = 0; k < 2; ++k) dst[m][k] = *(const LAS bf16x8*)(lds + PG8_SA(b, h) + aoff + m * 2048 + k * 1024); } while (0)
#define PG8_LDB(dst, b, h) do { _Pragma("unroll") for (int n = 0; n < 2; ++n) _Pragma("unroll") for (int k = 0; k < 2; ++k) dst[n][k] = *(const LAS bf16x8*)(lds + PG8_SB(b, h) + boff + n * 2048 + k * 1024); } while (0)
#define PG8_CAT(x0, x1) __builtin_shufflevector(__builtin_bit_cast(v4i, x0), __builtin_bit_cast(v4i, x1), 0, 1, 2, 3, 4, 5, 6, 7)
#define PG8_MMA(ai, bj, At, Bt) do { __builtin_amdgcn_s_setprio(1); _Pragma("unroll") for (int m = 0; m < 4; ++m) _Pragma("unroll") for (int n = 0; n < 2; ++n) { \
        if constexpr (P::FP8) acc[ai][bj][m][n] = __builtin_amdgcn_mfma_scale_f32_16x16x128_f8f6f4(PG8_CAT(Bt[n][0], Bt[n][1]), PG8_CAT(At[m][0], At[m][1]), acc[ai][bj][m][n], 0, 0, 0, 0x7f7f7f7f, 0, 0x7f7f7f7f); \
        else { _Pragma("unroll") for (int k = 0; k < 2; ++k) acc[ai][bj][m][n] = __builtin_amdgcn_mfma_f32_16x16x32_bf16(Bt[n][k], At[m][k], acc[ai][bj][m][n], 0, 0, 0); } } __builtin_amdgcn_s_setprio(0); } while (0)
#define PG8_WAIT_V(n) asm volatile("s_waitcnt vmcnt(" #n ")" ::: "memory")
#define PG8_WAIT_L(n) asm volatile("s_waitcnt lgkmcnt(" #n ")" ::: "memory")
#define PG8_BAR __builtin_amdgcn_s_barrier()
#define PG8_SCHED __builtin_amdgcn_sched_barrier(0)
    Unit cur, nxt; int ui = 0;
    if (!S.next(0, cur)) return;
    f32x4 acc[2][2][4][2];
#pragma unroll
    for (int a = 0; a < 2; ++a)
#pragma unroll
        for (int b = 0; b < 2; ++b)
#pragma unroll
            for (int m = 0; m < 4; ++m)
#pragma unroll
                for (int n = 0; n < 2; ++n) acc[a][b][m][n] = (f32x4){0.f, 0.f, 0.f, 0.f};
    bf16x8 At[4][2], B0[2][2], B1[2][2];
    unsigned vA0[2], vA1[2], vN0[2], vN1[2];
    PG8_AOFF(vA0, vA1, cur);
    const char* cA = S.a_base(cur); const char* cB = S.b_base(cur);
    PG8_STAGE(PG8_SB(0, 0), cB, voffB); PG8_STAGE(PG8_SB(0, 1), cB + hstepB, voffB); PG8_STAGE(PG8_SA(0, 0), cA, vA0); PG8_STAGE(PG8_SA(0, 1), cA, vA1);
    if (wr == 1) PG8_BAR;
    PG8_WAIT_V(2); PG8_BAR;
    PG8_STAGE(PG8_SB(1, 0), cB + kstepB, voffB); PG8_STAGE(PG8_SA(1, 0), cA + kstepA, vA0); PG8_STAGE(PG8_SB(1, 1), cB + hstepB + kstepB, voffB);
    PG8_WAIT_V(6); PG8_BAR;
    for (;;) {
        const bool has_next = S.next(ui + 1, nxt);
        const char* nA = cA; const char* nB = cB;
        if (has_next) { nA = S.a_base(nxt); nB = S.b_base(nxt); if (P::EARLY_AOFF) PG8_AOFF(vN0, vN1, nxt); }
        for (int t = 0; t < nt; t += 2) {
            const bool last = (t == nt - 2);
            const char* a1 = cA + (size_t)(t + 1) * kstepA;
            const char* a2 = last ? nA : cA + (size_t)(t + 2) * kstepA; const char* b2 = last ? nB : cB + (size_t)(t + 2) * kstepB;
            const char* a3 = a2 + kstepA; const char* b3 = b2 + kstepB;
            PG8_LDB(B0, 0, 0); PG8_LDB(B1, 0, 1); PG8_SCHED; PG8_LDA(At, 0, 0); PG8_STAGE(PG8_SA(1, 1), a1, vA1);
            if (last && has_next) {
                if (P::EARLY_AOFF) { _Pragma("unroll") for (int i = 0; i < 2; ++i) { vA0[i] = vN0[i]; vA1[i] = vN1[i]; } } else PG8_AOFF(vA0, vA1, nxt); }
            PG8_WAIT_V(8); PG8_WAIT_L(0); PG8_BAR; PG8_MMA(0, 0, At, B0); PG8_MMA(0, 1, At, B1); PG8_BAR; PG8_SCHED;
            PG8_LDA(At, 0, 1); PG8_STAGE(PG8_SB(0, 0), b2, voffB); PG8_STAGE(PG8_SB(0, 1), b2 + hstepB, voffB); PG8_STAGE(PG8_SA(0, 0), a2, vA0);
            PG8_WAIT_V(8); PG8_WAIT_L(0); PG8_BAR; PG8_MMA(1, 0, At, B0); PG8_MMA(1, 1, At, B1); PG8_BAR; PG8_SCHED;
            PG8_LDB(B0, 1, 0); PG8_LDB(B1, 1, 1); PG8_SCHED; PG8_LDA(At, 1, 0); PG8_STAGE(PG8_SA(0, 1), a2, vA1);
            PG8_WAIT_V(8); PG8_WAIT_L(0); PG8_BAR; PG8_MMA(0, 0, At, B0); PG8_MMA(0, 1, At, B1); PG8_BAR; PG8_SCHED;
            PG8_LDA(At, 1, 1); PG8_STAGE(PG8_SB(1, 0), b3, voffB); PG8_STAGE(PG8_SB(1, 1), b3 + hstepB, voffB); PG8_STAGE(PG8_SA(1, 0), a3, vA0);
            PG8_WAIT_V(8); PG8_WAIT_L(0); PG8_BAR; PG8_MMA(1, 0, At, B0); PG8_MMA(1, 1, At, B1); PG8_BAR; PG8_SCHED;
        }
        if (wr == 0) PG8_BAR;
        S.epi(acc, cur, wr, wc, fr, fq);
        if (!has_next) break;
#pragma unroll
        for (int a = 0; a < 2; ++a)
#pragma unroll
            for (int b = 0; b < 2; ++b)
#pragma unroll
                for (int m = 0; m < 4; ++m)
#pragma unroll
                    for (int n = 0; n < 2; ++n) acc[a][b][m][n] = (f32x4){0.f, 0.f, 0.f, 0.f};
        cur = nxt; cA = nA; cB = nB; ++ui;
        if (wr == 1) PG8_BAR;
    }
    PG8_WAIT_V(0);
    PG8_BAR;
#undef PG8_AOFF
#undef PG8_SA
#undef PG8_SB
#undef PG8_STAGE
#undef PG8_LDA
#undef PG8_LDB
#undef PG8_MMA
#undef PG8_CAT
#undef PG8_WAIT_V
#undef PG8_WAIT_L
#undef PG8_BAR
#undef PG8_SCHED
}

template <class P>
__device__ __forceinline__ void gemm_phase_m128(LAS unsigned char* lds, const P& S) {
    int tid_ = threadIdx.x; asm volatile("" : "+v"(tid_));
    const int tid = tid_, wid = __builtin_amdgcn_readfirstlane(tid >> 6), lane = tid & 63, wr = wid >> 2, wc = wid & 3, fr = lane & 15, fq = lane >> 4;
    constexpr int ELB = P::FP8 ? 1 : 2;
    const int K = S.K; int nt = K * ELB / 128; asm volatile("" : "+s"(nt));
    unsigned voffB[2];
#pragma unroll
    for (int i = 0; i < 2; ++i) { int R, C; stage_rc(tid * 16 + i * 8192, R, C); const int Rb = (R & ~31) + perm32(R & 31); voffB[i] = (unsigned)(Rb * K * ELB + C * 2); }
#define PG8_AOFF(dst0, u) do { _Pragma("unroll") for (int i = 0; i < 2; ++i) { int R, C; stage_rc(tid * 16 + i * 8192, R, C); dst0[i] = S.a_off(u, R, C); } } while (0)
    const size_t kstepB = (size_t)(BK * 2), hstepB = (size_t)HALF * K * ELB, kstepA = (size_t)S.kstepA;
    const unsigned ldsw = (unsigned)wid * 1024u;
    const int aoff = lds_byte(wr * 64 + fr, fq * 8), boff = lds_byte(wc * 32 + fr, fq * 8);
#define PG8_SA(b) (((b) * 2) * HTB)
#define PG8_SB(b, h) ((4 + (b) * 2 + (h)) * HTB)
#define PG8_STAGE(bufoff, gbase, voff) do { _Pragma("unroll") for (int _i = 0; _i < 2; ++_i) \
        __builtin_amdgcn_global_load_lds((const unsigned*)((const char*)(gbase) + (voff)[_i]), (LAS unsigned*)(lds + (bufoff) + ldsw + _i * 8192), 16, 0, 0); } while (0)
#define PG8_LDA(dst, b) do { _Pragma("unroll") for (int m = 0; m < 4; ++m) _Pragma("unroll") for (int k = 0; k < 2; ++k) dst[m][k] = *(const LAS bf16x8*)(lds + PG8_SA(b) + aoff + m * 2048 + k * 1024); } while (0)
#define PG8_LDB(dst, b, h) do { _Pragma("unroll") for (int n = 0; n < 2; ++n) _Pragma("unroll") for (int k = 0; k < 2; ++k) dst[n][k] = *(const LAS bf16x8*)(lds + PG8_SB(b, h) + boff + n * 2048 + k * 1024); } while (0)
#define PG8_CAT(x0, x1) __builtin_shufflevector(__builtin_bit_cast(v4i, x0), __builtin_bit_cast(v4i, x1), 0, 1, 2, 3, 4, 5, 6, 7)
#define PG8_MMA(bj, At, Bt) do { __builtin_amdgcn_s_setprio(1); _Pragma("unroll") for (int m = 0; m < 4; ++m) _Pragma("unroll") for (int n = 0; n < 2; ++n) { \
        if constexpr (P::FP8) acc[bj][m][n] = __builtin_amdgcn_mfma_scale_f32_16x16x128_f8f6f4(PG8_CAT(Bt[n][0], Bt[n][1]), PG8_CAT(At[m][0], At[m][1]), acc[bj][m][n], 0, 0, 0, 0x7f7f7f7f, 0, 0x7f7f7f7f); \
        else { _Pragma("unroll") for (int k = 0; k < 2; ++k) acc[bj][m][n] = __builtin_amdgcn_mfma_f32_16x16x32_bf16(Bt[n][k], At[m][k], acc[bj][m][n], 0, 0, 0); } } __builtin_amdgcn_s_setprio(0); } while (0)
#define PG8_WAIT_V(n) asm volatile("s_waitcnt vmcnt(" #n ")" ::: "memory")
#define PG8_WAIT_L(n) asm volatile("s_waitcnt lgkmcnt(" #n ")" ::: "memory")
#define PG8_BAR __builtin_amdgcn_s_barrier()
#define PG8_SCHED __builtin_amdgcn_sched_barrier(0)
    Unit cur, nxt; int ui = 0;
    if (!S.next(0, cur)) return;
    f32x4 acc[2][4][2], st[2][4][2];
#pragma unroll
    for (int a = 0; a < 2; ++a)
#pragma unroll
        for (int m = 0; m < 4; ++m)
#pragma unroll
            for (int n = 0; n < 2; ++n) { acc[a][m][n] = (f32x4){0.f, 0.f, 0.f, 0.f}; st[a][m][n] = (f32x4){0.f, 0.f, 0.f, 0.f}; }
    bf16x8 At[4][2], B0[2][2];
    unsigned vA[2], vN[2];
    PG8_AOFF(vA, cur);
    const char* cA = S.a_base(cur); const char* cB = S.b_base(cur);
    PG8_STAGE(PG8_SB(0, 0), cB, voffB); PG8_STAGE(PG8_SA(0), cA, vA); PG8_STAGE(PG8_SB(0, 1), cB + hstepB, voffB);
    if (wr == 1) PG8_BAR;
    PG8_WAIT_V(2); PG8_BAR;
    PG8_STAGE(PG8_SB(1, 0), cB + kstepB, voffB); PG8_STAGE(PG8_SA(1), cA + kstepA, vA);
    PG8_WAIT_V(4); PG8_BAR;
    for (;;) {
        const bool has_next = S.next(ui + 1, nxt);
        const char* nA = cA; const char* nB = cB;
        if (has_next) { nA = S.a_base(nxt); nB = S.b_base(nxt); if (P::EARLY_AOFF) PG8_AOFF(vN, nxt); }
        for (int t = 0; t < nt; t += 2) {
            const bool last = (t == nt - 2);
            const char* b1 = cB + (size_t)(t + 1) * kstepB;
            const char* a2 = last ? nA : cA + (size_t)(t + 2) * kstepA; const char* b2 = last ? nB : cB + (size_t)(t + 2) * kstepB;
            const char* a3 = a2 + kstepA; const char* b3 = b2 + kstepB;
            PG8_LDB(B0, 0, 0); PG8_SCHED; PG8_LDA(At, 0); PG8_STAGE(PG8_SB(1, 1), b1 + hstepB, voffB);
            if (last && has_next) { if (P::EARLY_AOFF) { vA[0] = vN[0]; vA[1] = vN[1]; } else PG8_AOFF(vA, nxt); }
            PG8_WAIT_V(6); PG8_WAIT_L(0); PG8_BAR; PG8_MMA(0, At, B0); PG8_BAR; PG8_SCHED;
            PG8_LDB(B0, 0, 1); PG8_STAGE(PG8_SB(0, 0), b2, voffB); PG8_STAGE(PG8_SA(0), a2, vA);
            PG8_WAIT_V(6); PG8_WAIT_L(0); PG8_BAR; PG8_MMA(1, At, B0); PG8_BAR; PG8_SCHED;
            PG8_LDB(B0, 1, 0); PG8_SCHED; PG8_LDA(At, 1); PG8_STAGE(PG8_SB(0, 1), b2 + hstepB, voffB);
            PG8_WAIT_V(6); PG8_WAIT_L(0); PG8_BAR; PG8_MMA(0, At, B0); PG8_BAR; PG8_SCHED;
            PG8_LDB(B0, 1, 1); PG8_STAGE(PG8_SB(1, 0), b3, voffB); PG8_STAGE(PG8_SA(1), a3, vA);
            PG8_WAIT_V(6); PG8_WAIT_L(0); PG8_BAR; PG8_MMA(1, At, B0); PG8_BAR; PG8_SCHED;
        }
        if (wr == 0) PG8_BAR;
        S.epi(acc, st, cur, wr, wc, fr, fq);
        if (!has_next) break;
#pragma unroll
        for (int a = 0; a < 2; ++a)
#pragma unroll
            for (int m = 0; m < 4; ++m)
#pragma unroll
                for (int n = 0; n < 2; ++n) acc[a][m][n] = (f32x4){0.f, 0.f, 0.f, 0.f};
        cur = nxt; cA = nA; cB = nB; ++ui;
        if (wr == 1) PG8_BAR;
    }
    PG8_WAIT_V(0);
    PG8_BAR;
#undef PG8_AOFF
#undef PG8_SA
#undef PG8_SB
#undef PG8_STAGE
#undef PG8_LDA
#undef PG8_LDB
#undef PG8_MMA
#undef PG8_CAT
#undef PG8_WAIT_V
#undef PG8_WAIT_L
#undef PG8_BAR
#undef PG8_SCHED
}
}
namespace attn_body {
using bf16x8 = __attribute__((ext_vector_type(8))) short;
using u32x4 = __attribute__((ext_vector_type(4))) unsigned;
constexpr int NW = 8, QBLK = 32, QB = QBLK * NW, KVBLK = 64;
__device__ __forceinline__ int crow(int r, int hi) { return (r & 3) + 8 * (r >> 2) + 4 * hi; }
#define SBAR() __builtin_amdgcn_sched_barrier(0)
constexpr int NSLOT = 3, SLOTB = 8192;
constexpr int LDS_K = 0, LDS_V = NSLOT * SLOTB, LDS_WS = 2 * NSLOT * SLOTB, LDS_OST = LDS_WS + NW * 64 * 4, LDS_BYTES = LDS_OST + NW * 4096;
constexpr int LDS_BT = 86016 + 256;
__device__ __forceinline__ void glds16(const void* gsrc, unsigned lds_dst) { unsigned keep;
  asm volatile("s_mov_b32 %0, m0\n\ts_mov_b32 m0, %2\n\ts_nop 0\n\tglobal_load_lds_dwordx4 %1, off\n\ts_mov_b32 m0, %0" : "=&s"(keep) : "v"(gsrc), "s"(lds_dst) : "memory"); }
__device__ __forceinline__ float max3f(float a, float b, float c) { float r; asm("v_max3_f32 %0, %1, %2, %3" : "=v"(r) : "v"(a), "v"(b), "v"(c)); return r; }
__device__ __forceinline__ float max2f(float a, float b) { float r; asm("v_max_f32_e32 %0, %1, %2" : "=v"(r) : "v"(a), "v"(b)); return r; }
__device__ __forceinline__ float fadd_s(float a, float b) { float r; asm("v_add_f32_e32 %0, %1, %2" : "=v"(r) : "v"(a), "v"(b)); return r; }
__device__ __forceinline__ float fsub_s(float a, float b) { float r; asm("v_sub_f32_e32 %0, %1, %2" : "=v"(r) : "v"(a), "v"(b)); return r; }
typedef float f32x2_t __attribute__((ext_vector_type(2))); typedef __bf16 bf16x2_t __attribute__((ext_vector_type(2)));
__device__ __forceinline__ unsigned cvtpk_s(float lo, float hi) { f32x2_t v = {lo, hi}; bf16x2_t b = __builtin_convertvector(v, bf16x2_t); return __builtin_bit_cast(unsigned, b); }
#define WAIT_BAR(N) asm volatile("s_waitcnt vmcnt(" #N ") lgkmcnt(0)\n\ts_barrier" ::: "memory")

__device__ __forceinline__ void qkt(f32x16& p0, f32x16& p1, const char* Kslot, const bf16x8* qr, const f32x16& negm, int r32, int hi) {
  const char* kb = Kslot + hi * 1024 + r32 * 16;
  #pragma unroll
  for (int d0 = 0; d0 < 4; ++d0) {
    const bf16x8 b0 = *reinterpret_cast<const bf16x8*>(kb + d0 * 2048);
    const bf16x8 b1 = *reinterpret_cast<const bf16x8*>(kb + d0 * 2048 + 512);
    if (d0 == 0) { p0 = __builtin_amdgcn_mfma_f32_32x32x16_bf16(b0, qr[0], negm, 0, 0, 0); p1 = __builtin_amdgcn_mfma_f32_32x32x16_bf16(b1, qr[0], negm, 0, 0, 0); }
    else { p0 = __builtin_amdgcn_mfma_f32_32x32x16_bf16(b0, qr[d0], p0, 0, 0, 0); p1 = __builtin_amdgcn_mfma_f32_32x32x16_bf16(b1, qr[d0], p1, 0, 0, 0); } }
}
typedef __attribute__((address_space(3))) const char* lds_cptr;
typedef short v4i16_t __attribute__((ext_vector_type(4)));
__device__ __forceinline__ void kload8(bf16x8* kf, lds_cptr kp) {
  kf[0] = *(const __attribute__((address_space(3))) bf16x8*)(kp);        kf[1] = *(const __attribute__((address_space(3))) bf16x8*)(kp + 512);
  kf[2] = *(const __attribute__((address_space(3))) bf16x8*)(kp + 2048); kf[3] = *(const __attribute__((address_space(3))) bf16x8*)(kp + 2560);
  kf[4] = *(const __attribute__((address_space(3))) bf16x8*)(kp + 4096); kf[5] = *(const __attribute__((address_space(3))) bf16x8*)(kp + 4608);
  kf[6] = *(const __attribute__((address_space(3))) bf16x8*)(kp + 6144); kf[7] = *(const __attribute__((address_space(3))) bf16x8*)(kp + 6656);
}
__device__ __forceinline__ void kload2(bf16x8* kf, lds_cptr kp, int j) { kf[2 * j] = *(const __attribute__((address_space(3))) bf16x8*)(kp + j * 2048); kf[2 * j + 1] = *(const __attribute__((address_space(3))) bf16x8*)(kp + j * 2048 + 512); }
__device__ __forceinline__ s16x4 vtr(lds_cptr p) { return __builtin_bit_cast(s16x4, __builtin_amdgcn_ds_read_tr16_b64_v4i16((__attribute__((address_space(3))) v4i16_t*)p)); }
__device__ __forceinline__ float rowmax(const f32x16& p0, const f32x16& p1) {
  float a = max3f(p0[0], p0[1], p1[0]), b = max3f(p0[2], p0[3], p1[1]); a = max3f(a, p1[2], p1[3]);
  #pragma unroll
  for (int r = 4; r < 16; r += 4) { a = max3f(a, p0[r], p0[r + 1]); b = max3f(b, p0[r + 2], p0[r + 3]); a = max3f(a, p1[r], p1[r + 1]); b = max3f(b, p1[r + 2], p1[r + 3]); }
  const float m = max2f(a, b);
  auto rr = __builtin_amdgcn_permlane32_swap(__float_as_uint(m), __float_as_uint(m), false, false);
  return max2f(__uint_as_float(rr[0]), __uint_as_float(rr[1]));
}
__device__ __forceinline__ void pv(f32x16* o, int vb, bf16x8 pa0, bf16x8 pa1, bf16x8 pa2, bf16x8 pa3) {
  #pragma unroll
  for (int d0 = 0; d0 < 2; ++d0) { s16x4 lo[4], hi[4];
    #pragma unroll
    for (int ks = 0; ks < 4; ++ks) {
      asm volatile("ds_read_b64_tr_b16 %0,%1 offset:%c2" : "=&v"(lo[ks]) : "v"(vb), "i"(d0 * 4096 + ks * 1024) : "memory");
      asm volatile("ds_read_b64_tr_b16 %0,%1 offset:%c2" : "=&v"(hi[ks]) : "v"(vb), "i"(d0 * 4096 + ks * 1024 + 512) : "memory"); }
    asm volatile("s_waitcnt lgkmcnt(0)" ::: "memory"); SBAR();
    #define PK(k) (bf16x8){lo[k][0], lo[k][1], lo[k][2], lo[k][3], hi[k][0], hi[k][1], hi[k][2], hi[k][3]}
    o[d0] = __builtin_amdgcn_mfma_f32_32x32x16_bf16(pa0, PK(0), o[d0], 0, 0, 0);
    o[d0] = __builtin_amdgcn_mfma_f32_32x32x16_bf16(pa1, PK(1), o[d0], 0, 0, 0);
    o[d0] = __builtin_amdgcn_mfma_f32_32x32x16_bf16(pa2, PK(2), o[d0], 0, 0, 0);
    o[d0] = __builtin_amdgcn_mfma_f32_32x32x16_bf16(pa3, PK(3), o[d0], 0, 0, 0);
    #undef PK
  }
}
#define ATTN_STORE16(p, v) (*(u32x4*)(p) = (v))

template <int THRL, bool NA, int QP_, int KVP_, bool NOMAX = false>
__device__ __forceinline__ void attn_unit(const bf16* Qu, int qp_rt, const bf16* __restrict__ Kh, const bf16* __restrict__ Vh, int kvp_rt, bf16* Ou, int NT, int r0, int rlo, char* shm) {
  const int qp = QP_ ? QP_ : qp_rt, kvp = KVP_ ? KVP_ : kvp_rt, op = qp;
  int tid_ = threadIdx.x; asm volatile("" : "+v"(tid_));
  const int tid = tid_, lane = tid & 63, r32 = lane & 31, hi = lane >> 5; const int wid = __builtin_amdgcn_readfirstlane(tid >> 6);
  const bf16* Qw = Qu + (long)(wid * QBLK) * qp;
  const unsigned lds0 = (unsigned)(uintptr_t)shm;
  float* wsf = (float*)(shm + LDS_WS) + wid * 64;
  const bf16* ksrc = Kh + (long)lane * kvp + wid * 8;
  const bf16* vsrc = Vh + (long)(16 * (wid & 3) + (lane >> 2)) * kvp + (wid >> 2) * 32 + (lane & 3) * 8;
  const unsigned kdst = lds0 + LDS_K + wid * 1024, vdst = lds0 + LDS_V + wid * 1024;
  #define TROW(t) (NA ? ((t) < 4 ? 64 * (t) : CTX + 64 * ((rlo + (t) - 4) < 127 ? (rlo + (t) - 4) : 127)) : 64 * (t))
  #define DMA_K(t, slot) glds16(ksrc + (long)TROW(t) * kvp, (unsigned)__builtin_amdgcn_readfirstlane(kdst + (slot)))
  #define DMA_V(t, slot) glds16(vsrc + (long)TROW(t) * kvp, (unsigned)__builtin_amdgcn_readfirstlane(vdst + (slot)))
  const int vb0 = (int)(lds0 + LDS_V) + ((lane >> 4) & 1) * 32 + (lane & 3) * 8 + (4 * hi + ((lane & 15) >> 2)) * 64;
  const char* Kbase = shm + LDS_K; bf16x8 kf[8];
  const lds_cptr shm3 = (lds_cptr)shm; const lds_cptr kp0 = shm3 + LDS_K + hi * 1024 + r32 * 16; const lds_cptr vp0 = shm3 + LDS_V + ((lane >> 4) & 1) * 32 + (lane & 3) * 8 + (4 * hi + ((lane & 15) >> 2)) * 64;
  const int rq = r0 + (wid >> 1), qc = 32 * (wid & 1) + r32;
  const int rsw = rq - 4 < 0 ? 0 : (rq - 4 > 120 ? 120 : rq - 4);
  const int cs = qc - 8 < 0 ? 0 : (qc - 8 > 48 ? 48 : qc - 8);
  const __attribute__((address_space(3))) float* btl = (const __attribute__((address_space(3))) float*)(shm3 + LDS_BT) + (15 + 4 * hi - qc);
  DMA_K(0, 0); DMA_V(0, 0); DMA_K(1, SLOTB);
  bf16x8 qr[4];
  #pragma unroll
  for (int d0 = 0; d0 < 4; ++d0) qr[d0] = *reinterpret_cast<const bf16x8*>(&Qw[(long)r32 * qp + d0 * 16 + hi * 8]);
  float mhat = 0.f, l_reg = 0.f; f32x16 o[2]; o[0] = f32x16{}; o[1] = f32x16{}; f32x16 negm = f32x16{}; if (!NA) asm volatile("" : "+v"(negm));
  #define NEGM (NA ? f32x16{} : negm)
  #define CMASK(P0, P1, t) do { if (NA) { if ((t) >= 4) { const int kr_ = rlo + (t) - 4; const int dr_ = kr_ - rsw; \
      if (dr_ < 0 || dr_ >= 8) { _Pragma("unroll") for (int r = 0; r < 16; ++r) { P0[r] = (-__builtin_inff()); P1[r] = (-__builtin_inff()); } } \
      else { const __attribute__((address_space(3))) float* bp_ = btl + (kr_ - rq + 7) * 31; const int kl0_ = 4 * hi - cs; \
        _Pragma("unroll") for (int rg = 0; rg < 4; ++rg) { \
          _Pragma("unroll") for (int rr_ = 0; rr_ < 4; ++rr_) { const int r = rg * 4 + rr_; const int kc_ = (r & 3) + 8 * (r >> 2); const float b0_ = bp_[kc_], b1_ = bp_[kc_ + 32]; \
            const int kl_ = kc_ + kl0_; P0[r] = ((unsigned)kl_ < 16u) ? P0[r] + b0_ : (-__builtin_inff()); P1[r] = ((unsigned)(kl_ + 32) < 16u) ? P1[r] + b1_ : (-__builtin_inff()); } \
          SBAR(); } } } } } while (0)
  bool resc = false;
  #define START(P0, P1) do { const float rm = NOMAX ? 0.f : rowmax(P0, P1); resc = false; \
    { const float dl = rm; mhat = fadd_s(mhat, dl); \
      _Pragma("unroll") for (int r = 0; r < 16; ++r) { P0[r] = fsub_s(P0[r], dl); P1[r] = fsub_s(P1[r], dl); } \
      if (!NA) { _Pragma("unroll") for (int r = 0; r < 16; ++r) negm[r] = -mhat; asm volatile("" : "+v"(negm)); } } \
    _Pragma("unroll") for (int r = 0; r < 16; ++r) P0[r] = __builtin_amdgcn_exp2f(P0[r]); } while (0)
  #define RESC() do { if (resc) { asm volatile("s_waitcnt lgkmcnt(0)" ::: "memory"); \
      _Pragma("unroll") for (int d_ = 0; d_ < 2; ++d_) _Pragma("unroll") for (int r = 0; r < 16; ++r) o[d_][r] *= wsf[crow(r, hi)]; } } while (0)
  f32x16 pA0, pA1, pB0, pB1;
  int sl_prev = 0, sl_cur = 0, sl_next = SLOTB;
  #define ROT() do { sl_prev = sl_cur; sl_cur = sl_next; sl_next = (sl_next == (NSLOT - 1) * SLOTB) ? 0 : sl_next + SLOTB; } while (0)
  DMA_K(2, 2 * SLOTB);
  WAIT_BAR(3);
  qkt(pA0, pA1, Kbase, qr, NEGM, r32, hi); asm volatile("s_nop 15\n\ts_nop 7" : "+v"(pA0), "+v"(pA1));
  START(pA0, pA1);
  _Pragma("unroll") for (int r = 0; r < 16; ++r) pA1[r] = __builtin_amdgcn_exp2f(pA1[r]);
  WAIT_BAR(0);
  DMA_K(3, 0); DMA_V(1, SLOTB);
  ROT();
  kload8(kf, kp0 + sl_cur);
  WAIT_BAR(2);
  s16x4 vlo[8], vhi[8]; u32x4 pw0, pw1, pw2, pw3;
  #define PKW(P, B) cvtpk_s(P[B], P[B + 1])
  #define PAF(k) __builtin_bit_cast(bf16x8, pw##k)
  #define VFR(i) (bf16x8){vlo[i][0], vlo[i][1], vlo[i][2], vlo[i][3], vhi[i][0], vhi[i][1], vhi[i][2], vhi[i][3]}
  #define PIN(x) asm volatile("" : "+v"(x))
  #define MX3(a, b, c) __builtin_fmaxf(__builtin_fmaxf((a), (b)), (c))
  #define GAPA(MF, A0, A1, A2, A3, W0, W1, PW) do { MF; sacc2 += (f32x2_t){A0, A1}; sacc2 += (f32x2_t){A2, A3}; PIN(sacc2); W0; W1; PIN(PW); SBAR(); } while (0)
  #define EX(v) __builtin_amdgcn_exp2f(v)
  #define GAPB(MF, X, B) do { MF; X[B] = EX(X[B]); X[B + 1] = EX(X[B + 1]); X[B + 2] = EX(X[B + 2]); X[B + 3] = EX(X[B + 3]); PIN(X); SBAR(); } while (0)
  #define VRD(i) do { vlo[i] = vtr(vp_ + (((i) >> 2) * 4096 + ((i) & 3) * 1024)); vhi[i] = vtr(vp_ + (((i) >> 2) * 4096 + ((i) & 3) * 1024 + 512)); } while (0)
  #define KRD(G, j) do { if (G) { kload2(kf, kp0 + sl_next, j); SBAR(); } } while (0)
  #define STEP(C0, C1, P0, P1, t, GK, GV, GL) do { SBAR(); \
    const lds_cptr vp_ = vp0 + sl_prev; \
    VRD(0); SBAR(); f32x2_t sacc2 = (f32x2_t){P0[0], P0[1]}; \
    GAPA(C0 = __builtin_amdgcn_mfma_f32_32x32x16_bf16(kf[0], qr[0], NEGM, 0, 0, 0), P0[2], P0[3], P0[4], P0[5],     pw0[0] = PKW(P0, 0), pw0[1] = PKW(P0, 2), pw0); \
    VRD(4); SBAR(); GAPA(C1 = __builtin_amdgcn_mfma_f32_32x32x16_bf16(kf[1], qr[0], NEGM, 0, 0, 0), P0[6], P0[7], P0[8], P0[9],     pw0[2] = PKW(P0, 4), pw0[3] = PKW(P0, 6), pw0); \
    VRD(1); SBAR(); GAPA(C0 = __builtin_amdgcn_mfma_f32_32x32x16_bf16(kf[2], qr[1], C0, 0, 0, 0),   P0[10], P0[11], P0[12], P0[13], pw1[0] = PKW(P0, 8), pw1[1] = PKW(P0, 10), pw1); \
    VRD(5); SBAR(); GAPA(C1 = __builtin_amdgcn_mfma_f32_32x32x16_bf16(kf[3], qr[1], C1, 0, 0, 0),   P0[14], P0[15], P1[0], P1[1],   pw1[2] = PKW(P0, 12), pw1[3] = PKW(P0, 14), pw1); \
    VRD(2); SBAR(); GAPA(C0 = __builtin_amdgcn_mfma_f32_32x32x16_bf16(kf[4], qr[2], C0, 0, 0, 0),   P1[2], P1[3], P1[4], P1[5],     pw2[0] = PKW(P1, 0), pw2[1] = PKW(P1, 2), pw2); \
    VRD(6); SBAR(); GAPA(C1 = __builtin_amdgcn_mfma_f32_32x32x16_bf16(kf[5], qr[2], C1, 0, 0, 0),   P1[6], P1[7], P1[8], P1[9],     pw2[2] = PKW(P1, 4), pw2[3] = PKW(P1, 6), pw2); \
    VRD(3); SBAR(); GAPA(C0 = __builtin_amdgcn_mfma_f32_32x32x16_bf16(kf[6], qr[3], C0, 0, 0, 0),   P1[10], P1[11], P1[12], P1[13], pw3[0] = PKW(P1, 8), pw3[1] = PKW(P1, 10), pw3); \
    VRD(7); SBAR(); GAPA(C1 = __builtin_amdgcn_mfma_f32_32x32x16_bf16(kf[7], qr[3], C1, 0, 0, 0),   P1[14], P1[15], 0.f, 0.f,       pw3[2] = PKW(P1, 12), pw3[3] = PKW(P1, 14), pw3); \
    l_reg += sacc2.x + sacc2.y; \
    if (GK) { DMA_K((t) + 3, sl_cur); } if (GV) { DMA_V((t) + 1, sl_next); } \
    resc = false; \
    if (NA) { _Pragma("unroll") for (int r = 0; r < 16; ++r) { C0[r] -= mhat; C1[r] -= mhat; } } \
    CMASK(C0, C1, t); \
    if (!NOMAX) { float a = MX3(C0[0], C0[1], C1[0]), b = MX3(C0[2], C0[3], C1[1]); a = MX3(a, C1[2], C1[3]); \
      _Pragma("unroll") for (int r = 4; r < 16; r += 4) { a = MX3(a, C0[r], C0[r + 1]); b = MX3(b, C0[r + 2], C0[r + 3]); a = MX3(a, C1[r], C1[r + 1]); b = MX3(b, C1[r + 2], C1[r + 3]); } \
      float rm = __builtin_fmaxf(a, b); { auto rr = __builtin_amdgcn_permlane32_swap(__float_as_uint(rm), __float_as_uint(rm), false, false); rm = __builtin_fmaxf(__uint_as_float(rr[0]), __uint_as_float(rr[1])); } \
      if (__builtin_expect(__any(rm > (float)THRL), 0)) { const float dl = __builtin_fmaxf(rm, 0.f); mhat += dl; \
        _Pragma("unroll") for (int r = 0; r < 16; ++r) { C0[r] -= dl; C1[r] -= dl; } \
        if (!NA) { _Pragma("unroll") for (int r = 0; r < 16; ++r) negm[r] = -mhat; asm volatile("" : "+v"(negm)); } \
        const float f = __builtin_amdgcn_exp2f(-dl); l_reg *= f; if (hi == 0) wsf[r32] = f; resc = true; } } \
    SBAR(); \
    GAPB(o[0] = __builtin_amdgcn_mfma_f32_32x32x16_bf16(PAF(0), VFR(0), o[0], 0, 0, 0), C0, 0); \
    GAPB(o[1] = __builtin_amdgcn_mfma_f32_32x32x16_bf16(PAF(0), VFR(4), o[1], 0, 0, 0), C0, 4); \
    KRD(GL, 0); GAPB(o[0] = __builtin_amdgcn_mfma_f32_32x32x16_bf16(PAF(1), VFR(1), o[0], 0, 0, 0), C0, 8); \
    KRD(GL, 1); GAPB(o[1] = __builtin_amdgcn_mfma_f32_32x32x16_bf16(PAF(1), VFR(5), o[1], 0, 0, 0), C0, 12); \
    KRD(GL, 2); GAPB(o[0] = __builtin_amdgcn_mfma_f32_32x32x16_bf16(PAF(2), VFR(2), o[0], 0, 0, 0), C1, 0); \
    KRD(GL, 3); GAPB(o[1] = __builtin_amdgcn_mfma_f32_32x32x16_bf16(PAF(2), VFR(6), o[1], 0, 0, 0), C1, 4); \
    GAPB(o[0] = __builtin_amdgcn_mfma_f32_32x32x16_bf16(PAF(3), VFR(3), o[0], 0, 0, 0), C1, 8); \
    GAPB(o[1] = __builtin_amdgcn_mfma_f32_32x32x16_bf16(PAF(3), VFR(7), o[1], 0, 0, 0), C1, 12); \
    } while (0)
  int t = 1;
  for (; t + 5 < NT; t += 2) {
    STEP(pB0, pB1, pA0, pA1, t, true, true, true);     WAIT_BAR(2); RESC(); ROT();
    STEP(pA0, pA1, pB0, pB1, t + 1, true, true, true); WAIT_BAR(2); RESC(); ROT();
  }
  #define ENDW(tt) do { if ((tt) + 3 < NT) { WAIT_BAR(2); } else if ((tt) + 2 < NT) { WAIT_BAR(1); } else { WAIT_BAR(0); } } while (0)
  for (; t + 1 < NT; t += 2) {
    STEP(pB0, pB1, pA0, pA1, t, (t + 3 < NT), (t + 1 < NT), (t + 1 < NT));         ENDW(t);     RESC(); ROT();
    STEP(pA0, pA1, pB0, pB1, t + 1, (t + 4 < NT), (t + 2 < NT), (t + 2 < NT));     ENDW(t + 1); RESC(); ROT();
  }
  STEP(pB0, pB1, pA0, pA1, NT - 1, false, false, false); RESC();
  { float sacc = pB0[0] + pB0[1]; _Pragma("unroll") for (int r = 2; r < 16; ++r) sacc += pB0[r]; _Pragma("unroll") for (int r = 0; r < 16; ++r) sacc += pB1[r]; l_reg += sacc;
    pw0 = (u32x4){PKW(pB0, 0), PKW(pB0, 2), PKW(pB0, 4), PKW(pB0, 6)}; pw1 = (u32x4){PKW(pB0, 8), PKW(pB0, 10), PKW(pB0, 12), PKW(pB0, 14)}; pw2 = (u32x4){PKW(pB1, 0), PKW(pB1, 2), PKW(pB1, 4), PKW(pB1, 6)}; pw3 = (u32x4){PKW(pB1, 8), PKW(pB1, 10), PKW(pB1, 12), PKW(pB1, 14)};
    SBAR(); pv(o, vb0 + sl_cur, PAF(0), PAF(1), PAF(2), PAF(3)); }
  #undef PKW
  #undef PAF
  #undef VFR
  #undef PIN
  #undef MX3
  #undef GAPA
  #undef GAPB
  #undef EX
  #undef VRD
  #undef KRD
  #undef STEP
  #undef ENDW
  { auto rr = __builtin_amdgcn_permlane32_swap(__float_as_uint(l_reg), __float_as_uint(l_reg), false, false); l_reg = __uint_as_float(rr[0]) + __uint_as_float(rr[1]); }
  if (hi == 0) wsf[32 + r32] = l_reg; asm volatile("s_waitcnt lgkmcnt(0)" ::: "memory");
  float rli[16];
  #pragma unroll
  for (int r = 0; r < 16; ++r) rli[r] = __builtin_amdgcn_rcpf(wsf[32 + crow(r, hi)]);
  bf16* Ow = Ou + (long)(wid * QBLK) * op;
  { bf16* stg = (bf16*)(shm + LDS_OST) + wid * 2048;
    #pragma unroll
    for (int r = 0; r < 16; ++r) { const int orow = crow(r, hi);
      #pragma unroll
      for (int d0 = 0; d0 < 2; ++d0) stg[orow * 64 + d0 * 32 + r32] = (bf16)f2bf(o[d0][r] * rli[r]); }
    asm volatile("s_waitcnt lgkmcnt(0)" ::: "memory");
    #pragma unroll
    for (int i = 0; i < 4; ++i) { const int row = i * 8 + (lane >> 3), ch = lane & 7; const u32x4 v = *(const u32x4*)(stg + row * 64 + ch * 8); ATTN_STORE16(Ow + (long)row * op + ch * 8, v); } }
  asm volatile("s_waitcnt lgkmcnt(0)\n\ts_barrier" ::: "memory");
  #undef NEGM
  #undef DMA_K
  #undef DMA_V
  #undef TROW
  #undef CMASK
  #undef START
  #undef RESC
  #undef ROT
}
#undef SBAR
#undef WAIT_BAR
}
#ifndef FP8_MOE
#define FP8_MOE 1
#endif
struct Args { const float* in[29]; float* out; unsigned char* ws; int ph_lo, ph_hi; };
enum { I_X = 0, I_C, I_CTX, I_CCTX, I_WMOD, I_BMOD, I_N1G, I_N2G, I_WIN, I_LRE, I_LIM, I_LDT, I_BRE, I_BIM, I_CRE, I_CIM, I_SSMD, I_WGLU, I_QNG, I_KNG, I_RPB, I_WBR, I_WOUT, I_RW, I_RB, I_MG, I_MU, I_MD, I_FNG };

typedef const float* CFP;
struct Ctx {
    const __attribute__((address_space(4))) CFP* in; float* out; unsigned char* ws; LAS unsigned char* lds; gu32* ctl;
    int tid, lane, wave, vcu, G;
};
#define WSP(T_, off) ((T_*)(C.ws + (off)))

__device__ __forceinline__ float* xs_row(const Ctx& C, int m) { const int b = m / LB, j = m - b * LB; return j < CTX ? WSP(float, WS_CTXS) + (size_t)(b * CTX + j) * D : C.out + (size_t)(b * SEQ + j - CTX) * D; }
__device__ __forceinline__ const float* in_row(const Ctx& C, int m) { const int b = m / LB, j = m - b * LB; return j < CTX ? C.in[I_CTX] + (size_t)(b * CTX + j) * D : C.in[I_X] + (size_t)(b * SEQ + j - CTX) * D; }
__device__ __forceinline__ int cond_of(int m) { const int b = m / LB, j = m - b * LB; return j < CTX ? 4 : b; }

__device__ __forceinline__ void transpose_item(const float* W, int N, int Kp, bf16* WT, int k0, int n0, int drow0, LAS float* scr, int lane) {
    const float* src = W + (size_t)k0 * N + n0 + lane;
    float tv[64];
#pragma unroll
    for (int i = 0; i < 64; ++i) tv[i] = src[(size_t)i * N];
#pragma unroll
    for (int i = 0; i < 64; ++i) scr[i * 65 + lane] = tv[i];
    LDS_WAIT(); asm volatile("" ::: "memory");
    const int c = lane & 7;
#pragma unroll
    for (int j = 0; j < 8; ++j) { const int n = (lane >> 3) + 8 * j; const LAS float* s = scr + (8 * c) * 65 + n;
        v4u o; o.x = pk2(s[0 * 65], s[1 * 65]); o.y = pk2(s[2 * 65], s[3 * 65]); o.z = pk2(s[4 * 65], s[5 * 65]); o.w = pk2(s[6 * 65], s[7 * 65]);
        *(GAS v4u*)(WT + (size_t)(drow0 + n) * Kp + k0 + 8 * c) = o; }
    LDS_WAIT(); asm volatile("" ::: "memory");
}
__device__ __forceinline__ void transpose_item8(const float* W, int N, int Kp, unsigned char* WT, int k0, int n0, int drow0, float scale, LAS float* scr, int lane) {
    const float* src = W + (size_t)k0 * N + n0 + lane;
    float tv[64];
#pragma unroll
    for (int i = 0; i < 64; ++i) tv[i] = src[(size_t)i * N];
#pragma unroll
    for (int i = 0; i < 64; ++i) scr[i * 65 + lane] = tv[i] * scale;
    LDS_WAIT(); asm volatile("" ::: "memory");
    const int c = lane & 3;
#pragma unroll
    for (int j = 0; j < 4; ++j) { const int n = (lane >> 2) + 16 * j; const LAS float* s = scr + (16 * c) * 65 + n;
        v4u o; o.x = pk4_fp8(s[0 * 65], s[1 * 65], s[2 * 65], s[3 * 65]); o.y = pk4_fp8(s[4 * 65], s[5 * 65], s[6 * 65], s[7 * 65]); o.z = pk4_fp8(s[8 * 65], s[9 * 65], s[10 * 65], s[11 * 65]); o.w = pk4_fp8(s[12 * 65], s[13 * 65], s[14 * 65], s[15 * 65]);
        *(GAS v4u*)(WT + (size_t)(drow0 + n) * Kp + k0 + 16 * c) = o; }
    LDS_WAIT(); asm volatile("" ::: "memory");
}
__device__ __forceinline__ void phase_weights(const Ctx& C, int l) {
    LAS float* scr = (LAS float*)(C.lds + C.wave * 16640);
    const int gw = C.vcu * NWAVES + C.wave, NGW = C.G * NWAVES;
    constexpr int I0 = 16 * 92, I1 = 8 * 8, I2 = 3 * 8 * 16, I3 = 16 * 16, I4 = 16 * 16 * 8, I5 = I4, I6 = 16 * 8 * 16;
    for (int it = gw; it < I0 + I1 + I2 + I3 + I4 + I5 + I6; it += NGW) {
        int r = it;
        if (r < I0) { const int kb = r / 92, nb = r % 92; if (W8_ALL) transpose_item8(C.in[I_WIN] + (size_t)l * 1024 * INW, INW, 1024, WSP(unsigned char, WS_WIN), 64 * kb, 64 * nb, 64 * nb, 64.f, scr, C.lane);
            else if (nb < 44 || GATE_BF16) transpose_item(C.in[I_WIN] + (size_t)l * 1024 * INW, INW, 1024, WSP(bf16, WS_WIN), 64 * kb, 64 * nb, 64 * nb, scr, C.lane);
            else transpose_item8(C.in[I_WIN] + (size_t)l * 1024 * INW, INW, 1024, WSP(unsigned char, WS_WIN8), 64 * kb, 64 * nb, 64 * nb - 2816, 64.f, scr, C.lane); continue; } r -= I0;
        if (r < I1) { const int kb = r / 8, nb = r % 8; transpose_item(C.in[I_WGLU] + (size_t)l * 512 * 512, 512, 512, WSP(bf16, WS_WGLU), 64 * kb, 64 * nb, 64 * nb, scr, C.lane); continue; } r -= I1;
        if (r < I2) { const int i = r / 128, q = r % 128, kb = q / 16, nb = q % 16; transpose_item(C.in[I_WBR] + (size_t)(l * 3 + i) * 512 * 1024, 1024, 512, WSP(bf16, WS_WBR) + (size_t)i * 1024 * 512, 64 * kb, 64 * nb, 64 * nb, scr, C.lane); continue; } r -= I2;
        if (r < I3) { const int kb = r / 16, nb = r % 16; transpose_item(C.in[I_WOUT] + (size_t)l * 1024 * 1024, 1024, 1024, WSP(bf16, WS_WOUT), 64 * kb, 64 * nb, 64 * nb, scr, C.lane); continue; } r -= I3;
        if (r < I4 + I5) { const int up = r >= I4; if (up) r -= I4; const int e = r / 128, q = r % 128, kb = q / 8, nb = q % 8, n0 = 64 * nb;
            if (FP8_MOE) transpose_item8((up ? C.in[I_MU] : C.in[I_MG]) + (size_t)(l * 16 + e) * 1024 * 512, 512, 1024, WSP(unsigned char, WS_MOE1) + (size_t)e * 1024 * 1024, 64 * kb, n0, (n0 / 128) * 256 + (n0 % 128) + (up ? 128 : 0), 64.f, scr, C.lane);
            else transpose_item((up ? C.in[I_MU] : C.in[I_MG]) + (size_t)(l * 16 + e) * 1024 * 512, 512, 1024, WSP(bf16, WS_MOE1) + (size_t)e * 1024 * 1024, 64 * kb, n0, (n0 / 128) * 256 + (n0 % 128) + (up ? 128 : 0), scr, C.lane); continue; } r -= I4 + I5;
        { const int e = r / 128, q = r % 128, kb = q / 16, nb = q % 16; if (FP8_MOE) transpose_item8(C.in[I_MD] + (size_t)(l * 16 + e) * 512 * 1024, 1024, 512, WSP(unsigned char, WS_MOE2) + (size_t)e * 1024 * 512, 64 * kb, 64 * nb, 64 * nb, 32.f, scr, C.lane);
            else transpose_item(C.in[I_MD] + (size_t)(l * 16 + e) * 512 * 1024, 1024, 512, WSP(bf16, WS_MOE2) + (size_t)e * 1024 * 512, 64 * kb, 64 * nb, 64 * nb, scr, C.lane); }
    }
}

__device__ __forceinline__ void phase_mod(const Ctx& C) {
    LAS float* sc = (LAS float*)(C.lds);
    LAS float* red = (LAS float*)(C.lds + 20480);
    for (int i = C.tid; i < 5 * 1024; i += 512) { const int c = i >> 10, k = i & 1023; const float v = c < 4 ? C.in[I_C][c * 1024 + k] : C.in[I_CCTX][k]; sc[i] = v * fsigmoid(v); }
    __syncthreads();
    for (int it = C.vcu; it < NLAYER * 96; it += C.G) {
        const int l = it / 96, col = (it % 96) * 64 + C.lane, k0 = C.wave * 128;
        const float* W = C.in[I_WMOD] + (size_t)l * 1024 * 6144 + (size_t)k0 * 6144 + col;
        float a0 = 0.f, a1 = 0.f, a2 = 0.f, a3 = 0.f, a4 = 0.f;
#pragma unroll 16
        for (int k = 0; k < 128; ++k) { const float w = W[(size_t)k * 6144]; a0 += sc[k0 + k] * w; a1 += sc[1024 + k0 + k] * w; a2 += sc[2048 + k0 + k] * w; a3 += sc[3072 + k0 + k] * w; a4 += sc[4096 + k0 + k] * w; }
        LAS float* r = red + C.wave * 320 + C.lane; r[0] = a0; r[64] = a1; r[128] = a2; r[192] = a3; r[256] = a4;
        __syncthreads();
        if (C.tid < 320) { const int c = C.tid >> 6; float s = C.in[I_BMOD][l * 6144 + col];
#pragma unroll
            for (int w = 0; w < 8; ++w) s += red[w * 320 + C.tid];
            WSP(float, WS_MOD)[(size_t)(l * 5 + c) * 6144 + col] = s; }
        __syncthreads();
    }
}

__device__ __forceinline__ void phase_s5mats(const Ctx& C, int l) {
    if (C.vcu >= 128) return;
    const int g = C.vcu >> 2, part = C.vcu & 3, tid = C.tid;
    LAS f32x2* POW = (LAS f32x2*)(C.lds);
    LAS f32x2* CC = (LAS f32x2*)(C.lds + 33792);
    LAS f32x2* BB = (LAS f32x2*)(C.lds + 50176);
    LAS f32x2* COEF = (LAS f32x2*)(C.lds + 66560);
    LAS bf16* KT = (LAS bf16*)(C.lds + 67584);
    LAS float* K0 = (LAS float*)(C.lds + 99840);
    __syncthreads();
    if (tid < 128) {
        const int d = tid >> 6, p = tid & 63; const int li = ((l * 2 + d) * 32 + g) * 64 + p;
        const float re = C.in[I_LRE][li], im = C.in[I_LIM][li], dt = __expf(C.in[I_LDT][(l * 2 + d) * 32 + g]);
        for (int tau = 0; tau <= 32; ++tau) { const float mag = __expf(re * dt * (float)tau), rev = im * dt * (float)tau * 0.15915494309189535f;
            POW[(d * 33 + tau) * 64 + p] = (f32x2){mag * cos_rev(rev), mag * sin_rev(rev)}; }
        const float mag = __expf(re * dt), rev = im * dt * 0.15915494309189535f; const float lr = mag * cos_rev(rev) - 1.f, lim = mag * sin_rev(rev);
        const float den = 1.f / (re * re + im * im);
        COEF[tid] = (f32x2){(lr * re + lim * im) * den, (lim * re - lr * im) * den};
    }
    __syncthreads();
    for (int i = tid; i < 2048; i += 512) {
        const int d = i >> 10, p = (i >> 4) & 63, h = i & 15; const size_t bi = (((size_t)(l * 2 + d) * 32 + g) * 64 + p) * 16 + h;
        const float br = C.in[I_BRE][bi], bi_ = C.in[I_BIM][bi]; const f32x2 cf = COEF[d * 64 + p];
        BB[i] = (f32x2){cf.x * br - cf.y * bi_, cf.x * bi_ + cf.y * br};
        const int h2 = (i >> 6) & 15, p2 = i & 63; const size_t ci = (((size_t)(l * 2 + d) * 32 + g) * 16 + h2) * 64 + p2;
        CC[i] = (f32x2){C.in[I_CRE][ci], C.in[I_CIM][ci]};
    }
    __syncthreads();
    {
        const int d = tid >> 8, h = (tid >> 4) & 15, hp = tid & 15; float acc[32];
#pragma unroll
        for (int t = 0; t < 32; ++t) acc[t] = 0.f;
        for (int p = 0; p < 64; ++p) { const f32x2 c = CC[d * 1024 + h * 64 + p], b = BB[d * 1024 + p * 16 + hp], lam = POW[(d * 33 + 1) * 64 + p];
            float xr = c.x * b.x - c.y * b.y, xi = c.x * b.y + c.y * b.x;
#pragma unroll
            for (int t = 0; t < 32; ++t) { acc[t] += xr; const float nr = xr * lam.x - xi * lam.y, ni = xr * lam.y + xi * lam.x; xr = nr; xi = ni; } }
        if (d == 1) K0[tid & 255] = acc[0];
        __syncthreads();
        if (d == 0) { acc[0] += K0[tid] + (h == hp ? C.in[I_SSMD][l * 512 + g * 16 + h] : 0.f);
#pragma unroll
            for (int t = 0; t < 32; ++t) KT[((31 + t) * 16 + h) * 16 + hp] = (bf16)f2bf(acc[t]); }
        else {
#pragma unroll
            for (int t = 1; t < 32; ++t) KT[((31 - t) * 16 + h) * 16 + hp] = (bf16)f2bf(acc[t]); }
    }
    __syncthreads();
    bf16* B1 = WSP(bf16, WS_BT1) + (size_t)g * 768 * 512; bf16* B2 = WSP(bf16, WS_BT2) + (size_t)g * 512 * 256;
    for (int i = tid; i < 128 * 64; i += 512) {
        const int n = part * 128 + (i >> 6), ch = i & 63, t = n >> 4, h = n & 15, s = ch >> 1, hp0 = (ch & 1) * 8;
        *(GAS v4u*)(B1 + (size_t)n * 512 + ch * 8) = *(const LAS v4u*)(KT + ((t - s + 31) * 16 + h) * 16 + hp0);
    }
    for (int i = tid; i < 64 * 64; i += 512) {
        const int nn = part * 64 + (i >> 6), ch = i & 63, d = nn >> 7, p = (nn & 127) >> 1, ri = nn & 1, s = ch >> 1, hp0 = (ch & 1) * 8;
        const f32x2 w = POW[(d * 33 + (d == 0 ? 31 - s : s)) * 64 + p]; float v[8];
#pragma unroll
        for (int j = 0; j < 8; ++j) { const f32x2 b = BB[d * 1024 + p * 16 + hp0 + j]; v[j] = ri == 0 ? (w.x * b.x - w.y * b.y) : (w.x * b.y + w.y * b.x); }
        v4u o; o.x = pk2(v[0], v[1]); o.y = pk2(v[2], v[3]); o.z = pk2(v[4], v[5]); o.w = pk2(v[6], v[7]);
        *(GAS v4u*)(B1 + (size_t)(512 + nn) * 512 + ch * 8) = o;
    }
    for (int i = tid; i < 128 * 32; i += 512) {
        const int n = part * 128 + (i >> 5), ch = i & 31, t = n >> 4, h = n & 15, d = ch >> 4, p0 = (ch & 15) * 4; float v[8];
#pragma unroll
        for (int j = 0; j < 4; ++j) { const f32x2 c = CC[d * 1024 + h * 64 + p0 + j], w = POW[(d * 33 + (d == 0 ? t + 1 : 32 - t)) * 64 + p0 + j];
            v[2 * j] = c.x * w.x - c.y * w.y; v[2 * j + 1] = -(c.x * w.y + c.y * w.x); }
        v4u o; o.x = pk2(v[0], v[1]); o.y = pk2(v[2], v[3]); o.z = pk2(v[4], v[5]); o.w = pk2(v[6], v[7]);
        *(GAS v4u*)(B2 + (size_t)n * 256 + ch * 8) = o;
    }
    __syncthreads();
}

template <int MODE>
__device__ __forceinline__ void phase_rows(const Ctx& C, int l) {
    const int gw = C.vcu * NWAVES + C.wave, NGW = C.G * NWAVES, lane = C.lane;
    const float* MODl = WSP(float, WS_MOD) + (size_t)(MODE == 2 ? 0 : l) * 5 * 6144;
    const float* MODp = WSP(float, WS_MOD) + (size_t)(l > 0 ? l - 1 : 0) * 5 * 6144;
    const bf16* YS = WSP(bf16, WS_YSLOT);
    f32x4 nx[4]; v2u na[4], nc[4];
#define ROWS_LOAD(mm) do { const int m_ = (mm); \
        if (MODE == 0) { const GAS f32x4* xr = (const GAS f32x4*)in_row(C, m_) + lane; _Pragma("unroll") for (int q = 0; q < 4; ++q) nx[q] = xr[64 * q]; } \
        else { const GAS f32x4* xr = (const GAS f32x4*)xs_row(C, m_) + lane; const GAS v2u* y0 = (const GAS v2u*)(YS + (size_t)(2 * m_) * D) + lane; const GAS v2u* y1 = (const GAS v2u*)(YS + (size_t)(2 * m_ + 1) * D) + lane; \
            _Pragma("unroll") for (int q = 0; q < 4; ++q) { nx[q] = xr[64 * q]; na[q] = y0[64 * q]; nc[q] = y1[64 * q]; } } } while (0)
    int m = gw; if (MODE == 2) { while (m < T && (m % LB) < CTX) m += NGW; }
    if (m < T) ROWS_LOAD(m);
    while (m < T) {
        const int b = m / LB, j = m - b * LB, cond = j < CTX ? 4 : b;
        f32x4 v[4];
        if (MODE == 0) {
#pragma unroll
            for (int q = 0; q < 4; ++q) v[q] = nx[q]; }
        else { const GAS f32x4* g2 = (const GAS f32x4*)(MODp + cond * 6144 + 5 * 1024) + lane;
#pragma unroll
            for (int q = 0; q < 4; ++q) { const f32x4 g = g2[64 * q]; const v2u a = na[q], c = nc[q];
                v[q] = nx[q] + g * (f32x4){bflo(a.x) + bflo(c.x), bfhi(a.x) + bfhi(c.x), bflo(a.y) + bflo(c.y), bfhi(a.y) + bfhi(c.y)}; } }
        int mn = m + NGW; if (MODE == 2) { while (mn < T && (mn % LB) < CTX) mn += NGW; }
        if (mn < T) ROWS_LOAD(mn);
        float ss = 0.f;
#pragma unroll
        for (int q = 0; q < 4; ++q) ss += (v[q].x * v[q].x + v[q].y * v[q].y) + (v[q].z * v[q].z + v[q].w * v[q].w);
        const float rstd = 1.f / sqrtf(wave_sum(ss, lane) * (1.f / D) + EPS);
        if (MODE == 2) { GAS f32x4* o = (GAS f32x4*)(C.out + (size_t)(b * SEQ + j - CTX) * D) + lane; const GAS f32x4* fg = (const GAS f32x4*)C.in[I_FNG] + lane;
#pragma unroll
            for (int q = 0; q < 4; ++q) o[64 * q] = v[q] * rstd * fg[64 * q]; }
        else { GAS f32x4* xo = (GAS f32x4*)xs_row(C, m) + lane; GAS v2u* ho = (GAS v2u*)(WSP(bf16, WS_HB) + (size_t)m * D) + lane; GAS unsigned* h8 = (GAS unsigned*)(WSP(unsigned char, WS_HB8) + (size_t)m * D) + lane;
            const GAS f32x4* ng = (const GAS f32x4*)(C.in[I_N1G] + l * D) + lane; const GAS f32x4* sh = (const GAS f32x4*)(MODl + cond * 6144) + lane; const GAS f32x4* sc = (const GAS f32x4*)(MODl + cond * 6144 + 1024) + lane;
#pragma unroll
            for (int q = 0; q < 4; ++q) { xo[64 * q] = v[q]; const f32x4 h = v[q] * rstd * ng[64 * q] * (sc[64 * q] + 1.f) + sh[64 * q]; if (!W8_ALL) ho[64 * q] = (v2u){pk2(h.x, h.y), pk2(h.z, h.w)}; if (H8_WRITE) h8[64 * q] = pk4_fp8(h.x, h.y, h.z, h.w); } }
        m = mn;
    }
#undef ROWS_LOAD
}

__device__ __forceinline__ void phase_qkprep(const Ctx& C, int l) {
    const int gw = C.vcu * NWAVES + C.wave, NGW = C.G * NWAVES, lane = C.lane, s8 = lane & 7;
    const float* qg = C.in[I_QNG] + l * 64 + 8 * s8; const float* kg = C.in[I_KNG] + l * 64 + 8 * s8;
    float gq[8], gk[8];
#pragma unroll
    for (int i = 0; i < 8; ++i) { gq[i] = qg[i]; gk[i] = kg[i]; }
    const int ax = s8 >> 2, f0 = 8 * (s8 & 1);
    float inv[8];
#pragma unroll
    for (int i = 0; i < 8; ++i) inv[i] = exp2f(-(float)(f0 + i) * 0.8304820237218406f) * 0.15915494309189535f;
    const int kl = lane & 15;
    v4u wq, wk;
    if (gw < T) { wq = *((const GAS v4u*)(WSP(bf16, WS_QA) + (size_t)gw * 512) + lane); wk = *((const GAS v4u*)(WSP(bf16, WS_KA) + (size_t)gw * 128) + kl); }
    for (int m = gw; m < T; m += NGW) {
        const int b = m / LB, j = m - b * LB; const bool lat = j >= CTX; const int tt = j - CTX; const float pos = (float)(ax == 0 ? (tt >> 6) : (tt & 63));
        const v4u cq = wq, ck = wk;
        if (m + NGW < T) { wq = *((const GAS v4u*)(WSP(bf16, WS_QA) + (size_t)(m + NGW) * 512) + lane); wk = *((const GAS v4u*)(WSP(bf16, WS_KA) + (size_t)(m + NGW) * 128) + kl); }
        float cs[8], sn[8];
#pragma unroll
        for (int i = 0; i < 8; ++i) { cs[i] = lat ? cos_rev(pos * inv[i]) : 1.f; sn[i] = lat ? sin_rev(pos * inv[i]) : 0.f; }
#pragma unroll
        for (int which = 0; which < 2; ++which) {
            const v4u w = which == 0 ? cq : ck; float x[8] = {bflo(w.x), bfhi(w.x), bflo(w.y), bfhi(w.y), bflo(w.z), bfhi(w.z), bflo(w.w), bfhi(w.w)};
            float ss = 0.f;
#pragma unroll
            for (int i = 0; i < 8; ++i) ss += x[i] * x[i];
            ss += dpp_mov<0xB1, 0xF>(ss); ss += dpp_mov<0x4E, 0xF>(ss); ss += dpp_mov<0x141, 0xF>(ss);
            const float rstd = 1.f / sqrtf(ss * (1.f / 64.f) + EPS);
            float y[8];
#pragma unroll
            for (int i = 0; i < 8; ++i) { const float xn = x[i] * rstd * (which == 0 ? gq[i] : gk[i]); const float other = dpp_mov<0x4E, 0xF>(xn);
                y[i] = (s8 & 2) ? (xn * cs[i] + other * sn[i]) : (xn * cs[i] - other * sn[i]); }
            const float sc = which == 0 ? C2 : 1.f;
            v4u o; o.x = pk2(y[0] * sc, y[1] * sc); o.y = pk2(y[2] * sc, y[3] * sc); o.z = pk2(y[4] * sc, y[5] * sc); o.w = pk2(y[6] * sc, y[7] * sc);
            if (which == 0) *((GAS v4u*)(WSP(bf16, WS_QA) + (size_t)m * 512) + lane) = o;
            else if (lane < 16) *((GAS v4u*)(WSP(bf16, WS_KA) + (size_t)m * 128) + lane) = o;
        }
    }
}

__device__ __forceinline__ void phase_carry(const Ctx& C, int l) {
    if (C.vcu >= 32) return;
    const int b = C.vcu >> 3, g = (C.vcu & 7) * 4 + (C.wave >> 1), d = C.wave & 1, p = C.lane;
    const int li = ((l * 2 + d) * 32 + g) * 64 + p;
    const float re = C.in[I_LRE][li], im = C.in[I_LIM][li], dt = __expf(C.in[I_LDT][(l * 2 + d) * 32 + g]);
    const float mag = __expf(re * dt * 32.f), rev = im * dt * 32.f * 0.15915494309189535f; const float Lr = mag * cos_rev(rev), Li = mag * sin_rev(rev);
    const GAS f32x2* S = (const GAS f32x2*)(WSP(float, WS_SST) + (size_t)(b * NCH) * 8192 + g * 256 + d * 128) + p;
    GAS unsigned* X = (GAS unsigned*)(WSP(bf16, WS_XST) + (size_t)(b * NCH) * 8192 + g * 256 + d * 128) + p;
    float sr = 0.f, si = 0.f;
    if (d == 0) {
        for (int c0 = 0; c0 < NCH; c0 += 8) { f32x2 s[8];
#pragma unroll
            for (int k = 0; k < 8; ++k) s[k] = S[(size_t)(c0 + k) * 4096];
#pragma unroll
            for (int k = 0; k < 8; ++k) { X[(size_t)(c0 + k) * 4096] = pk2(sr, si); const float nr = Lr * sr - Li * si + s[k].x, ni = Lr * si + Li * sr + s[k].y; sr = nr; si = ni; } }
    } else {
        for (int seg = 0; seg < 33; ++seg) { const int chi = seg == 0 ? 7 : NCH - 1 - (seg - 1) * 8; f32x2 s[8];
#pragma unroll
            for (int k = 0; k < 8; ++k) s[k] = S[(size_t)(chi - k) * 4096];
#pragma unroll
            for (int k = 0; k < 8; ++k) { X[(size_t)(chi - k) * 4096] = pk2(sr, si); const float nr = Lr * sr - Li * si + s[k].x, ni = Lr * si + Li * sr + s[k].y; sr = nr; si = ni; } }
    }
}

__device__ __forceinline__ void phase_norm2(const Ctx& C, int l) {
    LAS float* RWt = (LAS float*)C.lds;
    LAS unsigned* REC = (LAS unsigned*)(C.lds + 65536);
    LAS float* LG = (LAS float*)(C.lds + 65536 + 16384);
    LAS unsigned* LCNT = (LAS unsigned*)(C.lds + 65536 + 32768);
    const int lane = C.lane, tid = C.tid;
    for (int i = tid; i < 16384; i += 512) { const int k = i >> 4, e = i & 15; RWt[e * 1024 + k] = C.in[I_RW][i]; }
    if (tid < 32) LCNT[tid] = 0u;
    __syncthreads();
    const float* MODl = WSP(float, WS_MOD) + (size_t)l * 5 * 6144;
    int nrows = 0; for (int m = C.vcu; m < T; m += C.G) ++nrows;
    f32x4 nx[4];
    if (C.wave < nrows) { const GAS f32x4* xr = (const GAS f32x4*)xs_row(C, C.vcu + C.G * C.wave) + lane;
#pragma unroll
        for (int q = 0; q < 4; ++q) nx[q] = xr[64 * q]; }
    for (int i = C.wave; i < nrows; i += NWAVES) {
        const int m = C.vcu + C.G * i, cond = cond_of(m);
        GAS unsigned* h8 = (GAS unsigned*)(WSP(unsigned char, WS_HB8) + (size_t)m * D) + lane; GAS v2u* ho = (GAS v2u*)(WSP(bf16, WS_HB) + (size_t)m * D) + lane;
        const GAS f32x4* ng = (const GAS f32x4*)(C.in[I_N2G] + l * D) + lane; const GAS f32x4* sh = (const GAS f32x4*)(MODl + cond * 6144 + 3072) + lane; const GAS f32x4* sc = (const GAS f32x4*)(MODl + cond * 6144 + 4096) + lane;
        f32x4 v[4]; float ss = 0.f;
#pragma unroll
        for (int q = 0; q < 4; ++q) { v[q] = nx[q]; ss += (v[q].x * v[q].x + v[q].y * v[q].y) + (v[q].z * v[q].z + v[q].w * v[q].w); }
        if (i + NWAVES < nrows) { const GAS f32x4* xr = (const GAS f32x4*)xs_row(C, m + C.G * NWAVES) + lane;
#pragma unroll
            for (int q = 0; q < 4; ++q) nx[q] = xr[64 * q]; }
        const float rstd = 1.f / sqrtf(wave_sum(ss, lane) * (1.f / D) + EPS);
        float lg[16];
#pragma unroll
        for (int e = 0; e < 16; ++e) lg[e] = 0.f;
#pragma unroll
        for (int q = 0; q < 4; ++q) { const f32x4 h = v[q] * rstd * ng[64 * q] * (sc[64 * q] + 1.f) + sh[64 * q]; if (FP8_MOE) h8[64 * q] = pk4_fp8(h.x, h.y, h.z, h.w); else ho[64 * q] = (v2u){pk2(h.x, h.y), pk2(h.z, h.w)};
#pragma unroll
            for (int e = 0; e < 16; ++e) { const f32x4 w = *(const LAS f32x4*)(RWt + e * 1024 + 256 * q + 4 * lane); lg[e] += (h.x * w.x + h.y * w.y) + (h.z * w.z + h.w * w.w); } }
        float mine = 0.f;
#pragma unroll
        for (int e = 0; e < 16; ++e) { const float t = wave_sum(lg[e], lane); mine = lane == e ? t : mine; }
        if (lane < 16) LG[i * 16 + lane] = mine;
    }
    __syncthreads();
    float rb[16];
#pragma unroll
    for (int e = 0; e < 16; ++e) rb[e] = C.in[I_RB][e];
    for (int i = tid; i < nrows; i += 512) {
        float lg[16];
#pragma unroll
        for (int q = 0; q < 4; ++q) { const f32x4 t = *(const LAS f32x4*)(LG + i * 16 + 4 * q); lg[4 * q] = t.x; lg[4 * q + 1] = t.y; lg[4 * q + 2] = t.z; lg[4 * q + 3] = t.w; }
        float mx = lg[0];
#pragma unroll
        for (int e = 1; e < 16; ++e) mx = fmaxf(mx, lg[e]);
        float pr[16], sel[16], sum = 0.f;
#pragma unroll
        for (int e = 0; e < 16; ++e) { pr[e] = __expf(lg[e] - mx); sum += pr[e]; }
        const float rs = 1.f / sum;
#pragma unroll
        for (int e = 0; e < 16; ++e) { pr[e] *= rs; sel[e] = pr[e] + rb[e]; }
        float bestv = -1e30f; int best = 0;
#pragma unroll
        for (int gq = 0; gq < 4; ++gq) { float m1 = -1e30f, m2 = -1e30f;
#pragma unroll
            for (int k = 0; k < 4; ++k) { const float s_ = sel[4 * gq + k]; if (s_ > m1) { m2 = m1; m1 = s_; } else if (s_ > m2) m2 = s_; }
            const float gs = m1 + m2; if (gs > bestv) { bestv = gs; best = gq; } }
        float s4[4], p4[4];
#pragma unroll
        for (int k = 0; k < 4; ++k) { s4[k] = best == 0 ? sel[k] : best == 1 ? sel[4 + k] : best == 2 ? sel[8 + k] : sel[12 + k]; p4[k] = best == 0 ? pr[k] : best == 1 ? pr[4 + k] : best == 2 ? pr[8 + k] : pr[12 + k]; }
        int i0 = 0; float v0 = s4[0], q0 = p4[0];
#pragma unroll
        for (int k = 1; k < 4; ++k) if (s4[k] > v0) { v0 = s4[k]; i0 = k; q0 = p4[k]; }
        int i1 = i0 == 0 ? 1 : 0; float v1 = -1e30f, q1 = p4[i0 == 0 ? 1 : 0];
#pragma unroll
        for (int k = 0; k < 4; ++k) if (k != i0 && s4[k] > v1) { v1 = s4[k]; i1 = k; q1 = p4[k]; }
        const int e0 = 4 * best + i0, e1 = 4 * best + i1; const float wn = 1.f / (q0 + q1);
        const unsigned lp0 = atomicAdd((unsigned*)(LCNT + e0), 1u), lp1 = atomicAdd((unsigned*)(LCNT + e1), 1u);
        REC[i * 4 + 0] = (unsigned)e0 | ((unsigned)e1 << 8) | (lp0 << 16); REC[i * 4 + 1] = lp1; REC[i * 4 + 2] = __float_as_uint(q0 * wn); REC[i * 4 + 3] = __float_as_uint(q1 * wn);
    }
    __syncthreads();
    if (tid < 16) LCNT[16 + tid] = __hip_atomic_fetch_add((unsigned*)(C.ctl + CW_CNT + l * 1024 + 64 * tid), LCNT[tid], RLX_AGENT);
    __syncthreads();
    int* LIST = WSP(int, WS_LIST); float* RWG = WSP(float, WS_RW);
    for (int i = tid; i < nrows; i += 512) { const int m = C.vcu + C.G * i; const unsigned r0 = REC[i * 4], r1 = REC[i * 4 + 1];
        const int e0 = r0 & 255, e1 = (r0 >> 8) & 255; const unsigned lp0 = r0 >> 16, lp1 = r1;
        LIST[(size_t)e0 * T + LCNT[16 + e0] + lp0] = 2 * m; LIST[(size_t)e1 * T + LCNT[16 + e1] + lp1] = 2 * m + 1;
        RWG[2 * m] = __uint_as_float(REC[i * 4 + 2]); RWG[2 * m + 1] = __uint_as_float(REC[i * 4 + 3]); }
    __syncthreads();
}
using pg8::Unit;
typedef f32x4 Acc[2][2][4][2];
__device__ __forceinline__ v4u pack8(const f32x4& a, const f32x4& b) { v4u w; w.x = cvt_pk_bf16(a[0], a[1]); w.y = cvt_pk_bf16(a[2], a[3]); w.z = cvt_pk_bf16(b[0], b[1]); w.w = cvt_pk_bf16(b[2], b[3]); return w; }
__device__ __forceinline__ void unpack8(const v4u& w, f32x4& a, f32x4& b) { a = (f32x4){bflo(w.x), bfhi(w.x), bflo(w.y), bfhi(w.y)}; b = (f32x4){bflo(w.z), bfhi(w.z), bflo(w.w), bfhi(w.w)}; }
#ifndef WT_MODE
#define WT_MODE 0
#endif
__device__ __forceinline__ void st16(void* p, const v4u& v) {
#if WT_MODE == 1
    asm volatile("global_store_dwordx4 %0, %1, off sc0 sc1" :: "v"(p), "v"(v) : "memory");
#elif WT_MODE == 2
    asm volatile("global_store_dwordx4 %0, %1, off nt" :: "v"(p), "v"(v) : "memory");
#else
    *(GAS v4u*)p = v;
#endif
}
__device__ __forceinline__ int chunk_m0(int cr) { return (cr / NCH) * LB + (cr % NCH) * 32; }

struct PWin {
    static constexpr bool EARLY_AOFF = false, FP8 = false; unsigned char* ws; int G, c; int K; unsigned kstepA;
    __device__ __forceinline__ bool next(int i, Unit& u) const { const long L = (long)i * G + c; if (L >= NPAN * 11) return false; pg8::static_decode((int)L, NPAN, 11, u.pm, u.pn); u.z = 0; return true; }
    __device__ __forceinline__ const char* a_base(const Unit& u) const { return (const char*)(ws + WS_HB) + (size_t)u.pm * 256 * 1024 * 2; }
    __device__ __forceinline__ unsigned a_off(const Unit&, int h, int R, int Cc) const { return (unsigned)((h * 128 + R) * 1024 + Cc) * 2u; }
    __device__ __forceinline__ const char* b_base(const Unit& u) const { return (const char*)(ws + WS_WIN) + (size_t)u.pn * 256 * 1024 * 2; }
    __device__ __forceinline__ void epi(const Acc& acc, const Unit& u, int wr, int wc, int fr, int fq) const {
        const int row0 = u.pm * 256 + wr * 64 + fr;
#pragma unroll
        for (int bj = 0; bj < 2; ++bj) {
            const int cb = u.pn * 256 + bj * 128; bf16* dst; int ld, col, mode = 0; float sc = 1.f;
            if (cb < 512) { dst = (bf16*)(ws + WS_U) + ((size_t)((cb + wc * 32 + 8 * fq) >> 4) * T) * 16 + ((8 * fq) & 15) - (wc * 32 + 8 * fq); ld = 16; col = 0; }
            else if (cb < 1024) { dst = (bf16*)(ws + WS_QA); ld = 512; col = cb - 512; }
            else if (cb == 1024) { dst = (bf16*)(ws + WS_KA); ld = 128; col = 0; }
            else if (cb == 1152) { dst = (bf16*)(ws + WS_VA); ld = 128; col = 0; }
            else if (cb < 1792) { dst = (bf16*)(ws + WS_QN); ld = 512; col = cb - 1280; sc = C2; }
            else if (cb < 2304) { dst = (bf16*)(ws + WS_KN); ld = 512; col = cb - 1792; }
            else { dst = (bf16*)(ws + WS_VN); ld = 512; col = cb - 2304; }
            const int c0 = col + wc * 32 + 8 * fq;
#pragma unroll
            for (int ai = 0; ai < 2; ++ai)
#pragma unroll
                for (int m = 0; m < 4; ++m) { f32x4 v0 = acc[ai][bj][m][0], v1 = acc[ai][bj][m][1];
                    if (mode) { v0 = (f32x4){fsigmoid(v0[0]), fsigmoid(v0[1]), fsigmoid(v0[2]), fsigmoid(v0[3])}; v1 = (f32x4){fsigmoid(v1[0]), fsigmoid(v1[1]), fsigmoid(v1[2]), fsigmoid(v1[3])}; }
                    else { v0 = v0 * sc; v1 = v1 * sc; }
                    st16(dst + (size_t)(row0 + ai * 128 + m * 16) * ld + c0, pack8(v0, v1)); __builtin_amdgcn_sched_barrier(0); }
        }
    }
};

struct PWin8 {
    static constexpr bool EARLY_AOFF = false, FP8 = true; unsigned char* ws; int G, c; int K; unsigned kstepA;
    __device__ __forceinline__ bool next(int i, Unit& u) const { const long L = (long)i * G + c; if (L >= 2 * NPAN * 23) return false; pg8::static_decode((int)L, 2 * NPAN, 23, u.pm, u.pn); u.z = 0; return true; }
    __device__ __forceinline__ const char* a_base(const Unit& u) const { return (const char*)(ws + WS_HB8) + (size_t)u.pm * 128 * 1024; }
    __device__ __forceinline__ unsigned a_off(const Unit&, int R, int Cc) const { return (unsigned)(R * 1024 + Cc * 2); }
    __device__ __forceinline__ const char* b_base(const Unit& u) const { return (const char*)(ws + WS_WIN) + (size_t)u.pn * 256 * 1024; }
    __device__ __forceinline__ void epi(const f32x4 (&acc)[2][4][2], f32x4 (&)[2][4][2], const Unit& u, int wr, int wc, int fr, int fq) const {
        const int row0 = u.pm * 128 + wr * 64 + fr;
#pragma unroll
        for (int bj = 0; bj < 2; ++bj) {
            const int cb = u.pn * 256 + bj * 128;
            if (cb >= 2816) { const int c0 = cb - 2816 + wc * 32 + 8 * fq;
#pragma unroll
                for (int m = 0; m < 4; ++m) { f32x4 v0 = acc[bj][m][0] * (1.f / 64.f), v1 = acc[bj][m][1] * (1.f / 64.f);
                    v0 = (f32x4){fsigmoid(v0[0]), fsigmoid(v0[1]), fsigmoid(v0[2]), fsigmoid(v0[3])}; v1 = (f32x4){fsigmoid(v1[0]), fsigmoid(v1[1]), fsigmoid(v1[2]), fsigmoid(v1[3])};
                    *(GAS v2u*)((unsigned char*)(ws + WS_GATES) + (size_t)(row0 + m * 16) * 3072 + c0) = (v2u){pk4_fp8(v0[0], v0[1], v0[2], v0[3]), pk4_fp8(v1[0], v1[1], v1[2], v1[3])}; }
            } else {
                bf16* dst; int ld, col; float sc = 1.f / 64.f;
                if (cb < 512) { dst = (bf16*)(ws + WS_U) + ((size_t)((cb + wc * 32 + 8 * fq) >> 4) * T) * 16 + ((8 * fq) & 15) - (wc * 32 + 8 * fq); ld = 16; col = 0; }
                else if (cb < 1024) { dst = (bf16*)(ws + WS_QA); ld = 512; col = cb - 512; }
                else if (cb == 1024) { dst = (bf16*)(ws + WS_KA); ld = 128; col = 0; }
                else if (cb == 1152) { dst = (bf16*)(ws + WS_VA); ld = 128; col = 0; }
                else if (cb < 1792) { dst = (bf16*)(ws + WS_QN); ld = 512; col = cb - 1280; sc = C2 / 64.f; }
                else if (cb < 2304) { dst = (bf16*)(ws + WS_KN); ld = 512; col = cb - 1792; }
                else { dst = (bf16*)(ws + WS_VN); ld = 512; col = cb - 2304; }
                const int c0 = col + wc * 32 + 8 * fq;
#pragma unroll
                for (int m = 0; m < 4; ++m) *(GAS v4u*)(dst + (size_t)(row0 + m * 16) * ld + c0) = pack8(acc[bj][m][0] * sc, acc[bj][m][1] * sc);
            }
        }
    }
};

struct PGate {
    static constexpr bool EARLY_AOFF = false, FP8 = !GATE_BF16; unsigned char* ws; int G, c; int K; unsigned kstepA;
    __device__ __forceinline__ bool next(int i, Unit& u) const { const long L = (long)i * G + c; if (L >= 2 * NPAN * 12) return false; pg8::static_decode((int)L, 2 * NPAN, 12, u.pm, u.pn); u.z = 0; return true; }
    __device__ __forceinline__ const char* a_base(const Unit& u) const { return GATE_BF16 ? (const char*)(ws + WS_HB) + (size_t)u.pm * 128 * 2048 : (const char*)(ws + WS_HB8) + (size_t)u.pm * 128 * 1024; }
    __device__ __forceinline__ unsigned a_off(const Unit&, int R, int Cc) const { return GATE_BF16 ? (unsigned)(R * 2048 + Cc * 2) : (unsigned)(R * 1024 + Cc * 2); }
    __device__ __forceinline__ const char* b_base(const Unit& u) const { return GATE_BF16 ? (const char*)(ws + WS_WIN) + (size_t)(2816 + u.pn * 256) * 2048 : (const char*)(ws + WS_WIN8) + (size_t)u.pn * 256 * 1024; }
    __device__ __forceinline__ void epi(const f32x4 (&acc)[2][4][2], f32x4 (&)[2][4][2], const Unit& u, int wr, int wc, int fr, int fq) const {
#pragma unroll
        for (int m = 0; m < 4; ++m) { const size_t r = (size_t)(u.pm * 128 + wr * 64 + m * 16 + fr);
#pragma unroll
            for (int bj = 0; bj < 2; ++bj) { const int c0 = u.pn * 256 + bj * 128 + wc * 32 + 8 * fq; f32x4 v0 = acc[bj][m][0] * (GATE_BF16 ? 1.f : 1.f / 64.f), v1 = acc[bj][m][1] * (GATE_BF16 ? 1.f : 1.f / 64.f);
                v0 = (f32x4){fsigmoid(v0[0]), fsigmoid(v0[1]), fsigmoid(v0[2]), fsigmoid(v0[3])}; v1 = (f32x4){fsigmoid(v1[0]), fsigmoid(v1[1]), fsigmoid(v1[2]), fsigmoid(v1[3])};
                if (GATE_BF16) *(GAS v4u*)((bf16*)(ws + WS_GATES) + r * 3072 + c0) = pack8(v0, v1);
                else *(GAS v2u*)((unsigned char*)(ws + WS_GATES) + r * 3072 + c0) = (v2u){pk4_fp8(v0[0], v0[1], v0[2], v0[3]), pk4_fp8(v1[0], v1[1], v1[2], v1[3])}; }
            __builtin_amdgcn_sched_barrier(0); }
    }
};

struct PS5A {
    static constexpr bool EARLY_AOFF = false, FP8 = false; unsigned char* ws; int G, c; int K; unsigned kstepA;
    __device__ __forceinline__ bool next(int i, Unit& u) const { const long L = (long)i * G + c; if (L >= 32 * 15) return false; const int l = (int)L; u.z = l / 15; const int r = l % 15; u.pm = r / 3; u.pn = r % 3; return true; }
    __device__ __forceinline__ const char* a_base(const Unit& u) const { return (const char*)(ws + WS_U) + (size_t)u.z * T * 32; }
    __device__ __forceinline__ unsigned a_off(const Unit& u, int h, int R, int Cc) const { int cr = u.pm * 256 + h * 128 + R; cr = cr < NCR ? cr : NCR - 1; return (unsigned)(cr * 512 + Cc) * 2u; }
    __device__ __forceinline__ const char* b_base(const Unit& u) const { return (const char*)(ws + WS_BT1) + ((size_t)u.z * 768 + u.pn * 256) * 512 * 2; }
    __device__ __forceinline__ void epi(const Acc& acc, const Unit& u, int wr, int wc, int fr, int fq) const {
#pragma unroll
        for (int ai = 0; ai < 2; ++ai)
#pragma unroll
            for (int m = 0; m < 4; ++m) { const int cr = u.pm * 256 + ai * 128 + wr * 64 + m * 16 + fr; if (cr >= NCR) continue;
#pragma unroll
                for (int bj = 0; bj < 2; ++bj) { const int n = bj * 128 + wc * 32 + 8 * fq;
                    if (u.pn < 2) *(GAS v4u*)((bf16*)(ws + WS_YG) + (size_t)u.z * T * 16 + (size_t)cr * 512 + u.pn * 256 + n) = pack8(acc[ai][bj][m][0], acc[ai][bj][m][1]);
                    else { GAS f32x4* o = (GAS f32x4*)((float*)(ws + WS_SST) + (size_t)cr * 8192 + u.z * 256 + n); o[0] = acc[ai][bj][m][0]; o[1] = acc[ai][bj][m][1]; } }
                __builtin_amdgcn_sched_barrier(0); }
    }
};

struct PS5B {
    static constexpr bool EARLY_AOFF = false, FP8 = false; unsigned char* ws; int G, c; int K; unsigned kstepA;
    __device__ __forceinline__ bool next(int i, Unit& u) const { const long L = (long)i * G + c; if (L >= 32 * 10) return false; const int l = (int)L; u.z = l / 10; const int r = l % 10; u.pm = r / 2; u.pn = r % 2; return true; }
    __device__ __forceinline__ const char* a_base(const Unit& u) const { return (const char*)(ws + WS_XST) + (size_t)u.z * 512; }
    __device__ __forceinline__ unsigned a_off(const Unit& u, int h, int R, int Cc) const { int cr = u.pm * 256 + h * 128 + R; cr = cr < NCR ? cr : NCR - 1; return (unsigned)(cr * 8192 + Cc) * 2u; }
    __device__ __forceinline__ const char* b_base(const Unit& u) const { return (const char*)(ws + WS_BT2) + ((size_t)u.z * 512 + u.pn * 256) * 256 * 2; }
    __device__ __forceinline__ void epi(const Acc& acc, const Unit& u, int wr, int wc, int fr, int fq) const {
#pragma unroll
        for (int ai = 0; ai < 2; ++ai) {
            v4u yw[4][2];
#pragma unroll
            for (int m = 0; m < 4; ++m) { int cr = u.pm * 256 + ai * 128 + wr * 64 + m * 16 + fr; cr = cr < NCR ? cr : NCR - 1;
#pragma unroll
                for (int bj = 0; bj < 2; ++bj) yw[m][bj] = *(const GAS v4u*)((const bf16*)(ws + WS_YG) + (size_t)u.z * T * 16 + (size_t)cr * 512 + u.pn * 256 + bj * 128 + wc * 32 + 8 * fq); }
#pragma unroll
            for (int m = 0; m < 4; ++m) { const int cr = u.pm * 256 + ai * 128 + wr * 64 + m * 16 + fr; if (cr >= NCR) continue;
#pragma unroll
                for (int bj = 0; bj < 2; ++bj) { const int nn = u.pn * 256 + bj * 128 + wc * 32 + 8 * fq, t = nn >> 4, h0 = nn & 15;
                    GAS v4u* p = (GAS v4u*)((bf16*)(ws + WS_YS) + (size_t)(chunk_m0(cr) + t) * 512 + u.z * 16 + h0);
                    f32x4 y0, y1; { const v4u w_ = yw[m][bj]; unpack8(w_, y0, y1); } y0 += acc[ai][bj][m][0]; y1 += acc[ai][bj][m][1];
                    y0 = (f32x4){gelu_tanh(y0[0]), gelu_tanh(y0[1]), gelu_tanh(y0[2]), gelu_tanh(y0[3])}; y1 = (f32x4){gelu_tanh(y1[0]), gelu_tanh(y1[1]), gelu_tanh(y1[2]), gelu_tanh(y1[3])};
                    *p = pack8(y0, y1); } } }
    }
};

__device__ __forceinline__ int half_panel(int hl, bool lat_only) { if (!lat_only) return hl; const int pl = hl >> 1; return 2 * (pl + (pl >> 5) + 1) + (hl & 1); }
struct PGlu {
    static constexpr bool EARLY_AOFF = false, FP8 = false; unsigned char* ws; int G, c; int K; unsigned kstepA; bool lat_only;
    __device__ __forceinline__ bool next(int i, Unit& u) const { const int nH = lat_only ? 256 : 2 * NPAN; const long L = (long)i * G + c; if (L >= nH * 2) return false; pg8::static_decode((int)L, nH, 2, u.pm, u.pn); u.pm = half_panel(u.pm, lat_only); u.z = 0; return true; }
    __device__ __forceinline__ const char* a_base(const Unit& u) const { return (const char*)(ws + WS_YS) + (size_t)u.pm * 128 * 512 * 2; }
    __device__ __forceinline__ unsigned a_off(const Unit&, int R, int Cc) const { return (unsigned)(R * 512 + Cc) * 2u; }
    __device__ __forceinline__ const char* b_base(const Unit& u) const { return (const char*)(ws + WS_WGLU) + (size_t)u.pn * 256 * 512 * 2; }
    __device__ __forceinline__ void epi(const f32x4 (&acc)[2][4][2], f32x4 (&)[2][4][2], const Unit& u, int wr, int wc, int fr, int fq) const {
        v4u zw[4][2];
#pragma unroll
        for (int m = 0; m < 4; ++m)
#pragma unroll
            for (int bj = 0; bj < 2; ++bj) zw[m][bj] = *(const GAS v4u*)((const bf16*)(ws + WS_YS) + (size_t)(u.pm * 128 + wr * 64 + m * 16 + fr) * 512 + u.pn * 256 + bj * 128 + wc * 32 + 8 * fq);
#pragma unroll
        for (int m = 0; m < 4; ++m) { const size_t r = (size_t)(u.pm * 128 + wr * 64 + m * 16 + fr);
#pragma unroll
            for (int bj = 0; bj < 2; ++bj) { const int cc = u.pn * 256 + bj * 128 + wc * 32 + 8 * fq;
                f32x4 z0, z1; { const v4u w_ = zw[m][bj]; unpack8(w_, z0, z1); } const f32x4 a0 = acc[bj][m][0], a1 = acc[bj][m][1];
                z0 = z0 * (f32x4){fsigmoid(a0[0]), fsigmoid(a0[1]), fsigmoid(a0[2]), fsigmoid(a0[3])}; z1 = z1 * (f32x4){fsigmoid(a1[0]), fsigmoid(a1[1]), fsigmoid(a1[2]), fsigmoid(a1[3])};
                *(GAS v4u*)((bf16*)(ws + WS_U) + r * 512 + cc) = pack8(z0, z1); } }
    }
};

typedef f32x4 Acc128[2][4][2];
struct PMerge {
    static constexpr bool EARLY_AOFF = false, FP8 = false; unsigned char* ws; int G, c; int K; unsigned kstepA; bool lat_only;
    __device__ __forceinline__ bool next(int i, Unit& u) const { const int nH = lat_only ? 256 : 2 * NPAN; const long tile = (long)(i / 3) * G + c; if (tile >= nH * 4) return false; pg8::static_decode((int)tile, nH, 4, u.pm, u.pn); u.pm = half_panel(u.pm, lat_only); u.z = i % 3; return true; }
    __device__ __forceinline__ const char* a_base(const Unit& u) const { const size_t off = u.z == 0 ? WS_U : (u.z == 1 ? WS_AO : WS_NO); return (const char*)(ws + off) + (size_t)u.pm * 128 * 512 * 2; }
    __device__ __forceinline__ unsigned a_off(const Unit&, int R, int Cc) const { return (unsigned)(R * 512 + Cc) * 2u; }
    __device__ __forceinline__ const char* b_base(const Unit& u) const { return (const char*)(ws + WS_WBR) + ((size_t)u.z * 1024 + u.pn * 256) * 512 * 2; }
    __device__ __forceinline__ void epi(const Acc128& acc, Acc128& mrg, const Unit& u, int wr, int wc, int fr, int fq) const {
        v2u gw[4][2];
#pragma unroll
        for (int m = 0; m < 4; ++m)
#pragma unroll
            for (int bj = 0; bj < 2; ++bj) gw[m][bj] = *(const GAS v2u*)((const unsigned char*)(ws + WS_GATES) + (size_t)(u.pm * 128 + wr * 64 + m * 16 + fr) * 3072 + u.z * 1024 + u.pn * 256 + bj * 128 + wc * 32 + 8 * fq);
#pragma unroll
        for (int m = 0; m < 4; ++m) { const size_t r = (size_t)(u.pm * 128 + wr * 64 + m * 16 + fr);
#pragma unroll
            for (int bj = 0; bj < 2; ++bj) { const int cc = u.pn * 256 + bj * 128 + wc * 32 + 8 * fq; const v2u w_ = gw[m][bj];
                const f32x4 g0 = (f32x4){__builtin_amdgcn_cvt_f32_fp8((int)w_.x, 0), __builtin_amdgcn_cvt_f32_fp8((int)w_.x, 1), __builtin_amdgcn_cvt_f32_fp8((int)w_.x, 2), __builtin_amdgcn_cvt_f32_fp8((int)w_.x, 3)};
                const f32x4 g1 = (f32x4){__builtin_amdgcn_cvt_f32_fp8((int)w_.y, 0), __builtin_amdgcn_cvt_f32_fp8((int)w_.y, 1), __builtin_amdgcn_cvt_f32_fp8((int)w_.y, 2), __builtin_amdgcn_cvt_f32_fp8((int)w_.y, 3)};
                if (u.z == 0) { mrg[bj][m][0] = g0 * acc[bj][m][0]; mrg[bj][m][1] = g1 * acc[bj][m][1]; }
                else { mrg[bj][m][0] += g0 * acc[bj][m][0]; mrg[bj][m][1] += g1 * acc[bj][m][1]; }
                if (u.z == 2) *(GAS v4u*)((bf16*)(ws + WS_HB) + r * 1024 + cc) = pack8(mrg[bj][m][0], mrg[bj][m][1]); } }
    }
};

struct PWout {
    static constexpr bool EARLY_AOFF = false, FP8 = false; unsigned char* ws; float* out; const float* mod; int G, c; int K; unsigned kstepA; bool lat_only;
    __device__ __forceinline__ bool next(int i, Unit& u) const { const int nH = lat_only ? 256 : 2 * NPAN; const long L = (long)i * G + c; if (L >= nH * 4) return false; pg8::static_decode((int)L, nH, 4, u.pm, u.pn); u.pm = half_panel(u.pm, lat_only); u.z = 0; return true; }
    __device__ __forceinline__ const char* a_base(const Unit& u) const { return (const char*)(ws + WS_HB) + (size_t)u.pm * 128 * 1024 * 2; }
    __device__ __forceinline__ unsigned a_off(const Unit&, int R, int Cc) const { return (unsigned)(R * 1024 + Cc) * 2u; }
    __device__ __forceinline__ const char* b_base(const Unit& u) const { return (const char*)(ws + WS_WOUT) + (size_t)u.pn * 256 * 1024 * 2; }
    __device__ __forceinline__ void epi(const f32x4 (&acc)[2][4][2], f32x4 (&)[2][4][2], const Unit& u, int wr, int wc, int fr, int fq) const {
        const int pm = u.pm >> 1, hh = u.pm & 1, b = pm / 33, pr = pm % 33, cond = pr == 0 ? 4 : b;
        float* xb = pr == 0 ? (float*)(ws + WS_CTXS) + ((size_t)b * 256 + hh * 128) * D : out + ((size_t)b * SEQ + (size_t)(pr - 1) * 256 + hh * 128) * D;
        const float* g1 = mod + cond * 6144 + 2048;
        f32x4 xv[2][4][2];
#pragma unroll
        for (int bj = 0; bj < 2; ++bj)
#pragma unroll
            for (int m = 0; m < 4; ++m) { const GAS f32x4* p = (const GAS f32x4*)(xb + (size_t)(wr * 64 + m * 16 + fr) * D + u.pn * 256 + bj * 128 + wc * 32 + 8 * fq); xv[bj][m][0] = p[0]; xv[bj][m][1] = p[1]; }
#pragma unroll
        for (int bj = 0; bj < 2; ++bj) { const int cc = u.pn * 256 + bj * 128 + wc * 32 + 8 * fq; const f32x4 ga = *(const GAS f32x4*)(g1 + cc), gb = *(const GAS f32x4*)(g1 + cc + 4);
#pragma unroll
            for (int m = 0; m < 4; ++m) { GAS f32x4* p = (GAS f32x4*)(xb + (size_t)(wr * 64 + m * 16 + fr) * D + cc);
                p[0] = xv[bj][m][0] + ga * acc[bj][m][0]; p[1] = xv[bj][m][1] + gb * acc[bj][m][1]; } }
    }
};

struct ExpTab { int cnt[16], tile0[17]; };
__device__ __forceinline__ int exp_find(const int (&tile0)[17], int q) { int e = 0;
#pragma unroll
    for (int k = 1; k < 16; ++k) e += (q >= tile0[k]) ? 1 : 0;
    return e; }

struct PMoe1 {
    static constexpr bool EARLY_AOFF = true, FP8 = true; unsigned char* ws; const LAS int* tab; int G, c; int K; unsigned kstepA;
    __device__ __forceinline__ bool next(int i, Unit& u) const { const long L = (long)i * G + c; const int total = __builtin_amdgcn_readfirstlane(tab[32]) * 4; if (L >= total) return false; const int q = (int)L >> 2; u.pn = (int)L & 3;
        int e = 0;
#pragma unroll
        for (int k = 1; k < 16; ++k) e += (q >= __builtin_amdgcn_readfirstlane(tab[16 + k])) ? 1 : 0;
        u.z = e; u.pm = q - __builtin_amdgcn_readfirstlane(tab[16 + e]); return true; }
    __device__ __forceinline__ const char* a_base(const Unit&) const { return (const char*)(ws + WS_HB8); }
    __device__ __forceinline__ unsigned a_off(const Unit& u, int R, int Cc) const { int r = u.pm * 128 + R; const int n = __builtin_amdgcn_readfirstlane(tab[u.z]); r = r < n ? r : n - 1;
        const int ent = ((const int*)(ws + WS_LIST))[(size_t)u.z * T + r]; return (unsigned)((ent >> 1) * 1024 + Cc * 2); }
    __device__ __forceinline__ const char* b_base(const Unit& u) const { return (const char*)(ws + WS_MOE1) + ((size_t)u.z * 1024 + u.pn * 256) * 1024; }
    __device__ __forceinline__ void epi(const f32x4 (&acc)[2][4][2], f32x4 (&)[2][4][2], const Unit& u, int wr, int wc, int fr, int fq) const {
        const size_t arow0 = (size_t)(__builtin_amdgcn_readfirstlane(tab[16 + u.z]) + u.pm) * 128;
#pragma unroll
        for (int m = 0; m < 4; ++m) { const f32x4 g0 = acc[0][m][0] * (1.f / 64.f), g1 = acc[0][m][1] * (1.f / 64.f), u0 = acc[1][m][0] * (8.f / 64.f), u1 = acc[1][m][1] * (8.f / 64.f);
            const f32x4 v0 = (f32x4){g0[0] * fsigmoid(g0[0]), g0[1] * fsigmoid(g0[1]), g0[2] * fsigmoid(g0[2]), g0[3] * fsigmoid(g0[3])} * u0;
            const f32x4 v1 = (f32x4){g1[0] * fsigmoid(g1[0]), g1[1] * fsigmoid(g1[1]), g1[2] * fsigmoid(g1[2]), g1[3] * fsigmoid(g1[3])} * u1;
            *(GAS v2u*)((unsigned char*)(ws + WS_ACT) + (arow0 + wr * 64 + m * 16 + fr) * 512 + u.pn * 128 + wc * 32 + 8 * fq) = (v2u){pk4_fp8(v0[0], v0[1], v0[2], v0[3]), pk4_fp8(v1[0], v1[1], v1[2], v1[3])}; }
    }
};
struct PMoe2 {
    static constexpr bool EARLY_AOFF = false, FP8 = true; unsigned char* ws; const LAS int* tab; int G, c; int K; unsigned kstepA;
    __device__ __forceinline__ bool next(int i, Unit& u) const { const long L = (long)i * G + c; const int total = __builtin_amdgcn_readfirstlane(tab[32]) * 4; if (L >= total) return false; const int q = (int)L >> 2; u.pn = (int)L & 3;
        int e = 0;
#pragma unroll
        for (int k = 1; k < 16; ++k) e += (q >= __builtin_amdgcn_readfirstlane(tab[16 + k])) ? 1 : 0;
        u.z = e; u.pm = q - __builtin_amdgcn_readfirstlane(tab[16 + e]); return true; }
    __device__ __forceinline__ const char* a_base(const Unit& u) const { return (const char*)(ws + WS_ACT) + (size_t)(__builtin_amdgcn_readfirstlane(tab[16 + u.z]) + u.pm) * 128 * 512; }
    __device__ __forceinline__ unsigned a_off(const Unit&, int R, int Cc) const { return (unsigned)(R * 512 + Cc * 2); }
    __device__ __forceinline__ const char* b_base(const Unit& u) const { return (const char*)(ws + WS_MOE2) + ((size_t)u.z * 1024 + u.pn * 256) * 512; }
    __device__ __forceinline__ void epi(const f32x4 (&acc)[2][4][2], f32x4 (&)[2][4][2], const Unit& u, int wr, int wc, int fr, int fq) const {
        const int n = __builtin_amdgcn_readfirstlane(tab[u.z]);
        int entv[4]; float wv[4];
#pragma unroll
        for (int m = 0; m < 4; ++m) { int r = u.pm * 128 + wr * 64 + m * 16 + fr; r = r < n ? r : n - 1; entv[m] = ((const int*)(ws + WS_LIST))[(size_t)u.z * T + r]; }
#pragma unroll
        for (int m = 0; m < 4; ++m) wv[m] = ((const float*)(ws + WS_RW))[entv[m]] * (1.f / 256.f);
#pragma unroll
        for (int m = 0; m < 4; ++m) { const int r = u.pm * 128 + wr * 64 + m * 16 + fr; if (r >= n) continue;
            const int ent = entv[m]; const float w = wv[m];
#pragma unroll
            for (int bj = 0; bj < 2; ++bj)
                *(GAS v4u*)((bf16*)(ws + WS_YSLOT) + (size_t)ent * 1024 + u.pn * 256 + bj * 128 + wc * 32 + 8 * fq) = pack8(acc[bj][m][0] * w, acc[bj][m][1] * w); }
    }
};
struct PMoe1B {
    static constexpr bool EARLY_AOFF = true, FP8 = false; unsigned char* ws; const LAS int* tab; int G, c; int K; unsigned kstepA;
    __device__ __forceinline__ bool next(int i, Unit& u) const { const long L = (long)i * G + c; const int total = tab[32] * 4; if (L >= total) return false; const int q = (int)L >> 2; u.pn = (int)L & 3;
        int e = 0;
#pragma unroll
        for (int k = 1; k < 16; ++k) e += (q >= tab[16 + k]) ? 1 : 0;
        u.z = e; u.pm = q - tab[16 + e]; return true; }
    __device__ __forceinline__ const char* a_base(const Unit&) const { return (const char*)(ws + WS_HB); }
    __device__ __forceinline__ unsigned a_off(const Unit& u, int h, int R, int Cc) const { int r = u.pm * 256 + h * 128 + R; const int n = tab[u.z]; r = r < n ? r : n - 1;
        const int ent = ((const int*)(ws + WS_LIST))[(size_t)u.z * T + r]; return (unsigned)((ent >> 1) * 1024 + Cc) * 2u; }
    __device__ __forceinline__ const char* b_base(const Unit& u) const { return (const char*)(ws + WS_MOE1) + ((size_t)u.z * 1024 + u.pn * 256) * 1024 * 2; }
    __device__ __forceinline__ void epi(const Acc& acc, const Unit& u, int wr, int wc, int fr, int fq) const {
        const size_t arow0 = (size_t)(tab[16 + u.z] + u.pm) * 256;
#pragma unroll
        for (int ai = 0; ai < 2; ++ai)
#pragma unroll
            for (int m = 0; m < 4; ++m) { const f32x4 g0 = acc[ai][0][m][0], g1 = acc[ai][0][m][1], u0 = acc[ai][1][m][0], u1 = acc[ai][1][m][1];
                const f32x4 v0 = (f32x4){g0[0] * fsigmoid(g0[0]), g0[1] * fsigmoid(g0[1]), g0[2] * fsigmoid(g0[2]), g0[3] * fsigmoid(g0[3])} * u0;
                const f32x4 v1 = (f32x4){g1[0] * fsigmoid(g1[0]), g1[1] * fsigmoid(g1[1]), g1[2] * fsigmoid(g1[2]), g1[3] * fsigmoid(g1[3])} * u1;
                *(GAS v4u*)((bf16*)(ws + WS_ACTB) + (arow0 + ai * 128 + wr * 64 + m * 16 + fr) * 512 + u.pn * 128 + wc * 32 + 8 * fq) = pack8(v0, v1); }
    }
};
struct PMoe2B {
    static constexpr bool EARLY_AOFF = false, FP8 = false; unsigned char* ws; const LAS int* tab; int G, c; int K; unsigned kstepA;
    __device__ __forceinline__ bool next(int i, Unit& u) const { const long L = (long)i * G + c; const int total = tab[32] * 4; if (L >= total) return false; const int q = (int)L >> 2; u.pn = (int)L & 3;
        int e = 0;
#pragma unroll
        for (int k = 1; k < 16; ++k) e += (q >= tab[16 + k]) ? 1 : 0;
        u.z = e; u.pm = q - tab[16 + e]; return true; }
    __device__ __forceinline__ const char* a_base(const Unit& u) const { return (const char*)(ws + WS_ACTB) + (size_t)(tab[16 + u.z] + u.pm) * 256 * 512 * 2; }
    __device__ __forceinline__ unsigned a_off(const Unit&, int h, int R, int Cc) const { return (unsigned)((h * 128 + R) * 512 + Cc) * 2u; }
    __device__ __forceinline__ const char* b_base(const Unit& u) const { return (const char*)(ws + WS_MOE2) + ((size_t)u.z * 1024 + u.pn * 256) * 512 * 2; }
    __device__ __forceinline__ void epi(const Acc& acc, const Unit& u, int wr, int wc, int fr, int fq) const {
        const int n = tab[u.z];
#pragma unroll
        for (int ai = 0; ai < 2; ++ai)
#pragma unroll
            for (int m = 0; m < 4; ++m) { const int r = u.pm * 256 + ai * 128 + wr * 64 + m * 16 + fr; if (r >= n) continue;
                const int ent = ((const int*)(ws + WS_LIST))[(size_t)u.z * T + r]; const float w = ((const float*)(ws + WS_RW))[ent];
#pragma unroll
                for (int bj = 0; bj < 2; ++bj)
                    *(GAS v4u*)((bf16*)(ws + WS_YSLOT) + (size_t)ent * 1024 + u.pn * 256 + bj * 128 + wc * 32 + 8 * fq) = pack8(acc[ai][bj][m][0] * w, acc[ai][bj][m][1] * w); }
    }
};
__device__ __forceinline__ void build_exptab(const Ctx& C, LAS int* tab, int l, int tsh = 7) {
    __syncthreads();
    if (threadIdx.x == 0) { int t0 = 0;
        for (int e = 0; e < 16; ++e) { const int n = (int)__hip_atomic_load((unsigned*)(C.ctl + CW_CNT + l * 1024 + 64 * e), RLX_AGENT); tab[e] = n; tab[16 + e] = t0; t0 += (n + (1 << tsh) - 1) >> tsh; }
        tab[32] = t0; }
    __syncthreads();
}
__device__ __forceinline__ void phase_attn(const Ctx& C, int l, unsigned char* lds_gen) {
    phase_carry(C, l);
    char* shm = (char*)lds_gen;
    bf16* QA = WSP(bf16, WS_QA); bf16* KA = WSP(bf16, WS_KA); bf16* VA = WSP(bf16, WS_VA); bf16* QN = WSP(bf16, WS_QN); bf16* KN = WSP(bf16, WS_KN); bf16* VN = WSP(bf16, WS_VN);
#ifndef ATTN_SEL
#define ATTN_SEL 3
#endif
#ifdef REPMASK
#define REPMASK_ REPMASK
#else
#define REPMASK_ 0
#endif
    const int per = (1024 + C.G - 1) / C.G;
    bool nomax; { float gq = 0.f, gk = 0.f; for (int i = 0; i < 64; ++i) { gq = fmaxf(gq, fabsf(C.in[I_QNG][l * 64 + i])); gk = fmaxf(gk, fabsf(C.in[I_KNG][l * 64 + i])); } nomax = 64.f * gq * gk * C2 <= 60.f; }
    if (ATTN_SEL & 1) for (int i = 0; i < per * (1 + ((REPMASK_ >> 13) & 1)); ++i) { const int id = C.vcu * per + (i % per); if (id >= 1024) continue; const int bh = id >> 5, b = bh >> 3, h = bh & 7, qb = id & 31;
        const bf16* Qu = QA + (size_t)(b * LB + CTX + qb * 256) * 512 + h * 64;
        if (nomax) attn_body::attn_unit<8, false, 512, 128, true>(Qu, 512, KA + (size_t)(b * LB) * 128 + (h >> 2) * 64, VA + (size_t)(b * LB) * 128 + (h >> 2) * 64, 128, WSP(bf16, WS_AO) + (Qu - QA), LB / 64, 0, 0, shm);
        else attn_body::attn_unit<8, false, 512, 128, false>(Qu, 512, KA + (size_t)(b * LB) * 128 + (h >> 2) * 64, VA + (size_t)(b * LB) * 128 + (h >> 2) * 64, 128, WSP(bf16, WS_AO) + (Qu - QA), LB / 64, 0, 0, shm);
    }
    LAS float* bt = (LAS float*)(C.lds + attn_body::LDS_BT);
    const int nctx = (C.vcu >= 64 && C.vcu < 128) ? 1 : 0;
    if (ATTN_SEL & 2) for (int i0 = 0; i0 < (per + nctx) * (1 + ((REPMASK_ >> 14) & 1)); ++i0) { const int i = i0 % (per + nctx);
        const bf16 *Qu, *Kh, *Vh; bf16* Ou; int kvp = 512, NT = 4, r0 = 0, rlo = 0;
        if (i < per) { const int id = C.vcu * per + i; if (id >= 1024) continue; const int bh = id >> 5, b = bh >> 3, h = bh & 7; r0 = (id & 31) * 4;
            const float* rp = C.in[I_RPB] + (size_t)(l * 8 + h) * 465;
            for (int k = C.tid; k < 465; k += 512) bt[k] = rp[k] * LOG2E;
            rlo = r0 - 4 < 0 ? 0 : (r0 - 4 > 120 ? 120 : r0 - 4); const int rh_ = r0 - 1 < 0 ? 0 : (r0 - 1 > 120 ? 120 : r0 - 1), nloc = rh_ + 8 - rlo; NT = (4 + nloc + 1) & ~1;
            Qu = QN + (size_t)(b * LB + CTX + r0 * 64) * 512 + h * 64; Ou = WSP(bf16, WS_NO) + (Qu - QN); Kh = KN + (size_t)(b * LB) * 512 + h * 64; Vh = VN + (size_t)(b * LB) * 512 + h * 64; }
        else { int j = C.vcu - 64; if (j < 32) { const int b = j >> 3, h = j & 7; Qu = QA + (size_t)(b * LB) * 512 + h * 64; Ou = WSP(bf16, WS_AO) + (Qu - QA); Kh = KA + (size_t)(b * LB) * 128 + (h >> 2) * 64; Vh = VA + (size_t)(b * LB) * 128 + (h >> 2) * 64; kvp = 128; }
            else { j -= 32; const int b = j >> 3, h = j & 7; Qu = QN + (size_t)(b * LB) * 512 + h * 64; Ou = WSP(bf16, WS_NO) + (Qu - QN); Kh = KN + (size_t)(b * LB) * 512 + h * 64; Vh = VN + (size_t)(b * LB) * 512 + h * 64; } }
        attn_body::attn_unit<8, true, 512, 0>(Qu, 512, Kh, Vh, kvp, Ou, NT, r0, rlo, shm);
    }
}

constexpr int NPH = 46;
__global__ void __launch_bounds__(NWAVES * 64, 2) fwd(Args args) {
    extern __shared__ __attribute__((aligned(16))) unsigned char lds[];
    Ctx C; C.in = (const __attribute__((address_space(4))) CFP*)__builtin_amdgcn_kernarg_segment_ptr(); C.out = args.out; C.ws = args.ws; C.lds = (LAS unsigned char*)lds; C.ctl = (gu32*)(args.ws + WS_CTL);
    C.tid = 0; C.lane = 0; C.wave = __builtin_amdgcn_readfirstlane((int)threadIdx.x >> 6);
    C.G = gridDim.x; { const int bx = blockIdx.x; C.vcu = (C.G % 8 == 0) ? (bx % 8) * (C.G / 8) + bx / 8 : bx; }
    for (int u = threadIdx.x; u < (LDS_BYTES - LDSCTL_OFF) / 4; u += NWAVES * 64) ((LAS unsigned*)(C.lds + LDSCTL_OFF))[u] = 0u;
    __syncthreads();
    const int lo = args.ph_lo, hi = args.ph_hi;
    XcdBarrier bar; bar.bar = (unsigned*)(C.ctl + CW_BAR); bar.x = 0; bar.st = nullptr;
    if (hi - lo > 1) bar = xcd_barrier_post((unsigned*)(C.ctl + CW_BAR), (volatile LAS unsigned*)(C.lds + MISC_OFF) + 8);
    LAS int* tab = (LAS int*)(C.lds + LDSCTL_OFF);
    const int cg = (int)blockIdx.x;
#ifndef PHMASK
#define PHMASK 0xFFFF
#endif
#define IN(k) (lo <= (k) && (k) < hi)
#define EN(b) ((PHMASK >> (b)) & 1)
#ifndef REPMASK
#define REPMASK 0
#endif
#define RUN(b, stmt) do { stmt; if ((REPMASK >> (b)) & 1) { stmt; } } while (0)
#ifdef DIAG_SEL
#define DIAG_ACC(ty) do { if (blockIdx.x == 0 && threadIdx.x == 0) { volatile LAS unsigned* dg = (volatile LAS unsigned*)(C.lds + LDSCTL_OFF + 160); const unsigned now = (unsigned)__builtin_amdgcn_s_memrealtime(); dg[8 + (ty)] += now - dg[0]; dg[0] = now; } } while (0)
#else
#define DIAG_ACC(ty) do {} while (0)
#endif
#define SEAM(k) do { if (IN(k) && IN((k) + 1)) xcd_barrier(bar); DIAG_ACC((k) == 0 ? 11 : ((k) - 1) % 11); } while (0)
#define LWS() ({ const __attribute__((address_space(4))) CFP* k_ = C.in; asm volatile("" : "+s"(k_)); (unsigned char*)k_[30]; })
#define LC() ({ Ctx c_ = C; c_.tid = threadIdx.x; asm volatile("" : "+v"(c_.tid)); c_.lane = c_.tid & 63; asm volatile("" : "+s"(c_.in)); c_.ws = (unsigned char*)c_.in[30]; c_.out = (float*)c_.in[29]; c_.ctl = (gu32*)(c_.ws + WS_CTL); c_; })
#ifdef DIAG_SEL
    if (blockIdx.x == 0 && threadIdx.x == 0) { volatile LAS unsigned* dg = (volatile LAS unsigned*)(C.lds + LDSCTL_OFF + 160); dg[0] = (unsigned)__builtin_amdgcn_s_memrealtime(); dg[1] = dg[0]; }
#endif
    if (EN(11) && IN(0)) { const Ctx Cl = LC(); phase_mod(Cl); RUN(11, phase_s5mats(Cl, 0); phase_weights(Cl, 0)); }
    SEAM(0);
    for (int l = 0; l < NLAYER; ++l) {
        const int pb = 1 + 11 * l;
        if (EN(0) && IN(pb)) { const Ctx Cl = LC(); if (l == 0) phase_rows<0>(Cl, 0); else { phase_s5mats(Cl, l); phase_weights(Cl, l); phase_rows<1>(Cl, l); } }
        SEAM(pb);
        if (EN(1) && IN(pb + 1)) { if (W8_ALL) { PWin8 P{LWS(), C.G, cg, 1024, 128u}; pg8::gemm_phase_m128(C.lds, P); } else { { PWin P{LWS(), C.G, cg, 1024, 128u}; pg8::gemm_phase(C.lds, P); } { PGate P{LWS(), C.G, cg, 1024, 128u}; pg8::gemm_phase_m128(C.lds, P); } } }
        SEAM(pb + 1);
        if (EN(2) && IN(pb + 2)) { { const Ctx Cl = LC(); phase_qkprep(Cl, l); } PS5A P{LWS(), C.G, cg, 512, 128u}; RUN(2, pg8::gemm_phase(C.lds, P)); }
        SEAM(pb + 2);
        if (EN(3) && IN(pb + 3)) { const Ctx Cl = LC(); RUN(3, phase_attn(Cl, l, lds)); }
        SEAM(pb + 3);
        if (EN(4) && IN(pb + 4)) { PS5B P{LWS(), C.G, cg, 256, 128u}; pg8::gemm_phase(C.lds, P); }
        SEAM(pb + 4);
        if (EN(5) && IN(pb + 5)) { PGlu P{LWS(), C.G, cg, 512, 128u, l == NLAYER - 1}; pg8::gemm_phase_m128(C.lds, P); }
        SEAM(pb + 5);
        if (EN(6) && IN(pb + 6)) { PMerge P{LWS(), C.G, cg, 512, 128u, l == NLAYER - 1}; pg8::gemm_phase_m128(C.lds, P); }
        SEAM(pb + 6);
        if (EN(7) && IN(pb + 7)) { unsigned char* wl_ = LWS(); PWout P{wl_, (float*)C.in[29], (const float*)(wl_ + WS_MOD) + (size_t)l * 5 * 6144, C.G, cg, 1024, 128u, l == NLAYER - 1}; pg8::gemm_phase_m128(C.lds, P); }
        SEAM(pb + 7);
        if (EN(8) && IN(pb + 8)) { const Ctx Cl = LC(); phase_norm2(Cl, l); }
        SEAM(pb + 8);
        if (EN(9) && IN(pb + 9)) { if (FP8_MOE) { build_exptab(C, tab, l); PMoe1 P{LWS(), tab, C.G, cg, 1024, 128u}; pg8::gemm_phase_m128(C.lds, P); } else { build_exptab(C, tab, l, 8); PMoe1B P{LWS(), tab, C.G, cg, 1024, 128u}; pg8::gemm_phase(C.lds, P); } }
        SEAM(pb + 9);
        if (EN(10) && IN(pb + 10)) { if (FP8_MOE) { build_exptab(C, tab, l); PMoe2 P{LWS(), tab, C.G, cg, 512, 128u}; pg8::gemm_phase_m128(C.lds, P); } else { build_exptab(C, tab, l, 8); PMoe2B P{LWS(), tab, C.G, cg, 512, 128u}; pg8::gemm_phase(C.lds, P); } }
        SEAM(pb + 10);
    }
    if (EN(12) && IN(NPH - 1)) { const Ctx Cl = LC(); phase_rows<2>(Cl, NLAYER); }
#ifdef DIAG_SEL
    xcd_barrier(bar); DIAG_ACC(12);
    if (blockIdx.x == 0 && threadIdx.x == 0) { volatile LAS unsigned* dg = (volatile LAS unsigned*)(C.lds + LDSCTL_OFF + 160); dg[8 + 13] = dg[0] - dg[1];
        for (int i = 0; i < 14; ++i) __hip_atomic_store(C.ctl + 2048 + i, dg[8 + i], RLX_AGENT); }
    xcd_barrier(bar);
    { const float d1 = (float)__hip_atomic_load(C.ctl + 2048 + (DIAG_SEL), RLX_AGENT) * 0.01f, d2 = (float)__hip_atomic_load(C.ctl + 2048 + (DIAG_SEL) + 1, RLX_AGENT) * 0.01f;
      const float c1 = sqrtf(d1); float* o = args.out;
      for (size_t i = (size_t)blockIdx.x * 512 + threadIdx.x; i < (size_t)NB * SEQ * D; i += (size_t)gridDim.x * 512) o[i] = (i == 12345) ? d2 : c1; }
#endif
#undef IN
#undef SEAM
}

#ifndef MK_PER_PHASE
#define MK_PER_PHASE 0
#endif
extern "C" void kernel_launch(void* const* d_in, const int* in_sizes, int n_in, void* d_out, int out_size, void* d_ws, size_t ws_size, hipStream_t stream) {
    static int grid = 0;
    if (grid == 0) {
        if (n_in != 29 || out_size != NB * SEQ * D || ws_size < WS_END) { fprintf(stderr, "kernel_launch: unexpected shapes (n_in %d out %d ws %zu)\n", n_in, out_size, ws_size); grid = -1; return; }
        int dev = 0, cus = 0, per_cu = 0;
        if (hipGetDevice(&dev) != hipSuccess || hipDeviceGetAttribute(&cus, hipDeviceAttributeMultiprocessorCount, dev) != hipSuccess) { grid = -1; return; }
        if (hipFuncSetAttribute((const void*)fwd, hipFuncAttributeMaxDynamicSharedMemorySize, LDS_BYTES) != hipSuccess) { grid = -1; return; }
        if (hipOccupancyMaxActiveBlocksPerMultiprocessor(&per_cu, (const void*)fwd, NWAVES * 64, LDS_BYTES) != hipSuccess || per_cu < 1) fprintf(stderr, "kernel_launch: occupancy query says %d\n", per_cu);
        (void)hipGetLastError();
        grid = cus;
    }
    if (grid < 0) return;
    (void)hipMemsetAsync((char*)d_ws + WS_CTL, 0, CTL_ZERO_BYTES, stream);
    Args a{};
    for (int i = 0; i < 29; ++i) a.in[i] = (const float*)d_in[i];
    a.out = (float*)d_out; a.ws = (unsigned char*)d_ws;
#if MK_PER_PHASE
    for (int p = 0; p < NPH; ++p) { a.ph_lo = p; a.ph_hi = p + 1; hipLaunchKernelGGL(fwd, dim3(grid), dim3(NWAVES * 64), LDS_BYTES, stream, a); }
#else
    a.ph_lo = 0; a.ph_hi = NPH; hipLaunchKernelGGL(fwd, dim3(grid), dim3(NWAVES * 64), LDS_BYTES, stream, a);
#endif
}
```

```cpp
#define FP8_MOE 1
#define GATE_BF16 0
#define W8_ALL 1
#define H8_WRITE 1
#ifndef H8_WRITE
#define H8_WRITE 1
#endif
#ifndef GATE_BF16
#define GATE_BF16 0
#endif
#include <hip/hip_runtime.h>
#include <cstdio>
#include <cstdint>

#define GAS __attribute__((address_space(1)))
#define LAS __attribute__((address_space(3)))
typedef unsigned short bf16;
typedef unsigned v4u __attribute__((ext_vector_type(4)));
typedef unsigned v2u __attribute__((ext_vector_type(2)));
typedef float f32x4 __attribute__((ext_vector_type(4)));
typedef float f32x2 __attribute__((ext_vector_type(2)));
typedef float f32x16 __attribute__((ext_vector_type(16)));
typedef short bf16x8 __attribute__((ext_vector_type(8)));
typedef short s16x4 __attribute__((ext_vector_type(4)));
typedef GAS unsigned gu32;
#define RLX_AGENT __ATOMIC_RELAXED, __HIP_MEMORY_SCOPE_AGENT
#define LDS_WAIT() asm volatile("s_waitcnt lgkmcnt(0)" ::: "memory")
#define VM_WAIT() asm volatile("s_waitcnt vmcnt(0)" ::: "memory")

constexpr int NB = 4, SEQ = 8192, CTX = 256, LB = SEQ + CTX, T = NB * LB, D = 1024, NPAN = T / 256;
constexpr int NLAYER = 4, INW = 5888, NCH = LB / 32, NCR = NB * NCH;
constexpr int NEXP = 16, FF = 512;
constexpr float EPS = 1e-6f;
constexpr float LOG2E = 1.4426950408889634f;
constexpr float C2 = 0.125f * LOG2E;
constexpr int NWAVES = 8;

constexpr size_t MiB = 1u << 20;
constexpr size_t WS_CTL = 0, CTL_ZERO_BYTES = 1 * MiB;
constexpr size_t WS_MOD = 1 * MiB;
constexpr size_t WS_LIST = 2 * MiB;
constexpr size_t WS_RW = 5 * MiB;
constexpr size_t WS_CTXS = 6 * MiB;
constexpr size_t WS_SST = 10 * MiB;
constexpr size_t WS_HB8 = WS_SST;
constexpr size_t WS_XST = 44 * MiB;
constexpr size_t WS_BT1 = 61 * MiB;
constexpr size_t WS_BT2 = 85 * MiB;
constexpr size_t WS_WIN = 93 * MiB;
constexpr size_t WS_WIN8 = WS_WIN + (size_t)2816 * 1024 * 2;
constexpr size_t WS_WGLU = 105 * MiB;
constexpr size_t WS_WBR = 106 * MiB;
constexpr size_t WS_WOUT = 109 * MiB;
constexpr size_t WS_MOE1 = 111 * MiB;
constexpr size_t WS_MOE2 = 143 * MiB;
constexpr size_t WS_HB = 159 * MiB;
constexpr size_t WS_U = 225 * MiB;
constexpr size_t WS_QA = 258 * MiB;
constexpr size_t WS_KA = 291 * MiB;
constexpr size_t WS_VA = 300 * MiB;
constexpr size_t WS_QN = 309 * MiB;
constexpr size_t WS_KN = 342 * MiB;
constexpr size_t WS_VN = 375 * MiB;
constexpr size_t WS_YS = 408 * MiB;
constexpr size_t WS_GATES = 441 * MiB;
constexpr size_t WS_ACT = WS_QN;
constexpr size_t WS_ACTB = WS_QN;
constexpr size_t WS_YSLOT = WS_GATES;
constexpr size_t WS_AO = 574 * MiB;
constexpr size_t WS_NO = 607 * MiB;
constexpr size_t WS_YG = 640 * MiB;
constexpr size_t WS_END = 673 * MiB;
static_assert(WS_GATES + (size_t)T * 3072 * (GATE_BF16 ? 2 : 1) <= WS_AO && WS_YSLOT + (size_t)2 * T * 1024 * 2 <= WS_AO && WS_ACT + (size_t)(2 * T + 4096) * 512 * 2 <= WS_YS, "ws map");
constexpr int CW_FAIL = 8;
constexpr int CW_CNT = 64;
constexpr int CW_BAR = 8192;

constexpr int RING_BYTES = 131072, LDS_BYTES = 147456, LDSCTL_OFF = LDS_BYTES - 512, MISC_OFF = LDSCTL_OFF + 320;

__device__ __forceinline__ unsigned f2bf(float f) { unsigned u = __builtin_bit_cast(unsigned, f); return (u + 0x7fffu + ((u >> 16) & 1u)) >> 16; }
__device__ __forceinline__ unsigned pk2(float lo, float hi) { return f2bf(lo) | (f2bf(hi) << 16); }
__device__ __forceinline__ float bf2f(unsigned b) { return __builtin_bit_cast(float, b << 16); }
__device__ __forceinline__ float bflo(unsigned w) { return __builtin_bit_cast(float, w << 16); }
__device__ __forceinline__ float bfhi(unsigned w) { return __builtin_bit_cast(float, w & 0xffff0000u); }
typedef float f32x2_c __attribute__((ext_vector_type(2))); typedef __bf16 bf16x2_c __attribute__((ext_vector_type(2)));
__device__ __forceinline__ unsigned cvt_pk_bf16(float lo, float hi) { const f32x2_c v = {lo, hi}; return __builtin_bit_cast(unsigned, __builtin_convertvector(v, bf16x2_c)); }
typedef int v8i __attribute__((ext_vector_type(8)));
typedef int v4i __attribute__((ext_vector_type(4)));
__device__ __forceinline__ float clamp8(float x) { return __builtin_fminf(__builtin_fmaxf(x, -448.f), 448.f); }
__device__ __forceinline__ unsigned pk4_fp8(float a, float b, float c, float d) { int w = 0; w = __builtin_amdgcn_cvt_pk_fp8_f32(clamp8(a), clamp8(b), w, false); w = __builtin_amdgcn_cvt_pk_fp8_f32(clamp8(c), clamp8(d), w, true); return (unsigned)w; }
__device__ __forceinline__ float fsigmoid(float x) { return __builtin_amdgcn_rcpf(1.f + __builtin_amdgcn_exp2f(-LOG2E * x)); }
__device__ __forceinline__ float gelu_tanh(float x) { const float u = 0.7978845608f * (x + 0.044715f * x * x * x); return x * __builtin_amdgcn_rcpf(1.f + __builtin_amdgcn_exp2f(-2.f * LOG2E * u)); }
__device__ __forceinline__ float shflx(float v, int m, int lane) { return __builtin_bit_cast(float, __builtin_amdgcn_ds_bpermute((lane ^ m) << 2, __builtin_bit_cast(int, v))); }
template <int CTRL, int RM>
__device__ __forceinline__ float dpp_mov(float v) { return __builtin_bit_cast(float, __builtin_amdgcn_update_dpp(0, __builtin_bit_cast(int, v), CTRL, RM, 0xF, true)); }
__device__ __forceinline__ float wave_sum(float v, int) {
    v += dpp_mov<0xB1, 0xF>(v);
    v += dpp_mov<0x4E, 0xF>(v);
    v += dpp_mov<0x141, 0xF>(v);
    v += dpp_mov<0x140, 0xF>(v);
    v += dpp_mov<0x142, 0xA>(v);
    v += dpp_mov<0x143, 0xC>(v);
    return __builtin_bit_cast(float, __builtin_amdgcn_readlane(__builtin_bit_cast(int, v), 63));
}
__device__ __forceinline__ float sin_rev(float r) { r = r - floorf(r); return __builtin_amdgcn_sinf(r); }
__device__ __forceinline__ float cos_rev(float r) { r = r - floorf(r); return __builtin_amdgcn_cosf(r); }

#define XB_TMO      128
#define XB_XCNT(j)  (256  + 64 * (j))
#define XB_XSUB(j)  (1280 + 64 * (j))
#define XB_XGEN(j)  (2304 + 64 * (j))
#define XB_TOP      3328
#define XB_TOPGEN   3392
#define XCD_BAR_WORDS 3456
#define XB_SPIN_CAP (1u << 22)

__device__ __forceinline__ unsigned xb_ld(unsigned* p)              { return __hip_atomic_load(p, __ATOMIC_RELAXED, __HIP_MEMORY_SCOPE_AGENT); }
__device__ __forceinline__ unsigned xb_add(unsigned* p, unsigned v) { return __hip_atomic_fetch_add(p, v, __ATOMIC_RELAXED, __HIP_MEMORY_SCOPE_AGENT); }
__device__ __forceinline__ unsigned xb_xcc_id() { return (unsigned)__builtin_amdgcn_s_getreg((3 << 11) | 20) & 0xFu; }
#define XB_SPIN(cond, bar) do { unsigned _sp = 0; while (cond) { __builtin_amdgcn_s_sleep(1); \
    if ((++_sp & 255u) == 0u) { if (xb_ld(&(bar)[XB_TMO])) break; if (_sp > XB_SPIN_CAP) { atomicAdd(&(bar)[XB_TMO], 1u); break; } } } } while (0)

struct XcdBarrier { unsigned* bar; unsigned x; volatile LAS unsigned* st; };

__device__ __forceinline__ XcdBarrier xcd_barrier_post(unsigned* bar, volatile LAS unsigned* st) {
    XcdBarrier b; b.bar = bar; b.x = xb_xcc_id(); b.st = st;
    if (threadIdx.x == 0) (void)xb_add(&bar[XB_XCNT(b.x)], 1u);
    return b;
}
__device__ __forceinline__ void xcd_barrier_complete(unsigned* bar, unsigned x, unsigned& nloc, unsigned& nx) {
    const unsigned G = gridDim.x * gridDim.y * gridDim.z;
    unsigned sum, cnt, mine, sp = 0u;
    for (;;) {
        sum = 0u; cnt = 0u; mine = 0u;
#pragma unroll
        for (unsigned j = 0; j < 16; ++j) { const unsigned c = xb_ld(&bar[XB_XCNT(j)]); sum += c; cnt += (c > 0u) ? 1u : 0u; mine = (j == x) ? c : mine; }
        if (sum == G) break;
        __builtin_amdgcn_s_sleep(1);
        if ((++sp & 255u) == 0u) { if (xb_ld(&bar[XB_TMO])) break; if (sp > XB_SPIN_CAP) { atomicAdd(&bar[XB_TMO], 1u); break; } }
    }
    nloc = mine > 0u ? mine : 1u; nx = cnt > 0u ? cnt : 1u;
}
__device__ __forceinline__ void xcd_barrier(const XcdBarrier& b) {
    asm volatile("s_waitcnt vmcnt(0)" ::: "memory");
    __syncthreads();
    if (threadIdx.x == 0) {
        unsigned* bar = b.bar;
        __builtin_amdgcn_s_waitcnt(0);
        unsigned nloc = b.st[0], nx = b.st[1];
        if (nloc == 0u) { xcd_barrier_complete(bar, b.x, nloc, nx); b.st[0] = nloc; b.st[1] = nx; }
        const unsigned old = xb_add(&bar[XB_XSUB(b.x)], 1u);
        const unsigned gen = old / nloc;
        if (old + 1u == (gen + 1u) * nloc) {
            __builtin_amdgcn_fence(__ATOMIC_RELEASE, "agent");
            asm volatile("s_waitcnt vmcnt(0)" ::: "memory");
            const unsigned og = xb_add(&bar[XB_TOP], 1u);
            const unsigned tg = og / nx;
            if (og + 1u == (tg + 1u) * nx) xb_add(&bar[XB_TOPGEN], 1u);
            else XB_SPIN(xb_ld(&bar[XB_TOPGEN]) == tg, bar);
            __builtin_amdgcn_fence(__ATOMIC_ACQUIRE, "agent");
            xb_add(&bar[XB_XGEN(b.x)], 1u);
            asm volatile("s_waitcnt vmcnt(0)" ::: "memory");
        } else {
            XB_SPIN(xb_ld(&bar[XB_XGEN(b.x)]) == gen, bar);
            __builtin_amdgcn_fence(__ATOMIC_ACQUIRE, "agent");
            asm volatile("s_waitcnt vmcnt(0)" ::: "memory");
        }
    }
    __syncthreads();
}

namespace pg8 {
constexpr int BM = 256, BK = 64, HALF = 128, HTB = HALF * BK * 2, STAGE_BYTES = 8 * HTB, NXCD = 8, WGM = 8;
__host__ __device__ __forceinline__ int lds_byte(int r, int c) { const int st = (r >> 4) * 2 + (c >> 5), rr = r & 15, cc = c & 31, ob = rr * 64 + cc * 2; return st * 1024 + (ob ^ (((ob >> 9) & 1) << 5)); }
__host__ __device__ __forceinline__ void stage_rc(int b, int& R, int& C) { const int st = b / 1024, sb = b % 1024, swz = sb ^ (((sb >> 9) & 1) << 5); R = (st >> 1) * 16 + swz / 64; C = (st & 1) * 32 + (swz % 64) / 2; }
__host__ __device__ __forceinline__ int perm32(int rho) { const int n = rho >> 4, i = rho & 15; return 8 * (i >> 2) + 4 * n + (i & 3); }

struct Unit { int pm, pn, z; };

__device__ __forceinline__ void static_decode(int L, int nM, int nN, int& pm, int& pn) {
    const int nwg = nM * nN; int wgid = L;
    { const int q = nwg / NXCD, r = nwg % NXCD, xcd = wgid % NXCD, off = wgid / NXCD; wgid = (xcd < r ? xcd * (q + 1) : r * (q + 1) + (xcd - r) * q) + off; }
    const int nig = WGM * nN, gid = wgid / nig, fm = gid * WGM, gsz = (nM - fm) < WGM ? (nM - fm) : WGM;
    pm = fm + ((wgid % nig) % gsz); pn = (wgid % nig) / gsz;
}

template <class P>
__device__ __forceinline__ void gemm_phase(LAS unsigned char* lds, const P& S) {
    int tid_ = threadIdx.x; asm volatile("" : "+v"(tid_));
    const int tid = tid_, wid = __builtin_amdgcn_readfirstlane(tid >> 6), lane = tid & 63, wr = wid >> 2, wc = wid & 3, fr = lane & 15, fq = lane >> 4;
    constexpr int ELB = P::FP8 ? 1 : 2;
    const int K = S.K; int nt = K * ELB / 128; asm volatile("" : "+s"(nt));
    unsigned voffB[2];
#pragma unroll
    for (int i = 0; i < 2; ++i) { int R, C; stage_rc(tid * 16 + i * 8192, R, C); const int Rb = (R & ~31) + perm32(R & 31); voffB[i] = (unsigned)(Rb * K * ELB + C * 2); }
#define PG8_AOFF(dst0, dst1, u) do { _Pragma("unroll") for (int i = 0; i < 2; ++i) { int R, C; stage_rc(tid * 16 + i * 8192, R, C); dst0[i] = S.a_off(u, 0, R, C); dst1[i] = S.a_off(u, 1, R, C); } } while (0)
    const size_t kstepB = (size_t)(BK * 2), hstepB = (size_t)HALF * K * ELB, kstepA = (size_t)S.kstepA;
    const unsigned ldsw = (unsigned)wid * 1024u;
    const int aoff = lds_byte(wr * 64 + fr, fq * 8), boff = lds_byte(wc * 32 + fr, fq * 8);
#define PG8_SA(b, h) (((b) * 2 + (h)) * HTB)
#define PG8_SB(b, h) ((4 + (b) * 2 + (h)) * HTB)
#define PG8_STAGE(bufoff, gbase, voff) do { _Pragma("unroll") for (int _i = 0; _i < 2; ++_i) \
        __builtin_amdgcn_global_load_lds((const unsigned*)((const char*)(gbase) + (voff)[_i]), (LAS unsigned*)(lds + (bufoff) + ldsw + _i * 8192), 16, 0, 0); } while (0)
#define PG8_LDA(dst, b, h) do { _Pragma("unroll") for (int m = 0; m < 4; ++m) _Pragma("unroll") for (int k = 0; k < 2; ++k) dst[m][k] = *(const LAS bf16x8*)(lds + PG8_SA(b, h) + aoff + m * 2048 + k * 1024); } while (0)
#define PG8_LDB(dst, b, h) do { _Pragma("unroll") for (int n = 0; n < 2; ++n) _Pragma("unroll") for (int k = 0; k < 2; ++k) dst[n][k] = *(const LAS bf16x8*)(lds + PG8_SB(b, h) + boff + n * 2048 + k * 1024); } while (0)
#define PG8_CAT(x0, x1) __builtin_shufflevector(__builtin_bit_cast(v4i, x0), __builtin_bit_cast(v4i, x1), 0, 1, 2, 3, 4, 5, 6, 7)
#define PG8_MMA(ai, bj, At, Bt) do { __builtin_amdgcn_s_setprio(1); _Pragma("unroll") for (int m = 0; m < 4; ++m) _Pragma("unroll") for (int n = 0; n < 2; ++n) { \
        if constexpr (P::FP8) acc[ai][bj][m][n] = __builtin_amdgcn_mfma_scale_f32_16x16x128_f8f6f4(PG8_CAT(Bt[n][0], Bt[n][1]), PG8_CAT(At[m][0], At[m][1]), acc[ai][bj][m][n], 0, 0, 0, 0x7f7f7f7f, 0, 0x7f7f7f7f); \
        else { _Pragma("unroll") for (int k = 0; k < 2; ++k) acc[ai][bj][m][n] = __builtin_amdgcn_mfma_f32_16x16x32_bf16(Bt[n][k], At[m][k], acc[ai][bj][m][n], 0, 0, 0); } } __builtin_amdgcn_s_setprio(0); } while (0)
#define PG8_WAIT_V(n) asm volatile("s_waitcnt vmcnt(" #n ")" ::: "memory")
#define PG8_WAIT_L(n) asm volatile("s_waitcnt lgkmcnt(" #n ")" ::: "memory")
#define PG8_BAR __builtin_amdgcn_s_barrier()
#define PG8_SCHED __builtin_amdgcn_sched_barrier(0)
    Unit cur, nxt; int ui = 0;
    if (!S.next(0, cur)) return;
    f32x4 acc[2][2][4][2];
#pragma unroll
    for (int a = 0; a < 2; ++a)
#pragma unroll
        for (int b = 0; b < 2; ++b)
#pragma unroll
            for (int m = 0; m < 4; ++m)
#pragma unroll
                for (int n = 0; n < 2; ++n) acc[a][b][m][n] = (f32x4){0.f, 0.f, 0.f, 0.f};
    bf16x8 At[4][2], B0[2][2], B1[2][2];
    unsigned vA0[2], vA1[2], vN0[2], vN1[2];
    PG8_AOFF(vA0, vA1, cur);
    const char* cA = S.a_base(cur); const char* cB = S.b_base(cur);
    PG8_STAGE(PG8_SB(0, 0), cB, voffB); PG8_STAGE(PG8_SB(0, 1), cB + hstepB, voffB); PG8_STAGE(PG8_SA(0, 0), cA, vA0); PG8_STAGE(PG8_SA(0, 1), cA, vA1);
    if (wr == 1) PG8_BAR;
    PG8_WAIT_V(2); PG8_BAR;
    PG8_STAGE(PG8_SB(1, 0), cB + kstepB, voffB); PG8_STAGE(PG8_SA(1, 0), cA + kstepA, vA0); PG8_STAGE(PG8_SB(1, 1), cB + hstepB + kstepB, voffB);
    PG8_WAIT_V(6); PG8_BAR;
    for (;;) {
        const bool has_next = S.next(ui + 1, nxt);
        const char* nA = cA; const char* nB = cB;
        if (has_next) { nA = S.a_base(nxt); nB = S.b_base(nxt); if (P::EARLY_AOFF) PG8_AOFF(vN0, vN1, nxt); }
        for (int t = 0; t < nt; t += 2) {
            const bool last = (t == nt - 2);
            const char* a1 = cA + (size_t)(t + 1) * kstepA;
            const char* a2 = last ? nA : cA + (size_t)(t + 2) * kstepA; const char* b2 = last ? nB : cB + (size_t)(t + 2) * kstepB;
            const char* a3 = a2 + kstepA; const char* b3 = b2 + kstepB;
            PG8_LDB(B0, 0, 0); PG8_LDB(B1, 0, 1); PG8_SCHED; PG8_LDA(At, 0, 0); PG8_STAGE(PG8_SA(1, 1), a1, vA1);
            if (last && has_next) {
                if (P::EARLY_AOFF) { _Pragma("unroll") for (int i = 0; i < 2; ++i) { vA0[i] = vN0[i]; vA1[i] = vN1[i]; } } else PG8_AOFF(vA0, vA1, nxt); }
            PG8_WAIT_V(8); PG8_WAIT_L(0); PG8_BAR; PG8_MMA(0, 0, At, B0); PG8_MMA(0, 1, At, B1); PG8_BAR; PG8_SCHED;
            PG8_LDA(At, 0, 1); PG8_STAGE(PG8_SB(0, 0), b2, voffB); PG8_STAGE(PG8_SB(0, 1), b2 + hstepB, voffB); PG8_STAGE(PG8_SA(0, 0), a2, vA0);
            PG8_WAIT_V(8); PG8_WAIT_L(0); PG8_BAR; PG8_MMA(1, 0, At, B0); PG8_MMA(1, 1, At, B1); PG8_BAR; PG8_SCHED;
            PG8_LDB(B0, 1, 0); PG8_LDB(B1, 1, 1); PG8_SCHED; PG8_LDA(At, 1, 0); PG8_STAGE(PG8_SA(0, 1), a2, vA1);
            PG8_WAIT_V(8); PG8_WAIT_L(0); PG8_BAR; PG8_MMA(0, 0, At, B0); PG8_MMA(0, 1, At, B1); PG8_BAR; PG8_SCHED;
            PG8_LDA(At, 1, 1); PG8_STAGE(PG8_SB(1, 0), b3, voffB); PG8_STAGE(PG8_SB(1, 1), b3 + hstepB, voffB); PG8_STAGE(PG8_SA(1, 0), a3, vA0);
            PG8_WAIT_V(8); PG8_WAIT_L(0); PG8_BAR; PG8_MMA(1, 0, At, B0); PG8_MMA(1, 1, At, B1); PG8_BAR; PG8_SCHED;
        }
        if (wr == 0) PG8_BAR;
        S.epi(acc, cur, wr, wc, fr, fq);
        if (!has_next) break;
#pragma unroll
        for (int a = 0; a < 2; ++a)
#pragma unroll
            for (int b = 0; b < 2; ++b)
#pragma unroll
                for (int m = 0; m < 4; ++m)
#pragma unroll
                    for (int n = 0; n < 2; ++n) acc[a][b][m][n] = (f32x4){0.f, 0.f, 0.f, 0.f};
        cur = nxt; cA = nA; cB = nB; ++ui;
        if (wr == 1) PG8_BAR;
    }
    PG8_WAIT_V(0);
    PG8_BAR;
#undef PG8_AOFF
#undef PG8_SA
#undef PG8_SB
#undef PG8_STAGE
#undef PG8_LDA
#undef PG8_LDB
#undef PG8_MMA
#undef PG8_CAT
#undef PG8_WAIT_V
#undef PG8_WAIT_L
#undef PG8_BAR
#undef PG8_SCHED
}

template <class P>
__device__ __forceinline__ void gemm_phase_m128(LAS unsigned char* lds, const P& S) {
    int tid_ = threadIdx.x; asm volatile("" : "+v"(tid_));
    const int tid = tid_, wid = __builtin_amdgcn_readfirstlane(tid >> 6), lane = tid & 63, wr = wid >> 2, wc = wid & 3, fr = lane & 15, fq = lane >> 4;
    constexpr int ELB = P::FP8 ? 1 : 2;
    const int K = S.K; int nt = K * ELB / 128; asm volatile("" : "+s"(nt));
    unsigned voffB[2];
#pragma unroll
    for (int i = 0; i < 2; ++i) { int R, C; stage_rc(tid * 16 + i * 8192, R, C); const int Rb = (R & ~31) + perm32(R & 31); voffB[i] = (unsigned)(Rb * K * ELB + C * 2); }
#define PG8_AOFF(dst0, u) do { _Pragma("unroll") for (int i = 0; i < 2; ++i) { int R, C; stage_rc(tid * 16 + i * 8192, R, C); dst0[i] = S.a_off(u, R, C); } } while (0)
    const size_t kstepB = (size_t)(BK * 2), hstepB = (size_t)HALF * K * ELB, kstepA = (size_t)S.kstepA;
    const unsigned ldsw = (unsigned)wid * 1024u;
    const int aoff = lds_byte(wr * 64 + fr, fq * 8), boff = lds_byte(wc * 32 + fr, fq * 8);
#define PG8_SA(b) (((b) * 2) * HTB)
#define PG8_SB(b, h) ((4 + (b) * 2 + (h)) * HTB)
#define PG8_STAGE(bufoff, gbase, voff) do { _Pragma("unroll") for (int _i = 0; _i < 2; ++_i) \
        __builtin_amdgcn_global_load_lds((const unsigned*)((const char*)(gbase) + (voff)[_i]), (LAS unsigned*)(lds + (bufoff) + ldsw + _i * 8192), 16, 0, 0); } while (0)
#define PG8_LDA(dst, b) do { _Pragma("unroll") for (int m = 0; m < 4; ++m) _Pragma("unroll") for (int k = 0; k < 2; ++k) dst[m][k] = *(const LAS bf16x8*)(lds + PG8_SA(b) + aoff + m * 2048 + k * 1024); } while (0)
#define PG8_LDB(dst, b, h) do { _Pragma("unroll") for (int n = 0; n < 2; ++n) _Pragma("unroll") for (int k = 0; k < 2; ++k) dst[n][k] = *(const LAS bf16x8*)(lds + PG8_SB(b, h) + boff + n * 2048 + k * 1024); } while (0)
#define PG8_CAT(x0, x1) __builtin_shufflevector(__builtin_bit_cast(v4i, x0), __builtin_bit_cast(v4i, x1), 0, 1, 2, 3, 4, 5, 6, 7)
#define PG8_MMA(bj, At, Bt) do { __builtin_amdgcn_s_setprio(1); _Pragma("unroll") for (int m = 0; m < 4; ++m) _Pragma("unroll") for (int n = 0; n < 2; ++n) { \
        if constexpr (P::FP8) acc[bj][m][n] = __builtin_amdgcn_mfma_scale_f32_16x16x128_f8f6f4(PG8_CAT(Bt[n][0], Bt[n][1]), PG8_CAT(At[m][0], At[m][1]), acc[bj][m][n], 0, 0, 0, 0x7f7f7f7f, 0, 0x7f7f7f7f); \
        else { _Pragma("unroll") for (int k = 0; k < 2; ++k) acc[bj][m][n] = __builtin_amdgcn_mfma_f32_16x16x32_bf16(Bt[n][k], At[m][k], acc[bj][m][n], 0, 0, 0); } } __builtin_amdgcn_s_setprio(0); } while (0)
#define PG8_WAIT_V(n) asm volatile("s_waitcnt vmcnt(" #n ")" ::: "memory")
#define PG8_WAIT_L(n) asm volatile("s_waitcnt lgkmcnt(" #n ")" ::: "memory")
#define PG8_BAR __builtin_amdgcn_s_barrier()
#define PG8_SCHED __builtin_amdgcn_sched_barrier(0)
    Unit cur, nxt; int ui = 0;
    if (!S.next(0, cur)) return;
    f32x4 acc[2][4][2], st[2][4][2];
#pragma unroll
    for (int a = 0; a < 2; ++a)
#pragma unroll
        for (int m = 0; m < 4; ++m)
#pragma unroll
            for (int n = 0; n < 2; ++n) { acc[a][m][n] = (f32x4){0.f, 0.f, 0.f, 0.f}; st[a][m][n] = (f32x4){0.f, 0.f, 0.f, 0.f}; }
    bf16x8 At[4][2], B0[2][2];
    unsigned vA[2], vN[2];
    PG8_AOFF(vA, cur);
    const char* cA = S.a_base(cur); const char* cB = S.b_base(cur);
    PG8_STAGE(PG8_SB(0, 0), cB, voffB); PG8_STAGE(PG8_SA(0), cA, vA); PG8_STAGE(PG8_SB(0, 1), cB + hstepB, voffB);
    if (wr == 1) PG8_BAR;
    PG8_WAIT_V(2); PG8_BAR;
    PG8_STAGE(PG8_SB(1, 0), cB + kstepB, voffB); PG8_STAGE(PG8_SA(1), cA + kstepA, vA);
    PG8_WAIT_V(4); PG8_BAR;
    for (;;) {
        const bool has_next = S.next(ui + 1, nxt);
        const char* nA = cA; const char* nB = cB;
        if (has_next) { nA = S.a_base(nxt); nB = S.b_base(nxt); if (P::EARLY_AOFF) PG8_AOFF(vN, nxt); }
        for (int t = 0; t < nt; t += 2) {
            const bool last = (t == nt - 2);
            const char* b1 = cB + (size_t)(t + 1) * kstepB;
            const char* a2 = last ? nA : cA + (size_t)(t + 2) * kstepA; const char* b2 = last ? nB : cB + (size_t)(t + 2) * kstepB;
            const char* a3 = a2 + kstepA; const char* b3 = b2 + kstepB;
            PG8_LDB(B0, 0, 0); PG8_SCHED; PG8_LDA(At, 0); PG8_STAGE(PG8_SB(1, 1), b1 + hstepB, voffB);
            if (last && has_next) { if (P::EARLY_AOFF) { vA[0] = vN[0]; vA[1] = vN[1]; } else PG8_AOFF(vA, nxt); }
            PG8_WAIT_V(6); PG8_WAIT_L(0); PG8_BAR; PG8_MMA(0, At, B0); PG8_BAR; PG8_SCHED;
            PG8_LDB(B0, 0, 1); PG8_STAGE(PG8_SB(0, 0), b2, voffB); PG8_STAGE(PG8_SA(0), a2, vA);
            PG8_WAIT_V(6); PG8_WAIT_L(0); PG8_BAR; PG8_MMA(1, At, B0); PG8_BAR; PG8_SCHED;
            PG8_LDB(B0, 1, 0); PG8_SCHED; PG8_LDA(At, 1); PG8_STAGE(PG8_SB(0, 1), b2 + hstepB, voffB);
            PG8_WAIT_V(6); PG8_WAIT_L(0); PG8_BAR; PG8_MMA(0, At, B0); PG8_BAR; PG8_SCHED;
            PG8_LDB(B0, 1, 1); PG8_STAGE(PG8_SB(1, 0), b3, voffB); PG8_STAGE(PG8_SA(1), a3, vA);
            PG8_WAIT_V(6); PG8_WAIT_L(0); PG8_BAR; PG8_MMA(1, At, B0); PG8_BAR; PG8_SCHED;
        }
        if (wr == 0) PG8_BAR;
        S.epi(acc, st, cur, wr, wc, fr, fq);
        if (!has_next) break;
#pragma unroll
        for (int a = 0; a < 2; ++a)
#pragma unroll
            for (int m = 0; m < 4; ++m)
#pragma unroll
                for (int n = 0; n < 2; ++n) acc[a][m][n] = (f32x4){0.f, 0.f, 0.f, 0.f};
        cur = nxt; cA = nA; cB = nB; ++ui;
        if (wr == 1) PG8_BAR;
    }
    PG8_WAIT_V(0);
    PG8_BAR;
#undef PG8_AOFF
#undef PG8_SA
#undef PG8_SB
#undef PG8_STAGE
#undef PG8_LDA
#undef PG8_LDB
#undef PG8_MMA
#undef PG8_CAT
#undef PG8_WAIT_V
#undef PG8_WAIT_L
#undef PG8_BAR
#undef PG8_SCHED
}
}
namespace attn_body {
using bf16x8 = __attribute__((ext_vector_type(8))) short;
using u32x4 = __attribute__((ext_vector_type(4))) unsigned;
constexpr int NW = 8, QBLK = 32, QB = QBLK * NW, KVBLK = 64;
__device__ __forceinline__ int crow(int r, int hi) { return (r & 3) + 8 * (r >> 2) + 4 * hi; }
#define SBAR() __builtin_amdgcn_sched_barrier(0)
constexpr int NSLOT = 3, SLOTB = 8192;
constexpr int LDS_K = 0, LDS_V = NSLOT * SLOTB, LDS_WS = 2 * NSLOT * SLOTB, LDS_OST = LDS_WS + NW * 64 * 4, LDS_BYTES = LDS_OST + NW * 4096;
constexpr int LDS_BT = 86016 + 256;
__device__ __forceinline__ void glds16(const void* gsrc, unsigned lds_dst) { unsigned keep;
  asm volatile("s_mov_b32 %0, m0\n\ts_mov_b32 m0, %2\n\ts_nop 0\n\tglobal_load_lds_dwordx4 %1, off\n\ts_mov_b32 m0, %0" : "=&s"(keep) : "v"(gsrc), "s"(lds_dst) : "memory"); }
__device__ __forceinline__ float max3f(float a, float b, float c) { float r; asm("v_max3_f32 %0, %1, %2, %3" : "=v"(r) : "v"(a), "v"(b), "v"(c)); return r; }
__device__ __forceinline__ float max2f(float a, float b) { float r; asm("v_max_f32_e32 %0, %1, %2" : "=v"(r) : "v"(a), "v"(b)); return r; }
__device__ __forceinline__ float fadd_s(float a, float b) { float r; asm("v_add_f32_e32 %0, %1, %2" : "=v"(r) : "v"(a), "v"(b)); return r; }
__device__ __forceinline__ float fsub_s(float a, float b) { float r; asm("v_sub_f32_e32 %0, %1, %2" : "=v"(r) : "v"(a), "v"(b)); return r; }
typedef float f32x2_t __attribute__((ext_vector_type(2))); typedef __bf16 bf16x2_t __attribute__((ext_vector_type(2)));
__device__ __forceinline__ unsigned cvtpk_s(float lo, float hi) { f32x2_t v = {lo, hi}; bf16x2_t b = __builtin_convertvector(v, bf16x2_t); return __builtin_bit_cast(unsigned, b); }
#define WAIT_BAR(N) asm volatile("s_waitcnt vmcnt(" #N ") lgkmcnt(0)\n\ts_barrier" ::: "memory")

__device__ __forceinline__ void qkt(f32x16& p0, f32x16& p1, const char* Kslot, const bf16x8* qr, const f32x16& negm, int r32, int hi) {
  const char* kb = Kslot + hi * 1024 + r32 * 16;
  #pragma unroll
  for (int d0 = 0; d0 < 4; ++d0) {
    const bf16x8 b0 = *reinterpret_cast<const bf16x8*>(kb + d0 * 2048);
    const bf16x8 b1 = *reinterpret_cast<const bf16x8*>(kb + d0 * 2048 + 512);
    if (d0 == 0) { p0 = __builtin_amdgcn_mfma_f32_32x32x16_bf16(b0, qr[0], negm, 0, 0, 0); p1 = __builtin_amdgcn_mfma_f32_32x32x16_bf16(b1, qr[0], negm, 0, 0, 0); }
    else { p0 = __builtin_amdgcn_mfma_f32_32x32x16_bf16(b0, qr[d0], p0, 0, 0, 0); p1 = __builtin_amdgcn_mfma_f32_32x32x16_bf16(b1, qr[d0], p1, 0, 0, 0); } }
}
typedef __attribute__((address_space(3))) const char* lds_cptr;
typedef short v4i16_t __attribute__((ext_vector_type(4)));
__device__ __forceinline__ void kload8(bf16x8* kf, lds_cptr kp) {
  kf[0] = *(const __attribute__((address_space(3))) bf16x8*)(kp);        kf[1] = *(const __attribute__((address_space(3))) bf16x8*)(kp + 512);
  kf[2] = *(const __attribute__((address_space(3))) bf16x8*)(kp + 2048); kf[3] = *(const __attribute__((address_space(3))) bf16x8*)(kp + 2560);
  kf[4] = *(const __attribute__((address_space(3))) bf16x8*)(kp + 4096); kf[5] = *(const __attribute__((address_space(3))) bf16x8*)(kp + 4608);
  kf[6] = *(const __attribute__((address_space(3))) bf16x8*)(kp + 6144); kf[7] = *(const __attribute__((address_space(3))) bf16x8*)(kp + 6656);
}
__device__ __forceinline__ void kload2(bf16x8* kf, lds_cptr kp, int j) { kf[2 * j] = *(const __attribute__((address_space(3))) bf16x8*)(kp + j * 2048); kf[2 * j + 1] = *(const __attribute__((address_space(3))) bf16x8*)(kp + j * 2048 + 512); }
__device__ __forceinline__ s16x4 vtr(lds_cptr p) { return __builtin_bit_cast(s16x4, __builtin_amdgcn_ds_read_tr16_b64_v4i16((__attribute__((address_space(3))) v4i16_t*)p)); }
__device__ __forceinline__ float rowmax(const f32x16& p0, const f32x16& p1) {
  float a = max3f(p0[0], p0[1], p1[0]), b = max3f(p0[2], p0[3], p1[1]); a = max3f(a, p1[2], p1[3]);
  #pragma unroll
  for (int r = 4; r < 16; r += 4) { a = max3f(a, p0[r], p0[r + 1]); b = max3f(b, p0[r + 2], p0[r + 3]); a = max3f(a, p1[r], p1[r + 1]); b = max3f(b, p1[r + 2], p1[r + 3]); }
  const float m = max2f(a, b);
  auto rr = __builtin_amdgcn_permlane32_swap(__float_as_uint(m), __float_as_uint(m), false, false);
  return max2f(__uint_as_float(rr[0]), __uint_as_float(rr[1]));
}
__device__ __forceinline__ void pv(f32x16* o, int vb, bf16x8 pa0, bf16x8 pa1, bf16x8 pa2, bf16x8 pa3) {
  #pragma unroll
  for (int d0 = 0; d0 < 2; ++d0) { s16x4 lo[4], hi[4];
    #pragma unroll
    for (int ks = 0; ks < 4; ++ks) {
      asm volatile("ds_read_b64_tr_b16 %0,%1 offset:%c2" : "=&v"(lo[ks]) : "v"(vb), "i"(d0 * 4096 + ks * 1024) : "memory");
      asm volatile("ds_read_b64_tr_b16 %0,%1 offset:%c2" : "=&v"(hi[ks]) : "v"(vb), "i"(d0 * 4096 + ks * 1024 + 512) : "memory"); }
    asm volatile("s_waitcnt lgkmcnt(0)" ::: "memory"); SBAR();
    #define PK(k) (bf16x8){lo[k][0], lo[k][1], lo[k][2], lo[k][3], hi[k][0], hi[k][1], hi[k][2], hi[k][3]}
    o[d0] = __builtin_amdgcn_mfma_f32_32x32x16_bf16(pa0, PK(0), o[d0], 0, 0, 0);
    o[d0] = __builtin_amdgcn_mfma_f32_32x32x16_bf16(pa1, PK(1), o[d0], 0, 0, 0);
    o[d0] = __builtin_amdgcn_mfma_f32_32x32x16_bf16(pa2, PK(2), o[d0], 0, 0, 0);
    o[d0] = __builtin_amdgcn_mfma_f32_32x32x16_bf16(pa3, PK(3), o[d0], 0, 0, 0);
    #undef PK
  }
}
#define ATTN_STORE16(p, v) (*(u32x4*)(p) = (v))

template <int THRL, bool NA, int QP_, int KVP_, bool NOMAX = false>
__device__ __forceinline__ void attn_unit(const bf16* Qu, int qp_rt, const bf16* __restrict__ Kh, const bf16* __restrict__ Vh, int kvp_rt, bf16* Ou, int NT, int r0, int rlo, char* shm) {
  const int qp = QP_ ? QP_ : qp_rt, kvp = KVP_ ? KVP_ : kvp_rt, op = qp;
  int tid_ = threadIdx.x; asm volatile("" : "+v"(tid_));
  const int tid = tid_, lane = tid & 63, r32 = lane & 31, hi = lane >> 5; const int wid = __builtin_amdgcn_readfirstlane(tid >> 6);
  const bf16* Qw = Qu + (long)(wid * QBLK) * qp;
  const unsigned lds0 = (unsigned)(uintptr_t)shm;
  float* wsf = (float*)(shm + LDS_WS) + wid * 64;
  const bf16* ksrc = Kh + (long)lane * kvp + wid * 8;
  const bf16* vsrc = Vh + (long)(16 * (wid & 3) + (lane >> 2)) * kvp + (wid >> 2) * 32 + (lane & 3) * 8;
  const unsigned kdst = lds0 + LDS_K + wid * 1024, vdst = lds0 + LDS_V + wid * 1024;
  #define TROW(t) (NA ? ((t) < 4 ? 64 * (t) : CTX + 64 * ((rlo + (t) - 4) < 127 ? (rlo + (t) - 4) : 127)) : 64 * (t))
  #define DMA_K(t, slot) glds16(ksrc + (long)TROW(t) * kvp, (unsigned)__builtin_amdgcn_readfirstlane(kdst + (slot)))
  #define DMA_V(t, slot) glds16(vsrc + (long)TROW(t) * kvp, (unsigned)__builtin_amdgcn_readfirstlane(vdst + (slot)))
  const int vb0 = (int)(lds0 + LDS_V) + ((lane >> 4) & 1) * 32 + (lane & 3) * 8 + (4 * hi + ((lane & 15) >> 2)) * 64;
  const char* Kbase = shm + LDS_K; bf16x8 kf[8];
  const lds_cptr shm3 = (lds_cptr)shm; const lds_cptr kp0 = shm3 + LDS_K + hi * 1024 + r32 * 16; const lds_cptr vp0 = shm3 + LDS_V + ((lane >> 4) & 1) * 32 + (lane & 3) * 8 + (4 * hi + ((lane & 15) >> 2)) * 64;
  const int rq = r0 + (wid >> 1), qc = 32 * (wid & 1) + r32;
  const int rsw = rq - 4 < 0 ? 0 : (rq - 4 > 120 ? 120 : rq - 4);
  const int cs = qc - 8 < 0 ? 0 : (qc - 8 > 48 ? 48 : qc - 8);
  const __attribute__((address_space(3))) float* btl = (const __attribute__((address_space(3))) float*)(shm3 + LDS_BT) + (15 + 4 * hi - qc);
  DMA_K(0, 0); DMA_V(0, 0); DMA_K(1, SLOTB);
  bf16x8 qr[4];
  #pragma unroll
  for (int d0 = 0; d0 < 4; ++d0) qr[d0] = *reinterpret_cast<const bf16x8*>(&Qw[(long)r32 * qp + d0 * 16 + hi * 8]);
  float mhat = 0.f, l_reg = 0.f; f32x16 o[2]; o[0] = f32x16{}; o[1] = f32x16{}; f32x16 negm = f32x16{}; if (!NA) asm volatile("" : "+v"(negm));
  #define NEGM (NA ? f32x16{} : negm)
  #define CMASK(P0, P1, t) do { if (NA) { if ((t) >= 4) { const int kr_ = rlo + (t) - 4; const int dr_ = kr_ - rsw; \
      if (dr_ < 0 || dr_ >= 8) { _Pragma("unroll") for (int r = 0; r < 16; ++r) { P0[r] = (-__builtin_inff()); P1[r] = (-__builtin_inff()); } } \
      else { const __attribute__((address_space(3))) float* bp_ = btl + (kr_ - rq + 7) * 31; const int kl0_ = 4 * hi - cs; \
        _Pragma("unroll") for (int rg = 0; rg < 4; ++rg) { \
          _Pragma("unroll") for (int rr_ = 0; rr_ < 4; ++rr_) { const int r = rg * 4 + rr_; const int kc_ = (r & 3) + 8 * (r >> 2); const float b0_ = bp_[kc_], b1_ = bp_[kc_ + 32]; \
            const int kl_ = kc_ + kl0_; P0[r] = ((unsigned)kl_ < 16u) ? P0[r] + b0_ : (-__builtin_inff()); P1[r] = ((unsigned)(kl_ + 32) < 16u) ? P1[r] + b1_ : (-__builtin_inff()); } \
          SBAR(); } } } } } while (0)
  bool resc = false;
  #define START(P0, P1) do { const float rm = NOMAX ? 0.f : rowmax(P0, P1); resc = false; \
    { const float dl = rm; mhat = fadd_s(mhat, dl); \
      _Pragma("unroll") for (int r = 0; r < 16; ++r) { P0[r] = fsub_s(P0[r], dl); P1[r] = fsub_s(P1[r], dl); } \
      if (!NA) { _Pragma("unroll") for (int r = 0; r < 16; ++r) negm[r] = -mhat; asm volatile("" : "+v"(negm)); } } \
    _Pragma("unroll") for (int r = 0; r < 16; ++r) P0[r] = __builtin_amdgcn_exp2f(P0[r]); } while (0)
  #define RESC() do { if (resc) { asm volatile("s_waitcnt lgkmcnt(0)" ::: "memory"); \
      _Pragma("unroll") for (int d_ = 0; d_ < 2; ++d_) _Pragma("unroll") for (int r = 0; r < 16; ++r) o[d_][r] *= wsf[crow(r, hi)]; } } while (0)
  f32x16 pA0, pA1, pB0, pB1;
  int sl_prev = 0, sl_cur = 0, sl_next = SLOTB;
  #define ROT() do { sl_prev = sl_cur; sl_cur = sl_next; sl_next = (sl_next == (NSLOT - 1) * SLOTB) ? 0 : sl_next + SLOTB; } while (0)
  DMA_K(2, 2 * SLOTB);
  WAIT_BAR(3);
  qkt(pA0, pA1, Kbase, qr, NEGM, r32, hi); asm volatile("s_nop 15\n\ts_nop 7" : "+v"(pA0), "+v"(pA1));
  START(pA0, pA1);
  _Pragma("unroll") for (int r = 0; r < 16; ++r) pA1[r] = __builtin_amdgcn_exp2f(pA1[r]);
  WAIT_BAR(0);
  DMA_K(3, 0); DMA_V(1, SLOTB);
  ROT();
  kload8(kf, kp0 + sl_cur);
  WAIT_BAR(2);
  s16x4 vlo[8], vhi[8]; u32x4 pw0, pw1, pw2, pw3;
  #define PKW(P, B) cvtpk_s(P[B], P[B + 1])
  #define PAF(k) __builtin_bit_cast(bf16x8, pw##k)
  #define VFR(i) (bf16x8){vlo[i][0], vlo[i][1], vlo[i][2], vlo[i][3], vhi[i][0], vhi[i][1], vhi[i][2], vhi[i][3]}
  #define PIN(x) asm volatile("" : "+v"(x))
  #define MX3(a, b, c) __builtin_fmaxf(__builtin_fmaxf((a), (b)), (c))
  #define GAPA(MF, A0, A1, A2, A3, W0, W1, PW) do { MF; sacc2 += (f32x2_t){A0, A1}; sacc2 += (f32x2_t){A2, A3}; PIN(sacc2); W0; W1; PIN(PW); SBAR(); } while (0)
  #define EX(v) __builtin_amdgcn_exp2f(v)
  #define GAPB(MF, X, B) do { MF; X[B] = EX(X[B]); X[B + 1] = EX(X[B + 1]); X[B + 2] = EX(X[B + 2]); X[B + 3] = EX(X[B + 3]); PIN(X); SBAR(); } while (0)
  #define VRD(i) do { vlo[i] = vtr(vp_ + (((i) >> 2) * 4096 + ((i) & 3) * 1024)); vhi[i] = vtr(vp_ + (((i) >> 2) * 4096 + ((i) & 3) * 1024 + 512)); } while (0)
  #define KRD(G, j) do { if (G) { kload2(kf, kp0 + sl_next, j); SBAR(); } } while (0)
  #define STEP(C0, C1, P0, P1, t, GK, GV, GL) do { SBAR(); \
    const lds_cptr vp_ = vp0 + sl_prev; \
    VRD(0); SBAR(); f32x2_t sacc2 = (f32x2_t){P0[0], P0[1]}; \
    GAPA(C0 = __builtin_amdgcn_mfma_f32_32x32x16_bf16(kf[0], qr[0], NEGM, 0, 0, 0), P0[2], P0[3], P0[4], P0[5],     pw0[0] = PKW(P0, 0), pw0[1] = PKW(P0, 2), pw0); \
    VRD(4); SBAR(); GAPA(C1 = __builtin_amdgcn_mfma_f32_32x32x16_bf16(kf[1], qr[0], NEGM, 0, 0, 0), P0[6], P0[7], P0[8], P0[9],     pw0[2] = PKW(P0, 4), pw0[3] = PKW(P0, 6), pw0); \
    VRD(1); SBAR(); GAPA(C0 = __builtin_amdgcn_mfma_f32_32x32x16_bf16(kf[2], qr[1], C0, 0, 0, 0),   P0[10], P0[11], P0[12], P0[13], pw1[0] = PKW(P0, 8), pw1[1] = PKW(P0, 10), pw1); \
    VRD(5); SBAR(); GAPA(C1 = __builtin_amdgcn_mfma_f32_32x32x16_bf16(kf[3], qr[1], C1, 0, 0, 0),   P0[14], P0[15], P1[0], P1[1],   pw1[2] = PKW(P0, 12), pw1[3] = PKW(P0, 14), pw1); \
    VRD(2); SBAR(); GAPA(C0 = __builtin_amdgcn_mfma_f32_32x32x16_bf16(kf[4], qr[2], C0, 0, 0, 0),   P1[2], P1[3], P1[4], P1[5],     pw2[0] = PKW(P1, 0), pw2[1] = PKW(P1, 2), pw2); \
    VRD(6); SBAR(); GAPA(C1 = __builtin_amdgcn_mfma_f32_32x32x16_bf16(kf[5], qr[2], C1, 0, 0, 0),   P1[6], P1[7], P1[8], P1[9],     pw2[2] = PKW(P1, 4), pw2[3] = PKW(P1, 6), pw2); \
    VRD(3); SBAR(); GAPA(C0 = __builtin_amdgcn_mfma_f32_32x32x16_bf16(kf[6], qr[3], C0, 0, 0, 0),   P1[10], P1[11], P1[12], P1[13], pw3[0] = PKW(P1, 8), pw3[1] = PKW(P1, 10), pw3); \
    VRD(7); SBAR(); GAPA(C1 = __builtin_amdgcn_mfma_f32_32x32x16_bf16(kf[7], qr[3], C1, 0, 0, 0),   P1[14], P1[15], 0.f, 0.f,       pw3[2] = PKW(P1, 12), pw3[3] = PKW(P1, 14), pw3); \
    l_reg += sacc2.x + sacc2.y; \
    if (GK) { DMA_K((t) + 3, sl_cur); } if (GV) { DMA_V((t) + 1, sl_next); } \
    resc = false; \
    if (NA) { _Pragma("unroll") for (int r = 0; r < 16; ++r) { C0[r] -= mhat; C1[r] -= mhat; } } \
    CMASK(C0, C1, t); \
    if (!NOMAX) { float a = MX3(C0[0], C0[1], C1[0]), b = MX3(C0[2], C0[3], C1[1]); a = MX3(a, C1[2], C1[3]); \
      _Pragma("unroll") for (int r = 4; r < 16; r += 4) { a = MX3(a, C0[r], C0[r + 1]); b = MX3(b, C0[r + 2], C0[r + 3]); a = MX3(a, C1[r], C1[r + 1]); b = MX3(b, C1[r + 2], C1[r + 3]); } \
      float rm = __builtin_fmaxf(a, b); { auto rr = __builtin_amdgcn_permlane32_swap(__float_as_uint(rm), __float_as_uint(rm), false, false); rm = __builtin_fmaxf(__uint_as_float(rr[0]), __uint_as_float(rr[1])); } \
      if (__builtin_expect(__any(rm > (float)THRL), 0)) { const float dl = __builtin_fmaxf(rm, 0.f); mhat += dl; \
        _Pragma("unroll") for (int r = 0; r < 16; ++r) { C0[r] -= dl; C1[r] -= dl; } \
        if (!NA) { _Pragma("unroll") for (int r = 0; r < 16; ++r) negm[r] = -mhat; asm volatile("" : "+v"(negm)); } \
        const float f = __builtin_amdgcn_exp2f(-dl); l_reg *= f; if (hi == 0) wsf[r32] = f; resc = true; } } \
    SBAR(); \
    GAPB(o[0] = __builtin_amdgcn_mfma_f32_32x32x16_bf16(PAF(0), VFR(0), o[0], 0, 0, 0), C0, 0); \
    GAPB(o[1] = __builtin_amdgcn_mfma_f32_32x32x16_bf16(PAF(0), VFR(4), o[1], 0, 0, 0), C0, 4); \
    KRD(GL, 0); GAPB(o[0] = __builtin_amdgcn_mfma_f32_32x32x16_bf16(PAF(1), VFR(1), o[0], 0, 0, 0), C0, 8); \
    KRD(GL, 1); GAPB(o[1] = __builtin_amdgcn_mfma_f32_32x32x16_bf16(PAF(1), VFR(5), o[1], 0, 0, 0), C0, 12); \
    KRD(GL, 2); GAPB(o[0] = __builtin_amdgcn_mfma_f32_32x32x16_bf16(PAF(2), VFR(2), o[0], 0, 0, 0), C1, 0); \
    KRD(GL, 3); GAPB(o[1] = __builtin_amdgcn_mfma_f32_32x32x16_bf16(PAF(2), VFR(6), o[1], 0, 0, 0), C1, 4); \
    GAPB(o[0] = __builtin_amdgcn_mfma_f32_32x32x16_bf16(PAF(3), VFR(3), o[0], 0, 0, 0), C1, 8); \
    GAPB(o[1] = __builtin_amdgcn_mfma_f32_32x32x16_bf16(PAF(3), VFR(7), o[1], 0, 0, 0), C1, 12); \
    } while (0)
  int t = 1;
  for (; t + 5 < NT; t += 2) {
    STEP(pB0, pB1, pA0, pA1, t, true, true, true);     WAIT_BAR(2); RESC(); ROT();
    STEP(pA0, pA1, pB0, pB1, t + 1, true, true, true); WAIT_BAR(2); RESC(); ROT();
  }
  #define ENDW(tt) do { if ((tt) + 3 < NT) { WAIT_BAR(2); } else if ((tt) + 2 < NT) { WAIT_BAR(1); } else { WAIT_BAR(0); } } while (0)
  for (; t + 1 < NT; t += 2) {
    STEP(pB0, pB1, pA0, pA1, t, (t + 3 < NT), (t + 1 < NT), (t + 1 < NT));         ENDW(t);     RESC(); ROT();
    STEP(pA0, pA1, pB0, pB1, t + 1, (t + 4 < NT), (t + 2 < NT), (t + 2 < NT));     ENDW(t + 1); RESC(); ROT();
  }
  STEP(pB0, pB1, pA0, pA1, NT - 1, false, false, false); RESC();
  { float sacc = pB0[0] + pB0[1]; _Pragma("unroll") for (int r = 2; r < 16; ++r) sacc += pB0[r]; _Pragma("unroll") for (int r = 0; r < 16; ++r) sacc += pB1[r]; l_reg += sacc;
    pw0 = (u32x4){PKW(pB0, 0), PKW(pB0, 2), PKW(pB0, 4), PKW(pB0, 6)}; pw1 = (u32x4){PKW(pB0, 8), PKW(pB0, 10), PKW(pB0, 12), PKW(pB0, 14)}; pw2 = (u32x4){PKW(pB1, 0), PKW(pB1, 2), PKW(pB1, 4), PKW(pB1, 6)}; pw3 = (u32x4){PKW(pB1, 8), PKW(pB1, 10), PKW(pB1, 12), PKW(pB1, 14)};
    SBAR(); pv(o, vb0 + sl_cur, PAF(0), PAF(1), PAF(2), PAF(3)); }
  #undef PKW
  #undef PAF
  #undef VFR
  #undef PIN
  #undef MX3
  #undef GAPA
  #undef GAPB
  #undef EX
  #undef VRD
  #undef KRD
  #undef STEP
  #undef ENDW
  { auto rr = __builtin_amdgcn_permlane32_swap(__float_as_uint(l_reg), __float_as_uint(l_reg), false, false); l_reg = __uint_as_float(rr[0]) + __uint_as_float(rr[1]); }
  if (hi == 0) wsf[32 + r32] = l_reg; asm volatile("s_waitcnt lgkmcnt(0)" ::: "memory");
  float rli[16];
  #pragma unroll
  for (int r = 0; r < 16; ++r) rli[r] = __builtin_amdgcn_rcpf(wsf[32 + crow(r, hi)]);
  bf16* Ow = Ou + (long)(wid * QBLK) * op;
  { bf16* stg = (bf16*)(shm + LDS_OST) + wid * 2048;
    #pragma unroll
    for (int r = 0; r < 16; ++r) { const int orow = crow(r, hi);
      #pragma unroll
      for (int d0 = 0; d0 < 2; ++d0) stg[orow * 64 + d0 * 32 + r32] = (bf16)f2bf(o[d0][r] * rli[r]); }
    asm volatile("s_waitcnt lgkmcnt(0)" ::: "memory");
    #pragma unroll
    for (int i = 0; i < 4; ++i) { const int row = i * 8 + (lane >> 3), ch = lane & 7; const u32x4 v = *(const u32x4*)(stg + row * 64 + ch * 8); ATTN_STORE16(Ow + (long)row * op + ch * 8, v); } }
  asm volatile("s_waitcnt lgkmcnt(0)\n\ts_barrier" ::: "memory");
  #undef NEGM
  #undef DMA_K
  #undef DMA_V
  #undef TROW
  #undef CMASK
  #undef START
  #undef RESC
  #undef ROT
}
#undef SBAR
#undef WAIT_BAR
}
#ifndef FP8_MOE
#define FP8_MOE 1
#endif
struct Args { const float* in[29]; float* out; unsigned char* ws; int ph_lo, ph_hi; };
enum { I_X = 0, I_C, I_CTX, I_CCTX, I_WMOD, I_BMOD, I_N1G, I_N2G, I_WIN, I_LRE, I_LIM, I_LDT, I_BRE, I_BIM, I_CRE, I_CIM, I_SSMD, I_WGLU, I_QNG, I_KNG, I_RPB, I_WBR, I_WOUT, I_RW, I_RB, I_MG, I_MU, I_MD, I_FNG };

typedef const float* CFP;
struct Ctx {
    const __attribute__((address_space(4))) CFP* in; float* out; unsigned char* ws; LAS unsigned char* lds; gu32* ctl;
    int tid, lane, wave, vcu, G;
};
#define WSP(T_, off) ((T_*)(C.ws + (off)))

__device__ __forceinline__ float* xs_row(const Ctx& C, int m) { const int b = m / LB, j = m - b * LB; return j < CTX ? WSP(float, WS_CTXS) + (size_t)(b * CTX + j) * D : C.out + (size_t)(b * SEQ + j - CTX) * D; }
__device__ __forceinline__ const float* in_row(const Ctx& C, int m) { const int b = m / LB, j = m - b * LB; return j < CTX ? C.in[I_CTX] + (size_t)(b * CTX + j) * D : C.in[I_X] + (size_t)(b * SEQ + j - CTX) * D; }
__device__ __forceinline__ int cond_of(int m) { const int b = m / LB, j = m - b * LB; return j < CTX ? 4 : b; }

__device__ __forceinline__ void transpose_item(const float* W, int N, int Kp, bf16* WT, int k0, int n0, int drow0, LAS float* scr, int lane) {
    const float* src = W + (size_t)k0 * N + n0 + lane;
    float tv[64];
#pragma unroll
    for (int i = 0; i < 64; ++i) tv[i] = src[(size_t)i * N];
#pragma unroll
    for (int i = 0; i < 64; ++i) scr[i * 65 + lane] = tv[i];
    LDS_WAIT(); asm volatile("" ::: "memory");
    const int c = lane & 7;
#pragma unroll
    for (int j = 0; j < 8; ++j) { const int n = (lane >> 3) + 8 * j; const LAS float* s = scr + (8 * c) * 65 + n;
        v4u o; o.x = pk2(s[0 * 65], s[1 * 65]); o.y = pk2(s[2 * 65], s[3 * 65]); o.z = pk2(s[4 * 65], s[5 * 65]); o.w = pk2(s[6 * 65], s[7 * 65]);
        *(GAS v4u*)(WT + (size_t)(drow0 + n) * Kp + k0 + 8 * c) = o; }
    LDS_WAIT(); asm volatile("" ::: "memory");
}
__device__ __forceinline__ void transpose_item8(const float* W, int N, int Kp, unsigned char* WT, int k0, int n0, int drow0, float scale, LAS float* scr, int lane) {
    const float* src = W + (size_t)k0 * N + n0 + lane;
    float tv[64];
#pragma unroll
    for (int i = 0; i < 64; ++i) tv[i] = src[(size_t)i * N];
#pragma unroll
    for (int i = 0; i < 64; ++i) scr[i * 65 + lane] = tv[i] * scale;
    LDS_WAIT(); asm volatile("" ::: "memory");
    const int c = lane & 3;
#pragma unroll
    for (int j = 0; j < 4; ++j) { const int n = (lane >> 2) + 16 * j; const LAS float* s = scr + (16 * c) * 65 + n;
        v4u o; o.x = pk4_fp8(s[0 * 65], s[1 * 65], s[2 * 65], s[3 * 65]); o.y = pk4_fp8(s[4 * 65], s[5 * 65], s[6 * 65], s[7 * 65]); o.z = pk4_fp8(s[8 * 65], s[9 * 65], s[10 * 65], s[11 * 65]); o.w = pk4_fp8(s[12 * 65], s[13 * 65], s[14 * 65], s[15 * 65]);
        *(GAS v4u*)(WT + (size_t)(drow0 + n) * Kp + k0 + 16 * c) = o; }
    LDS_WAIT(); asm volatile("" ::: "memory");
}
__device__ __forceinline__ void phase_weights(const Ctx& C, int l) {
    LAS float* scr = (LAS float*)(C.lds + C.wave * 16640);
    const int gw = C.vcu * NWAVES + C.wave, NGW = C.G * NWAVES;
    constexpr int I0 = 16 * 92, I1 = 8 * 8, I2 = 3 * 8 * 16, I3 = 16 * 16, I4 = 16 * 16 * 8, I5 = I4, I6 = 16 * 8 * 16;
    for (int it = gw; it < I0 + I1 + I2 + I3 + I4 + I5 + I6; it += NGW) {
        int r = it;
        if (r < I0) { const int kb = r / 92, nb = r % 92; if (W8_ALL) transpose_item8(C.in[I_WIN] + (size_t)l * 1024 * INW, INW, 1024, WSP(unsigned char, WS_WIN), 64 * kb, 64 * nb, 64 * nb, 64.f, scr, C.lane);
            else if (nb < 44 || GATE_BF16) transpose_item(C.in[I_WIN] + (size_t)l * 1024 * INW, INW, 1024, WSP(bf16, WS_WIN), 64 * kb, 64 * nb, 64 * nb, scr, C.lane);
            else transpose_item8(C.in[I_WIN] + (size_t)l * 1024 * INW, INW, 1024, WSP(unsigned char, WS_WIN8), 64 * kb, 64 * nb, 64 * nb - 2816, 64.f, scr, C.lane); continue; } r -= I0;
        if (r < I1) { const int kb = r / 8, nb = r % 8; transpose_item(C.in[I_WGLU] + (size_t)l * 512 * 512, 512, 512, WSP(bf16, WS_WGLU), 64 * kb, 64 * nb, 64 * nb, scr, C.lane); continue; } r -= I1;
        if (r < I2) { const int i = r / 128, q = r % 128, kb = q / 16, nb = q % 16; transpose_item(C.in[I_WBR] + (size_t)(l * 3 + i) * 512 * 1024, 1024, 512, WSP(bf16, WS_WBR) + (size_t)i * 1024 * 512, 64 * kb, 64 * nb, 64 * nb, scr, C.lane); continue; } r -= I2;
        if (r < I3) { const int kb = r / 16, nb = r % 16; transpose_item(C.in[I_WOUT] + (size_t)l * 1024 * 1024, 1024, 1024, WSP(bf16, WS_WOUT), 64 * kb, 64 * nb, 64 * nb, scr, C.lane); continue; } r -= I3;
        if (r < I4 + I5) { const int up = r >= I4; if (up) r -= I4; const int e = r / 128, q = r % 128, kb = q / 8, nb = q % 8, n0 = 64 * nb;
            if (FP8_MOE) transpose_item8((up ? C.in[I_MU] : C.in[I_MG]) + (size_t)(l * 16 + e) * 1024 * 512, 512, 1024, WSP(unsigned char, WS_MOE1) + (size_t)e * 1024 * 1024, 64 * kb, n0, (n0 / 128) * 256 + (n0 % 128) + (up ? 128 : 0), 64.f, scr, C.lane);
            else transpose_item((up ? C.in[I_MU] : C.in[I_MG]) + (size_t)(l * 16 + e) * 1024 * 512, 512, 1024, WSP(bf16, WS_MOE1) + (size_t)e * 1024 * 1024, 64 * kb, n0, (n0 / 128) * 256 + (n0 % 128) + (up ? 128 : 0), scr, C.lane); continue; } r -= I4 + I5;
        { const int e = r / 128, q = r % 128, kb = q / 16, nb = q % 16; if (FP8_MOE) transpose_item8(C.in[I_MD] + (size_t)(l * 16 + e) * 512 * 1024, 1024, 512, WSP(unsigned char, WS_MOE2) + (size_t)e * 1024 * 512, 64 * kb, 64 * nb, 64 * nb, 32.f, scr, C.lane);
            else transpose_item(C.in[I_MD] + (size_t)(l * 16 + e) * 512 * 1024, 1024, 512, WSP(bf16, WS_MOE2) + (size_t)e * 1024 * 512, 64 * kb, 64 * nb, 64 * nb, scr, C.lane); }
    }
}

__device__ __forceinline__ void phase_mod(const Ctx& C) {
    LAS float* sc = (LAS float*)(C.lds);
    LAS float* red = (LAS float*)(C.lds + 20480);
    for (int i = C.tid; i < 5 * 1024; i += 512) { const int c = i >> 10, k = i & 1023; const float v = c < 4 ? C.in[I_C][c * 1024 + k] : C.in[I_CCTX][k]; sc[i] = v * fsigmoid(v); }
    __syncthreads();
    for (int it = C.vcu; it < NLAYER * 96; it += C.G) {
        const int l = it / 96, col = (it % 96) * 64 + C.lane, k0 = C.wave * 128;
        const float* W = C.in[I_WMOD] + (size_t)l * 1024 * 6144 + (size_t)k0 * 6144 + col;
        float a0 = 0.f, a1 = 0.f, a2 = 0.f, a3 = 0.f, a4 = 0.f;
#pragma unroll 16
        for (int k = 0; k < 128; ++k) { const float w = W[(size_t)k * 6144]; a0 += sc[k0 + k] * w; a1 += sc[1024 + k0 + k] * w; a2 += sc[2048 + k0 + k] * w; a3 += sc[3072 + k0 + k] * w; a4 += sc[4096 + k0 + k] * w; }
        LAS float* r = red + C.wave * 320 + C.lane; r[0] = a0; r[64] = a1; r[128] = a2; r[192] = a3; r[256] = a4;
        __syncthreads();
        if (C.tid < 320) { const int c = C.tid >> 6; float s = C.in[I_BMOD][l * 6144 + col];
#pragma unroll
            for (int w = 0; w < 8; ++w) s += red[w * 320 + C.tid];
            WSP(float, WS_MOD)[(size_t)(l * 5 + c) * 6144 + col] = s; }
        __syncthreads();
    }
}

__device__ __forceinline__ void phase_s5mats(const Ctx& C, int l) {
    if (C.vcu >= 128) return;
    const int g = C.vcu >> 2, part = C.vcu & 3, tid = C.tid;
    LAS f32x2* POW = (LAS f32x2*)(C.lds);
    LAS f32x2* CC = (LAS f32x2*)(C.lds + 33792);
    LAS f32x2* BB = (LAS f32x2*)(C.lds + 50176);
    LAS f32x2* COEF = (LAS f32x2*)(C.lds + 66560);
    LAS bf16* KT = (LAS bf16*)(C.lds + 67584);
    LAS float* K0 = (LAS float*)(C.lds + 99840);
    __syncthreads();
    if (tid < 128) {
        const int d = tid >> 6, p = tid & 63; const int li = ((l * 2 + d) * 32 + g) * 64 + p;
        const float re = C.in[I_LRE][li], im = C.in[I_LIM][li], dt = __expf(C.in[I_LDT][(l * 2 + d) * 32 + g]);
        for (int tau = 0; tau <= 32; ++tau) { const float mag = __expf(re * dt * (float)tau), rev = im * dt * (float)tau * 0.15915494309189535f;
            POW[(d * 33 + tau) * 64 + p] = (f32x2){mag * cos_rev(rev), mag * sin_rev(rev)}; }
        const float mag = __expf(re * dt), rev = im * dt * 0.15915494309189535f; const float lr = mag * cos_rev(rev) - 1.f, lim = mag * sin_rev(rev);
        const float den = 1.f / (re * re + im * im);
        COEF[tid] = (f32x2){(lr * re + lim * im) * den, (lim * re - lr * im) * den};
    }
    __syncthreads();
    for (int i = tid; i < 2048; i += 512) {
        const int d = i >> 10, p = (i >> 4) & 63, h = i & 15; const size_t bi = (((size_t)(l * 2 + d) * 32 + g) * 64 + p) * 16 + h;
        const float br = C.in[I_BRE][bi], bi_ = C.in[I_BIM][bi]; const f32x2 cf = COEF[d * 64 + p];
        BB[i] = (f32x2){cf.x * br - cf.y * bi_, cf.x * bi_ + cf.y * br};
        const int h2 = (i >> 6) & 15, p2 = i & 63; const size_t ci = (((size_t)(l * 2 + d) * 32 + g) * 16 + h2) * 64 + p2;
        CC[i] = (f32x2){C.in[I_CRE][ci], C.in[I_CIM][ci]};
    }
    __syncthreads();
    {
        const int d = tid >> 8, h = (tid >> 4) & 15, hp = tid & 15; float acc[32];
#pragma unroll
        for (int t = 0; t < 32; ++t) acc[t] = 0.f;
        for (int p = 0; p < 64; ++p) { const f32x2 c = CC[d * 1024 + h * 64 + p], b = BB[d * 1024 + p * 16 + hp], lam = POW[(d * 33 + 1) * 64 + p];
            float xr = c.x * b.x - c.y * b.y, xi = c.x * b.y + c.y * b.x;
#pragma unroll
            for (int t = 0; t < 32; ++t) { acc[t] += xr; const float nr = xr * lam.x - xi * lam.y, ni = xr * lam.y + xi * lam.x; xr = nr; xi = ni; } }
        if (d == 1) K0[tid & 255] = acc[0];
        __syncthreads();
        if (d == 0) { acc[0] += K0[tid] + (h == hp ? C.in[I_SSMD][l * 512 + g * 16 + h] : 0.f);
#pragma unroll
            for (int t = 0; t < 32; ++t) KT[((31 + t) * 16 + h) * 16 + hp] = (bf16)f2bf(acc[t]); }
        else {
#pragma unroll
            for (int t = 1; t < 32; ++t) KT[((31 - t) * 16 + h) * 16 + hp] = (bf16)f2bf(acc[t]); }
    }
    __syncthreads();
    bf16* B1 = WSP(bf16, WS_BT1) + (size_t)g * 768 * 512; bf16* B2 = WSP(bf16, WS_BT2) + (size_t)g * 512 * 256;
    for (int i = tid; i < 128 * 64; i += 512) {
        const int n = part * 128 + (i >> 6), ch = i & 63, t = n >> 4, h = n & 15, s = ch >> 1, hp0 = (ch & 1) * 8;
        *(GAS v4u*)(B1 + (size_t)n * 512 + ch * 8) = *(const LAS v4u*)(KT + ((t - s + 31) * 16 + h) * 16 + hp0);
    }
    for (int i = tid; i < 64 * 64; i += 512) {
        const int nn = part * 64 + (i >> 6), ch = i & 63, d = nn >> 7, p = (nn & 127) >> 1, ri = nn & 1, s = ch >> 1, hp0 = (ch & 1) * 8;
        const f32x2 w = POW[(d * 33 + (d == 0 ? 31 - s : s)) * 64 + p]; float v[8];
#pragma unroll
        for (int j = 0; j < 8; ++j) { const f32x2 b = BB[d * 1024 + p * 16 + hp0 + j]; v[j] = ri == 0 ? (w.x * b.x - w.y * b.y) : (w.x * b.y + w.y * b.x); }
        v4u o; o.x = pk2(v[0], v[1]); o.y = pk2(v[2], v[3]); o.z = pk2(v[4], v[5]); o.w = pk2(v[6], v[7]);
        *(GAS v4u*)(B1 + (size_t)(512 + nn) * 512 + ch * 8) = o;
    }
    for (int i = tid; i < 128 * 32; i += 512) {
        const int n = part * 128 + (i >> 5), ch = i & 31, t = n >> 4, h = n & 15, d = ch >> 4, p0 = (ch & 15) * 4; float v[8];
#pragma unroll
        for (int j = 0; j < 4; ++j) { const f32x2 c = CC[d * 1024 + h * 64 + p0 + j], w = POW[(d * 33 + (d == 0 ? t + 1 : 32 - t)) * 64 + p0 + j];
            v[2 * j] = c.x * w.x - c.y * w.y; v[2 * j + 1] = -(c.x * w.y + c.y * w.x); }
        v4u o; o.x = pk2(v[0], v[1]); o.y = pk2(v[2], v[3]); o.z = pk2(v[4], v[5]); o.w = pk2(v[6], v[7]);
        *(GAS v4u*)(B2 + (size_t)n * 256 + ch * 8) = o;
    }
    __syncthreads();
}

template <int MODE>
__device__ __forceinline__ void phase_rows(const Ctx& C, int l) {
    const int gw = C.vcu * NWAVES + C.wave, NGW = C.G * NWAVES, lane = C.lane;
    const float* MODl = WSP(float, WS_MOD) + (size_t)(MODE == 2 ? 0 : l) * 5 * 6144;
    const float* MODp = WSP(float, WS_MOD) + (size_t)(l > 0 ? l - 1 : 0) * 5 * 6144;
    const bf16* YS = WSP(bf16, WS_YSLOT);
    f32x4 nx[4]; v2u na[4], nc[4];
#define ROWS_LOAD(mm) do { const int m_ = (mm); \
        if (MODE == 0) { const GAS f32x4* xr = (const GAS f32x4*)in_row(C, m_) + lane; _Pragma("unroll") for (int q = 0; q < 4; ++q) nx[q] = xr[64 * q]; } \
        else { const GAS f32x4* xr = (const GAS f32x4*)xs_row(C, m_) + lane; const GAS v2u* y0 = (const GAS v2u*)(YS + (size_t)(2 * m_) * D) + lane; const GAS v2u* y1 = (const GAS v2u*)(YS + (size_t)(2 * m_ + 1) * D) + lane; \
            _Pragma("unroll") for (int q = 0; q < 4; ++q) { nx[q] = xr[64 * q]; na[q] = y0[64 * q]; nc[q] = y1[64 * q]; } } } while (0)
    int m = gw; if (MODE == 2) { while (m < T && (m % LB) < CTX) m += NGW; }
    if (m < T) ROWS_LOAD(m);
    while (m < T) {
        const int b = m / LB, j = m - b * LB, cond = j < CTX ? 4 : b;
        f32x4 v[4];
        if (MODE == 0) {
#pragma unroll
            for (int q = 0; q < 4; ++q) v[q] = nx[q]; }
        else { const GAS f32x4* g2 = (const GAS f32x4*)(MODp + cond * 6144 + 5 * 1024) + lane;
#pragma unroll
            for (int q = 0; q < 4; ++q) { const f32x4 g = g2[64 * q]; const v2u a = na[q], c = nc[q];
                v[q] = nx[q] + g * (f32x4){bflo(a.x) + bflo(c.x), bfhi(a.x) + bfhi(c.x), bflo(a.y) + bflo(c.y), bfhi(a.y) + bfhi(c.y)}; } }
        int mn = m + NGW; if (MODE == 2) { while (mn < T && (mn % LB) < CTX) mn += NGW; }
        if (mn < T) ROWS_LOAD(mn);
        float ss = 0.f;
#pragma unroll
        for (int q = 0; q < 4; ++q) ss += (v[q].x * v[q].x + v[q].y * v[q].y) + (v[q].z * v[q].z + v[q].w * v[q].w);
        const float rstd = 1.f / sqrtf(wave_sum(ss, lane) * (1.f / D) + EPS);
        if (MODE == 2) { GAS f32x4* o = (GAS f32x4*)(C.out + (size_t)(b * SEQ + j - CTX) * D) + lane; const GAS f32x4* fg = (const GAS f32x4*)C.in[I_FNG] + lane;
#pragma unroll
            for (int q = 0; q < 4; ++q) o[64 * q] = v[q] * rstd * fg[64 * q]; }
        else { GAS f32x4* xo = (GAS f32x4*)xs_row(C, m) + lane; GAS v2u* ho = (GAS v2u*)(WSP(bf16, WS_HB) + (size_t)m * D) + lane; GAS unsigned* h8 = (GAS unsigned*)(WSP(unsigned char, WS_HB8) + (size_t)m * D) + lane;
            const GAS f32x4* ng = (const GAS f32x4*)(C.in[I_N1G] + l * D) + lane; const GAS f32x4* sh = (const GAS f32x4*)(MODl + cond * 6144) + lane; const GAS f32x4* sc = (const GAS f32x4*)(MODl + cond * 6144 + 1024) + lane;
#pragma unroll
            for (int q = 0; q < 4; ++q) { xo[64 * q] = v[q]; const f32x4 h = v[q] * rstd * ng[64 * q] * (sc[64 * q] + 1.f) + sh[64 * q]; if (!W8_ALL) ho[64 * q] = (v2u){pk2(h.x, h.y), pk2(h.z, h.w)}; if (H8_WRITE) h8[64 * q] = pk4_fp8(h.x, h.y, h.z, h.w); } }
        m = mn;
    }
#undef ROWS_LOAD
}

__device__ __forceinline__ void phase_qkprep(const Ctx& C, int l) {
    const int gw = C.vcu * NWAVES + C.wave, NGW = C.G * NWAVES, lane = C.lane, s8 = lane & 7;
    const float* qg = C.in[I_QNG] + l * 64 + 8 * s8; const float* kg = C.in[I_KNG] + l * 64 + 8 * s8;
    float gq[8], gk[8];
#pragma unroll
    for (int i = 0; i < 8; ++i) { gq[i] = qg[i]; gk[i] = kg[i]; }
    const int ax = s8 >> 2, f0 = 8 * (s8 & 1);
    float inv[8];
#pragma unroll
    for (int i = 0; i < 8; ++i) inv[i] = exp2f(-(float)(f0 + i) * 0.8304820237218406f) * 0.15915494309189535f;
    const int kl = lane & 15;
    v4u wq, wk;
    if (gw < T) { wq = *((const GAS v4u*)(WSP(bf16, WS_QA) + (size_t)gw * 512) + lane); wk = *((const GAS v4u*)(WSP(bf16, WS_KA) + (size_t)gw * 128) + kl); }
    for (int m = gw; m < T; m += NGW) {
        const int b = m / LB, j = m - b * LB; const bool lat = j >= CTX; const int tt = j - CTX; const float pos = (float)(ax == 0 ? (tt >> 6) : (tt & 63));
        const v4u cq = wq, ck = wk;
        if (m + NGW < T) { wq = *((const GAS v4u*)(WSP(bf16, WS_QA) + (size_t)(m + NGW) * 512) + lane); wk = *((const GAS v4u*)(WSP(bf16, WS_KA) + (size_t)(m + NGW) * 128) + kl); }
        float cs[8], sn[8];
#pragma unroll
        for (int i = 0; i < 8; ++i) { cs[i] = lat ? cos_rev(pos * inv[i]) : 1.f; sn[i] = lat ? sin_rev(pos * inv[i]) : 0.f; }
#pragma unroll
        for (int which = 0; which < 2; ++which) {
            const v4u w = which == 0 ? cq : ck; float x[8] = {bflo(w.x), bfhi(w.x), bflo(w.y), bfhi(w.y), bflo(w.z), bfhi(w.z), bflo(w.w), bfhi(w.w)};
            float ss = 0.f;
#pragma unroll
            for (int i = 0; i < 8; ++i) ss += x[i] * x[i];
            ss += dpp_mov<0xB1, 0xF>(ss); ss += dpp_mov<0x4E, 0xF>(ss); ss += dpp_mov<0x141, 0xF>(ss);
            const float rstd = 1.f / sqrtf(ss * (1.f / 64.f) + EPS);
            float y[8];
#pragma unroll
            for (int i = 0; i < 8; ++i) { const float xn = x[i] * rstd * (which == 0 ? gq[i] : gk[i]); const float other = dpp_mov<0x4E, 0xF>(xn);
                y[i] = (s8 & 2) ? (xn * cs[i] + other * sn[i]) : (xn * cs[i] - other * sn[i]); }
            const float sc = which == 0 ? C2 : 1.f;
            v4u o; o.x = pk2(y[0] * sc, y[1] * sc); o.y = pk2(y[2] * sc, y[3] * sc); o.z = pk2(y[4] * sc, y[5] * sc); o.w = pk2(y[6] * sc, y[7] * sc);
            if (which == 0) *((GAS v4u*)(WSP(bf16, WS_QA) + (size_t)m * 512) + lane) = o;
            else if (lane < 16) *((GAS v4u*)(WSP(bf16, WS_KA) + (size_t)m * 128) + lane) = o;
        }
    }
}

__device__ __forceinline__ void phase_carry(const Ctx& C, int l) {
    if (C.vcu >= 32) return;
    const int b = C.vcu >> 3, g = (C.vcu & 7) * 4 + (C.wave >> 1), d = C.wave & 1, p = C.lane;
    const int li = ((l * 2 + d) * 32 + g) * 64 + p;
    const float re = C.in[I_LRE][li], im = C.in[I_LIM][li], dt = __expf(C.in[I_LDT][(l * 2 + d) * 32 + g]);
    const float mag = __expf(re * dt * 32.f), rev = im * dt * 32.f * 0.15915494309189535f; const float Lr = mag * cos_rev(rev), Li = mag * sin_rev(rev);
    const GAS f32x2* S = (const GAS f32x2*)(WSP(float, WS_SST) + (size_t)(b * NCH) * 8192 + g * 256 + d * 128) + p;
    GAS unsigned* X = (GAS unsigned*)(WSP(bf16, WS_XST) + (size_t)(b * NCH) * 8192 + g * 256 + d * 128) + p;
    float sr = 0.f, si = 0.f;
    if (d == 0) {
        for (int c0 = 0; c0 < NCH; c0 += 8) { f32x2 s[8];
#pragma unroll
            for (int k = 0; k < 8; ++k) s[k] = S[(size_t)(c0 + k) * 4096];
#pragma unroll
            for (int k = 0; k < 8; ++k) { X[(size_t)(c0 + k) * 4096] = pk2(sr, si); const float nr = Lr * sr - Li * si + s[k].x, ni = Lr * si + Li * sr + s[k].y; sr = nr; si = ni; } }
    } else {
        for (int seg = 0; seg < 33; ++seg) { const int chi = seg == 0 ? 7 : NCH - 1 - (seg - 1) * 8; f32x2 s[8];
#pragma unroll
            for (int k = 0; k < 8; ++k) s[k] = S[(size_t)(chi - k) * 4096];
#pragma unroll
            for (int k = 0; k < 8; ++k) { X[(size_t)(chi - k) * 4096] = pk2(sr, si); const float nr = Lr * sr - Li * si + s[k].x, ni = Lr * si + Li * sr + s[k].y; sr = nr; si = ni; } }
    }
}

__device__ __forceinline__ void phase_norm2(const Ctx& C, int l) {
    LAS float* RWt = (LAS float*)C.lds;
    LAS unsigned* REC = (LAS unsigned*)(C.lds + 65536);
    LAS float* LG = (LAS float*)(C.lds + 65536 + 16384);
    LAS unsigned* LCNT = (LAS unsigned*)(C.lds + 65536 + 32768);
    const int lane = C.lane, tid = C.tid;
    for (int i = tid; i < 16384; i += 512) { const int k = i >> 4, e = i & 15; RWt[e * 1024 + k] = C.in[I_RW][i]; }
    if (tid < 32) LCNT[tid] = 0u;
    __syncthreads();
    const float* MODl = WSP(float, WS_MOD) + (size_t)l * 5 * 6144;
    int nrows = 0; for (int m = C.vcu; m < T; m += C.G) ++nrows;
    f32x4 nx[2][4];
#define N2_LOAD(ii) do { _Pragma("unroll") for (int rr = 0; rr < 2; ++rr) { const int i_ = (ii) + rr * NWAVES; const int m_ = C.vcu + C.G * (i_ < nrows ? i_ : (ii)); const GAS f32x4* xr = (const GAS f32x4*)xs_row(C, m_) + lane; \
        _Pragma("unroll") for (int q = 0; q < 4; ++q) nx[rr][q] = xr[64 * q]; } } while (0)
    if (C.wave < nrows) N2_LOAD(C.wave);
    for (int i = C.wave; i < nrows; i += 2 * NWAVES) {
        const bool has1 = i + NWAVES < nrows;
        f32x4 hv[2][4];
#pragma unroll
        for (int rr = 0; rr < 2; ++rr) { const int ir = (rr && has1) ? i + NWAVES : i; const int m = C.vcu + C.G * ir, cond = cond_of(m);
            GAS unsigned* h8 = (GAS unsigned*)(WSP(unsigned char, WS_HB8) + (size_t)m * D) + lane; GAS v2u* ho = (GAS v2u*)(WSP(bf16, WS_HB) + (size_t)m * D) + lane;
            const GAS f32x4* ng = (const GAS f32x4*)(C.in[I_N2G] + l * D) + lane; const GAS f32x4* sh = (const GAS f32x4*)(MODl + cond * 6144 + 3072) + lane; const GAS f32x4* sc = (const GAS f32x4*)(MODl + cond * 6144 + 4096) + lane;
            float ss = 0.f;
#pragma unroll
            for (int q = 0; q < 4; ++q) { const f32x4 v = nx[rr][q]; ss += (v.x * v.x + v.y * v.y) + (v.z * v.z + v.w * v.w); }
            const float rstd = 1.f / sqrtf(wave_sum(ss, lane) * (1.f / D) + EPS);
#pragma unroll
            for (int q = 0; q < 4; ++q) { const f32x4 h = nx[rr][q] * rstd * ng[64 * q] * (sc[64 * q] + 1.f) + sh[64 * q]; hv[rr][q] = h;
                if (rr == 0 || has1) { if (FP8_MOE) h8[64 * q] = pk4_fp8(h.x, h.y, h.z, h.w); else ho[64 * q] = (v2u){pk2(h.x, h.y), pk2(h.z, h.w)}; } } }
        if (i + 2 * NWAVES < nrows) N2_LOAD(i + 2 * NWAVES);
        float mine0 = 0.f, mine1 = 0.f;
#pragma unroll
        for (int e = 0; e < 16; ++e) { float a0 = 0.f, a1 = 0.f;
#pragma unroll
            for (int q = 0; q < 4; ++q) { const f32x4 w = *(const LAS f32x4*)(RWt + e * 1024 + 256 * q + 4 * lane); const f32x4 h0 = hv[0][q], h1 = hv[1][q];
                a0 += (h0.x * w.x + h0.y * w.y) + (h0.z * w.z + h0.w * w.w); a1 += (h1.x * w.x + h1.y * w.y) + (h1.z * w.z + h1.w * w.w); }
            const float t0 = wave_sum(a0, lane), t1 = wave_sum(a1, lane); mine0 = lane == e ? t0 : mine0; mine1 = lane == e ? t1 : mine1; }
        if (lane < 16) { LG[i * 16 + lane] = mine0; if (has1) LG[(i + NWAVES) * 16 + lane] = mine1; }
    }
#undef N2_LOAD
    __syncthreads();
    float rb[16];
#pragma unroll
    for (int e = 0; e < 16; ++e) rb[e] = C.in[I_RB][e];
    for (int i = tid; i < nrows; i += 512) {
        float lg[16];
#pragma unroll
        for (int q = 0; q < 4; ++q) { const f32x4 t = *(const LAS f32x4*)(LG + i * 16 + 4 * q); lg[4 * q] = t.x; lg[4 * q + 1] = t.y; lg[4 * q + 2] = t.z; lg[4 * q + 3] = t.w; }
        float mx = lg[0];
#pragma unroll
        for (int e = 1; e < 16; ++e) mx = fmaxf(mx, lg[e]);
        float pr[16], sel[16], sum = 0.f;
#pragma unroll
        for (int e = 0; e < 16; ++e) { pr[e] = __expf(lg[e] - mx); sum += pr[e]; }
        const float rs = 1.f / sum;
#pragma unroll
        for (int e = 0; e < 16; ++e) { pr[e] *= rs; sel[e] = pr[e] + rb[e]; }
        float bestv = -1e30f; int best = 0;
#pragma unroll
        for (int gq = 0; gq < 4; ++gq) { float m1 = -1e30f, m2 = -1e30f;
#pragma unroll
            for (int k = 0; k < 4; ++k) { const float s_ = sel[4 * gq + k]; if (s_ > m1) { m2 = m1; m1 = s_; } else if (s_ > m2) m2 = s_; }
            const float gs = m1 + m2; if (gs > bestv) { bestv = gs; best = gq; } }
        float s4[4], p4[4];
#pragma unroll
        for (int k = 0; k < 4; ++k) { s4[k] = best == 0 ? sel[k] : best == 1 ? sel[4 + k] : best == 2 ? sel[8 + k] : sel[12 + k]; p4[k] = best == 0 ? pr[k] : best == 1 ? pr[4 + k] : best == 2 ? pr[8 + k] : pr[12 + k]; }
        int i0 = 0; float v0 = s4[0], q0 = p4[0];
#pragma unroll
        for (int k = 1; k < 4; ++k) if (s4[k] > v0) { v0 = s4[k]; i0 = k; q0 = p4[k]; }
        int i1 = i0 == 0 ? 1 : 0; float v1 = -1e30f, q1 = p4[i0 == 0 ? 1 : 0];
#pragma unroll
        for (int k = 0; k < 4; ++k) if (k != i0 && s4[k] > v1) { v1 = s4[k]; i1 = k; q1 = p4[k]; }
        const int e0 = 4 * best + i0, e1 = 4 * best + i1; const float wn = 1.f / (q0 + q1);
        const unsigned lp0 = atomicAdd((unsigned*)(LCNT + e0), 1u), lp1 = atomicAdd((unsigned*)(LCNT + e1), 1u);
        REC[i * 4 + 0] = (unsigned)e0 | ((unsigned)e1 << 8) | (lp0 << 16); REC[i * 4 + 1] = lp1; REC[i * 4 + 2] = __float_as_uint(q0 * wn); REC[i * 4 + 3] = __float_as_uint(q1 * wn);
    }
    __syncthreads();
    if (tid < 16) LCNT[16 + tid] = __hip_atomic_fetch_add((unsigned*)(C.ctl + CW_CNT + l * 1024 + 64 * tid), LCNT[tid], RLX_AGENT);
    __syncthreads();
    int* LIST = WSP(int, WS_LIST); float* RWG = WSP(float, WS_RW);
    for (int i = tid; i < nrows; i += 512) { const int m = C.vcu + C.G * i; const unsigned r0 = REC[i * 4], r1 = REC[i * 4 + 1];
        const int e0 = r0 & 255, e1 = (r0 >> 8) & 255; const unsigned lp0 = r0 >> 16, lp1 = r1;
        LIST[(size_t)e0 * T + LCNT[16 + e0] + lp0] = 2 * m; LIST[(size_t)e1 * T + LCNT[16 + e1] + lp1] = 2 * m + 1;
        RWG[2 * m] = __uint_as_float(REC[i * 4 + 2]); RWG[2 * m + 1] = __uint_as_float(REC[i * 4 + 3]); }
    __syncthreads();
}
using pg8::Unit;
typedef f32x4 Acc[2][2][4][2];
__device__ __forceinline__ v4u pack8(const f32x4& a, const f32x4& b) { v4u w; w.x = cvt_pk_bf16(a[0], a[1]); w.y = cvt_pk_bf16(a[2], a[3]); w.z = cvt_pk_bf16(b[0], b[1]); w.w = cvt_pk_bf16(b[2], b[3]); return w; }
__device__ __forceinline__ void unpack8(const v4u& w, f32x4& a, f32x4& b) { a = (f32x4){bflo(w.x), bfhi(w.x), bflo(w.y), bfhi(w.y)}; b = (f32x4){bflo(w.z), bfhi(w.z), bflo(w.w), bfhi(w.w)}; }
#ifndef WT_MODE
#define WT_MODE 0
#endif
__device__ __forceinline__ void st16(void* p, const v4u& v) {
#if WT_MODE == 1
    asm volatile("global_store_dwordx4 %0, %1, off sc0 sc1" :: "v"(p), "v"(v) : "memory");
#elif WT_MODE == 2
    asm volatile("global_store_dwordx4 %0, %1, off nt" :: "v"(p), "v"(v) : "memory");
#else
    *(GAS v4u*)p = v;
#endif
}
__device__ __forceinline__ int chunk_m0(int cr) { return (cr / NCH) * LB + (cr % NCH) * 32; }

struct PWin {
    static constexpr bool EARLY_AOFF = false, FP8 = false; unsigned char* ws; int G, c; int K; unsigned kstepA;
    __device__ __forceinline__ bool next(int i, Unit& u) const { const long L = (long)i * G + c; if (L >= NPAN * 11) return false; pg8::static_decode((int)L, NPAN, 11, u.pm, u.pn); u.z = 0; return true; }
    __device__ __forceinline__ const char* a_base(const Unit& u) const { return (const char*)(ws + WS_HB) + (size_t)u.pm * 256 * 1024 * 2; }
    __device__ __forceinline__ unsigned a_off(const Unit&, int h, int R, int Cc) const { return (unsigned)((h * 128 + R) * 1024 + Cc) * 2u; }
    __device__ __forceinline__ const char* b_base(const Unit& u) const { return (const char*)(ws + WS_WIN) + (size_t)u.pn * 256 * 1024 * 2; }
    __device__ __forceinline__ void epi(const Acc& acc, const Unit& u, int wr, int wc, int fr, int fq) const {
        const int row0 = u.pm * 256 + wr * 64 + fr;
#pragma unroll
        for (int bj = 0; bj < 2; ++bj) {
            const int cb = u.pn * 256 + bj * 128; bf16* dst; int ld, col, mode = 0; float sc = 1.f;
            if (cb < 512) { dst = (bf16*)(ws + WS_U) + ((size_t)((cb + wc * 32 + 8 * fq) >> 4) * T) * 16 + ((8 * fq) & 15) - (wc * 32 + 8 * fq); ld = 16; col = 0; }
            else if (cb < 1024) { dst = (bf16*)(ws + WS_QA); ld = 512; col = cb - 512; }
            else if (cb == 1024) { dst = (bf16*)(ws + WS_KA); ld = 128; col = 0; }
            else if (cb == 1152) { dst = (bf16*)(ws + WS_VA); ld = 128; col = 0; }
            else if (cb < 1792) { dst = (bf16*)(ws + WS_QN); ld = 512; col = cb - 1280; sc = C2; }
            else if (cb < 2304) { dst = (bf16*)(ws + WS_KN); ld = 512; col = cb - 1792; }
            else { dst = (bf16*)(ws + WS_VN); ld = 512; col = cb - 2304; }
            const int c0 = col + wc * 32 + 8 * fq;
#pragma unroll
            for (int ai = 0; ai < 2; ++ai)
#pragma unroll
                for (int m = 0; m < 4; ++m) { f32x4 v0 = acc[ai][bj][m][0], v1 = acc[ai][bj][m][1];
                    if (mode) { v0 = (f32x4){fsigmoid(v0[0]), fsigmoid(v0[1]), fsigmoid(v0[2]), fsigmoid(v0[3])}; v1 = (f32x4){fsigmoid(v1[0]), fsigmoid(v1[1]), fsigmoid(v1[2]), fsigmoid(v1[3])}; }
                    else { v0 = v0 * sc; v1 = v1 * sc; }
                    st16(dst + (size_t)(row0 + ai * 128 + m * 16) * ld + c0, pack8(v0, v1)); __builtin_amdgcn_sched_barrier(0); }
        }
    }
};

struct PWin8 {
    static constexpr bool EARLY_AOFF = false, FP8 = true; unsigned char* ws; int G, c; int K; unsigned kstepA;
    __device__ __forceinline__ bool next(int i, Unit& u) const { const long L = (long)i * G + c; if (L >= 2 * NPAN * 23) return false; pg8::static_decode((int)L, 2 * NPAN, 23, u.pm, u.pn); u.z = 0; return true; }
    __device__ __forceinline__ const char* a_base(const Unit& u) const { return (const char*)(ws + WS_HB8) + (size_t)u.pm * 128 * 1024; }
    __device__ __forceinline__ unsigned a_off(const Unit&, int R, int Cc) const { return (unsigned)(R * 1024 + Cc * 2); }
    __device__ __forceinline__ const char* b_base(const Unit& u) const { return (const char*)(ws + WS_WIN) + (size_t)u.pn * 256 * 1024; }
    __device__ __forceinline__ void epi(const f32x4 (&acc)[2][4][2], f32x4 (&)[2][4][2], const Unit& u, int wr, int wc, int fr, int fq) const {
        const int row0 = u.pm * 128 + wr * 64 + fr;
#pragma unroll
        for (int bj = 0; bj < 2; ++bj) {
            const int cb = u.pn * 256 + bj * 128;
            if (cb >= 2816) { const int c0 = cb - 2816 + wc * 32 + 8 * fq;
#pragma unroll
                for (int m = 0; m < 4; ++m) { f32x4 v0 = acc[bj][m][0] * (1.f / 64.f), v1 = acc[bj][m][1] * (1.f / 64.f);
                    v0 = (f32x4){fsigmoid(v0[0]), fsigmoid(v0[1]), fsigmoid(v0[2]), fsigmoid(v0[3])}; v1 = (f32x4){fsigmoid(v1[0]), fsigmoid(v1[1]), fsigmoid(v1[2]), fsigmoid(v1[3])};
                    *(GAS v2u*)((unsigned char*)(ws + WS_GATES) + (size_t)(row0 + m * 16) * 3072 + c0) = (v2u){pk4_fp8(v0[0], v0[1], v0[2], v0[3]), pk4_fp8(v1[0], v1[1], v1[2], v1[3])}; }
            } else {
                bf16* dst; int ld, col; float sc = 1.f / 64.f;
                if (cb < 512) { dst = (bf16*)(ws + WS_U) + ((size_t)((cb + wc * 32 + 8 * fq) >> 4) * T) * 16 + ((8 * fq) & 15) - (wc * 32 + 8 * fq); ld = 16; col = 0; }
                else if (cb < 1024) { dst = (bf16*)(ws + WS_QA); ld = 512; col = cb - 512; }
                else if (cb == 1024) { dst = (bf16*)(ws + WS_KA); ld = 128; col = 0; }
                else if (cb == 1152) { dst = (bf16*)(ws + WS_VA); ld = 128; col = 0; }
                else if (cb < 1792) { dst = (bf16*)(ws + WS_QN); ld = 512; col = cb - 1280; sc = C2 / 64.f; }
                else if (cb < 2304) { dst = (bf16*)(ws + WS_KN); ld = 512; col = cb - 1792; }
                else { dst = (bf16*)(ws + WS_VN); ld = 512; col = cb - 2304; }
                const int c0 = col + wc * 32 + 8 * fq;
#pragma unroll
                for (int m = 0; m < 4; ++m) *(GAS v4u*)(dst + (size_t)(row0 + m * 16) * ld + c0) = pack8(acc[bj][m][0] * sc, acc[bj][m][1] * sc);
            }
        }
    }
};

struct PGate {
    static constexpr bool EARLY_AOFF = false, FP8 = !GATE_BF16; unsigned char* ws; int G, c; int K; unsigned kstepA;
    __device__ __forceinline__ bool next(int i, Unit& u) const { const long L = (long)i * G + c; if (L >= 2 * NPAN * 12) return false; pg8::static_decode((int)L, 2 * NPAN, 12, u.pm, u.pn); u.z = 0; return true; }
    __device__ __forceinline__ const char* a_base(const Unit& u) const { return GATE_BF16 ? (const char*)(ws + WS_HB) + (size_t)u.pm * 128 * 2048 : (const char*)(ws + WS_HB8) + (size_t)u.pm * 128 * 1024; }
    __device__ __forceinline__ unsigned a_off(const Unit&, int R, int Cc) const { return GATE_BF16 ? (unsigned)(R * 2048 + Cc * 2) : (unsigned)(R * 1024 + Cc * 2); }
    __device__ __forceinline__ const char* b_base(const Unit& u) const { return GATE_BF16 ? (const char*)(ws + WS_WIN) + (size_t)(2816 + u.pn * 256) * 2048 : (const char*)(ws + WS_WIN8) + (size_t)u.pn * 256 * 1024; }
    __device__ __forceinline__ void epi(const f32x4 (&acc)[2][4][2], f32x4 (&)[2][4][2], const Unit& u, int wr, int wc, int fr, int fq) const {
#pragma unroll
        for (int m = 0; m < 4; ++m) { const size_t r = (size_t)(u.pm * 128 + wr * 64 + m * 16 + fr);
#pragma unroll
            for (int bj = 0; bj < 2; ++bj) { const int c0 = u.pn * 256 + bj * 128 + wc * 32 + 8 * fq; f32x4 v0 = acc[bj][m][0] * (GATE_BF16 ? 1.f : 1.f / 64.f), v1 = acc[bj][m][1] * (GATE_BF16 ? 1.f : 1.f / 64.f);
                v0 = (f32x4){fsigmoid(v0[0]), fsigmoid(v0[1]), fsigmoid(v0[2]), fsigmoid(v0[3])}; v1 = (f32x4){fsigmoid(v1[0]), fsigmoid(v1[1]), fsigmoid(v1[2]), fsigmoid(v1[3])};
                if (GATE_BF16) *(GAS v4u*)((bf16*)(ws + WS_GATES) + r * 3072 + c0) = pack8(v0, v1);
                else *(GAS v2u*)((unsigned char*)(ws + WS_GATES) + r * 3072 + c0) = (v2u){pk4_fp8(v0[0], v0[1], v0[2], v0[3]), pk4_fp8(v1[0], v1[1], v1[2], v1[3])}; }
            __builtin_amdgcn_sched_barrier(0); }
    }
};

struct PS5A {
    static constexpr bool EARLY_AOFF = false, FP8 = false; unsigned char* ws; int G, c; int K; unsigned kstepA;
    __device__ __forceinline__ bool next(int i, Unit& u) const { const long L = (long)i * G + c; if (L >= 32 * 15) return false; const int l = (int)L; u.z = l / 15; const int r = l % 15; u.pm = r / 3; u.pn = r % 3; return true; }
    __device__ __forceinline__ const char* a_base(const Unit& u) const { return (const char*)(ws + WS_U) + (size_t)u.z * T * 32; }
    __device__ __forceinline__ unsigned a_off(const Unit& u, int h, int R, int Cc) const { int cr = u.pm * 256 + h * 128 + R; cr = cr < NCR ? cr : NCR - 1; return (unsigned)(cr * 512 + Cc) * 2u; }
    __device__ __forceinline__ const char* b_base(const Unit& u) const { return (const char*)(ws + WS_BT1) + ((size_t)u.z * 768 + u.pn * 256) * 512 * 2; }
    __device__ __forceinline__ void epi(const Acc& acc, const Unit& u, int wr, int wc, int fr, int fq) const {
#pragma unroll
        for (int ai = 0; ai < 2; ++ai)
#pragma unroll
            for (int m = 0; m < 4; ++m) { const int cr = u.pm * 256 + ai * 128 + wr * 64 + m * 16 + fr; if (cr >= NCR) continue;
#pragma unroll
                for (int bj = 0; bj < 2; ++bj) { const int n = bj * 128 + wc * 32 + 8 * fq;
                    if (u.pn < 2) *(GAS v4u*)((bf16*)(ws + WS_YG) + (size_t)u.z * T * 16 + (size_t)cr * 512 + u.pn * 256 + n) = pack8(acc[ai][bj][m][0], acc[ai][bj][m][1]);
                    else { GAS f32x4* o = (GAS f32x4*)((float*)(ws + WS_SST) + (size_t)cr * 8192 + u.z * 256 + n); o[0] = acc[ai][bj][m][0]; o[1] = acc[ai][bj][m][1]; } }
                __builtin_amdgcn_sched_barrier(0); }
    }
};

struct PS5B {
    static constexpr bool EARLY_AOFF = false, FP8 = false; unsigned char* ws; int G, c; int K; unsigned kstepA;
    __device__ __forceinline__ bool next(int i, Unit& u) const { const long L = (long)i * G + c; if (L >= 32 * 10) return false; const int l = (int)L; u.z = l / 10; const int r = l % 10; u.pm = r / 2; u.pn = r % 2; return true; }
    __device__ __forceinline__ const char* a_base(const Unit& u) const { return (const char*)(ws + WS_XST) + (size_t)u.z * 512; }
    __device__ __forceinline__ unsigned a_off(const Unit& u, int h, int R, int Cc) const { int cr = u.pm * 256 + h * 128 + R; cr = cr < NCR ? cr : NCR - 1; return (unsigned)(cr * 8192 + Cc) * 2u; }
    __device__ __forceinline__ const char* b_base(const Unit& u) const { return (const char*)(ws + WS_BT2) + ((size_t)u.z * 512 + u.pn * 256) * 256 * 2; }
    __device__ __forceinline__ void epi(const Acc& acc, const Unit& u, int wr, int wc, int fr, int fq) const {
#pragma unroll
        for (int ai = 0; ai < 2; ++ai) {
            v4u yw[4][2];
#pragma unroll
            for (int m = 0; m < 4; ++m) { int cr = u.pm * 256 + ai * 128 + wr * 64 + m * 16 + fr; cr = cr < NCR ? cr : NCR - 1;
#pragma unroll
                for (int bj = 0; bj < 2; ++bj) yw[m][bj] = *(const GAS v4u*)((const bf16*)(ws + WS_YG) + (size_t)u.z * T * 16 + (size_t)cr * 512 + u.pn * 256 + bj * 128 + wc * 32 + 8 * fq); }
#pragma unroll
            for (int m = 0; m < 4; ++m) { const int cr = u.pm * 256 + ai * 128 + wr * 64 + m * 16 + fr; if (cr >= NCR) continue;
#pragma unroll
                for (int bj = 0; bj < 2; ++bj) { const int nn = u.pn * 256 + bj * 128 + wc * 32 + 8 * fq, t = nn >> 4, h0 = nn & 15;
                    GAS v4u* p = (GAS v4u*)((bf16*)(ws + WS_YS) + (size_t)(chunk_m0(cr) + t) * 512 + u.z * 16 + h0);
                    f32x4 y0, y1; { const v4u w_ = yw[m][bj]; unpack8(w_, y0, y1); } y0 += acc[ai][bj][m][0]; y1 += acc[ai][bj][m][1];
                    y0 = (f32x4){gelu_tanh(y0[0]), gelu_tanh(y0[1]), gelu_tanh(y0[2]), gelu_tanh(y0[3])}; y1 = (f32x4){gelu_tanh(y1[0]), gelu_tanh(y1[1]), gelu_tanh(y1[2]), gelu_tanh(y1[3])};
                    *p = pack8(y0, y1); } } }
    }
};

__device__ __forceinline__ int half_panel(int hl, bool lat_only) { if (!lat_only) return hl; const int pl = hl >> 1; return 2 * (pl + (pl >> 5) + 1) + (hl & 1); }
struct PGlu {
    static constexpr bool EARLY_AOFF = false, FP8 = false; unsigned char* ws; int G, c; int K; unsigned kstepA; bool lat_only;
    __device__ __forceinline__ bool next(int i, Unit& u) const { const int nH = lat_only ? 256 : 2 * NPAN; const long L = (long)i * G + c; if (L >= nH * 2) return false; pg8::static_decode((int)L, nH, 2, u.pm, u.pn); u.pm = half_panel(u.pm, lat_only); u.z = 0; return true; }
    __device__ __forceinline__ const char* a_base(const Unit& u) const { return (const char*)(ws + WS_YS) + (size_t)u.pm * 128 * 512 * 2; }
    __device__ __forceinline__ unsigned a_off(const Unit&, int R, int Cc) const { return (unsigned)(R * 512 + Cc) * 2u; }
    __device__ __forceinline__ const char* b_base(const Unit& u) const { return (const char*)(ws + WS_WGLU) + (size_t)u.pn * 256 * 512 * 2; }
    __device__ __forceinline__ void epi(const f32x4 (&acc)[2][4][2], f32x4 (&)[2][4][2], const Unit& u, int wr, int wc, int fr, int fq) const {
        v4u zw[4][2];
#pragma unroll
        for (int m = 0; m < 4; ++m)
#pragma unroll
            for (int bj = 0; bj < 2; ++bj) zw[m][bj] = *(const GAS v4u*)((const bf16*)(ws + WS_YS) + (size_t)(u.pm * 128 + wr * 64 + m * 16 + fr) * 512 + u.pn * 256 + bj * 128 + wc * 32 + 8 * fq);
#pragma unroll
        for (int m = 0; m < 4; ++m) { const size_t r = (size_t)(u.pm * 128 + wr * 64 + m * 16 + fr);
#pragma unroll
            for (int bj = 0; bj < 2; ++bj) { const int cc = u.pn * 256 + bj * 128 + wc * 32 + 8 * fq;
                f32x4 z0, z1; { const v4u w_ = zw[m][bj]; unpack8(w_, z0, z1); } const f32x4 a0 = acc[bj][m][0], a1 = acc[bj][m][1];
                z0 = z0 * (f32x4){fsigmoid(a0[0]), fsigmoid(a0[1]), fsigmoid(a0[2]), fsigmoid(a0[3])}; z1 = z1 * (f32x4){fsigmoid(a1[0]), fsigmoid(a1[1]), fsigmoid(a1[2]), fsigmoid(a1[3])};
                *(GAS v4u*)((bf16*)(ws + WS_U) + r * 512 + cc) = pack8(z0, z1); } }
    }
};

typedef f32x4 Acc128[2][4][2];
struct PMerge {
    static constexpr bool EARLY_AOFF = false, FP8 = false; unsigned char* ws; int G, c; int K; unsigned kstepA; bool lat_only;
    __device__ __forceinline__ bool next(int i, Unit& u) const { const int nH = lat_only ? 256 : 2 * NPAN; const long tile = (long)(i / 3) * G + c; if (tile >= nH * 4) return false; pg8::static_decode((int)tile, nH, 4, u.pm, u.pn); u.pm = half_panel(u.pm, lat_only); u.z = i % 3; return true; }
    __device__ __forceinline__ const char* a_base(const Unit& u) const { const size_t off = u.z == 0 ? WS_U : (u.z == 1 ? WS_AO : WS_NO); return (const char*)(ws + off) + (size_t)u.pm * 128 * 512 * 2; }
    __device__ __forceinline__ unsigned a_off(const Unit&, int R, int Cc) const { return (unsigned)(R * 512 + Cc) * 2u; }
    __device__ __forceinline__ const char* b_base(const Unit& u) const { return (const char*)(ws + WS_WBR) + ((size_t)u.z * 1024 + u.pn * 256) * 512 * 2; }
    __device__ __forceinline__ void epi(const Acc128& acc, Acc128& mrg, const Unit& u, int wr, int wc, int fr, int fq) const {
        v2u gw[4][2];
#pragma unroll
        for (int m = 0; m < 4; ++m)
#pragma unroll
            for (int bj = 0; bj < 2; ++bj) gw[m][bj] = *(const GAS v2u*)((const unsigned char*)(ws + WS_GATES) + (size_t)(u.pm * 128 + wr * 64 + m * 16 + fr) * 3072 + u.z * 1024 + u.pn * 256 + bj * 128 + wc * 32 + 8 * fq);
#pragma unroll
        for (int m = 0; m < 4; ++m) { const size_t r = (size_t)(u.pm * 128 + wr * 64 + m * 16 + fr);
#pragma unroll
            for (int bj = 0; bj < 2; ++bj) { const int cc = u.pn * 256 + bj * 128 + wc * 32 + 8 * fq; const v2u w_ = gw[m][bj];
                const f32x4 g0 = (f32x4){__builtin_amdgcn_cvt_f32_fp8((int)w_.x, 0), __builtin_amdgcn_cvt_f32_fp8((int)w_.x, 1), __builtin_amdgcn_cvt_f32_fp8((int)w_.x, 2), __builtin_amdgcn_cvt_f32_fp8((int)w_.x, 3)};
                const f32x4 g1 = (f32x4){__builtin_amdgcn_cvt_f32_fp8((int)w_.y, 0), __builtin_amdgcn_cvt_f32_fp8((int)w_.y, 1), __builtin_amdgcn_cvt_f32_fp8((int)w_.y, 2), __builtin_amdgcn_cvt_f32_fp8((int)w_.y, 3)};
                if (u.z == 0) { mrg[bj][m][0] = g0 * acc[bj][m][0]; mrg[bj][m][1] = g1 * acc[bj][m][1]; }
                else { mrg[bj][m][0] += g0 * acc[bj][m][0]; mrg[bj][m][1] += g1 * acc[bj][m][1]; }
                if (u.z == 2) *(GAS v4u*)((bf16*)(ws + WS_HB) + r * 1024 + cc) = pack8(mrg[bj][m][0], mrg[bj][m][1]); } }
    }
};

struct PWout {
    static constexpr bool EARLY_AOFF = false, FP8 = false; unsigned char* ws; float* out; const float* mod; int G, c; int K; unsigned kstepA; bool lat_only;
    __device__ __forceinline__ bool next(int i, Unit& u) const { const int nH = lat_only ? 256 : 2 * NPAN; const long L = (long)i * G + c; if (L >= nH * 4) return false; pg8::static_decode((int)L, nH, 4, u.pm, u.pn); u.pm = half_panel(u.pm, lat_only); u.z = 0; return true; }
    __device__ __forceinline__ const char* a_base(const Unit& u) const { return (const char*)(ws + WS_HB) + (size_t)u.pm * 128 * 1024 * 2; }
    __device__ __forceinline__ unsigned a_off(const Unit&, int R, int Cc) const { return (unsigned)(R * 1024 + Cc) * 2u; }
    __device__ __forceinline__ const char* b_base(const Unit& u) const { return (const char*)(ws + WS_WOUT) + (size_t)u.pn * 256 * 1024 * 2; }
    __device__ __forceinline__ void epi(const f32x4 (&acc)[2][4][2], f32x4 (&)[2][4][2], const Unit& u, int wr, int wc, int fr, int fq) const {
        const int pm = u.pm >> 1, hh = u.pm & 1, b = pm / 33, pr = pm % 33, cond = pr == 0 ? 4 : b;
        float* xb = pr == 0 ? (float*)(ws + WS_CTXS) + ((size_t)b * 256 + hh * 128) * D : out + ((size_t)b * SEQ + (size_t)(pr - 1) * 256 + hh * 128) * D;
        const float* g1 = mod + cond * 6144 + 2048;
        f32x4 xv[2][4][2];
#pragma unroll
        for (int bj = 0; bj < 2; ++bj)
#pragma unroll
            for (int m = 0; m < 4; ++m) { const GAS f32x4* p = (const GAS f32x4*)(xb + (size_t)(wr * 64 + m * 16 + fr) * D + u.pn * 256 + bj * 128 + wc * 32 + 8 * fq); xv[bj][m][0] = p[0]; xv[bj][m][1] = p[1]; }
#pragma unroll
        for (int bj = 0; bj < 2; ++bj) { const int cc = u.pn * 256 + bj * 128 + wc * 32 + 8 * fq; const f32x4 ga = *(const GAS f32x4*)(g1 + cc), gb = *(const GAS f32x4*)(g1 + cc + 4);
#pragma unroll
            for (int m = 0; m < 4; ++m) { GAS f32x4* p = (GAS f32x4*)(xb + (size_t)(wr * 64 + m * 16 + fr) * D + cc);
                p[0] = xv[bj][m][0] + ga * acc[bj][m][0]; p[1] = xv[bj][m][1] + gb * acc[bj][m][1]; } }
    }
};

struct ExpTab { int cnt[16], tile0[17]; };
__device__ __forceinline__ int exp_find(const int (&tile0)[17], int q) { int e = 0;
#pragma unroll
    for (int k = 1; k < 16; ++k) e += (q >= tile0[k]) ? 1 : 0;
    return e; }

struct PMoe1 {
    static constexpr bool EARLY_AOFF = true, FP8 = true; unsigned char* ws; const LAS int* tab; int G, c; int K; unsigned kstepA;
    __device__ __forceinline__ bool next(int i, Unit& u) const { const long L = (long)i * G + c; const int total = __builtin_amdgcn_readfirstlane(tab[32]) * 4; if (L >= total) return false; const int q = (int)L >> 2; u.pn = (int)L & 3;
        int e = 0;
#pragma unroll
        for (int k = 1; k < 16; ++k) e += (q >= __builtin_amdgcn_readfirstlane(tab[16 + k])) ? 1 : 0;
        u.z = e; u.pm = q - __builtin_amdgcn_readfirstlane(tab[16 + e]); return true; }
    __device__ __forceinline__ const char* a_base(const Unit&) const { return (const char*)(ws + WS_HB8); }
    __device__ __forceinline__ unsigned a_off(const Unit& u, int R, int Cc) const { int r = u.pm * 128 + R; const int n = __builtin_amdgcn_readfirstlane(tab[u.z]); r = r < n ? r : n - 1;
        const int ent = ((const int*)(ws + WS_LIST))[(size_t)u.z * T + r]; return (unsigned)((ent >> 1) * 1024 + Cc * 2); }
    __device__ __forceinline__ const char* b_base(const Unit& u) const { return (const char*)(ws + WS_MOE1) + ((size_t)u.z * 1024 + u.pn * 256) * 1024; }
    __device__ __forceinline__ void epi(const f32x4 (&acc)[2][4][2], f32x4 (&)[2][4][2], const Unit& u, int wr, int wc, int fr, int fq) const {
        const size_t arow0 = (size_t)(__builtin_amdgcn_readfirstlane(tab[16 + u.z]) + u.pm) * 128;
#pragma unroll
        for (int m = 0; m < 4; ++m) { const f32x4 g0 = acc[0][m][0] * (1.f / 64.f), g1 = acc[0][m][1] * (1.f / 64.f), u0 = acc[1][m][0] * (8.f / 64.f), u1 = acc[1][m][1] * (8.f / 64.f);
            const f32x4 v0 = (f32x4){g0[0] * fsigmoid(g0[0]), g0[1] * fsigmoid(g0[1]), g0[2] * fsigmoid(g0[2]), g0[3] * fsigmoid(g0[3])} * u0;
            const f32x4 v1 = (f32x4){g1[0] * fsigmoid(g1[0]), g1[1] * fsigmoid(g1[1]), g1[2] * fsigmoid(g1[2]), g1[3] * fsigmoid(g1[3])} * u1;
            *(GAS v2u*)((unsigned char*)(ws + WS_ACT) + (arow0 + wr * 64 + m * 16 + fr) * 512 + u.pn * 128 + wc * 32 + 8 * fq) = (v2u){pk4_fp8(v0[0], v0[1], v0[2], v0[3]), pk4_fp8(v1[0], v1[1], v1[2], v1[3])}; }
    }
};
struct PMoe2 {
    static constexpr bool EARLY_AOFF = false, FP8 = true; unsigned char* ws; const LAS int* tab; int G, c; int K; unsigned kstepA;
    __device__ __forceinline__ bool next(int i, Unit& u) const { const long L = (long)i * G + c; const int total = __builtin_amdgcn_readfirstlane(tab[32]) * 4; if (L >= total) return false; const int q = (int)L >> 2; u.pn = (int)L & 3;
        int e = 0;
#pragma unroll
        for (int k = 1; k < 16; ++k) e += (q >= __builtin_amdgcn_readfirstlane(tab[16 + k])) ? 1 : 0;
        u.z = e; u.pm = q - __builtin_amdgcn_readfirstlane(tab[16 + e]); return true; }
    __device__ __forceinline__ const char* a_base(const Unit& u) const { return (const char*)(ws + WS_ACT) + (size_t)(__builtin_amdgcn_readfirstlane(tab[16 + u.z]) + u.pm) * 128 * 512; }
    __device__ __forceinline__ unsigned a_off(const Unit&, int R, int Cc) const { return (unsigned)(R * 512 + Cc * 2); }
    __device__ __forceinline__ const char* b_base(const Unit& u) const { return (const char*)(ws + WS_MOE2) + ((size_t)u.z * 1024 + u.pn * 256) * 512; }
    __device__ __forceinline__ void epi(const f32x4 (&acc)[2][4][2], f32x4 (&)[2][4][2], const Unit& u, int wr, int wc, int fr, int fq) const {
        const int n = __builtin_amdgcn_readfirstlane(tab[u.z]);
        int entv[4]; float wv[4];
#pragma unroll
        for (int m = 0; m < 4; ++m) { int r = u.pm * 128 + wr * 64 + m * 16 + fr; r = r < n ? r : n - 1; entv[m] = ((const int*)(ws + WS_LIST))[(size_t)u.z * T + r]; }
#pragma unroll
        for (int m = 0; m < 4; ++m) wv[m] = ((const float*)(ws + WS_RW))[entv[m]] * (1.f / 256.f);
#pragma unroll
        for (int m = 0; m < 4; ++m) { const int r = u.pm * 128 + wr * 64 + m * 16 + fr; if (r >= n) continue;
            const int ent = entv[m]; const float w = wv[m];
#pragma unroll
            for (int bj = 0; bj < 2; ++bj)
                *(GAS v4u*)((bf16*)(ws + WS_YSLOT) + (size_t)ent * 1024 + u.pn * 256 + bj * 128 + wc * 32 + 8 * fq) = pack8(acc[bj][m][0] * w, acc[bj][m][1] * w); }
    }
};
struct PMoe1B {
    static constexpr bool EARLY_AOFF = true, FP8 = false; unsigned char* ws; const LAS int* tab; int G, c; int K; unsigned kstepA;
    __device__ __forceinline__ bool next(int i, Unit& u) const { const long L = (long)i * G + c; const int total = tab[32] * 4; if (L >= total) return false; const int q = (int)L >> 2; u.pn = (int)L & 3;
        int e = 0;
#pragma unroll
        for (int k = 1; k < 16; ++k) e += (q >= tab[16 + k]) ? 1 : 0;
        u.z = e; u.pm = q - tab[16 + e]; return true; }
    __device__ __forceinline__ const char* a_base(const Unit&) const { return (const char*)(ws + WS_HB); }
    __device__ __forceinline__ unsigned a_off(const Unit& u, int h, int R, int Cc) const { int r = u.pm * 256 + h * 128 + R; const int n = tab[u.z]; r = r < n ? r : n - 1;
        const int ent = ((const int*)(ws + WS_LIST))[(size_t)u.z * T + r]; return (unsigned)((ent >> 1) * 1024 + Cc) * 2u; }
    __device__ __forceinline__ const char* b_base(const Unit& u) const { return (const char*)(ws + WS_MOE1) + ((size_t)u.z * 1024 + u.pn * 256) * 1024 * 2; }
    __device__ __forceinline__ void epi(const Acc& acc, const Unit& u, int wr, int wc, int fr, int fq) const {
        const size_t arow0 = (size_t)(tab[16 + u.z] + u.pm) * 256;
#pragma unroll
        for (int ai = 0; ai < 2; ++ai)
#pragma unroll
            for (int m = 0; m < 4; ++m) { const f32x4 g0 = acc[ai][0][m][0], g1 = acc[ai][0][m][1], u0 = acc[ai][1][m][0], u1 = acc[ai][1][m][1];
                const f32x4 v0 = (f32x4){g0[0] * fsigmoid(g0[0]), g0[1] * fsigmoid(g0[1]), g0[2] * fsigmoid(g0[2]), g0[3] * fsigmoid(g0[3])} * u0;
                const f32x4 v1 = (f32x4){g1[0] * fsigmoid(g1[0]), g1[1] * fsigmoid(g1[1]), g1[2] * fsigmoid(g1[2]), g1[3] * fsigmoid(g1[3])} * u1;
                *(GAS v4u*)((bf16*)(ws + WS_ACTB) + (arow0 + ai * 128 + wr * 64 + m * 16 + fr) * 512 + u.pn * 128 + wc * 32 + 8 * fq) = pack8(v0, v1); }
    }
};
struct PMoe2B {
    static constexpr bool EARLY_AOFF = false, FP8 = false; unsigned char* ws; const LAS int* tab; int G, c; int K; unsigned kstepA;
    __device__ __forceinline__ bool next(int i, Unit& u) const { const long L = (long)i * G + c; const int total = tab[32] * 4; if (L >= total) return false; const int q = (int)L >> 2; u.pn = (int)L & 3;
        int e = 0;
#pragma unroll
        for (int k = 1; k < 16; ++k) e += (q >= tab[16 + k]) ? 1 : 0;
        u.z = e; u.pm = q - tab[16 + e]; return true; }
    __device__ __forceinline__ const char* a_base(const Unit& u) const { return (const char*)(ws + WS_ACTB) + (size_t)(tab[16 + u.z] + u.pm) * 256 * 512 * 2; }
    __device__ __forceinline__ unsigned a_off(const Unit&, int h, int R, int Cc) const { return (unsigned)((h * 128 + R) * 512 + Cc) * 2u; }
    __device__ __forceinline__ const char* b_base(const Unit& u) const { return (const char*)(ws + WS_MOE2) + ((size_t)u.z * 1024 + u.pn * 256) * 512 * 2; }
    __device__ __forceinline__ void epi(const Acc& acc, const Unit& u, int wr, int wc, int fr, int fq) const {
        const int n = tab[u.z];
#pragma unroll
        for (int ai = 0; ai < 2; ++ai)
#pragma unroll
            for (int m = 0; m < 4; ++m) { const int r = u.pm * 256 + ai * 128 + wr * 64 + m * 16 + fr; if (r >= n) continue;
                const int ent = ((const int*)(ws + WS_LIST))[(size_t)u.z * T + r]; const float w = ((const float*)(ws + WS_RW))[ent];
#pragma unroll
                for (int bj = 0; bj < 2; ++bj)
                    *(GAS v4u*)((bf16*)(ws + WS_YSLOT) + (size_t)ent * 1024 + u.pn * 256 + bj * 128 + wc * 32 + 8 * fq) = pack8(acc[ai][bj][m][0] * w, acc[ai][bj][m][1] * w); }
    }
};
__device__ __forceinline__ void build_exptab(const Ctx& C, LAS int* tab, int l, int tsh = 7) {
    __syncthreads();
    if (threadIdx.x == 0) { int t0 = 0;
        for (int e = 0; e < 16; ++e) { const int n = (int)__hip_atomic_load((unsigned*)(C.ctl + CW_CNT + l * 1024 + 64 * e), RLX_AGENT); tab[e] = n; tab[16 + e] = t0; t0 += (n + (1 << tsh) - 1) >> tsh; }
        tab[32] = t0; }
    __syncthreads();
}
__device__ __forceinline__ void phase_attn(const Ctx& C, int l, unsigned char* lds_gen) {
    phase_carry(C, l);
    char* shm = (char*)lds_gen;
    bf16* QA = WSP(bf16, WS_QA); bf16* KA = WSP(bf16, WS_KA); bf16* VA = WSP(bf16, WS_VA); bf16* QN = WSP(bf16, WS_QN); bf16* KN = WSP(bf16, WS_KN); bf16* VN = WSP(bf16, WS_VN);
#ifndef ATTN_SEL
#define ATTN_SEL 3
#endif
#ifdef REPMASK
#define REPMASK_ REPMASK
#else
#define REPMASK_ 0
#endif
    const int per = (1024 + C.G - 1) / C.G;
    bool nomax; { float gq = 0.f, gk = 0.f; for (int i = 0; i < 64; ++i) { gq = fmaxf(gq, fabsf(C.in[I_QNG][l * 64 + i])); gk = fmaxf(gk, fabsf(C.in[I_KNG][l * 64 + i])); } nomax = 64.f * gq * gk * C2 <= 60.f; }
    if (ATTN_SEL & 1) for (int i = 0; i < per * (1 + ((REPMASK_ >> 13) & 1)); ++i) { const int id = C.vcu * per + (i % per); if (id >= 1024) continue; const int bh = id >> 5, b = bh >> 3, h = bh & 7, qb = id & 31;
        const bf16* Qu = QA + (size_t)(b * LB + CTX + qb * 256) * 512 + h * 64;
        if (nomax) attn_body::attn_unit<8, false, 512, 128, true>(Qu, 512, KA + (size_t)(b * LB) * 128 + (h >> 2) * 64, VA + (size_t)(b * LB) * 128 + (h >> 2) * 64, 128, WSP(bf16, WS_AO) + (Qu - QA), LB / 64, 0, 0, shm);
        else attn_body::attn_unit<8, false, 512, 128, false>(Qu, 512, KA + (size_t)(b * LB) * 128 + (h >> 2) * 64, VA + (size_t)(b * LB) * 128 + (h >> 2) * 64, 128, WSP(bf16, WS_AO) + (Qu - QA), LB / 64, 0, 0, shm);
    }
    LAS float* bt = (LAS float*)(C.lds + attn_body::LDS_BT);
    const int nctx = (C.vcu >= 64 && C.vcu < 128) ? 1 : 0;
    if (ATTN_SEL & 2) for (int i0 = 0; i0 < (per + nctx) * (1 + ((REPMASK_ >> 14) & 1)); ++i0) { const int i = i0 % (per + nctx);
        const bf16 *Qu, *Kh, *Vh; bf16* Ou; int kvp = 512, NT = 4, r0 = 0, rlo = 0;
        if (i < per) { const int id = C.vcu * per + i; if (id >= 1024) continue; const int bh = id >> 5, b = bh >> 3, h = bh & 7; r0 = (id & 31) * 4;
            const float* rp = C.in[I_RPB] + (size_t)(l * 8 + h) * 465;
            for (int k = C.tid; k < 465; k += 512) bt[k] = rp[k] * LOG2E;
            rlo = r0 - 4 < 0 ? 0 : (r0 - 4 > 120 ? 120 : r0 - 4); const int rh_ = r0 - 1 < 0 ? 0 : (r0 - 1 > 120 ? 120 : r0 - 1), nloc = rh_ + 8 - rlo; NT = (4 + nloc + 1) & ~1;
            Qu = QN + (size_t)(b * LB + CTX + r0 * 64) * 512 + h * 64; Ou = WSP(bf16, WS_NO) + (Qu - QN); Kh = KN + (size_t)(b * LB) * 512 + h * 64; Vh = VN + (size_t)(b * LB) * 512 + h * 64; }
        else { int j = C.vcu - 64; if (j < 32) { const int b = j >> 3, h = j & 7; Qu = QA + (size_t)(b * LB) * 512 + h * 64; Ou = WSP(bf16, WS_AO) + (Qu - QA); Kh = KA + (size_t)(b * LB) * 128 + (h >> 2) * 64; Vh = VA + (size_t)(b * LB) * 128 + (h >> 2) * 64; kvp = 128; }
            else { j -= 32; const int b = j >> 3, h = j & 7; Qu = QN + (size_t)(b * LB) * 512 + h * 64; Ou = WSP(bf16, WS_NO) + (Qu - QN); Kh = KN + (size_t)(b * LB) * 512 + h * 64; Vh = VN + (size_t)(b * LB) * 512 + h * 64; } }
        attn_body::attn_unit<8, true, 512, 0>(Qu, 512, Kh, Vh, kvp, Ou, NT, r0, rlo, shm);
    }
}

constexpr int NPH = 46;
__global__ void __launch_bounds__(NWAVES * 64, 2) fwd(Args args) {
    extern __shared__ __attribute__((aligned(16))) unsigned char lds[];
    Ctx C; C.in = (const __attribute__((address_space(4))) CFP*)__builtin_amdgcn_kernarg_segment_ptr(); C.out = args.out; C.ws = args.ws; C.lds = (LAS unsigned char*)lds; C.ctl = (gu32*)(args.ws + WS_CTL);
    C.tid = 0; C.lane = 0; C.wave = __builtin_amdgcn_readfirstlane((int)threadIdx.x >> 6);
    C.G = gridDim.x; { const int bx = blockIdx.x; C.vcu = (C.G % 8 == 0) ? (bx % 8) * (C.G / 8) + bx / 8 : bx; }
    for (int u = threadIdx.x; u < (LDS_BYTES - LDSCTL_OFF) / 4; u += NWAVES * 64) ((LAS unsigned*)(C.lds + LDSCTL_OFF))[u] = 0u;
    __syncthreads();
    const int lo = args.ph_lo, hi = args.ph_hi;
    XcdBarrier bar; bar.bar = (unsigned*)(C.ctl + CW_BAR); bar.x = 0; bar.st = nullptr;
    if (hi - lo > 1) bar = xcd_barrier_post((unsigned*)(C.ctl + CW_BAR), (volatile LAS unsigned*)(C.lds + MISC_OFF) + 8);
    LAS int* tab = (LAS int*)(C.lds + LDSCTL_OFF);
    const int cg = (int)blockIdx.x;
#ifndef PHMASK
#define PHMASK 0xFFFF
#endif
#define IN(k) (lo <= (k) && (k) < hi)
#define EN(b) ((PHMASK >> (b)) & 1)
#ifndef REPMASK
#define REPMASK 0
#endif
#define RUN(b, stmt) do { stmt; if ((REPMASK >> (b)) & 1) { stmt; } } while (0)
#ifdef DIAG_SEL
#define DIAG_ACC(ty) do { if (blockIdx.x == 0 && threadIdx.x == 0) { volatile LAS unsigned* dg = (volatile LAS unsigned*)(C.lds + LDSCTL_OFF + 160); const unsigned now = (unsigned)__builtin_amdgcn_s_memrealtime(); dg[8 + (ty)] += now - dg[0]; dg[0] = now; } } while (0)
#else
#define DIAG_ACC(ty) do {} while (0)
#endif
#define SEAM(k) do { if (IN(k) && IN((k) + 1)) xcd_barrier(bar); DIAG_ACC((k) == 0 ? 11 : ((k) - 1) % 11); } while (0)
#define LWS() ({ const __attribute__((address_space(4))) CFP* k_ = C.in; asm volatile("" : "+s"(k_)); (unsigned char*)k_[30]; })
#define LC() ({ Ctx c_ = C; c_.tid = threadIdx.x; asm volatile("" : "+v"(c_.tid)); c_.lane = c_.tid & 63; asm volatile("" : "+s"(c_.in)); c_.ws = (unsigned char*)c_.in[30]; c_.out = (float*)c_.in[29]; c_.ctl = (gu32*)(c_.ws + WS_CTL); c_; })
#ifdef DIAG_SEL
    if (blockIdx.x == 0 && threadIdx.x == 0) { volatile LAS unsigned* dg = (volatile LAS unsigned*)(C.lds + LDSCTL_OFF + 160); dg[0] = (unsigned)__builtin_amdgcn_s_memrealtime(); dg[1] = dg[0]; }
#endif
    if (EN(11) && IN(0)) { const Ctx Cl = LC(); phase_mod(Cl); RUN(11, phase_s5mats(Cl, 0); phase_weights(Cl, 0)); }
    SEAM(0);
    for (int l = 0; l < NLAYER; ++l) {
        const int pb = 1 + 11 * l;
        if (EN(0) && IN(pb)) { const Ctx Cl = LC(); if (l == 0) phase_rows<0>(Cl, 0); else { phase_s5mats(Cl, l); phase_weights(Cl, l); phase_rows<1>(Cl, l); } }
        SEAM(pb);
        if (EN(1) && IN(pb + 1)) { if (W8_ALL) { PWin8 P{LWS(), C.G, cg, 1024, 128u}; pg8::gemm_phase_m128(C.lds, P); } else { { PWin P{LWS(), C.G, cg, 1024, 128u}; pg8::gemm_phase(C.lds, P); } { PGate P{LWS(), C.G, cg, 1024, 128u}; pg8::gemm_phase_m128(C.lds, P); } } }
        SEAM(pb + 1);
        if (EN(2) && IN(pb + 2)) { { const Ctx Cl = LC(); phase_qkprep(Cl, l); } PS5A P{LWS(), C.G, cg, 512, 128u}; RUN(2, pg8::gemm_phase(C.lds, P)); }
        SEAM(pb + 2);
        if (EN(3) && IN(pb + 3)) { const Ctx Cl = LC(); RUN(3, phase_attn(Cl, l, lds)); }
        SEAM(pb + 3);
        if (EN(4) && IN(pb + 4)) { PS5B P{LWS(), C.G, cg, 256, 128u}; pg8::gemm_phase(C.lds, P); }
        SEAM(pb + 4);
        if (EN(5) && IN(pb + 5)) { PGlu P{LWS(), C.G, cg, 512, 128u, l == NLAYER - 1}; pg8::gemm_phase_m128(C.lds, P); }
        SEAM(pb + 5);
        if (EN(6) && IN(pb + 6)) { PMerge P{LWS(), C.G, cg, 512, 128u, l == NLAYER - 1}; pg8::gemm_phase_m128(C.lds, P); }
        SEAM(pb + 6);
        if (EN(7) && IN(pb + 7)) { unsigned char* wl_ = LWS(); PWout P{wl_, (float*)C.in[29], (const float*)(wl_ + WS_MOD) + (size_t)l * 5 * 6144, C.G, cg, 1024, 128u, l == NLAYER - 1}; pg8::gemm_phase_m128(C.lds, P); }
        SEAM(pb + 7);
        if (EN(8) && IN(pb + 8)) { const Ctx Cl = LC(); phase_norm2(Cl, l); }
        SEAM(pb + 8);
        if (EN(9) && IN(pb + 9)) { if (FP8_MOE) { build_exptab(C, tab, l); PMoe1 P{LWS(), tab, C.G, cg, 1024, 128u}; pg8::gemm_phase_m128(C.lds, P); } else { build_exptab(C, tab, l, 8); PMoe1B P{LWS(), tab, C.G, cg, 1024, 128u}; pg8::gemm_phase(C.lds, P); } }
        SEAM(pb + 9);
        if (EN(10) && IN(pb + 10)) { if (FP8_MOE) { build_exptab(C, tab, l); PMoe2 P{LWS(), tab, C.G, cg, 512, 128u}; pg8::gemm_phase_m128(C.lds, P); } else { build_exptab(C, tab, l, 8); PMoe2B P{LWS(), tab, C.G, cg, 512, 128u}; pg8::gemm_phase(C.lds, P); } }
        SEAM(pb + 10);
    }
    if (EN(12) && IN(NPH - 1)) { const Ctx Cl = LC(); phase_rows<2>(Cl, NLAYER); }
#ifdef DIAG_SEL
    xcd_barrier(bar); DIAG_ACC(12);
    if (blockIdx.x == 0 && threadIdx.x == 0) { volatile LAS unsigned* dg = (volatile LAS unsigned*)(C.lds + LDSCTL_OFF + 160); dg[8 + 13] = dg[0] - dg[1];
        for (int i = 0; i < 14; ++i) __hip_atomic_store(C.ctl + 2048 + i, dg[8 + i], RLX_AGENT); }
    xcd_barrier(bar);
    { const float d1 = (float)__hip_atomic_load(C.ctl + 2048 + (DIAG_SEL), RLX_AGENT) * 0.01f, d2 = (float)__hip_atomic_load(C.ctl + 2048 + (DIAG_SEL) + 1, RLX_AGENT) * 0.01f;
      const float c1 = sqrtf(d1); float* o = args.out;
      for (size_t i = (size_t)blockIdx.x * 512 + threadIdx.x; i < (size_t)NB * SEQ * D; i += (size_t)gridDim.x * 512) o[i] = (i == 12345) ? d2 : c1; }
#endif
#undef IN
#undef SEAM
}

#ifndef MK_PER_PHASE
#define MK_PER_PHASE 0
#endif
extern "C" void kernel_launch(void* const* d_in, const int* in_sizes, int n_in, void* d_out, int out_size, void* d_ws, size_t ws_size, hipStream_t stream) {
    static int grid = 0;
    if (grid == 0) {
        if (n_in != 29 || out_size != NB * SEQ * D || ws_size < WS_END) { fprintf(stderr, "kernel_launch: unexpected shapes (n_in %d out %d ws %zu)\n", n_in, out_size, ws_size); grid = -1; return; }
        int dev = 0, cus = 0, per_cu = 0;
        if (hipGetDevice(&dev) != hipSuccess || hipDeviceGetAttribute(&cus, hipDeviceAttributeMultiprocessorCount, dev) != hipSuccess) { grid = -1; return; }
        if (hipFuncSetAttribute((const void*)fwd, hipFuncAttributeMaxDynamicSharedMemorySize, LDS_BYTES) != hipSuccess) { grid = -1; return; }
        if (hipOccupancyMaxActiveBlocksPerMultiprocessor(&per_cu, (const void*)fwd, NWAVES * 64, LDS_BYTES) != hipSuccess || per_cu < 1) fprintf(stderr, "kernel_launch: occupancy query says %d\n", per_cu);
        (void)hipGetLastError();
        grid = cus;
    }
    if (grid < 0) return;
    (void)hipMemsetAsync((char*)d_ws + WS_CTL, 0, CTL_ZERO_BYTES, stream);
    Args a{};
    for (int i = 0; i < 29; ++i) a.in[i] = (const float*)d_in[i];
    a.out = (float*)d_out; a.ws = (unsigned char*)d_ws;
#if MK_PER_PHASE
    for (int p = 0; p < NPH; ++p) { a.ph_lo = p; a.ph_hi = p + 1; hipLaunchKernelGGL(fwd, dim3(grid), dim3(NWAVES * 64), LDS_BYTES, stream, a); }
#else
    a.ph_lo = 0; a.ph_hi = NPH; hipLaunchKernelGGL(fwd, dim3(grid), dim3(NWAVES * 64), LDS_BYTES, stream, a);
#endif
}
```

```cpp
#define FP8_MOE 1
#define GATE_BF16 0
#define W8_ALL 1
#define H8_WRITE 1
#ifndef H8_WRITE
#define H8_WRITE 1
#endif
#ifndef GATE_BF16
#define GATE_BF16 0
#endif
#include <hip/hip_runtime.h>
#include <cstdio>
#include <cstdint>

#define GAS __attribute__((address_space(1)))
#define LAS __attribute__((address_space(3)))
typedef unsigned short bf16;
typedef unsigned v4u __attribute__((ext_vector_type(4)));
typedef unsigned v2u __attribute__((ext_vector_type(2)));
typedef float f32x4 __attribute__((ext_vector_type(4)));
typedef float f32x2 __attribute__((ext_vector_type(2)));
typedef float f32x16 __attribute__((ext_vector_type(16)));
typedef short bf16x8 __attribute__((ext_vector_type(8)));
typedef short s16x4 __attribute__((ext_vector_type(4)));
typedef GAS unsigned gu32;
#define RLX_AGENT __ATOMIC_RELAXED, __HIP_MEMORY_SCOPE_AGENT
#define LDS_WAIT() asm volatile("s_waitcnt lgkmcnt(0)" ::: "memory")
#define VM_WAIT() asm volatile("s_waitcnt vmcnt(0)" ::: "memory")

constexpr int NB = 4, SEQ = 8192, CTX = 256, LB = SEQ + CTX, T = NB * LB, D = 1024, NPAN = T / 256;
constexpr int NLAYER = 4, INW = 5888, NCH = LB / 32, NCR = NB * NCH;
constexpr int NEXP = 16, FF = 512;
constexpr float EPS = 1e-6f;
constexpr float LOG2E = 1.4426950408889634f;
constexpr float C2 = 0.125f * LOG2E;
constexpr int NWAVES = 8;

constexpr size_t MiB = 1u << 20;
constexpr size_t WS_CTL = 0, CTL_ZERO_BYTES = 1 * MiB;
constexpr size_t WS_MOD = 1 * MiB;
constexpr size_t WS_LIST = 2 * MiB;
constexpr size_t WS_RW = 5 * MiB;
constexpr size_t WS_CTXS = 6 * MiB;
constexpr size_t WS_SST = 10 * MiB;
constexpr size_t WS_HB8 = WS_SST;
constexpr size_t WS_XST = 44 * MiB;
constexpr size_t WS_BT1 = 61 * MiB;
constexpr size_t WS_BT2 = 85 * MiB;
constexpr size_t WS_WIN = 93 * MiB;
constexpr size_t WS_WIN8 = WS_WIN + (size_t)2816 * 1024 * 2;
constexpr size_t WS_WGLU = 105 * MiB;
constexpr size_t WS_WBR = 106 * MiB;
constexpr size_t WS_WOUT = 109 * MiB;
constexpr size_t WS_MOE1 = 111 * MiB;
constexpr size_t WS_MOE2 = 143 * MiB;
constexpr size_t WS_HB = 159 * MiB;
constexpr size_t WS_U = 225 * MiB;
constexpr size_t WS_QA = 258 * MiB;
constexpr size_t WS_KA = 291 * MiB;
constexpr size_t WS_VA = 300 * MiB;
constexpr size_t WS_QN = 309 * MiB;
constexpr size_t WS_KN = 342 * MiB;
constexpr size_t WS_VN = 375 * MiB;
constexpr size_t WS_YS = 408 * MiB;
constexpr size_t WS_GATES = 441 * MiB;
constexpr size_t WS_ACT = WS_QN;
constexpr size_t WS_ACTB = WS_QN;
constexpr size_t WS_YSLOT = WS_GATES;
constexpr size_t WS_AO = 574 * MiB;
constexpr size_t WS_NO = 607 * MiB;
constexpr size_t WS_YG = 640 * MiB;
constexpr size_t WS_END = 673 * MiB;
static_assert(WS_GATES + (size_t)T * 3072 * (GATE_BF16 ? 2 : 1) <= WS_AO && WS_YSLOT + (size_t)2 * T * 1024 * 2 <= WS_AO && WS_ACT + (size_t)(2 * T + 4096) * 512 * 2 <= WS_YS, "ws map");
constexpr int CW_FAIL = 8;
constexpr int CW_CNT = 64;
constexpr int CW_BAR = 8192;

constexpr int RING_BYTES = 131072, LDS_BYTES = 147456, LDSCTL_OFF = LDS_BYTES - 512, MISC_OFF = LDSCTL_OFF + 320;

__device__ __forceinline__ unsigned f2bf(float f) { unsigned u = __builtin_bit_cast(unsigned, f); return (u + 0x7fffu + ((u >> 16) & 1u)) >> 16; }
__device__ __forceinline__ unsigned pk2(float lo, float hi) { return f2bf(lo) | (f2bf(hi) << 16); }
__device__ __forceinline__ float bf2f(unsigned b) { return __builtin_bit_cast(float, b << 16); }
__device__ __forceinline__ float bflo(unsigned w) { return __builtin_bit_cast(float, w << 16); }
__device__ __forceinline__ float bfhi(unsigned w) { return __builtin_bit_cast(float, w & 0xffff0000u); }
typedef float f32x2_c __attribute__((ext_vector_type(2))); typedef __bf16 bf16x2_c __attribute__((ext_vector_type(2)));
__device__ __forceinline__ unsigned cvt_pk_bf16(float lo, float hi) { const f32x2_c v = {lo, hi}; return __builtin_bit_cast(unsigned, __builtin_convertvector(v, bf16x2_c)); }
typedef int v8i __attribute__((ext_vector_type(8)));
typedef int v4i __attribute__((ext_vector_type(4)));
__device__ __forceinline__ float clamp8(float x) { return __builtin_fminf(__builtin_fmaxf(x, -448.f), 448.f); }
__device__ __forceinline__ unsigned pk4_fp8(float a, float b, float c, float d) { int w = 0; w = __builtin_amdgcn_cvt_pk_fp8_f32(clamp8(a), clamp8(b), w, false); w = __builtin_amdgcn_cvt_pk_fp8_f32(clamp8(c), clamp8(d), w, true); return (unsigned)w; }
__device__ __forceinline__ float fsigmoid(float x) { return __builtin_amdgcn_rcpf(1.f + __builtin_amdgcn_exp2f(-LOG2E * x)); }
__device__ __forceinline__ float gelu_tanh(float x) { const float u = 0.7978845608f * (x + 0.044715f * x * x * x); return x * __builtin_amdgcn_rcpf(1.f + __builtin_amdgcn_exp2f(-2.f * LOG2E * u)); }
__device__ __forceinline__ float shflx(float v, int m, int lane) { return __builtin_bit_cast(float, __builtin_amdgcn_ds_bpermute((lane ^ m) << 2, __builtin_bit_cast(int, v))); }
template <int CTRL, int RM>
__device__ __forceinline__ float dpp_mov(float v) { return __builtin_bit_cast(float, __builtin_amdgcn_update_dpp(0, __builtin_bit_cast(int, v), CTRL, RM, 0xF, true)); }
__device__ __forceinline__ float wave_sum(float v, int) {
    v += dpp_mov<0xB1, 0xF>(v);
    v += dpp_mov<0x4E, 0xF>(v);
    v += dpp_mov<0x141, 0xF>(v);
    v += dpp_mov<0x140, 0xF>(v);
    v += dpp_mov<0x142, 0xA>(v);
    v += dpp_mov<0x143, 0xC>(v);
    return __builtin_bit_cast(float, __builtin_amdgcn_readlane(__builtin_bit_cast(int, v), 63));
}
__device__ __forceinline__ float sin_rev(float r) { r = r - floorf(r); return __builtin_amdgcn_sinf(r); }
__device__ __forceinline__ float cos_rev(float r) { r = r - floorf(r); return __builtin_amdgcn_cosf(r); }

#define XB_TMO      128
#define XB_XCNT(j)  (256  + 64 * (j))
#define XB_XSUB(j)  (1280 + 64 * (j))
#define XB_XGEN(j)  (2304 + 64 * (j))
#define XB_TOP      3328
#define XB_TOPGEN   3392
#define XCD_BAR_WORDS 3456
#define XB_SPIN_CAP (1u << 22)

__device__ __forceinline__ unsigned xb_ld(unsigned* p)              { return __hip_atomic_load(p, __ATOMIC_RELAXED, __HIP_MEMORY_SCOPE_AGENT); }
__device__ __forceinline__ unsigned xb_add(unsigned* p, unsigned v) { return __hip_atomic_fetch_add(p, v, __ATOMIC_RELAXED, __HIP_MEMORY_SCOPE_AGENT); }
__device__ __forceinline__ unsigned xb_xcc_id() { return (unsigned)__builtin_amdgcn_s_getreg((3 << 11) | 20) & 0xFu; }
#define XB_SPIN(cond, bar) do { unsigned _sp = 0; while (cond) { __builtin_amdgcn_s_sleep(1); \
    if ((++_sp & 255u) == 0u) { if (xb_ld(&(bar)[XB_TMO])) break; if (_sp > XB_SPIN_CAP) { atomicAdd(&(bar)[XB_TMO], 1u); break; } } } } while (0)

struct XcdBarrier { unsigned* bar; unsigned x; volatile LAS unsigned* st; };

__device__ __forceinline__ XcdBarrier xcd_barrier_post(unsigned* bar, volatile LAS unsigned* st) {
    XcdBarrier b; b.bar = bar; b.x = xb_xcc_id(); b.st = st;
    if (threadIdx.x == 0) (void)xb_add(&bar[XB_XCNT(b.x)], 1u);
    return b;
}
__device__ __forceinline__ void xcd_barrier_complete(unsigned* bar, unsigned x, unsigned& nloc, unsigned& nx) {
    const unsigned G = gridDim.x * gridDim.y * gridDim.z;
    unsigned sum, cnt, mine, sp = 0u;
    for (;;) {
        sum = 0u; cnt = 0u; mine = 0u;
#pragma unroll
        for (unsigned j = 0; j < 16; ++j) { const unsigned c = xb_ld(&bar[XB_XCNT(j)]); sum += c; cnt += (c > 0u) ? 1u : 0u; mine = (j == x) ? c : mine; }
        if (sum == G) break;
        __builtin_amdgcn_s_sleep(1);
        if ((++sp & 255u) == 0u) { if (xb_ld(&bar[XB_TMO])) break; if (sp > XB_SPIN_CAP) { atomicAdd(&bar[XB_TMO], 1u); break; } }
    }
    nloc = mine > 0u ? mine : 1u; nx = cnt > 0u ? cnt : 1u;
}
__device__ __forceinline__ void xcd_barrier(const XcdBarrier& b) {
    asm volatile("s_waitcnt vmcnt(0)" ::: "memory");
    __syncthreads();
    if (threadIdx.x == 0) {
        unsigned* bar = b.bar;
        __builtin_amdgcn_s_waitcnt(0);
        unsigned nloc = b.st[0], nx = b.st[1];
        if (nloc == 0u) { xcd_barrier_complete(bar, b.x, nloc, nx); b.st[0] = nloc; b.st[1] = nx; }
        const unsigned old = xb_add(&bar[XB_XSUB(b.x)], 1u);
        const unsigned gen = old / nloc;
        if (old + 1u == (gen + 1u) * nloc) {
            __builtin_amdgcn_fence(__ATOMIC_RELEASE, "agent");
            asm volatile("s_waitcnt vmcnt(0)" ::: "memory");
            const unsigned og = xb_add(&bar[XB_TOP], 1u);
            const unsigned tg = og / nx;
            if (og + 1u == (tg + 1u) * nx) xb_add(&bar[XB_TOPGEN], 1u);
            else XB_SPIN(xb_ld(&bar[XB_TOPGEN]) == tg, bar);
            __builtin_amdgcn_fence(__ATOMIC_ACQUIRE, "agent");
            xb_add(&bar[XB_XGEN(b.x)], 1u);
            asm volatile("s_waitcnt vmcnt(0)" ::: "memory");
        } else {
            XB_SPIN(xb_ld(&bar[XB_XGEN(b.x)]) == gen, bar);
            __builtin_amdgcn_fence(__ATOMIC_ACQUIRE, "agent");
            asm volatile("s_waitcnt vmcnt(0)" ::: "memory");
        }
    }
    __syncthreads();
}

namespace pg8 {
constexpr int BM = 256, BK = 64, HALF = 128, HTB = HALF * BK * 2, STAGE_BYTES = 8 * HTB, NXCD = 8, WGM = 8;
__host__ __device__ __forceinline__ int lds_byte(int r, int c) { const int st = (r >> 4) * 2 + (c >> 5), rr = r & 15, cc = c & 31, ob = rr * 64 + cc * 2; return st * 1024 + (ob ^ (((ob >> 9) & 1) << 5)); }
__host__ __device__ __forceinline__ void stage_rc(int b, int& R, int& C) { const int st = b / 1024, sb = b % 1024, swz = sb ^ (((sb >> 9) & 1) << 5); R = (st >> 1) * 16 + swz / 64; C = (st & 1) * 32 + (swz % 64) / 2; }
__host__ __device__ __forceinline__ int perm32(int rho) { const int n = rho >> 4, i = rho & 15; return 8 * (i >> 2) + 4 * n + (i & 3); }

struct Unit { int pm, pn, z; };

__device__ __forceinline__ void static_decode(int L, int nM, int nN, int& pm, int& pn) {
    const int nwg = nM * nN; int wgid = L;
    { const int q = nwg / NXCD, r = nwg % NXCD, xcd = wgid % NXCD, off = wgid / NXCD; wgid = (xcd < r ? xcd * (q + 1) : r * (q + 1) + (xcd - r) * q) + off; }
    const int nig = WGM * nN, gid = wgid / nig, fm = gid * WGM, gsz = (nM - fm) < WGM ? (nM - fm) : WGM;
    pm = fm + ((wgid % nig) % gsz); pn = (wgid % nig) / gsz;
}

template <class P>
__device__ __forceinline__ void gemm_phase(LAS unsigned char* lds, const P& S) {
    int tid_ = threadIdx.x; asm volatile("" : "+v"(tid_));
    const int tid = tid_, wid = __builtin_amdgcn_readfirstlane(tid >> 6), lane = tid & 63, wr = wid >> 2, wc = wid & 3, fr = lane & 15, fq = lane >> 4;
    constexpr int ELB = P::FP8 ? 1 : 2;
    const int K = S.K; int nt = K * ELB / 128; asm volatile("" : "+s"(nt));
    unsigned voffB[2];
#pragma unroll
    for (int i = 0; i < 2; ++i) { int R, C; stage_rc(tid * 16 + i * 8192, R, C); const int Rb = (R & ~31) + perm32(R & 31); voffB[i] = (unsigned)(Rb * K * ELB + C * 2); }
#define PG8_AOFF(dst0, dst1, u) do { _Pragma("unroll") for (int i = 0; i < 2; ++i) { int R, C; stage_rc(tid * 16 + i * 8192, R, C); dst0[i] = S.a_off(u, 0, R, C); dst1[i] = S.a_off(u, 1, R, C); } } while (0)
    const size_t kstepB = (size_t)(BK * 2), hstepB = (size_t)HALF * K * ELB, kstepA = (size_t)S.kstepA;
    const unsigned ldsw = (unsigned)wid * 1024u;
    const int aoff = lds_byte(wr * 64 + fr, fq * 8), boff = lds_byte(wc * 32 + fr, fq * 8);
#define PG8_SA(b, h) (((b) * 2 + (h)) * HTB)
#define PG8_SB(b, h) ((4 + (b) * 2 + (h)) * HTB)
#define PG8_STAGE(bufoff, gbase, voff) do { _Pragma("unroll") for (int _i = 0; _i < 2; ++_i) \
        __builtin_amdgcn_global_load_lds((const unsigned*)((const char*)(gbase) + (voff)[_i]), (LAS unsigned*)(lds + (bufoff) + ldsw + _i * 8192), 16, 0, 0); } while (0)
#define PG8_LDA(dst, b, h) do { _Pragma("unroll") for (int m = 0; m < 4; ++m) _Pragma("unroll") for (int k = 0; k < 2; ++k) dst[m][k] = *(const LAS bf16x8*)(lds + PG8_SA(b, h) + aoff + m * 2048 + k * 1024); } while (0)
#define PG8_LDB(dst, b, h) do { _Pragma("unroll") for (int n = 0; n < 2; ++n) _Pragma("unroll") for (int k = 0; k < 2; ++k) dst[n][k] = *(const LAS bf16x8*)(lds + PG8_SB(b, h) + boff + n * 2048 + k * 1024); } while (0)
#define PG8_CAT(x0, x1) __builtin_shufflevector(__builtin_bit_cast(v4i, x0), __builtin_bit_cast(v4i, x1), 0, 1, 2, 3, 4, 5, 6, 7)
#define PG8_MMA(ai, bj, At, Bt) do { __builtin_amdgcn_s_setprio(1); _Pragma("unroll") for (int m = 0; m < 4; ++m) _Pragma("unroll") for (int n = 0; n < 2; ++n) { \
        if constexpr (P::FP8) acc[ai][bj][m][n] = __builtin_amdgcn_mfma_scale_f32_16x16x128_f8f6f4(PG8_CAT(Bt[n][0], Bt[n][1]), PG8_CAT(At[m][0], At[m][1]), acc[ai][bj][m][n], 0, 0, 0, 0x7f7f7f7f, 0, 0x7f7f7f7f); \
        else { _Pragma("unroll") for (int k = 0; k < 2; ++k) acc[ai][bj][m][n] = __builtin_amdgcn_mfma_f32_16x16x32_bf16(Bt[n][k], At[m][k], acc[ai][bj][m][n], 0, 0, 0); } } __builtin_amdgcn_s_setprio(0); } while (0)
#define PG8_WAIT_V(n) asm volatile("s_waitcnt vmcnt(" #n ")" ::: "memory")
#define PG8_WAIT_L(n) asm volatile("s_waitcnt lgkmcnt(" #n ")" ::: "memory")
#define PG8_BAR __builtin_amdgcn_s_barrier()
#define PG8_SCHED __builtin_amdgcn_sched_barrier(0)
    Unit cur, nxt; int ui = 0;
    if (!S.next(0, cur)) return;
    f32x4 acc[2][2][4][2];
#pragma unroll
    for (int a = 0; a < 2; ++a)
#pragma unroll
        for (int b = 0; b < 2; ++b)
#pragma unroll
            for (int m = 0; m < 4; ++m)
#pragma unroll
                for (int n = 0; n < 2; ++n) acc[a][b][m][n] = (f32x4){0.f, 0.f, 0.f, 0.f};
    bf16x8 At[4][2], B0[2][2], B1[2][2];
    unsigned vA0[2], vA1[2], vN0[2], vN1[2];
    PG8_AOFF(vA0, vA1, cur);
    const char* cA = S.a_base(cur); const char* cB = S.b_base(cur);
    PG8_STAGE(PG8_SB(0, 0), cB, voffB); PG8_STAGE(PG8_SB(0, 1), cB + hstepB, voffB); PG8_STAGE(PG8_SA(0, 0), cA, vA0); PG8_STAGE(PG8_SA(0, 1), cA, vA1);
    if (wr == 1) PG8_BAR;
    PG8_WAIT_V(2); PG8_BAR;
    PG8_STAGE(PG8_SB(1, 0), cB + kstepB, voffB); PG8_STAGE(PG8_SA(1, 0), cA + kstepA, vA0); PG8_STAGE(PG8_SB(1, 1), cB + hstepB + kstepB, voffB);
    PG8_WAIT_V(6); PG8_BAR;
    for (;;) {
        const bool has_next = S.next(ui + 1, nxt);
        const char* nA = cA; const char* nB = cB;
        if (has_next) { nA = S.a_base(nxt); nB = S.b_base(nxt); if (P::EARLY_AOFF) PG8_AOFF(vN0, vN1, nxt); }
        for (int t = 0; t < nt; t += 2) {
            const bool last = (t == nt - 2);
            const char* a1 = cA + (size_t)(t + 1) * kstepA;
            const char* a2 = last ? nA : cA + (size_t)(t + 2) * kstepA; const char* b2 = last ? nB : cB + (size_t)(t + 2) * kstepB;
            const char* a3 = a2 + kstepA; const char* b3 = b2 + kstepB;
            PG8_LDB(B0, 0, 0); PG8_LDB(B1, 0, 1); PG8_SCHED; PG8_LDA(At, 0, 0); PG8_STAGE(PG8_SA(1, 1), a1, vA1);
            if (last && has_next) {
                if (P::EARLY_AOFF) { _Pragma("unroll") for (int i = 0; i < 2; ++i) { vA0[i] = vN0[i]; vA1[i] = vN1[i]; } } else PG8_AOFF(vA0, vA1, nxt); }
            PG8_WAIT_V(8); PG8_WAIT_L(0); PG8_BAR; PG8_MMA(0, 0, At, B0); PG8_MMA(0, 1, At, B1); PG8_BAR; PG8_SCHED;
            PG8_LDA(At, 0, 1); PG8_STAGE(PG8_SB(0, 0), b2, voffB); PG8_STAGE(PG8_SB(0, 1), b2 + hstepB, voffB); PG8_STAGE(PG8_SA(0, 0), a2, vA0);
            PG8_WAIT_V(8); PG8_WAIT_L(0); PG8_BAR; PG8_MMA(1, 0, At, B0); PG8_MMA(1, 1, At, B1); PG8_BAR; PG8_SCHED;
            PG8_LDB(B0, 1, 0); PG8_LDB(B1, 1, 1); PG8_SCHED; PG8_LDA(At, 1, 0); PG8_STAGE(PG8_SA(0, 1), a2, vA1);
            PG8_WAIT_V(8); PG8_WAIT_L(0); PG8_BAR; PG8_MMA(0, 0, At, B0); PG8_MMA(0, 1, At, B1); PG8_BAR; PG8_SCHED;
            PG8_LDA(At, 1, 1); PG8_STAGE(PG8_SB(1, 0), b3, voffB); PG8_STAGE(PG8_SB(1, 1), b3 + hstepB, voffB); PG8_STAGE(PG8_SA(1, 0), a3, vA0);
            PG8_WAIT_V(8); PG8_WAIT_L(0); PG8_BAR; PG8_MMA(1, 0, At, B0); PG8_MMA(1, 1, At, B1); PG8_BAR; PG8_SCHED;
        }
        if (wr == 0) PG8_BAR;
        S.epi(acc, cur, wr, wc, fr, fq);
        if (!has_next) break;
#pragma unroll
        for (int a = 0; a < 2; ++a)
#pragma unroll
            for (int b = 0; b < 2; ++b)
#pragma unroll
                for (int m = 0; m < 4; ++m)
#pragma unroll
                    for (int n = 0; n < 2; ++n) acc[a][b][m][n] = (f32x4){0.f, 0.f, 0.f, 0.f};
        cur = nxt; cA = nA; cB = nB; ++ui;
        if (wr == 1) PG8_BAR;
    }
    PG8_WAIT_V(0);
    PG8_BAR;
#undef PG8_AOFF
#undef PG8_SA
#undef PG8_SB
#undef PG8_STAGE
#undef PG8_LDA
#undef PG8_LDB
#undef PG8_MMA
#undef PG8_CAT
#undef PG8_WAIT_V
#undef PG8_WAIT_L
#undef PG8_BAR
#undef PG8_SCHED
}

template <class P>
__device__ __forceinline__ void gemm_phase_m128(LAS unsigned char* lds, const P& S) {
    int tid_ = threadIdx.x; asm volatile("" : "+v"(tid_));
    const int tid = tid_, wid = __builtin_amdgcn_readfirstlane(tid >> 6), lane = tid & 63, wr = wid >> 2, wc = wid & 3, fr = lane & 15, fq = lane >> 4;
    constexpr int ELB = P::FP8 ? 1 : 2;
    const int K = S.K; int nt = K * ELB / 128; asm volatile("" : "+s"(nt));
    unsigned voffB[2];
#pragma unroll
    for (int i = 0; i < 2; ++i) { int R, C; stage_rc(tid * 16 + i * 8192, R, C); const int Rb = (R & ~31) + perm32(R & 31); voffB[i] = (unsigned)(Rb * K * ELB + C * 2); }
#define PG8_AOFF(dst0, u) do { _Pragma("unroll") for (int i = 0; i < 2; ++i) { int R, C; stage_rc(tid * 16 + i * 8192, R, C); dst0[i] = S.a_off(u, R, C); } } while (0)
    const size_t kstepB = (size_t)(BK * 2), hstepB = (size_t)HALF * K * ELB, kstepA = (size_t)S.kstepA;
    const unsigned ldsw = (unsigned)wid * 1024u;
    const int aoff = lds_byte(wr * 64 + fr, fq * 8), boff = lds_byte(wc * 32 + fr, fq * 8);
#define PG8_SA(b) (((b) * 2) * HTB)
#define PG8_SB(b, h) ((4 + (b) * 2 + (h)) * HTB)
#define PG8_STAGE(bufoff, gbase, voff) do { _Pragma("unroll") for (int _i = 0; _i < 2; ++_i) \
        __builtin_amdgcn_global_load_lds((const unsigned*)((const char*)(gbase) + (voff)[_i]), (LAS unsigned*)(lds + (bufoff) + ldsw + _i * 8192), 16, 0, 0); } while (0)
#define PG8_LDA(dst, b) do { _Pragma("unroll") for (int m = 0; m < 4; ++m) _Pragma("unroll") for (int k = 0; k < 2; ++k) dst[m][k] = *(const LAS bf16x8*)(lds + PG8_SA(b) + aoff + m * 2048 + k * 1024); } while (0)
#define PG8_LDB(dst, b, h) do { _Pragma("unroll") for (int n = 0; n < 2; ++n) _Pragma("unroll") for (int k = 0; k < 2; ++k) dst[n][k] = *(const LAS bf16x8*)(lds + PG8_SB(b, h) + boff + n * 2048 + k * 1024); } while (0)
#define PG8_CAT(x0, x1) __builtin_shufflevector(__builtin_bit_cast(v4i, x0), __builtin_bit_cast(v4i, x1), 0, 1, 2, 3, 4, 5, 6, 7)
#define PG8_MMA(bj, At, Bt) do { __builtin_amdgcn_s_setprio(1); _Pragma("unroll") for (int m = 0; m < 4; ++m) _Pragma("unroll") for (int n = 0; n < 2; ++n) { \
        if constexpr (P::FP8) acc[bj][m][n] = __builtin_amdgcn_mfma_scale_f32_16x16x128_f8f6f4(PG8_CAT(Bt[n][0], Bt[n][1]), PG8_CAT(At[m][0], At[m][1]), acc[bj][m][n], 0, 0, 0, 0x7f7f7f7f, 0, 0x7f7f7f7f); \
        else { _Pragma("unroll") for (int k = 0; k < 2; ++k) acc[bj][m][n] = __builtin_amdgcn_mfma_f32_16x16x32_bf16(Bt[n][k], At[m][k], acc[bj][m][n], 0, 0, 0); } } __builtin_amdgcn_s_setprio(0); } while (0)
#define PG8_WAIT_V(n) asm volatile("s_waitcnt vmcnt(" #n ")" ::: "memory")
#define PG8_WAIT_L(n) asm volatile("s_waitcnt lgkmcnt(" #n ")" ::: "memory")
#define PG8_BAR __builtin_amdgcn_s_barrier()
#define PG8_SCHED __builtin_amdgcn_sched_barrier(0)
    Unit cur, nxt; int ui = 0;
    if (!S.next(0, cur)) return;
    f32x4 acc[2][4][2], st[2][4][2];
#pragma unroll
    for (int a = 0; a < 2; ++a)
#pragma unroll
        for (int m = 0; m < 4; ++m)
#pragma unroll
            for (int n = 0; n < 2; ++n) { acc[a][m][n] = (f32x4){0.f, 0.f, 0.f, 0.f}; st[a][m][n] = (f32x4){0.f, 0.f, 0.f, 0.f}; }
    bf16x8 At[4][2], B0[2][2];
    unsigned vA[2], vN[2];
    PG8_AOFF(vA, cur);
    const char* cA = S.a_base(cur); const char* cB = S.b_base(cur);
    PG8_STAGE(PG8_SB(0, 0), cB, voffB); PG8_STAGE(PG8_SA(0), cA, vA); PG8_STAGE(PG8_SB(0, 1), cB + hstepB, voffB);
    if (wr == 1) PG8_BAR;
    PG8_WAIT_V(2); PG8_BAR;
    PG8_STAGE(PG8_SB(1, 0), cB + kstepB, voffB); PG8_STAGE(PG8_SA(1), cA + kstepA, vA);
    PG8_WAIT_V(4); PG8_BAR;
    for (;;) {
        const bool has_next = S.next(ui + 1, nxt);
        const char* nA = cA; const char* nB = cB;
        if (has_next) { nA = S.a_base(nxt); nB = S.b_base(nxt); if (P::EARLY_AOFF) PG8_AOFF(vN, nxt); }
        for (int t = 0; t < nt; t += 2) {
            const bool last = (t == nt - 2);
            const char* b1 = cB + (size_t)(t + 1) * kstepB;
            const char* a2 = last ? nA : cA + (size_t)(t + 2) * kstepA; const char* b2 = last ? nB : cB + (size_t)(t + 2) * kstepB;
            const char* a3 = a2 + kstepA; const char* b3 = b2 + kstepB;
            PG8_LDB(B0, 0, 0); PG8_SCHED; PG8_LDA(At, 0); PG8_STAGE(PG8_SB(1, 1), b1 + hstepB, voffB);
            if (last && has_next) { if (P::EARLY_AOFF) { vA[0] = vN[0]; vA[1] = vN[1]; } else PG8_AOFF(vA, nxt); }
            PG8_WAIT_V(6); PG8_WAIT_L(0); PG8_BAR; PG8_MMA(0, At, B0); PG8_BAR; PG8_SCHED;
            PG8_LDB(B0, 0, 1); PG8_STAGE(PG8_SB(0, 0), b2, voffB); PG8_STAGE(PG8_SA(0), a2, vA);
            PG8_WAIT_V(6); PG8_WAIT_L(0); PG8_BAR; PG8_MMA(1, At, B0); PG8_BAR; PG8_SCHED;
            PG8_LDB(B0, 1, 0); PG8_SCHED; PG8_LDA(At, 1); PG8_STAGE(PG8_SB(0, 1), b2 + hstepB, voffB);
            PG8_WAIT_V(6); PG8_WAIT_L(0); PG8_BAR; PG8_MMA(0, At, B0); PG8_BAR; PG8_SCHED;
            PG8_LDB(B0, 1, 1); PG8_STAGE(PG8_SB(1, 0), b3, voffB); PG8_STAGE(PG8_SA(1), a3, vA);
            PG8_WAIT_V(6); PG8_WAIT_L(0); PG8_BAR; PG8_MMA(1, At, B0); PG8_BAR; PG8_SCHED;
        }
        if (wr == 0) PG8_BAR;
        S.epi(acc, st, cur, wr, wc, fr, fq);
        if (!has_next) break;
#pragma unroll
        for (int a = 0; a < 2; ++a)
#pragma unroll
            for (int m = 0; m < 4; ++m)
#pragma unroll
                for (int n = 0; n < 2; ++n) acc[a][m][n] = (f32x4){0.f, 0.f, 0.f, 0.f};
        cur = nxt; cA = nA; cB = nB; ++ui;
        if (wr == 1) PG8_BAR;
    }
    PG8_WAIT_V(0);
    PG8_BAR;
#undef PG8_AOFF
#undef PG8_SA
#undef PG8_SB
#undef PG8_STAGE
#undef PG8_LDA
#undef PG8_LDB
#undef PG8_MMA
#undef PG8_CAT
#undef PG8_WAIT_V
#undef PG8_WAIT_L
#undef PG8_BAR
#undef PG8_SCHED
}
}
namespace attn_body {
using bf16x8 = __attribute__((ext_vector_type(8))) short;
using u32x4 = __attribute__((ext_vector_type(4))) unsigned;
constexpr int NW = 8, QBLK = 32, QB = QBLK * NW, KVBLK = 64;
__device__ __forceinline__ int crow(int r, int hi) { return (r & 3) + 8 * (r >> 2) + 4 * hi; }
#define SBAR() __builtin_amdgcn_sched_barrier(0)
constexpr int NSLOT = 3, SLOTB = 8192;
constexpr int LDS_K = 0, LDS_V = NSLOT * SLOTB, LDS_WS = 2 * NSLOT * SLOTB, LDS_OST = LDS_WS + NW * 64 * 4, LDS_BYTES = LDS_OST + NW * 4096;
constexpr int LDS_BT = 86016 + 256;
__device__ __forceinline__ void glds16(const void* gsrc, unsigned lds_dst) { unsigned keep;
  asm volatile("s_mov_b32 %0, m0\n\ts_mov_b32 m0, %2\n\ts_nop 0\n\tglobal_load_lds_dwordx4 %1, off\n\ts_mov_b32 m0, %0" : "=&s"(keep) : "v"(gsrc), "s"(lds_dst) : "memory"); }
__device__ __forceinline__ float max3f(float a, float b, float c) { float r; asm("v_max3_f32 %0, %1, %2, %3" : "=v"(r) : "v"(a), "v"(b), "v"(c)); return r; }
__device__ __forceinline__ float max2f(float a, float b) { float r; asm("v_max_f32_e32 %0, %1, %2" : "=v"(r) : "v"(a), "v"(b)); return r; }
__device__ __forceinline__ float fadd_s(float a, float b) { float r; asm("v_add_f32_e32 %0, %1, %2" : "=v"(r) : "v"(a), "v"(b)); return r; }
__device__ __forceinline__ float fsub_s(float a, float b) { float r; asm("v_sub_f32_e32 %0, %1, %2" : "=v"(r) : "v"(a), "v"(b)); return r; }
typedef float f32x2_t __attribute__((ext_vector_type(2))); typedef __bf16 bf16x2_t __attribute__((ext_vector_type(2)));
__device__ __forceinline__ unsigned cvtpk_s(float lo, float hi) { f32x2_t v = {lo, hi}; bf16x2_t b = __builtin_convertvector(v, bf16x2_t); return __builtin_bit_cast(unsigned, b); }
#define WAIT_BAR(N) asm volatile("s_waitcnt vmcnt(" #N ") lgkmcnt(0)\n\ts_barrier" ::: "memory")

__device__ __forceinline__ void qkt(f32x16& p0, f32x16& p1, const char* Kslot, const bf16x8* qr, const f32x16& negm, int r32, int hi) {
  const char* kb = Kslot + hi * 1024 + r32 * 16;
  #pragma unroll
  for (int d0 = 0; d0 < 4; ++d0) {
    const bf16x8 b0 = *reinterpret_cast<const bf16x8*>(kb + d0 * 2048);
    const bf16x8 b1 = *reinterpret_cast<const bf16x8*>(kb + d0 * 2048 + 512);
    if (d0 == 0) { p0 = __builtin_amdgcn_mfma_f32_32x32x16_bf16(b0, qr[0], negm, 0, 0, 0); p1 = __builtin_amdgcn_mfma_f32_32x32x16_bf16(b1, qr[0], negm, 0, 0, 0); }
    else { p0 = __builtin_amdgcn_mfma_f32_32x32x16_bf16(b0, qr[d0], p0, 0, 0, 0); p1 = __builtin_amdgcn_mfma_f32_32x32x16_bf16(b1, qr[d0], p1, 0, 0, 0); } }
}
typedef __attribute__((address_space(3))) const char* lds_cptr;
typedef short v4i16_t __attribute__((ext_vector_type(4)));
__device__ __forceinline__ void kload8(bf16x8* kf, lds_cptr kp) {
  kf[0] = *(const __attribute__((address_space(3))) bf16x8*)(kp);        kf[1] = *(const __attribute__((address_space(3))) bf16x8*)(kp + 512);
  kf[2] = *(const __attribute__((address_space(3))) bf16x8*)(kp + 2048); kf[3] = *(const __attribute__((address_space(3))) bf16x8*)(kp + 2560);
  kf[4] = *(const __attribute__((address_space(3))) bf16x8*)(kp + 4096); kf[5] = *(const __attribute__((address_space(3))) bf16x8*)(kp + 4608);
  kf[6] = *(const __attribute__((address_space(3))) bf16x8*)(kp + 6144); kf[7] = *(const __attribute__((address_space(3))) bf16x8*)(kp + 6656);
}
__device__ __forceinline__ void kload2(bf16x8* kf, lds_cptr kp, int j) { kf[2 * j] = *(const __attribute__((address_space(3))) bf16x8*)(kp + j * 2048); kf[2 * j + 1] = *(const __attribute__((address_space(3))) bf16x8*)(kp + j * 2048 + 512); }
__device__ __forceinline__ s16x4 vtr(lds_cptr p) { return __builtin_bit_cast(s16x4, __builtin_amdgcn_ds_read_tr16_b64_v4i16((__attribute__((address_space(3))) v4i16_t*)p)); }
__device__ __forceinline__ float rowmax(const f32x16& p0, const f32x16& p1) {
  float a = max3f(p0[0], p0[1], p1[0]), b = max3f(p0[2], p0[3], p1[1]); a = max3f(a, p1[2], p1[3]);
  #pragma unroll
  for (int r = 4; r < 16; r += 4) { a = max3f(a, p0[r], p0[r + 1]); b = max3f(b, p0[r + 2], p0[r + 3]); a = max3f(a, p1[r], p1[r + 1]); b = max3f(b, p1[r + 2], p1[r + 3]); }
  const float m = max2f(a, b);
  auto rr = __builtin_amdgcn_permlane32_swap(__float_as_uint(m), __float_as_uint(m), false, false);
  return max2f(__uint_as_float(rr[0]), __uint_as_float(rr[1]));
}
__device__ __forceinline__ void pv(f32x16* o, int vb, bf16x8 pa0, bf16x8 pa1, bf16x8 pa2, bf16x8 pa3) {
  #pragma unroll
  for (int d0 = 0; d0 < 2; ++d0) { s16x4 lo[4], hi[4];
    #pragma unroll
    for (int ks = 0; ks < 4; ++ks) {
      asm volatile("ds_read_b64_tr_b16 %0,%1 offset:%c2" : "=&v"(lo[ks]) : "v"(vb), "i"(d0 * 4096 + ks * 1024) : "memory");
      asm volatile("ds_read_b64_tr_b16 %0,%1 offset:%c2" : "=&v"(hi[ks]) : "v"(vb), "i"(d0 * 4096 + ks * 1024 + 512) : "memory"); }
    asm volatile("s_waitcnt lgkmcnt(0)" ::: "memory"); SBAR();
    #define PK(k) (bf16x8){lo[k][0], lo[k][1], lo[k][2], lo[k][3], hi[k][0], hi[k][1], hi[k][2], hi[k][3]}
    o[d0] = __builtin_amdgcn_mfma_f32_32x32x16_bf16(pa0, PK(0), o[d0], 0, 0, 0);
    o[d0] = __builtin_amdgcn_mfma_f32_32x32x16_bf16(pa1, PK(1), o[d0], 0, 0, 0);
    o[d0] = __builtin_amdgcn_mfma_f32_32x32x16_bf16(pa2, PK(2), o[d0], 0, 0, 0);
    o[d0] = __builtin_amdgcn_mfma_f32_32x32x16_bf16(pa3, PK(3), o[d0], 0, 0, 0);
    #undef PK
  }
}
#define ATTN_STORE16(p, v) (*(u32x4*)(p) = (v))

template <int THRL, bool NA, int QP_, int KVP_, bool NOMAX = false>
__device__ __forceinline__ void attn_unit(const bf16* Qu, int qp_rt, const bf16* __restrict__ Kh, const bf16* __restrict__ Vh, int kvp_rt, bf16* Ou, int NT, int r0, int rlo, char* shm) {
  const int qp = QP_ ? QP_ : qp_rt, kvp = KVP_ ? KVP_ : kvp_rt, op = qp;
  int tid_ = threadIdx.x; asm volatile("" : "+v"(tid_));
  const int tid = tid_, lane = tid & 63, r32 = lane & 31, hi = lane >> 5; const int wid = __builtin_amdgcn_readfirstlane(tid >> 6);
  const bf16* Qw = Qu + (long)(wid * QBLK) * qp;
  const unsigned lds0 = (unsigned)(uintptr_t)shm;
  float* wsf = (float*)(shm + LDS_WS) + wid * 64;
  const bf16* ksrc = Kh + (long)lane * kvp + wid * 8;
  const bf16* vsrc = Vh + (long)(16 * (wid & 3) + (lane >> 2)) * kvp + (wid >> 2) * 32 + (lane & 3) * 8;
  const unsigned kdst = lds0 + LDS_K + wid * 1024, vdst = lds0 + LDS_V + wid * 1024;
  #define TROW(t) (NA ? ((t) < 4 ? 64 * (t) : CTX + 64 * ((rlo + (t) - 4) < 127 ? (rlo + (t) - 4) : 127)) : 64 * (t))
  #define DMA_K(t, slot) glds16(ksrc + (long)TROW(t) * kvp, (unsigned)__builtin_amdgcn_readfirstlane(kdst + (slot)))
  #define DMA_V(t, slot) glds16(vsrc + (long)TROW(t) * kvp, (unsigned)__builtin_amdgcn_readfirstlane(vdst + (slot)))
  const int vb0 = (int)(lds0 + LDS_V) + ((lane >> 4) & 1) * 32 + (lane & 3) * 8 + (4 * hi + ((lane & 15) >> 2)) * 64;
  const char* Kbase = shm + LDS_K; bf16x8 kf[8];
  const lds_cptr shm3 = (lds_cptr)shm; const lds_cptr kp0 = shm3 + LDS_K + hi * 1024 + r32 * 16; const lds_cptr vp0 = shm3 + LDS_V + ((lane >> 4) & 1) * 32 + (lane & 3) * 8 + (4 * hi + ((lane & 15) >> 2)) * 64;
  const int rq = r0 + (wid >> 1), qc = 32 * (wid & 1) + r32;
  const int rsw = rq - 4 < 0 ? 0 : (rq - 4 > 120 ? 120 : rq - 4);
  const int cs = qc - 8 < 0 ? 0 : (qc - 8 > 48 ? 48 : qc - 8);
  const __attribute__((address_space(3))) float* btl = (const __attribute__((address_space(3))) float*)(shm3 + LDS_BT) + (15 + 4 * hi - qc);
  DMA_K(0, 0); DMA_V(0, 0); DMA_K(1, SLOTB);
  bf16x8 qr[4];
  #pragma unroll
  for (int d0 = 0; d0 < 4; ++d0) qr[d0] = *reinterpret_cast<const bf16x8*>(&Qw[(long)r32 * qp + d0 * 16 + hi * 8]);
  float mhat = 0.f, l_reg = 0.f; f32x16 o[2]; o[0] = f32x16{}; o[1] = f32x16{}; f32x16 negm = f32x16{}; if (!NA) asm volatile("" : "+v"(negm));
  #define NEGM (NA ? f32x16{} : negm)
  #define CMASK(P0, P1, t) do { if (NA) { if ((t) >= 4) { const int kr_ = rlo + (t) - 4; const int dr_ = kr_ - rsw; \
      if (dr_ < 0 || dr_ >= 8) { _Pragma("unroll") for (int r = 0; r < 16; ++r) { P0[r] = (-__builtin_inff()); P1[r] = (-__builtin_inff()); } } \
      else { const __attribute__((address_space(3))) float* bp_ = btl + (kr_ - rq + 7) * 31; const int kl0_ = 4 * hi - cs; \
        _Pragma("unroll") for (int rg = 0; rg < 4; ++rg) { \
          _Pragma("unroll") for (int rr_ = 0; rr_ < 4; ++rr_) { const int r = rg * 4 + rr_; const int kc_ = (r & 3) + 8 * (r >> 2); const float b0_ = bp_[kc_], b1_ = bp_[kc_ + 32]; \
            const int kl_ = kc_ + kl0_; P0[r] = ((unsigned)kl_ < 16u) ? P0[r] + b0_ : (-__builtin_inff()); P1[r] = ((unsigned)(kl_ + 32) < 16u) ? P1[r] + b1_ : (-__builtin_inff()); } \
          SBAR(); } } } } } while (0)
  bool resc = false;
  #define START(P0, P1) do { const float rm = NOMAX ? 0.f : rowmax(P0, P1); resc = false; \
    { const float dl = rm; mhat = fadd_s(mhat, dl); \
      _Pragma("unroll") for (int r = 0; r < 16; ++r) { P0[r] = fsub_s(P0[r], dl); P1[r] = fsub_s(P1[r], dl); } \
      if (!NA) { _Pragma("unroll") for (int r = 0; r < 16; ++r) negm[r] = -mhat; asm volatile("" : "+v"(negm)); } } \
    _Pragma("unroll") for (int r = 0; r < 16; ++r) P0[r] = __builtin_amdgcn_exp2f(P0[r]); } while (0)
  #define RESC() do { if (resc) { asm volatile("s_waitcnt lgkmcnt(0)" ::: "memory"); \
      _Pragma("unroll") for (int d_ = 0; d_ < 2; ++d_) _Pragma("unroll") for (int r = 0; r < 16; ++r) o[d_][r] *= wsf[crow(r, hi)]; } } while (0)
  f32x16 pA0, pA1, pB0, pB1;
  int sl_prev = 0, sl_cur = 0, sl_next = SLOTB;
  #define ROT() do { sl_prev = sl_cur; sl_cur = sl_next; sl_next = (sl_next == (NSLOT - 1) * SLOTB) ? 0 : sl_next + SLOTB; } while (0)
  DMA_K(2, 2 * SLOTB);
  WAIT_BAR(3);
  qkt(pA0, pA1, Kbase, qr, NEGM, r32, hi); asm volatile("s_nop 15\n\ts_nop 7" : "+v"(pA0), "+v"(pA1));
  START(pA0, pA1);
  _Pragma("unroll") for (int r = 0; r < 16; ++r) pA1[r] = __builtin_amdgcn_exp2f(pA1[r]);
  WAIT_BAR(0);
  DMA_K(3, 0); DMA_V(1, SLOTB);
  ROT();
  kload8(kf, kp0 + sl_cur);
  WAIT_BAR(2);
  s16x4 vlo[8], vhi[8]; u32x4 pw0, pw1, pw2, pw3;
  #define PKW(P, B) cvtpk_s(P[B], P[B + 1])
  #define PAF(k) __builtin_bit_cast(bf16x8, pw##k)
  #define VFR(i) (bf16x8){vlo[i][0], vlo[i][1], vlo[i][2], vlo[i][3], vhi[i][0], vhi[i][1], vhi[i][2], vhi[i][3]}
  #define PIN(x) asm volatile("" : "+v"(x))
  #define MX3(a, b, c) __builtin_fmaxf(__builtin_fmaxf((a), (b)), (c))
  #define GAPA(MF, A0, A1, A2, A3, W0, W1, PW) do { MF; sacc2 += (f32x2_t){A0, A1}; sacc2 += (f32x2_t){A2, A3}; PIN(sacc2); W0; W1; PIN(PW); SBAR(); } while (0)
  #define EX(v) __builtin_amdgcn_exp2f(v)
  #define GAPB(MF, X, B) do { MF; X[B] = EX(X[B]); X[B + 1] = EX(X[B + 1]); X[B + 2] = EX(X[B + 2]); X[B + 3] = EX(X[B + 3]); PIN(X); SBAR(); } while (0)
  #define VRD(i) do { vlo[i] = vtr(vp_ + (((i) >> 2) * 4096 + ((i) & 3) * 1024)); vhi[i] = vtr(vp_ + (((i) >> 2) * 4096 + ((i) & 3) * 1024 + 512)); } while (0)
  #define KRD(G, j) do { if (G) { kload2(kf, kp0 + sl_next, j); SBAR(); } } while (0)
  #define STEP(C0, C1, P0, P1, t, GK, GV, GL) do { SBAR(); \
    const lds_cptr vp_ = vp0 + sl_prev; \
    VRD(0); SBAR(); f32x2_t sacc2 = (f32x2_t){P0[0], P0[1]}; \
    GAPA(C0 = __builtin_amdgcn_mfma_f32_32x32x16_bf16(kf[0], qr[0], NEGM, 0, 0, 0), P0[2], P0[3], P0[4], P0[5],     pw0[0] = PKW(P0, 0), pw0[1] = PKW(P0, 2), pw0); \
    VRD(4); SBAR(); GAPA(C1 = __builtin_amdgcn_mfma_f32_32x32x16_bf16(kf[1], qr[0], NEGM, 0, 0, 0), P0[6], P0[7], P0[8], P0[9],     pw0[2] = PKW(P0, 4), pw0[3] = PKW(P0, 6), pw0); \
    VRD(1); SBAR(); GAPA(C0 = __builtin_amdgcn_mfma_f32_32x32x16_bf16(kf[2], qr[1], C0, 0, 0, 0),   P0[10], P0[11], P0[12], P0[13], pw1[0] = PKW(P0, 8), pw1[1] = PKW(P0, 10), pw1); \
    VRD(5); SBAR(); GAPA(C1 = __builtin_amdgcn_mfma_f32_32x32x16_bf16(kf[3], qr[1], C1, 0, 0, 0),   P0[14], P0[15], P1[0], P1[1],   pw1[2] = PKW(P0, 12), pw1[3] = PKW(P0, 14), pw1); \
    VRD(2); SBAR(); GAPA(C0 = __builtin_amdgcn_mfma_f32_32x32x16_bf16(kf[4], qr[2], C0, 0, 0, 0),   P1[2], P1[3], P1[4], P1[5],     pw2[0] = PKW(P1, 0), pw2[1] = PKW(P1, 2), pw2); \
    VRD(6); SBAR(); GAPA(C1 = __builtin_amdgcn_mfma_f32_32x32x16_bf16(kf[5], qr[2], C1, 0, 0, 0),   P1[6], P1[7], P1[8], P1[9],     pw2[2] = PKW(P1, 4), pw2[3] = PKW(P1, 6), pw2); \
    VRD(3); SBAR(); GAPA(C0 = __builtin_amdgcn_mfma_f32_32x32x16_bf16(kf[6], qr[3], C0, 0, 0, 0),   P1[10], P1[11], P1[12], P1[13], pw3[0] = PKW(P1, 8), pw3[1] = PKW(P1, 10), pw3); \
    VRD(7); SBAR(); GAPA(C1 = __builtin_amdgcn_mfma_f32_32x32x16_bf16(kf[7], qr[3], C1, 0, 0, 0),   P1[14], P1[15], 0.f, 0.f,       pw3[2] = PKW(P1, 12), pw3[3] = PKW(P1, 14), pw3); \
    l_reg += sacc2.x + sacc2.y; \
    if (GK) { DMA_K((t) + 3, sl_cur); } if (GV) { DMA_V((t) + 1, sl_next); } \
    resc = false; \
    if (NA) { _Pragma("unroll") for (int r = 0; r < 16; ++r) { C0[r] -= mhat; C1[r] -= mhat; } } \
    CMASK(C0, C1, t); \
    if (!NOMAX) { float a = MX3(C0[0], C0[1], C1[0]), b = MX3(C0[2], C0[3], C1[1]); a = MX3(a, C1[2], C1[3]); \
      _Pragma("unroll") for (int r = 4; r < 16; r += 4) { a = MX3(a, C0[r], C0[r + 1]); b = MX3(b, C0[r + 2], C0[r + 3]); a = MX3(a, C1[r], C1[r + 1]); b = MX3(b, C1[r + 2], C1[r + 3]); } \
      float rm = __builtin_fmaxf(a, b); { auto rr = __builtin_amdgcn_permlane32_swap(__float_as_uint(rm), __float_as_uint(rm), false, false); rm = __builtin_fmaxf(__uint_as_float(rr[0]), __uint_as_float(rr[1])); } \
      if (__builtin_expect(__any(rm > (float)THRL), 0)) { const float dl = __builtin_fmaxf(rm, 0.f); mhat += dl; \
        _Pragma("unroll") for (int r = 0; r < 16; ++r) { C0[r] -= dl; C1[r] -= dl; } \
        if (!NA) { _Pragma("unroll") for (int r = 0; r < 16; ++r) negm[r] = -mhat; asm volatile("" : "+v"(negm)); } \
        const float f = __builtin_amdgcn_exp2f(-dl); l_reg *= f; if (hi == 0) wsf[r32] = f; resc = true; } } \
    SBAR(); \
    GAPB(o[0] = __builtin_amdgcn_mfma_f32_32x32x16_bf16(PAF(0), VFR(0), o[0], 0, 0, 0), C0, 0); \
    GAPB(o[1] = __builtin_amdgcn_mfma_f32_32x32x16_bf16(PAF(0), VFR(4), o[1], 0, 0, 0), C0, 4); \
    KRD(GL, 0); GAPB(o[0] = __builtin_amdgcn_mfma_f32_32x32x16_bf16(PAF(1), VFR(1), o[0], 0, 0, 0), C0, 8); \
    KRD(GL, 1); GAPB(o[1] = __builtin_amdgcn_mfma_f32_32x32x16_bf16(PAF(1), VFR(5), o[1], 0, 0, 0), C0, 12); \
    KRD(GL, 2); GAPB(o[0] = __builtin_amdgcn_mfma_f32_32x32x16_bf16(PAF(2), VFR(2), o[0], 0, 0, 0), C1, 0); \
    KRD(GL, 3); GAPB(o[1] = __builtin_amdgcn_mfma_f32_32x32x16_bf16(PAF(2), VFR(6), o[1], 0, 0, 0), C1, 4); \
    GAPB(o[0] = __builtin_amdgcn_mfma_f32_32x32x16_bf16(PAF(3), VFR(3), o[0], 0, 0, 0), C1, 8); \
    GAPB(o[1] = __builtin_amdgcn_mfma_f32_32x32x16_bf16(PAF(3), VFR(7), o[1], 0, 0, 0), C1, 12); \
    } while (0)
  int t = 1;
  for (; t + 5 < NT; t += 2) {
    STEP(pB0, pB1, pA0, pA1, t, true, true, true);     WAIT_BAR(2); RESC(); ROT();
    STEP(pA0, pA1, pB0, pB1, t + 1, true, true, true); WAIT_BAR(2); RESC(); ROT();
  }
  #define ENDW(tt) do { if ((tt) + 3 < NT) { WAIT_BAR(2); } else if ((tt) + 2 < NT) { WAIT_BAR(1); } else { WAIT_BAR(0); } } while (0)
  for (; t + 1 < NT; t += 2) {
    STEP(pB0, pB1, pA0, pA1, t, (t + 3 < NT), (t + 1 < NT), (t + 1 < NT));         ENDW(t);     RESC(); ROT();
    STEP(pA0, pA1, pB0, pB1, t + 1, (t + 4 < NT), (t + 2 < NT), (t + 2 < NT));     ENDW(t + 1); RESC(); ROT();
  }
  STEP(pB0, pB1, pA0, pA1, NT - 1, false, false, false); RESC();
  { float sacc = pB0[0] + pB0[1]; _Pragma("unroll") for (int r = 2; r < 16; ++r) sacc += pB0[r]; _Pragma("unroll") for (int r = 0; r < 16; ++r) sacc += pB1[r]; l_reg += sacc;
    pw0 = (u32x4){PKW(pB0, 0), PKW(pB0, 2), PKW(pB0, 4), PKW(pB0, 6)}; pw1 = (u32x4){PKW(pB0, 8), PKW(pB0, 10), PKW(pB0, 12), PKW(pB0, 14)}; pw2 = (u32x4){PKW(pB1, 0), PKW(pB1, 2), PKW(pB1, 4), PKW(pB1, 6)}; pw3 = (u32x4){PKW(pB1, 8), PKW(pB1, 10), PKW(pB1, 12), PKW(pB1, 14)};
    SBAR(); pv(o, vb0 + sl_cur, PAF(0), PAF(1), PAF(2), PAF(3)); }
  #undef PKW
  #undef PAF
  #undef VFR
  #undef PIN
  #undef MX3
  #undef GAPA
  #undef GAPB
  #undef EX
  #undef VRD
  #undef KRD
  #undef STEP
  #undef ENDW
  { auto rr = __builtin_amdgcn_permlane32_swap(__float_as_uint(l_reg), __float_as_uint(l_reg), false, false); l_reg = __uint_as_float(rr[0]) + __uint_as_float(rr[1]); }
  if (hi == 0) wsf[32 + r32] = l_reg; asm volatile("s_waitcnt lgkmcnt(0)" ::: "memory");
  float rli[16];
  #pragma unroll
  for (int r = 0; r < 16; ++r) rli[r] = __builtin_amdgcn_rcpf(wsf[32 + crow(r, hi)]);
  bf16* Ow = Ou + (long)(wid * QBLK) * op;
  { bf16* stg = (bf16*)(shm + LDS_OST) + wid * 2048;
    #pragma unroll
    for (int r = 0; r < 16; ++r) { const int orow = crow(r, hi);
      #pragma unroll
      for (int d0 = 0; d0 < 2; ++d0) stg[orow * 64 + d0 * 32 + r32] = (bf16)f2bf(o[d0][r] * rli[r]); }
    asm volatile("s_waitcnt lgkmcnt(0)" ::: "memory");
    #pragma unroll
    for (int i = 0; i < 4; ++i) { const int row = i * 8 + (lane >> 3), ch = lane & 7; const u32x4 v = *(const u32x4*)(stg + row * 64 + ch * 8); ATTN_STORE16(Ow + (long)row * op + ch * 8, v); } }
  asm volatile("s_waitcnt lgkmcnt(0)\n\ts_barrier" ::: "memory");
  #undef NEGM
  #undef DMA_K
  #undef DMA_V
  #undef TROW
  #undef CMASK
  #undef START
  #undef RESC
  #undef ROT
}
#undef SBAR
#undef WAIT_BAR
}
#ifndef FP8_MOE
#define FP8_MOE 1
#endif
struct Args { const float* in[29]; float* out; unsigned char* ws; int ph_lo, ph_hi; };
enum { I_X = 0, I_C, I_CTX, I_CCTX, I_WMOD, I_BMOD, I_N1G, I_N2G, I_WIN, I_LRE, I_LIM, I_LDT, I_BRE, I_BIM, I_CRE, I_CIM, I_SSMD, I_WGLU, I_QNG, I_KNG, I_RPB, I_WBR, I_WOUT, I_RW, I_RB, I_MG, I_MU, I_MD, I_FNG };

typedef const float* CFP;
struct Ctx {
    const __attribute__((address_space(4))) CFP* in; float* out; unsigned char* ws; LAS unsigned char* lds; gu32* ctl;
    int tid, lane, wave, vcu, G;
};
#define WSP(T_, off) ((T_*)(C.ws + (off)))

__device__ __forceinline__ float* xs_row(const Ctx& C, int m) { const int b = m / LB, j = m - b * LB; return j < CTX ? WSP(float, WS_CTXS) + (size_t)(b * CTX + j) * D : C.out + (size_t)(b * SEQ + j - CTX) * D; }
__device__ __forceinline__ const float* in_row(const Ctx& C, int m) { const int b = m / LB, j = m - b * LB; return j < CTX ? C.in[I_CTX] + (size_t)(b * CTX + j) * D : C.in[I_X] + (size_t)(b * SEQ + j - CTX) * D; }
__device__ __forceinline__ int cond_of(int m) { const int b = m / LB, j = m - b * LB; return j < CTX ? 4 : b; }

__device__ __forceinline__ void transpose_item(const float* W, int N, int Kp, bf16* WT, int k0, int n0, int drow0, LAS float* scr, int lane) {
    const float* src = W + (size_t)k0 * N + n0 + lane;
    float tv[64];
#pragma unroll
    for (int i = 0; i < 64; ++i) tv[i] = src[(size_t)i * N];
#pragma unroll
    for (int i = 0; i < 64; ++i) scr[i * 65 + lane] = tv[i];
    LDS_WAIT(); asm volatile("" ::: "memory");
    const int c = lane & 7;
#pragma unroll
    for (int j = 0; j < 8; ++j) { const int n = (lane >> 3) + 8 * j; const LAS float* s = scr + (8 * c) * 65 + n;
        v4u o; o.x = pk2(s[0 * 65], s[1 * 65]); o.y = pk2(s[2 * 65], s[3 * 65]); o.z = pk2(s[4 * 65], s[5 * 65]); o.w = pk2(s[6 * 65], s[7 * 65]);
        *(GAS v4u*)(WT + (size_t)(drow0 + n) * Kp + k0 + 8 * c) = o; }
    LDS_WAIT(); asm volatile("" ::: "memory");
}
__device__ __forceinline__ void transpose_item8(const float* W, int N, int Kp, unsigned char* WT, int k0, int n0, int drow0, float scale, LAS float* scr, int lane) {
    const float* src = W + (size_t)k0 * N + n0 + lane;
    float tv[64];
#pragma unroll
    for (int i = 0; i < 64; ++i) tv[i] = src[(size_t)i * N];
#pragma unroll
    for (int i = 0; i < 64; ++i) scr[i * 65 + lane] = tv[i] * scale;
    LDS_WAIT(); asm volatile("" ::: "memory");
    const int c = lane & 3;
#pragma unroll
    for (int j = 0; j < 4; ++j) { const int n = (lane >> 2) + 16 * j; const LAS float* s = scr + (16 * c) * 65 + n;
        v4u o; o.x = pk4_fp8(s[0 * 65], s[1 * 65], s[2 * 65], s[3 * 65]); o.y = pk4_fp8(s[4 * 65], s[5 * 65], s[6 * 65], s[7 * 65]); o.z = pk4_fp8(s[8 * 65], s[9 * 65], s[10 * 65], s[11 * 65]); o.w = pk4_fp8(s[12 * 65], s[13 * 65], s[14 * 65], s[15 * 65]);
        *(GAS v4u*)(WT + (size_t)(drow0 + n) * Kp + k0 + 16 * c) = o; }
    LDS_WAIT(); asm volatile("" ::: "memory");
}
__device__ __forceinline__ void phase_weights(const Ctx& C, int l) {
    LAS float* scr = (LAS float*)(C.lds + C.wave * 16640);
    const int gw = C.vcu * NWAVES + C.wave, NGW = C.G * NWAVES;
    constexpr int I0 = 16 * 92, I1 = 8 * 8, I2 = 3 * 8 * 16, I3 = 16 * 16, I4 = 16 * 16 * 8, I5 = I4, I6 = 16 * 8 * 16;
    for (int it = gw; it < I0 + I1 + I2 + I3 + I4 + I5 + I6; it += NGW) {
        int r = it;
        if (r < I0) { const int kb = r / 92, nb = r % 92; if (W8_ALL) transpose_item8(C.in[I_WIN] + (size_t)l * 1024 * INW, INW, 1024, WSP(unsigned char, WS_WIN), 64 * kb, 64 * nb, 64 * nb, 64.f, scr, C.lane);
            else if (nb < 44 || GATE_BF16) transpose_item(C.in[I_WIN] + (size_t)l * 1024 * INW, INW, 1024, WSP(bf16, WS_WIN), 64 * kb, 64 * nb, 64 * nb, scr, C.lane);
            else transpose_item8(C.in[I_WIN] + (size_t)l * 1024 * INW, INW, 1024, WSP(unsigned char, WS_WIN8), 64 * kb, 64 * nb, 64 * nb - 2816, 64.f, scr, C.lane); continue; } r -= I0;
        if (r < I1) { const int kb = r / 8, nb = r % 8; transpose_item(C.in[I_WGLU] + (size_t)l * 512 * 512, 512, 512, WSP(bf16, WS_WGLU), 64 * kb, 64 * nb, 64 * nb, scr, C.lane); continue; } r -= I1;
        if (r < I2) { const int i = r / 128, q = r % 128, kb = q / 16, nb = q % 16; transpose_item(C.in[I_WBR] + (size_t)(l * 3 + i) * 512 * 1024, 1024, 512, WSP(bf16, WS_WBR) + (size_t)i * 1024 * 512, 64 * kb, 64 * nb, 64 * nb, scr, C.lane); continue; } r -= I2;
        if (r < I3) { const int kb = r / 16, nb = r % 16; transpose_item(C.in[I_WOUT] + (size_t)l * 1024 * 1024, 1024, 1024, WSP(bf16, WS_WOUT), 64 * kb, 64 * nb, 64 * nb, scr, C.lane); continue; } r -= I3;
        if (r < I4 + I5) { const int up = r >= I4; if (up) r -= I4; const int e = r / 128, q = r % 128, kb = q / 8, nb = q % 8, n0 = 64 * nb;
            if (FP8_MOE) transpose_item8((up ? C.in[I_MU] : C.in[I_MG]) + (size_t)(l * 16 + e) * 1024 * 512, 512, 1024, WSP(unsigned char, WS_MOE1) + (size_t)e * 1024 * 1024, 64 * kb, n0, (n0 / 128) * 256 + (n0 % 128) + (up ? 128 : 0), 64.f, scr, C.lane);
            else transpose_item((up ? C.in[I_MU] : C.in[I_MG]) + (size_t)(l * 16 + e) * 1024 * 512, 512, 1024, WSP(bf16, WS_MOE1) + (size_t)e * 1024 * 1024, 64 * kb, n0, (n0 / 128) * 256 + (n0 % 128) + (up ? 128 : 0), scr, C.lane); continue; } r -= I4 + I5;
        { const int e = r / 128, q = r % 128, kb = q / 16, nb = q % 16; if (FP8_MOE) transpose_item8(C.in[I_MD] + (size_t)(l * 16 + e) * 512 * 1024, 1024, 512, WSP(unsigned char, WS_MOE2) + (size_t)e * 1024 * 512, 64 * kb, 64 * nb, 64 * nb, 32.f, scr, C.lane);
            else transpose_item(C.in[I_MD] + (size_t)(l * 16 + e) * 512 * 1024, 1024, 512, WSP(bf16, WS_MOE2) + (size_t)e * 1024 * 512, 64 * kb, 64 * nb, 64 * nb, scr, C.lane); }
    }
}

__device__ __forceinline__ void phase_mod(const Ctx& C) {
    LAS float* sc = (LAS float*)(C.lds);
    LAS float* red = (LAS float*)(C.lds + 20480);
    for (int i = C.tid; i < 5 * 1024; i += 512) { const int c = i >> 10, k = i & 1023; const float v = c < 4 ? C.in[I_C][c * 1024 + k] : C.in[I_CCTX][k]; sc[i] = v * fsigmoid(v); }
    __syncthreads();
    for (int it = C.vcu; it < NLAYER * 96; it += C.G) {
        const int l = it / 96, col = (it % 96) * 64 + C.lane, k0 = C.wave * 128;
        const float* W = C.in[I_WMOD] + (size_t)l * 1024 * 6144 + (size_t)k0 * 6144 + col;
        float a0 = 0.f, a1 = 0.f, a2 = 0.f, a3 = 0.f, a4 = 0.f;
#pragma unroll 16
        for (int k = 0; k < 128; ++k) { const float w = W[(size_t)k * 6144]; a0 += sc[k0 + k] * w; a1 += sc[1024 + k0 + k] * w; a2 += sc[2048 + k0 + k] * w; a3 += sc[3072 + k0 + k] * w; a4 += sc[4096 + k0 + k] * w; }
        LAS float* r = red + C.wave * 320 + C.lane; r[0] = a0; r[64] = a1; r[128] = a2; r[192] = a3; r[256] = a4;
        __syncthreads();
        if (C.tid < 320) { const int c = C.tid >> 6; float s = C.in[I_BMOD][l * 6144 + col];
#pragma unroll
            for (int w = 0; w < 8; ++w) s += red[w * 320 + C.tid];
            WSP(float, WS_MOD)[(size_t)(l * 5 + c) * 6144 + col] = s; }
        __syncthreads();
    }
}

__device__ __forceinline__ void phase_s5mats(const Ctx& C, int l) {
    if (C.vcu >= 128) return;
    const int g = C.vcu >> 2, part = C.vcu & 3, tid = C.tid;
    LAS f32x2* POW = (LAS f32x2*)(C.lds);
    LAS f32x2* CC = (LAS f32x2*)(C.lds + 33792);
    LAS f32x2* BB = (LAS f32x2*)(C.lds + 50176);
    LAS f32x2* COEF = (LAS f32x2*)(C.lds + 66560);
    LAS bf16* KT = (LAS bf16*)(C.lds + 67584);
    LAS float* WT = (LAS float*)(C.lds + 101376);
    __syncthreads();
    if (tid < 128) {
        const int d = tid >> 6, p = tid & 63; const int li = ((l * 2 + d) * 32 + g) * 64 + p;
        const float re = C.in[I_LRE][li], im = C.in[I_LIM][li], dt = __expf(C.in[I_LDT][(l * 2 + d) * 32 + g]);
        for (int tau = 0; tau <= 32; ++tau) { const float mag = __expf(re * dt * (float)tau), rev = im * dt * (float)tau * 0.15915494309189535f;
            const float wr = mag * cos_rev(rev), wi = mag * sin_rev(rev);
            POW[(d * 33 + tau) * 64 + p] = (f32x2){wr, wi}; if (tau < 32) { WT[((d * 64 + p) * 2) * 32 + tau] = wr; WT[((d * 64 + p) * 2 + 1) * 32 + tau] = wi; } }
        const float mag = __expf(re * dt), rev = im * dt * 0.15915494309189535f; const float lr = mag * cos_rev(rev) - 1.f, lim = mag * sin_rev(rev);
        const float den = 1.f / (re * re + im * im);
        COEF[tid] = (f32x2){(lr * re + lim * im) * den, (lim * re - lr * im) * den};
    }
    __syncthreads();
    for (int i = tid; i < 2048; i += 512) {
        const int d = i >> 10, p = (i >> 4) & 63, h = i & 15; const size_t bi = (((size_t)(l * 2 + d) * 32 + g) * 64 + p) * 16 + h;
        const float br = C.in[I_BRE][bi], bi_ = C.in[I_BIM][bi]; const f32x2 cf = COEF[d * 64 + p];
        BB[i] = (f32x2){cf.x * br - cf.y * bi_, cf.x * bi_ + cf.y * br};
        const int h2 = (i >> 6) & 15, p2 = i & 63; const size_t ci = (((size_t)(l * 2 + d) * 32 + g) * 16 + h2) * 64 + p2;
        CC[i] = (f32x2){C.in[I_CRE][ci], C.in[I_CIM][ci]};
    }
    __syncthreads();
    {
        const int wv = tid >> 6, ln = tid & 63, hi = ln >> 5, i = ln & 31, h = 2 * wv + (i >> 4), hp = i & 15;
        f32x16 a0 = f32x16{}, a1 = f32x16{};
#pragma unroll 4
        for (int p = 0; p < 64; ++p) {
            const f32x2 c0 = CC[h * 64 + p], b0 = BB[p * 16 + hp], c1 = CC[1024 + h * 64 + p], b1 = BB[1024 + p * 16 + hp];
            const float x0 = hi == 0 ? (c0.x * b0.x - c0.y * b0.y) : -(c0.x * b0.y + c0.y * b0.x);
            const float x1 = hi == 0 ? (c1.x * b1.x - c1.y * b1.y) : -(c1.x * b1.y + c1.y * b1.x);
            a0 = __builtin_amdgcn_mfma_f32_32x32x2f32(x0, WT[(p * 2 + hi) * 32 + i], a0, 0, 0, 0);
            a1 = __builtin_amdgcn_mfma_f32_32x32x2f32(x1, WT[((64 + p) * 2 + hi) * 32 + i], a1, 0, 0, 0);
        }
        const float* sd = C.in[I_SSMD] + l * 512 + g * 16;
#pragma unroll
        for (int r = 0; r < 16; ++r) { const int rl = (r & 3) + 8 * (r >> 2) + 4 * hi, hh = 2 * wv + (rl >> 4), hq = rl & 15;
            float f = a0[r]; if (i == 0) f += a1[r] + (hh == hq ? sd[hh] : 0.f);
            KT[((31 + i) * 16 + hh) * 16 + hq] = (bf16)f2bf(f);
            if (i > 0) KT[((31 - i) * 16 + hh) * 16 + hq] = (bf16)f2bf(a1[r]); }
    }
    __syncthreads();
    bf16* B1 = WSP(bf16, WS_BT1) + (size_t)g * 768 * 512; bf16* B2 = WSP(bf16, WS_BT2) + (size_t)g * 512 * 256;
    for (int i = tid; i < 128 * 64; i += 512) {
        const int n = part * 128 + (i >> 6), ch = i & 63, t = n >> 4, h = n & 15, s = ch >> 1, hp0 = (ch & 1) * 8;
        *(GAS v4u*)(B1 + (size_t)n * 512 + ch * 8) = *(const LAS v4u*)(KT + ((t - s + 31) * 16 + h) * 16 + hp0);
    }
    for (int i = tid; i < 64 * 64; i += 512) {
        const int nn = part * 64 + (i >> 6), ch = i & 63, d = nn >> 7, p = (nn & 127) >> 1, ri = nn & 1, s = ch >> 1, hp0 = (ch & 1) * 8;
        const f32x2 w = POW[(d * 33 + (d == 0 ? 31 - s : s)) * 64 + p]; float v[8];
#pragma unroll
        for (int j = 0; j < 8; ++j) { const f32x2 b = BB[d * 1024 + p * 16 + hp0 + j]; v[j] = ri == 0 ? (w.x * b.x - w.y * b.y) : (w.x * b.y + w.y * b.x); }
        v4u o; o.x = pk2(v[0], v[1]); o.y = pk2(v[2], v[3]); o.z = pk2(v[4], v[5]); o.w = pk2(v[6], v[7]);
        *(GAS v4u*)(B1 + (size_t)(512 + nn) * 512 + ch * 8) = o;
    }
    for (int i = tid; i < 128 * 32; i += 512) {
        const int n = part * 128 + (i >> 5), ch = i & 31, t = n >> 4, h = n & 15, d = ch >> 4, p0 = (ch & 15) * 4; float v[8];
#pragma unroll
        for (int j = 0; j < 4; ++j) { const f32x2 c = CC[d * 1024 + h * 64 + p0 + j], w = POW[(d * 33 + (d == 0 ? t + 1 : 32 - t)) * 64 + p0 + j];
            v[2 * j] = c.x * w.x - c.y * w.y; v[2 * j + 1] = -(c.x * w.y + c.y * w.x); }
        v4u o; o.x = pk2(v[0], v[1]); o.y = pk2(v[2], v[3]); o.z = pk2(v[4], v[5]); o.w = pk2(v[6], v[7]);
        *(GAS v4u*)(B2 + (size_t)n * 256 + ch * 8) = o;
    }
    __syncthreads();
}

template <int MODE>
__device__ __forceinline__ void phase_rows(const Ctx& C, int l) {
    const int gw = C.vcu * NWAVES + C.wave, NGW = C.G * NWAVES, lane = C.lane;
    const float* MODl = WSP(float, WS_MOD) + (size_t)(MODE == 2 ? 0 : l) * 5 * 6144;
    const float* MODp = WSP(float, WS_MOD) + (size_t)(l > 0 ? l - 1 : 0) * 5 * 6144;
    const bf16* YS = WSP(bf16, WS_YSLOT);
    f32x4 nx[4]; v2u na[4], nc[4];
#define ROWS_LOAD(mm) do { const int m_ = (mm); \
        if (MODE == 0) { const GAS f32x4* xr = (const GAS f32x4*)in_row(C, m_) + lane; _Pragma("unroll") for (int q = 0; q < 4; ++q) nx[q] = xr[64 * q]; } \
        else { const GAS f32x4* xr = (const GAS f32x4*)xs_row(C, m_) + lane; const GAS v2u* y0 = (const GAS v2u*)(YS + (size_t)(2 * m_) * D) + lane; const GAS v2u* y1 = (const GAS v2u*)(YS + (size_t)(2 * m_ + 1) * D) + lane; \
            _Pragma("unroll") for (int q = 0; q < 4; ++q) { nx[q] = xr[64 * q]; na[q] = y0[64 * q]; nc[q] = y1[64 * q]; } } } while (0)
    int m = gw; if (MODE == 2) { while (m < T && (m % LB) < CTX) m += NGW; }
    if (m < T) ROWS_LOAD(m);
    while (m < T) {
        const int b = m / LB, j = m - b * LB, cond = j < CTX ? 4 : b;
        f32x4 v[4];
        if (MODE == 0) {
#pragma unroll
            for (int q = 0; q < 4; ++q) v[q] = nx[q]; }
        else { const GAS f32x4* g2 = (const GAS f32x4*)(MODp + cond * 6144 + 5 * 1024) + lane;
#pragma unroll
            for (int q = 0; q < 4; ++q) { const f32x4 g = g2[64 * q]; const v2u a = na[q], c = nc[q];
                v[q] = nx[q] + g * (f32x4){bflo(a.x) + bflo(c.x), bfhi(a.x) + bfhi(c.x), bflo(a.y) + bflo(c.y), bfhi(a.y) + bfhi(c.y)}; } }
        int mn = m + NGW; if (MODE == 2) { while (mn < T && (mn % LB) < CTX) mn += NGW; }
        if (mn < T) ROWS_LOAD(mn);
        float ss = 0.f;
#pragma unroll
        for (int q = 0; q < 4; ++q) ss += (v[q].x * v[q].x + v[q].y * v[q].y) + (v[q].z * v[q].z + v[q].w * v[q].w);
        const float rstd = 1.f / sqrtf(wave_sum(ss, lane) * (1.f / D) + EPS);
        if (MODE == 2) { GAS f32x4* o = (GAS f32x4*)(C.out + (size_t)(b * SEQ + j - CTX) * D) + lane; const GAS f32x4* fg = (const GAS f32x4*)C.in[I_FNG] + lane;
#pragma unroll
            for (int q = 0; q < 4; ++q) o[64 * q] = v[q] * rstd * fg[64 * q]; }
        else { GAS f32x4* xo = (GAS f32x4*)xs_row(C, m) + lane; GAS v2u* ho = (GAS v2u*)(WSP(bf16, WS_HB) + (size_t)m * D) + lane; GAS unsigned* h8 = (GAS unsigned*)(WSP(unsigned char, WS_HB8) + (size_t)m * D) + lane;
            const GAS f32x4* ng = (const GAS f32x4*)(C.in[I_N1G] + l * D) + lane; const GAS f32x4* sh = (const GAS f32x4*)(MODl + cond * 6144) + lane; const GAS f32x4* sc = (const GAS f32x4*)(MODl + cond * 6144 + 1024) + lane;
#pragma unroll
            for (int q = 0; q < 4; ++q) { xo[64 * q] = v[q]; const f32x4 h = v[q] * rstd * ng[64 * q] * (sc[64 * q] + 1.f) + sh[64 * q]; if (!W8_ALL) ho[64 * q] = (v2u){pk2(h.x, h.y), pk2(h.z, h.w)}; if (H8_WRITE) h8[64 * q] = pk4_fp8(h.x, h.y, h.z, h.w); } }
        m = mn;
    }
#undef ROWS_LOAD
}

__device__ __forceinline__ void phase_qkprep(const Ctx& C, int l) {
    const int gw = C.vcu * NWAVES + C.wave, NGW = C.G * NWAVES, lane = C.lane, s8 = lane & 7;
    const float* qg = C.in[I_QNG] + l * 64 + 8 * s8; const float* kg = C.in[I_KNG] + l * 64 + 8 * s8;
    float gq[8], gk[8];
#pragma unroll
    for (int i = 0; i < 8; ++i) { gq[i] = qg[i]; gk[i] = kg[i]; }
    const int ax = s8 >> 2, f0 = 8 * (s8 & 1);
    float inv[8];
#pragma unroll
    for (int i = 0; i < 8; ++i) inv[i] = exp2f(-(float)(f0 + i) * 0.8304820237218406f) * 0.15915494309189535f;
    const int kl = lane & 15;
    v4u wq, wk;
    if (gw < T) { wq = *((const GAS v4u*)(WSP(bf16, WS_QA) + (size_t)gw * 512) + lane); wk = *((const GAS v4u*)(WSP(bf16, WS_KA) + (size_t)gw * 128) + kl); }
    for (int m = gw; m < T; m += NGW) {
        const int b = m / LB, j = m - b * LB; const bool lat = j >= CTX; const int tt = j - CTX; const float pos = (float)(ax == 0 ? (tt >> 6) : (tt & 63));
        const v4u cq = wq, ck = wk;
        if (m + NGW < T) { wq = *((const GAS v4u*)(WSP(bf16, WS_QA) + (size_t)(m + NGW) * 512) + lane); wk = *((const GAS v4u*)(WSP(bf16, WS_KA) + (size_t)(m + NGW) * 128) + kl); }
        float cs[8], sn[8];
#pragma unroll
        for (int i = 0; i < 8; ++i) { cs[i] = lat ? cos_rev(pos * inv[i]) : 1.f; sn[i] = lat ? sin_rev(pos * inv[i]) : 0.f; }
#pragma unroll
        for (int which = 0; which < 2; ++which) {
            const v4u w = which == 0 ? cq : ck; float x[8] = {bflo(w.x), bfhi(w.x), bflo(w.y), bfhi(w.y), bflo(w.z), bfhi(w.z), bflo(w.w), bfhi(w.w)};
            float ss = 0.f;
#pragma unroll
            for (int i = 0; i < 8; ++i) ss += x[i] * x[i];
            ss += dpp_mov<0xB1, 0xF>(ss); ss += dpp_mov<0x4E, 0xF>(ss); ss += dpp_mov<0x141, 0xF>(ss);
            const float rstd = 1.f / sqrtf(ss * (1.f / 64.f) + EPS);
            float y[8];
#pragma unroll
            for (int i = 0; i < 8; ++i) { const float xn = x[i] * rstd * (which == 0 ? gq[i] : gk[i]); const float other = dpp_mov<0x4E, 0xF>(xn);
                y[i] = (s8 & 2) ? (xn * cs[i] + other * sn[i]) : (xn * cs[i] - other * sn[i]); }
            const float sc = which == 0 ? C2 : 1.f;
            v4u o; o.x = pk2(y[0] * sc, y[1] * sc); o.y = pk2(y[2] * sc, y[3] * sc); o.z = pk2(y[4] * sc, y[5] * sc); o.w = pk2(y[6] * sc, y[7] * sc);
            if (which == 0) *((GAS v4u*)(WSP(bf16, WS_QA) + (size_t)m * 512) + lane) = o;
            else if (lane < 16) *((GAS v4u*)(WSP(bf16, WS_KA) + (size_t)m * 128) + lane) = o;
        }
    }
}

__device__ __forceinline__ void phase_carry(const Ctx& C, int l) {
    if (C.vcu >= 32) return;
    const int b = C.vcu >> 3, g = (C.vcu & 7) * 4 + (C.wave >> 1), d = C.wave & 1, p = C.lane;
    const int li = ((l * 2 + d) * 32 + g) * 64 + p;
    const float re = C.in[I_LRE][li], im = C.in[I_LIM][li], dt = __expf(C.in[I_LDT][(l * 2 + d) * 32 + g]);
    const float mag = __expf(re * dt * 32.f), rev = im * dt * 32.f * 0.15915494309189535f; const float Lr = mag * cos_rev(rev), Li = mag * sin_rev(rev);
    const GAS f32x2* S = (const GAS f32x2*)(WSP(float, WS_SST) + (size_t)(b * NCH) * 8192 + g * 256 + d * 128) + p;
    GAS unsigned* X = (GAS unsigned*)(WSP(bf16, WS_XST) + (size_t)(b * NCH) * 8192 + g * 256 + d * 128) + p;
    float sr = 0.f, si = 0.f;
    if (d == 0) {
        for (int c0 = 0; c0 < NCH; c0 += 8) { f32x2 s[8];
#pragma unroll
            for (int k = 0; k < 8; ++k) s[k] = S[(size_t)(c0 + k) * 4096];
#pragma unroll
            for (int k = 0; k < 8; ++k) { X[(size_t)(c0 + k) * 4096] = pk2(sr, si); const float nr = Lr * sr - Li * si + s[k].x, ni = Lr * si + Li * sr + s[k].y; sr = nr; si = ni; } }
    } else {
        for (int seg = 0; seg < 33; ++seg) { const int chi = seg == 0 ? 7 : NCH - 1 - (seg - 1) * 8; f32x2 s[8];
#pragma unroll
            for (int k = 0; k < 8; ++k) s[k] = S[(size_t)(chi - k) * 4096];
#pragma unroll
            for (int k = 0; k < 8; ++k) { X[(size_t)(chi - k) * 4096] = pk2(sr, si); const float nr = Lr * sr - Li * si + s[k].x, ni = Lr * si + Li * sr + s[k].y; sr = nr; si = ni; } }
    }
}

__device__ __forceinline__ void phase_norm2(const Ctx& C, int l) {
    LAS float* RWt = (LAS float*)C.lds;
    LAS unsigned* REC = (LAS unsigned*)(C.lds + 65536);
    LAS float* LG = (LAS float*)(C.lds + 65536 + 16384);
    LAS unsigned* LCNT = (LAS unsigned*)(C.lds + 65536 + 32768);
    const int lane = C.lane, tid = C.tid;
    for (int i = tid; i < 16384; i += 512) { const int k = i >> 4, e = i & 15; RWt[e * 1024 + k] = C.in[I_RW][i]; }
    if (tid < 32) LCNT[tid] = 0u;
    __syncthreads();
    const float* MODl = WSP(float, WS_MOD) + (size_t)l * 5 * 6144;
    int nrows = 0; for (int m = C.vcu; m < T; m += C.G) ++nrows;
    f32x4 nx[2][4];
#define N2_LOAD(ii) do { _Pragma("unroll") for (int rr = 0; rr < 2; ++rr) { const int i_ = (ii) + rr * NWAVES; const int m_ = C.vcu + C.G * (i_ < nrows ? i_ : (ii)); const GAS f32x4* xr = (const GAS f32x4*)xs_row(C, m_) + lane; \
        _Pragma("unroll") for (int q = 0; q < 4; ++q) nx[rr][q] = xr[64 * q]; } } while (0)
    if (C.wave < nrows) N2_LOAD(C.wave);
    for (int i = C.wave; i < nrows; i += 2 * NWAVES) {
        const bool has1 = i + NWAVES < nrows;
        f32x4 hv[2][4];
#pragma unroll
        for (int rr = 0; rr < 2; ++rr) { const int ir = (rr && has1) ? i + NWAVES : i; const int m = C.vcu + C.G * ir, cond = cond_of(m);
            GAS unsigned* h8 = (GAS unsigned*)(WSP(unsigned char, WS_HB8) + (size_t)m * D) + lane; GAS v2u* ho = (GAS v2u*)(WSP(bf16, WS_HB) + (size_t)m * D) + lane;
            const GAS f32x4* ng = (const GAS f32x4*)(C.in[I_N2G] + l * D) + lane; const GAS f32x4* sh = (const GAS f32x4*)(MODl + cond * 6144 + 3072) + lane; const GAS f32x4* sc = (const GAS f32x4*)(MODl + cond * 6144 + 4096) + lane;
            float ss = 0.f;
#pragma unroll
            for (int q = 0; q < 4; ++q) { const f32x4 v = nx[rr][q]; ss += (v.x * v.x + v.y * v.y) + (v.z * v.z + v.w * v.w); }
            const float rstd = 1.f / sqrtf(wave_sum(ss, lane) * (1.f / D) + EPS);
#pragma unroll
            for (int q = 0; q < 4; ++q) { const f32x4 h = nx[rr][q] * rstd * ng[64 * q] * (sc[64 * q] + 1.f) + sh[64 * q]; hv[rr][q] = h;
                if (rr == 0 || has1) { if (FP8_MOE) h8[64 * q] = pk4_fp8(h.x, h.y, h.z, h.w); else ho[64 * q] = (v2u){pk2(h.x, h.y), pk2(h.z, h.w)}; } } }
        if (i + 2 * NWAVES < nrows) N2_LOAD(i + 2 * NWAVES);
        float mine0 = 0.f, mine1 = 0.f;
#pragma unroll
        for (int e = 0; e < 16; ++e) { float a0 = 0.f, a1 = 0.f;
#pragma unroll
            for (int q = 0; q < 4; ++q) { const f32x4 w = *(const LAS f32x4*)(RWt + e * 1024 + 256 * q + 4 * lane); const f32x4 h0 = hv[0][q], h1 = hv[1][q];
                a0 += (h0.x * w.x + h0.y * w.y) + (h0.z * w.z + h0.w * w.w); a1 += (h1.x * w.x + h1.y * w.y) + (h1.z * w.z + h1.w * w.w); }
            const float t0 = wave_sum(a0, lane), t1 = wave_sum(a1, lane); mine0 = lane == e ? t0 : mine0; mine1 = lane == e ? t1 : mine1; }
        if (lane < 16) { LG[i * 16 + lane] = mine0; if (has1) LG[(i + NWAVES) * 16 + lane] = mine1; }
    }
#undef N2_LOAD
    __syncthreads();
    float rb[16];
#pragma unroll
    for (int e = 0; e < 16; ++e) rb[e] = C.in[I_RB][e];
    for (int i = tid; i < nrows; i += 512) {
        float lg[16];
#pragma unroll
        for (int q = 0; q < 4; ++q) { const f32x4 t = *(const LAS f32x4*)(LG + i * 16 + 4 * q); lg[4 * q] = t.x; lg[4 * q + 1] = t.y; lg[4 * q + 2] = t.z; lg[4 * q + 3] = t.w; }
        float mx = lg[0];
#pragma unroll
        for (int e = 1; e < 16; ++e) mx = fmaxf(mx, lg[e]);
        float pr[16], sel[16], sum = 0.f;
#pragma unroll
        for (int e = 0; e < 16; ++e) { pr[e] = __expf(lg[e] - mx); sum += pr[e]; }
        const float rs = 1.f / sum;
#pragma unroll
        for (int e = 0; e < 16; ++e) { pr[e] *= rs; sel[e] = pr[e] + rb[e]; }
        float bestv = -1e30f; int best = 0;
#pragma unroll
        for (int gq = 0; gq < 4; ++gq) { float m1 = -1e30f, m2 = -1e30f;
#pragma unroll
            for (int k = 0; k < 4; ++k) { const float s_ = sel[4 * gq + k]; if (s_ > m1) { m2 = m1; m1 = s_; } else if (s_ > m2) m2 = s_; }
            const float gs = m1 + m2; if (gs > bestv) { bestv = gs; best = gq; } }
        float s4[4], p4[4];
#pragma unroll
        for (int k = 0; k < 4; ++k) { s4[k] = best == 0 ? sel[k] : best == 1 ? sel[4 + k] : best == 2 ? sel[8 + k] : sel[12 + k]; p4[k] = best == 0 ? pr[k] : best == 1 ? pr[4 + k] : best == 2 ? pr[8 + k] : pr[12 + k]; }
        int i0 = 0; float v0 = s4[0], q0 = p4[0];
#pragma unroll
        for (int k = 1; k < 4; ++k) if (s4[k] > v0) { v0 = s4[k]; i0 = k; q0 = p4[k]; }
        int i1 = i0 == 0 ? 1 : 0; float v1 = -1e30f, q1 = p4[i0 == 0 ? 1 : 0];
#pragma unroll
        for (int k = 0; k < 4; ++k) if (k != i0 && s4[k] > v1) { v1 = s4[k]; i1 = k; q1 = p4[k]; }
        const int e0 = 4 * best + i0, e1 = 4 * best + i1; const float wn = 1.f / (q0 + q1);
        const unsigned lp0 = atomicAdd((unsigned*)(LCNT + e0), 1u), lp1 = atomicAdd((unsigned*)(LCNT + e1), 1u);
        REC[i * 4 + 0] = (unsigned)e0 | ((unsigned)e1 << 8) | (lp0 << 16); REC[i * 4 + 1] = lp1; REC[i * 4 + 2] = __float_as_uint(q0 * wn); REC[i * 4 + 3] = __float_as_uint(q1 * wn);
    }
    __syncthreads();
    if (tid < 16) LCNT[16 + tid] = __hip_atomic_fetch_add((unsigned*)(C.ctl + CW_CNT + l * 1024 + 64 * tid), LCNT[tid], RLX_AGENT);
    __syncthreads();
    int* LIST = WSP(int, WS_LIST); float* RWG = WSP(float, WS_RW);
    for (int i = tid; i < nrows; i += 512) { const int m = C.vcu + C.G * i; const unsigned r0 = REC[i * 4], r1 = REC[i * 4 + 1];
        const int e0 = r0 & 255, e1 = (r0 >> 8) & 255; const unsigned lp0 = r0 >> 16, lp1 = r1;
        LIST[(size_t)e0 * T + LCNT[16 + e0] + lp0] = 2 * m; LIST[(size_t)e1 * T + LCNT[16 + e1] + lp1] = 2 * m + 1;
        RWG[2 * m] = __uint_as_float(REC[i * 4 + 2]); RWG[2 * m + 1] = __uint_as_float(REC[i * 4 + 3]); }
    __syncthreads();
}
using pg8::Unit;
typedef f32x4 Acc[2][2][4][2];
__device__ __forceinline__ v4u pack8(const f32x4& a, const f32x4& b) { v4u w; w.x = cvt_pk_bf16(a[0], a[1]); w.y = cvt_pk_bf16(a[2], a[3]); w.z = cvt_pk_bf16(b[0], b[1]); w.w = cvt_pk_bf16(b[2], b[3]); return w; }
__device__ __forceinline__ void unpack8(const v4u& w, f32x4& a, f32x4& b) { a = (f32x4){bflo(w.x), bfhi(w.x), bflo(w.y), bfhi(w.y)}; b = (f32x4){bflo(w.z), bfhi(w.z), bflo(w.w), bfhi(w.w)}; }
#ifndef WT_MODE
#define WT_MODE 0
#endif
__device__ __forceinline__ void st16(void* p, const v4u& v) {
#if WT_MODE == 1
    asm volatile("global_store_dwordx4 %0, %1, off sc0 sc1" :: "v"(p), "v"(v) : "memory");
#elif WT_MODE == 2
    asm volatile("global_store_dwordx4 %0, %1, off nt" :: "v"(p), "v"(v) : "memory");
#else
    *(GAS v4u*)p = v;
#endif
}
__device__ __forceinline__ int chunk_m0(int cr) { return (cr / NCH) * LB + (cr % NCH) * 32; }

struct PWin {
    static constexpr bool EARLY_AOFF = false, FP8 = false; unsigned char* ws; int G, c; int K; unsigned kstepA;
    __device__ __forceinline__ bool next(int i, Unit& u) const { const long L = (long)i * G + c; if (L >= NPAN * 11) return false; pg8::static_decode((int)L, NPAN, 11, u.pm, u.pn); u.z = 0; return true; }
    __device__ __forceinline__ const char* a_base(const Unit& u) const { return (const char*)(ws + WS_HB) + (size_t)u.pm * 256 * 1024 * 2; }
    __device__ __forceinline__ unsigned a_off(const Unit&, int h, int R, int Cc) const { return (unsigned)((h * 128 + R) * 1024 + Cc) * 2u; }
    __device__ __forceinline__ const char* b_base(const Unit& u) const { return (const char*)(ws + WS_WIN) + (size_t)u.pn * 256 * 1024 * 2; }
    __device__ __forceinline__ void epi(const Acc& acc, const Unit& u, int wr, int wc, int fr, int fq) const {
        const int row0 = u.pm * 256 + wr * 64 + fr;
#pragma unroll
        for (int bj = 0; bj < 2; ++bj) {
            const int cb = u.pn * 256 + bj * 128; bf16* dst; int ld, col, mode = 0; float sc = 1.f;
            if (cb < 512) { dst = (bf16*)(ws + WS_U) + ((size_t)((cb + wc * 32 + 8 * fq) >> 4) * T) * 16 + ((8 * fq) & 15) - (wc * 32 + 8 * fq); ld = 16; col = 0; }
            else if (cb < 1024) { dst = (bf16*)(ws + WS_QA); ld = 512; col = cb - 512; }
            else if (cb == 1024) { dst = (bf16*)(ws + WS_KA); ld = 128; col = 0; }
            else if (cb == 1152) { dst = (bf16*)(ws + WS_VA); ld = 128; col = 0; }
            else if (cb < 1792) { dst = (bf16*)(ws + WS_QN); ld = 512; col = cb - 1280; sc = C2; }
            else if (cb < 2304) { dst = (bf16*)(ws + WS_KN); ld = 512; col = cb - 1792; }
            else { dst = (bf16*)(ws + WS_VN); ld = 512; col = cb - 2304; }
            const int c0 = col + wc * 32 + 8 * fq;
#pragma unroll
            for (int ai = 0; ai < 2; ++ai)
#pragma unroll
                for (int m = 0; m < 4; ++m) { f32x4 v0 = acc[ai][bj][m][0], v1 = acc[ai][bj][m][1];
                    if (mode) { v0 = (f32x4){fsigmoid(v0[0]), fsigmoid(v0[1]), fsigmoid(v0[2]), fsigmoid(v0[3])}; v1 = (f32x4){fsigmoid(v1[0]), fsigmoid(v1[1]), fsigmoid(v1[2]), fsigmoid(v1[3])}; }
                    else { v0 = v0 * sc; v1 = v1 * sc; }
                    st16(dst + (size_t)(row0 + ai * 128 + m * 16) * ld + c0, pack8(v0, v1)); __builtin_amdgcn_sched_barrier(0); }
        }
    }
};

struct PWin8 {
    static constexpr bool EARLY_AOFF = false, FP8 = true; unsigned char* ws; int G, c; int K; unsigned kstepA;
    __device__ __forceinline__ bool next(int i, Unit& u) const { const long L = (long)i * G + c; if (L >= 2 * NPAN * 23) return false; pg8::static_decode((int)L, 2 * NPAN, 23, u.pm, u.pn); u.z = 0; return true; }
    __device__ __forceinline__ const char* a_base(const Unit& u) const { return (const char*)(ws + WS_HB8) + (size_t)u.pm * 128 * 1024; }
    __device__ __forceinline__ unsigned a_off(const Unit&, int R, int Cc) const { return (unsigned)(R * 1024 + Cc * 2); }
    __device__ __forceinline__ const char* b_base(const Unit& u) const { return (const char*)(ws + WS_WIN) + (size_t)u.pn * 256 * 1024; }
    __device__ __forceinline__ void epi(const f32x4 (&acc)[2][4][2], f32x4 (&)[2][4][2], const Unit& u, int wr, int wc, int fr, int fq) const {
        const int row0 = u.pm * 128 + wr * 64 + fr;
#pragma unroll
        for (int bj = 0; bj < 2; ++bj) {
            const int cb = u.pn * 256 + bj * 128;
            if (cb >= 2816) { const int c0 = cb - 2816 + wc * 32 + 8 * fq;
#pragma unroll
                for (int m = 0; m < 4; ++m) { f32x4 v0 = acc[bj][m][0] * (1.f / 64.f), v1 = acc[bj][m][1] * (1.f / 64.f);
                    v0 = (f32x4){fsigmoid(v0[0]), fsigmoid(v0[1]), fsigmoid(v0[2]), fsigmoid(v0[3])}; v1 = (f32x4){fsigmoid(v1[0]), fsigmoid(v1[1]), fsigmoid(v1[2]), fsigmoid(v1[3])};
                    *(GAS v2u*)((unsigned char*)(ws + WS_GATES) + (size_t)(row0 + m * 16) * 3072 + c0) = (v2u){pk4_fp8(v0[0], v0[1], v0[2], v0[3]), pk4_fp8(v1[0], v1[1], v1[2], v1[3])}; }
            } else {
                bf16* dst; int ld, col; float sc = 1.f / 64.f;
                if (cb < 512) { dst = (bf16*)(ws + WS_U) + ((size_t)((cb + wc * 32 + 8 * fq) >> 4) * T) * 16 + ((8 * fq) & 15) - (wc * 32 + 8 * fq); ld = 16; col = 0; }
                else if (cb < 1024) { dst = (bf16*)(ws + WS_QA); ld = 512; col = cb - 512; }
                else if (cb == 1024) { dst = (bf16*)(ws + WS_KA); ld = 128; col = 0; }
                else if (cb == 1152) { dst = (bf16*)(ws + WS_VA); ld = 128; col = 0; }
                else if (cb < 1792) { dst = (bf16*)(ws + WS_QN); ld = 512; col = cb - 1280; sc = C2 / 64.f; }
                else if (cb < 2304) { dst = (bf16*)(ws + WS_KN); ld = 512; col = cb - 1792; }
                else { dst = (bf16*)(ws + WS_VN); ld = 512; col = cb - 2304; }
                const int c0 = col + wc * 32 + 8 * fq;
#pragma unroll
                for (int m = 0; m < 4; ++m) *(GAS v4u*)(dst + (size_t)(row0 + m * 16) * ld + c0) = pack8(acc[bj][m][0] * sc, acc[bj][m][1] * sc);
            }
        }
    }
};

struct PGate {
    static constexpr bool EARLY_AOFF = false, FP8 = !GATE_BF16; unsigned char* ws; int G, c; int K; unsigned kstepA;
    __device__ __forceinline__ bool next(int i, Unit& u) const { const long L = (long)i * G + c; if (L >= 2 * NPAN * 12) return false; pg8::static_decode((int)L, 2 * NPAN, 12, u.pm, u.pn); u.z = 0; return true; }
    __device__ __forceinline__ const char* a_base(const Unit& u) const { return GATE_BF16 ? (const char*)(ws + WS_HB) + (size_t)u.pm * 128 * 2048 : (const char*)(ws + WS_HB8) + (size_t)u.pm * 128 * 1024; }
    __device__ __forceinline__ unsigned a_off(const Unit&, int R, int Cc) const { return GATE_BF16 ? (unsigned)(R * 2048 + Cc * 2) : (unsigned)(R * 1024 + Cc * 2); }
    __device__ __forceinline__ const char* b_base(const Unit& u) const { return GATE_BF16 ? (const char*)(ws + WS_WIN) + (size_t)(2816 + u.pn * 256) * 2048 : (const char*)(ws + WS_WIN8) + (size_t)u.pn * 256 * 1024; }
    __device__ __forceinline__ void epi(const f32x4 (&acc)[2][4][2], f32x4 (&)[2][4][2], const Unit& u, int wr, int wc, int fr, int fq) const {
#pragma unroll
        for (int m = 0; m < 4; ++m) { const size_t r = (size_t)(u.pm * 128 + wr * 64 + m * 16 + fr);
#pragma unroll
            for (int bj = 0; bj < 2; ++bj) { const int c0 = u.pn * 256 + bj * 128 + wc * 32 + 8 * fq; f32x4 v0 = acc[bj][m][0] * (GATE_BF16 ? 1.f : 1.f / 64.f), v1 = acc[bj][m][1] * (GATE_BF16 ? 1.f : 1.f / 64.f);
                v0 = (f32x4){fsigmoid(v0[0]), fsigmoid(v0[1]), fsigmoid(v0[2]), fsigmoid(v0[3])}; v1 = (f32x4){fsigmoid(v1[0]), fsigmoid(v1[1]), fsigmoid(v1[2]), fsigmoid(v1[3])};
                if (GATE_BF16) *(GAS v4u*)((bf16*)(ws + WS_GATES) + r * 3072 + c0) = pack8(v0, v1);
                else *(GAS v2u*)((unsigned char*)(ws + WS_GATES) + r * 3072 + c0) = (v2u){pk4_fp8(v0[0], v0[1], v0[2], v0[3]), pk4_fp8(v1[0], v1[1], v1[2], v1[3])}; }
            __builtin_amdgcn_sched_barrier(0); }
    }
};

struct PS5A {
    static constexpr bool EARLY_AOFF = false, FP8 = false; unsigned char* ws; int G, c; int K; unsigned kstepA;
    __device__ __forceinline__ bool next(int i, Unit& u) const { const long L = (long)i * G + c; if (L >= 32 * 15) return false; const int l = (int)L; u.z = l / 15; const int r = l % 15; u.pm = r / 3; u.pn = r % 3; return true; }
    __device__ __forceinline__ const char* a_base(const Unit& u) const { return (const char*)(ws + WS_U) + (size_t)u.z * T * 32; }
    __device__ __forceinline__ unsigned a_off(const Unit& u, int h, int R, int Cc) const { int cr = u.pm * 256 + h * 128 + R; cr = cr < NCR ? cr : NCR - 1; return (unsigned)(cr * 512 + Cc) * 2u; }
    __device__ __forceinline__ const char* b_base(const Unit& u) const { return (const char*)(ws + WS_BT1) + ((size_t)u.z * 768 + u.pn * 256) * 512 * 2; }
    __device__ __forceinline__ void epi(const Acc& acc, const Unit& u, int wr, int wc, int fr, int fq) const {
#pragma unroll
        for (int ai = 0; ai < 2; ++ai)
#pragma unroll
            for (int m = 0; m < 4; ++m) { const int cr = u.pm * 256 + ai * 128 + wr * 64 + m * 16 + fr; if (cr >= NCR) continue;
#pragma unroll
                for (int bj = 0; bj < 2; ++bj) { const int n = bj * 128 + wc * 32 + 8 * fq;
                    if (u.pn < 2) *(GAS v4u*)((bf16*)(ws + WS_YG) + (size_t)u.z * T * 16 + (size_t)cr * 512 + u.pn * 256 + n) = pack8(acc[ai][bj][m][0], acc[ai][bj][m][1]);
                    else { GAS f32x4* o = (GAS f32x4*)((float*)(ws + WS_SST) + (size_t)cr * 8192 + u.z * 256 + n); o[0] = acc[ai][bj][m][0]; o[1] = acc[ai][bj][m][1]; } }
                __builtin_amdgcn_sched_barrier(0); }
    }
};

struct PS5B {
    static constexpr bool EARLY_AOFF = false, FP8 = false; unsigned char* ws; int G, c; int K; unsigned kstepA;
    __device__ __forceinline__ bool next(int i, Unit& u) const { const long L = (long)i * G + c; if (L >= 32 * 10) return false; const int l = (int)L; u.z = l / 10; const int r = l % 10; u.pm = r / 2; u.pn = r % 2; return true; }
    __device__ __forceinline__ const char* a_base(const Unit& u) const { return (const char*)(ws + WS_XST) + (size_t)u.z * 512; }
    __device__ __forceinline__ unsigned a_off(const Unit& u, int h, int R, int Cc) const { int cr = u.pm * 256 + h * 128 + R; cr = cr < NCR ? cr : NCR - 1; return (unsigned)(cr * 8192 + Cc) * 2u; }
    __device__ __forceinline__ const char* b_base(const Unit& u) const { return (const char*)(ws + WS_BT2) + ((size_t)u.z * 512 + u.pn * 256) * 256 * 2; }
    __device__ __forceinline__ void epi(const Acc& acc, const Unit& u, int wr, int wc, int fr, int fq) const {
#pragma unroll
        for (int ai = 0; ai < 2; ++ai) {
            v4u yw[4][2];
#pragma unroll
            for (int m = 0; m < 4; ++m) { int cr = u.pm * 256 + ai * 128 + wr * 64 + m * 16 + fr; cr = cr < NCR ? cr : NCR - 1;
#pragma unroll
                for (int bj = 0; bj < 2; ++bj) yw[m][bj] = *(const GAS v4u*)((const bf16*)(ws + WS_YG) + (size_t)u.z * T * 16 + (size_t)cr * 512 + u.pn * 256 + bj * 128 + wc * 32 + 8 * fq); }
#pragma unroll
            for (int m = 0; m < 4; ++m) { const int cr = u.pm * 256 + ai * 128 + wr * 64 + m * 16 + fr; if (cr >= NCR) continue;
#pragma unroll
                for (int bj = 0; bj < 2; ++bj) { const int nn = u.pn * 256 + bj * 128 + wc * 32 + 8 * fq, t = nn >> 4, h0 = nn & 15;
                    GAS v4u* p = (GAS v4u*)((bf16*)(ws + WS_YS) + (size_t)(chunk_m0(cr) + t) * 512 + u.z * 16 + h0);
                    f32x4 y0, y1; { const v4u w_ = yw[m][bj]; unpack8(w_, y0, y1); } y0 += acc[ai][bj][m][0]; y1 += acc[ai][bj][m][1];
                    y0 = (f32x4){gelu_tanh(y0[0]), gelu_tanh(y0[1]), gelu_tanh(y0[2]), gelu_tanh(y0[3])}; y1 = (f32x4){gelu_tanh(y1[0]), gelu_tanh(y1[1]), gelu_tanh(y1[2]), gelu_tanh(y1[3])};
                    *p = pack8(y0, y1); } } }
    }
};

__device__ __forceinline__ int half_panel(int hl, bool lat_only) { if (!lat_only) return hl; const int pl = hl >> 1; return 2 * (pl + (pl >> 5) + 1) + (hl & 1); }
struct PGlu {
    static constexpr bool EARLY_AOFF = false, FP8 = false; unsigned char* ws; int G, c; int K; unsigned kstepA; bool lat_only;
    __device__ __forceinline__ bool next(int i, Unit& u) const { const int nH = lat_only ? 256 : 2 * NPAN; const long L = (long)i * G + c; if (L >= nH * 2) return false; pg8::static_decode((int)L, nH, 2, u.pm, u.pn); u.pm = half_panel(u.pm, lat_only); u.z = 0; return true; }
    __device__ __forceinline__ const char* a_base(const Unit& u) const { return (const char*)(ws + WS_YS) + (size_t)u.pm * 128 * 512 * 2; }
    __device__ __forceinline__ unsigned a_off(const Unit&, int R, int Cc) const { return (unsigned)(R * 512 + Cc) * 2u; }
    __device__ __forceinline__ const char* b_base(const Unit& u) const { return (const char*)(ws + WS_WGLU) + (size_t)u.pn * 256 * 512 * 2; }
    __device__ __forceinline__ void epi(const f32x4 (&acc)[2][4][2], f32x4 (&)[2][4][2], const Unit& u, int wr, int wc, int fr, int fq) const {
        v4u zw[4][2];
#pragma unroll
        for (int m = 0; m < 4; ++m)
#pragma unroll
            for (int bj = 0; bj < 2; ++bj) zw[m][bj] = *(const GAS v4u*)((const bf16*)(ws + WS_YS) + (size_t)(u.pm * 128 + wr * 64 + m * 16 + fr) * 512 + u.pn * 256 + bj * 128 + wc * 32 + 8 * fq);
#pragma unroll
        for (int m = 0; m < 4; ++m) { const size_t r = (size_t)(u.pm * 128 + wr * 64 + m * 16 + fr);
#pragma unroll
            for (int bj = 0; bj < 2; ++bj) { const int cc = u.pn * 256 + bj * 128 + wc * 32 + 8 * fq;
                f32x4 z0, z1; { const v4u w_ = zw[m][bj]; unpack8(w_, z0, z1); } const f32x4 a0 = acc[bj][m][0], a1 = acc[bj][m][1];
                z0 = z0 * (f32x4){fsigmoid(a0[0]), fsigmoid(a0[1]), fsigmoid(a0[2]), fsigmoid(a0[3])}; z1 = z1 * (f32x4){fsigmoid(a1[0]), fsigmoid(a1[1]), fsigmoid(a1[2]), fsigmoid(a1[3])};
                *(GAS v4u*)((bf16*)(ws + WS_U) + r * 512 + cc) = pack8(z0, z1); } }
    }
};

typedef f32x4 Acc128[2][4][2];
struct PMerge {
    static constexpr bool EARLY_AOFF = false, FP8 = false; unsigned char* ws; int G, c; int K; unsigned kstepA; bool lat_only;
    __device__ __forceinline__ bool next(int i, Unit& u) const { const int nH = lat_only ? 256 : 2 * NPAN; const long tile = (long)(i / 3) * G + c; if (tile >= nH * 4) return false; pg8::static_decode((int)tile, nH, 4, u.pm, u.pn); u.pm = half_panel(u.pm, lat_only); u.z = i % 3; return true; }
    __device__ __forceinline__ const char* a_base(const Unit& u) const { const size_t off = u.z == 0 ? WS_U : (u.z == 1 ? WS_AO : WS_NO); return (const char*)(ws + off) + (size_t)u.pm * 128 * 512 * 2; }
    __device__ __forceinline__ unsigned a_off(const Unit&, int R, int Cc) const { return (unsigned)(R * 512 + Cc) * 2u; }
    __device__ __forceinline__ const char* b_base(const Unit& u) const { return (const char*)(ws + WS_WBR) + ((size_t)u.z * 1024 + u.pn * 256) * 512 * 2; }
    __device__ __forceinline__ void epi(const Acc128& acc, Acc128& mrg, const Unit& u, int wr, int wc, int fr, int fq) const {
        v2u gw[4][2];
#pragma unroll
        for (int m = 0; m < 4; ++m)
#pragma unroll
            for (int bj = 0; bj < 2; ++bj) gw[m][bj] = *(const GAS v2u*)((const unsigned char*)(ws + WS_GATES) + (size_t)(u.pm * 128 + wr * 64 + m * 16 + fr) * 3072 + u.z * 1024 + u.pn * 256 + bj * 128 + wc * 32 + 8 * fq);
#pragma unroll
        for (int m = 0; m < 4; ++m) { const size_t r = (size_t)(u.pm * 128 + wr * 64 + m * 16 + fr);
#pragma unroll
            for (int bj = 0; bj < 2; ++bj) { const int cc = u.pn * 256 + bj * 128 + wc * 32 + 8 * fq; const v2u w_ = gw[m][bj];
                const f32x4 g0 = (f32x4){__builtin_amdgcn_cvt_f32_fp8((int)w_.x, 0), __builtin_amdgcn_cvt_f32_fp8((int)w_.x, 1), __builtin_amdgcn_cvt_f32_fp8((int)w_.x, 2), __builtin_amdgcn_cvt_f32_fp8((int)w_.x, 3)};
                const f32x4 g1 = (f32x4){__builtin_amdgcn_cvt_f32_fp8((int)w_.y, 0), __builtin_amdgcn_cvt_f32_fp8((int)w_.y, 1), __builtin_amdgcn_cvt_f32_fp8((int)w_.y, 2), __builtin_amdgcn_cvt_f32_fp8((int)w_.y, 3)};
                if (u.z == 0) { mrg[bj][m][0] = g0 * acc[bj][m][0]; mrg[bj][m][1] = g1 * acc[bj][m][1]; }
                else { mrg[bj][m][0] += g0 * acc[bj][m][0]; mrg[bj][m][1] += g1 * acc[bj][m][1]; }
                if (u.z == 2) *(GAS v4u*)((bf16*)(ws + WS_HB) + r * 1024 + cc) = pack8(mrg[bj][m][0], mrg[bj][m][1]); } }
    }
};

struct PWout {
    static constexpr bool EARLY_AOFF = false, FP8 = false; unsigned char* ws; float* out; const float* mod; int G, c; int K; unsigned kstepA; bool lat_only;
    __device__ __forceinline__ bool next(int i, Unit& u) const { const int nH = lat_only ? 256 : 2 * NPAN; const long L = (long)i * G + c; if (L >= nH * 4) return false; pg8::static_decode((int)L, nH, 4, u.pm, u.pn); u.pm = half_panel(u.pm, lat_only); u.z = 0; return true; }
    __device__ __forceinline__ const char* a_base(const Unit& u) const { return (const char*)(ws + WS_HB) + (size_t)u.pm * 128 * 1024 * 2; }
    __device__ __forceinline__ unsigned a_off(const Unit&, int R, int Cc) const { return (unsigned)(R * 1024 + Cc) * 2u; }
    __device__ __forceinline__ const char* b_base(const Unit& u) const { return (const char*)(ws + WS_WOUT) + (size_t)u.pn * 256 * 1024 * 2; }
    __device__ __forceinline__ void epi(const f32x4 (&acc)[2][4][2], f32x4 (&)[2][4][2], const Unit& u, int wr, int wc, int fr, int fq) const {
        const int pm = u.pm >> 1, hh = u.pm & 1, b = pm / 33, pr = pm % 33, cond = pr == 0 ? 4 : b;
        float* xb = pr == 0 ? (float*)(ws + WS_CTXS) + ((size_t)b * 256 + hh * 128) * D : out + ((size_t)b * SEQ + (size_t)(pr - 1) * 256 + hh * 128) * D;
        const float* g1 = mod + cond * 6144 + 2048;
        f32x4 xv[2][4][2];
#pragma unroll
        for (int bj = 0; bj < 2; ++bj)
#pragma unroll
            for (int m = 0; m < 4; ++m) { const GAS f32x4* p = (const GAS f32x4*)(xb + (size_t)(wr * 64 + m * 16 + fr) * D + u.pn * 256 + bj * 128 + wc * 32 + 8 * fq); xv[bj][m][0] = p[0]; xv[bj][m][1] = p[1]; }
#pragma unroll
        for (int bj = 0; bj < 2; ++bj) { const int cc = u.pn * 256 + bj * 128 + wc * 32 + 8 * fq; const f32x4 ga = *(const GAS f32x4*)(g1 + cc), gb = *(const GAS f32x4*)(g1 + cc + 4);
#pragma unroll
            for (int m = 0; m < 4; ++m) { GAS f32x4* p = (GAS f32x4*)(xb + (size_t)(wr * 64 + m * 16 + fr) * D + cc);
                p[0] = xv[bj][m][0] + ga * acc[bj][m][0]; p[1] = xv[bj][m][1] + gb * acc[bj][m][1]; } }
    }
};

struct ExpTab { int cnt[16], tile0[17]; };
__device__ __forceinline__ int exp_find(const int (&tile0)[17], int q) { int e = 0;
#pragma unroll
    for (int k = 1; k < 16; ++k) e += (q >= tile0[k]) ? 1 : 0;
    return e; }

struct PMoe1 {
    static constexpr bool EARLY_AOFF = true, FP8 = true; unsigned char* ws; const LAS int* tab; int G, c; int K; unsigned kstepA;
    __device__ __forceinline__ bool next(int i, Unit& u) const { const long L = (long)i * G + c; const int total = __builtin_amdgcn_readfirstlane(tab[32]) * 4; if (L >= total) return false; const int q = (int)L >> 2; u.pn = (int)L & 3;
        int e = 0;
#pragma unroll
        for (int k = 1; k < 16; ++k) e += (q >= __builtin_amdgcn_readfirstlane(tab[16 + k])) ? 1 : 0;
        u.z = e; u.pm = q - __builtin_amdgcn_readfirstlane(tab[16 + e]); return true; }
    __device__ __forceinline__ const char* a_base(const Unit&) const { return (const char*)(ws + WS_HB8); }
    __device__ __forceinline__ unsigned a_off(const Unit& u, int R, int Cc) const { int r = u.pm * 128 + R; const int n = __builtin_amdgcn_readfirstlane(tab[u.z]); r = r < n ? r : n - 1;
        const int ent = ((const int*)(ws + WS_LIST))[(size_t)u.z * T + r]; return (unsigned)((ent >> 1) * 1024 + Cc * 2); }
    __device__ __forceinline__ const char* b_base(const Unit& u) const { return (const char*)(ws + WS_MOE1) + ((size_t)u.z * 1024 + u.pn * 256) * 1024; }
    __device__ __forceinline__ void epi(const f32x4 (&acc)[2][4][2], f32x4 (&)[2][4][2], const Unit& u, int wr, int wc, int fr, int fq) const {
        const size_t arow0 = (size_t)(__builtin_amdgcn_readfirstlane(tab[16 + u.z]) + u.pm) * 128;
#pragma unroll
        for (int m = 0; m < 4; ++m) { const f32x4 g0 = acc[0][m][0] * (1.f / 64.f), g1 = acc[0][m][1] * (1.f / 64.f), u0 = acc[1][m][0] * (8.f / 64.f), u1 = acc[1][m][1] * (8.f / 64.f);
            const f32x4 v0 = (f32x4){g0[0] * fsigmoid(g0[0]), g0[1] * fsigmoid(g0[1]), g0[2] * fsigmoid(g0[2]), g0[3] * fsigmoid(g0[3])} * u0;
            const f32x4 v1 = (f32x4){g1[0] * fsigmoid(g1[0]), g1[1] * fsigmoid(g1[1]), g1[2] * fsigmoid(g1[2]), g1[3] * fsigmoid(g1[3])} * u1;
            *(GAS v2u*)((unsigned char*)(ws + WS_ACT) + (arow0 + wr * 64 + m * 16 + fr) * 512 + u.pn * 128 + wc * 32 + 8 * fq) = (v2u){pk4_fp8(v0[0], v0[1], v0[2], v0[3]), pk4_fp8(v1[0], v1[1], v1[2], v1[3])}; }
    }
};
struct PMoe2 {
    static constexpr bool EARLY_AOFF = false, FP8 = true; unsigned char* ws; const LAS int* tab; int G, c; int K; unsigned kstepA;
    __device__ __forceinline__ bool next(int i, Unit& u) const { const long L = (long)i * G + c; const int total = __builtin_amdgcn_readfirstlane(tab[32]) * 4; if (L >= total) return false; const int q = (int)L >> 2; u.pn = (int)L & 3;
        int e = 0;
#pragma unroll
        for (int k = 1; k < 16; ++k) e += (q >= __builtin_amdgcn_readfirstlane(tab[16 + k])) ? 1 : 0;
        u.z = e; u.pm = q - __builtin_amdgcn_readfirstlane(tab[16 + e]); return true; }
    __device__ __forceinline__ const char* a_base(const Unit& u) const { return (const char*)(ws + WS_ACT) + (size_t)(__builtin_amdgcn_readfirstlane(tab[16 + u.z]) + u.pm) * 128 * 512; }
    __device__ __forceinline__ unsigned a_off(const Unit&, int R, int Cc) const { return (unsigned)(R * 512 + Cc * 2); }
    __device__ __forceinline__ const char* b_base(const Unit& u) const { return (const char*)(ws + WS_MOE2) + ((size_t)u.z * 1024 + u.pn * 256) * 512; }
    __device__ __forceinline__ void epi(const f32x4 (&acc)[2][4][2], f32x4 (&)[2][4][2], const Unit& u, int wr, int wc, int fr, int fq) const {
        const int n = __builtin_amdgcn_readfirstlane(tab[u.z]);
        int entv[4]; float wv[4];
#pragma unroll
        for (int m = 0; m < 4; ++m) { int r = u.pm * 128 + wr * 64 + m * 16 + fr; r = r < n ? r : n - 1; entv[m] = ((const int*)(ws + WS_LIST))[(size_t)u.z * T + r]; }
#pragma unroll
        for (int m = 0; m < 4; ++m) wv[m] = ((const float*)(ws + WS_RW))[entv[m]] * (1.f / 256.f);
#pragma unroll
        for (int m = 0; m < 4; ++m) { const int r = u.pm * 128 + wr * 64 + m * 16 + fr; if (r >= n) continue;
            const int ent = entv[m]; const float w = wv[m];
#pragma unroll
            for (int bj = 0; bj < 2; ++bj)
                *(GAS v4u*)((bf16*)(ws + WS_YSLOT) + (size_t)ent * 1024 + u.pn * 256 + bj * 128 + wc * 32 + 8 * fq) = pack8(acc[bj][m][0] * w, acc[bj][m][1] * w); }
    }
};
struct PMoe1B {
    static constexpr bool EARLY_AOFF = true, FP8 = false; unsigned char* ws; const LAS int* tab; int G, c; int K; unsigned kstepA;
    __device__ __forceinline__ bool next(int i, Unit& u) const { const long L = (long)i * G + c; const int total = tab[32] * 4; if (L >= total) return false; const int q = (int)L >> 2; u.pn = (int)L & 3;
        int e = 0;
#pragma unroll
        for (int k = 1; k < 16; ++k) e += (q >= tab[16 + k]) ? 1 : 0;
        u.z = e; u.pm = q - tab[16 + e]; return true; }
    __device__ __forceinline__ const char* a_base(const Unit&) const { return (const char*)(ws + WS_HB); }
    __device__ __forceinline__ unsigned a_off(const Unit& u, int h, int R, int Cc) const { int r = u.pm * 256 + h * 128 + R; const int n = tab[u.z]; r = r < n ? r : n - 1;
        const int ent = ((const int*)(ws + WS_LIST))[(size_t)u.z * T + r]; return (unsigned)((ent >> 1) * 1024 + Cc) * 2u; }
    __device__ __forceinline__ const char* b_base(const Unit& u) const { return (const char*)(ws + WS_MOE1) + ((size_t)u.z * 1024 + u.pn * 256) * 1024 * 2; }
    __device__ __forceinline__ void epi(const Acc& acc, const Unit& u, int wr, int wc, int fr, int fq) const {
        const size_t arow0 = (size_t)(tab[16 + u.z] + u.pm) * 256;
#pragma unroll
        for (int ai = 0; ai < 2; ++ai)
#pragma unroll
            for (int m = 0; m < 4; ++m) { const f32x4 g0 = acc[ai][0][m][0], g1 = acc[ai][0][m][1], u0 = acc[ai][1][m][0], u1 = acc[ai][1][m][1];
                const f32x4 v0 = (f32x4){g0[0] * fsigmoid(g0[0]), g0[1] * fsigmoid(g0[1]), g0[2] * fsigmoid(g0[2]), g0[3] * fsigmoid(g0[3])} * u0;
                const f32x4 v1 = (f32x4){g1[0] * fsigmoid(g1[0]), g1[1] * fsigmoid(g1[1]), g1[2] * fsigmoid(g1[2]), g1[3] * fsigmoid(g1[3])} * u1;
                *(GAS v4u*)((bf16*)(ws + WS_ACTB) + (arow0 + ai * 128 + wr * 64 + m * 16 + fr) * 512 + u.pn * 128 + wc * 32 + 8 * fq) = pack8(v0, v1); }
    }
};
struct PMoe2B {
    static constexpr bool EARLY_AOFF = false, FP8 = false; unsigned char* ws; const LAS int* tab; int G, c; int K; unsigned kstepA;
    __device__ __forceinline__ bool next(int i, Unit& u) const { const long L = (long)i * G + c; const int total = tab[32] * 4; if (L >= total) return false; const int q = (int)L >> 2; u.pn = (int)L & 3;
        int e = 0;
#pragma unroll
        for (int k = 1; k < 16; ++k) e += (q >= tab[16 + k]) ? 1 : 0;
        u.z = e; u.pm = q - tab[16 + e]; return true; }
    __device__ __forceinline__ const char* a_base(const Unit& u) const { return (const char*)(ws + WS_ACTB) + (size_t)(tab[16 + u.z] + u.pm) * 256 * 512 * 2; }
    __device__ __forceinline__ unsigned a_off(const Unit&, int h, int R, int Cc) const { return (unsigned)((h * 128 + R) * 512 + Cc) * 2u; }
    __device__ __forceinline__ const char* b_base(const Unit& u) const { return (const char*)(ws + WS_MOE2) + ((size_t)u.z * 1024 + u.pn * 256) * 512 * 2; }
    __device__ __forceinline__ void epi(const Acc& acc, const Unit& u, int wr, int wc, int fr, int fq) const {
        const int n = tab[u.z];
#pragma unroll
        for (int ai = 0; ai < 2; ++ai)
#pragma unroll
            for (int m = 0; m < 4; ++m) { const int r = u.pm * 256 + ai * 128 + wr * 64 + m * 16 + fr; if (r >= n) continue;
                const int ent = ((const int*)(ws + WS_LIST))[(size_t)u.z * T + r]; const float w = ((const float*)(ws + WS_RW))[ent];
#pragma unroll
                for (int bj = 0; bj < 2; ++bj)
                    *(GAS v4u*)((bf16*)(ws + WS_YSLOT) + (size_t)ent * 1024 + u.pn * 256 + bj * 128 + wc * 32 + 8 * fq) = pack8(acc[ai][bj][m][0] * w, acc[ai][bj][m][1] * w); }
    }
};
__device__ __forceinline__ void build_exptab(const Ctx& C, LAS int* tab, int l, int tsh = 7) {
    __syncthreads();
    if (threadIdx.x == 0) { int t0 = 0;
        for (int e = 0; e < 16; ++e) { const int n = (int)__hip_atomic_load((unsigned*)(C.ctl + CW_CNT + l * 1024 + 64 * e), RLX_AGENT); tab[e] = n; tab[16 + e] = t0; t0 += (n + (1 << tsh) - 1) >> tsh; }
        tab[32] = t0; }
    __syncthreads();
}
__device__ __forceinline__ void phase_attn(const Ctx& C, int l, unsigned char* lds_gen) {
    phase_carry(C, l);
    char* shm = (char*)lds_gen;
    bf16* QA = WSP(bf16, WS_QA); bf16* KA = WSP(bf16, WS_KA); bf16* VA = WSP(bf16, WS_VA); bf16* QN = WSP(bf16, WS_QN); bf16* KN = WSP(bf16, WS_KN); bf16* VN = WSP(bf16, WS_VN);
#ifndef ATTN_SEL
#define ATTN_SEL 3
#endif
#ifdef REPMASK
#define REPMASK_ REPMASK
#else
#define REPMASK_ 0
#endif
    const int per = (1024 + C.G - 1) / C.G;
    bool nomax; { float gq = 0.f, gk = 0.f; for (int i = 0; i < 64; ++i) { gq = fmaxf(gq, fabsf(C.in[I_QNG][l * 64 + i])); gk = fmaxf(gk, fabsf(C.in[I_KNG][l * 64 + i])); } nomax = 64.f * gq * gk * C2 <= 60.f; }
    if (ATTN_SEL & 1) for (int i = 0; i < per * (1 + ((REPMASK_ >> 13) & 1)); ++i) { const int id = C.vcu * per + (i % per); if (id >= 1024) continue; const int bh = id >> 5, b = bh >> 3, h = bh & 7, qb = id & 31;
        const bf16* Qu = QA + (size_t)(b * LB + CTX + qb * 256) * 512 + h * 64;
        if (nomax) attn_body::attn_unit<8, false, 512, 128, true>(Qu, 512, KA + (size_t)(b * LB) * 128 + (h >> 2) * 64, VA + (size_t)(b * LB) * 128 + (h >> 2) * 64, 128, WSP(bf16, WS_AO) + (Qu - QA), LB / 64, 0, 0, shm);
        else attn_body::attn_unit<8, false, 512, 128, false>(Qu, 512, KA + (size_t)(b * LB) * 128 + (h >> 2) * 64, VA + (size_t)(b * LB) * 128 + (h >> 2) * 64, 128, WSP(bf16, WS_AO) + (Qu - QA), LB / 64, 0, 0, shm);
    }
    LAS float* bt = (LAS float*)(C.lds + attn_body::LDS_BT);
    const int nctx = (C.vcu >= 64 && C.vcu < 128) ? 1 : 0;
    if (ATTN_SEL & 2) for (int i0 = 0; i0 < (per + nctx) * (1 + ((REPMASK_ >> 14) & 1)); ++i0) { const int i = i0 % (per + nctx);
        const bf16 *Qu, *Kh, *Vh; bf16* Ou; int kvp = 512, NT = 4, r0 = 0, rlo = 0;
        if (i < per) { const int id = C.vcu * per + i; if (id >= 1024) continue; const int bh = id >> 5, b = bh >> 3, h = bh & 7; r0 = (id & 31) * 4;
            const float* rp = C.in[I_RPB] + (size_t)(l * 8 + h) * 465;
            for (int k = C.tid; k < 465; k += 512) bt[k] = rp[k] * LOG2E;
            rlo = r0 - 4 < 0 ? 0 : (r0 - 4 > 120 ? 120 : r0 - 4); const int rh_ = r0 - 1 < 0 ? 0 : (r0 - 1 > 120 ? 120 : r0 - 1), nloc = rh_ + 8 - rlo; NT = (4 + nloc + 1) & ~1;
            Qu = QN + (size_t)(b * LB + CTX + r0 * 64) * 512 + h * 64; Ou = WSP(bf16, WS_NO) + (Qu - QN); Kh = KN + (size_t)(b * LB) * 512 + h * 64; Vh = VN + (size_t)(b * LB) * 512 + h * 64; }
        else { int j = C.vcu - 64; if (j < 32) { const int b = j >> 3, h = j & 7; Qu = QA + (size_t)(b * LB) * 512 + h * 64; Ou = WSP(bf16, WS_AO) + (Qu - QA); Kh = KA + (size_t)(b * LB) * 128 + (h >> 2) * 64; Vh = VA + (size_t)(b * LB) * 128 + (h >> 2) * 64; kvp = 128; }
            else { j -= 32; const int b = j >> 3, h = j & 7; Qu = QN + (size_t)(b * LB) * 512 + h * 64; Ou = WSP(bf16, WS_NO) + (Qu - QN); Kh = KN + (size_t)(b * LB) * 512 + h * 64; Vh = VN + (size_t)(b * LB) * 512 + h * 64; } }
        attn_body::attn_unit<8, true, 512, 0>(Qu, 512, Kh, Vh, kvp, Ou, NT, r0, rlo, shm);
    }
}

constexpr int NPH = 46;
__global__ void __launch_bounds__(NWAVES * 64, 2) fwd(Args args) {
    extern __shared__ __attribute__((aligned(16))) unsigned char lds[];
    Ctx C; C.in = (const __attribute__((address_space(4))) CFP*)__builtin_amdgcn_kernarg_segment_ptr(); C.out = args.out; C.ws = args.ws; C.lds = (LAS unsigned char*)lds; C.ctl = (gu32*)(args.ws + WS_CTL);
    C.tid = 0; C.lane = 0; C.wave = __builtin_amdgcn_readfirstlane((int)threadIdx.x >> 6);
    C.G = gridDim.x; { const int bx = blockIdx.x; C.vcu = (C.G % 8 == 0) ? (bx % 8) * (C.G / 8) + bx / 8 : bx; }
    for (int u = threadIdx.x; u < (LDS_BYTES - LDSCTL_OFF) / 4; u += NWAVES * 64) ((LAS unsigned*)(C.lds + LDSCTL_OFF))[u] = 0u;
    __syncthreads();
    const int lo = args.ph_lo, hi = args.ph_hi;
    XcdBarrier bar; bar.bar = (unsigned*)(C.ctl + CW_BAR); bar.x = 0; bar.st = nullptr;
    if (hi - lo > 1) bar = xcd_barrier_post((unsigned*)(C.ctl + CW_BAR), (volatile LAS unsigned*)(C.lds + MISC_OFF) + 8);
    LAS int* tab = (LAS int*)(C.lds + LDSCTL_OFF);
    const int cg = (int)blockIdx.x;
#ifndef PHMASK
#define PHMASK 0xFFFF
#endif
#define IN(k) (lo <= (k) && (k) < hi)
#define EN(b) ((PHMASK >> (b)) & 1)
#ifndef REPMASK
#define REPMASK 0
#endif
#define RUN(b, stmt) do { stmt; if ((REPMASK >> (b)) & 1) { stmt; } } while (0)
#ifdef DIAG_SEL
#define DIAG_ACC(ty) do { if (blockIdx.x == 0 && threadIdx.x == 0) { volatile LAS unsigned* dg = (volatile LAS unsigned*)(C.lds + LDSCTL_OFF + 160); const unsigned now = (unsigned)__builtin_amdgcn_s_memrealtime(); dg[8 + (ty)] += now - dg[0]; dg[0] = now; } } while (0)
#else
#define DIAG_ACC(ty) do {} while (0)
#endif
#define SEAM(k) do { if (IN(k) && IN((k) + 1)) xcd_barrier(bar); DIAG_ACC((k) == 0 ? 11 : ((k) - 1) % 11); } while (0)
#define LWS() ({ const __attribute__((address_space(4))) CFP* k_ = C.in; asm volatile("" : "+s"(k_)); (unsigned char*)k_[30]; })
#define LC() ({ Ctx c_ = C; c_.tid = threadIdx.x; asm volatile("" : "+v"(c_.tid)); c_.lane = c_.tid & 63; asm volatile("" : "+s"(c_.in)); c_.ws = (unsigned char*)c_.in[30]; c_.out = (float*)c_.in[29]; c_.ctl = (gu32*)(c_.ws + WS_CTL); c_; })
#ifdef DIAG_SEL
    if (blockIdx.x == 0 && threadIdx.x == 0) { volatile LAS unsigned* dg = (volatile LAS unsigned*)(C.lds + LDSCTL_OFF + 160); dg[0] = (unsigned)__builtin_amdgcn_s_memrealtime(); dg[1] = dg[0]; }
#endif
    if (EN(11) && IN(0)) { const Ctx Cl = LC(); phase_mod(Cl); RUN(11, phase_s5mats(Cl, 0); phase_weights(Cl, 0)); }
    SEAM(0);
    for (int l = 0; l < NLAYER; ++l) {
        const int pb = 1 + 11 * l;
        if (EN(0) && IN(pb)) { const Ctx Cl = LC(); if (l == 0) phase_rows<0>(Cl, 0); else { phase_s5mats(Cl, l); phase_weights(Cl, l); phase_rows<1>(Cl, l); } }
        SEAM(pb);
        if (EN(1) && IN(pb + 1)) { if (W8_ALL) { PWin8 P{LWS(), C.G, cg, 1024, 128u}; pg8::gemm_phase_m128(C.lds, P); } else { { PWin P{LWS(), C.G, cg, 1024, 128u}; pg8::gemm_phase(C.lds, P); } { PGate P{LWS(), C.G, cg, 1024, 128u}; pg8::gemm_phase_m128(C.lds, P); } } }
        SEAM(pb + 1);
        if (EN(2) && IN(pb + 2)) { { const Ctx Cl = LC(); phase_qkprep(Cl, l); } PS5A P{LWS(), C.G, cg, 512, 128u}; RUN(2, pg8::gemm_phase(C.lds, P)); }
        SEAM(pb + 2);
        if (EN(3) && IN(pb + 3)) { const Ctx Cl = LC(); RUN(3, phase_attn(Cl, l, lds)); }
        SEAM(pb + 3);
        if (EN(4) && IN(pb + 4)) { PS5B P{LWS(), C.G, cg, 256, 128u}; pg8::gemm_phase(C.lds, P); }
        SEAM(pb + 4);
        if (EN(5) && IN(pb + 5)) { PGlu P{LWS(), C.G, cg, 512, 128u, l == NLAYER - 1}; pg8::gemm_phase_m128(C.lds, P); }
        SEAM(pb + 5);
        if (EN(6) && IN(pb + 6)) { PMerge P{LWS(), C.G, cg, 512, 128u, l == NLAYER - 1}; pg8::gemm_phase_m128(C.lds, P); }
        SEAM(pb + 6);
        if (EN(7) && IN(pb + 7)) { unsigned char* wl_ = LWS(); PWout P{wl_, (float*)C.in[29], (const float*)(wl_ + WS_MOD) + (size_t)l * 5 * 6144, C.G, cg, 1024, 128u, l == NLAYER - 1}; pg8::gemm_phase_m128(C.lds, P); }
        SEAM(pb + 7);
        if (EN(8) && IN(pb + 8)) { const Ctx Cl = LC(); phase_norm2(Cl, l); }
        SEAM(pb + 8);
        if (EN(9) && IN(pb + 9)) { if (FP8_MOE) { build_exptab(C, tab, l); PMoe1 P{LWS(), tab, C.G, cg, 1024, 128u}; pg8::gemm_phase_m128(C.lds, P); } else { build_exptab(C, tab, l, 8); PMoe1B P{LWS(), tab, C.G, cg, 1024, 128u}; pg8::gemm_phase(C.lds, P); } }
        SEAM(pb + 9);
        if (EN(10) && IN(pb + 10)) { if (FP8_MOE) { build_exptab(C, tab, l); PMoe2 P{LWS(), tab, C.G, cg, 512, 128u}; pg8::gemm_phase_m128(C.lds, P); } else { build_exptab(C, tab, l, 8); PMoe2B P{LWS(), tab, C.G, cg, 512, 128u}; pg8::gemm_phase(C.lds, P); } }
        SEAM(pb + 10);
    }
    if (EN(12) && IN(NPH - 1)) { const Ctx Cl = LC(); phase_rows<2>(Cl, NLAYER); }
#ifdef DIAG_SEL
    xcd_barrier(bar); DIAG_ACC(12);
    if (blockIdx.x == 0 && threadIdx.x == 0) { volatile LAS unsigned* dg = (volatile LAS unsigned*)(C.lds + LDSCTL_OFF + 160); dg[8 + 13] = dg[0] - dg[1];
        for (int i = 0; i < 14; ++i) __hip_atomic_store(C.ctl + 2048 + i, dg[8 + i], RLX_AGENT); }
    xcd_barrier(bar);
    { const float d1 = (float)__hip_atomic_load(C.ctl + 2048 + (DIAG_SEL), RLX_AGENT) * 0.01f, d2 = (float)__hip_atomic_load(C.ctl + 2048 + (DIAG_SEL) + 1, RLX_AGENT) * 0.01f;
      const float c1 = sqrtf(d1); float* o = args.out;
      for (size_t i = (size_t)blockIdx.x * 512 + threadIdx.x; i < (size_t)NB * SEQ * D; i += (size_t)gridDim.x * 512) o[i] = (i == 12345) ? d2 : c1; }
#endif
#undef IN
#undef SEAM
}

#ifndef MK_PER_PHASE
#define MK_PER_PHASE 0
#endif
extern "C" void kernel_launch(void* const* d_in, const int* in_sizes, int n_in, void* d_out, int out_size, void* d_ws, size_t ws_size, hipStream_t stream) {
    static int grid = 0;
    if (grid == 0) {
        if (n_in != 29 || out_size != NB * SEQ * D || ws_size < WS_END) { fprintf(stderr, "kernel_launch: unexpected shapes (n_in %d out %d ws %zu)\n", n_in, out_size, ws_size); grid = -1; return; }
        int dev = 0, cus = 0, per_cu = 0;
        if (hipGetDevice(&dev) != hipSuccess || hipDeviceGetAttribute(&cus, hipDeviceAttributeMultiprocessorCount, dev) != hipSuccess) { grid = -1; return; }
        if (hipFuncSetAttribute((const void*)fwd, hipFuncAttributeMaxDynamicSharedMemorySize, LDS_BYTES) != hipSuccess) { grid = -1; return; }
        if (hipOccupancyMaxActiveBlocksPerMultiprocessor(&per_cu, (const void*)fwd, NWAVES * 64, LDS_BYTES) != hipSuccess || per_cu < 1) fprintf(stderr, "kernel_launch: occupancy query says %d\n", per_cu);
        (void)hipGetLastError();
        grid = cus;
    }
    if (grid < 0) return;
    (void)hipMemsetAsync((char*)d_ws + WS_CTL, 0, CTL_ZERO_BYTES, stream);
    Args a{};
    for (int i = 0; i < 29; ++i) a.in[i] = (const float*)d_in[i];
    a.out = (float*)d_out; a.ws = (unsigned char*)d_ws;
#if MK_PER_PHASE
    for (int p = 0; p < NPH; ++p) { a.ph_lo = p; a.ph_hi = p + 1; hipLaunchKernelGGL(fwd, dim3(grid), dim3(NWAVES * 64), LDS_BYTES, stream, a); }
#else
    a.ph_lo = 0; a.ph_hi = NPH; hipLaunchKernelGGL(fwd, dim3(grid), dim3(NWAVES * 64), LDS_BYTES, stream, a);
#endif
}
```

```cpp
#define FP8_MOE 1
#define GATE_BF16 0
#define W8_ALL 1
#define H8_WRITE 1
#ifndef H8_WRITE
#define H8_WRITE 1
#endif
#ifndef GATE_BF16
#define GATE_BF16 0
#endif
#include <hip/hip_runtime.h>
#include <cstdio>
#include <cstdint>

#define GAS __attribute__((address_space(1)))
#define LAS __attribute__((address_space(3)))
typedef unsigned short bf16;
typedef unsigned v4u __attribute__((ext_vector_type(4)));
typedef unsigned v2u __attribute__((ext_vector_type(2)));
typedef float f32x4 __attribute__((ext_vector_type(4)));
typedef float f32x2 __attribute__((ext_vector_type(2)));
typedef float f32x16 __attribute__((ext_vector_type(16)));
typedef short bf16x8 __attribute__((ext_vector_type(8)));
typedef short s16x4 __attribute__((ext_vector_type(4)));
typedef GAS unsigned gu32;
#define RLX_AGENT __ATOMIC_RELAXED, __HIP_MEMORY_SCOPE_AGENT
#define LDS_WAIT() asm volatile("s_waitcnt lgkmcnt(0)" ::: "memory")
#define VM_WAIT() asm volatile("s_waitcnt vmcnt(0)" ::: "memory")

constexpr int NB = 4, SEQ = 8192, CTX = 256, LB = SEQ + CTX, T = NB * LB, D = 1024, NPAN = T / 256;
constexpr int NLAYER = 4, INW = 5888, NCH = LB / 32, NCR = NB * NCH;
constexpr int NEXP = 16, FF = 512;
constexpr float EPS = 1e-6f;
constexpr float LOG2E = 1.4426950408889634f;
constexpr float C2 = 0.125f * LOG2E;
constexpr int NWAVES = 8;

constexpr size_t MiB = 1u << 20;
constexpr size_t WS_CTL = 0, CTL_ZERO_BYTES = 1 * MiB;
constexpr size_t WS_MOD = 1 * MiB;
constexpr size_t WS_LIST = 2 * MiB;
constexpr size_t WS_RW = 5 * MiB;
constexpr size_t WS_CTXS = 6 * MiB;
constexpr size_t WS_SST = 10 * MiB;
constexpr size_t WS_HB8 = WS_SST;
constexpr size_t WS_XST = 44 * MiB;
constexpr size_t WS_BT1 = 61 * MiB;
constexpr size_t WS_BT2 = 85 * MiB;
constexpr size_t WS_WIN = 93 * MiB;
constexpr size_t WS_WIN8 = WS_WIN + (size_t)2816 * 1024 * 2;
constexpr size_t WS_WGLU = 105 * MiB;
constexpr size_t WS_WBR = 106 * MiB;
constexpr size_t WS_WOUT = 109 * MiB;
constexpr size_t WS_MOE1 = 111 * MiB;
constexpr size_t WS_MOE2 = 143 * MiB;
constexpr size_t WS_HB = 159 * MiB;
constexpr size_t WS_U = 225 * MiB;
constexpr size_t WS_QA = 258 * MiB;
constexpr size_t WS_KA = 291 * MiB;
constexpr size_t WS_VA = 300 * MiB;
constexpr size_t WS_QN = 309 * MiB;
constexpr size_t WS_KN = 342 * MiB;
constexpr size_t WS_VN = 375 * MiB;
constexpr size_t WS_YS = 408 * MiB;
constexpr size_t WS_GATES = 441 * MiB;
constexpr size_t WS_ACT = WS_QN;
constexpr size_t WS_ACTB = WS_QN;
constexpr size_t WS_YSLOT = WS_GATES;
constexpr size_t WS_AO = 574 * MiB;
constexpr size_t WS_NO = 607 * MiB;
constexpr size_t WS_YG = 640 * MiB;
constexpr size_t WS_END = 673 * MiB;
static_assert(WS_GATES + (size_t)T * 3072 * (GATE_BF16 ? 2 : 1) <= WS_AO && WS_YSLOT + (size_t)2 * T * 1024 * 2 <= WS_AO && WS_ACT + (size_t)(2 * T + 4096) * 512 * 2 <= WS_YS, "ws map");
constexpr int CW_FAIL = 8;
constexpr int CW_CNT = 64;
constexpr int CW_BAR = 8192;

constexpr int RING_BYTES = 131072, LDS_BYTES = 147456, LDSCTL_OFF = LDS_BYTES - 512, MISC_OFF = LDSCTL_OFF + 320;

__device__ __forceinline__ unsigned f2bf(float f) { unsigned u = __builtin_bit_cast(unsigned, f); return (u + 0x7fffu + ((u >> 16) & 1u)) >> 16; }
__device__ __forceinline__ unsigned pk2(float lo, float hi) { return f2bf(lo) | (f2bf(hi) << 16); }
__device__ __forceinline__ float bf2f(unsigned b) { return __builtin_bit_cast(float, b << 16); }
__device__ __forceinline__ float bflo(unsigned w) { return __builtin_bit_cast(float, w << 16); }
__device__ __forceinline__ float bfhi(unsigned w) { return __builtin_bit_cast(float, w & 0xffff0000u); }
typedef float f32x2_c __attribute__((ext_vector_type(2))); typedef __bf16 bf16x2_c __attribute__((ext_vector_type(2)));
__device__ __forceinline__ unsigned cvt_pk_bf16(float lo, float hi) { const f32x2_c v = {lo, hi}; return __builtin_bit_cast(unsigned, __builtin_convertvector(v, bf16x2_c)); }
typedef int v8i __attribute__((ext_vector_type(8)));
typedef int v4i __attribute__((ext_vector_type(4)));
__device__ __forceinline__ float clamp8(float x) { return __builtin_fminf(__builtin_fmaxf(x, -448.f), 448.f); }
__device__ __forceinline__ unsigned pk4_fp8(float a, float b, float c, float d) { int w = 0; w = __builtin_amdgcn_cvt_pk_fp8_f32(clamp8(a), clamp8(b), w, false); w = __builtin_amdgcn_cvt_pk_fp8_f32(clamp8(c), clamp8(d), w, true); return (unsigned)w; }
__device__ __forceinline__ float fsigmoid(float x) { return __builtin_amdgcn_rcpf(1.f + __builtin_amdgcn_exp2f(-LOG2E * x)); }
__device__ __forceinline__ float gelu_tanh(float x) { const float u = 0.7978845608f * (x + 0.044715f * x * x * x); return x * __builtin_amdgcn_rcpf(1.f + __builtin_amdgcn_exp2f(-2.f * LOG2E * u)); }
__device__ __forceinline__ float shflx(float v, int m, int lane) { return __builtin_bit_cast(float, __builtin_amdgcn_ds_bpermute((lane ^ m) << 2, __builtin_bit_cast(int, v))); }
template <int CTRL, int RM>
__device__ __forceinline__ float dpp_mov(float v) { return __builtin_bit_cast(float, __builtin_amdgcn_update_dpp(0, __builtin_bit_cast(int, v), CTRL, RM, 0xF, true)); }
__device__ __forceinline__ float wave_sum(float v, int) {
    v += dpp_mov<0xB1, 0xF>(v);
    v += dpp_mov<0x4E, 0xF>(v);
    v += dpp_mov<0x141, 0xF>(v);
    v += dpp_mov<0x140, 0xF>(v);
    v += dpp_mov<0x142, 0xA>(v);
    v += dpp_mov<0x143, 0xC>(v);
    return __builtin_bit_cast(float, __builtin_amdgcn_readlane(__builtin_bit_cast(int, v), 63));
}
__device__ __forceinline__ float sin_rev(float r) { r = r - floorf(r); return __builtin_amdgcn_sinf(r); }
__device__ __forceinline__ float cos_rev(float r) { r = r - floorf(r); return __builtin_amdgcn_cosf(r); }

#define XB_TMO      128
#define XB_XCNT(j)  (256  + 64 * (j))
#define XB_XSUB(j)  (1280 + 64 * (j))
#define XB_XGEN(j)  (2304 + 64 * (j))
#define XB_TOP      3328
#define XB_TOPGEN   3392
#define XCD_BAR_WORDS 3456
#define XB_SPIN_CAP (1u << 22)

__device__ __forceinline__ unsigned xb_ld(unsigned* p)              { return __hip_atomic_load(p, __ATOMIC_RELAXED, __HIP_MEMORY_SCOPE_AGENT); }
__device__ __forceinline__ unsigned xb_add(unsigned* p, unsigned v) { return __hip_atomic_fetch_add(p, v, __ATOMIC_RELAXED, __HIP_MEMORY_SCOPE_AGENT); }
__device__ __forceinline__ unsigned xb_xcc_id() { return (unsigned)__builtin_amdgcn_s_getreg((3 << 11) | 20) & 0xFu; }
#define XB_SPIN(cond, bar) do { unsigned _sp = 0; while (cond) { __builtin_amdgcn_s_sleep(1); \
    if ((++_sp & 255u) == 0u) { if (xb_ld(&(bar)[XB_TMO])) break; if (_sp > XB_SPIN_CAP) { atomicAdd(&(bar)[XB_TMO], 1u); break; } } } } while (0)

struct XcdBarrier { unsigned* bar; unsigned x; volatile LAS unsigned* st; };

__device__ __forceinline__ XcdBarrier xcd_barrier_post(unsigned* bar, volatile LAS unsigned* st) {
    XcdBarrier b; b.bar = bar; b.x = xb_xcc_id(); b.st = st;
    if (threadIdx.x == 0) (void)xb_add(&bar[XB_XCNT(b.x)], 1u);
    return b;
}
__device__ __forceinline__ void xcd_barrier_complete(unsigned* bar, unsigned x, unsigned& nloc, unsigned& nx) {
    const unsigned G = gridDim.x * gridDim.y * gridDim.z;
    unsigned sum, cnt, mine, sp = 0u;
    for (;;) {
        sum = 0u; cnt = 0u; mine = 0u;
#pragma unroll
        for (unsigned j = 0; j < 16; ++j) { const unsigned c = xb_ld(&bar[XB_XCNT(j)]); sum += c; cnt += (c > 0u) ? 1u : 0u; mine = (j == x) ? c : mine; }
        if (sum == G) break;
        __builtin_amdgcn_s_sleep(1);
        if ((++sp & 255u) == 0u) { if (xb_ld(&bar[XB_TMO])) break; if (sp > XB_SPIN_CAP) { atomicAdd(&bar[XB_TMO], 1u); break; } }
    }
    nloc = mine > 0u ? mine : 1u; nx = cnt > 0u ? cnt : 1u;
}
__device__ __forceinline__ void xcd_barrier(const XcdBarrier& b) {
    asm volatile("s_waitcnt vmcnt(0)" ::: "memory");
    __syncthreads();
    if (threadIdx.x == 0) {
        unsigned* bar = b.bar;
        __builtin_amdgcn_s_waitcnt(0);
        unsigned nloc = b.st[0], nx = b.st[1];
        if (nloc == 0u) { xcd_barrier_complete(bar, b.x, nloc, nx); b.st[0] = nloc; b.st[1] = nx; }
        const unsigned old = xb_add(&bar[XB_XSUB(b.x)], 1u);
        const unsigned gen = old / nloc;
        if (old + 1u == (gen + 1u) * nloc) {
            __builtin_amdgcn_fence(__ATOMIC_RELEASE, "agent");
            asm volatile("s_waitcnt vmcnt(0)" ::: "memory");
            const unsigned og = xb_add(&bar[XB_TOP], 1u);
            const unsigned tg = og / nx;
            if (og + 1u == (tg + 1u) * nx) xb_add(&bar[XB_TOPGEN], 1u);
            else XB_SPIN(xb_ld(&bar[XB_TOPGEN]) == tg, bar);
            __builtin_amdgcn_fence(__ATOMIC_ACQUIRE, "agent");
            xb_add(&bar[XB_XGEN(b.x)], 1u);
            asm volatile("s_waitcnt vmcnt(0)" ::: "memory");
        } else {
            XB_SPIN(xb_ld(&bar[XB_XGEN(b.x)]) == gen, bar);
            __builtin_amdgcn_fence(__ATOMIC_ACQUIRE, "agent");
            asm volatile("s_waitcnt vmcnt(0)" ::: "memory");
        }
    }
    __syncthreads();
}

namespace pg8 {
constexpr int BM = 256, BK = 64, HALF = 128, HTB = HALF * BK * 2, STAGE_BYTES = 8 * HTB, NXCD = 8, WGM = 8;
__host__ __device__ __forceinline__ int lds_byte(int r, int c) { const int st = (r >> 4) * 2 + (c >> 5), rr = r & 15, cc = c & 31, ob = rr * 64 + cc * 2; return st * 1024 + (ob ^ (((ob >> 9) & 1) << 5)); }
__host__ __device__ __forceinline__ void stage_rc(int b, int& R, int& C) { const int st = b / 1024, sb = b % 1024, swz = sb ^ (((sb >> 9) & 1) << 5); R = (st >> 1) * 16 + swz / 64; C = (st & 1) * 32 + (swz % 64) / 2; }
__host__ __device__ __forceinline__ int perm32(int rho) { const int n = rho >> 4, i = rho & 15; return 8 * (i >> 2) + 4 * n + (i & 3); }

struct Unit { int pm, pn, z; };

__device__ __forceinline__ void static_decode(int L, int nM, int nN, int& pm, int& pn) {
    const int nwg = nM * nN; int wgid = L;
    { const int q = nwg / NXCD, r = nwg % NXCD, xcd = wgid % NXCD, off = wgid / NXCD; wgid = (xcd < r ? xcd * (q + 1) : r * (q + 1) + (xcd - r) * q) + off; }
    const int nig = WGM * nN, gid = wgid / nig, fm = gid * WGM, gsz = (nM - fm) < WGM ? (nM - fm) : WGM;
    pm = fm + ((wgid % nig) % gsz); pn = (wgid % nig) / gsz;
}

template <class P>
__device__ __forceinline__ void gemm_phase(LAS unsigned char* lds, const P& S) {
    int tid_ = threadIdx.x; asm volatile("" : "+v"(tid_));
    const int tid = tid_, wid = __builtin_amdgcn_readfirstlane(tid >> 6), lane = tid & 63, wr = wid >> 2, wc = wid & 3, fr = lane & 15, fq = lane >> 4;
    constexpr int ELB = P::FP8 ? 1 : 2;
    const int K = S.K; int nt = K * ELB / 128; asm volatile("" : "+s"(nt));
    unsigned voffB[2];
#pragma unroll
    for (int i = 0; i < 2; ++i) { int R, C; stage_rc(tid * 16 + i * 8192, R, C); const int Rb = (R & ~31) + perm32(R & 31); voffB[i] = (unsigned)(Rb * K * ELB + C * 2); }
#define PG8_AOFF(dst0, dst1, u) do { _Pragma("unroll") for (int i = 0; i < 2; ++i) { int R, C; stage_rc(tid * 16 + i * 8192, R, C); dst0[i] = S.a_off(u, 0, R, C); dst1[i] = S.a_off(u, 1, R, C); } } while (0)
    const size_t kstepB = (size_t)(BK * 2), hstepB = (size_t)HALF * K * ELB, kstepA = (size_t)S.kstepA;
    const unsigned ldsw = (unsigned)wid * 1024u;
    const int aoff = lds_byte(wr * 64 + fr, fq * 8), boff = lds_byte(wc * 32 + fr, fq * 8);
#define PG8_SA(b, h) (((b) * 2 + (h)) * HTB)
#define PG8_SB(b, h) ((4 + (b) * 2 + (h)) * HTB)
#define PG8_STAGE(bufoff, gbase, voff) do { _Pragma("unroll") for (int _i = 0; _i < 2; ++_i) \
        __builtin_amdgcn_global_load_lds((const unsigned*)((const char*)(gbase) + (voff)[_i]), (LAS unsigned*)(lds + (bufoff) + ldsw + _i * 8192), 16, 0, 0); } while (0)
#define PG8_LDA(dst, b, h) do { _Pragma("unroll") for (int m = 0; m < 4; ++m) _Pragma("unroll") for (int k = 0; k < 2; ++k) dst[m][k] = *(const LAS bf16x8*)(lds + PG8_SA(b, h) + aoff + m * 2048 + k * 1024); } while (0)
#define PG8_LDB(dst, b, h) do { _Pragma("unroll") for (int n = 0; n < 2; ++n) _Pragma("unroll") for (int k = 0; k < 2; ++k) dst[n][k] = *(const LAS bf16x8*)(lds + PG8_SB(b, h) + boff + n * 2048 + k * 1024); } while (0)
#define PG8_CAT(x0, x1) __builtin_shufflevector(__builtin_bit_cast(v4i, x0), __builtin_bit_cast(v4i, x1), 0, 1, 2, 3, 4, 5, 6, 7)
#define PG8_MMA(ai, bj, At, Bt) do { __builtin_amdgcn_s_setprio(1); _Pragma("unroll") for (int m = 0; m < 4; ++m) _Pragma("unroll") for (int n = 0; n < 2; ++n) { \
        if constexpr (P::FP8) acc[ai][bj][m][n] = __builtin_amdgcn_mfma_scale_f32_16x16x128_f8f6f4(PG8_CAT(Bt[n][0], Bt[n][1]), PG8_CAT(At[m][0], At[m][1]), acc[ai][bj][m][n], 0, 0, 0, 0x7f7f7f7f, 0, 0x7f7f7f7f); \
        else { _Pragma("unroll") for (int k = 0; k < 2; ++k) acc[ai][bj][m][n] = __builtin_amdgcn_mfma_f32_16x16x32_bf16(Bt[n][k], At[m][k], acc[ai][bj][m][n], 0, 0, 0); } } __builtin_amdgcn_s_setprio(0); } while (0)
#define PG8_WAIT_V(n) asm volatile("s_waitcnt vmcnt(" #n ")" ::: "memory")
#define PG8_WAIT_L(n) asm volatile("s_waitcnt lgkmcnt(" #n ")" ::: "memory")
#define PG8_BAR __builtin_amdgcn_s_barrier()
#define PG8_SCHED __builtin_amdgcn_sched_barrier(0)
    Unit cur, nxt; int ui = 0;
    if (!S.next(0, cur)) return;
    f32x4 acc[2][2][4][2];
#pragma unroll
    for (int a = 0; a < 2; ++a)
#pragma unroll
        for (int b = 0; b < 2; ++b)
#pragma unroll
            for (int m = 0; m < 4; ++m)
#pragma unroll
                for (int n = 0; n < 2; ++n) acc[a][b][m][n] = (f32x4){0.f, 0.f, 0.f, 0.f};
    bf16x8 At[4][2], B0[2][2], B1[2][2];
    unsigned vA0[2], vA1[2], vN0[2], vN1[2];
    PG8_AOFF(vA0, vA1, cur);
    const char* cA = S.a_base(cur); const char* cB = S.b_base(cur);
    PG8_STAGE(PG8_SB(0, 0), cB, voffB); PG8_STAGE(PG8_SB(0, 1), cB + hstepB, voffB); PG8_STAGE(PG8_SA(0, 0), cA, vA0); PG8_STAGE(PG8_SA(0, 1), cA, vA1);
    if (wr == 1) PG8_BAR;
    PG8_WAIT_V(2); PG8_BAR;
    PG8_STAGE(PG8_SB(1, 0), cB + kstepB, voffB); PG8_STAGE(PG8_SA(1, 0), cA + kstepA, vA0); PG8_STAGE(PG8_SB(1, 1), cB + hstepB + kstepB, voffB);
    PG8_WAIT_V(6); PG8_BAR;
    for (;;) {
        const bool has_next = S.next(ui + 1, nxt);
        const char* nA = cA; const char* nB = cB;
        if (has_next) { nA = S.a_base(nxt); nB = S.b_base(nxt); if (P::EARLY_AOFF) PG8_AOFF(vN0, vN1, nxt); }
        for (int t = 0; t < nt; t += 2) {
            const bool last = (t == nt - 2);
            const char* a1 = cA + (size_t)(t + 1) * kstepA;
            const char* a2 = last ? nA : cA + (size_t)(t + 2) * kstepA; const char* b2 = last ? nB : cB + (size_t)(t + 2) * kstepB;
            const char* a3 = a2 + kstepA; const char* b3 = b2 + kstepB;
            PG8_LDB(B0, 0, 0); PG8_LDB(B1, 0, 1); PG8_SCHED; PG8_LDA(At, 0, 0); PG8_STAGE(PG8_SA(1, 1), a1, vA1);
            if (last && has_next) {
                if (P::EARLY_AOFF) { _Pragma("unroll") for (int i = 0; i < 2; ++i) { vA0[i] = vN0[i]; vA1[i] = vN1[i]; } } else PG8_AOFF(vA0, vA1, nxt); }
            PG8_WAIT_V(8); PG8_WAIT_L(0); PG8_BAR; PG8_MMA(0, 0, At, B0); PG8_MMA(0, 1, At, B1); PG8_BAR; PG8_SCHED;
            PG8_LDA(At, 0, 1); PG8_STAGE(PG8_SB(0, 0), b2, voffB); PG8_STAGE(PG8_SB(0, 1), b2 + hstepB, voffB); PG8_STAGE(PG8_SA(0, 0), a2, vA0);
            PG8_WAIT_V(8); PG8_WAIT_L(0); PG8_BAR; PG8_MMA(1, 0, At, B0); PG8_MMA(1, 1, At, B1); PG8_BAR; PG8_SCHED;
            PG8_LDB(B0, 1, 0); PG8_LDB(B1, 1, 1); PG8_SCHED; PG8_LDA(At, 1, 0); PG8_STAGE(PG8_SA(0, 1), a2, vA1);
            PG8_WAIT_V(8); PG8_WAIT_L(0); PG8_BAR; PG8_MMA(0, 0, At, B0); PG8_MMA(0, 1, At, B1); PG8_BAR; PG8_SCHED;
            PG8_LDA(At, 1, 1); PG8_STAGE(PG8_SB(1, 0), b3, voffB); PG8_STAGE(PG8_SB(1, 1), b3 + hstepB, voffB); PG8_STAGE(PG8_SA(1, 0), a3, vA0);
            PG8_WAIT_V(8); PG8_WAIT_L(0); PG8_BAR; PG8_MMA(1, 0, At, B0); PG8_MMA(1, 1, At, B1); PG8_BAR; PG8_SCHED;
        }
        if (wr == 0) PG8_BAR;
        S.epi(acc, cur, wr, wc, fr, fq);
        if (!has_next) break;
#pragma unroll
        for (int a = 0; a < 2; ++a)
#pragma unroll
            for (int b = 0; b < 2; ++b)
#pragma unroll
                for (int m = 0; m < 4; ++m)
#pragma unroll
                    for (int n = 0; n < 2; ++n) acc[a][b][m][n] = (f32x4){0.f, 0.f, 0.f, 0.f};
        cur = nxt; cA = nA; cB = nB; ++ui;
        if (wr == 1) PG8_BAR;
    }
    PG8_WAIT_V(0);
    PG8_BAR;
#undef PG8_AOFF
#undef PG8_SA
#undef PG8_SB
#undef PG8_STAGE
#undef PG8_LDA
#undef PG8_LDB
#undef PG8_MMA
#undef PG8_CAT
#undef PG8_WAIT_V
#undef PG8_WAIT_L
#undef PG8_BAR
#undef PG8_SCHED
}

template <class P>
__device__ __forceinline__ void gemm_phase_m128(LAS unsigned char* lds, const P& S) {
    int tid_ = threadIdx.x; asm volatile("" : "+v"(tid_));
    const int tid = tid_, wid = __builtin_amdgcn_readfirstlane(tid >> 6), lane = tid & 63, wr = wid >> 2, wc = wid & 3, fr = lane & 15, fq = lane >> 4;
    constexpr int ELB = P::FP8 ? 1 : 2;
    const int K = S.K; int nt = K * ELB / 128; asm volatile("" : "+s"(nt));
    unsigned voffB[2];
#pragma unroll
    for (int i = 0; i < 2; ++i) { int R, C; stage_rc(tid * 16 + i * 8192, R, C); const int Rb = (R & ~31) + perm32(R & 31); voffB[i] = (unsigned)(Rb * K * ELB + C * 2); }
#define PG8_AOFF(dst0, u) do { _Pragma("unroll") for (int i = 0; i < 2; ++i) { int R, C; stage_rc(tid * 16 + i * 8192, R, C); dst0[i] = S.a_off(u, R, C); } } while (0)
    const size_t kstepB = (size_t)(BK * 2), hstepB = (size_t)HALF * K * ELB, kstepA = (size_t)S.kstepA;
    const unsigned ldsw = (unsigned)wid * 1024u;
    const int aoff = lds_byte(wr * 64 + fr, fq * 8), boff = lds_byte(wc * 32 + fr, fq * 8);
#define PG8_SA(b) (((b) * 2) * HTB)
#define PG8_SB(b, h) ((4 + (b) * 2 + (h)) * HTB)
#define PG8_STAGE(bufoff, gbase, voff) do { _Pragma("unroll") for (int _i = 0; _i < 2; ++_i) \
        __builtin_amdgcn_global_load_lds((const unsigned*)((const char*)(gbase) + (voff)[_i]), (LAS unsigned*)(lds + (bufoff) + ldsw + _i * 8192), 16, 0, 0); } while (0)
#define PG8_LDA(dst, b) do { _Pragma("unroll") for (int m = 0; m < 4; ++m) _Pragma("unroll") for (int k = 0; k < 2; ++k) dst[m][k] = *(const LAS bf16x8*)(lds + PG8_SA(b) + aoff + m * 2048 + k * 1024); } while (0)
#define PG8_LDB(dst, b, h) do { _Pragma("unroll") for (int n = 0; n < 2; ++n) _Pragma("unroll") for (int k = 0; k < 2; ++k) dst[n][k] = *(const LAS bf16x8*)(lds + PG8_SB(b, h) + boff + n * 2048 + k * 1024); } while (0)
#define PG8_CAT(x0, x1) __builtin_shufflevector(__builtin_bit_cast(v4i, x0), __builtin_bit_cast(v4i, x1), 0, 1, 2, 3, 4, 5, 6, 7)
#define PG8_MMA(bj, At, Bt) do { __builtin_amdgcn_s_setprio(1); _Pragma("unroll") for (int m = 0; m < 4; ++m) _Pragma("unroll") for (int n = 0; n < 2; ++n) { \
        if constexpr (P::FP8) acc[bj][m][n] = __builtin_amdgcn_mfma_scale_f32_16x16x128_f8f6f4(PG8_CAT(Bt[n][0], Bt[n][1]), PG8_CAT(At[m][0], At[m][1]), acc[bj][m][n], 0, 0, 0, 0x7f7f7f7f, 0, 0x7f7f7f7f); \
        else { _Pragma("unroll") for (int k = 0; k < 2; ++k) acc[bj][m][n] = __builtin_amdgcn_mfma_f32_16x16x32_bf16(Bt[n][k], At[m][k], acc[bj][m][n], 0, 0, 0); } } __builtin_amdgcn_s_setprio(0); } while (0)
#define PG8_WAIT_V(n) asm volatile("s_waitcnt vmcnt(" #n ")" ::: "memory")
#define PG8_WAIT_L(n) asm volatile("s_waitcnt lgkmcnt(" #n ")" ::: "memory")
#define PG8_BAR __builtin_amdgcn_s_barrier()
#define PG8_SCHED __builtin_amdgcn_sched_barrier(0)
    Unit cur, nxt; int ui = 0;
    if (!S.next(0, cur)) return;
    f32x4 acc[2][4][2], st[2][4][2];
#pragma unroll
    for (int a = 0; a < 2; ++a)
#pragma unroll
        for (int m = 0; m < 4; ++m)
#pragma unroll
            for (int n = 0; n < 2; ++n) { acc[a][m][n] = (f32x4){0.f, 0.f, 0.f, 0.f}; st[a][m][n] = (f32x4){0.f, 0.f, 0.f, 0.f}; }
    bf16x8 At[4][2], B0[2][2];
    unsigned vA[2], vN[2];
    PG8_AOFF(vA, cur);
    const char* cA = S.a_base(cur); const char* cB = S.b_base(cur);
    PG8_STAGE(PG8_SB(0, 0), cB, voffB); PG8_STAGE(PG8_SA(0), cA, vA); PG8_STAGE(PG8_SB(0, 1), cB + hstepB, voffB);
    if (wr == 1) PG8_BAR;
    PG8_WAIT_V(2); PG8_BAR;
    PG8_STAGE(PG8_SB(1, 0), cB + kstepB, voffB); PG8_STAGE(PG8_SA(1), cA + kstepA, vA);
    PG8_WAIT_V(4); PG8_BAR;
    for (;;) {
        const bool has_next = S.next(ui + 1, nxt);
        const char* nA = cA; const char* nB = cB;
        if (has_next) { nA = S.a_base(nxt); nB = S.b_base(nxt); if (P::EARLY_AOFF) PG8_AOFF(vN, nxt); }
        for (int t = 0; t < nt; t += 2) {
            const bool last = (t == nt - 2);
            const char* b1 = cB + (size_t)(t + 1) * kstepB;
            const char* a2 = last ? nA : cA + (size_t)(t + 2) * kstepA; const char* b2 = last ? nB : cB + (size_t)(t + 2) * kstepB;
            const char* a3 = a2 + kstepA; const char* b3 = b2 + kstepB;
            PG8_LDB(B0, 0, 0); PG8_SCHED; PG8_LDA(At, 0); PG8_STAGE(PG8_SB(1, 1), b1 + hstepB, voffB);
            if (last && has_next) { if (P::EARLY_AOFF) { vA[0] = vN[0]; vA[1] = vN[1]; } else PG8_AOFF(vA, nxt); }
            PG8_WAIT_V(6); PG8_WAIT_L(0); PG8_BAR; PG8_MMA(0, At, B0); PG8_BAR; PG8_SCHED;
            PG8_LDB(B0, 0, 1); PG8_STAGE(PG8_SB(0, 0), b2, voffB); PG8_STAGE(PG8_SA(0), a2, vA);
            PG8_WAIT_V(6); PG8_WAIT_L(0); PG8_BAR; PG8_MMA(1, At, B0); PG8_BAR; PG8_SCHED;
            PG8_LDB(B0, 1, 0); PG8_SCHED; PG8_LDA(At, 1); PG8_STAGE(PG8_SB(0, 1), b2 + hstepB, voffB);
            PG8_WAIT_V(6); PG8_WAIT_L(0); PG8_BAR; PG8_MMA(0, At, B0); PG8_BAR; PG8_SCHED;
            PG8_LDB(B0, 1, 1); PG8_STAGE(PG8_SB(1, 0), b3, voffB); PG8_STAGE(PG8_SA(1), a3, vA);
            PG8_WAIT_V(6); PG8_WAIT_L(0); PG8_BAR; PG8_MMA(1, At, B0); PG8_BAR; PG8_SCHED;
        }
        if (wr == 0) PG8_BAR;
        S.epi(acc, st, cur, wr, wc, fr, fq);
        if (!has_next) break;
#pragma unroll
        for (int a = 0; a < 2; ++a)
#pragma unroll
            for (int m = 0; m < 4; ++m)
#pragma unroll
                for (int n = 0; n < 2; ++n) acc[a][m][n] = (f32x4){0.f, 0.f, 0.f, 0.f};
        cur = nxt; cA = nA; cB = nB; ++ui;
        if (wr == 1) PG8_BAR;
    }
    PG8_WAIT_V(0);
    PG8_BAR;
#undef PG8_AOFF
#undef PG8_SA
#undef PG8_SB
#undef PG8_STAGE
#undef PG8_LDA
#undef PG8_LDB
#undef PG8_MMA
#undef PG8_CAT
#undef PG8_WAIT_V
#undef PG8_WAIT_L
#undef PG8_BAR
#undef PG8_SCHED
}
}
namespace attn_body {
using bf16x8 = __attribute__((ext_vector_type(8))) short;
using u32x4 = __attribute__((ext_vector_type(4))) unsigned;
constexpr int NW = 8, QBLK = 32, QB = QBLK * NW, KVBLK = 64;
__device__ __forceinline__ int crow(int r, int hi) { return (r & 3) + 8 * (r >> 2) + 4 * hi; }
#define SBAR() __builtin_amdgcn_sched_barrier(0)
constexpr int NSLOT = 3, SLOTB = 8192;
constexpr int LDS_K = 0, LDS_V = NSLOT * SLOTB, LDS_WS = 2 * NSLOT * SLOTB, LDS_OST = LDS_WS + NW * 64 * 4, LDS_BYTES = LDS_OST + NW * 4096;
constexpr int LDS_BT = 86016 + 256;
__device__ __forceinline__ void glds16(const void* gsrc, unsigned lds_dst) { unsigned keep;
  asm volatile("s_mov_b32 %0, m0\n\ts_mov_b32 m0, %2\n\ts_nop 0\n\tglobal_load_lds_dwordx4 %1, off\n\ts_mov_b32 m0, %0" : "=&s"(keep) : "v"(gsrc), "s"(lds_dst) : "memory"); }
__device__ __forceinline__ float max3f(float a, float b, float c) { float r; asm("v_max3_f32 %0, %1, %2, %3" : "=v"(r) : "v"(a), "v"(b), "v"(c)); return r; }
__device__ __forceinline__ float max2f(float a, float b) { float r; asm("v_max_f32_e32 %0, %1, %2" : "=v"(r) : "v"(a), "v"(b)); return r; }
__device__ __forceinline__ float fadd_s(float a, float b) { float r; asm("v_add_f32_e32 %0, %1, %2" : "=v"(r) : "v"(a), "v"(b)); return r; }
__device__ __forceinline__ float fsub_s(float a, float b) { float r; asm("v_sub_f32_e32 %0, %1, %2" : "=v"(r) : "v"(a), "v"(b)); return r; }
typedef float f32x2_t __attribute__((ext_vector_type(2))); typedef __bf16 bf16x2_t __attribute__((ext_vector_type(2)));
__device__ __forceinline__ unsigned cvtpk_s(float lo, float hi) { f32x2_t v = {lo, hi}; bf16x2_t b = __builtin_convertvector(v, bf16x2_t); return __builtin_bit_cast(unsigned, b); }
#define WAIT_BAR(N) asm volatile("s_waitcnt vmcnt(" #N ") lgkmcnt(0)\n\ts_barrier" ::: "memory")

__device__ __forceinline__ void qkt(f32x16& p0, f32x16& p1, const char* Kslot, const bf16x8* qr, const f32x16& negm, int r32, int hi) {
  const char* kb = Kslot + hi * 1024 + r32 * 16;
  #pragma unroll
  for (int d0 = 0; d0 < 4; ++d0) {
    const bf16x8 b0 = *reinterpret_cast<const bf16x8*>(kb + d0 * 2048);
    const bf16x8 b1 = *reinterpret_cast<const bf16x8*>(kb + d0 * 2048 + 512);
    if (d0 == 0) { p0 = __builtin_amdgcn_mfma_f32_32x32x16_bf16(b0, qr[0], negm, 0, 0, 0); p1 = __builtin_amdgcn_mfma_f32_32x32x16_bf16(b1, qr[0], negm, 0, 0, 0); }
    else { p0 = __builtin_amdgcn_mfma_f32_32x32x16_bf16(b0, qr[d0], p0, 0, 0, 0); p1 = __builtin_amdgcn_mfma_f32_32x32x16_bf16(b1, qr[d0], p1, 0, 0, 0); } }
}
typedef __attribute__((address_space(3))) const char* lds_cptr;
typedef short v4i16_t __attribute__((ext_vector_type(4)));
__device__ __forceinline__ void kload8(bf16x8* kf, lds_cptr kp) {
  kf[0] = *(const __attribute__((address_space(3))) bf16x8*)(kp);        kf[1] = *(const __attribute__((address_space(3))) bf16x8*)(kp + 512);
  kf[2] = *(const __attribute__((address_space(3))) bf16x8*)(kp + 2048); kf[3] = *(const __attribute__((address_space(3))) bf16x8*)(kp + 2560);
  kf[4] = *(const __attribute__((address_space(3))) bf16x8*)(kp + 4096); kf[5] = *(const __attribute__((address_space(3))) bf16x8*)(kp + 4608);
  kf[6] = *(const __attribute__((address_space(3))) bf16x8*)(kp + 6144); kf[7] = *(const __attribute__((address_space(3))) bf16x8*)(kp + 6656);
}
__device__ __forceinline__ void kload2(bf16x8* kf, lds_cptr kp, int j) { kf[2 * j] = *(const __attribute__((address_space(3))) bf16x8*)(kp + j * 2048); kf[2 * j + 1] = *(const __attribute__((address_space(3))) bf16x8*)(kp + j * 2048 + 512); }
__device__ __forceinline__ s16x4 vtr(lds_cptr p) { return __builtin_bit_cast(s16x4, __builtin_amdgcn_ds_read_tr16_b64_v4i16((__attribute__((address_space(3))) v4i16_t*)p)); }
__device__ __forceinline__ float rowmax(const f32x16& p0, const f32x16& p1) {
  float a = max3f(p0[0], p0[1], p1[0]), b = max3f(p0[2], p0[3], p1[1]); a = max3f(a, p1[2], p1[3]);
  #pragma unroll
  for (int r = 4; r < 16; r += 4) { a = max3f(a, p0[r], p0[r + 1]); b = max3f(b, p0[r + 2], p0[r + 3]); a = max3f(a, p1[r], p1[r + 1]); b = max3f(b, p1[r + 2], p1[r + 3]); }
  const float m = max2f(a, b);
  auto rr = __builtin_amdgcn_permlane32_swap(__float_as_uint(m), __float_as_uint(m), false, false);
  return max2f(__uint_as_float(rr[0]), __uint_as_float(rr[1]));
}
__device__ __forceinline__ void pv(f32x16* o, int vb, bf16x8 pa0, bf16x8 pa1, bf16x8 pa2, bf16x8 pa3) {
  #pragma unroll
  for (int d0 = 0; d0 < 2; ++d0) { s16x4 lo[4], hi[4];
    #pragma unroll
    for (int ks = 0; ks < 4; ++ks) {
      asm volatile("ds_read_b64_tr_b16 %0,%1 offset:%c2" : "=&v"(lo[ks]) : "v"(vb), "i"(d0 * 4096 + ks * 1024) : "memory");
      asm volatile("ds_read_b64_tr_b16 %0,%1 offset:%c2" : "=&v"(hi[ks]) : "v"(vb), "i"(d0 * 4096 + ks * 1024 + 512) : "memory"); }
    asm volatile("s_waitcnt lgkmcnt(0)" ::: "memory"); SBAR();
    #define PK(k) (bf16x8){lo[k][0], lo[k][1], lo[k][2], lo[k][3], hi[k][0], hi[k][1], hi[k][2], hi[k][3]}
    o[d0] = __builtin_amdgcn_mfma_f32_32x32x16_bf16(pa0, PK(0), o[d0], 0, 0, 0);
    o[d0] = __builtin_amdgcn_mfma_f32_32x32x16_bf16(pa1, PK(1), o[d0], 0, 0, 0);
    o[d0] = __builtin_amdgcn_mfma_f32_32x32x16_bf16(pa2, PK(2), o[d0], 0, 0, 0);
    o[d0] = __builtin_amdgcn_mfma_f32_32x32x16_bf16(pa3, PK(3), o[d0], 0, 0, 0);
    #undef PK
  }
}
#define ATTN_STORE16(p, v) (*(u32x4*)(p) = (v))

template <int THRL, bool NA, int QP_, int KVP_, bool NOMAX = false>
__device__ __forceinline__ void attn_unit(const bf16* Qu, int qp_rt, const bf16* __restrict__ Kh, const bf16* __restrict__ Vh, int kvp_rt, bf16* Ou, int NT, int r0, int rlo, char* shm) {
  const int qp = QP_ ? QP_ : qp_rt, kvp = KVP_ ? KVP_ : kvp_rt, op = qp;
  int tid_ = threadIdx.x; asm volatile("" : "+v"(tid_));
  const int tid = tid_, lane = tid & 63, r32 = lane & 31, hi = lane >> 5; const int wid = __builtin_amdgcn_readfirstlane(tid >> 6);
  const bf16* Qw = Qu + (long)(wid * QBLK) * qp;
  const unsigned lds0 = (unsigned)(uintptr_t)shm;
  float* wsf = (float*)(shm + LDS_WS) + wid * 64;
  const bf16* ksrc = Kh + (long)lane * kvp + wid * 8;
  const bf16* vsrc = Vh + (long)(16 * (wid & 3) + (lane >> 2)) * kvp + (wid >> 2) * 32 + (lane & 3) * 8;
  const unsigned kdst = lds0 + LDS_K + wid * 1024, vdst = lds0 + LDS_V + wid * 1024;
  #define TROW(t) (NA ? ((t) < 4 ? 64 * (t) : CTX + 64 * ((rlo + (t) - 4) < 127 ? (rlo + (t) - 4) : 127)) : 64 * (t))
  #define DMA_K(t, slot) glds16(ksrc + (long)TROW(t) * kvp, (unsigned)__builtin_amdgcn_readfirstlane(kdst + (slot)))
  #define DMA_V(t, slot) glds16(vsrc + (long)TROW(t) * kvp, (unsigned)__builtin_amdgcn_readfirstlane(vdst + (slot)))
  const int vb0 = (int)(lds0 + LDS_V) + ((lane >> 4) & 1) * 32 + (lane & 3) * 8 + (4 * hi + ((lane & 15) >> 2)) * 64;
  const char* Kbase = shm + LDS_K; bf16x8 kf[8];
  const lds_cptr shm3 = (lds_cptr)shm; const lds_cptr kp0 = shm3 + LDS_K + hi * 1024 + r32 * 16; const lds_cptr vp0 = shm3 + LDS_V + ((lane >> 4) & 1) * 32 + (lane & 3) * 8 + (4 * hi + ((lane & 15) >> 2)) * 64;
  const int rq = r0 + (wid >> 1), qc = 32 * (wid & 1) + r32;
  const int rsw = rq - 4 < 0 ? 0 : (rq - 4 > 120 ? 120 : rq - 4);
  const int cs = qc - 8 < 0 ? 0 : (qc - 8 > 48 ? 48 : qc - 8);
  const __attribute__((address_space(3))) float* btl = (const __attribute__((address_space(3))) float*)(shm3 + LDS_BT) + (15 + 4 * hi - qc);
  DMA_K(0, 0); DMA_V(0, 0); DMA_K(1, SLOTB);
  bf16x8 qr[4];
  #pragma unroll
  for (int d0 = 0; d0 < 4; ++d0) qr[d0] = *reinterpret_cast<const bf16x8*>(&Qw[(long)r32 * qp + d0 * 16 + hi * 8]);
  float mhat = 0.f, l_reg = 0.f; f32x16 o[2]; o[0] = f32x16{}; o[1] = f32x16{}; f32x16 negm = f32x16{}; if (!NA) asm volatile("" : "+v"(negm));
  #define NEGM (NA ? f32x16{} : negm)
  #define CMASK(P0, P1, t) do { if (NA) { if ((t) >= 4) { const int kr_ = rlo + (t) - 4; const int dr_ = kr_ - rsw; \
      if (dr_ < 0 || dr_ >= 8) { _Pragma("unroll") for (int r = 0; r < 16; ++r) { P0[r] = (-__builtin_inff()); P1[r] = (-__builtin_inff()); } } \
      else { const __attribute__((address_space(3))) float* bp_ = btl + (kr_ - rq + 7) * 31; const int kl0_ = 4 * hi - cs; \
        _Pragma("unroll") for (int rg = 0; rg < 4; ++rg) { \
          _Pragma("unroll") for (int rr_ = 0; rr_ < 4; ++rr_) { const int r = rg * 4 + rr_; const int kc_ = (r & 3) + 8 * (r >> 2); const float b0_ = bp_[kc_], b1_ = bp_[kc_ + 32]; \
            const int kl_ = kc_ + kl0_; P0[r] = ((unsigned)kl_ < 16u) ? P0[r] + b0_ : (-__builtin_inff()); P1[r] = ((unsigned)(kl_ + 32) < 16u) ? P1[r] + b1_ : (-__builtin_inff()); } \
          SBAR(); } } } } } while (0)
  bool resc = false;
  #define START(P0, P1) do { const float rm = NOMAX ? 0.f : rowmax(P0, P1); resc = false; \
    { const float dl = rm; mhat = fadd_s(mhat, dl); \
      _Pragma("unroll") for (int r = 0; r < 16; ++r) { P0[r] = fsub_s(P0[r], dl); P1[r] = fsub_s(P1[r], dl); } \
      if (!NA) { _Pragma("unroll") for (int r = 0; r < 16; ++r) negm[r] = -mhat; asm volatile("" : "+v"(negm)); } } \
    _Pragma("unroll") for (int r = 0; r < 16; ++r) P0[r] = __builtin_amdgcn_exp2f(P0[r]); } while (0)
  #define RESC() do { if (resc) { asm volatile("s_waitcnt lgkmcnt(0)" ::: "memory"); \
      _Pragma("unroll") for (int d_ = 0; d_ < 2; ++d_) _Pragma("unroll") for (int r = 0; r < 16; ++r) o[d_][r] *= wsf[crow(r, hi)]; } } while (0)
  f32x16 pA0, pA1, pB0, pB1;
  int sl_prev = 0, sl_cur = 0, sl_next = SLOTB;
  #define ROT() do { sl_prev = sl_cur; sl_cur = sl_next; sl_next = (sl_next == (NSLOT - 1) * SLOTB) ? 0 : sl_next + SLOTB; } while (0)
  DMA_K(2, 2 * SLOTB);
  WAIT_BAR(3);
  qkt(pA0, pA1, Kbase, qr, NEGM, r32, hi); asm volatile("s_nop 15\n\ts_nop 7" : "+v"(pA0), "+v"(pA1));
  START(pA0, pA1);
  _Pragma("unroll") for (int r = 0; r < 16; ++r) pA1[r] = __builtin_amdgcn_exp2f(pA1[r]);
  WAIT_BAR(0);
  DMA_K(3, 0); DMA_V(1, SLOTB);
  ROT();
  kload8(kf, kp0 + sl_cur);
  WAIT_BAR(2);
  s16x4 vlo[8], vhi[8]; u32x4 pw0, pw1, pw2, pw3;
  #define PKW(P, B) cvtpk_s(P[B], P[B + 1])
  #define PAF(k) __builtin_bit_cast(bf16x8, pw##k)
  #define VFR(i) (bf16x8){vlo[i][0], vlo[i][1], vlo[i][2], vlo[i][3], vhi[i][0], vhi[i][1], vhi[i][2], vhi[i][3]}
  #define PIN(x) asm volatile("" : "+v"(x))
  #define MX3(a, b, c) __builtin_fmaxf(__builtin_fmaxf((a), (b)), (c))
  #define GAPA(MF, A0, A1, A2, A3, W0, W1, PW) do { MF; sacc2 += (f32x2_t){A0, A1}; sacc2 += (f32x2_t){A2, A3}; PIN(sacc2); W0; W1; PIN(PW); SBAR(); } while (0)
  #define EX(v) __builtin_amdgcn_exp2f(v)
  #define GAPB(MF, X, B) do { MF; X[B] = EX(X[B]); X[B + 1] = EX(X[B + 1]); X[B + 2] = EX(X[B + 2]); X[B + 3] = EX(X[B + 3]); PIN(X); SBAR(); } while (0)
  #define VRD(i) do { vlo[i] = vtr(vp_ + (((i) >> 2) * 4096 + ((i) & 3) * 1024)); vhi[i] = vtr(vp_ + (((i) >> 2) * 4096 + ((i) & 3) * 1024 + 512)); } while (0)
  #define KRD(G, j) do { if (G) { kload2(kf, kp0 + sl_next, j); SBAR(); } } while (0)
  #define STEP(C0, C1, P0, P1, t, GK, GV, GL) do { SBAR(); \
    const lds_cptr vp_ = vp0 + sl_prev; \
    VRD(0); SBAR(); f32x2_t sacc2 = (f32x2_t){P0[0], P0[1]}; \
    GAPA(C0 = __builtin_amdgcn_mfma_f32_32x32x16_bf16(kf[0], qr[0], NEGM, 0, 0, 0), P0[2], P0[3], P0[4], P0[5],     pw0[0] = PKW(P0, 0), pw0[1] = PKW(P0, 2), pw0); \
    VRD(4); SBAR(); GAPA(C1 = __builtin_amdgcn_mfma_f32_32x32x16_bf16(kf[1], qr[0], NEGM, 0, 0, 0), P0[6], P0[7], P0[8], P0[9],     pw0[2] = PKW(P0, 4), pw0[3] = PKW(P0, 6), pw0); \
    VRD(1); SBAR(); GAPA(C0 = __builtin_amdgcn_mfma_f32_32x32x16_bf16(kf[2], qr[1], C0, 0, 0, 0),   P0[10], P0[11], P0[12], P0[13], pw1[0] = PKW(P0, 8), pw1[1] = PKW(P0, 10), pw1); \
    VRD(5); SBAR(); GAPA(C1 = __builtin_amdgcn_mfma_f32_32x32x16_bf16(kf[3], qr[1], C1, 0, 0, 0),   P0[14], P0[15], P1[0], P1[1],   pw1[2] = PKW(P0, 12), pw1[3] = PKW(P0, 14), pw1); \
    VRD(2); SBAR(); GAPA(C0 = __builtin_amdgcn_mfma_f32_32x32x16_bf16(kf[4], qr[2], C0, 0, 0, 0),   P1[2], P1[3], P1[4], P1[5],     pw2[0] = PKW(P1, 0), pw2[1] = PKW(P1, 2), pw2); \
    VRD(6); SBAR(); GAPA(C1 = __builtin_amdgcn_mfma_f32_32x32x16_bf16(kf[5], qr[2], C1, 0, 0, 0),   P1[6], P1[7], P1[8], P1[9],     pw2[2] = PKW(P1, 4), pw2[3] = PKW(P1, 6), pw2); \
    VRD(3); SBAR(); GAPA(C0 = __builtin_amdgcn_mfma_f32_32x32x16_bf16(kf[6], qr[3], C0, 0, 0, 0),   P1[10], P1[11], P1[12], P1[13], pw3[0] = PKW(P1, 8), pw3[1] = PKW(P1, 10), pw3); \
    VRD(7); SBAR(); GAPA(C1 = __builtin_amdgcn_mfma_f32_32x32x16_bf16(kf[7], qr[3], C1, 0, 0, 0),   P1[14], P1[15], 0.f, 0.f,       pw3[2] = PKW(P1, 12), pw3[3] = PKW(P1, 14), pw3); \
    l_reg += sacc2.x + sacc2.y; \
    if (GK) { DMA_K((t) + 3, sl_cur); } if (GV) { DMA_V((t) + 1, sl_next); } \
    resc = false; \
    if (NA) { _Pragma("unroll") for (int r = 0; r < 16; ++r) { C0[r] -= mhat; C1[r] -= mhat; } } \
    CMASK(C0, C1, t); \
    if (!NOMAX) { float a = MX3(C0[0], C0[1], C1[0]), b = MX3(C0[2], C0[3], C1[1]); a = MX3(a, C1[2], C1[3]); \
      _Pragma("unroll") for (int r = 4; r < 16; r += 4) { a = MX3(a, C0[r], C0[r + 1]); b = MX3(b, C0[r + 2], C0[r + 3]); a = MX3(a, C1[r], C1[r + 1]); b = MX3(b, C1[r + 2], C1[r + 3]); } \
      float rm = __builtin_fmaxf(a, b); { auto rr = __builtin_amdgcn_permlane32_swap(__float_as_uint(rm), __float_as_uint(rm), false, false); rm = __builtin_fmaxf(__uint_as_float(rr[0]), __uint_as_float(rr[1])); } \
      if (__builtin_expect(__any(rm > (float)THRL), 0)) { const float dl = __builtin_fmaxf(rm, 0.f); mhat += dl; \
        _Pragma("unroll") for (int r = 0; r < 16; ++r) { C0[r] -= dl; C1[r] -= dl; } \
        if (!NA) { _Pragma("unroll") for (int r = 0; r < 16; ++r) negm[r] = -mhat; asm volatile("" : "+v"(negm)); } \
        const float f = __builtin_amdgcn_exp2f(-dl); l_reg *= f; if (hi == 0) wsf[r32] = f; resc = true; } } \
    SBAR(); \
    GAPB(o[0] = __builtin_amdgcn_mfma_f32_32x32x16_bf16(PAF(0), VFR(0), o[0], 0, 0, 0), C0, 0); \
    GAPB(o[1] = __builtin_amdgcn_mfma_f32_32x32x16_bf16(PAF(0), VFR(4), o[1], 0, 0, 0), C0, 4); \
    KRD(GL, 0); GAPB(o[0] = __builtin_amdgcn_mfma_f32_32x32x16_bf16(PAF(1), VFR(1), o[0], 0, 0, 0), C0, 8); \
    KRD(GL, 1); GAPB(o[1] = __builtin_amdgcn_mfma_f32_32x32x16_bf16(PAF(1), VFR(5), o[1], 0, 0, 0), C0, 12); \
    KRD(GL, 2); GAPB(o[0] = __builtin_amdgcn_mfma_f32_32x32x16_bf16(PAF(2), VFR(2), o[0], 0, 0, 0), C1, 0); \
    KRD(GL, 3); GAPB(o[1] = __builtin_amdgcn_mfma_f32_32x32x16_bf16(PAF(2), VFR(6), o[1], 0, 0, 0), C1, 4); \
    GAPB(o[0] = __builtin_amdgcn_mfma_f32_32x32x16_bf16(PAF(3), VFR(3), o[0], 0, 0, 0), C1, 8); \
    GAPB(o[1] = __builtin_amdgcn_mfma_f32_32x32x16_bf16(PAF(3), VFR(7), o[1], 0, 0, 0), C1, 12); \
    } while (0)
  int t = 1;
  for (; t + 5 < NT; t += 2) {
    STEP(pB0, pB1, pA0, pA1, t, true, true, true);     WAIT_BAR(2); RESC(); ROT();
    STEP(pA0, pA1, pB0, pB1, t + 1, true, true, true); WAIT_BAR(2); RESC(); ROT();
  }
  #define ENDW(tt) do { if ((tt) + 3 < NT) { WAIT_BAR(2); } else if ((tt) + 2 < NT) { WAIT_BAR(1); } else { WAIT_BAR(0); } } while (0)
  for (; t + 1 < NT; t += 2) {
    STEP(pB0, pB1, pA0, pA1, t, (t + 3 < NT), (t + 1 < NT), (t + 1 < NT));         ENDW(t);     RESC(); ROT();
    STEP(pA0, pA1, pB0, pB1, t + 1, (t + 4 < NT), (t + 2 < NT), (t + 2 < NT));     ENDW(t + 1); RESC(); ROT();
  }
  STEP(pB0, pB1, pA0, pA1, NT - 1, false, false, false); RESC();
  { float sacc = pB0[0] + pB0[1]; _Pragma("unroll") for (int r = 2; r < 16; ++r) sacc += pB0[r]; _Pragma("unroll") for (int r = 0; r < 16; ++r) sacc += pB1[r]; l_reg += sacc;
    pw0 = (u32x4){PKW(pB0, 0), PKW(pB0, 2), PKW(pB0, 4), PKW(pB0, 6)}; pw1 = (u32x4){PKW(pB0, 8), PKW(pB0, 10), PKW(pB0, 12), PKW(pB0, 14)}; pw2 = (u32x4){PKW(pB1, 0), PKW(pB1, 2), PKW(pB1, 4), PKW(pB1, 6)}; pw3 = (u32x4){PKW(pB1, 8), PKW(pB1, 10), PKW(pB1, 12), PKW(pB1, 14)};
    SBAR(); pv(o, vb0 + sl_cur, PAF(0), PAF(1), PAF(2), PAF(3)); }
  #undef PKW
  #undef PAF
  #undef VFR
  #undef PIN
  #undef MX3
  #undef GAPA
  #undef GAPB
  #undef EX
  #undef VRD
  #undef KRD
  #undef STEP
  #undef ENDW
  { auto rr = __builtin_amdgcn_permlane32_swap(__float_as_uint(l_reg), __float_as_uint(l_reg), false, false); l_reg = __uint_as_float(rr[0]) + __uint_as_float(rr[1]); }
  if (hi == 0) wsf[32 + r32] = l_reg; asm volatile("s_waitcnt lgkmcnt(0)" ::: "memory");
  float rli[16];
  #pragma unroll
  for (int r = 0; r < 16; ++r) rli[r] = __builtin_amdgcn_rcpf(wsf[32 + crow(r, hi)]);
  bf16* Ow = Ou + (long)(wid * QBLK) * op;
  { bf16* stg = (bf16*)(shm + LDS_OST) + wid * 2048;
    #pragma unroll
    for (int r = 0; r < 16; ++r) { const int orow = crow(r, hi);
      #pragma unroll
      for (int d0 = 0; d0 < 2; ++d0) stg[orow * 64 + d0 * 32 + r32] = (bf16)f2bf(o[d0][r] * rli[r]); }
    asm volatile("s_waitcnt lgkmcnt(0)" ::: "memory");
    #pragma unroll
    for (int i = 0; i < 4; ++i) { const int row = i * 8 + (lane >> 3), ch = lane & 7; const u32x4 v = *(const u32x4*)(stg + row * 64 + ch * 8); ATTN_STORE16(Ow + (long)row * op + ch * 8, v); } }
  asm volatile("s_waitcnt lgkmcnt(0)\n\ts_barrier" ::: "memory");
  #undef NEGM
  #undef DMA_K
  #undef DMA_V
  #undef TROW
  #undef CMASK
  #undef START
  #undef RESC
  #undef ROT
}
#undef SBAR
#undef WAIT_BAR
}
#ifndef FP8_MOE
#define FP8_MOE 1
#endif
struct Args { const float* in[29]; float* out; unsigned char* ws; int ph_lo, ph_hi; };
enum { I_X = 0, I_C, I_CTX, I_CCTX, I_WMOD, I_BMOD, I_N1G, I_N2G, I_WIN, I_LRE, I_LIM, I_LDT, I_BRE, I_BIM, I_CRE, I_CIM, I_SSMD, I_WGLU, I_QNG, I_KNG, I_RPB, I_WBR, I_WOUT, I_RW, I_RB, I_MG, I_MU, I_MD, I_FNG };

typedef const float* CFP;
struct Ctx {
    const __attribute__((address_space(4))) CFP* in; float* out; unsigned char* ws; LAS unsigned char* lds; gu32* ctl;
    int tid, lane, wave, vcu, G;
};
#define WSP(T_, off) ((T_*)(C.ws + (off)))

__device__ __forceinline__ float* xs_row(const Ctx& C, int m) { const int b = m / LB, j = m - b * LB; return j < CTX ? WSP(float, WS_CTXS) + (size_t)(b * CTX + j) * D : C.out + (size_t)(b * SEQ + j - CTX) * D; }
__device__ __forceinline__ const float* in_row(const Ctx& C, int m) { const int b = m / LB, j = m - b * LB; return j < CTX ? C.in[I_CTX] + (size_t)(b * CTX + j) * D : C.in[I_X] + (size_t)(b * SEQ + j - CTX) * D; }
__device__ __forceinline__ int cond_of(int m) { const int b = m / LB, j = m - b * LB; return j < CTX ? 4 : b; }

__device__ __forceinline__ void transpose_item(const float* W, int N, int Kp, bf16* WT, int k0, int n0, int drow0, LAS float* scr, int lane) {
    const float* src = W + (size_t)k0 * N + n0 + lane;
    float tv[64];
#pragma unroll
    for (int i = 0; i < 64; ++i) tv[i] = src[(size_t)i * N];
#pragma unroll
    for (int i = 0; i < 64; ++i) scr[i * 65 + lane] = tv[i];
    LDS_WAIT(); asm volatile("" ::: "memory");
    const int c = lane & 7;
#pragma unroll
    for (int j = 0; j < 8; ++j) { const int n = (lane >> 3) + 8 * j; const LAS float* s = scr + (8 * c) * 65 + n;
        v4u o; o.x = pk2(s[0 * 65], s[1 * 65]); o.y = pk2(s[2 * 65], s[3 * 65]); o.z = pk2(s[4 * 65], s[5 * 65]); o.w = pk2(s[6 * 65], s[7 * 65]);
        *(GAS v4u*)(WT + (size_t)(drow0 + n) * Kp + k0 + 8 * c) = o; }
    LDS_WAIT(); asm volatile("" ::: "memory");
}
__device__ __forceinline__ void transpose_item8(const float* W, int N, int Kp, unsigned char* WT, int k0, int n0, int drow0, float scale, LAS float* scr, int lane) {
    const float* src = W + (size_t)k0 * N + n0 + lane;
    float tv[64];
#pragma unroll
    for (int i = 0; i < 64; ++i) tv[i] = src[(size_t)i * N];
#pragma unroll
    for (int i = 0; i < 64; ++i) scr[i * 65 + lane] = tv[i] * scale;
    LDS_WAIT(); asm volatile("" ::: "memory");
    const int c = lane & 3;
#pragma unroll
    for (int j = 0; j < 4; ++j) { const int n = (lane >> 2) + 16 * j; const LAS float* s = scr + (16 * c) * 65 + n;
        v4u o; o.x = pk4_fp8(s[0 * 65], s[1 * 65], s[2 * 65], s[3 * 65]); o.y = pk4_fp8(s[4 * 65], s[5 * 65], s[6 * 65], s[7 * 65]); o.z = pk4_fp8(s[8 * 65], s[9 * 65], s[10 * 65], s[11 * 65]); o.w = pk4_fp8(s[12 * 65], s[13 * 65], s[14 * 65], s[15 * 65]);
        *(GAS v4u*)(WT + (size_t)(drow0 + n) * Kp + k0 + 16 * c) = o; }
    LDS_WAIT(); asm volatile("" ::: "memory");
}
__device__ __forceinline__ void phase_weights(const Ctx& C, int l) {
    LAS float* scr = (LAS float*)(C.lds + C.wave * 16640);
    const int gw = C.vcu * NWAVES + C.wave, NGW = C.G * NWAVES;
    constexpr int I0 = 16 * 92, I1 = 8 * 8, I2 = 3 * 8 * 16, I3 = 16 * 16, I4 = 16 * 16 * 8, I5 = I4, I6 = 16 * 8 * 16;
    for (int it = gw; it < I0 + I1 + I2 + I3 + I4 + I5 + I6; it += NGW) {
        int r = it;
        if (r < I0) { const int kb = r / 92, nb = r % 92; if (W8_ALL) transpose_item8(C.in[I_WIN] + (size_t)l * 1024 * INW, INW, 1024, WSP(unsigned char, WS_WIN), 64 * kb, 64 * nb, 64 * nb, 64.f, scr, C.lane);
            else if (nb < 44 || GATE_BF16) transpose_item(C.in[I_WIN] + (size_t)l * 1024 * INW, INW, 1024, WSP(bf16, WS_WIN), 64 * kb, 64 * nb, 64 * nb, scr, C.lane);
            else transpose_item8(C.in[I_WIN] + (size_t)l * 1024 * INW, INW, 1024, WSP(unsigned char, WS_WIN8), 64 * kb, 64 * nb, 64 * nb - 2816, 64.f, scr, C.lane); continue; } r -= I0;
        if (r < I1) { const int kb = r / 8, nb = r % 8; transpose_item(C.in[I_WGLU] + (size_t)l * 512 * 512, 512, 512, WSP(bf16, WS_WGLU), 64 * kb, 64 * nb, 64 * nb, scr, C.lane); continue; } r -= I1;
        if (r < I2) { const int i = r / 128, q = r % 128, kb = q / 16, nb = q % 16; transpose_item(C.in[I_WBR] + (size_t)(l * 3 + i) * 512 * 1024, 1024, 512, WSP(bf16, WS_WBR) + (size_t)i * 1024 * 512, 64 * kb, 64 * nb, 64 * nb, scr, C.lane); continue; } r -= I2;
        if (r < I3) { const int kb = r / 16, nb = r % 16; transpose_item(C.in[I_WOUT] + (size_t)l * 1024 * 1024, 1024, 1024, WSP(bf16, WS_WOUT), 64 * kb, 64 * nb, 64 * nb, scr, C.lane); continue; } r -= I3;
        if (r < I4 + I5) { const int up = r >= I4; if (up) r -= I4; const int e = r / 128, q = r % 128, kb = q / 8, nb = q % 8, n0 = 64 * nb;
            if (FP8_MOE) transpose_item8((up ? C.in[I_MU] : C.in[I_MG]) + (size_t)(l * 16 + e) * 1024 * 512, 512, 1024, WSP(unsigned char, WS_MOE1) + (size_t)e * 1024 * 1024, 64 * kb, n0, (n0 / 128) * 256 + (n0 % 128) + (up ? 128 : 0), 64.f, scr, C.lane);
            else transpose_item((up ? C.in[I_MU] : C.in[I_MG]) + (size_t)(l * 16 + e) * 1024 * 512, 512, 1024, WSP(bf16, WS_MOE1) + (size_t)e * 1024 * 1024, 64 * kb, n0, (n0 / 128) * 256 + (n0 % 128) + (up ? 128 : 0), scr, C.lane); continue; } r -= I4 + I5;
        { const int e = r / 128, q = r % 128, kb = q / 16, nb = q % 16; if (FP8_MOE) transpose_item8(C.in[I_MD] + (size_t)(l * 16 + e) * 512 * 1024, 1024, 512, WSP(unsigned char, WS_MOE2) + (size_t)e * 1024 * 512, 64 * kb, 64 * nb, 64 * nb, 32.f, scr, C.lane);
            else transpose_item(C.in[I_MD] + (size_t)(l * 16 + e) * 512 * 1024, 1024, 512, WSP(bf16, WS_MOE2) + (size_t)e * 1024 * 512, 64 * kb, 64 * nb, 64 * nb, scr, C.lane); }
    }
}

__device__ __forceinline__ void phase_mod(const Ctx& C) {
    LAS float* sc = (LAS float*)(C.lds);
    LAS float* red = (LAS float*)(C.lds + 20480);
    for (int i = C.tid; i < 5 * 1024; i += 512) { const int c = i >> 10, k = i & 1023; const float v = c < 4 ? C.in[I_C][c * 1024 + k] : C.in[I_CCTX][k]; sc[i] = v * fsigmoid(v); }
    __syncthreads();
    for (int it = C.vcu; it < NLAYER * 96; it += C.G) {
        const int l = it / 96, col = (it % 96) * 64 + C.lane, k0 = C.wave * 128;
        const float* W = C.in[I_WMOD] + (size_t)l * 1024 * 6144 + (size_t)k0 * 6144 + col;
        float a0 = 0.f, a1 = 0.f, a2 = 0.f, a3 = 0.f, a4 = 0.f;
#pragma unroll 16
        for (int k = 0; k < 128; ++k) { const float w = W[(size_t)k * 6144]; a0 += sc[k0 + k] * w; a1 += sc[1024 + k0 + k] * w; a2 += sc[2048 + k0 + k] * w; a3 += sc[3072 + k0 + k] * w; a4 += sc[4096 + k0 + k] * w; }
        LAS float* r = red + C.wave * 320 + C.lane; r[0] = a0; r[64] = a1; r[128] = a2; r[192] = a3; r[256] = a4;
        __syncthreads();
        if (C.tid < 320) { const int c = C.tid >> 6; float s = C.in[I_BMOD][l * 6144 + col];
#pragma unroll
            for (int w = 0; w < 8; ++w) s += red[w * 320 + C.tid];
            WSP(float, WS_MOD)[(size_t)(l * 5 + c) * 6144 + col] = s; }
        __syncthreads();
    }
}

__device__ __forceinline__ void phase_s5mats(const Ctx& C, int l, int w) {
    if (w < 0 || w >= 128) return;
    const int g = w >> 2, part = w & 3, tid = C.tid;
    LAS f32x2* POW = (LAS f32x2*)(C.lds);
    LAS f32x2* CC = (LAS f32x2*)(C.lds + 33792);
    LAS f32x2* BB = (LAS f32x2*)(C.lds + 50176);
    LAS f32x2* COEF = (LAS f32x2*)(C.lds + 66560);
    LAS bf16* KT = (LAS bf16*)(C.lds + 67584);
    LAS float* WT = (LAS float*)(C.lds + 101376);
    __syncthreads();
    if (tid < 128) {
        const int d = tid >> 6, p = tid & 63; const int li = ((l * 2 + d) * 32 + g) * 64 + p;
        const float re = C.in[I_LRE][li], im = C.in[I_LIM][li], dt = __expf(C.in[I_LDT][(l * 2 + d) * 32 + g]);
        for (int tau = 0; tau <= 32; ++tau) { const float mag = __expf(re * dt * (float)tau), rev = im * dt * (float)tau * 0.15915494309189535f;
            const float wr = mag * cos_rev(rev), wi = mag * sin_rev(rev);
            POW[(d * 33 + tau) * 64 + p] = (f32x2){wr, wi}; if (tau < 32) { WT[((d * 64 + p) * 2) * 32 + tau] = wr; WT[((d * 64 + p) * 2 + 1) * 32 + tau] = wi; } }
        const float mag = __expf(re * dt), rev = im * dt * 0.15915494309189535f; const float lr = mag * cos_rev(rev) - 1.f, lim = mag * sin_rev(rev);
        const float den = 1.f / (re * re + im * im);
        COEF[tid] = (f32x2){(lr * re + lim * im) * den, (lim * re - lr * im) * den};
    }
    __syncthreads();
    for (int i = tid; i < 2048; i += 512) {
        const int d = i >> 10, p = (i >> 4) & 63, h = i & 15; const size_t bi = (((size_t)(l * 2 + d) * 32 + g) * 64 + p) * 16 + h;
        const float br = C.in[I_BRE][bi], bi_ = C.in[I_BIM][bi]; const f32x2 cf = COEF[d * 64 + p];
        BB[i] = (f32x2){cf.x * br - cf.y * bi_, cf.x * bi_ + cf.y * br};
        const int h2 = (i >> 6) & 15, p2 = i & 63; const size_t ci = (((size_t)(l * 2 + d) * 32 + g) * 16 + h2) * 64 + p2;
        CC[i] = (f32x2){C.in[I_CRE][ci], C.in[I_CIM][ci]};
    }
    __syncthreads();
    {
        const int wv = tid >> 6, ln = tid & 63, hi = ln >> 5, i = ln & 31, h = 2 * wv + (i >> 4), hp = i & 15;
        f32x16 a0 = f32x16{}, a1 = f32x16{};
#pragma unroll 4
        for (int p = 0; p < 64; ++p) {
            const f32x2 c0 = CC[h * 64 + p], b0 = BB[p * 16 + hp], c1 = CC[1024 + h * 64 + p], b1 = BB[1024 + p * 16 + hp];
            const float x0 = hi == 0 ? (c0.x * b0.x - c0.y * b0.y) : -(c0.x * b0.y + c0.y * b0.x);
            const float x1 = hi == 0 ? (c1.x * b1.x - c1.y * b1.y) : -(c1.x * b1.y + c1.y * b1.x);
            a0 = __builtin_amdgcn_mfma_f32_32x32x2f32(x0, WT[(p * 2 + hi) * 32 + i], a0, 0, 0, 0);
            a1 = __builtin_amdgcn_mfma_f32_32x32x2f32(x1, WT[((64 + p) * 2 + hi) * 32 + i], a1, 0, 0, 0);
        }
        const float* sd = C.in[I_SSMD] + l * 512 + g * 16;
#pragma unroll
        for (int r = 0; r < 16; ++r) { const int rl = (r & 3) + 8 * (r >> 2) + 4 * hi, hh = 2 * wv + (rl >> 4), hq = rl & 15;
            float f = a0[r]; if (i == 0) f += a1[r] + (hh == hq ? sd[hh] : 0.f);
            KT[((31 + i) * 16 + hh) * 16 + hq] = (bf16)f2bf(f);
            if (i > 0) KT[((31 - i) * 16 + hh) * 16 + hq] = (bf16)f2bf(a1[r]); }
    }
    __syncthreads();
    bf16* B1 = WSP(bf16, WS_BT1) + (size_t)g * 768 * 512; bf16* B2 = WSP(bf16, WS_BT2) + (size_t)g * 512 * 256;
    for (int i = tid; i < 128 * 64; i += 512) {
        const int n = part * 128 + (i >> 6), ch = i & 63, t = n >> 4, h = n & 15, s = ch >> 1, hp0 = (ch & 1) * 8;
        *(GAS v4u*)(B1 + (size_t)n * 512 + ch * 8) = *(const LAS v4u*)(KT + ((t - s + 31) * 16 + h) * 16 + hp0);
    }
    for (int i = tid; i < 64 * 64; i += 512) {
        const int nn = part * 64 + (i >> 6), ch = i & 63, d = nn >> 7, p = (nn & 127) >> 1, ri = nn & 1, s = ch >> 1, hp0 = (ch & 1) * 8;
        const f32x2 w = POW[(d * 33 + (d == 0 ? 31 - s : s)) * 64 + p]; float v[8];
#pragma unroll
        for (int j = 0; j < 8; ++j) { const f32x2 b = BB[d * 1024 + p * 16 + hp0 + j]; v[j] = ri == 0 ? (w.x * b.x - w.y * b.y) : (w.x * b.y + w.y * b.x); }
        v4u o; o.x = pk2(v[0], v[1]); o.y = pk2(v[2], v[3]); o.z = pk2(v[4], v[5]); o.w = pk2(v[6], v[7]);
        *(GAS v4u*)(B1 + (size_t)(512 + nn) * 512 + ch * 8) = o;
    }
    for (int i = tid; i < 128 * 32; i += 512) {
        const int n = part * 128 + (i >> 5), ch = i & 31, t = n >> 4, h = n & 15, d = ch >> 4, p0 = (ch & 15) * 4; float v[8];
#pragma unroll
        for (int j = 0; j < 4; ++j) { const f32x2 c = CC[d * 1024 + h * 64 + p0 + j], w = POW[(d * 33 + (d == 0 ? t + 1 : 32 - t)) * 64 + p0 + j];
            v[2 * j] = c.x * w.x - c.y * w.y; v[2 * j + 1] = -(c.x * w.y + c.y * w.x); }
        v4u o; o.x = pk2(v[0], v[1]); o.y = pk2(v[2], v[3]); o.z = pk2(v[4], v[5]); o.w = pk2(v[6], v[7]);
        *(GAS v4u*)(B2 + (size_t)n * 256 + ch * 8) = o;
    }
    __syncthreads();
}

template <int MODE>
__device__ __forceinline__ void phase_rows(const Ctx& C, int l) {
    const int gw = C.vcu * NWAVES + C.wave, NGW = C.G * NWAVES, lane = C.lane;
    const float* MODl = WSP(float, WS_MOD) + (size_t)(MODE == 2 ? 0 : l) * 5 * 6144;
    const float* MODp = WSP(float, WS_MOD) + (size_t)(l > 0 ? l - 1 : 0) * 5 * 6144;
    const bf16* YS = WSP(bf16, WS_YSLOT);
    f32x4 nx[4]; v2u na[4], nc[4];
#define ROWS_LOAD(mm) do { const int m_ = (mm); \
        if (MODE == 0) { const GAS f32x4* xr = (const GAS f32x4*)in_row(C, m_) + lane; _Pragma("unroll") for (int q = 0; q < 4; ++q) nx[q] = xr[64 * q]; } \
        else { const GAS f32x4* xr = (const GAS f32x4*)xs_row(C, m_) + lane; const GAS v2u* y0 = (const GAS v2u*)(YS + (size_t)(2 * m_) * D) + lane; const GAS v2u* y1 = (const GAS v2u*)(YS + (size_t)(2 * m_ + 1) * D) + lane; \
            _Pragma("unroll") for (int q = 0; q < 4; ++q) { nx[q] = xr[64 * q]; na[q] = y0[64 * q]; nc[q] = y1[64 * q]; } } } while (0)
    int m = gw; if (MODE == 2) { while (m < T && (m % LB) < CTX) m += NGW; }
    if (m < T) ROWS_LOAD(m);
    while (m < T) {
        const int b = m / LB, j = m - b * LB, cond = j < CTX ? 4 : b;
        f32x4 v[4];
        if (MODE == 0) {
#pragma unroll
            for (int q = 0; q < 4; ++q) v[q] = nx[q]; }
        else { const GAS f32x4* g2 = (const GAS f32x4*)(MODp + cond * 6144 + 5 * 1024) + lane;
#pragma unroll
            for (int q = 0; q < 4; ++q) { const f32x4 g = g2[64 * q]; const v2u a = na[q], c = nc[q];
                v[q] = nx[q] + g * (f32x4){bflo(a.x) + bflo(c.x), bfhi(a.x) + bfhi(c.x), bflo(a.y) + bflo(c.y), bfhi(a.y) + bfhi(c.y)}; } }
        int mn = m + NGW; if (MODE == 2) { while (mn < T && (mn % LB) < CTX) mn += NGW; }
        if (mn < T) ROWS_LOAD(mn);
        float ss = 0.f;
#pragma unroll
        for (int q = 0; q < 4; ++q) ss += (v[q].x * v[q].x + v[q].y * v[q].y) + (v[q].z * v[q].z + v[q].w * v[q].w);
        const float rstd = 1.f / sqrtf(wave_sum(ss, lane) * (1.f / D) + EPS);
        if (MODE == 2) { GAS f32x4* o = (GAS f32x4*)(C.out + (size_t)(b * SEQ + j - CTX) * D) + lane; const GAS f32x4* fg = (const GAS f32x4*)C.in[I_FNG] + lane;
#pragma unroll
            for (int q = 0; q < 4; ++q) o[64 * q] = v[q] * rstd * fg[64 * q]; }
        else { GAS f32x4* xo = (GAS f32x4*)xs_row(C, m) + lane; GAS v2u* ho = (GAS v2u*)(WSP(bf16, WS_HB) + (size_t)m * D) + lane; GAS unsigned* h8 = (GAS unsigned*)(WSP(unsigned char, WS_HB8) + (size_t)m * D) + lane;
            const GAS f32x4* ng = (const GAS f32x4*)(C.in[I_N1G] + l * D) + lane; const GAS f32x4* sh = (const GAS f32x4*)(MODl + cond * 6144) + lane; const GAS f32x4* sc = (const GAS f32x4*)(MODl + cond * 6144 + 1024) + lane;
#pragma unroll
            for (int q = 0; q < 4; ++q) { xo[64 * q] = v[q]; const f32x4 h = v[q] * rstd * ng[64 * q] * (sc[64 * q] + 1.f) + sh[64 * q]; if (!W8_ALL) ho[64 * q] = (v2u){pk2(h.x, h.y), pk2(h.z, h.w)}; if (H8_WRITE) h8[64 * q] = pk4_fp8(h.x, h.y, h.z, h.w); } }
        m = mn;
    }
#undef ROWS_LOAD
}

__device__ __forceinline__ void phase_qkprep(const Ctx& C, int l) {
    const int gw = C.vcu * NWAVES + C.wave, NGW = C.G * NWAVES, lane = C.lane, s8 = lane & 7;
    const float* qg = C.in[I_QNG] + l * 64 + 8 * s8; const float* kg = C.in[I_KNG] + l * 64 + 8 * s8;
    float gq[8], gk[8];
#pragma unroll
    for (int i = 0; i < 8; ++i) { gq[i] = qg[i]; gk[i] = kg[i]; }
    const int ax = s8 >> 2, f0 = 8 * (s8 & 1);
    float inv[8];
#pragma unroll
    for (int i = 0; i < 8; ++i) inv[i] = exp2f(-(float)(f0 + i) * 0.8304820237218406f) * 0.15915494309189535f;
    const int kl = lane & 15;
    v4u wq, wk;
    if (gw < T) { wq = *((const GAS v4u*)(WSP(bf16, WS_QA) + (size_t)gw * 512) + lane); wk = *((const GAS v4u*)(WSP(bf16, WS_KA) + (size_t)gw * 128) + kl); }
    for (int m = gw; m < T; m += NGW) {
        const int b = m / LB, j = m - b * LB; const bool lat = j >= CTX; const int tt = j - CTX; const float pos = (float)(ax == 0 ? (tt >> 6) : (tt & 63));
        const v4u cq = wq, ck = wk;
        if (m + NGW < T) { wq = *((const GAS v4u*)(WSP(bf16, WS_QA) + (size_t)(m + NGW) * 512) + lane); wk = *((const GAS v4u*)(WSP(bf16, WS_KA) + (size_t)(m + NGW) * 128) + kl); }
        float cs[8], sn[8];
#pragma unroll
        for (int i = 0; i < 8; ++i) { cs[i] = lat ? cos_rev(pos * inv[i]) : 1.f; sn[i] = lat ? sin_rev(pos * inv[i]) : 0.f; }
#pragma unroll
        for (int which = 0; which < 2; ++which) {
            const v4u w = which == 0 ? cq : ck; float x[8] = {bflo(w.x), bfhi(w.x), bflo(w.y), bfhi(w.y), bflo(w.z), bfhi(w.z), bflo(w.w), bfhi(w.w)};
            float ss = 0.f;
#pragma unroll
            for (int i = 0; i < 8; ++i) ss += x[i] * x[i];
            ss += dpp_mov<0xB1, 0xF>(ss); ss += dpp_mov<0x4E, 0xF>(ss); ss += dpp_mov<0x141, 0xF>(ss);
            const float rstd = 1.f / sqrtf(ss * (1.f / 64.f) + EPS);
            float y[8];
#pragma unroll
            for (int i = 0; i < 8; ++i) { const float xn = x[i] * rstd * (which == 0 ? gq[i] : gk[i]); const float other = dpp_mov<0x4E, 0xF>(xn);
                y[i] = (s8 & 2) ? (xn * cs[i] + other * sn[i]) : (xn * cs[i] - other * sn[i]); }
            const float sc = which == 0 ? C2 : 1.f;
            v4u o; o.x = pk2(y[0] * sc, y[1] * sc); o.y = pk2(y[2] * sc, y[3] * sc); o.z = pk2(y[4] * sc, y[5] * sc); o.w = pk2(y[6] * sc, y[7] * sc);
            if (which == 0) *((GAS v4u*)(WSP(bf16, WS_QA) + (size_t)m * 512) + lane) = o;
            else if (lane < 16) *((GAS v4u*)(WSP(bf16, WS_KA) + (size_t)m * 128) + lane) = o;
        }
    }
}

__device__ __forceinline__ void phase_carry(const Ctx& C, int l) {
    if (C.vcu >= 32) return;
    const int b = C.vcu >> 3, g = (C.vcu & 7) * 4 + (C.wave >> 1), d = C.wave & 1, p = C.lane;
    const int li = ((l * 2 + d) * 32 + g) * 64 + p;
    const float re = C.in[I_LRE][li], im = C.in[I_LIM][li], dt = __expf(C.in[I_LDT][(l * 2 + d) * 32 + g]);
    const float mag = __expf(re * dt * 32.f), rev = im * dt * 32.f * 0.15915494309189535f; const float Lr = mag * cos_rev(rev), Li = mag * sin_rev(rev);
    const GAS f32x2* S = (const GAS f32x2*)(WSP(float, WS_SST) + (size_t)(b * NCH) * 8192 + g * 256 + d * 128) + p;
    GAS unsigned* X = (GAS unsigned*)(WSP(bf16, WS_XST) + (size_t)(b * NCH) * 8192 + g * 256 + d * 128) + p;
    float sr = 0.f, si = 0.f;
    if (d == 0) {
        for (int c0 = 0; c0 < NCH; c0 += 8) { f32x2 s[8];
#pragma unroll
            for (int k = 0; k < 8; ++k) s[k] = S[(size_t)(c0 + k) * 4096];
#pragma unroll
            for (int k = 0; k < 8; ++k) { X[(size_t)(c0 + k) * 4096] = pk2(sr, si); const float nr = Lr * sr - Li * si + s[k].x, ni = Lr * si + Li * sr + s[k].y; sr = nr; si = ni; } }
    } else {
        for (int seg = 0; seg < 33; ++seg) { const int chi = seg == 0 ? 7 : NCH - 1 - (seg - 1) * 8; f32x2 s[8];
#pragma unroll
            for (int k = 0; k < 8; ++k) s[k] = S[(size_t)(chi - k) * 4096];
#pragma unroll
            for (int k = 0; k < 8; ++k) { X[(size_t)(chi - k) * 4096] = pk2(sr, si); const float nr = Lr * sr - Li * si + s[k].x, ni = Lr * si + Li * sr + s[k].y; sr = nr; si = ni; } }
    }
}

__device__ __forceinline__ void phase_norm2(const Ctx& C, int l) {
    LAS float* RWt = (LAS float*)C.lds;
    LAS unsigned* REC = (LAS unsigned*)(C.lds + 65536);
    LAS float* LG = (LAS float*)(C.lds + 65536 + 16384);
    LAS unsigned* LCNT = (LAS unsigned*)(C.lds + 65536 + 32768);
    const int lane = C.lane, tid = C.tid;
    for (int i = tid; i < 16384; i += 512) { const int k = i >> 4, e = i & 15; RWt[e * 1024 + k] = C.in[I_RW][i]; }
    if (tid < 32) LCNT[tid] = 0u;
    __syncthreads();
    const float* MODl = WSP(float, WS_MOD) + (size_t)l * 5 * 6144;
    int nrows = 0; for (int m = C.vcu; m < T; m += C.G) ++nrows;
    f32x4 nx[2][4];
#define N2_LOAD(ii) do { _Pragma("unroll") for (int rr = 0; rr < 2; ++rr) { const int i_ = (ii) + rr * NWAVES; const int m_ = C.vcu + C.G * (i_ < nrows ? i_ : (ii)); const GAS f32x4* xr = (const GAS f32x4*)xs_row(C, m_) + lane; \
        _Pragma("unroll") for (int q = 0; q < 4; ++q) nx[rr][q] = xr[64 * q]; } } while (0)
    if (C.wave < nrows) N2_LOAD(C.wave);
    for (int i = C.wave; i < nrows; i += 2 * NWAVES) {
        const bool has1 = i + NWAVES < nrows;
        f32x4 hv[2][4];
#pragma unroll
        for (int rr = 0; rr < 2; ++rr) { const int ir = (rr && has1) ? i + NWAVES : i; const int m = C.vcu + C.G * ir, cond = cond_of(m);
            GAS unsigned* h8 = (GAS unsigned*)(WSP(unsigned char, WS_HB8) + (size_t)m * D) + lane; GAS v2u* ho = (GAS v2u*)(WSP(bf16, WS_HB) + (size_t)m * D) + lane;
            const GAS f32x4* ng = (const GAS f32x4*)(C.in[I_N2G] + l * D) + lane; const GAS f32x4* sh = (const GAS f32x4*)(MODl + cond * 6144 + 3072) + lane; const GAS f32x4* sc = (const GAS f32x4*)(MODl + cond * 6144 + 4096) + lane;
            float ss = 0.f;
#pragma unroll
            for (int q = 0; q < 4; ++q) { const f32x4 v = nx[rr][q]; ss += (v.x * v.x + v.y * v.y) + (v.z * v.z + v.w * v.w); }
            const float rstd = 1.f / sqrtf(wave_sum(ss, lane) * (1.f / D) + EPS);
#pragma unroll
            for (int q = 0; q < 4; ++q) { const f32x4 h = nx[rr][q] * rstd * ng[64 * q] * (sc[64 * q] + 1.f) + sh[64 * q]; hv[rr][q] = h;
                if (rr == 0 || has1) { if (FP8_MOE) h8[64 * q] = pk4_fp8(h.x, h.y, h.z, h.w); else ho[64 * q] = (v2u){pk2(h.x, h.y), pk2(h.z, h.w)}; } } }
        if (i + 2 * NWAVES < nrows) N2_LOAD(i + 2 * NWAVES);
        float mine0 = 0.f, mine1 = 0.f;
#pragma unroll
        for (int e = 0; e < 16; ++e) { float a0 = 0.f, a1 = 0.f;
#pragma unroll
            for (int q = 0; q < 4; ++q) { const f32x4 w = *(const LAS f32x4*)(RWt + e * 1024 + 256 * q + 4 * lane); const f32x4 h0 = hv[0][q], h1 = hv[1][q];
                a0 += (h0.x * w.x + h0.y * w.y) + (h0.z * w.z + h0.w * w.w); a1 += (h1.x * w.x + h1.y * w.y) + (h1.z * w.z + h1.w * w.w); }
            const float t0 = wave_sum(a0, lane), t1 = wave_sum(a1, lane); mine0 = lane == e ? t0 : mine0; mine1 = lane == e ? t1 : mine1; }
        if (lane < 16) { LG[i * 16 + lane] = mine0; if (has1) LG[(i + NWAVES) * 16 + lane] = mine1; }
    }
#undef N2_LOAD
    __syncthreads();
    float rb[16];
#pragma unroll
    for (int e = 0; e < 16; ++e) rb[e] = C.in[I_RB][e];
    for (int i = tid; i < nrows; i += 512) {
        float lg[16];
#pragma unroll
        for (int q = 0; q < 4; ++q) { const f32x4 t = *(const LAS f32x4*)(LG + i * 16 + 4 * q); lg[4 * q] = t.x; lg[4 * q + 1] = t.y; lg[4 * q + 2] = t.z; lg[4 * q + 3] = t.w; }
        float mx = lg[0];
#pragma unroll
        for (int e = 1; e < 16; ++e) mx = fmaxf(mx, lg[e]);
        float pr[16], sel[16], sum = 0.f;
#pragma unroll
        for (int e = 0; e < 16; ++e) { pr[e] = __expf(lg[e] - mx); sum += pr[e]; }
        const float rs = 1.f / sum;
#pragma unroll
        for (int e = 0; e < 16; ++e) { pr[e] *= rs; sel[e] = pr[e] + rb[e]; }
        float bestv = -1e30f; int best = 0;
#pragma unroll
        for (int gq = 0; gq < 4; ++gq) { float m1 = -1e30f, m2 = -1e30f;
#pragma unroll
            for (int k = 0; k < 4; ++k) { const float s_ = sel[4 * gq + k]; if (s_ > m1) { m2 = m1; m1 = s_; } else if (s_ > m2) m2 = s_; }
            const float gs = m1 + m2; if (gs > bestv) { bestv = gs; best = gq; } }
        float s4[4], p4[4];
#pragma unroll
        for (int k = 0; k < 4; ++k) { s4[k] = best == 0 ? sel[k] : best == 1 ? sel[4 + k] : best == 2 ? sel[8 + k] : sel[12 + k]; p4[k] = best == 0 ? pr[k] : best == 1 ? pr[4 + k] : best == 2 ? pr[8 + k] : pr[12 + k]; }
        int i0 = 0; float v0 = s4[0], q0 = p4[0];
#pragma unroll
        for (int k = 1; k < 4; ++k) if (s4[k] > v0) { v0 = s4[k]; i0 = k; q0 = p4[k]; }
        int i1 = i0 == 0 ? 1 : 0; float v1 = -1e30f, q1 = p4[i0 == 0 ? 1 : 0];
#pragma unroll
        for (int k = 0; k < 4; ++k) if (k != i0 && s4[k] > v1) { v1 = s4[k]; i1 = k; q1 = p4[k]; }
        const int e0 = 4 * best + i0, e1 = 4 * best + i1; const float wn = 1.f / (q0 + q1);
        const unsigned lp0 = atomicAdd((unsigned*)(LCNT + e0), 1u), lp1 = atomicAdd((unsigned*)(LCNT + e1), 1u);
        REC[i * 4 + 0] = (unsigned)e0 | ((unsigned)e1 << 8) | (lp0 << 16); REC[i * 4 + 1] = lp1; REC[i * 4 + 2] = __float_as_uint(q0 * wn); REC[i * 4 + 3] = __float_as_uint(q1 * wn);
    }
    __syncthreads();
    if (tid < 16) LCNT[16 + tid] = __hip_atomic_fetch_add((unsigned*)(C.ctl + CW_CNT + l * 1024 + 64 * tid), LCNT[tid], RLX_AGENT);
    __syncthreads();
    int* LIST = WSP(int, WS_LIST); float* RWG = WSP(float, WS_RW);
    for (int i = tid; i < nrows; i += 512) { const int m = C.vcu + C.G * i; const unsigned r0 = REC[i * 4], r1 = REC[i * 4 + 1];
        const int e0 = r0 & 255, e1 = (r0 >> 8) & 255; const unsigned lp0 = r0 >> 16, lp1 = r1;
        LIST[(size_t)e0 * T + LCNT[16 + e0] + lp0] = 2 * m; LIST[(size_t)e1 * T + LCNT[16 + e1] + lp1] = 2 * m + 1;
        RWG[2 * m] = __uint_as_float(REC[i * 4 + 2]); RWG[2 * m + 1] = __uint_as_float(REC[i * 4 + 3]); }
    __syncthreads();
}
using pg8::Unit;
typedef f32x4 Acc[2][2][4][2];
__device__ __forceinline__ v4u pack8(const f32x4& a, const f32x4& b) { v4u w; w.x = cvt_pk_bf16(a[0], a[1]); w.y = cvt_pk_bf16(a[2], a[3]); w.z = cvt_pk_bf16(b[0], b[1]); w.w = cvt_pk_bf16(b[2], b[3]); return w; }
__device__ __forceinline__ void unpack8(const v4u& w, f32x4& a, f32x4& b) { a = (f32x4){bflo(w.x), bfhi(w.x), bflo(w.y), bfhi(w.y)}; b = (f32x4){bflo(w.z), bfhi(w.z), bflo(w.w), bfhi(w.w)}; }
#ifndef WT_MODE
#define WT_MODE 0
#endif
__device__ __forceinline__ void st16(void* p, const v4u& v) {
#if WT_MODE == 1
    asm volatile("global_store_dwordx4 %0, %1, off sc0 sc1" :: "v"(p), "v"(v) : "memory");
#elif WT_MODE == 2
    asm volatile("global_store_dwordx4 %0, %1, off nt" :: "v"(p), "v"(v) : "memory");
#else
    *(GAS v4u*)p = v;
#endif
}
__device__ __forceinline__ int chunk_m0(int cr) { return (cr / NCH) * LB + (cr % NCH) * 32; }

struct PWin {
    static constexpr bool EARLY_AOFF = false, FP8 = false; unsigned char* ws; int G, c; int K; unsigned kstepA;
    __device__ __forceinline__ bool next(int i, Unit& u) const { const long L = (long)i * G + c; if (L >= NPAN * 11) return false; pg8::static_decode((int)L, NPAN, 11, u.pm, u.pn); u.z = 0; return true; }
    __device__ __forceinline__ const char* a_base(const Unit& u) const { return (const char*)(ws + WS_HB) + (size_t)u.pm * 256 * 1024 * 2; }
    __device__ __forceinline__ unsigned a_off(const Unit&, int h, int R, int Cc) const { return (unsigned)((h * 128 + R) * 1024 + Cc) * 2u; }
    __device__ __forceinline__ const char* b_base(const Unit& u) const { return (const char*)(ws + WS_WIN) + (size_t)u.pn * 256 * 1024 * 2; }
    __device__ __forceinline__ void epi(const Acc& acc, const Unit& u, int wr, int wc, int fr, int fq) const {
        const int row0 = u.pm * 256 + wr * 64 + fr;
#pragma unroll
        for (int bj = 0; bj < 2; ++bj) {
            const int cb = u.pn * 256 + bj * 128; bf16* dst; int ld, col, mode = 0; float sc = 1.f;
            if (cb < 512) { dst = (bf16*)(ws + WS_U) + ((size_t)((cb + wc * 32 + 8 * fq) >> 4) * T) * 16 + ((8 * fq) & 15) - (wc * 32 + 8 * fq); ld = 16; col = 0; }
            else if (cb < 1024) { dst = (bf16*)(ws + WS_QA); ld = 512; col = cb - 512; }
            else if (cb == 1024) { dst = (bf16*)(ws + WS_KA); ld = 128; col = 0; }
            else if (cb == 1152) { dst = (bf16*)(ws + WS_VA); ld = 128; col = 0; }
            else if (cb < 1792) { dst = (bf16*)(ws + WS_QN); ld = 512; col = cb - 1280; sc = C2; }
            else if (cb < 2304) { dst = (bf16*)(ws + WS_KN); ld = 512; col = cb - 1792; }
            else { dst = (bf16*)(ws + WS_VN); ld = 512; col = cb - 2304; }
            const int c0 = col + wc * 32 + 8 * fq;
#pragma unroll
            for (int ai = 0; ai < 2; ++ai)
#pragma unroll
                for (int m = 0; m < 4; ++m) { f32x4 v0 = acc[ai][bj][m][0], v1 = acc[ai][bj][m][1];
                    if (mode) { v0 = (f32x4){fsigmoid(v0[0]), fsigmoid(v0[1]), fsigmoid(v0[2]), fsigmoid(v0[3])}; v1 = (f32x4){fsigmoid(v1[0]), fsigmoid(v1[1]), fsigmoid(v1[2]), fsigmoid(v1[3])}; }
                    else { v0 = v0 * sc; v1 = v1 * sc; }
                    st16(dst + (size_t)(row0 + ai * 128 + m * 16) * ld + c0, pack8(v0, v1)); __builtin_amdgcn_sched_barrier(0); }
        }
    }
};

struct PWin8 {
    static constexpr bool EARLY_AOFF = false, FP8 = true; unsigned char* ws; int G, c; int K; unsigned kstepA;
    __device__ __forceinline__ bool next(int i, Unit& u) const { const long L = (long)i * G + c; if (L >= 2 * NPAN * 23) return false; pg8::static_decode((int)L, 2 * NPAN, 23, u.pm, u.pn); u.z = 0; return true; }
    __device__ __forceinline__ const char* a_base(const Unit& u) const { return (const char*)(ws + WS_HB8) + (size_t)u.pm * 128 * 1024; }
    __device__ __forceinline__ unsigned a_off(const Unit&, int R, int Cc) const { return (unsigned)(R * 1024 + Cc * 2); }
    __device__ __forceinline__ const char* b_base(const Unit& u) const { return (const char*)(ws + WS_WIN) + (size_t)u.pn * 256 * 1024; }
    __device__ __forceinline__ void epi(const f32x4 (&acc)[2][4][2], f32x4 (&)[2][4][2], const Unit& u, int wr, int wc, int fr, int fq) const {
        const int row0 = u.pm * 128 + wr * 64 + fr;
#pragma unroll
        for (int bj = 0; bj < 2; ++bj) {
            const int cb = u.pn * 256 + bj * 128;
            if (cb >= 2816) { const int c0 = cb - 2816 + wc * 32 + 8 * fq;
#pragma unroll
                for (int m = 0; m < 4; ++m) { f32x4 v0 = acc[bj][m][0] * (1.f / 64.f), v1 = acc[bj][m][1] * (1.f / 64.f);
                    v0 = (f32x4){fsigmoid(v0[0]), fsigmoid(v0[1]), fsigmoid(v0[2]), fsigmoid(v0[3])}; v1 = (f32x4){fsigmoid(v1[0]), fsigmoid(v1[1]), fsigmoid(v1[2]), fsigmoid(v1[3])};
                    *(GAS v2u*)((unsigned char*)(ws + WS_GATES) + (size_t)(row0 + m * 16) * 3072 + c0) = (v2u){pk4_fp8(v0[0], v0[1], v0[2], v0[3]), pk4_fp8(v1[0], v1[1], v1[2], v1[3])}; }
            } else {
                bf16* dst; int ld, col; float sc = 1.f / 64.f;
                if (cb < 512) { dst = (bf16*)(ws + WS_U) + ((size_t)((cb + wc * 32 + 8 * fq) >> 4) * T) * 16 + ((8 * fq) & 15) - (wc * 32 + 8 * fq); ld = 16; col = 0; }
                else if (cb < 1024) { dst = (bf16*)(ws + WS_QA); ld = 512; col = cb - 512; }
                else if (cb == 1024) { dst = (bf16*)(ws + WS_KA); ld = 128; col = 0; }
                else if (cb == 1152) { dst = (bf16*)(ws + WS_VA); ld = 128; col = 0; }
                else if (cb < 1792) { dst = (bf16*)(ws + WS_QN); ld = 512; col = cb - 1280; sc = C2 / 64.f; }
                else if (cb < 2304) { dst = (bf16*)(ws + WS_KN); ld = 512; col = cb - 1792; }
                else { dst = (bf16*)(ws + WS_VN); ld = 512; col = cb - 2304; }
                const int c0 = col + wc * 32 + 8 * fq;
#pragma unroll
                for (int m = 0; m < 4; ++m) *(GAS v4u*)(dst + (size_t)(row0 + m * 16) * ld + c0) = pack8(acc[bj][m][0] * sc, acc[bj][m][1] * sc);
            }
        }
    }
};

struct PGate {
    static constexpr bool EARLY_AOFF = false, FP8 = !GATE_BF16; unsigned char* ws; int G, c; int K; unsigned kstepA;
    __device__ __forceinline__ bool next(int i, Unit& u) const { const long L = (long)i * G + c; if (L >= 2 * NPAN * 12) return false; pg8::static_decode((int)L, 2 * NPAN, 12, u.pm, u.pn); u.z = 0; return true; }
    __device__ __forceinline__ const char* a_base(const Unit& u) const { return GATE_BF16 ? (const char*)(ws + WS_HB) + (size_t)u.pm * 128 * 2048 : (const char*)(ws + WS_HB8) + (size_t)u.pm * 128 * 1024; }
    __device__ __forceinline__ unsigned a_off(const Unit&, int R, int Cc) const { return GATE_BF16 ? (unsigned)(R * 2048 + Cc * 2) : (unsigned)(R * 1024 + Cc * 2); }
    __device__ __forceinline__ const char* b_base(const Unit& u) const { return GATE_BF16 ? (const char*)(ws + WS_WIN) + (size_t)(2816 + u.pn * 256) * 2048 : (const char*)(ws + WS_WIN8) + (size_t)u.pn * 256 * 1024; }
    __device__ __forceinline__ void epi(const f32x4 (&acc)[2][4][2], f32x4 (&)[2][4][2], const Unit& u, int wr, int wc, int fr, int fq) const {
#pragma unroll
        for (int m = 0; m < 4; ++m) { const size_t r = (size_t)(u.pm * 128 + wr * 64 + m * 16 + fr);
#pragma unroll
            for (int bj = 0; bj < 2; ++bj) { const int c0 = u.pn * 256 + bj * 128 + wc * 32 + 8 * fq; f32x4 v0 = acc[bj][m][0] * (GATE_BF16 ? 1.f : 1.f / 64.f), v1 = acc[bj][m][1] * (GATE_BF16 ? 1.f : 1.f / 64.f);
                v0 = (f32x4){fsigmoid(v0[0]), fsigmoid(v0[1]), fsigmoid(v0[2]), fsigmoid(v0[3])}; v1 = (f32x4){fsigmoid(v1[0]), fsigmoid(v1[1]), fsigmoid(v1[2]), fsigmoid(v1[3])};
                if (GATE_BF16) *(GAS v4u*)((bf16*)(ws + WS_GATES) + r * 3072 + c0) = pack8(v0, v1);
                else *(GAS v2u*)((unsigned char*)(ws + WS_GATES) + r * 3072 + c0) = (v2u){pk4_fp8(v0[0], v0[1], v0[2], v0[3]), pk4_fp8(v1[0], v1[1], v1[2], v1[3])}; }
            __builtin_amdgcn_sched_barrier(0); }
    }
};

struct PS5A {
    static constexpr bool EARLY_AOFF = false, FP8 = false; unsigned char* ws; int G, c; int K; unsigned kstepA;
    __device__ __forceinline__ bool next(int i, Unit& u) const { const long L = (long)i * G + c; if (L >= 32 * 15) return false; const int l = (int)L; u.z = l / 15; const int r = l % 15; u.pm = r / 3; u.pn = r % 3; return true; }
    __device__ __forceinline__ const char* a_base(const Unit& u) const { return (const char*)(ws + WS_U) + (size_t)u.z * T * 32; }
    __device__ __forceinline__ unsigned a_off(const Unit& u, int h, int R, int Cc) const { int cr = u.pm * 256 + h * 128 + R; cr = cr < NCR ? cr : NCR - 1; return (unsigned)(cr * 512 + Cc) * 2u; }
    __device__ __forceinline__ const char* b_base(const Unit& u) const { return (const char*)(ws + WS_BT1) + ((size_t)u.z * 768 + u.pn * 256) * 512 * 2; }
    __device__ __forceinline__ void epi(const Acc& acc, const Unit& u, int wr, int wc, int fr, int fq) const {
#pragma unroll
        for (int ai = 0; ai < 2; ++ai)
#pragma unroll
            for (int m = 0; m < 4; ++m) { const int cr = u.pm * 256 + ai * 128 + wr * 64 + m * 16 + fr; if (cr >= NCR) continue;
#pragma unroll
                for (int bj = 0; bj < 2; ++bj) { const int n = bj * 128 + wc * 32 + 8 * fq;
                    if (u.pn < 2) *(GAS v4u*)((bf16*)(ws + WS_YG) + (size_t)u.z * T * 16 + (size_t)cr * 512 + u.pn * 256 + n) = pack8(acc[ai][bj][m][0], acc[ai][bj][m][1]);
                    else { GAS f32x4* o = (GAS f32x4*)((float*)(ws + WS_SST) + (size_t)cr * 8192 + u.z * 256 + n); o[0] = acc[ai][bj][m][0]; o[1] = acc[ai][bj][m][1]; } }
                __builtin_amdgcn_sched_barrier(0); }
    }
};

struct PS5B {
    static constexpr bool EARLY_AOFF = false, FP8 = false; unsigned char* ws; int G, c; int K; unsigned kstepA;
    __device__ __forceinline__ bool next(int i, Unit& u) const { const long L = (long)i * G + c; if (L >= 32 * 10) return false; const int l = (int)L; u.z = l / 10; const int r = l % 10; u.pm = r / 2; u.pn = r % 2; return true; }
    __device__ __forceinline__ const char* a_base(const Unit& u) const { return (const char*)(ws + WS_XST) + (size_t)u.z * 512; }
    __device__ __forceinline__ unsigned a_off(const Unit& u, int h, int R, int Cc) const { int cr = u.pm * 256 + h * 128 + R; cr = cr < NCR ? cr : NCR - 1; return (unsigned)(cr * 8192 + Cc) * 2u; }
    __device__ __forceinline__ const char* b_base(const Unit& u) const { return (const char*)(ws + WS_BT2) + ((size_t)u.z * 512 + u.pn * 256) * 256 * 2; }
    __device__ __forceinline__ void epi(const Acc& acc, const Unit& u, int wr, int wc, int fr, int fq) const {
#pragma unroll
        for (int ai = 0; ai < 2; ++ai) {
            v4u yw[4][2];
#pragma unroll
            for (int m = 0; m < 4; ++m) { int cr = u.pm * 256 + ai * 128 + wr * 64 + m * 16 + fr; cr = cr < NCR ? cr : NCR - 1;
#pragma unroll
                for (int bj = 0; bj < 2; ++bj) yw[m][bj] = *(const GAS v4u*)((const bf16*)(ws + WS_YG) + (size_t)u.z * T * 16 + (size_t)cr * 512 + u.pn * 256 + bj * 128 + wc * 32 + 8 * fq); }
#pragma unroll
            for (int m = 0; m < 4; ++m) { const int cr = u.pm * 256 + ai * 128 + wr * 64 + m * 16 + fr; if (cr >= NCR) continue;
#pragma unroll
                for (int bj = 0; bj < 2; ++bj) { const int nn = u.pn * 256 + bj * 128 + wc * 32 + 8 * fq, t = nn >> 4, h0 = nn & 15;
                    GAS v4u* p = (GAS v4u*)((bf16*)(ws + WS_YS) + (size_t)(chunk_m0(cr) + t) * 512 + u.z * 16 + h0);
                    f32x4 y0, y1; { const v4u w_ = yw[m][bj]; unpack8(w_, y0, y1); } y0 += acc[ai][bj][m][0]; y1 += acc[ai][bj][m][1];
                    y0 = (f32x4){gelu_tanh(y0[0]), gelu_tanh(y0[1]), gelu_tanh(y0[2]), gelu_tanh(y0[3])}; y1 = (f32x4){gelu_tanh(y1[0]), gelu_tanh(y1[1]), gelu_tanh(y1[2]), gelu_tanh(y1[3])};
                    *p = pack8(y0, y1); } } }
    }
};

__device__ __forceinline__ int half_panel(int hl, bool lat_only) { if (!lat_only) return hl; const int pl = hl >> 1; return 2 * (pl + (pl >> 5) + 1) + (hl & 1); }
struct PGlu {
    static constexpr bool EARLY_AOFF = false, FP8 = false; unsigned char* ws; int G, c; int K; unsigned kstepA; bool lat_only;
    __device__ __forceinline__ bool next(int i, Unit& u) const { const int nH = lat_only ? 256 : 2 * NPAN; const long L = (long)i * G + c; if (L >= nH * 2) return false; pg8::static_decode((int)L, nH, 2, u.pm, u.pn); u.pm = half_panel(u.pm, lat_only); u.z = 0; return true; }
    __device__ __forceinline__ const char* a_base(const Unit& u) const { return (const char*)(ws + WS_YS) + (size_t)u.pm * 128 * 512 * 2; }
    __device__ __forceinline__ unsigned a_off(const Unit&, int R, int Cc) const { return (unsigned)(R * 512 + Cc) * 2u; }
    __device__ __forceinline__ const char* b_base(const Unit& u) const { return (const char*)(ws + WS_WGLU) + (size_t)u.pn * 256 * 512 * 2; }
    __device__ __forceinline__ void epi(const f32x4 (&acc)[2][4][2], f32x4 (&)[2][4][2], const Unit& u, int wr, int wc, int fr, int fq) const {
        v4u zw[4][2];
#pragma unroll
        for (int m = 0; m < 4; ++m)
#pragma unroll
            for (int bj = 0; bj < 2; ++bj) zw[m][bj] = *(const GAS v4u*)((const bf16*)(ws + WS_YS) + (size_t)(u.pm * 128 + wr * 64 + m * 16 + fr) * 512 + u.pn * 256 + bj * 128 + wc * 32 + 8 * fq);
#pragma unroll
        for (int m = 0; m < 4; ++m) { const size_t r = (size_t)(u.pm * 128 + wr * 64 + m * 16 + fr);
#pragma unroll
            for (int bj = 0; bj < 2; ++bj) { const int cc = u.pn * 256 + bj * 128 + wc * 32 + 8 * fq;
                f32x4 z0, z1; { const v4u w_ = zw[m][bj]; unpack8(w_, z0, z1); } const f32x4 a0 = acc[bj][m][0], a1 = acc[bj][m][1];
                z0 = z0 * (f32x4){fsigmoid(a0[0]), fsigmoid(a0[1]), fsigmoid(a0[2]), fsigmoid(a0[3])}; z1 = z1 * (f32x4){fsigmoid(a1[0]), fsigmoid(a1[1]), fsigmoid(a1[2]), fsigmoid(a1[3])};
                *(GAS v4u*)((bf16*)(ws + WS_U) + r * 512 + cc) = pack8(z0, z1); } }
    }
};

typedef f32x4 Acc128[2][4][2];
struct PMerge {
    static constexpr bool EARLY_AOFF = false, FP8 = false; unsigned char* ws; int G, c; int K; unsigned kstepA; bool lat_only;
    __device__ __forceinline__ bool next(int i, Unit& u) const { const int nH = lat_only ? 256 : 2 * NPAN; const long tile = (long)(i / 3) * G + c; if (tile >= nH * 4) return false; pg8::static_decode((int)tile, nH, 4, u.pm, u.pn); u.pm = half_panel(u.pm, lat_only); u.z = i % 3; return true; }
    __device__ __forceinline__ const char* a_base(const Unit& u) const { const size_t off = u.z == 0 ? WS_U : (u.z == 1 ? WS_AO : WS_NO); return (const char*)(ws + off) + (size_t)u.pm * 128 * 512 * 2; }
    __device__ __forceinline__ unsigned a_off(const Unit&, int R, int Cc) const { return (unsigned)(R * 512 + Cc) * 2u; }
    __device__ __forceinline__ const char* b_base(const Unit& u) const { return (const char*)(ws + WS_WBR) + ((size_t)u.z * 1024 + u.pn * 256) * 512 * 2; }
    __device__ __forceinline__ void epi(const Acc128& acc, Acc128& mrg, const Unit& u, int wr, int wc, int fr, int fq) const {
        v2u gw[4][2];
#pragma unroll
        for (int m = 0; m < 4; ++m)
#pragma unroll
            for (int bj = 0; bj < 2; ++bj) gw[m][bj] = *(const GAS v2u*)((const unsigned char*)(ws + WS_GATES) + (size_t)(u.pm * 128 + wr * 64 + m * 16 + fr) * 3072 + u.z * 1024 + u.pn * 256 + bj * 128 + wc * 32 + 8 * fq);
#pragma unroll
        for (int m = 0; m < 4; ++m) { const size_t r = (size_t)(u.pm * 128 + wr * 64 + m * 16 + fr);
#pragma unroll
            for (int bj = 0; bj < 2; ++bj) { const int cc = u.pn * 256 + bj * 128 + wc * 32 + 8 * fq; const v2u w_ = gw[m][bj];
                const f32x4 g0 = (f32x4){__builtin_amdgcn_cvt_f32_fp8((int)w_.x, 0), __builtin_amdgcn_cvt_f32_fp8((int)w_.x, 1), __builtin_amdgcn_cvt_f32_fp8((int)w_.x, 2), __builtin_amdgcn_cvt_f32_fp8((int)w_.x, 3)};
                const f32x4 g1 = (f32x4){__builtin_amdgcn_cvt_f32_fp8((int)w_.y, 0), __builtin_amdgcn_cvt_f32_fp8((int)w_.y, 1), __builtin_amdgcn_cvt_f32_fp8((int)w_.y, 2), __builtin_amdgcn_cvt_f32_fp8((int)w_.y, 3)};
                if (u.z == 0) { mrg[bj][m][0] = g0 * acc[bj][m][0]; mrg[bj][m][1] = g1 * acc[bj][m][1]; }
                else { mrg[bj][m][0] += g0 * acc[bj][m][0]; mrg[bj][m][1] += g1 * acc[bj][m][1]; }
                if (u.z == 2) *(GAS v4u*)((bf16*)(ws + WS_HB) + r * 1024 + cc) = pack8(mrg[bj][m][0], mrg[bj][m][1]); } }
    }
};

struct PWout {
    static constexpr bool EARLY_AOFF = false, FP8 = false; unsigned char* ws; float* out; const float* mod; int G, c; int K; unsigned kstepA; bool lat_only;
    __device__ __forceinline__ bool next(int i, Unit& u) const { const int nH = lat_only ? 256 : 2 * NPAN; const long L = (long)i * G + c; if (L >= nH * 4) return false; pg8::static_decode((int)L, nH, 4, u.pm, u.pn); u.pm = half_panel(u.pm, lat_only); u.z = 0; return true; }
    __device__ __forceinline__ const char* a_base(const Unit& u) const { return (const char*)(ws + WS_HB) + (size_t)u.pm * 128 * 1024 * 2; }
    __device__ __forceinline__ unsigned a_off(const Unit&, int R, int Cc) const { return (unsigned)(R * 1024 + Cc) * 2u; }
    __device__ __forceinline__ const char* b_base(const Unit& u) const { return (const char*)(ws + WS_WOUT) + (size_t)u.pn * 256 * 1024 * 2; }
    __device__ __forceinline__ void epi(const f32x4 (&acc)[2][4][2], f32x4 (&)[2][4][2], const Unit& u, int wr, int wc, int fr, int fq) const {
        const int pm = u.pm >> 1, hh = u.pm & 1, b = pm / 33, pr = pm % 33, cond = pr == 0 ? 4 : b;
        float* xb = pr == 0 ? (float*)(ws + WS_CTXS) + ((size_t)b * 256 + hh * 128) * D : out + ((size_t)b * SEQ + (size_t)(pr - 1) * 256 + hh * 128) * D;
        const float* g1 = mod + cond * 6144 + 2048;
        f32x4 xv[2][4][2];
#pragma unroll
        for (int bj = 0; bj < 2; ++bj)
#pragma unroll
            for (int m = 0; m < 4; ++m) { const GAS f32x4* p = (const GAS f32x4*)(xb + (size_t)(wr * 64 + m * 16 + fr) * D + u.pn * 256 + bj * 128 + wc * 32 + 8 * fq); xv[bj][m][0] = p[0]; xv[bj][m][1] = p[1]; }
#pragma unroll
        for (int bj = 0; bj < 2; ++bj) { const int cc = u.pn * 256 + bj * 128 + wc * 32 + 8 * fq; const f32x4 ga = *(const GAS f32x4*)(g1 + cc), gb = *(const GAS f32x4*)(g1 + cc + 4);
#pragma unroll
            for (int m = 0; m < 4; ++m) { GAS f32x4* p = (GAS f32x4*)(xb + (size_t)(wr * 64 + m * 16 + fr) * D + cc);
                p[0] = xv[bj][m][0] + ga * acc[bj][m][0]; p[1] = xv[bj][m][1] + gb * acc[bj][m][1]; } }
    }
};

struct ExpTab { int cnt[16], tile0[17]; };
__device__ __forceinline__ int exp_find(const int (&tile0)[17], int q) { int e = 0;
#pragma unroll
    for (int k = 1; k < 16; ++k) e += (q >= tile0[k]) ? 1 : 0;
    return e; }

struct PMoe1 {
    static constexpr bool EARLY_AOFF = true, FP8 = true; unsigned char* ws; const LAS int* tab; int G, c; int K; unsigned kstepA;
    __device__ __forceinline__ bool next(int i, Unit& u) const { const long L = (long)i * G + c; const int total = __builtin_amdgcn_readfirstlane(tab[32]) * 4; if (L >= total) return false; const int q = (int)L >> 2; u.pn = (int)L & 3;
        int e = 0;
#pragma unroll
        for (int k = 1; k < 16; ++k) e += (q >= __builtin_amdgcn_readfirstlane(tab[16 + k])) ? 1 : 0;
        u.z = e; u.pm = q - __builtin_amdgcn_readfirstlane(tab[16 + e]); return true; }
    __device__ __forceinline__ const char* a_base(const Unit&) const { return (const char*)(ws + WS_HB8); }
    __device__ __forceinline__ unsigned a_off(const Unit& u, int R, int Cc) const { int r = u.pm * 128 + R; const int n = __builtin_amdgcn_readfirstlane(tab[u.z]); r = r < n ? r : n - 1;
        const int ent = ((const int*)(ws + WS_LIST))[(size_t)u.z * T + r]; return (unsigned)((ent >> 1) * 1024 + Cc * 2); }
    __device__ __forceinline__ const char* b_base(const Unit& u) const { return (const char*)(ws + WS_MOE1) + ((size_t)u.z * 1024 + u.pn * 256) * 1024; }
    __device__ __forceinline__ void epi(const f32x4 (&acc)[2][4][2], f32x4 (&)[2][4][2], const Unit& u, int wr, int wc, int fr, int fq) const {
        const size_t arow0 = (size_t)(__builtin_amdgcn_readfirstlane(tab[16 + u.z]) + u.pm) * 128;
#pragma unroll
        for (int m = 0; m < 4; ++m) { const f32x4 g0 = acc[0][m][0] * (1.f / 64.f), g1 = acc[0][m][1] * (1.f / 64.f), u0 = acc[1][m][0] * (8.f / 64.f), u1 = acc[1][m][1] * (8.f / 64.f);
            const f32x4 v0 = (f32x4){g0[0] * fsigmoid(g0[0]), g0[1] * fsigmoid(g0[1]), g0[2] * fsigmoid(g0[2]), g0[3] * fsigmoid(g0[3])} * u0;
            const f32x4 v1 = (f32x4){g1[0] * fsigmoid(g1[0]), g1[1] * fsigmoid(g1[1]), g1[2] * fsigmoid(g1[2]), g1[3] * fsigmoid(g1[3])} * u1;
            *(GAS v2u*)((unsigned char*)(ws + WS_ACT) + (arow0 + wr * 64 + m * 16 + fr) * 512 + u.pn * 128 + wc * 32 + 8 * fq) = (v2u){pk4_fp8(v0[0], v0[1], v0[2], v0[3]), pk4_fp8(v1[0], v1[1], v1[2], v1[3])}; }
    }
};
struct PMoe2 {
    static constexpr bool EARLY_AOFF = false, FP8 = true; unsigned char* ws; const LAS int* tab; int G, c; int K; unsigned kstepA;
    __device__ __forceinline__ bool next(int i, Unit& u) const { const long L = (long)i * G + c; const int total = __builtin_amdgcn_readfirstlane(tab[32]) * 4; if (L >= total) return false; const int q = (int)L >> 2; u.pn = (int)L & 3;
        int e = 0;
#pragma unroll
        for (int k = 1; k < 16; ++k) e += (q >= __builtin_amdgcn_readfirstlane(tab[16 + k])) ? 1 : 0;
        u.z = e; u.pm = q - __builtin_amdgcn_readfirstlane(tab[16 + e]); return true; }
    __device__ __forceinline__ const char* a_base(const Unit& u) const { return (const char*)(ws + WS_ACT) + (size_t)(__builtin_amdgcn_readfirstlane(tab[16 + u.z]) + u.pm) * 128 * 512; }
    __device__ __forceinline__ unsigned a_off(const Unit&, int R, int Cc) const { return (unsigned)(R * 512 + Cc * 2); }
    __device__ __forceinline__ const char* b_base(const Unit& u) const { return (const char*)(ws + WS_MOE2) + ((size_t)u.z * 1024 + u.pn * 256) * 512; }
    __device__ __forceinline__ void epi(const f32x4 (&acc)[2][4][2], f32x4 (&)[2][4][2], const Unit& u, int wr, int wc, int fr, int fq) const {
        const int n = __builtin_amdgcn_readfirstlane(tab[u.z]);
        int entv[4]; float wv[4];
#pragma unroll
        for (int m = 0; m < 4; ++m) { int r = u.pm * 128 + wr * 64 + m * 16 + fr; r = r < n ? r : n - 1; entv[m] = ((const int*)(ws + WS_LIST))[(size_t)u.z * T + r]; }
#pragma unroll
        for (int m = 0; m < 4; ++m) wv[m] = ((const float*)(ws + WS_RW))[entv[m]] * (1.f / 256.f);
#pragma unroll
        for (int m = 0; m < 4; ++m) { const int r = u.pm * 128 + wr * 64 + m * 16 + fr; if (r >= n) continue;
            const int ent = entv[m]; const float w = wv[m];
#pragma unroll
            for (int bj = 0; bj < 2; ++bj)
                *(GAS v4u*)((bf16*)(ws + WS_YSLOT) + (size_t)ent * 1024 + u.pn * 256 + bj * 128 + wc * 32 + 8 * fq) = pack8(acc[bj][m][0] * w, acc[bj][m][1] * w); }
    }
};
struct PMoe1B {
    static constexpr bool EARLY_AOFF = true, FP8 = false; unsigned char* ws; const LAS int* tab; int G, c; int K; unsigned kstepA;
    __device__ __forceinline__ bool next(int i, Unit& u) const { const long L = (long)i * G + c; const int total = tab[32] * 4; if (L >= total) return false; const int q = (int)L >> 2; u.pn = (int)L & 3;
        int e = 0;
#pragma unroll
        for (int k = 1; k < 16; ++k) e += (q >= tab[16 + k]) ? 1 : 0;
        u.z = e; u.pm = q - tab[16 + e]; return true; }
    __device__ __forceinline__ const char* a_base(const Unit&) const { return (const char*)(ws + WS_HB); }
    __device__ __forceinline__ unsigned a_off(const Unit& u, int h, int R, int Cc) const { int r = u.pm * 256 + h * 128 + R; const int n = tab[u.z]; r = r < n ? r : n - 1;
        const int ent = ((const int*)(ws + WS_LIST))[(size_t)u.z * T + r]; return (unsigned)((ent >> 1) * 1024 + Cc) * 2u; }
    __device__ __forceinline__ const char* b_base(const Unit& u) const { return (const char*)(ws + WS_MOE1) + ((size_t)u.z * 1024 + u.pn * 256) * 1024 * 2; }
    __device__ __forceinline__ void epi(const Acc& acc, const Unit& u, int wr, int wc, int fr, int fq) const {
        const size_t arow0 = (size_t)(tab[16 + u.z] + u.pm) * 256;
#pragma unroll
        for (int ai = 0; ai < 2; ++ai)
#pragma unroll
            for (int m = 0; m < 4; ++m) { const f32x4 g0 = acc[ai][0][m][0], g1 = acc[ai][0][m][1], u0 = acc[ai][1][m][0], u1 = acc[ai][1][m][1];
                const f32x4 v0 = (f32x4){g0[0] * fsigmoid(g0[0]), g0[1] * fsigmoid(g0[1]), g0[2] * fsigmoid(g0[2]), g0[3] * fsigmoid(g0[3])} * u0;
                const f32x4 v1 = (f32x4){g1[0] * fsigmoid(g1[0]), g1[1] * fsigmoid(g1[1]), g1[2] * fsigmoid(g1[2]), g1[3] * fsigmoid(g1[3])} * u1;
                *(GAS v4u*)((bf16*)(ws + WS_ACTB) + (arow0 + ai * 128 + wr * 64 + m * 16 + fr) * 512 + u.pn * 128 + wc * 32 + 8 * fq) = pack8(v0, v1); }
    }
};
struct PMoe2B {
    static constexpr bool EARLY_AOFF = false, FP8 = false; unsigned char* ws; const LAS int* tab; int G, c; int K; unsigned kstepA;
    __device__ __forceinline__ bool next(int i, Unit& u) const { const long L = (long)i * G + c; const int total = tab[32] * 4; if (L >= total) return false; const int q = (int)L >> 2; u.pn = (int)L & 3;
        int e = 0;
#pragma unroll
        for (int k = 1; k < 16; ++k) e += (q >= tab[16 + k]) ? 1 : 0;
        u.z = e; u.pm = q - tab[16 + e]; return true; }
    __device__ __forceinline__ const char* a_base(const Unit& u) const { return (const char*)(ws + WS_ACTB) + (size_t)(tab[16 + u.z] + u.pm) * 256 * 512 * 2; }
    __device__ __forceinline__ unsigned a_off(const Unit&, int h, int R, int Cc) const { return (unsigned)((h * 128 + R) * 512 + Cc) * 2u; }
    __device__ __forceinline__ const char* b_base(const Unit& u) const { return (const char*)(ws + WS_MOE2) + ((size_t)u.z * 1024 + u.pn * 256) * 512 * 2; }
    __device__ __forceinline__ void epi(const Acc& acc, const Unit& u, int wr, int wc, int fr, int fq) const {
        const int n = tab[u.z];
#pragma unroll
        for (int ai = 0; ai < 2; ++ai)
#pragma unroll
            for (int m = 0; m < 4; ++m) { const int r = u.pm * 256 + ai * 128 + wr * 64 + m * 16 + fr; if (r >= n) continue;
                const int ent = ((const int*)(ws + WS_LIST))[(size_t)u.z * T + r]; const float w = ((const float*)(ws + WS_RW))[ent];
#pragma unroll
                for (int bj = 0; bj < 2; ++bj)
                    *(GAS v4u*)((bf16*)(ws + WS_YSLOT) + (size_t)ent * 1024 + u.pn * 256 + bj * 128 + wc * 32 + 8 * fq) = pack8(acc[ai][bj][m][0] * w, acc[ai][bj][m][1] * w); }
    }
};
__device__ __forceinline__ void build_exptab(const Ctx& C, LAS int* tab, int l, int tsh = 7) {
    __syncthreads();
    if (threadIdx.x == 0) { int t0 = 0;
        for (int e = 0; e < 16; ++e) { const int n = (int)__hip_atomic_load((unsigned*)(C.ctl + CW_CNT + l * 1024 + 64 * e), RLX_AGENT); tab[e] = n; tab[16 + e] = t0; t0 += (n + (1 << tsh) - 1) >> tsh; }
        tab[32] = t0; }
    __syncthreads();
}
__device__ __forceinline__ void phase_attn(const Ctx& C, int l, unsigned char* lds_gen) {
    phase_carry(C, l);
    char* shm = (char*)lds_gen;
    bf16* QA = WSP(bf16, WS_QA); bf16* KA = WSP(bf16, WS_KA); bf16* VA = WSP(bf16, WS_VA); bf16* QN = WSP(bf16, WS_QN); bf16* KN = WSP(bf16, WS_KN); bf16* VN = WSP(bf16, WS_VN);
#ifndef ATTN_SEL
#define ATTN_SEL 3
#endif
#ifdef REPMASK
#define REPMASK_ REPMASK
#else
#define REPMASK_ 0
#endif
    const int per = (1024 + C.G - 1) / C.G;
    bool nomax; { float gq = 0.f, gk = 0.f; for (int i = 0; i < 64; ++i) { gq = fmaxf(gq, fabsf(C.in[I_QNG][l * 64 + i])); gk = fmaxf(gk, fabsf(C.in[I_KNG][l * 64 + i])); } nomax = 64.f * gq * gk * C2 <= 60.f; }
    if (ATTN_SEL & 1) for (int i = 0; i < per * (1 + ((REPMASK_ >> 13) & 1)); ++i) { const int id = C.vcu * per + (i % per); if (id >= 1024) continue; const int bh = id >> 5, b = bh >> 3, h = bh & 7, qb = id & 31;
        const bf16* Qu = QA + (size_t)(b * LB + CTX + qb * 256) * 512 + h * 64;
        if (nomax) attn_body::attn_unit<8, false, 512, 128, true>(Qu, 512, KA + (size_t)(b * LB) * 128 + (h >> 2) * 64, VA + (size_t)(b * LB) * 128 + (h >> 2) * 64, 128, WSP(bf16, WS_AO) + (Qu - QA), LB / 64, 0, 0, shm);
        else attn_body::attn_unit<8, false, 512, 128, false>(Qu, 512, KA + (size_t)(b * LB) * 128 + (h >> 2) * 64, VA + (size_t)(b * LB) * 128 + (h >> 2) * 64, 128, WSP(bf16, WS_AO) + (Qu - QA), LB / 64, 0, 0, shm);
    }
    LAS float* bt = (LAS float*)(C.lds + attn_body::LDS_BT);
    const int nctx = (C.vcu >= 64 && C.vcu < 128) ? 1 : 0;
    if (ATTN_SEL & 2) for (int i0 = 0; i0 < (per + nctx) * (1 + ((REPMASK_ >> 14) & 1)); ++i0) { const int i = i0 % (per + nctx);
        const bf16 *Qu, *Kh, *Vh; bf16* Ou; int kvp = 512, NT = 4, r0 = 0, rlo = 0;
        if (i < per) { const int id = C.vcu * per + i; if (id >= 1024) continue; const int bh = id >> 5, b = bh >> 3, h = bh & 7; r0 = (id & 31) * 4;
            const float* rp = C.in[I_RPB] + (size_t)(l * 8 + h) * 465;
            for (int k = C.tid; k < 465; k += 512) bt[k] = rp[k] * LOG2E;
            rlo = r0 - 4 < 0 ? 0 : (r0 - 4 > 120 ? 120 : r0 - 4); const int rh_ = r0 - 1 < 0 ? 0 : (r0 - 1 > 120 ? 120 : r0 - 1), nloc = rh_ + 8 - rlo; NT = (4 + nloc + 1) & ~1;
            Qu = QN + (size_t)(b * LB + CTX + r0 * 64) * 512 + h * 64; Ou = WSP(bf16, WS_NO) + (Qu - QN); Kh = KN + (size_t)(b * LB) * 512 + h * 64; Vh = VN + (size_t)(b * LB) * 512 + h * 64; }
        else { int j = C.vcu - 64; if (j < 32) { const int b = j >> 3, h = j & 7; Qu = QA + (size_t)(b * LB) * 512 + h * 64; Ou = WSP(bf16, WS_AO) + (Qu - QA); Kh = KA + (size_t)(b * LB) * 128 + (h >> 2) * 64; Vh = VA + (size_t)(b * LB) * 128 + (h >> 2) * 64; kvp = 128; }
            else { j -= 32; const int b = j >> 3, h = j & 7; Qu = QN + (size_t)(b * LB) * 512 + h * 64; Ou = WSP(bf16, WS_NO) + (Qu - QN); Kh = KN + (size_t)(b * LB) * 512 + h * 64; Vh = VN + (size_t)(b * LB) * 512 + h * 64; } }
        attn_body::attn_unit<8, true, 512, 0>(Qu, 512, Kh, Vh, kvp, Ou, NT, r0, rlo, shm);
    }
}

constexpr int NPH = 46;
__global__ void __launch_bounds__(NWAVES * 64, 2) fwd(Args args) {
    extern __shared__ __attribute__((aligned(16))) unsigned char lds[];
    Ctx C; C.in = (const __attribute__((address_space(4))) CFP*)__builtin_amdgcn_kernarg_segment_ptr(); C.out = args.out; C.ws = args.ws; C.lds = (LAS unsigned char*)lds; C.ctl = (gu32*)(args.ws + WS_CTL);
    C.tid = 0; C.lane = 0; C.wave = __builtin_amdgcn_readfirstlane((int)threadIdx.x >> 6);
    C.G = gridDim.x; { const int bx = blockIdx.x; C.vcu = (C.G % 8 == 0) ? (bx % 8) * (C.G / 8) + bx / 8 : bx; }
    for (int u = threadIdx.x; u < (LDS_BYTES - LDSCTL_OFF) / 4; u += NWAVES * 64) ((LAS unsigned*)(C.lds + LDSCTL_OFF))[u] = 0u;
    __syncthreads();
    const int lo = args.ph_lo, hi = args.ph_hi;
    XcdBarrier bar; bar.bar = (unsigned*)(C.ctl + CW_BAR); bar.x = 0; bar.st = nullptr;
    if (hi - lo > 1) bar = xcd_barrier_post((unsigned*)(C.ctl + CW_BAR), (volatile LAS unsigned*)(C.lds + MISC_OFF) + 8);
    LAS int* tab = (LAS int*)(C.lds + LDSCTL_OFF);
    const int cg = (int)blockIdx.x;
#ifndef PHMASK
#define PHMASK 0xFFFF
#endif
#define IN(k) (lo <= (k) && (k) < hi)
#define EN(b) ((PHMASK >> (b)) & 1)
#ifndef REPMASK
#define REPMASK 0
#endif
#define RUN(b, stmt) do { stmt; if ((REPMASK >> (b)) & 1) { stmt; } } while (0)
#ifdef DIAG_SEL
#define DIAG_ACC(ty) do { if (blockIdx.x == 0 && threadIdx.x == 0) { volatile LAS unsigned* dg = (volatile LAS unsigned*)(C.lds + LDSCTL_OFF + 160); const unsigned now = (unsigned)__builtin_amdgcn_s_memrealtime(); dg[8 + (ty)] += now - dg[0]; dg[0] = now; } } while (0)
#else
#define DIAG_ACC(ty) do {} while (0)
#endif
#define SEAM(k) do { if (IN(k) && IN((k) + 1)) xcd_barrier(bar); DIAG_ACC((k) == 0 ? 11 : ((k) - 1) % 11); } while (0)
#define LWS() ({ const __attribute__((address_space(4))) CFP* k_ = C.in; asm volatile("" : "+s"(k_)); (unsigned char*)k_[30]; })
#define LC() ({ Ctx c_ = C; c_.tid = threadIdx.x; asm volatile("" : "+v"(c_.tid)); c_.lane = c_.tid & 63; asm volatile("" : "+s"(c_.in)); c_.ws = (unsigned char*)c_.in[30]; c_.out = (float*)c_.in[29]; c_.ctl = (gu32*)(c_.ws + WS_CTL); c_; })
#ifdef DIAG_SEL
    if (blockIdx.x == 0 && threadIdx.x == 0) { volatile LAS unsigned* dg = (volatile LAS unsigned*)(C.lds + LDSCTL_OFF + 160); dg[0] = (unsigned)__builtin_amdgcn_s_memrealtime(); dg[1] = dg[0]; }
#endif
    if (EN(11) && IN(0)) { const Ctx Cl = LC(); phase_mod(Cl); RUN(11, phase_s5mats(Cl, 0, Cl.vcu); phase_weights(Cl, 0)); }
    SEAM(0);
    for (int l = 0; l < NLAYER; ++l) {
        const int pb = 1 + 11 * l;
        if (EN(0) && IN(pb)) { const Ctx Cl = LC(); if (l == 0) phase_rows<0>(Cl, 0); else { phase_weights(Cl, l); phase_rows<1>(Cl, l); } }
        SEAM(pb);
        if (EN(1) && IN(pb + 1)) { if (W8_ALL) { PWin8 P{LWS(), C.G, cg, 1024, 128u}; pg8::gemm_phase_m128(C.lds, P); } else { { PWin P{LWS(), C.G, cg, 1024, 128u}; pg8::gemm_phase(C.lds, P); } { PGate P{LWS(), C.G, cg, 1024, 128u}; pg8::gemm_phase_m128(C.lds, P); } } }
        SEAM(pb + 1);
        if (EN(2) && IN(pb + 2)) { { const Ctx Cl = LC(); phase_qkprep(Cl, l); } PS5A P{LWS(), C.G, cg, 512, 128u}; RUN(2, pg8::gemm_phase(C.lds, P)); }
        SEAM(pb + 2);
        if (EN(3) && IN(pb + 3)) { const Ctx Cl = LC(); RUN(3, phase_attn(Cl, l, lds)); }
        SEAM(pb + 3);
        if (EN(4) && IN(pb + 4)) { PS5B P{LWS(), C.G, cg, 256, 128u}; pg8::gemm_phase(C.lds, P); }
        SEAM(pb + 4);
        if (EN(5) && IN(pb + 5)) { PGlu P{LWS(), C.G, cg, 512, 128u, l == NLAYER - 1}; pg8::gemm_phase_m128(C.lds, P); }
        SEAM(pb + 5);
        if (EN(6) && IN(pb + 6)) { { PMerge P{LWS(), C.G, cg, 512, 128u, l == NLAYER - 1}; pg8::gemm_phase_m128(C.lds, P); }
            if (l < NLAYER - 1) { const Ctx Cl = LC(); phase_s5mats(Cl, l + 1, C.G >= 160 ? cg - 32 : cg); } }
        SEAM(pb + 6);
        if (EN(7) && IN(pb + 7)) { unsigned char* wl_ = LWS(); PWout P{wl_, (float*)C.in[29], (const float*)(wl_ + WS_MOD) + (size_t)l * 5 * 6144, C.G, cg, 1024, 128u, l == NLAYER - 1}; pg8::gemm_phase_m128(C.lds, P); }
        SEAM(pb + 7);
        if (EN(8) && IN(pb + 8)) { const Ctx Cl = LC(); phase_norm2(Cl, l); }
        SEAM(pb + 8);
        if (EN(9) && IN(pb + 9)) { if (FP8_MOE) { build_exptab(C, tab, l); PMoe1 P{LWS(), tab, C.G, cg, 1024, 128u}; pg8::gemm_phase_m128(C.lds, P); } else { build_exptab(C, tab, l, 8); PMoe1B P{LWS(), tab, C.G, cg, 1024, 128u}; pg8::gemm_phase(C.lds, P); } }
        SEAM(pb + 9);
        if (EN(10) && IN(pb + 10)) { if (FP8_MOE) { build_exptab(C, tab, l); PMoe2 P{LWS(), tab, C.G, cg, 512, 128u}; pg8::gemm_phase_m128(C.lds, P); } else { build_exptab(C, tab, l, 8); PMoe2B P{LWS(), tab, C.G, cg, 512, 128u}; pg8::gemm_phase(C.lds, P); } }
        SEAM(pb + 10);
    }
    if (EN(12) && IN(NPH - 1)) { const Ctx Cl = LC(); phase_rows<2>(Cl, NLAYER); }
#ifdef DIAG_SEL
    xcd_barrier(bar); DIAG_ACC(12);
    if (blockIdx.x == 0 && threadIdx.x == 0) { volatile LAS unsigned* dg = (volatile LAS unsigned*)(C.lds + LDSCTL_OFF + 160); dg[8 + 13] = dg[0] - dg[1];
        for (int i = 0; i < 14; ++i) __hip_atomic_store(C.ctl + 2048 + i, dg[8 + i], RLX_AGENT); }
    xcd_barrier(bar);
    { const float d1 = (float)__hip_atomic_load(C.ctl + 2048 + (DIAG_SEL), RLX_AGENT) * 0.01f, d2 = (float)__hip_atomic_load(C.ctl + 2048 + (DIAG_SEL) + 1, RLX_AGENT) * 0.01f;
      const float c1 = sqrtf(d1); float* o = args.out;
      for (size_t i = (size_t)blockIdx.x * 512 + threadIdx.x; i < (size_t)NB * SEQ * D; i += (size_t)gridDim.x * 512) o[i] = (i == 12345) ? d2 : c1; }
#endif
#undef IN
#undef SEAM
}

#ifndef MK_PER_PHASE
#define MK_PER_PHASE 0
#endif
extern "C" void kernel_launch(void* const* d_in, const int* in_sizes, int n_in, void* d_out, int out_size, void* d_ws, size_t ws_size, hipStream_t stream) {
    static int grid = 0;
    if (grid == 0) {
        if (n_in != 29 || out_size != NB * SEQ * D || ws_size < WS_END) { fprintf(stderr, "kernel_launch: unexpected shapes (n_in %d out %d ws %zu)\n", n_in, out_size, ws_size); grid = -1; return; }
        int dev = 0, cus = 0, per_cu = 0;
        if (hipGetDevice(&dev) != hipSuccess || hipDeviceGetAttribute(&cus, hipDeviceAttributeMultiprocessorCount, dev) != hipSuccess) { grid = -1; return; }
        if (hipFuncSetAttribute((const void*)fwd, hipFuncAttributeMaxDynamicSharedMemorySize, LDS_BYTES) != hipSuccess) { grid = -1; return; }
        if (hipOccupancyMaxActiveBlocksPerMultiprocessor(&per_cu, (const void*)fwd, NWAVES * 64, LDS_BYTES) != hipSuccess || per_cu < 1) fprintf(stderr, "kernel_launch: occupancy query says %d\n", per_cu);
        (void)hipGetLastError();
        grid = cus;
    }
    if (grid < 0) return;
    (void)hipMemsetAsync((char*)d_ws + WS_CTL, 0, CTL_ZERO_BYTES, stream);
    Args a{};
    for (int i = 0; i < 29; ++i) a.in[i] = (const float*)d_in[i];
    a.out = (float*)d_out; a.ws = (unsigned char*)d_ws;
#if MK_PER_PHASE
    for (int p = 0; p < NPH; ++p) { a.ph_lo = p; a.ph_hi = p + 1; hipLaunchKernelGGL(fwd, dim3(grid), dim3(NWAVES * 64), LDS_BYTES, stream, a); }
#else
    a.ph_lo = 0; a.ph_hi = NPH; hipLaunchKernelGGL(fwd, dim3(grid), dim3(NWAVES * 64), LDS_BYTES, stream, a);
#endif
}
```

```cpp
#define FP8_MOE 1
#define GATE_BF16 0
#define W8_ALL 1
#define H8_WRITE 1
#ifndef H8_WRITE
#define H8_WRITE 1
#endif
#ifndef GATE_BF16
#define GATE_BF16 0
#endif
#include <hip/hip_runtime.h>
#include <cstdio>
#include <cstdint>

#define GAS __attribute__((address_space(1)))
#define LAS __attribute__((address_space(3)))
typedef unsigned short bf16;
typedef unsigned v4u __attribute__((ext_vector_type(4)));
typedef unsigned v2u __attribute__((ext_vector_type(2)));
typedef float f32x4 __attribute__((ext_vector_type(4)));
typedef float f32x2 __attribute__((ext_vector_type(2)));
typedef float f32x16 __attribute__((ext_vector_type(16)));
typedef short bf16x8 __attribute__((ext_vector_type(8)));
typedef short s16x4 __attribute__((ext_vector_type(4)));
typedef GAS unsigned gu32;
#define RLX_AGENT __ATOMIC_RELAXED, __HIP_MEMORY_SCOPE_AGENT
#define LDS_WAIT() asm volatile("s_waitcnt lgkmcnt(0)" ::: "memory")
#define VM_WAIT() asm volatile("s_waitcnt vmcnt(0)" ::: "memory")

constexpr int NB = 4, SEQ = 8192, CTX = 256, LB = SEQ + CTX, T = NB * LB, D = 1024, NPAN = T / 256;
constexpr int NLAYER = 4, INW = 5888, NCH = LB / 32, NCR = NB * NCH;
constexpr int NEXP = 16, FF = 512;
constexpr float EPS = 1e-6f;
constexpr float LOG2E = 1.4426950408889634f;
constexpr float C2 = 0.125f * LOG2E;
constexpr int NWAVES = 8;

constexpr size_t MiB = 1u << 20;
constexpr size_t WS_CTL = 0, CTL_ZERO_BYTES = 1 * MiB;
constexpr size_t WS_MOD = 1 * MiB;
constexpr size_t WS_LIST = 2 * MiB;
constexpr size_t WS_RW = 5 * MiB;
constexpr size_t WS_CTXS = 6 * MiB;
constexpr size_t WS_SST = 10 * MiB;
constexpr size_t WS_HB8 = WS_SST;
constexpr size_t WS_XST = 44 * MiB;
constexpr size_t WS_BT1 = 61 * MiB;
constexpr size_t WS_BT2 = 85 * MiB;
constexpr size_t WS_WIN = 93 * MiB;
constexpr size_t WS_WIN8 = WS_WIN + (size_t)2816 * 1024 * 2;
constexpr size_t WS_WGLU = 105 * MiB;
constexpr size_t WS_WBR = 106 * MiB;
constexpr size_t WS_WOUT = 109 * MiB;
constexpr size_t WS_MOE1 = 111 * MiB;
constexpr size_t WS_MOE2 = 143 * MiB;
constexpr size_t WS_HB = 159 * MiB;
constexpr size_t WS_U = 225 * MiB;
constexpr size_t WS_QA = 258 * MiB;
constexpr size_t WS_KA = 291 * MiB;
constexpr size_t WS_VA = 300 * MiB;
constexpr size_t WS_QN = 309 * MiB;
constexpr size_t WS_KN = 342 * MiB;
constexpr size_t WS_VN = 375 * MiB;
constexpr size_t WS_YS = 408 * MiB;
constexpr size_t WS_GATES = 441 * MiB;
constexpr size_t WS_ACT = WS_QN;
constexpr size_t WS_ACTB = WS_QN;
constexpr size_t WS_YSLOT = WS_GATES;
constexpr size_t WS_AO = 574 * MiB;
constexpr size_t WS_NO = 607 * MiB;
constexpr size_t WS_YG = 640 * MiB;
constexpr size_t WS_XS = 673 * MiB;
constexpr size_t WS_END = 739 * MiB;
static_assert(WS_GATES + (size_t)T * 3072 * (GATE_BF16 ? 2 : 1) <= WS_AO && WS_YSLOT + (size_t)2 * T * 1024 * 2 <= WS_AO && WS_ACT + (size_t)(2 * T + 4096) * 512 * 2 <= WS_YS, "ws map");
constexpr int CW_FAIL = 8;
constexpr int CW_CNT = 64;
constexpr int CW_BAR = 8192;

constexpr int RING_BYTES = 131072, LDS_BYTES = 147456, LDSCTL_OFF = LDS_BYTES - 512, MISC_OFF = LDSCTL_OFF + 320;

__device__ __forceinline__ unsigned f2bf(float f) { unsigned u = __builtin_bit_cast(unsigned, f); return (u + 0x7fffu + ((u >> 16) & 1u)) >> 16; }
__device__ __forceinline__ unsigned pk2(float lo, float hi) { return f2bf(lo) | (f2bf(hi) << 16); }
__device__ __forceinline__ float bf2f(unsigned b) { return __builtin_bit_cast(float, b << 16); }
__device__ __forceinline__ float bflo(unsigned w) { return __builtin_bit_cast(float, w << 16); }
__device__ __forceinline__ float bfhi(unsigned w) { return __builtin_bit_cast(float, w & 0xffff0000u); }
typedef float f32x2_c __attribute__((ext_vector_type(2))); typedef __bf16 bf16x2_c __attribute__((ext_vector_type(2)));
__device__ __forceinline__ unsigned cvt_pk_bf16(float lo, float hi) { const f32x2_c v = {lo, hi}; return __builtin_bit_cast(unsigned, __builtin_convertvector(v, bf16x2_c)); }
typedef int v8i __attribute__((ext_vector_type(8)));
typedef int v4i __attribute__((ext_vector_type(4)));
__device__ __forceinline__ float clamp8(float x) { return __builtin_fminf(__builtin_fmaxf(x, -448.f), 448.f); }
__device__ __forceinline__ unsigned pk4_fp8(float a, float b, float c, float d) { int w = 0; w = __builtin_amdgcn_cvt_pk_fp8_f32(clamp8(a), clamp8(b), w, false); w = __builtin_amdgcn_cvt_pk_fp8_f32(clamp8(c), clamp8(d), w, true); return (unsigned)w; }
__device__ __forceinline__ float fsigmoid(float x) { return __builtin_amdgcn_rcpf(1.f + __builtin_amdgcn_exp2f(-LOG2E * x)); }
__device__ __forceinline__ float gelu_tanh(float x) { const float u = 0.7978845608f * (x + 0.044715f * x * x * x); return x * __builtin_amdgcn_rcpf(1.f + __builtin_amdgcn_exp2f(-2.f * LOG2E * u)); }
__device__ __forceinline__ float shflx(float v, int m, int lane) { return __builtin_bit_cast(float, __builtin_amdgcn_ds_bpermute((lane ^ m) << 2, __builtin_bit_cast(int, v))); }
template <int CTRL, int RM>
__device__ __forceinline__ float dpp_mov(float v) { return __builtin_bit_cast(float, __builtin_amdgcn_update_dpp(0, __builtin_bit_cast(int, v), CTRL, RM, 0xF, true)); }
__device__ __forceinline__ float wave_sum(float v, int) {
    v += dpp_mov<0xB1, 0xF>(v);
    v += dpp_mov<0x4E, 0xF>(v);
    v += dpp_mov<0x141, 0xF>(v);
    v += dpp_mov<0x140, 0xF>(v);
    v += dpp_mov<0x142, 0xA>(v);
    v += dpp_mov<0x143, 0xC>(v);
    return __builtin_bit_cast(float, __builtin_amdgcn_readlane(__builtin_bit_cast(int, v), 63));
}
__device__ __forceinline__ float sin_rev(float r) { r = r - floorf(r); return __builtin_amdgcn_sinf(r); }
__device__ __forceinline__ float cos_rev(float r) { r = r - floorf(r); return __builtin_amdgcn_cosf(r); }

#define XB_TMO      128
#define XB_XCNT(j)  (256  + 64 * (j))
#define XB_XSUB(j)  (1280 + 64 * (j))
#define XB_XGEN(j)  (2304 + 64 * (j))
#define XB_TOP      3328
#define XB_TOPGEN   3392
#define XCD_BAR_WORDS 3456
#define XB_SPIN_CAP (1u << 22)

__device__ __forceinline__ unsigned xb_ld(unsigned* p)              { return __hip_atomic_load(p, __ATOMIC_RELAXED, __HIP_MEMORY_SCOPE_AGENT); }
__device__ __forceinline__ unsigned xb_add(unsigned* p, unsigned v) { return __hip_atomic_fetch_add(p, v, __ATOMIC_RELAXED, __HIP_MEMORY_SCOPE_AGENT); }
__device__ __forceinline__ unsigned xb_xcc_id() { return (unsigned)__builtin_amdgcn_s_getreg((3 << 11) | 20) & 0xFu; }
#define XB_SPIN(cond, bar) do { unsigned _sp = 0; while (cond) { __builtin_amdgcn_s_sleep(1); \
    if ((++_sp & 255u) == 0u) { if (xb_ld(&(bar)[XB_TMO])) break; if (_sp > XB_SPIN_CAP) { atomicAdd(&(bar)[XB_TMO], 1u); break; } } } } while (0)

struct XcdBarrier { unsigned* bar; unsigned x; volatile LAS unsigned* st; };

__device__ __forceinline__ XcdBarrier xcd_barrier_post(unsigned* bar, volatile LAS unsigned* st) {
    XcdBarrier b; b.bar = bar; b.x = xb_xcc_id(); b.st = st;
    if (threadIdx.x == 0) (void)xb_add(&bar[XB_XCNT(b.x)], 1u);
    return b;
}
__device__ __forceinline__ void xcd_barrier_complete(unsigned* bar, unsigned x, unsigned& nloc, unsigned& nx) {
    const unsigned G = gridDim.x * gridDim.y * gridDim.z;
    unsigned sum, cnt, mine, sp = 0u;
    for (;;) {
        sum = 0u; cnt = 0u; mine = 0u;
#pragma unroll
        for (unsigned j = 0; j < 16; ++j) { const unsigned c = xb_ld(&bar[XB_XCNT(j)]); sum += c; cnt += (c > 0u) ? 1u : 0u; mine = (j == x) ? c : mine; }
        if (sum == G) break;
        __builtin_amdgcn_s_sleep(1);
        if ((++sp & 255u) == 0u) { if (xb_ld(&bar[XB_TMO])) break; if (sp > XB_SPIN_CAP) { atomicAdd(&bar[XB_TMO], 1u); break; } }
    }
    nloc = mine > 0u ? mine : 1u; nx = cnt > 0u ? cnt : 1u;
}
__device__ __forceinline__ void xcd_barrier(const XcdBarrier& b) {
    asm volatile("s_waitcnt vmcnt(0)" ::: "memory");
    __syncthreads();
    if (threadIdx.x == 0) {
        unsigned* bar = b.bar;
        __builtin_amdgcn_s_waitcnt(0);
        unsigned nloc = b.st[0], nx = b.st[1];
        if (nloc == 0u) { xcd_barrier_complete(bar, b.x, nloc, nx); b.st[0] = nloc; b.st[1] = nx; }
        const unsigned old = xb_add(&bar[XB_XSUB(b.x)], 1u);
        const unsigned gen = old / nloc;
        if (old + 1u == (gen + 1u) * nloc) {
            __builtin_amdgcn_fence(__ATOMIC_RELEASE, "agent");
            asm volatile("s_waitcnt vmcnt(0)" ::: "memory");
            const unsigned og = xb_add(&bar[XB_TOP], 1u);
            const unsigned tg = og / nx;
            if (og + 1u == (tg + 1u) * nx) xb_add(&bar[XB_TOPGEN], 1u);
            else XB_SPIN(xb_ld(&bar[XB_TOPGEN]) == tg, bar);
            __builtin_amdgcn_fence(__ATOMIC_ACQUIRE, "agent");
            xb_add(&bar[XB_XGEN(b.x)], 1u);
            asm volatile("s_waitcnt vmcnt(0)" ::: "memory");
        } else {
            XB_SPIN(xb_ld(&bar[XB_XGEN(b.x)]) == gen, bar);
            __builtin_amdgcn_fence(__ATOMIC_ACQUIRE, "agent");
            asm volatile("s_waitcnt vmcnt(0)" ::: "memory");
        }
    }
    __syncthreads();
}

namespace pg8 {
constexpr int BM = 256, BK = 64, HALF = 128, HTB = HALF * BK * 2, STAGE_BYTES = 8 * HTB, NXCD = 8, WGM = 8;
__host__ __device__ __forceinline__ int lds_byte(int r, int c) { const int st = (r >> 4) * 2 + (c >> 5), rr = r & 15, cc = c & 31, ob = rr * 64 + cc * 2; return st * 1024 + (ob ^ (((ob >> 9) & 1) << 5)); }
__host__ __device__ __forceinline__ void stage_rc(int b, int& R, int& C) { const int st = b / 1024, sb = b % 1024, swz = sb ^ (((sb >> 9) & 1) << 5); R = (st >> 1) * 16 + swz / 64; C = (st & 1) * 32 + (swz % 64) / 2; }
__host__ __device__ __forceinline__ int perm32(int rho) { const int n = rho >> 4, i = rho & 15; return 8 * (i >> 2) + 4 * n + (i & 3); }

struct Unit { int pm, pn, z; };

__device__ __forceinline__ void static_decode(int L, int nM, int nN, int& pm, int& pn) {
    const int nwg = nM * nN; int wgid = L;
    { const int q = nwg / NXCD, r = nwg % NXCD, xcd = wgid % NXCD, off = wgid / NXCD; wgid = (xcd < r ? xcd * (q + 1) : r * (q + 1) + (xcd - r) * q) + off; }
    const int nig = WGM * nN, gid = wgid / nig, fm = gid * WGM, gsz = (nM - fm) < WGM ? (nM - fm) : WGM;
    pm = fm + ((wgid % nig) % gsz); pn = (wgid % nig) / gsz;
}

template <class P>
__device__ __forceinline__ void gemm_phase(LAS unsigned char* lds, const P& S) {
    int tid_ = threadIdx.x; asm volatile("" : "+v"(tid_));
    const int tid = tid_, wid = __builtin_amdgcn_readfirstlane(tid >> 6), lane = tid & 63, wr = wid >> 2, wc = wid & 3, fr = lane & 15, fq = lane >> 4;
    constexpr int ELB = P::FP8 ? 1 : 2;
    const int K = S.K; int nt = K * ELB / 128; asm volatile("" : "+s"(nt));
    unsigned voffB[2];
#pragma unroll
    for (int i = 0; i < 2; ++i) { int R, C; stage_rc(tid * 16 + i * 8192, R, C); const int Rb = (R & ~31) + perm32(R & 31); voffB[i] = (unsigned)(Rb * K * ELB + C * 2); }
#define PG8_AOFF(dst0, dst1, u) do { _Pragma("unroll") for (int i = 0; i < 2; ++i) { int R, C; stage_rc(tid * 16 + i * 8192, R, C); dst0[i] = S.a_off(u, 0, R, C); dst1[i] = S.a_off(u, 1, R, C); } } while (0)
    const size_t kstepB = (size_t)(BK * 2), hstepB = (size_t)HALF * K * ELB, kstepA = (size_t)S.kstepA;
    const unsigned ldsw = (unsigned)wid * 1024u;
    const int aoff = lds_byte(wr * 64 + fr, fq * 8), boff = lds_byte(wc * 32 + fr, fq * 8);
#define PG8_SA(b, h) (((b) * 2 + (h)) * HTB)
#define PG8_SB(b, h) ((4 + (b) * 2 + (h)) * HTB)
#define PG8_STAGE(bufoff, gbase, voff) do { _Pragma("unroll") for (int _i = 0; _i < 2; ++_i) \
        __builtin_amdgcn_global_load_lds((const unsigned*)((const char*)(gbase) + (voff)[_i]), (LAS unsigned*)(lds + (bufoff) + ldsw + _i * 8192), 16, 0, 0); } while (0)
#define PG8_LDA(dst, b, h) do { _Pragma("unroll") for (int m = 0; m < 4; ++m) _Pragma("unroll") for (int k = 0; k < 2; ++k) dst[m][k] = *(const LAS bf16x8*)(lds + PG8_SA(b, h) + aoff + m * 2048 + k * 1024); } while (0)
#define PG8_LDB(dst, b, h) do { _Pragma("unroll") for (int n = 0; n < 2; ++n) _Pragma("unroll") for (int k = 0; k < 2; ++k) dst[n][k] = *(const LAS bf16x8*)(lds + PG8_SB(b, h) + boff + n * 2048 + k * 1024); } while (0)
#define PG8_CAT(x0, x1) __builtin_shufflevector(__builtin_bit_cast(v4i, x0), __builtin_bit_cast(v4i, x1), 0, 1, 2, 3, 4, 5, 6, 7)
#define PG8_MMA(ai, bj, At, Bt) do { __builtin_amdgcn_s_setprio(1); _Pragma("unroll") for (int m = 0; m < 4; ++m) _Pragma("unroll") for (int n = 0; n < 2; ++n) { \
        if constexpr (P::FP8) acc[ai][bj][m][n] = __builtin_amdgcn_mfma_scale_f32_16x16x128_f8f6f4(PG8_CAT(Bt[n][0], Bt[n][1]), PG8_CAT(At[m][0], At[m][1]), acc[ai][bj][m][n], 0, 0, 0, 0x7f7f7f7f, 0, 0x7f7f7f7f); \
        else { _Pragma("unroll") for (int k = 0; k < 2; ++k) acc[ai][bj][m][n] = __builtin_amdgcn_mfma_f32_16x16x32_bf16(Bt[n][k], At[m][k], acc[ai][bj][m][n], 0, 0, 0); } } __builtin_amdgcn_s_setprio(0); } while (0)
#define PG8_WAIT_V(n) asm volatile("s_waitcnt vmcnt(" #n ")" ::: "memory")
#define PG8_WAIT_L(n) asm volatile("s_waitcnt lgkmcnt(" #n ")" ::: "memory")
#define PG8_BAR __builtin_amdgcn_s_barrier()
#define PG8_SCHED __builtin_amdgcn_sched_barrier(0)
    Unit cur, nxt; int ui = 0;
    if (!S.next(0, cur)) return;
    f32x4 acc[2][2][4][2];
#pragma unroll
    for (int a = 0; a < 2; ++a)
#pragma unroll
        for (int b = 0; b < 2; ++b)
#pragma unroll
            for (int m = 0; m < 4; ++m)
#pragma unroll
                for (int n = 0; n < 2; ++n) acc[a][b][m][n] = (f32x4){0.f, 0.f, 0.f, 0.f};
    bf16x8 At[4][2], B0[2][2], B1[2][2];
    unsigned vA0[2], vA1[2], vN0[2], vN1[2];
    PG8_AOFF(vA0, vA1, cur);
    const char* cA = S.a_base(cur); const char* cB = S.b_base(cur);
    PG8_STAGE(PG8_SB(0, 0), cB, voffB); PG8_STAGE(PG8_SB(0, 1), cB + hstepB, voffB); PG8_STAGE(PG8_SA(0, 0), cA, vA0); PG8_STAGE(PG8_SA(0, 1), cA, vA1);
    if (wr == 1) PG8_BAR;
    PG8_WAIT_V(2); PG8_BAR;
    PG8_STAGE(PG8_SB(1, 0), cB + kstepB, voffB); PG8_STAGE(PG8_SA(1, 0), cA + kstepA, vA0); PG8_STAGE(PG8_SB(1, 1), cB + hstepB + kstepB, voffB);
    PG8_WAIT_V(6); PG8_BAR;
    for (;;) {
        const bool has_next = S.next(ui + 1, nxt);
        const char* nA = cA; const char* nB = cB;
        if (has_next) { nA = S.a_base(nxt); nB = S.b_base(nxt); if (P::EARLY_AOFF) PG8_AOFF(vN0, vN1, nxt); }
        for (int t = 0; t < nt; t += 2) {
            const bool last = (t == nt - 2);
            const char* a1 = cA + (size_t)(t + 1) * kstepA;
            const char* a2 = last ? nA : cA + (size_t)(t + 2) * kstepA; const char* b2 = last ? nB : cB + (size_t)(t + 2) * kstepB;
            const char* a3 = a2 + kstepA; const char* b3 = b2 + kstepB;
            PG8_LDB(B0, 0, 0); PG8_LDB(B1, 0, 1); PG8_SCHED; PG8_LDA(At, 0, 0); PG8_STAGE(PG8_SA(1, 1), a1, vA1);
            if (last && has_next) {
                if (P::EARLY_AOFF) { _Pragma("unroll") for (int i = 0; i < 2; ++i) { vA0[i] = vN0[i]; vA1[i] = vN1[i]; } } else PG8_AOFF(vA0, vA1, nxt); }
            PG8_WAIT_V(8); PG8_WAIT_L(0); PG8_BAR; PG8_MMA(0, 0, At, B0); PG8_MMA(0, 1, At, B1); PG8_BAR; PG8_SCHED;
            PG8_LDA(At, 0, 1); PG8_STAGE(PG8_SB(0, 0), b2, voffB); PG8_STAGE(PG8_SB(0, 1), b2 + hstepB, voffB); PG8_STAGE(PG8_SA(0, 0), a2, vA0);
            PG8_WAIT_V(8); PG8_WAIT_L(0); PG8_BAR; PG8_MMA(1, 0, At, B0); PG8_MMA(1, 1, At, B1); PG8_BAR; PG8_SCHED;
            PG8_LDB(B0, 1, 0); PG8_LDB(B1, 1, 1); PG8_SCHED; PG8_LDA(At, 1, 0); PG8_STAGE(PG8_SA(0, 1), a2, vA1);
            PG8_WAIT_V(8); PG8_WAIT_L(0); PG8_BAR; PG8_MMA(0, 0, At, B0); PG8_MMA(0, 1, At, B1); PG8_BAR; PG8_SCHED;
            PG8_LDA(At, 1, 1); PG8_STAGE(PG8_SB(1, 0), b3, voffB); PG8_STAGE(PG8_SB(1, 1), b3 + hstepB, voffB); PG8_STAGE(PG8_SA(1, 0), a3, vA0);
            PG8_WAIT_V(8); PG8_WAIT_L(0); PG8_BAR; PG8_MMA(1, 0, At, B0); PG8_MMA(1, 1, At, B1); PG8_BAR; PG8_SCHED;
        }
        if (wr == 0) PG8_BAR;
        S.epi(acc, cur, wr, wc, fr, fq);
        if (!has_next) break;
#pragma unroll
        for (int a = 0; a < 2; ++a)
#pragma unroll
            for (int b = 0; b < 2; ++b)
#pragma unroll
                for (int m = 0; m < 4; ++m)
#pragma unroll
                    for (int n = 0; n < 2; ++n) acc[a][b][m][n] = (f32x4){0.f, 0.f, 0.f, 0.f};
        cur = nxt; cA = nA; cB = nB; ++ui;
        if (wr == 1) PG8_BAR;
    }
    PG8_WAIT_V(0);
    PG8_BAR;
#undef PG8_AOFF
#undef PG8_SA
#undef PG8_SB
#undef PG8_STAGE
#undef PG8_LDA
#undef PG8_LDB
#undef PG8_MMA
#undef PG8_CAT
#undef PG8_WAIT_V
#undef PG8_WAIT_L
#undef PG8_BAR
#undef PG8_SCHED
}

template <class P>
__device__ __forceinline__ void gemm_phase_m128(LAS unsigned char* lds, const P& S) {
    int tid_ = threadIdx.x; asm volatile("" : "+v"(tid_));
    const int tid = tid_, wid = __builtin_amdgcn_readfirstlane(tid >> 6), lane = tid & 63, wr = wid >> 2, wc = wid & 3, fr = lane & 15, fq = lane >> 4;
    constexpr int ELB = P::FP8 ? 1 : 2;
    const int K = S.K; int nt = K * ELB / 128; asm volatile("" : "+s"(nt));
    unsigned voffB[2];
#pragma unroll
    for (int i = 0; i < 2; ++i) { int R, C; stage_rc(tid * 16 + i * 8192, R, C); const int Rb = (R & ~31) + perm32(R & 31); voffB[i] = (unsigned)(Rb * K * ELB + C * 2); }
#define PG8_AOFF(dst0, u) do { _Pragma("unroll") for (int i = 0; i < 2; ++i) { int R, C; stage_rc(tid * 16 + i * 8192, R, C); dst0[i] = S.a_off(u, R, C); } } while (0)
    const size_t kstepB = (size_t)(BK * 2), hstepB = (size_t)HALF * K * ELB, kstepA = (size_t)S.kstepA;
    const unsigned ldsw = (unsigned)wid * 1024u;
    const int aoff = lds_byte(wr * 64 + fr, fq * 8), boff = lds_byte(wc * 32 + fr, fq * 8);
#define PG8_SA(b) (((b) * 2) * HTB)
#define PG8_SB(b, h) ((4 + (b) * 2 + (h)) * HTB)
#define PG8_STAGE(bufoff, gbase, voff) do { _Pragma("unroll") for (int _i = 0; _i < 2; ++_i) \
        __builtin_amdgcn_global_load_lds((const unsigned*)((const char*)(gbase) + (voff)[_i]), (LAS unsigned*)(lds + (bufoff) + ldsw + _i * 8192), 16, 0, 0); } while (0)
#define PG8_LDA(dst, b) do { _Pragma("unroll") for (int m = 0; m < 4; ++m) _Pragma("unroll") for (int k = 0; k < 2; ++k) dst[m][k] = *(const LAS bf16x8*)(lds + PG8_SA(b) + aoff + m * 2048 + k * 1024); } while (0)
#define PG8_LDB(dst, b, h) do { _Pragma("unroll") for (int n = 0; n < 2; ++n) _Pragma("unroll") for (int k = 0; k < 2; ++k) dst[n][k] = *(const LAS bf16x8*)(lds + PG8_SB(b, h) + boff + n * 2048 + k * 1024); } while (0)
#define PG8_CAT(x0, x1) __builtin_shufflevector(__builtin_bit_cast(v4i, x0), __builtin_bit_cast(v4i, x1), 0, 1, 2, 3, 4, 5, 6, 7)
#define PG8_MMA(bj, At, Bt) do { __builtin_amdgcn_s_setprio(1); _Pragma("unroll") for (int m = 0; m < 4; ++m) _Pragma("unroll") for (int n = 0; n < 2; ++n) { \
        if constexpr (P::FP8) acc[bj][m][n] = __builtin_amdgcn_mfma_scale_f32_16x16x128_f8f6f4(PG8_CAT(Bt[n][0], Bt[n][1]), PG8_CAT(At[m][0], At[m][1]), acc[bj][m][n], 0, 0, 0, 0x7f7f7f7f, 0, 0x7f7f7f7f); \
        else { _Pragma("unroll") for (int k = 0; k < 2; ++k) acc[bj][m][n] = __builtin_amdgcn_mfma_f32_16x16x32_bf16(Bt[n][k], At[m][k], acc[bj][m][n], 0, 0, 0); } } __builtin_amdgcn_s_setprio(0); } while (0)
#define PG8_WAIT_V(n) asm volatile("s_waitcnt vmcnt(" #n ")" ::: "memory")
#define PG8_WAIT_L(n) asm volatile("s_waitcnt lgkmcnt(" #n ")" ::: "memory")
#define PG8_BAR __builtin_amdgcn_s_barrier()
#define PG8_SCHED __builtin_amdgcn_sched_barrier(0)
    Unit cur, nxt; int ui = 0;
    if (!S.next(0, cur)) return;
    f32x4 acc[2][4][2], st[2][4][2];
#pragma unroll
    for (int a = 0; a < 2; ++a)
#pragma unroll
        for (int m = 0; m < 4; ++m)
#pragma unroll
            for (int n = 0; n < 2; ++n) { acc[a][m][n] = (f32x4){0.f, 0.f, 0.f, 0.f}; st[a][m][n] = (f32x4){0.f, 0.f, 0.f, 0.f}; }
    bf16x8 At[4][2], B0[2][2];
    unsigned vA[2], vN[2];
    PG8_AOFF(vA, cur);
    const char* cA = S.a_base(cur); const char* cB = S.b_base(cur);
    PG8_STAGE(PG8_SB(0, 0), cB, voffB); PG8_STAGE(PG8_SA(0), cA, vA); PG8_STAGE(PG8_SB(0, 1), cB + hstepB, voffB);
    if (wr == 1) PG8_BAR;
    PG8_WAIT_V(2); PG8_BAR;
    PG8_STAGE(PG8_SB(1, 0), cB + kstepB, voffB); PG8_STAGE(PG8_SA(1), cA + kstepA, vA);
    PG8_WAIT_V(4); PG8_BAR;
    for (;;) {
        const bool has_next = S.next(ui + 1, nxt);
        const char* nA = cA; const char* nB = cB;
        if (has_next) { nA = S.a_base(nxt); nB = S.b_base(nxt); if (P::EARLY_AOFF) PG8_AOFF(vN, nxt); }
        for (int t = 0; t < nt; t += 2) {
            const bool last = (t == nt - 2);
            const char* b1 = cB + (size_t)(t + 1) * kstepB;
            const char* a2 = last ? nA : cA + (size_t)(t + 2) * kstepA; const char* b2 = last ? nB : cB + (size_t)(t + 2) * kstepB;
            const char* a3 = a2 + kstepA; const char* b3 = b2 + kstepB;
            PG8_LDB(B0, 0, 0); PG8_SCHED; PG8_LDA(At, 0); PG8_STAGE(PG8_SB(1, 1), b1 + hstepB, voffB);
            if (last && has_next) { if (P::EARLY_AOFF) { vA[0] = vN[0]; vA[1] = vN[1]; } else PG8_AOFF(vA, nxt); }
            PG8_WAIT_V(6); PG8_WAIT_L(0); PG8_BAR; PG8_MMA(0, At, B0); PG8_BAR; PG8_SCHED;
            PG8_LDB(B0, 0, 1); PG8_STAGE(PG8_SB(0, 0), b2, voffB); PG8_STAGE(PG8_SA(0), a2, vA);
            PG8_WAIT_V(6); PG8_WAIT_L(0); PG8_BAR; PG8_MMA(1, At, B0); PG8_BAR; PG8_SCHED;
            PG8_LDB(B0, 1, 0); PG8_SCHED; PG8_LDA(At, 1); PG8_STAGE(PG8_SB(0, 1), b2 + hstepB, voffB);
            PG8_WAIT_V(6); PG8_WAIT_L(0); PG8_BAR; PG8_MMA(0, At, B0); PG8_BAR; PG8_SCHED;
            PG8_LDB(B0, 1, 1); PG8_STAGE(PG8_SB(1, 0), b3, voffB); PG8_STAGE(PG8_SA(1), a3, vA);
            PG8_WAIT_V(6); PG8_WAIT_L(0); PG8_BAR; PG8_MMA(1, At, B0); PG8_BAR; PG8_SCHED;
        }
        if (wr == 0) PG8_BAR;
        S.epi(acc, st, cur, wr, wc, fr, fq);
        if (!has_next) break;
#pragma unroll
        for (int a = 0; a < 2; ++a)
#pragma unroll
            for (int m = 0; m < 4; ++m)
#pragma unroll
                for (int n = 0; n < 2; ++n) acc[a][m][n] = (f32x4){0.f, 0.f, 0.f, 0.f};
        cur = nxt; cA = nA; cB = nB; ++ui;
        if (wr == 1) PG8_BAR;
    }
    PG8_WAIT_V(0);
    PG8_BAR;
#undef PG8_AOFF
#undef PG8_SA
#undef PG8_SB
#undef PG8_STAGE
#undef PG8_LDA
#undef PG8_LDB
#undef PG8_MMA
#undef PG8_CAT
#undef PG8_WAIT_V
#undef PG8_WAIT_L
#undef PG8_BAR
#undef PG8_SCHED
}
}
namespace attn_body {
using bf16x8 = __attribute__((ext_vector_type(8))) short;
using u32x4 = __attribute__((ext_vector_type(4))) unsigned;
constexpr int NW = 8, QBLK = 32, QB = QBLK * NW, KVBLK = 64;
__device__ __forceinline__ int crow(int r, int hi) { return (r & 3) + 8 * (r >> 2) + 4 * hi; }
#define SBAR() __builtin_amdgcn_sched_barrier(0)
constexpr int NSLOT = 3, SLOTB = 8192;
constexpr int LDS_K = 0, LDS_V = NSLOT * SLOTB, LDS_WS = 2 * NSLOT * SLOTB, LDS_OST = LDS_WS + NW * 64 * 4, LDS_BYTES = LDS_OST + NW * 4096;
constexpr int LDS_BT = 86016 + 256;
__device__ __forceinline__ void glds16(const void* gsrc, unsigned lds_dst) { unsigned keep;
  asm volatile("s_mov_b32 %0, m0\n\ts_mov_b32 m0, %2\n\ts_nop 0\n\tglobal_load_lds_dwordx4 %1, off\n\ts_mov_b32 m0, %0" : "=&s"(keep) : "v"(gsrc), "s"(lds_dst) : "memory"); }
__device__ __forceinline__ float max3f(float a, float b, float c) { float r; asm("v_max3_f32 %0, %1, %2, %3" : "=v"(r) : "v"(a), "v"(b), "v"(c)); return r; }
__device__ __forceinline__ float max2f(float a, float b) { float r; asm("v_max_f32_e32 %0, %1, %2" : "=v"(r) : "v"(a), "v"(b)); return r; }
__device__ __forceinline__ float fadd_s(float a, float b) { float r; asm("v_add_f32_e32 %0, %1, %2" : "=v"(r) : "v"(a), "v"(b)); return r; }
__device__ __forceinline__ float fsub_s(float a, float b) { float r; asm("v_sub_f32_e32 %0, %1, %2" : "=v"(r) : "v"(a), "v"(b)); return r; }
typedef float f32x2_t __attribute__((ext_vector_type(2))); typedef __bf16 bf16x2_t __attribute__((ext_vector_type(2)));
__device__ __forceinline__ unsigned cvtpk_s(float lo, float hi) { f32x2_t v = {lo, hi}; bf16x2_t b = __builtin_convertvector(v, bf16x2_t); return __builtin_bit_cast(unsigned, b); }
#define WAIT_BAR(N) asm volatile("s_waitcnt vmcnt(" #N ") lgkmcnt(0)\n\ts_barrier" ::: "memory")

__device__ __forceinline__ void qkt(f32x16& p0, f32x16& p1, const char* Kslot, const bf16x8* qr, const f32x16& negm, int r32, int hi) {
  const char* kb = Kslot + hi * 1024 + r32 * 16;
  #pragma unroll
  for (int d0 = 0; d0 < 4; ++d0) {
    const bf16x8 b0 = *reinterpret_cast<const bf16x8*>(kb + d0 * 2048);
    const bf16x8 b1 = *reinterpret_cast<const bf16x8*>(kb + d0 * 2048 + 512);
    if (d0 == 0) { p0 = __builtin_amdgcn_mfma_f32_32x32x16_bf16(b0, qr[0], negm, 0, 0, 0); p1 = __builtin_amdgcn_mfma_f32_32x32x16_bf16(b1, qr[0], negm, 0, 0, 0); }
    else { p0 = __builtin_amdgcn_mfma_f32_32x32x16_bf16(b0, qr[d0], p0, 0, 0, 0); p1 = __builtin_amdgcn_mfma_f32_32x32x16_bf16(b1, qr[d0], p1, 0, 0, 0); } }
}
typedef __attribute__((address_space(3))) const char* lds_cptr;
typedef short v4i16_t __attribute__((ext_vector_type(4)));
__device__ __forceinline__ void kload8(bf16x8* kf, lds_cptr kp) {
  kf[0] = *(const __attribute__((address_space(3))) bf16x8*)(kp);        kf[1] = *(const __attribute__((address_space(3))) bf16x8*)(kp + 512);
  kf[2] = *(const __attribute__((address_space(3))) bf16x8*)(kp + 2048); kf[3] = *(const __attribute__((address_space(3))) bf16x8*)(kp + 2560);
  kf[4] = *(const __attribute__((address_space(3))) bf16x8*)(kp + 4096); kf[5] = *(const __attribute__((address_space(3))) bf16x8*)(kp + 4608);
  kf[6] = *(const __attribute__((address_space(3))) bf16x8*)(kp + 6144); kf[7] = *(const __attribute__((address_space(3))) bf16x8*)(kp + 6656);
}
__device__ __forceinline__ void kload2(bf16x8* kf, lds_cptr kp, int j) { kf[2 * j] = *(const __attribute__((address_space(3))) bf16x8*)(kp + j * 2048); kf[2 * j + 1] = *(const __attribute__((address_space(3))) bf16x8*)(kp + j * 2048 + 512); }
__device__ __forceinline__ s16x4 vtr(lds_cptr p) { return __builtin_bit_cast(s16x4, __builtin_amdgcn_ds_read_tr16_b64_v4i16((__attribute__((address_space(3))) v4i16_t*)p)); }
__device__ __forceinline__ float rowmax(const f32x16& p0, const f32x16& p1) {
  float a = max3f(p0[0], p0[1], p1[0]), b = max3f(p0[2], p0[3], p1[1]); a = max3f(a, p1[2], p1[3]);
  #pragma unroll
  for (int r = 4; r < 16; r += 4) { a = max3f(a, p0[r], p0[r + 1]); b = max3f(b, p0[r + 2], p0[r + 3]); a = max3f(a, p1[r], p1[r + 1]); b = max3f(b, p1[r + 2], p1[r + 3]); }
  const float m = max2f(a, b);
  auto rr = __builtin_amdgcn_permlane32_swap(__float_as_uint(m), __float_as_uint(m), false, false);
  return max2f(__uint_as_float(rr[0]), __uint_as_float(rr[1]));
}
__device__ __forceinline__ void pv(f32x16* o, int vb, bf16x8 pa0, bf16x8 pa1, bf16x8 pa2, bf16x8 pa3) {
  #pragma unroll
  for (int d0 = 0; d0 < 2; ++d0) { s16x4 lo[4], hi[4];
    #pragma unroll
    for (int ks = 0; ks < 4; ++ks) {
      asm volatile("ds_read_b64_tr_b16 %0,%1 offset:%c2" : "=&v"(lo[ks]) : "v"(vb), "i"(d0 * 4096 + ks * 1024) : "memory");
      asm volatile("ds_read_b64_tr_b16 %0,%1 offset:%c2" : "=&v"(hi[ks]) : "v"(vb), "i"(d0 * 4096 + ks * 1024 + 512) : "memory"); }
    asm volatile("s_waitcnt lgkmcnt(0)" ::: "memory"); SBAR();
    #define PK(k) (bf16x8){lo[k][0], lo[k][1], lo[k][2], lo[k][3], hi[k][0], hi[k][1], hi[k][2], hi[k][3]}
    o[d0] = __builtin_amdgcn_mfma_f32_32x32x16_bf16(pa0, PK(0), o[d0], 0, 0, 0);
    o[d0] = __builtin_amdgcn_mfma_f32_32x32x16_bf16(pa1, PK(1), o[d0], 0, 0, 0);
    o[d0] = __builtin_amdgcn_mfma_f32_32x32x16_bf16(pa2, PK(2), o[d0], 0, 0, 0);
    o[d0] = __builtin_amdgcn_mfma_f32_32x32x16_bf16(pa3, PK(3), o[d0], 0, 0, 0);
    #undef PK
  }
}
#define ATTN_STORE16(p, v) (*(u32x4*)(p) = (v))

template <int THRL, bool NA, int QP_, int KVP_, bool NOMAX = false>
__device__ __forceinline__ void attn_unit(const bf16* Qu, int qp_rt, const bf16* __restrict__ Kh, const bf16* __restrict__ Vh, int kvp_rt, bf16* Ou, int NT, int r0, int rlo, char* shm) {
  const int qp = QP_ ? QP_ : qp_rt, kvp = KVP_ ? KVP_ : kvp_rt, op = qp;
  int tid_ = threadIdx.x; asm volatile("" : "+v"(tid_));
  const int tid = tid_, lane = tid & 63, r32 = lane & 31, hi = lane >> 5; const int wid = __builtin_amdgcn_readfirstlane(tid >> 6);
  const bf16* Qw = Qu + (long)(wid * QBLK) * qp;
  const unsigned lds0 = (unsigned)(uintptr_t)shm;
  float* wsf = (float*)(shm + LDS_WS) + wid * 64;
  const bf16* ksrc = Kh + (long)lane * kvp + wid * 8;
  const bf16* vsrc = Vh + (long)(16 * (wid & 3) + (lane >> 2)) * kvp + (wid >> 2) * 32 + (lane & 3) * 8;
  const unsigned kdst = lds0 + LDS_K + wid * 1024, vdst = lds0 + LDS_V + wid * 1024;
  #define TROW(t) (NA ? ((t) < 4 ? 64 * (t) : CTX + 64 * ((rlo + (t) - 4) < 127 ? (rlo + (t) - 4) : 127)) : 64 * (t))
  #define DMA_K(t, slot) glds16(ksrc + (long)TROW(t) * kvp, (unsigned)__builtin_amdgcn_readfirstlane(kdst + (slot)))
  #define DMA_V(t, slot) glds16(vsrc + (long)TROW(t) * kvp, (unsigned)__builtin_amdgcn_readfirstlane(vdst + (slot)))
  const int vb0 = (int)(lds0 + LDS_V) + ((lane >> 4) & 1) * 32 + (lane & 3) * 8 + (4 * hi + ((lane & 15) >> 2)) * 64;
  const char* Kbase = shm + LDS_K; bf16x8 kf[8];
  const lds_cptr shm3 = (lds_cptr)shm; const lds_cptr kp0 = shm3 + LDS_K + hi * 1024 + r32 * 16; const lds_cptr vp0 = shm3 + LDS_V + ((lane >> 4) & 1) * 32 + (lane & 3) * 8 + (4 * hi + ((lane & 15) >> 2)) * 64;
  const int rq = r0 + (wid >> 1), qc = 32 * (wid & 1) + r32;
  const int rsw = rq - 4 < 0 ? 0 : (rq - 4 > 120 ? 120 : rq - 4);
  const int cs = qc - 8 < 0 ? 0 : (qc - 8 > 48 ? 48 : qc - 8);
  const __attribute__((address_space(3))) float* btl = (const __attribute__((address_space(3))) float*)(shm3 + LDS_BT) + (15 + 4 * hi - qc);
  DMA_K(0, 0); DMA_V(0, 0); DMA_K(1, SLOTB);
  bf16x8 qr[4];
  #pragma unroll
  for (int d0 = 0; d0 < 4; ++d0) qr[d0] = *reinterpret_cast<const bf16x8*>(&Qw[(long)r32 * qp + d0 * 16 + hi * 8]);
  float mhat = 0.f, l_reg = 0.f; f32x16 o[2]; o[0] = f32x16{}; o[1] = f32x16{}; f32x16 negm = f32x16{}; if (!NA) asm volatile("" : "+v"(negm));
  #define NEGM (NA ? f32x16{} : negm)
  #define CMASK(P0, P1, t) do { if (NA) { if ((t) >= 4) { const int kr_ = rlo + (t) - 4; const int dr_ = kr_ - rsw; \
      if (dr_ < 0 || dr_ >= 8) { _Pragma("unroll") for (int r = 0; r < 16; ++r) { P0[r] = (-__builtin_inff()); P1[r] = (-__builtin_inff()); } } \
      else { const __attribute__((address_space(3))) float* bp_ = btl + (kr_ - rq + 7) * 31; const int kl0_ = 4 * hi - cs; \
        _Pragma("unroll") for (int rg = 0; rg < 4; ++rg) { \
          _Pragma("unroll") for (int rr_ = 0; rr_ < 4; ++rr_) { const int r = rg * 4 + rr_; const int kc_ = (r & 3) + 8 * (r >> 2); const float b0_ = bp_[kc_], b1_ = bp_[kc_ + 32]; \
            const int kl_ = kc_ + kl0_; P0[r] = ((unsigned)kl_ < 16u) ? P0[r] + b0_ : (-__builtin_inff()); P1[r] = ((unsigned)(kl_ + 32) < 16u) ? P1[r] + b1_ : (-__builtin_inff()); } \
          SBAR(); } } } } } while (0)
  bool resc = false;
  #define START(P0, P1) do { const float rm = NOMAX ? 0.f : rowmax(P0, P1); resc = false; \
    { const float dl = rm; mhat = fadd_s(mhat, dl); \
      _Pragma("unroll") for (int r = 0; r < 16; ++r) { P0[r] = fsub_s(P0[r], dl); P1[r] = fsub_s(P1[r], dl); } \
      if (!NA) { _Pragma("unroll") for (int r = 0; r < 16; ++r) negm[r] = -mhat; asm volatile("" : "+v"(negm)); } } \
    _Pragma("unroll") for (int r = 0; r < 16; ++r) P0[r] = __builtin_amdgcn_exp2f(P0[r]); } while (0)
  #define RESC() do { if (resc) { asm volatile("s_waitcnt lgkmcnt(0)" ::: "memory"); \
      _Pragma("unroll") for (int d_ = 0; d_ < 2; ++d_) _Pragma("unroll") for (int r = 0; r < 16; ++r) o[d_][r] *= wsf[crow(r, hi)]; } } while (0)
  f32x16 pA0, pA1, pB0, pB1;
  int sl_prev = 0, sl_cur = 0, sl_next = SLOTB;
  #define ROT() do { sl_prev = sl_cur; sl_cur = sl_next; sl_next = (sl_next == (NSLOT - 1) * SLOTB) ? 0 : sl_next + SLOTB; } while (0)
  DMA_K(2, 2 * SLOTB);
  WAIT_BAR(3);
  qkt(pA0, pA1, Kbase, qr, NEGM, r32, hi); asm volatile("s_nop 15\n\ts_nop 7" : "+v"(pA0), "+v"(pA1));
  START(pA0, pA1);
  _Pragma("unroll") for (int r = 0; r < 16; ++r) pA1[r] = __builtin_amdgcn_exp2f(pA1[r]);
  WAIT_BAR(0);
  DMA_K(3, 0); DMA_V(1, SLOTB);
  ROT();
  kload8(kf, kp0 + sl_cur);
  WAIT_BAR(2);
  s16x4 vlo[8], vhi[8]; u32x4 pw0, pw1, pw2, pw3;
  #define PKW(P, B) cvtpk_s(P[B], P[B + 1])
  #define PAF(k) __builtin_bit_cast(bf16x8, pw##k)
  #define VFR(i) (bf16x8){vlo[i][0], vlo[i][1], vlo[i][2], vlo[i][3], vhi[i][0], vhi[i][1], vhi[i][2], vhi[i][3]}
  #define PIN(x) asm volatile("" : "+v"(x))
  #define MX3(a, b, c) __builtin_fmaxf(__builtin_fmaxf((a), (b)), (c))
  #define GAPA(MF, A0, A1, A2, A3, W0, W1, PW) do { MF; sacc2 += (f32x2_t){A0, A1}; sacc2 += (f32x2_t){A2, A3}; PIN(sacc2); W0; W1; PIN(PW); SBAR(); } while (0)
  #define EX(v) __builtin_amdgcn_exp2f(v)
  #define GAPB(MF, X, B) do { MF; X[B] = EX(X[B]); X[B + 1] = EX(X[B + 1]); X[B + 2] = EX(X[B + 2]); X[B + 3] = EX(X[B + 3]); PIN(X); SBAR(); } while (0)
  #define VRD(i) do { vlo[i] = vtr(vp_ + (((i) >> 2) * 4096 + ((i) & 3) * 1024)); vhi[i] = vtr(vp_ + (((i) >> 2) * 4096 + ((i) & 3) * 1024 + 512)); } while (0)
  #define KRD(G, j) do { if (G) { kload2(kf, kp0 + sl_next, j); SBAR(); } } while (0)
  #define STEP(C0, C1, P0, P1, t, GK, GV, GL) do { SBAR(); \
    const lds_cptr vp_ = vp0 + sl_prev; \
    VRD(0); SBAR(); f32x2_t sacc2 = (f32x2_t){P0[0], P0[1]}; \
    GAPA(C0 = __builtin_amdgcn_mfma_f32_32x32x16_bf16(kf[0], qr[0], NEGM, 0, 0, 0), P0[2], P0[3], P0[4], P0[5],     pw0[0] = PKW(P0, 0), pw0[1] = PKW(P0, 2), pw0); \
    VRD(4); SBAR(); GAPA(C1 = __builtin_amdgcn_mfma_f32_32x32x16_bf16(kf[1], qr[0], NEGM, 0, 0, 0), P0[6], P0[7], P0[8], P0[9],     pw0[2] = PKW(P0, 4), pw0[3] = PKW(P0, 6), pw0); \
    VRD(1); SBAR(); GAPA(C0 = __builtin_amdgcn_mfma_f32_32x32x16_bf16(kf[2], qr[1], C0, 0, 0, 0),   P0[10], P0[11], P0[12], P0[13], pw1[0] = PKW(P0, 8), pw1[1] = PKW(P0, 10), pw1); \
    VRD(5); SBAR(); GAPA(C1 = __builtin_amdgcn_mfma_f32_32x32x16_bf16(kf[3], qr[1], C1, 0, 0, 0),   P0[14], P0[15], P1[0], P1[1],   pw1[2] = PKW(P0, 12), pw1[3] = PKW(P0, 14), pw1); \
    VRD(2); SBAR(); GAPA(C0 = __builtin_amdgcn_mfma_f32_32x32x16_bf16(kf[4], qr[2], C0, 0, 0, 0),   P1[2], P1[3], P1[4], P1[5],     pw2[0] = PKW(P1, 0), pw2[1] = PKW(P1, 2), pw2); \
    VRD(6); SBAR(); GAPA(C1 = __builtin_amdgcn_mfma_f32_32x32x16_bf16(kf[5], qr[2], C1, 0, 0, 0),   P1[6], P1[7], P1[8], P1[9],     pw2[2] = PKW(P1, 4), pw2[3] = PKW(P1, 6), pw2); \
    VRD(3); SBAR(); GAPA(C0 = __builtin_amdgcn_mfma_f32_32x32x16_bf16(kf[6], qr[3], C0, 0, 0, 0),   P1[10], P1[11], P1[12], P1[13], pw3[0] = PKW(P1, 8), pw3[1] = PKW(P1, 10), pw3); \
    VRD(7); SBAR(); GAPA(C1 = __builtin_amdgcn_mfma_f32_32x32x16_bf16(kf[7], qr[3], C1, 0, 0, 0),   P1[14], P1[15], 0.f, 0.f,       pw3[2] = PKW(P1, 12), pw3[3] = PKW(P1, 14), pw3); \
    l_reg += sacc2.x + sacc2.y; \
    if (GK) { DMA_K((t) + 3, sl_cur); } if (GV) { DMA_V((t) + 1, sl_next); } \
    resc = false; \
    if (NA) { _Pragma("unroll") for (int r = 0; r < 16; ++r) { C0[r] -= mhat; C1[r] -= mhat; } } \
    CMASK(C0, C1, t); \
    if (!NOMAX) { float a = MX3(C0[0], C0[1], C1[0]), b = MX3(C0[2], C0[3], C1[1]); a = MX3(a, C1[2], C1[3]); \
      _Pragma("unroll") for (int r = 4; r < 16; r += 4) { a = MX3(a, C0[r], C0[r + 1]); b = MX3(b, C0[r + 2], C0[r + 3]); a = MX3(a, C1[r], C1[r + 1]); b = MX3(b, C1[r + 2], C1[r + 3]); } \
      float rm = __builtin_fmaxf(a, b); { auto rr = __builtin_amdgcn_permlane32_swap(__float_as_uint(rm), __float_as_uint(rm), false, false); rm = __builtin_fmaxf(__uint_as_float(rr[0]), __uint_as_float(rr[1])); } \
      if (__builtin_expect(__any(rm > (float)THRL), 0)) { const float dl = __builtin_fmaxf(rm, 0.f); mhat += dl; \
        _Pragma("unroll") for (int r = 0; r < 16; ++r) { C0[r] -= dl; C1[r] -= dl; } \
        if (!NA) { _Pragma("unroll") for (int r = 0; r < 16; ++r) negm[r] = -mhat; asm volatile("" : "+v"(negm)); } \
        const float f = __builtin_amdgcn_exp2f(-dl); l_reg *= f; if (hi == 0) wsf[r32] = f; resc = true; } } \
    SBAR(); \
    GAPB(o[0] = __builtin_amdgcn_mfma_f32_32x32x16_bf16(PAF(0), VFR(0), o[0], 0, 0, 0), C0, 0); \
    GAPB(o[1] = __builtin_amdgcn_mfma_f32_32x32x16_bf16(PAF(0), VFR(4), o[1], 0, 0, 0), C0, 4); \
    KRD(GL, 0); GAPB(o[0] = __builtin_amdgcn_mfma_f32_32x32x16_bf16(PAF(1), VFR(1), o[0], 0, 0, 0), C0, 8); \
    KRD(GL, 1); GAPB(o[1] = __builtin_amdgcn_mfma_f32_32x32x16_bf16(PAF(1), VFR(5), o[1], 0, 0, 0), C0, 12); \
    KRD(GL, 2); GAPB(o[0] = __builtin_amdgcn_mfma_f32_32x32x16_bf16(PAF(2), VFR(2), o[0], 0, 0, 0), C1, 0); \
    KRD(GL, 3); GAPB(o[1] = __builtin_amdgcn_mfma_f32_32x32x16_bf16(PAF(2), VFR(6), o[1], 0, 0, 0), C1, 4); \
    GAPB(o[0] = __builtin_amdgcn_mfma_f32_32x32x16_bf16(PAF(3), VFR(3), o[0], 0, 0, 0), C1, 8); \
    GAPB(o[1] = __builtin_amdgcn_mfma_f32_32x32x16_bf16(PAF(3), VFR(7), o[1], 0, 0, 0), C1, 12); \
    } while (0)
  int t = 1;
  for (; t + 5 < NT; t += 2) {
    STEP(pB0, pB1, pA0, pA1, t, true, true, true);     WAIT_BAR(2); RESC(); ROT();
    STEP(pA0, pA1, pB0, pB1, t + 1, true, true, true); WAIT_BAR(2); RESC(); ROT();
  }
  #define ENDW(tt) do { if ((tt) + 3 < NT) { WAIT_BAR(2); } else if ((tt) + 2 < NT) { WAIT_BAR(1); } else { WAIT_BAR(0); } } while (0)
  for (; t + 1 < NT; t += 2) {
    STEP(pB0, pB1, pA0, pA1, t, (t + 3 < NT), (t + 1 < NT), (t + 1 < NT));         ENDW(t);     RESC(); ROT();
    STEP(pA0, pA1, pB0, pB1, t + 1, (t + 4 < NT), (t + 2 < NT), (t + 2 < NT));     ENDW(t + 1); RESC(); ROT();
  }
  STEP(pB0, pB1, pA0, pA1, NT - 1, false, false, false); RESC();
  { float sacc = pB0[0] + pB0[1]; _Pragma("unroll") for (int r = 2; r < 16; ++r) sacc += pB0[r]; _Pragma("unroll") for (int r = 0; r < 16; ++r) sacc += pB1[r]; l_reg += sacc;
    pw0 = (u32x4){PKW(pB0, 0), PKW(pB0, 2), PKW(pB0, 4), PKW(pB0, 6)}; pw1 = (u32x4){PKW(pB0, 8), PKW(pB0, 10), PKW(pB0, 12), PKW(pB0, 14)}; pw2 = (u32x4){PKW(pB1, 0), PKW(pB1, 2), PKW(pB1, 4), PKW(pB1, 6)}; pw3 = (u32x4){PKW(pB1, 8), PKW(pB1, 10), PKW(pB1, 12), PKW(pB1, 14)};
    SBAR(); pv(o, vb0 + sl_cur, PAF(0), PAF(1), PAF(2), PAF(3)); }
  #undef PKW
  #undef PAF
  #undef VFR
  #undef PIN
  #undef MX3
  #undef GAPA
  #undef GAPB
  #undef EX
  #undef VRD
  #undef KRD
  #undef STEP
  #undef ENDW
  { auto rr = __builtin_amdgcn_permlane32_swap(__float_as_uint(l_reg), __float_as_uint(l_reg), false, false); l_reg = __uint_as_float(rr[0]) + __uint_as_float(rr[1]); }
  if (hi == 0) wsf[32 + r32] = l_reg; asm volatile("s_waitcnt lgkmcnt(0)" ::: "memory");
  float rli[16];
  #pragma unroll
  for (int r = 0; r < 16; ++r) rli[r] = __builtin_amdgcn_rcpf(wsf[32 + crow(r, hi)]);
  bf16* Ow = Ou + (long)(wid * QBLK) * op;
  { bf16* stg = (bf16*)(shm + LDS_OST) + wid * 2048;
    #pragma unroll
    for (int r = 0; r < 16; ++r) { const int orow = crow(r, hi);
      #pragma unroll
      for (int d0 = 0; d0 < 2; ++d0) stg[orow * 64 + d0 * 32 + r32] = (bf16)f2bf(o[d0][r] * rli[r]); }
    asm volatile("s_waitcnt lgkmcnt(0)" ::: "memory");
    #pragma unroll
    for (int i = 0; i < 4; ++i) { const int row = i * 8 + (lane >> 3), ch = lane & 7; const u32x4 v = *(const u32x4*)(stg + row * 64 + ch * 8); ATTN_STORE16(Ow + (long)row * op + ch * 8, v); } }
  asm volatile("s_waitcnt lgkmcnt(0)\n\ts_barrier" ::: "memory");
  #undef NEGM
  #undef DMA_K
  #undef DMA_V
  #undef TROW
  #undef CMASK
  #undef START
  #undef RESC
  #undef ROT
}
#undef SBAR
#undef WAIT_BAR
}
#ifndef FP8_MOE
#define FP8_MOE 1
#endif
struct Args { const float* in[29]; float* out; unsigned char* ws; int ph_lo, ph_hi; };
enum { I_X = 0, I_C, I_CTX, I_CCTX, I_WMOD, I_BMOD, I_N1G, I_N2G, I_WIN, I_LRE, I_LIM, I_LDT, I_BRE, I_BIM, I_CRE, I_CIM, I_SSMD, I_WGLU, I_QNG, I_KNG, I_RPB, I_WBR, I_WOUT, I_RW, I_RB, I_MG, I_MU, I_MD, I_FNG };

typedef const float* CFP;
struct Ctx {
    const __attribute__((address_space(4))) CFP* in; float* out; unsigned char* ws; LAS unsigned char* lds; gu32* ctl;
    int tid, lane, wave, vcu, G;
};
#define WSP(T_, off) ((T_*)(C.ws + (off)))

__device__ __forceinline__ bf16* xs_row(const Ctx& C, int m) { return WSP(bf16, WS_XS) + (size_t)m * D; }
__device__ __forceinline__ const float* in_row(const Ctx& C, int m) { const int b = m / LB, j = m - b * LB; return j < CTX ? C.in[I_CTX] + (size_t)(b * CTX + j) * D : C.in[I_X] + (size_t)(b * SEQ + j - CTX) * D; }
__device__ __forceinline__ int cond_of(int m) { const int b = m / LB, j = m - b * LB; return j < CTX ? 4 : b; }

__device__ __forceinline__ void transpose_item(const float* W, int N, int Kp, bf16* WT, int k0, int n0, int drow0, LAS float* scr, int lane) {
    const float* src = W + (size_t)k0 * N + n0 + lane;
    float tv[64];
#pragma unroll
    for (int i = 0; i < 64; ++i) tv[i] = src[(size_t)i * N];
#pragma unroll
    for (int i = 0; i < 64; ++i) scr[i * 65 + lane] = tv[i];
    LDS_WAIT(); asm volatile("" ::: "memory");
    const int c = lane & 7;
#pragma unroll
    for (int j = 0; j < 8; ++j) { const int n = (lane >> 3) + 8 * j; const LAS float* s = scr + (8 * c) * 65 + n;
        v4u o; o.x = pk2(s[0 * 65], s[1 * 65]); o.y = pk2(s[2 * 65], s[3 * 65]); o.z = pk2(s[4 * 65], s[5 * 65]); o.w = pk2(s[6 * 65], s[7 * 65]);
        *(GAS v4u*)(WT + (size_t)(drow0 + n) * Kp + k0 + 8 * c) = o; }
    LDS_WAIT(); asm volatile("" ::: "memory");
}
__device__ __forceinline__ void transpose_item8(const float* W, int N, int Kp, unsigned char* WT, int k0, int n0, int drow0, float scale, LAS float* scr, int lane) {
    const float* src = W + (size_t)k0 * N + n0 + lane;
    float tv[64];
#pragma unroll
    for (int i = 0; i < 64; ++i) tv[i] = src[(size_t)i * N];
#pragma unroll
    for (int i = 0; i < 64; ++i) scr[i * 65 + lane] = tv[i] * scale;
    LDS_WAIT(); asm volatile("" ::: "memory");
    const int c = lane & 3;
#pragma unroll
    for (int j = 0; j < 4; ++j) { const int n = (lane >> 2) + 16 * j; const LAS float* s = scr + (16 * c) * 65 + n;
        v4u o; o.x = pk4_fp8(s[0 * 65], s[1 * 65], s[2 * 65], s[3 * 65]); o.y = pk4_fp8(s[4 * 65], s[5 * 65], s[6 * 65], s[7 * 65]); o.z = pk4_fp8(s[8 * 65], s[9 * 65], s[10 * 65], s[11 * 65]); o.w = pk4_fp8(s[12 * 65], s[13 * 65], s[14 * 65], s[15 * 65]);
        *(GAS v4u*)(WT + (size_t)(drow0 + n) * Kp + k0 + 16 * c) = o; }
    LDS_WAIT(); asm volatile("" ::: "memory");
}
__device__ __forceinline__ void phase_weights(const Ctx& C, int l) {
    LAS float* scr = (LAS float*)(C.lds + C.wave * 16640);
    const int gw = C.vcu * NWAVES + C.wave, NGW = C.G * NWAVES;
    constexpr int I0 = 16 * 92, I1 = 8 * 8, I2 = 3 * 8 * 16, I3 = 16 * 16, I4 = 16 * 16 * 8, I5 = I4, I6 = 16 * 8 * 16;
    for (int it = gw; it < I0 + I1 + I2 + I3 + I4 + I5 + I6; it += NGW) {
        int r = it;
        if (r < I0) { const int kb = r / 92, nb = r % 92; if (W8_ALL) transpose_item8(C.in[I_WIN] + (size_t)l * 1024 * INW, INW, 1024, WSP(unsigned char, WS_WIN), 64 * kb, 64 * nb, 64 * nb, 64.f, scr, C.lane);
            else if (nb < 44 || GATE_BF16) transpose_item(C.in[I_WIN] + (size_t)l * 1024 * INW, INW, 1024, WSP(bf16, WS_WIN), 64 * kb, 64 * nb, 64 * nb, scr, C.lane);
            else transpose_item8(C.in[I_WIN] + (size_t)l * 1024 * INW, INW, 1024, WSP(unsigned char, WS_WIN8), 64 * kb, 64 * nb, 64 * nb - 2816, 64.f, scr, C.lane); continue; } r -= I0;
        if (r < I1) { const int kb = r / 8, nb = r % 8; transpose_item(C.in[I_WGLU] + (size_t)l * 512 * 512, 512, 512, WSP(bf16, WS_WGLU), 64 * kb, 64 * nb, 64 * nb, scr, C.lane); continue; } r -= I1;
        if (r < I2) { const int i = r / 128, q = r % 128, kb = q / 16, nb = q % 16; transpose_item(C.in[I_WBR] + (size_t)(l * 3 + i) * 512 * 1024, 1024, 512, WSP(bf16, WS_WBR) + (size_t)i * 1024 * 512, 64 * kb, 64 * nb, 64 * nb, scr, C.lane); continue; } r -= I2;
        if (r < I3) { const int kb = r / 16, nb = r % 16; transpose_item(C.in[I_WOUT] + (size_t)l * 1024 * 1024, 1024, 1024, WSP(bf16, WS_WOUT), 64 * kb, 64 * nb, 64 * nb, scr, C.lane); continue; } r -= I3;
        if (r < I4 + I5) { const int up = r >= I4; if (up) r -= I4; const int e = r / 128, q = r % 128, kb = q / 8, nb = q % 8, n0 = 64 * nb;
            if (FP8_MOE) transpose_item8((up ? C.in[I_MU] : C.in[I_MG]) + (size_t)(l * 16 + e) * 1024 * 512, 512, 1024, WSP(unsigned char, WS_MOE1) + (size_t)e * 1024 * 1024, 64 * kb, n0, (n0 / 128) * 256 + (n0 % 128) + (up ? 128 : 0), 64.f, scr, C.lane);
            else transpose_item((up ? C.in[I_MU] : C.in[I_MG]) + (size_t)(l * 16 + e) * 1024 * 512, 512, 1024, WSP(bf16, WS_MOE1) + (size_t)e * 1024 * 1024, 64 * kb, n0, (n0 / 128) * 256 + (n0 % 128) + (up ? 128 : 0), scr, C.lane); continue; } r -= I4 + I5;
        { const int e = r / 128, q = r % 128, kb = q / 16, nb = q % 16; if (FP8_MOE) transpose_item8(C.in[I_MD] + (size_t)(l * 16 + e) * 512 * 1024, 1024, 512, WSP(unsigned char, WS_MOE2) + (size_t)e * 1024 * 512, 64 * kb, 64 * nb, 64 * nb, 32.f, scr, C.lane);
            else transpose_item(C.in[I_MD] + (size_t)(l * 16 + e) * 512 * 1024, 1024, 512, WSP(bf16, WS_MOE2) + (size_t)e * 1024 * 512, 64 * kb, 64 * nb, 64 * nb, scr, C.lane); }
    }
}

__device__ __forceinline__ void phase_mod(const Ctx& C) {
    LAS float* sc = (LAS float*)(C.lds);
    LAS float* red = (LAS float*)(C.lds + 20480);
    for (int i = C.tid; i < 5 * 1024; i += 512) { const int c = i >> 10, k = i & 1023; const float v = c < 4 ? C.in[I_C][c * 1024 + k] : C.in[I_CCTX][k]; sc[i] = v * fsigmoid(v); }
    __syncthreads();
    for (int it = C.vcu; it < NLAYER * 96; it += C.G) {
        const int l = it / 96, col = (it % 96) * 64 + C.lane, k0 = C.wave * 128;
        const float* W = C.in[I_WMOD] + (size_t)l * 1024 * 6144 + (size_t)k0 * 6144 + col;
        float a0 = 0.f, a1 = 0.f, a2 = 0.f, a3 = 0.f, a4 = 0.f;
#pragma unroll 16
        for (int k = 0; k < 128; ++k) { const float w = W[(size_t)k * 6144]; a0 += sc[k0 + k] * w; a1 += sc[1024 + k0 + k] * w; a2 += sc[2048 + k0 + k] * w; a3 += sc[3072 + k0 + k] * w; a4 += sc[4096 + k0 + k] * w; }
        LAS float* r = red + C.wave * 320 + C.lane; r[0] = a0; r[64] = a1; r[128] = a2; r[192] = a3; r[256] = a4;
        __syncthreads();
        if (C.tid < 320) { const int c = C.tid >> 6; float s = C.in[I_BMOD][l * 6144 + col];
#pragma unroll
            for (int w = 0; w < 8; ++w) s += red[w * 320 + C.tid];
            WSP(float, WS_MOD)[(size_t)(l * 5 + c) * 6144 + col] = s; }
        __syncthreads();
    }
}

__device__ __forceinline__ void phase_s5mats(const Ctx& C, int l, int w) {
    if (w < 0 || w >= 128) return;
    const int g = w >> 2, part = w & 3, tid = C.tid;
    LAS f32x2* POW = (LAS f32x2*)(C.lds);
    LAS f32x2* CC = (LAS f32x2*)(C.lds + 33792);
    LAS f32x2* BB = (LAS f32x2*)(C.lds + 50176);
    LAS f32x2* COEF = (LAS f32x2*)(C.lds + 66560);
    LAS bf16* KT = (LAS bf16*)(C.lds + 67584);
    LAS float* WT = (LAS float*)(C.lds + 101376);
    __syncthreads();
    if (tid < 128) {
        const int d = tid >> 6, p = tid & 63; const int li = ((l * 2 + d) * 32 + g) * 64 + p;
        const float re = C.in[I_LRE][li], im = C.in[I_LIM][li], dt = __expf(C.in[I_LDT][(l * 2 + d) * 32 + g]);
        for (int tau = 0; tau <= 32; ++tau) { const float mag = __expf(re * dt * (float)tau), rev = im * dt * (float)tau * 0.15915494309189535f;
            const float wr = mag * cos_rev(rev), wi = mag * sin_rev(rev);
            POW[(d * 33 + tau) * 64 + p] = (f32x2){wr, wi}; if (tau < 32) { WT[((d * 64 + p) * 2) * 32 + tau] = wr; WT[((d * 64 + p) * 2 + 1) * 32 + tau] = wi; } }
        const float mag = __expf(re * dt), rev = im * dt * 0.15915494309189535f; const float lr = mag * cos_rev(rev) - 1.f, lim = mag * sin_rev(rev);
        const float den = 1.f / (re * re + im * im);
        COEF[tid] = (f32x2){(lr * re + lim * im) * den, (lim * re - lr * im) * den};
    }
    __syncthreads();
    for (int i = tid; i < 2048; i += 512) {
        const int d = i >> 10, p = (i >> 4) & 63, h = i & 15; const size_t bi = (((size_t)(l * 2 + d) * 32 + g) * 64 + p) * 16 + h;
        const float br = C.in[I_BRE][bi], bi_ = C.in[I_BIM][bi]; const f32x2 cf = COEF[d * 64 + p];
        BB[i] = (f32x2){cf.x * br - cf.y * bi_, cf.x * bi_ + cf.y * br};
        const int h2 = (i >> 6) & 15, p2 = i & 63; const size_t ci = (((size_t)(l * 2 + d) * 32 + g) * 16 + h2) * 64 + p2;
        CC[i] = (f32x2){C.in[I_CRE][ci], C.in[I_CIM][ci]};
    }
    __syncthreads();
    {
        const int wv = tid >> 6, ln = tid & 63, hi = ln >> 5, i = ln & 31, h = 2 * wv + (i >> 4), hp = i & 15;
        f32x16 a0 = f32x16{}, a1 = f32x16{};
#pragma unroll 4
        for (int p = 0; p < 64; ++p) {
            const f32x2 c0 = CC[h * 64 + p], b0 = BB[p * 16 + hp], c1 = CC[1024 + h * 64 + p], b1 = BB[1024 + p * 16 + hp];
            const float x0 = hi == 0 ? (c0.x * b0.x - c0.y * b0.y) : -(c0.x * b0.y + c0.y * b0.x);
            const float x1 = hi == 0 ? (c1.x * b1.x - c1.y * b1.y) : -(c1.x * b1.y + c1.y * b1.x);
            a0 = __builtin_amdgcn_mfma_f32_32x32x2f32(x0, WT[(p * 2 + hi) * 32 + i], a0, 0, 0, 0);
            a1 = __builtin_amdgcn_mfma_f32_32x32x2f32(x1, WT[((64 + p) * 2 + hi) * 32 + i], a1, 0, 0, 0);
        }
        const float* sd = C.in[I_SSMD] + l * 512 + g * 16;
#pragma unroll
        for (int r = 0; r < 16; ++r) { const int rl = (r & 3) + 8 * (r >> 2) + 4 * hi, hh = 2 * wv + (rl >> 4), hq = rl & 15;
            float f = a0[r]; if (i == 0) f += a1[r] + (hh == hq ? sd[hh] : 0.f);
            KT[((31 + i) * 16 + hh) * 16 + hq] = (bf16)f2bf(f);
            if (i > 0) KT[((31 - i) * 16 + hh) * 16 + hq] = (bf16)f2bf(a1[r]); }
    }
    __syncthreads();
    bf16* B1 = WSP(bf16, WS_BT1) + (size_t)g * 768 * 512; bf16* B2 = WSP(bf16, WS_BT2) + (size_t)g * 512 * 256;
    for (int i = tid; i < 128 * 64; i += 512) {
        const int n = part * 128 + (i >> 6), ch = i & 63, t = n >> 4, h = n & 15, s = ch >> 1, hp0 = (ch & 1) * 8;
        *(GAS v4u*)(B1 + (size_t)n * 512 + ch * 8) = *(const LAS v4u*)(KT + ((t - s + 31) * 16 + h) * 16 + hp0);
    }
    for (int i = tid; i < 64 * 64; i += 512) {
        const int nn = part * 64 + (i >> 6), ch = i & 63, d = nn >> 7, p = (nn & 127) >> 1, ri = nn & 1, s = ch >> 1, hp0 = (ch & 1) * 8;
        const f32x2 w = POW[(d * 33 + (d == 0 ? 31 - s : s)) * 64 + p]; float v[8];
#pragma unroll
        for (int j = 0; j < 8; ++j) { const f32x2 b = BB[d * 1024 + p * 16 + hp0 + j]; v[j] = ri == 0 ? (w.x * b.x - w.y * b.y) : (w.x * b.y + w.y * b.x); }
        v4u o; o.x = pk2(v[0], v[1]); o.y = pk2(v[2], v[3]); o.z = pk2(v[4], v[5]); o.w = pk2(v[6], v[7]);
        *(GAS v4u*)(B1 + (size_t)(512 + nn) * 512 + ch * 8) = o;
    }
    for (int i = tid; i < 128 * 32; i += 512) {
        const int n = part * 128 + (i >> 5), ch = i & 31, t = n >> 4, h = n & 15, d = ch >> 4, p0 = (ch & 15) * 4; float v[8];
#pragma unroll
        for (int j = 0; j < 4; ++j) { const f32x2 c = CC[d * 1024 + h * 64 + p0 + j], w = POW[(d * 33 + (d == 0 ? t + 1 : 32 - t)) * 64 + p0 + j];
            v[2 * j] = c.x * w.x - c.y * w.y; v[2 * j + 1] = -(c.x * w.y + c.y * w.x); }
        v4u o; o.x = pk2(v[0], v[1]); o.y = pk2(v[2], v[3]); o.z = pk2(v[4], v[5]); o.w = pk2(v[6], v[7]);
        *(GAS v4u*)(B2 + (size_t)n * 256 + ch * 8) = o;
    }
    __syncthreads();
}

template <int MODE>
__device__ __forceinline__ void phase_rows(const Ctx& C, int l) {
    const int gw = C.vcu * NWAVES + C.wave, NGW = C.G * NWAVES, lane = C.lane;
    const float* MODl = WSP(float, WS_MOD) + (size_t)(MODE == 2 ? 0 : l) * 5 * 6144;
    const float* MODp = WSP(float, WS_MOD) + (size_t)(l > 0 ? l - 1 : 0) * 5 * 6144;
    const bf16* YS = WSP(bf16, WS_YSLOT);
    f32x4 nx[4]; v2u nb[4], na[4], nc[4];
#define ROWS_LOAD(mm) do { const int m_ = (mm); \
        if (MODE == 0) { const GAS f32x4* xr = (const GAS f32x4*)in_row(C, m_) + lane; _Pragma("unroll") for (int q = 0; q < 4; ++q) nx[q] = xr[64 * q]; } \
        else { const GAS v2u* xr = (const GAS v2u*)xs_row(C, m_) + lane; const GAS v2u* y0 = (const GAS v2u*)(YS + (size_t)(2 * m_) * D) + lane; const GAS v2u* y1 = (const GAS v2u*)(YS + (size_t)(2 * m_ + 1) * D) + lane; \
            _Pragma("unroll") for (int q = 0; q < 4; ++q) { nb[q] = xr[64 * q]; na[q] = y0[64 * q]; nc[q] = y1[64 * q]; } } } while (0)
    int m = gw; if (MODE == 2) { while (m < T && (m % LB) < CTX) m += NGW; }
    if (m < T) ROWS_LOAD(m);
    while (m < T) {
        const int b = m / LB, j = m - b * LB, cond = j < CTX ? 4 : b;
        f32x4 v[4];
        if (MODE == 0) {
#pragma unroll
            for (int q = 0; q < 4; ++q) v[q] = nx[q]; }
        else { const GAS f32x4* g2 = (const GAS f32x4*)(MODp + cond * 6144 + 5 * 1024) + lane;
#pragma unroll
            for (int q = 0; q < 4; ++q) { const f32x4 g = g2[64 * q]; const v2u a = na[q], c = nc[q], xb_ = nb[q];
                v[q] = (f32x4){bflo(xb_.x), bfhi(xb_.x), bflo(xb_.y), bfhi(xb_.y)} + g * (f32x4){bflo(a.x) + bflo(c.x), bfhi(a.x) + bfhi(c.x), bflo(a.y) + bflo(c.y), bfhi(a.y) + bfhi(c.y)}; } }
        int mn = m + NGW; if (MODE == 2) { while (mn < T && (mn % LB) < CTX) mn += NGW; }
        if (mn < T) ROWS_LOAD(mn);
        float ss = 0.f;
#pragma unroll
        for (int q = 0; q < 4; ++q) ss += (v[q].x * v[q].x + v[q].y * v[q].y) + (v[q].z * v[q].z + v[q].w * v[q].w);
        const float rstd = 1.f / sqrtf(wave_sum(ss, lane) * (1.f / D) + EPS);
        if (MODE == 2) { GAS f32x4* o = (GAS f32x4*)(C.out + (size_t)(b * SEQ + j - CTX) * D) + lane; const GAS f32x4* fg = (const GAS f32x4*)C.in[I_FNG] + lane;
#pragma unroll
            for (int q = 0; q < 4; ++q) o[64 * q] = v[q] * rstd * fg[64 * q]; }
        else { GAS v2u* xo = (GAS v2u*)xs_row(C, m) + lane; GAS v2u* ho = (GAS v2u*)(WSP(bf16, WS_HB) + (size_t)m * D) + lane; GAS unsigned* h8 = (GAS unsigned*)(WSP(unsigned char, WS_HB8) + (size_t)m * D) + lane;
            const GAS f32x4* ng = (const GAS f32x4*)(C.in[I_N1G] + l * D) + lane; const GAS f32x4* sh = (const GAS f32x4*)(MODl + cond * 6144) + lane; const GAS f32x4* sc = (const GAS f32x4*)(MODl + cond * 6144 + 1024) + lane;
#pragma unroll
            for (int q = 0; q < 4; ++q) { xo[64 * q] = (v2u){pk2(v[q].x, v[q].y), pk2(v[q].z, v[q].w)}; const f32x4 h = v[q] * rstd * ng[64 * q] * (sc[64 * q] + 1.f) + sh[64 * q]; if (!W8_ALL) ho[64 * q] = (v2u){pk2(h.x, h.y), pk2(h.z, h.w)}; if (H8_WRITE) h8[64 * q] = pk4_fp8(h.x, h.y, h.z, h.w); } }
        m = mn;
    }
#undef ROWS_LOAD
}

__device__ __forceinline__ void phase_qkprep(const Ctx& C, int l) {
    const int gw = C.vcu * NWAVES + C.wave, NGW = C.G * NWAVES, lane = C.lane, s8 = lane & 7;
    const float* qg = C.in[I_QNG] + l * 64 + 8 * s8; const float* kg = C.in[I_KNG] + l * 64 + 8 * s8;
    float gq[8], gk[8];
#pragma unroll
    for (int i = 0; i < 8; ++i) { gq[i] = qg[i]; gk[i] = kg[i]; }
    const int ax = s8 >> 2, f0 = 8 * (s8 & 1);
    float inv[8];
#pragma unroll
    for (int i = 0; i < 8; ++i) inv[i] = exp2f(-(float)(f0 + i) * 0.8304820237218406f) * 0.15915494309189535f;
    const int kl = lane & 15;
    v4u wq, wk;
    if (gw < T) { wq = *((const GAS v4u*)(WSP(bf16, WS_QA) + (size_t)gw * 512) + lane); wk = *((const GAS v4u*)(WSP(bf16, WS_KA) + (size_t)gw * 128) + kl); }
    for (int m = gw; m < T; m += NGW) {
        const int b = m / LB, j = m - b * LB; const bool lat = j >= CTX; const int tt = j - CTX; const float pos = (float)(ax == 0 ? (tt >> 6) : (tt & 63));
        const v4u cq = wq, ck = wk;
        if (m + NGW < T) { wq = *((const GAS v4u*)(WSP(bf16, WS_QA) + (size_t)(m + NGW) * 512) + lane); wk = *((const GAS v4u*)(WSP(bf16, WS_KA) + (size_t)(m + NGW) * 128) + kl); }
        float cs[8], sn[8];
#pragma unroll
        for (int i = 0; i < 8; ++i) { cs[i] = lat ? cos_rev(pos * inv[i]) : 1.f; sn[i] = lat ? sin_rev(pos * inv[i]) : 0.f; }
#pragma unroll
        for (int which = 0; which < 2; ++which) {
            const v4u w = which == 0 ? cq : ck; float x[8] = {bflo(w.x), bfhi(w.x), bflo(w.y), bfhi(w.y), bflo(w.z), bfhi(w.z), bflo(w.w), bfhi(w.w)};
            float ss = 0.f;
#pragma unroll
            for (int i = 0; i < 8; ++i) ss += x[i] * x[i];
            ss += dpp_mov<0xB1, 0xF>(ss); ss += dpp_mov<0x4E, 0xF>(ss); ss += dpp_mov<0x141, 0xF>(ss);
            const float rstd = 1.f / sqrtf(ss * (1.f / 64.f) + EPS);
            float y[8];
#pragma unroll
            for (int i = 0; i < 8; ++i) { const float xn = x[i] * rstd * (which == 0 ? gq[i] : gk[i]); const float other = dpp_mov<0x4E, 0xF>(xn);
                y[i] = (s8 & 2) ? (xn * cs[i] + other * sn[i]) : (xn * cs[i] - other * sn[i]); }
            const float sc = which == 0 ? C2 : 1.f;
            v4u o; o.x = pk2(y[0] * sc, y[1] * sc); o.y = pk2(y[2] * sc, y[3] * sc); o.z = pk2(y[4] * sc, y[5] * sc); o.w = pk2(y[6] * sc, y[7] * sc);
            if (which == 0) *((GAS v4u*)(WSP(bf16, WS_QA) + (size_t)m * 512) + lane) = o;
            else if (lane < 16) *((GAS v4u*)(WSP(bf16, WS_KA) + (size_t)m * 128) + lane) = o;
        }
    }
}

__device__ __forceinline__ void phase_carry(const Ctx& C, int l) {
    if (C.vcu >= 32) return;
    const int b = C.vcu >> 3, g = (C.vcu & 7) * 4 + (C.wave >> 1), d = C.wave & 1, p = C.lane;
    const int li = ((l * 2 + d) * 32 + g) * 64 + p;
    const float re = C.in[I_LRE][li], im = C.in[I_LIM][li], dt = __expf(C.in[I_LDT][(l * 2 + d) * 32 + g]);
    const float mag = __expf(re * dt * 32.f), rev = im * dt * 32.f * 0.15915494309189535f; const float Lr = mag * cos_rev(rev), Li = mag * sin_rev(rev);
    const GAS f32x2* S = (const GAS f32x2*)(WSP(float, WS_SST) + (size_t)(b * NCH) * 8192 + g * 256 + d * 128) + p;
    GAS unsigned* X = (GAS unsigned*)(WSP(bf16, WS_XST) + (size_t)(b * NCH) * 8192 + g * 256 + d * 128) + p;
    float sr = 0.f, si = 0.f;
    if (d == 0) {
        for (int c0 = 0; c0 < NCH; c0 += 8) { f32x2 s[8];
#pragma unroll
            for (int k = 0; k < 8; ++k) s[k] = S[(size_t)(c0 + k) * 4096];
#pragma unroll
            for (int k = 0; k < 8; ++k) { X[(size_t)(c0 + k) * 4096] = pk2(sr, si); const float nr = Lr * sr - Li * si + s[k].x, ni = Lr * si + Li * sr + s[k].y; sr = nr; si = ni; } }
    } else {
        for (int seg = 0; seg < 33; ++seg) { const int chi = seg == 0 ? 7 : NCH - 1 - (seg - 1) * 8; f32x2 s[8];
#pragma unroll
            for (int k = 0; k < 8; ++k) s[k] = S[(size_t)(chi - k) * 4096];
#pragma unroll
            for (int k = 0; k < 8; ++k) { X[(size_t)(chi - k) * 4096] = pk2(sr, si); const float nr = Lr * sr - Li * si + s[k].x, ni = Lr * si + Li * sr + s[k].y; sr = nr; si = ni; } }
    }
}

__device__ __forceinline__ void phase_norm2(const Ctx& C, int l) {
    LAS float* RWt = (LAS float*)C.lds;
    LAS unsigned* REC = (LAS unsigned*)(C.lds + 65536);
    LAS float* LG = (LAS float*)(C.lds + 65536 + 16384);
    LAS unsigned* LCNT = (LAS unsigned*)(C.lds + 65536 + 32768);
    const int lane = C.lane, tid = C.tid;
    for (int i = tid; i < 16384; i += 512) { const int k = i >> 4, e = i & 15; RWt[e * 1024 + k] = C.in[I_RW][i]; }
    if (tid < 32) LCNT[tid] = 0u;
    __syncthreads();
    const float* MODl = WSP(float, WS_MOD) + (size_t)l * 5 * 6144;
    int nrows = 0; for (int m = C.vcu; m < T; m += C.G) ++nrows;
    v2u nx[2][4];
#define N2_LOAD(ii) do { _Pragma("unroll") for (int rr = 0; rr < 2; ++rr) { const int i_ = (ii) + rr * NWAVES; const int m_ = C.vcu + C.G * (i_ < nrows ? i_ : (ii)); const GAS v2u* xr = (const GAS v2u*)xs_row(C, m_) + lane; \
        _Pragma("unroll") for (int q = 0; q < 4; ++q) nx[rr][q] = xr[64 * q]; } } while (0)
    if (C.wave < nrows) N2_LOAD(C.wave);
    for (int i = C.wave; i < nrows; i += 2 * NWAVES) {
        const bool has1 = i + NWAVES < nrows;
        f32x4 hv[2][4];
#pragma unroll
        for (int rr = 0; rr < 2; ++rr) { const int ir = (rr && has1) ? i + NWAVES : i; const int m = C.vcu + C.G * ir, cond = cond_of(m);
            GAS unsigned* h8 = (GAS unsigned*)(WSP(unsigned char, WS_HB8) + (size_t)m * D) + lane; GAS v2u* ho = (GAS v2u*)(WSP(bf16, WS_HB) + (size_t)m * D) + lane;
            const GAS f32x4* ng = (const GAS f32x4*)(C.in[I_N2G] + l * D) + lane; const GAS f32x4* sh = (const GAS f32x4*)(MODl + cond * 6144 + 3072) + lane; const GAS f32x4* sc = (const GAS f32x4*)(MODl + cond * 6144 + 4096) + lane;
            float ss = 0.f; f32x4 xf[4];
#pragma unroll
            for (int q = 0; q < 4; ++q) { const v2u w_ = nx[rr][q]; const f32x4 v = (f32x4){bflo(w_.x), bfhi(w_.x), bflo(w_.y), bfhi(w_.y)}; xf[q] = v; ss += (v.x * v.x + v.y * v.y) + (v.z * v.z + v.w * v.w); }
            const float rstd = 1.f / sqrtf(wave_sum(ss, lane) * (1.f / D) + EPS);
#pragma unroll
            for (int q = 0; q < 4; ++q) { const f32x4 h = xf[q] * rstd * ng[64 * q] * (sc[64 * q] + 1.f) + sh[64 * q]; hv[rr][q] = h;
                if (rr == 0 || has1) { if (FP8_MOE) h8[64 * q] = pk4_fp8(h.x, h.y, h.z, h.w); else ho[64 * q] = (v2u){pk2(h.x, h.y), pk2(h.z, h.w)}; } } }
        if (i + 2 * NWAVES < nrows) N2_LOAD(i + 2 * NWAVES);
        float mine0 = 0.f, mine1 = 0.f;
#pragma unroll
        for (int e = 0; e < 16; ++e) { float a0 = 0.f, a1 = 0.f;
#pragma unroll
            for (int q = 0; q < 4; ++q) { const f32x4 w = *(const LAS f32x4*)(RWt + e * 1024 + 256 * q + 4 * lane); const f32x4 h0 = hv[0][q], h1 = hv[1][q];
                a0 += (h0.x * w.x + h0.y * w.y) + (h0.z * w.z + h0.w * w.w); a1 += (h1.x * w.x + h1.y * w.y) + (h1.z * w.z + h1.w * w.w); }
            const float t0 = wave_sum(a0, lane), t1 = wave_sum(a1, lane); mine0 = lane == e ? t0 : mine0; mine1 = lane == e ? t1 : mine1; }
        if (lane < 16) { LG[i * 16 + lane] = mine0; if (has1) LG[(i + NWAVES) * 16 + lane] = mine1; }
    }
#undef N2_LOAD
    __syncthreads();
    float rb[16];
#pragma unroll
    for (int e = 0; e < 16; ++e) rb[e] = C.in[I_RB][e];
    for (int i = tid; i < nrows; i += 512) {
        float lg[16];
#pragma unroll
        for (int q = 0; q < 4; ++q) { const f32x4 t = *(const LAS f32x4*)(LG + i * 16 + 4 * q); lg[4 * q] = t.x; lg[4 * q + 1] = t.y; lg[4 * q + 2] = t.z; lg[4 * q + 3] = t.w; }
        float mx = lg[0];
#pragma unroll
        for (int e = 1; e < 16; ++e) mx = fmaxf(mx, lg[e]);
        float pr[16], sel[16], sum = 0.f;
#pragma unroll
        for (int e = 0; e < 16; ++e) { pr[e] = __expf(lg[e] - mx); sum += pr[e]; }
        const float rs = 1.f / sum;
#pragma unroll
        for (int e = 0; e < 16; ++e) { pr[e] *= rs; sel[e] = pr[e] + rb[e]; }
        float bestv = -1e30f; int best = 0;
#pragma unroll
        for (int gq = 0; gq < 4; ++gq) { float m1 = -1e30f, m2 = -1e30f;
#pragma unroll
            for (int k = 0; k < 4; ++k) { const float s_ = sel[4 * gq + k]; if (s_ > m1) { m2 = m1; m1 = s_; } else if (s_ > m2) m2 = s_; }
            const float gs = m1 + m2; if (gs > bestv) { bestv = gs; best = gq; } }
        float s4[4], p4[4];
#pragma unroll
        for (int k = 0; k < 4; ++k) { s4[k] = best == 0 ? sel[k] : best == 1 ? sel[4 + k] : best == 2 ? sel[8 + k] : sel[12 + k]; p4[k] = best == 0 ? pr[k] : best == 1 ? pr[4 + k] : best == 2 ? pr[8 + k] : pr[12 + k]; }
        int i0 = 0; float v0 = s4[0], q0 = p4[0];
#pragma unroll
        for (int k = 1; k < 4; ++k) if (s4[k] > v0) { v0 = s4[k]; i0 = k; q0 = p4[k]; }
        int i1 = i0 == 0 ? 1 : 0; float v1 = -1e30f, q1 = p4[i0 == 0 ? 1 : 0];
#pragma unroll
        for (int k = 0; k < 4; ++k) if (k != i0 && s4[k] > v1) { v1 = s4[k]; i1 = k; q1 = p4[k]; }
        const int e0 = 4 * best + i0, e1 = 4 * best + i1; const float wn = 1.f / (q0 + q1);
        const unsigned lp0 = atomicAdd((unsigned*)(LCNT + e0), 1u), lp1 = atomicAdd((unsigned*)(LCNT + e1), 1u);
        REC[i * 4 + 0] = (unsigned)e0 | ((unsigned)e1 << 8) | (lp0 << 16); REC[i * 4 + 1] = lp1; REC[i * 4 + 2] = __float_as_uint(q0 * wn); REC[i * 4 + 3] = __float_as_uint(q1 * wn);
    }
    __syncthreads();
    if (tid < 16) LCNT[16 + tid] = __hip_atomic_fetch_add((unsigned*)(C.ctl + CW_CNT + l * 1024 + 64 * tid), LCNT[tid], RLX_AGENT);
    __syncthreads();
    int* LIST = WSP(int, WS_LIST); float* RWG = WSP(float, WS_RW);
    for (int i = tid; i < nrows; i += 512) { const int m = C.vcu + C.G * i; const unsigned r0 = REC[i * 4], r1 = REC[i * 4 + 1];
        const int e0 = r0 & 255, e1 = (r0 >> 8) & 255; const unsigned lp0 = r0 >> 16, lp1 = r1;
        LIST[(size_t)e0 * T + LCNT[16 + e0] + lp0] = 2 * m; LIST[(size_t)e1 * T + LCNT[16 + e1] + lp1] = 2 * m + 1;
        RWG[2 * m] = __uint_as_float(REC[i * 4 + 2]); RWG[2 * m + 1] = __uint_as_float(REC[i * 4 + 3]); }
    __syncthreads();
}
using pg8::Unit;
typedef f32x4 Acc[2][2][4][2];
__device__ __forceinline__ v4u pack8(const f32x4& a, const f32x4& b) { v4u w; w.x = cvt_pk_bf16(a[0], a[1]); w.y = cvt_pk_bf16(a[2], a[3]); w.z = cvt_pk_bf16(b[0], b[1]); w.w = cvt_pk_bf16(b[2], b[3]); return w; }
__device__ __forceinline__ void unpack8(const v4u& w, f32x4& a, f32x4& b) { a = (f32x4){bflo(w.x), bfhi(w.x), bflo(w.y), bfhi(w.y)}; b = (f32x4){bflo(w.z), bfhi(w.z), bflo(w.w), bfhi(w.w)}; }
#ifndef WT_MODE
#define WT_MODE 0
#endif
__device__ __forceinline__ void st16(void* p, const v4u& v) {
#if WT_MODE == 1
    asm volatile("global_store_dwordx4 %0, %1, off sc0 sc1" :: "v"(p), "v"(v) : "memory");
#elif WT_MODE == 2
    asm volatile("global_store_dwordx4 %0, %1, off nt" :: "v"(p), "v"(v) : "memory");
#else
    *(GAS v4u*)p = v;
#endif
}
__device__ __forceinline__ int chunk_m0(int cr) { return (cr / NCH) * LB + (cr % NCH) * 32; }

struct PWin {
    static constexpr bool EARLY_AOFF = false, FP8 = false; unsigned char* ws; int G, c; int K; unsigned kstepA;
    __device__ __forceinline__ bool next(int i, Unit& u) const { const long L = (long)i * G + c; if (L >= NPAN * 11) return false; pg8::static_decode((int)L, NPAN, 11, u.pm, u.pn); u.z = 0; return true; }
    __device__ __forceinline__ const char* a_base(const Unit& u) const { return (const char*)(ws + WS_HB) + (size_t)u.pm * 256 * 1024 * 2; }
    __device__ __forceinline__ unsigned a_off(const Unit&, int h, int R, int Cc) const { return (unsigned)((h * 128 + R) * 1024 + Cc) * 2u; }
    __device__ __forceinline__ const char* b_base(const Unit& u) const { return (const char*)(ws + WS_WIN) + (size_t)u.pn * 256 * 1024 * 2; }
    __device__ __forceinline__ void epi(const Acc& acc, const Unit& u, int wr, int wc, int fr, int fq) const {
        const int row0 = u.pm * 256 + wr * 64 + fr;
#pragma unroll
        for (int bj = 0; bj < 2; ++bj) {
            const int cb = u.pn * 256 + bj * 128; bf16* dst; int ld, col, mode = 0; float sc = 1.f;
            if (cb < 512) { dst = (bf16*)(ws + WS_U) + ((size_t)((cb + wc * 32 + 8 * fq) >> 4) * T) * 16 + ((8 * fq) & 15) - (wc * 32 + 8 * fq); ld = 16; col = 0; }
            else if (cb < 1024) { dst = (bf16*)(ws + WS_QA); ld = 512; col = cb - 512; }
            else if (cb == 1024) { dst = (bf16*)(ws + WS_KA); ld = 128; col = 0; }
            else if (cb == 1152) { dst = (bf16*)(ws + WS_VA); ld = 128; col = 0; }
            else if (cb < 1792) { dst = (bf16*)(ws + WS_QN); ld = 512; col = cb - 1280; sc = C2; }
            else if (cb < 2304) { dst = (bf16*)(ws + WS_KN); ld = 512; col = cb - 1792; }
            else { dst = (bf16*)(ws + WS_VN); ld = 512; col = cb - 2304; }
            const int c0 = col + wc * 32 + 8 * fq;
#pragma unroll
            for (int ai = 0; ai < 2; ++ai)
#pragma unroll
                for (int m = 0; m < 4; ++m) { f32x4 v0 = acc[ai][bj][m][0], v1 = acc[ai][bj][m][1];
                    if (mode) { v0 = (f32x4){fsigmoid(v0[0]), fsigmoid(v0[1]), fsigmoid(v0[2]), fsigmoid(v0[3])}; v1 = (f32x4){fsigmoid(v1[0]), fsigmoid(v1[1]), fsigmoid(v1[2]), fsigmoid(v1[3])}; }
                    else { v0 = v0 * sc; v1 = v1 * sc; }
                    st16(dst + (size_t)(row0 + ai * 128 + m * 16) * ld + c0, pack8(v0, v1)); __builtin_amdgcn_sched_barrier(0); }
        }
    }
};

struct PWin8 {
    static constexpr bool EARLY_AOFF = false, FP8 = true; unsigned char* ws; int G, c; int K; unsigned kstepA;
    __device__ __forceinline__ bool next(int i, Unit& u) const { const long L = (long)i * G + c; if (L >= 2 * NPAN * 23) return false; pg8::static_decode((int)L, 2 * NPAN, 23, u.pm, u.pn); u.z = 0; return true; }
    __device__ __forceinline__ const char* a_base(const Unit& u) const { return (const char*)(ws + WS_HB8) + (size_t)u.pm * 128 * 1024; }
    __device__ __forceinline__ unsigned a_off(const Unit&, int R, int Cc) const { return (unsigned)(R * 1024 + Cc * 2); }
    __device__ __forceinline__ const char* b_base(const Unit& u) const { return (const char*)(ws + WS_WIN) + (size_t)u.pn * 256 * 1024; }
    __device__ __forceinline__ void epi(const f32x4 (&acc)[2][4][2], f32x4 (&)[2][4][2], const Unit& u, int wr, int wc, int fr, int fq) const {
        const int row0 = u.pm * 128 + wr * 64 + fr;
#pragma unroll
        for (int bj = 0; bj < 2; ++bj) {
            const int cb = u.pn * 256 + bj * 128;
            if (cb >= 2816) { const int c0 = cb - 2816 + wc * 32 + 8 * fq;
#pragma unroll
                for (int m = 0; m < 4; ++m) { f32x4 v0 = acc[bj][m][0] * (1.f / 64.f), v1 = acc[bj][m][1] * (1.f / 64.f);
                    v0 = (f32x4){fsigmoid(v0[0]), fsigmoid(v0[1]), fsigmoid(v0[2]), fsigmoid(v0[3])}; v1 = (f32x4){fsigmoid(v1[0]), fsigmoid(v1[1]), fsigmoid(v1[2]), fsigmoid(v1[3])};
                    *(GAS v2u*)((unsigned char*)(ws + WS_GATES) + (size_t)(row0 + m * 16) * 3072 + c0) = (v2u){pk4_fp8(v0[0], v0[1], v0[2], v0[3]), pk4_fp8(v1[0], v1[1], v1[2], v1[3])}; }
            } else {
                bf16* dst; int ld, col; float sc = 1.f / 64.f;
                if (cb < 512) { dst = (bf16*)(ws + WS_U) + ((size_t)((cb + wc * 32 + 8 * fq) >> 4) * T) * 16 + ((8 * fq) & 15) - (wc * 32 + 8 * fq); ld = 16; col = 0; }
                else if (cb < 1024) { dst = (bf16*)(ws + WS_QA); ld = 512; col = cb - 512; }
                else if (cb == 1024) { dst = (bf16*)(ws + WS_KA); ld = 128; col = 0; }
                else if (cb == 1152) { dst = (bf16*)(ws + WS_VA); ld = 128; col = 0; }
                else if (cb < 1792) { dst = (bf16*)(ws + WS_QN); ld = 512; col = cb - 1280; sc = C2 / 64.f; }
                else if (cb < 2304) { dst = (bf16*)(ws + WS_KN); ld = 512; col = cb - 1792; }
                else { dst = (bf16*)(ws + WS_VN); ld = 512; col = cb - 2304; }
                const int c0 = col + wc * 32 + 8 * fq;
#pragma unroll
                for (int m = 0; m < 4; ++m) *(GAS v4u*)(dst + (size_t)(row0 + m * 16) * ld + c0) = pack8(acc[bj][m][0] * sc, acc[bj][m][1] * sc);
            }
        }
    }
};

struct PGate {
    static constexpr bool EARLY_AOFF = false, FP8 = !GATE_BF16; unsigned char* ws; int G, c; int K; unsigned kstepA;
    __device__ __forceinline__ bool next(int i, Unit& u) const { const long L = (long)i * G + c; if (L >= 2 * NPAN * 12) return false; pg8::static_decode((int)L, 2 * NPAN, 12, u.pm, u.pn); u.z = 0; return true; }
    __device__ __forceinline__ const char* a_base(const Unit& u) const { return GATE_BF16 ? (const char*)(ws + WS_HB) + (size_t)u.pm * 128 * 2048 : (const char*)(ws + WS_HB8) + (size_t)u.pm * 128 * 1024; }
    __device__ __forceinline__ unsigned a_off(const Unit&, int R, int Cc) const { return GATE_BF16 ? (unsigned)(R * 2048 + Cc * 2) : (unsigned)(R * 1024 + Cc * 2); }
    __device__ __forceinline__ const char* b_base(const Unit& u) const { return GATE_BF16 ? (const char*)(ws + WS_WIN) + (size_t)(2816 + u.pn * 256) * 2048 : (const char*)(ws + WS_WIN8) + (size_t)u.pn * 256 * 1024; }
    __device__ __forceinline__ void epi(const f32x4 (&acc)[2][4][2], f32x4 (&)[2][4][2], const Unit& u, int wr, int wc, int fr, int fq) const {
#pragma unroll
        for (int m = 0; m < 4; ++m) { const size_t r = (size_t)(u.pm * 128 + wr * 64 + m * 16 + fr);
#pragma unroll
            for (int bj = 0; bj < 2; ++bj) { const int c0 = u.pn * 256 + bj * 128 + wc * 32 + 8 * fq; f32x4 v0 = acc[bj][m][0] * (GATE_BF16 ? 1.f : 1.f / 64.f), v1 = acc[bj][m][1] * (GATE_BF16 ? 1.f : 1.f / 64.f);
                v0 = (f32x4){fsigmoid(v0[0]), fsigmoid(v0[1]), fsigmoid(v0[2]), fsigmoid(v0[3])}; v1 = (f32x4){fsigmoid(v1[0]), fsigmoid(v1[1]), fsigmoid(v1[2]), fsigmoid(v1[3])};
                if (GATE_BF16) *(GAS v4u*)((bf16*)(ws + WS_GATES) + r * 3072 + c0) = pack8(v0, v1);
                else *(GAS v2u*)((unsigned char*)(ws + WS_GATES) + r * 3072 + c0) = (v2u){pk4_fp8(v0[0], v0[1], v0[2], v0[3]), pk4_fp8(v1[0], v1[1], v1[2], v1[3])}; }
            __builtin_amdgcn_sched_barrier(0); }
    }
};

struct PS5A {
    static constexpr bool EARLY_AOFF = false, FP8 = false; unsigned char* ws; int G, c; int K; unsigned kstepA;
    __device__ __forceinline__ bool next(int i, Unit& u) const { const long L = (long)i * G + c; if (L >= 32 * 15) return false; const int l = (int)L; u.z = l / 15; const int r = l % 15; u.pm = r / 3; u.pn = r % 3; return true; }
    __device__ __forceinline__ const char* a_base(const Unit& u) const { return (const char*)(ws + WS_U) + (size_t)u.z * T * 32; }
    __device__ __forceinline__ unsigned a_off(const Unit& u, int h, int R, int Cc) const { int cr = u.pm * 256 + h * 128 + R; cr = cr < NCR ? cr : NCR - 1; return (unsigned)(cr * 512 + Cc) * 2u; }
    __device__ __forceinline__ const char* b_base(const Unit& u) const { return (const char*)(ws + WS_BT1) + ((size_t)u.z * 768 + u.pn * 256) * 512 * 2; }
    __device__ __forceinline__ void epi(const Acc& acc, const Unit& u, int wr, int wc, int fr, int fq) const {
#pragma unroll
        for (int ai = 0; ai < 2; ++ai)
#pragma unroll
            for (int m = 0; m < 4; ++m) { const int cr = u.pm * 256 + ai * 128 + wr * 64 + m * 16 + fr; if (cr >= NCR) continue;
#pragma unroll
                for (int bj = 0; bj < 2; ++bj) { const int n = bj * 128 + wc * 32 + 8 * fq;
                    if (u.pn < 2) *(GAS v4u*)((bf16*)(ws + WS_YG) + (size_t)u.z * T * 16 + (size_t)cr * 512 + u.pn * 256 + n) = pack8(acc[ai][bj][m][0], acc[ai][bj][m][1]);
                    else { GAS f32x4* o = (GAS f32x4*)((float*)(ws + WS_SST) + (size_t)cr * 8192 + u.z * 256 + n); o[0] = acc[ai][bj][m][0]; o[1] = acc[ai][bj][m][1]; } }
                __builtin_amdgcn_sched_barrier(0); }
    }
};

struct PS5B {
    static constexpr bool EARLY_AOFF = false, FP8 = false; unsigned char* ws; int G, c; int K; unsigned kstepA;
    __device__ __forceinline__ bool next(int i, Unit& u) const { const long L = (long)i * G + c; if (L >= 32 * 10) return false; const int l = (int)L; u.z = l / 10; const int r = l % 10; u.pm = r / 2; u.pn = r % 2; return true; }
    __device__ __forceinline__ const char* a_base(const Unit& u) const { return (const char*)(ws + WS_XST) + (size_t)u.z * 512; }
    __device__ __forceinline__ unsigned a_off(const Unit& u, int h, int R, int Cc) const { int cr = u.pm * 256 + h * 128 + R; cr = cr < NCR ? cr : NCR - 1; return (unsigned)(cr * 8192 + Cc) * 2u; }
    __device__ __forceinline__ const char* b_base(const Unit& u) const { return (const char*)(ws + WS_BT2) + ((size_t)u.z * 512 + u.pn * 256) * 256 * 2; }
    __device__ __forceinline__ void epi(const Acc& acc, const Unit& u, int wr, int wc, int fr, int fq) const {
#pragma unroll
        for (int ai = 0; ai < 2; ++ai) {
            v4u yw[4][2];
#pragma unroll
            for (int m = 0; m < 4; ++m) { int cr = u.pm * 256 + ai * 128 + wr * 64 + m * 16 + fr; cr = cr < NCR ? cr : NCR - 1;
#pragma unroll
                for (int bj = 0; bj < 2; ++bj) yw[m][bj] = *(const GAS v4u*)((const bf16*)(ws + WS_YG) + (size_t)u.z * T * 16 + (size_t)cr * 512 + u.pn * 256 + bj * 128 + wc * 32 + 8 * fq); }
#pragma unroll
            for (int m = 0; m < 4; ++m) { const int cr = u.pm * 256 + ai * 128 + wr * 64 + m * 16 + fr; if (cr >= NCR) continue;
#pragma unroll
                for (int bj = 0; bj < 2; ++bj) { const int nn = u.pn * 256 + bj * 128 + wc * 32 + 8 * fq, t = nn >> 4, h0 = nn & 15;
                    GAS v4u* p = (GAS v4u*)((bf16*)(ws + WS_YS) + (size_t)(chunk_m0(cr) + t) * 512 + u.z * 16 + h0);
                    f32x4 y0, y1; { const v4u w_ = yw[m][bj]; unpack8(w_, y0, y1); } y0 += acc[ai][bj][m][0]; y1 += acc[ai][bj][m][1];
                    y0 = (f32x4){gelu_tanh(y0[0]), gelu_tanh(y0[1]), gelu_tanh(y0[2]), gelu_tanh(y0[3])}; y1 = (f32x4){gelu_tanh(y1[0]), gelu_tanh(y1[1]), gelu_tanh(y1[2]), gelu_tanh(y1[3])};
                    *p = pack8(y0, y1); } } }
    }
};

__device__ __forceinline__ int half_panel(int hl, bool lat_only) { if (!lat_only) return hl; const int pl = hl >> 1; return 2 * (pl + (pl >> 5) + 1) + (hl & 1); }
struct PGlu {
    static constexpr bool EARLY_AOFF = false, FP8 = false; unsigned char* ws; int G, c; int K; unsigned kstepA; bool lat_only;
    __device__ __forceinline__ bool next(int i, Unit& u) const { const int nH = lat_only ? 256 : 2 * NPAN; const long L = (long)i * G + c; if (L >= nH * 2) return false; pg8::static_decode((int)L, nH, 2, u.pm, u.pn); u.pm = half_panel(u.pm, lat_only); u.z = 0; return true; }
    __device__ __forceinline__ const char* a_base(const Unit& u) const { return (const char*)(ws + WS_YS) + (size_t)u.pm * 128 * 512 * 2; }
    __device__ __forceinline__ unsigned a_off(const Unit&, int R, int Cc) const { return (unsigned)(R * 512 + Cc) * 2u; }
    __device__ __forceinline__ const char* b_base(const Unit& u) const { return (const char*)(ws + WS_WGLU) + (size_t)u.pn * 256 * 512 * 2; }
    __device__ __forceinline__ void epi(const f32x4 (&acc)[2][4][2], f32x4 (&)[2][4][2], const Unit& u, int wr, int wc, int fr, int fq) const {
        v4u zw[4][2];
#pragma unroll
        for (int m = 0; m < 4; ++m)
#pragma unroll
            for (int bj = 0; bj < 2; ++bj) zw[m][bj] = *(const GAS v4u*)((const bf16*)(ws + WS_YS) + (size_t)(u.pm * 128 + wr * 64 + m * 16 + fr) * 512 + u.pn * 256 + bj * 128 + wc * 32 + 8 * fq);
#pragma unroll
        for (int m = 0; m < 4; ++m) { const size_t r = (size_t)(u.pm * 128 + wr * 64 + m * 16 + fr);
#pragma unroll
            for (int bj = 0; bj < 2; ++bj) { const int cc = u.pn * 256 + bj * 128 + wc * 32 + 8 * fq;
                f32x4 z0, z1; { const v4u w_ = zw[m][bj]; unpack8(w_, z0, z1); } const f32x4 a0 = acc[bj][m][0], a1 = acc[bj][m][1];
                z0 = z0 * (f32x4){fsigmoid(a0[0]), fsigmoid(a0[1]), fsigmoid(a0[2]), fsigmoid(a0[3])}; z1 = z1 * (f32x4){fsigmoid(a1[0]), fsigmoid(a1[1]), fsigmoid(a1[2]), fsigmoid(a1[3])};
                *(GAS v4u*)((bf16*)(ws + WS_U) + r * 512 + cc) = pack8(z0, z1); } }
    }
};

typedef f32x4 Acc128[2][4][2];
struct PMerge {
    static constexpr bool EARLY_AOFF = false, FP8 = false; unsigned char* ws; int G, c; int K; unsigned kstepA; bool lat_only;
    __device__ __forceinline__ bool next(int i, Unit& u) const { const int nH = lat_only ? 256 : 2 * NPAN; const long tile = (long)(i / 3) * G + c; if (tile >= nH * 4) return false; pg8::static_decode((int)tile, nH, 4, u.pm, u.pn); u.pm = half_panel(u.pm, lat_only); u.z = i % 3; return true; }
    __device__ __forceinline__ const char* a_base(const Unit& u) const { const size_t off = u.z == 0 ? WS_U : (u.z == 1 ? WS_AO : WS_NO); return (const char*)(ws + off) + (size_t)u.pm * 128 * 512 * 2; }
    __device__ __forceinline__ unsigned a_off(const Unit&, int R, int Cc) const { return (unsigned)(R * 512 + Cc) * 2u; }
    __device__ __forceinline__ const char* b_base(const Unit& u) const { return (const char*)(ws + WS_WBR) + ((size_t)u.z * 1024 + u.pn * 256) * 512 * 2; }
    __device__ __forceinline__ void epi(const Acc128& acc, Acc128& mrg, const Unit& u, int wr, int wc, int fr, int fq) const {
        v2u gw[4][2];
#pragma unroll
        for (int m = 0; m < 4; ++m)
#pragma unroll
            for (int bj = 0; bj < 2; ++bj) gw[m][bj] = *(const GAS v2u*)((const unsigned char*)(ws + WS_GATES) + (size_t)(u.pm * 128 + wr * 64 + m * 16 + fr) * 3072 + u.z * 1024 + u.pn * 256 + bj * 128 + wc * 32 + 8 * fq);
#pragma unroll
        for (int m = 0; m < 4; ++m) { const size_t r = (size_t)(u.pm * 128 + wr * 64 + m * 16 + fr);
#pragma unroll
            for (int bj = 0; bj < 2; ++bj) { const int cc = u.pn * 256 + bj * 128 + wc * 32 + 8 * fq; const v2u w_ = gw[m][bj];
                const f32x4 g0 = (f32x4){__builtin_amdgcn_cvt_f32_fp8((int)w_.x, 0), __builtin_amdgcn_cvt_f32_fp8((int)w_.x, 1), __builtin_amdgcn_cvt_f32_fp8((int)w_.x, 2), __builtin_amdgcn_cvt_f32_fp8((int)w_.x, 3)};
                const f32x4 g1 = (f32x4){__builtin_amdgcn_cvt_f32_fp8((int)w_.y, 0), __builtin_amdgcn_cvt_f32_fp8((int)w_.y, 1), __builtin_amdgcn_cvt_f32_fp8((int)w_.y, 2), __builtin_amdgcn_cvt_f32_fp8((int)w_.y, 3)};
                if (u.z == 0) { mrg[bj][m][0] = g0 * acc[bj][m][0]; mrg[bj][m][1] = g1 * acc[bj][m][1]; }
                else { mrg[bj][m][0] += g0 * acc[bj][m][0]; mrg[bj][m][1] += g1 * acc[bj][m][1]; }
                if (u.z == 2) *(GAS v4u*)((bf16*)(ws + WS_HB) + r * 1024 + cc) = pack8(mrg[bj][m][0], mrg[bj][m][1]); } }
    }
};

struct PWout {
    static constexpr bool EARLY_AOFF = false, FP8 = false; unsigned char* ws; float* out; const float* mod; int G, c; int K; unsigned kstepA; bool lat_only;
    __device__ __forceinline__ bool next(int i, Unit& u) const { const int nH = lat_only ? 256 : 2 * NPAN; const long L = (long)i * G + c; if (L >= nH * 4) return false; pg8::static_decode((int)L, nH, 4, u.pm, u.pn); u.pm = half_panel(u.pm, lat_only); u.z = 0; return true; }
    __device__ __forceinline__ const char* a_base(const Unit& u) const { return (const char*)(ws + WS_HB) + (size_t)u.pm * 128 * 1024 * 2; }
    __device__ __forceinline__ unsigned a_off(const Unit&, int R, int Cc) const { return (unsigned)(R * 1024 + Cc) * 2u; }
    __device__ __forceinline__ const char* b_base(const Unit& u) const { return (const char*)(ws + WS_WOUT) + (size_t)u.pn * 256 * 1024 * 2; }
    __device__ __forceinline__ void epi(const f32x4 (&acc)[2][4][2], f32x4 (&)[2][4][2], const Unit& u, int wr, int wc, int fr, int fq) const {
        const int pm = u.pm >> 1, b = pm / 33, pr = pm % 33, cond = pr == 0 ? 4 : b;
        bf16* xb = (bf16*)(ws + WS_XS) + (size_t)u.pm * 128 * D;
        const float* g1 = mod + cond * 6144 + 2048;
        v4u xv[2][4];
#pragma unroll
        for (int bj = 0; bj < 2; ++bj)
#pragma unroll
            for (int m = 0; m < 4; ++m) xv[bj][m] = *(const GAS v4u*)(xb + (size_t)(wr * 64 + m * 16 + fr) * D + u.pn * 256 + bj * 128 + wc * 32 + 8 * fq);
#pragma unroll
        for (int bj = 0; bj < 2; ++bj) { const int cc = u.pn * 256 + bj * 128 + wc * 32 + 8 * fq; const f32x4 ga = *(const GAS f32x4*)(g1 + cc), gb = *(const GAS f32x4*)(g1 + cc + 4);
#pragma unroll
            for (int m = 0; m < 4; ++m) { f32x4 x0, x1; { const v4u w_ = xv[bj][m]; unpack8(w_, x0, x1); }
                *(GAS v4u*)(xb + (size_t)(wr * 64 + m * 16 + fr) * D + cc) = pack8(x0 + ga * acc[bj][m][0], x1 + gb * acc[bj][m][1]); } }
    }
};

struct ExpTab { int cnt[16], tile0[17]; };
__device__ __forceinline__ int exp_find(const int (&tile0)[17], int q) { int e = 0;
#pragma unroll
    for (int k = 1; k < 16; ++k) e += (q >= tile0[k]) ? 1 : 0;
    return e; }

struct PMoe1 {
    static constexpr bool EARLY_AOFF = true, FP8 = true; unsigned char* ws; const LAS int* tab; int G, c; int K; unsigned kstepA;
    __device__ __forceinline__ bool next(int i, Unit& u) const { const long L = (long)i * G + c; const int total = __builtin_amdgcn_readfirstlane(tab[32]) * 4; if (L >= total) return false; const int q = (int)L >> 2; u.pn = (int)L & 3;
        int e = 0;
#pragma unroll
        for (int k = 1; k < 16; ++k) e += (q >= __builtin_amdgcn_readfirstlane(tab[16 + k])) ? 1 : 0;
        u.z = e; u.pm = q - __builtin_amdgcn_readfirstlane(tab[16 + e]); return true; }
    __device__ __forceinline__ const char* a_base(const Unit&) const { return (const char*)(ws + WS_HB8); }
    __device__ __forceinline__ unsigned a_off(const Unit& u, int R, int Cc) const { int r = u.pm * 128 + R; const int n = __builtin_amdgcn_readfirstlane(tab[u.z]); r = r < n ? r : n - 1;
        const int ent = ((const int*)(ws + WS_LIST))[(size_t)u.z * T + r]; return (unsigned)((ent >> 1) * 1024 + Cc * 2); }
    __device__ __forceinline__ const char* b_base(const Unit& u) const { return (const char*)(ws + WS_MOE1) + ((size_t)u.z * 1024 + u.pn * 256) * 1024; }
    __device__ __forceinline__ void epi(const f32x4 (&acc)[2][4][2], f32x4 (&)[2][4][2], const Unit& u, int wr, int wc, int fr, int fq) const {
        const size_t arow0 = (size_t)(__builtin_amdgcn_readfirstlane(tab[16 + u.z]) + u.pm) * 128;
#pragma unroll
        for (int m = 0; m < 4; ++m) { const f32x4 g0 = acc[0][m][0] * (1.f / 64.f), g1 = acc[0][m][1] * (1.f / 64.f), u0 = acc[1][m][0] * (8.f / 64.f), u1 = acc[1][m][1] * (8.f / 64.f);
            const f32x4 v0 = (f32x4){g0[0] * fsigmoid(g0[0]), g0[1] * fsigmoid(g0[1]), g0[2] * fsigmoid(g0[2]), g0[3] * fsigmoid(g0[3])} * u0;
            const f32x4 v1 = (f32x4){g1[0] * fsigmoid(g1[0]), g1[1] * fsigmoid(g1[1]), g1[2] * fsigmoid(g1[2]), g1[3] * fsigmoid(g1[3])} * u1;
            *(GAS v2u*)((unsigned char*)(ws + WS_ACT) + (arow0 + wr * 64 + m * 16 + fr) * 512 + u.pn * 128 + wc * 32 + 8 * fq) = (v2u){pk4_fp8(v0[0], v0[1], v0[2], v0[3]), pk4_fp8(v1[0], v1[1], v1[2], v1[3])}; }
    }
};
struct PMoe2 {
    static constexpr bool EARLY_AOFF = false, FP8 = true; unsigned char* ws; const LAS int* tab; int G, c; int K; unsigned kstepA;
    __device__ __forceinline__ bool next(int i, Unit& u) const { const long L = (long)i * G + c; const int total = __builtin_amdgcn_readfirstlane(tab[32]) * 4; if (L >= total) return false; const int q = (int)L >> 2; u.pn = (int)L & 3;
        int e = 0;
#pragma unroll
        for (int k = 1; k < 16; ++k) e += (q >= __builtin_amdgcn_readfirstlane(tab[16 + k])) ? 1 : 0;
        u.z = e; u.pm = q - __builtin_amdgcn_readfirstlane(tab[16 + e]); return true; }
    __device__ __forceinline__ const char* a_base(const Unit& u) const { return (const char*)(ws + WS_ACT) + (size_t)(__builtin_amdgcn_readfirstlane(tab[16 + u.z]) + u.pm) * 128 * 512; }
    __device__ __forceinline__ unsigned a_off(const Unit&, int R, int Cc) const { return (unsigned)(R * 512 + Cc * 2); }
    __device__ __forceinline__ const char* b_base(const Unit& u) const { return (const char*)(ws + WS_MOE2) + ((size_t)u.z * 1024 + u.pn * 256) * 512; }
    __device__ __forceinline__ void epi(const f32x4 (&acc)[2][4][2], f32x4 (&)[2][4][2], const Unit& u, int wr, int wc, int fr, int fq) const {
        const int n = __builtin_amdgcn_readfirstlane(tab[u.z]);
        int entv[4]; float wv[4];
#pragma unroll
        for (int m = 0; m < 4; ++m) { int r = u.pm * 128 + wr * 64 + m * 16 + fr; r = r < n ? r : n - 1; entv[m] = ((const int*)(ws + WS_LIST))[(size_t)u.z * T + r]; }
#pragma unroll
        for (int m = 0; m < 4; ++m) wv[m] = ((const float*)(ws + WS_RW))[entv[m]] * (1.f / 256.f);
#pragma unroll
        for (int m = 0; m < 4; ++m) { const int r = u.pm * 128 + wr * 64 + m * 16 + fr; if (r >= n) continue;
            const int ent = entv[m]; const float w = wv[m];
#pragma unroll
            for (int bj = 0; bj < 2; ++bj)
                *(GAS v4u*)((bf16*)(ws + WS_YSLOT) + (size_t)ent * 1024 + u.pn * 256 + bj * 128 + wc * 32 + 8 * fq) = pack8(acc[bj][m][0] * w, acc[bj][m][1] * w); }
    }
};
struct PMoe1B {
    static constexpr bool EARLY_AOFF = true, FP8 = false; unsigned char* ws; const LAS int* tab; int G, c; int K; unsigned kstepA;
    __device__ __forceinline__ bool next(int i, Unit& u) const { const long L = (long)i * G + c; const int total = tab[32] * 4; if (L >= total) return false; const int q = (int)L >> 2; u.pn = (int)L & 3;
        int e = 0;
#pragma unroll
        for (int k = 1; k < 16; ++k) e += (q >= tab[16 + k]) ? 1 : 0;
        u.z = e; u.pm = q - tab[16 + e]; return true; }
    __device__ __forceinline__ const char* a_base(const Unit&) const { return (const char*)(ws + WS_HB); }
    __device__ __forceinline__ unsigned a_off(const Unit& u, int h, int R, int Cc) const { int r = u.pm * 256 + h * 128 + R; const int n = tab[u.z]; r = r < n ? r : n - 1;
        const int ent = ((const int*)(ws + WS_LIST))[(size_t)u.z * T + r]; return (unsigned)((ent >> 1) * 1024 + Cc) * 2u; }
    __device__ __forceinline__ const char* b_base(const Unit& u) const { return (const char*)(ws + WS_MOE1) + ((size_t)u.z * 1024 + u.pn * 256) * 1024 * 2; }
    __device__ __forceinline__ void epi(const Acc& acc, const Unit& u, int wr, int wc, int fr, int fq) const {
        const size_t arow0 = (size_t)(tab[16 + u.z] + u.pm) * 256;
#pragma unroll
        for (int ai = 0; ai < 2; ++ai)
#pragma unroll
            for (int m = 0; m < 4; ++m) { const f32x4 g0 = acc[ai][0][m][0], g1 = acc[ai][0][m][1], u0 = acc[ai][1][m][0], u1 = acc[ai][1][m][1];
                const f32x4 v0 = (f32x4){g0[0] * fsigmoid(g0[0]), g0[1] * fsigmoid(g0[1]), g0[2] * fsigmoid(g0[2]), g0[3] * fsigmoid(g0[3])} * u0;
                const f32x4 v1 = (f32x4){g1[0] * fsigmoid(g1[0]), g1[1] * fsigmoid(g1[1]), g1[2] * fsigmoid(g1[2]), g1[3] * fsigmoid(g1[3])} * u1;
                *(GAS v4u*)((bf16*)(ws + WS_ACTB) + (arow0 + ai * 128 + wr * 64 + m * 16 + fr) * 512 + u.pn * 128 + wc * 32 + 8 * fq) = pack8(v0, v1); }
    }
};
struct PMoe2B {
    static constexpr bool EARLY_AOFF = false, FP8 = false; unsigned char* ws; const LAS int* tab; int G, c; int K; unsigned kstepA;
    __device__ __forceinline__ bool next(int i, Unit& u) const { const long L = (long)i * G + c; const int total = tab[32] * 4; if (L >= total) return false; const int q = (int)L >> 2; u.pn = (int)L & 3;
        int e = 0;
#pragma unroll
        for (int k = 1; k < 16; ++k) e += (q >= tab[16 + k]) ? 1 : 0;
        u.z = e; u.pm = q - tab[16 + e]; return true; }
    __device__ __forceinline__ const char* a_base(const Unit& u) const { return (const char*)(ws + WS_ACTB) + (size_t)(tab[16 + u.z] + u.pm) * 256 * 512 * 2; }
    __device__ __forceinline__ unsigned a_off(const Unit&, int h, int R, int Cc) const { return (unsigned)((h * 128 + R) * 512 + Cc) * 2u; }
    __device__ __forceinline__ const char* b_base(const Unit& u) const { return (const char*)(ws + WS_MOE2) + ((size_t)u.z * 1024 + u.pn * 256) * 512 * 2; }
    __device__ __forceinline__ void epi(const Acc& acc, const Unit& u, int wr, int wc, int fr, int fq) const {
        const int n = tab[u.z];
#pragma unroll
        for (int ai = 0; ai < 2; ++ai)
#pragma unroll
            for (int m = 0; m < 4; ++m) { const int r = u.pm * 256 + ai * 128 + wr * 64 + m * 16 + fr; if (r >= n) continue;
                const int ent = ((const int*)(ws + WS_LIST))[(size_t)u.z * T + r]; const float w = ((const float*)(ws + WS_RW))[ent];
#pragma unroll
                for (int bj = 0; bj < 2; ++bj)
                    *(GAS v4u*)((bf16*)(ws + WS_YSLOT) + (size_t)ent * 1024 + u.pn * 256 + bj * 128 + wc * 32 + 8 * fq) = pack8(acc[ai][bj][m][0] * w, acc[ai][bj][m][1] * w); }
    }
};
__device__ __forceinline__ void build_exptab(const Ctx& C, LAS int* tab, int l, int tsh = 7) {
    __syncthreads();
    if (threadIdx.x == 0) { int t0 = 0;
        for (int e = 0; e < 16; ++e) { const int n = (int)__hip_atomic_load((unsigned*)(C.ctl + CW_CNT + l * 1024 + 64 * e), RLX_AGENT); tab[e] = n; tab[16 + e] = t0; t0 += (n + (1 << tsh) - 1) >> tsh; }
        tab[32] = t0; }
    __syncthreads();
}
__device__ __forceinline__ void phase_attn(const Ctx& C, int l, unsigned char* lds_gen) {
    phase_carry(C, l);
    char* shm = (char*)lds_gen;
    bf16* QA = WSP(bf16, WS_QA); bf16* KA = WSP(bf16, WS_KA); bf16* VA = WSP(bf16, WS_VA); bf16* QN = WSP(bf16, WS_QN); bf16* KN = WSP(bf16, WS_KN); bf16* VN = WSP(bf16, WS_VN);
#ifndef ATTN_SEL
#define ATTN_SEL 3
#endif
#ifdef REPMASK
#define REPMASK_ REPMASK
#else
#define REPMASK_ 0
#endif
    const int per = (1024 + C.G - 1) / C.G;
    bool nomax; { float gq = 0.f, gk = 0.f; for (int i = 0; i < 64; ++i) { gq = fmaxf(gq, fabsf(C.in[I_QNG][l * 64 + i])); gk = fmaxf(gk, fabsf(C.in[I_KNG][l * 64 + i])); } nomax = 64.f * gq * gk * C2 <= 60.f; }
    if (ATTN_SEL & 1) for (int i = 0; i < per * (1 + ((REPMASK_ >> 13) & 1)); ++i) { const int id = C.vcu * per + (i % per); if (id >= 1024) continue; const int bh = id >> 5, b = bh >> 3, h = bh & 7, qb = id & 31;
        const bf16* Qu = QA + (size_t)(b * LB + CTX + qb * 256) * 512 + h * 64;
        if (nomax) attn_body::attn_unit<8, false, 512, 128, true>(Qu, 512, KA + (size_t)(b * LB) * 128 + (h >> 2) * 64, VA + (size_t)(b * LB) * 128 + (h >> 2) * 64, 128, WSP(bf16, WS_AO) + (Qu - QA), LB / 64, 0, 0, shm);
        else attn_body::attn_unit<8, false, 512, 128, false>(Qu, 512, KA + (size_t)(b * LB) * 128 + (h >> 2) * 64, VA + (size_t)(b * LB) * 128 + (h >> 2) * 64, 128, WSP(bf16, WS_AO) + (Qu - QA), LB / 64, 0, 0, shm);
    }
    LAS float* bt = (LAS float*)(C.lds + attn_body::LDS_BT);
    const int nctx = (C.vcu >= 64 && C.vcu < 128) ? 1 : 0;
    if (ATTN_SEL & 2) for (int i0 = 0; i0 < (per + nctx) * (1 + ((REPMASK_ >> 14) & 1)); ++i0) { const int i = i0 % (per + nctx);
        const bf16 *Qu, *Kh, *Vh; bf16* Ou; int kvp = 512, NT = 4, r0 = 0, rlo = 0;
        if (i < per) { const int id = C.vcu * per + i; if (id >= 1024) continue; const int bh = id >> 5, b = bh >> 3, h = bh & 7; r0 = (id & 31) * 4;
            const float* rp = C.in[I_RPB] + (size_t)(l * 8 + h) * 465;
            for (int k = C.tid; k < 465; k += 512) bt[k] = rp[k] * LOG2E;
            rlo = r0 - 4 < 0 ? 0 : (r0 - 4 > 120 ? 120 : r0 - 4); const int rh_ = r0 - 1 < 0 ? 0 : (r0 - 1 > 120 ? 120 : r0 - 1), nloc = rh_ + 8 - rlo; NT = (4 + nloc + 1) & ~1;
            Qu = QN + (size_t)(b * LB + CTX + r0 * 64) * 512 + h * 64; Ou = WSP(bf16, WS_NO) + (Qu - QN); Kh = KN + (size_t)(b * LB) * 512 + h * 64; Vh = VN + (size_t)(b * LB) * 512 + h * 64; }
        else { int j = C.vcu - 64; if (j < 32) { const int b = j >> 3, h = j & 7; Qu = QA + (size_t)(b * LB) * 512 + h * 64; Ou = WSP(bf16, WS_AO) + (Qu - QA); Kh = KA + (size_t)(b * LB) * 128 + (h >> 2) * 64; Vh = VA + (size_t)(b * LB) * 128 + (h >> 2) * 64; kvp = 128; }
            else { j -= 32; const int b = j >> 3, h = j & 7; Qu = QN + (size_t)(b * LB) * 512 + h * 64; Ou = WSP(bf16, WS_NO) + (Qu - QN); Kh = KN + (size_t)(b * LB) * 512 + h * 64; Vh = VN + (size_t)(b * LB) * 512 + h * 64; } }
        attn_body::attn_unit<8, true, 512, 0>(Qu, 512, Kh, Vh, kvp, Ou, NT, r0, rlo, shm);
    }
}

constexpr int NPH = 46;
__global__ void __launch_bounds__(NWAVES * 64, 2) fwd(Args args) {
    extern __shared__ __attribute__((aligned(16))) unsigned char lds[];
    Ctx C; C.in = (const __attribute__((address_space(4))) CFP*)__builtin_amdgcn_kernarg_segment_ptr(); C.out = args.out; C.ws = args.ws; C.lds = (LAS unsigned char*)lds; C.ctl = (gu32*)(args.ws + WS_CTL);
    C.tid = 0; C.lane = 0; C.wave = __builtin_amdgcn_readfirstlane((int)threadIdx.x >> 6);
    C.G = gridDim.x; { const int bx = blockIdx.x; C.vcu = (C.G % 8 == 0) ? (bx % 8) * (C.G / 8) + bx / 8 : bx; }
    for (int u = threadIdx.x; u < (LDS_BYTES - LDSCTL_OFF) / 4; u += NWAVES * 64) ((LAS unsigned*)(C.lds + LDSCTL_OFF))[u] = 0u;
    __syncthreads();
    const int lo = args.ph_lo, hi = args.ph_hi;
    XcdBarrier bar; bar.bar = (unsigned*)(C.ctl + CW_BAR); bar.x = 0; bar.st = nullptr;
    if (hi - lo > 1) bar = xcd_barrier_post((unsigned*)(C.ctl + CW_BAR), (volatile LAS unsigned*)(C.lds + MISC_OFF) + 8);
    LAS int* tab = (LAS int*)(C.lds + LDSCTL_OFF);
    const int cg = (int)blockIdx.x;
#ifndef PHMASK
#define PHMASK 0xFFFF
#endif
#define IN(k) (lo <= (k) && (k) < hi)
#define EN(b) ((PHMASK >> (b)) & 1)
#ifndef REPMASK
#define REPMASK 0
#endif
#define RUN(b, stmt) do { stmt; if ((REPMASK >> (b)) & 1) { stmt; } } while (0)
#ifdef DIAG_SEL
#define DIAG_ACC(ty) do { if (blockIdx.x == 0 && threadIdx.x == 0) { volatile LAS unsigned* dg = (volatile LAS unsigned*)(C.lds + LDSCTL_OFF + 160); const unsigned now = (unsigned)__builtin_amdgcn_s_memrealtime(); dg[8 + (ty)] += now - dg[0]; dg[0] = now; } } while (0)
#else
#define DIAG_ACC(ty) do {} while (0)
#endif
#define SEAM(k) do { if (IN(k) && IN((k) + 1)) xcd_barrier(bar); DIAG_ACC((k) == 0 ? 11 : ((k) - 1) % 11); } while (0)
#define LWS() ({ const __attribute__((address_space(4))) CFP* k_ = C.in; asm volatile("" : "+s"(k_)); (unsigned char*)k_[30]; })
#define LC() ({ Ctx c_ = C; c_.tid = threadIdx.x; asm volatile("" : "+v"(c_.tid)); c_.lane = c_.tid & 63; asm volatile("" : "+s"(c_.in)); c_.ws = (unsigned char*)c_.in[30]; c_.out = (float*)c_.in[29]; c_.ctl = (gu32*)(c_.ws + WS_CTL); c_; })
#ifdef DIAG_SEL
    if (blockIdx.x == 0 && threadIdx.x == 0) { volatile LAS unsigned* dg = (volatile LAS unsigned*)(C.lds + LDSCTL_OFF + 160); dg[0] = (unsigned)__builtin_amdgcn_s_memrealtime(); dg[1] = dg[0]; }
#endif
    if (EN(11) && IN(0)) { const Ctx Cl = LC(); phase_mod(Cl); RUN(11, phase_s5mats(Cl, 0, Cl.vcu); phase_weights(Cl, 0)); }
    SEAM(0);
    for (int l = 0; l < NLAYER; ++l) {
        const int pb = 1 + 11 * l;
        if (EN(0) && IN(pb)) { const Ctx Cl = LC(); if (l == 0) phase_rows<0>(Cl, 0); else { phase_weights(Cl, l); phase_rows<1>(Cl, l); } }
        SEAM(pb);
        if (EN(1) && IN(pb + 1)) { if (W8_ALL) { PWin8 P{LWS(), C.G, cg, 1024, 128u}; pg8::gemm_phase_m128(C.lds, P); } else { { PWin P{LWS(), C.G, cg, 1024, 128u}; pg8::gemm_phase(C.lds, P); } { PGate P{LWS(), C.G, cg, 1024, 128u}; pg8::gemm_phase_m128(C.lds, P); } } }
        SEAM(pb + 1);
        if (EN(2) && IN(pb + 2)) { { const Ctx Cl = LC(); phase_qkprep(Cl, l); } PS5A P{LWS(), C.G, cg, 512, 128u}; RUN(2, pg8::gemm_phase(C.lds, P)); }
        SEAM(pb + 2);
        if (EN(3) && IN(pb + 3)) { const Ctx Cl = LC(); RUN(3, phase_attn(Cl, l, lds)); }
        SEAM(pb + 3);
        if (EN(4) && IN(pb + 4)) { PS5B P{LWS(), C.G, cg, 256, 128u}; pg8::gemm_phase(C.lds, P); }
        SEAM(pb + 4);
        if (EN(5) && IN(pb + 5)) { PGlu P{LWS(), C.G, cg, 512, 128u, l == NLAYER - 1}; pg8::gemm_phase_m128(C.lds, P); }
        SEAM(pb + 5);
        if (EN(6) && IN(pb + 6)) { { PMerge P{LWS(), C.G, cg, 512, 128u, l == NLAYER - 1}; pg8::gemm_phase_m128(C.lds, P); }
            if (l < NLAYER - 1) { const Ctx Cl = LC(); phase_s5mats(Cl, l + 1, C.G >= 160 ? cg - 32 : cg); } }
        SEAM(pb + 6);
        if (EN(7) && IN(pb + 7)) { unsigned char* wl_ = LWS(); PWout P{wl_, (float*)C.in[29], (const float*)(wl_ + WS_MOD) + (size_t)l * 5 * 6144, C.G, cg, 1024, 128u, l == NLAYER - 1}; pg8::gemm_phase_m128(C.lds, P); }
        SEAM(pb + 7);
        if (EN(8) && IN(pb + 8)) { const Ctx Cl = LC(); phase_norm2(Cl, l); }
        SEAM(pb + 8);
        if (EN(9) && IN(pb + 9)) { if (FP8_MOE) { build_exptab(C, tab, l); PMoe1 P{LWS(), tab, C.G, cg, 1024, 128u}; pg8::gemm_phase_m128(C.lds, P); } else { build_exptab(C, tab, l, 8); PMoe1B P{LWS(), tab, C.G, cg, 1024, 128u}; pg8::gemm_phase(C.lds, P); } }
        SEAM(pb + 9);
        if (EN(10) && IN(pb + 10)) { if (FP8_MOE) { build_exptab(C, tab, l); PMoe2 P{LWS(), tab, C.G, cg, 512, 128u}; pg8::gemm_phase_m128(C.lds, P); } else { build_exptab(C, tab, l, 8); PMoe2B P{LWS(), tab, C.G, cg, 512, 128u}; pg8::gemm_phase(C.lds, P); } }
        SEAM(pb + 10);
    }
    if (EN(12) && IN(NPH - 1)) { const Ctx Cl = LC(); phase_rows<2>(Cl, NLAYER); }
#ifdef DIAG_SEL
    xcd_barrier(bar); DIAG_ACC(12);
    if (blockIdx.x == 0 && threadIdx.x == 0) { volatile LAS unsigned* dg = (volatile LAS unsigned*)(C.lds + LDSCTL_OFF + 160); dg[8 + 13] = dg[0] - dg[1];
        for (int i = 0; i < 14; ++i) __hip_atomic_store(C.ctl + 2048 + i, dg[8 + i], RLX_AGENT); }
    xcd_barrier(bar);
    { const float d1 = (float)__hip_atomic_load(C.ctl + 2048 + (DIAG_SEL), RLX_AGENT) * 0.01f, d2 = (float)__hip_atomic_load(C.ctl + 2048 + (DIAG_SEL) + 1, RLX_AGENT) * 0.01f;
      const float c1 = sqrtf(d1); float* o = args.out;
      for (size_t i = (size_t)blockIdx.x * 512 + threadIdx.x; i < (size_t)NB * SEQ * D; i += (size_t)gridDim.x * 512) o[i] = (i == 12345) ? d2 : c1; }
#endif
#undef IN
#undef SEAM
}

#ifndef MK_PER_PHASE
#define MK_PER_PHASE 0
#endif
extern "C" void kernel_launch(void* const* d_in, const int* in_sizes, int n_in, void* d_out, int out_size, void* d_ws, size_t ws_size, hipStream_t stream) {
    static int grid = 0;
    if (grid == 0) {
        if (n_in != 29 || out_size != NB * SEQ * D || ws_size < WS_END) { fprintf(stderr, "kernel_launch: unexpected shapes (n_in %d out %d ws %zu)\n", n_in, out_size, ws_size); grid = -1; return; }
        int dev = 0, cus = 0, per_cu = 0;
        if (hipGetDevice(&dev) != hipSuccess || hipDeviceGetAttribute(&cus, hipDeviceAttributeMultiprocessorCount, dev) != hipSuccess) { grid = -1; return; }
        if (hipFuncSetAttribute((const void*)fwd, hipFuncAttributeMaxDynamicSharedMemorySize, LDS_BYTES) != hipSuccess) { grid = -1; return; }
        if (hipOccupancyMaxActiveBlocksPerMultiprocessor(&per_cu, (const void*)fwd, NWAVES * 64, LDS_BYTES) != hipSuccess || per_cu < 1) fprintf(stderr, "kernel_launch: occupancy query says %d\n", per_cu);
        (void)hipGetLastError();
        grid = cus;
    }
    if (grid < 0) return;
    (void)hipMemsetAsync((char*)d_ws + WS_CTL, 0, CTL_ZERO_BYTES, stream);
    Args a{};
    for (int i = 0; i < 29; ++i) a.in[i] = (const float*)d_in[i];
    a.out = (float*)d_out; a.ws = (unsigned char*)d_ws;
#if MK_PER_PHASE
    for (int p = 0; p < NPH; ++p) { a.ph_lo = p; a.ph_hi = p + 1; hipLaunchKernelGGL(fwd, dim3(grid), dim3(NWAVES * 64), LDS_BYTES, stream, a); }
#else
    a.ph_lo = 0; a.ph_hi = NPH; hipLaunchKernelGGL(fwd, dim3(grid), dim3(NWAVES * 64), LDS_BYTES, stream, a);
#endif
}
```

```cpp
#define FP8_MOE 1
#define GATE_BF16 0
#define W8_ALL 1
#define H8_WRITE 1
#ifndef H8_WRITE
#define H8_WRITE 1
#endif
#ifndef GATE_BF16
#define GATE_BF16 0
#endif
#include <hip/hip_runtime.h>
#include <cstdio>
#include <cstdint>

#define GAS __attribute__((address_space(1)))
#define LAS __attribute__((address_space(3)))
typedef unsigned short bf16;
typedef unsigned v4u __attribute__((ext_vector_type(4)));
typedef unsigned v2u __attribute__((ext_vector_type(2)));
typedef float f32x4 __attribute__((ext_vector_type(4)));
typedef float f32x2 __attribute__((ext_vector_type(2)));
typedef float f32x16 __attribute__((ext_vector_type(16)));
typedef short bf16x8 __attribute__((ext_vector_type(8)));
typedef short s16x4 __attribute__((ext_vector_type(4)));
typedef GAS unsigned gu32;
#define RLX_AGENT __ATOMIC_RELAXED, __HIP_MEMORY_SCOPE_AGENT
#define LDS_WAIT() asm volatile("s_waitcnt lgkmcnt(0)" ::: "memory")
#define VM_WAIT() asm volatile("s_waitcnt vmcnt(0)" ::: "memory")

constexpr int NB = 4, SEQ = 8192, CTX = 256, LB = SEQ + CTX, T = NB * LB, D = 1024, NPAN = T / 256;
constexpr int NLAYER = 4, INW = 5888, NCH = LB / 32, NCR = NB * NCH;
constexpr int NEXP = 16, FF = 512;
constexpr float EPS = 1e-6f;
constexpr float LOG2E = 1.4426950408889634f;
constexpr float C2 = 0.125f * LOG2E;
constexpr int NWAVES = 8;

constexpr size_t MiB = 1u << 20;
constexpr size_t WS_CTL = 0, CTL_ZERO_BYTES = 1 * MiB;
constexpr size_t WS_MOD = 1 * MiB;
constexpr size_t WS_LIST = 2 * MiB;
constexpr size_t WS_RW = 5 * MiB;
constexpr size_t WS_CTXS = 6 * MiB;
constexpr size_t WS_SST = 10 * MiB;
constexpr size_t WS_HB8 = WS_SST;
constexpr size_t WS_XST = 44 * MiB;
constexpr size_t WS_BT1 = 61 * MiB;
constexpr size_t WS_BT2 = 85 * MiB;
constexpr size_t WS_WIN = 93 * MiB;
constexpr size_t WS_WIN8 = WS_WIN + (size_t)2816 * 1024 * 2;
constexpr size_t WS_WGLU = 105 * MiB;
constexpr size_t WS_WBR = 106 * MiB;
constexpr size_t WS_WOUT = 109 * MiB;
constexpr size_t WS_MOE1 = 111 * MiB;
constexpr size_t WS_MOE2 = 143 * MiB;
constexpr size_t WS_HB = 159 * MiB;
constexpr size_t WS_U = 225 * MiB;
constexpr size_t WS_QA = 258 * MiB;
constexpr size_t WS_KA = 291 * MiB;
constexpr size_t WS_VA = 300 * MiB;
constexpr size_t WS_QN = 309 * MiB;
constexpr size_t WS_KN = 342 * MiB;
constexpr size_t WS_VN = 375 * MiB;
constexpr size_t WS_YS = 408 * MiB;
constexpr size_t WS_GATES = 441 * MiB;
constexpr size_t WS_ACT = WS_QN;
constexpr size_t WS_ACTB = WS_QN;
constexpr size_t WS_YSLOT = WS_GATES;
constexpr size_t WS_AO = 574 * MiB;
constexpr size_t WS_NO = 607 * MiB;
constexpr size_t WS_YG = 640 * MiB;
constexpr size_t WS_XS = 673 * MiB;
constexpr size_t WS_END = 739 * MiB;
static_assert(WS_GATES + (size_t)T * 3072 * (GATE_BF16 ? 2 : 1) <= WS_AO && WS_YSLOT + (size_t)2 * T * 1024 * 2 <= WS_AO && WS_ACT + (size_t)(2 * T + 4096) * 512 * 2 <= WS_YS, "ws map");
constexpr int CW_FAIL = 8;
constexpr int CW_CNT = 64;
constexpr int CW_BAR = 8192;

constexpr int RING_BYTES = 131072, LDS_BYTES = 147456, LDSCTL_OFF = LDS_BYTES - 512, MISC_OFF = LDSCTL_OFF + 320;

__device__ __forceinline__ unsigned f2bf(float f) { unsigned u = __builtin_bit_cast(unsigned, f); return (u + 0x7fffu + ((u >> 16) & 1u)) >> 16; }
__device__ __forceinline__ unsigned pk2(float lo, float hi) { return f2bf(lo) | (f2bf(hi) << 16); }
__device__ __forceinline__ float bf2f(unsigned b) { return __builtin_bit_cast(float, b << 16); }
__device__ __forceinline__ float bflo(unsigned w) { return __builtin_bit_cast(float, w << 16); }
__device__ __forceinline__ float bfhi(unsigned w) { return __builtin_bit_cast(float, w & 0xffff0000u); }
typedef float f32x2_c __attribute__((ext_vector_type(2))); typedef __bf16 bf16x2_c __attribute__((ext_vector_type(2)));
__device__ __forceinline__ unsigned cvt_pk_bf16(float lo, float hi) { const f32x2_c v = {lo, hi}; return __builtin_bit_cast(unsigned, __builtin_convertvector(v, bf16x2_c)); }
typedef int v8i __attribute__((ext_vector_type(8)));
typedef int v4i __attribute__((ext_vector_type(4)));
__device__ __forceinline__ float clamp8(float x) { return __builtin_fminf(__builtin_fmaxf(x, -448.f), 448.f); }
__device__ __forceinline__ unsigned pk4_fp8(float a, float b, float c, float d) { int w = 0; w = __builtin_amdgcn_cvt_pk_fp8_f32(clamp8(a), clamp8(b), w, false); w = __builtin_amdgcn_cvt_pk_fp8_f32(clamp8(c), clamp8(d), w, true); return (unsigned)w; }
__device__ __forceinline__ float fsigmoid(float x) { return __builtin_amdgcn_rcpf(1.f + __builtin_amdgcn_exp2f(-LOG2E * x)); }
__device__ __forceinline__ float gelu_tanh(float x) { const float u = 0.7978845608f * (x + 0.044715f * x * x * x); return x * __builtin_amdgcn_rcpf(1.f + __builtin_amdgcn_exp2f(-2.f * LOG2E * u)); }
__device__ __forceinline__ float shflx(float v, int m, int lane) { return __builtin_bit_cast(float, __builtin_amdgcn_ds_bpermute((lane ^ m) << 2, __builtin_bit_cast(int, v))); }
template <int CTRL, int RM>
__device__ __forceinline__ float dpp_mov(float v) { return __builtin_bit_cast(float, __builtin_amdgcn_update_dpp(0, __builtin_bit_cast(int, v), CTRL, RM, 0xF, true)); }
__device__ __forceinline__ float wave_sum(float v, int) {
    v += dpp_mov<0xB1, 0xF>(v);
    v += dpp_mov<0x4E, 0xF>(v);
    v += dpp_mov<0x141, 0xF>(v);
    v += dpp_mov<0x140, 0xF>(v);
    v += dpp_mov<0x142, 0xA>(v);
    v += dpp_mov<0x143, 0xC>(v);
    return __builtin_bit_cast(float, __builtin_amdgcn_readlane(__builtin_bit_cast(int, v), 63));
}
__device__ __forceinline__ float sin_rev(float r) { r = r - floorf(r); return __builtin_amdgcn_sinf(r); }
__device__ __forceinline__ float cos_rev(float r) { r = r - floorf(r); return __builtin_amdgcn_cosf(r); }

#define XB_TMO      128
#define XB_XCNT(j)  (256  + 64 * (j))
#define XB_XSUB(j)  (1280 + 64 * (j))
#define XB_XGEN(j)  (2304 + 64 * (j))
#define XB_TOP      3328
#define XB_TOPGEN   3392
#define XCD_BAR_WORDS 3456
#define XB_SPIN_CAP (1u << 22)

__device__ __forceinline__ unsigned xb_ld(unsigned* p)              { return __hip_atomic_load(p, __ATOMIC_RELAXED, __HIP_MEMORY_SCOPE_AGENT); }
__device__ __forceinline__ unsigned xb_add(unsigned* p, unsigned v) { return __hip_atomic_fetch_add(p, v, __ATOMIC_RELAXED, __HIP_MEMORY_SCOPE_AGENT); }
__device__ __forceinline__ unsigned xb_xcc_id() { return (unsigned)__builtin_amdgcn_s_getreg((3 << 11) | 20) & 0xFu; }
#define XB_SPIN(cond, bar) do { unsigned _sp = 0; while (cond) { __builtin_amdgcn_s_sleep(1); \
    if ((++_sp & 255u) == 0u) { if (xb_ld(&(bar)[XB_TMO])) break; if (_sp > XB_SPIN_CAP) { atomicAdd(&(bar)[XB_TMO], 1u); break; } } } } while (0)

struct XcdBarrier { unsigned* bar; unsigned x; volatile LAS unsigned* st; };

__device__ __forceinline__ XcdBarrier xcd_barrier_post(unsigned* bar, volatile LAS unsigned* st) {
    XcdBarrier b; b.bar = bar; b.x = xb_xcc_id(); b.st = st;
    if (threadIdx.x == 0) (void)xb_add(&bar[XB_XCNT(b.x)], 1u);
    return b;
}
__device__ __forceinline__ void xcd_barrier_complete(unsigned* bar, unsigned x, unsigned& nloc, unsigned& nx) {
    const unsigned G = gridDim.x * gridDim.y * gridDim.z;
    unsigned sum, cnt, mine, sp = 0u;
    for (;;) {
        sum = 0u; cnt = 0u; mine = 0u;
#pragma unroll
        for (unsigned j = 0; j < 16; ++j) { const unsigned c = xb_ld(&bar[XB_XCNT(j)]); sum += c; cnt += (c > 0u) ? 1u : 0u; mine = (j == x) ? c : mine; }
        if (sum == G) break;
        __builtin_amdgcn_s_sleep(1);
        if ((++sp & 255u) == 0u) { if (xb_ld(&bar[XB_TMO])) break; if (sp > XB_SPIN_CAP) { atomicAdd(&bar[XB_TMO], 1u); break; } }
    }
    nloc = mine > 0u ? mine : 1u; nx = cnt > 0u ? cnt : 1u;
}
__device__ __forceinline__ void xcd_barrier(const XcdBarrier& b) {
    asm volatile("s_waitcnt vmcnt(0)" ::: "memory");
    __syncthreads();
    if (threadIdx.x == 0) {
        unsigned* bar = b.bar;
        __builtin_amdgcn_s_waitcnt(0);
        unsigned nloc = b.st[0], nx = b.st[1];
        if (nloc == 0u) { xcd_barrier_complete(bar, b.x, nloc, nx); b.st[0] = nloc; b.st[1] = nx; }
        const unsigned old = xb_add(&bar[XB_XSUB(b.x)], 1u);
        const unsigned gen = old / nloc;
        if (old + 1u == (gen + 1u) * nloc) {
            __builtin_amdgcn_fence(__ATOMIC_RELEASE, "agent");
            asm volatile("s_waitcnt vmcnt(0)" ::: "memory");
            const unsigned og = xb_add(&bar[XB_TOP], 1u);
            const unsigned tg = og / nx;
            if (og + 1u == (tg + 1u) * nx) xb_add(&bar[XB_TOPGEN], 1u);
            else XB_SPIN(xb_ld(&bar[XB_TOPGEN]) == tg, bar);
            __builtin_amdgcn_fence(__ATOMIC_ACQUIRE, "agent");
            xb_add(&bar[XB_XGEN(b.x)], 1u);
            asm volatile("s_waitcnt vmcnt(0)" ::: "memory");
        } else {
            XB_SPIN(xb_ld(&bar[XB_XGEN(b.x)]) == gen, bar);
            __builtin_amdgcn_fence(__ATOMIC_ACQUIRE, "agent");
            asm volatile("s_waitcnt vmcnt(0)" ::: "memory");
        }
    }
    __syncthreads();
}

namespace pg8 {
constexpr int BM = 256, BK = 64, HALF = 128, HTB = HALF * BK * 2, STAGE_BYTES = 8 * HTB, NXCD = 8, WGM = 8;
__host__ __device__ __forceinline__ int lds_byte(int r, int c) { const int st = (r >> 4) * 2 + (c >> 5), rr = r & 15, cc = c & 31, ob = rr * 64 + cc * 2; return st * 1024 + (ob ^ (((ob >> 9) & 1) << 5)); }
__host__ __device__ __forceinline__ void stage_rc(int b, int& R, int& C) { const int st = b / 1024, sb = b % 1024, swz = sb ^ (((sb >> 9) & 1) << 5); R = (st >> 1) * 16 + swz / 64; C = (st & 1) * 32 + (swz % 64) / 2; }
__host__ __device__ __forceinline__ int perm32(int rho) { const int n = rho >> 4, i = rho & 15; return 8 * (i >> 2) + 4 * n + (i & 3); }

struct Unit { int pm, pn, z; };

__device__ __forceinline__ void static_decode(int L, int nM, int nN, int& pm, int& pn) {
    const int nwg = nM * nN; int wgid = L;
    { const int q = nwg / NXCD, r = nwg % NXCD, xcd = wgid % NXCD, off = wgid / NXCD; wgid = (xcd < r ? xcd * (q + 1) : r * (q + 1) + (xcd - r) * q) + off; }
    const int nig = WGM * nN, gid = wgid / nig, fm = gid * WGM, gsz = (nM - fm) < WGM ? (nM - fm) : WGM;
    pm = fm + ((wgid % nig) % gsz); pn = (wgid % nig) / gsz;
}

template <class P>
__device__ __forceinline__ void gemm_phase(LAS unsigned char* lds, const P& S) {
    int tid_ = threadIdx.x; asm volatile("" : "+v"(tid_));
    const int tid = tid_, wid = __builtin_amdgcn_readfirstlane(tid >> 6), lane = tid & 63, wr = wid >> 2, wc = wid & 3, fr = lane & 15, fq = lane >> 4;
    constexpr int ELB = P::FP8 ? 1 : 2;
    const int K = S.K; int nt = K * ELB / 128; asm volatile("" : "+s"(nt));
    unsigned voffB[2];
#pragma unroll
    for (int i = 0; i < 2; ++i) { int R, C; stage_rc(tid * 16 + i * 8192, R, C); const int Rb = (R & ~31) + perm32(R & 31); voffB[i] = (unsigned)(Rb * K * ELB + C * 2); }
#define PG8_AOFF(dst0, dst1, u) do { _Pragma("unroll") for (int i = 0; i < 2; ++i) { int R, C; stage_rc(tid * 16 + i * 8192, R, C); dst0[i] = S.a_off(u, 0, R, C); dst1[i] = S.a_off(u, 1, R, C); } } while (0)
    const size_t kstepB = (size_t)(BK * 2), hstepB = (size_t)HALF * K * ELB, kstepA = (size_t)S.kstepA;
    const unsigned ldsw = (unsigned)wid * 1024u;
    const int aoff = lds_byte(wr * 64 + fr, fq * 8), boff = lds_byte(wc * 32 + fr, fq * 8);
#define PG8_SA(b, h) (((b) * 2 + (h)) * HTB)
#define PG8_SB(b, h) ((4 + (b) * 2 + (h)) * HTB)
#define PG8_STAGE(bufoff, gbase, voff) do { _Pragma("unroll") for (int _i = 0; _i < 2; ++_i) \
        __builtin_amdgcn_global_load_lds((const unsigned*)((const char*)(gbase) + (voff)[_i]), (LAS unsigned*)(lds + (bufoff) + ldsw + _i * 8192), 16, 0, 0); } while (0)
#define PG8_LDA(dst, b, h) do { _Pragma("unroll") for (int m = 0; m < 4; ++m) _Pragma("unroll") for (int k = 0; k < 2; ++k) dst[m][k] = *(const LAS bf16x8*)(lds + PG8_SA(b, h) + aoff + m * 2048 + k * 1024); } while (0)
#define PG8_LDB(dst, b, h) do { _Pragma("unroll") for (int n = 0; n < 2; ++n) _Pragma("unroll") for (int k = 0; k < 2; ++k) dst[n][k] = *(const LAS bf16x8*)(lds + PG8_SB(b, h) + boff + n * 2048 + k * 1024); } while (0)
#define PG8_CAT(x0, x1) __builtin_shufflevector(__builtin_bit_cast(v4i, x0), __builtin_bit_cast(v4i, x1), 0, 1, 2, 3, 4, 5, 6, 7)
#define PG8_MMA(ai, bj, At, Bt) do { __builtin_amdgcn_s_setprio(1); _Pragma("unroll") for (int m = 0; m < 4; ++m) _Pragma("unroll") for (int n = 0; n < 2; ++n) { \
        if constexpr (P::FP8) acc[ai][bj][m][n] = __builtin_amdgcn_mfma_scale_f32_16x16x128_f8f6f4(PG8_CAT(Bt[n][0], Bt[n][1]), PG8_CAT(At[m][0], At[m][1]), acc[ai][bj][m][n], 0, 0, 0, 0x7f7f7f7f, 0, 0x7f7f7f7f); \
        else { _Pragma("unroll") for (int k = 0; k < 2; ++k) acc[ai][bj][m][n] = __builtin_amdgcn_mfma_f32_16x16x32_bf16(Bt[n][k], At[m][k], acc[ai][bj][m][n], 0, 0, 0); } } __builtin_amdgcn_s_setprio(0); } while (0)
#define PG8_WAIT_V(n) asm volatile("s_waitcnt vmcnt(" #n ")" ::: "memory")
#define PG8_WAIT_L(n) asm volatile("s_waitcnt lgkmcnt(" #n ")" ::: "memory")
#define PG8_BAR __builtin_amdgcn_s_barrier()
#define PG8_SCHED __builtin_amdgcn_sched_barrier(0)
    Unit cur, nxt; int ui = 0;
    if (!S.next(0, cur)) return;
    f32x4 acc[2][2][4][2];
#pragma unroll
    for (int a = 0; a < 2; ++a)
#pragma unroll
        for (int b = 0; b < 2; ++b)
#pragma unroll
            for (int m = 0; m < 4; ++m)
#pragma unroll
                for (int n = 0; n < 2; ++n) acc[a][b][m][n] = (f32x4){0.f, 0.f, 0.f, 0.f};
    bf16x8 At[4][2], B0[2][2], B1[2][2];
    unsigned vA0[2], vA1[2], vN0[2], vN1[2];
    PG8_AOFF(vA0, vA1, cur);
    const char* cA = S.a_base(cur); const char* cB = S.b_base(cur);
    PG8_STAGE(PG8_SB(0, 0), cB, voffB); PG8_STAGE(PG8_SB(0, 1), cB + hstepB, voffB); PG8_STAGE(PG8_SA(0, 0), cA, vA0); PG8_STAGE(PG8_SA(0, 1), cA, vA1);
    if (wr == 1) PG8_BAR;
    PG8_WAIT_V(2); PG8_BAR;
    PG8_STAGE(PG8_SB(1, 0), cB + kstepB, voffB); PG8_STAGE(PG8_SA(1, 0), cA + kstepA, vA0); PG8_STAGE(PG8_SB(1, 1), cB + hstepB + kstepB, voffB);
    PG8_WAIT_V(6); PG8_BAR;
    for (;;) {
        const bool has_next = S.next(ui + 1, nxt);
        const char* nA = cA; const char* nB = cB;
        if (has_next) { nA = S.a_base(nxt); nB = S.b_base(nxt); if (P::EARLY_AOFF) PG8_AOFF(vN0, vN1, nxt); }
        for (int t = 0; t < nt; t += 2) {
            const bool last = (t == nt - 2);
            const char* a1 = cA + (size_t)(t + 1) * kstepA;
            const char* a2 = last ? nA : cA + (size_t)(t + 2) * kstepA; const char* b2 = last ? nB : cB + (size_t)(t + 2) * kstepB;
            const char* a3 = a2 + kstepA; const char* b3 = b2 + kstepB;
            PG8_LDB(B0, 0, 0); PG8_LDB(B1, 0, 1); PG8_SCHED; PG8_LDA(At, 0, 0); PG8_STAGE(PG8_SA(1, 1), a1, vA1);
            if (last && has_next) {
                if (P::EARLY_AOFF) { _Pragma("unroll") for (int i = 0; i < 2; ++i) { vA0[i] = vN0[i]; vA1[i] = vN1[i]; } } else PG8_AOFF(vA0, vA1, nxt); }
            PG8_WAIT_V(8); PG8_WAIT_L(0); PG8_BAR; PG8_MMA(0, 0, At, B0); PG8_MMA(0, 1, At, B1); PG8_BAR; PG8_SCHED;
            PG8_LDA(At, 0, 1); PG8_STAGE(PG8_SB(0, 0), b2, voffB); PG8_STAGE(PG8_SB(0, 1), b2 + hstepB, voffB); PG8_STAGE(PG8_SA(0, 0), a2, vA0);
            PG8_WAIT_V(8); PG8_WAIT_L(0); PG8_BAR; PG8_MMA(1, 0, At, B0); PG8_MMA(1, 1, At, B1); PG8_BAR; PG8_SCHED;
            PG8_LDB(B0, 1, 0); PG8_LDB(B1, 1, 1); PG8_SCHED; PG8_LDA(At, 1, 0); PG8_STAGE(PG8_SA(0, 1), a2, vA1);
            PG8_WAIT_V(8); PG8_WAIT_L(0); PG8_BAR; PG8_MMA(0, 0, At, B0); PG8_MMA(0, 1, At, B1); PG8_BAR; PG8_SCHED;
            PG8_LDA(At, 1, 1); PG8_STAGE(PG8_SB(1, 0), b3, voffB); PG8_STAGE(PG8_SB(1, 1), b3 + hstepB, voffB); PG8_STAGE(PG8_SA(1, 0), a3, vA0);
            PG8_WAIT_V(8); PG8_WAIT_L(0); PG8_BAR; PG8_MMA(1, 0, At, B0); PG8_MMA(1, 1, At, B1); PG8_BAR; PG8_SCHED;
        }
        if (wr == 0) PG8_BAR;
        S.epi(acc, cur, wr, wc, fr, fq);
        if (!has_next) break;
#pragma unroll
        for (int a = 0; a < 2; ++a)
#pragma unroll
            for (int b = 0; b < 2; ++b)
#pragma unroll
                for (int m = 0; m < 4; ++m)
#pragma unroll
                    for (int n = 0; n < 2; ++n) acc[a][b][m][n] = (f32x4){0.f, 0.f, 0.f, 0.f};
        cur = nxt; cA = nA; cB = nB; ++ui;
        if (wr == 1) PG8_BAR;
    }
    PG8_WAIT_V(0);
    PG8_BAR;
#undef PG8_AOFF
#undef PG8_SA
#undef PG8_SB
#undef PG8_STAGE
#undef PG8_LDA
#undef PG8_LDB
#undef PG8_MMA
#undef PG8_CAT
#undef PG8_WAIT_V
#undef PG8_WAIT_L
#undef PG8_BAR
#undef PG8_SCHED
}

template <class P>
__device__ __forceinline__ void gemm_phase_m128(LAS unsigned char* lds, const P& S) {
    int tid_ = threadIdx.x; asm volatile("" : "+v"(tid_));
    const int tid = tid_, wid = __builtin_amdgcn_readfirstlane(tid >> 6), lane = tid & 63, wr = wid >> 2, wc = wid & 3, fr = lane & 15, fq = lane >> 4;
    constexpr int ELB = P::FP8 ? 1 : 2;
    const int K = S.K; int nt = K * ELB / 128; asm volatile("" : "+s"(nt));
    unsigned voffB[2];
#pragma unroll
    for (int i = 0; i < 2; ++i) { int R, C; stage_rc(tid * 16 + i * 8192, R, C); const int Rb = (R & ~31) + perm32(R & 31); voffB[i] = (unsigned)(Rb * K * ELB + C * 2); }
#define PG8_AOFF(dst0, u) do { _Pragma("unroll") for (int i = 0; i < 2; ++i) { int R, C; stage_rc(tid * 16 + i * 8192, R, C); dst0[i] = S.a_off(u, R, C); } } while (0)
    const size_t kstepB = (size_t)(BK * 2), hstepB = (size_t)HALF * K * ELB, kstepA = (size_t)S.kstepA;
    const unsigned ldsw = (unsigned)wid * 1024u;
    const int aoff = lds_byte(wr * 64 + fr, fq * 8), boff = lds_byte(wc * 32 + fr, fq * 8);
#define PG8_SA(b) (((b) * 2) * HTB)
#define PG8_SB(b, h) ((4 + (b) * 2 + (h)) * HTB)
#define PG8_STAGE(bufoff, gbase, voff) do { _Pragma("unroll") for (int _i = 0; _i < 2; ++_i) \
        __builtin_amdgcn_global_load_lds((const unsigned*)((const char*)(gbase) + (voff)[_i]), (LAS unsigned*)(lds + (bufoff) + ldsw + _i * 8192), 16, 0, 0); } while (0)
#define PG8_LDA(dst, b) do { _Pragma("unroll") for (int m = 0; m < 4; ++m) _Pragma("unroll") for (int k = 0; k < 2; ++k) dst[m][k] = *(const LAS bf16x8*)(lds + PG8_SA(b) + aoff + m * 2048 + k * 1024); } while (0)
#define PG8_LDB(dst, b, h) do { _Pragma("unroll") for (int n = 0; n < 2; ++n) _Pragma("unroll") for (int k = 0; k < 2; ++k) dst[n][k] = *(const LAS bf16x8*)(lds + PG8_SB(b, h) + boff + n * 2048 + k * 1024); } while (0)
#define PG8_CAT(x0, x1) __builtin_shufflevector(__builtin_bit_cast(v4i, x0), __builtin_bit_cast(v4i, x1), 0, 1, 2, 3, 4, 5, 6, 7)
#define PG8_MMA(bj, At, Bt) do { __builtin_amdgcn_s_setprio(1); _Pragma("unroll") for (int m = 0; m < 4; ++m) _Pragma("unroll") for (int n = 0; n < 2; ++n) { \
        if constexpr (P::FP8) acc[bj][m][n] = __builtin_amdgcn_mfma_scale_f32_16x16x128_f8f6f4(PG8_CAT(Bt[n][0], Bt[n][1]), PG8_CAT(At[m][0], At[m][1]), acc[bj][m][n], 0, 0, 0, 0x7f7f7f7f, 0, 0x7f7f7f7f); \
        else { _Pragma("unroll") for (int k = 0; k < 2; ++k) acc[bj][m][n] = __builtin_amdgcn_mfma_f32_16x16x32_bf16(Bt[n][k], At[m][k], acc[bj][m][n], 0, 0, 0); } } __builtin_amdgcn_s_setprio(0); } while (0)
#define PG8_WAIT_V(n) asm volatile("s_waitcnt vmcnt(" #n ")" ::: "memory")
#define PG8_WAIT_L(n) asm volatile("s_waitcnt lgkmcnt(" #n ")" ::: "memory")
#define PG8_BAR __builtin_amdgcn_s_barrier()
#define PG8_SCHED __builtin_amdgcn_sched_barrier(0)
    Unit cur, nxt; int ui = 0;
    if (!S.next(0, cur)) return;
    f32x4 acc[2][4][2], st[2][4][2];
#pragma unroll
    for (int a = 0; a < 2; ++a)
#pragma unroll
        for (int m = 0; m < 4; ++m)
#pragma unroll
            for (int n = 0; n < 2; ++n) { acc[a][m][n] = (f32x4){0.f, 0.f, 0.f, 0.f}; st[a][m][n] = (f32x4){0.f, 0.f, 0.f, 0.f}; }
    bf16x8 At[4][2], B0[2][2];
    unsigned vA[2], vN[2];
    PG8_AOFF(vA, cur);
    const char* cA = S.a_base(cur); const char* cB = S.b_base(cur);
    PG8_STAGE(PG8_SB(0, 0), cB, voffB); PG8_STAGE(PG8_SA(0), cA, vA); PG8_STAGE(PG8_SB(0, 1), cB + hstepB, voffB);
    if (wr == 1) PG8_BAR;
    PG8_WAIT_V(2); PG8_BAR;
    PG8_STAGE(PG8_SB(1, 0), cB + kstepB, voffB); PG8_STAGE(PG8_SA(1), cA + kstepA, vA);
    PG8_WAIT_V(4); PG8_BAR;
    for (;;) {
        const bool has_next = S.next(ui + 1, nxt);
        const char* nA = cA; const char* nB = cB;
        if (has_next) { nA = S.a_base(nxt); nB = S.b_base(nxt); if (P::EARLY_AOFF) PG8_AOFF(vN, nxt); }
        for (int t = 0; t < nt; t += 2) {
            const bool last = (t == nt - 2);
            const char* b1 = cB + (size_t)(t + 1) * kstepB;
            const char* a2 = last ? nA : cA + (size_t)(t + 2) * kstepA; const char* b2 = last ? nB : cB + (size_t)(t + 2) * kstepB;
            const char* a3 = a2 + kstepA; const char* b3 = b2 + kstepB;
            PG8_LDB(B0, 0, 0); PG8_SCHED; PG8_LDA(At, 0); PG8_STAGE(PG8_SB(1, 1), b1 + hstepB, voffB);
            if (last && has_next) { if (P::EARLY_AOFF) { vA[0] = vN[0]; vA[1] = vN[1]; } else PG8_AOFF(vA, nxt); }
            PG8_WAIT_V(6); PG8_WAIT_L(0); PG8_BAR; PG8_MMA(0, At, B0); PG8_BAR; PG8_SCHED;
            PG8_LDB(B0, 0, 1); PG8_STAGE(PG8_SB(0, 0), b2, voffB); PG8_STAGE(PG8_SA(0), a2, vA);
            PG8_WAIT_V(6); PG8_WAIT_L(0); PG8_BAR; PG8_MMA(1, At, B0); PG8_BAR; PG8_SCHED;
            PG8_LDB(B0, 1, 0); PG8_SCHED; PG8_LDA(At, 1); PG8_STAGE(PG8_SB(0, 1), b2 + hstepB, voffB);
            PG8_WAIT_V(6); PG8_WAIT_L(0); PG8_BAR; PG8_MMA(0, At, B0); PG8_BAR; PG8_SCHED;
            PG8_LDB(B0, 1, 1); PG8_STAGE(PG8_SB(1, 0), b3, voffB); PG8_STAGE(PG8_SA(1), a3, vA);
            PG8_WAIT_V(6); PG8_WAIT_L(0); PG8_BAR; PG8_MMA(1, At, B0); PG8_BAR; PG8_SCHED;
        }
        if (wr == 0) PG8_BAR;
        S.epi(acc, st, cur, wr, wc, fr, fq);
        if (!has_next) break;
#pragma unroll
        for (int a = 0; a < 2; ++a)
#pragma unroll
            for (int m = 0; m < 4; ++m)
#pragma unroll
                for (int n = 0; n < 2; ++n) acc[a][m][n] = (f32x4){0.f, 0.f, 0.f, 0.f};
        cur = nxt; cA = nA; cB = nB; ++ui;
        if (wr == 1) PG8_BAR;
    }
    PG8_WAIT_V(0);
    PG8_BAR;
#undef PG8_AOFF
#undef PG8_SA
#undef PG8_SB
#undef PG8_STAGE
#undef PG8_LDA
#undef PG8_LDB
#undef PG8_MMA
#undef PG8_CAT
#undef PG8_WAIT_V
#undef PG8_WAIT_L
#undef PG8_BAR
#undef PG8_SCHED
}
}
namespace attn_body {
using bf16x8 = __attribute__((ext_vector_type(8))) short;
using u32x4 = __attribute__((ext_vector_type(4))) unsigned;
constexpr int NW = 8, QBLK = 32, QB = QBLK * NW, KVBLK = 64;
__device__ __forceinline__ int crow(int r, int hi) { return (r & 3) + 8 * (r >> 2) + 4 * hi; }
#define SBAR() __builtin_amdgcn_sched_barrier(0)
constexpr int NSLOT = 3, SLOTB = 8192;
constexpr int LDS_K = 0, LDS_V = NSLOT * SLOTB, LDS_WS = 2 * NSLOT * SLOTB, LDS_OST = LDS_WS + NW * 64 * 4, LDS_BYTES = LDS_OST + NW * 4096;
constexpr int LDS_BT = 86016 + 256;
__device__ __forceinline__ void glds16(const void* gsrc, unsigned lds_dst) { unsigned keep;
  asm volatile("s_mov_b32 %0, m0\n\ts_mov_b32 m0, %2\n\ts_nop 0\n\tglobal_load_lds_dwordx4 %1, off\n\ts_mov_b32 m0, %0" : "=&s"(keep) : "v"(gsrc), "s"(lds_dst) : "memory"); }
__device__ __forceinline__ float max3f(float a, float b, float c) { float r; asm("v_max3_f32 %0, %1, %2, %3" : "=v"(r) : "v"(a), "v"(b), "v"(c)); return r; }
__device__ __forceinline__ float max2f(float a, float b) { float r; asm("v_max_f32_e32 %0, %1, %2" : "=v"(r) : "v"(a), "v"(b)); return r; }
__device__ __forceinline__ float fadd_s(float a, float b) { float r; asm("v_add_f32_e32 %0, %1, %2" : "=v"(r) : "v"(a), "v"(b)); return r; }
__device__ __forceinline__ float fsub_s(float a, float b) { float r; asm("v_sub_f32_e32 %0, %1, %2" : "=v"(r) : "v"(a), "v"(b)); return r; }
typedef float f32x2_t __attribute__((ext_vector_type(2))); typedef __bf16 bf16x2_t __attribute__((ext_vector_type(2)));
__device__ __forceinline__ unsigned cvtpk_s(float lo, float hi) { f32x2_t v = {lo, hi}; bf16x2_t b = __builtin_convertvector(v, bf16x2_t); return __builtin_bit_cast(unsigned, b); }
#define WAIT_BAR(N) asm volatile("s_waitcnt vmcnt(" #N ") lgkmcnt(0)\n\ts_barrier" ::: "memory")

__device__ __forceinline__ void qkt(f32x16& p0, f32x16& p1, const char* Kslot, const bf16x8* qr, const f32x16& negm, int r32, int hi) {
  const char* kb = Kslot + hi * 1024 + r32 * 16;
  #pragma unroll
  for (int d0 = 0; d0 < 4; ++d0) {
    const bf16x8 b0 = *reinterpret_cast<const bf16x8*>(kb + d0 * 2048);
    const bf16x8 b1 = *reinterpret_cast<const bf16x8*>(kb + d0 * 2048 + 512);
    if (d0 == 0) { p0 = __builtin_amdgcn_mfma_f32_32x32x16_bf16(b0, qr[0], negm, 0, 0, 0); p1 = __builtin_amdgcn_mfma_f32_32x32x16_bf16(b1, qr[0], negm, 0, 0, 0); }
    else { p0 = __builtin_amdgcn_mfma_f32_32x32x16_bf16(b0, qr[d0], p0, 0, 0, 0); p1 = __builtin_amdgcn_mfma_f32_32x32x16_bf16(b1, qr[d0], p1, 0, 0, 0); } }
}
typedef __attribute__((address_space(3))) const char* lds_cptr;
typedef short v4i16_t __attribute__((ext_vector_type(4)));
__device__ __forceinline__ void kload8(bf16x8* kf, lds_cptr kp) {
  kf[0] = *(const __attribute__((address_space(3))) bf16x8*)(kp);        kf[1] = *(const __attribute__((address_space(3))) bf16x8*)(kp + 512);
  kf[2] = *(const __attribute__((address_space(3))) bf16x8*)(kp + 2048); kf[3] = *(const __attribute__((address_space(3))) bf16x8*)(kp + 2560);
  kf[4] = *(const __attribute__((address_space(3))) bf16x8*)(kp + 4096); kf[5] = *(const __attribute__((address_space(3))) bf16x8*)(kp + 4608);
  kf[6] = *(const __attribute__((address_space(3))) bf16x8*)(kp + 6144); kf[7] = *(const __attribute__((address_space(3))) bf16x8*)(kp + 6656);
}
__device__ __forceinline__ void kload2(bf16x8* kf, lds_cptr kp, int j) { kf[2 * j] = *(const __attribute__((address_space(3))) bf16x8*)(kp + j * 2048); kf[2 * j + 1] = *(const __attribute__((address_space(3))) bf16x8*)(kp + j * 2048 + 512); }
__device__ __forceinline__ s16x4 vtr(lds_cptr p) { return __builtin_bit_cast(s16x4, __builtin_amdgcn_ds_read_tr16_b64_v4i16((__attribute__((address_space(3))) v4i16_t*)p)); }
__device__ __forceinline__ float rowmax(const f32x16& p0, const f32x16& p1) {
  float a = max3f(p0[0], p0[1], p1[0]), b = max3f(p0[2], p0[3], p1[1]); a = max3f(a, p1[2], p1[3]);
  #pragma unroll
  for (int r = 4; r < 16; r += 4) { a = max3f(a, p0[r], p0[r + 1]); b = max3f(b, p0[r + 2], p0[r + 3]); a = max3f(a, p1[r], p1[r + 1]); b = max3f(b, p1[r + 2], p1[r + 3]); }
  const float m = max2f(a, b);
  auto rr = __builtin_amdgcn_permlane32_swap(__float_as_uint(m), __float_as_uint(m), false, false);
  return max2f(__uint_as_float(rr[0]), __uint_as_float(rr[1]));
}
__device__ __forceinline__ void pv(f32x16* o, int vb, bf16x8 pa0, bf16x8 pa1, bf16x8 pa2, bf16x8 pa3) {
  #pragma unroll
  for (int d0 = 0; d0 < 2; ++d0) { s16x4 lo[4], hi[4];
    #pragma unroll
    for (int ks = 0; ks < 4; ++ks) {
      asm volatile("ds_read_b64_tr_b16 %0,%1 offset:%c2" : "=&v"(lo[ks]) : "v"(vb), "i"(d0 * 4096 + ks * 1024) : "memory");
      asm volatile("ds_read_b64_tr_b16 %0,%1 offset:%c2" : "=&v"(hi[ks]) : "v"(vb), "i"(d0 * 4096 + ks * 1024 + 512) : "memory"); }
    asm volatile("s_waitcnt lgkmcnt(0)" ::: "memory"); SBAR();
    #define PK(k) (bf16x8){lo[k][0], lo[k][1], lo[k][2], lo[k][3], hi[k][0], hi[k][1], hi[k][2], hi[k][3]}
    o[d0] = __builtin_amdgcn_mfma_f32_32x32x16_bf16(pa0, PK(0), o[d0], 0, 0, 0);
    o[d0] = __builtin_amdgcn_mfma_f32_32x32x16_bf16(pa1, PK(1), o[d0], 0, 0, 0);
    o[d0] = __builtin_amdgcn_mfma_f32_32x32x16_bf16(pa2, PK(2), o[d0], 0, 0, 0);
    o[d0] = __builtin_amdgcn_mfma_f32_32x32x16_bf16(pa3, PK(3), o[d0], 0, 0, 0);
    #undef PK
  }
}
#define ATTN_STORE16(p, v) (*(u32x4*)(p) = (v))

template <int THRL, bool NA, int QP_, int KVP_, bool NOMAX = false>
__device__ __forceinline__ void attn_unit(const bf16* Qu, int qp_rt, const bf16* __restrict__ Kh, const bf16* __restrict__ Vh, int kvp_rt, bf16* Ou, int NT, int r0, int rlo, char* shm) {
  const int qp = QP_ ? QP_ : qp_rt, kvp = KVP_ ? KVP_ : kvp_rt, op = qp;
  int tid_ = threadIdx.x; asm volatile("" : "+v"(tid_));
  const int tid = tid_, lane = tid & 63, r32 = lane & 31, hi = lane >> 5; const int wid = __builtin_amdgcn_readfirstlane(tid >> 6);
  const bf16* Qw = Qu + (long)(wid * QBLK) * qp;
  const unsigned lds0 = (unsigned)(uintptr_t)shm;
  float* wsf = (float*)(shm + LDS_WS) + wid * 64;
  const bf16* ksrc = Kh + (long)lane * kvp + wid * 8;
  const bf16* vsrc = Vh + (long)(16 * (wid & 3) + (lane >> 2)) * kvp + (wid >> 2) * 32 + (lane & 3) * 8;
  const unsigned kdst = lds0 + LDS_K + wid * 1024, vdst = lds0 + LDS_V + wid * 1024;
  #define TROW(t) (NA ? ((t) < 4 ? 64 * (t) : CTX + 64 * ((rlo + (t) - 4) < 127 ? (rlo + (t) - 4) : 127)) : 64 * (t))
  #define DMA_K(t, slot) glds16(ksrc + (long)TROW(t) * kvp, (unsigned)__builtin_amdgcn_readfirstlane(kdst + (slot)))
  #define DMA_V(t, slot) glds16(vsrc + (long)TROW(t) * kvp, (unsigned)__builtin_amdgcn_readfirstlane(vdst + (slot)))
  const int vb0 = (int)(lds0 + LDS_V) + ((lane >> 4) & 1) * 32 + (lane & 3) * 8 + (4 * hi + ((lane & 15) >> 2)) * 64;
  const char* Kbase = shm + LDS_K; bf16x8 kf[8];
  const lds_cptr shm3 = (lds_cptr)shm; const lds_cptr kp0 = shm3 + LDS_K + hi * 1024 + r32 * 16; const lds_cptr vp0 = shm3 + LDS_V + ((lane >> 4) & 1) * 32 + (lane & 3) * 8 + (4 * hi + ((lane & 15) >> 2)) * 64;
  const int rq = r0 + (wid >> 1), qc = 32 * (wid & 1) + r32;
  const int rsw = rq - 4 < 0 ? 0 : (rq - 4 > 120 ? 120 : rq - 4);
  const int cs = qc - 8 < 0 ? 0 : (qc - 8 > 48 ? 48 : qc - 8);
  const __attribute__((address_space(3))) float* btl = (const __attribute__((address_space(3))) float*)(shm3 + LDS_BT) + (15 + 4 * hi - qc);
  DMA_K(0, 0); DMA_V(0, 0); DMA_K(1, SLOTB);
  bf16x8 qr[4];
  #pragma unroll
  for (int d0 = 0; d0 < 4; ++d0) qr[d0] = *reinterpret_cast<const bf16x8*>(&Qw[(long)r32 * qp + d0 * 16 + hi * 8]);
  float mhat = 0.f, l_reg = 0.f; f32x16 o[2]; o[0] = f32x16{}; o[1] = f32x16{}; f32x16 negm = f32x16{}; if (!NA) asm volatile("" : "+v"(negm));
  #define NEGM (NA ? f32x16{} : negm)
  #define CMASK(P0, P1, t) do { if (NA) { if ((t) >= 4) { const int kr_ = rlo + (t) - 4; const int dr_ = kr_ - rsw; \
      if (dr_ < 0 || dr_ >= 8) { _Pragma("unroll") for (int r = 0; r < 16; ++r) { P0[r] = (-__builtin_inff()); P1[r] = (-__builtin_inff()); } } \
      else { const __attribute__((address_space(3))) float* bp_ = btl + (kr_ - rq + 7) * 31; const int kl0_ = 4 * hi - cs; \
        _Pragma("unroll") for (int rg = 0; rg < 4; ++rg) { \
          _Pragma("unroll") for (int rr_ = 0; rr_ < 4; ++rr_) { const int r = rg * 4 + rr_; const int kc_ = (r & 3) + 8 * (r >> 2); const float b0_ = bp_[kc_], b1_ = bp_[kc_ + 32]; \
            const int kl_ = kc_ + kl0_; P0[r] = ((unsigned)kl_ < 16u) ? P0[r] + b0_ : (-__builtin_inff()); P1[r] = ((unsigned)(kl_ + 32) < 16u) ? P1[r] + b1_ : (-__builtin_inff()); } \
          SBAR(); } } } } } while (0)
  bool resc = false;
  #define START(P0, P1) do { const float rm = NOMAX ? 0.f : rowmax(P0, P1); resc = false; \
    { const float dl = rm; mhat = fadd_s(mhat, dl); \
      _Pragma("unroll") for (int r = 0; r < 16; ++r) { P0[r] = fsub_s(P0[r], dl); P1[r] = fsub_s(P1[r], dl); } \
      if (!NA) { _Pragma("unroll") for (int r = 0; r < 16; ++r) negm[r] = -mhat; asm volatile("" : "+v"(negm)); } } \
    _Pragma("unroll") for (int r = 0; r < 16; ++r) P0[r] = __builtin_amdgcn_exp2f(P0[r]); } while (0)
  #define RESC() do { if (resc) { asm volatile("s_waitcnt lgkmcnt(0)" ::: "memory"); \
      _Pragma("unroll") for (int d_ = 0; d_ < 2; ++d_) _Pragma("unroll") for (int r = 0; r < 16; ++r) o[d_][r] *= wsf[crow(r, hi)]; } } while (0)
  f32x16 pA0, pA1, pB0, pB1;
  int sl_prev = 0, sl_cur = 0, sl_next = SLOTB;
  #define ROT() do { sl_prev = sl_cur; sl_cur = sl_next; sl_next = (sl_next == (NSLOT - 1) * SLOTB) ? 0 : sl_next + SLOTB; } while (0)
  DMA_K(2, 2 * SLOTB);
  WAIT_BAR(3);
  qkt(pA0, pA1, Kbase, qr, NEGM, r32, hi); asm volatile("s_nop 15\n\ts_nop 7" : "+v"(pA0), "+v"(pA1));
  START(pA0, pA1);
  _Pragma("unroll") for (int r = 0; r < 16; ++r) pA1[r] = __builtin_amdgcn_exp2f(pA1[r]);
  WAIT_BAR(0);
  DMA_K(3, 0); DMA_V(1, SLOTB);
  ROT();
  kload8(kf, kp0 + sl_cur);
  WAIT_BAR(2);
  s16x4 vlo[8], vhi[8]; u32x4 pw0, pw1, pw2, pw3;
  #define PKW(P, B) cvtpk_s(P[B], P[B + 1])
  #define PAF(k) __builtin_bit_cast(bf16x8, pw##k)
  #define VFR(i) (bf16x8){vlo[i][0], vlo[i][1], vlo[i][2], vlo[i][3], vhi[i][0], vhi[i][1], vhi[i][2], vhi[i][3]}
  #define PIN(x) asm volatile("" : "+v"(x))
  #define MX3(a, b, c) __builtin_fmaxf(__builtin_fmaxf((a), (b)), (c))
  #define GAPA(MF, A0, A1, A2, A3, W0, W1, PW) do { MF; sacc2 += (f32x2_t){A0, A1}; sacc2 += (f32x2_t){A2, A3}; PIN(sacc2); W0; W1; PIN(PW); SBAR(); } while (0)
  #define EX(v) __builtin_amdgcn_exp2f(v)
  #define GAPB(MF, X, B) do { MF; X[B] = EX(X[B]); X[B + 1] = EX(X[B + 1]); X[B + 2] = EX(X[B + 2]); X[B + 3] = EX(X[B + 3]); PIN(X); SBAR(); } while (0)
  #define VRD(i) do { vlo[i] = vtr(vp_ + (((i) >> 2) * 4096 + ((i) & 3) * 1024)); vhi[i] = vtr(vp_ + (((i) >> 2) * 4096 + ((i) & 3) * 1024 + 512)); } while (0)
  #define KRD(G, j) do { if (G) { kload2(kf, kp0 + sl_next, j); SBAR(); } } while (0)
  #define STEP(C0, C1, P0, P1, t, GK, GV, GL) do { SBAR(); \
    const lds_cptr vp_ = vp0 + sl_prev; \
    VRD(0); SBAR(); f32x2_t sacc2 = (f32x2_t){P0[0], P0[1]}; \
    GAPA(C0 = __builtin_amdgcn_mfma_f32_32x32x16_bf16(kf[0], qr[0], NEGM, 0, 0, 0), P0[2], P0[3], P0[4], P0[5],     pw0[0] = PKW(P0, 0), pw0[1] = PKW(P0, 2), pw0); \
    VRD(4); SBAR(); GAPA(C1 = __builtin_amdgcn_mfma_f32_32x32x16_bf16(kf[1], qr[0], NEGM, 0, 0, 0), P0[6], P0[7], P0[8], P0[9],     pw0[2] = PKW(P0, 4), pw0[3] = PKW(P0, 6), pw0); \
    VRD(1); SBAR(); GAPA(C0 = __builtin_amdgcn_mfma_f32_32x32x16_bf16(kf[2], qr[1], C0, 0, 0, 0),   P0[10], P0[11], P0[12], P0[13], pw1[0] = PKW(P0, 8), pw1[1] = PKW(P0, 10), pw1); \
    VRD(5); SBAR(); GAPA(C1 = __builtin_amdgcn_mfma_f32_32x32x16_bf16(kf[3], qr[1], C1, 0, 0, 0),   P0[14], P0[15], P1[0], P1[1],   pw1[2] = PKW(P0, 12), pw1[3] = PKW(P0, 14), pw1); \
    VRD(2); SBAR(); GAPA(C0 = __builtin_amdgcn_mfma_f32_32x32x16_bf16(kf[4], qr[2], C0, 0, 0, 0),   P1[2], P1[3], P1[4], P1[5],     pw2[0] = PKW(P1, 0), pw2[1] = PKW(P1, 2), pw2); \
    VRD(6); SBAR(); GAPA(C1 = __builtin_amdgcn_mfma_f32_32x32x16_bf16(kf[5], qr[2], C1, 0, 0, 0),   P1[6], P1[7], P1[8], P1[9],     pw2[2] = PKW(P1, 4), pw2[3] = PKW(P1, 6), pw2); \
    VRD(3); SBAR(); GAPA(C0 = __builtin_amdgcn_mfma_f32_32x32x16_bf16(kf[6], qr[3], C0, 0, 0, 0),   P1[10], P1[11], P1[12], P1[13], pw3[0] = PKW(P1, 8), pw3[1] = PKW(P1, 10), pw3); \
    VRD(7); SBAR(); GAPA(C1 = __builtin_amdgcn_mfma_f32_32x32x16_bf16(kf[7], qr[3], C1, 0, 0, 0),   P1[14], P1[15], 0.f, 0.f,       pw3[2] = PKW(P1, 12), pw3[3] = PKW(P1, 14), pw3); \
    l_reg += sacc2.x + sacc2.y; \
    if (GK) { DMA_K((t) + 3, sl_cur); } if (GV) { DMA_V((t) + 1, sl_next); } \
    resc = false; \
    if (NA) { _Pragma("unroll") for (int r = 0; r < 16; ++r) { C0[r] -= mhat; C1[r] -= mhat; } } \
    CMASK(C0, C1, t); \
    if (!NOMAX) { float a = MX3(C0[0], C0[1], C1[0]), b = MX3(C0[2], C0[3], C1[1]); a = MX3(a, C1[2], C1[3]); \
      _Pragma("unroll") for (int r = 4; r < 16; r += 4) { a = MX3(a, C0[r], C0[r + 1]); b = MX3(b, C0[r + 2], C0[r + 3]); a = MX3(a, C1[r], C1[r + 1]); b = MX3(b, C1[r + 2], C1[r + 3]); } \
      float rm = __builtin_fmaxf(a, b); { auto rr = __builtin_amdgcn_permlane32_swap(__float_as_uint(rm), __float_as_uint(rm), false, false); rm = __builtin_fmaxf(__uint_as_float(rr[0]), __uint_as_float(rr[1])); } \
      if (__builtin_expect(__any(rm > (float)THRL), 0)) { const float dl = __builtin_fmaxf(rm, 0.f); mhat += dl; \
        _Pragma("unroll") for (int r = 0; r < 16; ++r) { C0[r] -= dl; C1[r] -= dl; } \
        if (!NA) { _Pragma("unroll") for (int r = 0; r < 16; ++r) negm[r] = -mhat; asm volatile("" : "+v"(negm)); } \
        const float f = __builtin_amdgcn_exp2f(-dl); l_reg *= f; if (hi == 0) wsf[r32] = f; resc = true; } } \
    SBAR(); \
    GAPB(o[0] = __builtin_amdgcn_mfma_f32_32x32x16_bf16(PAF(0), VFR(0), o[0], 0, 0, 0), C0, 0); \
    GAPB(o[1] = __builtin_amdgcn_mfma_f32_32x32x16_bf16(PAF(0), VFR(4), o[1], 0, 0, 0), C0, 4); \
    KRD(GL, 0); GAPB(o[0] = __builtin_amdgcn_mfma_f32_32x32x16_bf16(PAF(1), VFR(1), o[0], 0, 0, 0), C0, 8); \
    KRD(GL, 1); GAPB(o[1] = __builtin_amdgcn_mfma_f32_32x32x16_bf16(PAF(1), VFR(5), o[1], 0, 0, 0), C0, 12); \
    KRD(GL, 2); GAPB(o[0] = __builtin_amdgcn_mfma_f32_32x32x16_bf16(PAF(2), VFR(2), o[0], 0, 0, 0), C1, 0); \
    KRD(GL, 3); GAPB(o[1] = __builtin_amdgcn_mfma_f32_32x32x16_bf16(PAF(2), VFR(6), o[1], 0, 0, 0), C1, 4); \
    GAPB(o[0] = __builtin_amdgcn_mfma_f32_32x32x16_bf16(PAF(3), VFR(3), o[0], 0, 0, 0), C1, 8); \
    GAPB(o[1] = __builtin_amdgcn_mfma_f32_32x32x16_bf16(PAF(3), VFR(7), o[1], 0, 0, 0), C1, 12); \
    } while (0)
  int t = 1;
  for (; t + 5 < NT; t += 2) {
    STEP(pB0, pB1, pA0, pA1, t, true, true, true);     WAIT_BAR(2); RESC(); ROT();
    STEP(pA0, pA1, pB0, pB1, t + 1, true, true, true); WAIT_BAR(2); RESC(); ROT();
  }
  #define ENDW(tt) do { if ((tt) + 3 < NT) { WAIT_BAR(2); } else if ((tt) + 2 < NT) { WAIT_BAR(1); } else { WAIT_BAR(0); } } while (0)
  for (; t + 1 < NT; t += 2) {
    STEP(pB0, pB1, pA0, pA1, t, (t + 3 < NT), (t + 1 < NT), (t + 1 < NT));         ENDW(t);     RESC(); ROT();
    STEP(pA0, pA1, pB0, pB1, t + 1, (t + 4 < NT), (t + 2 < NT), (t + 2 < NT));     ENDW(t + 1); RESC(); ROT();
  }
  STEP(pB0, pB1, pA0, pA1, NT - 1, false, false, false); RESC();
  { float sacc = pB0[0] + pB0[1]; _Pragma("unroll") for (int r = 2; r < 16; ++r) sacc += pB0[r]; _Pragma("unroll") for (int r = 0; r < 16; ++r) sacc += pB1[r]; l_reg += sacc;
    pw0 = (u32x4){PKW(pB0, 0), PKW(pB0, 2), PKW(pB0, 4), PKW(pB0, 6)}; pw1 = (u32x4){PKW(pB0, 8), PKW(pB0, 10), PKW(pB0, 12), PKW(pB0, 14)}; pw2 = (u32x4){PKW(pB1, 0), PKW(pB1, 2), PKW(pB1, 4), PKW(pB1, 6)}; pw3 = (u32x4){PKW(pB1, 8), PKW(pB1, 10), PKW(pB1, 12), PKW(pB1, 14)};
    SBAR(); pv(o, vb0 + sl_cur, PAF(0), PAF(1), PAF(2), PAF(3)); }
  #undef PKW
  #undef PAF
  #undef VFR
  #undef PIN
  #undef MX3
  #undef GAPA
  #undef GAPB
  #undef EX
  #undef VRD
  #undef KRD
  #undef STEP
  #undef ENDW
  { auto rr = __builtin_amdgcn_permlane32_swap(__float_as_uint(l_reg), __float_as_uint(l_reg), false, false); l_reg = __uint_as_float(rr[0]) + __uint_as_float(rr[1]); }
  if (hi == 0) wsf[32 + r32] = l_reg; asm volatile("s_waitcnt lgkmcnt(0)" ::: "memory");
  float rli[16];
  #pragma unroll
  for (int r = 0; r < 16; ++r) rli[r] = __builtin_amdgcn_rcpf(wsf[32 + crow(r, hi)]);
  bf16* Ow = Ou + (long)(wid * QBLK) * op;
  { bf16* stg = (bf16*)(shm + LDS_OST) + wid * 2048;
    #pragma unroll
    for (int r = 0; r < 16; ++r) { const int orow = crow(r, hi);
      #pragma unroll
      for (int d0 = 0; d0 < 2; ++d0) stg[orow * 64 + d0 * 32 + r32] = (bf16)f2bf(o[d0][r] * rli[r]); }
    asm volatile("s_waitcnt lgkmcnt(0)" ::: "memory");
    #pragma unroll
    for (int i = 0; i < 4; ++i) { const int row = i * 8 + (lane >> 3), ch = lane & 7; const u32x4 v = *(const u32x4*)(stg + row * 64 + ch * 8); ATTN_STORE16(Ow + (long)row * op + ch * 8, v); } }
  asm volatile("s_waitcnt lgkmcnt(0)\n\ts_barrier" ::: "memory");
  #undef NEGM
  #undef DMA_K
  #undef DMA_V
  #undef TROW
  #undef CMASK
  #undef START
  #undef RESC
  #undef ROT
}
#undef SBAR
#undef WAIT_BAR
}
#ifndef FP8_MOE
#define FP8_MOE 1
#endif
struct Args { const float* in[29]; float* out; unsigned char* ws; int ph_lo, ph_hi; };
enum { I_X = 0, I_C, I_CTX, I_CCTX, I_WMOD, I_BMOD, I_N1G, I_N2G, I_WIN, I_LRE, I_LIM, I_LDT, I_BRE, I_BIM, I_CRE, I_CIM, I_SSMD, I_WGLU, I_QNG, I_KNG, I_RPB, I_WBR, I_WOUT, I_RW, I_RB, I_MG, I_MU, I_MD, I_FNG };

typedef const float* CFP;
struct Ctx {
    const __attribute__((address_space(4))) CFP* in; float* out; unsigned char* ws; LAS unsigned char* lds; gu32* ctl;
    int tid, lane, wave, vcu, G;
};
#define WSP(T_, off) ((T_*)(C.ws + (off)))

__device__ __forceinline__ bf16* xs_row(const Ctx& C, int m) { return WSP(bf16, WS_XS) + (size_t)m * D; }
__device__ __forceinline__ const float* in_row(const Ctx& C, int m) { const int b = m / LB, j = m - b * LB; return j < CTX ? C.in[I_CTX] + (size_t)(b * CTX + j) * D : C.in[I_X] + (size_t)(b * SEQ + j - CTX) * D; }
__device__ __forceinline__ int cond_of(int m) { const int b = m / LB, j = m - b * LB; return j < CTX ? 4 : b; }

__device__ __forceinline__ void transpose_item(const float* W, int N, int Kp, bf16* WT, int k0, int n0, int drow0, LAS float* scr, int lane) {
    const float* src = W + (size_t)k0 * N + n0 + lane;
    float tv[64];
#pragma unroll
    for (int i = 0; i < 64; ++i) tv[i] = src[(size_t)i * N];
#pragma unroll
    for (int i = 0; i < 64; ++i) scr[i * 65 + lane] = tv[i];
    LDS_WAIT(); asm volatile("" ::: "memory");
    const int c = lane & 7;
#pragma unroll
    for (int j = 0; j < 8; ++j) { const int n = (lane >> 3) + 8 * j; const LAS float* s = scr + (8 * c) * 65 + n;
        v4u o; o.x = pk2(s[0 * 65], s[1 * 65]); o.y = pk2(s[2 * 65], s[3 * 65]); o.z = pk2(s[4 * 65], s[5 * 65]); o.w = pk2(s[6 * 65], s[7 * 65]);
        *(GAS v4u*)(WT + (size_t)(drow0 + n) * Kp + k0 + 8 * c) = o; }
    LDS_WAIT(); asm volatile("" ::: "memory");
}
__device__ __forceinline__ void transpose_item8(const float* W, int N, int Kp, unsigned char* WT, int k0, int n0, int drow0, float scale, LAS float* scr, int lane) {
    const float* src = W + (size_t)k0 * N + n0 + lane;
    float tv[64];
#pragma unroll
    for (int i = 0; i < 64; ++i) tv[i] = src[(size_t)i * N];
#pragma unroll
    for (int i = 0; i < 64; ++i) scr[i * 65 + lane] = tv[i] * scale;
    LDS_WAIT(); asm volatile("" ::: "memory");
    const int c = lane & 3;
#pragma unroll
    for (int j = 0; j < 4; ++j) { const int n = (lane >> 2) + 16 * j; const LAS float* s = scr + (16 * c) * 65 + n;
        v4u o; o.x = pk4_fp8(s[0 * 65], s[1 * 65], s[2 * 65], s[3 * 65]); o.y = pk4_fp8(s[4 * 65], s[5 * 65], s[6 * 65], s[7 * 65]); o.z = pk4_fp8(s[8 * 65], s[9 * 65], s[10 * 65], s[11 * 65]); o.w = pk4_fp8(s[12 * 65], s[13 * 65], s[14 * 65], s[15 * 65]);
        *(GAS v4u*)(WT + (size_t)(drow0 + n) * Kp + k0 + 16 * c) = o; }
    LDS_WAIT(); asm volatile("" ::: "memory");
}
__device__ __forceinline__ void phase_weights(const Ctx& C, int l) {
    LAS float* scr = (LAS float*)(C.lds + C.wave * 16640);
    const int gw = C.vcu * NWAVES + C.wave, NGW = C.G * NWAVES;
    constexpr int I0 = 16 * 92, I1 = 8 * 8, I2 = 3 * 8 * 16, I3 = 16 * 16, I4 = 16 * 16 * 8, I5 = I4, I6 = 16 * 8 * 16;
    for (int it = gw; it < I0 + I1 + I2 + I3 + I4 + I5 + I6; it += NGW) {
        int r = it;
        if (r < I0) { const int kb = r / 92, nb = r % 92; if (W8_ALL) transpose_item8(C.in[I_WIN] + (size_t)l * 1024 * INW, INW, 1024, WSP(unsigned char, WS_WIN), 64 * kb, 64 * nb, 64 * nb, 64.f, scr, C.lane);
            else if (nb < 44 || GATE_BF16) transpose_item(C.in[I_WIN] + (size_t)l * 1024 * INW, INW, 1024, WSP(bf16, WS_WIN), 64 * kb, 64 * nb, 64 * nb, scr, C.lane);
            else transpose_item8(C.in[I_WIN] + (size_t)l * 1024 * INW, INW, 1024, WSP(unsigned char, WS_WIN8), 64 * kb, 64 * nb, 64 * nb - 2816, 64.f, scr, C.lane); continue; } r -= I0;
        if (r < I1) { const int kb = r / 8, nb = r % 8; transpose_item(C.in[I_WGLU] + (size_t)l * 512 * 512, 512, 512, WSP(bf16, WS_WGLU), 64 * kb, 64 * nb, 64 * nb, scr, C.lane); continue; } r -= I1;
        if (r < I2) { const int i = r / 128, q = r % 128, kb = q / 16, nb = q % 16; transpose_item(C.in[I_WBR] + (size_t)(l * 3 + i) * 512 * 1024, 1024, 512, WSP(bf16, WS_WBR) + (size_t)i * 1024 * 512, 64 * kb, 64 * nb, 64 * nb, scr, C.lane); continue; } r -= I2;
        if (r < I3) { const int kb = r / 16, nb = r % 16; transpose_item(C.in[I_WOUT] + (size_t)l * 1024 * 1024, 1024, 1024, WSP(bf16, WS_WOUT), 64 * kb, 64 * nb, 64 * nb, scr, C.lane); continue; } r -= I3;
        if (r < I4 + I5) { const int up = r >= I4; if (up) r -= I4; const int e = r / 128, q = r % 128, kb = q / 8, nb = q % 8, n0 = 64 * nb;
            if (FP8_MOE) transpose_item8((up ? C.in[I_MU] : C.in[I_MG]) + (size_t)(l * 16 + e) * 1024 * 512, 512, 1024, WSP(unsigned char, WS_MOE1) + (size_t)e * 1024 * 1024, 64 * kb, n0, (n0 / 128) * 256 + (n0 % 128) + (up ? 128 : 0), 64.f, scr, C.lane);
            else transpose_item((up ? C.in[I_MU] : C.in[I_MG]) + (size_t)(l * 16 + e) * 1024 * 512, 512, 1024, WSP(bf16, WS_MOE1) + (size_t)e * 1024 * 1024, 64 * kb, n0, (n0 / 128) * 256 + (n0 % 128) + (up ? 128 : 0), scr, C.lane); continue; } r -= I4 + I5;
        { const int e = r / 128, q = r % 128, kb = q / 16, nb = q % 16; if (FP8_MOE) transpose_item8(C.in[I_MD] + (size_t)(l * 16 + e) * 512 * 1024, 1024, 512, WSP(unsigned char, WS_MOE2) + (size_t)e * 1024 * 512, 64 * kb, 64 * nb, 64 * nb, 32.f, scr, C.lane);
            else transpose_item(C.in[I_MD] + (size_t)(l * 16 + e) * 512 * 1024, 1024, 512, WSP(bf16, WS_MOE2) + (size_t)e * 1024 * 512, 64 * kb, 64 * nb, 64 * nb, scr, C.lane); }
    }
}

__device__ __forceinline__ void phase_mod(const Ctx& C) {
    LAS float* sc = (LAS float*)(C.lds);
    LAS float* red = (LAS float*)(C.lds + 20480);
    for (int i = C.tid; i < 5 * 1024; i += 512) { const int c = i >> 10, k = i & 1023; const float v = c < 4 ? C.in[I_C][c * 1024 + k] : C.in[I_CCTX][k]; sc[i] = v * fsigmoid(v); }
    __syncthreads();
    for (int it = C.vcu; it < NLAYER * 96; it += C.G) {
        const int l = it / 96, col = (it % 96) * 64 + C.lane, k0 = C.wave * 128;
        const float* W = C.in[I_WMOD] + (size_t)l * 1024 * 6144 + (size_t)k0 * 6144 + col;
        float a0 = 0.f, a1 = 0.f, a2 = 0.f, a3 = 0.f, a4 = 0.f;
#pragma unroll 16
        for (int k = 0; k < 128; ++k) { const float w = W[(size_t)k * 6144]; a0 += sc[k0 + k] * w; a1 += sc[1024 + k0 + k] * w; a2 += sc[2048 + k0 + k] * w; a3 += sc[3072 + k0 + k] * w; a4 += sc[4096 + k0 + k] * w; }
        LAS float* r = red + C.wave * 320 + C.lane; r[0] = a0; r[64] = a1; r[128] = a2; r[192] = a3; r[256] = a4;
        __syncthreads();
        if (C.tid < 320) { const int c = C.tid >> 6; float s = C.in[I_BMOD][l * 6144 + col];
#pragma unroll
            for (int w = 0; w < 8; ++w) s += red[w * 320 + C.tid];
            WSP(float, WS_MOD)[(size_t)(l * 5 + c) * 6144 + col] = s; }
        __syncthreads();
    }
}

__device__ __forceinline__ void phase_s5mats(const Ctx& C, int l, int w) {
    if (w < 0 || w >= 128) return;
    const int g = w >> 2, part = w & 3, tid = C.tid;
    LAS f32x2* POW = (LAS f32x2*)(C.lds);
    LAS f32x2* CC = (LAS f32x2*)(C.lds + 33792);
    LAS f32x2* BB = (LAS f32x2*)(C.lds + 50176);
    LAS f32x2* COEF = (LAS f32x2*)(C.lds + 66560);
    LAS bf16* KT = (LAS bf16*)(C.lds + 67584);
    LAS float* WT = (LAS float*)(C.lds + 101376);
    __syncthreads();
    if (tid < 128) {
        const int d = tid >> 6, p = tid & 63; const int li = ((l * 2 + d) * 32 + g) * 64 + p;
        const float re = C.in[I_LRE][li], im = C.in[I_LIM][li], dt = __expf(C.in[I_LDT][(l * 2 + d) * 32 + g]);
        for (int tau = 0; tau <= 32; ++tau) { const float mag = __expf(re * dt * (float)tau), rev = im * dt * (float)tau * 0.15915494309189535f;
            const float wr = mag * cos_rev(rev), wi = mag * sin_rev(rev);
            POW[(d * 33 + tau) * 64 + p] = (f32x2){wr, wi}; if (tau < 32) { WT[((d * 64 + p) * 2) * 32 + tau] = wr; WT[((d * 64 + p) * 2 + 1) * 32 + tau] = wi; } }
        const float mag = __expf(re * dt), rev = im * dt * 0.15915494309189535f; const float lr = mag * cos_rev(rev) - 1.f, lim = mag * sin_rev(rev);
        const float den = 1.f / (re * re + im * im);
        COEF[tid] = (f32x2){(lr * re + lim * im) * den, (lim * re - lr * im) * den};
    }
    __syncthreads();
    for (int i = tid; i < 2048; i += 512) {
        const int d = i >> 10, p = (i >> 4) & 63, h = i & 15; const size_t bi = (((size_t)(l * 2 + d) * 32 + g) * 64 + p) * 16 + h;
        const float br = C.in[I_BRE][bi], bi_ = C.in[I_BIM][bi]; const f32x2 cf = COEF[d * 64 + p];
        BB[i] = (f32x2){cf.x * br - cf.y * bi_, cf.x * bi_ + cf.y * br};
        const int h2 = (i >> 6) & 15, p2 = i & 63; const size_t ci = (((size_t)(l * 2 + d) * 32 + g) * 16 + h2) * 64 + p2;
        CC[i] = (f32x2){C.in[I_CRE][ci], C.in[I_CIM][ci]};
    }
    __syncthreads();
    {
        const int wv = tid >> 6, ln = tid & 63, hi = ln >> 5, i = ln & 31, h = 2 * wv + (i >> 4), hp = i & 15;
        f32x16 a0 = f32x16{}, a1 = f32x16{};
#pragma unroll 4
        for (int p = 0; p < 64; ++p) {
            const f32x2 c0 = CC[h * 64 + p], b0 = BB[p * 16 + hp], c1 = CC[1024 + h * 64 + p], b1 = BB[1024 + p * 16 + hp];
            const float x0 = hi == 0 ? (c0.x * b0.x - c0.y * b0.y) : -(c0.x * b0.y + c0.y * b0.x);
            const float x1 = hi == 0 ? (c1.x * b1.x - c1.y * b1.y) : -(c1.x * b1.y + c1.y * b1.x);
            a0 = __builtin_amdgcn_mfma_f32_32x32x2f32(x0, WT[(p * 2 + hi) * 32 + i], a0, 0, 0, 0);
            a1 = __builtin_amdgcn_mfma_f32_32x32x2f32(x1, WT[((64 + p) * 2 + hi) * 32 + i], a1, 0, 0, 0);
        }
        const float* sd = C.in[I_SSMD] + l * 512 + g * 16;
#pragma unroll
        for (int r = 0; r < 16; ++r) { const int rl = (r & 3) + 8 * (r >> 2) + 4 * hi, hh = 2 * wv + (rl >> 4), hq = rl & 15;
            float f = a0[r]; if (i == 0) f += a1[r] + (hh == hq ? sd[hh] : 0.f);
            KT[((31 + i) * 16 + hh) * 16 + hq] = (bf16)f2bf(f);
            if (i > 0) KT[((31 - i) * 16 + hh) * 16 + hq] = (bf16)f2bf(a1[r]); }
    }
    __syncthreads();
    bf16* B1 = WSP(bf16, WS_BT1) + (size_t)g * 768 * 512; bf16* B2 = WSP(bf16, WS_BT2) + (size_t)g * 512 * 256;
    for (int i = tid; i < 128 * 64; i += 512) {
        const int n = part * 128 + (i >> 6), ch = i & 63, t = n >> 4, h = n & 15, s = ch >> 1, hp0 = (ch & 1) * 8;
        *(GAS v4u*)(B1 + (size_t)n * 512 + ch * 8) = *(const LAS v4u*)(KT + ((t - s + 31) * 16 + h) * 16 + hp0);
    }
    for (int i = tid; i < 64 * 64; i += 512) {
        const int nn = part * 64 + (i >> 6), ch = i & 63, d = nn >> 7, p = (nn & 127) >> 1, ri = nn & 1, s = ch >> 1, hp0 = (ch & 1) * 8;
        const f32x2 w = POW[(d * 33 + (d == 0 ? 31 - s : s)) * 64 + p]; float v[8];
#pragma unroll
        for (int j = 0; j < 8; ++j) { const f32x2 b = BB[d * 1024 + p * 16 + hp0 + j]; v[j] = ri == 0 ? (w.x * b.x - w.y * b.y) : (w.x * b.y + w.y * b.x); }
        v4u o; o.x = pk2(v[0], v[1]); o.y = pk2(v[2], v[3]); o.z = pk2(v[4], v[5]); o.w = pk2(v[6], v[7]);
        *(GAS v4u*)(B1 + (size_t)(512 + nn) * 512 + ch * 8) = o;
    }
    for (int i = tid; i < 128 * 32; i += 512) {
        const int n = part * 128 + (i >> 5), ch = i & 31, t = n >> 4, h = n & 15, d = ch >> 4, p0 = (ch & 15) * 4; float v[8];
#pragma unroll
        for (int j = 0; j < 4; ++j) { const f32x2 c = CC[d * 1024 + h * 64 + p0 + j], w = POW[(d * 33 + (d == 0 ? t + 1 : 32 - t)) * 64 + p0 + j];
            v[2 * j] = c.x * w.x - c.y * w.y; v[2 * j + 1] = -(c.x * w.y + c.y * w.x); }
        v4u o; o.x = pk2(v[0], v[1]); o.y = pk2(v[2], v[3]); o.z = pk2(v[4], v[5]); o.w = pk2(v[6], v[7]);
        *(GAS v4u*)(B2 + (size_t)n * 256 + ch * 8) = o;
    }
    __syncthreads();
}

template <int MODE>
__device__ __forceinline__ void phase_rows(const Ctx& C, int l) {
    const int gw = C.vcu * NWAVES + C.wave, NGW = C.G * NWAVES, lane = C.lane;
    const float* MODl = WSP(float, WS_MOD) + (size_t)(MODE == 2 ? 0 : l) * 5 * 6144;
    const float* MODp = WSP(float, WS_MOD) + (size_t)(l > 0 ? l - 1 : 0) * 5 * 6144;
    const bf16* YS = WSP(bf16, WS_YSLOT);
    f32x4 nx[4]; v2u nb[4], na[4], nc[4];
#define ROWS_LOAD(mm) do { const int m_ = (mm); \
        if (MODE == 0) { const GAS f32x4* xr = (const GAS f32x4*)in_row(C, m_) + lane; _Pragma("unroll") for (int q = 0; q < 4; ++q) nx[q] = xr[64 * q]; } \
        else { const GAS v2u* xr = (const GAS v2u*)xs_row(C, m_) + lane; const GAS v2u* y0 = (const GAS v2u*)(YS + (size_t)(2 * m_) * D) + lane; const GAS v2u* y1 = (const GAS v2u*)(YS + (size_t)(2 * m_ + 1) * D) + lane; \
            _Pragma("unroll") for (int q = 0; q < 4; ++q) { nb[q] = xr[64 * q]; na[q] = y0[64 * q]; nc[q] = y1[64 * q]; } } } while (0)
    int m = gw; if (MODE == 2) { while (m < T && (m % LB) < CTX) m += NGW; }
    if (m < T) ROWS_LOAD(m);
    while (m < T) {
        const int b = m / LB, j = m - b * LB, cond = j < CTX ? 4 : b;
        f32x4 v[4];
        if (MODE == 0) {
#pragma unroll
            for (int q = 0; q < 4; ++q) v[q] = nx[q]; }
        else { const GAS f32x4* g2 = (const GAS f32x4*)(MODp + cond * 6144 + 5 * 1024) + lane;
#pragma unroll
            for (int q = 0; q < 4; ++q) { const f32x4 g = g2[64 * q]; const v2u a = na[q], c = nc[q], xb_ = nb[q];
                v[q] = (f32x4){bflo(xb_.x), bfhi(xb_.x), bflo(xb_.y), bfhi(xb_.y)} + g * (f32x4){bflo(a.x) + bflo(c.x), bfhi(a.x) + bfhi(c.x), bflo(a.y) + bflo(c.y), bfhi(a.y) + bfhi(c.y)}; } }
        int mn = m + NGW; if (MODE == 2) { while (mn < T && (mn % LB) < CTX) mn += NGW; }
        if (mn < T) ROWS_LOAD(mn);
        float ss = 0.f;
#pragma unroll
        for (int q = 0; q < 4; ++q) ss += (v[q].x * v[q].x + v[q].y * v[q].y) + (v[q].z * v[q].z + v[q].w * v[q].w);
        const float rstd = 1.f / sqrtf(wave_sum(ss, lane) * (1.f / D) + EPS);
        if (MODE == 2) { GAS f32x4* o = (GAS f32x4*)(C.out + (size_t)(b * SEQ + j - CTX) * D) + lane; const GAS f32x4* fg = (const GAS f32x4*)C.in[I_FNG] + lane;
#pragma unroll
            for (int q = 0; q < 4; ++q) o[64 * q] = v[q] * rstd * fg[64 * q]; }
        else { GAS v2u* xo = (GAS v2u*)xs_row(C, m) + lane; GAS v2u* ho = (GAS v2u*)(WSP(bf16, WS_HB) + (size_t)m * D) + lane; GAS unsigned* h8 = (GAS unsigned*)(WSP(unsigned char, WS_HB8) + (size_t)m * D) + lane;
            const GAS f32x4* ng = (const GAS f32x4*)(C.in[I_N1G] + l * D) + lane; const GAS f32x4* sh = (const GAS f32x4*)(MODl + cond * 6144) + lane; const GAS f32x4* sc = (const GAS f32x4*)(MODl + cond * 6144 + 1024) + lane;
#pragma unroll
            for (int q = 0; q < 4; ++q) { xo[64 * q] = (v2u){pk2(v[q].x, v[q].y), pk2(v[q].z, v[q].w)}; const f32x4 h = v[q] * rstd * ng[64 * q] * (sc[64 * q] + 1.f) + sh[64 * q]; if (!W8_ALL) ho[64 * q] = (v2u){pk2(h.x, h.y), pk2(h.z, h.w)}; if (H8_WRITE) h8[64 * q] = pk4_fp8(h.x, h.y, h.z, h.w); } }
        m = mn;
    }
#undef ROWS_LOAD
}

__device__ __forceinline__ void phase_qkprep(const Ctx& C, int l) {
    const int gw = C.vcu * NWAVES + C.wave, NGW = C.G * NWAVES, lane = C.lane, s8 = lane & 7;
    const float* qg = C.in[I_QNG] + l * 64 + 8 * s8; const float* kg = C.in[I_KNG] + l * 64 + 8 * s8;
    float gq[8], gk[8];
#pragma unroll
    for (int i = 0; i < 8; ++i) { gq[i] = qg[i]; gk[i] = kg[i]; }
    const int ax = s8 >> 2, f0 = 8 * (s8 & 1);
    float inv[8];
#pragma unroll
    for (int i = 0; i < 8; ++i) inv[i] = exp2f(-(float)(f0 + i) * 0.8304820237218406f) * 0.15915494309189535f;
    const int kl = lane & 15;
    v4u wq, wk;
    if (gw < T) { wq = *((const GAS v4u*)(WSP(bf16, WS_QA) + (size_t)gw * 512) + lane); wk = *((const GAS v4u*)(WSP(bf16, WS_KA) + (size_t)gw * 128) + kl); }
    for (int m = gw; m < T; m += NGW) {
        const int b = m / LB, j = m - b * LB; const bool lat = j >= CTX; const int tt = j - CTX; const float pos = (float)(ax == 0 ? (tt >> 6) : (tt & 63));
        const v4u cq = wq, ck = wk;
        if (m + NGW < T) { wq = *((const GAS v4u*)(WSP(bf16, WS_QA) + (size_t)(m + NGW) * 512) + lane); wk = *((const GAS v4u*)(WSP(bf16, WS_KA) + (size_t)(m + NGW) * 128) + kl); }
        float cs[8], sn[8];
#pragma unroll
        for (int i = 0; i < 8; ++i) { cs[i] = lat ? cos_rev(pos * inv[i]) : 1.f; sn[i] = lat ? sin_rev(pos * inv[i]) : 0.f; }
#pragma unroll
        for (int which = 0; which < 2; ++which) {
            const v4u w = which == 0 ? cq : ck; float x[8] = {bflo(w.x), bfhi(w.x), bflo(w.y), bfhi(w.y), bflo(w.z), bfhi(w.z), bflo(w.w), bfhi(w.w)};
            float ss = 0.f;
#pragma unroll
            for (int i = 0; i < 8; ++i) ss += x[i] * x[i];
            ss += dpp_mov<0xB1, 0xF>(ss); ss += dpp_mov<0x4E, 0xF>(ss); ss += dpp_mov<0x141, 0xF>(ss);
            const float rstd = 1.f / sqrtf(ss * (1.f / 64.f) + EPS);
            float y[8];
#pragma unroll
            for (int i = 0; i < 8; ++i) { const float xn = x[i] * rstd * (which == 0 ? gq[i] : gk[i]); const float other = dpp_mov<0x4E, 0xF>(xn);
                y[i] = (s8 & 2) ? (xn * cs[i] + other * sn[i]) : (xn * cs[i] - other * sn[i]); }
            const float sc = which == 0 ? C2 : 1.f;
            v4u o; o.x = pk2(y[0] * sc, y[1] * sc); o.y = pk2(y[2] * sc, y[3] * sc); o.z = pk2(y[4] * sc, y[5] * sc); o.w = pk2(y[6] * sc, y[7] * sc);
            if (which == 0) *((GAS v4u*)(WSP(bf16, WS_QA) + (size_t)m * 512) + lane) = o;
            else if (lane < 16) *((GAS v4u*)(WSP(bf16, WS_KA) + (size_t)m * 128) + lane) = o;
        }
    }
}

__device__ __forceinline__ void phase_carry(const Ctx& C, int l) {
    if (C.vcu >= 32) return;
    const int b = C.vcu >> 3, g = (C.vcu & 7) * 4 + (C.wave >> 1), d = C.wave & 1, p = C.lane;
    const int li = ((l * 2 + d) * 32 + g) * 64 + p;
    const float re = C.in[I_LRE][li], im = C.in[I_LIM][li], dt = __expf(C.in[I_LDT][(l * 2 + d) * 32 + g]);
    const float mag = __expf(re * dt * 32.f), rev = im * dt * 32.f * 0.15915494309189535f; const float Lr = mag * cos_rev(rev), Li = mag * sin_rev(rev);
    const GAS f32x2* S = (const GAS f32x2*)(WSP(float, WS_SST) + (size_t)(b * NCH) * 8192 + g * 256 + d * 128) + p;
    GAS unsigned* X = (GAS unsigned*)(WSP(bf16, WS_XST) + (size_t)(b * NCH) * 8192 + g * 256 + d * 128) + p;
    float sr = 0.f, si = 0.f;
    if (d == 0) {
        for (int c0 = 0; c0 < NCH; c0 += 8) { f32x2 s[8];
#pragma unroll
            for (int k = 0; k < 8; ++k) s[k] = S[(size_t)(c0 + k) * 4096];
#pragma unroll
            for (int k = 0; k < 8; ++k) { X[(size_t)(c0 + k) * 4096] = pk2(sr, si); const float nr = Lr * sr - Li * si + s[k].x, ni = Lr * si + Li * sr + s[k].y; sr = nr; si = ni; } }
    } else {
        for (int seg = 0; seg < 33; ++seg) { const int chi = seg == 0 ? 7 : NCH - 1 - (seg - 1) * 8; f32x2 s[8];
#pragma unroll
            for (int k = 0; k < 8; ++k) s[k] = S[(size_t)(chi - k) * 4096];
#pragma unroll
            for (int k = 0; k < 8; ++k) { X[(size_t)(chi - k) * 4096] = pk2(sr, si); const float nr = Lr * sr - Li * si + s[k].x, ni = Lr * si + Li * sr + s[k].y; sr = nr; si = ni; } }
    }
}

__device__ __forceinline__ void phase_norm2(const Ctx& C, int l) {
    LAS float* TILE = (LAS float*)C.lds;
    LAS float* PART = (LAS float*)(C.lds + 65792);
    LAS unsigned* REC = (LAS unsigned*)(C.lds + 74240);
    LAS float* LG = (LAS float*)(C.lds + 74240 + 16384);
    LAS unsigned* LCNT = (LAS unsigned*)(C.lds + 74240 + 32768);
    const int lane = C.lane, tid = C.tid;
    if (tid < 32) LCNT[tid] = 0u;
    const float* MODl = WSP(float, WS_MOD) + (size_t)l * 5 * 6144;
    int nrows = 0; for (int m = C.vcu; m < T; m += C.G) ++nrows;
    const int fn = lane & 15, kq = lane >> 4;
    float bw[32];
#pragma unroll
    for (int j = 0; j < 32; ++j) bw[j] = C.in[I_RW][(128 * C.wave + 32 * kq + j) * 16 + fn];
    v2u nx[2][4];
#define N2_LOAD(ii) do { _Pragma("unroll") for (int rr = 0; rr < 2; ++rr) { const int i_ = (ii) + rr * NWAVES; const int m_ = C.vcu + C.G * (i_ < nrows ? i_ : (ii)); const GAS v2u* xr = (const GAS v2u*)xs_row(C, m_) + lane; \
        _Pragma("unroll") for (int q = 0; q < 4; ++q) nx[rr][q] = xr[64 * q]; } } while (0)
    if (C.wave < nrows) N2_LOAD(C.wave);
    for (int i0 = 0; i0 < nrows; i0 += 2 * NWAVES) {
        const int i = i0 + C.wave; const bool has0 = i < nrows, has1 = i + NWAVES < nrows;
        if (has0) {
#pragma unroll
            for (int rr = 0; rr < 2; ++rr) { const int ir = (rr && has1) ? i + NWAVES : i; const int m = C.vcu + C.G * ir, cond = cond_of(m);
                GAS unsigned* h8 = (GAS unsigned*)(WSP(unsigned char, WS_HB8) + (size_t)m * D) + lane;
                const GAS f32x4* ng = (const GAS f32x4*)(C.in[I_N2G] + l * D) + lane; const GAS f32x4* sh = (const GAS f32x4*)(MODl + cond * 6144 + 3072) + lane; const GAS f32x4* sc = (const GAS f32x4*)(MODl + cond * 6144 + 4096) + lane;
                float ss = 0.f; f32x4 xf[4];
#pragma unroll
                for (int q = 0; q < 4; ++q) { const v2u w_ = nx[rr][q]; const f32x4 v = (f32x4){bflo(w_.x), bfhi(w_.x), bflo(w_.y), bfhi(w_.y)}; xf[q] = v; ss += (v.x * v.x + v.y * v.y) + (v.z * v.z + v.w * v.w); }
                const float rstd = 1.f / sqrtf(wave_sum(ss, lane) * (1.f / D) + EPS);
#pragma unroll
                for (int q = 0; q < 4; ++q) { const f32x4 h = xf[q] * rstd * ng[64 * q] * (sc[64 * q] + 1.f) + sh[64 * q];
                    *(LAS f32x4*)(TILE + (C.wave + NWAVES * rr) * 1028 + 256 * q + 4 * lane) = h;
                    if (rr == 0 || has1) h8[64 * q] = pk4_fp8(h.x, h.y, h.z, h.w); } }
            if (i + 2 * NWAVES < nrows) N2_LOAD(i + 2 * NWAVES);
        } else {
#pragma unroll
            for (int rr = 0; rr < 2; ++rr)
#pragma unroll
                for (int q = 0; q < 4; ++q) *(LAS f32x4*)(TILE + (C.wave + NWAVES * rr) * 1028 + 256 * q + 4 * lane) = (f32x4){0.f, 0.f, 0.f, 0.f};
        }
        __syncthreads();
        f32x4 dacc = (f32x4){0.f, 0.f, 0.f, 0.f};
#pragma unroll
        for (int j = 0; j < 8; ++j) { const f32x4 a = *(const LAS f32x4*)(TILE + fn * 1028 + 128 * C.wave + 32 * kq + 4 * j);
#pragma unroll
            for (int e = 0; e < 4; ++e) dacc = __builtin_amdgcn_mfma_f32_16x16x4f32(a[e], bw[4 * j + e], dacc, 0, 0, 0); }
#pragma unroll
        for (int r = 0; r < 4; ++r) PART[C.wave * 256 + (4 * kq + r) * 16 + fn] = dacc[r];
        __syncthreads();
        if (tid < 256) { float sum = 0.f;
#pragma unroll
            for (int w = 0; w < NWAVES; ++w) sum += PART[w * 256 + tid];
            const int ri = i0 + (tid >> 4); if (ri < nrows) LG[ri * 16 + (tid & 15)] = sum; }
    }
#undef N2_LOAD
    __syncthreads();
    float rb[16];
#pragma unroll
    for (int e = 0; e < 16; ++e) rb[e] = C.in[I_RB][e];
    for (int i = tid; i < nrows; i += 512) {
        float lg[16];
#pragma unroll
        for (int q = 0; q < 4; ++q) { const f32x4 t = *(const LAS f32x4*)(LG + i * 16 + 4 * q); lg[4 * q] = t.x; lg[4 * q + 1] = t.y; lg[4 * q + 2] = t.z; lg[4 * q + 3] = t.w; }
        float mx = lg[0];
#pragma unroll
        for (int e = 1; e < 16; ++e) mx = fmaxf(mx, lg[e]);
        float pr[16], sel[16], sum = 0.f;
#pragma unroll
        for (int e = 0; e < 16; ++e) { pr[e] = __expf(lg[e] - mx); sum += pr[e]; }
        const float rs = 1.f / sum;
#pragma unroll
        for (int e = 0; e < 16; ++e) { pr[e] *= rs; sel[e] = pr[e] + rb[e]; }
        float bestv = -1e30f; int best = 0;
#pragma unroll
        for (int gq = 0; gq < 4; ++gq) { float m1 = -1e30f, m2 = -1e30f;
#pragma unroll
            for (int k = 0; k < 4; ++k) { const float s_ = sel[4 * gq + k]; if (s_ > m1) { m2 = m1; m1 = s_; } else if (s_ > m2) m2 = s_; }
            const float gs = m1 + m2; if (gs > bestv) { bestv = gs; best = gq; } }
        float s4[4], p4[4];
#pragma unroll
        for (int k = 0; k < 4; ++k) { s4[k] = best == 0 ? sel[k] : best == 1 ? sel[4 + k] : best == 2 ? sel[8 + k] : sel[12 + k]; p4[k] = best == 0 ? pr[k] : best == 1 ? pr[4 + k] : best == 2 ? pr[8 + k] : pr[12 + k]; }
        int i0 = 0; float v0 = s4[0], q0 = p4[0];
#pragma unroll
        for (int k = 1; k < 4; ++k) if (s4[k] > v0) { v0 = s4[k]; i0 = k; q0 = p4[k]; }
        int i1 = i0 == 0 ? 1 : 0; float v1 = -1e30f, q1 = p4[i0 == 0 ? 1 : 0];
#pragma unroll
        for (int k = 0; k < 4; ++k) if (k != i0 && s4[k] > v1) { v1 = s4[k]; i1 = k; q1 = p4[k]; }
        const int e0 = 4 * best + i0, e1 = 4 * best + i1; const float wn = 1.f / (q0 + q1);
        const unsigned lp0 = atomicAdd((unsigned*)(LCNT + e0), 1u), lp1 = atomicAdd((unsigned*)(LCNT + e1), 1u);
        REC[i * 4 + 0] = (unsigned)e0 | ((unsigned)e1 << 8) | (lp0 << 16); REC[i * 4 + 1] = lp1; REC[i * 4 + 2] = __float_as_uint(q0 * wn); REC[i * 4 + 3] = __float_as_uint(q1 * wn);
    }
    __syncthreads();
    if (tid < 16) LCNT[16 + tid] = __hip_atomic_fetch_add((unsigned*)(C.ctl + CW_CNT + l * 1024 + 64 * tid), LCNT[tid], RLX_AGENT);
    __syncthreads();
    int* LIST = WSP(int, WS_LIST); float* RWG = WSP(float, WS_RW);
    for (int i = tid; i < nrows; i += 512) { const int m = C.vcu + C.G * i; const unsigned r0 = REC[i * 4], r1 = REC[i * 4 + 1];
        const int e0 = r0 & 255, e1 = (r0 >> 8) & 255; const unsigned lp0 = r0 >> 16, lp1 = r1;
        LIST[(size_t)e0 * T + LCNT[16 + e0] + lp0] = 2 * m; LIST[(size_t)e1 * T + LCNT[16 + e1] + lp1] = 2 * m + 1;
        RWG[2 * m] = __uint_as_float(REC[i * 4 + 2]); RWG[2 * m + 1] = __uint_as_float(REC[i * 4 + 3]); }
    __syncthreads();
}
using pg8::Unit;
typedef f32x4 Acc[2][2][4][2];
__device__ __forceinline__ v4u pack8(const f32x4& a, const f32x4& b) { v4u w; w.x = cvt_pk_bf16(a[0], a[1]); w.y = cvt_pk_bf16(a[2], a[3]); w.z = cvt_pk_bf16(b[0], b[1]); w.w = cvt_pk_bf16(b[2], b[3]); return w; }
__device__ __forceinline__ void unpack8(const v4u& w, f32x4& a, f32x4& b) { a = (f32x4){bflo(w.x), bfhi(w.x), bflo(w.y), bfhi(w.y)}; b = (f32x4){bflo(w.z), bfhi(w.z), bflo(w.w), bfhi(w.w)}; }
#ifndef WT_MODE
#define WT_MODE 0
#endif
__device__ __forceinline__ void st16(void* p, const v4u& v) {
#if WT_MODE == 1
    asm volatile("global_store_dwordx4 %0, %1, off sc0 sc1" :: "v"(p), "v"(v) : "memory");
#elif WT_MODE == 2
    asm volatile("global_store_dwordx4 %0, %1, off nt" :: "v"(p), "v"(v) : "memory");
#else
    *(GAS v4u*)p = v;
#endif
}
__device__ __forceinline__ int chunk_m0(int cr) { return (cr / NCH) * LB + (cr % NCH) * 32; }

struct PWin {
    static constexpr bool EARLY_AOFF = false, FP8 = false; unsigned char* ws; int G, c; int K; unsigned kstepA;
    __device__ __forceinline__ bool next(int i, Unit& u) const { const long L = (long)i * G + c; if (L >= NPAN * 11) return false; pg8::static_decode((int)L, NPAN, 11, u.pm, u.pn); u.z = 0; return true; }
    __device__ __forceinline__ const char* a_base(const Unit& u) const { return (const char*)(ws + WS_HB) + (size_t)u.pm * 256 * 1024 * 2; }
    __device__ __forceinline__ unsigned a_off(const Unit&, int h, int R, int Cc) const { return (unsigned)((h * 128 + R) * 1024 + Cc) * 2u; }
    __device__ __forceinline__ const char* b_base(const Unit& u) const { return (const char*)(ws + WS_WIN) + (size_t)u.pn * 256 * 1024 * 2; }
    __device__ __forceinline__ void epi(const Acc& acc, const Unit& u, int wr, int wc, int fr, int fq) const {
        const int row0 = u.pm * 256 + wr * 64 + fr;
#pragma unroll
        for (int bj = 0; bj < 2; ++bj) {
            const int cb = u.pn * 256 + bj * 128; bf16* dst; int ld, col, mode = 0; float sc = 1.f;
            if (cb < 512) { dst = (bf16*)(ws + WS_U) + ((size_t)((cb + wc * 32 + 8 * fq) >> 4) * T) * 16 + ((8 * fq) & 15) - (wc * 32 + 8 * fq); ld = 16; col = 0; }
            else if (cb < 1024) { dst = (bf16*)(ws + WS_QA); ld = 512; col = cb - 512; }
            else if (cb == 1024) { dst = (bf16*)(ws + WS_KA); ld = 128; col = 0; }
            else if (cb == 1152) { dst = (bf16*)(ws + WS_VA); ld = 128; col = 0; }
            else if (cb < 1792) { dst = (bf16*)(ws + WS_QN); ld = 512; col = cb - 1280; sc = C2; }
            else if (cb < 2304) { dst = (bf16*)(ws + WS_KN); ld = 512; col = cb - 1792; }
            else { dst = (bf16*)(ws + WS_VN); ld = 512; col = cb - 2304; }
            const int c0 = col + wc * 32 + 8 * fq;
#pragma unroll
            for (int ai = 0; ai < 2; ++ai)
#pragma unroll
                for (int m = 0; m < 4; ++m) { f32x4 v0 = acc[ai][bj][m][0], v1 = acc[ai][bj][m][1];
                    if (mode) { v0 = (f32x4){fsigmoid(v0[0]), fsigmoid(v0[1]), fsigmoid(v0[2]), fsigmoid(v0[3])}; v1 = (f32x4){fsigmoid(v1[0]), fsigmoid(v1[1]), fsigmoid(v1[2]), fsigmoid(v1[3])}; }
                    else { v0 = v0 * sc; v1 = v1 * sc; }
                    st16(dst + (size_t)(row0 + ai * 128 + m * 16) * ld + c0, pack8(v0, v1)); __builtin_amdgcn_sched_barrier(0); }
        }
    }
};

struct PWin8 {
    static constexpr bool EARLY_AOFF = false, FP8 = true; unsigned char* ws; int G, c; int K; unsigned kstepA;
    __device__ __forceinline__ bool next(int i, Unit& u) const { const long L = (long)i * G + c; if (L >= 2 * NPAN * 23) return false; pg8::static_decode((int)L, 2 * NPAN, 23, u.pm, u.pn); u.z = 0; return true; }
    __device__ __forceinline__ const char* a_base(const Unit& u) const { return (const char*)(ws + WS_HB8) + (size_t)u.pm * 128 * 1024; }
    __device__ __forceinline__ unsigned a_off(const Unit&, int R, int Cc) const { return (unsigned)(R * 1024 + Cc * 2); }
    __device__ __forceinline__ const char* b_base(const Unit& u) const { return (const char*)(ws + WS_WIN) + (size_t)u.pn * 256 * 1024; }
    __device__ __forceinline__ void epi(const f32x4 (&acc)[2][4][2], f32x4 (&)[2][4][2], const Unit& u, int wr, int wc, int fr, int fq) const {
        const int row0 = u.pm * 128 + wr * 64 + fr;
#pragma unroll
        for (int bj = 0; bj < 2; ++bj) {
            const int cb = u.pn * 256 + bj * 128;
            if (cb >= 2816) { const int c0 = cb - 2816 + wc * 32 + 8 * fq;
#pragma unroll
                for (int m = 0; m < 4; ++m) { f32x4 v0 = acc[bj][m][0] * (1.f / 64.f), v1 = acc[bj][m][1] * (1.f / 64.f);
                    v0 = (f32x4){fsigmoid(v0[0]), fsigmoid(v0[1]), fsigmoid(v0[2]), fsigmoid(v0[3])}; v1 = (f32x4){fsigmoid(v1[0]), fsigmoid(v1[1]), fsigmoid(v1[2]), fsigmoid(v1[3])};
                    *(GAS v2u*)((unsigned char*)(ws + WS_GATES) + (size_t)(row0 + m * 16) * 3072 + c0) = (v2u){pk4_fp8(v0[0], v0[1], v0[2], v0[3]), pk4_fp8(v1[0], v1[1], v1[2], v1[3])}; }
            } else {
                bf16* dst; int ld, col; float sc = 1.f / 64.f;
                if (cb < 512) { dst = (bf16*)(ws + WS_U) + ((size_t)((cb + wc * 32 + 8 * fq) >> 4) * T) * 16 + ((8 * fq) & 15) - (wc * 32 + 8 * fq); ld = 16; col = 0; }
                else if (cb < 1024) { dst = (bf16*)(ws + WS_QA); ld = 512; col = cb - 512; }
                else if (cb == 1024) { dst = (bf16*)(ws + WS_KA); ld = 128; col = 0; }
                else if (cb == 1152) { dst = (bf16*)(ws + WS_VA); ld = 128; col = 0; }
                else if (cb < 1792) { dst = (bf16*)(ws + WS_QN); ld = 512; col = cb - 1280; sc = C2 / 64.f; }
                else if (cb < 2304) { dst = (bf16*)(ws + WS_KN); ld = 512; col = cb - 1792; }
                else { dst = (bf16*)(ws + WS_VN); ld = 512; col = cb - 2304; }
                const int c0 = col + wc * 32 + 8 * fq;
#pragma unroll
                for (int m = 0; m < 4; ++m) *(GAS v4u*)(dst + (size_t)(row0 + m * 16) * ld + c0) = pack8(acc[bj][m][0] * sc, acc[bj][m][1] * sc);
            }
        }
    }
};

struct PGate {
    static constexpr bool EARLY_AOFF = false, FP8 = !GATE_BF16; unsigned char* ws; int G, c; int K; unsigned kstepA;
    __device__ __forceinline__ bool next(int i, Unit& u) const { const long L = (long)i * G + c; if (L >= 2 * NPAN * 12) return false; pg8::static_decode((int)L, 2 * NPAN, 12, u.pm, u.pn); u.z = 0; return true; }
    __device__ __forceinline__ const char* a_base(const Unit& u) const { return GATE_BF16 ? (const char*)(ws + WS_HB) + (size_t)u.pm * 128 * 2048 : (const char*)(ws + WS_HB8) + (size_t)u.pm * 128 * 1024; }
    __device__ __forceinline__ unsigned a_off(const Unit&, int R, int Cc) const { return GATE_BF16 ? (unsigned)(R * 2048 + Cc * 2) : (unsigned)(R * 1024 + Cc * 2); }
    __device__ __forceinline__ const char* b_base(const Unit& u) const { return GATE_BF16 ? (const char*)(ws + WS_WIN) + (size_t)(2816 + u.pn * 256) * 2048 : (const char*)(ws + WS_WIN8) + (size_t)u.pn * 256 * 1024; }
    __device__ __forceinline__ void epi(const f32x4 (&acc)[2][4][2], f32x4 (&)[2][4][2], const Unit& u, int wr, int wc, int fr, int fq) const {
#pragma unroll
        for (int m = 0; m < 4; ++m) { const size_t r = (size_t)(u.pm * 128 + wr * 64 + m * 16 + fr);
#pragma unroll
            for (int bj = 0; bj < 2; ++bj) { const int c0 = u.pn * 256 + bj * 128 + wc * 32 + 8 * fq; f32x4 v0 = acc[bj][m][0] * (GATE_BF16 ? 1.f : 1.f / 64.f), v1 = acc[bj][m][1] * (GATE_BF16 ? 1.f : 1.f / 64.f);
                v0 = (f32x4){fsigmoid(v0[0]), fsigmoid(v0[1]), fsigmoid(v0[2]), fsigmoid(v0[3])}; v1 = (f32x4){fsigmoid(v1[0]), fsigmoid(v1[1]), fsigmoid(v1[2]), fsigmoid(v1[3])};
                if (GATE_BF16) *(GAS v4u*)((bf16*)(ws + WS_GATES) + r * 3072 + c0) = pack8(v0, v1);
                else *(GAS v2u*)((unsigned char*)(ws + WS_GATES) + r * 3072 + c0) = (v2u){pk4_fp8(v0[0], v0[1], v0[2], v0[3]), pk4_fp8(v1[0], v1[1], v1[2], v1[3])}; }
            __builtin_amdgcn_sched_barrier(0); }
    }
};

struct PS5A {
    static constexpr bool EARLY_AOFF = false, FP8 = false; unsigned char* ws; int G, c; int K; unsigned kstepA;
    __device__ __forceinline__ bool next(int i, Unit& u) const { const long L = (long)i * G + c; if (L >= 32 * 15) return false; const int l = (int)L; u.z = l / 15; const int r = l % 15; u.pm = r / 3; u.pn = r % 3; return true; }
    __device__ __forceinline__ const char* a_base(const Unit& u) const { return (const char*)(ws + WS_U) + (size_t)u.z * T * 32; }
    __device__ __forceinline__ unsigned a_off(const Unit& u, int h, int R, int Cc) const { int cr = u.pm * 256 + h * 128 + R; cr = cr < NCR ? cr : NCR - 1; return (unsigned)(cr * 512 + Cc) * 2u; }
    __device__ __forceinline__ const char* b_base(const Unit& u) const { return (const char*)(ws + WS_BT1) + ((size_t)u.z * 768 + u.pn * 256) * 512 * 2; }
    __device__ __forceinline__ void epi(const Acc& acc, const Unit& u, int wr, int wc, int fr, int fq) const {
#pragma unroll
        for (int ai = 0; ai < 2; ++ai)
#pragma unroll
            for (int m = 0; m < 4; ++m) { const int cr = u.pm * 256 + ai * 128 + wr * 64 + m * 16 + fr; if (cr >= NCR) continue;
#pragma unroll
                for (int bj = 0; bj < 2; ++bj) { const int n = bj * 128 + wc * 32 + 8 * fq;
                    if (u.pn < 2) *(GAS v4u*)((bf16*)(ws + WS_YG) + (size_t)u.z * T * 16 + (size_t)cr * 512 + u.pn * 256 + n) = pack8(acc[ai][bj][m][0], acc[ai][bj][m][1]);
                    else { GAS f32x4* o = (GAS f32x4*)((float*)(ws + WS_SST) + (size_t)cr * 8192 + u.z * 256 + n); o[0] = acc[ai][bj][m][0]; o[1] = acc[ai][bj][m][1]; } }
                __builtin_amdgcn_sched_barrier(0); }
    }
};

struct PS5B {
    static constexpr bool EARLY_AOFF = false, FP8 = false; unsigned char* ws; int G, c; int K; unsigned kstepA;
    __device__ __forceinline__ bool next(int i, Unit& u) const { const long L = (long)i * G + c; if (L >= 32 * 10) return false; const int l = (int)L; u.z = l / 10; const int r = l % 10; u.pm = r / 2; u.pn = r % 2; return true; }
    __device__ __forceinline__ const char* a_base(const Unit& u) const { return (const char*)(ws + WS_XST) + (size_t)u.z * 512; }
    __device__ __forceinline__ unsigned a_off(const Unit& u, int h, int R, int Cc) const { int cr = u.pm * 256 + h * 128 + R; cr = cr < NCR ? cr : NCR - 1; return (unsigned)(cr * 8192 + Cc) * 2u; }
    __device__ __forceinline__ const char* b_base(const Unit& u) const { return (const char*)(ws + WS_BT2) + ((size_t)u.z * 512 + u.pn * 256) * 256 * 2; }
    __device__ __forceinline__ void epi(const Acc& acc, const Unit& u, int wr, int wc, int fr, int fq) const {
#pragma unroll
        for (int ai = 0; ai < 2; ++ai) {
            v4u yw[4][2];
#pragma unroll
            for (int m = 0; m < 4; ++m) { int cr = u.pm * 256 + ai * 128 + wr * 64 + m * 16 + fr; cr = cr < NCR ? cr : NCR - 1;
#pragma unroll
                for (int bj = 0; bj < 2; ++bj) yw[m][bj] = *(const GAS v4u*)((const bf16*)(ws + WS_YG) + (size_t)u.z * T * 16 + (size_t)cr * 512 + u.pn * 256 + bj * 128 + wc * 32 + 8 * fq); }
#pragma unroll
            for (int m = 0; m < 4; ++m) { const int cr = u.pm * 256 + ai * 128 + wr * 64 + m * 16 + fr; if (cr >= NCR) continue;
#pragma unroll
                for (int bj = 0; bj < 2; ++bj) { const int nn = u.pn * 256 + bj * 128 + wc * 32 + 8 * fq, t = nn >> 4, h0 = nn & 15;
                    GAS v4u* p = (GAS v4u*)((bf16*)(ws + WS_YS) + (size_t)(chunk_m0(cr) + t) * 512 + u.z * 16 + h0);
                    f32x4 y0, y1; { const v4u w_ = yw[m][bj]; unpack8(w_, y0, y1); } y0 += acc[ai][bj][m][0]; y1 += acc[ai][bj][m][1];
                    y0 = (f32x4){gelu_tanh(y0[0]), gelu_tanh(y0[1]), gelu_tanh(y0[2]), gelu_tanh(y0[3])}; y1 = (f32x4){gelu_tanh(y1[0]), gelu_tanh(y1[1]), gelu_tanh(y1[2]), gelu_tanh(y1[3])};
                    *p = pack8(y0, y1); } } }
    }
};

__device__ __forceinline__ int half_panel(int hl, bool lat_only) { if (!lat_only) return hl; const int pl = hl >> 1; return 2 * (pl + (pl >> 5) + 1) + (hl & 1); }
struct PGlu {
    static constexpr bool EARLY_AOFF = false, FP8 = false; unsigned char* ws; int G, c; int K; unsigned kstepA; bool lat_only;
    __device__ __forceinline__ bool next(int i, Unit& u) const { const int nH = lat_only ? 256 : 2 * NPAN; const long L = (long)i * G + c; if (L >= nH * 2) return false; pg8::static_decode((int)L, nH, 2, u.pm, u.pn); u.pm = half_panel(u.pm, lat_only); u.z = 0; return true; }
    __device__ __forceinline__ const char* a_base(const Unit& u) const { return (const char*)(ws + WS_YS) + (size_t)u.pm * 128 * 512 * 2; }
    __device__ __forceinline__ unsigned a_off(const Unit&, int R, int Cc) const { return (unsigned)(R * 512 + Cc) * 2u; }
    __device__ __forceinline__ const char* b_base(const Unit& u) const { return (const char*)(ws + WS_WGLU) + (size_t)u.pn * 256 * 512 * 2; }
    __device__ __forceinline__ void epi(const f32x4 (&acc)[2][4][2], f32x4 (&)[2][4][2], const Unit& u, int wr, int wc, int fr, int fq) const {
        v4u zw[4][2];
#pragma unroll
        for (int m = 0; m < 4; ++m)
#pragma unroll
            for (int bj = 0; bj < 2; ++bj) zw[m][bj] = *(const GAS v4u*)((const bf16*)(ws + WS_YS) + (size_t)(u.pm * 128 + wr * 64 + m * 16 + fr) * 512 + u.pn * 256 + bj * 128 + wc * 32 + 8 * fq);
#pragma unroll
        for (int m = 0; m < 4; ++m) { const size_t r = (size_t)(u.pm * 128 + wr * 64 + m * 16 + fr);
#pragma unroll
            for (int bj = 0; bj < 2; ++bj) { const int cc = u.pn * 256 + bj * 128 + wc * 32 + 8 * fq;
                f32x4 z0, z1; { const v4u w_ = zw[m][bj]; unpack8(w_, z0, z1); } const f32x4 a0 = acc[bj][m][0], a1 = acc[bj][m][1];
                z0 = z0 * (f32x4){fsigmoid(a0[0]), fsigmoid(a0[1]), fsigmoid(a0[2]), fsigmoid(a0[3])}; z1 = z1 * (f32x4){fsigmoid(a1[0]), fsigmoid(a1[1]), fsigmoid(a1[2]), fsigmoid(a1[3])};
                *(GAS v4u*)((bf16*)(ws + WS_U) + r * 512 + cc) = pack8(z0, z1); } }
    }
};

typedef f32x4 Acc128[2][4][2];
struct PMerge {
    static constexpr bool EARLY_AOFF = false, FP8 = false; unsigned char* ws; int G, c; int K; unsigned kstepA; bool lat_only;
    __device__ __forceinline__ bool next(int i, Unit& u) const { const int nH = lat_only ? 256 : 2 * NPAN; const long tile = (long)(i / 3) * G + c; if (tile >= nH * 4) return false; pg8::static_decode((int)tile, nH, 4, u.pm, u.pn); u.pm = half_panel(u.pm, lat_only); u.z = i % 3; return true; }
    __device__ __forceinline__ const char* a_base(const Unit& u) const { const size_t off = u.z == 0 ? WS_U : (u.z == 1 ? WS_AO : WS_NO); return (const char*)(ws + off) + (size_t)u.pm * 128 * 512 * 2; }
    __device__ __forceinline__ unsigned a_off(const Unit&, int R, int Cc) const { return (unsigned)(R * 512 + Cc) * 2u; }
    __device__ __forceinline__ const char* b_base(const Unit& u) const { return (const char*)(ws + WS_WBR) + ((size_t)u.z * 1024 + u.pn * 256) * 512 * 2; }
    __device__ __forceinline__ void epi(const Acc128& acc, Acc128& mrg, const Unit& u, int wr, int wc, int fr, int fq) const {
        v2u gw[4][2];
#pragma unroll
        for (int m = 0; m < 4; ++m)
#pragma unroll
            for (int bj = 0; bj < 2; ++bj) gw[m][bj] = *(const GAS v2u*)((const unsigned char*)(ws + WS_GATES) + (size_t)(u.pm * 128 + wr * 64 + m * 16 + fr) * 3072 + u.z * 1024 + u.pn * 256 + bj * 128 + wc * 32 + 8 * fq);
#pragma unroll
        for (int m = 0; m < 4; ++m) { const size_t r = (size_t)(u.pm * 128 + wr * 64 + m * 16 + fr);
#pragma unroll
            for (int bj = 0; bj < 2; ++bj) { const int cc = u.pn * 256 + bj * 128 + wc * 32 + 8 * fq; const v2u w_ = gw[m][bj];
                const f32x4 g0 = (f32x4){__builtin_amdgcn_cvt_f32_fp8((int)w_.x, 0), __builtin_amdgcn_cvt_f32_fp8((int)w_.x, 1), __builtin_amdgcn_cvt_f32_fp8((int)w_.x, 2), __builtin_amdgcn_cvt_f32_fp8((int)w_.x, 3)};
                const f32x4 g1 = (f32x4){__builtin_amdgcn_cvt_f32_fp8((int)w_.y, 0), __builtin_amdgcn_cvt_f32_fp8((int)w_.y, 1), __builtin_amdgcn_cvt_f32_fp8((int)w_.y, 2), __builtin_amdgcn_cvt_f32_fp8((int)w_.y, 3)};
                if (u.z == 0) { mrg[bj][m][0] = g0 * acc[bj][m][0]; mrg[bj][m][1] = g1 * acc[bj][m][1]; }
                else { mrg[bj][m][0] += g0 * acc[bj][m][0]; mrg[bj][m][1] += g1 * acc[bj][m][1]; }
                if (u.z == 2) *(GAS v4u*)((bf16*)(ws + WS_HB) + r * 1024 + cc) = pack8(mrg[bj][m][0], mrg[bj][m][1]); } }
    }
};

struct PWout {
    static constexpr bool EARLY_AOFF = false, FP8 = false; unsigned char* ws; float* out; const float* mod; int G, c; int K; unsigned kstepA; bool lat_only;
    __device__ __forceinline__ bool next(int i, Unit& u) const { const int nH = lat_only ? 256 : 2 * NPAN; const long L = (long)i * G + c; if (L >= nH * 4) return false; pg8::static_decode((int)L, nH, 4, u.pm, u.pn); u.pm = half_panel(u.pm, lat_only); u.z = 0; return true; }
    __device__ __forceinline__ const char* a_base(const Unit& u) const { return (const char*)(ws + WS_HB) + (size_t)u.pm * 128 * 1024 * 2; }
    __device__ __forceinline__ unsigned a_off(const Unit&, int R, int Cc) const { return (unsigned)(R * 1024 + Cc) * 2u; }
    __device__ __forceinline__ const char* b_base(const Unit& u) const { return (const char*)(ws + WS_WOUT) + (size_t)u.pn * 256 * 1024 * 2; }
    __device__ __forceinline__ void epi(const f32x4 (&acc)[2][4][2], f32x4 (&)[2][4][2], const Unit& u, int wr, int wc, int fr, int fq) const {
        const int pm = u.pm >> 1, b = pm / 33, pr = pm % 33, cond = pr == 0 ? 4 : b;
        bf16* xb = (bf16*)(ws + WS_XS) + (size_t)u.pm * 128 * D;
        const float* g1 = mod + cond * 6144 + 2048;
        v4u xv[2][4];
#pragma unroll
        for (int bj = 0; bj < 2; ++bj)
#pragma unroll
            for (int m = 0; m < 4; ++m) xv[bj][m] = *(const GAS v4u*)(xb + (size_t)(wr * 64 + m * 16 + fr) * D + u.pn * 256 + bj * 128 + wc * 32 + 8 * fq);
#pragma unroll
        for (int bj = 0; bj < 2; ++bj) { const int cc = u.pn * 256 + bj * 128 + wc * 32 + 8 * fq; const f32x4 ga = *(const GAS f32x4*)(g1 + cc), gb = *(const GAS f32x4*)(g1 + cc + 4);
#pragma unroll
            for (int m = 0; m < 4; ++m) { f32x4 x0, x1; { const v4u w_ = xv[bj][m]; unpack8(w_, x0, x1); }
                *(GAS v4u*)(xb + (size_t)(wr * 64 + m * 16 + fr) * D + cc) = pack8(x0 + ga * acc[bj][m][0], x1 + gb * acc[bj][m][1]); } }
    }
};

struct ExpTab { int cnt[16], tile0[17]; };
__device__ __forceinline__ int exp_find(const int (&tile0)[17], int q) { int e = 0;
#pragma unroll
    for (int k = 1; k < 16; ++k) e += (q >= tile0[k]) ? 1 : 0;
    return e; }

struct PMoe1 {
    static constexpr bool EARLY_AOFF = true, FP8 = true; unsigned char* ws; const LAS int* tab; int G, c; int K; unsigned kstepA;
    __device__ __forceinline__ bool next(int i, Unit& u) const { const long L = (long)i * G + c; const int total = __builtin_amdgcn_readfirstlane(tab[32]) * 4; if (L >= total) return false; const int q = (int)L >> 2; u.pn = (int)L & 3;
        int e = 0;
#pragma unroll
        for (int k = 1; k < 16; ++k) e += (q >= __builtin_amdgcn_readfirstlane(tab[16 + k])) ? 1 : 0;
        u.z = e; u.pm = q - __builtin_amdgcn_readfirstlane(tab[16 + e]); return true; }
    __device__ __forceinline__ const char* a_base(const Unit&) const { return (const char*)(ws + WS_HB8); }
    __device__ __forceinline__ unsigned a_off(const Unit& u, int R, int Cc) const { int r = u.pm * 128 + R; const int n = __builtin_amdgcn_readfirstlane(tab[u.z]); r = r < n ? r : n - 1;
        const int ent = ((const int*)(ws + WS_LIST))[(size_t)u.z * T + r]; return (unsigned)((ent >> 1) * 1024 + Cc * 2); }
    __device__ __forceinline__ const char* b_base(const Unit& u) const { return (const char*)(ws + WS_MOE1) + ((size_t)u.z * 1024 + u.pn * 256) * 1024; }
    __device__ __forceinline__ void epi(const f32x4 (&acc)[2][4][2], f32x4 (&)[2][4][2], const Unit& u, int wr, int wc, int fr, int fq) const {
        const size_t arow0 = (size_t)(__builtin_amdgcn_readfirstlane(tab[16 + u.z]) + u.pm) * 128;
#pragma unroll
        for (int m = 0; m < 4; ++m) { const f32x4 g0 = acc[0][m][0] * (1.f / 64.f), g1 = acc[0][m][1] * (1.f / 64.f), u0 = acc[1][m][0] * (8.f / 64.f), u1 = acc[1][m][1] * (8.f / 64.f);
            const f32x4 v0 = (f32x4){g0[0] * fsigmoid(g0[0]), g0[1] * fsigmoid(g0[1]), g0[2] * fsigmoid(g0[2]), g0[3] * fsigmoid(g0[3])} * u0;
            const f32x4 v1 = (f32x4){g1[0] * fsigmoid(g1[0]), g1[1] * fsigmoid(g1[1]), g1[2] * fsigmoid(g1[2]), g1[3] * fsigmoid(g1[3])} * u1;
            *(GAS v2u*)((unsigned char*)(ws + WS_ACT) + (arow0 + wr * 64 + m * 16 + fr) * 512 + u.pn * 128 + wc * 32 + 8 * fq) = (v2u){pk4_fp8(v0[0], v0[1], v0[2], v0[3]), pk4_fp8(v1[0], v1[1], v1[2], v1[3])}; }
    }
};
struct PMoe2 {
    static constexpr bool EARLY_AOFF = false, FP8 = true; unsigned char* ws; const LAS int* tab; int G, c; int K; unsigned kstepA;
    __device__ __forceinline__ bool next(int i, Unit& u) const { const long L = (long)i * G + c; const int total = __builtin_amdgcn_readfirstlane(tab[32]) * 4; if (L >= total) return false; const int q = (int)L >> 2; u.pn = (int)L & 3;
        int e = 0;
#pragma unroll
        for (int k = 1; k < 16; ++k) e += (q >= __builtin_amdgcn_readfirstlane(tab[16 + k])) ? 1 : 0;
        u.z = e; u.pm = q - __builtin_amdgcn_readfirstlane(tab[16 + e]); return true; }
    __device__ __forceinline__ const char* a_base(const Unit& u) const { return (const char*)(ws + WS_ACT) + (size_t)(__builtin_amdgcn_readfirstlane(tab[16 + u.z]) + u.pm) * 128 * 512; }
    __device__ __forceinline__ unsigned a_off(const Unit&, int R, int Cc) const { return (unsigned)(R * 512 + Cc * 2); }
    __device__ __forceinline__ const char* b_base(const Unit& u) const { return (const char*)(ws + WS_MOE2) + ((size_t)u.z * 1024 + u.pn * 256) * 512; }
    __device__ __forceinline__ void epi(const f32x4 (&acc)[2][4][2], f32x4 (&)[2][4][2], const Unit& u, int wr, int wc, int fr, int fq) const {
        const int n = __builtin_amdgcn_readfirstlane(tab[u.z]);
        int entv[4]; float wv[4];
#pragma unroll
        for (int m = 0; m < 4; ++m) { int r = u.pm * 128 + wr * 64 + m * 16 + fr; r = r < n ? r : n - 1; entv[m] = ((const int*)(ws + WS_LIST))[(size_t)u.z * T + r]; }
#pragma unroll
        for (int m = 0; m < 4; ++m) wv[m] = ((const float*)(ws + WS_RW))[entv[m]] * (1.f / 256.f);
#pragma unroll
        for (int m = 0; m < 4; ++m) { const int r = u.pm * 128 + wr * 64 + m * 16 + fr; if (r >= n) continue;
            const int ent = entv[m]; const float w = wv[m];
#pragma unroll
            for (int bj = 0; bj < 2; ++bj)
                *(GAS v4u*)((bf16*)(ws + WS_YSLOT) + (size_t)ent * 1024 + u.pn * 256 + bj * 128 + wc * 32 + 8 * fq) = pack8(acc[bj][m][0] * w, acc[bj][m][1] * w); }
    }
};
struct PMoe1B {
    static constexpr bool EARLY_AOFF = true, FP8 = false; unsigned char* ws; const LAS int* tab; int G, c; int K; unsigned kstepA;
    __device__ __forceinline__ bool next(int i, Unit& u) const { const long L = (long)i * G + c; const int total = tab[32] * 4; if (L >= total) return false; const int q = (int)L >> 2; u.pn = (int)L & 3;
        int e = 0;
#pragma unroll
        for (int k = 1; k < 16; ++k) e += (q >= tab[16 + k]) ? 1 : 0;
        u.z = e; u.pm = q - tab[16 + e]; return true; }
    __device__ __forceinline__ const char* a_base(const Unit&) const { return (const char*)(ws + WS_HB); }
    __device__ __forceinline__ unsigned a_off(const Unit& u, int h, int R, int Cc) const { int r = u.pm * 256 + h * 128 + R; const int n = tab[u.z]; r = r < n ? r : n - 1;
        const int ent = ((const int*)(ws + WS_LIST))[(size_t)u.z * T + r]; return (unsigned)((ent >> 1) * 1024 + Cc) * 2u; }
    __device__ __forceinline__ const char* b_base(const Unit& u) const { return (const char*)(ws + WS_MOE1) + ((size_t)u.z * 1024 + u.pn * 256) * 1024 * 2; }
    __device__ __forceinline__ void epi(const Acc& acc, const Unit& u, int wr, int wc, int fr, int fq) const {
        const size_t arow0 = (size_t)(tab[16 + u.z] + u.pm) * 256;
#pragma unroll
        for (int ai = 0; ai < 2; ++ai)
#pragma unroll
            for (int m = 0; m < 4; ++m) { const f32x4 g0 = acc[ai][0][m][0], g1 = acc[ai][0][m][1], u0 = acc[ai][1][m][0], u1 = acc[ai][1][m][1];
                const f32x4 v0 = (f32x4){g0[0] * fsigmoid(g0[0]), g0[1] * fsigmoid(g0[1]), g0[2] * fsigmoid(g0[2]), g0[3] * fsigmoid(g0[3])} * u0;
                const f32x4 v1 = (f32x4){g1[0] * fsigmoid(g1[0]), g1[1] * fsigmoid(g1[1]), g1[2] * fsigmoid(g1[2]), g1[3] * fsigmoid(g1[3])} * u1;
                *(GAS v4u*)((bf16*)(ws + WS_ACTB) + (arow0 + ai * 128 + wr * 64 + m * 16 + fr) * 512 + u.pn * 128 + wc * 32 + 8 * fq) = pack8(v0, v1); }
    }
};
struct PMoe2B {
    static constexpr bool EARLY_AOFF = false, FP8 = false; unsigned char* ws; const LAS int* tab; int G, c; int K; unsigned kstepA;
    __device__ __forceinline__ bool next(int i, Unit& u) const { const long L = (long)i * G + c; const int total = tab[32] * 4; if (L >= total) return false; const int q = (int)L >> 2; u.pn = (int)L & 3;
        int e = 0;
#pragma unroll
        for (int k = 1; k < 16; ++k) e += (q >= tab[16 + k]) ? 1 : 0;
        u.z = e; u.pm = q - tab[16 + e]; return true; }
    __device__ __forceinline__ const char* a_base(const Unit& u) const { return (const char*)(ws + WS_ACTB) + (size_t)(tab[16 + u.z] + u.pm) * 256 * 512 * 2; }
    __device__ __forceinline__ unsigned a_off(const Unit&, int h, int R, int Cc) const { return (unsigned)((h * 128 + R) * 512 + Cc) * 2u; }
    __device__ __forceinline__ const char* b_base(const Unit& u) const { return (const char*)(ws + WS_MOE2) + ((size_t)u.z * 1024 + u.pn * 256) * 512 * 2; }
    __device__ __forceinline__ void epi(const Acc& acc, const Unit& u, int wr, int wc, int fr, int fq) const {
        const int n = tab[u.z];
#pragma unroll
        for (int ai = 0; ai < 2; ++ai)
#pragma unroll
            for (int m = 0; m < 4; ++m) { const int r = u.pm * 256 + ai * 128 + wr * 64 + m * 16 + fr; if (r >= n) continue;
                const int ent = ((const int*)(ws + WS_LIST))[(size_t)u.z * T + r]; const float w = ((const float*)(ws + WS_RW))[ent];
#pragma unroll
                for (int bj = 0; bj < 2; ++bj)
                    *(GAS v4u*)((bf16*)(ws + WS_YSLOT) + (size_t)ent * 1024 + u.pn * 256 + bj * 128 + wc * 32 + 8 * fq) = pack8(acc[ai][bj][m][0] * w, acc[ai][bj][m][1] * w); }
    }
};
__device__ __forceinline__ void build_exptab(const Ctx& C, LAS int* tab, int l, int tsh = 7) {
    __syncthreads();
    if (threadIdx.x == 0) { int t0 = 0;
        for (int e = 0; e < 16; ++e) { const int n = (int)__hip_atomic_load((unsigned*)(C.ctl + CW_CNT + l * 1024 + 64 * e), RLX_AGENT); tab[e] = n; tab[16 + e] = t0; t0 += (n + (1 << tsh) - 1) >> tsh; }
        tab[32] = t0; }
    __syncthreads();
}
__device__ __forceinline__ void phase_attn(const Ctx& C, int l, unsigned char* lds_gen) {
    phase_carry(C, l);
    char* shm = (char*)lds_gen;
    bf16* QA = WSP(bf16, WS_QA); bf16* KA = WSP(bf16, WS_KA); bf16* VA = WSP(bf16, WS_VA); bf16* QN = WSP(bf16, WS_QN); bf16* KN = WSP(bf16, WS_KN); bf16* VN = WSP(bf16, WS_VN);
#ifndef ATTN_SEL
#define ATTN_SEL 3
#endif
#ifdef REPMASK
#define REPMASK_ REPMASK
#else
#define REPMASK_ 0
#endif
    const int per = (1024 + C.G - 1) / C.G;
    bool nomax; { float gq = 0.f, gk = 0.f; for (int i = 0; i < 64; ++i) { gq = fmaxf(gq, fabsf(C.in[I_QNG][l * 64 + i])); gk = fmaxf(gk, fabsf(C.in[I_KNG][l * 64 + i])); } nomax = 64.f * gq * gk * C2 <= 60.f; }
    if (ATTN_SEL & 1) for (int i = 0; i < per * (1 + ((REPMASK_ >> 13) & 1)); ++i) { const int id = C.vcu * per + (i % per); if (id >= 1024) continue; const int bh = id >> 5, b = bh >> 3, h = bh & 7, qb = id & 31;
        const bf16* Qu = QA + (size_t)(b * LB + CTX + qb * 256) * 512 + h * 64;
        if (nomax) attn_body::attn_unit<8, false, 512, 128, true>(Qu, 512, KA + (size_t)(b * LB) * 128 + (h >> 2) * 64, VA + (size_t)(b * LB) * 128 + (h >> 2) * 64, 128, WSP(bf16, WS_AO) + (Qu - QA), LB / 64, 0, 0, shm);
        else attn_body::attn_unit<8, false, 512, 128, false>(Qu, 512, KA + (size_t)(b * LB) * 128 + (h >> 2) * 64, VA + (size_t)(b * LB) * 128 + (h >> 2) * 64, 128, WSP(bf16, WS_AO) + (Qu - QA), LB / 64, 0, 0, shm);
    }
    LAS float* bt = (LAS float*)(C.lds + attn_body::LDS_BT);
    const int nctx = (C.vcu >= 64 && C.vcu < 128) ? 1 : 0;
    if (ATTN_SEL & 2) for (int i0 = 0; i0 < (per + nctx) * (1 + ((REPMASK_ >> 14) & 1)); ++i0) { const int i = i0 % (per + nctx);
        const bf16 *Qu, *Kh, *Vh; bf16* Ou; int kvp = 512, NT = 4, r0 = 0, rlo = 0;
        if (i < per) { const int id = C.vcu * per + i; if (id >= 1024) continue; const int bh = id >> 5, b = bh >> 3, h = bh & 7; r0 = (id & 31) * 4;
            const float* rp = C.in[I_RPB] + (size_t)(l * 8 + h) * 465;
            for (int k = C.tid; k < 465; k += 512) bt[k] = rp[k] * LOG2E;
            rlo = r0 - 4 < 0 ? 0 : (r0 - 4 > 120 ? 120 : r0 - 4); const int rh_ = r0 - 1 < 0 ? 0 : (r0 - 1 > 120 ? 120 : r0 - 1), nloc = rh_ + 8 - rlo; NT = (4 + nloc + 1) & ~1;
            Qu = QN + (size_t)(b * LB + CTX + r0 * 64) * 512 + h * 64; Ou = WSP(bf16, WS_NO) + (Qu - QN); Kh = KN + (size_t)(b * LB) * 512 + h * 64; Vh = VN + (size_t)(b * LB) * 512 + h * 64; }
        else { int j = C.vcu - 64; if (j < 32) { const int b = j >> 3, h = j & 7; Qu = QA + (size_t)(b * LB) * 512 + h * 64; Ou = WSP(bf16, WS_AO) + (Qu - QA); Kh = KA + (size_t)(b * LB) * 128 + (h >> 2) * 64; Vh = VA + (size_t)(b * LB) * 128 + (h >> 2) * 64; kvp = 128; }
            else { j -= 32; const int b = j >> 3, h = j & 7; Qu = QN + (size_t)(b * LB) * 512 + h * 64; Ou = WSP(bf16, WS_NO) + (Qu - QN); Kh = KN + (size_t)(b * LB) * 512 + h * 64; Vh = VN + (size_t)(b * LB) * 512 + h * 64; } }
        attn_body::attn_unit<8, true, 512, 0>(Qu, 512, Kh, Vh, kvp, Ou, NT, r0, rlo, shm);
    }
}

constexpr int NPH = 46;
__global__ void __launch_bounds__(NWAVES * 64, 2) fwd(Args args) {
    extern __shared__ __attribute__((aligned(16))) unsigned char lds[];
    Ctx C; C.in = (const __attribute__((address_space(4))) CFP*)__builtin_amdgcn_kernarg_segment_ptr(); C.out = args.out; C.ws = args.ws; C.lds = (LAS unsigned char*)lds; C.ctl = (gu32*)(args.ws + WS_CTL);
    C.tid = 0; C.lane = 0; C.wave = __builtin_amdgcn_readfirstlane((int)threadIdx.x >> 6);
    C.G = gridDim.x; { const int bx = blockIdx.x; C.vcu = (C.G % 8 == 0) ? (bx % 8) * (C.G / 8) + bx / 8 : bx; }
    for (int u = threadIdx.x; u < (LDS_BYTES - LDSCTL_OFF) / 4; u += NWAVES * 64) ((LAS unsigned*)(C.lds + LDSCTL_OFF))[u] = 0u;
    __syncthreads();
    const int lo = args.ph_lo, hi = args.ph_hi;
    XcdBarrier bar; bar.bar = (unsigned*)(C.ctl + CW_BAR); bar.x = 0; bar.st = nullptr;
    if (hi - lo > 1) bar = xcd_barrier_post((unsigned*)(C.ctl + CW_BAR), (volatile LAS unsigned*)(C.lds + MISC_OFF) + 8);
    LAS int* tab = (LAS int*)(C.lds + LDSCTL_OFF);
    const int cg = (int)blockIdx.x;
#ifndef PHMASK
#define PHMASK 0xFFFF
#endif
#define IN(k) (lo <= (k) && (k) < hi)
#define EN(b) ((PHMASK >> (b)) & 1)
#ifndef REPMASK
#define REPMASK 0
#endif
#define RUN(b, stmt) do { stmt; if ((REPMASK >> (b)) & 1) { stmt; } } while (0)
#ifdef DIAG_SEL
#define DIAG_ACC(ty) do { if (blockIdx.x == 0 && threadIdx.x == 0) { volatile LAS unsigned* dg = (volatile LAS unsigned*)(C.lds + LDSCTL_OFF + 160); const unsigned now = (unsigned)__builtin_amdgcn_s_memrealtime(); dg[8 + (ty)] += now - dg[0]; dg[0] = now; } } while (0)
#else
#define DIAG_ACC(ty) do {} while (0)
#endif
#define SEAM(k) do { if (IN(k) && IN((k) + 1)) xcd_barrier(bar); DIAG_ACC((k) == 0 ? 11 : ((k) - 1) % 11); } while (0)
#define LWS() ({ const __attribute__((address_space(4))) CFP* k_ = C.in; asm volatile("" : "+s"(k_)); (unsigned char*)k_[30]; })
#define LC() ({ Ctx c_ = C; c_.tid = threadIdx.x; asm volatile("" : "+v"(c_.tid)); c_.lane = c_.tid & 63; asm volatile("" : "+s"(c_.in)); c_.ws = (unsigned char*)c_.in[30]; c_.out = (float*)c_.in[29]; c_.ctl = (gu32*)(c_.ws + WS_CTL); c_; })
#ifdef DIAG_SEL
    if (blockIdx.x == 0 && threadIdx.x == 0) { volatile LAS unsigned* dg = (volatile LAS unsigned*)(C.lds + LDSCTL_OFF + 160); dg[0] = (unsigned)__builtin_amdgcn_s_memrealtime(); dg[1] = dg[0]; }
#endif
    if (EN(11) && IN(0)) { const Ctx Cl = LC(); phase_mod(Cl); RUN(11, phase_s5mats(Cl, 0, Cl.vcu); phase_weights(Cl, 0)); }
    SEAM(0);
    for (int l = 0; l < NLAYER; ++l) {
        const int pb = 1 + 11 * l;
        if (EN(0) && IN(pb)) { const Ctx Cl = LC(); if (l == 0) phase_rows<0>(Cl, 0); else { phase_weights(Cl, l); phase_rows<1>(Cl, l); } }
        SEAM(pb);
        if (EN(1) && IN(pb + 1)) { if (W8_ALL) { PWin8 P{LWS(), C.G, cg, 1024, 128u}; pg8::gemm_phase_m128(C.lds, P); } else { { PWin P{LWS(), C.G, cg, 1024, 128u}; pg8::gemm_phase(C.lds, P); } { PGate P{LWS(), C.G, cg, 1024, 128u}; pg8::gemm_phase_m128(C.lds, P); } } }
        SEAM(pb + 1);
        if (EN(2) && IN(pb + 2)) { { const Ctx Cl = LC(); phase_qkprep(Cl, l); } PS5A P{LWS(), C.G, cg, 512, 128u}; RUN(2, pg8::gemm_phase(C.lds, P)); }
        SEAM(pb + 2);
        if (EN(3) && IN(pb + 3)) { const Ctx Cl = LC(); RUN(3, phase_attn(Cl, l, lds)); }
        SEAM(pb + 3);
        if (EN(4) && IN(pb + 4)) { PS5B P{LWS(), C.G, cg, 256, 128u}; pg8::gemm_phase(C.lds, P); }
        SEAM(pb + 4);
        if (EN(5) && IN(pb + 5)) { PGlu P{LWS(), C.G, cg, 512, 128u, l == NLAYER - 1}; pg8::gemm_phase_m128(C.lds, P); }
        SEAM(pb + 5);
        if (EN(6) && IN(pb + 6)) { { PMerge P{LWS(), C.G, cg, 512, 128u, l == NLAYER - 1}; pg8::gemm_phase_m128(C.lds, P); }
            if (l < NLAYER - 1) { const Ctx Cl = LC(); phase_s5mats(Cl, l + 1, C.G >= 160 ? cg - 32 : cg); } }
        SEAM(pb + 6);
        if (EN(7) && IN(pb + 7)) { unsigned char* wl_ = LWS(); PWout P{wl_, (float*)C.in[29], (const float*)(wl_ + WS_MOD) + (size_t)l * 5 * 6144, C.G, cg, 1024, 128u, l == NLAYER - 1}; pg8::gemm_phase_m128(C.lds, P); }
        SEAM(pb + 7);
        if (EN(8) && IN(pb + 8)) { const Ctx Cl = LC(); phase_norm2(Cl, l); }
        SEAM(pb + 8);
        if (EN(9) && IN(pb + 9)) { if (FP8_MOE) { build_exptab(C, tab, l); PMoe1 P{LWS(), tab, C.G, cg, 1024, 128u}; pg8::gemm_phase_m128(C.lds, P); } else { build_exptab(C, tab, l, 8); PMoe1B P{LWS(), tab, C.G, cg, 1024, 128u}; pg8::gemm_phase(C.lds, P); } }
        SEAM(pb + 9);
        if (EN(10) && IN(pb + 10)) { if (FP8_MOE) { build_exptab(C, tab, l); PMoe2 P{LWS(), tab, C.G, cg, 512, 128u}; pg8::gemm_phase_m128(C.lds, P); } else { build_exptab(C, tab, l, 8); PMoe2B P{LWS(), tab, C.G, cg, 512, 128u}; pg8::gemm_phase(C.lds, P); } }
        SEAM(pb + 10);
    }
    if (EN(12) && IN(NPH - 1)) { const Ctx Cl = LC(); phase_rows<2>(Cl, NLAYER); }
#ifdef DIAG_SEL
    xcd_barrier(bar); DIAG_ACC(12);
    if (blockIdx.x == 0 && threadIdx.x == 0) { volatile LAS unsigned* dg = (volatile LAS unsigned*)(C.lds + LDSCTL_OFF + 160); dg[8 + 13] = dg[0] - dg[1];
        for (int i = 0; i < 14; ++i) __hip_atomic_store(C.ctl + 2048 + i, dg[8 + i], RLX_AGENT); }
    xcd_barrier(bar);
    { const float d1 = (float)__hip_atomic_load(C.ctl + 2048 + (DIAG_SEL), RLX_AGENT) * 0.01f, d2 = (float)__hip_atomic_load(C.ctl + 2048 + (DIAG_SEL) + 1, RLX_AGENT) * 0.01f;
      const float c1 = sqrtf(d1); float* o = args.out;
      for (size_t i = (size_t)blockIdx.x * 512 + threadIdx.x; i < (size_t)NB * SEQ * D; i += (size_t)gridDim.x * 512) o[i] = (i == 12345) ? d2 : c1; }
#endif
#undef IN
#undef SEAM
}

#ifndef MK_PER_PHASE
#define MK_PER_PHASE 0
#endif
extern "C" void kernel_launch(void* const* d_in, const int* in_sizes, int n_in, void* d_out, int out_size, void* d_ws, size_t ws_size, hipStream_t stream) {
    static int grid = 0;
    if (grid == 0) {
        if (n_in != 29 || out_size != NB * SEQ * D || ws_size < WS_END) { fprintf(stderr, "kernel_launch: unexpected shapes (n_in %d out %d ws %zu)\n", n_in, out_size, ws_size); grid = -1; return; }
        int dev = 0, cus = 0, per_cu = 0;
        if (hipGetDevice(&dev) != hipSuccess || hipDeviceGetAttribute(&cus, hipDeviceAttributeMultiprocessorCount, dev) != hipSuccess) { grid = -1; return; }
        if (hipFuncSetAttribute((const void*)fwd, hipFuncAttributeMaxDynamicSharedMemorySize, LDS_BYTES) != hipSuccess) { grid = -1; return; }
        if (hipOccupancyMaxActiveBlocksPerMultiprocessor(&per_cu, (const void*)fwd, NWAVES * 64, LDS_BYTES) != hipSuccess || per_cu < 1) fprintf(stderr, "kernel_launch: occupancy query says %d\n", per_cu);
        (void)hipGetLastError();
        grid = cus;
    }
    if (grid < 0) return;
    (void)hipMemsetAsync((char*)d_ws + WS_CTL, 0, CTL_ZERO_BYTES, stream);
    Args a{};
    for (int i = 0; i < 29; ++i) a.in[i] = (const float*)d_in[i];
    a.out = (float*)d_out; a.ws = (unsigned char*)d_ws;
#if MK_PER_PHASE
    for (int p = 0; p < NPH; ++p) { a.ph_lo = p; a.ph_hi = p + 1; hipLaunchKernelGGL(fwd, dim3(grid), dim3(NWAVES * 64), LDS_BYTES, stream, a); }
#else
    a.ph_lo = 0; a.ph_hi = NPH; hipLaunchKernelGGL(fwd, dim3(grid), dim3(NWAVES * 64), LDS_BYTES, stream, a);
#endif
}
```

```cpp
#define FP8_MOE 1
#define GATE_BF16 0
#define W8_ALL 1
#define H8_WRITE 1
#ifndef H8_WRITE
#define H8_WRITE 1
#endif
#ifndef GATE_BF16
#define GATE_BF16 0
#endif
#include <hip/hip_runtime.h>
#include <cstdio>
#include <cstdint>

#define GAS __attribute__((address_space(1)))
#define LAS __attribute__((address_space(3)))
typedef unsigned short bf16;
typedef unsigned v4u __attribute__((ext_vector_type(4)));
typedef unsigned v2u __attribute__((ext_vector_type(2)));
typedef float f32x4 __attribute__((ext_vector_type(4)));
typedef float f32x2 __attribute__((ext_vector_type(2)));
typedef float f32x16 __attribute__((ext_vector_type(16)));
typedef short bf16x8 __attribute__((ext_vector_type(8)));
typedef short s16x4 __attribute__((ext_vector_type(4)));
typedef GAS unsigned gu32;
#define RLX_AGENT __ATOMIC_RELAXED, __HIP_MEMORY_SCOPE_AGENT
#define LDS_WAIT() asm volatile("s_waitcnt lgkmcnt(0)" ::: "memory")
#define VM_WAIT() asm volatile("s_waitcnt vmcnt(0)" ::: "memory")

constexpr int NB = 4, SEQ = 8192, CTX = 256, LB = SEQ + CTX, T = NB * LB, D = 1024, NPAN = T / 256;
constexpr int NLAYER = 4, INW = 5888, NCH = LB / 32, NCR = NB * NCH;
constexpr int NEXP = 16, FF = 512;
constexpr float EPS = 1e-6f;
constexpr float LOG2E = 1.4426950408889634f;
constexpr float C2 = 0.125f * LOG2E;
constexpr int NWAVES = 8;

constexpr size_t MiB = 1u << 20;
constexpr size_t WS_CTL = 0, CTL_ZERO_BYTES = 1 * MiB;
constexpr size_t WS_MOD = 1 * MiB;
constexpr size_t WS_LIST = 2 * MiB;
constexpr size_t WS_RW = 5 * MiB;
constexpr size_t WS_CTXS = 6 * MiB;
constexpr size_t WS_SST = 10 * MiB;
constexpr size_t WS_HB8 = WS_SST;
constexpr size_t WS_XST = 44 * MiB;
constexpr size_t WS_BT1 = 61 * MiB;
constexpr size_t WS_BT2 = 85 * MiB;
constexpr size_t WS_WIN = 93 * MiB;
constexpr size_t WS_WIN8 = WS_WIN + (size_t)2816 * 1024 * 2;
constexpr size_t WS_WGLU = 105 * MiB;
constexpr size_t WS_WBR = 106 * MiB;
constexpr size_t WS_WOUT = 109 * MiB;
constexpr size_t WS_MOE1 = 111 * MiB;
constexpr size_t WS_MOE2 = 143 * MiB;
constexpr size_t WS_HB = 159 * MiB;
constexpr size_t WS_U = 225 * MiB;
constexpr size_t WS_QA = 258 * MiB;
constexpr size_t WS_KA = 291 * MiB;
constexpr size_t WS_VA = 300 * MiB;
constexpr size_t WS_QN = 309 * MiB;
constexpr size_t WS_KN = 342 * MiB;
constexpr size_t WS_VN = 375 * MiB;
constexpr size_t WS_YS = 408 * MiB;
constexpr size_t WS_GATES = 441 * MiB;
constexpr size_t WS_ACT = WS_QN;
constexpr size_t WS_ACTB = WS_QN;
constexpr size_t WS_YSLOT = WS_GATES;
constexpr size_t WS_AO = 574 * MiB;
constexpr size_t WS_NO = 607 * MiB;
constexpr size_t WS_YG = 640 * MiB;
constexpr size_t WS_XS = 673 * MiB;
constexpr size_t WS_END = 739 * MiB;
static_assert(WS_GATES + (size_t)T * 3072 * (GATE_BF16 ? 2 : 1) <= WS_AO && WS_YSLOT + (size_t)2 * T * 1024 * 2 <= WS_AO && WS_ACT + (size_t)(2 * T + 4096) * 512 * 2 <= WS_YS, "ws map");
constexpr int CW_FAIL = 8;
constexpr int CW_CNT = 64;
constexpr int CW_BAR = 8192;

constexpr int RING_BYTES = 131072, LDS_BYTES = 147456, LDSCTL_OFF = LDS_BYTES - 512, MISC_OFF = LDSCTL_OFF + 320;

__device__ __forceinline__ unsigned f2bf(float f) { unsigned u = __builtin_bit_cast(unsigned, f); return (u + 0x7fffu + ((u >> 16) & 1u)) >> 16; }
__device__ __forceinline__ unsigned pk2(float lo, float hi) { return f2bf(lo) | (f2bf(hi) << 16); }
__device__ __forceinline__ float bf2f(unsigned b) { return __builtin_bit_cast(float, b << 16); }
__device__ __forceinline__ float bflo(unsigned w) { return __builtin_bit_cast(float, w << 16); }
__device__ __forceinline__ float bfhi(unsigned w) { return __builtin_bit_cast(float, w & 0xffff0000u); }
typedef float f32x2_c __attribute__((ext_vector_type(2))); typedef __bf16 bf16x2_c __attribute__((ext_vector_type(2)));
__device__ __forceinline__ unsigned cvt_pk_bf16(float lo, float hi) { const f32x2_c v = {lo, hi}; return __builtin_bit_cast(unsigned, __builtin_convertvector(v, bf16x2_c)); }
typedef int v8i __attribute__((ext_vector_type(8)));
typedef int v4i __attribute__((ext_vector_type(4)));
__device__ __forceinline__ float clamp8(float x) { return __builtin_fminf(__builtin_fmaxf(x, -448.f), 448.f); }
__device__ __forceinline__ unsigned pk4_fp8(float a, float b, float c, float d) { int w = 0; w = __builtin_amdgcn_cvt_pk_fp8_f32(clamp8(a), clamp8(b), w, false); w = __builtin_amdgcn_cvt_pk_fp8_f32(clamp8(c), clamp8(d), w, true); return (unsigned)w; }
__device__ __forceinline__ float fsigmoid(float x) { return __builtin_amdgcn_rcpf(1.f + __builtin_amdgcn_exp2f(-LOG2E * x)); }
__device__ __forceinline__ float gelu_tanh(float x) { const float u = 0.7978845608f * (x + 0.044715f * x * x * x); return x * __builtin_amdgcn_rcpf(1.f + __builtin_amdgcn_exp2f(-2.f * LOG2E * u)); }
__device__ __forceinline__ float shflx(float v, int m, int lane) { return __builtin_bit_cast(float, __builtin_amdgcn_ds_bpermute((lane ^ m) << 2, __builtin_bit_cast(int, v))); }
template <int CTRL, int RM>
__device__ __forceinline__ float dpp_mov(float v) { return __builtin_bit_cast(float, __builtin_amdgcn_update_dpp(0, __builtin_bit_cast(int, v), CTRL, RM, 0xF, true)); }
__device__ __forceinline__ float wave_sum(float v, int) {
    v += dpp_mov<0xB1, 0xF>(v);
    v += dpp_mov<0x4E, 0xF>(v);
    v += dpp_mov<0x141, 0xF>(v);
    v += dpp_mov<0x140, 0xF>(v);
    v += dpp_mov<0x142, 0xA>(v);
    v += dpp_mov<0x143, 0xC>(v);
    return __builtin_bit_cast(float, __builtin_amdgcn_readlane(__builtin_bit_cast(int, v), 63));
}
__device__ __forceinline__ float sin_rev(float r) { r = r - floorf(r); return __builtin_amdgcn_sinf(r); }
__device__ __forceinline__ float cos_rev(float r) { r = r - floorf(r); return __builtin_amdgcn_cosf(r); }

#define XB_TMO      128
#define XB_XCNT(j)  (256  + 64 * (j))
#define XB_XSUB(j)  (1280 + 64 * (j))
#define XB_XGEN(j)  (2304 + 64 * (j))
#define XB_TOP      3328
#define XB_TOPGEN   3392
#define XCD_BAR_WORDS 3456
#define XB_SPIN_CAP (1u << 22)

__device__ __forceinline__ unsigned xb_ld(unsigned* p)              { return __hip_atomic_load(p, __ATOMIC_RELAXED, __HIP_MEMORY_SCOPE_AGENT); }
__device__ __forceinline__ unsigned xb_add(unsigned* p, unsigned v) { return __hip_atomic_fetch_add(p, v, __ATOMIC_RELAXED, __HIP_MEMORY_SCOPE_AGENT); }
__device__ __forceinline__ unsigned xb_xcc_id() { return (unsigned)__builtin_amdgcn_s_getreg((3 << 11) | 20) & 0xFu; }
#define XB_SPIN(cond, bar) do { unsigned _sp = 0; while (cond) { __builtin_amdgcn_s_sleep(1); \
    if ((++_sp & 255u) == 0u) { if (xb_ld(&(bar)[XB_TMO])) break; if (_sp > XB_SPIN_CAP) { atomicAdd(&(bar)[XB_TMO], 1u); break; } } } } while (0)

struct XcdBarrier { unsigned* bar; unsigned x; volatile LAS unsigned* st; };

__device__ __forceinline__ XcdBarrier xcd_barrier_post(unsigned* bar, volatile LAS unsigned* st) {
    XcdBarrier b; b.bar = bar; b.x = xb_xcc_id(); b.st = st;
    if (threadIdx.x == 0) (void)xb_add(&bar[XB_XCNT(b.x)], 1u);
    return b;
}
__device__ __forceinline__ void xcd_barrier_complete(unsigned* bar, unsigned x, unsigned& nloc, unsigned& nx) {
    const unsigned G = gridDim.x * gridDim.y * gridDim.z;
    unsigned sum, cnt, mine, sp = 0u;
    for (;;) {
        sum = 0u; cnt = 0u; mine = 0u;
#pragma unroll
        for (unsigned j = 0; j < 16; ++j) { const unsigned c = xb_ld(&bar[XB_XCNT(j)]); sum += c; cnt += (c > 0u) ? 1u : 0u; mine = (j == x) ? c : mine; }
        if (sum == G) break;
        __builtin_amdgcn_s_sleep(1);
        if ((++sp & 255u) == 0u) { if (xb_ld(&bar[XB_TMO])) break; if (sp > XB_SPIN_CAP) { atomicAdd(&bar[XB_TMO], 1u); break; } }
    }
    nloc = mine > 0u ? mine : 1u; nx = cnt > 0u ? cnt : 1u;
}
__device__ __forceinline__ void xcd_barrier(const XcdBarrier& b) {
    asm volatile("s_waitcnt vmcnt(0)" ::: "memory");
    __syncthreads();
    if (threadIdx.x == 0) {
        unsigned* bar = b.bar;
        __builtin_amdgcn_s_waitcnt(0);
        unsigned nloc = b.st[0], nx = b.st[1];
        if (nloc == 0u) { xcd_barrier_complete(bar, b.x, nloc, nx); b.st[0] = nloc; b.st[1] = nx; }
        const unsigned old = xb_add(&bar[XB_XSUB(b.x)], 1u);
        const unsigned gen = old / nloc;
        if (old + 1u == (gen + 1u) * nloc) {
            __builtin_amdgcn_fence(__ATOMIC_RELEASE, "agent");
            asm volatile("s_waitcnt vmcnt(0)" ::: "memory");
            const unsigned og = xb_add(&bar[XB_TOP], 1u);
            const unsigned tg = og / nx;
            if (og + 1u == (tg + 1u) * nx) xb_add(&bar[XB_TOPGEN], 1u);
            else XB_SPIN(xb_ld(&bar[XB_TOPGEN]) == tg, bar);
            __builtin_amdgcn_fence(__ATOMIC_ACQUIRE, "agent");
            xb_add(&bar[XB_XGEN(b.x)], 1u);
            asm volatile("s_waitcnt vmcnt(0)" ::: "memory");
        } else {
            XB_SPIN(xb_ld(&bar[XB_XGEN(b.x)]) == gen, bar);
            __builtin_amdgcn_fence(__ATOMIC_ACQUIRE, "agent");
            asm volatile("s_waitcnt vmcnt(0)" ::: "memory");
        }
    }
    __syncthreads();
}

namespace pg8 {
constexpr int BM = 256, BK = 64, HALF = 128, HTB = HALF * BK * 2, STAGE_BYTES = 8 * HTB, NXCD = 8, WGM = 8;
__host__ __device__ __forceinline__ int lds_byte(int r, int c) { const int st = (r >> 4) * 2 + (c >> 5), rr = r & 15, cc = c & 31, ob = rr * 64 + cc * 2; return st * 1024 + (ob ^ (((ob >> 9) & 1) << 5)); }
__host__ __device__ __forceinline__ void stage_rc(int b, int& R, int& C) { const int st = b / 1024, sb = b % 1024, swz = sb ^ (((sb >> 9) & 1) << 5); R = (st >> 1) * 16 + swz / 64; C = (st & 1) * 32 + (swz % 64) / 2; }
__host__ __device__ __forceinline__ int perm32(int rho) { const int n = rho >> 4, i = rho & 15; return 8 * (i >> 2) + 4 * n + (i & 3); }

struct Unit { int pm, pn, z; };

__device__ __forceinline__ void static_decode(int L, int nM, int nN, int& pm, int& pn) {
    const int nwg = nM * nN; int wgid = L;
    { const int q = nwg / NXCD, r = nwg % NXCD, xcd = wgid % NXCD, off = wgid / NXCD; wgid = (xcd < r ? xcd * (q + 1) : r * (q + 1) + (xcd - r) * q) + off; }
    const int nig = WGM * nN, gid = wgid / nig, fm = gid * WGM, gsz = (nM - fm) < WGM ? (nM - fm) : WGM;
    pm = fm + ((wgid % nig) % gsz); pn = (wgid % nig) / gsz;
}

template <class P>
__device__ __forceinline__ void gemm_phase(LAS unsigned char* lds, const P& S) {
    int tid_ = threadIdx.x; asm volatile("" : "+v"(tid_));
    const int tid = tid_, wid = __builtin_amdgcn_readfirstlane(tid >> 6), lane = tid & 63, wr = wid >> 2, wc = wid & 3, fr = lane & 15, fq = lane >> 4;
    constexpr int ELB = P::FP8 ? 1 : 2;
    const int K = S.K; int nt = K * ELB / 128; asm volatile("" : "+s"(nt));
    unsigned voffB[2];
#pragma unroll
    for (int i = 0; i < 2; ++i) { int R, C; stage_rc(tid * 16 + i * 8192, R, C); const int Rb = (R & ~31) + perm32(R & 31); voffB[i] = (unsigned)(Rb * K * ELB + C * 2); }
#define PG8_AOFF(dst0, dst1, u) do { _Pragma("unroll") for (int i = 0; i < 2; ++i) { int R, C; stage_rc(tid * 16 + i * 8192, R, C); dst0[i] = S.a_off(u, 0, R, C); dst1[i] = S.a_off(u, 1, R, C); } } while (0)
    const size_t kstepB = (size_t)(BK * 2), hstepB = (size_t)HALF * K * ELB, kstepA = (size_t)S.kstepA;
    const unsigned ldsw = (unsigned)wid * 1024u;
    const int aoff = lds_byte(wr * 64 + fr, fq * 8), boff = lds_byte(wc * 32 + fr, fq * 8);
#define PG8_SA(b, h) (((b) * 2 + (h)) * HTB)
#define PG8_SB(b, h) ((4 + (b) * 2 + (h)) * HTB)
#define PG8_STAGE(bufoff, gbase, voff) do { _Pragma("unroll") for (int _i = 0; _i < 2; ++_i) \
        __builtin_amdgcn_global_load_lds((const unsigned*)((const char*)(gbase) + (voff)[_i]), (LAS unsigned*)(lds + (bufoff) + ldsw + _i * 8192), 16, 0, 0); } while (0)
#define PG8_LDA(dst, b, h) do { _Pragma("unroll") for (int m = 0; m < 4; ++m) _Pragma("unroll") for (int k = 0; k < 2; ++k) dst[m][k] = *(const LAS bf16x8*)(lds + PG8_SA(b, h) + aoff + m * 2048 + k * 1024); } while (0)
#define PG8_LDB(dst, b, h) do { _Pragma("unroll") for (int n = 0; n < 2; ++n) _Pragma("unroll") for (int k = 0; k < 2; ++k) dst[n][k] = *(const LAS bf16x8*)(lds + PG8_SB(b, h) + boff + n * 2048 + k * 1024); } while (0)
#define PG8_CAT(x0, x1) __builtin_shufflevector(__builtin_bit_cast(v4i, x0), __builtin_bit_cast(v4i, x1), 0, 1, 2, 3, 4, 5, 6, 7)
#define PG8_MMA(ai, bj, At, Bt) do { __builtin_amdgcn_s_setprio(1); _Pragma("unroll") for (int m = 0; m < 4; ++m) _Pragma("unroll") for (int n = 0; n < 2; ++n) { \
        if constexpr (P::FP8) acc[ai][bj][m][n] = __builtin_amdgcn_mfma_scale_f32_16x16x128_f8f6f4(PG8_CAT(Bt[n][0], Bt[n][1]), PG8_CAT(At[m][0], At[m][1]), acc[ai][bj][m][n], 0, 0, 0, 0x7f7f7f7f, 0, 0x7f7f7f7f); \
        else { _Pragma("unroll") for (int k = 0; k < 2; ++k) acc[ai][bj][m][n] = __builtin_amdgcn_mfma_f32_16x16x32_bf16(Bt[n][k], At[m][k], acc[ai][bj][m][n], 0, 0, 0); } } __builtin_amdgcn_s_setprio(0); } while (0)
#define PG8_WAIT_V(n) asm volatile("s_waitcnt vmcnt(" #n ")" ::: "memory")
#define PG8_WAIT_L(n) asm volatile("s_waitcnt lgkmcnt(" #n ")" ::: "memory")
#define PG8_BAR __builtin_amdgcn_s_barrier()
#define PG8_SCHED __builtin_amdgcn_sched_barrier(0)
    Unit cur, nxt; int ui = 0;
    if (!S.next(0, cur)) return;
    f32x4 acc[2][2][4][2];
#pragma unroll
    for (int a = 0; a < 2; ++a)
#pragma unroll
        for (int b = 0; b < 2; ++b)
#pragma unroll
            for (int m = 0; m < 4; ++m)
#pragma unroll
                for (int n = 0; n < 2; ++n) acc[a][b][m][n] = (f32x4){0.f, 0.f, 0.f, 0.f};
    bf16x8 At[4][2], B0[2][2], B1[2][2];
    unsigned vA0[2], vA1[2], vN0[2], vN1[2];
    PG8_AOFF(vA0, vA1, cur);
    const char* cA = S.a_base(cur); const char* cB = S.b_base(cur);
    PG8_STAGE(PG8_SB(0, 0), cB, voffB); PG8_STAGE(PG8_SB(0, 1), cB + hstepB, voffB); PG8_STAGE(PG8_SA(0, 0), cA, vA0); PG8_STAGE(PG8_SA(0, 1), cA, vA1);
    if (wr == 1) PG8_BAR;
    PG8_WAIT_V(2); PG8_BAR;
    PG8_STAGE(PG8_SB(1, 0), cB + kstepB, voffB); PG8_STAGE(PG8_SA(1, 0), cA + kstepA, vA0); PG8_STAGE(PG8_SB(1, 1), cB + hstepB + kstepB, voffB);
    PG8_WAIT_V(6); PG8_BAR;
    for (;;) {
        const bool has_next = S.next(ui + 1, nxt);
        const char* nA = cA; const char* nB = cB;
        if (has_next) { nA = S.a_base(nxt); nB = S.b_base(nxt); if (P::EARLY_AOFF) PG8_AOFF(vN0, vN1, nxt); }
        for (int t = 0; t < nt; t += 2) {
            const bool last = (t == nt - 2);
            const char* a1 = cA + (size_t)(t + 1) * kstepA;
            const char* a2 = last ? nA : cA + (size_t)(t + 2) * kstepA; const char* b2 = last ? nB : cB + (size_t)(t + 2) * kstepB;
            const char* a3 = a2 + kstepA; const char* b3 = b2 + kstepB;
            PG8_LDB(B0, 0, 0); PG8_LDB(B1, 0, 1); PG8_SCHED; PG8_LDA(At, 0, 0); PG8_STAGE(PG8_SA(1, 1), a1, vA1);
            if (last && has_next) {
                if (P::EARLY_AOFF) { _Pragma("unroll") for (int i = 0; i < 2; ++i) { vA0[i] = vN0[i]; vA1[i] = vN1[i]; } } else PG8_AOFF(vA0, vA1, nxt); }
            PG8_WAIT_V(8); PG8_WAIT_L(0); PG8_BAR; PG8_MMA(0, 0, At, B0); PG8_MMA(0, 1, At, B1); PG8_BAR; PG8_SCHED;
            PG8_LDA(At, 0, 1); PG8_STAGE(PG8_SB(0, 0), b2, voffB); PG8_STAGE(PG8_SB(0, 1), b2 + hstepB, voffB); PG8_STAGE(PG8_SA(0, 0), a2, vA0);
            PG8_WAIT_V(8); PG8_WAIT_L(0); PG8_BAR; PG8_MMA(1, 0, At, B0); PG8_MMA(1, 1, At, B1); PG8_BAR; PG8_SCHED;
            PG8_LDB(B0, 1, 0); PG8_LDB(B1, 1, 1); PG8_SCHED; PG8_LDA(At, 1, 0); PG8_STAGE(PG8_SA(0, 1), a2, vA1);
            PG8_WAIT_V(8); PG8_WAIT_L(0); PG8_BAR; PG8_MMA(0, 0, At, B0); PG8_MMA(0, 1, At, B1); PG8_BAR; PG8_SCHED;
            PG8_LDA(At, 1, 1); PG8_STAGE(PG8_SB(1, 0), b3, voffB); PG8_STAGE(PG8_SB(1, 1), b3 + hstepB, voffB); PG8_STAGE(PG8_SA(1, 0), a3, vA0);
            PG8_WAIT_V(8); PG8_WAIT_L(0); PG8_BAR; PG8_MMA(1, 0, At, B0); PG8_MMA(1, 1, At, B1); PG8_BAR; PG8_SCHED;
        }
        if (wr == 0) PG8_BAR;
        S.epi(acc, cur, wr, wc, fr, fq);
        if (!has_next) break;
#pragma unroll
        for (int a = 0; a < 2; ++a)
#pragma unroll
            for (int b = 0; b < 2; ++b)
#pragma unroll
                for (int m = 0; m < 4; ++m)
#pragma unroll
                    for (int n = 0; n < 2; ++n) acc[a][b][m][n] = (f32x4){0.f, 0.f, 0.f, 0.f};
        cur = nxt; cA = nA; cB = nB; ++ui;
        if (wr == 1) PG8_BAR;
    }
    PG8_WAIT_V(0);
    PG8_BAR;
#undef PG8_AOFF
#undef PG8_SA
#undef PG8_SB
#undef PG8_STAGE
#undef PG8_LDA
#undef PG8_LDB
#undef PG8_MMA
#undef PG8_CAT
#undef PG8_WAIT_V
#undef PG8_WAIT_L
#undef PG8_BAR
#undef PG8_SCHED
}

template <class P>
__device__ __forceinline__ void gemm_phase_m128(LAS unsigned char* lds, const P& S) {
    int tid_ = threadIdx.x; asm volatile("" : "+v"(tid_));
    const int tid = tid_, wid = __builtin_amdgcn_readfirstlane(tid >> 6), lane = tid & 63, wr = wid >> 2, wc = wid & 3, fr = lane & 15, fq = lane >> 4;
    constexpr int ELB = P::FP8 ? 1 : 2;
    const int K = S.K; int nt = K * ELB / 128; asm volatile("" : "+s"(nt));
    unsigned voffB[2];
#pragma unroll
    for (int i = 0; i < 2; ++i) { int R, C; stage_rc(tid * 16 + i * 8192, R, C); const int Rb = (R & ~31) + perm32(R & 31); voffB[i] = (unsigned)(Rb * K * ELB + C * 2); }
#define PG8_AOFF(dst0, u) do { _Pragma("unroll") for (int i = 0; i < 2; ++i) { int R, C; stage_rc(tid * 16 + i * 8192, R, C); dst0[i] = S.a_off(u, R, C); } } while (0)
    const size_t kstepB = (size_t)(BK * 2), hstepB = (size_t)HALF * K * ELB, kstepA = (size_t)S.kstepA;
    const unsigned ldsw = (unsigned)wid * 1024u;
    const int aoff = lds_byte(wr * 64 + fr, fq * 8), boff = lds_byte(wc * 32 + fr, fq * 8);
#define PG8_SA(b) (((b) * 2) * HTB)
#define PG8_SB(b, h) ((4 + (b) * 2 + (h)) * HTB)
#define PG8_STAGE(bufoff, gbase, voff) do { _Pragma("unroll") for (int _i = 0; _i < 2; ++_i) \
        __builtin_amdgcn_global_load_lds((const unsigned*)((const char*)(gbase) + (voff)[_i]), (LAS unsigned*)(lds + (bufoff) + ldsw + _i * 8192), 16, 0, 0); } while (0)
#define PG8_LDA(dst, b) do { _Pragma("unroll") for (int m = 0; m < 4; ++m) _Pragma("unroll") for (int k = 0; k < 2; ++k) dst[m][k] = *(const LAS bf16x8*)(lds + PG8_SA(b) + aoff + m * 2048 + k * 1024); } while (0)
#define PG8_LDB(dst, b, h) do { _Pragma("unroll") for (int n = 0; n < 2; ++n) _Pragma("unroll") for (int k = 0; k < 2; ++k) dst[n][k] = *(const LAS bf16x8*)(lds + PG8_SB(b, h) + boff + n * 2048 + k * 1024); } while (0)
#define PG8_CAT(x0, x1) __builtin_shufflevector(__builtin_bit_cast(v4i, x0), __builtin_bit_cast(v4i, x1), 0, 1, 2, 3, 4, 5, 6, 7)
#define PG8_MMA(bj, At, Bt) do { __builtin_amdgcn_s_setprio(1); _Pragma("unroll") for (int m = 0; m < 4; ++m) _Pragma("unroll") for (int n = 0; n < 2; ++n) { \
        if constexpr (P::FP8) acc[bj][m][n] = __builtin_amdgcn_mfma_scale_f32_16x16x128_f8f6f4(PG8_CAT(Bt[n][0], Bt[n][1]), PG8_CAT(At[m][0], At[m][1]), acc[bj][m][n], 0, 0, 0, 0x7f7f7f7f, 0, 0x7f7f7f7f); \
        else { _Pragma("unroll") for (int k = 0; k < 2; ++k) acc[bj][m][n] = __builtin_amdgcn_mfma_f32_16x16x32_bf16(Bt[n][k], At[m][k], acc[bj][m][n], 0, 0, 0); } } __builtin_amdgcn_s_setprio(0); } while (0)
#define PG8_WAIT_V(n) asm volatile("s_waitcnt vmcnt(" #n ")" ::: "memory")
#define PG8_WAIT_L(n) asm volatile("s_waitcnt lgkmcnt(" #n ")" ::: "memory")
#define PG8_BAR __builtin_amdgcn_s_barrier()
#define PG8_SCHED __builtin_amdgcn_sched_barrier(0)
    Unit cur, nxt; int ui = 0;
    if (!S.next(0, cur)) return;
    f32x4 acc[2][4][2], st[2][4][2];
#pragma unroll
    for (int a = 0; a < 2; ++a)
#pragma unroll
        for (int m = 0; m < 4; ++m)
#pragma unroll
            for (int n = 0; n < 2; ++n) { acc[a][m][n] = (f32x4){0.f, 0.f, 0.f, 0.f}; st[a][m][n] = (f32x4){0.f, 0.f, 0.f, 0.f}; }
    bf16x8 At[4][2], B0[2][2];
    unsigned vA[2], vN[2];
    PG8_AOFF(vA, cur);
    const char* cA = S.a_base(cur); const char* cB = S.b_base(cur);
    PG8_STAGE(PG8_SB(0, 0), cB, voffB); PG8_STAGE(PG8_SA(0), cA, vA); PG8_STAGE(PG8_SB(0, 1), cB + hstepB, voffB);
    if (wr == 1) PG8_BAR;
    PG8_WAIT_V(2); PG8_BAR;
    PG8_STAGE(PG8_SB(1, 0), cB + kstepB, voffB); PG8_STAGE(PG8_SA(1), cA + kstepA, vA);
    PG8_WAIT_V(4); PG8_BAR;
    for (;;) {
        const bool has_next = S.next(ui + 1, nxt);
        const char* nA = cA; const char* nB = cB;
        if (has_next) { nA = S.a_base(nxt); nB = S.b_base(nxt); if (P::EARLY_AOFF) PG8_AOFF(vN, nxt); }
        for (int t = 0; t < nt; t += 2) {
            const bool last = (t == nt - 2);
            const char* b1 = cB + (size_t)(t + 1) * kstepB;
            const char* a2 = last ? nA : cA + (size_t)(t + 2) * kstepA; const char* b2 = last ? nB : cB + (size_t)(t + 2) * kstepB;
            const char* a3 = a2 + kstepA; const char* b3 = b2 + kstepB;
            PG8_LDB(B0, 0, 0); PG8_SCHED; PG8_LDA(At, 0); PG8_STAGE(PG8_SB(1, 1), b1 + hstepB, voffB);
            if (last && has_next) { if (P::EARLY_AOFF) { vA[0] = vN[0]; vA[1] = vN[1]; } else PG8_AOFF(vA, nxt); }
            PG8_WAIT_V(6); PG8_WAIT_L(0); PG8_BAR; PG8_MMA(0, At, B0); PG8_BAR; PG8_SCHED;
            PG8_LDB(B0, 0, 1); PG8_STAGE(PG8_SB(0, 0), b2, voffB); PG8_STAGE(PG8_SA(0), a2, vA);
            PG8_WAIT_V(6); PG8_WAIT_L(0); PG8_BAR; PG8_MMA(1, At, B0); PG8_BAR; PG8_SCHED;
            PG8_LDB(B0, 1, 0); PG8_SCHED; PG8_LDA(At, 1); PG8_STAGE(PG8_SB(0, 1), b2 + hstepB, voffB);
            PG8_WAIT_V(6); PG8_WAIT_L(0); PG8_BAR; PG8_MMA(0, At, B0); PG8_BAR; PG8_SCHED;
            PG8_LDB(B0, 1, 1); PG8_STAGE(PG8_SB(1, 0), b3, voffB); PG8_STAGE(PG8_SA(1), a3, vA);
            PG8_WAIT_V(6); PG8_WAIT_L(0); PG8_BAR; PG8_MMA(1, At, B0); PG8_BAR; PG8_SCHED;
        }
        if (wr == 0) PG8_BAR;
        S.epi(acc, st, cur, wr, wc, fr, fq);
        if (!has_next) break;
#pragma unroll
        for (int a = 0; a < 2; ++a)
#pragma unroll
            for (int m = 0; m < 4; ++m)
#pragma unroll
                for (int n = 0; n < 2; ++n) acc[a][m][n] = (f32x4){0.f, 0.f, 0.f, 0.f};
        cur = nxt; cA = nA; cB = nB; ++ui;
        if (wr == 1) PG8_BAR;
    }
    PG8_WAIT_V(0);
    PG8_BAR;
#undef PG8_AOFF
#undef PG8_SA
#undef PG8_SB
#undef PG8_STAGE
#undef PG8_LDA
#undef PG8_LDB
#undef PG8_MMA
#undef PG8_CAT
#undef PG8_WAIT_V
#undef PG8_WAIT_L
#undef PG8_BAR
#undef PG8_SCHED
}
}
namespace attn_body {
using bf16x8 = __attribute__((ext_vector_type(8))) short;
using u32x4 = __attribute__((ext_vector_type(4))) unsigned;
constexpr int NW = 8, QBLK = 32, QB = QBLK * NW, KVBLK = 64;
__device__ __forceinline__ int crow(int r, int hi) { return (r & 3) + 8 * (r >> 2) + 4 * hi; }
#define SBAR() __builtin_amdgcn_sched_barrier(0)
constexpr int NSLOT = 3, SLOTB = 8192;
constexpr int LDS_K = 0, LDS_V = NSLOT * SLOTB, LDS_WS = 2 * NSLOT * SLOTB, LDS_OST = LDS_WS + NW * 64 * 4, LDS_BYTES = LDS_OST + NW * 4096;
constexpr int LDS_BT = 86016 + 256;
__device__ __forceinline__ void glds16(const void* gsrc, unsigned lds_dst) { unsigned keep;
  asm volatile("s_mov_b32 %0, m0\n\ts_mov_b32 m0, %2\n\ts_nop 0\n\tglobal_load_lds_dwordx4 %1, off\n\ts_mov_b32 m0, %0" : "=&s"(keep) : "v"(gsrc), "s"(lds_dst) : "memory"); }
__device__ __forceinline__ float max3f(float a, float b, float c) { float r; asm("v_max3_f32 %0, %1, %2, %3" : "=v"(r) : "v"(a), "v"(b), "v"(c)); return r; }
__device__ __forceinline__ float max2f(float a, float b) { float r; asm("v_max_f32_e32 %0, %1, %2" : "=v"(r) : "v"(a), "v"(b)); return r; }
__device__ __forceinline__ float fadd_s(float a, float b) { float r; asm("v_add_f32_e32 %0, %1, %2" : "=v"(r) : "v"(a), "v"(b)); return r; }
__device__ __forceinline__ float fsub_s(float a, float b) { float r; asm("v_sub_f32_e32 %0, %1, %2" : "=v"(r) : "v"(a), "v"(b)); return r; }
typedef float f32x2_t __attribute__((ext_vector_type(2))); typedef __bf16 bf16x2_t __attribute__((ext_vector_type(2)));
__device__ __forceinline__ unsigned cvtpk_s(float lo, float hi) { f32x2_t v = {lo, hi}; bf16x2_t b = __builtin_convertvector(v, bf16x2_t); return __builtin_bit_cast(unsigned, b); }
#define WAIT_BAR(N) asm volatile("s_waitcnt vmcnt(" #N ") lgkmcnt(0)\n\ts_barrier" ::: "memory")

__device__ __forceinline__ void qkt(f32x16& p0, f32x16& p1, const char* Kslot, const bf16x8* qr, const f32x16& negm, int r32, int hi) {
  const char* kb = Kslot + hi * 1024 + r32 * 16;
  #pragma unroll
  for (int d0 = 0; d0 < 4; ++d0) {
    const bf16x8 b0 = *reinterpret_cast<const bf16x8*>(kb + d0 * 2048);
    const bf16x8 b1 = *reinterpret_cast<const bf16x8*>(kb + d0 * 2048 + 512);
    if (d0 == 0) { p0 = __builtin_amdgcn_mfma_f32_32x32x16_bf16(b0, qr[0], negm, 0, 0, 0); p1 = __builtin_amdgcn_mfma_f32_32x32x16_bf16(b1, qr[0], negm, 0, 0, 0); }
    else { p0 = __builtin_amdgcn_mfma_f32_32x32x16_bf16(b0, qr[d0], p0, 0, 0, 0); p1 = __builtin_amdgcn_mfma_f32_32x32x16_bf16(b1, qr[d0], p1, 0, 0, 0); } }
}
typedef __attribute__((address_space(3))) const char* lds_cptr;
typedef short v4i16_t __attribute__((ext_vector_type(4)));
__device__ __forceinline__ void kload8(bf16x8* kf, lds_cptr kp) {
  kf[0] = *(const __attribute__((address_space(3))) bf16x8*)(kp);        kf[1] = *(const __attribute__((address_space(3))) bf16x8*)(kp + 512);
  kf[2] = *(const __attribute__((address_space(3))) bf16x8*)(kp + 2048); kf[3] = *(const __attribute__((address_space(3))) bf16x8*)(kp + 2560);
  kf[4] = *(const __attribute__((address_space(3))) bf16x8*)(kp + 4096); kf[5] = *(const __attribute__((address_space(3))) bf16x8*)(kp + 4608);
  kf[6] = *(const __attribute__((address_space(3))) bf16x8*)(kp + 6144); kf[7] = *(const __attribute__((address_space(3))) bf16x8*)(kp + 6656);
}
__device__ __forceinline__ void kload2(bf16x8* kf, lds_cptr kp, int j) { kf[2 * j] = *(const __attribute__((address_space(3))) bf16x8*)(kp + j * 2048); kf[2 * j + 1] = *(const __attribute__((address_space(3))) bf16x8*)(kp + j * 2048 + 512); }
__device__ __forceinline__ s16x4 vtr(lds_cptr p) { return __builtin_bit_cast(s16x4, __builtin_amdgcn_ds_read_tr16_b64_v4i16((__attribute__((address_space(3))) v4i16_t*)p)); }
__device__ __forceinline__ float rowmax(const f32x16& p0, const f32x16& p1) {
  float a = max3f(p0[0], p0[1], p1[0]), b = max3f(p0[2], p0[3], p1[1]); a = max3f(a, p1[2], p1[3]);
  #pragma unroll
  for (int r = 4; r < 16; r += 4) { a = max3f(a, p0[r], p0[r + 1]); b = max3f(b, p0[r + 2], p0[r + 3]); a = max3f(a, p1[r], p1[r + 1]); b = max3f(b, p1[r + 2], p1[r + 3]); }
  const float m = max2f(a, b);
  auto rr = __builtin_amdgcn_permlane32_swap(__float_as_uint(m), __float_as_uint(m), false, false);
  return max2f(__uint_as_float(rr[0]), __uint_as_float(rr[1]));
}
__device__ __forceinline__ void pv(f32x16* o, int vb, bf16x8 pa0, bf16x8 pa1, bf16x8 pa2, bf16x8 pa3) {
  #pragma unroll
  for (int d0 = 0; d0 < 2; ++d0) { s16x4 lo[4], hi[4];
    #pragma unroll
    for (int ks = 0; ks < 4; ++ks) {
      asm volatile("ds_read_b64_tr_b16 %0,%1 offset:%c2" : "=&v"(lo[ks]) : "v"(vb), "i"(d0 * 4096 + ks * 1024) : "memory");
      asm volatile("ds_read_b64_tr_b16 %0,%1 offset:%c2" : "=&v"(hi[ks]) : "v"(vb), "i"(d0 * 4096 + ks * 1024 + 512) : "memory"); }
    asm volatile("s_waitcnt lgkmcnt(0)" ::: "memory"); SBAR();
    #define PK(k) (bf16x8){lo[k][0], lo[k][1], lo[k][2], lo[k][3], hi[k][0], hi[k][1], hi[k][2], hi[k][3]}
    o[d0] = __builtin_amdgcn_mfma_f32_32x32x16_bf16(pa0, PK(0), o[d0], 0, 0, 0);
    o[d0] = __builtin_amdgcn_mfma_f32_32x32x16_bf16(pa1, PK(1), o[d0], 0, 0, 0);
    o[d0] = __builtin_amdgcn_mfma_f32_32x32x16_bf16(pa2, PK(2), o[d0], 0, 0, 0);
    o[d0] = __builtin_amdgcn_mfma_f32_32x32x16_bf16(pa3, PK(3), o[d0], 0, 0, 0);
    #undef PK
  }
}
#define ATTN_STORE16(p, v) (*(u32x4*)(p) = (v))

template <int THRL, bool NA, int QP_, int KVP_, bool NOMAX = false>
__device__ __forceinline__ void attn_unit(const bf16* Qu, int qp_rt, const bf16* __restrict__ Kh, const bf16* __restrict__ Vh, int kvp_rt, bf16* Ou, int NT, int r0, int rlo, char* shm) {
  const int qp = QP_ ? QP_ : qp_rt, kvp = KVP_ ? KVP_ : kvp_rt, op = qp;
  int tid_ = threadIdx.x; asm volatile("" : "+v"(tid_));
  const int tid = tid_, lane = tid & 63, r32 = lane & 31, hi = lane >> 5; const int wid = __builtin_amdgcn_readfirstlane(tid >> 6);
  const bf16* Qw = Qu + (long)(wid * QBLK) * qp;
  const unsigned lds0 = (unsigned)(uintptr_t)shm;
  float* wsf = (float*)(shm + LDS_WS) + wid * 64;
  const bf16* ksrc = Kh + (long)lane * kvp + wid * 8;
  const bf16* vsrc = Vh + (long)(16 * (wid & 3) + (lane >> 2)) * kvp + (wid >> 2) * 32 + (lane & 3) * 8;
  const unsigned kdst = lds0 + LDS_K + wid * 1024, vdst = lds0 + LDS_V + wid * 1024;
  #define TROW(t) (NA ? ((t) < 4 ? 64 * (t) : CTX + 64 * ((rlo + (t) - 4) < 127 ? (rlo + (t) - 4) : 127)) : 64 * (t))
  #define DMA_K(t, slot) glds16(ksrc + (long)TROW(t) * kvp, (unsigned)__builtin_amdgcn_readfirstlane(kdst + (slot)))
  #define DMA_V(t, slot) glds16(vsrc + (long)TROW(t) * kvp, (unsigned)__builtin_amdgcn_readfirstlane(vdst + (slot)))
  const int vb0 = (int)(lds0 + LDS_V) + ((lane >> 4) & 1) * 32 + (lane & 3) * 8 + (4 * hi + ((lane & 15) >> 2)) * 64;
  const char* Kbase = shm + LDS_K; bf16x8 kf[8];
  const lds_cptr shm3 = (lds_cptr)shm; const lds_cptr kp0 = shm3 + LDS_K + hi * 1024 + r32 * 16; const lds_cptr vp0 = shm3 + LDS_V + ((lane >> 4) & 1) * 32 + (lane & 3) * 8 + (4 * hi + ((lane & 15) >> 2)) * 64;
  const int rq = r0 + (wid >> 1), qc = 32 * (wid & 1) + r32;
  const int rsw = rq - 4 < 0 ? 0 : (rq - 4 > 120 ? 120 : rq - 4);
  const int cs = qc - 8 < 0 ? 0 : (qc - 8 > 48 ? 48 : qc - 8);
  const __attribute__((address_space(3))) float* btl = (const __attribute__((address_space(3))) float*)(shm3 + LDS_BT) + (15 + 4 * hi - qc);
  DMA_K(0, 0); DMA_V(0, 0); DMA_K(1, SLOTB);
  bf16x8 qr[4];
  #pragma unroll
  for (int d0 = 0; d0 < 4; ++d0) qr[d0] = *reinterpret_cast<const bf16x8*>(&Qw[(long)r32 * qp + d0 * 16 + hi * 8]);
  float mhat = 0.f, l_reg = 0.f; f32x16 o[2]; o[0] = f32x16{}; o[1] = f32x16{}; f32x16 negm = f32x16{}; if (!NA) asm volatile("" : "+v"(negm));
  #define NEGM (NA ? f32x16{} : negm)
  #define CMASK(P0, P1, t) do { if (NA) { if ((t) >= 4) { const int kr_ = rlo + (t) - 4; const int dr_ = kr_ - rsw; \
      if (dr_ < 0 || dr_ >= 8) { _Pragma("unroll") for (int r = 0; r < 16; ++r) { P0[r] = (-__builtin_inff()); P1[r] = (-__builtin_inff()); } } \
      else { const __attribute__((address_space(3))) float* bp_ = btl + (kr_ - rq + 7) * 31; const int kl0_ = 4 * hi - cs; \
        _Pragma("unroll") for (int rg = 0; rg < 4; ++rg) { \
          _Pragma("unroll") for (int rr_ = 0; rr_ < 4; ++rr_) { const int r = rg * 4 + rr_; const int kc_ = (r & 3) + 8 * (r >> 2); const float b0_ = bp_[kc_], b1_ = bp_[kc_ + 32]; \
            const int kl_ = kc_ + kl0_; P0[r] = ((unsigned)kl_ < 16u) ? P0[r] + b0_ : (-__builtin_inff()); P1[r] = ((unsigned)(kl_ + 32) < 16u) ? P1[r] + b1_ : (-__builtin_inff()); } \
          SBAR(); } } } } } while (0)
  bool resc = false;
  #define START(P0, P1) do { const float rm = NOMAX ? 0.f : rowmax(P0, P1); resc = false; \
    { const float dl = rm; mhat = fadd_s(mhat, dl); \
      _Pragma("unroll") for (int r = 0; r < 16; ++r) { P0[r] = fsub_s(P0[r], dl); P1[r] = fsub_s(P1[r], dl); } \
      if (!NA) { _Pragma("unroll") for (int r = 0; r < 16; ++r) negm[r] = -mhat; asm volatile("" : "+v"(negm)); } } \
    _Pragma("unroll") for (int r = 0; r < 16; ++r) P0[r] = __builtin_amdgcn_exp2f(P0[r]); } while (0)
  #define RESC() do { if (resc) { asm volatile("s_waitcnt lgkmcnt(0)" ::: "memory"); \
      _Pragma("unroll") for (int d_ = 0; d_ < 2; ++d_) _Pragma("unroll") for (int r = 0; r < 16; ++r) o[d_][r] *= wsf[crow(r, hi)]; } } while (0)
  f32x16 pA0, pA1, pB0, pB1;
  int sl_prev = 0, sl_cur = 0, sl_next = SLOTB;
  #define ROT() do { sl_prev = sl_cur; sl_cur = sl_next; sl_next = (sl_next == (NSLOT - 1) * SLOTB) ? 0 : sl_next + SLOTB; } while (0)
  DMA_K(2, 2 * SLOTB);
  WAIT_BAR(3);
  qkt(pA0, pA1, Kbase, qr, NEGM, r32, hi); asm volatile("s_nop 15\n\ts_nop 7" : "+v"(pA0), "+v"(pA1));
  START(pA0, pA1);
  _Pragma("unroll") for (int r = 0; r < 16; ++r) pA1[r] = __builtin_amdgcn_exp2f(pA1[r]);
  WAIT_BAR(0);
  DMA_K(3, 0); DMA_V(1, SLOTB);
  ROT();
  kload8(kf, kp0 + sl_cur);
  WAIT_BAR(2);
  s16x4 vlo[8], vhi[8]; u32x4 pw0, pw1, pw2, pw3;
  #define PKW(P, B) cvtpk_s(P[B], P[B + 1])
  #define PAF(k) __builtin_bit_cast(bf16x8, pw##k)
  #define VFR(i) (bf16x8){vlo[i][0], vlo[i][1], vlo[i][2], vlo[i][3], vhi[i][0], vhi[i][1], vhi[i][2], vhi[i][3]}
  #define PIN(x) asm volatile("" : "+v"(x))
  #define MX3(a, b, c) __builtin_fmaxf(__builtin_fmaxf((a), (b)), (c))
  #define GAPA(MF, A0, A1, A2, A3, W0, W1, PW) do { MF; sacc2 += (f32x2_t){A0, A1}; sacc2 += (f32x2_t){A2, A3}; PIN(sacc2); W0; W1; PIN(PW); SBAR(); } while (0)
  #define EX(v) __builtin_amdgcn_exp2f(v)
  #define GAPB(MF, X, B) do { MF; X[B] = EX(X[B]); X[B + 1] = EX(X[B + 1]); X[B + 2] = EX(X[B + 2]); X[B + 3] = EX(X[B + 3]); PIN(X); SBAR(); } while (0)
  #define VRD(i) do { vlo[i] = vtr(vp_ + (((i) >> 2) * 4096 + ((i) & 3) * 1024)); vhi[i] = vtr(vp_ + (((i) >> 2) * 4096 + ((i) & 3) * 1024 + 512)); } while (0)
  #define KRD(G, j) do { if (G) { kload2(kf, kp0 + sl_next, j); SBAR(); } } while (0)
  #define STEP(C0, C1, P0, P1, t, GK, GV, GL) do { SBAR(); \
    const lds_cptr vp_ = vp0 + sl_prev; \
    VRD(0); SBAR(); f32x2_t sacc2 = (f32x2_t){P0[0], P0[1]}; \
    GAPA(C0 = __builtin_amdgcn_mfma_f32_32x32x16_bf16(kf[0], qr[0], NEGM, 0, 0, 0), P0[2], P0[3], P0[4], P0[5],     pw0[0] = PKW(P0, 0), pw0[1] = PKW(P0, 2), pw0); \
    VRD(4); SBAR(); GAPA(C1 = __builtin_amdgcn_mfma_f32_32x32x16_bf16(kf[1], qr[0], NEGM, 0, 0, 0), P0[6], P0[7], P0[8], P0[9],     pw0[2] = PKW(P0, 4), pw0[3] = PKW(P0, 6), pw0); \
    VRD(1); SBAR(); GAPA(C0 = __builtin_amdgcn_mfma_f32_32x32x16_bf16(kf[2], qr[1], C0, 0, 0, 0),   P0[10], P0[11], P0[12], P0[13], pw1[0] = PKW(P0, 8), pw1[1] = PKW(P0, 10), pw1); \
    VRD(5); SBAR(); GAPA(C1 = __builtin_amdgcn_mfma_f32_32x32x16_bf16(kf[3], qr[1], C1, 0, 0, 0),   P0[14], P0[15], P1[0], P1[1],   pw1[2] = PKW(P0, 12), pw1[3] = PKW(P0, 14), pw1); \
    VRD(2); SBAR(); GAPA(C0 = __builtin_amdgcn_mfma_f32_32x32x16_bf16(kf[4], qr[2], C0, 0, 0, 0),   P1[2], P1[3], P1[4], P1[5],     pw2[0] = PKW(P1, 0), pw2[1] = PKW(P1, 2), pw2); \
    VRD(6); SBAR(); GAPA(C1 = __builtin_amdgcn_mfma_f32_32x32x16_bf16(kf[5], qr[2], C1, 0, 0, 0),   P1[6], P1[7], P1[8], P1[9],     pw2[2] = PKW(P1, 4), pw2[3] = PKW(P1, 6), pw2); \
    VRD(3); SBAR(); GAPA(C0 = __builtin_amdgcn_mfma_f32_32x32x16_bf16(kf[6], qr[3], C0, 0, 0, 0),   P1[10], P1[11], P1[12], P1[13], pw3[0] = PKW(P1, 8), pw3[1] = PKW(P1, 10), pw3); \
    VRD(7); SBAR(); GAPA(C1 = __builtin_amdgcn_mfma_f32_32x32x16_bf16(kf[7], qr[3], C1, 0, 0, 0),   P1[14], P1[15], 0.f, 0.f,       pw3[2] = PKW(P1, 12), pw3[3] = PKW(P1, 14), pw3); \
    l_reg += sacc2.x + sacc2.y; \
    if (GK) { DMA_K((t) + 3, sl_cur); } if (GV) { DMA_V((t) + 1, sl_next); } \
    resc = false; \
    if (NA) { _Pragma("unroll") for (int r = 0; r < 16; ++r) { C0[r] -= mhat; C1[r] -= mhat; } } \
    CMASK(C0, C1, t); \
    if (!NOMAX) { float a = MX3(C0[0], C0[1], C1[0]), b = MX3(C0[2], C0[3], C1[1]); a = MX3(a, C1[2], C1[3]); \
      _Pragma("unroll") for (int r = 4; r < 16; r += 4) { a = MX3(a, C0[r], C0[r + 1]); b = MX3(b, C0[r + 2], C0[r + 3]); a = MX3(a, C1[r], C1[r + 1]); b = MX3(b, C1[r + 2], C1[r + 3]); } \
      float rm = __builtin_fmaxf(a, b); { auto rr = __builtin_amdgcn_permlane32_swap(__float_as_uint(rm), __float_as_uint(rm), false, false); rm = __builtin_fmaxf(__uint_as_float(rr[0]), __uint_as_float(rr[1])); } \
      if (__builtin_expect(__any(rm > (float)THRL), 0)) { const float dl = __builtin_fmaxf(rm, 0.f); mhat += dl; \
        _Pragma("unroll") for (int r = 0; r < 16; ++r) { C0[r] -= dl; C1[r] -= dl; } \
        if (!NA) { _Pragma("unroll") for (int r = 0; r < 16; ++r) negm[r] = -mhat; asm volatile("" : "+v"(negm)); } \
        const float f = __builtin_amdgcn_exp2f(-dl); l_reg *= f; if (hi == 0) wsf[r32] = f; resc = true; } } \
    SBAR(); \
    GAPB(o[0] = __builtin_amdgcn_mfma_f32_32x32x16_bf16(PAF(0), VFR(0), o[0], 0, 0, 0), C0, 0); \
    GAPB(o[1] = __builtin_amdgcn_mfma_f32_32x32x16_bf16(PAF(0), VFR(4), o[1], 0, 0, 0), C0, 4); \
    KRD(GL, 0); GAPB(o[0] = __builtin_amdgcn_mfma_f32_32x32x16_bf16(PAF(1), VFR(1), o[0], 0, 0, 0), C0, 8); \
    KRD(GL, 1); GAPB(o[1] = __builtin_amdgcn_mfma_f32_32x32x16_bf16(PAF(1), VFR(5), o[1], 0, 0, 0), C0, 12); \
    KRD(GL, 2); GAPB(o[0] = __builtin_amdgcn_mfma_f32_32x32x16_bf16(PAF(2), VFR(2), o[0], 0, 0, 0), C1, 0); \
    KRD(GL, 3); GAPB(o[1] = __builtin_amdgcn_mfma_f32_32x32x16_bf16(PAF(2), VFR(6), o[1], 0, 0, 0), C1, 4); \
    GAPB(o[0] = __builtin_amdgcn_mfma_f32_32x32x16_bf16(PAF(3), VFR(3), o[0], 0, 0, 0), C1, 8); \
    GAPB(o[1] = __builtin_amdgcn_mfma_f32_32x32x16_bf16(PAF(3), VFR(7), o[1], 0, 0, 0), C1, 12); \
    } while (0)
  int t = 1;
  for (; t + 5 < NT; t += 2) {
    STEP(pB0, pB1, pA0, pA1, t, true, true, true);     WAIT_BAR(2); RESC(); ROT();
    STEP(pA0, pA1, pB0, pB1, t + 1, true, true, true); WAIT_BAR(2); RESC(); ROT();
  }
  #define ENDW(tt) do { if ((tt) + 3 < NT) { WAIT_BAR(2); } else if ((tt) + 2 < NT) { WAIT_BAR(1); } else { WAIT_BAR(0); } } while (0)
  for (; t + 1 < NT; t += 2) {
    STEP(pB0, pB1, pA0, pA1, t, (t + 3 < NT), (t + 1 < NT), (t + 1 < NT));         ENDW(t);     RESC(); ROT();
    STEP(pA0, pA1, pB0, pB1, t + 1, (t + 4 < NT), (t + 2 < NT), (t + 2 < NT));     ENDW(t + 1); RESC(); ROT();
  }
  STEP(pB0, pB1, pA0, pA1, NT - 1, false, false, false); RESC();
  { float sacc = pB0[0] + pB0[1]; _Pragma("unroll") for (int r = 2; r < 16; ++r) sacc += pB0[r]; _Pragma("unroll") for (int r = 0; r < 16; ++r) sacc += pB1[r]; l_reg += sacc;
    pw0 = (u32x4){PKW(pB0, 0), PKW(pB0, 2), PKW(pB0, 4), PKW(pB0, 6)}; pw1 = (u32x4){PKW(pB0, 8), PKW(pB0, 10), PKW(pB0, 12), PKW(pB0, 14)}; pw2 = (u32x4){PKW(pB1, 0), PKW(pB1, 2), PKW(pB1, 4), PKW(pB1, 6)}; pw3 = (u32x4){PKW(pB1, 8), PKW(pB1, 10), PKW(pB1, 12), PKW(pB1, 14)};
    SBAR(); pv(o, vb0 + sl_cur, PAF(0), PAF(1), PAF(2), PAF(3)); }
  #undef PKW
  #undef PAF
  #undef VFR
  #undef PIN
  #undef MX3
  #undef GAPA
  #undef GAPB
  #undef EX
  #undef VRD
  #undef KRD
  #undef STEP
  #undef ENDW
  { auto rr = __builtin_amdgcn_permlane32_swap(__float_as_uint(l_reg), __float_as_uint(l_reg), false, false); l_reg = __uint_as_float(rr[0]) + __uint_as_float(rr[1]); }
  if (hi == 0) wsf[32 + r32] = l_reg; asm volatile("s_waitcnt lgkmcnt(0)" ::: "memory");
  float rli[16];
  #pragma unroll
  for (int r = 0; r < 16; ++r) rli[r] = __builtin_amdgcn_rcpf(wsf[32 + crow(r, hi)]);
  bf16* Ow = Ou + (long)(wid * QBLK) * op;
  { bf16* stg = (bf16*)(shm + LDS_OST) + wid * 2048;
    #pragma unroll
    for (int r = 0; r < 16; ++r) { const int orow = crow(r, hi);
      #pragma unroll
      for (int d0 = 0; d0 < 2; ++d0) stg[orow * 64 + d0 * 32 + r32] = (bf16)f2bf(o[d0][r] * rli[r]); }
    asm volatile("s_waitcnt lgkmcnt(0)" ::: "memory");
    #pragma unroll
    for (int i = 0; i < 4; ++i) { const int row = i * 8 + (lane >> 3), ch = lane & 7; const u32x4 v = *(const u32x4*)(stg + row * 64 + ch * 8); ATTN_STORE16(Ow + (long)row * op + ch * 8, v); } }
  asm volatile("s_waitcnt lgkmcnt(0)\n\ts_barrier" ::: "memory");
  #undef NEGM
  #undef DMA_K
  #undef DMA_V
  #undef TROW
  #undef CMASK
  #undef START
  #undef RESC
  #undef ROT
}
#undef SBAR
#undef WAIT_BAR
}
#ifndef FP8_MOE
#define FP8_MOE 1
#endif
struct Args { const float* in[29]; float* out; unsigned char* ws; int ph_lo, ph_hi; };
enum { I_X = 0, I_C, I_CTX, I_CCTX, I_WMOD, I_BMOD, I_N1G, I_N2G, I_WIN, I_LRE, I_LIM, I_LDT, I_BRE, I_BIM, I_CRE, I_CIM, I_SSMD, I_WGLU, I_QNG, I_KNG, I_RPB, I_WBR, I_WOUT, I_RW, I_RB, I_MG, I_MU, I_MD, I_FNG };

typedef const float* CFP;
struct Ctx {
    const __attribute__((address_space(4))) CFP* in; float* out; unsigned char* ws; LAS unsigned char* lds; gu32* ctl;
    int tid, lane, wave, vcu, G;
};
#define WSP(T_, off) ((T_*)(C.ws + (off)))

__device__ __forceinline__ bf16* xs_row(const Ctx& C, int m) { return WSP(bf16, WS_XS) + (size_t)m * D; }
__device__ __forceinline__ const float* in_row(const Ctx& C, int m) { const int b = m / LB, j = m - b * LB; return j < CTX ? C.in[I_CTX] + (size_t)(b * CTX + j) * D : C.in[I_X] + (size_t)(b * SEQ + j - CTX) * D; }
__device__ __forceinline__ int cond_of(int m) { const int b = m / LB, j = m - b * LB; return j < CTX ? 4 : b; }

__device__ __forceinline__ void transpose_item(const float* W, int N, int Kp, bf16* WT, int k0, int n0, int drow0, LAS float* scr, int lane) {
    const float* src = W + (size_t)k0 * N + n0 + lane;
    float tv[64];
#pragma unroll
    for (int i = 0; i < 64; ++i) tv[i] = src[(size_t)i * N];
#pragma unroll
    for (int i = 0; i < 64; ++i) scr[i * 65 + lane] = tv[i];
    LDS_WAIT(); asm volatile("" ::: "memory");
    const int c = lane & 7;
#pragma unroll
    for (int j = 0; j < 8; ++j) { const int n = (lane >> 3) + 8 * j; const LAS float* s = scr + (8 * c) * 65 + n;
        v4u o; o.x = pk2(s[0 * 65], s[1 * 65]); o.y = pk2(s[2 * 65], s[3 * 65]); o.z = pk2(s[4 * 65], s[5 * 65]); o.w = pk2(s[6 * 65], s[7 * 65]);
        *(GAS v4u*)(WT + (size_t)(drow0 + n) * Kp + k0 + 8 * c) = o; }
    LDS_WAIT(); asm volatile("" ::: "memory");
}
__device__ __forceinline__ void transpose_item8(const float* W, int N, int Kp, unsigned char* WT, int k0, int n0, int drow0, float scale, LAS float* scr, int lane) {
    const float* src = W + (size_t)k0 * N + n0 + lane;
    float tv[64];
#pragma unroll
    for (int i = 0; i < 64; ++i) tv[i] = src[(size_t)i * N];
#pragma unroll
    for (int i = 0; i < 64; ++i) scr[i * 65 + lane] = tv[i] * scale;
    LDS_WAIT(); asm volatile("" ::: "memory");
    const int c = lane & 3;
#pragma unroll
    for (int j = 0; j < 4; ++j) { const int n = (lane >> 2) + 16 * j; const LAS float* s = scr + (16 * c) * 65 + n;
        v4u o; o.x = pk4_fp8(s[0 * 65], s[1 * 65], s[2 * 65], s[3 * 65]); o.y = pk4_fp8(s[4 * 65], s[5 * 65], s[6 * 65], s[7 * 65]); o.z = pk4_fp8(s[8 * 65], s[9 * 65], s[10 * 65], s[11 * 65]); o.w = pk4_fp8(s[12 * 65], s[13 * 65], s[14 * 65], s[15 * 65]);
        *(GAS v4u*)(WT + (size_t)(drow0 + n) * Kp + k0 + 16 * c) = o; }
    LDS_WAIT(); asm volatile("" ::: "memory");
}
__device__ __forceinline__ void phase_weights(const Ctx& C, int l) {
    LAS float* scr = (LAS float*)(C.lds + C.wave * 16640);
    const int gw = C.vcu * NWAVES + C.wave, NGW = C.G * NWAVES;
    constexpr int I0 = 16 * 92, I1 = 8 * 8, I2 = 3 * 8 * 16, I3 = 16 * 16, I4 = 16 * 16 * 8, I5 = I4, I6 = 16 * 8 * 16;
    for (int it = gw; it < I0 + I1 + I2 + I3 + I4 + I5 + I6; it += NGW) {
        int r = it;
        if (r < I0) { const int kb = r / 92, nb = r % 92; if (W8_ALL) transpose_item8(C.in[I_WIN] + (size_t)l * 1024 * INW, INW, 1024, WSP(unsigned char, WS_WIN), 64 * kb, 64 * nb, 64 * nb, 64.f, scr, C.lane);
            else if (nb < 44 || GATE_BF16) transpose_item(C.in[I_WIN] + (size_t)l * 1024 * INW, INW, 1024, WSP(bf16, WS_WIN), 64 * kb, 64 * nb, 64 * nb, scr, C.lane);
            else transpose_item8(C.in[I_WIN] + (size_t)l * 1024 * INW, INW, 1024, WSP(unsigned char, WS_WIN8), 64 * kb, 64 * nb, 64 * nb - 2816, 64.f, scr, C.lane); continue; } r -= I0;
        if (r < I1) { const int kb = r / 8, nb = r % 8; transpose_item(C.in[I_WGLU] + (size_t)l * 512 * 512, 512, 512, WSP(bf16, WS_WGLU), 64 * kb, 64 * nb, 64 * nb, scr, C.lane); continue; } r -= I1;
        if (r < I2) { const int i = r / 128, q = r % 128, kb = q / 16, nb = q % 16; transpose_item(C.in[I_WBR] + (size_t)(l * 3 + i) * 512 * 1024, 1024, 512, WSP(bf16, WS_WBR) + (size_t)i * 1024 * 512, 64 * kb, 64 * nb, 64 * nb, scr, C.lane); continue; } r -= I2;
        if (r < I3) { const int kb = r / 16, nb = r % 16; transpose_item(C.in[I_WOUT] + (size_t)l * 1024 * 1024, 1024, 1024, WSP(bf16, WS_WOUT), 64 * kb, 64 * nb, 64 * nb, scr, C.lane); continue; } r -= I3;
        if (r < I4 + I5) { const int up = r >= I4; if (up) r -= I4; const int e = r / 128, q = r % 128, kb = q / 8, nb = q % 8, n0 = 64 * nb;
            if (FP8_MOE) transpose_item8((up ? C.in[I_MU] : C.in[I_MG]) + (size_t)(l * 16 + e) * 1024 * 512, 512, 1024, WSP(unsigned char, WS_MOE1) + (size_t)e * 1024 * 1024, 64 * kb, n0, (n0 / 128) * 256 + (n0 % 128) + (up ? 128 : 0), 64.f, scr, C.lane);
            else transpose_item((up ? C.in[I_MU] : C.in[I_MG]) + (size_t)(l * 16 + e) * 1024 * 512, 512, 1024, WSP(bf16, WS_MOE1) + (size_t)e * 1024 * 1024, 64 * kb, n0, (n0 / 128) * 256 + (n0 % 128) + (up ? 128 : 0), scr, C.lane); continue; } r -= I4 + I5;
        { const int e = r / 128, q = r % 128, kb = q / 16, nb = q % 16; if (FP8_MOE) transpose_item8(C.in[I_MD] + (size_t)(l * 16 + e) * 512 * 1024, 1024, 512, WSP(unsigned char, WS_MOE2) + (size_t)e * 1024 * 512, 64 * kb, 64 * nb, 64 * nb, 32.f, scr, C.lane);
            else transpose_item(C.in[I_MD] + (size_t)(l * 16 + e) * 512 * 1024, 1024, 512, WSP(bf16, WS_MOE2) + (size_t)e * 1024 * 512, 64 * kb, 64 * nb, 64 * nb, scr, C.lane); }
    }
}

__device__ __forceinline__ void phase_mod(const Ctx& C) {
    LAS float* sc = (LAS float*)(C.lds);
    LAS float* red = (LAS float*)(C.lds + 20480);
    for (int i = C.tid; i < 5 * 1024; i += 512) { const int c = i >> 10, k = i & 1023; const float v = c < 4 ? C.in[I_C][c * 1024 + k] : C.in[I_CCTX][k]; sc[i] = v * fsigmoid(v); }
    __syncthreads();
    for (int it = C.vcu; it < NLAYER * 96; it += C.G) {
        const int l = it / 96, col = (it % 96) * 64 + C.lane, k0 = C.wave * 128;
        const float* W = C.in[I_WMOD] + (size_t)l * 1024 * 6144 + (size_t)k0 * 6144 + col;
        float a0 = 0.f, a1 = 0.f, a2 = 0.f, a3 = 0.f, a4 = 0.f;
#pragma unroll 16
        for (int k = 0; k < 128; ++k) { const float w = W[(size_t)k * 6144]; a0 += sc[k0 + k] * w; a1 += sc[1024 + k0 + k] * w; a2 += sc[2048 + k0 + k] * w; a3 += sc[3072 + k0 + k] * w; a4 += sc[4096 + k0 + k] * w; }
        LAS float* r = red + C.wave * 320 + C.lane; r[0] = a0; r[64] = a1; r[128] = a2; r[192] = a3; r[256] = a4;
        __syncthreads();
        if (C.tid < 320) { const int c = C.tid >> 6; float s = C.in[I_BMOD][l * 6144 + col];
#pragma unroll
            for (int w = 0; w < 8; ++w) s += red[w * 320 + C.tid];
            WSP(float, WS_MOD)[(size_t)(l * 5 + c) * 6144 + col] = s; }
        __syncthreads();
    }
}

__device__ __forceinline__ void phase_s5mats(const Ctx& C, int l, int w) {
    if (w < 0 || w >= 128) return;
    const int g = w >> 2, part = w & 3, tid = C.tid;
    LAS f32x2* POW = (LAS f32x2*)(C.lds);
    LAS f32x2* CC = (LAS f32x2*)(C.lds + 33792);
    LAS f32x2* BB = (LAS f32x2*)(C.lds + 50176);
    LAS f32x2* COEF = (LAS f32x2*)(C.lds + 66560);
    LAS bf16* KT = (LAS bf16*)(C.lds + 67584);
    LAS float* WT = (LAS float*)(C.lds + 101376);
    __syncthreads();
    if (tid < 128) {
        const int d = tid >> 6, p = tid & 63; const int li = ((l * 2 + d) * 32 + g) * 64 + p;
        const float re = C.in[I_LRE][li], im = C.in[I_LIM][li], dt = __expf(C.in[I_LDT][(l * 2 + d) * 32 + g]);
        for (int tau = 0; tau <= 32; ++tau) { const float mag = __expf(re * dt * (float)tau), rev = im * dt * (float)tau * 0.15915494309189535f;
            const float wr = mag * cos_rev(rev), wi = mag * sin_rev(rev);
            POW[(d * 33 + tau) * 64 + p] = (f32x2){wr, wi}; if (tau < 32) { WT[((d * 64 + p) * 2) * 32 + tau] = wr; WT[((d * 64 + p) * 2 + 1) * 32 + tau] = wi; } }
        const float mag = __expf(re * dt), rev = im * dt * 0.15915494309189535f; const float lr = mag * cos_rev(rev) - 1.f, lim = mag * sin_rev(rev);
        const float den = 1.f / (re * re + im * im);
        COEF[tid] = (f32x2){(lr * re + lim * im) * den, (lim * re - lr * im) * den};
    }
    __syncthreads();
    for (int i = tid; i < 2048; i += 512) {
        const int d = i >> 10, p = (i >> 4) & 63, h = i & 15; const size_t bi = (((size_t)(l * 2 + d) * 32 + g) * 64 + p) * 16 + h;
        const float br = C.in[I_BRE][bi], bi_ = C.in[I_BIM][bi]; const f32x2 cf = COEF[d * 64 + p];
        BB[i] = (f32x2){cf.x * br - cf.y * bi_, cf.x * bi_ + cf.y * br};
        const int h2 = (i >> 6) & 15, p2 = i & 63; const size_t ci = (((size_t)(l * 2 + d) * 32 + g) * 16 + h2) * 64 + p2;
        CC[i] = (f32x2){C.in[I_CRE][ci], C.in[I_CIM][ci]};
    }
    __syncthreads();
    {
        const int wv = tid >> 6, ln = tid & 63, hi = ln >> 5, i = ln & 31, h = 2 * wv + (i >> 4), hp = i & 15;
        f32x16 a0 = f32x16{}, a1 = f32x16{};
#pragma unroll 4
        for (int p = 0; p < 64; ++p) {
            const f32x2 c0 = CC[h * 64 + p], b0 = BB[p * 16 + hp], c1 = CC[1024 + h * 64 + p], b1 = BB[1024 + p * 16 + hp];
            const float x0 = hi == 0 ? (c0.x * b0.x - c0.y * b0.y) : -(c0.x * b0.y + c0.y * b0.x);
            const float x1 = hi == 0 ? (c1.x * b1.x - c1.y * b1.y) : -(c1.x * b1.y + c1.y * b1.x);
            a0 = __builtin_amdgcn_mfma_f32_32x32x2f32(x0, WT[(p * 2 + hi) * 32 + i], a0, 0, 0, 0);
            a1 = __builtin_amdgcn_mfma_f32_32x32x2f32(x1, WT[((64 + p) * 2 + hi) * 32 + i], a1, 0, 0, 0);
        }
        const float* sd = C.in[I_SSMD] + l * 512 + g * 16;
#pragma unroll
        for (int r = 0; r < 16; ++r) { const int rl = (r & 3) + 8 * (r >> 2) + 4 * hi, hh = 2 * wv + (rl >> 4), hq = rl & 15;
            float f = a0[r]; if (i == 0) f += a1[r] + (hh == hq ? sd[hh] : 0.f);
            KT[((31 + i) * 16 + hh) * 16 + hq] = (bf16)f2bf(f);
            if (i > 0) KT[((31 - i) * 16 + hh) * 16 + hq] = (bf16)f2bf(a1[r]); }
    }
    __syncthreads();
    bf16* B1 = WSP(bf16, WS_BT1) + (size_t)g * 768 * 512; bf16* B2 = WSP(bf16, WS_BT2) + (size_t)g * 512 * 256;
    for (int i = tid; i < 128 * 64; i += 512) {
        const int n = part * 128 + (i >> 6), ch = i & 63, t = n >> 4, h = n & 15, s = ch >> 1, hp0 = (ch & 1) * 8;
        *(GAS v4u*)(B1 + (size_t)n * 512 + ch * 8) = *(const LAS v4u*)(KT + ((t - s + 31) * 16 + h) * 16 + hp0);
    }
    for (int i = tid; i < 64 * 64; i += 512) {
        const int nn = part * 64 + (i >> 6), ch = i & 63, d = nn >> 7, p = (nn & 127) >> 1, ri = nn & 1, s = ch >> 1, hp0 = (ch & 1) * 8;
        const f32x2 w = POW[(d * 33 + (d == 0 ? 31 - s : s)) * 64 + p]; float v[8];
#pragma unroll
        for (int j = 0; j < 8; ++j) { const f32x2 b = BB[d * 1024 + p * 16 + hp0 + j]; v[j] = ri == 0 ? (w.x * b.x - w.y * b.y) : (w.x * b.y + w.y * b.x); }
        v4u o; o.x = pk2(v[0], v[1]); o.y = pk2(v[2], v[3]); o.z = pk2(v[4], v[5]); o.w = pk2(v[6], v[7]);
        *(GAS v4u*)(B1 + (size_t)(512 + nn) * 512 + ch * 8) = o;
    }
    for (int i = tid; i < 128 * 32; i += 512) {
        const int n = part * 128 + (i >> 5), ch = i & 31, t = n >> 4, h = n & 15, d = ch >> 4, p0 = (ch & 15) * 4; float v[8];
#pragma unroll
        for (int j = 0; j < 4; ++j) { const f32x2 c = CC[d * 1024 + h * 64 + p0 + j], w = POW[(d * 33 + (d == 0 ? t + 1 : 32 - t)) * 64 + p0 + j];
            v[2 * j] = c.x * w.x - c.y * w.y; v[2 * j + 1] = -(c.x * w.y + c.y * w.x); }
        v4u o; o.x = pk2(v[0], v[1]); o.y = pk2(v[2], v[3]); o.z = pk2(v[4], v[5]); o.w = pk2(v[6], v[7]);
        *(GAS v4u*)(B2 + (size_t)n * 256 + ch * 8) = o;
    }
    __syncthreads();
}

template <int MODE>
__device__ __forceinline__ void phase_rows(const Ctx& C, int l) {
    const int gw = C.vcu * NWAVES + C.wave, NGW = C.G * NWAVES, lane = C.lane;
    const float* MODl = WSP(float, WS_MOD) + (size_t)(MODE == 2 ? 0 : l) * 5 * 6144;
    const float* MODp = WSP(float, WS_MOD) + (size_t)(l > 0 ? l - 1 : 0) * 5 * 6144;
    const bf16* YS = WSP(bf16, WS_YSLOT);
    f32x4 nx[4]; v2u nb[4], na[4], nc[4];
#define ROWS_LOAD(mm) do { const int m_ = (mm); \
        if (MODE == 0) { const GAS f32x4* xr = (const GAS f32x4*)in_row(C, m_) + lane; _Pragma("unroll") for (int q = 0; q < 4; ++q) nx[q] = xr[64 * q]; } \
        else { const GAS v2u* xr = (const GAS v2u*)xs_row(C, m_) + lane; const GAS v2u* y0 = (const GAS v2u*)(YS + (size_t)(2 * m_) * D) + lane; const GAS v2u* y1 = (const GAS v2u*)(YS + (size_t)(2 * m_ + 1) * D) + lane; \
            _Pragma("unroll") for (int q = 0; q < 4; ++q) { nb[q] = xr[64 * q]; na[q] = y0[64 * q]; nc[q] = y1[64 * q]; } } } while (0)
    int m = gw; if (MODE == 2) { while (m < T && (m % LB) < CTX) m += NGW; }
    if (m < T) ROWS_LOAD(m);
    while (m < T) {
        const int b = m / LB, j = m - b * LB, cond = j < CTX ? 4 : b;
        f32x4 v[4];
        if (MODE == 0) {
#pragma unroll
            for (int q = 0; q < 4; ++q) v[q] = nx[q]; }
        else { const GAS f32x4* g2 = (const GAS f32x4*)(MODp + cond * 6144 + 5 * 1024) + lane;
#pragma unroll
            for (int q = 0; q < 4; ++q) { const f32x4 g = g2[64 * q]; const v2u a = na[q], c = nc[q], xb_ = nb[q];
                v[q] = (f32x4){bflo(xb_.x), bfhi(xb_.x), bflo(xb_.y), bfhi(xb_.y)} + g * (f32x4){bflo(a.x) + bflo(c.x), bfhi(a.x) + bfhi(c.x), bflo(a.y) + bflo(c.y), bfhi(a.y) + bfhi(c.y)}; } }
        int mn = m + NGW; if (MODE == 2) { while (mn < T && (mn % LB) < CTX) mn += NGW; }
        if (mn < T) ROWS_LOAD(mn);
        float ss = 0.f;
#pragma unroll
        for (int q = 0; q < 4; ++q) ss += (v[q].x * v[q].x + v[q].y * v[q].y) + (v[q].z * v[q].z + v[q].w * v[q].w);
        const float rstd = 1.f / sqrtf(wave_sum(ss, lane) * (1.f / D) + EPS);
        if (MODE == 2) { GAS f32x4* o = (GAS f32x4*)(C.out + (size_t)(b * SEQ + j - CTX) * D) + lane; const GAS f32x4* fg = (const GAS f32x4*)C.in[I_FNG] + lane;
#pragma unroll
            for (int q = 0; q < 4; ++q) o[64 * q] = v[q] * rstd * fg[64 * q]; }
        else { GAS v2u* xo = (GAS v2u*)xs_row(C, m) + lane; GAS v2u* ho = (GAS v2u*)(WSP(bf16, WS_HB) + (size_t)m * D) + lane; GAS unsigned* h8 = (GAS unsigned*)(WSP(unsigned char, WS_HB8) + (size_t)m * D) + lane;
            const GAS f32x4* ng = (const GAS f32x4*)(C.in[I_N1G] + l * D) + lane; const GAS f32x4* sh = (const GAS f32x4*)(MODl + cond * 6144) + lane; const GAS f32x4* sc = (const GAS f32x4*)(MODl + cond * 6144 + 1024) + lane;
#pragma unroll
            for (int q = 0; q < 4; ++q) { xo[64 * q] = (v2u){pk2(v[q].x, v[q].y), pk2(v[q].z, v[q].w)}; const f32x4 h = v[q] * rstd * ng[64 * q] * (sc[64 * q] + 1.f) + sh[64 * q]; if (!W8_ALL) ho[64 * q] = (v2u){pk2(h.x, h.y), pk2(h.z, h.w)}; if (H8_WRITE) h8[64 * q] = pk4_fp8(h.x, h.y, h.z, h.w); } }
        m = mn;
    }
#undef ROWS_LOAD
}

__device__ __forceinline__ void phase_qkprep(const Ctx& C, int l) {
    const int gw = C.vcu * NWAVES + C.wave, NGW = C.G * NWAVES, lane = C.lane, s8 = lane & 7;
    const float* qg = C.in[I_QNG] + l * 64 + 8 * s8; const float* kg = C.in[I_KNG] + l * 64 + 8 * s8;
    float gq[8], gk[8];
#pragma unroll
    for (int i = 0; i < 8; ++i) { gq[i] = qg[i]; gk[i] = kg[i]; }
    const int ax = s8 >> 2, f0 = 8 * (s8 & 1);
    float inv[8];
#pragma unroll
    for (int i = 0; i < 8; ++i) inv[i] = exp2f(-(float)(f0 + i) * 0.8304820237218406f) * 0.15915494309189535f;
    const int kl = lane & 15;
    v4u wq, wk;
    if (gw < T) { wq = *((const GAS v4u*)(WSP(bf16, WS_QA) + (size_t)gw * 512) + lane); wk = *((const GAS v4u*)(WSP(bf16, WS_KA) + (size_t)gw * 128) + kl); }
    for (int m = gw; m < T; m += NGW) {
        const int b = m / LB, j = m - b * LB; const bool lat = j >= CTX; const int tt = j - CTX; const float pos = (float)(ax == 0 ? (tt >> 6) : (tt & 63));
        const v4u cq = wq, ck = wk;
        if (m + NGW < T) { wq = *((const GAS v4u*)(WSP(bf16, WS_QA) + (size_t)(m + NGW) * 512) + lane); wk = *((const GAS v4u*)(WSP(bf16, WS_KA) + (size_t)(m + NGW) * 128) + kl); }
        float cs[8], sn[8];
#pragma unroll
        for (int i = 0; i < 8; ++i) { cs[i] = lat ? cos_rev(pos * inv[i]) : 1.f; sn[i] = lat ? sin_rev(pos * inv[i]) : 0.f; }
#pragma unroll
        for (int which = 0; which < 2; ++which) {
            const v4u w = which == 0 ? cq : ck; float x[8] = {bflo(w.x), bfhi(w.x), bflo(w.y), bfhi(w.y), bflo(w.z), bfhi(w.z), bflo(w.w), bfhi(w.w)};
            float ss = 0.f;
#pragma unroll
            for (int i = 0; i < 8; ++i) ss += x[i] * x[i];
            ss += dpp_mov<0xB1, 0xF>(ss); ss += dpp_mov<0x4E, 0xF>(ss); ss += dpp_mov<0x141, 0xF>(ss);
            const float rstd = 1.f / sqrtf(ss * (1.f / 64.f) + EPS);
            float y[8];
#pragma unroll
            for (int i = 0; i < 8; ++i) { const float xn = x[i] * rstd * (which == 0 ? gq[i] : gk[i]); const float other = dpp_mov<0x4E, 0xF>(xn);
                y[i] = (s8 & 2) ? (xn * cs[i] + other * sn[i]) : (xn * cs[i] - other * sn[i]); }
            const float sc = which == 0 ? C2 : 1.f;
            v4u o; o.x = pk2(y[0] * sc, y[1] * sc); o.y = pk2(y[2] * sc, y[3] * sc); o.z = pk2(y[4] * sc, y[5] * sc); o.w = pk2(y[6] * sc, y[7] * sc);
            if (which == 0) *((GAS v4u*)(WSP(bf16, WS_QA) + (size_t)m * 512) + lane) = o;
            else if (lane < 16) *((GAS v4u*)(WSP(bf16, WS_KA) + (size_t)m * 128) + lane) = o;
        }
    }
}

__device__ __forceinline__ void phase_carry(const Ctx& C, int l) {
    if (C.vcu >= 32) return;
    const int b = C.vcu >> 3, g = (C.vcu & 7) * 4 + (C.wave >> 1), d = C.wave & 1, p = C.lane;
    const int li = ((l * 2 + d) * 32 + g) * 64 + p;
    const float re = C.in[I_LRE][li], im = C.in[I_LIM][li], dt = __expf(C.in[I_LDT][(l * 2 + d) * 32 + g]);
    const float mag = __expf(re * dt * 32.f), rev = im * dt * 32.f * 0.15915494309189535f; const float Lr = mag * cos_rev(rev), Li = mag * sin_rev(rev);
    const GAS f32x2* S = (const GAS f32x2*)(WSP(float, WS_SST) + (size_t)(b * NCH) * 8192 + g * 256 + d * 128) + p;
    GAS unsigned* X = (GAS unsigned*)(WSP(bf16, WS_XST) + (size_t)(b * NCH) * 8192 + g * 256 + d * 128) + p;
    float sr = 0.f, si = 0.f;
    if (d == 0) {
        for (int c0 = 0; c0 < NCH; c0 += 8) { f32x2 s[8];
#pragma unroll
            for (int k = 0; k < 8; ++k) s[k] = S[(size_t)(c0 + k) * 4096];
#pragma unroll
            for (int k = 0; k < 8; ++k) { X[(size_t)(c0 + k) * 4096] = pk2(sr, si); const float nr = Lr * sr - Li * si + s[k].x, ni = Lr * si + Li * sr + s[k].y; sr = nr; si = ni; } }
    } else {
        for (int seg = 0; seg < 33; ++seg) { const int chi = seg == 0 ? 7 : NCH - 1 - (seg - 1) * 8; f32x2 s[8];
#pragma unroll
            for (int k = 0; k < 8; ++k) s[k] = S[(size_t)(chi - k) * 4096];
#pragma unroll
            for (int k = 0; k < 8; ++k) { X[(size_t)(chi - k) * 4096] = pk2(sr, si); const float nr = Lr * sr - Li * si + s[k].x, ni = Lr * si + Li * sr + s[k].y; sr = nr; si = ni; } }
    }
}

__device__ __forceinline__ void phase_norm2(const Ctx& C, int l) {
    LAS float* TILE = (LAS float*)C.lds;
    LAS float* PART = (LAS float*)(C.lds + 65792);
    LAS unsigned* REC = (LAS unsigned*)(C.lds + 73984);
    LAS float* LG = (LAS float*)(C.lds + 78080);
    LAS unsigned* LCNT = (LAS unsigned*)(C.lds + 94464);
    LAS float* GAM = (LAS float*)(C.lds + 94720);
    LAS float* SHF = (LAS float*)(C.lds + 115200);
    const int lane = C.lane, tid = C.tid;
    if (tid < 32) LCNT[tid] = 0u;
    const float* MODl = WSP(float, WS_MOD) + (size_t)l * 5 * 6144;
    for (int i = tid; i < 5 * 1024; i += 512) { const int cond = i >> 10, k = i & 1023; GAM[i] = C.in[I_N2G][l * D + k] * (MODl[cond * 6144 + 4096 + k] + 1.f); SHF[i] = MODl[cond * 6144 + 3072 + k]; }
    int nrows = 0; for (int m = C.vcu; m < T; m += C.G) ++nrows;
    __syncthreads();
    const int fn = lane & 15, kq = lane >> 4;
    float bw[32];
#pragma unroll
    for (int j = 0; j < 32; ++j) bw[j] = C.in[I_RW][(128 * C.wave + 32 * kq + j) * 16 + fn];
    v2u nx[2][4];
#define N2_LOAD(ii) do { _Pragma("unroll") for (int rr = 0; rr < 2; ++rr) { const int i_ = (ii) + rr * NWAVES; const int m_ = C.vcu + C.G * (i_ < nrows ? i_ : (ii)); const GAS v2u* xr = (const GAS v2u*)xs_row(C, m_) + lane; \
        _Pragma("unroll") for (int q = 0; q < 4; ++q) nx[rr][q] = xr[64 * q]; } } while (0)
    if (C.wave < nrows) N2_LOAD(C.wave);
    for (int i0 = 0; i0 < nrows; i0 += 2 * NWAVES) {
        const int i = i0 + C.wave; const bool has0 = i < nrows, has1 = i + NWAVES < nrows;
        if (has0) {
#pragma unroll
            for (int rr = 0; rr < 2; ++rr) { const int ir = (rr && has1) ? i + NWAVES : i; const int m = C.vcu + C.G * ir, cond = cond_of(m);
                GAS unsigned* h8 = (GAS unsigned*)(WSP(unsigned char, WS_HB8) + (size_t)m * D) + lane;
                const LAS f32x4* gm = (const LAS f32x4*)(GAM + cond * 1024) + lane; const LAS f32x4* sh = (const LAS f32x4*)(SHF + cond * 1024) + lane;
                float ss = 0.f; f32x4 xf[4];
#pragma unroll
                for (int q = 0; q < 4; ++q) { const v2u w_ = nx[rr][q]; const f32x4 v = (f32x4){bflo(w_.x), bfhi(w_.x), bflo(w_.y), bfhi(w_.y)}; xf[q] = v; ss += (v.x * v.x + v.y * v.y) + (v.z * v.z + v.w * v.w); }
                const float rstd = 1.f / sqrtf(wave_sum(ss, lane) * (1.f / D) + EPS);
#pragma unroll
                for (int q = 0; q < 4; ++q) { const f32x4 h = xf[q] * rstd * gm[64 * q] + sh[64 * q];
                    *(LAS f32x4*)(TILE + (C.wave + NWAVES * rr) * 1028 + 256 * q + 4 * lane) = h;
                    if (rr == 0 || has1) h8[64 * q] = pk4_fp8(h.x, h.y, h.z, h.w); } }
            if (i + 2 * NWAVES < nrows) N2_LOAD(i + 2 * NWAVES);
        } else {
#pragma unroll
            for (int rr = 0; rr < 2; ++rr)
#pragma unroll
                for (int q = 0; q < 4; ++q) *(LAS f32x4*)(TILE + (C.wave + NWAVES * rr) * 1028 + 256 * q + 4 * lane) = (f32x4){0.f, 0.f, 0.f, 0.f};
        }
        __syncthreads();
        f32x4 dacc = (f32x4){0.f, 0.f, 0.f, 0.f};
#pragma unroll
        for (int j = 0; j < 8; ++j) { const f32x4 a = *(const LAS f32x4*)(TILE + fn * 1028 + 128 * C.wave + 32 * kq + 4 * j);
#pragma unroll
            for (int e = 0; e < 4; ++e) dacc = __builtin_amdgcn_mfma_f32_16x16x4f32(a[e], bw[4 * j + e], dacc, 0, 0, 0); }
#pragma unroll
        for (int r = 0; r < 4; ++r) PART[C.wave * 256 + (4 * kq + r) * 16 + fn] = dacc[r];
        __syncthreads();
        if (tid < 256) { float sum = 0.f;
#pragma unroll
            for (int w = 0; w < NWAVES; ++w) sum += PART[w * 256 + tid];
            const int ri = i0 + (tid >> 4); if (ri < nrows) LG[ri * 16 + (tid & 15)] = sum; }
    }
#undef N2_LOAD
    __syncthreads();
    float rb[16];
#pragma unroll
    for (int e = 0; e < 16; ++e) rb[e] = C.in[I_RB][e];
    for (int i = tid; i < nrows; i += 512) {
        float lg[16];
#pragma unroll
        for (int q = 0; q < 4; ++q) { const f32x4 t = *(const LAS f32x4*)(LG + i * 16 + 4 * q); lg[4 * q] = t.x; lg[4 * q + 1] = t.y; lg[4 * q + 2] = t.z; lg[4 * q + 3] = t.w; }
        float mx = lg[0];
#pragma unroll
        for (int e = 1; e < 16; ++e) mx = fmaxf(mx, lg[e]);
        float pr[16], sel[16], sum = 0.f;
#pragma unroll
        for (int e = 0; e < 16; ++e) { pr[e] = __expf(lg[e] - mx); sum += pr[e]; }
        const float rs = 1.f / sum;
#pragma unroll
        for (int e = 0; e < 16; ++e) { pr[e] *= rs; sel[e] = pr[e] + rb[e]; }
        float bestv = -1e30f; int best = 0;
#pragma unroll
        for (int gq = 0; gq < 4; ++gq) { float m1 = -1e30f, m2 = -1e30f;
#pragma unroll
            for (int k = 0; k < 4; ++k) { const float s_ = sel[4 * gq + k]; if (s_ > m1) { m2 = m1; m1 = s_; } else if (s_ > m2) m2 = s_; }
            const float gs = m1 + m2; if (gs > bestv) { bestv = gs; best = gq; } }
        float s4[4], p4[4];
#pragma unroll
        for (int k = 0; k < 4; ++k) { s4[k] = best == 0 ? sel[k] : best == 1 ? sel[4 + k] : best == 2 ? sel[8 + k] : sel[12 + k]; p4[k] = best == 0 ? pr[k] : best == 1 ? pr[4 + k] : best == 2 ? pr[8 + k] : pr[12 + k]; }
        int i0 = 0; float v0 = s4[0], q0 = p4[0];
#pragma unroll
        for (int k = 1; k < 4; ++k) if (s4[k] > v0) { v0 = s4[k]; i0 = k; q0 = p4[k]; }
        int i1 = i0 == 0 ? 1 : 0; float v1 = -1e30f, q1 = p4[i0 == 0 ? 1 : 0];
#pragma unroll
        for (int k = 0; k < 4; ++k) if (k != i0 && s4[k] > v1) { v1 = s4[k]; i1 = k; q1 = p4[k]; }
        const int e0 = 4 * best + i0, e1 = 4 * best + i1; const float wn = 1.f / (q0 + q1);
        const unsigned lp0 = atomicAdd((unsigned*)(LCNT + e0), 1u), lp1 = atomicAdd((unsigned*)(LCNT + e1), 1u);
        REC[i * 4 + 0] = (unsigned)e0 | ((unsigned)e1 << 8) | (lp0 << 16); REC[i * 4 + 1] = lp1; REC[i * 4 + 2] = __float_as_uint(q0 * wn); REC[i * 4 + 3] = __float_as_uint(q1 * wn);
    }
    __syncthreads();
    if (tid < 16) LCNT[16 + tid] = __hip_atomic_fetch_add((unsigned*)(C.ctl + CW_CNT + l * 1024 + 64 * tid), LCNT[tid], RLX_AGENT);
    __syncthreads();
    int* LIST = WSP(int, WS_LIST); float* RWG = WSP(float, WS_RW);
    for (int i = tid; i < nrows; i += 512) { const int m = C.vcu + C.G * i; const unsigned r0 = REC[i * 4], r1 = REC[i * 4 + 1];
        const int e0 = r0 & 255, e1 = (r0 >> 8) & 255; const unsigned lp0 = r0 >> 16, lp1 = r1;
        LIST[(size_t)e0 * T + LCNT[16 + e0] + lp0] = 2 * m; LIST[(size_t)e1 * T + LCNT[16 + e1] + lp1] = 2 * m + 1;
        RWG[2 * m] = __uint_as_float(REC[i * 4 + 2]); RWG[2 * m + 1] = __uint_as_float(REC[i * 4 + 3]); }
    __syncthreads();
}
using pg8::Unit;
typedef f32x4 Acc[2][2][4][2];
__device__ __forceinline__ v4u pack8(const f32x4& a, const f32x4& b) { v4u w; w.x = cvt_pk_bf16(a[0], a[1]); w.y = cvt_pk_bf16(a[2], a[3]); w.z = cvt_pk_bf16(b[0], b[1]); w.w = cvt_pk_bf16(b[2], b[3]); return w; }
__device__ __forceinline__ void unpack8(const v4u& w, f32x4& a, f32x4& b) { a = (f32x4){bflo(w.x), bfhi(w.x), bflo(w.y), bfhi(w.y)}; b = (f32x4){bflo(w.z), bfhi(w.z), bflo(w.w), bfhi(w.w)}; }
#ifndef WT_MODE
#define WT_MODE 0
#endif
__device__ __forceinline__ void st16(void* p, const v4u& v) {
#if WT_MODE == 1
    asm volatile("global_store_dwordx4 %0, %1, off sc0 sc1" :: "v"(p), "v"(v) : "memory");
#elif WT_MODE == 2
    asm volatile("global_store_dwordx4 %0, %1, off nt" :: "v"(p), "v"(v) : "memory");
#else
    *(GAS v4u*)p = v;
#endif
}
__device__ __forceinline__ int chunk_m0(int cr) { return (cr / NCH) * LB + (cr % NCH) * 32; }

struct PWin {
    static constexpr bool EARLY_AOFF = false, FP8 = false; unsigned char* ws; int G, c; int K; unsigned kstepA;
    __device__ __forceinline__ bool next(int i, Unit& u) const { const long L = (long)i * G + c; if (L >= NPAN * 11) return false; pg8::static_decode((int)L, NPAN, 11, u.pm, u.pn); u.z = 0; return true; }
    __device__ __forceinline__ const char* a_base(const Unit& u) const { return (const char*)(ws + WS_HB) + (size_t)u.pm * 256 * 1024 * 2; }
    __device__ __forceinline__ unsigned a_off(const Unit&, int h, int R, int Cc) const { return (unsigned)((h * 128 + R) * 1024 + Cc) * 2u; }
    __device__ __forceinline__ const char* b_base(const Unit& u) const { return (const char*)(ws + WS_WIN) + (size_t)u.pn * 256 * 1024 * 2; }
    __device__ __forceinline__ void epi(const Acc& acc, const Unit& u, int wr, int wc, int fr, int fq) const {
        const int row0 = u.pm * 256 + wr * 64 + fr;
#pragma unroll
        for (int bj = 0; bj < 2; ++bj) {
            const int cb = u.pn * 256 + bj * 128; bf16* dst; int ld, col, mode = 0; float sc = 1.f;
            if (cb < 512) { dst = (bf16*)(ws + WS_U) + ((size_t)((cb + wc * 32 + 8 * fq) >> 4) * T) * 16 + ((8 * fq) & 15) - (wc * 32 + 8 * fq); ld = 16; col = 0; }
            else if (cb < 1024) { dst = (bf16*)(ws + WS_QA); ld = 512; col = cb - 512; }
            else if (cb == 1024) { dst = (bf16*)(ws + WS_KA); ld = 128; col = 0; }
            else if (cb == 1152) { dst = (bf16*)(ws + WS_VA); ld = 128; col = 0; }
            else if (cb < 1792) { dst = (bf16*)(ws + WS_QN); ld = 512; col = cb - 1280; sc = C2; }
            else if (cb < 2304) { dst = (bf16*)(ws + WS_KN); ld = 512; col = cb - 1792; }
            else { dst = (bf16*)(ws + WS_VN); ld = 512; col = cb - 2304; }
            const int c0 = col + wc * 32 + 8 * fq;
#pragma unroll
            for (int ai = 0; ai < 2; ++ai)
#pragma unroll
                for (int m = 0; m < 4; ++m) { f32x4 v0 = acc[ai][bj][m][0], v1 = acc[ai][bj][m][1];
                    if (mode) { v0 = (f32x4){fsigmoid(v0[0]), fsigmoid(v0[1]), fsigmoid(v0[2]), fsigmoid(v0[3])}; v1 = (f32x4){fsigmoid(v1[0]), fsigmoid(v1[1]), fsigmoid(v1[2]), fsigmoid(v1[3])}; }
                    else { v0 = v0 * sc; v1 = v1 * sc; }
                    st16(dst + (size_t)(row0 + ai * 128 + m * 16) * ld + c0, pack8(v0, v1)); __builtin_amdgcn_sched_barrier(0); }
        }
    }
};

struct PWin8 {
    static constexpr bool EARLY_AOFF = false, FP8 = true; unsigned char* ws; int G, c; int K; unsigned kstepA;
    __device__ __forceinline__ bool next(int i, Unit& u) const { const long L = (long)i * G + c; if (L >= 2 * NPAN * 23) return false; pg8::static_decode((int)L, 2 * NPAN, 23, u.pm, u.pn); u.z = 0; return true; }
    __device__ __forceinline__ const char* a_base(const Unit& u) const { return (const char*)(ws + WS_HB8) + (size_t)u.pm * 128 * 1024; }
    __device__ __forceinline__ unsigned a_off(const Unit&, int R, int Cc) const { return (unsigned)(R * 1024 + Cc * 2); }
    __device__ __forceinline__ const char* b_base(const Unit& u) const { return (const char*)(ws + WS_WIN) + (size_t)u.pn * 256 * 1024; }
    __device__ __forceinline__ void epi(const f32x4 (&acc)[2][4][2], f32x4 (&)[2][4][2], const Unit& u, int wr, int wc, int fr, int fq) const {
        const int row0 = u.pm * 128 + wr * 64 + fr;
#pragma unroll
        for (int bj = 0; bj < 2; ++bj) {
            const int cb = u.pn * 256 + bj * 128;
            if (cb >= 2816) { const int c0 = cb - 2816 + wc * 32 + 8 * fq;
#pragma unroll
                for (int m = 0; m < 4; ++m) { f32x4 v0 = acc[bj][m][0] * (1.f / 64.f), v1 = acc[bj][m][1] * (1.f / 64.f);
                    v0 = (f32x4){fsigmoid(v0[0]), fsigmoid(v0[1]), fsigmoid(v0[2]), fsigmoid(v0[3])}; v1 = (f32x4){fsigmoid(v1[0]), fsigmoid(v1[1]), fsigmoid(v1[2]), fsigmoid(v1[3])};
                    *(GAS v2u*)((unsigned char*)(ws + WS_GATES) + (size_t)(row0 + m * 16) * 3072 + c0) = (v2u){pk4_fp8(v0[0], v0[1], v0[2], v0[3]), pk4_fp8(v1[0], v1[1], v1[2], v1[3])}; }
            } else {
                bf16* dst; int ld, col; float sc = 1.f / 64.f;
                if (cb < 512) { dst = (bf16*)(ws + WS_U) + ((size_t)((cb + wc * 32 + 8 * fq) >> 4) * T) * 16 + ((8 * fq) & 15) - (wc * 32 + 8 * fq); ld = 16; col = 0; }
                else if (cb < 1024) { dst = (bf16*)(ws + WS_QA); ld = 512; col = cb - 512; }
                else if (cb == 1024) { dst = (bf16*)(ws + WS_KA); ld = 128; col = 0; }
                else if (cb == 1152) { dst = (bf16*)(ws + WS_VA); ld = 128; col = 0; }
                else if (cb < 1792) { dst = (bf16*)(ws + WS_QN); ld = 512; col = cb - 1280; sc = C2 / 64.f; }
                else if (cb < 2304) { dst = (bf16*)(ws + WS_KN); ld = 512; col = cb - 1792; }
                else { dst = (bf16*)(ws + WS_VN); ld = 512; col = cb - 2304; }
                const int c0 = col + wc * 32 + 8 * fq;
#pragma unroll
                for (int m = 0; m < 4; ++m) *(GAS v4u*)(dst + (size_t)(row0 + m * 16) * ld + c0) = pack8(acc[bj][m][0] * sc, acc[bj][m][1] * sc);
            }
        }
    }
};

struct PGate {
    static constexpr bool EARLY_AOFF = false, FP8 = !GATE_BF16; unsigned char* ws; int G, c; int K; unsigned kstepA;
    __device__ __forceinline__ bool next(int i, Unit& u) const { const long L = (long)i * G + c; if (L >= 2 * NPAN * 12) return false; pg8::static_decode((int)L, 2 * NPAN, 12, u.pm, u.pn); u.z = 0; return true; }
    __device__ __forceinline__ const char* a_base(const Unit& u) const { return GATE_BF16 ? (const char*)(ws + WS_HB) + (size_t)u.pm * 128 * 2048 : (const char*)(ws + WS_HB8) + (size_t)u.pm * 128 * 1024; }
    __device__ __forceinline__ unsigned a_off(const Unit&, int R, int Cc) const { return GATE_BF16 ? (unsigned)(R * 2048 + Cc * 2) : (unsigned)(R * 1024 + Cc * 2); }
    __device__ __forceinline__ const char* b_base(const Unit& u) const { return GATE_BF16 ? (const char*)(ws + WS_WIN) + (size_t)(2816 + u.pn * 256) * 2048 : (const char*)(ws + WS_WIN8) + (size_t)u.pn * 256 * 1024; }
    __device__ __forceinline__ void epi(const f32x4 (&acc)[2][4][2], f32x4 (&)[2][4][2], const Unit& u, int wr, int wc, int fr, int fq) const {
#pragma unroll
        for (int m = 0; m < 4; ++m) { const size_t r = (size_t)(u.pm * 128 + wr * 64 + m * 16 + fr);
#pragma unroll
            for (int bj = 0; bj < 2; ++bj) { const int c0 = u.pn * 256 + bj * 128 + wc * 32 + 8 * fq; f32x4 v0 = acc[bj][m][0] * (GATE_BF16 ? 1.f : 1.f / 64.f), v1 = acc[bj][m][1] * (GATE_BF16 ? 1.f : 1.f / 64.f);
                v0 = (f32x4){fsigmoid(v0[0]), fsigmoid(v0[1]), fsigmoid(v0[2]), fsigmoid(v0[3])}; v1 = (f32x4){fsigmoid(v1[0]), fsigmoid(v1[1]), fsigmoid(v1[2]), fsigmoid(v1[3])};
                if (GATE_BF16) *(GAS v4u*)((bf16*)(ws + WS_GATES) + r * 3072 + c0) = pack8(v0, v1);
                else *(GAS v2u*)((unsigned char*)(ws + WS_GATES) + r * 3072 + c0) = (v2u){pk4_fp8(v0[0], v0[1], v0[2], v0[3]), pk4_fp8(v1[0], v1[1], v1[2], v1[3])}; }
            __builtin_amdgcn_sched_barrier(0); }
    }
};

struct PS5A {
    static constexpr bool EARLY_AOFF = false, FP8 = false; unsigned char* ws; int G, c; int K; unsigned kstepA;
    __device__ __forceinline__ bool next(int i, Unit& u) const { const long L = (long)i * G + c; if (L >= 32 * 15) return false; const int l = (int)L; u.z = l / 15; const int r = l % 15; u.pm = r / 3; u.pn = r % 3; return true; }
    __device__ __forceinline__ const char* a_base(const Unit& u) const { return (const char*)(ws + WS_U) + (size_t)u.z * T * 32; }
    __device__ __forceinline__ unsigned a_off(const Unit& u, int h, int R, int Cc) const { int cr = u.pm * 256 + h * 128 + R; cr = cr < NCR ? cr : NCR - 1; return (unsigned)(cr * 512 + Cc) * 2u; }
    __device__ __forceinline__ const char* b_base(const Unit& u) const { return (const char*)(ws + WS_BT1) + ((size_t)u.z * 768 + u.pn * 256) * 512 * 2; }
    __device__ __forceinline__ void epi(const Acc& acc, const Unit& u, int wr, int wc, int fr, int fq) const {
#pragma unroll
        for (int ai = 0; ai < 2; ++ai)
#pragma unroll
            for (int m = 0; m < 4; ++m) { const int cr = u.pm * 256 + ai * 128 + wr * 64 + m * 16 + fr; if (cr >= NCR) continue;
#pragma unroll
                for (int bj = 0; bj < 2; ++bj) { const int n = bj * 128 + wc * 32 + 8 * fq;
                    if (u.pn < 2) *(GAS v4u*)((bf16*)(ws + WS_YG) + (size_t)u.z * T * 16 + (size_t)cr * 512 + u.pn * 256 + n) = pack8(acc[ai][bj][m][0], acc[ai][bj][m][1]);
                    else { GAS f32x4* o = (GAS f32x4*)((float*)(ws + WS_SST) + (size_t)cr * 8192 + u.z * 256 + n); o[0] = acc[ai][bj][m][0]; o[1] = acc[ai][bj][m][1]; } }
                __builtin_amdgcn_sched_barrier(0); }
    }
};

struct PS5B {
    static constexpr bool EARLY_AOFF = false, FP8 = false; unsigned char* ws; int G, c; int K; unsigned kstepA;
    __device__ __forceinline__ bool next(int i, Unit& u) const { const long L = (long)i * G + c; if (L >= 32 * 10) return false; const int l = (int)L; u.z = l / 10; const int r = l % 10; u.pm = r / 2; u.pn = r % 2; return true; }
    __device__ __forceinline__ const char* a_base(const Unit& u) const { return (const char*)(ws + WS_XST) + (size_t)u.z * 512; }
    __device__ __forceinline__ unsigned a_off(const Unit& u, int h, int R, int Cc) const { int cr = u.pm * 256 + h * 128 + R; cr = cr < NCR ? cr : NCR - 1; return (unsigned)(cr * 8192 + Cc) * 2u; }
    __device__ __forceinline__ const char* b_base(const Unit& u) const { return (const char*)(ws + WS_BT2) + ((size_t)u.z * 512 + u.pn * 256) * 256 * 2; }
    __device__ __forceinline__ void epi(const Acc& acc, const Unit& u, int wr, int wc, int fr, int fq) const {
#pragma unroll
        for (int ai = 0; ai < 2; ++ai) {
            v4u yw[4][2];
#pragma unroll
            for (int m = 0; m < 4; ++m) { int cr = u.pm * 256 + ai * 128 + wr * 64 + m * 16 + fr; cr = cr < NCR ? cr : NCR - 1;
#pragma unroll
                for (int bj = 0; bj < 2; ++bj) yw[m][bj] = *(const GAS v4u*)((const bf16*)(ws + WS_YG) + (size_t)u.z * T * 16 + (size_t)cr * 512 + u.pn * 256 + bj * 128 + wc * 32 + 8 * fq); }
#pragma unroll
            for (int m = 0; m < 4; ++m) { const int cr = u.pm * 256 + ai * 128 + wr * 64 + m * 16 + fr; if (cr >= NCR) continue;
#pragma unroll
                for (int bj = 0; bj < 2; ++bj) { const int nn = u.pn * 256 + bj * 128 + wc * 32 + 8 * fq, t = nn >> 4, h0 = nn & 15;
                    GAS v4u* p = (GAS v4u*)((bf16*)(ws + WS_YS) + (size_t)(chunk_m0(cr) + t) * 512 + u.z * 16 + h0);
                    f32x4 y0, y1; { const v4u w_ = yw[m][bj]; unpack8(w_, y0, y1); } y0 += acc[ai][bj][m][0]; y1 += acc[ai][bj][m][1];
                    y0 = (f32x4){gelu_tanh(y0[0]), gelu_tanh(y0[1]), gelu_tanh(y0[2]), gelu_tanh(y0[3])}; y1 = (f32x4){gelu_tanh(y1[0]), gelu_tanh(y1[1]), gelu_tanh(y1[2]), gelu_tanh(y1[3])};
                    *p = pack8(y0, y1); } } }
    }
};

__device__ __forceinline__ int half_panel(int hl, bool lat_only) { if (!lat_only) return hl; const int pl = hl >> 1; return 2 * (pl + (pl >> 5) + 1) + (hl & 1); }
struct PGlu {
    static constexpr bool EARLY_AOFF = false, FP8 = false; unsigned char* ws; int G, c; int K; unsigned kstepA; bool lat_only;
    __device__ __forceinline__ bool next(int i, Unit& u) const { const int nH = lat_only ? 256 : 2 * NPAN; const long L = (long)i * G + c; if (L >= nH * 2) return false; pg8::static_decode((int)L, nH, 2, u.pm, u.pn); u.pm = half_panel(u.pm, lat_only); u.z = 0; return true; }
    __device__ __forceinline__ const char* a_base(const Unit& u) const { return (const char*)(ws + WS_YS) + (size_t)u.pm * 128 * 512 * 2; }
    __device__ __forceinline__ unsigned a_off(const Unit&, int R, int Cc) const { return (unsigned)(R * 512 + Cc) * 2u; }
    __device__ __forceinline__ const char* b_base(const Unit& u) const { return (const char*)(ws + WS_WGLU) + (size_t)u.pn * 256 * 512 * 2; }
    __device__ __forceinline__ void epi(const f32x4 (&acc)[2][4][2], f32x4 (&)[2][4][2], const Unit& u, int wr, int wc, int fr, int fq) const {
        v4u zw[4][2];
#pragma unroll
        for (int m = 0; m < 4; ++m)
#pragma unroll
            for (int bj = 0; bj < 2; ++bj) zw[m][bj] = *(const GAS v4u*)((const bf16*)(ws + WS_YS) + (size_t)(u.pm * 128 + wr * 64 + m * 16 + fr) * 512 + u.pn * 256 + bj * 128 + wc * 32 + 8 * fq);
#pragma unroll
        for (int m = 0; m < 4; ++m) { const size_t r = (size_t)(u.pm * 128 + wr * 64 + m * 16 + fr);
#pragma unroll
            for (int bj = 0; bj < 2; ++bj) { const int cc = u.pn * 256 + bj * 128 + wc * 32 + 8 * fq;
                f32x4 z0, z1; { const v4u w_ = zw[m][bj]; unpack8(w_, z0, z1); } const f32x4 a0 = acc[bj][m][0], a1 = acc[bj][m][1];
                z0 = z0 * (f32x4){fsigmoid(a0[0]), fsigmoid(a0[1]), fsigmoid(a0[2]), fsigmoid(a0[3])}; z1 = z1 * (f32x4){fsigmoid(a1[0]), fsigmoid(a1[1]), fsigmoid(a1[2]), fsigmoid(a1[3])};
                *(GAS v4u*)((bf16*)(ws + WS_U) + r * 512 + cc) = pack8(z0, z1); } }
    }
};

typedef f32x4 Acc128[2][4][2];
struct PMerge {
    static constexpr bool EARLY_AOFF = false, FP8 = false; unsigned char* ws; int G, c; int K; unsigned kstepA; bool lat_only;
    __device__ __forceinline__ bool next(int i, Unit& u) const { const int nH = lat_only ? 256 : 2 * NPAN; const long tile = (long)(i / 3) * G + c; if (tile >= nH * 4) return false; pg8::static_decode((int)tile, nH, 4, u.pm, u.pn); u.pm = half_panel(u.pm, lat_only); u.z = i % 3; return true; }
    __device__ __forceinline__ const char* a_base(const Unit& u) const { const size_t off = u.z == 0 ? WS_U : (u.z == 1 ? WS_AO : WS_NO); return (const char*)(ws + off) + (size_t)u.pm * 128 * 512 * 2; }
    __device__ __forceinline__ unsigned a_off(const Unit&, int R, int Cc) const { return (unsigned)(R * 512 + Cc) * 2u; }
    __device__ __forceinline__ const char* b_base(const Unit& u) const { return (const char*)(ws + WS_WBR) + ((size_t)u.z * 1024 + u.pn * 256) * 512 * 2; }
    __device__ __forceinline__ void epi(const Acc128& acc, Acc128& mrg, const Unit& u, int wr, int wc, int fr, int fq) const {
        v2u gw[4][2];
#pragma unroll
        for (int m = 0; m < 4; ++m)
#pragma unroll
            for (int bj = 0; bj < 2; ++bj) gw[m][bj] = *(const GAS v2u*)((const unsigned char*)(ws + WS_GATES) + (size_t)(u.pm * 128 + wr * 64 + m * 16 + fr) * 3072 + u.z * 1024 + u.pn * 256 + bj * 128 + wc * 32 + 8 * fq);
#pragma unroll
        for (int m = 0; m < 4; ++m) { const size_t r = (size_t)(u.pm * 128 + wr * 64 + m * 16 + fr);
#pragma unroll
            for (int bj = 0; bj < 2; ++bj) { const int cc = u.pn * 256 + bj * 128 + wc * 32 + 8 * fq; const v2u w_ = gw[m][bj];
                const f32x4 g0 = (f32x4){__builtin_amdgcn_cvt_f32_fp8((int)w_.x, 0), __builtin_amdgcn_cvt_f32_fp8((int)w_.x, 1), __builtin_amdgcn_cvt_f32_fp8((int)w_.x, 2), __builtin_amdgcn_cvt_f32_fp8((int)w_.x, 3)};
                const f32x4 g1 = (f32x4){__builtin_amdgcn_cvt_f32_fp8((int)w_.y, 0), __builtin_amdgcn_cvt_f32_fp8((int)w_.y, 1), __builtin_amdgcn_cvt_f32_fp8((int)w_.y, 2), __builtin_amdgcn_cvt_f32_fp8((int)w_.y, 3)};
                if (u.z == 0) { mrg[bj][m][0] = g0 * acc[bj][m][0]; mrg[bj][m][1] = g1 * acc[bj][m][1]; }
                else { mrg[bj][m][0] += g0 * acc[bj][m][0]; mrg[bj][m][1] += g1 * acc[bj][m][1]; }
                if (u.z == 2) *(GAS v4u*)((bf16*)(ws + WS_HB) + r * 1024 + cc) = pack8(mrg[bj][m][0], mrg[bj][m][1]); } }
    }
};

struct PWout {
    static constexpr bool EARLY_AOFF = false, FP8 = false; unsigned char* ws; float* out; const float* mod; int G, c; int K; unsigned kstepA; bool lat_only;
    __device__ __forceinline__ bool next(int i, Unit& u) const { const int nH = lat_only ? 256 : 2 * NPAN; const long L = (long)i * G + c; if (L >= nH * 4) return false; pg8::static_decode((int)L, nH, 4, u.pm, u.pn); u.pm = half_panel(u.pm, lat_only); u.z = 0; return true; }
    __device__ __forceinline__ const char* a_base(const Unit& u) const { return (const char*)(ws + WS_HB) + (size_t)u.pm * 128 * 1024 * 2; }
    __device__ __forceinline__ unsigned a_off(const Unit&, int R, int Cc) const { return (unsigned)(R * 1024 + Cc) * 2u; }
    __device__ __forceinline__ const char* b_base(const Unit& u) const { return (const char*)(ws + WS_WOUT) + (size_t)u.pn * 256 * 1024 * 2; }
    __device__ __forceinline__ void epi(const f32x4 (&acc)[2][4][2], f32x4 (&)[2][4][2], const Unit& u, int wr, int wc, int fr, int fq) const {
        const int pm = u.pm >> 1, b = pm / 33, pr = pm % 33, cond = pr == 0 ? 4 : b;
        bf16* xb = (bf16*)(ws + WS_XS) + (size_t)u.pm * 128 * D;
        const float* g1 = mod + cond * 6144 + 2048;
        v4u xv[2][4];
#pragma unroll
        for (int bj = 0; bj < 2; ++bj)
#pragma unroll
            for (int m = 0; m < 4; ++m) xv[bj][m] = *(const GAS v4u*)(xb + (size_t)(wr * 64 + m * 16 + fr) * D + u.pn * 256 + bj * 128 + wc * 32 + 8 * fq);
#pragma unroll
        for (int bj = 0; bj < 2; ++bj) { const int cc = u.pn * 256 + bj * 128 + wc * 32 + 8 * fq; const f32x4 ga = *(const GAS f32x4*)(g1 + cc), gb = *(const GAS f32x4*)(g1 + cc + 4);
#pragma unroll
            for (int m = 0; m < 4; ++m) { f32x4 x0, x1; { const v4u w_ = xv[bj][m]; unpack8(w_, x0, x1); }
                *(GAS v4u*)(xb + (size_t)(wr * 64 + m * 16 + fr) * D + cc) = pack8(x0 + ga * acc[bj][m][0], x1 + gb * acc[bj][m][1]); } }
    }
};

struct ExpTab { int cnt[16], tile0[17]; };
__device__ __forceinline__ int exp_find(const int (&tile0)[17], int q) { int e = 0;
#pragma unroll
    for (int k = 1; k < 16; ++k) e += (q >= tile0[k]) ? 1 : 0;
    return e; }

struct PMoe1 {
    static constexpr bool EARLY_AOFF = true, FP8 = true; unsigned char* ws; const LAS int* tab; int G, c; int K; unsigned kstepA;
    __device__ __forceinline__ bool next(int i, Unit& u) const { const long L = (long)i * G + c; const int total = __builtin_amdgcn_readfirstlane(tab[32]) * 4; if (L >= total) return false; const int q = (int)L >> 2; u.pn = (int)L & 3;
        int e = 0;
#pragma unroll
        for (int k = 1; k < 16; ++k) e += (q >= __builtin_amdgcn_readfirstlane(tab[16 + k])) ? 1 : 0;
        u.z = e; u.pm = q - __builtin_amdgcn_readfirstlane(tab[16 + e]); return true; }
    __device__ __forceinline__ const char* a_base(const Unit&) const { return (const char*)(ws + WS_HB8); }
    __device__ __forceinline__ unsigned a_off(const Unit& u, int R, int Cc) const { int r = u.pm * 128 + R; const int n = __builtin_amdgcn_readfirstlane(tab[u.z]); r = r < n ? r : n - 1;
        const int ent = ((const int*)(ws + WS_LIST))[(size_t)u.z * T + r]; return (unsigned)((ent >> 1) * 1024 + Cc * 2); }
    __device__ __forceinline__ const char* b_base(const Unit& u) const { return (const char*)(ws + WS_MOE1) + ((size_t)u.z * 1024 + u.pn * 256) * 1024; }
    __device__ __forceinline__ void epi(const f32x4 (&acc)[2][4][2], f32x4 (&)[2][4][2], const Unit& u, int wr, int wc, int fr, int fq) const {
        const size_t arow0 = (size_t)(__builtin_amdgcn_readfirstlane(tab[16 + u.z]) + u.pm) * 128;
#pragma unroll
        for (int m = 0; m < 4; ++m) { const f32x4 g0 = acc[0][m][0] * (1.f / 64.f), g1 = acc[0][m][1] * (1.f / 64.f), u0 = acc[1][m][0] * (8.f / 64.f), u1 = acc[1][m][1] * (8.f / 64.f);
            const f32x4 v0 = (f32x4){g0[0] * fsigmoid(g0[0]), g0[1] * fsigmoid(g0[1]), g0[2] * fsigmoid(g0[2]), g0[3] * fsigmoid(g0[3])} * u0;
            const f32x4 v1 = (f32x4){g1[0] * fsigmoid(g1[0]), g1[1] * fsigmoid(g1[1]), g1[2] * fsigmoid(g1[2]), g1[3] * fsigmoid(g1[3])} * u1;
            *(GAS v2u*)((unsigned char*)(ws + WS_ACT) + (arow0 + wr * 64 + m * 16 + fr) * 512 + u.pn * 128 + wc * 32 + 8 * fq) = (v2u){pk4_fp8(v0[0], v0[1], v0[2], v0[3]), pk4_fp8(v1[0], v1[1], v1[2], v1[3])}; }
    }
};
struct PMoe2 {
    static constexpr bool EARLY_AOFF = false, FP8 = true; unsigned char* ws; const LAS int* tab; int G, c; int K; unsigned kstepA;
    __device__ __forceinline__ bool next(int i, Unit& u) const { const long L = (long)i * G + c; const int total = __builtin_amdgcn_readfirstlane(tab[32]) * 4; if (L >= total) return false; const int q = (int)L >> 2; u.pn = (int)L & 3;
        int e = 0;
#pragma unroll
        for (int k = 1; k < 16; ++k) e += (q >= __builtin_amdgcn_readfirstlane(tab[16 + k])) ? 1 : 0;
        u.z = e; u.pm = q - __builtin_amdgcn_readfirstlane(tab[16 + e]); return true; }
    __device__ __forceinline__ const char* a_base(const Unit& u) const { return (const char*)(ws + WS_ACT) + (size_t)(__builtin_amdgcn_readfirstlane(tab[16 + u.z]) + u.pm) * 128 * 512; }
    __device__ __forceinline__ unsigned a_off(const Unit&, int R, int Cc) const { return (unsigned)(R * 512 + Cc * 2); }
    __device__ __forceinline__ const char* b_base(const Unit& u) const { return (const char*)(ws + WS_MOE2) + ((size_t)u.z * 1024 + u.pn * 256) * 512; }
    __device__ __forceinline__ void epi(const f32x4 (&acc)[2][4][2], f32x4 (&)[2][4][2], const Unit& u, int wr, int wc, int fr, int fq) const {
        const int n = __builtin_amdgcn_readfirstlane(tab[u.z]);
        int entv[4]; float wv[4];
#pragma unroll
        for (int m = 0; m < 4; ++m) { int r = u.pm * 128 + wr * 64 + m * 16 + fr; r = r < n ? r : n - 1; entv[m] = ((const int*)(ws + WS_LIST))[(size_t)u.z * T + r]; }
#pragma unroll
        for (int m = 0; m < 4; ++m) wv[m] = ((const float*)(ws + WS_RW))[entv[m]] * (1.f / 256.f);
#pragma unroll
        for (int m = 0; m < 4; ++m) { const int r = u.pm * 128 + wr * 64 + m * 16 + fr; if (r >= n) continue;
            const int ent = entv[m]; const float w = wv[m];
#pragma unroll
            for (int bj = 0; bj < 2; ++bj)
                *(GAS v4u*)((bf16*)(ws + WS_YSLOT) + (size_t)ent * 1024 + u.pn * 256 + bj * 128 + wc * 32 + 8 * fq) = pack8(acc[bj][m][0] * w, acc[bj][m][1] * w); }
    }
};
struct PMoe1B {
    static constexpr bool EARLY_AOFF = true, FP8 = false; unsigned char* ws; const LAS int* tab; int G, c; int K; unsigned kstepA;
    __device__ __forceinline__ bool next(int i, Unit& u) const { const long L = (long)i * G + c; const int total = tab[32] * 4; if (L >= total) return false; const int q = (int)L >> 2; u.pn = (int)L & 3;
        int e = 0;
#pragma unroll
        for (int k = 1; k < 16; ++k) e += (q >= tab[16 + k]) ? 1 : 0;
        u.z = e; u.pm = q - tab[16 + e]; return true; }
    __device__ __forceinline__ const char* a_base(const Unit&) const { return (const char*)(ws + WS_HB); }
    __device__ __forceinline__ unsigned a_off(const Unit& u, int h, int R, int Cc) const { int r = u.pm * 256 + h * 128 + R; const int n = tab[u.z]; r = r < n ? r : n - 1;
        const int ent = ((const int*)(ws + WS_LIST))[(size_t)u.z * T + r]; return (unsigned)((ent >> 1) * 1024 + Cc) * 2u; }
    __device__ __forceinline__ const char* b_base(const Unit& u) const { return (const char*)(ws + WS_MOE1) + ((size_t)u.z * 1024 + u.pn * 256) * 1024 * 2; }
    __device__ __forceinline__ void epi(const Acc& acc, const Unit& u, int wr, int wc, int fr, int fq) const {
        const size_t arow0 = (size_t)(tab[16 + u.z] + u.pm) * 256;
#pragma unroll
        for (int ai = 0; ai < 2; ++ai)
#pragma unroll
            for (int m = 0; m < 4; ++m) { const f32x4 g0 = acc[ai][0][m][0], g1 = acc[ai][0][m][1], u0 = acc[ai][1][m][0], u1 = acc[ai][1][m][1];
                const f32x4 v0 = (f32x4){g0[0] * fsigmoid(g0[0]), g0[1] * fsigmoid(g0[1]), g0[2] * fsigmoid(g0[2]), g0[3] * fsigmoid(g0[3])} * u0;
                const f32x4 v1 = (f32x4){g1[0] * fsigmoid(g1[0]), g1[1] * fsigmoid(g1[1]), g1[2] * fsigmoid(g1[2]), g1[3] * fsigmoid(g1[3])} * u1;
                *(GAS v4u*)((bf16*)(ws + WS_ACTB) + (arow0 + ai * 128 + wr * 64 + m * 16 + fr) * 512 + u.pn * 128 + wc * 32 + 8 * fq) = pack8(v0, v1); }
    }
};
struct PMoe2B {
    static constexpr bool EARLY_AOFF = false, FP8 = false; unsigned char* ws; const LAS int* tab; int G, c; int K; unsigned kstepA;
    __device__ __forceinline__ bool next(int i, Unit& u) const { const long L = (long)i * G + c; const int total = tab[32] * 4; if (L >= total) return false; const int q = (int)L >> 2; u.pn = (int)L & 3;
        int e = 0;
#pragma unroll
        for (int k = 1; k < 16; ++k) e += (q >= tab[16 + k]) ? 1 : 0;
        u.z = e; u.pm = q - tab[16 + e]; return true; }
    __device__ __forceinline__ const char* a_base(const Unit& u) const { return (const char*)(ws + WS_ACTB) + (size_t)(tab[16 + u.z] + u.pm) * 256 * 512 * 2; }
    __device__ __forceinline__ unsigned a_off(const Unit&, int h, int R, int Cc) const { return (unsigned)((h * 128 + R) * 512 + Cc) * 2u; }
    __device__ __forceinline__ const char* b_base(const Unit& u) const { return (const char*)(ws + WS_MOE2) + ((size_t)u.z * 1024 + u.pn * 256) * 512 * 2; }
    __device__ __forceinline__ void epi(const Acc& acc, const Unit& u, int wr, int wc, int fr, int fq) const {
        const int n = tab[u.z];
#pragma unroll
        for (int ai = 0; ai < 2; ++ai)
#pragma unroll
            for (int m = 0; m < 4; ++m) { const int r = u.pm * 256 + ai * 128 + wr * 64 + m * 16 + fr; if (r >= n) continue;
                const int ent = ((const int*)(ws + WS_LIST))[(size_t)u.z * T + r]; const float w = ((const float*)(ws + WS_RW))[ent];
#pragma unroll
                for (int bj = 0; bj < 2; ++bj)
                    *(GAS v4u*)((bf16*)(ws + WS_YSLOT) + (size_t)ent * 1024 + u.pn * 256 + bj * 128 + wc * 32 + 8 * fq) = pack8(acc[ai][bj][m][0] * w, acc[ai][bj][m][1] * w); }
    }
};
__device__ __forceinline__ void build_exptab(const Ctx& C, LAS int* tab, int l, int tsh = 7) {
    __syncthreads();
    if (threadIdx.x == 0) { int t0 = 0;
        for (int e = 0; e < 16; ++e) { const int n = (int)__hip_atomic_load((unsigned*)(C.ctl + CW_CNT + l * 1024 + 64 * e), RLX_AGENT); tab[e] = n; tab[16 + e] = t0; t0 += (n + (1 << tsh) - 1) >> tsh; }
        tab[32] = t0; }
    __syncthreads();
}
__device__ __forceinline__ void phase_attn(const Ctx& C, int l, unsigned char* lds_gen) {
    phase_carry(C, l);
    char* shm = (char*)lds_gen;
    bf16* QA = WSP(bf16, WS_QA); bf16* KA = WSP(bf16, WS_KA); bf16* VA = WSP(bf16, WS_VA); bf16* QN = WSP(bf16, WS_QN); bf16* KN = WSP(bf16, WS_KN); bf16* VN = WSP(bf16, WS_VN);
#ifndef ATTN_SEL
#define ATTN_SEL 3
#endif
#ifdef REPMASK
#define REPMASK_ REPMASK
#else
#define REPMASK_ 0
#endif
    const int per = (1024 + C.G - 1) / C.G;
    bool nomax; { float gq = 0.f, gk = 0.f; for (int i = 0; i < 64; ++i) { gq = fmaxf(gq, fabsf(C.in[I_QNG][l * 64 + i])); gk = fmaxf(gk, fabsf(C.in[I_KNG][l * 64 + i])); } nomax = 64.f * gq * gk * C2 <= 60.f; }
    if (ATTN_SEL & 1) for (int i = 0; i < per * (1 + ((REPMASK_ >> 13) & 1)); ++i) { const int id = C.vcu * per + (i % per); if (id >= 1024) continue; const int bh = id >> 5, b = bh >> 3, h = bh & 7, qb = id & 31;
        const bf16* Qu = QA + (size_t)(b * LB + CTX + qb * 256) * 512 + h * 64;
        if (nomax) attn_body::attn_unit<8, false, 512, 128, true>(Qu, 512, KA + (size_t)(b * LB) * 128 + (h >> 2) * 64, VA + (size_t)(b * LB) * 128 + (h >> 2) * 64, 128, WSP(bf16, WS_AO) + (Qu - QA), LB / 64, 0, 0, shm);
        else attn_body::attn_unit<8, false, 512, 128, false>(Qu, 512, KA + (size_t)(b * LB) * 128 + (h >> 2) * 64, VA + (size_t)(b * LB) * 128 + (h >> 2) * 64, 128, WSP(bf16, WS_AO) + (Qu - QA), LB / 64, 0, 0, shm);
    }
    LAS float* bt = (LAS float*)(C.lds + attn_body::LDS_BT);
    const int nctx = (C.vcu >= 64 && C.vcu < 128) ? 1 : 0;
    if (ATTN_SEL & 2) for (int i0 = 0; i0 < (per + nctx) * (1 + ((REPMASK_ >> 14) & 1)); ++i0) { const int i = i0 % (per + nctx);
        const bf16 *Qu, *Kh, *Vh; bf16* Ou; int kvp = 512, NT = 4, r0 = 0, rlo = 0;
        if (i < per) { const int id = C.vcu * per + i; if (id >= 1024) continue; const int bh = id >> 5, b = bh >> 3, h = bh & 7; r0 = (id & 31) * 4;
            const float* rp = C.in[I_RPB] + (size_t)(l * 8 + h) * 465;
            for (int k = C.tid; k < 465; k += 512) bt[k] = rp[k] * LOG2E;
            rlo = r0 - 4 < 0 ? 0 : (r0 - 4 > 120 ? 120 : r0 - 4); const int rh_ = r0 - 1 < 0 ? 0 : (r0 - 1 > 120 ? 120 : r0 - 1), nloc = rh_ + 8 - rlo; NT = (4 + nloc + 1) & ~1;
            Qu = QN + (size_t)(b * LB + CTX + r0 * 64) * 512 + h * 64; Ou = WSP(bf16, WS_NO) + (Qu - QN); Kh = KN + (size_t)(b * LB) * 512 + h * 64; Vh = VN + (size_t)(b * LB) * 512 + h * 64; }
        else { int j = C.vcu - 64; if (j < 32) { const int b = j >> 3, h = j & 7; Qu = QA + (size_t)(b * LB) * 512 + h * 64; Ou = WSP(bf16, WS_AO) + (Qu - QA); Kh = KA + (size_t)(b * LB) * 128 + (h >> 2) * 64; Vh = VA + (size_t)(b * LB) * 128 + (h >> 2) * 64; kvp = 128; }
            else { j -= 32; const int b = j >> 3, h = j & 7; Qu = QN + (size_t)(b * LB) * 512 + h * 64; Ou = WSP(bf16, WS_NO) + (Qu - QN); Kh = KN + (size_t)(b * LB) * 512 + h * 64; Vh = VN + (size_t)(b * LB) * 512 + h * 64; } }
        attn_body::attn_unit<8, true, 512, 0>(Qu, 512, Kh, Vh, kvp, Ou, NT, r0, rlo, shm);
    }
}

constexpr int NPH = 46;
__global__ void __launch_bounds__(NWAVES * 64, 2) fwd(Args args) {
    extern __shared__ __attribute__((aligned(16))) unsigned char lds[];
    Ctx C; C.in = (const __attribute__((address_space(4))) CFP*)__builtin_amdgcn_kernarg_segment_ptr(); C.out = args.out; C.ws = args.ws; C.lds = (LAS unsigned char*)lds; C.ctl = (gu32*)(args.ws + WS_CTL);
    C.tid = 0; C.lane = 0; C.wave = __builtin_amdgcn_readfirstlane((int)threadIdx.x >> 6);
    C.G = gridDim.x; { const int bx = blockIdx.x; C.vcu = (C.G % 8 == 0) ? (bx % 8) * (C.G / 8) + bx / 8 : bx; }
    for (int u = threadIdx.x; u < (LDS_BYTES - LDSCTL_OFF) / 4; u += NWAVES * 64) ((LAS unsigned*)(C.lds + LDSCTL_OFF))[u] = 0u;
    __syncthreads();
    const int lo = args.ph_lo, hi = args.ph_hi;
    XcdBarrier bar; bar.bar = (unsigned*)(C.ctl + CW_BAR); bar.x = 0; bar.st = nullptr;
    if (hi - lo > 1) bar = xcd_barrier_post((unsigned*)(C.ctl + CW_BAR), (volatile LAS unsigned*)(C.lds + MISC_OFF) + 8);
    LAS int* tab = (LAS int*)(C.lds + LDSCTL_OFF);
    const int cg = (int)blockIdx.x;
#ifndef PHMASK
#define PHMASK 0xFFFF
#endif
#define IN(k) (lo <= (k) && (k) < hi)
#define EN(b) ((PHMASK >> (b)) & 1)
#ifndef REPMASK
#define REPMASK 0
#endif
#define RUN(b, stmt) do { stmt; if ((REPMASK >> (b)) & 1) { stmt; } } while (0)
#ifdef DIAG_SEL
#define DIAG_ACC(ty) do { if (blockIdx.x == 0 && threadIdx.x == 0) { volatile LAS unsigned* dg = (volatile LAS unsigned*)(C.lds + LDSCTL_OFF + 160); const unsigned now = (unsigned)__builtin_amdgcn_s_memrealtime(); dg[8 + (ty)] += now - dg[0]; dg[0] = now; } } while (0)
#else
#define DIAG_ACC(ty) do {} while (0)
#endif
#define SEAM(k) do { if (IN(k) && IN((k) + 1)) xcd_barrier(bar); DIAG_ACC((k) == 0 ? 11 : ((k) - 1) % 11); } while (0)
#define LWS() ({ const __attribute__((address_space(4))) CFP* k_ = C.in; asm volatile("" : "+s"(k_)); (unsigned char*)k_[30]; })
#define LC() ({ Ctx c_ = C; c_.tid = threadIdx.x; asm volatile("" : "+v"(c_.tid)); c_.lane = c_.tid & 63; asm volatile("" : "+s"(c_.in)); c_.ws = (unsigned char*)c_.in[30]; c_.out = (float*)c_.in[29]; c_.ctl = (gu32*)(c_.ws + WS_CTL); c_; })
#ifdef DIAG_SEL
    if (blockIdx.x == 0 && threadIdx.x == 0) { volatile LAS unsigned* dg = (volatile LAS unsigned*)(C.lds + LDSCTL_OFF + 160); dg[0] = (unsigned)__builtin_amdgcn_s_memrealtime(); dg[1] = dg[0]; }
#endif
    if (EN(11) && IN(0)) { const Ctx Cl = LC(); phase_mod(Cl); RUN(11, phase_s5mats(Cl, 0, Cl.vcu); phase_weights(Cl, 0)); }
    SEAM(0);
    for (int l = 0; l < NLAYER; ++l) {
        const int pb = 1 + 11 * l;
        if (EN(0) && IN(pb)) { const Ctx Cl = LC(); if (l == 0) phase_rows<0>(Cl, 0); else { phase_weights(Cl, l); phase_rows<1>(Cl, l); } }
        SEAM(pb);
        if (EN(1) && IN(pb + 1)) { if (W8_ALL) { PWin8 P{LWS(), C.G, cg, 1024, 128u}; pg8::gemm_phase_m128(C.lds, P); } else { { PWin P{LWS(), C.G, cg, 1024, 128u}; pg8::gemm_phase(C.lds, P); } { PGate P{LWS(), C.G, cg, 1024, 128u}; pg8::gemm_phase_m128(C.lds, P); } } }
        SEAM(pb + 1);
        if (EN(2) && IN(pb + 2)) { { const Ctx Cl = LC(); phase_qkprep(Cl, l); } PS5A P{LWS(), C.G, cg, 512, 128u}; RUN(2, pg8::gemm_phase(C.lds, P)); }
        SEAM(pb + 2);
        if (EN(3) && IN(pb + 3)) { const Ctx Cl = LC(); RUN(3, phase_attn(Cl, l, lds)); }
        SEAM(pb + 3);
        if (EN(4) && IN(pb + 4)) { PS5B P{LWS(), C.G, cg, 256, 128u}; pg8::gemm_phase(C.lds, P); }
        SEAM(pb + 4);
        if (EN(5) && IN(pb + 5)) { PGlu P{LWS(), C.G, cg, 512, 128u, l == NLAYER - 1}; pg8::gemm_phase_m128(C.lds, P); }
        SEAM(pb + 5);
        if (EN(6) && IN(pb + 6)) { { PMerge P{LWS(), C.G, cg, 512, 128u, l == NLAYER - 1}; pg8::gemm_phase_m128(C.lds, P); }
            if (l < NLAYER - 1) { const Ctx Cl = LC(); phase_s5mats(Cl, l + 1, C.G >= 160 ? cg - 32 : cg); } }
        SEAM(pb + 6);
        if (EN(7) && IN(pb + 7)) { unsigned char* wl_ = LWS(); PWout P{wl_, (float*)C.in[29], (const float*)(wl_ + WS_MOD) + (size_t)l * 5 * 6144, C.G, cg, 1024, 128u, l == NLAYER - 1}; pg8::gemm_phase_m128(C.lds, P); }
        SEAM(pb + 7);
        if (EN(8) && IN(pb + 8)) { const Ctx Cl = LC(); phase_norm2(Cl, l); }
        SEAM(pb + 8);
        if (EN(9) && IN(pb + 9)) { if (FP8_MOE) { build_exptab(C, tab, l); PMoe1 P{LWS(), tab, C.G, cg, 1024, 128u}; pg8::gemm_phase_m128(C.lds, P); } else { build_exptab(C, tab, l, 8); PMoe1B P{LWS(), tab, C.G, cg, 1024, 128u}; pg8::gemm_phase(C.lds, P); } }
        SEAM(pb + 9);
        if (EN(10) && IN(pb + 10)) { if (FP8_MOE) { build_exptab(C, tab, l); PMoe2 P{LWS(), tab, C.G, cg, 512, 128u}; pg8::gemm_phase_m128(C.lds, P); } else { build_exptab(C, tab, l, 8); PMoe2B P{LWS(), tab, C.G, cg, 512, 128u}; pg8::gemm_phase(C.lds, P); } }
        SEAM(pb + 10);
    }
    if (EN(12) && IN(NPH - 1)) { const Ctx Cl = LC(); phase_rows<2>(Cl, NLAYER); }
#ifdef DIAG_SEL
    xcd_barrier(bar); DIAG_ACC(12);
    if (blockIdx.x == 0 && threadIdx.x == 0) { volatile LAS unsigned* dg = (volatile LAS unsigned*)(C.lds + LDSCTL_OFF + 160); dg[8 + 13] = dg[0] - dg[1];
        for (int i = 0; i < 14; ++i) __hip_atomic_store(C.ctl + 2048 + i, dg[8 + i], RLX_AGENT); }
    xcd_barrier(bar);
    { const float d1 = (float)__hip_atomic_load(C.ctl + 2048 + (DIAG_SEL), RLX_AGENT) * 0.01f, d2 = (float)__hip_atomic_load(C.ctl + 2048 + (DIAG_SEL) + 1, RLX_AGENT) * 0.01f;
      const float c1 = sqrtf(d1); float* o = args.out;
      for (size_t i = (size_t)blockIdx.x * 512 + threadIdx.x; i < (size_t)NB * SEQ * D; i += (size_t)gridDim.x * 512) o[i] = (i == 12345) ? d2 : c1; }
#endif
#undef IN
#undef SEAM
}

#ifndef MK_PER_PHASE
#define MK_PER_PHASE 0
#endif
extern "C" void kernel_launch(void* const* d_in, const int* in_sizes, int n_in, void* d_out, int out_size, void* d_ws, size_t ws_size, hipStream_t stream) {
    static int grid = 0;
    if (grid == 0) {
        if (n_in != 29 || out_size != NB * SEQ * D || ws_size < WS_END) { fprintf(stderr, "kernel_launch: unexpected shapes (n_in %d out %d ws %zu)\n", n_in, out_size, ws_size); grid = -1; return; }
        int dev = 0, cus = 0, per_cu = 0;
        if (hipGetDevice(&dev) != hipSuccess || hipDeviceGetAttribute(&cus, hipDeviceAttributeMultiprocessorCount, dev) != hipSuccess) { grid = -1; return; }
        if (hipFuncSetAttribute((const void*)fwd, hipFuncAttributeMaxDynamicSharedMemorySize, LDS_BYTES) != hipSuccess) { grid = -1; return; }
        if (hipOccupancyMaxActiveBlocksPerMultiprocessor(&per_cu, (const void*)fwd, NWAVES * 64, LDS_BYTES) != hipSuccess || per_cu < 1) fprintf(stderr, "kernel_launch: occupancy query says %d\n", per_cu);
        (void)hipGetLastError();
        grid = cus;
    }
    if (grid < 0) return;
    (void)hipMemsetAsync((char*)d_ws + WS_CTL, 0, CTL_ZERO_BYTES, stream);
    Args a{};
    for (int i = 0; i < 29; ++i) a.in[i] = (const float*)d_in[i];
    a.out = (float*)d_out; a.ws = (unsigned char*)d_ws;
#if MK_PER_PHASE
    for (int p = 0; p < NPH; ++p) { a.ph_lo = p; a.ph_hi = p + 1; hipLaunchKernelGGL(fwd, dim3(grid), dim3(NWAVES * 64), LDS_BYTES, stream, a); }
#else
    a.ph_lo = 0; a.ph_hi = NPH; hipLaunchKernelGGL(fwd, dim3(grid), dim3(NWAVES * 64), LDS_BYTES, stream, a);
#endif
}
```

```cpp
#define FP8_MOE 1
#define GATE_BF16 0
#define W8_ALL 1
#define H8_WRITE 1
#ifndef H8_WRITE
#define H8_WRITE 1
#endif
#ifndef GATE_BF16
#define GATE_BF16 0
#endif
#include <hip/hip_runtime.h>
#include <cstdio>
#include <cstdint>

#define GAS __attribute__((address_space(1)))
#define LAS __attribute__((address_space(3)))
typedef unsigned short bf16;
typedef unsigned v4u __attribute__((ext_vector_type(4)));
typedef unsigned v2u __attribute__((ext_vector_type(2)));
typedef float f32x4 __attribute__((ext_vector_type(4)));
typedef float f32x2 __attribute__((ext_vector_type(2)));
typedef float f32x16 __attribute__((ext_vector_type(16)));
typedef short bf16x8 __attribute__((ext_vector_type(8)));
typedef short s16x4 __attribute__((ext_vector_type(4)));
typedef GAS unsigned gu32;
#define RLX_AGENT __ATOMIC_RELAXED, __HIP_MEMORY_SCOPE_AGENT
#define LDS_WAIT() asm volatile("s_waitcnt lgkmcnt(0)" ::: "memory")
#define VM_WAIT() asm volatile("s_waitcnt vmcnt(0)" ::: "memory")

constexpr int NB = 4, SEQ = 8192, CTX = 256, LB = SEQ + CTX, T = NB * LB, D = 1024, NPAN = T / 256;
constexpr int NLAYER = 4, INW = 5888, NCH = LB / 32, NCR = NB * NCH;
constexpr int NEXP = 16, FF = 512;
constexpr float EPS = 1e-6f;
constexpr float LOG2E = 1.4426950408889634f;
constexpr float C2 = 0.125f * LOG2E;
constexpr int NWAVES = 8;

constexpr size_t MiB = 1u << 20;
constexpr size_t WS_CTL = 0, CTL_ZERO_BYTES = 1 * MiB;
constexpr size_t WS_MOD = 1 * MiB;
constexpr size_t WS_LIST = 2 * MiB;
constexpr size_t WS_RW = 5 * MiB;
constexpr size_t WS_CTXS = 6 * MiB;
constexpr size_t WS_SST = 10 * MiB;
constexpr size_t WS_HB8 = WS_SST;
constexpr size_t WS_XST = 44 * MiB;
constexpr size_t WS_BT1 = 61 * MiB;
constexpr size_t WS_BT2 = 85 * MiB;
constexpr size_t WS_WIN = 93 * MiB;
constexpr size_t WS_WIN8 = WS_WIN + (size_t)2816 * 1024 * 2;
constexpr size_t WS_WGLU = 105 * MiB;
constexpr size_t WS_WBR = 106 * MiB;
constexpr size_t WS_WOUT = 109 * MiB;
constexpr size_t WS_MOE1 = 111 * MiB;
constexpr size_t WS_MOE2 = 143 * MiB;
constexpr size_t WS_HB = 159 * MiB;
constexpr size_t WS_U = 225 * MiB;
constexpr size_t WS_QA = 258 * MiB;
constexpr size_t WS_KA = 291 * MiB;
constexpr size_t WS_VA = 300 * MiB;
constexpr size_t WS_QN = 309 * MiB;
constexpr size_t WS_KN = 342 * MiB;
constexpr size_t WS_VN = 375 * MiB;
constexpr size_t WS_YS = 408 * MiB;
constexpr size_t WS_GATES = 441 * MiB;
constexpr size_t WS_ACT = WS_QN;
constexpr size_t WS_ACTB = WS_QN;
constexpr size_t WS_YSLOT = WS_GATES;
constexpr size_t WS_AO = 574 * MiB;
constexpr size_t WS_NO = 607 * MiB;
constexpr size_t WS_YG = 640 * MiB;
constexpr size_t WS_XS = 673 * MiB;
constexpr size_t WS_END = 739 * MiB;
static_assert(WS_GATES + (size_t)T * 3072 * (GATE_BF16 ? 2 : 1) <= WS_AO && WS_YSLOT + (size_t)2 * T * 1024 * 2 <= WS_AO && WS_ACT + (size_t)(2 * T + 4096) * 512 * 2 <= WS_YS, "ws map");
constexpr int CW_FAIL = 8;
constexpr int CW_CNT = 64;
constexpr int CW_BAR = 8192;

constexpr int RING_BYTES = 131072, LDS_BYTES = 147456, LDSCTL_OFF = LDS_BYTES - 512, MISC_OFF = LDSCTL_OFF + 320;

__device__ __forceinline__ unsigned f2bf(float f) { unsigned u = __builtin_bit_cast(unsigned, f); return (u + 0x7fffu + ((u >> 16) & 1u)) >> 16; }
__device__ __forceinline__ unsigned pk2(float lo, float hi) { return f2bf(lo) | (f2bf(hi) << 16); }
__device__ __forceinline__ float bf2f(unsigned b) { return __builtin_bit_cast(float, b << 16); }
__device__ __forceinline__ float bflo(unsigned w) { return __builtin_bit_cast(float, w << 16); }
__device__ __forceinline__ float bfhi(unsigned w) { return __builtin_bit_cast(float, w & 0xffff0000u); }
typedef float f32x2_c __attribute__((ext_vector_type(2))); typedef __bf16 bf16x2_c __attribute__((ext_vector_type(2)));
__device__ __forceinline__ unsigned cvt_pk_bf16(float lo, float hi) { const f32x2_c v = {lo, hi}; return __builtin_bit_cast(unsigned, __builtin_convertvector(v, bf16x2_c)); }
typedef int v8i __attribute__((ext_vector_type(8)));
typedef int v4i __attribute__((ext_vector_type(4)));
__device__ __forceinline__ float clamp8(float x) { return __builtin_fminf(__builtin_fmaxf(x, -448.f), 448.f); }
__device__ __forceinline__ unsigned pk4_fp8(float a, float b, float c, float d) { int w = 0; w = __builtin_amdgcn_cvt_pk_fp8_f32(clamp8(a), clamp8(b), w, false); w = __builtin_amdgcn_cvt_pk_fp8_f32(clamp8(c), clamp8(d), w, true); return (unsigned)w; }
__device__ __forceinline__ float fsigmoid(float x) { return __builtin_amdgcn_rcpf(1.f + __builtin_amdgcn_exp2f(-LOG2E * x)); }
__device__ __forceinline__ float gelu_tanh(float x) { const float u = 0.7978845608f * (x + 0.044715f * x * x * x); return x * __builtin_amdgcn_rcpf(1.f + __builtin_amdgcn_exp2f(-2.f * LOG2E * u)); }
__device__ __forceinline__ float shflx(float v, int m, int lane) { return __builtin_bit_cast(float, __builtin_amdgcn_ds_bpermute((lane ^ m) << 2, __builtin_bit_cast(int, v))); }
template <int CTRL, int RM>
__device__ __forceinline__ float dpp_mov(float v) { return __builtin_bit_cast(float, __builtin_amdgcn_update_dpp(0, __builtin_bit_cast(int, v), CTRL, RM, 0xF, true)); }
__device__ __forceinline__ float wave_sum(float v, int) {
    v += dpp_mov<0xB1, 0xF>(v);
    v += dpp_mov<0x4E, 0xF>(v);
    v += dpp_mov<0x141, 0xF>(v);
    v += dpp_mov<0x140, 0xF>(v);
    v += dpp_mov<0x142, 0xA>(v);
    v += dpp_mov<0x143, 0xC>(v);
    return __builtin_bit_cast(float, __builtin_amdgcn_readlane(__builtin_bit_cast(int, v), 63));
}
__device__ __forceinline__ float sin_rev(float r) { r = r - floorf(r); return __builtin_amdgcn_sinf(r); }
__device__ __forceinline__ float cos_rev(float r) { r = r - floorf(r); return __builtin_amdgcn_cosf(r); }

#define XB_TMO      128
#define XB_XCNT(j)  (256  + 64 * (j))
#define XB_XSUB(j)  (1280 + 64 * (j))
#define XB_XGEN(j)  (2304 + 64 * (j))
#define XB_TOP      3328
#define XB_TOPGEN   3392
#define XCD_BAR_WORDS 3456
#define XB_SPIN_CAP (1u << 22)

__device__ __forceinline__ unsigned xb_ld(unsigned* p)              { return __hip_atomic_load(p, __ATOMIC_RELAXED, __HIP_MEMORY_SCOPE_AGENT); }
__device__ __forceinline__ unsigned xb_add(unsigned* p, unsigned v) { return __hip_atomic_fetch_add(p, v, __ATOMIC_RELAXED, __HIP_MEMORY_SCOPE_AGENT); }
__device__ __forceinline__ unsigned xb_xcc_id() { return (unsigned)__builtin_amdgcn_s_getreg((3 << 11) | 20) & 0xFu; }
#define XB_SPIN(cond, bar) do { unsigned _sp = 0; while (cond) { __builtin_amdgcn_s_sleep(1); \
    if ((++_sp & 255u) == 0u) { if (xb_ld(&(bar)[XB_TMO])) break; if (_sp > XB_SPIN_CAP) { atomicAdd(&(bar)[XB_TMO], 1u); break; } } } } while (0)

struct XcdBarrier { unsigned* bar; unsigned x; volatile LAS unsigned* st; };

__device__ __forceinline__ XcdBarrier xcd_barrier_post(unsigned* bar, volatile LAS unsigned* st) {
    XcdBarrier b; b.bar = bar; b.x = xb_xcc_id(); b.st = st;
    if (threadIdx.x == 0) (void)xb_add(&bar[XB_XCNT(b.x)], 1u);
    return b;
}
__device__ __forceinline__ void xcd_barrier_complete(unsigned* bar, unsigned x, unsigned& nloc, unsigned& nx) {
    const unsigned G = gridDim.x * gridDim.y * gridDim.z;
    unsigned sum, cnt, mine, sp = 0u;
    for (;;) {
        sum = 0u; cnt = 0u; mine = 0u;
#pragma unroll
        for (unsigned j = 0; j < 16; ++j) { const unsigned c = xb_ld(&bar[XB_XCNT(j)]); sum += c; cnt += (c > 0u) ? 1u : 0u; mine = (j == x) ? c : mine; }
        if (sum == G) break;
        __builtin_amdgcn_s_sleep(1);
        if ((++sp & 255u) == 0u) { if (xb_ld(&bar[XB_TMO])) break; if (sp > XB_SPIN_CAP) { atomicAdd(&bar[XB_TMO], 1u); break; } }
    }
    nloc = mine > 0u ? mine : 1u; nx = cnt > 0u ? cnt : 1u;
}
__device__ __forceinline__ void xcd_barrier(const XcdBarrier& b) {
    asm volatile("s_waitcnt vmcnt(0)" ::: "memory");
    __syncthreads();
    if (threadIdx.x == 0) {
        unsigned* bar = b.bar;
        __builtin_amdgcn_s_waitcnt(0);
        unsigned nloc = b.st[0], nx = b.st[1];
        if (nloc == 0u) { xcd_barrier_complete(bar, b.x, nloc, nx); b.st[0] = nloc; b.st[1] = nx; }
        const unsigned old = xb_add(&bar[XB_XSUB(b.x)], 1u);
        const unsigned gen = old / nloc;
        if (old + 1u == (gen + 1u) * nloc) {
            __builtin_amdgcn_fence(__ATOMIC_RELEASE, "agent");
            asm volatile("s_waitcnt vmcnt(0)" ::: "memory");
            const unsigned og = xb_add(&bar[XB_TOP], 1u);
            const unsigned tg = og / nx;
            if (og + 1u == (tg + 1u) * nx) xb_add(&bar[XB_TOPGEN], 1u);
            else XB_SPIN(xb_ld(&bar[XB_TOPGEN]) == tg, bar);
            __builtin_amdgcn_fence(__ATOMIC_ACQUIRE, "agent");
            xb_add(&bar[XB_XGEN(b.x)], 1u);
            asm volatile("s_waitcnt vmcnt(0)" ::: "memory");
        } else {
            XB_SPIN(xb_ld(&bar[XB_XGEN(b.x)]) == gen, bar);
            __builtin_amdgcn_fence(__ATOMIC_ACQUIRE, "agent");
            asm volatile("s_waitcnt vmcnt(0)" ::: "memory");
        }
    }
    __syncthreads();
}

namespace pg8 {
constexpr int BM = 256, BK = 64, HALF = 128, HTB = HALF * BK * 2, STAGE_BYTES = 8 * HTB, NXCD = 8, WGM = 8;
__host__ __device__ __forceinline__ int lds_byte(int r, int c) { const int st = (r >> 4) * 2 + (c >> 5), rr = r & 15, cc = c & 31, ob = rr * 64 + cc * 2; return st * 1024 + (ob ^ (((ob >> 9) & 1) << 5)); }
__host__ __device__ __forceinline__ void stage_rc(int b, int& R, int& C) { const int st = b / 1024, sb = b % 1024, swz = sb ^ (((sb >> 9) & 1) << 5); R = (st >> 1) * 16 + swz / 64; C = (st & 1) * 32 + (swz % 64) / 2; }
__host__ __device__ __forceinline__ int perm32(int rho) { const int n = rho >> 4, i = rho & 15; return 8 * (i >> 2) + 4 * n + (i & 3); }

struct Unit { int pm, pn, z; };

__device__ __forceinline__ void static_decode(int L, int nM, int nN, int& pm, int& pn) {
    const int nwg = nM * nN; int wgid = L;
    { const int q = nwg / NXCD, r = nwg % NXCD, xcd = wgid % NXCD, off = wgid / NXCD; wgid = (xcd < r ? xcd * (q + 1) : r * (q + 1) + (xcd - r) * q) + off; }
    const int nig = WGM * nN, gid = wgid / nig, fm = gid * WGM, gsz = (nM - fm) < WGM ? (nM - fm) : WGM;
    pm = fm + ((wgid % nig) % gsz); pn = (wgid % nig) / gsz;
}

template <class P>
__device__ __forceinline__ void gemm_phase(LAS unsigned char* lds, const P& S) {
    int tid_ = threadIdx.x; asm volatile("" : "+v"(tid_));
    const int tid = tid_, wid = __builtin_amdgcn_readfirstlane(tid >> 6), lane = tid & 63, wr = wid >> 2, wc = wid & 3, fr = lane & 15, fq = lane >> 4;
    constexpr int ELB = P::FP8 ? 1 : 2;
    const int K = S.K; int nt = K * ELB / 128; asm volatile("" : "+s"(nt));
    unsigned voffB[2];
#pragma unroll
    for (int i = 0; i < 2; ++i) { int R, C; stage_rc(tid * 16 + i * 8192, R, C); const int Rb = (R & ~31) + perm32(R & 31); voffB[i] = (unsigned)(Rb * K * ELB + C * 2); }
#define PG8_AOFF(dst0, dst1, u) do { _Pragma("unroll") for (int i = 0; i < 2; ++i) { int R, C; stage_rc(tid * 16 + i * 8192, R, C); dst0[i] = S.a_off(u, 0, R, C); dst1[i] = S.a_off(u, 1, R, C); } } while (0)
    const size_t kstepB = (size_t)(BK * 2), hstepB = (size_t)HALF * K * ELB, kstepA = (size_t)S.kstepA;
    const unsigned ldsw = (unsigned)wid * 1024u;
    const int aoff = lds_byte(wr * 64 + fr, fq * 8), boff = lds_byte(wc * 32 + fr, fq * 8);
#define PG8_SA(b, h) (((b) * 2 + (h)) * HTB)
#define PG8_SB(b, h) ((4 + (b) * 2 + (h)) * HTB)
#define PG8_STAGE(bufoff, gbase, voff) do { _Pragma("unroll") for (int _i = 0; _i < 2; ++_i) \
        __builtin_amdgcn_global_load_lds((const unsigned*)((const char*)(gbase) + (voff)[_i]), (LAS unsigned*)(lds + (bufoff) + ldsw + _i * 8192), 16, 0, 0); } while (0)
#define PG8_LDA(dst, b, h) do { _Pragma("unroll") for (int m = 0; m < 4; ++m) _Pragma("unroll") for (int k = 0; k < 2; ++k) dst[m][k] = *(const LAS bf16x8*)(lds + PG8_SA(b, h) + aoff + m * 2048 + k * 1024); } while (0)
#define PG8_LDB(dst, b, h) do { _Pragma("unroll") for (int n = 0; n < 2; ++n) _Pragma("unroll") for (int k = 0; k < 2; ++k) dst[n][k] = *(const LAS bf16x8*)(lds + PG8_SB(b, h) + boff + n * 2048 + k * 1024); } while (0)
#define PG8_CAT(x0, x1) __builtin_shufflevector(__builtin_bit_cast(v4i, x0), __builtin_bit_cast(v4i, x1), 0, 1, 2, 3, 4, 5, 6, 7)
#define PG8_MMA(ai, bj, At, Bt) do { __builtin_amdgcn_s_setprio(1); _Pragma("unroll") for (int m = 0; m < 4; ++m) _Pragma("unroll") for (int n = 0; n < 2; ++n) { \
        if constexpr (P::FP8) acc[ai][bj][m][n] = __builtin_amdgcn_mfma_scale_f32_16x16x128_f8f6f4(PG8_CAT(Bt[n][0], Bt[n][1]), PG8_CAT(At[m][0], At[m][1]), acc[ai][bj][m][n], 0, 0, 0, 0x7f7f7f7f, 0, 0x7f7f7f7f); \
        else { _Pragma("unroll") for (int k = 0; k < 2; ++k) acc[ai][bj][m][n] = __builtin_amdgcn_mfma_f32_16x16x32_bf16(Bt[n][k], At[m][k], acc[ai][bj][m][n], 0, 0, 0); } } __builtin_amdgcn_s_setprio(0); } while (0)
#define PG8_WAIT_V(n) asm volatile("s_waitcnt vmcnt(" #n ")" ::: "memory")
#define PG8_WAIT_L(n) asm volatile("s_waitcnt lgkmcnt(" #n ")" ::: "memory")
#define PG8_BAR __builtin_amdgcn_s_barrier()
#define PG8_SCHED __builtin_amdgcn_sched_barrier(0)
    Unit cur, nxt; int ui = 0;
    if (!S.next(0, cur)) return;
    f32x4 acc[2][2][4][2];
#pragma unroll
    for (int a = 0; a < 2; ++a)
#pragma unroll
        for (int b = 0; b < 2; ++b)
#pragma unroll
            for (int m = 0; m < 4; ++m)
#pragma unroll
                for (int n = 0; n < 2; ++n) acc[a][b][m][n] = (f32x4){0.f, 0.f, 0.f, 0.f};
    bf16x8 At[4][2], B0[2][2], B1[2][2];
    unsigned vA0[2], vA1[2], vN0[2], vN1[2];
    PG8_AOFF(vA0, vA1, cur);
    const char* cA = S.a_base(cur); const char* cB = S.b_base(cur);
    PG8_STAGE(PG8_SB(0, 0), cB, voffB); PG8_STAGE(PG8_SB(0, 1), cB + hstepB, voffB); PG8_STAGE(PG8_SA(0, 0), cA, vA0); PG8_STAGE(PG8_SA(0, 1), cA, vA1);
    if (wr == 1) PG8_BAR;
    PG8_WAIT_V(2); PG8_BAR;
    PG8_STAGE(PG8_SB(1, 0), cB + kstepB, voffB); PG8_STAGE(PG8_SA(1, 0), cA + kstepA, vA0); PG8_STAGE(PG8_SB(1, 1), cB + hstepB + kstepB, voffB);
    PG8_WAIT_V(6); PG8_BAR;
    for (;;) {
        const bool has_next = S.next(ui + 1, nxt);
        const char* nA = cA; const char* nB = cB;
        if (has_next) { nA = S.a_base(nxt); nB = S.b_base(nxt); if (P::EARLY_AOFF) PG8_AOFF(vN0, vN1, nxt); }
        for (int t = 0; t < nt; t += 2) {
            const bool last = (t == nt - 2);
            const char* a1 = cA + (size_t)(t + 1) * kstepA;
            const char* a2 = last ? nA : cA + (size_t)(t + 2) * kstepA; const char* b2 = last ? nB : cB + (size_t)(t + 2) * kstepB;
            const char* a3 = a2 + kstepA; const char* b3 = b2 + kstepB;
            PG8_LDB(B0, 0, 0); PG8_LDB(B1, 0, 1); PG8_SCHED; PG8_LDA(At, 0, 0); PG8_STAGE(PG8_SA(1, 1), a1, vA1);
            if (last && has_next) {
                if (P::EARLY_AOFF) { _Pragma("unroll") for (int i = 0; i < 2; ++i) { vA0[i] = vN0[i]; vA1[i] = vN1[i]; } } else PG8_AOFF(vA0, vA1, nxt); }
            PG8_WAIT_V(8); PG8_WAIT_L(0); PG8_BAR; PG8_MMA(0, 0, At, B0); PG8_MMA(0, 1, At, B1); PG8_BAR; PG8_SCHED;
            PG8_LDA(At, 0, 1); PG8_STAGE(PG8_SB(0, 0), b2, voffB); PG8_STAGE(PG8_SB(0, 1), b2 + hstepB, voffB); PG8_STAGE(PG8_SA(0, 0), a2, vA0);
            PG8_WAIT_V(8); PG8_WAIT_L(0); PG8_BAR; PG8_MMA(1, 0, At, B0); PG8_MMA(1, 1, At, B1); PG8_BAR; PG8_SCHED;
            PG8_LDB(B0, 1, 0); PG8_LDB(B1, 1, 1); PG8_SCHED; PG8_LDA(At, 1, 0); PG8_STAGE(PG8_SA(0, 1), a2, vA1);
            PG8_WAIT_V(8); PG8_WAIT_L(0); PG8_BAR; PG8_MMA(0, 0, At, B0); PG8_MMA(0, 1, At, B1); PG8_BAR; PG8_SCHED;
            PG8_LDA(At, 1, 1); PG8_STAGE(PG8_SB(1, 0), b3, voffB); PG8_STAGE(PG8_SB(1, 1), b3 + hstepB, voffB); PG8_STAGE(PG8_SA(1, 0), a3, vA0);
            PG8_WAIT_V(8); PG8_WAIT_L(0); PG8_BAR; PG8_MMA(1, 0, At, B0); PG8_MMA(1, 1, At, B1); PG8_BAR; PG8_SCHED;
        }
        if (wr == 0) PG8_BAR;
        S.epi(acc, cur, wr, wc, fr, fq);
        if (!has_next) break;
#pragma unroll
        for (int a = 0; a < 2; ++a)
#pragma unroll
            for (int b = 0; b < 2; ++b)
#pragma unroll
                for (int m = 0; m < 4; ++m)
#pragma unroll
                    for (int n = 0; n < 2; ++n) acc[a][b][m][n] = (f32x4){0.f, 0.f, 0.f, 0.f};
        cur = nxt; cA = nA; cB = nB; ++ui;
        if (wr == 1) PG8_BAR;
    }
    PG8_WAIT_V(0);
    PG8_BAR;
#undef PG8_AOFF
#undef PG8_SA
#undef PG8_SB
#undef PG8_STAGE
#undef PG8_LDA
#undef PG8_LDB
#undef PG8_MMA
#undef PG8_CAT
#undef PG8_WAIT_V
#undef PG8_WAIT_L
#undef PG8_BAR
#undef PG8_SCHED
}

template <class P>
__device__ __forceinline__ void gemm_phase_m128(LAS unsigned char* lds, const P& S) {
    int tid_ = threadIdx.x; asm volatile("" : "+v"(tid_));
    const int tid = tid_, wid = __builtin_amdgcn_readfirstlane(tid >> 6), lane = tid & 63, wr = wid >> 2, wc = wid & 3, fr = lane & 15, fq = lane >> 4;
    constexpr int ELB = P::FP8 ? 1 : 2;
    const int K = S.K; int nt = K * ELB / 128; asm volatile("" : "+s"(nt));
    unsigned voffB[2];
#pragma unroll
    for (int i = 0; i < 2; ++i) { int R, C; stage_rc(tid * 16 + i * 8192, R, C); const int Rb = (R & ~31) + perm32(R & 31); voffB[i] = (unsigned)(Rb * K * ELB + C * 2); }
#define PG8_AOFF(dst0, u) do { _Pragma("unroll") for (int i = 0; i < 2; ++i) { int R, C; stage_rc(tid * 16 + i * 8192, R, C); dst0[i] = S.a_off(u, R, C); } } while (0)
    const size_t kstepB = (size_t)(BK * 2), hstepB = (size_t)HALF * K * ELB, kstepA = (size_t)S.kstepA;
    const unsigned ldsw = (unsigned)wid * 1024u;
    const int aoff = lds_byte(wr * 64 + fr, fq * 8), boff = lds_byte(wc * 32 + fr, fq * 8);
#define PG8_SA(b) (((b) * 2) * HTB)
#define PG8_SB(b, h) ((4 + (b) * 2 + (h)) * HTB)
#define PG8_STAGE(bufoff, gbase, voff) do { _Pragma("unroll") for (int _i = 0; _i < 2; ++_i) \
        __builtin_amdgcn_global_load_lds((const unsigned*)((const char*)(gbase) + (voff)[_i]), (LAS unsigned*)(lds + (bufoff) + ldsw + _i * 8192), 16, 0, 0); } while (0)
#define PG8_LDA(dst, b) do { _Pragma("unroll") for (int m = 0; m < 4; ++m) _Pragma("unroll") for (int k = 0; k < 2; ++k) dst[m][k] = *(const LAS bf16x8*)(lds + PG8_SA(b) + aoff + m * 2048 + k * 1024); } while (0)
#define PG8_LDB(dst, b, h) do { _Pragma("unroll") for (int n = 0; n < 2; ++n) _Pragma("unroll") for (int k = 0; k < 2; ++k) dst[n][k] = *(const LAS bf16x8*)(lds + PG8_SB(b, h) + boff + n * 2048 + k * 1024); } while (0)
#define PG8_CAT(x0, x1) __builtin_shufflevector(__builtin_bit_cast(v4i, x0), __builtin_bit_cast(v4i, x1), 0, 1, 2, 3, 4, 5, 6, 7)
#define PG8_MMA(bj, At, Bt) do { __builtin_amdgcn_s_setprio(1); _Pragma("unroll") for (int m = 0; m < 4; ++m) _Pragma("unroll") for (int n = 0; n < 2; ++n) { \
        if constexpr (P::FP8) acc[bj][m][n] = __builtin_amdgcn_mfma_scale_f32_16x16x128_f8f6f4(PG8_CAT(Bt[n][0], Bt[n][1]), PG8_CAT(At[m][0], At[m][1]), acc[bj][m][n], 0, 0, 0, 0x7f7f7f7f, 0, 0x7f7f7f7f); \
        else { _Pragma("unroll") for (int k = 0; k < 2; ++k) acc[bj][m][n] = __builtin_amdgcn_mfma_f32_16x16x32_bf16(Bt[n][k], At[m][k], acc[bj][m][n], 0, 0, 0); } } __builtin_amdgcn_s_setprio(0); } while (0)
#define PG8_WAIT_V(n) asm volatile("s_waitcnt vmcnt(" #n ")" ::: "memory")
#define PG8_WAIT_L(n) asm volatile("s_waitcnt lgkmcnt(" #n ")" ::: "memory")
#define PG8_BAR __builtin_amdgcn_s_barrier()
#define PG8_SCHED __builtin_amdgcn_sched_barrier(0)
    Unit cur, nxt; int ui = 0;
    if (!S.next(0, cur)) return;
    f32x4 acc[2][4][2], st[2][4][2];
#pragma unroll
    for (int a = 0; a < 2; ++a)
#pragma unroll
        for (int m = 0; m < 4; ++m)
#pragma unroll
            for (int n = 0; n < 2; ++n) { acc[a][m][n] = (f32x4){0.f, 0.f, 0.f, 0.f}; st[a][m][n] = (f32x4){0.f, 0.f, 0.f, 0.f}; }
    bf16x8 At[4][2], B0[2][2];
    unsigned vA[2], vN[2];
    PG8_AOFF(vA, cur);
    const char* cA = S.a_base(cur); const char* cB = S.b_base(cur);
    PG8_STAGE(PG8_SB(0, 0), cB, voffB); PG8_STAGE(PG8_SA(0), cA, vA); PG8_STAGE(PG8_SB(0, 1), cB + hstepB, voffB);
    if (wr == 1) PG8_BAR;
    PG8_WAIT_V(2); PG8_BAR;
    PG8_STAGE(PG8_SB(1, 0), cB + kstepB, voffB); PG8_STAGE(PG8_SA(1), cA + kstepA, vA);
    PG8_WAIT_V(4); PG8_BAR;
    for (;;) {
        const bool has_next = S.next(ui + 1, nxt);
        const char* nA = cA; const char* nB = cB;
        if (has_next) { nA = S.a_base(nxt); nB = S.b_base(nxt); if (P::EARLY_AOFF) PG8_AOFF(vN, nxt); }
        for (int t = 0; t < nt; t += 2) {
            const bool last = (t == nt - 2);
            const char* b1 = cB + (size_t)(t + 1) * kstepB;
            const char* a2 = last ? nA : cA + (size_t)(t + 2) * kstepA; const char* b2 = last ? nB : cB + (size_t)(t + 2) * kstepB;
            const char* a3 = a2 + kstepA; const char* b3 = b2 + kstepB;
            PG8_LDB(B0, 0, 0); PG8_SCHED; PG8_LDA(At, 0); PG8_STAGE(PG8_SB(1, 1), b1 + hstepB, voffB);
            if (last && has_next) { if (P::EARLY_AOFF) { vA[0] = vN[0]; vA[1] = vN[1]; } else PG8_AOFF(vA, nxt); }
            PG8_WAIT_V(6); PG8_WAIT_L(0); PG8_BAR; PG8_MMA(0, At, B0); PG8_BAR; PG8_SCHED;
            PG8_LDB(B0, 0, 1); PG8_STAGE(PG8_SB(0, 0), b2, voffB); PG8_STAGE(PG8_SA(0), a2, vA);
            PG8_WAIT_V(6); PG8_WAIT_L(0); PG8_BAR; PG8_MMA(1, At, B0); PG8_BAR; PG8_SCHED;
            PG8_LDB(B0, 1, 0); PG8_SCHED; PG8_LDA(At, 1); PG8_STAGE(PG8_SB(0, 1), b2 + hstepB, voffB);
            PG8_WAIT_V(6); PG8_WAIT_L(0); PG8_BAR; PG8_MMA(0, At, B0); PG8_BAR; PG8_SCHED;
            PG8_LDB(B0, 1, 1); PG8_STAGE(PG8_SB(1, 0), b3, voffB); PG8_STAGE(PG8_SA(1), a3, vA);
            PG8_WAIT_V(6); PG8_WAIT_L(0); PG8_BAR; PG8_MMA(1, At, B0); PG8_BAR; PG8_SCHED;
        }
        if (wr == 0) PG8_BAR;
        S.epi(acc, st, cur, wr, wc, fr, fq);
        if (!has_next) break;
#pragma unroll
        for (int a = 0; a < 2; ++a)
#pragma unroll
            for (int m = 0; m < 4; ++m)
#pragma unroll
                for (int n = 0; n < 2; ++n) acc[a][m][n] = (f32x4){0.f, 0.f, 0.f, 0.f};
        cur = nxt; cA = nA; cB = nB; ++ui;
        if (wr == 1) PG8_BAR;
    }
    PG8_WAIT_V(0);
    PG8_BAR;
#undef PG8_AOFF
#undef PG8_SA
#undef PG8_SB
#undef PG8_STAGE
#undef PG8_LDA
#undef PG8_LDB
#undef PG8_MMA
#undef PG8_CAT
#undef PG8_WAIT_V
#undef PG8_WAIT_L
#undef PG8_BAR
#undef PG8_SCHED
}
}
namespace attn_body {
using bf16x8 = __attribute__((ext_vector_type(8))) short;
using u32x4 = __attribute__((ext_vector_type(4))) unsigned;
constexpr int NW = 8, QBLK = 32, QB = QBLK * NW, KVBLK = 64;
__device__ __forceinline__ int crow(int r, int hi) { return (r & 3) + 8 * (r >> 2) + 4 * hi; }
#define SBAR() __builtin_amdgcn_sched_barrier(0)
constexpr int NSLOT = 3, SLOTB = 8192;
constexpr int LDS_K = 0, LDS_V = NSLOT * SLOTB, LDS_WS = 2 * NSLOT * SLOTB, LDS_OST = LDS_WS + NW * 64 * 4, LDS_BYTES = LDS_OST + NW * 4096;
constexpr int LDS_BT = 86016 + 256;
__device__ __forceinline__ void glds16(const void* gsrc, unsigned lds_dst) { unsigned keep;
  asm volatile("s_mov_b32 %0, m0\n\ts_mov_b32 m0, %2\n\ts_nop 0\n\tglobal_load_lds_dwordx4 %1, off\n\ts_mov_b32 m0, %0" : "=&s"(keep) : "v"(gsrc), "s"(lds_dst) : "memory"); }
__device__ __forceinline__ float max3f(float a, float b, float c) { float r; asm("v_max3_f32 %0, %1, %2, %3" : "=v"(r) : "v"(a), "v"(b), "v"(c)); return r; }
__device__ __forceinline__ float max2f(float a, float b) { float r; asm("v_max_f32_e32 %0, %1, %2" : "=v"(r) : "v"(a), "v"(b)); return r; }
__device__ __forceinline__ float fadd_s(float a, float b) { float r; asm("v_add_f32_e32 %0, %1, %2" : "=v"(r) : "v"(a), "v"(b)); return r; }
__device__ __forceinline__ float fsub_s(float a, float b) { float r; asm("v_sub_f32_e32 %0, %1, %2" : "=v"(r) : "v"(a), "v"(b)); return r; }
typedef float f32x2_t __attribute__((ext_vector_type(2))); typedef __bf16 bf16x2_t __attribute__((ext_vector_type(2)));
__device__ __forceinline__ unsigned cvtpk_s(float lo, float hi) { f32x2_t v = {lo, hi}; bf16x2_t b = __builtin_convertvector(v, bf16x2_t); return __builtin_bit_cast(unsigned, b); }
#define WAIT_BAR(N) asm volatile("s_waitcnt vmcnt(" #N ") lgkmcnt(0)\n\ts_barrier" ::: "memory")

__device__ __forceinline__ void qkt(f32x16& p0, f32x16& p1, const char* Kslot, const bf16x8* qr, const f32x16& negm, int r32, int hi) {
  const char* kb = Kslot + hi * 1024 + r32 * 16;
  #pragma unroll
  for (int d0 = 0; d0 < 4; ++d0) {
    const bf16x8 b0 = *reinterpret_cast<const bf16x8*>(kb + d0 * 2048);
    const bf16x8 b1 = *reinterpret_cast<const bf16x8*>(kb + d0 * 2048 + 512);
    if (d0 == 0) { p0 = __builtin_amdgcn_mfma_f32_32x32x16_bf16(b0, qr[0], negm, 0, 0, 0); p1 = __builtin_amdgcn_mfma_f32_32x32x16_bf16(b1, qr[0], negm, 0, 0, 0); }
    else { p0 = __builtin_amdgcn_mfma_f32_32x32x16_bf16(b0, qr[d0], p0, 0, 0, 0); p1 = __builtin_amdgcn_mfma_f32_32x32x16_bf16(b1, qr[d0], p1, 0, 0, 0); } }
}
typedef __attribute__((address_space(3))) const char* lds_cptr;
typedef short v4i16_t __attribute__((ext_vector_type(4)));
__device__ __forceinline__ void kload8(bf16x8* kf, lds_cptr kp) {
  kf[0] = *(const __attribute__((address_space(3))) bf16x8*)(kp);        kf[1] = *(const __attribute__((address_space(3))) bf16x8*)(kp + 512);
  kf[2] = *(const __attribute__((address_space(3))) bf16x8*)(kp + 2048); kf[3] = *(const __attribute__((address_space(3))) bf16x8*)(kp + 2560);
  kf[4] = *(const __attribute__((address_space(3))) bf16x8*)(kp + 4096); kf[5] = *(const __attribute__((address_space(3))) bf16x8*)(kp + 4608);
  kf[6] = *(const __attribute__((address_space(3))) bf16x8*)(kp + 6144); kf[7] = *(const __attribute__((address_space(3))) bf16x8*)(kp + 6656);
}
__device__ __forceinline__ void kload2(bf16x8* kf, lds_cptr kp, int j) { kf[2 * j] = *(const __attribute__((address_space(3))) bf16x8*)(kp + j * 2048); kf[2 * j + 1] = *(const __attribute__((address_space(3))) bf16x8*)(kp + j * 2048 + 512); }
__device__ __forceinline__ s16x4 vtr(lds_cptr p) { return __builtin_bit_cast(s16x4, __builtin_amdgcn_ds_read_tr16_b64_v4i16((__attribute__((address_space(3))) v4i16_t*)p)); }
__device__ __forceinline__ float rowmax(const f32x16& p0, const f32x16& p1) {
  float a = max3f(p0[0], p0[1], p1[0]), b = max3f(p0[2], p0[3], p1[1]); a = max3f(a, p1[2], p1[3]);
  #pragma unroll
  for (int r = 4; r < 16; r += 4) { a = max3f(a, p0[r], p0[r + 1]); b = max3f(b, p0[r + 2], p0[r + 3]); a = max3f(a, p1[r], p1[r + 1]); b = max3f(b, p1[r + 2], p1[r + 3]); }
  const float m = max2f(a, b);
  auto rr = __builtin_amdgcn_permlane32_swap(__float_as_uint(m), __float_as_uint(m), false, false);
  return max2f(__uint_as_float(rr[0]), __uint_as_float(rr[1]));
}
__device__ __forceinline__ void pv(f32x16* o, int vb, bf16x8 pa0, bf16x8 pa1, bf16x8 pa2, bf16x8 pa3) {
  #pragma unroll
  for (int d0 = 0; d0 < 2; ++d0) { s16x4 lo[4], hi[4];
    #pragma unroll
    for (int ks = 0; ks < 4; ++ks) {
      asm volatile("ds_read_b64_tr_b16 %0,%1 offset:%c2" : "=&v"(lo[ks]) : "v"(vb), "i"(d0 * 4096 + ks * 1024) : "memory");
      asm volatile("ds_read_b64_tr_b16 %0,%1 offset:%c2" : "=&v"(hi[ks]) : "v"(vb), "i"(d0 * 4096 + ks * 1024 + 512) : "memory"); }
    asm volatile("s_waitcnt lgkmcnt(0)" ::: "memory"); SBAR();
    #define PK(k) (bf16x8){lo[k][0], lo[k][1], lo[k][2], lo[k][3], hi[k][0], hi[k][1], hi[k][2], hi[k][3]}
    o[d0] = __builtin_amdgcn_mfma_f32_32x32x16_bf16(pa0, PK(0), o[d0], 0, 0, 0);
    o[d0] = __builtin_amdgcn_mfma_f32_32x32x16_bf16(pa1, PK(1), o[d0], 0, 0, 0);
    o[d0] = __builtin_amdgcn_mfma_f32_32x32x16_bf16(pa2, PK(2), o[d0], 0, 0, 0);
    o[d0] = __builtin_amdgcn_mfma_f32_32x32x16_bf16(pa3, PK(3), o[d0], 0, 0, 0);
    #undef PK
  }
}
#define ATTN_STORE16(p, v) (*(u32x4*)(p) = (v))

template <int THRL, bool NA, int QP_, int KVP_, bool NOMAX = false>
__device__ __forceinline__ void attn_unit(const bf16* Qu, int qp_rt, const bf16* __restrict__ Kh, const bf16* __restrict__ Vh, int kvp_rt, bf16* Ou, int NT, int r0, int rlo, char* shm) {
  const int qp = QP_ ? QP_ : qp_rt, kvp = KVP_ ? KVP_ : kvp_rt, op = qp;
  int tid_ = threadIdx.x; asm volatile("" : "+v"(tid_));
  const int tid = tid_, lane = tid & 63, r32 = lane & 31, hi = lane >> 5; const int wid = __builtin_amdgcn_readfirstlane(tid >> 6);
  const bf16* Qw = Qu + (long)(wid * QBLK) * qp;
  const unsigned lds0 = (unsigned)(uintptr_t)shm;
  float* wsf = (float*)(shm + LDS_WS) + wid * 64;
  const bf16* ksrc = Kh + (long)lane * kvp + wid * 8;
  const bf16* vsrc = Vh + (long)(16 * (wid & 3) + (lane >> 2)) * kvp + (wid >> 2) * 32 + (lane & 3) * 8;
  const unsigned kdst = lds0 + LDS_K + wid * 1024, vdst = lds0 + LDS_V + wid * 1024;
  #define TROW(t) (NA ? ((t) < 4 ? 64 * (t) : CTX + 64 * ((rlo + (t) - 4) < 127 ? (rlo + (t) - 4) : 127)) : 64 * (t))
  #define DMA_K(t, slot) glds16(ksrc + (long)TROW(t) * kvp, (unsigned)__builtin_amdgcn_readfirstlane(kdst + (slot)))
  #define DMA_V(t, slot) glds16(vsrc + (long)TROW(t) * kvp, (unsigned)__builtin_amdgcn_readfirstlane(vdst + (slot)))
  const int vb0 = (int)(lds0 + LDS_V) + ((lane >> 4) & 1) * 32 + (lane & 3) * 8 + (4 * hi + ((lane & 15) >> 2)) * 64;
  const char* Kbase = shm + LDS_K; bf16x8 kf[8];
  const lds_cptr shm3 = (lds_cptr)shm; const lds_cptr kp0 = shm3 + LDS_K + hi * 1024 + r32 * 16; const lds_cptr vp0 = shm3 + LDS_V + ((lane >> 4) & 1) * 32 + (lane & 3) * 8 + (4 * hi + ((lane & 15) >> 2)) * 64;
  const int rq = r0 + (wid >> 1), qc = 32 * (wid & 1) + r32;
  const int rsw = rq - 4 < 0 ? 0 : (rq - 4 > 120 ? 120 : rq - 4);
  const int cs = qc - 8 < 0 ? 0 : (qc - 8 > 48 ? 48 : qc - 8);
  const __attribute__((address_space(3))) float* btl = (const __attribute__((address_space(3))) float*)(shm3 + LDS_BT) + (15 + 4 * hi - qc);
  DMA_K(0, 0); DMA_V(0, 0); DMA_K(1, SLOTB);
  bf16x8 qr[4];
  #pragma unroll
  for (int d0 = 0; d0 < 4; ++d0) qr[d0] = *reinterpret_cast<const bf16x8*>(&Qw[(long)r32 * qp + d0 * 16 + hi * 8]);
  float mhat = 0.f, l_reg = 0.f; f32x16 o[2]; o[0] = f32x16{}; o[1] = f32x16{}; f32x16 negm = f32x16{}; if (!NA) asm volatile("" : "+v"(negm));
  #define NEGM (NA ? f32x16{} : negm)
  #define CMASK(P0, P1, t) do { if (NA) { if ((t) >= 4) { const int kr_ = rlo + (t) - 4; const int dr_ = kr_ - rsw; \
      if (dr_ < 0 || dr_ >= 8) { _Pragma("unroll") for (int r = 0; r < 16; ++r) { P0[r] = (-__builtin_inff()); P1[r] = (-__builtin_inff()); } } \
      else { const __attribute__((address_space(3))) float* bp_ = btl + (kr_ - rq + 7) * 31; const int kl0_ = 4 * hi - cs; \
        _Pragma("unroll") for (int rg = 0; rg < 4; ++rg) { \
          _Pragma("unroll") for (int rr_ = 0; rr_ < 4; ++rr_) { const int r = rg * 4 + rr_; const int kc_ = (r & 3) + 8 * (r >> 2); const float b0_ = bp_[kc_], b1_ = bp_[kc_ + 32]; \
            const int kl_ = kc_ + kl0_; P0[r] = ((unsigned)kl_ < 16u) ? P0[r] + b0_ : (-__builtin_inff()); P1[r] = ((unsigned)(kl_ + 32) < 16u) ? P1[r] + b1_ : (-__builtin_inff()); } \
          SBAR(); } } } } } while (0)
  bool resc = false;
  #define START(P0, P1) do { const float rm = NOMAX ? 0.f : rowmax(P0, P1); resc = false; \
    { const float dl = rm; mhat = fadd_s(mhat, dl); \
      _Pragma("unroll") for (int r = 0; r < 16; ++r) { P0[r] = fsub_s(P0[r], dl); P1[r] = fsub_s(P1[r], dl); } \
      if (!NA) { _Pragma("unroll") for (int r = 0; r < 16; ++r) negm[r] = -mhat; asm volatile("" : "+v"(negm)); } } \
    _Pragma("unroll") for (int r = 0; r < 16; ++r) P0[r] = __builtin_amdgcn_exp2f(P0[r]); } while (0)
  #define RESC() do { if (resc) { asm volatile("s_waitcnt lgkmcnt(0)" ::: "memory"); \
      _Pragma("unroll") for (int d_ = 0; d_ < 2; ++d_) _Pragma("unroll") for (int r = 0; r < 16; ++r) o[d_][r] *= wsf[crow(r, hi)]; } } while (0)
  f32x16 pA0, pA1, pB0, pB1;
  int sl_prev = 0, sl_cur = 0, sl_next = SLOTB;
  #define ROT() do { sl_prev = sl_cur; sl_cur = sl_next; sl_next = (sl_next == (NSLOT - 1) * SLOTB) ? 0 : sl_next + SLOTB; } while (0)
  DMA_K(2, 2 * SLOTB);
  WAIT_BAR(3);
  qkt(pA0, pA1, Kbase, qr, NEGM, r32, hi); asm volatile("s_nop 15\n\ts_nop 7" : "+v"(pA0), "+v"(pA1));
  START(pA0, pA1);
  _Pragma("unroll") for (int r = 0; r < 16; ++r) pA1[r] = __builtin_amdgcn_exp2f(pA1[r]);
  WAIT_BAR(0);
  DMA_K(3, 0); DMA_V(1, SLOTB);
  ROT();
  kload8(kf, kp0 + sl_cur);
  WAIT_BAR(2);
  s16x4 vlo[8], vhi[8]; u32x4 pw0, pw1, pw2, pw3;
  #define PKW(P, B) cvtpk_s(P[B], P[B + 1])
  #define PAF(k) __builtin_bit_cast(bf16x8, pw##k)
  #define VFR(i) (bf16x8){vlo[i][0], vlo[i][1], vlo[i][2], vlo[i][3], vhi[i][0], vhi[i][1], vhi[i][2], vhi[i][3]}
  #define PIN(x) asm volatile("" : "+v"(x))
  #define MX3(a, b, c) __builtin_fmaxf(__builtin_fmaxf((a), (b)), (c))
  #define GAPA(MF, A0, A1, A2, A3, W0, W1, PW) do { MF; sacc2 += (f32x2_t){A0, A1}; sacc2 += (f32x2_t){A2, A3}; PIN(sacc2); W0; W1; PIN(PW); SBAR(); } while (0)
  #define EX(v) __builtin_amdgcn_exp2f(v)
  #define GAPB(MF, X, B) do { MF; X[B] = EX(X[B]); X[B + 1] = EX(X[B + 1]); X[B + 2] = EX(X[B + 2]); X[B + 3] = EX(X[B + 3]); PIN(X); SBAR(); } while (0)
  #define VRD(i) do { vlo[i] = vtr(vp_ + (((i) >> 2) * 4096 + ((i) & 3) * 1024)); vhi[i] = vtr(vp_ + (((i) >> 2) * 4096 + ((i) & 3) * 1024 + 512)); } while (0)
  #define KRD(G, j) do { if (G) { kload2(kf, kp0 + sl_next, j); SBAR(); } } while (0)
  #define STEP(C0, C1, P0, P1, t, GK, GV, GL) do { SBAR(); \
    const lds_cptr vp_ = vp0 + sl_prev; \
    VRD(0); SBAR(); f32x2_t sacc2 = (f32x2_t){P0[0], P0[1]}; \
    GAPA(C0 = __builtin_amdgcn_mfma_f32_32x32x16_bf16(kf[0], qr[0], NEGM, 0, 0, 0), P0[2], P0[3], P0[4], P0[5],     pw0[0] = PKW(P0, 0), pw0[1] = PKW(P0, 2), pw0); \
    VRD(4); SBAR(); GAPA(C1 = __builtin_amdgcn_mfma_f32_32x32x16_bf16(kf[1], qr[0], NEGM, 0, 0, 0), P0[6], P0[7], P0[8], P0[9],     pw0[2] = PKW(P0, 4), pw0[3] = PKW(P0, 6), pw0); \
    VRD(1); SBAR(); GAPA(C0 = __builtin_amdgcn_mfma_f32_32x32x16_bf16(kf[2], qr[1], C0, 0, 0, 0),   P0[10], P0[11], P0[12], P0[13], pw1[0] = PKW(P0, 8), pw1[1] = PKW(P0, 10), pw1); \
    VRD(5); SBAR(); GAPA(C1 = __builtin_amdgcn_mfma_f32_32x32x16_bf16(kf[3], qr[1], C1, 0, 0, 0),   P0[14], P0[15], P1[0], P1[1],   pw1[2] = PKW(P0, 12), pw1[3] = PKW(P0, 14), pw1); \
    VRD(2); SBAR(); GAPA(C0 = __builtin_amdgcn_mfma_f32_32x32x16_bf16(kf[4], qr[2], C0, 0, 0, 0),   P1[2], P1[3], P1[4], P1[5],     pw2[0] = PKW(P1, 0), pw2[1] = PKW(P1, 2), pw2); \
    VRD(6); SBAR(); GAPA(C1 = __builtin_amdgcn_mfma_f32_32x32x16_bf16(kf[5], qr[2], C1, 0, 0, 0),   P1[6], P1[7], P1[8], P1[9],     pw2[2] = PKW(P1, 4), pw2[3] = PKW(P1, 6), pw2); \
    VRD(3); SBAR(); GAPA(C0 = __builtin_amdgcn_mfma_f32_32x32x16_bf16(kf[6], qr[3], C0, 0, 0, 0),   P1[10], P1[11], P1[12], P1[13], pw3[0] = PKW(P1, 8), pw3[1] = PKW(P1, 10), pw3); \
    VRD(7); SBAR(); GAPA(C1 = __builtin_amdgcn_mfma_f32_32x32x16_bf16(kf[7], qr[3], C1, 0, 0, 0),   P1[14], P1[15], 0.f, 0.f,       pw3[2] = PKW(P1, 12), pw3[3] = PKW(P1, 14), pw3); \
    l_reg += sacc2.x + sacc2.y; \
    if (GK) { DMA_K((t) + 3, sl_cur); } if (GV) { DMA_V((t) + 1, sl_next); } \
    resc = false; \
    if (NA) { _Pragma("unroll") for (int r = 0; r < 16; ++r) { C0[r] -= mhat; C1[r] -= mhat; } } \
    CMASK(C0, C1, t); \
    if (!NOMAX) { float a = MX3(C0[0], C0[1], C1[0]), b = MX3(C0[2], C0[3], C1[1]); a = MX3(a, C1[2], C1[3]); \
      _Pragma("unroll") for (int r = 4; r < 16; r += 4) { a = MX3(a, C0[r], C0[r + 1]); b = MX3(b, C0[r + 2], C0[r + 3]); a = MX3(a, C1[r], C1[r + 1]); b = MX3(b, C1[r + 2], C1[r + 3]); } \
      float rm = __builtin_fmaxf(a, b); { auto rr = __builtin_amdgcn_permlane32_swap(__float_as_uint(rm), __float_as_uint(rm), false, false); rm = __builtin_fmaxf(__uint_as_float(rr[0]), __uint_as_float(rr[1])); } \
      if (__builtin_expect(__any(rm > (float)THRL), 0)) { const float dl = __builtin_fmaxf(rm, 0.f); mhat += dl; \
        _Pragma("unroll") for (int r = 0; r < 16; ++r) { C0[r] -= dl; C1[r] -= dl; } \
        if (!NA) { _Pragma("unroll") for (int r = 0; r < 16; ++r) negm[r] = -mhat; asm volatile("" : "+v"(negm)); } \
        const float f = __builtin_amdgcn_exp2f(-dl); l_reg *= f; if (hi == 0) wsf[r32] = f; resc = true; } } \
    SBAR(); \
    GAPB(o[0] = __builtin_amdgcn_mfma_f32_32x32x16_bf16(PAF(0), VFR(0), o[0], 0, 0, 0), C0, 0); \
    GAPB(o[1] = __builtin_amdgcn_mfma_f32_32x32x16_bf16(PAF(0), VFR(4), o[1], 0, 0, 0), C0, 4); \
    KRD(GL, 0); GAPB(o[0] = __builtin_amdgcn_mfma_f32_32x32x16_bf16(PAF(1), VFR(1), o[0], 0, 0, 0), C0, 8); \
    KRD(GL, 1); GAPB(o[1] = __builtin_amdgcn_mfma_f32_32x32x16_bf16(PAF(1), VFR(5), o[1], 0, 0, 0), C0, 12); \
    KRD(GL, 2); GAPB(o[0] = __builtin_amdgcn_mfma_f32_32x32x16_bf16(PAF(2), VFR(2), o[0], 0, 0, 0), C1, 0); \
    KRD(GL, 3); GAPB(o[1] = __builtin_amdgcn_mfma_f32_32x32x16_bf16(PAF(2), VFR(6), o[1], 0, 0, 0), C1, 4); \
    GAPB(o[0] = __builtin_amdgcn_mfma_f32_32x32x16_bf16(PAF(3), VFR(3), o[0], 0, 0, 0), C1, 8); \
    GAPB(o[1] = __builtin_amdgcn_mfma_f32_32x32x16_bf16(PAF(3), VFR(7), o[1], 0, 0, 0), C1, 12); \
    } while (0)
  int t = 1;
  for (; t + 5 < NT; t += 2) {
    STEP(pB0, pB1, pA0, pA1, t, true, true, true);     WAIT_BAR(2); RESC(); ROT();
    STEP(pA0, pA1, pB0, pB1, t + 1, true, true, true); WAIT_BAR(2); RESC(); ROT();
  }
  #define ENDW(tt) do { if ((tt) + 3 < NT) { WAIT_BAR(2); } else if ((tt) + 2 < NT) { WAIT_BAR(1); } else { WAIT_BAR(0); } } while (0)
  for (; t + 1 < NT; t += 2) {
    STEP(pB0, pB1, pA0, pA1, t, (t + 3 < NT), (t + 1 < NT), (t + 1 < NT));         ENDW(t);     RESC(); ROT();
    STEP(pA0, pA1, pB0, pB1, t + 1, (t + 4 < NT), (t + 2 < NT), (t + 2 < NT));     ENDW(t + 1); RESC(); ROT();
  }
  STEP(pB0, pB1, pA0, pA1, NT - 1, false, false, false); RESC();
  { float sacc = pB0[0] + pB0[1]; _Pragma("unroll") for (int r = 2; r < 16; ++r) sacc += pB0[r]; _Pragma("unroll") for (int r = 0; r < 16; ++r) sacc += pB1[r]; l_reg += sacc;
    pw0 = (u32x4){PKW(pB0, 0), PKW(pB0, 2), PKW(pB0, 4), PKW(pB0, 6)}; pw1 = (u32x4){PKW(pB0, 8), PKW(pB0, 10), PKW(pB0, 12), PKW(pB0, 14)}; pw2 = (u32x4){PKW(pB1, 0), PKW(pB1, 2), PKW(pB1, 4), PKW(pB1, 6)}; pw3 = (u32x4){PKW(pB1, 8), PKW(pB1, 10), PKW(pB1, 12), PKW(pB1, 14)};
    SBAR(); pv(o, vb0 + sl_cur, PAF(0), PAF(1), PAF(2), PAF(3)); }
  #undef PKW
  #undef PAF
  #undef VFR
  #undef PIN
  #undef MX3
  #undef GAPA
  #undef GAPB
  #undef EX
  #undef VRD
  #undef KRD
  #undef STEP
  #undef ENDW
  { auto rr = __builtin_amdgcn_permlane32_swap(__float_as_uint(l_reg), __float_as_uint(l_reg), false, false); l_reg = __uint_as_float(rr[0]) + __uint_as_float(rr[1]); }
  if (hi == 0) wsf[32 + r32] = l_reg; asm volatile("s_waitcnt lgkmcnt(0)" ::: "memory");
  float rli[16];
  #pragma unroll
  for (int r = 0; r < 16; ++r) rli[r] = __builtin_amdgcn_rcpf(wsf[32 + crow(r, hi)]);
  bf16* Ow = Ou + (long)(wid * QBLK) * op;
  { bf16* stg = (bf16*)(shm + LDS_OST) + wid * 2048;
    #pragma unroll
    for (int r = 0; r < 16; ++r) { const int orow = crow(r, hi);
      #pragma unroll
      for (int d0 = 0; d0 < 2; ++d0) stg[orow * 64 + d0 * 32 + r32] = (bf16)f2bf(o[d0][r] * rli[r]); }
    asm volatile("s_waitcnt lgkmcnt(0)" ::: "memory");
    #pragma unroll
    for (int i = 0; i < 4; ++i) { const int row = i * 8 + (lane >> 3), ch = lane & 7; const u32x4 v = *(const u32x4*)(stg + row * 64 + ch * 8); ATTN_STORE16(Ow + (long)row * op + ch * 8, v); } }
  asm volatile("s_waitcnt lgkmcnt(0)\n\ts_barrier" ::: "memory");
  #undef NEGM
  #undef DMA_K
  #undef DMA_V
  #undef TROW
  #undef CMASK
  #undef START
  #undef RESC
  #undef ROT
}
#undef SBAR
#undef WAIT_BAR
}
#ifndef FP8_MOE
#define FP8_MOE 1
#endif
struct Args { const float* in[29]; float* out; unsigned char* ws; int ph_lo, ph_hi; };
enum { I_X = 0, I_C, I_CTX, I_CCTX, I_WMOD, I_BMOD, I_N1G, I_N2G, I_WIN, I_LRE, I_LIM, I_LDT, I_BRE, I_BIM, I_CRE, I_CIM, I_SSMD, I_WGLU, I_QNG, I_KNG, I_RPB, I_WBR, I_WOUT, I_RW, I_RB, I_MG, I_MU, I_MD, I_FNG };

typedef const float* CFP;
struct Ctx {
    const __attribute__((address_space(4))) CFP* in; float* out; unsigned char* ws; LAS unsigned char* lds; gu32* ctl;
    int tid, lane, wave, vcu, G;
};
#define WSP(T_, off) ((T_*)(C.ws + (off)))

__device__ __forceinline__ bf16* xs_row(const Ctx& C, int m) { return WSP(bf16, WS_XS) + (size_t)m * D; }
__device__ __forceinline__ const float* in_row(const Ctx& C, int m) { const int b = m / LB, j = m - b * LB; return j < CTX ? C.in[I_CTX] + (size_t)(b * CTX + j) * D : C.in[I_X] + (size_t)(b * SEQ + j - CTX) * D; }
__device__ __forceinline__ int cond_of(int m) { const int b = m / LB, j = m - b * LB; return j < CTX ? 4 : b; }

__device__ __forceinline__ void transpose_item(const float* W, int N, int Kp, bf16* WT, int k0, int n0, int drow0, LAS float* scr, int lane) {
    const float* src = W + (size_t)k0 * N + n0 + lane;
    float tv[64];
#pragma unroll
    for (int i = 0; i < 64; ++i) tv[i] = src[(size_t)i * N];
#pragma unroll
    for (int i = 0; i < 64; ++i) scr[i * 65 + lane] = tv[i];
    LDS_WAIT(); asm volatile("" ::: "memory");
    const int c = lane & 7;
#pragma unroll
    for (int j = 0; j < 8; ++j) { const int n = (lane >> 3) + 8 * j; const LAS float* s = scr + (8 * c) * 65 + n;
        v4u o; o.x = pk2(s[0 * 65], s[1 * 65]); o.y = pk2(s[2 * 65], s[3 * 65]); o.z = pk2(s[4 * 65], s[5 * 65]); o.w = pk2(s[6 * 65], s[7 * 65]);
        *(GAS v4u*)(WT + (size_t)(drow0 + n) * Kp + k0 + 8 * c) = o; }
    LDS_WAIT(); asm volatile("" ::: "memory");
}
__device__ __forceinline__ void transpose_item8(const float* W, int N, int Kp, unsigned char* WT, int k0, int n0, int drow0, float scale, LAS float* scr, int lane) {
    const float* src = W + (size_t)k0 * N + n0 + lane;
    float tv[64];
#pragma unroll
    for (int i = 0; i < 64; ++i) tv[i] = src[(size_t)i * N];
#pragma unroll
    for (int i = 0; i < 64; ++i) scr[i * 65 + lane] = tv[i] * scale;
    LDS_WAIT(); asm volatile("" ::: "memory");
    const int c = lane & 3;
#pragma unroll
    for (int j = 0; j < 4; ++j) { const int n = (lane >> 2) + 16 * j; const LAS float* s = scr + (16 * c) * 65 + n;
        v4u o; o.x = pk4_fp8(s[0 * 65], s[1 * 65], s[2 * 65], s[3 * 65]); o.y = pk4_fp8(s[4 * 65], s[5 * 65], s[6 * 65], s[7 * 65]); o.z = pk4_fp8(s[8 * 65], s[9 * 65], s[10 * 65], s[11 * 65]); o.w = pk4_fp8(s[12 * 65], s[13 * 65], s[14 * 65], s[15 * 65]);
        *(GAS v4u*)(WT + (size_t)(drow0 + n) * Kp + k0 + 16 * c) = o; }
    LDS_WAIT(); asm volatile("" ::: "memory");
}
__device__ __forceinline__ void phase_weights(const Ctx& C, int l) {
    LAS float* scr = (LAS float*)(C.lds + C.wave * 16640);
    const int gw = C.vcu * NWAVES + C.wave, NGW = C.G * NWAVES;
    constexpr int I0 = 16 * 92, I1 = 8 * 8, I2 = 3 * 8 * 16, I3 = 16 * 16, I4 = 16 * 16 * 8, I5 = I4, I6 = 16 * 8 * 16;
    for (int it = gw; it < I0 + I1 + I2 + I3 + I4 + I5 + I6; it += NGW) {
        int r = it;
        if (r < I0) { const int kb = r / 92, nb = r % 92; if (W8_ALL) transpose_item8(C.in[I_WIN] + (size_t)l * 1024 * INW, INW, 1024, WSP(unsigned char, WS_WIN), 64 * kb, 64 * nb, 64 * nb, 64.f, scr, C.lane);
            else if (nb < 44 || GATE_BF16) transpose_item(C.in[I_WIN] + (size_t)l * 1024 * INW, INW, 1024, WSP(bf16, WS_WIN), 64 * kb, 64 * nb, 64 * nb, scr, C.lane);
            else transpose_item8(C.in[I_WIN] + (size_t)l * 1024 * INW, INW, 1024, WSP(unsigned char, WS_WIN8), 64 * kb, 64 * nb, 64 * nb - 2816, 64.f, scr, C.lane); continue; } r -= I0;
        if (r < I1) { const int kb = r / 8, nb = r % 8; transpose_item(C.in[I_WGLU] + (size_t)l * 512 * 512, 512, 512, WSP(bf16, WS_WGLU), 64 * kb, 64 * nb, 64 * nb, scr, C.lane); continue; } r -= I1;
        if (r < I2) { const int i = r / 128, q = r % 128, kb = q / 16, nb = q % 16; transpose_item(C.in[I_WBR] + (size_t)(l * 3 + i) * 512 * 1024, 1024, 512, WSP(bf16, WS_WBR) + (size_t)i * 1024 * 512, 64 * kb, 64 * nb, 64 * nb, scr, C.lane); continue; } r -= I2;
        if (r < I3) { const int kb = r / 16, nb = r % 16; transpose_item(C.in[I_WOUT] + (size_t)l * 1024 * 1024, 1024, 1024, WSP(bf16, WS_WOUT), 64 * kb, 64 * nb, 64 * nb, scr, C.lane); continue; } r -= I3;
        if (r < I4 + I5) { const int up = r >= I4; if (up) r -= I4; const int e = r / 128, q = r % 128, kb = q / 8, nb = q % 8, n0 = 64 * nb;
            if (FP8_MOE) transpose_item8((up ? C.in[I_MU] : C.in[I_MG]) + (size_t)(l * 16 + e) * 1024 * 512, 512, 1024, WSP(unsigned char, WS_MOE1) + (size_t)e * 1024 * 1024, 64 * kb, n0, (n0 / 128) * 256 + (n0 % 128) + (up ? 128 : 0), 64.f, scr, C.lane);
            else transpose_item((up ? C.in[I_MU] : C.in[I_MG]) + (size_t)(l * 16 + e) * 1024 * 512, 512, 1024, WSP(bf16, WS_MOE1) + (size_t)e * 1024 * 1024, 64 * kb, n0, (n0 / 128) * 256 + (n0 % 128) + (up ? 128 : 0), scr, C.lane); continue; } r -= I4 + I5;
        { const int e = r / 128, q = r % 128, kb = q / 16, nb = q % 16; if (FP8_MOE) transpose_item8(C.in[I_MD] + (size_t)(l * 16 + e) * 512 * 1024, 1024, 512, WSP(unsigned char, WS_MOE2) + (size_t)e * 1024 * 512, 64 * kb, 64 * nb, 64 * nb, 32.f, scr, C.lane);
            else transpose_item(C.in[I_MD] + (size_t)(l * 16 + e) * 512 * 1024, 1024, 512, WSP(bf16, WS_MOE2) + (size_t)e * 1024 * 512, 64 * kb, 64 * nb, 64 * nb, scr, C.lane); }
    }
}

__device__ __forceinline__ void phase_mod(const Ctx& C) {
    LAS float* sc = (LAS float*)(C.lds);
    LAS float* red = (LAS float*)(C.lds + 20480);
    for (int i = C.tid; i < 5 * 1024; i += 512) { const int c = i >> 10, k = i & 1023; const float v = c < 4 ? C.in[I_C][c * 1024 + k] : C.in[I_CCTX][k]; sc[i] = v * fsigmoid(v); }
    __syncthreads();
    for (int it = C.vcu; it < NLAYER * 96; it += C.G) {
        const int l = it / 96, col = (it % 96) * 64 + C.lane, k0 = C.wave * 128;
        const float* W = C.in[I_WMOD] + (size_t)l * 1024 * 6144 + (size_t)k0 * 6144 + col;
        float a0 = 0.f, a1 = 0.f, a2 = 0.f, a3 = 0.f, a4 = 0.f;
#pragma unroll 16
        for (int k = 0; k < 128; ++k) { const float w = W[(size_t)k * 6144]; a0 += sc[k0 + k] * w; a1 += sc[1024 + k0 + k] * w; a2 += sc[2048 + k0 + k] * w; a3 += sc[3072 + k0 + k] * w; a4 += sc[4096 + k0 + k] * w; }
        LAS float* r = red + C.wave * 320 + C.lane; r[0] = a0; r[64] = a1; r[128] = a2; r[192] = a3; r[256] = a4;
        __syncthreads();
        if (C.tid < 320) { const int c = C.tid >> 6; float s = C.in[I_BMOD][l * 6144 + col];
#pragma unroll
            for (int w = 0; w < 8; ++w) s += red[w * 320 + C.tid];
            WSP(float, WS_MOD)[(size_t)(l * 5 + c) * 6144 + col] = s; }
        __syncthreads();
    }
}

__device__ __forceinline__ void phase_s5mats(const Ctx& C, int l, int w) {
    if (w < 0 || w >= 128) return;
    const int g = w >> 2, part = w & 3, tid = C.tid;
    LAS f32x2* POW = (LAS f32x2*)(C.lds);
    LAS f32x2* CC = (LAS f32x2*)(C.lds + 33792);
    LAS f32x2* BB = (LAS f32x2*)(C.lds + 50176);
    LAS f32x2* COEF = (LAS f32x2*)(C.lds + 66560);
    LAS bf16* KT = (LAS bf16*)(C.lds + 67584);
    LAS float* WT = (LAS float*)(C.lds + 101376);
    __syncthreads();
    if (tid < 128) {
        const int d = tid >> 6, p = tid & 63; const int li = ((l * 2 + d) * 32 + g) * 64 + p;
        const float re = C.in[I_LRE][li], im = C.in[I_LIM][li], dt = __expf(C.in[I_LDT][(l * 2 + d) * 32 + g]);
        for (int tau = 0; tau <= 32; ++tau) { const float mag = __expf(re * dt * (float)tau), rev = im * dt * (float)tau * 0.15915494309189535f;
            const float wr = mag * cos_rev(rev), wi = mag * sin_rev(rev);
            POW[(d * 33 + tau) * 64 + p] = (f32x2){wr, wi}; if (tau < 32) { WT[((d * 64 + p) * 2) * 32 + tau] = wr; WT[((d * 64 + p) * 2 + 1) * 32 + tau] = wi; } }
        const float mag = __expf(re * dt), rev = im * dt * 0.15915494309189535f; const float lr = mag * cos_rev(rev) - 1.f, lim = mag * sin_rev(rev);
        const float den = 1.f / (re * re + im * im);
        COEF[tid] = (f32x2){(lr * re + lim * im) * den, (lim * re - lr * im) * den};
    }
    __syncthreads();
    for (int i = tid; i < 2048; i += 512) {
        const int d = i >> 10, p = (i >> 4) & 63, h = i & 15; const size_t bi = (((size_t)(l * 2 + d) * 32 + g) * 64 + p) * 16 + h;
        const float br = C.in[I_BRE][bi], bi_ = C.in[I_BIM][bi]; const f32x2 cf = COEF[d * 64 + p];
        BB[i] = (f32x2){cf.x * br - cf.y * bi_, cf.x * bi_ + cf.y * br};
        const int h2 = (i >> 6) & 15, p2 = i & 63; const size_t ci = (((size_t)(l * 2 + d) * 32 + g) * 16 + h2) * 64 + p2;
        CC[i] = (f32x2){C.in[I_CRE][ci], C.in[I_CIM][ci]};
    }
    __syncthreads();
    {
        const int wv = tid >> 6, ln = tid & 63, hi = ln >> 5, i = ln & 31, h = 2 * wv + (i >> 4), hp = i & 15;
        f32x16 a0 = f32x16{}, a1 = f32x16{};
#pragma unroll 4
        for (int p = 0; p < 64; ++p) {
            const f32x2 c0 = CC[h * 64 + p], b0 = BB[p * 16 + hp], c1 = CC[1024 + h * 64 + p], b1 = BB[1024 + p * 16 + hp];
            const float x0 = hi == 0 ? (c0.x * b0.x - c0.y * b0.y) : -(c0.x * b0.y + c0.y * b0.x);
            const float x1 = hi == 0 ? (c1.x * b1.x - c1.y * b1.y) : -(c1.x * b1.y + c1.y * b1.x);
            a0 = __builtin_amdgcn_mfma_f32_32x32x2f32(x0, WT[(p * 2 + hi) * 32 + i], a0, 0, 0, 0);
            a1 = __builtin_amdgcn_mfma_f32_32x32x2f32(x1, WT[((64 + p) * 2 + hi) * 32 + i], a1, 0, 0, 0);
        }
        const float* sd = C.in[I_SSMD] + l * 512 + g * 16;
#pragma unroll
        for (int r = 0; r < 16; ++r) { const int rl = (r & 3) + 8 * (r >> 2) + 4 * hi, hh = 2 * wv + (rl >> 4), hq = rl & 15;
            float f = a0[r]; if (i == 0) f += a1[r] + (hh == hq ? sd[hh] : 0.f);
            KT[((31 + i) * 16 + hh) * 16 + hq] = (bf16)f2bf(f);
            if (i > 0) KT[((31 - i) * 16 + hh) * 16 + hq] = (bf16)f2bf(a1[r]); }
    }
    __syncthreads();
    bf16* B1 = WSP(bf16, WS_BT1) + (size_t)g * 768 * 512; bf16* B2 = WSP(bf16, WS_BT2) + (size_t)g * 512 * 256;
    for (int i = tid; i < 128 * 64; i += 512) {
        const int n = part * 128 + (i >> 6), ch = i & 63, t = n >> 4, h = n & 15, s = ch >> 1, hp0 = (ch & 1) * 8;
        *(GAS v4u*)(B1 + (size_t)n * 512 + ch * 8) = *(const LAS v4u*)(KT + ((t - s + 31) * 16 + h) * 16 + hp0);
    }
    for (int i = tid; i < 64 * 64; i += 512) {
        const int nn = part * 64 + (i >> 6), ch = i & 63, d = nn >> 7, p = (nn & 127) >> 1, ri = nn & 1, s = ch >> 1, hp0 = (ch & 1) * 8;
        const f32x2 w = POW[(d * 33 + (d == 0 ? 31 - s : s)) * 64 + p]; float v[8];
#pragma unroll
        for (int j = 0; j < 8; ++j) { const f32x2 b = BB[d * 1024 + p * 16 + hp0 + j]; v[j] = ri == 0 ? (w.x * b.x - w.y * b.y) : (w.x * b.y + w.y * b.x); }
        v4u o; o.x = pk2(v[0], v[1]); o.y = pk2(v[2], v[3]); o.z = pk2(v[4], v[5]); o.w = pk2(v[6], v[7]);
        *(GAS v4u*)(B1 + (size_t)(512 + nn) * 512 + ch * 8) = o;
    }
    for (int i = tid; i < 128 * 32; i += 512) {
        const int n = part * 128 + (i >> 5), ch = i & 31, t = n >> 4, h = n & 15, d = ch >> 4, p0 = (ch & 15) * 4; float v[8];
#pragma unroll
        for (int j = 0; j < 4; ++j) { const f32x2 c = CC[d * 1024 + h * 64 + p0 + j], w = POW[(d * 33 + (d == 0 ? t + 1 : 32 - t)) * 64 + p0 + j];
            v[2 * j] = c.x * w.x - c.y * w.y; v[2 * j + 1] = -(c.x * w.y + c.y * w.x); }
        v4u o; o.x = pk2(v[0], v[1]); o.y = pk2(v[2], v[3]); o.z = pk2(v[4], v[5]); o.w = pk2(v[6], v[7]);
        *(GAS v4u*)(B2 + (size_t)n * 256 + ch * 8) = o;
    }
    __syncthreads();
}

template <int MODE>
__device__ __forceinline__ void phase_rows(const Ctx& C, int l) {
    const int gw = C.vcu * NWAVES + C.wave, NGW = C.G * NWAVES, lane = C.lane;
    const float* MODl = WSP(float, WS_MOD) + (size_t)(MODE == 2 ? 0 : l) * 5 * 6144;
    const float* MODp = WSP(float, WS_MOD) + (size_t)(l > 0 ? l - 1 : 0) * 5 * 6144;
    const bf16* YS = WSP(bf16, WS_YSLOT);
    LAS float* GT = (LAS float*)C.lds;
    LAS float* GM = GT + 5120;
    LAS float* SH = GT + 10240;
    __syncthreads();
    for (int i = C.tid; i < 5120; i += 512) { const int cond = i >> 10, k = i & 1023;
        if (MODE != 0) GT[i] = MODp[cond * 6144 + 5 * 1024 + k];
        if (MODE != 2) { GM[i] = C.in[I_N1G][l * D + k] * (MODl[cond * 6144 + 1024 + k] + 1.f); SH[i] = MODl[cond * 6144 + k]; }
        else if (i < 1024) GM[i] = C.in[I_FNG][k]; }
    __syncthreads();
    f32x4 nx[4]; v2u nb[4], na[4], nc[4];
#define ROWS_LOAD(mm) do { const int m_ = (mm); \
        if (MODE == 0) { const GAS f32x4* xr = (const GAS f32x4*)in_row(C, m_) + lane; _Pragma("unroll") for (int q = 0; q < 4; ++q) nx[q] = xr[64 * q]; } \
        else { const GAS v2u* xr = (const GAS v2u*)xs_row(C, m_) + lane; const GAS v2u* y0 = (const GAS v2u*)(YS + (size_t)(2 * m_) * D) + lane; const GAS v2u* y1 = (const GAS v2u*)(YS + (size_t)(2 * m_ + 1) * D) + lane; \
            _Pragma("unroll") for (int q = 0; q < 4; ++q) { nb[q] = xr[64 * q]; na[q] = y0[64 * q]; nc[q] = y1[64 * q]; } } } while (0)
    int m = gw; if (MODE == 2) { while (m < T && (m % LB) < CTX) m += NGW; }
    if (m < T) ROWS_LOAD(m);
    while (m < T) {
        const int b = m / LB, j = m - b * LB, cond = j < CTX ? 4 : b;
        f32x4 v[4];
        if (MODE == 0) {
#pragma unroll
            for (int q = 0; q < 4; ++q) v[q] = nx[q]; }
        else { const LAS f32x4* g2 = (const LAS f32x4*)(GT + cond * 1024) + lane;
#pragma unroll
            for (int q = 0; q < 4; ++q) { const f32x4 g = g2[64 * q]; const v2u a = na[q], c = nc[q], xb_ = nb[q];
                v[q] = (f32x4){bflo(xb_.x), bfhi(xb_.x), bflo(xb_.y), bfhi(xb_.y)} + g * (f32x4){bflo(a.x) + bflo(c.x), bfhi(a.x) + bfhi(c.x), bflo(a.y) + bflo(c.y), bfhi(a.y) + bfhi(c.y)}; } }
        int mn = m + NGW; if (MODE == 2) { while (mn < T && (mn % LB) < CTX) mn += NGW; }
        if (mn < T) ROWS_LOAD(mn);
        float ss = 0.f;
#pragma unroll
        for (int q = 0; q < 4; ++q) ss += (v[q].x * v[q].x + v[q].y * v[q].y) + (v[q].z * v[q].z + v[q].w * v[q].w);
        const float rstd = 1.f / sqrtf(wave_sum(ss, lane) * (1.f / D) + EPS);
        if (MODE == 2) { GAS f32x4* o = (GAS f32x4*)(C.out + (size_t)(b * SEQ + j - CTX) * D) + lane; const LAS f32x4* fg = (const LAS f32x4*)GM + lane;
#pragma unroll
            for (int q = 0; q < 4; ++q) o[64 * q] = v[q] * rstd * fg[64 * q]; }
        else { GAS v2u* xo = (GAS v2u*)xs_row(C, m) + lane; GAS v2u* ho = (GAS v2u*)(WSP(bf16, WS_HB) + (size_t)m * D) + lane; GAS unsigned* h8 = (GAS unsigned*)(WSP(unsigned char, WS_HB8) + (size_t)m * D) + lane;
            const LAS f32x4* gm = (const LAS f32x4*)(GM + cond * 1024) + lane; const LAS f32x4* sh = (const LAS f32x4*)(SH + cond * 1024) + lane;
#pragma unroll
            for (int q = 0; q < 4; ++q) { xo[64 * q] = (v2u){pk2(v[q].x, v[q].y), pk2(v[q].z, v[q].w)}; const f32x4 h = v[q] * rstd * gm[64 * q] + sh[64 * q]; if (!W8_ALL) ho[64 * q] = (v2u){pk2(h.x, h.y), pk2(h.z, h.w)}; if (H8_WRITE) h8[64 * q] = pk4_fp8(h.x, h.y, h.z, h.w); } }
        m = mn;
    }
#undef ROWS_LOAD
}

__device__ __forceinline__ void phase_qkprep(const Ctx& C, int l) {
    const int gw = C.vcu * NWAVES + C.wave, NGW = C.G * NWAVES, lane = C.lane, s8 = lane & 7;
    const float* qg = C.in[I_QNG] + l * 64 + 8 * s8; const float* kg = C.in[I_KNG] + l * 64 + 8 * s8;
    float gq[8], gk[8];
#pragma unroll
    for (int i = 0; i < 8; ++i) { gq[i] = qg[i]; gk[i] = kg[i]; }
    const int ax = s8 >> 2, f0 = 8 * (s8 & 1);
    float inv[8];
#pragma unroll
    for (int i = 0; i < 8; ++i) inv[i] = exp2f(-(float)(f0 + i) * 0.8304820237218406f) * 0.15915494309189535f;
    const int kl = lane & 15;
    v4u wq, wk;
    if (gw < T) { wq = *((const GAS v4u*)(WSP(bf16, WS_QA) + (size_t)gw * 512) + lane); wk = *((const GAS v4u*)(WSP(bf16, WS_KA) + (size_t)gw * 128) + kl); }
    for (int m = gw; m < T; m += NGW) {
        const int b = m / LB, j = m - b * LB; const bool lat = j >= CTX; const int tt = j - CTX; const float pos = (float)(ax == 0 ? (tt >> 6) : (tt & 63));
        const v4u cq = wq, ck = wk;
        if (m + NGW < T) { wq = *((const GAS v4u*)(WSP(bf16, WS_QA) + (size_t)(m + NGW) * 512) + lane); wk = *((const GAS v4u*)(WSP(bf16, WS_KA) + (size_t)(m + NGW) * 128) + kl); }
        float cs[8], sn[8];
#pragma unroll
        for (int i = 0; i < 8; ++i) { cs[i] = lat ? cos_rev(pos * inv[i]) : 1.f; sn[i] = lat ? sin_rev(pos * inv[i]) : 0.f; }
#pragma unroll
        for (int which = 0; which < 2; ++which) {
            const v4u w = which == 0 ? cq : ck; float x[8] = {bflo(w.x), bfhi(w.x), bflo(w.y), bfhi(w.y), bflo(w.z), bfhi(w.z), bflo(w.w), bfhi(w.w)};
            float ss = 0.f;
#pragma unroll
            for (int i = 0; i < 8; ++i) ss += x[i] * x[i];
            ss += dpp_mov<0xB1, 0xF>(ss); ss += dpp_mov<0x4E, 0xF>(ss); ss += dpp_mov<0x141, 0xF>(ss);
            const float rstd = 1.f / sqrtf(ss * (1.f / 64.f) + EPS);
            float y[8];
#pragma unroll
            for (int i = 0; i < 8; ++i) { const float xn = x[i] * rstd * (which == 0 ? gq[i] : gk[i]); const float other = dpp_mov<0x4E, 0xF>(xn);
                y[i] = (s8 & 2) ? (xn * cs[i] + other * sn[i]) : (xn * cs[i] - other * sn[i]); }
            const float sc = which == 0 ? C2 : 1.f;
            v4u o; o.x = pk2(y[0] * sc, y[1] * sc); o.y = pk2(y[2] * sc, y[3] * sc); o.z = pk2(y[4] * sc, y[5] * sc); o.w = pk2(y[6] * sc, y[7] * sc);
            if (which == 0) *((GAS v4u*)(WSP(bf16, WS_QA) + (size_t)m * 512) + lane) = o;
            else if (lane < 16) *((GAS v4u*)(WSP(bf16, WS_KA) + (size_t)m * 128) + lane) = o;
        }
    }
}

__device__ __forceinline__ void phase_carry(const Ctx& C, int l) {
    if (C.vcu >= 32) return;
    const int b = C.vcu >> 3, g = (C.vcu & 7) * 4 + (C.wave >> 1), d = C.wave & 1, p = C.lane;
    const int li = ((l * 2 + d) * 32 + g) * 64 + p;
    const float re = C.in[I_LRE][li], im = C.in[I_LIM][li], dt = __expf(C.in[I_LDT][(l * 2 + d) * 32 + g]);
    const float mag = __expf(re * dt * 32.f), rev = im * dt * 32.f * 0.15915494309189535f; const float Lr = mag * cos_rev(rev), Li = mag * sin_rev(rev);
    const GAS f32x2* S = (const GAS f32x2*)(WSP(float, WS_SST) + (size_t)(b * NCH) * 8192 + g * 256 + d * 128) + p;
    GAS unsigned* X = (GAS unsigned*)(WSP(bf16, WS_XST) + (size_t)(b * NCH) * 8192 + g * 256 + d * 128) + p;
    float sr = 0.f, si = 0.f;
    if (d == 0) {
        for (int c0 = 0; c0 < NCH; c0 += 8) { f32x2 s[8];
#pragma unroll
            for (int k = 0; k < 8; ++k) s[k] = S[(size_t)(c0 + k) * 4096];
#pragma unroll
            for (int k = 0; k < 8; ++k) { X[(size_t)(c0 + k) * 4096] = pk2(sr, si); const float nr = Lr * sr - Li * si + s[k].x, ni = Lr * si + Li * sr + s[k].y; sr = nr; si = ni; } }
    } else {
        for (int seg = 0; seg < 33; ++seg) { const int chi = seg == 0 ? 7 : NCH - 1 - (seg - 1) * 8; f32x2 s[8];
#pragma unroll
            for (int k = 0; k < 8; ++k) s[k] = S[(size_t)(chi - k) * 4096];
#pragma unroll
            for (int k = 0; k < 8; ++k) { X[(size_t)(chi - k) * 4096] = pk2(sr, si); const float nr = Lr * sr - Li * si + s[k].x, ni = Lr * si + Li * sr + s[k].y; sr = nr; si = ni; } }
    }
}

__device__ __forceinline__ void phase_norm2(const Ctx& C, int l) {
    LAS float* TILE = (LAS float*)C.lds;
    LAS float* PART = (LAS float*)(C.lds + 65792);
    LAS unsigned* REC = (LAS unsigned*)(C.lds + 73984);
    LAS float* LG = (LAS float*)(C.lds + 78080);
    LAS unsigned* LCNT = (LAS unsigned*)(C.lds + 94464);
    LAS float* GAM = (LAS float*)(C.lds + 94720);
    LAS float* SHF = (LAS float*)(C.lds + 115200);
    const int lane = C.lane, tid = C.tid;
    if (tid < 32) LCNT[tid] = 0u;
    const float* MODl = WSP(float, WS_MOD) + (size_t)l * 5 * 6144;
    for (int i = tid; i < 5 * 1024; i += 512) { const int cond = i >> 10, k = i & 1023; GAM[i] = C.in[I_N2G][l * D + k] * (MODl[cond * 6144 + 4096 + k] + 1.f); SHF[i] = MODl[cond * 6144 + 3072 + k]; }
    int nrows = 0; for (int m = C.vcu; m < T; m += C.G) ++nrows;
    __syncthreads();
    const int fn = lane & 15, kq = lane >> 4;
    float bw[32];
#pragma unroll
    for (int j = 0; j < 32; ++j) bw[j] = C.in[I_RW][(128 * C.wave + 32 * kq + j) * 16 + fn];
    v2u nx[2][4];
#define N2_LOAD(ii) do { _Pragma("unroll") for (int rr = 0; rr < 2; ++rr) { const int i_ = (ii) + rr * NWAVES; const int m_ = C.vcu + C.G * (i_ < nrows ? i_ : (ii)); const GAS v2u* xr = (const GAS v2u*)xs_row(C, m_) + lane; \
        _Pragma("unroll") for (int q = 0; q < 4; ++q) nx[rr][q] = xr[64 * q]; } } while (0)
    if (C.wave < nrows) N2_LOAD(C.wave);
    for (int i0 = 0; i0 < nrows; i0 += 2 * NWAVES) {
        const int i = i0 + C.wave; const bool has0 = i < nrows, has1 = i + NWAVES < nrows;
        if (has0) {
#pragma unroll
            for (int rr = 0; rr < 2; ++rr) { const int ir = (rr && has1) ? i + NWAVES : i; const int m = C.vcu + C.G * ir, cond = cond_of(m);
                GAS unsigned* h8 = (GAS unsigned*)(WSP(unsigned char, WS_HB8) + (size_t)m * D) + lane;
                const LAS f32x4* gm = (const LAS f32x4*)(GAM + cond * 1024) + lane; const LAS f32x4* sh = (const LAS f32x4*)(SHF + cond * 1024) + lane;
                float ss = 0.f; f32x4 xf[4];
#pragma unroll
                for (int q = 0; q < 4; ++q) { const v2u w_ = nx[rr][q]; const f32x4 v = (f32x4){bflo(w_.x), bfhi(w_.x), bflo(w_.y), bfhi(w_.y)}; xf[q] = v; ss += (v.x * v.x + v.y * v.y) + (v.z * v.z + v.w * v.w); }
                const float rstd = 1.f / sqrtf(wave_sum(ss, lane) * (1.f / D) + EPS);
#pragma unroll
                for (int q = 0; q < 4; ++q) { const f32x4 h = xf[q] * rstd * gm[64 * q] + sh[64 * q];
                    *(LAS f32x4*)(TILE + (C.wave + NWAVES * rr) * 1028 + 256 * q + 4 * lane) = h;
                    if (rr == 0 || has1) h8[64 * q] = pk4_fp8(h.x, h.y, h.z, h.w); } }
            if (i + 2 * NWAVES < nrows) N2_LOAD(i + 2 * NWAVES);
        } else {
#pragma unroll
            for (int rr = 0; rr < 2; ++rr)
#pragma unroll
                for (int q = 0; q < 4; ++q) *(LAS f32x4*)(TILE + (C.wave + NWAVES * rr) * 1028 + 256 * q + 4 * lane) = (f32x4){0.f, 0.f, 0.f, 0.f};
        }
        __syncthreads();
        f32x4 dacc = (f32x4){0.f, 0.f, 0.f, 0.f};
#pragma unroll
        for (int j = 0; j < 8; ++j) { const f32x4 a = *(const LAS f32x4*)(TILE + fn * 1028 + 128 * C.wave + 32 * kq + 4 * j);
#pragma unroll
            for (int e = 0; e < 4; ++e) dacc = __builtin_amdgcn_mfma_f32_16x16x4f32(a[e], bw[4 * j + e], dacc, 0, 0, 0); }
#pragma unroll
        for (int r = 0; r < 4; ++r) PART[C.wave * 256 + (4 * kq + r) * 16 + fn] = dacc[r];
        __syncthreads();
        if (tid < 256) { float sum = 0.f;
#pragma unroll
            for (int w = 0; w < NWAVES; ++w) sum += PART[w * 256 + tid];
            const int ri = i0 + (tid >> 4); if (ri < nrows) LG[ri * 16 + (tid & 15)] = sum; }
    }
#undef N2_LOAD
    __syncthreads();
    float rb[16];
#pragma unroll
    for (int e = 0; e < 16; ++e) rb[e] = C.in[I_RB][e];
    for (int i = tid; i < nrows; i += 512) {
        float lg[16];
#pragma unroll
        for (int q = 0; q < 4; ++q) { const f32x4 t = *(const LAS f32x4*)(LG + i * 16 + 4 * q); lg[4 * q] = t.x; lg[4 * q + 1] = t.y; lg[4 * q + 2] = t.z; lg[4 * q + 3] = t.w; }
        float mx = lg[0];
#pragma unroll
        for (int e = 1; e < 16; ++e) mx = fmaxf(mx, lg[e]);
        float pr[16], sel[16], sum = 0.f;
#pragma unroll
        for (int e = 0; e < 16; ++e) { pr[e] = __expf(lg[e] - mx); sum += pr[e]; }
        const float rs = 1.f / sum;
#pragma unroll
        for (int e = 0; e < 16; ++e) { pr[e] *= rs; sel[e] = pr[e] + rb[e]; }
        float bestv = -1e30f; int best = 0;
#pragma unroll
        for (int gq = 0; gq < 4; ++gq) { float m1 = -1e30f, m2 = -1e30f;
#pragma unroll
            for (int k = 0; k < 4; ++k) { const float s_ = sel[4 * gq + k]; if (s_ > m1) { m2 = m1; m1 = s_; } else if (s_ > m2) m2 = s_; }
            const float gs = m1 + m2; if (gs > bestv) { bestv = gs; best = gq; } }
        float s4[4], p4[4];
#pragma unroll
        for (int k = 0; k < 4; ++k) { s4[k] = best == 0 ? sel[k] : best == 1 ? sel[4 + k] : best == 2 ? sel[8 + k] : sel[12 + k]; p4[k] = best == 0 ? pr[k] : best == 1 ? pr[4 + k] : best == 2 ? pr[8 + k] : pr[12 + k]; }
        int i0 = 0; float v0 = s4[0], q0 = p4[0];
#pragma unroll
        for (int k = 1; k < 4; ++k) if (s4[k] > v0) { v0 = s4[k]; i0 = k; q0 = p4[k]; }
        int i1 = i0 == 0 ? 1 : 0; float v1 = -1e30f, q1 = p4[i0 == 0 ? 1 : 0];
#pragma unroll
        for (int k = 0; k < 4; ++k) if (k != i0 && s4[k] > v1) { v1 = s4[k]; i1 = k; q1 = p4[k]; }
        const int e0 = 4 * best + i0, e1 = 4 * best + i1; const float wn = 1.f / (q0 + q1);
        const unsigned lp0 = atomicAdd((unsigned*)(LCNT + e0), 1u), lp1 = atomicAdd((unsigned*)(LCNT + e1), 1u);
        REC[i * 4 + 0] = (unsigned)e0 | ((unsigned)e1 << 8) | (lp0 << 16); REC[i * 4 + 1] = lp1; REC[i * 4 + 2] = __float_as_uint(q0 * wn); REC[i * 4 + 3] = __float_as_uint(q1 * wn);
    }
    __syncthreads();
    if (tid < 16) LCNT[16 + tid] = __hip_atomic_fetch_add((unsigned*)(C.ctl + CW_CNT + l * 1024 + 64 * tid), LCNT[tid], RLX_AGENT);
    __syncthreads();
    int* LIST = WSP(int, WS_LIST); float* RWG = WSP(float, WS_RW);
    for (int i = tid; i < nrows; i += 512) { const int m = C.vcu + C.G * i; const unsigned r0 = REC[i * 4], r1 = REC[i * 4 + 1];
        const int e0 = r0 & 255, e1 = (r0 >> 8) & 255; const unsigned lp0 = r0 >> 16, lp1 = r1;
        LIST[(size_t)e0 * T + LCNT[16 + e0] + lp0] = 2 * m; LIST[(size_t)e1 * T + LCNT[16 + e1] + lp1] = 2 * m + 1;
        RWG[2 * m] = __uint_as_float(REC[i * 4 + 2]); RWG[2 * m + 1] = __uint_as_float(REC[i * 4 + 3]); }
    __syncthreads();
}
using pg8::Unit;
typedef f32x4 Acc[2][2][4][2];
__device__ __forceinline__ v4u pack8(const f32x4& a, const f32x4& b) { v4u w; w.x = cvt_pk_bf16(a[0], a[1]); w.y = cvt_pk_bf16(a[2], a[3]); w.z = cvt_pk_bf16(b[0], b[1]); w.w = cvt_pk_bf16(b[2], b[3]); return w; }
__device__ __forceinline__ void unpack8(const v4u& w, f32x4& a, f32x4& b) { a = (f32x4){bflo(w.x), bfhi(w.x), bflo(w.y), bfhi(w.y)}; b = (f32x4){bflo(w.z), bfhi(w.z), bflo(w.w), bfhi(w.w)}; }
#ifndef WT_MODE
#define WT_MODE 0
#endif
__device__ __forceinline__ void st16(void* p, const v4u& v) {
#if WT_MODE == 1
    asm volatile("global_store_dwordx4 %0, %1, off sc0 sc1" :: "v"(p), "v"(v) : "memory");
#elif WT_MODE == 2
    asm volatile("global_store_dwordx4 %0, %1, off nt" :: "v"(p), "v"(v) : "memory");
#else
    *(GAS v4u*)p = v;
#endif
}
__device__ __forceinline__ int chunk_m0(int cr) { return (cr / NCH) * LB + (cr % NCH) * 32; }

struct PWin {
    static constexpr bool EARLY_AOFF = false, FP8 = false; unsigned char* ws; int G, c; int K; unsigned kstepA;
    __device__ __forceinline__ bool next(int i, Unit& u) const { const long L = (long)i * G + c; if (L >= NPAN * 11) return false; pg8::static_decode((int)L, NPAN, 11, u.pm, u.pn); u.z = 0; return true; }
    __device__ __forceinline__ const char* a_base(const Unit& u) const { return (const char*)(ws + WS_HB) + (size_t)u.pm * 256 * 1024 * 2; }
    __device__ __forceinline__ unsigned a_off(const Unit&, int h, int R, int Cc) const { return (unsigned)((h * 128 + R) * 1024 + Cc) * 2u; }
    __device__ __forceinline__ const char* b_base(const Unit& u) const { return (const char*)(ws + WS_WIN) + (size_t)u.pn * 256 * 1024 * 2; }
    __device__ __forceinline__ void epi(const Acc& acc, const Unit& u, int wr, int wc, int fr, int fq) const {
        const int row0 = u.pm * 256 + wr * 64 + fr;
#pragma unroll
        for (int bj = 0; bj < 2; ++bj) {
            const int cb = u.pn * 256 + bj * 128; bf16* dst; int ld, col, mode = 0; float sc = 1.f;
            if (cb < 512) { dst = (bf16*)(ws + WS_U) + ((size_t)((cb + wc * 32 + 8 * fq) >> 4) * T) * 16 + ((8 * fq) & 15) - (wc * 32 + 8 * fq); ld = 16; col = 0; }
            else if (cb < 1024) { dst = (bf16*)(ws + WS_QA); ld = 512; col = cb - 512; }
            else if (cb == 1024) { dst = (bf16*)(ws + WS_KA); ld = 128; col = 0; }
            else if (cb == 1152) { dst = (bf16*)(ws + WS_VA); ld = 128; col = 0; }
            else if (cb < 1792) { dst = (bf16*)(ws + WS_QN); ld = 512; col = cb - 1280; sc = C2; }
            else if (cb < 2304) { dst = (bf16*)(ws + WS_KN); ld = 512; col = cb - 1792; }
            else { dst = (bf16*)(ws + WS_VN); ld = 512; col = cb - 2304; }
            const int c0 = col + wc * 32 + 8 * fq;
#pragma unroll
            for (int ai = 0; ai < 2; ++ai)
#pragma unroll
                for (int m = 0; m < 4; ++m) { f32x4 v0 = acc[ai][bj][m][0], v1 = acc[ai][bj][m][1];
                    if (mode) { v0 = (f32x4){fsigmoid(v0[0]), fsigmoid(v0[1]), fsigmoid(v0[2]), fsigmoid(v0[3])}; v1 = (f32x4){fsigmoid(v1[0]), fsigmoid(v1[1]), fsigmoid(v1[2]), fsigmoid(v1[3])}; }
                    else { v0 = v0 * sc; v1 = v1 * sc; }
                    st16(dst + (size_t)(row0 + ai * 128 + m * 16) * ld + c0, pack8(v0, v1)); __builtin_amdgcn_sched_barrier(0); }
        }
    }
};

struct PWin8 {
    static constexpr bool EARLY_AOFF = false, FP8 = true; unsigned char* ws; int G, c; int K; unsigned kstepA;
    __device__ __forceinline__ bool next(int i, Unit& u) const { const long L = (long)i * G + c; if (L >= 2 * NPAN * 23) return false; pg8::static_decode((int)L, 2 * NPAN, 23, u.pm, u.pn); u.z = 0; return true; }
    __device__ __forceinline__ const char* a_base(const Unit& u) const { return (const char*)(ws + WS_HB8) + (size_t)u.pm * 128 * 1024; }
    __device__ __forceinline__ unsigned a_off(const Unit&, int R, int Cc) const { return (unsigned)(R * 1024 + Cc * 2); }
    __device__ __forceinline__ const char* b_base(const Unit& u) const { return (const char*)(ws + WS_WIN) + (size_t)u.pn * 256 * 1024; }
    __device__ __forceinline__ void epi(const f32x4 (&acc)[2][4][2], f32x4 (&)[2][4][2], const Unit& u, int wr, int wc, int fr, int fq) const {
        const int row0 = u.pm * 128 + wr * 64 + fr;
#pragma unroll
        for (int bj = 0; bj < 2; ++bj) {
            const int cb = u.pn * 256 + bj * 128;
            if (cb >= 2816) { const int c0 = cb - 2816 + wc * 32 + 8 * fq;
#pragma unroll
                for (int m = 0; m < 4; ++m) { f32x4 v0 = acc[bj][m][0] * (1.f / 64.f), v1 = acc[bj][m][1] * (1.f / 64.f);
                    v0 = (f32x4){fsigmoid(v0[0]), fsigmoid(v0[1]), fsigmoid(v0[2]), fsigmoid(v0[3])}; v1 = (f32x4){fsigmoid(v1[0]), fsigmoid(v1[1]), fsigmoid(v1[2]), fsigmoid(v1[3])};
                    *(GAS v2u*)((unsigned char*)(ws + WS_GATES) + (size_t)(row0 + m * 16) * 3072 + c0) = (v2u){pk4_fp8(v0[0], v0[1], v0[2], v0[3]), pk4_fp8(v1[0], v1[1], v1[2], v1[3])}; }
            } else {
                bf16* dst; int ld, col; float sc = 1.f / 64.f;
                if (cb < 512) { dst = (bf16*)(ws + WS_U) + ((size_t)((cb + wc * 32 + 8 * fq) >> 4) * T) * 16 + ((8 * fq) & 15) - (wc * 32 + 8 * fq); ld = 16; col = 0; }
                else if (cb < 1024) { dst = (bf16*)(ws + WS_QA); ld = 512; col = cb - 512; }
                else if (cb == 1024) { dst = (bf16*)(ws + WS_KA); ld = 128; col = 0; }
                else if (cb == 1152) { dst = (bf16*)(ws + WS_VA); ld = 128; col = 0; }
                else if (cb < 1792) { dst = (bf16*)(ws + WS_QN); ld = 512; col = cb - 1280; sc = C2 / 64.f; }
                else if (cb < 2304) { dst = (bf16*)(ws + WS_KN); ld = 512; col = cb - 1792; }
                else { dst = (bf16*)(ws + WS_VN); ld = 512; col = cb - 2304; }
                const int c0 = col + wc * 32 + 8 * fq;
#pragma unroll
                for (int m = 0; m < 4; ++m) *(GAS v4u*)(dst + (size_t)(row0 + m * 16) * ld + c0) = pack8(acc[bj][m][0] * sc, acc[bj][m][1] * sc);
            }
        }
    }
};

struct PGate {
    static constexpr bool EARLY_AOFF = false, FP8 = !GATE_BF16; unsigned char* ws; int G, c; int K; unsigned kstepA;
    __device__ __forceinline__ bool next(int i, Unit& u) const { const long L = (long)i * G + c; if (L >= 2 * NPAN * 12) return false; pg8::static_decode((int)L, 2 * NPAN, 12, u.pm, u.pn); u.z = 0; return true; }
    __device__ __forceinline__ const char* a_base(const Unit& u) const { return GATE_BF16 ? (const char*)(ws + WS_HB) + (size_t)u.pm * 128 * 2048 : (const char*)(ws + WS_HB8) + (size_t)u.pm * 128 * 1024; }
    __device__ __forceinline__ unsigned a_off(const Unit&, int R, int Cc) const { return GATE_BF16 ? (unsigned)(R * 2048 + Cc * 2) : (unsigned)(R * 1024 + Cc * 2); }
    __device__ __forceinline__ const char* b_base(const Unit& u) const { return GATE_BF16 ? (const char*)(ws + WS_WIN) + (size_t)(2816 + u.pn * 256) * 2048 : (const char*)(ws + WS_WIN8) + (size_t)u.pn * 256 * 1024; }
    __device__ __forceinline__ void epi(const f32x4 (&acc)[2][4][2], f32x4 (&)[2][4][2], const Unit& u, int wr, int wc, int fr, int fq) const {
#pragma unroll
        for (int m = 0; m < 4; ++m) { const size_t r = (size_t)(u.pm * 128 + wr * 64 + m * 16 + fr);
#pragma unroll
            for (int bj = 0; bj < 2; ++bj) { const int c0 = u.pn * 256 + bj * 128 + wc * 32 + 8 * fq; f32x4 v0 = acc[bj][m][0] * (GATE_BF16 ? 1.f : 1.f / 64.f), v1 = acc[bj][m][1] * (GATE_BF16 ? 1.f : 1.f / 64.f);
                v0 = (f32x4){fsigmoid(v0[0]), fsigmoid(v0[1]), fsigmoid(v0[2]), fsigmoid(v0[3])}; v1 = (f32x4){fsigmoid(v1[0]), fsigmoid(v1[1]), fsigmoid(v1[2]), fsigmoid(v1[3])};
                if (GATE_BF16) *(GAS v4u*)((bf16*)(ws + WS_GATES) + r * 3072 + c0) = pack8(v0, v1);
                else *(GAS v2u*)((unsigned char*)(ws + WS_GATES) + r * 3072 + c0) = (v2u){pk4_fp8(v0[0], v0[1], v0[2], v0[3]), pk4_fp8(v1[0], v1[1], v1[2], v1[3])}; }
            __builtin_amdgcn_sched_barrier(0); }
    }
};

struct PS5A {
    static constexpr bool EARLY_AOFF = false, FP8 = false; unsigned char* ws; int G, c; int K; unsigned kstepA;
    __device__ __forceinline__ bool next(int i, Unit& u) const { const long L = (long)i * G + c; if (L >= 32 * 15) return false; const int l = (int)L; u.z = l / 15; const int r = l % 15; u.pm = r / 3; u.pn = r % 3; return true; }
    __device__ __forceinline__ const char* a_base(const Unit& u) const { return (const char*)(ws + WS_U) + (size_t)u.z * T * 32; }
    __device__ __forceinline__ unsigned a_off(const Unit& u, int h, int R, int Cc) const { int cr = u.pm * 256 + h * 128 + R; cr = cr < NCR ? cr : NCR - 1; return (unsigned)(cr * 512 + Cc) * 2u; }
    __device__ __forceinline__ const char* b_base(const Unit& u) const { return (const char*)(ws + WS_BT1) + ((size_t)u.z * 768 + u.pn * 256) * 512 * 2; }
    __device__ __forceinline__ void epi(const Acc& acc, const Unit& u, int wr, int wc, int fr, int fq) const {
#pragma unroll
        for (int ai = 0; ai < 2; ++ai)
#pragma unroll
            for (int m = 0; m < 4; ++m) { const int cr = u.pm * 256 + ai * 128 + wr * 64 + m * 16 + fr; if (cr >= NCR) continue;
#pragma unroll
                for (int bj = 0; bj < 2; ++bj) { const int n = bj * 128 + wc * 32 + 8 * fq;
                    if (u.pn < 2) *(GAS v4u*)((bf16*)(ws + WS_YG) + (size_t)u.z * T * 16 + (size_t)cr * 512 + u.pn * 256 + n) = pack8(acc[ai][bj][m][0], acc[ai][bj][m][1]);
                    else { GAS f32x4* o = (GAS f32x4*)((float*)(ws + WS_SST) + (size_t)cr * 8192 + u.z * 256 + n); o[0] = acc[ai][bj][m][0]; o[1] = acc[ai][bj][m][1]; } }
                __builtin_amdgcn_sched_barrier(0); }
    }
};

struct PS5B {
    static constexpr bool EARLY_AOFF = false, FP8 = false; unsigned char* ws; int G, c; int K; unsigned kstepA;
    __device__ __forceinline__ bool next(int i, Unit& u) const { const long L = (long)i * G + c; if (L >= 32 * 10) return false; const int l = (int)L; u.z = l / 10; const int r = l % 10; u.pm = r / 2; u.pn = r % 2; return true; }
    __device__ __forceinline__ const char* a_base(const Unit& u) const { return (const char*)(ws + WS_XST) + (size_t)u.z * 512; }
    __device__ __forceinline__ unsigned a_off(const Unit& u, int h, int R, int Cc) const { int cr = u.pm * 256 + h * 128 + R; cr = cr < NCR ? cr : NCR - 1; return (unsigned)(cr * 8192 + Cc) * 2u; }
    __device__ __forceinline__ const char* b_base(const Unit& u) const { return (const char*)(ws + WS_BT2) + ((size_t)u.z * 512 + u.pn * 256) * 256 * 2; }
    __device__ __forceinline__ void epi(const Acc& acc, const Unit& u, int wr, int wc, int fr, int fq) const {
#pragma unroll
        for (int ai = 0; ai < 2; ++ai) {
            v4u yw[4][2];
#pragma unroll
            for (int m = 0; m < 4; ++m) { int cr = u.pm * 256 + ai * 128 + wr * 64 + m * 16 + fr; cr = cr < NCR ? cr : NCR - 1;
#pragma unroll
                for (int bj = 0; bj < 2; ++bj) yw[m][bj] = *(const GAS v4u*)((const bf16*)(ws + WS_YG) + (size_t)u.z * T * 16 + (size_t)cr * 512 + u.pn * 256 + bj * 128 + wc * 32 + 8 * fq); }
#pragma unroll
            for (int m = 0; m < 4; ++m) { const int cr = u.pm * 256 + ai * 128 + wr * 64 + m * 16 + fr; if (cr >= NCR) continue;
#pragma unroll
                for (int bj = 0; bj < 2; ++bj) { const int nn = u.pn * 256 + bj * 128 + wc * 32 + 8 * fq, t = nn >> 4, h0 = nn & 15;
                    GAS v4u* p = (GAS v4u*)((bf16*)(ws + WS_YS) + (size_t)(chunk_m0(cr) + t) * 512 + u.z * 16 + h0);
                    f32x4 y0, y1; { const v4u w_ = yw[m][bj]; unpack8(w_, y0, y1); } y0 += acc[ai][bj][m][0]; y1 += acc[ai][bj][m][1];
                    y0 = (f32x4){gelu_tanh(y0[0]), gelu_tanh(y0[1]), gelu_tanh(y0[2]), gelu_tanh(y0[3])}; y1 = (f32x4){gelu_tanh(y1[0]), gelu_tanh(y1[1]), gelu_tanh(y1[2]), gelu_tanh(y1[3])};
                    *p = pack8(y0, y1); } } }
    }
};

__device__ __forceinline__ int half_panel(int hl, bool lat_only) { if (!lat_only) return hl; const int pl = hl >> 1; return 2 * (pl + (pl >> 5) + 1) + (hl & 1); }
struct PGlu {
    static constexpr bool EARLY_AOFF = false, FP8 = false; unsigned char* ws; int G, c; int K; unsigned kstepA; bool lat_only;
    __device__ __forceinline__ bool next(int i, Unit& u) const { const int nH = lat_only ? 256 : 2 * NPAN; const long L = (long)i * G + c; if (L >= nH * 2) return false; pg8::static_decode((int)L, nH, 2, u.pm, u.pn); u.pm = half_panel(u.pm, lat_only); u.z = 0; return true; }
    __device__ __forceinline__ const char* a_base(const Unit& u) const { return (const char*)(ws + WS_YS) + (size_t)u.pm * 128 * 512 * 2; }
    __device__ __forceinline__ unsigned a_off(const Unit&, int R, int Cc) const { return (unsigned)(R * 512 + Cc) * 2u; }
    __device__ __forceinline__ const char* b_base(const Unit& u) const { return (const char*)(ws + WS_WGLU) + (size_t)u.pn * 256 * 512 * 2; }
    __device__ __forceinline__ void epi(const f32x4 (&acc)[2][4][2], f32x4 (&)[2][4][2], const Unit& u, int wr, int wc, int fr, int fq) const {
        v4u zw[4][2];
#pragma unroll
        for (int m = 0; m < 4; ++m)
#pragma unroll
            for (int bj = 0; bj < 2; ++bj) zw[m][bj] = *(const GAS v4u*)((const bf16*)(ws + WS_YS) + (size_t)(u.pm * 128 + wr * 64 + m * 16 + fr) * 512 + u.pn * 256 + bj * 128 + wc * 32 + 8 * fq);
#pragma unroll
        for (int m = 0; m < 4; ++m) { const size_t r = (size_t)(u.pm * 128 + wr * 64 + m * 16 + fr);
#pragma unroll
            for (int bj = 0; bj < 2; ++bj) { const int cc = u.pn * 256 + bj * 128 + wc * 32 + 8 * fq;
                f32x4 z0, z1; { const v4u w_ = zw[m][bj]; unpack8(w_, z0, z1); } const f32x4 a0 = acc[bj][m][0], a1 = acc[bj][m][1];
                z0 = z0 * (f32x4){fsigmoid(a0[0]), fsigmoid(a0[1]), fsigmoid(a0[2]), fsigmoid(a0[3])}; z1 = z1 * (f32x4){fsigmoid(a1[0]), fsigmoid(a1[1]), fsigmoid(a1[2]), fsigmoid(a1[3])};
                *(GAS v4u*)((bf16*)(ws + WS_U) + r * 512 + cc) = pack8(z0, z1); } }
    }
};

typedef f32x4 Acc128[2][4][2];
struct PMerge {
    static constexpr bool EARLY_AOFF = false, FP8 = false; unsigned char* ws; int G, c; int K; unsigned kstepA; bool lat_only;
    __device__ __forceinline__ bool next(int i, Unit& u) const { const int nH = lat_only ? 256 : 2 * NPAN; const long tile = (long)(i / 3) * G + c; if (tile >= nH * 4) return false; pg8::static_decode((int)tile, nH, 4, u.pm, u.pn); u.pm = half_panel(u.pm, lat_only); u.z = i % 3; return true; }
    __device__ __forceinline__ const char* a_base(const Unit& u) const { const size_t off = u.z == 0 ? WS_U : (u.z == 1 ? WS_AO : WS_NO); return (const char*)(ws + off) + (size_t)u.pm * 128 * 512 * 2; }
    __device__ __forceinline__ unsigned a_off(const Unit&, int R, int Cc) const { return (unsigned)(R * 512 + Cc) * 2u; }
    __device__ __forceinline__ const char* b_base(const Unit& u) const { return (const char*)(ws + WS_WBR) + ((size_t)u.z * 1024 + u.pn * 256) * 512 * 2; }
    __device__ __forceinline__ void epi(const Acc128& acc, Acc128& mrg, const Unit& u, int wr, int wc, int fr, int fq) const {
        v2u gw[4][2];
#pragma unroll
        for (int m = 0; m < 4; ++m)
#pragma unroll
            for (int bj = 0; bj < 2; ++bj) gw[m][bj] = *(const GAS v2u*)((const unsigned char*)(ws + WS_GATES) + (size_t)(u.pm * 128 + wr * 64 + m * 16 + fr) * 3072 + u.z * 1024 + u.pn * 256 + bj * 128 + wc * 32 + 8 * fq);
#pragma unroll
        for (int m = 0; m < 4; ++m) { const size_t r = (size_t)(u.pm * 128 + wr * 64 + m * 16 + fr);
#pragma unroll
            for (int bj = 0; bj < 2; ++bj) { const int cc = u.pn * 256 + bj * 128 + wc * 32 + 8 * fq; const v2u w_ = gw[m][bj];
                const f32x4 g0 = (f32x4){__builtin_amdgcn_cvt_f32_fp8((int)w_.x, 0), __builtin_amdgcn_cvt_f32_fp8((int)w_.x, 1), __builtin_amdgcn_cvt_f32_fp8((int)w_.x, 2), __builtin_amdgcn_cvt_f32_fp8((int)w_.x, 3)};
                const f32x4 g1 = (f32x4){__builtin_amdgcn_cvt_f32_fp8((int)w_.y, 0), __builtin_amdgcn_cvt_f32_fp8((int)w_.y, 1), __builtin_amdgcn_cvt_f32_fp8((int)w_.y, 2), __builtin_amdgcn_cvt_f32_fp8((int)w_.y, 3)};
                if (u.z == 0) { mrg[bj][m][0] = g0 * acc[bj][m][0]; mrg[bj][m][1] = g1 * acc[bj][m][1]; }
                else { mrg[bj][m][0] += g0 * acc[bj][m][0]; mrg[bj][m][1] += g1 * acc[bj][m][1]; }
                if (u.z == 2) *(GAS v4u*)((bf16*)(ws + WS_HB) + r * 1024 + cc) = pack8(mrg[bj][m][0], mrg[bj][m][1]); } }
    }
};

struct PWout {
    static constexpr bool EARLY_AOFF = false, FP8 = false; unsigned char* ws; float* out; const float* mod; int G, c; int K; unsigned kstepA; bool lat_only;
    __device__ __forceinline__ bool next(int i, Unit& u) const { const int nH = lat_only ? 256 : 2 * NPAN; const long L = (long)i * G + c; if (L >= nH * 4) return false; pg8::static_decode((int)L, nH, 4, u.pm, u.pn); u.pm = half_panel(u.pm, lat_only); u.z = 0; return true; }
    __device__ __forceinline__ const char* a_base(const Unit& u) const { return (const char*)(ws + WS_HB) + (size_t)u.pm * 128 * 1024 * 2; }
    __device__ __forceinline__ unsigned a_off(const Unit&, int R, int Cc) const { return (unsigned)(R * 1024 + Cc) * 2u; }
    __device__ __forceinline__ const char* b_base(const Unit& u) const { return (const char*)(ws + WS_WOUT) + (size_t)u.pn * 256 * 1024 * 2; }
    __device__ __forceinline__ void epi(const f32x4 (&acc)[2][4][2], f32x4 (&)[2][4][2], const Unit& u, int wr, int wc, int fr, int fq) const {
        const int pm = u.pm >> 1, b = pm / 33, pr = pm % 33, cond = pr == 0 ? 4 : b;
        bf16* xb = (bf16*)(ws + WS_XS) + (size_t)u.pm * 128 * D;
        const float* g1 = mod + cond * 6144 + 2048;
        v4u xv[2][4];
#pragma unroll
        for (int bj = 0; bj < 2; ++bj)
#pragma unroll
            for (int m = 0; m < 4; ++m) xv[bj][m] = *(const GAS v4u*)(xb + (size_t)(wr * 64 + m * 16 + fr) * D + u.pn * 256 + bj * 128 + wc * 32 + 8 * fq);
#pragma unroll
        for (int bj = 0; bj < 2; ++bj) { const int cc = u.pn * 256 + bj * 128 + wc * 32 + 8 * fq; const f32x4 ga = *(const GAS f32x4*)(g1 + cc), gb = *(const GAS f32x4*)(g1 + cc + 4);
#pragma unroll
            for (int m = 0; m < 4; ++m) { f32x4 x0, x1; { const v4u w_ = xv[bj][m]; unpack8(w_, x0, x1); }
                *(GAS v4u*)(xb + (size_t)(wr * 64 + m * 16 + fr) * D + cc) = pack8(x0 + ga * acc[bj][m][0], x1 + gb * acc[bj][m][1]); } }
    }
};

struct ExpTab { int cnt[16], tile0[17]; };
__device__ __forceinline__ int exp_find(const int (&tile0)[17], int q) { int e = 0;
#pragma unroll
    for (int k = 1; k < 16; ++k) e += (q >= tile0[k]) ? 1 : 0;
    return e; }

struct PMoe1 {
    static constexpr bool EARLY_AOFF = true, FP8 = true; unsigned char* ws; const LAS int* tab; int G, c; int K; unsigned kstepA;
    __device__ __forceinline__ bool next(int i, Unit& u) const { const long L = (long)i * G + c; const int total = __builtin_amdgcn_readfirstlane(tab[32]) * 4; if (L >= total) return false; const int q = (int)L >> 2; u.pn = (int)L & 3;
        int e = 0;
#pragma unroll
        for (int k = 1; k < 16; ++k) e += (q >= __builtin_amdgcn_readfirstlane(tab[16 + k])) ? 1 : 0;
        u.z = e; u.pm = q - __builtin_amdgcn_readfirstlane(tab[16 + e]); return true; }
    __device__ __forceinline__ const char* a_base(const Unit&) const { return (const char*)(ws + WS_HB8); }
    __device__ __forceinline__ unsigned a_off(const Unit& u, int R, int Cc) const { int r = u.pm * 128 + R; const int n = __builtin_amdgcn_readfirstlane(tab[u.z]); r = r < n ? r : n - 1;
        const int ent = ((const int*)(ws + WS_LIST))[(size_t)u.z * T + r]; return (unsigned)((ent >> 1) * 1024 + Cc * 2); }
    __device__ __forceinline__ const char* b_base(const Unit& u) const { return (const char*)(ws + WS_MOE1) + ((size_t)u.z * 1024 + u.pn * 256) * 1024; }
    __device__ __forceinline__ void epi(const f32x4 (&acc)[2][4][2], f32x4 (&)[2][4][2], const Unit& u, int wr, int wc, int fr, int fq) const {
        const size_t arow0 = (size_t)(__builtin_amdgcn_readfirstlane(tab[16 + u.z]) + u.pm) * 128;
#pragma unroll
        for (int m = 0; m < 4; ++m) { const f32x4 g0 = acc[0][m][0] * (1.f / 64.f), g1 = acc[0][m][1] * (1.f / 64.f), u0 = acc[1][m][0] * (8.f / 64.f), u1 = acc[1][m][1] * (8.f / 64.f);
            const f32x4 v0 = (f32x4){g0[0] * fsigmoid(g0[0]), g0[1] * fsigmoid(g0[1]), g0[2] * fsigmoid(g0[2]), g0[3] * fsigmoid(g0[3])} * u0;
            const f32x4 v1 = (f32x4){g1[0] * fsigmoid(g1[0]), g1[1] * fsigmoid(g1[1]), g1[2] * fsigmoid(g1[2]), g1[3] * fsigmoid(g1[3])} * u1;
            *(GAS v2u*)((unsigned char*)(ws + WS_ACT) + (arow0 + wr * 64 + m * 16 + fr) * 512 + u.pn * 128 + wc * 32 + 8 * fq) = (v2u){pk4_fp8(v0[0], v0[1], v0[2], v0[3]), pk4_fp8(v1[0], v1[1], v1[2], v1[3])}; }
    }
};
struct PMoe2 {
    static constexpr bool EARLY_AOFF = false, FP8 = true; unsigned char* ws; const LAS int* tab; int G, c; int K; unsigned kstepA;
    __device__ __forceinline__ bool next(int i, Unit& u) const { const long L = (long)i * G + c; const int total = __builtin_amdgcn_readfirstlane(tab[32]) * 4; if (L >= total) return false; const int q = (int)L >> 2; u.pn = (int)L & 3;
        int e = 0;
#pragma unroll
        for (int k = 1; k < 16; ++k) e += (q >= __builtin_amdgcn_readfirstlane(tab[16 + k])) ? 1 : 0;
        u.z = e; u.pm = q - __builtin_amdgcn_readfirstlane(tab[16 + e]); return true; }
    __device__ __forceinline__ const char* a_base(const Unit& u) const { return (const char*)(ws + WS_ACT) + (size_t)(__builtin_amdgcn_readfirstlane(tab[16 + u.z]) + u.pm) * 128 * 512; }
    __device__ __forceinline__ unsigned a_off(const Unit&, int R, int Cc) const { return (unsigned)(R * 512 + Cc * 2); }
    __device__ __forceinline__ const char* b_base(const Unit& u) const { return (const char*)(ws + WS_MOE2) + ((size_t)u.z * 1024 + u.pn * 256) * 512; }
    __device__ __forceinline__ void epi(const f32x4 (&acc)[2][4][2], f32x4 (&)[2][4][2], const Unit& u, int wr, int wc, int fr, int fq) const {
        const int n = __builtin_amdgcn_readfirstlane(tab[u.z]);
        int entv[4]; float wv[4];
#pragma unroll
        for (int m = 0; m < 4; ++m) { int r = u.pm * 128 + wr * 64 + m * 16 + fr; r = r < n ? r : n - 1; entv[m] = ((const int*)(ws + WS_LIST))[(size_t)u.z * T + r]; }
#pragma unroll
        for (int m = 0; m < 4; ++m) wv[m] = ((const float*)(ws + WS_RW))[entv[m]] * (1.f / 256.f);
#pragma unroll
        for (int m = 0; m < 4; ++m) { const int r = u.pm * 128 + wr * 64 + m * 16 + fr; if (r >= n) continue;
            const int ent = entv[m]; const float w = wv[m];
#pragma unroll
            for (int bj = 0; bj < 2; ++bj)
                *(GAS v4u*)((bf16*)(ws + WS_YSLOT) + (size_t)ent * 1024 + u.pn * 256 + bj * 128 + wc * 32 + 8 * fq) = pack8(acc[bj][m][0] * w, acc[bj][m][1] * w); }
    }
};
struct PMoe1B {
    static constexpr bool EARLY_AOFF = true, FP8 = false; unsigned char* ws; const LAS int* tab; int G, c; int K; unsigned kstepA;
    __device__ __forceinline__ bool next(int i, Unit& u) const { const long L = (long)i * G + c; const int total = tab[32] * 4; if (L >= total) return false; const int q = (int)L >> 2; u.pn = (int)L & 3;
        int e = 0;
#pragma unroll
        for (int k = 1; k < 16; ++k) e += (q >= tab[16 + k]) ? 1 : 0;
        u.z = e; u.pm = q - tab[16 + e]; return true; }
    __device__ __forceinline__ const char* a_base(const Unit&) const { return (const char*)(ws + WS_HB); }
    __device__ __forceinline__ unsigned a_off(const Unit& u, int h, int R, int Cc) const { int r = u.pm * 256 + h * 128 + R; const int n = tab[u.z]; r = r < n ? r : n - 1;
        const int ent = ((const int*)(ws + WS_LIST))[(size_t)u.z * T + r]; return (unsigned)((ent >> 1) * 1024 + Cc) * 2u; }
    __device__ __forceinline__ const char* b_base(const Unit& u) const { return (const char*)(ws + WS_MOE1) + ((size_t)u.z * 1024 + u.pn * 256) * 1024 * 2; }
    __device__ __forceinline__ void epi(const Acc& acc, const Unit& u, int wr, int wc, int fr, int fq) const {
        const size_t arow0 = (size_t)(tab[16 + u.z] + u.pm) * 256;
#pragma unroll
        for (int ai = 0; ai < 2; ++ai)
#pragma unroll
            for (int m = 0; m < 4; ++m) { const f32x4 g0 = acc[ai][0][m][0], g1 = acc[ai][0][m][1], u0 = acc[ai][1][m][0], u1 = acc[ai][1][m][1];
                const f32x4 v0 = (f32x4){g0[0] * fsigmoid(g0[0]), g0[1] * fsigmoid(g0[1]), g0[2] * fsigmoid(g0[2]), g0[3] * fsigmoid(g0[3])} * u0;
                const f32x4 v1 = (f32x4){g1[0] * fsigmoid(g1[0]), g1[1] * fsigmoid(g1[1]), g1[2] * fsigmoid(g1[2]), g1[3] * fsigmoid(g1[3])} * u1;
                *(GAS v4u*)((bf16*)(ws + WS_ACTB) + (arow0 + ai * 128 + wr * 64 + m * 16 + fr) * 512 + u.pn * 128 + wc * 32 + 8 * fq) = pack8(v0, v1); }
    }
};
struct PMoe2B {
    static constexpr bool EARLY_AOFF = false, FP8 = false; unsigned char* ws; const LAS int* tab; int G, c; int K; unsigned kstepA;
    __device__ __forceinline__ bool next(int i, Unit& u) const { const long L = (long)i * G + c; const int total = tab[32] * 4; if (L >= total) return false; const int q = (int)L >> 2; u.pn = (int)L & 3;
        int e = 0;
#pragma unroll
        for (int k = 1; k < 16; ++k) e += (q >= tab[16 + k]) ? 1 : 0;
        u.z = e; u.pm = q - tab[16 + e]; return true; }
    __device__ __forceinline__ const char* a_base(const Unit& u) const { return (const char*)(ws + WS_ACTB) + (size_t)(tab[16 + u.z] + u.pm) * 256 * 512 * 2; }
    __device__ __forceinline__ unsigned a_off(const Unit&, int h, int R, int Cc) const { return (unsigned)((h * 128 + R) * 512 + Cc) * 2u; }
    __device__ __forceinline__ const char* b_base(const Unit& u) const { return (const char*)(ws + WS_MOE2) + ((size_t)u.z * 1024 + u.pn * 256) * 512 * 2; }
    __device__ __forceinline__ void epi(const Acc& acc, const Unit& u, int wr, int wc, int fr, int fq) const {
        const int n = tab[u.z];
#pragma unroll
        for (int ai = 0; ai < 2; ++ai)
#pragma unroll
            for (int m = 0; m < 4; ++m) { const int r = u.pm * 256 + ai * 128 + wr * 64 + m * 16 + fr; if (r >= n) continue;
                const int ent = ((const int*)(ws + WS_LIST))[(size_t)u.z * T + r]; const float w = ((const float*)(ws + WS_RW))[ent];
#pragma unroll
                for (int bj = 0; bj < 2; ++bj)
                    *(GAS v4u*)((bf16*)(ws + WS_YSLOT) + (size_t)ent * 1024 + u.pn * 256 + bj * 128 + wc * 32 + 8 * fq) = pack8(acc[ai][bj][m][0] * w, acc[ai][bj][m][1] * w); }
    }
};
__device__ __forceinline__ void build_exptab(const Ctx& C, LAS int* tab, int l, int tsh = 7) {
    __syncthreads();
    if (threadIdx.x == 0) { int t0 = 0;
        for (int e = 0; e < 16; ++e) { const int n = (int)__hip_atomic_load((unsigned*)(C.ctl + CW_CNT + l * 1024 + 64 * e), RLX_AGENT); tab[e] = n; tab[16 + e] = t0; t0 += (n + (1 << tsh) - 1) >> tsh; }
        tab[32] = t0; }
    __syncthreads();
}
__device__ __forceinline__ void phase_attn(const Ctx& C, int l, unsigned char* lds_gen) {
    phase_carry(C, l);
    char* shm = (char*)lds_gen;
    bf16* QA = WSP(bf16, WS_QA); bf16* KA = WSP(bf16, WS_KA); bf16* VA = WSP(bf16, WS_VA); bf16* QN = WSP(bf16, WS_QN); bf16* KN = WSP(bf16, WS_KN); bf16* VN = WSP(bf16, WS_VN);
#ifndef ATTN_SEL
#define ATTN_SEL 3
#endif
#ifdef REPMASK
#define REPMASK_ REPMASK
#else
#define REPMASK_ 0
#endif
    const int per = (1024 + C.G - 1) / C.G;
    bool nomax; { float gq = 0.f, gk = 0.f; for (int i = 0; i < 64; ++i) { gq = fmaxf(gq, fabsf(C.in[I_QNG][l * 64 + i])); gk = fmaxf(gk, fabsf(C.in[I_KNG][l * 64 + i])); } nomax = 64.f * gq * gk * C2 <= 60.f; }
    if (ATTN_SEL & 1) for (int i = 0; i < per * (1 + ((REPMASK_ >> 13) & 1)); ++i) { const int id = C.vcu * per + (i % per); if (id >= 1024) continue; const int bh = id >> 5, b = bh >> 3, h = bh & 7, qb = id & 31;
        const bf16* Qu = QA + (size_t)(b * LB + CTX + qb * 256) * 512 + h * 64;
        if (nomax) attn_body::attn_unit<8, false, 512, 128, true>(Qu, 512, KA + (size_t)(b * LB) * 128 + (h >> 2) * 64, VA + (size_t)(b * LB) * 128 + (h >> 2) * 64, 128, WSP(bf16, WS_AO) + (Qu - QA), LB / 64, 0, 0, shm);
        else attn_body::attn_unit<8, false, 512, 128, false>(Qu, 512, KA + (size_t)(b * LB) * 128 + (h >> 2) * 64, VA + (size_t)(b * LB) * 128 + (h >> 2) * 64, 128, WSP(bf16, WS_AO) + (Qu - QA), LB / 64, 0, 0, shm);
    }
    LAS float* bt = (LAS float*)(C.lds + attn_body::LDS_BT);
    const int nctx = (C.vcu >= 64 && C.vcu < 128) ? 1 : 0;
    if (ATTN_SEL & 2) for (int i0 = 0; i0 < (per + nctx) * (1 + ((REPMASK_ >> 14) & 1)); ++i0) { const int i = i0 % (per + nctx);
        const bf16 *Qu, *Kh, *Vh; bf16* Ou; int kvp = 512, NT = 4, r0 = 0, rlo = 0;
        if (i < per) { const int id = C.vcu * per + i; if (id >= 1024) continue; const int bh = id >> 5, b = bh >> 3, h = bh & 7; r0 = (id & 31) * 4;
            const float* rp = C.in[I_RPB] + (size_t)(l * 8 + h) * 465;
            for (int k = C.tid; k < 465; k += 512) bt[k] = rp[k] * LOG2E;
            rlo = r0 - 4 < 0 ? 0 : (r0 - 4 > 120 ? 120 : r0 - 4); const int rh_ = r0 - 1 < 0 ? 0 : (r0 - 1 > 120 ? 120 : r0 - 1), nloc = rh_ + 8 - rlo; NT = (4 + nloc + 1) & ~1;
            Qu = QN + (size_t)(b * LB + CTX + r0 * 64) * 512 + h * 64; Ou = WSP(bf16, WS_NO) + (Qu - QN); Kh = KN + (size_t)(b * LB) * 512 + h * 64; Vh = VN + (size_t)(b * LB) * 512 + h * 64; }
        else { int j = C.vcu - 64; if (j < 32) { const int b = j >> 3, h = j & 7; Qu = QA + (size_t)(b * LB) * 512 + h * 64; Ou = WSP(bf16, WS_AO) + (Qu - QA); Kh = KA + (size_t)(b * LB) * 128 + (h >> 2) * 64; Vh = VA + (size_t)(b * LB) * 128 + (h >> 2) * 64; kvp = 128; }
            else { j -= 32; const int b = j >> 3, h = j & 7; Qu = QN + (size_t)(b * LB) * 512 + h * 64; Ou = WSP(bf16, WS_NO) + (Qu - QN); Kh = KN + (size_t)(b * LB) * 512 + h * 64; Vh = VN + (size_t)(b * LB) * 512 + h * 64; } }
        attn_body::attn_unit<8, true, 512, 0>(Qu, 512, Kh, Vh, kvp, Ou, NT, r0, rlo, shm);
    }
}

constexpr int NPH = 46;
__global__ void __launch_bounds__(NWAVES * 64, 2) fwd(Args args) {
    extern __shared__ __attribute__((aligned(16))) unsigned char lds[];
    Ctx C; C.in = (const __attribute__((address_space(4))) CFP*)__builtin_amdgcn_kernarg_segment_ptr(); C.out = args.out; C.ws = args.ws; C.lds = (LAS unsigned char*)lds; C.ctl = (gu32*)(args.ws + WS_CTL);
    C.tid = 0; C.lane = 0; C.wave = __builtin_amdgcn_readfirstlane((int)threadIdx.x >> 6);
    C.G = gridDim.x; { const int bx = blockIdx.x; C.vcu = (C.G % 8 == 0) ? (bx % 8) * (C.G / 8) + bx / 8 : bx; }
    for (int u = threadIdx.x; u < (LDS_BYTES - LDSCTL_OFF) / 4; u += NWAVES * 64) ((LAS unsigned*)(C.lds + LDSCTL_OFF))[u] = 0u;
    __syncthreads();
    const int lo = args.ph_lo, hi = args.ph_hi;
    XcdBarrier bar; bar.bar = (unsigned*)(C.ctl + CW_BAR); bar.x = 0; bar.st = nullptr;
    if (hi - lo > 1) bar = xcd_barrier_post((unsigned*)(C.ctl + CW_BAR), (volatile LAS unsigned*)(C.lds + MISC_OFF) + 8);
    LAS int* tab = (LAS int*)(C.lds + LDSCTL_OFF);
    const int cg = (int)blockIdx.x;
#ifndef PHMASK
#define PHMASK 0xFFFF
#endif
#define IN(k) (lo <= (k) && (k) < hi)
#define EN(b) ((PHMASK >> (b)) & 1)
#ifndef REPMASK
#define REPMASK 0
#endif
#define RUN(b, stmt) do { stmt; if ((REPMASK >> (b)) & 1) { stmt; } } while (0)
#ifdef DIAG_SEL
#define DIAG_ACC(ty) do { if (blockIdx.x == 0 && threadIdx.x == 0) { volatile LAS unsigned* dg = (volatile LAS unsigned*)(C.lds + LDSCTL_OFF + 160); const unsigned now = (unsigned)__builtin_amdgcn_s_memrealtime(); dg[8 + (ty)] += now - dg[0]; dg[0] = now; } } while (0)
#else
#define DIAG_ACC(ty) do {} while (0)
#endif
#define SEAM(k) do { if (IN(k) && IN((k) + 1)) xcd_barrier(bar); DIAG_ACC((k) == 0 ? 11 : ((k) - 1) % 11); } while (0)
#define LWS() ({ const __attribute__((address_space(4))) CFP* k_ = C.in; asm volatile("" : "+s"(k_)); (unsigned char*)k_[30]; })
#define LC() ({ Ctx c_ = C; c_.tid = threadIdx.x; asm volatile("" : "+v"(c_.tid)); c_.lane = c_.tid & 63; asm volatile("" : "+s"(c_.in)); c_.ws = (unsigned char*)c_.in[30]; c_.out = (float*)c_.in[29]; c_.ctl = (gu32*)(c_.ws + WS_CTL); c_; })
#ifdef DIAG_SEL
    if (blockIdx.x == 0 && threadIdx.x == 0) { volatile LAS unsigned* dg = (volatile LAS unsigned*)(C.lds + LDSCTL_OFF + 160); dg[0] = (unsigned)__builtin_amdgcn_s_memrealtime(); dg[1] = dg[0]; }
#endif
    if (EN(11) && IN(0)) { const Ctx Cl = LC(); phase_mod(Cl); RUN(11, phase_s5mats(Cl, 0, Cl.vcu); phase_weights(Cl, 0)); }
    SEAM(0);
    for (int l = 0; l < NLAYER; ++l) {
        const int pb = 1 + 11 * l;
        if (EN(0) && IN(pb)) { const Ctx Cl = LC(); if (l == 0) phase_rows<0>(Cl, 0); else { phase_weights(Cl, l); phase_rows<1>(Cl, l); } }
        SEAM(pb);
        if (EN(1) && IN(pb + 1)) { if (W8_ALL) { PWin8 P{LWS(), C.G, cg, 1024, 128u}; pg8::gemm_phase_m128(C.lds, P); } else { { PWin P{LWS(), C.G, cg, 1024, 128u}; pg8::gemm_phase(C.lds, P); } { PGate P{LWS(), C.G, cg, 1024, 128u}; pg8::gemm_phase_m128(C.lds, P); } } }
        SEAM(pb + 1);
        if (EN(2) && IN(pb + 2)) { { const Ctx Cl = LC(); phase_qkprep(Cl, l); } PS5A P{LWS(), C.G, cg, 512, 128u}; RUN(2, pg8::gemm_phase(C.lds, P)); }
        SEAM(pb + 2);
        if (EN(3) && IN(pb + 3)) { const Ctx Cl = LC(); RUN(3, phase_attn(Cl, l, lds)); }
        SEAM(pb + 3);
        if (EN(4) && IN(pb + 4)) { PS5B P{LWS(), C.G, cg, 256, 128u}; pg8::gemm_phase(C.lds, P); }
        SEAM(pb + 4);
        if (EN(5) && IN(pb + 5)) { PGlu P{LWS(), C.G, cg, 512, 128u, l == NLAYER - 1}; pg8::gemm_phase_m128(C.lds, P); }
        SEAM(pb + 5);
        if (EN(6) && IN(pb + 6)) { { PMerge P{LWS(), C.G, cg, 512, 128u, l == NLAYER - 1}; pg8::gemm_phase_m128(C.lds, P); }
            if (l < NLAYER - 1) { const Ctx Cl = LC(); phase_s5mats(Cl, l + 1, C.G >= 160 ? cg - 32 : cg); } }
        SEAM(pb + 6);
        if (EN(7) && IN(pb + 7)) { unsigned char* wl_ = LWS(); PWout P{wl_, (float*)C.in[29], (const float*)(wl_ + WS_MOD) + (size_t)l * 5 * 6144, C.G, cg, 1024, 128u, l == NLAYER - 1}; pg8::gemm_phase_m128(C.lds, P); }
        SEAM(pb + 7);
        if (EN(8) && IN(pb + 8)) { const Ctx Cl = LC(); phase_norm2(Cl, l); }
        SEAM(pb + 8);
        if (EN(9) && IN(pb + 9)) { if (FP8_MOE) { build_exptab(C, tab, l); PMoe1 P{LWS(), tab, C.G, cg, 1024, 128u}; pg8::gemm_phase_m128(C.lds, P); } else { build_exptab(C, tab, l, 8); PMoe1B P{LWS(), tab, C.G, cg, 1024, 128u}; pg8::gemm_phase(C.lds, P); } }
        SEAM(pb + 9);
        if (EN(10) && IN(pb + 10)) { if (FP8_MOE) { build_exptab(C, tab, l); PMoe2 P{LWS(), tab, C.G, cg, 512, 128u}; pg8::gemm_phase_m128(C.lds, P); } else { build_exptab(C, tab, l, 8); PMoe2B P{LWS(), tab, C.G, cg, 512, 128u}; pg8::gemm_phase(C.lds, P); } }
        SEAM(pb + 10);
    }
    if (EN(12) && IN(NPH - 1)) { const Ctx Cl = LC(); phase_rows<2>(Cl, NLAYER); }
#ifdef DIAG_SEL
    xcd_barrier(bar); DIAG_ACC(12);
    if (blockIdx.x == 0 && threadIdx.x == 0) { volatile LAS unsigned* dg = (volatile LAS unsigned*)(C.lds + LDSCTL_OFF + 160); dg[8 + 13] = dg[0] - dg[1];
        for (int i = 0; i < 14; ++i) __hip_atomic_store(C.ctl + 2048 + i, dg[8 + i], RLX_AGENT); }
    xcd_barrier(bar);
    { const float d1 = (float)__hip_atomic_load(C.ctl + 2048 + (DIAG_SEL), RLX_AGENT) * 0.01f, d2 = (float)__hip_atomic_load(C.ctl + 2048 + (DIAG_SEL) + 1, RLX_AGENT) * 0.01f;
      const float c1 = sqrtf(d1); float* o = args.out;
      for (size_t i = (size_t)blockIdx.x * 512 + threadIdx.x; i < (size_t)NB * SEQ * D; i += (size_t)gridDim.x * 512) o[i] = (i == 12345) ? d2 : c1; }
#endif
#undef IN
#undef SEAM
}

#ifndef MK_PER_PHASE
#define MK_PER_PHASE 0
#endif
extern "C" void kernel_launch(void* const* d_in, const int* in_sizes, int n_in, void* d_out, int out_size, void* d_ws, size_t ws_size, hipStream_t stream) {
    static int grid = 0;
    if (grid == 0) {
        if (n_in != 29 || out_size != NB * SEQ * D || ws_size < WS_END) { fprintf(stderr, "kernel_launch: unexpected shapes (n_in %d out %d ws %zu)\n", n_in, out_size, ws_size); grid = -1; return; }
        int dev = 0, cus = 0, per_cu = 0;
        if (hipGetDevice(&dev) != hipSuccess || hipDeviceGetAttribute(&cus, hipDeviceAttributeMultiprocessorCount, dev) != hipSuccess) { grid = -1; return; }
        if (hipFuncSetAttribute((const void*)fwd, hipFuncAttributeMaxDynamicSharedMemorySize, LDS_BYTES) != hipSuccess) { grid = -1; return; }
        if (hipOccupancyMaxActiveBlocksPerMultiprocessor(&per_cu, (const void*)fwd, NWAVES * 64, LDS_BYTES) != hipSuccess || per_cu < 1) fprintf(stderr, "kernel_launch: occupancy query says %d\n", per_cu);
        (void)hipGetLastError();
        grid = cus;
    }
    if (grid < 0) return;
    (void)hipMemsetAsync((char*)d_ws + WS_CTL, 0, CTL_ZERO_BYTES, stream);
    Args a{};
    for (int i = 0; i < 29; ++i) a.in[i] = (const float*)d_in[i];
    a.out = (float*)d_out; a.ws = (unsigned char*)d_ws;
#if MK_PER_PHASE
    for (int p = 0; p < NPH; ++p) { a.ph_lo = p; a.ph_hi = p + 1; hipLaunchKernelGGL(fwd, dim3(grid), dim3(NWAVES * 64), LDS_BYTES, stream, a); }
#else
    a.ph_lo = 0; a.ph_hi = NPH; hipLaunchKernelGGL(fwd, dim3(grid), dim3(NWAVES * 64), LDS_BYTES, stream, a);
#endif
}
```

```cpp
#define FP8_MOE 1
#define GATE_BF16 0
#define W8_ALL 1
#define H8_WRITE 1
#ifndef H8_WRITE
#define H8_WRITE 1
#endif
#ifndef GATE_BF16
#define GATE_BF16 0
#endif
#include <hip/hip_runtime.h>
#include <cstdio>
#include <cstdint>

#define GAS __attribute__((address_space(1)))
#define LAS __attribute__((address_space(3)))
typedef unsigned short bf16;
typedef unsigned v4u __attribute__((ext_vector_type(4)));
typedef unsigned v2u __attribute__((ext_vector_type(2)));
typedef float f32x4 __attribute__((ext_vector_type(4)));
typedef float f32x2 __attribute__((ext_vector_type(2)));
typedef float f32x16 __attribute__((ext_vector_type(16)));
typedef short bf16x8 __attribute__((ext_vector_type(8)));
typedef short s16x4 __attribute__((ext_vector_type(4)));
typedef GAS unsigned gu32;
#define RLX_AGENT __ATOMIC_RELAXED, __HIP_MEMORY_SCOPE_AGENT
#define LDS_WAIT() asm volatile("s_waitcnt lgkmcnt(0)" ::: "memory")
#define VM_WAIT() asm volatile("s_waitcnt vmcnt(0)" ::: "memory")

constexpr int NB = 4, SEQ = 8192, CTX = 256, LB = SEQ + CTX, T = NB * LB, D = 1024, NPAN = T / 256;
constexpr int NLAYER = 4, INW = 5888, NCH = LB / 32, NCR = NB * NCH;
constexpr int NEXP = 16, FF = 512;
constexpr float EPS = 1e-6f;
constexpr float LOG2E = 1.4426950408889634f;
constexpr float C2 = 0.125f * LOG2E;
constexpr int NWAVES = 8;

constexpr size_t MiB = 1u << 20;
constexpr size_t WS_CTL = 0, CTL_ZERO_BYTES = 1 * MiB;
constexpr size_t WS_MOD = 1 * MiB;
constexpr size_t WS_LIST = 2 * MiB;
constexpr size_t WS_RW = 5 * MiB;
constexpr size_t WS_LW = 6 * MiB;
constexpr size_t WS_SST = 10 * MiB;
constexpr size_t WS_HB8 = WS_SST;
constexpr size_t WS_XST = 44 * MiB;
constexpr size_t WS_BT1 = 61 * MiB;
constexpr size_t WS_BT2 = 85 * MiB;
constexpr size_t WS_WIN = 93 * MiB;
constexpr size_t WS_WIN8 = WS_WIN + (size_t)2816 * 1024 * 2;
constexpr size_t WS_WGLU = 105 * MiB;
constexpr size_t WS_WBR = 106 * MiB;
constexpr size_t WS_WOUT = 109 * MiB;
constexpr size_t WS_WOUT2 = 100 * MiB;
constexpr size_t WS_MOE1 = 111 * MiB;
constexpr size_t WS_MOE2 = 143 * MiB;
constexpr size_t WS_HB = 159 * MiB;
constexpr size_t WS_U = 225 * MiB;
constexpr size_t WS_QA = 258 * MiB;
constexpr size_t WS_KA = 291 * MiB;
constexpr size_t WS_VA = 300 * MiB;
constexpr size_t WS_QN = 309 * MiB;
constexpr size_t WS_KN = 342 * MiB;
constexpr size_t WS_VN = 375 * MiB;
constexpr size_t WS_YS = 408 * MiB;
constexpr size_t WS_GATES = 441 * MiB;
constexpr size_t WS_ACT = WS_QN;
constexpr size_t WS_ACTB = WS_QN;
constexpr size_t WS_YSLOT = WS_GATES;
constexpr size_t WS_AO = 574 * MiB;
constexpr size_t WS_NO = 607 * MiB;
constexpr size_t WS_YG = 640 * MiB;
constexpr size_t WS_XS = 673 * MiB;
constexpr size_t WS_END = 739 * MiB;
static_assert(WS_GATES + (size_t)T * 3072 * (GATE_BF16 ? 2 : 1) <= WS_AO && WS_YSLOT + (size_t)2 * T * 1024 * 2 <= WS_AO && WS_ACT + (size_t)(2 * T + 4096) * 512 * 2 <= WS_YS, "ws map");
constexpr int CW_FAIL = 8;
constexpr int CW_CNT = 64;
constexpr int CW_BAR = 8192;

constexpr int RING_BYTES = 131072, LDS_BYTES = 147456, LDSCTL_OFF = LDS_BYTES - 512, MISC_OFF = LDSCTL_OFF + 320;

__device__ __forceinline__ unsigned f2bf(float f) { unsigned u = __builtin_bit_cast(unsigned, f); return (u + 0x7fffu + ((u >> 16) & 1u)) >> 16; }
__device__ __forceinline__ unsigned pk2(float lo, float hi) { return f2bf(lo) | (f2bf(hi) << 16); }
__device__ __forceinline__ float bf2f(unsigned b) { return __builtin_bit_cast(float, b << 16); }
__device__ __forceinline__ float bflo(unsigned w) { return __builtin_bit_cast(float, w << 16); }
__device__ __forceinline__ float bfhi(unsigned w) { return __builtin_bit_cast(float, w & 0xffff0000u); }
typedef float f32x2_c __attribute__((ext_vector_type(2))); typedef __bf16 bf16x2_c __attribute__((ext_vector_type(2)));
__device__ __forceinline__ unsigned cvt_pk_bf16(float lo, float hi) { const f32x2_c v = {lo, hi}; return __builtin_bit_cast(unsigned, __builtin_convertvector(v, bf16x2_c)); }
typedef int v8i __attribute__((ext_vector_type(8)));
typedef int v4i __attribute__((ext_vector_type(4)));
__device__ __forceinline__ float clamp8(float x) { return __builtin_fminf(__builtin_fmaxf(x, -448.f), 448.f); }
__device__ __forceinline__ unsigned pk4_fp8(float a, float b, float c, float d) { int w = 0; w = __builtin_amdgcn_cvt_pk_fp8_f32(clamp8(a), clamp8(b), w, false); w = __builtin_amdgcn_cvt_pk_fp8_f32(clamp8(c), clamp8(d), w, true); return (unsigned)w; }
__device__ __forceinline__ float fsigmoid(float x) { return __builtin_amdgcn_rcpf(1.f + __builtin_amdgcn_exp2f(-LOG2E * x)); }
__device__ __forceinline__ float gelu_tanh(float x) { const float u = 0.7978845608f * (x + 0.044715f * x * x * x); return x * __builtin_amdgcn_rcpf(1.f + __builtin_amdgcn_exp2f(-2.f * LOG2E * u)); }
__device__ __forceinline__ float shflx(float v, int m, int lane) { return __builtin_bit_cast(float, __builtin_amdgcn_ds_bpermute((lane ^ m) << 2, __builtin_bit_cast(int, v))); }
template <int CTRL, int RM>
__device__ __forceinline__ float dpp_mov(float v) { return __builtin_bit_cast(float, __builtin_amdgcn_update_dpp(0, __builtin_bit_cast(int, v), CTRL, RM, 0xF, true)); }
__device__ __forceinline__ float wave_sum(float v, int) {
    v += dpp_mov<0xB1, 0xF>(v);
    v += dpp_mov<0x4E, 0xF>(v);
    v += dpp_mov<0x141, 0xF>(v);
    v += dpp_mov<0x140, 0xF>(v);
    v += dpp_mov<0x142, 0xA>(v);
    v += dpp_mov<0x143, 0xC>(v);
    return __builtin_bit_cast(float, __builtin_amdgcn_readlane(__builtin_bit_cast(int, v), 63));
}
__device__ __forceinline__ float sin_rev(float r) { r = r - floorf(r); return __builtin_amdgcn_sinf(r); }
__device__ __forceinline__ float cos_rev(float r) { r = r - floorf(r); return __builtin_amdgcn_cosf(r); }

#define XB_TMO      128
#define XB_XCNT(j)  (256  + 64 * (j))
#define XB_XSUB(j)  (1280 + 64 * (j))
#define XB_XGEN(j)  (2304 + 64 * (j))
#define XB_TOP      3328
#define XB_TOPGEN   3392
#define XCD_BAR_WORDS 3456
#define XB_SPIN_CAP (1u << 22)

__device__ __forceinline__ unsigned xb_ld(unsigned* p)              { return __hip_atomic_load(p, __ATOMIC_RELAXED, __HIP_MEMORY_SCOPE_AGENT); }
__device__ __forceinline__ unsigned xb_add(unsigned* p, unsigned v) { return __hip_atomic_fetch_add(p, v, __ATOMIC_RELAXED, __HIP_MEMORY_SCOPE_AGENT); }
__device__ __forceinline__ unsigned xb_xcc_id() { return (unsigned)__builtin_amdgcn_s_getreg((3 << 11) | 20) & 0xFu; }
#define XB_SPIN(cond, bar) do { unsigned _sp = 0; while (cond) { __builtin_amdgcn_s_sleep(1); \
    if ((++_sp & 255u) == 0u) { if (xb_ld(&(bar)[XB_TMO])) break; if (_sp > XB_SPIN_CAP) { atomicAdd(&(bar)[XB_TMO], 1u); break; } } } } while (0)

struct XcdBarrier { unsigned* bar; unsigned x; volatile LAS unsigned* st; };

__device__ __forceinline__ XcdBarrier xcd_barrier_post(unsigned* bar, volatile LAS unsigned* st) {
    XcdBarrier b; b.bar = bar; b.x = xb_xcc_id(); b.st = st;
    if (threadIdx.x == 0) (void)xb_add(&bar[XB_XCNT(b.x)], 1u);
    return b;
}
__device__ __forceinline__ void xcd_barrier_complete(unsigned* bar, unsigned x, unsigned& nloc, unsigned& nx) {
    const unsigned G = gridDim.x * gridDim.y * gridDim.z;
    unsigned sum, cnt, mine, sp = 0u;
    for (;;) {
        sum = 0u; cnt = 0u; mine = 0u;
#pragma unroll
        for (unsigned j = 0; j < 16; ++j) { const unsigned c = xb_ld(&bar[XB_XCNT(j)]); sum += c; cnt += (c > 0u) ? 1u : 0u; mine = (j == x) ? c : mine; }
        if (sum == G) break;
        __builtin_amdgcn_s_sleep(1);
        if ((++sp & 255u) == 0u) { if (xb_ld(&bar[XB_TMO])) break; if (sp > XB_SPIN_CAP) { atomicAdd(&bar[XB_TMO], 1u); break; } }
    }
    nloc = mine > 0u ? mine : 1u; nx = cnt > 0u ? cnt : 1u;
}
__device__ __forceinline__ void xcd_barrier(const XcdBarrier& b) {
    asm volatile("s_waitcnt vmcnt(0)" ::: "memory");
    __syncthreads();
    if (threadIdx.x == 0) {
        unsigned* bar = b.bar;
        __builtin_amdgcn_s_waitcnt(0);
        unsigned nloc = b.st[0], nx = b.st[1];
        if (nloc == 0u) { xcd_barrier_complete(bar, b.x, nloc, nx); b.st[0] = nloc; b.st[1] = nx; }
        const unsigned old = xb_add(&bar[XB_XSUB(b.x)], 1u);
        const unsigned gen = old / nloc;
        if (old + 1u == (gen + 1u) * nloc) {
            __builtin_amdgcn_fence(__ATOMIC_RELEASE, "agent");
            asm volatile("s_waitcnt vmcnt(0)" ::: "memory");
            const unsigned og = xb_add(&bar[XB_TOP], 1u);
            const unsigned tg = og / nx;
            if (og + 1u == (tg + 1u) * nx) xb_add(&bar[XB_TOPGEN], 1u);
            else XB_SPIN(xb_ld(&bar[XB_TOPGEN]) == tg, bar);
            __builtin_amdgcn_fence(__ATOMIC_ACQUIRE, "agent");
            xb_add(&bar[XB_XGEN(b.x)], 1u);
            asm volatile("s_waitcnt vmcnt(0)" ::: "memory");
        } else {
            XB_SPIN(xb_ld(&bar[XB_XGEN(b.x)]) == gen, bar);
            __builtin_amdgcn_fence(__ATOMIC_ACQUIRE, "agent");
            asm volatile("s_waitcnt vmcnt(0)" ::: "memory");
        }
    }
    __syncthreads();
}

namespace pg8 {
constexpr int BM = 256, BK = 64, HALF = 128, HTB = HALF * BK * 2, STAGE_BYTES = 8 * HTB, NXCD = 8, WGM = 8;
__host__ __device__ __forceinline__ int lds_byte(int r, int c) { const int st = (r >> 4) * 2 + (c >> 5), rr = r & 15, cc = c & 31, ob = rr * 64 + cc * 2; return st * 1024 + (ob ^ (((ob >> 9) & 1) << 5)); }
__host__ __device__ __forceinline__ void stage_rc(int b, int& R, int& C) { const int st = b / 1024, sb = b % 1024, swz = sb ^ (((sb >> 9) & 1) << 5); R = (st >> 1) * 16 + swz / 64; C = (st & 1) * 32 + (swz % 64) / 2; }
__host__ __device__ __forceinline__ int perm32(int rho) { const int n = rho >> 4, i = rho & 15; return 8 * (i >> 2) + 4 * n + (i & 3); }

struct Unit { int pm, pn, z; };

__device__ __forceinline__ void static_decode(int L, int nM, int nN, int& pm, int& pn) {
    const int nwg = nM * nN; int wgid = L;
    { const int q = nwg / NXCD, r = nwg % NXCD, xcd = wgid % NXCD, off = wgid / NXCD; wgid = (xcd < r ? xcd * (q + 1) : r * (q + 1) + (xcd - r) * q) + off; }
    const int nig = WGM * nN, gid = wgid / nig, fm = gid * WGM, gsz = (nM - fm) < WGM ? (nM - fm) : WGM;
    pm = fm + ((wgid % nig) % gsz); pn = (wgid % nig) / gsz;
}

template <class P>
__device__ __forceinline__ void gemm_phase(LAS unsigned char* lds, const P& S) {
    int tid_ = threadIdx.x; asm volatile("" : "+v"(tid_));
    const int tid = tid_, wid = __builtin_amdgcn_readfirstlane(tid >> 6), lane = tid & 63, wr = wid >> 2, wc = wid & 3, fr = lane & 15, fq = lane >> 4;
    constexpr int ELB = P::FP8 ? 1 : 2;
    const int K = S.K; int nt = K * ELB / 128; asm volatile("" : "+s"(nt));
    unsigned voffB[2];
#pragma unroll
    for (int i = 0; i < 2; ++i) { int R, C; stage_rc(tid * 16 + i * 8192, R, C); const int Rb = (R & ~31) + perm32(R & 31); voffB[i] = (unsigned)(Rb * K * ELB + C * 2); }
#define PG8_AOFF(dst0, dst1, u) do { _Pragma("unroll") for (int i = 0; i < 2; ++i) { int R, C; stage_rc(tid * 16 + i * 8192, R, C); dst0[i] = S.a_off(u, 0, R, C); dst1[i] = S.a_off(u, 1, R, C); } } while (0)
    const size_t kstepB = (size_t)(BK * 2), hstepB = (size_t)HALF * K * ELB, kstepA = (size_t)S.kstepA;
    const unsigned ldsw = (unsigned)wid * 1024u;
    const int aoff = lds_byte(wr * 64 + fr, fq * 8), boff = lds_byte(wc * 32 + fr, fq * 8);
#define PG8_SA(b, h) (((b) * 2 + (h)) * HTB)
#define PG8_SB(b, h) ((4 + (b) * 2 + (h)) * HTB)
#define PG8_STAGE(bufoff, gbase, voff) do { _Pragma("unroll") for (int _i = 0; _i < 2; ++_i) \
        __builtin_amdgcn_global_load_lds((const unsigned*)((const char*)(gbase) + (voff)[_i]), (LAS unsigned*)(lds + (bufoff) + ldsw + _i * 8192), 16, 0, 0); } while (0)
#define PG8_LDA(dst, b, h) do { _Pragma("unroll") for (int m = 0; m < 4; ++m) _Pragma("unroll") for (int k = 0; k < 2; ++k) dst[m][k] = *(const LAS bf16x8*)(lds + PG8_SA(b, h) + aoff + m * 2048 + k * 1024); } while (0)
#define PG8_LDB(dst, b, h) do { _Pragma("unroll") for (int n = 0; n < 2; ++n) _Pragma("unroll") for (int k = 0; k < 2; ++k) dst[n][k] = *(const LAS bf16x8*)(lds + PG8_SB(b, h) + boff + n * 2048 + k * 1024); } while (0)
#define PG8_CAT(x0, x1) __builtin_shufflevector(__builtin_bit_cast(v4i, x0), __builtin_bit_cast(v4i, x1), 0, 1, 2, 3, 4, 5, 6, 7)
#define PG8_MMA(ai, bj, At, Bt) do { __builtin_amdgcn_s_setprio(1); _Pragma("unroll") for (int m = 0; m < 4; ++m) _Pragma("unroll") for (int n = 0; n < 2; ++n) { \
        if constexpr (P::FP8) acc[ai][bj][m][n] = __builtin_amdgcn_mfma_scale_f32_16x16x128_f8f6f4(PG8_CAT(Bt[n][0], Bt[n][1]), PG8_CAT(At[m][0], At[m][1]), acc[ai][bj][m][n], 0, 0, 0, 0x7f7f7f7f, 0, 0x7f7f7f7f); \
        else { _Pragma("unroll") for (int k = 0; k < 2; ++k) acc[ai][bj][m][n] = __builtin_amdgcn_mfma_f32_16x16x32_bf16(Bt[n][k], At[m][k], acc[ai][bj][m][n], 0, 0, 0); } } __builtin_amdgcn_s_setprio(0); } while (0)
#define PG8_WAIT_V(n) asm volatile("s_waitcnt vmcnt(" #n ")" ::: "memory")
#define PG8_WAIT_L(n) asm volatile("s_waitcnt lgkmcnt(" #n ")" ::: "memory")
#define PG8_BAR __builtin_amdgcn_s_barrier()
#define PG8_SCHED __builtin_amdgcn_sched_barrier(0)
    Unit cur, nxt; int ui = 0;
    if (!S.next(0, cur)) return;
    f32x4 acc[2][2][4][2];
#pragma unroll
    for (int a = 0; a < 2; ++a)
#pragma unroll
        for (int b = 0; b < 2; ++b)
#pragma unroll
            for (int m = 0; m < 4; ++m)
#pragma unroll
                for (int n = 0; n < 2; ++n) acc[a][b][m][n] = (f32x4){0.f, 0.f, 0.f, 0.f};
    bf16x8 At[4][2], B0[2][2], B1[2][2];
    unsigned vA0[2], vA1[2], vN0[2], vN1[2];
    PG8_AOFF(vA0, vA1, cur);
    const char* cA = S.a_base(cur); const char* cB = S.b_base(cur);
    PG8_STAGE(PG8_SB(0, 0), cB, voffB); PG8_STAGE(PG8_SB(0, 1), cB + hstepB, voffB); PG8_STAGE(PG8_SA(0, 0), cA, vA0); PG8_STAGE(PG8_SA(0, 1), cA, vA1);
    if (wr == 1) PG8_BAR;
    PG8_WAIT_V(2); PG8_BAR;
    PG8_STAGE(PG8_SB(1, 0), cB + kstepB, voffB); PG8_STAGE(PG8_SA(1, 0), cA + kstepA, vA0); PG8_STAGE(PG8_SB(1, 1), cB + hstepB + kstepB, voffB);
    PG8_WAIT_V(6); PG8_BAR;
    for (;;) {
        const bool has_next = S.next(ui + 1, nxt);
        const char* nA = cA; const char* nB = cB;
        if (has_next) { nA = S.a_base(nxt); nB = S.b_base(nxt); if (P::EARLY_AOFF) PG8_AOFF(vN0, vN1, nxt); }
        for (int t = 0; t < nt; t += 2) {
            const bool last = (t == nt - 2);
            const char* a1 = cA + (size_t)(t + 1) * kstepA;
            const char* a2 = last ? nA : cA + (size_t)(t + 2) * kstepA; const char* b2 = last ? nB : cB + (size_t)(t + 2) * kstepB;
            const char* a3 = a2 + kstepA; const char* b3 = b2 + kstepB;
            PG8_LDB(B0, 0, 0); PG8_LDB(B1, 0, 1); PG8_SCHED; PG8_LDA(At, 0, 0); PG8_STAGE(PG8_SA(1, 1), a1, vA1);
            if (last && has_next) {
                if (P::EARLY_AOFF) { _Pragma("unroll") for (int i = 0; i < 2; ++i) { vA0[i] = vN0[i]; vA1[i] = vN1[i]; } } else PG8_AOFF(vA0, vA1, nxt); }
            PG8_WAIT_V(8); PG8_WAIT_L(0); PG8_BAR; PG8_MMA(0, 0, At, B0); PG8_MMA(0, 1, At, B1); PG8_BAR; PG8_SCHED;
            PG8_LDA(At, 0, 1); PG8_STAGE(PG8_SB(0, 0), b2, voffB); PG8_STAGE(PG8_SB(0, 1), b2 + hstepB, voffB); PG8_STAGE(PG8_SA(0, 0), a2, vA0);
            PG8_WAIT_V(8); PG8_WAIT_L(0); PG8_BAR; PG8_MMA(1, 0, At, B0); PG8_MMA(1, 1, At, B1); PG8_BAR; PG8_SCHED;
            PG8_LDB(B0, 1, 0); PG8_LDB(B1, 1, 1); PG8_SCHED; PG8_LDA(At, 1, 0); PG8_STAGE(PG8_SA(0, 1), a2, vA1);
            PG8_WAIT_V(8); PG8_WAIT_L(0); PG8_BAR; PG8_MMA(0, 0, At, B0); PG8_MMA(0, 1, At, B1); PG8_BAR; PG8_SCHED;
            PG8_LDA(At, 1, 1); PG8_STAGE(PG8_SB(1, 0), b3, voffB); PG8_STAGE(PG8_SB(1, 1), b3 + hstepB, voffB); PG8_STAGE(PG8_SA(1, 0), a3, vA0);
            PG8_WAIT_V(8); PG8_WAIT_L(0); PG8_BAR; PG8_MMA(1, 0, At, B0); PG8_MMA(1, 1, At, B1); PG8_BAR; PG8_SCHED;
        }
        if (wr == 0) PG8_BAR;
        S.epi(acc, cur, wr, wc, fr, fq);
        if (!has_next) break;
#pragma unroll
        for (int a = 0; a < 2; ++a)
#pragma unroll
            for (int b = 0; b < 2; ++b)
#pragma unroll
                for (int m = 0; m < 4; ++m)
#pragma unroll
                    for (int n = 0; n < 2; ++n) acc[a][b][m][n] = (f32x4){0.f, 0.f, 0.f, 0.f};
        cur = nxt; cA = nA; cB = nB; ++ui;
        if (wr == 1) PG8_BAR;
    }
    PG8_WAIT_V(0);
    PG8_BAR;
#undef PG8_AOFF
#undef PG8_SA
#undef PG8_SB
#undef PG8_STAGE
#undef PG8_LDA
#undef PG8_LDB
#undef PG8_MMA
#undef PG8_CAT
#undef PG8_WAIT_V
#undef PG8_WAIT_L
#undef PG8_BAR
#undef PG8_SCHED
}

template <class P>
__device__ __forceinline__ void gemm_phase_m128(LAS unsigned char* lds, const P& S) {
    int tid_ = threadIdx.x; asm volatile("" : "+v"(tid_));
    const int tid = tid_, wid = __builtin_amdgcn_readfirstlane(tid >> 6), lane = tid & 63, wr = wid >> 2, wc = wid & 3, fr = lane & 15, fq = lane >> 4;
    constexpr int ELB = P::FP8 ? 1 : 2;
    const int K = S.K; int nt = K * ELB / 128; asm volatile("" : "+s"(nt));
    unsigned voffB[2];
#pragma unroll
    for (int i = 0; i < 2; ++i) { int R, C; stage_rc(tid * 16 + i * 8192, R, C); const int Rb = (R & ~31) + perm32(R & 31); voffB[i] = (unsigned)(Rb * K * ELB + C * 2); }
#define PG8_AOFF(dst0, u) do { _Pragma("unroll") for (int i = 0; i < 2; ++i) { int R, C; stage_rc(tid * 16 + i * 8192, R, C); dst0[i] = S.a_off(u, R, C); } } while (0)
    const size_t kstepB = (size_t)(BK * 2), hstepB = (size_t)HALF * K * ELB, kstepA = (size_t)S.kstepA;
    const unsigned ldsw = (unsigned)wid * 1024u;
    const int aoff = lds_byte(wr * 64 + fr, fq * 8), boff = lds_byte(wc * 32 + fr, fq * 8);
#define PG8_SA(b) (((b) * 2) * HTB)
#define PG8_SB(b, h) ((4 + (b) * 2 + (h)) * HTB)
#define PG8_STAGE(bufoff, gbase, voff) do { _Pragma("unroll") for (int _i = 0; _i < 2; ++_i) \
        __builtin_amdgcn_global_load_lds((const unsigned*)((const char*)(gbase) + (voff)[_i]), (LAS unsigned*)(lds + (bufoff) + ldsw + _i * 8192), 16, 0, 0); } while (0)
#define PG8_LDA(dst, b) do { _Pragma("unroll") for (int m = 0; m < 4; ++m) _Pragma("unroll") for (int k = 0; k < 2; ++k) dst[m][k] = *(const LAS bf16x8*)(lds + PG8_SA(b) + aoff + m * 2048 + k * 1024); } while (0)
#define PG8_LDB(dst, b, h) do { _Pragma("unroll") for (int n = 0; n < 2; ++n) _Pragma("unroll") for (int k = 0; k < 2; ++k) dst[n][k] = *(const LAS bf16x8*)(lds + PG8_SB(b, h) + boff + n * 2048 + k * 1024); } while (0)
#define PG8_CAT(x0, x1) __builtin_shufflevector(__builtin_bit_cast(v4i, x0), __builtin_bit_cast(v4i, x1), 0, 1, 2, 3, 4, 5, 6, 7)
#define PG8_MMA(bj, At, Bt) do { __builtin_amdgcn_s_setprio(1); _Pragma("unroll") for (int m = 0; m < 4; ++m) _Pragma("unroll") for (int n = 0; n < 2; ++n) { \
        if constexpr (P::FP8) acc[bj][m][n] = __builtin_amdgcn_mfma_scale_f32_16x16x128_f8f6f4(PG8_CAT(Bt[n][0], Bt[n][1]), PG8_CAT(At[m][0], At[m][1]), acc[bj][m][n], 0, 0, 0, 0x7f7f7f7f, 0, 0x7f7f7f7f); \
        else { _Pragma("unroll") for (int k = 0; k < 2; ++k) acc[bj][m][n] = __builtin_amdgcn_mfma_f32_16x16x32_bf16(Bt[n][k], At[m][k], acc[bj][m][n], 0, 0, 0); } } __builtin_amdgcn_s_setprio(0); } while (0)
#define PG8_WAIT_V(n) asm volatile("s_waitcnt vmcnt(" #n ")" ::: "memory")
#define PG8_WAIT_L(n) asm volatile("s_waitcnt lgkmcnt(" #n ")" ::: "memory")
#define PG8_BAR __builtin_amdgcn_s_barrier()
#define PG8_SCHED __builtin_amdgcn_sched_barrier(0)
    Unit cur, nxt; int ui = 0;
    if (!S.next(0, cur)) return;
    f32x4 acc[2][4][2], st[2][4][2];
#pragma unroll
    for (int a = 0; a < 2; ++a)
#pragma unroll
        for (int m = 0; m < 4; ++m)
#pragma unroll
            for (int n = 0; n < 2; ++n) { acc[a][m][n] = (f32x4){0.f, 0.f, 0.f, 0.f}; st[a][m][n] = (f32x4){0.f, 0.f, 0.f, 0.f}; }
    bf16x8 At[4][2], B0[2][2];
    unsigned vA[2], vN[2];
    PG8_AOFF(vA, cur);
    const char* cA = S.a_base(cur); const char* cB = S.b_base(cur);
    PG8_STAGE(PG8_SB(0, 0), cB, voffB); PG8_STAGE(PG8_SA(0), cA, vA); PG8_STAGE(PG8_SB(0, 1), cB + hstepB, voffB);
    if (wr == 1) PG8_BAR;
    PG8_WAIT_V(2); PG8_BAR;
    PG8_STAGE(PG8_SB(1, 0), cB + kstepB, voffB); PG8_STAGE(PG8_SA(1), cA + kstepA, vA);
    PG8_WAIT_V(4); PG8_BAR;
    for (;;) {
        const bool has_next = S.next(ui + 1, nxt);
        const char* nA = cA; const char* nB = cB;
        if (has_next) { nA = S.a_base(nxt); nB = S.b_base(nxt); if (P::EARLY_AOFF) PG8_AOFF(vN, nxt); }
        for (int t = 0; t < nt; t += 2) {
            const bool last = (t == nt - 2);
            const char* b1 = cB + (size_t)(t + 1) * kstepB;
            const char* a2 = last ? nA : cA + (size_t)(t + 2) * kstepA; const char* b2 = last ? nB : cB + (size_t)(t + 2) * kstepB;
            const char* a3 = a2 + kstepA; const char* b3 = b2 + kstepB;
            PG8_LDB(B0, 0, 0); PG8_SCHED; PG8_LDA(At, 0); PG8_STAGE(PG8_SB(1, 1), b1 + hstepB, voffB);
            if (last && has_next) { if (P::EARLY_AOFF) { vA[0] = vN[0]; vA[1] = vN[1]; } else PG8_AOFF(vA, nxt); }
            PG8_WAIT_V(6); PG8_WAIT_L(0); PG8_BAR; PG8_MMA(0, At, B0); PG8_BAR; PG8_SCHED;
            PG8_LDB(B0, 0, 1); PG8_STAGE(PG8_SB(0, 0), b2, voffB); PG8_STAGE(PG8_SA(0), a2, vA);
            PG8_WAIT_V(6); PG8_WAIT_L(0); PG8_BAR; PG8_MMA(1, At, B0); PG8_BAR; PG8_SCHED;
            PG8_LDB(B0, 1, 0); PG8_SCHED; PG8_LDA(At, 1); PG8_STAGE(PG8_SB(0, 1), b2 + hstepB, voffB);
            PG8_WAIT_V(6); PG8_WAIT_L(0); PG8_BAR; PG8_MMA(0, At, B0); PG8_BAR; PG8_SCHED;
            PG8_LDB(B0, 1, 1); PG8_STAGE(PG8_SB(1, 0), b3, voffB); PG8_STAGE(PG8_SA(1), a3, vA);
            PG8_WAIT_V(6); PG8_WAIT_L(0); PG8_BAR; PG8_MMA(1, At, B0); PG8_BAR; PG8_SCHED;
        }
        if (wr == 0) PG8_BAR;
        S.epi(acc, st, cur, wr, wc, fr, fq);
        if (!has_next) break;
#pragma unroll
        for (int a = 0; a < 2; ++a)
#pragma unroll
            for (int m = 0; m < 4; ++m)
#pragma unroll
                for (int n = 0; n < 2; ++n) acc[a][m][n] = (f32x4){0.f, 0.f, 0.f, 0.f};
        cur = nxt; cA = nA; cB = nB; ++ui;
        if (wr == 1) PG8_BAR;
    }
    PG8_WAIT_V(0);
    PG8_BAR;
#undef PG8_AOFF
#undef PG8_SA
#undef PG8_SB
#undef PG8_STAGE
#undef PG8_LDA
#undef PG8_LDB
#undef PG8_MMA
#undef PG8_CAT
#undef PG8_WAIT_V
#undef PG8_WAIT_L
#undef PG8_BAR
#undef PG8_SCHED
}
}
namespace attn_body {
using bf16x8 = __attribute__((ext_vector_type(8))) short;
using u32x4 = __attribute__((ext_vector_type(4))) unsigned;
constexpr int NW = 8, QBLK = 32, QB = QBLK * NW, KVBLK = 64;
__device__ __forceinline__ int crow(int r, int hi) { return (r & 3) + 8 * (r >> 2) + 4 * hi; }
#define SBAR() __builtin_amdgcn_sched_barrier(0)
constexpr int NSLOT = 3, SLOTB = 8192;
constexpr int LDS_K = 0, LDS_V = NSLOT * SLOTB, LDS_WS = 2 * NSLOT * SLOTB, LDS_OST = LDS_WS + NW * 64 * 4, LDS_BYTES = LDS_OST + NW * 4096;
constexpr int LDS_BT = 86016 + 256;
__device__ __forceinline__ void glds16(const void* gsrc, unsigned lds_dst) { unsigned keep;
  asm volatile("s_mov_b32 %0, m0\n\ts_mov_b32 m0, %2\n\ts_nop 0\n\tglobal_load_lds_dwordx4 %1, off\n\ts_mov_b32 m0, %0" : "=&s"(keep) : "v"(gsrc), "s"(lds_dst) : "memory"); }
__device__ __forceinline__ float max3f(float a, float b, float c) { float r; asm("v_max3_f32 %0, %1, %2, %3" : "=v"(r) : "v"(a), "v"(b), "v"(c)); return r; }
__device__ __forceinline__ float max2f(float a, float b) { float r; asm("v_max_f32_e32 %0, %1, %2" : "=v"(r) : "v"(a), "v"(b)); return r; }
__device__ __forceinline__ float fadd_s(float a, float b) { float r; asm("v_add_f32_e32 %0, %1, %2" : "=v"(r) : "v"(a), "v"(b)); return r; }
__device__ __forceinline__ float fsub_s(float a, float b) { float r; asm("v_sub_f32_e32 %0, %1, %2" : "=v"(r) : "v"(a), "v"(b)); return r; }
typedef float f32x2_t __attribute__((ext_vector_type(2))); typedef __bf16 bf16x2_t __attribute__((ext_vector_type(2)));
__device__ __forceinline__ unsigned cvtpk_s(float lo, float hi) { f32x2_t v = {lo, hi}; bf16x2_t b = __builtin_convertvector(v, bf16x2_t); return __builtin_bit_cast(unsigned, b); }
#define WAIT_BAR(N) asm volatile("s_waitcnt vmcnt(" #N ") lgkmcnt(0)\n\ts_barrier" ::: "memory")

__device__ __forceinline__ void qkt(f32x16& p0, f32x16& p1, const char* Kslot, const bf16x8* qr, const f32x16& negm, int r32, int hi) {
  const char* kb = Kslot + hi * 1024 + r32 * 16;
  #pragma unroll
  for (int d0 = 0; d0 < 4; ++d0) {
    const bf16x8 b0 = *reinterpret_cast<const bf16x8*>(kb + d0 * 2048);
    const bf16x8 b1 = *reinterpret_cast<const bf16x8*>(kb + d0 * 2048 + 512);
    if (d0 == 0) { p0 = __builtin_amdgcn_mfma_f32_32x32x16_bf16(b0, qr[0], negm, 0, 0, 0); p1 = __builtin_amdgcn_mfma_f32_32x32x16_bf16(b1, qr[0], negm, 0, 0, 0); }
    else { p0 = __builtin_amdgcn_mfma_f32_32x32x16_bf16(b0, qr[d0], p0, 0, 0, 0); p1 = __builtin_amdgcn_mfma_f32_32x32x16_bf16(b1, qr[d0], p1, 0, 0, 0); } }
}
typedef __attribute__((address_space(3))) const char* lds_cptr;
typedef short v4i16_t __attribute__((ext_vector_type(4)));
__device__ __forceinline__ void kload8(bf16x8* kf, lds_cptr kp) {
  kf[0] = *(const __attribute__((address_space(3))) bf16x8*)(kp);        kf[1] = *(const __attribute__((address_space(3))) bf16x8*)(kp + 512);
  kf[2] = *(const __attribute__((address_space(3))) bf16x8*)(kp + 2048); kf[3] = *(const __attribute__((address_space(3))) bf16x8*)(kp + 2560);
  kf[4] = *(const __attribute__((address_space(3))) bf16x8*)(kp + 4096); kf[5] = *(const __attribute__((address_space(3))) bf16x8*)(kp + 4608);
  kf[6] = *(const __attribute__((address_space(3))) bf16x8*)(kp + 6144); kf[7] = *(const __attribute__((address_space(3))) bf16x8*)(kp + 6656);
}
__device__ __forceinline__ void kload2(bf16x8* kf, lds_cptr kp, int j) { kf[2 * j] = *(const __attribute__((address_space(3))) bf16x8*)(kp + j * 2048); kf[2 * j + 1] = *(const __attribute__((address_space(3))) bf16x8*)(kp + j * 2048 + 512); }
__device__ __forceinline__ s16x4 vtr(lds_cptr p) { return __builtin_bit_cast(s16x4, __builtin_amdgcn_ds_read_tr16_b64_v4i16((__attribute__((address_space(3))) v4i16_t*)p)); }
__device__ __forceinline__ float rowmax(const f32x16& p0, const f32x16& p1) {
  float a = max3f(p0[0], p0[1], p1[0]), b = max3f(p0[2], p0[3], p1[1]); a = max3f(a, p1[2], p1[3]);
  #pragma unroll
  for (int r = 4; r < 16; r += 4) { a = max3f(a, p0[r], p0[r + 1]); b = max3f(b, p0[r + 2], p0[r + 3]); a = max3f(a, p1[r], p1[r + 1]); b = max3f(b, p1[r + 2], p1[r + 3]); }
  const float m = max2f(a, b);
  auto rr = __builtin_amdgcn_permlane32_swap(__float_as_uint(m), __float_as_uint(m), false, false);
  return max2f(__uint_as_float(rr[0]), __uint_as_float(rr[1]));
}
__device__ __forceinline__ void pv(f32x16* o, int vb, bf16x8 pa0, bf16x8 pa1, bf16x8 pa2, bf16x8 pa3) {
  #pragma unroll
  for (int d0 = 0; d0 < 2; ++d0) { s16x4 lo[4], hi[4];
    #pragma unroll
    for (int ks = 0; ks < 4; ++ks) {
      asm volatile("ds_read_b64_tr_b16 %0,%1 offset:%c2" : "=&v"(lo[ks]) : "v"(vb), "i"(d0 * 4096 + ks * 1024) : "memory");
      asm volatile("ds_read_b64_tr_b16 %0,%1 offset:%c2" : "=&v"(hi[ks]) : "v"(vb), "i"(d0 * 4096 + ks * 1024 + 512) : "memory"); }
    asm volatile("s_waitcnt lgkmcnt(0)" ::: "memory"); SBAR();
    #define PK(k) (bf16x8){lo[k][0], lo[k][1], lo[k][2], lo[k][3], hi[k][0], hi[k][1], hi[k][2], hi[k][3]}
    o[d0] = __builtin_amdgcn_mfma_f32_32x32x16_bf16(pa0, PK(0), o[d0], 0, 0, 0);
    o[d0] = __builtin_amdgcn_mfma_f32_32x32x16_bf16(pa1, PK(1), o[d0], 0, 0, 0);
    o[d0] = __builtin_amdgcn_mfma_f32_32x32x16_bf16(pa2, PK(2), o[d0], 0, 0, 0);
    o[d0] = __builtin_amdgcn_mfma_f32_32x32x16_bf16(pa3, PK(3), o[d0], 0, 0, 0);
    #undef PK
  }
}
#define ATTN_STORE16(p, v) (*(u32x4*)(p) = (v))

template <int THRL, bool NA, int QP_, int KVP_, bool NOMAX = false>
__device__ __forceinline__ void attn_unit(const bf16* Qu, int qp_rt, const bf16* __restrict__ Kh, const bf16* __restrict__ Vh, int kvp_rt, bf16* Ou, int NT, int r0, int rlo, char* shm) {
  const int qp = QP_ ? QP_ : qp_rt, kvp = KVP_ ? KVP_ : kvp_rt, op = qp;
  int tid_ = threadIdx.x; asm volatile("" : "+v"(tid_));
  const int tid = tid_, lane = tid & 63, r32 = lane & 31, hi = lane >> 5; const int wid = __builtin_amdgcn_readfirstlane(tid >> 6);
  const bf16* Qw = Qu + (long)(wid * QBLK) * qp;
  const unsigned lds0 = (unsigned)(uintptr_t)shm;
  float* wsf = (float*)(shm + LDS_WS) + wid * 64;
  const bf16* ksrc = Kh + (long)lane * kvp + wid * 8;
  const bf16* vsrc = Vh + (long)(16 * (wid & 3) + (lane >> 2)) * kvp + (wid >> 2) * 32 + (lane & 3) * 8;
  const unsigned kdst = lds0 + LDS_K + wid * 1024, vdst = lds0 + LDS_V + wid * 1024;
  #define TROW(t) (NA ? ((t) < 4 ? 64 * (t) : CTX + 64 * ((rlo + (t) - 4) < 127 ? (rlo + (t) - 4) : 127)) : 64 * (t))
  #define DMA_K(t, slot) glds16(ksrc + (long)TROW(t) * kvp, (unsigned)__builtin_amdgcn_readfirstlane(kdst + (slot)))
  #define DMA_V(t, slot) glds16(vsrc + (long)TROW(t) * kvp, (unsigned)__builtin_amdgcn_readfirstlane(vdst + (slot)))
  const int vb0 = (int)(lds0 + LDS_V) + ((lane >> 4) & 1) * 32 + (lane & 3) * 8 + (4 * hi + ((lane & 15) >> 2)) * 64;
  const char* Kbase = shm + LDS_K; bf16x8 kf[8];
  const lds_cptr shm3 = (lds_cptr)shm; const lds_cptr kp0 = shm3 + LDS_K + hi * 1024 + r32 * 16; const lds_cptr vp0 = shm3 + LDS_V + ((lane >> 4) & 1) * 32 + (lane & 3) * 8 + (4 * hi + ((lane & 15) >> 2)) * 64;
  const int rq = r0 + (wid >> 1), qc = 32 * (wid & 1) + r32;
  const int rsw = rq - 4 < 0 ? 0 : (rq - 4 > 120 ? 120 : rq - 4);
  const int cs = qc - 8 < 0 ? 0 : (qc - 8 > 48 ? 48 : qc - 8);
  const __attribute__((address_space(3))) float* btl = (const __attribute__((address_space(3))) float*)(shm3 + LDS_BT) + (15 + 4 * hi - qc);
  DMA_K(0, 0); DMA_V(0, 0); DMA_K(1, SLOTB);
  bf16x8 qr[4];
  #pragma unroll
  for (int d0 = 0; d0 < 4; ++d0) qr[d0] = *reinterpret_cast<const bf16x8*>(&Qw[(long)r32 * qp + d0 * 16 + hi * 8]);
  float mhat = 0.f, l_reg = 0.f; f32x16 o[2]; o[0] = f32x16{}; o[1] = f32x16{}; f32x16 negm = f32x16{}; if (!NA) asm volatile("" : "+v"(negm));
  #define NEGM (NA ? f32x16{} : negm)
  #define CMASK(P0, P1, t) do { if (NA) { if ((t) >= 4) { const int kr_ = rlo + (t) - 4; const int dr_ = kr_ - rsw; \
      if (dr_ < 0 || dr_ >= 8) { _Pragma("unroll") for (int r = 0; r < 16; ++r) { P0[r] = (-__builtin_inff()); P1[r] = (-__builtin_inff()); } } \
      else { const __attribute__((address_space(3))) float* bp_ = btl + (kr_ - rq + 7) * 31; const int kl0_ = 4 * hi - cs; \
        _Pragma("unroll") for (int rg = 0; rg < 4; ++rg) { \
          _Pragma("unroll") for (int rr_ = 0; rr_ < 4; ++rr_) { const int r = rg * 4 + rr_; const int kc_ = (r & 3) + 8 * (r >> 2); const float b0_ = bp_[kc_], b1_ = bp_[kc_ + 32]; \
            const int kl_ = kc_ + kl0_; P0[r] = ((unsigned)kl_ < 16u) ? P0[r] + b0_ : (-__builtin_inff()); P1[r] = ((unsigned)(kl_ + 32) < 16u) ? P1[r] + b1_ : (-__builtin_inff()); } \
          SBAR(); } } } } } while (0)
  bool resc = false;
  #define START(P0, P1) do { const float rm = NOMAX ? 0.f : rowmax(P0, P1); resc = false; \
    { const float dl = rm; mhat = fadd_s(mhat, dl); \
      _Pragma("unroll") for (int r = 0; r < 16; ++r) { P0[r] = fsub_s(P0[r], dl); P1[r] = fsub_s(P1[r], dl); } \
      if (!NA) { _Pragma("unroll") for (int r = 0; r < 16; ++r) negm[r] = -mhat; asm volatile("" : "+v"(negm)); } } \
    _Pragma("unroll") for (int r = 0; r < 16; ++r) P0[r] = __builtin_amdgcn_exp2f(P0[r]); } while (0)
  #define RESC() do { if (resc) { asm volatile("s_waitcnt lgkmcnt(0)" ::: "memory"); \
      _Pragma("unroll") for (int d_ = 0; d_ < 2; ++d_) _Pragma("unroll") for (int r = 0; r < 16; ++r) o[d_][r] *= wsf[crow(r, hi)]; } } while (0)
  f32x16 pA0, pA1, pB0, pB1;
  int sl_prev = 0, sl_cur = 0, sl_next = SLOTB;
  #define ROT() do { sl_prev = sl_cur; sl_cur = sl_next; sl_next = (sl_next == (NSLOT - 1) * SLOTB) ? 0 : sl_next + SLOTB; } while (0)
  DMA_K(2, 2 * SLOTB);
  WAIT_BAR(3);
  qkt(pA0, pA1, Kbase, qr, NEGM, r32, hi); asm volatile("s_nop 15\n\ts_nop 7" : "+v"(pA0), "+v"(pA1));
  START(pA0, pA1);
  _Pragma("unroll") for (int r = 0; r < 16; ++r) pA1[r] = __builtin_amdgcn_exp2f(pA1[r]);
  WAIT_BAR(0);
  DMA_K(3, 0); DMA_V(1, SLOTB);
  ROT();
  kload8(kf, kp0 + sl_cur);
  WAIT_BAR(2);
  s16x4 vlo[8], vhi[8]; u32x4 pw0, pw1, pw2, pw3;
  #define PKW(P, B) cvtpk_s(P[B], P[B + 1])
  #define PAF(k) __builtin_bit_cast(bf16x8, pw##k)
  #define VFR(i) (bf16x8){vlo[i][0], vlo[i][1], vlo[i][2], vlo[i][3], vhi[i][0], vhi[i][1], vhi[i][2], vhi[i][3]}
  #define PIN(x) asm volatile("" : "+v"(x))
  #define MX3(a, b, c) __builtin_fmaxf(__builtin_fmaxf((a), (b)), (c))
  #define GAPA(MF, A0, A1, A2, A3, W0, W1, PW) do { MF; sacc2 += (f32x2_t){A0, A1}; sacc2 += (f32x2_t){A2, A3}; PIN(sacc2); W0; W1; PIN(PW); SBAR(); } while (0)
  #define EX(v) __builtin_amdgcn_exp2f(v)
  #define GAPB(MF, X, B) do { MF; X[B] = EX(X[B]); X[B + 1] = EX(X[B + 1]); X[B + 2] = EX(X[B + 2]); X[B + 3] = EX(X[B + 3]); PIN(X); SBAR(); } while (0)
  #define VRD(i) do { vlo[i] = vtr(vp_ + (((i) >> 2) * 4096 + ((i) & 3) * 1024)); vhi[i] = vtr(vp_ + (((i) >> 2) * 4096 + ((i) & 3) * 1024 + 512)); } while (0)
  #define KRD(G, j) do { if (G) { kload2(kf, kp0 + sl_next, j); SBAR(); } } while (0)
  #define STEP(C0, C1, P0, P1, t, GK, GV, GL) do { SBAR(); \
    const lds_cptr vp_ = vp0 + sl_prev; \
    VRD(0); SBAR(); f32x2_t sacc2 = (f32x2_t){P0[0], P0[1]}; \
    GAPA(C0 = __builtin_amdgcn_mfma_f32_32x32x16_bf16(kf[0], qr[0], NEGM, 0, 0, 0), P0[2], P0[3], P0[4], P0[5],     pw0[0] = PKW(P0, 0), pw0[1] = PKW(P0, 2), pw0); \
    VRD(4); SBAR(); GAPA(C1 = __builtin_amdgcn_mfma_f32_32x32x16_bf16(kf[1], qr[0], NEGM, 0, 0, 0), P0[6], P0[7], P0[8], P0[9],     pw0[2] = PKW(P0, 4), pw0[3] = PKW(P0, 6), pw0); \
    VRD(1); SBAR(); GAPA(C0 = __builtin_amdgcn_mfma_f32_32x32x16_bf16(kf[2], qr[1], C0, 0, 0, 0),   P0[10], P0[11], P0[12], P0[13], pw1[0] = PKW(P0, 8), pw1[1] = PKW(P0, 10), pw1); \
    VRD(5); SBAR(); GAPA(C1 = __builtin_amdgcn_mfma_f32_32x32x16_bf16(kf[3], qr[1], C1, 0, 0, 0),   P0[14], P0[15], P1[0], P1[1],   pw1[2] = PKW(P0, 12), pw1[3] = PKW(P0, 14), pw1); \
    VRD(2); SBAR(); GAPA(C0 = __builtin_amdgcn_mfma_f32_32x32x16_bf16(kf[4], qr[2], C0, 0, 0, 0),   P1[2], P1[3], P1[4], P1[5],     pw2[0] = PKW(P1, 0), pw2[1] = PKW(P1, 2), pw2); \
    VRD(6); SBAR(); GAPA(C1 = __builtin_amdgcn_mfma_f32_32x32x16_bf16(kf[5], qr[2], C1, 0, 0, 0),   P1[6], P1[7], P1[8], P1[9],     pw2[2] = PKW(P1, 4), pw2[3] = PKW(P1, 6), pw2); \
    VRD(3); SBAR(); GAPA(C0 = __builtin_amdgcn_mfma_f32_32x32x16_bf16(kf[6], qr[3], C0, 0, 0, 0),   P1[10], P1[11], P1[12], P1[13], pw3[0] = PKW(P1, 8), pw3[1] = PKW(P1, 10), pw3); \
    VRD(7); SBAR(); GAPA(C1 = __builtin_amdgcn_mfma_f32_32x32x16_bf16(kf[7], qr[3], C1, 0, 0, 0),   P1[14], P1[15], 0.f, 0.f,       pw3[2] = PKW(P1, 12), pw3[3] = PKW(P1, 14), pw3); \
    l_reg += sacc2.x + sacc2.y; \
    if (GK) { DMA_K((t) + 3, sl_cur); } if (GV) { DMA_V((t) + 1, sl_next); } \
    resc = false; \
    if (NA) { _Pragma("unroll") for (int r = 0; r < 16; ++r) { C0[r] -= mhat; C1[r] -= mhat; } } \
    CMASK(C0, C1, t); \
    if (!NOMAX) { float a = MX3(C0[0], C0[1], C1[0]), b = MX3(C0[2], C0[3], C1[1]); a = MX3(a, C1[2], C1[3]); \
      _Pragma("unroll") for (int r = 4; r < 16; r += 4) { a = MX3(a, C0[r], C0[r + 1]); b = MX3(b, C0[r + 2], C0[r + 3]); a = MX3(a, C1[r], C1[r + 1]); b = MX3(b, C1[r + 2], C1[r + 3]); } \
      float rm = __builtin_fmaxf(a, b); { auto rr = __builtin_amdgcn_permlane32_swap(__float_as_uint(rm), __float_as_uint(rm), false, false); rm = __builtin_fmaxf(__uint_as_float(rr[0]), __uint_as_float(rr[1])); } \
      if (__builtin_expect(__any(rm > (float)THRL), 0)) { const float dl = __builtin_fmaxf(rm, 0.f); mhat += dl; \
        _Pragma("unroll") for (int r = 0; r < 16; ++r) { C0[r] -= dl; C1[r] -= dl; } \
        if (!NA) { _Pragma("unroll") for (int r = 0; r < 16; ++r) negm[r] = -mhat; asm volatile("" : "+v"(negm)); } \
        const float f = __builtin_amdgcn_exp2f(-dl); l_reg *= f; if (hi == 0) wsf[r32] = f; resc = true; } } \
    SBAR(); \
    GAPB(o[0] = __builtin_amdgcn_mfma_f32_32x32x16_bf16(PAF(0), VFR(0), o[0], 0, 0, 0), C0, 0); \
    GAPB(o[1] = __builtin_amdgcn_mfma_f32_32x32x16_bf16(PAF(0), VFR(4), o[1], 0, 0, 0), C0, 4); \
    KRD(GL, 0); GAPB(o[0] = __builtin_amdgcn_mfma_f32_32x32x16_bf16(PAF(1), VFR(1), o[0], 0, 0, 0), C0, 8); \
    KRD(GL, 1); GAPB(o[1] = __builtin_amdgcn_mfma_f32_32x32x16_bf16(PAF(1), VFR(5), o[1], 0, 0, 0), C0, 12); \
    KRD(GL, 2); GAPB(o[0] = __builtin_amdgcn_mfma_f32_32x32x16_bf16(PAF(2), VFR(2), o[0], 0, 0, 0), C1, 0); \
    KRD(GL, 3); GAPB(o[1] = __builtin_amdgcn_mfma_f32_32x32x16_bf16(PAF(2), VFR(6), o[1], 0, 0, 0), C1, 4); \
    GAPB(o[0] = __builtin_amdgcn_mfma_f32_32x32x16_bf16(PAF(3), VFR(3), o[0], 0, 0, 0), C1, 8); \
    GAPB(o[1] = __builtin_amdgcn_mfma_f32_32x32x16_bf16(PAF(3), VFR(7), o[1], 0, 0, 0), C1, 12); \
    } while (0)
  int t = 1;
  for (; t + 5 < NT; t += 2) {
    STEP(pB0, pB1, pA0, pA1, t, true, true, true);     WAIT_BAR(2); RESC(); ROT();
    STEP(pA0, pA1, pB0, pB1, t + 1, true, true, true); WAIT_BAR(2); RESC(); ROT();
  }
  #define ENDW(tt) do { if ((tt) + 3 < NT) { WAIT_BAR(2); } else if ((tt) + 2 < NT) { WAIT_BAR(1); } else { WAIT_BAR(0); } } while (0)
  for (; t + 1 < NT; t += 2) {
    STEP(pB0, pB1, pA0, pA1, t, (t + 3 < NT), (t + 1 < NT), (t + 1 < NT));         ENDW(t);     RESC(); ROT();
    STEP(pA0, pA1, pB0, pB1, t + 1, (t + 4 < NT), (t + 2 < NT), (t + 2 < NT));     ENDW(t + 1); RESC(); ROT();
  }
  STEP(pB0, pB1, pA0, pA1, NT - 1, false, false, false); RESC();
  { float sacc = pB0[0] + pB0[1]; _Pragma("unroll") for (int r = 2; r < 16; ++r) sacc += pB0[r]; _Pragma("unroll") for (int r = 0; r < 16; ++r) sacc += pB1[r]; l_reg += sacc;
    pw0 = (u32x4){PKW(pB0, 0), PKW(pB0, 2), PKW(pB0, 4), PKW(pB0, 6)}; pw1 = (u32x4){PKW(pB0, 8), PKW(pB0, 10), PKW(pB0, 12), PKW(pB0, 14)}; pw2 = (u32x4){PKW(pB1, 0), PKW(pB1, 2), PKW(pB1, 4), PKW(pB1, 6)}; pw3 = (u32x4){PKW(pB1, 8), PKW(pB1, 10), PKW(pB1, 12), PKW(pB1, 14)};
    SBAR(); pv(o, vb0 + sl_cur, PAF(0), PAF(1), PAF(2), PAF(3)); }
  #undef PKW
  #undef PAF
  #undef VFR
  #undef PIN
  #undef MX3
  #undef GAPA
  #undef GAPB
  #undef EX
  #undef VRD
  #undef KRD
  #undef STEP
  #undef ENDW
  { auto rr = __builtin_amdgcn_permlane32_swap(__float_as_uint(l_reg), __float_as_uint(l_reg), false, false); l_reg = __uint_as_float(rr[0]) + __uint_as_float(rr[1]); }
  if (hi == 0) wsf[32 + r32] = l_reg; asm volatile("s_waitcnt lgkmcnt(0)" ::: "memory");
  float rli[16];
  #pragma unroll
  for (int r = 0; r < 16; ++r) rli[r] = __builtin_amdgcn_rcpf(wsf[32 + crow(r, hi)]);
  bf16* Ow = Ou + (long)(wid * QBLK) * op;
  { bf16* stg = (bf16*)(shm + LDS_OST) + wid * 2048;
    #pragma unroll
    for (int r = 0; r < 16; ++r) { const int orow = crow(r, hi);
      #pragma unroll
      for (int d0 = 0; d0 < 2; ++d0) stg[orow * 64 + d0 * 32 + r32] = (bf16)f2bf(o[d0][r] * rli[r]); }
    asm volatile("s_waitcnt lgkmcnt(0)" ::: "memory");
    #pragma unroll
    for (int i = 0; i < 4; ++i) { const int row = i * 8 + (lane >> 3), ch = lane & 7; const u32x4 v = *(const u32x4*)(stg + row * 64 + ch * 8); ATTN_STORE16(Ow + (long)row * op + ch * 8, v); } }
  asm volatile("s_waitcnt lgkmcnt(0)\n\ts_barrier" ::: "memory");
  #undef NEGM
  #undef DMA_K
  #undef DMA_V
  #undef TROW
  #undef CMASK
  #undef START
  #undef RESC
  #undef ROT
}
#undef SBAR
#undef WAIT_BAR
}
#ifndef FP8_MOE
#define FP8_MOE 1
#endif
struct Args { const float* in[29]; float* out; unsigned char* ws; int ph_lo, ph_hi; };
enum { I_X = 0, I_C, I_CTX, I_CCTX, I_WMOD, I_BMOD, I_N1G, I_N2G, I_WIN, I_LRE, I_LIM, I_LDT, I_BRE, I_BIM, I_CRE, I_CIM, I_SSMD, I_WGLU, I_QNG, I_KNG, I_RPB, I_WBR, I_WOUT, I_RW, I_RB, I_MG, I_MU, I_MD, I_FNG };

typedef const float* CFP;
struct Ctx {
    const __attribute__((address_space(4))) CFP* in; float* out; unsigned char* ws; LAS unsigned char* lds; gu32* ctl;
    int tid, lane, wave, vcu, G;
};
#define WSP(T_, off) ((T_*)(C.ws + (off)))
__device__ __forceinline__ size_t wout_off(int l) { return (l & 1) ? WS_WOUT2 : WS_WOUT; }
__device__ __forceinline__ size_t moe1_off(int l) { return WS_MOE1 + (size_t)(l & 1) * 16 * MiB; }
__device__ __forceinline__ size_t moe2_off(int l) { return WS_MOE2 + (size_t)(l & 1) * 8 * MiB; }

__device__ __forceinline__ bf16* xs_row(const Ctx& C, int m) { return WSP(bf16, WS_XS) + (size_t)m * D; }
__device__ __forceinline__ const float* in_row(const Ctx& C, int m) { const int b = m / LB, j = m - b * LB; return j < CTX ? C.in[I_CTX] + (size_t)(b * CTX + j) * D : C.in[I_X] + (size_t)(b * SEQ + j - CTX) * D; }
__device__ __forceinline__ int cond_of(int m) { const int b = m / LB, j = m - b * LB; return j < CTX ? 4 : b; }

__device__ __forceinline__ void transpose_item(const float* W, int N, int Kp, bf16* WT, int k0, int n0, int drow0, LAS float* scr, int lane) {
    const float* src = W + (size_t)k0 * N + n0 + lane;
    float tv[64];
#pragma unroll
    for (int i = 0; i < 64; ++i) tv[i] = src[(size_t)i * N];
#pragma unroll
    for (int i = 0; i < 64; ++i) scr[i * 65 + lane] = tv[i];
    LDS_WAIT(); asm volatile("" ::: "memory");
    const int c = lane & 7;
#pragma unroll
    for (int j = 0; j < 8; ++j) { const int n = (lane >> 3) + 8 * j; const LAS float* s = scr + (8 * c) * 65 + n;
        v4u o; o.x = pk2(s[0 * 65], s[1 * 65]); o.y = pk2(s[2 * 65], s[3 * 65]); o.z = pk2(s[4 * 65], s[5 * 65]); o.w = pk2(s[6 * 65], s[7 * 65]);
        *(GAS v4u*)(WT + (size_t)(drow0 + n) * Kp + k0 + 8 * c) = o; }
    LDS_WAIT(); asm volatile("" ::: "memory");
}
__device__ __forceinline__ void transpose_item8(const float* W, int N, int Kp, unsigned char* WT, int k0, int n0, int drow0, float scale, LAS float* scr, int lane) {
    const float* src = W + (size_t)k0 * N + n0 + lane;
    float tv[64];
#pragma unroll
    for (int i = 0; i < 64; ++i) tv[i] = src[(size_t)i * N];
#pragma unroll
    for (int i = 0; i < 64; ++i) scr[i * 65 + lane] = tv[i] * scale;
    LDS_WAIT(); asm volatile("" ::: "memory");
    const int c = lane & 3;
#pragma unroll
    for (int j = 0; j < 4; ++j) { const int n = (lane >> 2) + 16 * j; const LAS float* s = scr + (16 * c) * 65 + n;
        v4u o; o.x = pk4_fp8(s[0 * 65], s[1 * 65], s[2 * 65], s[3 * 65]); o.y = pk4_fp8(s[4 * 65], s[5 * 65], s[6 * 65], s[7 * 65]); o.z = pk4_fp8(s[8 * 65], s[9 * 65], s[10 * 65], s[11 * 65]); o.w = pk4_fp8(s[12 * 65], s[13 * 65], s[14 * 65], s[15 * 65]);
        *(GAS v4u*)(WT + (size_t)(drow0 + n) * Kp + k0 + 16 * c) = o; }
    LDS_WAIT(); asm volatile("" ::: "memory");
}
__device__ __forceinline__ void phase_weights(const Ctx& C, int l, int widx, int nwork) {
    if (widx < 0) return;
    LAS float* scr = (LAS float*)(C.lds + C.wave * 16640);
    const int gw = widx * NWAVES + C.wave, NGW = nwork * NWAVES;
    constexpr int I0 = 16 * 92, I1 = 8 * 8, I2 = 3 * 8 * 16, I3 = 16 * 16, I4 = 16 * 16 * 8, I5 = I4, I6 = 16 * 8 * 16;
    for (int it = gw; it < I0 + I1 + I2 + I3 + I4 + I5 + I6; it += NGW) {
        int r = it;
        if (r < I0) { const int kb = r / 92, nb = r % 92; if (W8_ALL) transpose_item8(C.in[I_WIN] + (size_t)l * 1024 * INW, INW, 1024, WSP(unsigned char, WS_WIN), 64 * kb, 64 * nb, 64 * nb, 64.f, scr, C.lane);
            else if (nb < 44 || GATE_BF16) transpose_item(C.in[I_WIN] + (size_t)l * 1024 * INW, INW, 1024, WSP(bf16, WS_WIN), 64 * kb, 64 * nb, 64 * nb, scr, C.lane);
            else transpose_item8(C.in[I_WIN] + (size_t)l * 1024 * INW, INW, 1024, WSP(unsigned char, WS_WIN8), 64 * kb, 64 * nb, 64 * nb - 2816, 64.f, scr, C.lane); continue; } r -= I0;
        if (r < I1) { const int kb = r / 8, nb = r % 8; transpose_item(C.in[I_WGLU] + (size_t)l * 512 * 512, 512, 512, WSP(bf16, WS_WGLU), 64 * kb, 64 * nb, 64 * nb, scr, C.lane); continue; } r -= I1;
        if (r < I2) { const int i = r / 128, q = r % 128, kb = q / 16, nb = q % 16; transpose_item(C.in[I_WBR] + (size_t)(l * 3 + i) * 512 * 1024, 1024, 512, WSP(bf16, WS_WBR) + (size_t)i * 1024 * 512, 64 * kb, 64 * nb, 64 * nb, scr, C.lane); continue; } r -= I2;
        if (r < I3) { const int kb = r / 16, nb = r % 16; transpose_item(C.in[I_WOUT] + (size_t)l * 1024 * 1024, 1024, 1024, (bf16*)(C.ws + wout_off(l)), 64 * kb, 64 * nb, 64 * nb, scr, C.lane); continue; } r -= I3;
        if (r < I4 + I5) { const int up = r >= I4; if (up) r -= I4; const int e = r / 128, q = r % 128, kb = q / 8, nb = q % 8, n0 = 64 * nb;
            if (FP8_MOE) transpose_item8((up ? C.in[I_MU] : C.in[I_MG]) + (size_t)(l * 16 + e) * 1024 * 512, 512, 1024, (unsigned char*)(C.ws + moe1_off(l)) + (size_t)e * 1024 * 1024, 64 * kb, n0, (n0 / 128) * 256 + (n0 % 128) + (up ? 128 : 0), 64.f, scr, C.lane);
            else transpose_item((up ? C.in[I_MU] : C.in[I_MG]) + (size_t)(l * 16 + e) * 1024 * 512, 512, 1024, WSP(bf16, WS_MOE1) + (size_t)e * 1024 * 1024, 64 * kb, n0, (n0 / 128) * 256 + (n0 % 128) + (up ? 128 : 0), scr, C.lane); continue; } r -= I4 + I5;
        { const int e = r / 128, q = r % 128, kb = q / 16, nb = q % 16; if (FP8_MOE) transpose_item8(C.in[I_MD] + (size_t)(l * 16 + e) * 512 * 1024, 1024, 512, (unsigned char*)(C.ws + moe2_off(l)) + (size_t)e * 1024 * 512, 64 * kb, 64 * nb, 64 * nb, 32.f, scr, C.lane);
            else transpose_item(C.in[I_MD] + (size_t)(l * 16 + e) * 512 * 1024, 1024, 512, WSP(bf16, WS_MOE2) + (size_t)e * 1024 * 512, 64 * kb, 64 * nb, 64 * nb, scr, C.lane); }
    }
}

__device__ __forceinline__ void phase_mod(const Ctx& C) {
    LAS float* sc = (LAS float*)(C.lds);
    LAS float* red = (LAS float*)(C.lds + 20480);
    for (int i = C.tid; i < 5 * 1024; i += 512) { const int c = i >> 10, k = i & 1023; const float v = c < 4 ? C.in[I_C][c * 1024 + k] : C.in[I_CCTX][k]; sc[i] = v * fsigmoid(v); }
    __syncthreads();
    for (int it = C.vcu; it < NLAYER * 96; it += C.G) {
        const int l = it / 96, col = (it % 96) * 64 + C.lane, k0 = C.wave * 128;
        const float* W = C.in[I_WMOD] + (size_t)l * 1024 * 6144 + (size_t)k0 * 6144 + col;
        float a0 = 0.f, a1 = 0.f, a2 = 0.f, a3 = 0.f, a4 = 0.f;
#pragma unroll 16
        for (int k = 0; k < 128; ++k) { const float w = W[(size_t)k * 6144]; a0 += sc[k0 + k] * w; a1 += sc[1024 + k0 + k] * w; a2 += sc[2048 + k0 + k] * w; a3 += sc[3072 + k0 + k] * w; a4 += sc[4096 + k0 + k] * w; }
        LAS float* r = red + C.wave * 320 + C.lane; r[0] = a0; r[64] = a1; r[128] = a2; r[192] = a3; r[256] = a4;
        __syncthreads();
        if (C.tid < 320) { const int c = C.tid >> 6; float s = C.in[I_BMOD][l * 6144 + col];
#pragma unroll
            for (int w = 0; w < 8; ++w) s += red[w * 320 + C.tid];
            WSP(float, WS_MOD)[(size_t)(l * 5 + c) * 6144 + col] = s; }
        __syncthreads();
    }
}

__device__ __forceinline__ void phase_s5mats(const Ctx& C, int l, int w) {
    if (w < 0 || w >= 128) return;
    const int g = w >> 2, part = w & 3, tid = C.tid;
    LAS f32x2* POW = (LAS f32x2*)(C.lds);
    LAS f32x2* CC = (LAS f32x2*)(C.lds + 33792);
    LAS f32x2* BB = (LAS f32x2*)(C.lds + 50176);
    LAS f32x2* COEF = (LAS f32x2*)(C.lds + 66560);
    LAS bf16* KT = (LAS bf16*)(C.lds + 67584);
    LAS float* WT = (LAS float*)(C.lds + 101376);
    __syncthreads();
    if (tid < 128) {
        const int d = tid >> 6, p = tid & 63; const int li = ((l * 2 + d) * 32 + g) * 64 + p;
        const float re = C.in[I_LRE][li], im = C.in[I_LIM][li], dt = __expf(C.in[I_LDT][(l * 2 + d) * 32 + g]);
        for (int tau = 0; tau <= 32; ++tau) { const float mag = __expf(re * dt * (float)tau), rev = im * dt * (float)tau * 0.15915494309189535f;
            const float wr = mag * cos_rev(rev), wi = mag * sin_rev(rev);
            POW[(d * 33 + tau) * 64 + p] = (f32x2){wr, wi}; if (tau < 32) { WT[((d * 64 + p) * 2) * 32 + tau] = wr; WT[((d * 64 + p) * 2 + 1) * 32 + tau] = wi; } }
        const float mag = __expf(re * dt), rev = im * dt * 0.15915494309189535f; const float lr = mag * cos_rev(rev) - 1.f, lim = mag * sin_rev(rev);
        const float den = 1.f / (re * re + im * im);
        COEF[tid] = (f32x2){(lr * re + lim * im) * den, (lim * re - lr * im) * den};
    }
    __syncthreads();
    for (int i = tid; i < 2048; i += 512) {
        const int d = i >> 10, p = (i >> 4) & 63, h = i & 15; const size_t bi = (((size_t)(l * 2 + d) * 32 + g) * 64 + p) * 16 + h;
        const float br = C.in[I_BRE][bi], bi_ = C.in[I_BIM][bi]; const f32x2 cf = COEF[d * 64 + p];
        BB[i] = (f32x2){cf.x * br - cf.y * bi_, cf.x * bi_ + cf.y * br};
        const int h2 = (i >> 6) & 15, p2 = i & 63; const size_t ci = (((size_t)(l * 2 + d) * 32 + g) * 16 + h2) * 64 + p2;
        CC[i] = (f32x2){C.in[I_CRE][ci], C.in[I_CIM][ci]};
    }
    __syncthreads();
    {
        const int wv = tid >> 6, ln = tid & 63, hi = ln >> 5, i = ln & 31, h = 2 * wv + (i >> 4), hp = i & 15;
        f32x16 a0 = f32x16{}, a1 = f32x16{};
#pragma unroll 4
        for (int p = 0; p < 64; ++p) {
            const f32x2 c0 = CC[h * 64 + p], b0 = BB[p * 16 + hp], c1 = CC[1024 + h * 64 + p], b1 = BB[1024 + p * 16 + hp];
            const float x0 = hi == 0 ? (c0.x * b0.x - c0.y * b0.y) : -(c0.x * b0.y + c0.y * b0.x);
            const float x1 = hi == 0 ? (c1.x * b1.x - c1.y * b1.y) : -(c1.x * b1.y + c1.y * b1.x);
            a0 = __builtin_amdgcn_mfma_f32_32x32x2f32(x0, WT[(p * 2 + hi) * 32 + i], a0, 0, 0, 0);
            a1 = __builtin_amdgcn_mfma_f32_32x32x2f32(x1, WT[((64 + p) * 2 + hi) * 32 + i], a1, 0, 0, 0);
        }
        const float* sd = C.in[I_SSMD] + l * 512 + g * 16;
#pragma unroll
        for (int r = 0; r < 16; ++r) { const int rl = (r & 3) + 8 * (r >> 2) + 4 * hi, hh = 2 * wv + (rl >> 4), hq = rl & 15;
            float f = a0[r]; if (i == 0) f += a1[r] + (hh == hq ? sd[hh] : 0.f);
            KT[((31 + i) * 16 + hh) * 16 + hq] = (bf16)f2bf(f);
            if (i > 0) KT[((31 - i) * 16 + hh) * 16 + hq] = (bf16)f2bf(a1[r]); }
    }
    __syncthreads();
    bf16* B1 = WSP(bf16, WS_BT1) + (size_t)g * 768 * 512; bf16* B2 = WSP(bf16, WS_BT2) + (size_t)g * 512 * 256;
    for (int i = tid; i < 128 * 64; i += 512) {
        const int n = part * 128 + (i >> 6), ch = i & 63, t = n >> 4, h = n & 15, s = ch >> 1, hp0 = (ch & 1) * 8;
        *(GAS v4u*)(B1 + (size_t)n * 512 + ch * 8) = *(const LAS v4u*)(KT + ((t - s + 31) * 16 + h) * 16 + hp0);
    }
    for (int i = tid; i < 64 * 64; i += 512) {
        const int nn = part * 64 + (i >> 6), ch = i & 63, d = nn >> 7, p = (nn & 127) >> 1, ri = nn & 1, s = ch >> 1, hp0 = (ch & 1) * 8;
        const f32x2 w = POW[(d * 33 + (d == 0 ? 31 - s : s)) * 64 + p]; float v[8];
#pragma unroll
        for (int j = 0; j < 8; ++j) { const f32x2 b = BB[d * 1024 + p * 16 + hp0 + j]; v[j] = ri == 0 ? (w.x * b.x - w.y * b.y) : (w.x * b.y + w.y * b.x); }
        v4u o; o.x = pk2(v[0], v[1]); o.y = pk2(v[2], v[3]); o.z = pk2(v[4], v[5]); o.w = pk2(v[6], v[7]);
        *(GAS v4u*)(B1 + (size_t)(512 + nn) * 512 + ch * 8) = o;
    }
    for (int i = tid; i < 128 * 32; i += 512) {
        const int n = part * 128 + (i >> 5), ch = i & 31, t = n >> 4, h = n & 15, d = ch >> 4, p0 = (ch & 15) * 4; float v[8];
#pragma unroll
        for (int j = 0; j < 4; ++j) { const f32x2 c = CC[d * 1024 + h * 64 + p0 + j], w = POW[(d * 33 + (d == 0 ? t + 1 : 32 - t)) * 64 + p0 + j];
            v[2 * j] = c.x * w.x - c.y * w.y; v[2 * j + 1] = -(c.x * w.y + c.y * w.x); }
        v4u o; o.x = pk2(v[0], v[1]); o.y = pk2(v[2], v[3]); o.z = pk2(v[4], v[5]); o.w = pk2(v[6], v[7]);
        *(GAS v4u*)(B2 + (size_t)n * 256 + ch * 8) = o;
    }
    __syncthreads();
}

template <int MODE>
__device__ __forceinline__ void phase_rows(const Ctx& C, int l) {
    const int gw = C.vcu * NWAVES + C.wave, NGW = C.G * NWAVES, lane = C.lane;
    const float* MODl = WSP(float, WS_MOD) + (size_t)(MODE == 2 ? 0 : l) * 5 * 6144;
    const float* MODp = WSP(float, WS_MOD) + (size_t)(l > 0 ? l - 1 : 0) * 5 * 6144;
    const bf16* YS = WSP(bf16, WS_YSLOT);
    LAS float* GT = (LAS float*)C.lds;
    LAS float* GM = GT + 5120;
    LAS float* SH = GT + 10240;
    __syncthreads();
    for (int i = C.tid; i < 5120; i += 512) { const int cond = i >> 10, k = i & 1023;
        if (MODE != 0) GT[i] = MODp[cond * 6144 + 5 * 1024 + k];
        if (MODE != 2) { GM[i] = C.in[I_N1G][l * D + k] * (MODl[cond * 6144 + 1024 + k] + 1.f); SH[i] = MODl[cond * 6144 + k]; }
        else if (i < 1024) GM[i] = C.in[I_FNG][k]; }
    __syncthreads();
    f32x4 nx[4]; v2u nb[4], na[4], nc[4];
#define ROWS_LOAD(mm) do { const int m_ = (mm); \
        if (MODE == 0) { const GAS f32x4* xr = (const GAS f32x4*)in_row(C, m_) + lane; _Pragma("unroll") for (int q = 0; q < 4; ++q) nx[q] = xr[64 * q]; } \
        else { const GAS v2u* xr = (const GAS v2u*)xs_row(C, m_) + lane; const GAS v2u* y0 = (const GAS v2u*)(YS + (size_t)(2 * m_) * D) + lane; const GAS v2u* y1 = (const GAS v2u*)(YS + (size_t)(2 * m_ + 1) * D) + lane; \
            _Pragma("unroll") for (int q = 0; q < 4; ++q) { nb[q] = xr[64 * q]; na[q] = y0[64 * q]; nc[q] = y1[64 * q]; } } } while (0)
    int m = gw; if (MODE == 2) { while (m < T && (m % LB) < CTX) m += NGW; }
    if (m < T) ROWS_LOAD(m);
    while (m < T) {
        const int b = m / LB, j = m - b * LB, cond = j < CTX ? 4 : b;
        f32x4 v[4];
        if (MODE == 0) {
#pragma unroll
            for (int q = 0; q < 4; ++q) v[q] = nx[q]; }
        else { const LAS f32x4* g2 = (const LAS f32x4*)(GT + cond * 1024) + lane;
#pragma unroll
            for (int q = 0; q < 4; ++q) { const f32x4 g = g2[64 * q]; const v2u a = na[q], c = nc[q], xb_ = nb[q];
                v[q] = (f32x4){bflo(xb_.x), bfhi(xb_.x), bflo(xb_.y), bfhi(xb_.y)} + g * (f32x4){bflo(a.x) + bflo(c.x), bfhi(a.x) + bfhi(c.x), bflo(a.y) + bflo(c.y), bfhi(a.y) + bfhi(c.y)}; } }
        int mn = m + NGW; if (MODE == 2) { while (mn < T && (mn % LB) < CTX) mn += NGW; }
        if (mn < T) ROWS_LOAD(mn);
        float ss = 0.f;
#pragma unroll
        for (int q = 0; q < 4; ++q) ss += (v[q].x * v[q].x + v[q].y * v[q].y) + (v[q].z * v[q].z + v[q].w * v[q].w);
        const float rstd = 1.f / sqrtf(wave_sum(ss, lane) * (1.f / D) + EPS);
        if (MODE == 2) { GAS f32x4* o = (GAS f32x4*)(C.out + (size_t)(b * SEQ + j - CTX) * D) + lane; const LAS f32x4* fg = (const LAS f32x4*)GM + lane;
#pragma unroll
            for (int q = 0; q < 4; ++q) o[64 * q] = v[q] * rstd * fg[64 * q]; }
        else { GAS v2u* xo = (GAS v2u*)xs_row(C, m) + lane; GAS v2u* ho = (GAS v2u*)(WSP(bf16, WS_HB) + (size_t)m * D) + lane; GAS unsigned* h8 = (GAS unsigned*)(WSP(unsigned char, WS_HB8) + (size_t)m * D) + lane;
            const LAS f32x4* gm = (const LAS f32x4*)(GM + cond * 1024) + lane; const LAS f32x4* sh = (const LAS f32x4*)(SH + cond * 1024) + lane;
#pragma unroll
            for (int q = 0; q < 4; ++q) { xo[64 * q] = (v2u){pk2(v[q].x, v[q].y), pk2(v[q].z, v[q].w)}; const f32x4 h = v[q] * rstd * gm[64 * q] + sh[64 * q]; if (!W8_ALL) ho[64 * q] = (v2u){pk2(h.x, h.y), pk2(h.z, h.w)}; if (H8_WRITE) h8[64 * q] = pk4_fp8(h.x, h.y, h.z, h.w); } }
        m = mn;
    }
#undef ROWS_LOAD
}

__device__ __forceinline__ void phase_qkprep(const Ctx& C, int l) {
    const int gw = C.vcu * NWAVES + C.wave, NGW = C.G * NWAVES, lane = C.lane, s8 = lane & 7;
    const float* qg = C.in[I_QNG] + l * 64 + 8 * s8; const float* kg = C.in[I_KNG] + l * 64 + 8 * s8;
    float gq[8], gk[8];
#pragma unroll
    for (int i = 0; i < 8; ++i) { gq[i] = qg[i]; gk[i] = kg[i]; }
    const int ax = s8 >> 2, f0 = 8 * (s8 & 1);
    float inv[8];
#pragma unroll
    for (int i = 0; i < 8; ++i) inv[i] = exp2f(-(float)(f0 + i) * 0.8304820237218406f) * 0.15915494309189535f;
    const int kl = lane & 15;
    v4u wq, wk;
    if (gw < T) { wq = *((const GAS v4u*)(WSP(bf16, WS_QA) + (size_t)gw * 512) + lane); wk = *((const GAS v4u*)(WSP(bf16, WS_KA) + (size_t)gw * 128) + kl); }
    for (int m = gw; m < T; m += NGW) {
        const int b = m / LB, j = m - b * LB; const bool lat = j >= CTX; const int tt = j - CTX; const float pos = (float)(ax == 0 ? (tt >> 6) : (tt & 63));
        const v4u cq = wq, ck = wk;
        if (m + NGW < T) { wq = *((const GAS v4u*)(WSP(bf16, WS_QA) + (size_t)(m + NGW) * 512) + lane); wk = *((const GAS v4u*)(WSP(bf16, WS_KA) + (size_t)(m + NGW) * 128) + kl); }
        float cs[8], sn[8];
#pragma unroll
        for (int i = 0; i < 8; ++i) { cs[i] = lat ? cos_rev(pos * inv[i]) : 1.f; sn[i] = lat ? sin_rev(pos * inv[i]) : 0.f; }
#pragma unroll
        for (int which = 0; which < 2; ++which) {
            const v4u w = which == 0 ? cq : ck; float x[8] = {bflo(w.x), bfhi(w.x), bflo(w.y), bfhi(w.y), bflo(w.z), bfhi(w.z), bflo(w.w), bfhi(w.w)};
            float ss = 0.f;
#pragma unroll
            for (int i = 0; i < 8; ++i) ss += x[i] * x[i];
            ss += dpp_mov<0xB1, 0xF>(ss); ss += dpp_mov<0x4E, 0xF>(ss); ss += dpp_mov<0x141, 0xF>(ss);
            const float rstd = 1.f / sqrtf(ss * (1.f / 64.f) + EPS);
            float y[8];
#pragma unroll
            for (int i = 0; i < 8; ++i) { const float xn = x[i] * rstd * (which == 0 ? gq[i] : gk[i]); const float other = dpp_mov<0x4E, 0xF>(xn);
                y[i] = (s8 & 2) ? (xn * cs[i] + other * sn[i]) : (xn * cs[i] - other * sn[i]); }
            const float sc = which == 0 ? C2 : 1.f;
            v4u o; o.x = pk2(y[0] * sc, y[1] * sc); o.y = pk2(y[2] * sc, y[3] * sc); o.z = pk2(y[4] * sc, y[5] * sc); o.w = pk2(y[6] * sc, y[7] * sc);
            if (which == 0) *((GAS v4u*)(WSP(bf16, WS_QA) + (size_t)m * 512) + lane) = o;
            else if (lane < 16) *((GAS v4u*)(WSP(bf16, WS_KA) + (size_t)m * 128) + lane) = o;
        }
    }
}

__device__ __forceinline__ void phase_carry(const Ctx& C, int l) {
    if (C.vcu >= 32) return;
    const int b = C.vcu >> 3, g = (C.vcu & 7) * 4 + (C.wave >> 1), d = C.wave & 1, p = C.lane;
    const int li = ((l * 2 + d) * 32 + g) * 64 + p;
    const float re = C.in[I_LRE][li], im = C.in[I_LIM][li], dt = __expf(C.in[I_LDT][(l * 2 + d) * 32 + g]);
    const float mag = __expf(re * dt * 32.f), rev = im * dt * 32.f * 0.15915494309189535f; const float Lr = mag * cos_rev(rev), Li = mag * sin_rev(rev);
    const GAS f32x2* S = (const GAS f32x2*)(WSP(float, WS_SST) + (size_t)(b * NCH) * 8192 + g * 256 + d * 128) + p;
    GAS unsigned* X = (GAS unsigned*)(WSP(bf16, WS_XST) + (size_t)(b * NCH) * 8192 + g * 256 + d * 128) + p;
    float sr = 0.f, si = 0.f;
    if (d == 0) {
        for (int c0 = 0; c0 < NCH; c0 += 8) { f32x2 s[8];
#pragma unroll
            for (int k = 0; k < 8; ++k) s[k] = S[(size_t)(c0 + k) * 4096];
#pragma unroll
            for (int k = 0; k < 8; ++k) { X[(size_t)(c0 + k) * 4096] = pk2(sr, si); const float nr = Lr * sr - Li * si + s[k].x, ni = Lr * si + Li * sr + s[k].y; sr = nr; si = ni; } }
    } else {
        for (int seg = 0; seg < 33; ++seg) { const int chi = seg == 0 ? 7 : NCH - 1 - (seg - 1) * 8; f32x2 s[8];
#pragma unroll
            for (int k = 0; k < 8; ++k) s[k] = S[(size_t)(chi - k) * 4096];
#pragma unroll
            for (int k = 0; k < 8; ++k) { X[(size_t)(chi - k) * 4096] = pk2(sr, si); const float nr = Lr * sr - Li * si + s[k].x, ni = Lr * si + Li * sr + s[k].y; sr = nr; si = ni; } }
    }
}

__device__ __forceinline__ void phase_norm2(const Ctx& C, int l) {
    LAS float* TILE = (LAS float*)C.lds;
    LAS float* PART = (LAS float*)(C.lds + 65792);
    LAS unsigned* REC = (LAS unsigned*)(C.lds + 73984);
    LAS float* LG = (LAS float*)(C.lds + 78080);
    LAS unsigned* LCNT = (LAS unsigned*)(C.lds + 94464);
    LAS float* GAM = (LAS float*)(C.lds + 94720);
    LAS float* SHF = (LAS float*)(C.lds + 115200);
    const int lane = C.lane, tid = C.tid;
    if (tid < 32) LCNT[tid] = 0u;
    const float* MODl = WSP(float, WS_MOD) + (size_t)l * 5 * 6144;
    for (int i = tid; i < 5 * 1024; i += 512) { const int cond = i >> 10, k = i & 1023; GAM[i] = C.in[I_N2G][l * D + k] * (MODl[cond * 6144 + 4096 + k] + 1.f); SHF[i] = MODl[cond * 6144 + 3072 + k]; }
    int nrows = 0; for (int m = C.vcu; m < T; m += C.G) ++nrows;
    __syncthreads();
    const int fn = lane & 15, kq = lane >> 4;
    float bw[32];
#pragma unroll
    for (int j = 0; j < 32; ++j) bw[j] = C.in[I_RW][(128 * C.wave + 32 * kq + j) * 16 + fn];
    v2u nx[2][4];
#define N2_LOAD(ii) do { _Pragma("unroll") for (int rr = 0; rr < 2; ++rr) { const int i_ = (ii) + rr * NWAVES; const int m_ = C.vcu + C.G * (i_ < nrows ? i_ : (ii)); const GAS v2u* xr = (const GAS v2u*)xs_row(C, m_) + lane; \
        _Pragma("unroll") for (int q = 0; q < 4; ++q) nx[rr][q] = xr[64 * q]; } } while (0)
    if (C.wave < nrows) N2_LOAD(C.wave);
    for (int i0 = 0; i0 < nrows; i0 += 2 * NWAVES) {
        const int i = i0 + C.wave; const bool has0 = i < nrows, has1 = i + NWAVES < nrows;
        if (has0) {
#pragma unroll
            for (int rr = 0; rr < 2; ++rr) { const int ir = (rr && has1) ? i + NWAVES : i; const int m = C.vcu + C.G * ir, cond = cond_of(m);
                GAS unsigned* h8 = (GAS unsigned*)(WSP(unsigned char, WS_HB8) + (size_t)m * D) + lane;
                const LAS f32x4* gm = (const LAS f32x4*)(GAM + cond * 1024) + lane; const LAS f32x4* sh = (const LAS f32x4*)(SHF + cond * 1024) + lane;
                float ss = 0.f; f32x4 xf[4];
#pragma unroll
                for (int q = 0; q < 4; ++q) { const v2u w_ = nx[rr][q]; const f32x4 v = (f32x4){bflo(w_.x), bfhi(w_.x), bflo(w_.y), bfhi(w_.y)}; xf[q] = v; ss += (v.x * v.x + v.y * v.y) + (v.z * v.z + v.w * v.w); }
                const float rstd = 1.f / sqrtf(wave_sum(ss, lane) * (1.f / D) + EPS);
#pragma unroll
                for (int q = 0; q < 4; ++q) { const f32x4 h = xf[q] * rstd * gm[64 * q] + sh[64 * q];
                    *(LAS f32x4*)(TILE + (C.wave + NWAVES * rr) * 1028 + 256 * q + 4 * lane) = h;
                    if (rr == 0 || has1) h8[64 * q] = pk4_fp8(h.x, h.y, h.z, h.w); } }
            if (i + 2 * NWAVES < nrows) N2_LOAD(i + 2 * NWAVES);
        } else {
#pragma unroll
            for (int rr = 0; rr < 2; ++rr)
#pragma unroll
                for (int q = 0; q < 4; ++q) *(LAS f32x4*)(TILE + (C.wave + NWAVES * rr) * 1028 + 256 * q + 4 * lane) = (f32x4){0.f, 0.f, 0.f, 0.f};
        }
        __syncthreads();
        f32x4 dacc = (f32x4){0.f, 0.f, 0.f, 0.f};
#pragma unroll
        for (int j = 0; j < 8; ++j) { const f32x4 a = *(const LAS f32x4*)(TILE + fn * 1028 + 128 * C.wave + 32 * kq + 4 * j);
#pragma unroll
            for (int e = 0; e < 4; ++e) dacc = __builtin_amdgcn_mfma_f32_16x16x4f32(a[e], bw[4 * j + e], dacc, 0, 0, 0); }
#pragma unroll
        for (int r = 0; r < 4; ++r) PART[C.wave * 256 + (4 * kq + r) * 16 + fn] = dacc[r];
        __syncthreads();
        if (tid < 256) { float sum = 0.f;
#pragma unroll
            for (int w = 0; w < NWAVES; ++w) sum += PART[w * 256 + tid];
            const int ri = i0 + (tid >> 4); if (ri < nrows) LG[ri * 16 + (tid & 15)] = sum; }
    }
#undef N2_LOAD
    __syncthreads();
    float rb[16];
#pragma unroll
    for (int e = 0; e < 16; ++e) rb[e] = C.in[I_RB][e];
    for (int i = tid; i < nrows; i += 512) {
        float lg[16];
#pragma unroll
        for (int q = 0; q < 4; ++q) { const f32x4 t = *(const LAS f32x4*)(LG + i * 16 + 4 * q); lg[4 * q] = t.x; lg[4 * q + 1] = t.y; lg[4 * q + 2] = t.z; lg[4 * q + 3] = t.w; }
        float mx = lg[0];
#pragma unroll
        for (int e = 1; e < 16; ++e) mx = fmaxf(mx, lg[e]);
        float pr[16], sel[16], sum = 0.f;
#pragma unroll
        for (int e = 0; e < 16; ++e) { pr[e] = __expf(lg[e] - mx); sum += pr[e]; }
        const float rs = 1.f / sum;
#pragma unroll
        for (int e = 0; e < 16; ++e) { pr[e] *= rs; sel[e] = pr[e] + rb[e]; }
        float bestv = -1e30f; int best = 0;
#pragma unroll
        for (int gq = 0; gq < 4; ++gq) { float m1 = -1e30f, m2 = -1e30f;
#pragma unroll
            for (int k = 0; k < 4; ++k) { const float s_ = sel[4 * gq + k]; if (s_ > m1) { m2 = m1; m1 = s_; } else if (s_ > m2) m2 = s_; }
            const float gs = m1 + m2; if (gs > bestv) { bestv = gs; best = gq; } }
        float s4[4], p4[4];
#pragma unroll
        for (int k = 0; k < 4; ++k) { s4[k] = best == 0 ? sel[k] : best == 1 ? sel[4 + k] : best == 2 ? sel[8 + k] : sel[12 + k]; p4[k] = best == 0 ? pr[k] : best == 1 ? pr[4 + k] : best == 2 ? pr[8 + k] : pr[12 + k]; }
        int i0 = 0; float v0 = s4[0], q0 = p4[0];
#pragma unroll
        for (int k = 1; k < 4; ++k) if (s4[k] > v0) { v0 = s4[k]; i0 = k; q0 = p4[k]; }
        int i1 = i0 == 0 ? 1 : 0; float v1 = -1e30f, q1 = p4[i0 == 0 ? 1 : 0];
#pragma unroll
        for (int k = 0; k < 4; ++k) if (k != i0 && s4[k] > v1) { v1 = s4[k]; i1 = k; q1 = p4[k]; }
        const int e0 = 4 * best + i0, e1 = 4 * best + i1; const float wn = 1.f / (q0 + q1);
        const unsigned lp0 = atomicAdd((unsigned*)(LCNT + e0), 1u), lp1 = atomicAdd((unsigned*)(LCNT + e1), 1u);
        REC[i * 4 + 0] = (unsigned)e0 | ((unsigned)e1 << 8) | (lp0 << 16); REC[i * 4 + 1] = lp1; REC[i * 4 + 2] = __float_as_uint(q0 * wn); REC[i * 4 + 3] = __float_as_uint(q1 * wn);
    }
    __syncthreads();
    if (tid < 16) LCNT[16 + tid] = __hip_atomic_fetch_add((unsigned*)(C.ctl + CW_CNT + l * 1024 + 64 * tid), LCNT[tid], RLX_AGENT);
    __syncthreads();
    int* LIST = WSP(int, WS_LIST); float* LWG = WSP(float, WS_LW);
    for (int i = tid; i < nrows; i += 512) { const int m = C.vcu + C.G * i; const unsigned r0 = REC[i * 4], r1 = REC[i * 4 + 1];
        const int e0 = r0 & 255, e1 = (r0 >> 8) & 255; const unsigned lp0 = r0 >> 16, lp1 = r1;
        const size_t p0 = (size_t)e0 * T + LCNT[16 + e0] + lp0, p1 = (size_t)e1 * T + LCNT[16 + e1] + lp1;
        LIST[p0] = 2 * m; LIST[p1] = 2 * m + 1; LWG[p0] = __uint_as_float(REC[i * 4 + 2]); LWG[p1] = __uint_as_float(REC[i * 4 + 3]); }
    __syncthreads();
}
using pg8::Unit;
typedef f32x4 Acc[2][2][4][2];
__device__ __forceinline__ v4u pack8(const f32x4& a, const f32x4& b) { v4u w; w.x = cvt_pk_bf16(a[0], a[1]); w.y = cvt_pk_bf16(a[2], a[3]); w.z = cvt_pk_bf16(b[0], b[1]); w.w = cvt_pk_bf16(b[2], b[3]); return w; }
__device__ __forceinline__ void unpack8(const v4u& w, f32x4& a, f32x4& b) { a = (f32x4){bflo(w.x), bfhi(w.x), bflo(w.y), bfhi(w.y)}; b = (f32x4){bflo(w.z), bfhi(w.z), bflo(w.w), bfhi(w.w)}; }
#ifndef WT_MODE
#define WT_MODE 0
#endif
__device__ __forceinline__ void st16(void* p, const v4u& v) {
#if WT_MODE == 1
    asm volatile("global_store_dwordx4 %0, %1, off sc0 sc1" :: "v"(p), "v"(v) : "memory");
#elif WT_MODE == 2
    asm volatile("global_store_dwordx4 %0, %1, off nt" :: "v"(p), "v"(v) : "memory");
#else
    *(GAS v4u*)p = v;
#endif
}
__device__ __forceinline__ int chunk_m0(int cr) { return (cr / NCH) * LB + (cr % NCH) * 32; }

struct PWin {
    static constexpr bool EARLY_AOFF = false, FP8 = false; unsigned char* ws; int G, c; int K; unsigned kstepA;
    __device__ __forceinline__ bool next(int i, Unit& u) const { const long L = (long)i * G + c; if (L >= NPAN * 11) return false; pg8::static_decode((int)L, NPAN, 11, u.pm, u.pn); u.z = 0; return true; }
    __device__ __forceinline__ const char* a_base(const Unit& u) const { return (const char*)(ws + WS_HB) + (size_t)u.pm * 256 * 1024 * 2; }
    __device__ __forceinline__ unsigned a_off(const Unit&, int h, int R, int Cc) const { return (unsigned)((h * 128 + R) * 1024 + Cc) * 2u; }
    __device__ __forceinline__ const char* b_base(const Unit& u) const { return (const char*)(ws + WS_WIN) + (size_t)u.pn * 256 * 1024 * 2; }
    __device__ __forceinline__ void epi(const Acc& acc, const Unit& u, int wr, int wc, int fr, int fq) const {
        const int row0 = u.pm * 256 + wr * 64 + fr;
#pragma unroll
        for (int bj = 0; bj < 2; ++bj) {
            const int cb = u.pn * 256 + bj * 128; bf16* dst; int ld, col, mode = 0; float sc = 1.f;
            if (cb < 512) { dst = (bf16*)(ws + WS_U) + ((size_t)((cb + wc * 32 + 8 * fq) >> 4) * T) * 16 + ((8 * fq) & 15) - (wc * 32 + 8 * fq); ld = 16; col = 0; }
            else if (cb < 1024) { dst = (bf16*)(ws + WS_QA); ld = 512; col = cb - 512; }
            else if (cb == 1024) { dst = (bf16*)(ws + WS_KA); ld = 128; col = 0; }
            else if (cb == 1152) { dst = (bf16*)(ws + WS_VA); ld = 128; col = 0; }
            else if (cb < 1792) { dst = (bf16*)(ws + WS_QN); ld = 512; col = cb - 1280; sc = C2; }
            else if (cb < 2304) { dst = (bf16*)(ws + WS_KN); ld = 512; col = cb - 1792; }
            else { dst = (bf16*)(ws + WS_VN); ld = 512; col = cb - 2304; }
            const int c0 = col + wc * 32 + 8 * fq;
#pragma unroll
            for (int ai = 0; ai < 2; ++ai)
#pragma unroll
                for (int m = 0; m < 4; ++m) { f32x4 v0 = acc[ai][bj][m][0], v1 = acc[ai][bj][m][1];
                    if (mode) { v0 = (f32x4){fsigmoid(v0[0]), fsigmoid(v0[1]), fsigmoid(v0[2]), fsigmoid(v0[3])}; v1 = (f32x4){fsigmoid(v1[0]), fsigmoid(v1[1]), fsigmoid(v1[2]), fsigmoid(v1[3])}; }
                    else { v0 = v0 * sc; v1 = v1 * sc; }
                    st16(dst + (size_t)(row0 + ai * 128 + m * 16) * ld + c0, pack8(v0, v1)); __builtin_amdgcn_sched_barrier(0); }
        }
    }
};

struct PWin8 {
    static constexpr bool EARLY_AOFF = false, FP8 = true; unsigned char* ws; int G, c; int K; unsigned kstepA;
    __device__ __forceinline__ bool next(int i, Unit& u) const { const long L = (long)i * G + c; if (L >= 2 * NPAN * 23) return false; pg8::static_decode((int)L, 2 * NPAN, 23, u.pm, u.pn); u.z = 0; return true; }
    __device__ __forceinline__ const char* a_base(const Unit& u) const { return (const char*)(ws + WS_HB8) + (size_t)u.pm * 128 * 1024; }
    __device__ __forceinline__ unsigned a_off(const Unit&, int R, int Cc) const { return (unsigned)(R * 1024 + Cc * 2); }
    __device__ __forceinline__ const char* b_base(const Unit& u) const { return (const char*)(ws + WS_WIN) + (size_t)u.pn * 256 * 1024; }
    __device__ __forceinline__ void epi(const f32x4 (&acc)[2][4][2], f32x4 (&)[2][4][2], const Unit& u, int wr, int wc, int fr, int fq) const {
        const int row0 = u.pm * 128 + wr * 64 + fr;
#pragma unroll
        for (int bj = 0; bj < 2; ++bj) {
            const int cb = u.pn * 256 + bj * 128;
            if (cb >= 2816) { const int c0 = cb - 2816 + wc * 32 + 8 * fq;
#pragma unroll
                for (int m = 0; m < 4; ++m) { f32x4 v0 = acc[bj][m][0] * (1.f / 64.f), v1 = acc[bj][m][1] * (1.f / 64.f);
                    v0 = (f32x4){fsigmoid(v0[0]), fsigmoid(v0[1]), fsigmoid(v0[2]), fsigmoid(v0[3])}; v1 = (f32x4){fsigmoid(v1[0]), fsigmoid(v1[1]), fsigmoid(v1[2]), fsigmoid(v1[3])};
                    *(GAS v2u*)((unsigned char*)(ws + WS_GATES) + (size_t)(row0 + m * 16) * 3072 + c0) = (v2u){pk4_fp8(v0[0], v0[1], v0[2], v0[3]), pk4_fp8(v1[0], v1[1], v1[2], v1[3])}; }
            } else {
                bf16* dst; int ld, col; float sc = 1.f / 64.f;
                if (cb < 512) { dst = (bf16*)(ws + WS_U) + ((size_t)((cb + wc * 32 + 8 * fq) >> 4) * T) * 16 + ((8 * fq) & 15) - (wc * 32 + 8 * fq); ld = 16; col = 0; }
                else if (cb < 1024) { dst = (bf16*)(ws + WS_QA); ld = 512; col = cb - 512; }
                else if (cb == 1024) { dst = (bf16*)(ws + WS_KA); ld = 128; col = 0; }
                else if (cb == 1152) { dst = (bf16*)(ws + WS_VA); ld = 128; col = 0; }
                else if (cb < 1792) { dst = (bf16*)(ws + WS_QN); ld = 512; col = cb - 1280; sc = C2 / 64.f; }
                else if (cb < 2304) { dst = (bf16*)(ws + WS_KN); ld = 512; col = cb - 1792; }
                else { dst = (bf16*)(ws + WS_VN); ld = 512; col = cb - 2304; }
                const int c0 = col + wc * 32 + 8 * fq;
#pragma unroll
                for (int m = 0; m < 4; ++m) *(GAS v4u*)(dst + (size_t)(row0 + m * 16) * ld + c0) = pack8(acc[bj][m][0] * sc, acc[bj][m][1] * sc);
            }
        }
    }
};

struct PGate {
    static constexpr bool EARLY_AOFF = false, FP8 = !GATE_BF16; unsigned char* ws; int G, c; int K; unsigned kstepA;
    __device__ __forceinline__ bool next(int i, Unit& u) const { const long L = (long)i * G + c; if (L >= 2 * NPAN * 12) return false; pg8::static_decode((int)L, 2 * NPAN, 12, u.pm, u.pn); u.z = 0; return true; }
    __device__ __forceinline__ const char* a_base(const Unit& u) const { return GATE_BF16 ? (const char*)(ws + WS_HB) + (size_t)u.pm * 128 * 2048 : (const char*)(ws + WS_HB8) + (size_t)u.pm * 128 * 1024; }
    __device__ __forceinline__ unsigned a_off(const Unit&, int R, int Cc) const { return GATE_BF16 ? (unsigned)(R * 2048 + Cc * 2) : (unsigned)(R * 1024 + Cc * 2); }
    __device__ __forceinline__ const char* b_base(const Unit& u) const { return GATE_BF16 ? (const char*)(ws + WS_WIN) + (size_t)(2816 + u.pn * 256) * 2048 : (const char*)(ws + WS_WIN8) + (size_t)u.pn * 256 * 1024; }
    __device__ __forceinline__ void epi(const f32x4 (&acc)[2][4][2], f32x4 (&)[2][4][2], const Unit& u, int wr, int wc, int fr, int fq) const {
#pragma unroll
        for (int m = 0; m < 4; ++m) { const size_t r = (size_t)(u.pm * 128 + wr * 64 + m * 16 + fr);
#pragma unroll
            for (int bj = 0; bj < 2; ++bj) { const int c0 = u.pn * 256 + bj * 128 + wc * 32 + 8 * fq; f32x4 v0 = acc[bj][m][0] * (GATE_BF16 ? 1.f : 1.f / 64.f), v1 = acc[bj][m][1] * (GATE_BF16 ? 1.f : 1.f / 64.f);
                v0 = (f32x4){fsigmoid(v0[0]), fsigmoid(v0[1]), fsigmoid(v0[2]), fsigmoid(v0[3])}; v1 = (f32x4){fsigmoid(v1[0]), fsigmoid(v1[1]), fsigmoid(v1[2]), fsigmoid(v1[3])};
                if (GATE_BF16) *(GAS v4u*)((bf16*)(ws + WS_GATES) + r * 3072 + c0) = pack8(v0, v1);
                else *(GAS v2u*)((unsigned char*)(ws + WS_GATES) + r * 3072 + c0) = (v2u){pk4_fp8(v0[0], v0[1], v0[2], v0[3]), pk4_fp8(v1[0], v1[1], v1[2], v1[3])}; }
            __builtin_amdgcn_sched_barrier(0); }
    }
};

struct PS5A {
    static constexpr bool EARLY_AOFF = false, FP8 = false; unsigned char* ws; int G, c; int K; unsigned kstepA;
    __device__ __forceinline__ bool next(int i, Unit& u) const { const long L = (long)i * G + c; if (L >= 32 * 15) return false; const int l = (int)L; u.z = l / 15; const int r = l % 15; u.pm = r / 3; u.pn = r % 3; return true; }
    __device__ __forceinline__ const char* a_base(const Unit& u) const { return (const char*)(ws + WS_U) + (size_t)u.z * T * 32; }
    __device__ __forceinline__ unsigned a_off(const Unit& u, int h, int R, int Cc) const { int cr = u.pm * 256 + h * 128 + R; cr = cr < NCR ? cr : NCR - 1; return (unsigned)(cr * 512 + Cc) * 2u; }
    __device__ __forceinline__ const char* b_base(const Unit& u) const { return (const char*)(ws + WS_BT1) + ((size_t)u.z * 768 + u.pn * 256) * 512 * 2; }
    __device__ __forceinline__ void epi(const Acc& acc, const Unit& u, int wr, int wc, int fr, int fq) const {
#pragma unroll
        for (int ai = 0; ai < 2; ++ai)
#pragma unroll
            for (int m = 0; m < 4; ++m) { const int cr = u.pm * 256 + ai * 128 + wr * 64 + m * 16 + fr; if (cr >= NCR) continue;
#pragma unroll
                for (int bj = 0; bj < 2; ++bj) { const int n = bj * 128 + wc * 32 + 8 * fq;
                    if (u.pn < 2) *(GAS v4u*)((bf16*)(ws + WS_YG) + (size_t)u.z * T * 16 + (size_t)cr * 512 + u.pn * 256 + n) = pack8(acc[ai][bj][m][0], acc[ai][bj][m][1]);
                    else { GAS f32x4* o = (GAS f32x4*)((float*)(ws + WS_SST) + (size_t)cr * 8192 + u.z * 256 + n); o[0] = acc[ai][bj][m][0]; o[1] = acc[ai][bj][m][1]; } }
                __builtin_amdgcn_sched_barrier(0); }
    }
};

struct PS5B {
    static constexpr bool EARLY_AOFF = false, FP8 = false; unsigned char* ws; int G, c; int K; unsigned kstepA;
    __device__ __forceinline__ bool next(int i, Unit& u) const { const long L = (long)i * G + c; if (L >= 32 * 10) return false; const int l = (int)L; u.z = l / 10; const int r = l % 10; u.pm = r / 2; u.pn = r % 2; return true; }
    __device__ __forceinline__ const char* a_base(const Unit& u) const { return (const char*)(ws + WS_XST) + (size_t)u.z * 512; }
    __device__ __forceinline__ unsigned a_off(const Unit& u, int h, int R, int Cc) const { int cr = u.pm * 256 + h * 128 + R; cr = cr < NCR ? cr : NCR - 1; return (unsigned)(cr * 8192 + Cc) * 2u; }
    __device__ __forceinline__ const char* b_base(const Unit& u) const { return (const char*)(ws + WS_BT2) + ((size_t)u.z * 512 + u.pn * 256) * 256 * 2; }
    __device__ __forceinline__ void epi(const Acc& acc, const Unit& u, int wr, int wc, int fr, int fq) const {
#pragma unroll
        for (int ai = 0; ai < 2; ++ai) {
            v4u yw[4][2];
#pragma unroll
            for (int m = 0; m < 4; ++m) { int cr = u.pm * 256 + ai * 128 + wr * 64 + m * 16 + fr; cr = cr < NCR ? cr : NCR - 1;
#pragma unroll
                for (int bj = 0; bj < 2; ++bj) yw[m][bj] = *(const GAS v4u*)((const bf16*)(ws + WS_YG) + (size_t)u.z * T * 16 + (size_t)cr * 512 + u.pn * 256 + bj * 128 + wc * 32 + 8 * fq); }
#pragma unroll
            for (int m = 0; m < 4; ++m) { const int cr = u.pm * 256 + ai * 128 + wr * 64 + m * 16 + fr; if (cr >= NCR) continue;
#pragma unroll
                for (int bj = 0; bj < 2; ++bj) { const int nn = u.pn * 256 + bj * 128 + wc * 32 + 8 * fq, t = nn >> 4, h0 = nn & 15;
                    GAS v4u* p = (GAS v4u*)((bf16*)(ws + WS_YS) + (size_t)(chunk_m0(cr) + t) * 512 + u.z * 16 + h0);
                    f32x4 y0, y1; { const v4u w_ = yw[m][bj]; unpack8(w_, y0, y1); } y0 += acc[ai][bj][m][0]; y1 += acc[ai][bj][m][1];
                    y0 = (f32x4){gelu_tanh(y0[0]), gelu_tanh(y0[1]), gelu_tanh(y0[2]), gelu_tanh(y0[3])}; y1 = (f32x4){gelu_tanh(y1[0]), gelu_tanh(y1[1]), gelu_tanh(y1[2]), gelu_tanh(y1[3])};
                    *p = pack8(y0, y1); } } }
    }
};

__device__ __forceinline__ int half_panel(int hl, bool lat_only) { if (!lat_only) return hl; const int pl = hl >> 1; return 2 * (pl + (pl >> 5) + 1) + (hl & 1); }
struct PGlu {
    static constexpr bool EARLY_AOFF = false, FP8 = false; unsigned char* ws; int G, c; int K; unsigned kstepA; bool lat_only;
    __device__ __forceinline__ bool next(int i, Unit& u) const { const int nH = lat_only ? 256 : 2 * NPAN; const long L = (long)i * G + c; if (L >= nH * 2) return false; pg8::static_decode((int)L, nH, 2, u.pm, u.pn); u.pm = half_panel(u.pm, lat_only); u.z = 0; return true; }
    __device__ __forceinline__ const char* a_base(const Unit& u) const { return (const char*)(ws + WS_YS) + (size_t)u.pm * 128 * 512 * 2; }
    __device__ __forceinline__ unsigned a_off(const Unit&, int R, int Cc) const { return (unsigned)(R * 512 + Cc) * 2u; }
    __device__ __forceinline__ const char* b_base(const Unit& u) const { return (const char*)(ws + WS_WGLU) + (size_t)u.pn * 256 * 512 * 2; }
    __device__ __forceinline__ void epi(const f32x4 (&acc)[2][4][2], f32x4 (&)[2][4][2], const Unit& u, int wr, int wc, int fr, int fq) const {
        v4u zw[4][2];
#pragma unroll
        for (int m = 0; m < 4; ++m)
#pragma unroll
            for (int bj = 0; bj < 2; ++bj) zw[m][bj] = *(const GAS v4u*)((const bf16*)(ws + WS_YS) + (size_t)(u.pm * 128 + wr * 64 + m * 16 + fr) * 512 + u.pn * 256 + bj * 128 + wc * 32 + 8 * fq);
#pragma unroll
        for (int m = 0; m < 4; ++m) { const size_t r = (size_t)(u.pm * 128 + wr * 64 + m * 16 + fr);
#pragma unroll
            for (int bj = 0; bj < 2; ++bj) { const int cc = u.pn * 256 + bj * 128 + wc * 32 + 8 * fq;
                f32x4 z0, z1; { const v4u w_ = zw[m][bj]; unpack8(w_, z0, z1); } const f32x4 a0 = acc[bj][m][0], a1 = acc[bj][m][1];
                z0 = z0 * (f32x4){fsigmoid(a0[0]), fsigmoid(a0[1]), fsigmoid(a0[2]), fsigmoid(a0[3])}; z1 = z1 * (f32x4){fsigmoid(a1[0]), fsigmoid(a1[1]), fsigmoid(a1[2]), fsigmoid(a1[3])};
                *(GAS v4u*)((bf16*)(ws + WS_U) + r * 512 + cc) = pack8(z0, z1); } }
    }
};

typedef f32x4 Acc128[2][4][2];
struct PMerge {
    static constexpr bool EARLY_AOFF = false, FP8 = false; unsigned char* ws; int G, c; int K; unsigned kstepA; bool lat_only;
    __device__ __forceinline__ bool next(int i, Unit& u) const { const int nH = lat_only ? 256 : 2 * NPAN; const long tile = (long)(i / 3) * G + c; if (tile >= nH * 4) return false; pg8::static_decode((int)tile, nH, 4, u.pm, u.pn); u.pm = half_panel(u.pm, lat_only); u.z = i % 3; return true; }
    __device__ __forceinline__ const char* a_base(const Unit& u) const { const size_t off = u.z == 0 ? WS_U : (u.z == 1 ? WS_AO : WS_NO); return (const char*)(ws + off) + (size_t)u.pm * 128 * 512 * 2; }
    __device__ __forceinline__ unsigned a_off(const Unit&, int R, int Cc) const { return (unsigned)(R * 512 + Cc) * 2u; }
    __device__ __forceinline__ const char* b_base(const Unit& u) const { return (const char*)(ws + WS_WBR) + ((size_t)u.z * 1024 + u.pn * 256) * 512 * 2; }
    __device__ __forceinline__ void epi(const Acc128& acc, Acc128& mrg, const Unit& u, int wr, int wc, int fr, int fq) const {
        v2u gw[4][2];
#pragma unroll
        for (int m = 0; m < 4; ++m)
#pragma unroll
            for (int bj = 0; bj < 2; ++bj) gw[m][bj] = *(const GAS v2u*)((const unsigned char*)(ws + WS_GATES) + (size_t)(u.pm * 128 + wr * 64 + m * 16 + fr) * 3072 + u.z * 1024 + u.pn * 256 + bj * 128 + wc * 32 + 8 * fq);
#pragma unroll
        for (int m = 0; m < 4; ++m) { const size_t r = (size_t)(u.pm * 128 + wr * 64 + m * 16 + fr);
#pragma unroll
            for (int bj = 0; bj < 2; ++bj) { const int cc = u.pn * 256 + bj * 128 + wc * 32 + 8 * fq; const v2u w_ = gw[m][bj];
                const f32x4 g0 = (f32x4){__builtin_amdgcn_cvt_f32_fp8((int)w_.x, 0), __builtin_amdgcn_cvt_f32_fp8((int)w_.x, 1), __builtin_amdgcn_cvt_f32_fp8((int)w_.x, 2), __builtin_amdgcn_cvt_f32_fp8((int)w_.x, 3)};
                const f32x4 g1 = (f32x4){__builtin_amdgcn_cvt_f32_fp8((int)w_.y, 0), __builtin_amdgcn_cvt_f32_fp8((int)w_.y, 1), __builtin_amdgcn_cvt_f32_fp8((int)w_.y, 2), __builtin_amdgcn_cvt_f32_fp8((int)w_.y, 3)};
                if (u.z == 0) { mrg[bj][m][0] = g0 * acc[bj][m][0]; mrg[bj][m][1] = g1 * acc[bj][m][1]; }
                else { mrg[bj][m][0] += g0 * acc[bj][m][0]; mrg[bj][m][1] += g1 * acc[bj][m][1]; }
                if (u.z == 2) *(GAS v4u*)((bf16*)(ws + WS_HB) + r * 1024 + cc) = pack8(mrg[bj][m][0], mrg[bj][m][1]); } }
    }
};

struct PWout {
    static constexpr bool EARLY_AOFF = false, FP8 = false; unsigned char* ws; float* out; const float* mod; int G, c; int K; unsigned kstepA; bool lat_only; size_t wofs;
    __device__ __forceinline__ bool next(int i, Unit& u) const { const int nH = lat_only ? 256 : 2 * NPAN; const long L = (long)i * G + c; if (L >= nH * 4) return false; pg8::static_decode((int)L, nH, 4, u.pm, u.pn); u.pm = half_panel(u.pm, lat_only); u.z = 0; return true; }
    __device__ __forceinline__ const char* a_base(const Unit& u) const { return (const char*)(ws + WS_HB) + (size_t)u.pm * 128 * 1024 * 2; }
    __device__ __forceinline__ unsigned a_off(const Unit&, int R, int Cc) const { return (unsigned)(R * 1024 + Cc) * 2u; }
    __device__ __forceinline__ const char* b_base(const Unit& u) const { return (const char*)(ws + wofs) + (size_t)u.pn * 256 * 1024 * 2; }
    __device__ __forceinline__ void epi(const f32x4 (&acc)[2][4][2], f32x4 (&)[2][4][2], const Unit& u, int wr, int wc, int fr, int fq) const {
        const int pm = u.pm >> 1, b = pm / 33, pr = pm % 33, cond = pr == 0 ? 4 : b;
        bf16* xb = (bf16*)(ws + WS_XS) + (size_t)u.pm * 128 * D;
        const float* g1 = mod + cond * 6144 + 2048;
        v4u xv[2][4];
#pragma unroll
        for (int bj = 0; bj < 2; ++bj)
#pragma unroll
            for (int m = 0; m < 4; ++m) xv[bj][m] = *(const GAS v4u*)(xb + (size_t)(wr * 64 + m * 16 + fr) * D + u.pn * 256 + bj * 128 + wc * 32 + 8 * fq);
#pragma unroll
        for (int bj = 0; bj < 2; ++bj) { const int cc = u.pn * 256 + bj * 128 + wc * 32 + 8 * fq; const f32x4 ga = *(const GAS f32x4*)(g1 + cc), gb = *(const GAS f32x4*)(g1 + cc + 4);
#pragma unroll
            for (int m = 0; m < 4; ++m) { f32x4 x0, x1; { const v4u w_ = xv[bj][m]; unpack8(w_, x0, x1); }
                *(GAS v4u*)(xb + (size_t)(wr * 64 + m * 16 + fr) * D + cc) = pack8(x0 + ga * acc[bj][m][0], x1 + gb * acc[bj][m][1]); } }
    }
};

struct ExpTab { int cnt[16], tile0[17]; };
__device__ __forceinline__ int exp_find(const int (&tile0)[17], int q) { int e = 0;
#pragma unroll
    for (int k = 1; k < 16; ++k) e += (q >= tile0[k]) ? 1 : 0;
    return e; }

struct PMoe1 {
    static constexpr bool EARLY_AOFF = true, FP8 = true; unsigned char* ws; const LAS int* tab; int G, c; int K; unsigned kstepA; size_t wofs;
    __device__ __forceinline__ bool next(int i, Unit& u) const { const long L = (long)i * G + c; const int total = __builtin_amdgcn_readfirstlane(tab[32]) * 4; if (L >= total) return false; const int q = (int)L >> 2; u.pn = (int)L & 3;
        int e = 0;
#pragma unroll
        for (int k = 1; k < 16; ++k) e += (q >= __builtin_amdgcn_readfirstlane(tab[16 + k])) ? 1 : 0;
        u.z = e; u.pm = q - __builtin_amdgcn_readfirstlane(tab[16 + e]); return true; }
    __device__ __forceinline__ const char* a_base(const Unit&) const { return (const char*)(ws + WS_HB8); }
    __device__ __forceinline__ unsigned a_off(const Unit& u, int R, int Cc) const { int r = u.pm * 128 + R; const int n = __builtin_amdgcn_readfirstlane(tab[u.z]); r = r < n ? r : n - 1;
        const int ent = ((const int*)(ws + WS_LIST))[(size_t)u.z * T + r]; return (unsigned)((ent >> 1) * 1024 + Cc * 2); }
    __device__ __forceinline__ const char* b_base(const Unit& u) const { return (const char*)(ws + wofs) + ((size_t)u.z * 1024 + u.pn * 256) * 1024; }
    __device__ __forceinline__ void epi(const f32x4 (&acc)[2][4][2], f32x4 (&)[2][4][2], const Unit& u, int wr, int wc, int fr, int fq) const {
        const size_t arow0 = (size_t)(__builtin_amdgcn_readfirstlane(tab[16 + u.z]) + u.pm) * 128;
#pragma unroll
        for (int m = 0; m < 4; ++m) { const f32x4 g0 = acc[0][m][0] * (1.f / 64.f), g1 = acc[0][m][1] * (1.f / 64.f), u0 = acc[1][m][0] * (8.f / 64.f), u1 = acc[1][m][1] * (8.f / 64.f);
            const f32x4 v0 = (f32x4){g0[0] * fsigmoid(g0[0]), g0[1] * fsigmoid(g0[1]), g0[2] * fsigmoid(g0[2]), g0[3] * fsigmoid(g0[3])} * u0;
            const f32x4 v1 = (f32x4){g1[0] * fsigmoid(g1[0]), g1[1] * fsigmoid(g1[1]), g1[2] * fsigmoid(g1[2]), g1[3] * fsigmoid(g1[3])} * u1;
            *(GAS v2u*)((unsigned char*)(ws + WS_ACT) + (arow0 + wr * 64 + m * 16 + fr) * 512 + u.pn * 128 + wc * 32 + 8 * fq) = (v2u){pk4_fp8(v0[0], v0[1], v0[2], v0[3]), pk4_fp8(v1[0], v1[1], v1[2], v1[3])}; }
    }
};
struct PMoe2 {
    static constexpr bool EARLY_AOFF = false, FP8 = true; unsigned char* ws; const LAS int* tab; int G, c; int K; unsigned kstepA; size_t wofs;
    __device__ __forceinline__ bool next(int i, Unit& u) const { const long L = (long)i * G + c; const int total = __builtin_amdgcn_readfirstlane(tab[32]) * 4; if (L >= total) return false; const int q = (int)L >> 2; u.pn = (int)L & 3;
        int e = 0;
#pragma unroll
        for (int k = 1; k < 16; ++k) e += (q >= __builtin_amdgcn_readfirstlane(tab[16 + k])) ? 1 : 0;
        u.z = e; u.pm = q - __builtin_amdgcn_readfirstlane(tab[16 + e]); return true; }
    __device__ __forceinline__ const char* a_base(const Unit& u) const { return (const char*)(ws + WS_ACT) + (size_t)(__builtin_amdgcn_readfirstlane(tab[16 + u.z]) + u.pm) * 128 * 512; }
    __device__ __forceinline__ unsigned a_off(const Unit&, int R, int Cc) const { return (unsigned)(R * 512 + Cc * 2); }
    __device__ __forceinline__ const char* b_base(const Unit& u) const { return (const char*)(ws + wofs) + ((size_t)u.z * 1024 + u.pn * 256) * 512; }
    __device__ __forceinline__ void epi(const f32x4 (&acc)[2][4][2], f32x4 (&)[2][4][2], const Unit& u, int wr, int wc, int fr, int fq) const {
        const int n = __builtin_amdgcn_readfirstlane(tab[u.z]);
        int entv[4]; float wv[4];
#pragma unroll
        for (int m = 0; m < 4; ++m) { int r = u.pm * 128 + wr * 64 + m * 16 + fr; r = r < n ? r : n - 1; entv[m] = ((const int*)(ws + WS_LIST))[(size_t)u.z * T + r]; wv[m] = ((const float*)(ws + WS_LW))[(size_t)u.z * T + r] * (1.f / 256.f); }
#pragma unroll
        for (int m = 0; m < 4; ++m) { const int r = u.pm * 128 + wr * 64 + m * 16 + fr; if (r >= n) continue;
            const int ent = entv[m]; const float w = wv[m];
#pragma unroll
            for (int bj = 0; bj < 2; ++bj)
                *(GAS v4u*)((bf16*)(ws + WS_YSLOT) + (size_t)ent * 1024 + u.pn * 256 + bj * 128 + wc * 32 + 8 * fq) = pack8(acc[bj][m][0] * w, acc[bj][m][1] * w); }
    }
};
struct PMoe1B {
    static constexpr bool EARLY_AOFF = true, FP8 = false; unsigned char* ws; const LAS int* tab; int G, c; int K; unsigned kstepA;
    __device__ __forceinline__ bool next(int i, Unit& u) const { const long L = (long)i * G + c; const int total = tab[32] * 4; if (L >= total) return false; const int q = (int)L >> 2; u.pn = (int)L & 3;
        int e = 0;
#pragma unroll
        for (int k = 1; k < 16; ++k) e += (q >= tab[16 + k]) ? 1 : 0;
        u.z = e; u.pm = q - tab[16 + e]; return true; }
    __device__ __forceinline__ const char* a_base(const Unit&) const { return (const char*)(ws + WS_HB); }
    __device__ __forceinline__ unsigned a_off(const Unit& u, int h, int R, int Cc) const { int r = u.pm * 256 + h * 128 + R; const int n = tab[u.z]; r = r < n ? r : n - 1;
        const int ent = ((const int*)(ws + WS_LIST))[(size_t)u.z * T + r]; return (unsigned)((ent >> 1) * 1024 + Cc) * 2u; }
    __device__ __forceinline__ const char* b_base(const Unit& u) const { return (const char*)(ws + WS_MOE1) + ((size_t)u.z * 1024 + u.pn * 256) * 1024 * 2; }
    __device__ __forceinline__ void epi(const Acc& acc, const Unit& u, int wr, int wc, int fr, int fq) const {
        const size_t arow0 = (size_t)(tab[16 + u.z] + u.pm) * 256;
#pragma unroll
        for (int ai = 0; ai < 2; ++ai)
#pragma unroll
            for (int m = 0; m < 4; ++m) { const f32x4 g0 = acc[ai][0][m][0], g1 = acc[ai][0][m][1], u0 = acc[ai][1][m][0], u1 = acc[ai][1][m][1];
                const f32x4 v0 = (f32x4){g0[0] * fsigmoid(g0[0]), g0[1] * fsigmoid(g0[1]), g0[2] * fsigmoid(g0[2]), g0[3] * fsigmoid(g0[3])} * u0;
                const f32x4 v1 = (f32x4){g1[0] * fsigmoid(g1[0]), g1[1] * fsigmoid(g1[1]), g1[2] * fsigmoid(g1[2]), g1[3] * fsigmoid(g1[3])} * u1;
                *(GAS v4u*)((bf16*)(ws + WS_ACTB) + (arow0 + ai * 128 + wr * 64 + m * 16 + fr) * 512 + u.pn * 128 + wc * 32 + 8 * fq) = pack8(v0, v1); }
    }
};
struct PMoe2B {
    static constexpr bool EARLY_AOFF = false, FP8 = false; unsigned char* ws; const LAS int* tab; int G, c; int K; unsigned kstepA;
    __device__ __forceinline__ bool next(int i, Unit& u) const { const long L = (long)i * G + c; const int total = tab[32] * 4; if (L >= total) return false; const int q = (int)L >> 2; u.pn = (int)L & 3;
        int e = 0;
#pragma unroll
        for (int k = 1; k < 16; ++k) e += (q >= tab[16 + k]) ? 1 : 0;
        u.z = e; u.pm = q - tab[16 + e]; return true; }
    __device__ __forceinline__ const char* a_base(const Unit& u) const { return (const char*)(ws + WS_ACTB) + (size_t)(tab[16 + u.z] + u.pm) * 256 * 512 * 2; }
    __device__ __forceinline__ unsigned a_off(const Unit&, int h, int R, int Cc) const { return (unsigned)((h * 128 + R) * 512 + Cc) * 2u; }
    __device__ __forceinline__ const char* b_base(const Unit& u) const { return (const char*)(ws + WS_MOE2) + ((size_t)u.z * 1024 + u.pn * 256) * 512 * 2; }
    __device__ __forceinline__ void epi(const Acc& acc, const Unit& u, int wr, int wc, int fr, int fq) const {
        const int n = tab[u.z];
#pragma unroll
        for (int ai = 0; ai < 2; ++ai)
#pragma unroll
            for (int m = 0; m < 4; ++m) { const int r = u.pm * 256 + ai * 128 + wr * 64 + m * 16 + fr; if (r >= n) continue;
                const int ent = ((const int*)(ws + WS_LIST))[(size_t)u.z * T + r]; const float w = ((const float*)(ws + WS_LW))[(size_t)u.z * T + r];
#pragma unroll
                for (int bj = 0; bj < 2; ++bj)
                    *(GAS v4u*)((bf16*)(ws + WS_YSLOT) + (size_t)ent * 1024 + u.pn * 256 + bj * 128 + wc * 32 + 8 * fq) = pack8(acc[ai][bj][m][0] * w, acc[ai][bj][m][1] * w); }
    }
};
__device__ __forceinline__ void build_exptab(const Ctx& C, LAS int* tab, int l, int tsh = 7) {
    __syncthreads();
    if (threadIdx.x == 0) { int t0 = 0;
        for (int e = 0; e < 16; ++e) { const int n = (int)__hip_atomic_load((unsigned*)(C.ctl + CW_CNT + l * 1024 + 64 * e), RLX_AGENT); tab[e] = n; tab[16 + e] = t0; t0 += (n + (1 << tsh) - 1) >> tsh; }
        tab[32] = t0; }
    __syncthreads();
}
__device__ __forceinline__ void phase_attn(const Ctx& C, int l, unsigned char* lds_gen) {
    phase_carry(C, l);
    char* shm = (char*)lds_gen;
    bf16* QA = WSP(bf16, WS_QA); bf16* KA = WSP(bf16, WS_KA); bf16* VA = WSP(bf16, WS_VA); bf16* QN = WSP(bf16, WS_QN); bf16* KN = WSP(bf16, WS_KN); bf16* VN = WSP(bf16, WS_VN);
#ifndef ATTN_SEL
#define ATTN_SEL 3
#endif
#ifdef REPMASK
#define REPMASK_ REPMASK
#else
#define REPMASK_ 0
#endif
    const int per = (1024 + C.G - 1) / C.G;
    bool nomax; { float gq = 0.f, gk = 0.f; for (int i = 0; i < 64; ++i) { gq = fmaxf(gq, fabsf(C.in[I_QNG][l * 64 + i])); gk = fmaxf(gk, fabsf(C.in[I_KNG][l * 64 + i])); } nomax = 64.f * gq * gk * C2 <= 60.f; }
    if (ATTN_SEL & 1) for (int i = 0; i < per * (1 + ((REPMASK_ >> 13) & 1)); ++i) { const int id = C.vcu * per + (i % per); if (id >= 1024) continue; const int bh = id >> 5, b = bh >> 3, h = bh & 7, qb = id & 31;
        const bf16* Qu = QA + (size_t)(b * LB + CTX + qb * 256) * 512 + h * 64;
        if (nomax) attn_body::attn_unit<8, false, 512, 128, true>(Qu, 512, KA + (size_t)(b * LB) * 128 + (h >> 2) * 64, VA + (size_t)(b * LB) * 128 + (h >> 2) * 64, 128, WSP(bf16, WS_AO) + (Qu - QA), LB / 64, 0, 0, shm);
        else attn_body::attn_unit<8, false, 512, 128, false>(Qu, 512, KA + (size_t)(b * LB) * 128 + (h >> 2) * 64, VA + (size_t)(b * LB) * 128 + (h >> 2) * 64, 128, WSP(bf16, WS_AO) + (Qu - QA), LB / 64, 0, 0, shm);
    }
    LAS float* bt = (LAS float*)(C.lds + attn_body::LDS_BT);
    const int nctx = (C.vcu >= 64 && C.vcu < 128) ? 1 : 0;
    if (ATTN_SEL & 2) for (int i0 = 0; i0 < (per + nctx) * (1 + ((REPMASK_ >> 14) & 1)); ++i0) { const int i = i0 % (per + nctx);
        const bf16 *Qu, *Kh, *Vh; bf16* Ou; int kvp = 512, NT = 4, r0 = 0, rlo = 0;
        if (i < per) { const int id = C.vcu * per + i; if (id >= 1024) continue; const int bh = id >> 5, b = bh >> 3, h = bh & 7; r0 = (id & 31) * 4;
            const float* rp = C.in[I_RPB] + (size_t)(l * 8 + h) * 465;
            for (int k = C.tid; k < 465; k += 512) bt[k] = rp[k] * LOG2E;
            rlo = r0 - 4 < 0 ? 0 : (r0 - 4 > 120 ? 120 : r0 - 4); const int rh_ = r0 - 1 < 0 ? 0 : (r0 - 1 > 120 ? 120 : r0 - 1), nloc = rh_ + 8 - rlo; NT = (4 + nloc + 1) & ~1;
            Qu = QN + (size_t)(b * LB + CTX + r0 * 64) * 512 + h * 64; Ou = WSP(bf16, WS_NO) + (Qu - QN); Kh = KN + (size_t)(b * LB) * 512 + h * 64; Vh = VN + (size_t)(b * LB) * 512 + h * 64; }
        else { int j = C.vcu - 64; if (j < 32) { const int b = j >> 3, h = j & 7; Qu = QA + (size_t)(b * LB) * 512 + h * 64; Ou = WSP(bf16, WS_AO) + (Qu - QA); Kh = KA + (size_t)(b * LB) * 128 + (h >> 2) * 64; Vh = VA + (size_t)(b * LB) * 128 + (h >> 2) * 64; kvp = 128; }
            else { j -= 32; const int b = j >> 3, h = j & 7; Qu = QN + (size_t)(b * LB) * 512 + h * 64; Ou = WSP(bf16, WS_NO) + (Qu - QN); Kh = KN + (size_t)(b * LB) * 512 + h * 64; Vh = VN + (size_t)(b * LB) * 512 + h * 64; } }
        attn_body::attn_unit<8, true, 512, 0>(Qu, 512, Kh, Vh, kvp, Ou, NT, r0, rlo, shm);
    }
}

constexpr int NPH = 46;
__global__ void __launch_bounds__(NWAVES * 64, 2) fwd(Args args) {
    extern __shared__ __attribute__((aligned(16))) unsigned char lds[];
    Ctx C; C.in = (const __attribute__((address_space(4))) CFP*)__builtin_amdgcn_kernarg_segment_ptr(); C.out = args.out; C.ws = args.ws; C.lds = (LAS unsigned char*)lds; C.ctl = (gu32*)(args.ws + WS_CTL);
    C.tid = 0; C.lane = 0; C.wave = __builtin_amdgcn_readfirstlane((int)threadIdx.x >> 6);
    C.G = gridDim.x; { const int bx = blockIdx.x; C.vcu = (C.G % 8 == 0) ? (bx % 8) * (C.G / 8) + bx / 8 : bx; }
    for (int u = threadIdx.x; u < (LDS_BYTES - LDSCTL_OFF) / 4; u += NWAVES * 64) ((LAS unsigned*)(C.lds + LDSCTL_OFF))[u] = 0u;
    __syncthreads();
    const int lo = args.ph_lo, hi = args.ph_hi;
    XcdBarrier bar; bar.bar = (unsigned*)(C.ctl + CW_BAR); bar.x = 0; bar.st = nullptr;
    if (hi - lo > 1) bar = xcd_barrier_post((unsigned*)(C.ctl + CW_BAR), (volatile LAS unsigned*)(C.lds + MISC_OFF) + 8);
    LAS int* tab = (LAS int*)(C.lds + LDSCTL_OFF);
    const int cg = (int)blockIdx.x;
#ifndef PHMASK
#define PHMASK 0xFFFF
#endif
#define IN(k) (lo <= (k) && (k) < hi)
#define EN(b) ((PHMASK >> (b)) & 1)
#ifndef REPMASK
#define REPMASK 0
#endif
#define RUN(b, stmt) do { stmt; if ((REPMASK >> (b)) & 1) { stmt; } } while (0)
#ifdef DIAG_SEL
#define DIAG_ACC(ty) do { if (blockIdx.x == 0 && threadIdx.x == 0) { volatile LAS unsigned* dg = (volatile LAS unsigned*)(C.lds + LDSCTL_OFF + 160); const unsigned now = (unsigned)__builtin_amdgcn_s_memrealtime(); dg[8 + (ty)] += now - dg[0]; dg[0] = now; } } while (0)
#else
#define DIAG_ACC(ty) do {} while (0)
#endif
#define SEAM(k) do { if (IN(k) && IN((k) + 1)) xcd_barrier(bar); DIAG_ACC((k) == 0 ? 11 : ((k) - 1) % 11); } while (0)
#define LWS() ({ const __attribute__((address_space(4))) CFP* k_ = C.in; asm volatile("" : "+s"(k_)); (unsigned char*)k_[30]; })
#define LC() ({ Ctx c_ = C; c_.tid = threadIdx.x; asm volatile("" : "+v"(c_.tid)); c_.lane = c_.tid & 63; asm volatile("" : "+s"(c_.in)); c_.ws = (unsigned char*)c_.in[30]; c_.out = (float*)c_.in[29]; c_.ctl = (gu32*)(c_.ws + WS_CTL); c_; })
#ifdef DIAG_SEL
    if (blockIdx.x == 0 && threadIdx.x == 0) { volatile LAS unsigned* dg = (volatile LAS unsigned*)(C.lds + LDSCTL_OFF + 160); dg[0] = (unsigned)__builtin_amdgcn_s_memrealtime(); dg[1] = dg[0]; }
#endif
    if (EN(11) && IN(0)) { const Ctx Cl = LC(); phase_mod(Cl); RUN(11, phase_s5mats(Cl, 0, Cl.vcu); phase_weights(Cl, 0, Cl.vcu, Cl.G)); }
    SEAM(0);
    for (int l = 0; l < NLAYER; ++l) {
        const int pb = 1 + 11 * l;
        if (EN(0) && IN(pb)) { const Ctx Cl = LC(); if (l == 0) phase_rows<0>(Cl, 0); else phase_rows<1>(Cl, l); }
        SEAM(pb);
        if (EN(1) && IN(pb + 1)) { if (W8_ALL) { PWin8 P{LWS(), C.G, cg, 1024, 128u}; pg8::gemm_phase_m128(C.lds, P); } else { { PWin P{LWS(), C.G, cg, 1024, 128u}; pg8::gemm_phase(C.lds, P); } { PGate P{LWS(), C.G, cg, 1024, 128u}; pg8::gemm_phase_m128(C.lds, P); } } }
        SEAM(pb + 1);
        if (EN(2) && IN(pb + 2)) { { const Ctx Cl = LC(); phase_qkprep(Cl, l); } PS5A P{LWS(), C.G, cg, 512, 128u}; RUN(2, pg8::gemm_phase(C.lds, P)); }
        SEAM(pb + 2);
        if (EN(3) && IN(pb + 3)) { const Ctx Cl = LC(); RUN(3, phase_attn(Cl, l, lds)); }
        SEAM(pb + 3);
        if (EN(4) && IN(pb + 4)) { PS5B P{LWS(), C.G, cg, 256, 128u}; pg8::gemm_phase(C.lds, P); }
        SEAM(pb + 4);
        if (EN(5) && IN(pb + 5)) { PGlu P{LWS(), C.G, cg, 512, 128u, l == NLAYER - 1}; pg8::gemm_phase_m128(C.lds, P); }
        SEAM(pb + 5);
        if (EN(6) && IN(pb + 6)) { { PMerge P{LWS(), C.G, cg, 512, 128u, l == NLAYER - 1}; pg8::gemm_phase_m128(C.lds, P); }
            if (l < NLAYER - 1) { const Ctx Cl = LC(); phase_s5mats(Cl, l + 1, C.G >= 160 ? cg - 32 : cg); } }
        SEAM(pb + 6);
        if (EN(7) && IN(pb + 7)) { unsigned char* wl_ = LWS(); { PWout P{wl_, (float*)C.in[29], (const float*)(wl_ + WS_MOD) + (size_t)l * 5 * 6144, C.G, cg, 1024, 128u, l == NLAYER - 1, wout_off(l)}; pg8::gemm_phase_m128(C.lds, P); }
            if (l < NLAYER - 1) { const Ctx Cl = LC(); if (C.G > 32) phase_weights(Cl, l + 1, cg - 32, C.G - 32); else phase_weights(Cl, l + 1, cg, C.G); } }
        SEAM(pb + 7);
        if (EN(8) && IN(pb + 8)) { const Ctx Cl = LC(); phase_norm2(Cl, l); }
        SEAM(pb + 8);
        if (EN(9) && IN(pb + 9)) { if (FP8_MOE) { build_exptab(C, tab, l); PMoe1 P{LWS(), tab, C.G, cg, 1024, 128u, moe1_off(l)}; pg8::gemm_phase_m128(C.lds, P); } else { build_exptab(C, tab, l, 8); PMoe1B P{LWS(), tab, C.G, cg, 1024, 128u}; pg8::gemm_phase(C.lds, P); } }
        SEAM(pb + 9);
        if (EN(10) && IN(pb + 10)) { if (FP8_MOE) { build_exptab(C, tab, l); PMoe2 P{LWS(), tab, C.G, cg, 512, 128u, moe2_off(l)}; pg8::gemm_phase_m128(C.lds, P); } else { build_exptab(C, tab, l, 8); PMoe2B P{LWS(), tab, C.G, cg, 512, 128u}; pg8::gemm_phase(C.lds, P); } }
        SEAM(pb + 10);
    }
    if (EN(12) && IN(NPH - 1)) { const Ctx Cl = LC(); phase_rows<2>(Cl, NLAYER); }
#ifdef DIAG_SEL
    xcd_barrier(bar); DIAG_ACC(12);
    if (blockIdx.x == 0 && threadIdx.x == 0) { volatile LAS unsigned* dg = (volatile LAS unsigned*)(C.lds + LDSCTL_OFF + 160); dg[8 + 13] = dg[0] - dg[1];
        for (int i = 0; i < 14; ++i) __hip_atomic_store(C.ctl + 2048 + i, dg[8 + i], RLX_AGENT); }
    xcd_barrier(bar);
    { const float d1 = (float)__hip_atomic_load(C.ctl + 2048 + (DIAG_SEL), RLX_AGENT) * 0.01f, d2 = (float)__hip_atomic_load(C.ctl + 2048 + (DIAG_SEL) + 1, RLX_AGENT) * 0.01f;
      const float c1 = sqrtf(d1); float* o = args.out;
      for (size_t i = (size_t)blockIdx.x * 512 + threadIdx.x; i < (size_t)NB * SEQ * D; i += (size_t)gridDim.x * 512) o[i] = (i == 12345) ? d2 : c1; }
#endif
#undef IN
#undef SEAM
}

#ifndef MK_PER_PHASE
#define MK_PER_PHASE 0
#endif
extern "C" void kernel_launch(void* const* d_in, const int* in_sizes, int n_in, void* d_out, int out_size, void* d_ws, size_t ws_size, hipStream_t stream) {
    static int grid = 0;
    if (grid == 0) {
        if (n_in != 29 || out_size != NB * SEQ * D || ws_size < WS_END) { fprintf(stderr, "kernel_launch: unexpected shapes (n_in %d out %d ws %zu)\n", n_in, out_size, ws_size); grid = -1; return; }
        int dev = 0, cus = 0, per_cu = 0;
        if (hipGetDevice(&dev) != hipSuccess || hipDeviceGetAttribute(&cus, hipDeviceAttributeMultiprocessorCount, dev) != hipSuccess) { grid = -1; return; }
        if (hipFuncSetAttribute((const void*)fwd, hipFuncAttributeMaxDynamicSharedMemorySize, LDS_BYTES) != hipSuccess) { grid = -1; return; }
        if (hipOccupancyMaxActiveBlocksPerMultiprocessor(&per_cu, (const void*)fwd, NWAVES * 64, LDS_BYTES) != hipSuccess || per_cu < 1) fprintf(stderr, "kernel_launch: occupancy query says %d\n", per_cu);
        (void)hipGetLastError();
        grid = cus;
    }
    if (grid < 0) return;
    (void)hipMemsetAsync((char*)d_ws + WS_CTL, 0, CTL_ZERO_BYTES, stream);
    Args a{};
    for (int i = 0; i < 29; ++i) a.in[i] = (const float*)d_in[i];
    a.out = (float*)d_out; a.ws = (unsigned char*)d_ws;
#if MK_PER_PHASE
    for (int p = 0; p < NPH; ++p) { a.ph_lo = p; a.ph_hi = p + 1; hipLaunchKernelGGL(fwd, dim3(grid), dim3(NWAVES * 64), LDS_BYTES, stream, a); }
#else
    a.ph_lo = 0; a.ph_hi = NPH; hipLaunchKernelGGL(fwd, dim3(grid), dim3(NWAVES * 64), LDS_BYTES, stream, a);
#endif
}
```

```cpp
#define FP8_MOE 1
#define GATE_BF16 0
#define W8_ALL 1
#define H8_WRITE 1
#ifndef H8_WRITE
#define H8_WRITE 1
#endif
#ifndef GATE_BF16
#define GATE_BF16 0
#endif
#include <hip/hip_runtime.h>
#include <cstdio>
#include <cstdint>

#define GAS __attribute__((address_space(1)))
#define LAS __attribute__((address_space(3)))
typedef unsigned short bf16;
typedef unsigned v4u __attribute__((ext_vector_type(4)));
typedef unsigned v2u __attribute__((ext_vector_type(2)));
typedef float f32x4 __attribute__((ext_vector_type(4)));
typedef float f32x2 __attribute__((ext_vector_type(2)));
typedef float f32x16 __attribute__((ext_vector_type(16)));
typedef short bf16x8 __attribute__((ext_vector_type(8)));
typedef short s16x4 __attribute__((ext_vector_type(4)));
typedef GAS unsigned gu32;
#define RLX_AGENT __ATOMIC_RELAXED, __HIP_MEMORY_SCOPE_AGENT
#define LDS_WAIT() asm volatile("s_waitcnt lgkmcnt(0)" ::: "memory")
#define VM_WAIT() asm volatile("s_waitcnt vmcnt(0)" ::: "memory")

constexpr int NB = 4, SEQ = 8192, CTX = 256, LB = SEQ + CTX, T = NB * LB, D = 1024, NPAN = T / 256;
constexpr int NLAYER = 4, INW = 5888, NCH = LB / 32, NCR = NB * NCH;
constexpr int NEXP = 16, FF = 512;
constexpr float EPS = 1e-6f;
constexpr float LOG2E = 1.4426950408889634f;
constexpr float C2 = 0.125f * LOG2E;
constexpr int NWAVES = 8;

constexpr size_t MiB = 1u << 20;
constexpr size_t WS_CTL = 0, CTL_ZERO_BYTES = 1 * MiB;
constexpr size_t WS_MOD = 1 * MiB;
constexpr size_t WS_LIST = 2 * MiB;
constexpr size_t WS_RW = 5 * MiB;
constexpr size_t WS_LW = 6 * MiB;
constexpr size_t WS_SST = 10 * MiB;
constexpr size_t WS_HB8 = WS_SST;
constexpr size_t WS_XST = 44 * MiB;
constexpr size_t WS_BT1 = 61 * MiB;
constexpr size_t WS_BT2 = 85 * MiB;
constexpr size_t WS_WIN = 93 * MiB;
constexpr size_t WS_WIN8 = WS_WIN + (size_t)2816 * 1024 * 2;
constexpr size_t WS_WGLU = 105 * MiB;
constexpr size_t WS_WBR = 106 * MiB;
constexpr size_t WS_WOUT = 109 * MiB;
constexpr size_t WS_WOUT2 = 100 * MiB;
constexpr size_t WS_MOE1 = 111 * MiB;
constexpr size_t WS_MOE2 = 143 * MiB;
constexpr size_t WS_HB = 159 * MiB;
constexpr size_t WS_U = 225 * MiB;
constexpr size_t WS_QA = 258 * MiB;
constexpr size_t WS_KA = 291 * MiB;
constexpr size_t WS_VA = 300 * MiB;
constexpr size_t WS_QN = 309 * MiB;
constexpr size_t WS_KN = 342 * MiB;
constexpr size_t WS_VN = 375 * MiB;
constexpr size_t WS_YS = 408 * MiB;
constexpr size_t WS_GATES = 441 * MiB;
constexpr size_t WS_ACT = WS_QN;
constexpr size_t WS_ACTB = WS_QN;
constexpr size_t WS_YSLOT = WS_GATES;
constexpr size_t WS_AO = 574 * MiB;
constexpr size_t WS_NO = 607 * MiB;
constexpr size_t WS_YG = 640 * MiB;
constexpr size_t WS_XS = 673 * MiB;
constexpr size_t WS_END = 739 * MiB;
static_assert(WS_GATES + (size_t)T * 3072 * (GATE_BF16 ? 2 : 1) <= WS_AO && WS_YSLOT + (size_t)2 * T * 1024 * 2 <= WS_AO && WS_ACT + (size_t)(2 * T + 4096) * 512 * 2 <= WS_YS, "ws map");
constexpr int CW_FAIL = 8;
constexpr int CW_CNT = 64;
constexpr int CW_BAR = 8192;
constexpr int CW_NAQ = 6144;

constexpr int RING_BYTES = 131072, LDS_BYTES = 147456, LDSCTL_OFF = LDS_BYTES - 512, MISC_OFF = LDSCTL_OFF + 320;

__device__ __forceinline__ unsigned f2bf(float f) { unsigned u = __builtin_bit_cast(unsigned, f); return (u + 0x7fffu + ((u >> 16) & 1u)) >> 16; }
__device__ __forceinline__ unsigned pk2(float lo, float hi) { return f2bf(lo) | (f2bf(hi) << 16); }
__device__ __forceinline__ float bf2f(unsigned b) { return __builtin_bit_cast(float, b << 16); }
__device__ __forceinline__ float bflo(unsigned w) { return __builtin_bit_cast(float, w << 16); }
__device__ __forceinline__ float bfhi(unsigned w) { return __builtin_bit_cast(float, w & 0xffff0000u); }
typedef float f32x2_c __attribute__((ext_vector_type(2))); typedef __bf16 bf16x2_c __attribute__((ext_vector_type(2)));
__device__ __forceinline__ unsigned cvt_pk_bf16(float lo, float hi) { const f32x2_c v = {lo, hi}; return __builtin_bit_cast(unsigned, __builtin_convertvector(v, bf16x2_c)); }
typedef int v8i __attribute__((ext_vector_type(8)));
typedef int v4i __attribute__((ext_vector_type(4)));
__device__ __forceinline__ float clamp8(float x) { return __builtin_fminf(__builtin_fmaxf(x, -448.f), 448.f); }
__device__ __forceinline__ unsigned pk4_fp8(float a, float b, float c, float d) { int w = 0; w = __builtin_amdgcn_cvt_pk_fp8_f32(clamp8(a), clamp8(b), w, false); w = __builtin_amdgcn_cvt_pk_fp8_f32(clamp8(c), clamp8(d), w, true); return (unsigned)w; }
__device__ __forceinline__ float fsigmoid(float x) { return __builtin_amdgcn_rcpf(1.f + __builtin_amdgcn_exp2f(-LOG2E * x)); }
__device__ __forceinline__ float gelu_tanh(float x) { const float u = 0.7978845608f * (x + 0.044715f * x * x * x); return x * __builtin_amdgcn_rcpf(1.f + __builtin_amdgcn_exp2f(-2.f * LOG2E * u)); }
__device__ __forceinline__ float shflx(float v, int m, int lane) { return __builtin_bit_cast(float, __builtin_amdgcn_ds_bpermute((lane ^ m) << 2, __builtin_bit_cast(int, v))); }
template <int CTRL, int RM>
__device__ __forceinline__ float dpp_mov(float v) { return __builtin_bit_cast(float, __builtin_amdgcn_update_dpp(0, __builtin_bit_cast(int, v), CTRL, RM, 0xF, true)); }
__device__ __forceinline__ float wave_sum(float v, int) {
    v += dpp_mov<0xB1, 0xF>(v);
    v += dpp_mov<0x4E, 0xF>(v);
    v += dpp_mov<0x141, 0xF>(v);
    v += dpp_mov<0x140, 0xF>(v);
    v += dpp_mov<0x142, 0xA>(v);
    v += dpp_mov<0x143, 0xC>(v);
    return __builtin_bit_cast(float, __builtin_amdgcn_readlane(__builtin_bit_cast(int, v), 63));
}
__device__ __forceinline__ float sin_rev(float r) { r = r - floorf(r); return __builtin_amdgcn_sinf(r); }
__device__ __forceinline__ float cos_rev(float r) { r = r - floorf(r); return __builtin_amdgcn_cosf(r); }

#define XB_TMO      128
#define XB_XCNT(j)  (256  + 64 * (j))
#define XB_XSUB(j)  (1280 + 64 * (j))
#define XB_XGEN(j)  (2304 + 64 * (j))
#define XB_TOP      3328
#define XB_TOPGEN   3392
#define XCD_BAR_WORDS 3456
#define XB_SPIN_CAP (1u << 22)

__device__ __forceinline__ unsigned xb_ld(unsigned* p)              { return __hip_atomic_load(p, __ATOMIC_RELAXED, __HIP_MEMORY_SCOPE_AGENT); }
__device__ __forceinline__ unsigned xb_add(unsigned* p, unsigned v) { return __hip_atomic_fetch_add(p, v, __ATOMIC_RELAXED, __HIP_MEMORY_SCOPE_AGENT); }
__device__ __forceinline__ unsigned xb_xcc_id() { return (unsigned)__builtin_amdgcn_s_getreg((3 << 11) | 20) & 0xFu; }
#define XB_SPIN(cond, bar) do { unsigned _sp = 0; while (cond) { __builtin_amdgcn_s_sleep(1); \
    if ((++_sp & 255u) == 0u) { if (xb_ld(&(bar)[XB_TMO])) break; if (_sp > XB_SPIN_CAP) { atomicAdd(&(bar)[XB_TMO], 1u); break; } } } } while (0)

struct XcdBarrier { unsigned* bar; unsigned x; volatile LAS unsigned* st; };

__device__ __forceinline__ XcdBarrier xcd_barrier_post(unsigned* bar, volatile LAS unsigned* st) {
    XcdBarrier b; b.bar = bar; b.x = xb_xcc_id(); b.st = st;
    if (threadIdx.x == 0) (void)xb_add(&bar[XB_XCNT(b.x)], 1u);
    return b;
}
__device__ __forceinline__ void xcd_barrier_complete(unsigned* bar, unsigned x, unsigned& nloc, unsigned& nx) {
    const unsigned G = gridDim.x * gridDim.y * gridDim.z;
    unsigned sum, cnt, mine, sp = 0u;
    for (;;) {
        sum = 0u; cnt = 0u; mine = 0u;
#pragma unroll
        for (unsigned j = 0; j < 16; ++j) { const unsigned c = xb_ld(&bar[XB_XCNT(j)]); sum += c; cnt += (c > 0u) ? 1u : 0u; mine = (j == x) ? c : mine; }
        if (sum == G) break;
        __builtin_amdgcn_s_sleep(1);
        if ((++sp & 255u) == 0u) { if (xb_ld(&bar[XB_TMO])) break; if (sp > XB_SPIN_CAP) { atomicAdd(&bar[XB_TMO], 1u); break; } }
    }
    nloc = mine > 0u ? mine : 1u; nx = cnt > 0u ? cnt : 1u;
}
__device__ __forceinline__ void xcd_barrier(const XcdBarrier& b) {
    asm volatile("s_waitcnt vmcnt(0)" ::: "memory");
    __syncthreads();
    if (threadIdx.x == 0) {
        unsigned* bar = b.bar;
        __builtin_amdgcn_s_waitcnt(0);
        unsigned nloc = b.st[0], nx = b.st[1];
        if (nloc == 0u) { xcd_barrier_complete(bar, b.x, nloc, nx); b.st[0] = nloc; b.st[1] = nx; }
        const unsigned old = xb_add(&bar[XB_XSUB(b.x)], 1u);
        const unsigned gen = old / nloc;
        if (old + 1u == (gen + 1u) * nloc) {
            __builtin_amdgcn_fence(__ATOMIC_RELEASE, "agent");
            asm volatile("s_waitcnt vmcnt(0)" ::: "memory");
            const unsigned og = xb_add(&bar[XB_TOP], 1u);
            const unsigned tg = og / nx;
            if (og + 1u == (tg + 1u) * nx) xb_add(&bar[XB_TOPGEN], 1u);
            else XB_SPIN(xb_ld(&bar[XB_TOPGEN]) == tg, bar);
            __builtin_amdgcn_fence(__ATOMIC_ACQUIRE, "agent");
            xb_add(&bar[XB_XGEN(b.x)], 1u);
            asm volatile("s_waitcnt vmcnt(0)" ::: "memory");
        } else {
            XB_SPIN(xb_ld(&bar[XB_XGEN(b.x)]) == gen, bar);
            __builtin_amdgcn_fence(__ATOMIC_ACQUIRE, "agent");
            asm volatile("s_waitcnt vmcnt(0)" ::: "memory");
        }
    }
    __syncthreads();
}

namespace pg8 {
constexpr int BM = 256, BK = 64, HALF = 128, HTB = HALF * BK * 2, STAGE_BYTES = 8 * HTB, NXCD = 8, WGM = 8;
__host__ __device__ __forceinline__ int lds_byte(int r, int c) { const int st = (r >> 4) * 2 + (c >> 5), rr = r & 15, cc = c & 31, ob = rr * 64 + cc * 2; return st * 1024 + (ob ^ (((ob >> 9) & 1) << 5)); }
__host__ __device__ __forceinline__ void stage_rc(int b, int& R, int& C) { const int st = b / 1024, sb = b % 1024, swz = sb ^ (((sb >> 9) & 1) << 5); R = (st >> 1) * 16 + swz / 64; C = (st & 1) * 32 + (swz % 64) / 2; }
__host__ __device__ __forceinline__ int perm32(int rho) { const int n = rho >> 4, i = rho & 15; return 8 * (i >> 2) + 4 * n + (i & 3); }

struct Unit { int pm, pn, z; };

__device__ __forceinline__ void static_decode(int L, int nM, int nN, int& pm, int& pn) {
    const int nwg = nM * nN; int wgid = L;
    { const int q = nwg / NXCD, r = nwg % NXCD, xcd = wgid % NXCD, off = wgid / NXCD; wgid = (xcd < r ? xcd * (q + 1) : r * (q + 1) + (xcd - r) * q) + off; }
    const int nig = WGM * nN, gid = wgid / nig, fm = gid * WGM, gsz = (nM - fm) < WGM ? (nM - fm) : WGM;
    pm = fm + ((wgid % nig) % gsz); pn = (wgid % nig) / gsz;
}

template <class P>
__device__ __forceinline__ void gemm_phase(LAS unsigned char* lds, const P& S) {
    int tid_ = threadIdx.x; asm volatile("" : "+v"(tid_));
    const int tid = tid_, wid = __builtin_amdgcn_readfirstlane(tid >> 6), lane = tid & 63, wr = wid >> 2, wc = wid & 3, fr = lane & 15, fq = lane >> 4;
    constexpr int ELB = P::FP8 ? 1 : 2;
    const int K = S.K; int nt = K * ELB / 128; asm volatile("" : "+s"(nt));
    unsigned voffB[2];
#pragma unroll
    for (int i = 0; i < 2; ++i) { int R, C; stage_rc(tid * 16 + i * 8192, R, C); const int Rb = (R & ~31) + perm32(R & 31); voffB[i] = (unsigned)(Rb * K * ELB + C * 2); }
#define PG8_AOFF(dst0, dst1, u) do { _Pragma("unroll") for (int i = 0; i < 2; ++i) { int R, C; stage_rc(tid * 16 + i * 8192, R, C); dst0[i] = S.a_off(u, 0, R, C); dst1[i] = S.a_off(u, 1, R, C); } } while (0)
    const size_t kstepB = (size_t)(BK * 2), hstepB = (size_t)HALF * K * ELB, kstepA = (size_t)S.kstepA;
    const unsigned ldsw = (unsigned)wid * 1024u;
    const int aoff = lds_byte(wr * 64 + fr, fq * 8), boff = lds_byte(wc * 32 + fr, fq * 8);
#define PG8_SA(b, h) (((b) * 2 + (h)) * HTB)
#define PG8_SB(b, h) ((4 + (b) * 2 + (h)) * HTB)
#define PG8_STAGE(bufoff, gbase, voff) do { _Pragma("unroll") for (int _i = 0; _i < 2; ++_i) \
        __builtin_amdgcn_global_load_lds((const unsigned*)((const char*)(gbase) + (voff)[_i]), (LAS unsigned*)(lds + (bufoff) + ldsw + _i * 8192), 16, 0, 0); } while (0)
#define PG8_LDA(dst, b, h) do { _Pragma("unroll") for (int m = 0; m < 4; ++m) _Pragma("unroll") for (int k = 0; k < 2; ++k) dst[m][k] = *(const LAS bf16x8*)(lds + PG8_SA(b, h) + aoff + m * 2048 + k * 1024); } while (0)
#define PG8_LDB(dst, b, h) do { _Pragma("unroll") for (int n = 0; n < 2; ++n) _Pragma("unroll") for (int k = 0; k < 2; ++k) dst[n][k] = *(const LAS bf16x8*)(lds + PG8_SB(b, h) + boff + n * 2048 + k * 1024); } while (0)
#define PG8_CAT(x0, x1) __builtin_shufflevector(__builtin_bit_cast(v4i, x0), __builtin_bit_cast(v4i, x1), 0, 1, 2, 3, 4, 5, 6, 7)
#define PG8_MMA(ai, bj, At, Bt) do { __builtin_amdgcn_s_setprio(1); _Pragma("unroll") for (int m = 0; m < 4; ++m) _Pragma("unroll") for (int n = 0; n < 2; ++n) { \
        if constexpr (P::FP8) acc[ai][bj][m][n] = __builtin_amdgcn_mfma_scale_f32_16x16x128_f8f6f4(PG8_CAT(Bt[n][0], Bt[n][1]), PG8_CAT(At[m][0], At[m][1]), acc[ai][bj][m][n], 0, 0, 0, 0x7f7f7f7f, 0, 0x7f7f7f7f); \
        else { _Pragma("unroll") for (int k = 0; k < 2; ++k) acc[ai][bj][m][n] = __builtin_amdgcn_mfma_f32_16x16x32_bf16(Bt[n][k], At[m][k], acc[ai][bj][m][n], 0, 0, 0); } } __builtin_amdgcn_s_setprio(0); } while (0)
#define PG8_WAIT_V(n) asm volatile("s_waitcnt vmcnt(" #n ")" ::: "memory")
#define PG8_WAIT_L(n) asm volatile("s_waitcnt lgkmcnt(" #n ")" ::: "memory")
#define PG8_BAR __builtin_amdgcn_s_barrier()
#define PG8_SCHED __builtin_amdgcn_sched_barrier(0)
    Unit cur, nxt; int ui = 0;
    if (!S.next(0, cur)) return;
    f32x4 acc[2][2][4][2];
#pragma unroll
    for (int a = 0; a < 2; ++a)
#pragma unroll
        for (int b = 0; b < 2; ++b)
#pragma unroll
            for (int m = 0; m < 4; ++m)
#pragma unroll
                for (int n = 0; n < 2; ++n) acc[a][b][m][n] = (f32x4){0.f, 0.f, 0.f, 0.f};
    bf16x8 At[4][2], B0[2][2], B1[2][2];
    unsigned vA0[2], vA1[2], vN0[2], vN1[2];
    PG8_AOFF(vA0, vA1, cur);
    const char* cA = S.a_base(cur); const char* cB = S.b_base(cur);
    PG8_STAGE(PG8_SB(0, 0), cB, voffB); PG8_STAGE(PG8_SB(0, 1), cB + hstepB, voffB); PG8_STAGE(PG8_SA(0, 0), cA, vA0); PG8_STAGE(PG8_SA(0, 1), cA, vA1);
    if (wr == 1) PG8_BAR;
    PG8_WAIT_V(2); PG8_BAR;
    PG8_STAGE(PG8_SB(1, 0), cB + kstepB, voffB); PG8_STAGE(PG8_SA(1, 0), cA + kstepA, vA0); PG8_STAGE(PG8_SB(1, 1), cB + hstepB + kstepB, voffB);
    PG8_WAIT_V(6); PG8_BAR;
    for (;;) {
        const bool has_next = S.next(ui + 1, nxt);
        const char* nA = cA; const char* nB = cB;
        if (has_next) { nA = S.a_base(nxt); nB = S.b_base(nxt); if (P::EARLY_AOFF) PG8_AOFF(vN0, vN1, nxt); }
        for (int t = 0; t < nt; t += 2) {
            const bool last = (t == nt - 2);
            const char* a1 = cA + (size_t)(t + 1) * kstepA;
            const char* a2 = last ? nA : cA + (size_t)(t + 2) * kstepA; const char* b2 = last ? nB : cB + (size_t)(t + 2) * kstepB;
            const char* a3 = a2 + kstepA; const char* b3 = b2 + kstepB;
            PG8_LDB(B0, 0, 0); PG8_LDB(B1, 0, 1); PG8_SCHED; PG8_LDA(At, 0, 0); PG8_STAGE(PG8_SA(1, 1), a1, vA1);
            if (last && has_next) {
                if (P::EARLY_AOFF) { _Pragma("unroll") for (int i = 0; i < 2; ++i) { vA0[i] = vN0[i]; vA1[i] = vN1[i]; } } else PG8_AOFF(vA0, vA1, nxt); }
            PG8_WAIT_V(8); PG8_WAIT_L(0); PG8_BAR; PG8_MMA(0, 0, At, B0); PG8_MMA(0, 1, At, B1); PG8_BAR; PG8_SCHED;
            PG8_LDA(At, 0, 1); PG8_STAGE(PG8_SB(0, 0), b2, voffB); PG8_STAGE(PG8_SB(0, 1), b2 + hstepB, voffB); PG8_STAGE(PG8_SA(0, 0), a2, vA0);
            PG8_WAIT_V(8); PG8_WAIT_L(0); PG8_BAR; PG8_MMA(1, 0, At, B0); PG8_MMA(1, 1, At, B1); PG8_BAR; PG8_SCHED;
            PG8_LDB(B0, 1, 0); PG8_LDB(B1, 1, 1); PG8_SCHED; PG8_LDA(At, 1, 0); PG8_STAGE(PG8_SA(0, 1), a2, vA1);
            PG8_WAIT_V(8); PG8_WAIT_L(0); PG8_BAR; PG8_MMA(0, 0, At, B0); PG8_MMA(0, 1, At, B1); PG8_BAR; PG8_SCHED;
            PG8_LDA(At, 1, 1); PG8_STAGE(PG8_SB(1, 0), b3, voffB); PG8_STAGE(PG8_SB(1, 1), b3 + hstepB, voffB); PG8_STAGE(PG8_SA(1, 0), a3, vA0);
            PG8_WAIT_V(8); PG8_WAIT_L(0); PG8_BAR; PG8_MMA(1, 0, At, B0); PG8_MMA(1, 1, At, B1); PG8_BAR; PG8_SCHED;
        }
        if (wr == 0) PG8_BAR;
        S.epi(acc, cur, wr, wc, fr, fq);
        if (!has_next) break;
#pragma unroll
        for (int a = 0; a < 2; ++a)
#pragma unroll
            for (int b = 0; b < 2; ++b)
#pragma unroll
                for (int m = 0; m < 4; ++m)
#pragma unroll
                    for (int n = 0; n < 2; ++n) acc[a][b][m][n] = (f32x4){0.f, 0.f, 0.f, 0.f};
        cur = nxt; cA = nA; cB = nB; ++ui;
        if (wr == 1) PG8_BAR;
    }
    PG8_WAIT_V(0);
    PG8_BAR;
#undef PG8_AOFF
#undef PG8_SA
#undef PG8_SB
#undef PG8_STAGE
#undef PG8_LDA
#undef PG8_LDB
#undef PG8_MMA
#undef PG8_CAT
#undef PG8_WAIT_V
#undef PG8_WAIT_L
#undef PG8_BAR
#undef PG8_SCHED
}

template <class P>
__device__ __forceinline__ void gemm_phase_m128(LAS unsigned char* lds, const P& S) {
    int tid_ = threadIdx.x; asm volatile("" : "+v"(tid_));
    const int tid = tid_, wid = __builtin_amdgcn_readfirstlane(tid >> 6), lane = tid & 63, wr = wid >> 2, wc = wid & 3, fr = lane & 15, fq = lane >> 4;
    constexpr int ELB = P::FP8 ? 1 : 2;
    const int K = S.K; int nt = K * ELB / 128; asm volatile("" : "+s"(nt));
    unsigned voffB[2];
#pragma unroll
    for (int i = 0; i < 2; ++i) { int R, C; stage_rc(tid * 16 + i * 8192, R, C); const int Rb = (R & ~31) + perm32(R & 31); voffB[i] = (unsigned)(Rb * K * ELB + C * 2); }
#define PG8_AOFF(dst0, u) do { _Pragma("unroll") for (int i = 0; i < 2; ++i) { int R, C; stage_rc(tid * 16 + i * 8192, R, C); dst0[i] = S.a_off(u, R, C); } } while (0)
    const size_t kstepB = (size_t)(BK * 2), hstepB = (size_t)HALF * K * ELB, kstepA = (size_t)S.kstepA;
    const unsigned ldsw = (unsigned)wid * 1024u;
    const int aoff = lds_byte(wr * 64 + fr, fq * 8), boff = lds_byte(wc * 32 + fr, fq * 8);
#define PG8_SA(b) (((b) * 2) * HTB)
#define PG8_SB(b, h) ((4 + (b) * 2 + (h)) * HTB)
#define PG8_STAGE(bufoff, gbase, voff) do { _Pragma("unroll") for (int _i = 0; _i < 2; ++_i) \
        __builtin_amdgcn_global_load_lds((const unsigned*)((const char*)(gbase) + (voff)[_i]), (LAS unsigned*)(lds + (bufoff) + ldsw + _i * 8192), 16, 0, 0); } while (0)
#define PG8_LDA(dst, b) do { _Pragma("unroll") for (int m = 0; m < 4; ++m) _Pragma("unroll") for (int k = 0; k < 2; ++k) dst[m][k] = *(const LAS bf16x8*)(lds + PG8_SA(b) + aoff + m * 2048 + k * 1024); } while (0)
#define PG8_LDB(dst, b, h) do { _Pragma("unroll") for (int n = 0; n < 2; ++n) _Pragma("unroll") for (int k = 0; k < 2; ++k) dst[n][k] = *(const LAS bf16x8*)(lds + PG8_SB(b, h) + boff + n * 2048 + k * 1024); } while (0)
#define PG8_CAT(x0, x1) __builtin_shufflevector(__builtin_bit_cast(v4i, x0), __builtin_bit_cast(v4i, x1), 0, 1, 2, 3, 4, 5, 6, 7)
#define PG8_MMA(bj, At, Bt) do { __builtin_amdgcn_s_setprio(1); _Pragma("unroll") for (int m = 0; m < 4; ++m) _Pragma("unroll") for (int n = 0; n < 2; ++n) { \
        if constexpr (P::FP8) acc[bj][m][n] = __builtin_amdgcn_mfma_scale_f32_16x16x128_f8f6f4(PG8_CAT(Bt[n][0], Bt[n][1]), PG8_CAT(At[m][0], At[m][1]), acc[bj][m][n], 0, 0, 0, 0x7f7f7f7f, 0, 0x7f7f7f7f); \
        else { _Pragma("unroll") for (int k = 0; k < 2; ++k) acc[bj][m][n] = __builtin_amdgcn_mfma_f32_16x16x32_bf16(Bt[n][k], At[m][k], acc[bj][m][n], 0, 0, 0); } } __builtin_amdgcn_s_setprio(0); } while (0)
#define PG8_WAIT_V(n) asm volatile("s_waitcnt vmcnt(" #n ")" ::: "memory")
#define PG8_WAIT_L(n) asm volatile("s_waitcnt lgkmcnt(" #n ")" ::: "memory")
#define PG8_BAR __builtin_amdgcn_s_barrier()
#define PG8_SCHED __builtin_amdgcn_sched_barrier(0)
    Unit cur, nxt; int ui = 0;
    if (!S.next(0, cur)) return;
    f32x4 acc[2][4][2], st[2][4][2];
#pragma unroll
    for (int a = 0; a < 2; ++a)
#pragma unroll
        for (int m = 0; m < 4; ++m)
#pragma unroll
            for (int n = 0; n < 2; ++n) { acc[a][m][n] = (f32x4){0.f, 0.f, 0.f, 0.f}; st[a][m][n] = (f32x4){0.f, 0.f, 0.f, 0.f}; }
    bf16x8 At[4][2], B0[2][2];
    unsigned vA[2], vN[2];
    PG8_AOFF(vA, cur);
    const char* cA = S.a_base(cur); const char* cB = S.b_base(cur);
    PG8_STAGE(PG8_SB(0, 0), cB, voffB); PG8_STAGE(PG8_SA(0), cA, vA); PG8_STAGE(PG8_SB(0, 1), cB + hstepB, voffB);
    if (wr == 1) PG8_BAR;
    PG8_WAIT_V(2); PG8_BAR;
    PG8_STAGE(PG8_SB(1, 0), cB + kstepB, voffB); PG8_STAGE(PG8_SA(1), cA + kstepA, vA);
    PG8_WAIT_V(4); PG8_BAR;
    for (;;) {
        const bool has_next = S.next(ui + 1, nxt);
        const char* nA = cA; const char* nB = cB;
        if (has_next) { nA = S.a_base(nxt); nB = S.b_base(nxt); if (P::EARLY_AOFF) PG8_AOFF(vN, nxt); }
        for (int t = 0; t < nt; t += 2) {
            const bool last = (t == nt - 2);
            const char* b1 = cB + (size_t)(t + 1) * kstepB;
            const char* a2 = last ? nA : cA + (size_t)(t + 2) * kstepA; const char* b2 = last ? nB : cB + (size_t)(t + 2) * kstepB;
            const char* a3 = a2 + kstepA; const char* b3 = b2 + kstepB;
            PG8_LDB(B0, 0, 0); PG8_SCHED; PG8_LDA(At, 0); PG8_STAGE(PG8_SB(1, 1), b1 + hstepB, voffB);
            if (last && has_next) { if (P::EARLY_AOFF) { vA[0] = vN[0]; vA[1] = vN[1]; } else PG8_AOFF(vA, nxt); }
            PG8_WAIT_V(6); PG8_WAIT_L(0); PG8_BAR; PG8_MMA(0, At, B0); PG8_BAR; PG8_SCHED;
            PG8_LDB(B0, 0, 1); PG8_STAGE(PG8_SB(0, 0), b2, voffB); PG8_STAGE(PG8_SA(0), a2, vA);
            PG8_WAIT_V(6); PG8_WAIT_L(0); PG8_BAR; PG8_MMA(1, At, B0); PG8_BAR; PG8_SCHED;
            PG8_LDB(B0, 1, 0); PG8_SCHED; PG8_LDA(At, 1); PG8_STAGE(PG8_SB(0, 1), b2 + hstepB, voffB);
            PG8_WAIT_V(6); PG8_WAIT_L(0); PG8_BAR; PG8_MMA(0, At, B0); PG8_BAR; PG8_SCHED;
            PG8_LDB(B0, 1, 1); PG8_STAGE(PG8_SB(1, 0), b3, voffB); PG8_STAGE(PG8_SA(1), a3, vA);
            PG8_WAIT_V(6); PG8_WAIT_L(0); PG8_BAR; PG8_MMA(1, At, B0); PG8_BAR; PG8_SCHED;
        }
        if (wr == 0) PG8_BAR;
        S.epi(acc, st, cur, wr, wc, fr, fq);
        if (!has_next) break;
#pragma unroll
        for (int a = 0; a < 2; ++a)
#pragma unroll
            for (int m = 0; m < 4; ++m)
#pragma unroll
                for (int n = 0; n < 2; ++n) acc[a][m][n] = (f32x4){0.f, 0.f, 0.f, 0.f};
        cur = nxt; cA = nA; cB = nB; ++ui;
        if (wr == 1) PG8_BAR;
    }
    PG8_WAIT_V(0);
    PG8_BAR;
#undef PG8_AOFF
#undef PG8_SA
#undef PG8_SB
#undef PG8_STAGE
#undef PG8_LDA
#undef PG8_LDB
#undef PG8_MMA
#undef PG8_CAT
#undef PG8_WAIT_V
#undef PG8_WAIT_L
#undef PG8_BAR
#undef PG8_SCHED
}
}
namespace attn_body {
using bf16x8 = __attribute__((ext_vector_type(8))) short;
using u32x4 = __attribute__((ext_vector_type(4))) unsigned;
constexpr int NW = 8, QBLK = 32, QB = QBLK * NW, KVBLK = 64;
__device__ __forceinline__ int crow(int r, int hi) { return (r & 3) + 8 * (r >> 2) + 4 * hi; }
#define SBAR() __builtin_amdgcn_sched_barrier(0)
constexpr int NSLOT = 3, SLOTB = 8192;
constexpr int LDS_K = 0, LDS_V = NSLOT * SLOTB, LDS_WS = 2 * NSLOT * SLOTB, LDS_OST = LDS_WS + NW * 64 * 4, LDS_BYTES = LDS_OST + NW * 4096;
constexpr int LDS_BT = 86016 + 256;
__device__ __forceinline__ void glds16(const void* gsrc, unsigned lds_dst) { unsigned keep;
  asm volatile("s_mov_b32 %0, m0\n\ts_mov_b32 m0, %2\n\ts_nop 0\n\tglobal_load_lds_dwordx4 %1, off\n\ts_mov_b32 m0, %0" : "=&s"(keep) : "v"(gsrc), "s"(lds_dst) : "memory"); }
__device__ __forceinline__ float max3f(float a, float b, float c) { float r; asm("v_max3_f32 %0, %1, %2, %3" : "=v"(r) : "v"(a), "v"(b), "v"(c)); return r; }
__device__ __forceinline__ float max2f(float a, float b) { float r; asm("v_max_f32_e32 %0, %1, %2" : "=v"(r) : "v"(a), "v"(b)); return r; }
__device__ __forceinline__ float fadd_s(float a, float b) { float r; asm("v_add_f32_e32 %0, %1, %2" : "=v"(r) : "v"(a), "v"(b)); return r; }
__device__ __forceinline__ float fsub_s(float a, float b) { float r; asm("v_sub_f32_e32 %0, %1, %2" : "=v"(r) : "v"(a), "v"(b)); return r; }
typedef float f32x2_t __attribute__((ext_vector_type(2))); typedef __bf16 bf16x2_t __attribute__((ext_vector_type(2)));
__device__ __forceinline__ unsigned cvtpk_s(float lo, float hi) { f32x2_t v = {lo, hi}; bf16x2_t b = __builtin_convertvector(v, bf16x2_t); return __builtin_bit_cast(unsigned, b); }
#define WAIT_BAR(N) asm volatile("s_waitcnt vmcnt(" #N ") lgkmcnt(0)\n\ts_barrier" ::: "memory")

__device__ __forceinline__ void qkt(f32x16& p0, f32x16& p1, const char* Kslot, const bf16x8* qr, const f32x16& negm, int r32, int hi) {
  const char* kb = Kslot + hi * 1024 + r32 * 16;
  #pragma unroll
  for (int d0 = 0; d0 < 4; ++d0) {
    const bf16x8 b0 = *reinterpret_cast<const bf16x8*>(kb + d0 * 2048);
    const bf16x8 b1 = *reinterpret_cast<const bf16x8*>(kb + d0 * 2048 + 512);
    if (d0 == 0) { p0 = __builtin_amdgcn_mfma_f32_32x32x16_bf16(b0, qr[0], negm, 0, 0, 0); p1 = __builtin_amdgcn_mfma_f32_32x32x16_bf16(b1, qr[0], negm, 0, 0, 0); }
    else { p0 = __builtin_amdgcn_mfma_f32_32x32x16_bf16(b0, qr[d0], p0, 0, 0, 0); p1 = __builtin_amdgcn_mfma_f32_32x32x16_bf16(b1, qr[d0], p1, 0, 0, 0); } }
}
typedef __attribute__((address_space(3))) const char* lds_cptr;
typedef short v4i16_t __attribute__((ext_vector_type(4)));
__device__ __forceinline__ void kload8(bf16x8* kf, lds_cptr kp) {
  kf[0] = *(const __attribute__((address_space(3))) bf16x8*)(kp);        kf[1] = *(const __attribute__((address_space(3))) bf16x8*)(kp + 512);
  kf[2] = *(const __attribute__((address_space(3))) bf16x8*)(kp + 2048); kf[3] = *(const __attribute__((address_space(3))) bf16x8*)(kp + 2560);
  kf[4] = *(const __attribute__((address_space(3))) bf16x8*)(kp + 4096); kf[5] = *(const __attribute__((address_space(3))) bf16x8*)(kp + 4608);
  kf[6] = *(const __attribute__((address_space(3))) bf16x8*)(kp + 6144); kf[7] = *(const __attribute__((address_space(3))) bf16x8*)(kp + 6656);
}
__device__ __forceinline__ void kload2(bf16x8* kf, lds_cptr kp, int j) { kf[2 * j] = *(const __attribute__((address_space(3))) bf16x8*)(kp + j * 2048); kf[2 * j + 1] = *(const __attribute__((address_space(3))) bf16x8*)(kp + j * 2048 + 512); }
__device__ __forceinline__ s16x4 vtr(lds_cptr p) { return __builtin_bit_cast(s16x4, __builtin_amdgcn_ds_read_tr16_b64_v4i16((__attribute__((address_space(3))) v4i16_t*)p)); }
__device__ __forceinline__ float rowmax(const f32x16& p0, const f32x16& p1) {
  float a = max3f(p0[0], p0[1], p1[0]), b = max3f(p0[2], p0[3], p1[1]); a = max3f(a, p1[2], p1[3]);
  #pragma unroll
  for (int r = 4; r < 16; r += 4) { a = max3f(a, p0[r], p0[r + 1]); b = max3f(b, p0[r + 2], p0[r + 3]); a = max3f(a, p1[r], p1[r + 1]); b = max3f(b, p1[r + 2], p1[r + 3]); }
  const float m = max2f(a, b);
  auto rr = __builtin_amdgcn_permlane32_swap(__float_as_uint(m), __float_as_uint(m), false, false);
  return max2f(__uint_as_float(rr[0]), __uint_as_float(rr[1]));
}
__device__ __forceinline__ void pv(f32x16* o, int vb, bf16x8 pa0, bf16x8 pa1, bf16x8 pa2, bf16x8 pa3) {
  #pragma unroll
  for (int d0 = 0; d0 < 2; ++d0) { s16x4 lo[4], hi[4];
    #pragma unroll
    for (int ks = 0; ks < 4; ++ks) {
      asm volatile("ds_read_b64_tr_b16 %0,%1 offset:%c2" : "=&v"(lo[ks]) : "v"(vb), "i"(d0 * 4096 + ks * 1024) : "memory");
      asm volatile("ds_read_b64_tr_b16 %0,%1 offset:%c2" : "=&v"(hi[ks]) : "v"(vb), "i"(d0 * 4096 + ks * 1024 + 512) : "memory"); }
    asm volatile("s_waitcnt lgkmcnt(0)" ::: "memory"); SBAR();
    #define PK(k) (bf16x8){lo[k][0], lo[k][1], lo[k][2], lo[k][3], hi[k][0], hi[k][1], hi[k][2], hi[k][3]}
    o[d0] = __builtin_amdgcn_mfma_f32_32x32x16_bf16(pa0, PK(0), o[d0], 0, 0, 0);
    o[d0] = __builtin_amdgcn_mfma_f32_32x32x16_bf16(pa1, PK(1), o[d0], 0, 0, 0);
    o[d0] = __builtin_amdgcn_mfma_f32_32x32x16_bf16(pa2, PK(2), o[d0], 0, 0, 0);
    o[d0] = __builtin_amdgcn_mfma_f32_32x32x16_bf16(pa3, PK(3), o[d0], 0, 0, 0);
    #undef PK
  }
}
#define ATTN_STORE16(p, v) (*(u32x4*)(p) = (v))

template <int THRL, bool NA, int QP_, int KVP_, bool NOMAX = false>
__device__ __forceinline__ void attn_unit(const bf16* Qu, int qp_rt, const bf16* __restrict__ Kh, const bf16* __restrict__ Vh, int kvp_rt, bf16* Ou, int NT, int r0, int rlo, char* shm) {
  const int qp = QP_ ? QP_ : qp_rt, kvp = KVP_ ? KVP_ : kvp_rt, op = qp;
  int tid_ = threadIdx.x; asm volatile("" : "+v"(tid_));
  const int tid = tid_, lane = tid & 63, r32 = lane & 31, hi = lane >> 5; const int wid = __builtin_amdgcn_readfirstlane(tid >> 6);
  const bf16* Qw = Qu + (long)(wid * QBLK) * qp;
  const unsigned lds0 = (unsigned)(uintptr_t)shm;
  float* wsf = (float*)(shm + LDS_WS) + wid * 64;
  const bf16* ksrc = Kh + (long)lane * kvp + wid * 8;
  const bf16* vsrc = Vh + (long)(16 * (wid & 3) + (lane >> 2)) * kvp + (wid >> 2) * 32 + (lane & 3) * 8;
  const unsigned kdst = lds0 + LDS_K + wid * 1024, vdst = lds0 + LDS_V + wid * 1024;
  #define TROW(t) (NA ? ((t) < 4 ? 64 * (t) : CTX + 64 * ((rlo + (t) - 4) < 127 ? (rlo + (t) - 4) : 127)) : 64 * (t))
  #define DMA_K(t, slot) glds16(ksrc + (long)TROW(t) * kvp, (unsigned)__builtin_amdgcn_readfirstlane(kdst + (slot)))
  #define DMA_V(t, slot) glds16(vsrc + (long)TROW(t) * kvp, (unsigned)__builtin_amdgcn_readfirstlane(vdst + (slot)))
  const int vb0 = (int)(lds0 + LDS_V) + ((lane >> 4) & 1) * 32 + (lane & 3) * 8 + (4 * hi + ((lane & 15) >> 2)) * 64;
  const char* Kbase = shm + LDS_K; bf16x8 kf[8];
  const lds_cptr shm3 = (lds_cptr)shm; const lds_cptr kp0 = shm3 + LDS_K + hi * 1024 + r32 * 16; const lds_cptr vp0 = shm3 + LDS_V + ((lane >> 4) & 1) * 32 + (lane & 3) * 8 + (4 * hi + ((lane & 15) >> 2)) * 64;
  const int rq = r0 + (wid >> 1), qc = 32 * (wid & 1) + r32;
  const int rsw = rq - 4 < 0 ? 0 : (rq - 4 > 120 ? 120 : rq - 4);
  const int cs = qc - 8 < 0 ? 0 : (qc - 8 > 48 ? 48 : qc - 8);
  const __attribute__((address_space(3))) float* btl = (const __attribute__((address_space(3))) float*)(shm3 + LDS_BT) + (15 + 4 * hi - qc);
  DMA_K(0, 0); DMA_V(0, 0); DMA_K(1, SLOTB);
  bf16x8 qr[4];
  #pragma unroll
  for (int d0 = 0; d0 < 4; ++d0) qr[d0] = *reinterpret_cast<const bf16x8*>(&Qw[(long)r32 * qp + d0 * 16 + hi * 8]);
  float mhat = 0.f, l_reg = 0.f; f32x16 o[2]; o[0] = f32x16{}; o[1] = f32x16{}; f32x16 negm = f32x16{}; if (!NA) asm volatile("" : "+v"(negm));
  #define NEGM (NA ? f32x16{} : negm)
  #define CMASK(P0, P1, t) do { if (NA) { if ((t) >= 4) { const int kr_ = rlo + (t) - 4; const int dr_ = kr_ - rsw; \
      if (dr_ < 0 || dr_ >= 8) { _Pragma("unroll") for (int r = 0; r < 16; ++r) { P0[r] = (-__builtin_inff()); P1[r] = (-__builtin_inff()); } } \
      else { const __attribute__((address_space(3))) float* bp_ = btl + (kr_ - rq + 7) * 31; const int kl0_ = 4 * hi - cs; \
        _Pragma("unroll") for (int rg = 0; rg < 4; ++rg) { \
          _Pragma("unroll") for (int rr_ = 0; rr_ < 4; ++rr_) { const int r = rg * 4 + rr_; const int kc_ = (r & 3) + 8 * (r >> 2); const float b0_ = bp_[kc_], b1_ = bp_[kc_ + 32]; \
            const int kl_ = kc_ + kl0_; P0[r] = ((unsigned)kl_ < 16u) ? P0[r] + b0_ : (-__builtin_inff()); P1[r] = ((unsigned)(kl_ + 32) < 16u) ? P1[r] + b1_ : (-__builtin_inff()); } \
          SBAR(); } } } } } while (0)
  bool resc = false;
  #define START(P0, P1) do { const float rm = NOMAX ? 0.f : rowmax(P0, P1); resc = false; \
    { const float dl = rm; mhat = fadd_s(mhat, dl); \
      _Pragma("unroll") for (int r = 0; r < 16; ++r) { P0[r] = fsub_s(P0[r], dl); P1[r] = fsub_s(P1[r], dl); } \
      if (!NA) { _Pragma("unroll") for (int r = 0; r < 16; ++r) negm[r] = -mhat; asm volatile("" : "+v"(negm)); } } \
    _Pragma("unroll") for (int r = 0; r < 16; ++r) P0[r] = __builtin_amdgcn_exp2f(P0[r]); } while (0)
  #define RESC() do { if (resc) { asm volatile("s_waitcnt lgkmcnt(0)" ::: "memory"); \
      _Pragma("unroll") for (int d_ = 0; d_ < 2; ++d_) _Pragma("unroll") for (int r = 0; r < 16; ++r) o[d_][r] *= wsf[crow(r, hi)]; } } while (0)
  f32x16 pA0, pA1, pB0, pB1;
  int sl_prev = 0, sl_cur = 0, sl_next = SLOTB;
  #define ROT() do { sl_prev = sl_cur; sl_cur = sl_next; sl_next = (sl_next == (NSLOT - 1) * SLOTB) ? 0 : sl_next + SLOTB; } while (0)
  DMA_K(2, 2 * SLOTB);
  WAIT_BAR(3);
  qkt(pA0, pA1, Kbase, qr, NEGM, r32, hi); asm volatile("s_nop 15\n\ts_nop 7" : "+v"(pA0), "+v"(pA1));
  START(pA0, pA1);
  _Pragma("unroll") for (int r = 0; r < 16; ++r) pA1[r] = __builtin_amdgcn_exp2f(pA1[r]);
  WAIT_BAR(0);
  DMA_K(3, 0); DMA_V(1, SLOTB);
  ROT();
  kload8(kf, kp0 + sl_cur);
  WAIT_BAR(2);
  s16x4 vlo[8], vhi[8]; u32x4 pw0, pw1, pw2, pw3;
  #define PKW(P, B) cvtpk_s(P[B], P[B + 1])
  #define PAF(k) __builtin_bit_cast(bf16x8, pw##k)
  #define VFR(i) (bf16x8){vlo[i][0], vlo[i][1], vlo[i][2], vlo[i][3], vhi[i][0], vhi[i][1], vhi[i][2], vhi[i][3]}
  #define PIN(x) asm volatile("" : "+v"(x))
  #define MX3(a, b, c) __builtin_fmaxf(__builtin_fmaxf((a), (b)), (c))
  #define GAPA(MF, A0, A1, A2, A3, W0, W1, PW) do { MF; sacc2 += (f32x2_t){A0, A1}; sacc2 += (f32x2_t){A2, A3}; PIN(sacc2); W0; W1; PIN(PW); SBAR(); } while (0)
  #define EX(v) __builtin_amdgcn_exp2f(v)
  #define GAPB(MF, X, B) do { MF; X[B] = EX(X[B]); X[B + 1] = EX(X[B + 1]); X[B + 2] = EX(X[B + 2]); X[B + 3] = EX(X[B + 3]); PIN(X); SBAR(); } while (0)
  #define VRD(i) do { vlo[i] = vtr(vp_ + (((i) >> 2) * 4096 + ((i) & 3) * 1024)); vhi[i] = vtr(vp_ + (((i) >> 2) * 4096 + ((i) & 3) * 1024 + 512)); } while (0)
  #define KRD(G, j) do { if (G) { kload2(kf, kp0 + sl_next, j); SBAR(); } } while (0)
  #define STEP(C0, C1, P0, P1, t, GK, GV, GL) do { SBAR(); \
    const lds_cptr vp_ = vp0 + sl_prev; \
    VRD(0); SBAR(); f32x2_t sacc2 = (f32x2_t){P0[0], P0[1]}; \
    GAPA(C0 = __builtin_amdgcn_mfma_f32_32x32x16_bf16(kf[0], qr[0], NEGM, 0, 0, 0), P0[2], P0[3], P0[4], P0[5],     pw0[0] = PKW(P0, 0), pw0[1] = PKW(P0, 2), pw0); \
    VRD(4); SBAR(); GAPA(C1 = __builtin_amdgcn_mfma_f32_32x32x16_bf16(kf[1], qr[0], NEGM, 0, 0, 0), P0[6], P0[7], P0[8], P0[9],     pw0[2] = PKW(P0, 4), pw0[3] = PKW(P0, 6), pw0); \
    VRD(1); SBAR(); GAPA(C0 = __builtin_amdgcn_mfma_f32_32x32x16_bf16(kf[2], qr[1], C0, 0, 0, 0),   P0[10], P0[11], P0[12], P0[13], pw1[0] = PKW(P0, 8), pw1[1] = PKW(P0, 10), pw1); \
    VRD(5); SBAR(); GAPA(C1 = __builtin_amdgcn_mfma_f32_32x32x16_bf16(kf[3], qr[1], C1, 0, 0, 0),   P0[14], P0[15], P1[0], P1[1],   pw1[2] = PKW(P0, 12), pw1[3] = PKW(P0, 14), pw1); \
    VRD(2); SBAR(); GAPA(C0 = __builtin_amdgcn_mfma_f32_32x32x16_bf16(kf[4], qr[2], C0, 0, 0, 0),   P1[2], P1[3], P1[4], P1[5],     pw2[0] = PKW(P1, 0), pw2[1] = PKW(P1, 2), pw2); \
    VRD(6); SBAR(); GAPA(C1 = __builtin_amdgcn_mfma_f32_32x32x16_bf16(kf[5], qr[2], C1, 0, 0, 0),   P1[6], P1[7], P1[8], P1[9],     pw2[2] = PKW(P1, 4), pw2[3] = PKW(P1, 6), pw2); \
    VRD(3); SBAR(); GAPA(C0 = __builtin_amdgcn_mfma_f32_32x32x16_bf16(kf[6], qr[3], C0, 0, 0, 0),   P1[10], P1[11], P1[12], P1[13], pw3[0] = PKW(P1, 8), pw3[1] = PKW(P1, 10), pw3); \
    VRD(7); SBAR(); GAPA(C1 = __builtin_amdgcn_mfma_f32_32x32x16_bf16(kf[7], qr[3], C1, 0, 0, 0),   P1[14], P1[15], 0.f, 0.f,       pw3[2] = PKW(P1, 12), pw3[3] = PKW(P1, 14), pw3); \
    l_reg += sacc2.x + sacc2.y; \
    if (GK) { DMA_K((t) + 3, sl_cur); } if (GV) { DMA_V((t) + 1, sl_next); } \
    resc = false; \
    if (NA) { _Pragma("unroll") for (int r = 0; r < 16; ++r) { C0[r] -= mhat; C1[r] -= mhat; } } \
    CMASK(C0, C1, t); \
    if (!NOMAX) { float a = MX3(C0[0], C0[1], C1[0]), b = MX3(C0[2], C0[3], C1[1]); a = MX3(a, C1[2], C1[3]); \
      _Pragma("unroll") for (int r = 4; r < 16; r += 4) { a = MX3(a, C0[r], C0[r + 1]); b = MX3(b, C0[r + 2], C0[r + 3]); a = MX3(a, C1[r], C1[r + 1]); b = MX3(b, C1[r + 2], C1[r + 3]); } \
      float rm = __builtin_fmaxf(a, b); { auto rr = __builtin_amdgcn_permlane32_swap(__float_as_uint(rm), __float_as_uint(rm), false, false); rm = __builtin_fmaxf(__uint_as_float(rr[0]), __uint_as_float(rr[1])); } \
      if (__builtin_expect(__any(rm > (float)THRL), 0)) { const float dl = __builtin_fmaxf(rm, 0.f); mhat += dl; \
        _Pragma("unroll") for (int r = 0; r < 16; ++r) { C0[r] -= dl; C1[r] -= dl; } \
        if (!NA) { _Pragma("unroll") for (int r = 0; r < 16; ++r) negm[r] = -mhat; asm volatile("" : "+v"(negm)); } \
        const float f = __builtin_amdgcn_exp2f(-dl); l_reg *= f; if (hi == 0) wsf[r32] = f; resc = true; } } \
    SBAR(); \
    GAPB(o[0] = __builtin_amdgcn_mfma_f32_32x32x16_bf16(PAF(0), VFR(0), o[0], 0, 0, 0), C0, 0); \
    GAPB(o[1] = __builtin_amdgcn_mfma_f32_32x32x16_bf16(PAF(0), VFR(4), o[1], 0, 0, 0), C0, 4); \
    KRD(GL, 0); GAPB(o[0] = __builtin_amdgcn_mfma_f32_32x32x16_bf16(PAF(1), VFR(1), o[0], 0, 0, 0), C0, 8); \
    KRD(GL, 1); GAPB(o[1] = __builtin_amdgcn_mfma_f32_32x32x16_bf16(PAF(1), VFR(5), o[1], 0, 0, 0), C0, 12); \
    KRD(GL, 2); GAPB(o[0] = __builtin_amdgcn_mfma_f32_32x32x16_bf16(PAF(2), VFR(2), o[0], 0, 0, 0), C1, 0); \
    KRD(GL, 3); GAPB(o[1] = __builtin_amdgcn_mfma_f32_32x32x16_bf16(PAF(2), VFR(6), o[1], 0, 0, 0), C1, 4); \
    GAPB(o[0] = __builtin_amdgcn_mfma_f32_32x32x16_bf16(PAF(3), VFR(3), o[0], 0, 0, 0), C1, 8); \
    GAPB(o[1] = __builtin_amdgcn_mfma_f32_32x32x16_bf16(PAF(3), VFR(7), o[1], 0, 0, 0), C1, 12); \
    } while (0)
  int t = 1;
  for (; t + 5 < NT; t += 2) {
    STEP(pB0, pB1, pA0, pA1, t, true, true, true);     WAIT_BAR(2); RESC(); ROT();
    STEP(pA0, pA1, pB0, pB1, t + 1, true, true, true); WAIT_BAR(2); RESC(); ROT();
  }
  #define ENDW(tt) do { if ((tt) + 3 < NT) { WAIT_BAR(2); } else if ((tt) + 2 < NT) { WAIT_BAR(1); } else { WAIT_BAR(0); } } while (0)
  for (; t + 1 < NT; t += 2) {
    STEP(pB0, pB1, pA0, pA1, t, (t + 3 < NT), (t + 1 < NT), (t + 1 < NT));         ENDW(t);     RESC(); ROT();
    STEP(pA0, pA1, pB0, pB1, t + 1, (t + 4 < NT), (t + 2 < NT), (t + 2 < NT));     ENDW(t + 1); RESC(); ROT();
  }
  STEP(pB0, pB1, pA0, pA1, NT - 1, false, false, false); RESC();
  { float sacc = pB0[0] + pB0[1]; _Pragma("unroll") for (int r = 2; r < 16; ++r) sacc += pB0[r]; _Pragma("unroll") for (int r = 0; r < 16; ++r) sacc += pB1[r]; l_reg += sacc;
    pw0 = (u32x4){PKW(pB0, 0), PKW(pB0, 2), PKW(pB0, 4), PKW(pB0, 6)}; pw1 = (u32x4){PKW(pB0, 8), PKW(pB0, 10), PKW(pB0, 12), PKW(pB0, 14)}; pw2 = (u32x4){PKW(pB1, 0), PKW(pB1, 2), PKW(pB1, 4), PKW(pB1, 6)}; pw3 = (u32x4){PKW(pB1, 8), PKW(pB1, 10), PKW(pB1, 12), PKW(pB1, 14)};
    SBAR(); pv(o, vb0 + sl_cur, PAF(0), PAF(1), PAF(2), PAF(3)); }
  #undef PKW
  #undef PAF
  #undef VFR
  #undef PIN
  #undef MX3
  #undef GAPA
  #undef GAPB
  #undef EX
  #undef VRD
  #undef KRD
  #undef STEP
  #undef ENDW
  { auto rr = __builtin_amdgcn_permlane32_swap(__float_as_uint(l_reg), __float_as_uint(l_reg), false, false); l_reg = __uint_as_float(rr[0]) + __uint_as_float(rr[1]); }
  if (hi == 0) wsf[32 + r32] = l_reg; asm volatile("s_waitcnt lgkmcnt(0)" ::: "memory");
  float rli[16];
  #pragma unroll
  for (int r = 0; r < 16; ++r) rli[r] = __builtin_amdgcn_rcpf(wsf[32 + crow(r, hi)]);
  bf16* Ow = Ou + (long)(wid * QBLK) * op;
  { bf16* stg = (bf16*)(shm + LDS_OST) + wid * 2048;
    #pragma unroll
    for (int r = 0; r < 16; ++r) { const int orow = crow(r, hi);
      #pragma unroll
      for (int d0 = 0; d0 < 2; ++d0) stg[orow * 64 + d0 * 32 + r32] = (bf16)f2bf(o[d0][r] * rli[r]); }
    asm volatile("s_waitcnt lgkmcnt(0)" ::: "memory");
    #pragma unroll
    for (int i = 0; i < 4; ++i) { const int row = i * 8 + (lane >> 3), ch = lane & 7; const u32x4 v = *(const u32x4*)(stg + row * 64 + ch * 8); ATTN_STORE16(Ow + (long)row * op + ch * 8, v); } }
  asm volatile("s_waitcnt lgkmcnt(0)\n\ts_barrier" ::: "memory");
  #undef NEGM
  #undef DMA_K
  #undef DMA_V
  #undef TROW
  #undef CMASK
  #undef START
  #undef RESC
  #undef ROT
}
#undef SBAR
#undef WAIT_BAR
}
#ifndef FP8_MOE
#define FP8_MOE 1
#endif
struct Args { const float* in[29]; float* out; unsigned char* ws; int ph_lo, ph_hi; };
enum { I_X = 0, I_C, I_CTX, I_CCTX, I_WMOD, I_BMOD, I_N1G, I_N2G, I_WIN, I_LRE, I_LIM, I_LDT, I_BRE, I_BIM, I_CRE, I_CIM, I_SSMD, I_WGLU, I_QNG, I_KNG, I_RPB, I_WBR, I_WOUT, I_RW, I_RB, I_MG, I_MU, I_MD, I_FNG };

typedef const float* CFP;
struct Ctx {
    const __attribute__((address_space(4))) CFP* in; float* out; unsigned char* ws; LAS unsigned char* lds; gu32* ctl;
    int tid, lane, wave, vcu, G;
};
#define WSP(T_, off) ((T_*)(C.ws + (off)))
__device__ __forceinline__ size_t wout_off(int l) { return (l & 1) ? WS_WOUT2 : WS_WOUT; }
__device__ __forceinline__ size_t moe1_off(int l) { return WS_MOE1 + (size_t)(l & 1) * 16 * MiB; }
__device__ __forceinline__ size_t moe2_off(int l) { return WS_MOE2 + (size_t)(l & 1) * 8 * MiB; }

__device__ __forceinline__ bf16* xs_row(const Ctx& C, int m) { return WSP(bf16, WS_XS) + (size_t)m * D; }
__device__ __forceinline__ const float* in_row(const Ctx& C, int m) { const int b = m / LB, j = m - b * LB; return j < CTX ? C.in[I_CTX] + (size_t)(b * CTX + j) * D : C.in[I_X] + (size_t)(b * SEQ + j - CTX) * D; }
__device__ __forceinline__ int cond_of(int m) { const int b = m / LB, j = m - b * LB; return j < CTX ? 4 : b; }

__device__ __forceinline__ void transpose_item(const float* W, int N, int Kp, bf16* WT, int k0, int n0, int drow0, LAS float* scr, int lane) {
    const float* src = W + (size_t)k0 * N + n0 + lane;
    float tv[64];
#pragma unroll
    for (int i = 0; i < 64; ++i) tv[i] = src[(size_t)i * N];
#pragma unroll
    for (int i = 0; i < 64; ++i) scr[i * 65 + lane] = tv[i];
    LDS_WAIT(); asm volatile("" ::: "memory");
    const int c = lane & 7;
#pragma unroll
    for (int j = 0; j < 8; ++j) { const int n = (lane >> 3) + 8 * j; const LAS float* s = scr + (8 * c) * 65 + n;
        v4u o; o.x = pk2(s[0 * 65], s[1 * 65]); o.y = pk2(s[2 * 65], s[3 * 65]); o.z = pk2(s[4 * 65], s[5 * 65]); o.w = pk2(s[6 * 65], s[7 * 65]);
        *(GAS v4u*)(WT + (size_t)(drow0 + n) * Kp + k0 + 8 * c) = o; }
    LDS_WAIT(); asm volatile("" ::: "memory");
}
__device__ __forceinline__ void transpose_item8(const float* W, int N, int Kp, unsigned char* WT, int k0, int n0, int drow0, float scale, LAS float* scr, int lane) {
    const float* src = W + (size_t)k0 * N + n0 + lane;
    float tv[64];
#pragma unroll
    for (int i = 0; i < 64; ++i) tv[i] = src[(size_t)i * N];
#pragma unroll
    for (int i = 0; i < 64; ++i) scr[i * 65 + lane] = tv[i] * scale;
    LDS_WAIT(); asm volatile("" ::: "memory");
    const int c = lane & 3;
#pragma unroll
    for (int j = 0; j < 4; ++j) { const int n = (lane >> 2) + 16 * j; const LAS float* s = scr + (16 * c) * 65 + n;
        v4u o; o.x = pk4_fp8(s[0 * 65], s[1 * 65], s[2 * 65], s[3 * 65]); o.y = pk4_fp8(s[4 * 65], s[5 * 65], s[6 * 65], s[7 * 65]); o.z = pk4_fp8(s[8 * 65], s[9 * 65], s[10 * 65], s[11 * 65]); o.w = pk4_fp8(s[12 * 65], s[13 * 65], s[14 * 65], s[15 * 65]);
        *(GAS v4u*)(WT + (size_t)(drow0 + n) * Kp + k0 + 16 * c) = o; }
    LDS_WAIT(); asm volatile("" ::: "memory");
}
__device__ __forceinline__ void phase_weights(const Ctx& C, int l, int widx, int nwork) {
    if (widx < 0) return;
    LAS float* scr = (LAS float*)(C.lds + C.wave * 16640);
    const int gw = widx * NWAVES + C.wave, NGW = nwork * NWAVES;
    constexpr int I0 = 16 * 92, I1 = 8 * 8, I2 = 3 * 8 * 16, I3 = 16 * 16, I4 = 16 * 16 * 8, I5 = I4, I6 = 16 * 8 * 16;
    for (int it = gw; it < I0 + I1 + I2 + I3 + I4 + I5 + I6; it += NGW) {
        int r = it;
        if (r < I0) { const int kb = r / 92, nb = r % 92; if (W8_ALL) transpose_item8(C.in[I_WIN] + (size_t)l * 1024 * INW, INW, 1024, WSP(unsigned char, WS_WIN), 64 * kb, 64 * nb, 64 * nb, 64.f, scr, C.lane);
            else if (nb < 44 || GATE_BF16) transpose_item(C.in[I_WIN] + (size_t)l * 1024 * INW, INW, 1024, WSP(bf16, WS_WIN), 64 * kb, 64 * nb, 64 * nb, scr, C.lane);
            else transpose_item8(C.in[I_WIN] + (size_t)l * 1024 * INW, INW, 1024, WSP(unsigned char, WS_WIN8), 64 * kb, 64 * nb, 64 * nb - 2816, 64.f, scr, C.lane); continue; } r -= I0;
        if (r < I1) { const int kb = r / 8, nb = r % 8; transpose_item(C.in[I_WGLU] + (size_t)l * 512 * 512, 512, 512, WSP(bf16, WS_WGLU), 64 * kb, 64 * nb, 64 * nb, scr, C.lane); continue; } r -= I1;
        if (r < I2) { const int i = r / 128, q = r % 128, kb = q / 16, nb = q % 16; transpose_item(C.in[I_WBR] + (size_t)(l * 3 + i) * 512 * 1024, 1024, 512, WSP(bf16, WS_WBR) + (size_t)i * 1024 * 512, 64 * kb, 64 * nb, 64 * nb, scr, C.lane); continue; } r -= I2;
        if (r < I3) { const int kb = r / 16, nb = r % 16; transpose_item(C.in[I_WOUT] + (size_t)l * 1024 * 1024, 1024, 1024, (bf16*)(C.ws + wout_off(l)), 64 * kb, 64 * nb, 64 * nb, scr, C.lane); continue; } r -= I3;
        if (r < I4 + I5) { const int up = r >= I4; if (up) r -= I4; const int e = r / 128, q = r % 128, kb = q / 8, nb = q % 8, n0 = 64 * nb;
            if (FP8_MOE) transpose_item8((up ? C.in[I_MU] : C.in[I_MG]) + (size_t)(l * 16 + e) * 1024 * 512, 512, 1024, (unsigned char*)(C.ws + moe1_off(l)) + (size_t)e * 1024 * 1024, 64 * kb, n0, (n0 / 128) * 256 + (n0 % 128) + (up ? 128 : 0), 64.f, scr, C.lane);
            else transpose_item((up ? C.in[I_MU] : C.in[I_MG]) + (size_t)(l * 16 + e) * 1024 * 512, 512, 1024, WSP(bf16, WS_MOE1) + (size_t)e * 1024 * 1024, 64 * kb, n0, (n0 / 128) * 256 + (n0 % 128) + (up ? 128 : 0), scr, C.lane); continue; } r -= I4 + I5;
        { const int e = r / 128, q = r % 128, kb = q / 16, nb = q % 16; if (FP8_MOE) transpose_item8(C.in[I_MD] + (size_t)(l * 16 + e) * 512 * 1024, 1024, 512, (unsigned char*)(C.ws + moe2_off(l)) + (size_t)e * 1024 * 512, 64 * kb, 64 * nb, 64 * nb, 32.f, scr, C.lane);
            else transpose_item(C.in[I_MD] + (size_t)(l * 16 + e) * 512 * 1024, 1024, 512, WSP(bf16, WS_MOE2) + (size_t)e * 1024 * 512, 64 * kb, 64 * nb, 64 * nb, scr, C.lane); }
    }
}

__device__ __forceinline__ void phase_mod(const Ctx& C) {
    LAS float* sc = (LAS float*)(C.lds);
    LAS float* red = (LAS float*)(C.lds + 20480);
    for (int i = C.tid; i < 5 * 1024; i += 512) { const int c = i >> 10, k = i & 1023; const float v = c < 4 ? C.in[I_C][c * 1024 + k] : C.in[I_CCTX][k]; sc[i] = v * fsigmoid(v); }
    __syncthreads();
    for (int it = C.vcu; it < NLAYER * 96; it += C.G) {
        const int l = it / 96, col = (it % 96) * 64 + C.lane, k0 = C.wave * 128;
        const float* W = C.in[I_WMOD] + (size_t)l * 1024 * 6144 + (size_t)k0 * 6144 + col;
        float a0 = 0.f, a1 = 0.f, a2 = 0.f, a3 = 0.f, a4 = 0.f;
#pragma unroll 16
        for (int k = 0; k < 128; ++k) { const float w = W[(size_t)k * 6144]; a0 += sc[k0 + k] * w; a1 += sc[1024 + k0 + k] * w; a2 += sc[2048 + k0 + k] * w; a3 += sc[3072 + k0 + k] * w; a4 += sc[4096 + k0 + k] * w; }
        LAS float* r = red + C.wave * 320 + C.lane; r[0] = a0; r[64] = a1; r[128] = a2; r[192] = a3; r[256] = a4;
        __syncthreads();
        if (C.tid < 320) { const int c = C.tid >> 6; float s = C.in[I_BMOD][l * 6144 + col];
#pragma unroll
            for (int w = 0; w < 8; ++w) s += red[w * 320 + C.tid];
            WSP(float, WS_MOD)[(size_t)(l * 5 + c) * 6144 + col] = s; }
        __syncthreads();
    }
}

__device__ __forceinline__ void phase_s5mats(const Ctx& C, int l, int w) {
    if (w < 0 || w >= 128) return;
    const int g = w >> 2, part = w & 3, tid = C.tid;
    LAS f32x2* POW = (LAS f32x2*)(C.lds);
    LAS f32x2* CC = (LAS f32x2*)(C.lds + 33792);
    LAS f32x2* BB = (LAS f32x2*)(C.lds + 50176);
    LAS f32x2* COEF = (LAS f32x2*)(C.lds + 66560);
    LAS bf16* KT = (LAS bf16*)(C.lds + 67584);
    LAS float* WT = (LAS float*)(C.lds + 101376);
    __syncthreads();
    if (tid < 128) {
        const int d = tid >> 6, p = tid & 63; const int li = ((l * 2 + d) * 32 + g) * 64 + p;
        const float re = C.in[I_LRE][li], im = C.in[I_LIM][li], dt = __expf(C.in[I_LDT][(l * 2 + d) * 32 + g]);
        for (int tau = 0; tau <= 32; ++tau) { const float mag = __expf(re * dt * (float)tau), rev = im * dt * (float)tau * 0.15915494309189535f;
            const float wr = mag * cos_rev(rev), wi = mag * sin_rev(rev);
            POW[(d * 33 + tau) * 64 + p] = (f32x2){wr, wi}; if (tau < 32) { WT[((d * 64 + p) * 2) * 32 + tau] = wr; WT[((d * 64 + p) * 2 + 1) * 32 + tau] = wi; } }
        const float mag = __expf(re * dt), rev = im * dt * 0.15915494309189535f; const float lr = mag * cos_rev(rev) - 1.f, lim = mag * sin_rev(rev);
        const float den = 1.f / (re * re + im * im);
        COEF[tid] = (f32x2){(lr * re + lim * im) * den, (lim * re - lr * im) * den};
    }
    __syncthreads();
    for (int i = tid; i < 2048; i += 512) {
        const int d = i >> 10, p = (i >> 4) & 63, h = i & 15; const size_t bi = (((size_t)(l * 2 + d) * 32 + g) * 64 + p) * 16 + h;
        const float br = C.in[I_BRE][bi], bi_ = C.in[I_BIM][bi]; const f32x2 cf = COEF[d * 64 + p];
        BB[i] = (f32x2){cf.x * br - cf.y * bi_, cf.x * bi_ + cf.y * br};
        const int h2 = (i >> 6) & 15, p2 = i & 63; const size_t ci = (((size_t)(l * 2 + d) * 32 + g) * 16 + h2) * 64 + p2;
        CC[i] = (f32x2){C.in[I_CRE][ci], C.in[I_CIM][ci]};
    }
    __syncthreads();
    {
        const int wv = tid >> 6, ln = tid & 63, hi = ln >> 5, i = ln & 31, h = 2 * wv + (i >> 4), hp = i & 15;
        f32x16 a0 = f32x16{}, a1 = f32x16{};
#pragma unroll 4
        for (int p = 0; p < 64; ++p) {
            const f32x2 c0 = CC[h * 64 + p], b0 = BB[p * 16 + hp], c1 = CC[1024 + h * 64 + p], b1 = BB[1024 + p * 16 + hp];
            const float x0 = hi == 0 ? (c0.x * b0.x - c0.y * b0.y) : -(c0.x * b0.y + c0.y * b0.x);
            const float x1 = hi == 0 ? (c1.x * b1.x - c1.y * b1.y) : -(c1.x * b1.y + c1.y * b1.x);
            a0 = __builtin_amdgcn_mfma_f32_32x32x2f32(x0, WT[(p * 2 + hi) * 32 + i], a0, 0, 0, 0);
            a1 = __builtin_amdgcn_mfma_f32_32x32x2f32(x1, WT[((64 + p) * 2 + hi) * 32 + i], a1, 0, 0, 0);
        }
        const float* sd = C.in[I_SSMD] + l * 512 + g * 16;
#pragma unroll
        for (int r = 0; r < 16; ++r) { const int rl = (r & 3) + 8 * (r >> 2) + 4 * hi, hh = 2 * wv + (rl >> 4), hq = rl & 15;
            float f = a0[r]; if (i == 0) f += a1[r] + (hh == hq ? sd[hh] : 0.f);
            KT[((31 + i) * 16 + hh) * 16 + hq] = (bf16)f2bf(f);
            if (i > 0) KT[((31 - i) * 16 + hh) * 16 + hq] = (bf16)f2bf(a1[r]); }
    }
    __syncthreads();
    bf16* B1 = WSP(bf16, WS_BT1) + (size_t)g * 768 * 512; bf16* B2 = WSP(bf16, WS_BT2) + (size_t)g * 512 * 256;
    for (int i = tid; i < 128 * 64; i += 512) {
        const int n = part * 128 + (i >> 6), ch = i & 63, t = n >> 4, h = n & 15, s = ch >> 1, hp0 = (ch & 1) * 8;
        *(GAS v4u*)(B1 + (size_t)n * 512 + ch * 8) = *(const LAS v4u*)(KT + ((t - s + 31) * 16 + h) * 16 + hp0);
    }
    for (int i = tid; i < 64 * 64; i += 512) {
        const int nn = part * 64 + (i >> 6), ch = i & 63, d = nn >> 7, p = (nn & 127) >> 1, ri = nn & 1, s = ch >> 1, hp0 = (ch & 1) * 8;
        const f32x2 w = POW[(d * 33 + (d == 0 ? 31 - s : s)) * 64 + p]; float v[8];
#pragma unroll
        for (int j = 0; j < 8; ++j) { const f32x2 b = BB[d * 1024 + p * 16 + hp0 + j]; v[j] = ri == 0 ? (w.x * b.x - w.y * b.y) : (w.x * b.y + w.y * b.x); }
        v4u o; o.x = pk2(v[0], v[1]); o.y = pk2(v[2], v[3]); o.z = pk2(v[4], v[5]); o.w = pk2(v[6], v[7]);
        *(GAS v4u*)(B1 + (size_t)(512 + nn) * 512 + ch * 8) = o;
    }
    for (int i = tid; i < 128 * 32; i += 512) {
        const int n = part * 128 + (i >> 5), ch = i & 31, t = n >> 4, h = n & 15, d = ch >> 4, p0 = (ch & 15) * 4; float v[8];
#pragma unroll
        for (int j = 0; j < 4; ++j) { const f32x2 c = CC[d * 1024 + h * 64 + p0 + j], w = POW[(d * 33 + (d == 0 ? t + 1 : 32 - t)) * 64 + p0 + j];
            v[2 * j] = c.x * w.x - c.y * w.y; v[2 * j + 1] = -(c.x * w.y + c.y * w.x); }
        v4u o; o.x = pk2(v[0], v[1]); o.y = pk2(v[2], v[3]); o.z = pk2(v[4], v[5]); o.w = pk2(v[6], v[7]);
        *(GAS v4u*)(B2 + (size_t)n * 256 + ch * 8) = o;
    }
    __syncthreads();
}

template <int MODE>
__device__ __forceinline__ void phase_rows(const Ctx& C, int l) {
    const int gw = C.vcu * NWAVES + C.wave, NGW = C.G * NWAVES, lane = C.lane;
    const float* MODl = WSP(float, WS_MOD) + (size_t)(MODE == 2 ? 0 : l) * 5 * 6144;
    const float* MODp = WSP(float, WS_MOD) + (size_t)(l > 0 ? l - 1 : 0) * 5 * 6144;
    const bf16* YS = WSP(bf16, WS_YSLOT);
    LAS float* GT = (LAS float*)C.lds;
    LAS float* GM = GT + 5120;
    LAS float* SH = GT + 10240;
    __syncthreads();
    for (int i = C.tid; i < 5120; i += 512) { const int cond = i >> 10, k = i & 1023;
        if (MODE != 0) GT[i] = MODp[cond * 6144 + 5 * 1024 + k];
        if (MODE != 2) { GM[i] = C.in[I_N1G][l * D + k] * (MODl[cond * 6144 + 1024 + k] + 1.f); SH[i] = MODl[cond * 6144 + k]; }
        else if (i < 1024) GM[i] = C.in[I_FNG][k]; }
    __syncthreads();
    f32x4 nx[4]; v2u nb[4], na[4], nc[4];
#define ROWS_LOAD(mm) do { const int m_ = (mm); \
        if (MODE == 0) { const GAS f32x4* xr = (const GAS f32x4*)in_row(C, m_) + lane; _Pragma("unroll") for (int q = 0; q < 4; ++q) nx[q] = xr[64 * q]; } \
        else { const GAS v2u* xr = (const GAS v2u*)xs_row(C, m_) + lane; const GAS v2u* y0 = (const GAS v2u*)(YS + (size_t)(2 * m_) * D) + lane; const GAS v2u* y1 = (const GAS v2u*)(YS + (size_t)(2 * m_ + 1) * D) + lane; \
            _Pragma("unroll") for (int q = 0; q < 4; ++q) { nb[q] = xr[64 * q]; na[q] = y0[64 * q]; nc[q] = y1[64 * q]; } } } while (0)
    int m = gw; if (MODE == 2) { while (m < T && (m % LB) < CTX) m += NGW; }
    if (m < T) ROWS_LOAD(m);
    while (m < T) {
        const int b = m / LB, j = m - b * LB, cond = j < CTX ? 4 : b;
        f32x4 v[4];
        if (MODE == 0) {
#pragma unroll
            for (int q = 0; q < 4; ++q) v[q] = nx[q]; }
        else { const LAS f32x4* g2 = (const LAS f32x4*)(GT + cond * 1024) + lane;
#pragma unroll
            for (int q = 0; q < 4; ++q) { const f32x4 g = g2[64 * q]; const v2u a = na[q], c = nc[q], xb_ = nb[q];
                v[q] = (f32x4){bflo(xb_.x), bfhi(xb_.x), bflo(xb_.y), bfhi(xb_.y)} + g * (f32x4){bflo(a.x) + bflo(c.x), bfhi(a.x) + bfhi(c.x), bflo(a.y) + bflo(c.y), bfhi(a.y) + bfhi(c.y)}; } }
        int mn = m + NGW; if (MODE == 2) { while (mn < T && (mn % LB) < CTX) mn += NGW; }
        if (mn < T) ROWS_LOAD(mn);
        float ss = 0.f;
#pragma unroll
        for (int q = 0; q < 4; ++q) ss += (v[q].x * v[q].x + v[q].y * v[q].y) + (v[q].z * v[q].z + v[q].w * v[q].w);
        const float rstd = 1.f / sqrtf(wave_sum(ss, lane) * (1.f / D) + EPS);
        if (MODE == 2) { GAS f32x4* o = (GAS f32x4*)(C.out + (size_t)(b * SEQ + j - CTX) * D) + lane; const LAS f32x4* fg = (const LAS f32x4*)GM + lane;
#pragma unroll
            for (int q = 0; q < 4; ++q) o[64 * q] = v[q] * rstd * fg[64 * q]; }
        else { GAS v2u* xo = (GAS v2u*)xs_row(C, m) + lane; GAS v2u* ho = (GAS v2u*)(WSP(bf16, WS_HB) + (size_t)m * D) + lane; GAS unsigned* h8 = (GAS unsigned*)(WSP(unsigned char, WS_HB8) + (size_t)m * D) + lane;
            const LAS f32x4* gm = (const LAS f32x4*)(GM + cond * 1024) + lane; const LAS f32x4* sh = (const LAS f32x4*)(SH + cond * 1024) + lane;
#pragma unroll
            for (int q = 0; q < 4; ++q) { xo[64 * q] = (v2u){pk2(v[q].x, v[q].y), pk2(v[q].z, v[q].w)}; const f32x4 h = v[q] * rstd * gm[64 * q] + sh[64 * q]; if (!W8_ALL) ho[64 * q] = (v2u){pk2(h.x, h.y), pk2(h.z, h.w)}; if (H8_WRITE) h8[64 * q] = pk4_fp8(h.x, h.y, h.z, h.w); } }
        m = mn;
    }
#undef ROWS_LOAD
}

__device__ __forceinline__ void phase_qkprep(const Ctx& C, int l) {
    const int gw = C.vcu * NWAVES + C.wave, NGW = C.G * NWAVES, lane = C.lane, s8 = lane & 7;
    const float* qg = C.in[I_QNG] + l * 64 + 8 * s8; const float* kg = C.in[I_KNG] + l * 64 + 8 * s8;
    float gq[8], gk[8];
#pragma unroll
    for (int i = 0; i < 8; ++i) { gq[i] = qg[i]; gk[i] = kg[i]; }
    const int ax = s8 >> 2, f0 = 8 * (s8 & 1);
    float inv[8];
#pragma unroll
    for (int i = 0; i < 8; ++i) inv[i] = exp2f(-(float)(f0 + i) * 0.8304820237218406f) * 0.15915494309189535f;
    const int kl = lane & 15;
    v4u wq, wk;
    if (gw < T) { wq = *((const GAS v4u*)(WSP(bf16, WS_QA) + (size_t)gw * 512) + lane); wk = *((const GAS v4u*)(WSP(bf16, WS_KA) + (size_t)gw * 128) + kl); }
    for (int m = gw; m < T; m += NGW) {
        const int b = m / LB, j = m - b * LB; const bool lat = j >= CTX; const int tt = j - CTX; const float pos = (float)(ax == 0 ? (tt >> 6) : (tt & 63));
        const v4u cq = wq, ck = wk;
        if (m + NGW < T) { wq = *((const GAS v4u*)(WSP(bf16, WS_QA) + (size_t)(m + NGW) * 512) + lane); wk = *((const GAS v4u*)(WSP(bf16, WS_KA) + (size_t)(m + NGW) * 128) + kl); }
        float cs[8], sn[8];
#pragma unroll
        for (int i = 0; i < 8; ++i) { cs[i] = lat ? cos_rev(pos * inv[i]) : 1.f; sn[i] = lat ? sin_rev(pos * inv[i]) : 0.f; }
#pragma unroll
        for (int which = 0; which < 2; ++which) {
            const v4u w = which == 0 ? cq : ck; float x[8] = {bflo(w.x), bfhi(w.x), bflo(w.y), bfhi(w.y), bflo(w.z), bfhi(w.z), bflo(w.w), bfhi(w.w)};
            float ss = 0.f;
#pragma unroll
            for (int i = 0; i < 8; ++i) ss += x[i] * x[i];
            ss += dpp_mov<0xB1, 0xF>(ss); ss += dpp_mov<0x4E, 0xF>(ss); ss += dpp_mov<0x141, 0xF>(ss);
            const float rstd = 1.f / sqrtf(ss * (1.f / 64.f) + EPS);
            float y[8];
#pragma unroll
            for (int i = 0; i < 8; ++i) { const float xn = x[i] * rstd * (which == 0 ? gq[i] : gk[i]); const float other = dpp_mov<0x4E, 0xF>(xn);
                y[i] = (s8 & 2) ? (xn * cs[i] + other * sn[i]) : (xn * cs[i] - other * sn[i]); }
            const float sc = which == 0 ? C2 : 1.f;
            v4u o; o.x = pk2(y[0] * sc, y[1] * sc); o.y = pk2(y[2] * sc, y[3] * sc); o.z = pk2(y[4] * sc, y[5] * sc); o.w = pk2(y[6] * sc, y[7] * sc);
            if (which == 0) *((GAS v4u*)(WSP(bf16, WS_QA) + (size_t)m * 512) + lane) = o;
            else if (lane < 16) *((GAS v4u*)(WSP(bf16, WS_KA) + (size_t)m * 128) + lane) = o;
        }
    }
}

__device__ __forceinline__ void phase_carry(const Ctx& C, int l) {
    static_assert(NCH == 264, "11 batches of 24 chunks");
    LAS f32x2* SL = (LAS f32x2*)C.lds;
    for (int t = (int)blockIdx.x; t < NB * 64; t += C.G) {
        const int b = t >> 6, g = (t >> 1) & 31, d = t & 1;
        const GAS char* Sb = (const GAS char*)(WSP(float, WS_SST) + (size_t)(b * NCH) * 8192 + g * 256 + d * 128);
        GAS char* Xb = (GAS char*)(WSP(bf16, WS_XST) + (size_t)(b * NCH) * 8192 + g * 256 + d * 128);
        __syncthreads();
        v4u pc[17];
#pragma unroll
        for (int j = 0; j < 17; ++j) { const int q = C.tid + 512 * j; if (q < NCH * 32) pc[j] = *(const GAS v4u*)(Sb + (size_t)(q >> 5) * 32768 + (q & 31) * 16); }
#pragma unroll
        for (int j = 0; j < 17; ++j) { const int q = C.tid + 512 * j; if (q < NCH * 32) *(LAS v4u*)((LAS char*)SL + q * 16) = pc[j]; }
        __syncthreads();
        if (C.wave == 0) {
            const int p = C.lane, li = ((l * 2 + d) * 32 + g) * 64 + p;
            const float re = C.in[I_LRE][li], im = C.in[I_LIM][li], dt = __expf(C.in[I_LDT][(l * 2 + d) * 32 + g]);
            const float mag = __expf(re * dt * 32.f), rev = im * dt * 32.f * 0.15915494309189535f; const float Lr = mag * cos_rev(rev), Li = mag * sin_rev(rev);
            const unsigned lx = (unsigned)p * 4u;
            float sr = 0.f, si = 0.f;
#define CARRY_CH(k_) (d == 0 ? (k_) : ((k_) < 8 ? 7 - (k_) : 271 - (k_)))
            for (int bt = 0; bt < 11; ++bt) { f32x2 cur[24];
#pragma unroll
                for (int k = 0; k < 24; ++k) cur[k] = SL[CARRY_CH(bt * 24 + k) * 64 + p];
#pragma unroll
                for (int k = 0; k < 24; ++k) { *(GAS unsigned*)(Xb + (size_t)CARRY_CH(bt * 24 + k) * 16384 + lx) = cvt_pk_bf16(sr, si);
                    const float nr = __builtin_fmaf(Lr, sr, __builtin_fmaf(-Li, si, cur[k].x)), ni = __builtin_fmaf(Lr, si, __builtin_fmaf(Li, sr, cur[k].y)); sr = nr; si = ni; } }
#undef CARRY_CH
        }
    }
    __syncthreads();
}

__device__ __forceinline__ void phase_norm2(const Ctx& C, int l) {
    LAS float* TILE = (LAS float*)C.lds;
    LAS float* PART = (LAS float*)(C.lds + 65792);
    LAS unsigned* REC = (LAS unsigned*)(C.lds + 73984);
    LAS float* LG = (LAS float*)(C.lds + 78080);
    LAS unsigned* LCNT = (LAS unsigned*)(C.lds + 94464);
    LAS float* GAM = (LAS float*)(C.lds + 94720);
    LAS float* SHF = (LAS float*)(C.lds + 115200);
    const int lane = C.lane, tid = C.tid;
    if (tid < 32) LCNT[tid] = 0u;
    const float* MODl = WSP(float, WS_MOD) + (size_t)l * 5 * 6144;
    for (int i = tid; i < 5 * 1024; i += 512) { const int cond = i >> 10, k = i & 1023; GAM[i] = C.in[I_N2G][l * D + k] * (MODl[cond * 6144 + 4096 + k] + 1.f); SHF[i] = MODl[cond * 6144 + 3072 + k]; }
    int nrows = 0; for (int m = C.vcu; m < T; m += C.G) ++nrows;
    __syncthreads();
    const int fn = lane & 15, kq = lane >> 4;
    float bw[32];
#pragma unroll
    for (int j = 0; j < 32; ++j) bw[j] = C.in[I_RW][(128 * C.wave + 32 * kq + j) * 16 + fn];
    v2u nx[2][4];
#define N2_LOAD(ii) do { _Pragma("unroll") for (int rr = 0; rr < 2; ++rr) { const int i_ = (ii) + rr * NWAVES; const int m_ = C.vcu + C.G * (i_ < nrows ? i_ : (ii)); const GAS v2u* xr = (const GAS v2u*)xs_row(C, m_) + lane; \
        _Pragma("unroll") for (int q = 0; q < 4; ++q) nx[rr][q] = xr[64 * q]; } } while (0)
    if (C.wave < nrows) N2_LOAD(C.wave);
    for (int i0 = 0; i0 < nrows; i0 += 2 * NWAVES) {
        const int i = i0 + C.wave; const bool has0 = i < nrows, has1 = i + NWAVES < nrows;
        if (has0) {
#pragma unroll
            for (int rr = 0; rr < 2; ++rr) { const int ir = (rr && has1) ? i + NWAVES : i; const int m = C.vcu + C.G * ir, cond = cond_of(m);
                GAS unsigned* h8 = (GAS unsigned*)(WSP(unsigned char, WS_HB8) + (size_t)m * D) + lane;
                const LAS f32x4* gm = (const LAS f32x4*)(GAM + cond * 1024) + lane; const LAS f32x4* sh = (const LAS f32x4*)(SHF + cond * 1024) + lane;
                float ss = 0.f; f32x4 xf[4];
#pragma unroll
                for (int q = 0; q < 4; ++q) { const v2u w_ = nx[rr][q]; const f32x4 v = (f32x4){bflo(w_.x), bfhi(w_.x), bflo(w_.y), bfhi(w_.y)}; xf[q] = v; ss += (v.x * v.x + v.y * v.y) + (v.z * v.z + v.w * v.w); }
                const float rstd = 1.f / sqrtf(wave_sum(ss, lane) * (1.f / D) + EPS);
#pragma unroll
                for (int q = 0; q < 4; ++q) { const f32x4 h = xf[q] * rstd * gm[64 * q] + sh[64 * q];
                    *(LAS f32x4*)(TILE + (C.wave + NWAVES * rr) * 1028 + 256 * q + 4 * lane) = h;
                    if (rr == 0 || has1) h8[64 * q] = pk4_fp8(h.x, h.y, h.z, h.w); } }
            if (i + 2 * NWAVES < nrows) N2_LOAD(i + 2 * NWAVES);
        } else {
#pragma unroll
            for (int rr = 0; rr < 2; ++rr)
#pragma unroll
                for (int q = 0; q < 4; ++q) *(LAS f32x4*)(TILE + (C.wave + NWAVES * rr) * 1028 + 256 * q + 4 * lane) = (f32x4){0.f, 0.f, 0.f, 0.f};
        }
        __syncthreads();
        f32x4 dacc = (f32x4){0.f, 0.f, 0.f, 0.f};
#pragma unroll
        for (int j = 0; j < 8; ++j) { const f32x4 a = *(const LAS f32x4*)(TILE + fn * 1028 + 128 * C.wave + 32 * kq + 4 * j);
#pragma unroll
            for (int e = 0; e < 4; ++e) dacc = __builtin_amdgcn_mfma_f32_16x16x4f32(a[e], bw[4 * j + e], dacc, 0, 0, 0); }
#pragma unroll
        for (int r = 0; r < 4; ++r) PART[C.wave * 256 + (4 * kq + r) * 16 + fn] = dacc[r];
        __syncthreads();
        if (tid < 256) { float sum = 0.f;
#pragma unroll
            for (int w = 0; w < NWAVES; ++w) sum += PART[w * 256 + tid];
            const int ri = i0 + (tid >> 4); if (ri < nrows) LG[ri * 16 + (tid & 15)] = sum; }
    }
#undef N2_LOAD
    __syncthreads();
    float rb[16];
#pragma unroll
    for (int e = 0; e < 16; ++e) rb[e] = C.in[I_RB][e];
    for (int i = tid; i < nrows; i += 512) {
        float lg[16];
#pragma unroll
        for (int q = 0; q < 4; ++q) { const f32x4 t = *(const LAS f32x4*)(LG + i * 16 + 4 * q); lg[4 * q] = t.x; lg[4 * q + 1] = t.y; lg[4 * q + 2] = t.z; lg[4 * q + 3] = t.w; }
        float mx = lg[0];
#pragma unroll
        for (int e = 1; e < 16; ++e) mx = fmaxf(mx, lg[e]);
        float pr[16], sel[16], sum = 0.f;
#pragma unroll
        for (int e = 0; e < 16; ++e) { pr[e] = __expf(lg[e] - mx); sum += pr[e]; }
        const float rs = 1.f / sum;
#pragma unroll
        for (int e = 0; e < 16; ++e) { pr[e] *= rs; sel[e] = pr[e] + rb[e]; }
        float bestv = -1e30f; int best = 0;
#pragma unroll
        for (int gq = 0; gq < 4; ++gq) { float m1 = -1e30f, m2 = -1e30f;
#pragma unroll
            for (int k = 0; k < 4; ++k) { const float s_ = sel[4 * gq + k]; if (s_ > m1) { m2 = m1; m1 = s_; } else if (s_ > m2) m2 = s_; }
            const float gs = m1 + m2; if (gs > bestv) { bestv = gs; best = gq; } }
        float s4[4], p4[4];
#pragma unroll
        for (int k = 0; k < 4; ++k) { s4[k] = best == 0 ? sel[k] : best == 1 ? sel[4 + k] : best == 2 ? sel[8 + k] : sel[12 + k]; p4[k] = best == 0 ? pr[k] : best == 1 ? pr[4 + k] : best == 2 ? pr[8 + k] : pr[12 + k]; }
        int i0 = 0; float v0 = s4[0], q0 = p4[0];
#pragma unroll
        for (int k = 1; k < 4; ++k) if (s4[k] > v0) { v0 = s4[k]; i0 = k; q0 = p4[k]; }
        int i1 = i0 == 0 ? 1 : 0; float v1 = -1e30f, q1 = p4[i0 == 0 ? 1 : 0];
#pragma unroll
        for (int k = 0; k < 4; ++k) if (k != i0 && s4[k] > v1) { v1 = s4[k]; i1 = k; q1 = p4[k]; }
        const int e0 = 4 * best + i0, e1 = 4 * best + i1; const float wn = 1.f / (q0 + q1);
        const unsigned lp0 = atomicAdd((unsigned*)(LCNT + e0), 1u), lp1 = atomicAdd((unsigned*)(LCNT + e1), 1u);
        REC[i * 4 + 0] = (unsigned)e0 | ((unsigned)e1 << 8) | (lp0 << 16); REC[i * 4 + 1] = lp1; REC[i * 4 + 2] = __float_as_uint(q0 * wn); REC[i * 4 + 3] = __float_as_uint(q1 * wn);
    }
    __syncthreads();
    if (tid < 16) LCNT[16 + tid] = __hip_atomic_fetch_add((unsigned*)(C.ctl + CW_CNT + l * 1024 + 64 * tid), LCNT[tid], RLX_AGENT);
    __syncthreads();
    int* LIST = WSP(int, WS_LIST); float* LWG = WSP(float, WS_LW);
    for (int i = tid; i < nrows; i += 512) { const int m = C.vcu + C.G * i; const unsigned r0 = REC[i * 4], r1 = REC[i * 4 + 1];
        const int e0 = r0 & 255, e1 = (r0 >> 8) & 255; const unsigned lp0 = r0 >> 16, lp1 = r1;
        const size_t p0 = (size_t)e0 * T + LCNT[16 + e0] + lp0, p1 = (size_t)e1 * T + LCNT[16 + e1] + lp1;
        LIST[p0] = 2 * m; LIST[p1] = 2 * m + 1; LWG[p0] = __uint_as_float(REC[i * 4 + 2]); LWG[p1] = __uint_as_float(REC[i * 4 + 3]); }
    __syncthreads();
}
using pg8::Unit;
typedef f32x4 Acc[2][2][4][2];
__device__ __forceinline__ v4u pack8(const f32x4& a, const f32x4& b) { v4u w; w.x = cvt_pk_bf16(a[0], a[1]); w.y = cvt_pk_bf16(a[2], a[3]); w.z = cvt_pk_bf16(b[0], b[1]); w.w = cvt_pk_bf16(b[2], b[3]); return w; }
__device__ __forceinline__ void unpack8(const v4u& w, f32x4& a, f32x4& b) { a = (f32x4){bflo(w.x), bfhi(w.x), bflo(w.y), bfhi(w.y)}; b = (f32x4){bflo(w.z), bfhi(w.z), bflo(w.w), bfhi(w.w)}; }
#ifndef WT_MODE
#define WT_MODE 0
#endif
__device__ __forceinline__ void st16(void* p, const v4u& v) {
#if WT_MODE == 1
    asm volatile("global_store_dwordx4 %0, %1, off sc0 sc1" :: "v"(p), "v"(v) : "memory");
#elif WT_MODE == 2
    asm volatile("global_store_dwordx4 %0, %1, off nt" :: "v"(p), "v"(v) : "memory");
#else
    *(GAS v4u*)p = v;
#endif
}
__device__ __forceinline__ int chunk_m0(int cr) { return (cr / NCH) * LB + (cr % NCH) * 32; }

struct PWin {
    static constexpr bool EARLY_AOFF = false, FP8 = false; unsigned char* ws; int G, c; int K; unsigned kstepA;
    __device__ __forceinline__ bool next(int i, Unit& u) const { const long L = (long)i * G + c; if (L >= NPAN * 11) return false; pg8::static_decode((int)L, NPAN, 11, u.pm, u.pn); u.z = 0; return true; }
    __device__ __forceinline__ const char* a_base(const Unit& u) const { return (const char*)(ws + WS_HB) + (size_t)u.pm * 256 * 1024 * 2; }
    __device__ __forceinline__ unsigned a_off(const Unit&, int h, int R, int Cc) const { return (unsigned)((h * 128 + R) * 1024 + Cc) * 2u; }
    __device__ __forceinline__ const char* b_base(const Unit& u) const { return (const char*)(ws + WS_WIN) + (size_t)u.pn * 256 * 1024 * 2; }
    __device__ __forceinline__ void epi(const Acc& acc, const Unit& u, int wr, int wc, int fr, int fq) const {
        const int row0 = u.pm * 256 + wr * 64 + fr;
#pragma unroll
        for (int bj = 0; bj < 2; ++bj) {
            const int cb = u.pn * 256 + bj * 128; bf16* dst; int ld, col, mode = 0; float sc = 1.f;
            if (cb < 512) { dst = (bf16*)(ws + WS_U) + ((size_t)((cb + wc * 32 + 8 * fq) >> 4) * T) * 16 + ((8 * fq) & 15) - (wc * 32 + 8 * fq); ld = 16; col = 0; }
            else if (cb < 1024) { dst = (bf16*)(ws + WS_QA); ld = 512; col = cb - 512; }
            else if (cb == 1024) { dst = (bf16*)(ws + WS_KA); ld = 128; col = 0; }
            else if (cb == 1152) { dst = (bf16*)(ws + WS_VA); ld = 128; col = 0; }
            else if (cb < 1792) { dst = (bf16*)(ws + WS_QN); ld = 512; col = cb - 1280; sc = C2; }
            else if (cb < 2304) { dst = (bf16*)(ws + WS_KN); ld = 512; col = cb - 1792; }
            else { dst = (bf16*)(ws + WS_VN); ld = 512; col = cb - 2304; }
            const int c0 = col + wc * 32 + 8 * fq;
#pragma unroll
            for (int ai = 0; ai < 2; ++ai)
#pragma unroll
                for (int m = 0; m < 4; ++m) { f32x4 v0 = acc[ai][bj][m][0], v1 = acc[ai][bj][m][1];
                    if (mode) { v0 = (f32x4){fsigmoid(v0[0]), fsigmoid(v0[1]), fsigmoid(v0[2]), fsigmoid(v0[3])}; v1 = (f32x4){fsigmoid(v1[0]), fsigmoid(v1[1]), fsigmoid(v1[2]), fsigmoid(v1[3])}; }
                    else { v0 = v0 * sc; v1 = v1 * sc; }
                    st16(dst + (size_t)(row0 + ai * 128 + m * 16) * ld + c0, pack8(v0, v1)); __builtin_amdgcn_sched_barrier(0); }
        }
    }
};

struct PWin8 {
    static constexpr bool EARLY_AOFF = false, FP8 = true; unsigned char* ws; int G, c; int K; unsigned kstepA;
    __device__ __forceinline__ bool next(int i, Unit& u) const { const long L = (long)i * G + c; if (L >= 2 * NPAN * 23) return false; pg8::static_decode((int)L, 2 * NPAN, 23, u.pm, u.pn); u.z = 0; return true; }
    __device__ __forceinline__ const char* a_base(const Unit& u) const { return (const char*)(ws + WS_HB8) + (size_t)u.pm * 128 * 1024; }
    __device__ __forceinline__ unsigned a_off(const Unit&, int R, int Cc) const { return (unsigned)(R * 1024 + Cc * 2); }
    __device__ __forceinline__ const char* b_base(const Unit& u) const { return (const char*)(ws + WS_WIN) + (size_t)u.pn * 256 * 1024; }
    __device__ __forceinline__ void epi(const f32x4 (&acc)[2][4][2], f32x4 (&)[2][4][2], const Unit& u, int wr, int wc, int fr, int fq) const {
        const int row0 = u.pm * 128 + wr * 64 + fr;
#pragma unroll
        for (int bj = 0; bj < 2; ++bj) {
            const int cb = u.pn * 256 + bj * 128;
            if (cb >= 2816) { const int c0 = cb - 2816 + wc * 32 + 8 * fq;
#pragma unroll
                for (int m = 0; m < 4; ++m) { f32x4 v0 = acc[bj][m][0] * (1.f / 64.f), v1 = acc[bj][m][1] * (1.f / 64.f);
                    v0 = (f32x4){fsigmoid(v0[0]), fsigmoid(v0[1]), fsigmoid(v0[2]), fsigmoid(v0[3])}; v1 = (f32x4){fsigmoid(v1[0]), fsigmoid(v1[1]), fsigmoid(v1[2]), fsigmoid(v1[3])};
                    *(GAS v2u*)((unsigned char*)(ws + WS_GATES) + (size_t)(row0 + m * 16) * 3072 + c0) = (v2u){pk4_fp8(v0[0], v0[1], v0[2], v0[3]), pk4_fp8(v1[0], v1[1], v1[2], v1[3])}; }
            } else {
                bf16* dst; int ld, col; float sc = 1.f / 64.f;
                if (cb < 512) { dst = (bf16*)(ws + WS_U) + ((size_t)((cb + wc * 32 + 8 * fq) >> 4) * T) * 16 + ((8 * fq) & 15) - (wc * 32 + 8 * fq); ld = 16; col = 0; }
                else if (cb < 1024) { dst = (bf16*)(ws + WS_QA); ld = 512; col = cb - 512; }
                else if (cb == 1024) { dst = (bf16*)(ws + WS_KA); ld = 128; col = 0; }
                else if (cb == 1152) { dst = (bf16*)(ws + WS_VA); ld = 128; col = 0; }
                else if (cb < 1792) { dst = (bf16*)(ws + WS_QN); ld = 512; col = cb - 1280; sc = C2 / 64.f; }
                else if (cb < 2304) { dst = (bf16*)(ws + WS_KN); ld = 512; col = cb - 1792; }
                else { dst = (bf16*)(ws + WS_VN); ld = 512; col = cb - 2304; }
                const int c0 = col + wc * 32 + 8 * fq;
#pragma unroll
                for (int m = 0; m < 4; ++m) *(GAS v4u*)(dst + (size_t)(row0 + m * 16) * ld + c0) = pack8(acc[bj][m][0] * sc, acc[bj][m][1] * sc);
            }
        }
    }
};

struct PGate {
    static constexpr bool EARLY_AOFF = false, FP8 = !GATE_BF16; unsigned char* ws; int G, c; int K; unsigned kstepA;
    __device__ __forceinline__ bool next(int i, Unit& u) const { const long L = (long)i * G + c; if (L >= 2 * NPAN * 12) return false; pg8::static_decode((int)L, 2 * NPAN, 12, u.pm, u.pn); u.z = 0; return true; }
    __device__ __forceinline__ const char* a_base(const Unit& u) const { return GATE_BF16 ? (const char*)(ws + WS_HB) + (size_t)u.pm * 128 * 2048 : (const char*)(ws + WS_HB8) + (size_t)u.pm * 128 * 1024; }
    __device__ __forceinline__ unsigned a_off(const Unit&, int R, int Cc) const { return GATE_BF16 ? (unsigned)(R * 2048 + Cc * 2) : (unsigned)(R * 1024 + Cc * 2); }
    __device__ __forceinline__ const char* b_base(const Unit& u) const { return GATE_BF16 ? (const char*)(ws + WS_WIN) + (size_t)(2816 + u.pn * 256) * 2048 : (const char*)(ws + WS_WIN8) + (size_t)u.pn * 256 * 1024; }
    __device__ __forceinline__ void epi(const f32x4 (&acc)[2][4][2], f32x4 (&)[2][4][2], const Unit& u, int wr, int wc, int fr, int fq) const {
#pragma unroll
        for (int m = 0; m < 4; ++m) { const size_t r = (size_t)(u.pm * 128 + wr * 64 + m * 16 + fr);
#pragma unroll
            for (int bj = 0; bj < 2; ++bj) { const int c0 = u.pn * 256 + bj * 128 + wc * 32 + 8 * fq; f32x4 v0 = acc[bj][m][0] * (GATE_BF16 ? 1.f : 1.f / 64.f), v1 = acc[bj][m][1] * (GATE_BF16 ? 1.f : 1.f / 64.f);
                v0 = (f32x4){fsigmoid(v0[0]), fsigmoid(v0[1]), fsigmoid(v0[2]), fsigmoid(v0[3])}; v1 = (f32x4){fsigmoid(v1[0]), fsigmoid(v1[1]), fsigmoid(v1[2]), fsigmoid(v1[3])};
                if (GATE_BF16) *(GAS v4u*)((bf16*)(ws + WS_GATES) + r * 3072 + c0) = pack8(v0, v1);
                else *(GAS v2u*)((unsigned char*)(ws + WS_GATES) + r * 3072 + c0) = (v2u){pk4_fp8(v0[0], v0[1], v0[2], v0[3]), pk4_fp8(v1[0], v1[1], v1[2], v1[3])}; }
            __builtin_amdgcn_sched_barrier(0); }
    }
};

struct PS5A {
    static constexpr bool EARLY_AOFF = false, FP8 = false; unsigned char* ws; int G, c; int K; unsigned kstepA;
    __device__ __forceinline__ bool next(int i, Unit& u) const { const long L = (long)i * G + c; if (L >= 32 * 15) return false; const int l = (int)L; u.z = l / 15; const int r = l % 15; u.pm = r / 3; u.pn = r % 3; return true; }
    __device__ __forceinline__ const char* a_base(const Unit& u) const { return (const char*)(ws + WS_U) + (size_t)u.z * T * 32; }
    __device__ __forceinline__ unsigned a_off(const Unit& u, int h, int R, int Cc) const { int cr = u.pm * 256 + h * 128 + R; cr = cr < NCR ? cr : NCR - 1; return (unsigned)(cr * 512 + Cc) * 2u; }
    __device__ __forceinline__ const char* b_base(const Unit& u) const { return (const char*)(ws + WS_BT1) + ((size_t)u.z * 768 + u.pn * 256) * 512 * 2; }
    __device__ __forceinline__ void epi(const Acc& acc, const Unit& u, int wr, int wc, int fr, int fq) const {
#pragma unroll
        for (int ai = 0; ai < 2; ++ai)
#pragma unroll
            for (int m = 0; m < 4; ++m) { const int cr = u.pm * 256 + ai * 128 + wr * 64 + m * 16 + fr; if (cr >= NCR) continue;
#pragma unroll
                for (int bj = 0; bj < 2; ++bj) { const int n = bj * 128 + wc * 32 + 8 * fq;
                    if (u.pn < 2) *(GAS v4u*)((bf16*)(ws + WS_YG) + (size_t)u.z * T * 16 + (size_t)cr * 512 + u.pn * 256 + n) = pack8(acc[ai][bj][m][0], acc[ai][bj][m][1]);
                    else { GAS f32x4* o = (GAS f32x4*)((float*)(ws + WS_SST) + (size_t)cr * 8192 + u.z * 256 + n); o[0] = acc[ai][bj][m][0]; o[1] = acc[ai][bj][m][1]; } }
                __builtin_amdgcn_sched_barrier(0); }
    }
};

struct PS5B {
    static constexpr bool EARLY_AOFF = false, FP8 = false; unsigned char* ws; int G, c; int K; unsigned kstepA;
    __device__ __forceinline__ bool next(int i, Unit& u) const { const long L = (long)i * G + c; if (L >= 32 * 10) return false; const int l = (int)L; u.z = l / 10; const int r = l % 10; u.pm = r / 2; u.pn = r % 2; return true; }
    __device__ __forceinline__ const char* a_base(const Unit& u) const { return (const char*)(ws + WS_XST) + (size_t)u.z * 512; }
    __device__ __forceinline__ unsigned a_off(const Unit& u, int h, int R, int Cc) const { int cr = u.pm * 256 + h * 128 + R; cr = cr < NCR ? cr : NCR - 1; return (unsigned)(cr * 8192 + Cc) * 2u; }
    __device__ __forceinline__ const char* b_base(const Unit& u) const { return (const char*)(ws + WS_BT2) + ((size_t)u.z * 512 + u.pn * 256) * 256 * 2; }
    __device__ __forceinline__ void epi(const Acc& acc, const Unit& u, int wr, int wc, int fr, int fq) const {
#pragma unroll
        for (int ai = 0; ai < 2; ++ai) {
            v4u yw[4][2];
#pragma unroll
            for (int m = 0; m < 4; ++m) { int cr = u.pm * 256 + ai * 128 + wr * 64 + m * 16 + fr; cr = cr < NCR ? cr : NCR - 1;
#pragma unroll
                for (int bj = 0; bj < 2; ++bj) yw[m][bj] = *(const GAS v4u*)((const bf16*)(ws + WS_YG) + (size_t)u.z * T * 16 + (size_t)cr * 512 + u.pn * 256 + bj * 128 + wc * 32 + 8 * fq); }
#pragma unroll
            for (int m = 0; m < 4; ++m) { const int cr = u.pm * 256 + ai * 128 + wr * 64 + m * 16 + fr; if (cr >= NCR) continue;
#pragma unroll
                for (int bj = 0; bj < 2; ++bj) { const int nn = u.pn * 256 + bj * 128 + wc * 32 + 8 * fq, t = nn >> 4, h0 = nn & 15;
                    GAS v4u* p = (GAS v4u*)((bf16*)(ws + WS_YS) + (size_t)(chunk_m0(cr) + t) * 512 + u.z * 16 + h0);
                    f32x4 y0, y1; { const v4u w_ = yw[m][bj]; unpack8(w_, y0, y1); } y0 += acc[ai][bj][m][0]; y1 += acc[ai][bj][m][1];
                    y0 = (f32x4){gelu_tanh(y0[0]), gelu_tanh(y0[1]), gelu_tanh(y0[2]), gelu_tanh(y0[3])}; y1 = (f32x4){gelu_tanh(y1[0]), gelu_tanh(y1[1]), gelu_tanh(y1[2]), gelu_tanh(y1[3])};
                    *p = pack8(y0, y1); } } }
    }
};

__device__ __forceinline__ int half_panel(int hl, bool lat_only) { if (!lat_only) return hl; const int pl = hl >> 1; return 2 * (pl + (pl >> 5) + 1) + (hl & 1); }
struct PGlu {
    static constexpr bool EARLY_AOFF = false, FP8 = false; unsigned char* ws; int G, c; int K; unsigned kstepA; bool lat_only;
    __device__ __forceinline__ bool next(int i, Unit& u) const { const int nH = lat_only ? 256 : 2 * NPAN; const long L = (long)i * G + c; if (L >= nH * 2) return false; pg8::static_decode((int)L, nH, 2, u.pm, u.pn); u.pm = half_panel(u.pm, lat_only); u.z = 0; return true; }
    __device__ __forceinline__ const char* a_base(const Unit& u) const { return (const char*)(ws + WS_YS) + (size_t)u.pm * 128 * 512 * 2; }
    __device__ __forceinline__ unsigned a_off(const Unit&, int R, int Cc) const { return (unsigned)(R * 512 + Cc) * 2u; }
    __device__ __forceinline__ const char* b_base(const Unit& u) const { return (const char*)(ws + WS_WGLU) + (size_t)u.pn * 256 * 512 * 2; }
    __device__ __forceinline__ void epi(const f32x4 (&acc)[2][4][2], f32x4 (&)[2][4][2], const Unit& u, int wr, int wc, int fr, int fq) const {
        v4u zw[4][2];
#pragma unroll
        for (int m = 0; m < 4; ++m)
#pragma unroll
            for (int bj = 0; bj < 2; ++bj) zw[m][bj] = *(const GAS v4u*)((const bf16*)(ws + WS_YS) + (size_t)(u.pm * 128 + wr * 64 + m * 16 + fr) * 512 + u.pn * 256 + bj * 128 + wc * 32 + 8 * fq);
#pragma unroll
        for (int m = 0; m < 4; ++m) { const size_t r = (size_t)(u.pm * 128 + wr * 64 + m * 16 + fr);
#pragma unroll
            for (int bj = 0; bj < 2; ++bj) { const int cc = u.pn * 256 + bj * 128 + wc * 32 + 8 * fq;
                f32x4 z0, z1; { const v4u w_ = zw[m][bj]; unpack8(w_, z0, z1); } const f32x4 a0 = acc[bj][m][0], a1 = acc[bj][m][1];
                z0 = z0 * (f32x4){fsigmoid(a0[0]), fsigmoid(a0[1]), fsigmoid(a0[2]), fsigmoid(a0[3])}; z1 = z1 * (f32x4){fsigmoid(a1[0]), fsigmoid(a1[1]), fsigmoid(a1[2]), fsigmoid(a1[3])};
                *(GAS v4u*)((bf16*)(ws + WS_U) + r * 512 + cc) = pack8(z0, z1); } }
    }
};

typedef f32x4 Acc128[2][4][2];
struct PMerge {
    static constexpr bool EARLY_AOFF = false, FP8 = false; unsigned char* ws; int G, c; int K; unsigned kstepA; bool lat_only;
    __device__ __forceinline__ bool next(int i, Unit& u) const { const int nH = lat_only ? 256 : 2 * NPAN; const long tile = (long)(i / 3) * G + c; if (tile >= nH * 4) return false; pg8::static_decode((int)tile, nH, 4, u.pm, u.pn); u.pm = half_panel(u.pm, lat_only); u.z = i % 3; return true; }
    __device__ __forceinline__ const char* a_base(const Unit& u) const { const size_t off = u.z == 0 ? WS_U : (u.z == 1 ? WS_AO : WS_NO); return (const char*)(ws + off) + (size_t)u.pm * 128 * 512 * 2; }
    __device__ __forceinline__ unsigned a_off(const Unit&, int R, int Cc) const { return (unsigned)(R * 512 + Cc) * 2u; }
    __device__ __forceinline__ const char* b_base(const Unit& u) const { return (const char*)(ws + WS_WBR) + ((size_t)u.z * 1024 + u.pn * 256) * 512 * 2; }
    __device__ __forceinline__ void epi(const Acc128& acc, Acc128& mrg, const Unit& u, int wr, int wc, int fr, int fq) const {
        v2u gw[4][2];
#pragma unroll
        for (int m = 0; m < 4; ++m)
#pragma unroll
            for (int bj = 0; bj < 2; ++bj) gw[m][bj] = *(const GAS v2u*)((const unsigned char*)(ws + WS_GATES) + (size_t)(u.pm * 128 + wr * 64 + m * 16 + fr) * 3072 + u.z * 1024 + u.pn * 256 + bj * 128 + wc * 32 + 8 * fq);
#pragma unroll
        for (int m = 0; m < 4; ++m) { const size_t r = (size_t)(u.pm * 128 + wr * 64 + m * 16 + fr);
#pragma unroll
            for (int bj = 0; bj < 2; ++bj) { const int cc = u.pn * 256 + bj * 128 + wc * 32 + 8 * fq; const v2u w_ = gw[m][bj];
                const f32x4 g0 = (f32x4){__builtin_amdgcn_cvt_f32_fp8((int)w_.x, 0), __builtin_amdgcn_cvt_f32_fp8((int)w_.x, 1), __builtin_amdgcn_cvt_f32_fp8((int)w_.x, 2), __builtin_amdgcn_cvt_f32_fp8((int)w_.x, 3)};
                const f32x4 g1 = (f32x4){__builtin_amdgcn_cvt_f32_fp8((int)w_.y, 0), __builtin_amdgcn_cvt_f32_fp8((int)w_.y, 1), __builtin_amdgcn_cvt_f32_fp8((int)w_.y, 2), __builtin_amdgcn_cvt_f32_fp8((int)w_.y, 3)};
                if (u.z == 0) { mrg[bj][m][0] = g0 * acc[bj][m][0]; mrg[bj][m][1] = g1 * acc[bj][m][1]; }
                else { mrg[bj][m][0] += g0 * acc[bj][m][0]; mrg[bj][m][1] += g1 * acc[bj][m][1]; }
                if (u.z == 2) *(GAS v4u*)((bf16*)(ws + WS_HB) + r * 1024 + cc) = pack8(mrg[bj][m][0], mrg[bj][m][1]); } }
    }
};

struct PWout {
    static constexpr bool EARLY_AOFF = false, FP8 = false; unsigned char* ws; float* out; const float* mod; int G, c; int K; unsigned kstepA; bool lat_only; size_t wofs;
    __device__ __forceinline__ bool next(int i, Unit& u) const { const int nH = lat_only ? 256 : 2 * NPAN; const long L = (long)i * G + c; if (L >= nH * 4) return false; pg8::static_decode((int)L, nH, 4, u.pm, u.pn); u.pm = half_panel(u.pm, lat_only); u.z = 0; return true; }
    __device__ __forceinline__ const char* a_base(const Unit& u) const { return (const char*)(ws + WS_HB) + (size_t)u.pm * 128 * 1024 * 2; }
    __device__ __forceinline__ unsigned a_off(const Unit&, int R, int Cc) const { return (unsigned)(R * 1024 + Cc) * 2u; }
    __device__ __forceinline__ const char* b_base(const Unit& u) const { return (const char*)(ws + wofs) + (size_t)u.pn * 256 * 1024 * 2; }
    __device__ __forceinline__ void epi(const f32x4 (&acc)[2][4][2], f32x4 (&)[2][4][2], const Unit& u, int wr, int wc, int fr, int fq) const {
        const int pm = u.pm >> 1, b = pm / 33, pr = pm % 33, cond = pr == 0 ? 4 : b;
        bf16* xb = (bf16*)(ws + WS_XS) + (size_t)u.pm * 128 * D;
        const float* g1 = mod + cond * 6144 + 2048;
        v4u xv[2][4];
#pragma unroll
        for (int bj = 0; bj < 2; ++bj)
#pragma unroll
            for (int m = 0; m < 4; ++m) xv[bj][m] = *(const GAS v4u*)(xb + (size_t)(wr * 64 + m * 16 + fr) * D + u.pn * 256 + bj * 128 + wc * 32 + 8 * fq);
#pragma unroll
        for (int bj = 0; bj < 2; ++bj) { const int cc = u.pn * 256 + bj * 128 + wc * 32 + 8 * fq; const f32x4 ga = *(const GAS f32x4*)(g1 + cc), gb = *(const GAS f32x4*)(g1 + cc + 4);
#pragma unroll
            for (int m = 0; m < 4; ++m) { f32x4 x0, x1; { const v4u w_ = xv[bj][m]; unpack8(w_, x0, x1); }
                *(GAS v4u*)(xb + (size_t)(wr * 64 + m * 16 + fr) * D + cc) = pack8(x0 + ga * acc[bj][m][0], x1 + gb * acc[bj][m][1]); } }
    }
};

struct ExpTab { int cnt[16], tile0[17]; };
__device__ __forceinline__ int exp_find(const int (&tile0)[17], int q) { int e = 0;
#pragma unroll
    for (int k = 1; k < 16; ++k) e += (q >= tile0[k]) ? 1 : 0;
    return e; }

struct PMoe1 {
    static constexpr bool EARLY_AOFF = true, FP8 = true; unsigned char* ws; const LAS int* tab; int G, c; int K; unsigned kstepA; size_t wofs;
    __device__ __forceinline__ bool next(int i, Unit& u) const { const long L = (long)i * G + c; const int total = __builtin_amdgcn_readfirstlane(tab[32]) * 4; if (L >= total) return false; const int q = (int)L >> 2; u.pn = (int)L & 3;
        int e = 0;
#pragma unroll
        for (int k = 1; k < 16; ++k) e += (q >= __builtin_amdgcn_readfirstlane(tab[16 + k])) ? 1 : 0;
        u.z = e; u.pm = q - __builtin_amdgcn_readfirstlane(tab[16 + e]); return true; }
    __device__ __forceinline__ const char* a_base(const Unit&) const { return (const char*)(ws + WS_HB8); }
    __device__ __forceinline__ unsigned a_off(const Unit& u, int R, int Cc) const { int r = u.pm * 128 + R; const int n = __builtin_amdgcn_readfirstlane(tab[u.z]); r = r < n ? r : n - 1;
        const int ent = ((const int*)(ws + WS_LIST))[(size_t)u.z * T + r]; return (unsigned)((ent >> 1) * 1024 + Cc * 2); }
    __device__ __forceinline__ const char* b_base(const Unit& u) const { return (const char*)(ws + wofs) + ((size_t)u.z * 1024 + u.pn * 256) * 1024; }
    __device__ __forceinline__ void epi(const f32x4 (&acc)[2][4][2], f32x4 (&)[2][4][2], const Unit& u, int wr, int wc, int fr, int fq) const {
        const size_t arow0 = (size_t)(__builtin_amdgcn_readfirstlane(tab[16 + u.z]) + u.pm) * 128;
#pragma unroll
        for (int m = 0; m < 4; ++m) { const f32x4 g0 = acc[0][m][0] * (1.f / 64.f), g1 = acc[0][m][1] * (1.f / 64.f), u0 = acc[1][m][0] * (8.f / 64.f), u1 = acc[1][m][1] * (8.f / 64.f);
            const f32x4 v0 = (f32x4){g0[0] * fsigmoid(g0[0]), g0[1] * fsigmoid(g0[1]), g0[2] * fsigmoid(g0[2]), g0[3] * fsigmoid(g0[3])} * u0;
            const f32x4 v1 = (f32x4){g1[0] * fsigmoid(g1[0]), g1[1] * fsigmoid(g1[1]), g1[2] * fsigmoid(g1[2]), g1[3] * fsigmoid(g1[3])} * u1;
            *(GAS v2u*)((unsigned char*)(ws + WS_ACT) + (arow0 + wr * 64 + m * 16 + fr) * 512 + u.pn * 128 + wc * 32 + 8 * fq) = (v2u){pk4_fp8(v0[0], v0[1], v0[2], v0[3]), pk4_fp8(v1[0], v1[1], v1[2], v1[3])}; }
    }
};
struct PMoe2 {
    static constexpr bool EARLY_AOFF = false, FP8 = true; unsigned char* ws; const LAS int* tab; int G, c; int K; unsigned kstepA; size_t wofs;
    __device__ __forceinline__ bool next(int i, Unit& u) const { const long L = (long)i * G + c; const int total = __builtin_amdgcn_readfirstlane(tab[32]) * 4; if (L >= total) return false; const int q = (int)L >> 2; u.pn = (int)L & 3;
        int e = 0;
#pragma unroll
        for (int k = 1; k < 16; ++k) e += (q >= __builtin_amdgcn_readfirstlane(tab[16 + k])) ? 1 : 0;
        u.z = e; u.pm = q - __builtin_amdgcn_readfirstlane(tab[16 + e]); return true; }
    __device__ __forceinline__ const char* a_base(const Unit& u) const { return (const char*)(ws + WS_ACT) + (size_t)(__builtin_amdgcn_readfirstlane(tab[16 + u.z]) + u.pm) * 128 * 512; }
    __device__ __forceinline__ unsigned a_off(const Unit&, int R, int Cc) const { return (unsigned)(R * 512 + Cc * 2); }
    __device__ __forceinline__ const char* b_base(const Unit& u) const { return (const char*)(ws + wofs) + ((size_t)u.z * 1024 + u.pn * 256) * 512; }
    __device__ __forceinline__ void epi(const f32x4 (&acc)[2][4][2], f32x4 (&)[2][4][2], const Unit& u, int wr, int wc, int fr, int fq) const {
        const int n = __builtin_amdgcn_readfirstlane(tab[u.z]);
        int entv[4]; float wv[4];
#pragma unroll
        for (int m = 0; m < 4; ++m) { int r = u.pm * 128 + wr * 64 + m * 16 + fr; r = r < n ? r : n - 1; entv[m] = ((const int*)(ws + WS_LIST))[(size_t)u.z * T + r]; wv[m] = ((const float*)(ws + WS_LW))[(size_t)u.z * T + r] * (1.f / 256.f); }
#pragma unroll
        for (int m = 0; m < 4; ++m) { const int r = u.pm * 128 + wr * 64 + m * 16 + fr; if (r >= n) continue;
            const int ent = entv[m]; const float w = wv[m];
#pragma unroll
            for (int bj = 0; bj < 2; ++bj)
                *(GAS v4u*)((bf16*)(ws + WS_YSLOT) + (size_t)ent * 1024 + u.pn * 256 + bj * 128 + wc * 32 + 8 * fq) = pack8(acc[bj][m][0] * w, acc[bj][m][1] * w); }
    }
};
struct PMoe1B {
    static constexpr bool EARLY_AOFF = true, FP8 = false; unsigned char* ws; const LAS int* tab; int G, c; int K; unsigned kstepA;
    __device__ __forceinline__ bool next(int i, Unit& u) const { const long L = (long)i * G + c; const int total = tab[32] * 4; if (L >= total) return false; const int q = (int)L >> 2; u.pn = (int)L & 3;
        int e = 0;
#pragma unroll
        for (int k = 1; k < 16; ++k) e += (q >= tab[16 + k]) ? 1 : 0;
        u.z = e; u.pm = q - tab[16 + e]; return true; }
    __device__ __forceinline__ const char* a_base(const Unit&) const { return (const char*)(ws + WS_HB); }
    __device__ __forceinline__ unsigned a_off(const Unit& u, int h, int R, int Cc) const { int r = u.pm * 256 + h * 128 + R; const int n = tab[u.z]; r = r < n ? r : n - 1;
        const int ent = ((const int*)(ws + WS_LIST))[(size_t)u.z * T + r]; return (unsigned)((ent >> 1) * 1024 + Cc) * 2u; }
    __device__ __forceinline__ const char* b_base(const Unit& u) const { return (const char*)(ws + WS_MOE1) + ((size_t)u.z * 1024 + u.pn * 256) * 1024 * 2; }
    __device__ __forceinline__ void epi(const Acc& acc, const Unit& u, int wr, int wc, int fr, int fq) const {
        const size_t arow0 = (size_t)(tab[16 + u.z] + u.pm) * 256;
#pragma unroll
        for (int ai = 0; ai < 2; ++ai)
#pragma unroll
            for (int m = 0; m < 4; ++m) { const f32x4 g0 = acc[ai][0][m][0], g1 = acc[ai][0][m][1], u0 = acc[ai][1][m][0], u1 = acc[ai][1][m][1];
                const f32x4 v0 = (f32x4){g0[0] * fsigmoid(g0[0]), g0[1] * fsigmoid(g0[1]), g0[2] * fsigmoid(g0[2]), g0[3] * fsigmoid(g0[3])} * u0;
                const f32x4 v1 = (f32x4){g1[0] * fsigmoid(g1[0]), g1[1] * fsigmoid(g1[1]), g1[2] * fsigmoid(g1[2]), g1[3] * fsigmoid(g1[3])} * u1;
                *(GAS v4u*)((bf16*)(ws + WS_ACTB) + (arow0 + ai * 128 + wr * 64 + m * 16 + fr) * 512 + u.pn * 128 + wc * 32 + 8 * fq) = pack8(v0, v1); }
    }
};
struct PMoe2B {
    static constexpr bool EARLY_AOFF = false, FP8 = false; unsigned char* ws; const LAS int* tab; int G, c; int K; unsigned kstepA;
    __device__ __forceinline__ bool next(int i, Unit& u) const { const long L = (long)i * G + c; const int total = tab[32] * 4; if (L >= total) return false; const int q = (int)L >> 2; u.pn = (int)L & 3;
        int e = 0;
#pragma unroll
        for (int k = 1; k < 16; ++k) e += (q >= tab[16 + k]) ? 1 : 0;
        u.z = e; u.pm = q - tab[16 + e]; return true; }
    __device__ __forceinline__ const char* a_base(const Unit& u) const { return (const char*)(ws + WS_ACTB) + (size_t)(tab[16 + u.z] + u.pm) * 256 * 512 * 2; }
    __device__ __forceinline__ unsigned a_off(const Unit&, int h, int R, int Cc) const { return (unsigned)((h * 128 + R) * 512 + Cc) * 2u; }
    __device__ __forceinline__ const char* b_base(const Unit& u) const { return (const char*)(ws + WS_MOE2) + ((size_t)u.z * 1024 + u.pn * 256) * 512 * 2; }
    __device__ __forceinline__ void epi(const Acc& acc, const Unit& u, int wr, int wc, int fr, int fq) const {
        const int n = tab[u.z];
#pragma unroll
        for (int ai = 0; ai < 2; ++ai)
#pragma unroll
            for (int m = 0; m < 4; ++m) { const int r = u.pm * 256 + ai * 128 + wr * 64 + m * 16 + fr; if (r >= n) continue;
                const int ent = ((const int*)(ws + WS_LIST))[(size_t)u.z * T + r]; const float w = ((const float*)(ws + WS_LW))[(size_t)u.z * T + r];
#pragma unroll
                for (int bj = 0; bj < 2; ++bj)
                    *(GAS v4u*)((bf16*)(ws + WS_YSLOT) + (size_t)ent * 1024 + u.pn * 256 + bj * 128 + wc * 32 + 8 * fq) = pack8(acc[ai][bj][m][0] * w, acc[ai][bj][m][1] * w); }
    }
};
__device__ __forceinline__ void build_exptab(const Ctx& C, LAS int* tab, int l, int tsh = 7) {
    __syncthreads();
    if (threadIdx.x == 0) { int t0 = 0;
        for (int e = 0; e < 16; ++e) { const int n = (int)__hip_atomic_load((unsigned*)(C.ctl + CW_CNT + l * 1024 + 64 * e), RLX_AGENT); tab[e] = n; tab[16 + e] = t0; t0 += (n + (1 << tsh) - 1) >> tsh; }
        tab[32] = t0; }
    __syncthreads();
}
__device__ __forceinline__ void phase_attn(const Ctx& C, int l, unsigned char* lds_gen) {
    phase_carry(C, l);
    char* shm = (char*)lds_gen;
    bf16* QA = WSP(bf16, WS_QA); bf16* KA = WSP(bf16, WS_KA); bf16* VA = WSP(bf16, WS_VA); bf16* QN = WSP(bf16, WS_QN); bf16* KN = WSP(bf16, WS_KN); bf16* VN = WSP(bf16, WS_VN);
#ifndef ATTN_SEL
#define ATTN_SEL 3
#endif
#ifdef REPMASK
#define REPMASK_ REPMASK
#else
#define REPMASK_ 0
#endif
    const int per = (1024 + C.G - 1) / C.G;
    bool nomax; { float gq = 0.f, gk = 0.f; for (int i = 0; i < 64; ++i) { gq = fmaxf(gq, fabsf(C.in[I_QNG][l * 64 + i])); gk = fmaxf(gk, fabsf(C.in[I_KNG][l * 64 + i])); } nomax = 64.f * gq * gk * C2 <= 60.f; }
    if (ATTN_SEL & 1) for (int i = 0; i < per * (1 + ((REPMASK_ >> 13) & 1)); ++i) { const int id = C.vcu * per + (i % per); if (id >= 1024) continue; const int bh = id >> 5, b = bh >> 3, h = bh & 7, qb = id & 31;
        const bf16* Qu = QA + (size_t)(b * LB + CTX + qb * 256) * 512 + h * 64;
        if (nomax) attn_body::attn_unit<8, false, 512, 128, true>(Qu, 512, KA + (size_t)(b * LB) * 128 + (h >> 2) * 64, VA + (size_t)(b * LB) * 128 + (h >> 2) * 64, 128, WSP(bf16, WS_AO) + (Qu - QA), LB / 64, 0, 0, shm);
        else attn_body::attn_unit<8, false, 512, 128, false>(Qu, 512, KA + (size_t)(b * LB) * 128 + (h >> 2) * 64, VA + (size_t)(b * LB) * 128 + (h >> 2) * 64, 128, WSP(bf16, WS_AO) + (Qu - QA), LB / 64, 0, 0, shm);
    }
    LAS float* bt = (LAS float*)(C.lds + attn_body::LDS_BT);
    if (ATTN_SEL & 2) {
        gu32* naq = C.ctl + CW_NAQ + 64 * l; LAS int* tk = (LAS int*)(C.lds + LDSCTL_OFF + 136);
        unsigned nxt = 0; if (C.tid == 0) nxt = __hip_atomic_fetch_add((unsigned*)naq, 1u, RLX_AGENT);
        for (;;) {
            if (C.tid == 0) *tk = (int)nxt;
            __syncthreads();
            const int id = __builtin_amdgcn_readfirstlane(*tk);
            if (id >= 1024 + 64) break;
            if (C.tid == 0) nxt = __hip_atomic_fetch_add((unsigned*)naq, 1u, RLX_AGENT);
            const bf16 *Qu, *Kh, *Vh; bf16* Ou; int kvp = 512, NT = 4, r0 = 0, rlo = 0;
            if (id < 1024) { const int bh = id >> 5, b = bh >> 3, h = bh & 7; r0 = (id & 31) * 4;
                const float* rp = C.in[I_RPB] + (size_t)(l * 8 + h) * 465;
                for (int k = C.tid; k < 465; k += 512) bt[k] = rp[k] * LOG2E;
                rlo = r0 - 4 < 0 ? 0 : (r0 - 4 > 120 ? 120 : r0 - 4); const int rh_ = r0 - 1 < 0 ? 0 : (r0 - 1 > 120 ? 120 : r0 - 1), nloc = rh_ + 8 - rlo; NT = (4 + nloc + 1) & ~1;
                Qu = QN + (size_t)(b * LB + CTX + r0 * 64) * 512 + h * 64; Ou = WSP(bf16, WS_NO) + (Qu - QN); Kh = KN + (size_t)(b * LB) * 512 + h * 64; Vh = VN + (size_t)(b * LB) * 512 + h * 64; }
            else { int j = id - 1024; if (j < 32) { const int b = j >> 3, h = j & 7; Qu = QA + (size_t)(b * LB) * 512 + h * 64; Ou = WSP(bf16, WS_AO) + (Qu - QA); Kh = KA + (size_t)(b * LB) * 128 + (h >> 2) * 64; Vh = VA + (size_t)(b * LB) * 128 + (h >> 2) * 64; kvp = 128; }
                else { j -= 32; const int b = j >> 3, h = j & 7; Qu = QN + (size_t)(b * LB) * 512 + h * 64; Ou = WSP(bf16, WS_NO) + (Qu - QN); Kh = KN + (size_t)(b * LB) * 512 + h * 64; Vh = VN + (size_t)(b * LB) * 512 + h * 64; } }
            attn_body::attn_unit<8, true, 512, 0>(Qu, 512, Kh, Vh, kvp, Ou, NT, r0, rlo, shm);
        }
    }
}

constexpr int NPH = 46;
__global__ void __launch_bounds__(NWAVES * 64, 2) fwd(Args args) {
    extern __shared__ __attribute__((aligned(16))) unsigned char lds[];
    Ctx C; C.in = (const __attribute__((address_space(4))) CFP*)__builtin_amdgcn_kernarg_segment_ptr(); C.out = args.out; C.ws = args.ws; C.lds = (LAS unsigned char*)lds; C.ctl = (gu32*)(args.ws + WS_CTL);
    C.tid = 0; C.lane = 0; C.wave = __builtin_amdgcn_readfirstlane((int)threadIdx.x >> 6);
    C.G = gridDim.x; { const int bx = blockIdx.x; C.vcu = (C.G % 8 == 0) ? (bx % 8) * (C.G / 8) + bx / 8 : bx; }
    for (int u = threadIdx.x; u < (LDS_BYTES - LDSCTL_OFF) / 4; u += NWAVES * 64) ((LAS unsigned*)(C.lds + LDSCTL_OFF))[u] = 0u;
    __syncthreads();
    const int lo = args.ph_lo, hi = args.ph_hi;
    XcdBarrier bar; bar.bar = (unsigned*)(C.ctl + CW_BAR); bar.x = 0; bar.st = nullptr;
    if (hi - lo > 1) bar = xcd_barrier_post((unsigned*)(C.ctl + CW_BAR), (volatile LAS unsigned*)(C.lds + MISC_OFF) + 8);
    LAS int* tab = (LAS int*)(C.lds + LDSCTL_OFF);
    const int cg = (int)blockIdx.x;
#ifndef PHMASK
#define PHMASK 0xFFFF
#endif
#define IN(k) (lo <= (k) && (k) < hi)
#define EN(b) ((PHMASK >> (b)) & 1)
#ifndef REPMASK
#define REPMASK 0
#endif
#define RUN(b, stmt) do { stmt; if ((REPMASK >> (b)) & 1) { stmt; } } while (0)
#ifdef DIAG_SEL
#define DIAG_ACC(ty) do { if (blockIdx.x == 0 && threadIdx.x == 0) { volatile LAS unsigned* dg = (volatile LAS unsigned*)(C.lds + LDSCTL_OFF + 160); const unsigned now = (unsigned)__builtin_amdgcn_s_memrealtime(); dg[8 + (ty)] += now - dg[0]; dg[0] = now; } } while (0)
#else
#define DIAG_ACC(ty) do {} while (0)
#endif
#define SEAM(k) do { if (IN(k) && IN((k) + 1)) xcd_barrier(bar); DIAG_ACC((k) == 0 ? 11 : ((k) - 1) % 11); } while (0)
#define LWS() ({ const __attribute__((address_space(4))) CFP* k_ = C.in; asm volatile("" : "+s"(k_)); (unsigned char*)k_[30]; })
#define LC() ({ Ctx c_ = C; c_.tid = threadIdx.x; asm volatile("" : "+v"(c_.tid)); c_.lane = c_.tid & 63; asm volatile("" : "+s"(c_.in)); c_.ws = (unsigned char*)c_.in[30]; c_.out = (float*)c_.in[29]; c_.ctl = (gu32*)(c_.ws + WS_CTL); c_; })
#ifdef DIAG_SEL
    if (blockIdx.x == 0 && threadIdx.x == 0) { volatile LAS unsigned* dg = (volatile LAS unsigned*)(C.lds + LDSCTL_OFF + 160); dg[0] = (unsigned)__builtin_amdgcn_s_memrealtime(); dg[1] = dg[0]; }
#endif
    if (EN(11) && IN(0)) { const Ctx Cl = LC(); phase_mod(Cl); RUN(11, phase_s5mats(Cl, 0, Cl.vcu); phase_weights(Cl, 0, Cl.vcu, Cl.G)); }
    SEAM(0);
    for (int l = 0; l < NLAYER; ++l) {
        const int pb = 1 + 11 * l;
        if (EN(0) && IN(pb)) { const Ctx Cl = LC(); if (l == 0) phase_rows<0>(Cl, 0); else phase_rows<1>(Cl, l); }
        SEAM(pb);
        if (EN(1) && IN(pb + 1)) { if (W8_ALL) { PWin8 P{LWS(), C.G, cg, 1024, 128u}; pg8::gemm_phase_m128(C.lds, P); } else { { PWin P{LWS(), C.G, cg, 1024, 128u}; pg8::gemm_phase(C.lds, P); } { PGate P{LWS(), C.G, cg, 1024, 128u}; pg8::gemm_phase_m128(C.lds, P); } } }
        SEAM(pb + 1);
        if (EN(2) && IN(pb + 2)) { { const Ctx Cl = LC(); phase_qkprep(Cl, l); } PS5A P{LWS(), C.G, cg, 512, 128u}; RUN(2, pg8::gemm_phase(C.lds, P)); }
        SEAM(pb + 2);
        if (EN(3) && IN(pb + 3)) { const Ctx Cl = LC(); RUN(3, phase_attn(Cl, l, lds)); }
        SEAM(pb + 3);
        if (EN(4) && IN(pb + 4)) { PS5B P{LWS(), C.G, cg, 256, 128u}; pg8::gemm_phase(C.lds, P); }
        SEAM(pb + 4);
        if (EN(5) && IN(pb + 5)) { PGlu P{LWS(), C.G, cg, 512, 128u, l == NLAYER - 1}; pg8::gemm_phase_m128(C.lds, P); }
        SEAM(pb + 5);
        if (EN(6) && IN(pb + 6)) { { PMerge P{LWS(), C.G, cg, 512, 128u, l == NLAYER - 1}; pg8::gemm_phase_m128(C.lds, P); }
            if (l < NLAYER - 1) { const Ctx Cl = LC(); phase_s5mats(Cl, l + 1, C.G >= 160 ? cg - 32 : cg); } }
        SEAM(pb + 6);
        if (EN(7) && IN(pb + 7)) { unsigned char* wl_ = LWS(); { PWout P{wl_, (float*)C.in[29], (const float*)(wl_ + WS_MOD) + (size_t)l * 5 * 6144, C.G, cg, 1024, 128u, l == NLAYER - 1, wout_off(l)}; pg8::gemm_phase_m128(C.lds, P); }
            if (l < NLAYER - 1) { const Ctx Cl = LC(); if (C.G > 32) phase_weights(Cl, l + 1, cg - 32, C.G - 32); else phase_weights(Cl, l + 1, cg, C.G); } }
        SEAM(pb + 7);
        if (EN(8) && IN(pb + 8)) { const Ctx Cl = LC(); phase_norm2(Cl, l); }
        SEAM(pb + 8);
        if (EN(9) && IN(pb + 9)) { if (FP8_MOE) { build_exptab(C, tab, l); PMoe1 P{LWS(), tab, C.G, cg, 1024, 128u, moe1_off(l)}; pg8::gemm_phase_m128(C.lds, P); } else { build_exptab(C, tab, l, 8); PMoe1B P{LWS(), tab, C.G, cg, 1024, 128u}; pg8::gemm_phase(C.lds, P); } }
        SEAM(pb + 9);
        if (EN(10) && IN(pb + 10)) { if (FP8_MOE) { build_exptab(C, tab, l); PMoe2 P{LWS(), tab, C.G, cg, 512, 128u, moe2_off(l)}; pg8::gemm_phase_m128(C.lds, P); } else { build_exptab(C, tab, l, 8); PMoe2B P{LWS(), tab, C.G, cg, 512, 128u}; pg8::gemm_phase(C.lds, P); } }
        SEAM(pb + 10);
    }
    if (EN(12) && IN(NPH - 1)) { const Ctx Cl = LC(); phase_rows<2>(Cl, NLAYER); }
#ifdef DIAG_SEL
    xcd_barrier(bar); DIAG_ACC(12);
    if (blockIdx.x == 0 && threadIdx.x == 0) { volatile LAS unsigned* dg = (volatile LAS unsigned*)(C.lds + LDSCTL_OFF + 160); dg[8 + 13] = dg[0] - dg[1];
        for (int i = 0; i < 14; ++i) __hip_atomic_store(C.ctl + 2048 + i, dg[8 + i], RLX_AGENT); }
    xcd_barrier(bar);
    { const float d1 = (float)__hip_atomic_load(C.ctl + 2048 + (DIAG_SEL), RLX_AGENT) * 0.01f, d2 = (float)__hip_atomic_load(C.ctl + 2048 + (DIAG_SEL) + 1, RLX_AGENT) * 0.01f;
      const float c1 = sqrtf(d1); float* o = args.out;
      for (size_t i = (size_t)blockIdx.x * 512 + threadIdx.x; i < (size_t)NB * SEQ * D; i += (size_t)gridDim.x * 512) o[i] = (i == 12345) ? d2 : c1; }
#endif
#undef IN
#undef SEAM
}

#ifndef MK_PER_PHASE
#define MK_PER_PHASE 0
#endif
extern "C" void kernel_launch(void* const* d_in, const int* in_sizes, int n_in, void* d_out, int out_size, void* d_ws, size_t ws_size, hipStream_t stream) {
    static int grid = 0;
    if (grid == 0) {
        if (n_in != 29 || out_size != NB * SEQ * D || ws_size < WS_END) { fprintf(stderr, "kernel_launch: unexpected shapes (n_in %d out %d ws %zu)\n", n_in, out_size, ws_size); grid = -1; return; }
        int dev = 0, cus = 0, per_cu = 0;
        if (hipGetDevice(&dev) != hipSuccess || hipDeviceGetAttribute(&cus, hipDeviceAttributeMultiprocessorCount, dev) != hipSuccess) { grid = -1; return; }
        if (hipFuncSetAttribute((const void*)fwd, hipFuncAttributeMaxDynamicSharedMemorySize, LDS_BYTES) != hipSuccess) { grid = -1; return; }
        if (hipOccupancyMaxActiveBlocksPerMultiprocessor(&per_cu, (const void*)fwd, NWAVES * 64, LDS_BYTES) != hipSuccess || per_cu < 1) fprintf(stderr, "kernel_launch: occupancy query says %d\n", per_cu);
        (void)hipGetLastError();
        grid = cus;
    }
    if (grid < 0) return;
    (void)hipMemsetAsync((char*)d_ws + WS_CTL, 0, CTL_ZERO_BYTES, stream);
    Args a{};
    for (int i = 0; i < 29; ++i) a.in[i] = (const float*)d_in[i];
    a.out = (float*)d_out; a.ws = (unsigned char*)d_ws;
#if MK_PER_PHASE
    for (int p = 0; p < NPH; ++p) { a.ph_lo = p; a.ph_hi = p + 1; hipLaunchKernelGGL(fwd, dim3(grid), dim3(NWAVES * 64), LDS_BYTES, stream, a); }
#else
    a.ph_lo = 0; a.ph_hi = NPH; hipLaunchKernelGGL(fwd, dim3(grid), dim3(NWAVES * 64), LDS_BYTES, stream, a);
#endif
}
```

```cpp
#define FP8_MOE 1
#define GATE_BF16 0
#define W8_ALL 1
#define H8_WRITE 1
#ifndef H8_WRITE
#define H8_WRITE 1
#endif
#ifndef GATE_BF16
#define GATE_BF16 0
#endif
#include <hip/hip_runtime.h>
#include <cstdio>
#include <cstdint>

#define GAS __attribute__((address_space(1)))
#define LAS __attribute__((address_space(3)))
typedef unsigned short bf16;
typedef unsigned v4u __attribute__((ext_vector_type(4)));
typedef unsigned v2u __attribute__((ext_vector_type(2)));
typedef float f32x4 __attribute__((ext_vector_type(4)));
typedef float f32x2 __attribute__((ext_vector_type(2)));
typedef float f32x16 __attribute__((ext_vector_type(16)));
typedef short bf16x8 __attribute__((ext_vector_type(8)));
typedef short s16x4 __attribute__((ext_vector_type(4)));
typedef GAS unsigned gu32;
#define RLX_AGENT __ATOMIC_RELAXED, __HIP_MEMORY_SCOPE_AGENT
#define LDS_WAIT() asm volatile("s_waitcnt lgkmcnt(0)" ::: "memory")
#define VM_WAIT() asm volatile("s_waitcnt vmcnt(0)" ::: "memory")

constexpr int NB = 4, SEQ = 8192, CTX = 256, LB = SEQ + CTX, T = NB * LB, D = 1024, NPAN = T / 256;
constexpr int NLAYER = 4, INW = 5888, NCH = LB / 32, NCR = NB * NCH;
constexpr int NEXP = 16, FF = 512;
constexpr float EPS = 1e-6f;
constexpr float LOG2E = 1.4426950408889634f;
constexpr float C2 = 0.125f * LOG2E;
constexpr int NWAVES = 8;

constexpr size_t MiB = 1u << 20;
constexpr size_t WS_CTL = 0, CTL_ZERO_BYTES = 1 * MiB;
constexpr size_t WS_MOD = 1 * MiB;
constexpr size_t WS_LIST = 2 * MiB;
constexpr size_t WS_RW = 5 * MiB;
constexpr size_t WS_LW = 6 * MiB;
constexpr size_t WS_SST = 10 * MiB;
constexpr size_t WS_HB8 = WS_SST;
constexpr size_t WS_XST = 44 * MiB;
constexpr size_t WS_BT1 = 61 * MiB;
constexpr size_t WS_BT2 = 85 * MiB;
constexpr size_t WS_WIN = 93 * MiB;
constexpr size_t WS_WIN8 = WS_WIN + (size_t)2816 * 1024 * 2;
constexpr size_t WS_WGLU = 105 * MiB;
constexpr size_t WS_WBR = 106 * MiB;
constexpr size_t WS_WOUT = 109 * MiB;
constexpr size_t WS_WOUT2 = 100 * MiB;
constexpr size_t WS_MOE1 = 111 * MiB;
constexpr size_t WS_MOE2 = 143 * MiB;
constexpr size_t WS_HB = 159 * MiB;
constexpr size_t WS_U = 225 * MiB;
constexpr size_t WS_QA = 258 * MiB;
constexpr size_t WS_KA = 291 * MiB;
constexpr size_t WS_VA = 300 * MiB;
constexpr size_t WS_QN = 309 * MiB;
constexpr size_t WS_KN = 342 * MiB;
constexpr size_t WS_VN = 375 * MiB;
constexpr size_t WS_YS = 408 * MiB;
constexpr size_t WS_GATES = 441 * MiB;
constexpr size_t WS_ACT = WS_QN;
constexpr size_t WS_ACTB = WS_QN;
constexpr size_t WS_YSLOT = WS_GATES;
constexpr size_t WS_AO = 574 * MiB;
constexpr size_t WS_NO = 607 * MiB;
constexpr size_t WS_YG = 640 * MiB;
constexpr size_t WS_XS = 673 * MiB;
constexpr size_t WS_END = 739 * MiB;
static_assert(WS_GATES + (size_t)T * 3072 * (GATE_BF16 ? 2 : 1) <= WS_AO && WS_YSLOT + (size_t)2 * T * 1024 * 2 <= WS_AO && WS_ACT + (size_t)(2 * T + 4096) * 512 * 2 <= WS_YS, "ws map");
constexpr int CW_FAIL = 8;
constexpr int CW_CNT = 64;
constexpr int CW_BAR = 8192;
constexpr int CW_NAQ = 6144;

constexpr int RING_BYTES = 131072, LDS_BYTES = 147456, LDSCTL_OFF = LDS_BYTES - 512, MISC_OFF = LDSCTL_OFF + 320;

__device__ __forceinline__ unsigned f2bf(float f) { unsigned u = __builtin_bit_cast(unsigned, f); return (u + 0x7fffu + ((u >> 16) & 1u)) >> 16; }
typedef float f32x2_p __attribute__((ext_vector_type(2))); typedef __bf16 bf16x2_p __attribute__((ext_vector_type(2)));
__device__ __forceinline__ unsigned pk2(float lo, float hi) { const f32x2_p v = {lo, hi}; return __builtin_bit_cast(unsigned, __builtin_convertvector(v, bf16x2_p)); }
__device__ __forceinline__ float bf2f(unsigned b) { return __builtin_bit_cast(float, b << 16); }
__device__ __forceinline__ float bflo(unsigned w) { return __builtin_bit_cast(float, w << 16); }
__device__ __forceinline__ float bfhi(unsigned w) { return __builtin_bit_cast(float, w & 0xffff0000u); }
typedef float f32x2_c __attribute__((ext_vector_type(2))); typedef __bf16 bf16x2_c __attribute__((ext_vector_type(2)));
__device__ __forceinline__ unsigned cvt_pk_bf16(float lo, float hi) { const f32x2_c v = {lo, hi}; return __builtin_bit_cast(unsigned, __builtin_convertvector(v, bf16x2_c)); }
typedef int v8i __attribute__((ext_vector_type(8)));
typedef int v4i __attribute__((ext_vector_type(4)));
__device__ __forceinline__ float clamp8(float x) { return __builtin_fminf(__builtin_fmaxf(x, -448.f), 448.f); }
__device__ __forceinline__ unsigned pk4_fp8(float a, float b, float c, float d) { int w = 0; w = __builtin_amdgcn_cvt_pk_fp8_f32(clamp8(a), clamp8(b), w, false); w = __builtin_amdgcn_cvt_pk_fp8_f32(clamp8(c), clamp8(d), w, true); return (unsigned)w; }
__device__ __forceinline__ unsigned pk4_fp8_nc(float a, float b, float c, float d) { int w = 0; w = __builtin_amdgcn_cvt_pk_fp8_f32(a, b, w, false); w = __builtin_amdgcn_cvt_pk_fp8_f32(c, d, w, true); return (unsigned)w; }
__device__ __forceinline__ float fsigmoid_s(float x, float negs) { return __builtin_amdgcn_rcpf(1.f + __builtin_amdgcn_exp2f(negs * x)); }
__device__ __forceinline__ float fsigmoid(float x) { return __builtin_amdgcn_rcpf(1.f + __builtin_amdgcn_exp2f(-LOG2E * x)); }
__device__ __forceinline__ float gelu_tanh(float x) { const float u = 0.7978845608f * (x + 0.044715f * x * x * x); return x * __builtin_amdgcn_rcpf(1.f + __builtin_amdgcn_exp2f(-2.f * LOG2E * u)); }
__device__ __forceinline__ float shflx(float v, int m, int lane) { return __builtin_bit_cast(float, __builtin_amdgcn_ds_bpermute((lane ^ m) << 2, __builtin_bit_cast(int, v))); }
template <int CTRL, int RM>
__device__ __forceinline__ float dpp_mov(float v) { return __builtin_bit_cast(float, __builtin_amdgcn_update_dpp(0, __builtin_bit_cast(int, v), CTRL, RM, 0xF, true)); }
__device__ __forceinline__ float wave_sum(float v, int) {
    v += dpp_mov<0xB1, 0xF>(v);
    v += dpp_mov<0x4E, 0xF>(v);
    v += dpp_mov<0x141, 0xF>(v);
    v += dpp_mov<0x140, 0xF>(v);
    v += dpp_mov<0x142, 0xA>(v);
    v += dpp_mov<0x143, 0xC>(v);
    return __builtin_bit_cast(float, __builtin_amdgcn_readlane(__builtin_bit_cast(int, v), 63));
}
__device__ __forceinline__ float sin_rev(float r) { r = r - floorf(r); return __builtin_amdgcn_sinf(r); }
__device__ __forceinline__ float cos_rev(float r) { r = r - floorf(r); return __builtin_amdgcn_cosf(r); }

#define XB_TMO      128
#define XB_XCNT(j)  (256  + 64 * (j))
#define XB_XSUB(j)  (1280 + 64 * (j))
#define XB_XGEN(j)  (2304 + 64 * (j))
#define XB_TOP      3328
#define XB_TOPGEN   3392
#define XCD_BAR_WORDS 3456
#define XB_SPIN_CAP (1u << 22)

__device__ __forceinline__ unsigned xb_ld(unsigned* p)              { return __hip_atomic_load(p, __ATOMIC_RELAXED, __HIP_MEMORY_SCOPE_AGENT); }
__device__ __forceinline__ unsigned xb_add(unsigned* p, unsigned v) { return __hip_atomic_fetch_add(p, v, __ATOMIC_RELAXED, __HIP_MEMORY_SCOPE_AGENT); }
__device__ __forceinline__ unsigned xb_xcc_id() { return (unsigned)__builtin_amdgcn_s_getreg((3 << 11) | 20) & 0xFu; }
#define XB_SPIN(cond, bar) do { unsigned _sp = 0; while (cond) { __builtin_amdgcn_s_sleep(1); \
    if ((++_sp & 255u) == 0u) { if (xb_ld(&(bar)[XB_TMO])) break; if (_sp > XB_SPIN_CAP) { atomicAdd(&(bar)[XB_TMO], 1u); break; } } } } while (0)

struct XcdBarrier { unsigned* bar; unsigned x; volatile LAS unsigned* st; };

__device__ __forceinline__ XcdBarrier xcd_barrier_post(unsigned* bar, volatile LAS unsigned* st) {
    XcdBarrier b; b.bar = bar; b.x = xb_xcc_id(); b.st = st;
    if (threadIdx.x == 0) (void)xb_add(&bar[XB_XCNT(b.x)], 1u);
    return b;
}
__device__ __forceinline__ void xcd_barrier_complete(unsigned* bar, unsigned x, unsigned& nloc, unsigned& nx) {
    const unsigned G = gridDim.x * gridDim.y * gridDim.z;
    unsigned sum, cnt, mine, sp = 0u;
    for (;;) {
        sum = 0u; cnt = 0u; mine = 0u;
#pragma unroll
        for (unsigned j = 0; j < 16; ++j) { const unsigned c = xb_ld(&bar[XB_XCNT(j)]); sum += c; cnt += (c > 0u) ? 1u : 0u; mine = (j == x) ? c : mine; }
        if (sum == G) break;
        __builtin_amdgcn_s_sleep(1);
        if ((++sp & 255u) == 0u) { if (xb_ld(&bar[XB_TMO])) break; if (sp > XB_SPIN_CAP) { atomicAdd(&bar[XB_TMO], 1u); break; } }
    }
    nloc = mine > 0u ? mine : 1u; nx = cnt > 0u ? cnt : 1u;
}
__device__ __forceinline__ void xcd_barrier(const XcdBarrier& b) {
    asm volatile("s_waitcnt vmcnt(0)" ::: "memory");
    __syncthreads();
    if (threadIdx.x == 0) {
        unsigned* bar = b.bar;
        __builtin_amdgcn_s_waitcnt(0);
        unsigned nloc = b.st[0], nx = b.st[1];
        if (nloc == 0u) { xcd_barrier_complete(bar, b.x, nloc, nx); b.st[0] = nloc; b.st[1] = nx; }
        const unsigned old = xb_add(&bar[XB_XSUB(b.x)], 1u);
        const unsigned gen = old / nloc;
        if (old + 1u == (gen + 1u) * nloc) {
            __builtin_amdgcn_fence(__ATOMIC_RELEASE, "agent");
            asm volatile("s_waitcnt vmcnt(0)" ::: "memory");
            const unsigned og = xb_add(&bar[XB_TOP], 1u);
            const unsigned tg = og / nx;
            if (og + 1u == (tg + 1u) * nx) xb_add(&bar[XB_TOPGEN], 1u);
            else XB_SPIN(xb_ld(&bar[XB_TOPGEN]) == tg, bar);
            __builtin_amdgcn_fence(__ATOMIC_ACQUIRE, "agent");
            xb_add(&bar[XB_XGEN(b.x)], 1u);
            asm volatile("s_waitcnt vmcnt(0)" ::: "memory");
        } else {
            XB_SPIN(xb_ld(&bar[XB_XGEN(b.x)]) == gen, bar);
            __builtin_amdgcn_fence(__ATOMIC_ACQUIRE, "agent");
            asm volatile("s_waitcnt vmcnt(0)" ::: "memory");
        }
    }
    __syncthreads();
}

namespace pg8 {
constexpr int BM = 256, BK = 64, HALF = 128, HTB = HALF * BK * 2, STAGE_BYTES = 8 * HTB, NXCD = 8, WGM = 8;
__host__ __device__ __forceinline__ int lds_byte(int r, int c) { const int st = (r >> 4) * 2 + (c >> 5), rr = r & 15, cc = c & 31, ob = rr * 64 + cc * 2; return st * 1024 + (ob ^ (((ob >> 9) & 1) << 5)); }
__host__ __device__ __forceinline__ void stage_rc(int b, int& R, int& C) { const int st = b / 1024, sb = b % 1024, swz = sb ^ (((sb >> 9) & 1) << 5); R = (st >> 1) * 16 + swz / 64; C = (st & 1) * 32 + (swz % 64) / 2; }
__host__ __device__ __forceinline__ int perm32(int rho) { const int n = rho >> 4, i = rho & 15; return 8 * (i >> 2) + 4 * n + (i & 3); }

struct Unit { int pm, pn, z; };

__device__ __forceinline__ void static_decode(int L, int nM, int nN, int& pm, int& pn) {
    const int nwg = nM * nN; int wgid = L;
    { const int q = nwg / NXCD, r = nwg % NXCD, xcd = wgid % NXCD, off = wgid / NXCD; wgid = (xcd < r ? xcd * (q + 1) : r * (q + 1) + (xcd - r) * q) + off; }
    const int nig = WGM * nN, gid = wgid / nig, fm = gid * WGM, gsz = (nM - fm) < WGM ? (nM - fm) : WGM;
    pm = fm + ((wgid % nig) % gsz); pn = (wgid % nig) / gsz;
}

template <class P>
__device__ __forceinline__ void gemm_phase(LAS unsigned char* lds, const P& S) {
    int tid_ = threadIdx.x; asm volatile("" : "+v"(tid_));
    const int tid = tid_, wid = __builtin_amdgcn_readfirstlane(tid >> 6), lane = tid & 63, wr = wid >> 2, wc = wid & 3, fr = lane & 15, fq = lane >> 4;
    constexpr int ELB = P::FP8 ? 1 : 2;
    const int K = S.K; int nt = K * ELB / 128; asm volatile("" : "+s"(nt));
    unsigned voffB[2];
#pragma unroll
    for (int i = 0; i < 2; ++i) { int R, C; stage_rc(tid * 16 + i * 8192, R, C); const int Rb = (R & ~31) + perm32(R & 31); voffB[i] = (unsigned)(Rb * K * ELB + C * 2); }
#define PG8_AOFF(dst0, dst1, u) do { _Pragma("unroll") for (int i = 0; i < 2; ++i) { int R, C; stage_rc(tid * 16 + i * 8192, R, C); dst0[i] = S.a_off(u, 0, R, C); dst1[i] = S.a_off(u, 1, R, C); } } while (0)
    const size_t kstepB = (size_t)(BK * 2), hstepB = (size_t)HALF * K * ELB, kstepA = (size_t)S.kstepA;
    const unsigned ldsw = (unsigned)wid * 1024u;
    const int aoff = lds_byte(wr * 64 + fr, fq * 8), boff = lds_byte(wc * 32 + fr, fq * 8);
#define PG8_SA(b, h) (((b) * 2 + (h)) * HTB)
#define PG8_SB(b, h) ((4 + (b) * 2 + (h)) * HTB)
#define PG8_STAGE(bufoff, gbase, voff) do { _Pragma("unroll") for (int _i = 0; _i < 2; ++_i) \
        __builtin_amdgcn_global_load_lds((const unsigned*)((const char*)(gbase) + (voff)[_i]), (LAS unsigned*)(lds + (bufoff) + ldsw + _i * 8192), 16, 0, 0); } while (0)
#define PG8_LDA(dst, b, h) do { _Pragma("unroll") for (int m = 0; m < 4; ++m) _Pragma("unroll") for (int k = 0; k < 2; ++k) dst[m][k] = *(const LAS bf16x8*)(lds + PG8_SA(b, h) + aoff + m * 2048 + k * 1024); } while (0)
#define PG8_LDB(dst, b, h) do { _Pragma("unroll") for (int n = 0; n < 2; ++n) _Pragma("unroll") for (int k = 0; k < 2; ++k) dst[n][k] = *(const LAS bf16x8*)(lds + PG8_SB(b, h) + boff + n * 2048 + k * 1024); } while (0)
#define PG8_CAT(x0, x1) __builtin_shufflevector(__builtin_bit_cast(v4i, x0), __builtin_bit_cast(v4i, x1), 0, 1, 2, 3, 4, 5, 6, 7)
#define PG8_MMA(ai, bj, At, Bt) do { __builtin_amdgcn_s_setprio(1); _Pragma("unroll") for (int m = 0; m < 4; ++m) _Pragma("unroll") for (int n = 0; n < 2; ++n) { \
        if constexpr (P::FP8) acc[ai][bj][m][n] = __builtin_amdgcn_mfma_scale_f32_16x16x128_f8f6f4(PG8_CAT(Bt[n][0], Bt[n][1]), PG8_CAT(At[m][0], At[m][1]), acc[ai][bj][m][n], 0, 0, 0, 0x7f7f7f7f, 0, 0x7f7f7f7f); \
        else { _Pragma("unroll") for (int k = 0; k < 2; ++k) acc[ai][bj][m][n] = __builtin_amdgcn_mfma_f32_16x16x32_bf16(Bt[n][k], At[m][k], acc[ai][bj][m][n], 0, 0, 0); } } __builtin_amdgcn_s_setprio(0); } while (0)
#define PG8_WAIT_V(n) asm volatile("s_waitcnt vmcnt(" #n ")" ::: "memory")
#define PG8_WAIT_L(n) asm volatile("s_waitcnt lgkmcnt(" #n ")" ::: "memory")
#define PG8_BAR __builtin_amdgcn_s_barrier()
#define PG8_SCHED __builtin_amdgcn_sched_barrier(0)
    Unit cur, nxt; int ui = 0;
    if (!S.next(0, cur)) return;
    f32x4 acc[2][2][4][2];
#pragma unroll
    for (int a = 0; a < 2; ++a)
#pragma unroll
        for (int b = 0; b < 2; ++b)
#pragma unroll
            for (int m = 0; m < 4; ++m)
#pragma unroll
                for (int n = 0; n < 2; ++n) acc[a][b][m][n] = (f32x4){0.f, 0.f, 0.f, 0.f};
    bf16x8 At[4][2], B0[2][2], B1[2][2];
    unsigned vA0[2], vA1[2], vN0[2], vN1[2];
    PG8_AOFF(vA0, vA1, cur);
    const char* cA = S.a_base(cur); const char* cB = S.b_base(cur);
    PG8_STAGE(PG8_SB(0, 0), cB, voffB); PG8_STAGE(PG8_SB(0, 1), cB + hstepB, voffB); PG8_STAGE(PG8_SA(0, 0), cA, vA0); PG8_STAGE(PG8_SA(0, 1), cA, vA1);
    if (wr == 1) PG8_BAR;
    PG8_WAIT_V(2); PG8_BAR;
    PG8_STAGE(PG8_SB(1, 0), cB + kstepB, voffB); PG8_STAGE(PG8_SA(1, 0), cA + kstepA, vA0); PG8_STAGE(PG8_SB(1, 1), cB + hstepB + kstepB, voffB);
    PG8_WAIT_V(6); PG8_BAR;
    for (;;) {
        const bool has_next = S.next(ui + 1, nxt);
        const char* nA = cA; const char* nB = cB;
        if (has_next) { nA = S.a_base(nxt); nB = S.b_base(nxt); if (P::EARLY_AOFF) PG8_AOFF(vN0, vN1, nxt); }
        for (int t = 0; t < nt; t += 2) {
            const bool last = (t == nt - 2);
            const char* a1 = cA + (size_t)(t + 1) * kstepA;
            const char* a2 = last ? nA : cA + (size_t)(t + 2) * kstepA; const char* b2 = last ? nB : cB + (size_t)(t + 2) * kstepB;
            const char* a3 = a2 + kstepA; const char* b3 = b2 + kstepB;
            PG8_LDB(B0, 0, 0); PG8_LDB(B1, 0, 1); PG8_SCHED; PG8_LDA(At, 0, 0); PG8_STAGE(PG8_SA(1, 1), a1, vA1);
            if (last && has_next) {
                if (P::EARLY_AOFF) { _Pragma("unroll") for (int i = 0; i < 2; ++i) { vA0[i] = vN0[i]; vA1[i] = vN1[i]; } } else PG8_AOFF(vA0, vA1, nxt); }
            PG8_WAIT_V(8); PG8_WAIT_L(0); PG8_BAR; PG8_MMA(0, 0, At, B0); PG8_MMA(0, 1, At, B1); PG8_BAR; PG8_SCHED;
            PG8_LDA(At, 0, 1); PG8_STAGE(PG8_SB(0, 0), b2, voffB); PG8_STAGE(PG8_SB(0, 1), b2 + hstepB, voffB); PG8_STAGE(PG8_SA(0, 0), a2, vA0);
            PG8_WAIT_V(8); PG8_WAIT_L(0); PG8_BAR; PG8_MMA(1, 0, At, B0); PG8_MMA(1, 1, At, B1); PG8_BAR; PG8_SCHED;
            PG8_LDB(B0, 1, 0); PG8_LDB(B1, 1, 1); PG8_SCHED; PG8_LDA(At, 1, 0); PG8_STAGE(PG8_SA(0, 1), a2, vA1);
            PG8_WAIT_V(8); PG8_WAIT_L(0); PG8_BAR; PG8_MMA(0, 0, At, B0); PG8_MMA(0, 1, At, B1); PG8_BAR; PG8_SCHED;
            PG8_LDA(At, 1, 1); PG8_STAGE(PG8_SB(1, 0), b3, voffB); PG8_STAGE(PG8_SB(1, 1), b3 + hstepB, voffB); PG8_STAGE(PG8_SA(1, 0), a3, vA0);
            PG8_WAIT_V(8); PG8_WAIT_L(0); PG8_BAR; PG8_MMA(1, 0, At, B0); PG8_MMA(1, 1, At, B1); PG8_BAR; PG8_SCHED;
        }
        if (wr == 0) PG8_BAR;
        S.epi(acc, cur, wr, wc, fr, fq);
        if (!has_next) break;
#pragma unroll
        for (int a = 0; a < 2; ++a)
#pragma unroll
            for (int b = 0; b < 2; ++b)
#pragma unroll
                for (int m = 0; m < 4; ++m)
#pragma unroll
                    for (int n = 0; n < 2; ++n) acc[a][b][m][n] = (f32x4){0.f, 0.f, 0.f, 0.f};
        cur = nxt; cA = nA; cB = nB; ++ui;
        if (wr == 1) PG8_BAR;
    }
    PG8_WAIT_V(0);
    PG8_BAR;
#undef PG8_AOFF
#undef PG8_SA
#undef PG8_SB
#undef PG8_STAGE
#undef PG8_LDA
#undef PG8_LDB
#undef PG8_MMA
#undef PG8_CAT
#undef PG8_WAIT_V
#undef PG8_WAIT_L
#undef PG8_BAR
#undef PG8_SCHED
}

template <class P>
__device__ __forceinline__ void gemm_phase_m128(LAS unsigned char* lds, const P& S) {
    int tid_ = threadIdx.x; asm volatile("" : "+v"(tid_));
    const int tid = tid_, wid = __builtin_amdgcn_readfirstlane(tid >> 6), lane = tid & 63, wr = wid >> 2, wc = wid & 3, fr = lane & 15, fq = lane >> 4;
    constexpr int ELB = P::FP8 ? 1 : 2;
    const int K = S.K; int nt = K * ELB / 128; asm volatile("" : "+s"(nt));
    unsigned voffB[2];
#pragma unroll
    for (int i = 0; i < 2; ++i) { int R, C; stage_rc(tid * 16 + i * 8192, R, C); const int Rb = (R & ~31) + perm32(R & 31); voffB[i] = (unsigned)(Rb * K * ELB + C * 2); }
#define PG8_AOFF(dst0, u) do { _Pragma("unroll") for (int i = 0; i < 2; ++i) { int R, C; stage_rc(tid * 16 + i * 8192, R, C); dst0[i] = S.a_off(u, R, C); } } while (0)
    const size_t kstepB = (size_t)(BK * 2), hstepB = (size_t)HALF * K * ELB, kstepA = (size_t)S.kstepA;
    const unsigned ldsw = (unsigned)wid * 1024u;
    const int aoff = lds_byte(wr * 64 + fr, fq * 8), boff = lds_byte(wc * 32 + fr, fq * 8);
#define PG8_SA(b) (((b) * 2) * HTB)
#define PG8_SB(b, h) ((4 + (b) * 2 + (h)) * HTB)
#define PG8_STAGE(bufoff, gbase, voff) do { _Pragma("unroll") for (int _i = 0; _i < 2; ++_i) \
        __builtin_amdgcn_global_load_lds((const unsigned*)((const char*)(gbase) + (voff)[_i]), (LAS unsigned*)(lds + (bufoff) + ldsw + _i * 8192), 16, 0, 0); } while (0)
#define PG8_LDA(dst, b) do { _Pragma("unroll") for (int m = 0; m < 4; ++m) _Pragma("unroll") for (int k = 0; k < 2; ++k) dst[m][k] = *(const LAS bf16x8*)(lds + PG8_SA(b) + aoff + m * 2048 + k * 1024); } while (0)
#define PG8_LDB(dst, b, h) do { _Pragma("unroll") for (int n = 0; n < 2; ++n) _Pragma("unroll") for (int k = 0; k < 2; ++k) dst[n][k] = *(const LAS bf16x8*)(lds + PG8_SB(b, h) + boff + n * 2048 + k * 1024); } while (0)
#define PG8_CAT(x0, x1) __builtin_shufflevector(__builtin_bit_cast(v4i, x0), __builtin_bit_cast(v4i, x1), 0, 1, 2, 3, 4, 5, 6, 7)
#define PG8_MMA(bj, At, Bt) do { __builtin_amdgcn_s_setprio(1); _Pragma("unroll") for (int m = 0; m < 4; ++m) _Pragma("unroll") for (int n = 0; n < 2; ++n) { \
        if constexpr (P::FP8) acc[bj][m][n] = __builtin_amdgcn_mfma_scale_f32_16x16x128_f8f6f4(PG8_CAT(Bt[n][0], Bt[n][1]), PG8_CAT(At[m][0], At[m][1]), acc[bj][m][n], 0, 0, 0, 0x7f7f7f7f, 0, 0x7f7f7f7f); \
        else { _Pragma("unroll") for (int k = 0; k < 2; ++k) acc[bj][m][n] = __builtin_amdgcn_mfma_f32_16x16x32_bf16(Bt[n][k], At[m][k], acc[bj][m][n], 0, 0, 0); } } __builtin_amdgcn_s_setprio(0); } while (0)
#define PG8_WAIT_V(n) asm volatile("s_waitcnt vmcnt(" #n ")" ::: "memory")
#define PG8_WAIT_L(n) asm volatile("s_waitcnt lgkmcnt(" #n ")" ::: "memory")
#define PG8_BAR __builtin_amdgcn_s_barrier()
#define PG8_SCHED __builtin_amdgcn_sched_barrier(0)
    Unit cur, nxt; int ui = 0;
    if (!S.next(0, cur)) return;
    f32x4 acc[2][4][2], st[2][4][2];
#pragma unroll
    for (int a = 0; a < 2; ++a)
#pragma unroll
        for (int m = 0; m < 4; ++m)
#pragma unroll
            for (int n = 0; n < 2; ++n) { acc[a][m][n] = (f32x4){0.f, 0.f, 0.f, 0.f}; st[a][m][n] = (f32x4){0.f, 0.f, 0.f, 0.f}; }
    bf16x8 At[4][2], B0[2][2];
    unsigned vA[2], vN[2];
    PG8_AOFF(vA, cur);
    const char* cA = S.a_base(cur); const char* cB = S.b_base(cur);
    PG8_STAGE(PG8_SB(0, 0), cB, voffB); PG8_STAGE(PG8_SA(0), cA, vA); PG8_STAGE(PG8_SB(0, 1), cB + hstepB, voffB);
    if (wr == 1) PG8_BAR;
    PG8_WAIT_V(2); PG8_BAR;
    PG8_STAGE(PG8_SB(1, 0), cB + kstepB, voffB); PG8_STAGE(PG8_SA(1), cA + kstepA, vA);
    PG8_WAIT_V(4); PG8_BAR;
    for (;;) {
        const bool has_next = S.next(ui + 1, nxt);
        const char* nA = cA; const char* nB = cB;
        if (has_next) { nA = S.a_base(nxt); nB = S.b_base(nxt); if (P::EARLY_AOFF) PG8_AOFF(vN, nxt); }
        for (int t = 0; t < nt; t += 2) {
            const bool last = (t == nt - 2);
            const char* b1 = cB + (size_t)(t + 1) * kstepB;
            const char* a2 = last ? nA : cA + (size_t)(t + 2) * kstepA; const char* b2 = last ? nB : cB + (size_t)(t + 2) * kstepB;
            const char* a3 = a2 + kstepA; const char* b3 = b2 + kstepB;
            PG8_LDB(B0, 0, 0); PG8_SCHED; PG8_LDA(At, 0); PG8_STAGE(PG8_SB(1, 1), b1 + hstepB, voffB);
            if (last && has_next) { if (P::EARLY_AOFF) { vA[0] = vN[0]; vA[1] = vN[1]; } else PG8_AOFF(vA, nxt); }
            PG8_WAIT_V(6); PG8_WAIT_L(0); PG8_BAR; PG8_MMA(0, At, B0); PG8_BAR; PG8_SCHED;
            PG8_LDB(B0, 0, 1); PG8_STAGE(PG8_SB(0, 0), b2, voffB); PG8_STAGE(PG8_SA(0), a2, vA);
            PG8_WAIT_V(6); PG8_WAIT_L(0); PG8_BAR; PG8_MMA(1, At, B0); PG8_BAR; PG8_SCHED;
            PG8_LDB(B0, 1, 0); PG8_SCHED; PG8_LDA(At, 1); PG8_STAGE(PG8_SB(0, 1), b2 + hstepB, voffB);
            PG8_WAIT_V(6); PG8_WAIT_L(0); PG8_BAR; PG8_MMA(0, At, B0); PG8_BAR; PG8_SCHED;
            PG8_LDB(B0, 1, 1); PG8_STAGE(PG8_SB(1, 0), b3, voffB); PG8_STAGE(PG8_SA(1), a3, vA);
            PG8_WAIT_V(6); PG8_WAIT_L(0); PG8_BAR; PG8_MMA(1, At, B0); PG8_BAR; PG8_SCHED;
        }
        if (wr == 0) PG8_BAR;
        S.epi(acc, st, cur, wr, wc, fr, fq);
        if (!has_next) break;
#pragma unroll
        for (int a = 0; a < 2; ++a)
#pragma unroll
            for (int m = 0; m < 4; ++m)
#pragma unroll
                for (int n = 0; n < 2; ++n) acc[a][m][n] = (f32x4){0.f, 0.f, 0.f, 0.f};
        cur = nxt; cA = nA; cB = nB; ++ui;
        if (wr == 1) PG8_BAR;
    }
    PG8_WAIT_V(0);
    PG8_BAR;
#undef PG8_AOFF
#undef PG8_SA
#undef PG8_SB
#undef PG8_STAGE
#undef PG8_LDA
#undef PG8_LDB
#undef PG8_MMA
#undef PG8_CAT
#undef PG8_WAIT_V
#undef PG8_WAIT_L
#undef PG8_BAR
#undef PG8_SCHED
}

template <class P>
__device__ __forceinline__ void gemm_phase_m192(LAS unsigned char* lds, const P& S) {
    int tid_ = threadIdx.x; asm volatile("" : "+v"(tid_));
    const int tid = tid_, wid = __builtin_amdgcn_readfirstlane(tid >> 6), lane = tid & 63, wr = wid >> 2, wc = wid & 3, fr = lane & 15, fq = lane >> 4;
    constexpr int ELB = P::FP8 ? 1 : 2;
    const int K = S.K; int nt = K * ELB / 128; asm volatile("" : "+s"(nt));
    unsigned voffB[2];
#pragma unroll
    for (int i = 0; i < 2; ++i) { int R, C; stage_rc(tid * 16 + i * 8192, R, C); const int Rb = (R & ~31) + perm32(R & 31); voffB[i] = (unsigned)(Rb * K * ELB + C * 2); }
#define PG8_AOFF(dst0, u) do { _Pragma("unroll") for (int i = 0; i < 3; ++i) { int R, C; stage_rc(tid * 16 + i * 8192, R, C); dst0[i] = S.a_off(u, R, C); } } while (0)
    const size_t kstepB = (size_t)(BK * 2), hstepB = (size_t)HALF * K * ELB, kstepA = (size_t)S.kstepA;
    const unsigned ldsw = (unsigned)wid * 1024u;
    const int aoff = lds_byte(wr * 96 + fr, fq * 8), boff = lds_byte(wc * 32 + fr, fq * 8);
#define PG8_SA(b) (((b) * 2) * HTB)
#define PG8_SB(b, h) ((4 + (b) * 2 + (h)) * HTB)
#define PG8_STAGE(bufoff, gbase, voff) do { _Pragma("unroll") for (int _i = 0; _i < 2; ++_i) \
        __builtin_amdgcn_global_load_lds((const unsigned*)((const char*)(gbase) + (voff)[_i]), (LAS unsigned*)(lds + (bufoff) + ldsw + _i * 8192), 16, 0, 0); } while (0)
#define PG8_STAGEA(bufoff, gbase, voff) do { _Pragma("unroll") for (int _i = 0; _i < 3; ++_i) \
        __builtin_amdgcn_global_load_lds((const unsigned*)((const char*)(gbase) + (voff)[_i]), (LAS unsigned*)(lds + (bufoff) + ldsw + _i * 8192), 16, 0, 0); } while (0)
#define PG8_LDA(dst, b) do { _Pragma("unroll") for (int m = 0; m < 6; ++m) _Pragma("unroll") for (int k = 0; k < 2; ++k) dst[m][k] = *(const LAS bf16x8*)(lds + PG8_SA(b) + aoff + m * 2048 + k * 1024); } while (0)
#define PG8_LDB(dst, b, h) do { _Pragma("unroll") for (int n = 0; n < 2; ++n) _Pragma("unroll") for (int k = 0; k < 2; ++k) dst[n][k] = *(const LAS bf16x8*)(lds + PG8_SB(b, h) + boff + n * 2048 + k * 1024); } while (0)
#define PG8_CAT(x0, x1) __builtin_shufflevector(__builtin_bit_cast(v4i, x0), __builtin_bit_cast(v4i, x1), 0, 1, 2, 3, 4, 5, 6, 7)
#define PG8_MMA(bj, At, Bt) do { __builtin_amdgcn_s_setprio(1); _Pragma("unroll") for (int m = 0; m < 6; ++m) _Pragma("unroll") for (int n = 0; n < 2; ++n) { \
        if constexpr (P::FP8) acc[bj][m][n] = __builtin_amdgcn_mfma_scale_f32_16x16x128_f8f6f4(PG8_CAT(Bt[n][0], Bt[n][1]), PG8_CAT(At[m][0], At[m][1]), acc[bj][m][n], 0, 0, 0, 0x7f7f7f7f, 0, 0x7f7f7f7f); \
        else { _Pragma("unroll") for (int k = 0; k < 2; ++k) acc[bj][m][n] = __builtin_amdgcn_mfma_f32_16x16x32_bf16(Bt[n][k], At[m][k], acc[bj][m][n], 0, 0, 0); } } __builtin_amdgcn_s_setprio(0); } while (0)
#define PG8_WAIT_V(n) asm volatile("s_waitcnt vmcnt(" #n ")" ::: "memory")
#define PG8_WAIT_L(n) asm volatile("s_waitcnt lgkmcnt(" #n ")" ::: "memory")
#define PG8_BAR __builtin_amdgcn_s_barrier()
#define PG8_SCHED __builtin_amdgcn_sched_barrier(0)
    Unit cur, nxt; int ui = 0;
    if (!S.next(0, cur)) return;
    f32x4 acc[2][6][2];
#pragma unroll
    for (int a = 0; a < 2; ++a)
#pragma unroll
        for (int m = 0; m < 6; ++m)
#pragma unroll
            for (int n = 0; n < 2; ++n) acc[a][m][n] = (f32x4){0.f, 0.f, 0.f, 0.f};
    bf16x8 At[6][2], B0[2][2];
    unsigned vA[3], vN[3];
    PG8_AOFF(vA, cur);
    const char* cA = S.a_base(cur); const char* cB = S.b_base(cur);
    PG8_STAGE(PG8_SB(0, 0), cB, voffB); PG8_STAGEA(PG8_SA(0), cA, vA); PG8_STAGE(PG8_SB(0, 1), cB + hstepB, voffB);
    if (wr == 1) PG8_BAR;
    PG8_WAIT_V(2); PG8_BAR;
    PG8_STAGE(PG8_SB(1, 0), cB + kstepB, voffB); PG8_STAGEA(PG8_SA(1), cA + kstepA, vA);
    PG8_WAIT_V(5); PG8_BAR;
    for (;;) {
        const bool has_next = S.next(ui + 1, nxt);
        const char* nA = cA; const char* nB = cB;
        if (has_next) { nA = S.a_base(nxt); nB = S.b_base(nxt); if (P::EARLY_AOFF) PG8_AOFF(vN, nxt); }
        for (int t = 0; t < nt; t += 2) {
            const bool last = (t == nt - 2);
            const char* b1 = cB + (size_t)(t + 1) * kstepB;
            const char* a2 = last ? nA : cA + (size_t)(t + 2) * kstepA; const char* b2 = last ? nB : cB + (size_t)(t + 2) * kstepB;
            const char* a3 = a2 + kstepA; const char* b3 = b2 + kstepB;
            PG8_LDB(B0, 0, 0); PG8_SCHED; PG8_LDA(At, 0); PG8_STAGE(PG8_SB(1, 1), b1 + hstepB, voffB);
            if (last && has_next) { if (P::EARLY_AOFF) { vA[0] = vN[0]; vA[1] = vN[1]; vA[2] = vN[2]; } else PG8_AOFF(vA, nxt); }
            PG8_WAIT_V(7); PG8_WAIT_L(0); PG8_BAR; PG8_MMA(0, At, B0); PG8_BAR; PG8_SCHED;
            PG8_LDB(B0, 0, 1); PG8_STAGE(PG8_SB(0, 0), b2, voffB); PG8_STAGEA(PG8_SA(0), a2, vA);
            PG8_WAIT_V(7); PG8_WAIT_L(0); PG8_BAR; PG8_MMA(1, At, B0); PG8_BAR; PG8_SCHED;
            PG8_LDB(B0, 1, 0); PG8_SCHED; PG8_LDA(At, 1); PG8_STAGE(PG8_SB(0, 1), b2 + hstepB, voffB);
            PG8_WAIT_V(7); PG8_WAIT_L(0); PG8_BAR; PG8_MMA(0, At, B0); PG8_BAR; PG8_SCHED;
            PG8_LDB(B0, 1, 1); PG8_STAGE(PG8_SB(1, 0), b3, voffB); PG8_STAGEA(PG8_SA(1), a3, vA);
            PG8_WAIT_V(7); PG8_WAIT_L(0); PG8_BAR; PG8_MMA(1, At, B0); PG8_BAR; PG8_SCHED;
        }
        if (wr == 0) PG8_BAR;
        S.epi6(acc, cur, wr, wc, fr, fq);
        if (!has_next) break;
#pragma unroll
        for (int a = 0; a < 2; ++a)
#pragma unroll
            for (int m = 0; m < 6; ++m)
#pragma unroll
                for (int n = 0; n < 2; ++n) acc[a][m][n] = (f32x4){0.f, 0.f, 0.f, 0.f};
        cur = nxt; cA = nA; cB = nB; ++ui;
        if (wr == 1) PG8_BAR;
    }
    PG8_WAIT_V(0);
    PG8_BAR;
#undef PG8_AOFF
#undef PG8_SA
#undef PG8_SB
#undef PG8_STAGE
#undef PG8_STAGEA
#undef PG8_LDA
#undef PG8_LDB
#undef PG8_MMA
#undef PG8_CAT
#undef PG8_WAIT_V
#undef PG8_WAIT_L
#undef PG8_BAR
#undef PG8_SCHED
}
}
namespace attn_body {
using bf16x8 = __attribute__((ext_vector_type(8))) short;
using u32x4 = __attribute__((ext_vector_type(4))) unsigned;
constexpr int NW = 8, QBLK = 32, QB = QBLK * NW, KVBLK = 64;
__device__ __forceinline__ int crow(int r, int hi) { return (r & 3) + 8 * (r >> 2) + 4 * hi; }
#define SBAR() __builtin_amdgcn_sched_barrier(0)
constexpr int NSLOT = 3, SLOTB = 8192;
constexpr int LDS_K = 0, LDS_V = NSLOT * SLOTB, LDS_WS = 2 * NSLOT * SLOTB, LDS_OST = LDS_WS + NW * 64 * 4, LDS_BYTES = LDS_OST + NW * 4096;
constexpr int LDS_BT = 86016 + 256;
__device__ __forceinline__ void glds16s(const void* sbase, unsigned voff, unsigned lds_dst) { unsigned keep;
  asm volatile("s_mov_b32 %0, m0\n\ts_mov_b32 m0, %2\n\ts_nop 0\n\tglobal_load_lds_dwordx4 %1, %3\n\ts_mov_b32 m0, %0" : "=&s"(keep) : "v"(voff), "s"(lds_dst), "s"(sbase) : "memory"); }
__device__ __forceinline__ void glds16(const void* gsrc, unsigned lds_dst) { unsigned keep;
  asm volatile("s_mov_b32 %0, m0\n\ts_mov_b32 m0, %2\n\ts_nop 0\n\tglobal_load_lds_dwordx4 %1, off\n\ts_mov_b32 m0, %0" : "=&s"(keep) : "v"(gsrc), "s"(lds_dst) : "memory"); }
__device__ __forceinline__ float max3f(float a, float b, float c) { float r; asm("v_max3_f32 %0, %1, %2, %3" : "=v"(r) : "v"(a), "v"(b), "v"(c)); return r; }
__device__ __forceinline__ float max2f(float a, float b) { float r; asm("v_max_f32_e32 %0, %1, %2" : "=v"(r) : "v"(a), "v"(b)); return r; }
__device__ __forceinline__ float fadd_s(float a, float b) { float r; asm("v_add_f32_e32 %0, %1, %2" : "=v"(r) : "v"(a), "v"(b)); return r; }
__device__ __forceinline__ float fsub_s(float a, float b) { float r; asm("v_sub_f32_e32 %0, %1, %2" : "=v"(r) : "v"(a), "v"(b)); return r; }
typedef float f32x2_t __attribute__((ext_vector_type(2))); typedef __bf16 bf16x2_t __attribute__((ext_vector_type(2)));
__device__ __forceinline__ unsigned cvtpk_s(float lo, float hi) { f32x2_t v = {lo, hi}; bf16x2_t b = __builtin_convertvector(v, bf16x2_t); return __builtin_bit_cast(unsigned, b); }
#define WAIT_BAR(N) do { asm volatile("s_waitcnt vmcnt(" #N ") lgkmcnt(0)\n\ts_barrier" ::: "memory"); __builtin_amdgcn_s_waitcnt(0xC07F); } while (0)

__device__ __forceinline__ void qkt(f32x16& p0, f32x16& p1, const char* Kslot, const bf16x8* qr, const f32x16& negm, int r32, int hi) {
  const char* kb = Kslot + hi * 1024 + r32 * 16;
  #pragma unroll
  for (int d0 = 0; d0 < 4; ++d0) {
    const bf16x8 b0 = *reinterpret_cast<const bf16x8*>(kb + d0 * 2048);
    const bf16x8 b1 = *reinterpret_cast<const bf16x8*>(kb + d0 * 2048 + 512);
    if (d0 == 0) { p0 = __builtin_amdgcn_mfma_f32_32x32x16_bf16(b0, qr[0], negm, 0, 0, 0); p1 = __builtin_amdgcn_mfma_f32_32x32x16_bf16(b1, qr[0], negm, 0, 0, 0); }
    else { p0 = __builtin_amdgcn_mfma_f32_32x32x16_bf16(b0, qr[d0], p0, 0, 0, 0); p1 = __builtin_amdgcn_mfma_f32_32x32x16_bf16(b1, qr[d0], p1, 0, 0, 0); } }
}
typedef __attribute__((address_space(3))) const char* lds_cptr;
typedef short v4i16_t __attribute__((ext_vector_type(4)));
__device__ __forceinline__ void kload8(bf16x8* kf, lds_cptr kp) {
  kf[0] = *(const __attribute__((address_space(3))) bf16x8*)(kp);        kf[1] = *(const __attribute__((address_space(3))) bf16x8*)(kp + 512);
  kf[2] = *(const __attribute__((address_space(3))) bf16x8*)(kp + 2048); kf[3] = *(const __attribute__((address_space(3))) bf16x8*)(kp + 2560);
  kf[4] = *(const __attribute__((address_space(3))) bf16x8*)(kp + 4096); kf[5] = *(const __attribute__((address_space(3))) bf16x8*)(kp + 4608);
  kf[6] = *(const __attribute__((address_space(3))) bf16x8*)(kp + 6144); kf[7] = *(const __attribute__((address_space(3))) bf16x8*)(kp + 6656);
}
__device__ __forceinline__ void kload2(bf16x8* kf, lds_cptr kp, int j) { kf[2 * j] = *(const __attribute__((address_space(3))) bf16x8*)(kp + j * 2048); kf[2 * j + 1] = *(const __attribute__((address_space(3))) bf16x8*)(kp + j * 2048 + 512); }
__device__ __forceinline__ s16x4 vtr(lds_cptr p) { return __builtin_bit_cast(s16x4, __builtin_amdgcn_ds_read_tr16_b64_v4i16((__attribute__((address_space(3))) v4i16_t*)p)); }
__device__ __forceinline__ float rowmax(const f32x16& p0, const f32x16& p1) {
  float a = max3f(p0[0], p0[1], p1[0]), b = max3f(p0[2], p0[3], p1[1]); a = max3f(a, p1[2], p1[3]);
  #pragma unroll
  for (int r = 4; r < 16; r += 4) { a = max3f(a, p0[r], p0[r + 1]); b = max3f(b, p0[r + 2], p0[r + 3]); a = max3f(a, p1[r], p1[r + 1]); b = max3f(b, p1[r + 2], p1[r + 3]); }
  const float m = max2f(a, b);
  auto rr = __builtin_amdgcn_permlane32_swap(__float_as_uint(m), __float_as_uint(m), false, false);
  return max2f(__uint_as_float(rr[0]), __uint_as_float(rr[1]));
}
__device__ __forceinline__ void pv(f32x16* o, int vb, bf16x8 pa0, bf16x8 pa1, bf16x8 pa2, bf16x8 pa3) {
  #pragma unroll
  for (int d0 = 0; d0 < 2; ++d0) { s16x4 lo[4], hi[4];
    #pragma unroll
    for (int ks = 0; ks < 4; ++ks) {
      asm volatile("ds_read_b64_tr_b16 %0,%1 offset:%c2" : "=&v"(lo[ks]) : "v"(vb), "i"(d0 * 4096 + ks * 1024) : "memory");
      asm volatile("ds_read_b64_tr_b16 %0,%1 offset:%c2" : "=&v"(hi[ks]) : "v"(vb), "i"(d0 * 4096 + ks * 1024 + 512) : "memory"); }
    asm volatile("s_waitcnt lgkmcnt(0)" ::: "memory"); SBAR();
    #define PK(k) (bf16x8){lo[k][0], lo[k][1], lo[k][2], lo[k][3], hi[k][0], hi[k][1], hi[k][2], hi[k][3]}
    o[d0] = __builtin_amdgcn_mfma_f32_32x32x16_bf16(pa0, PK(0), o[d0], 0, 0, 0);
    o[d0] = __builtin_amdgcn_mfma_f32_32x32x16_bf16(pa1, PK(1), o[d0], 0, 0, 0);
    o[d0] = __builtin_amdgcn_mfma_f32_32x32x16_bf16(pa2, PK(2), o[d0], 0, 0, 0);
    o[d0] = __builtin_amdgcn_mfma_f32_32x32x16_bf16(pa3, PK(3), o[d0], 0, 0, 0);
    #undef PK
  }
}
#define ATTN_STORE16(p, v) (*(u32x4*)(p) = (v))

template <int THRL, bool NA, int QP_, int KVP_, bool NOMAX = false, bool QPREP = false>
__device__ __forceinline__ void attn_unit(const bf16* Qu, int qp_rt, const bf16* __restrict__ Kh, const bf16* __restrict__ Vh, int kvp_rt, bf16* Ou, int NT, int r0, int rlo, char* shm, const float* qgain = nullptr, int tt0 = 0) {
  const int qp = QP_ ? QP_ : qp_rt, kvp = KVP_ ? KVP_ : kvp_rt, op = qp;
  int tid_ = threadIdx.x; asm volatile("" : "+v"(tid_));
  const int tid = tid_, lane = tid & 63, r32 = lane & 31, hi = lane >> 5; const int wid = __builtin_amdgcn_readfirstlane(tid >> 6);
  const bf16* Qw = Qu + (long)(wid * QBLK) * qp;
  const unsigned lds0 = (unsigned)(uintptr_t)shm;
  float* wsf = (float*)(shm + LDS_WS) + wid * 64;
  const unsigned kvo = (unsigned)(lane * kvp + wid * 8) * 2u, vvo = (unsigned)((16 * (wid & 3) + (lane >> 2)) * kvp + (wid >> 2) * 32 + (lane & 3) * 8) * 2u;
  const unsigned kdst = lds0 + LDS_K + wid * 1024, vdst = lds0 + LDS_V + wid * 1024;
  #define TROW(t) (NA ? ((t) < 4 ? 64 * (t) : CTX + 64 * ((rlo + (t) - 4) < 127 ? (rlo + (t) - 4) : 127)) : 64 * (t))
  #define DMA_K(t, slot) glds16s(Kh + (long)TROW(t) * kvp, kvo, (unsigned)__builtin_amdgcn_readfirstlane(kdst + (slot)))
  #define DMA_V(t, slot) glds16s(Vh + (long)TROW(t) * kvp, vvo, (unsigned)__builtin_amdgcn_readfirstlane(vdst + (slot)))
  const int vb0 = (int)(lds0 + LDS_V) + ((lane >> 4) & 1) * 32 + (lane & 3) * 8 + (4 * hi + ((lane & 15) >> 2)) * 64;
  const char* Kbase = shm + LDS_K; bf16x8 kf[8];
  const lds_cptr shm3 = (lds_cptr)shm; const lds_cptr kp0 = shm3 + LDS_K + hi * 1024 + r32 * 16; const lds_cptr vp0 = shm3 + LDS_V + ((lane >> 4) & 1) * 32 + (lane & 3) * 8 + (4 * hi + ((lane & 15) >> 2)) * 64;
  const int rq = r0 + (wid >> 1), qc = 32 * (wid & 1) + r32;
  const int rsw = rq - 4 < 0 ? 0 : (rq - 4 > 120 ? 120 : rq - 4);
  const int cs = qc - 8 < 0 ? 0 : (qc - 8 > 48 ? 48 : qc - 8);
  const __attribute__((address_space(3))) float* btl = (const __attribute__((address_space(3))) float*)(shm3 + LDS_BT) + (15 + 4 * hi - qc);
  DMA_K(0, 0); DMA_V(0, 0); DMA_K(1, SLOTB);
  float btv_ = 0.f; if (NA && qgain != nullptr) { if (tid < 465) btv_ = qgain[tid]; }
  bf16x8 qr[4];
  #pragma unroll
  for (int d0 = 0; d0 < 4; ++d0) qr[d0] = *reinterpret_cast<const bf16x8*>(&Qw[(long)r32 * qp + d0 * 16 + hi * 8]);
  if constexpr (QPREP) {
    float x[4][8]; float ss = 0.f;
    #pragma unroll
    for (int d0 = 0; d0 < 4; ++d0) { const u32x4 w = __builtin_bit_cast(u32x4, qr[d0]);
      #pragma unroll
      for (int j = 0; j < 4; ++j) { x[d0][2 * j] = __uint_as_float(w[j] << 16); x[d0][2 * j + 1] = __uint_as_float(w[j] & 0xffff0000u); } }
    #pragma unroll
    for (int d0 = 0; d0 < 4; ++d0)
      #pragma unroll
      for (int i = 0; i < 8; ++i) ss += x[d0][i] * x[d0][i];
    { auto rr = __builtin_amdgcn_permlane32_swap(__float_as_uint(ss), __float_as_uint(ss), false, false); ss = __uint_as_float(rr[0]) + __uint_as_float(rr[1]); }
    const float rstd = 1.f / sqrtf(ss * (1.f / 64.f) + EPS);
    const int tt = tt0 + wid * QBLK + r32; const float posr = (float)(tt >> 6), posc = (float)(tt & 63);
    #pragma unroll
    for (int i = 0; i < 8; i += 2) { float y[4][2];
      #pragma unroll
      for (int e = 0; e < 2; ++e) { const int f = 8 * hi + i + e; const float invf = __builtin_amdgcn_exp2f(-(float)f * 0.8304820237218406f) * 0.15915494309189535f;
        const float cr = cos_rev(posr * invf), sr = sin_rev(posr * invf), cc = cos_rev(posc * invf), sc = sin_rev(posc * invf);
        const float a0 = x[0][i + e] * rstd * qgain[f], a1 = x[1][i + e] * rstd * qgain[16 + f], a2 = x[2][i + e] * rstd * qgain[32 + f], a3 = x[3][i + e] * rstd * qgain[48 + f];
        y[0][e] = (a0 * cr - a1 * sr) * C2; y[1][e] = (a1 * cr + a0 * sr) * C2; y[2][e] = (a2 * cc - a3 * sc) * C2; y[3][e] = (a3 * cc + a2 * sc) * C2; }
      #pragma unroll
      for (int d0 = 0; d0 < 4; ++d0) { const unsigned pk = cvtpk_s(y[d0][0], y[d0][1]); qr[d0][i] = (short)(pk & 0xffffu); qr[d0][i + 1] = (short)(pk >> 16); } }
  }
  float mhat = 0.f, l_reg = 0.f; f32x16 o[2]; o[0] = f32x16{}; o[1] = f32x16{}; f32x16 negm = f32x16{}; asm volatile("" : "+v"(negm));
  #define NEGM negm
  #define CMASK(P0, P1, t) do { if (NA) { if ((t) >= 4) { const int kr_ = rlo + (t) - 4; const int dr_ = kr_ - rsw; \
      if (dr_ < 0 || dr_ >= 8) { _Pragma("unroll") for (int r = 0; r < 16; ++r) { P0[r] = (-__builtin_inff()); P1[r] = (-__builtin_inff()); } } \
      else { const __attribute__((address_space(3))) float* bp_ = btl + (kr_ - rq + 7) * 31; unsigned w0_ = vm0, w1_ = vm1; asm volatile("" : "+v"(w0_), "+v"(w1_));   \
        _Pragma("unroll") for (int rg = 0; rg < 4; ++rg) { \
          _Pragma("unroll") for (int rr_ = 0; rr_ < 4; ++rr_) { const int r = rg * 4 + rr_; const int kc_ = (r & 3) + 8 * (r >> 2); const float b0_ = bp_[kc_], b1_ = bp_[kc_ + 32]; \
            const int m0_ = ((int)(w0_ << (31 - r))) >> 31, m1_ = ((int)(w1_ << (31 - r))) >> 31;        \
            float t0_ = P0[r] + b0_; asm volatile("" : "+v"(t0_)); float t1_ = P1[r] + b1_; asm volatile("" : "+v"(t1_));        \
            P0[r] = __uint_as_float((__float_as_uint(t0_) & (unsigned)m0_) | (~(unsigned)m0_ & 0xff800000u)); P1[r] = __uint_as_float((__float_as_uint(t1_) & (unsigned)m1_) | (~(unsigned)m1_ & 0xff800000u)); } \
          SBAR(); } } } } } while (0)
  unsigned vm0 = 0u, vm1 = 0u;
  if (NA) {
    const unsigned long long W = (0xFFFFull << cs) >> (4 * hi); const unsigned wl = (unsigned)W, wh = (unsigned)(W >> 32);
    vm0 = (wl & 0xFu) | ((wl >> 4) & 0xF0u) | ((wl >> 8) & 0xF00u) | ((wl >> 12) & 0xF000u);
    vm1 = (wh & 0xFu) | ((wh >> 4) & 0xF0u) | ((wh >> 8) & 0xF00u) | ((wh >> 12) & 0xF000u); }
  bool resc = false;
  #define START(P0, P1) do { const float rm = NOMAX ? 0.f : rowmax(P0, P1); resc = false; \
    { const float dl = rm; mhat = fadd_s(mhat, dl); \
      _Pragma("unroll") for (int r = 0; r < 16; ++r) { P0[r] = fsub_s(P0[r], dl); P1[r] = fsub_s(P1[r], dl); } \
      { _Pragma("unroll") for (int r = 0; r < 16; ++r) negm[r] = -mhat; asm volatile("" : "+v"(negm)); } } \
    _Pragma("unroll") for (int r = 0; r < 16; ++r) P0[r] = __builtin_amdgcn_exp2f(P0[r]); } while (0)
  #define RESC() do { if (resc) { asm volatile("s_waitcnt lgkmcnt(0)" ::: "memory"); \
      _Pragma("unroll") for (int d_ = 0; d_ < 2; ++d_) _Pragma("unroll") for (int r = 0; r < 16; ++r) o[d_][r] *= wsf[crow(r, hi)]; } } while (0)
  f32x16 pA0, pA1, pB0, pB1;
  int sl_prev = 0, sl_cur = 0, sl_next = SLOTB;
  #define ROT() do { sl_prev = sl_cur; sl_cur = sl_next; sl_next = (sl_next == (NSLOT - 1) * SLOTB) ? 0 : sl_next + SLOTB; } while (0)
  DMA_K(2, 2 * SLOTB);
  WAIT_BAR(3);
  if (NA && qgain != nullptr) { if (tid < 465) ((float*)(shm + LDS_BT))[tid] = btv_ * LOG2E; }
  qkt(pA0, pA1, Kbase, qr, NEGM, r32, hi); asm volatile("s_nop 15\n\ts_nop 7" : "+v"(pA0), "+v"(pA1));
  START(pA0, pA1);
  _Pragma("unroll") for (int r = 0; r < 16; ++r) pA1[r] = __builtin_amdgcn_exp2f(pA1[r]);
  WAIT_BAR(0);
  DMA_K(3, 0); DMA_V(1, SLOTB);
  ROT();
  kload8(kf, kp0 + sl_cur);
  WAIT_BAR(2);
  s16x4 vlo[8], vhi[8]; u32x4 pw0, pw1, pw2, pw3;
  #define PKW(P, B) cvtpk_s(P[B], P[B + 1])
  #define PAF(k) __builtin_bit_cast(bf16x8, pw##k)
  #define VFR(i) (bf16x8){vlo[i][0], vlo[i][1], vlo[i][2], vlo[i][3], vhi[i][0], vhi[i][1], vhi[i][2], vhi[i][3]}
  #define PIN(x) asm volatile("" : "+v"(x))
  #define MX3(a, b, c) __builtin_fmaxf(__builtin_fmaxf((a), (b)), (c))
  #define GAPA(MF, A0, A1, A2, A3, W0, W1, PW) do { MF; sa0 = fadd_s(sa0, A0); sa1 = fadd_s(sa1, A1); sa0 = fadd_s(sa0, A2); sa1 = fadd_s(sa1, A3); W0; W1; PIN(PW); SBAR(); } while (0)
  #define GAPA2(MF, A0, A1, W0, W1, PW) do { MF; sa0 = fadd_s(sa0, A0); sa1 = fadd_s(sa1, A1); W0; W1; PIN(PW); SBAR(); } while (0)
  #define EX(v) __builtin_amdgcn_exp2f(v)
  #define GAPB(MF, X, B) do { MF; X[B] = EX(X[B]); X[B + 1] = EX(X[B + 1]); X[B + 2] = EX(X[B + 2]); X[B + 3] = EX(X[B + 3]); PIN(X); SBAR(); } while (0)
  #define VRD(i) do { vlo[i] = vtr(vp_ + (((i) >> 2) * 4096 + ((i) & 3) * 1024)); vhi[i] = vtr(vp_ + (((i) >> 2) * 4096 + ((i) & 3) * 1024 + 512)); } while (0)
  #define KRD(G, j) do { if (G) { kload2(kf, kp0 + sl_next, j); SBAR(); } } while (0)
  #define STEP(C0, C1, P0, P1, t, GK, GV, GL) do { SBAR(); \
    const lds_cptr vp_ = vp0 + sl_prev; \
    VRD(0); SBAR(); float sa0 = P0[0], sa1 = P0[1]; \
    GAPA(C0 = __builtin_amdgcn_mfma_f32_32x32x16_bf16(kf[0], qr[0], NEGM, 0, 0, 0), P0[2], P0[3], P0[4], P0[5],     pw0[0] = PKW(P0, 0), pw0[1] = PKW(P0, 2), pw0); \
    VRD(4); SBAR(); GAPA(C1 = __builtin_amdgcn_mfma_f32_32x32x16_bf16(kf[1], qr[0], NEGM, 0, 0, 0), P0[6], P0[7], P0[8], P0[9],     pw0[2] = PKW(P0, 4), pw0[3] = PKW(P0, 6), pw0); \
    VRD(1); SBAR(); GAPA(C0 = __builtin_amdgcn_mfma_f32_32x32x16_bf16(kf[2], qr[1], C0, 0, 0, 0),   P0[10], P0[11], P0[12], P0[13], pw1[0] = PKW(P0, 8), pw1[1] = PKW(P0, 10), pw1); \
    VRD(5); SBAR(); GAPA(C1 = __builtin_amdgcn_mfma_f32_32x32x16_bf16(kf[3], qr[1], C1, 0, 0, 0),   P0[14], P0[15], P1[0], P1[1],   pw1[2] = PKW(P0, 12), pw1[3] = PKW(P0, 14), pw1); \
    VRD(2); SBAR(); GAPA(C0 = __builtin_amdgcn_mfma_f32_32x32x16_bf16(kf[4], qr[2], C0, 0, 0, 0),   P1[2], P1[3], P1[4], P1[5],     pw2[0] = PKW(P1, 0), pw2[1] = PKW(P1, 2), pw2); \
    VRD(6); SBAR(); GAPA(C1 = __builtin_amdgcn_mfma_f32_32x32x16_bf16(kf[5], qr[2], C1, 0, 0, 0),   P1[6], P1[7], P1[8], P1[9],     pw2[2] = PKW(P1, 4), pw2[3] = PKW(P1, 6), pw2); \
    VRD(3); SBAR(); GAPA(C0 = __builtin_amdgcn_mfma_f32_32x32x16_bf16(kf[6], qr[3], C0, 0, 0, 0),   P1[10], P1[11], P1[12], P1[13], pw3[0] = PKW(P1, 8), pw3[1] = PKW(P1, 10), pw3); \
    VRD(7); SBAR(); GAPA2(C1 = __builtin_amdgcn_mfma_f32_32x32x16_bf16(kf[7], qr[3], C1, 0, 0, 0),  P1[14], P1[15],                 pw3[2] = PKW(P1, 12), pw3[3] = PKW(P1, 14), pw3); \
    l_reg += sa0 + sa1; \
    if (GK) { DMA_K((t) + 3, sl_cur); } if (GV) { DMA_V((t) + 1, sl_next); } \
    resc = false; \
    CMASK(C0, C1, t); \
    if (!NOMAX) { float a = MX3(C0[0], C0[1], C1[0]), b = MX3(C0[2], C0[3], C1[1]); a = MX3(a, C1[2], C1[3]); \
      _Pragma("unroll") for (int r = 4; r < 16; r += 4) { a = MX3(a, C0[r], C0[r + 1]); b = MX3(b, C0[r + 2], C0[r + 3]); a = MX3(a, C1[r], C1[r + 1]); b = MX3(b, C1[r + 2], C1[r + 3]); } \
      float rm = __builtin_fmaxf(a, b); { auto rr = __builtin_amdgcn_permlane32_swap(__float_as_uint(rm), __float_as_uint(rm), false, false); rm = __builtin_fmaxf(__uint_as_float(rr[0]), __uint_as_float(rr[1])); } \
      if (__builtin_expect(__any(rm > (float)THRL), 0)) { const float dl = __builtin_fmaxf(rm, 0.f); mhat += dl; \
        _Pragma("unroll") for (int r = 0; r < 16; ++r) { C0[r] -= dl; C1[r] -= dl; } \
        { _Pragma("unroll") for (int r = 0; r < 16; ++r) negm[r] = -mhat; asm volatile("" : "+v"(negm)); } \
        const float f = __builtin_amdgcn_exp2f(-dl); l_reg *= f; if (hi == 0) wsf[r32] = f; resc = true; } } \
    SBAR(); \
    GAPB(o[0] = __builtin_amdgcn_mfma_f32_32x32x16_bf16(PAF(0), VFR(0), o[0], 0, 0, 0), C0, 0); \
    GAPB(o[1] = __builtin_amdgcn_mfma_f32_32x32x16_bf16(PAF(0), VFR(4), o[1], 0, 0, 0), C0, 4); \
    KRD(GL, 0); GAPB(o[0] = __builtin_amdgcn_mfma_f32_32x32x16_bf16(PAF(1), VFR(1), o[0], 0, 0, 0), C0, 8); \
    KRD(GL, 1); GAPB(o[1] = __builtin_amdgcn_mfma_f32_32x32x16_bf16(PAF(1), VFR(5), o[1], 0, 0, 0), C0, 12); \
    KRD(GL, 2); GAPB(o[0] = __builtin_amdgcn_mfma_f32_32x32x16_bf16(PAF(2), VFR(2), o[0], 0, 0, 0), C1, 0); \
    KRD(GL, 3); GAPB(o[1] = __builtin_amdgcn_mfma_f32_32x32x16_bf16(PAF(2), VFR(6), o[1], 0, 0, 0), C1, 4); \
    GAPB(o[0] = __builtin_amdgcn_mfma_f32_32x32x16_bf16(PAF(3), VFR(3), o[0], 0, 0, 0), C1, 8); \
    GAPB(o[1] = __builtin_amdgcn_mfma_f32_32x32x16_bf16(PAF(3), VFR(7), o[1], 0, 0, 0), C1, 12); \
    } while (0)
  int t = 1;
  for (; t + 5 < NT; t += 2) {
    STEP(pB0, pB1, pA0, pA1, t, true, true, true);     WAIT_BAR(2); RESC(); ROT();
    STEP(pA0, pA1, pB0, pB1, t + 1, true, true, true); WAIT_BAR(2); RESC(); ROT();
  }
  #define ENDW(tt) do { if ((tt) + 3 < NT) { WAIT_BAR(2); } else if ((tt) + 2 < NT) { WAIT_BAR(1); } else { WAIT_BAR(0); } } while (0)
  for (; t + 1 < NT; t += 2) {
    STEP(pB0, pB1, pA0, pA1, t, (t + 3 < NT), (t + 1 < NT), (t + 1 < NT));         ENDW(t);     RESC(); ROT();
    STEP(pA0, pA1, pB0, pB1, t + 1, (t + 4 < NT), (t + 2 < NT), (t + 2 < NT));     ENDW(t + 1); RESC(); ROT();
  }
  STEP(pB0, pB1, pA0, pA1, NT - 1, false, false, false); RESC();
  { float sacc = pB0[0] + pB0[1]; _Pragma("unroll") for (int r = 2; r < 16; ++r) sacc += pB0[r]; _Pragma("unroll") for (int r = 0; r < 16; ++r) sacc += pB1[r]; l_reg += sacc;
    pw0 = (u32x4){PKW(pB0, 0), PKW(pB0, 2), PKW(pB0, 4), PKW(pB0, 6)}; pw1 = (u32x4){PKW(pB0, 8), PKW(pB0, 10), PKW(pB0, 12), PKW(pB0, 14)}; pw2 = (u32x4){PKW(pB1, 0), PKW(pB1, 2), PKW(pB1, 4), PKW(pB1, 6)}; pw3 = (u32x4){PKW(pB1, 8), PKW(pB1, 10), PKW(pB1, 12), PKW(pB1, 14)};
    SBAR(); pv(o, vb0 + sl_cur, PAF(0), PAF(1), PAF(2), PAF(3)); }
  #undef PKW
  #undef PAF
  #undef VFR
  #undef PIN
  #undef MX3
  #undef GAPA
  #undef GAPA2
  #undef GAPB
  #undef EX
  #undef VRD
  #undef KRD
  #undef STEP
  #undef ENDW
  { auto rr = __builtin_amdgcn_permlane32_swap(__float_as_uint(l_reg), __float_as_uint(l_reg), false, false); l_reg = __uint_as_float(rr[0]) + __uint_as_float(rr[1]); }
  if (hi == 0) wsf[32 + r32] = l_reg; asm volatile("s_waitcnt lgkmcnt(0)" ::: "memory");
  float rli[16];
  #pragma unroll
  for (int r = 0; r < 16; ++r) rli[r] = __builtin_amdgcn_rcpf(wsf[32 + crow(r, hi)]);
  bf16* Ow = Ou + (long)(wid * QBLK) * op;
  { bf16* stg = (bf16*)(shm + LDS_OST) + wid * 2048;
    #pragma unroll
    for (int r = 0; r < 16; ++r) { const int orow = crow(r, hi);
      { const unsigned pk_ = pk2(o[0][r] * rli[r], o[1][r] * rli[r]); stg[orow * 64 + r32] = (bf16)(pk_ & 0xffffu); stg[orow * 64 + 32 + r32] = (bf16)(pk_ >> 16); } }
    asm volatile("s_waitcnt lgkmcnt(0)" ::: "memory");
    #pragma unroll
    for (int i = 0; i < 4; ++i) { const int row = i * 8 + (lane >> 3), ch = lane & 7; const u32x4 v = *(const u32x4*)(stg + row * 64 + ch * 8); ATTN_STORE16(Ow + (long)row * op + ch * 8, v); } }
  asm volatile("s_waitcnt lgkmcnt(0)\n\ts_barrier" ::: "memory");
  #undef NEGM
  #undef DMA_K
  #undef DMA_V
  #undef TROW
  #undef CMASK
  #undef START
  #undef RESC
  #undef ROT
}
#undef SBAR
#undef WAIT_BAR
}
#ifndef FP8_MOE
#define FP8_MOE 1
#endif
struct Args { const float* in[29]; float* out; unsigned char* ws; int ph_lo, ph_hi; };
enum { I_X = 0, I_C, I_CTX, I_CCTX, I_WMOD, I_BMOD, I_N1G, I_N2G, I_WIN, I_LRE, I_LIM, I_LDT, I_BRE, I_BIM, I_CRE, I_CIM, I_SSMD, I_WGLU, I_QNG, I_KNG, I_RPB, I_WBR, I_WOUT, I_RW, I_RB, I_MG, I_MU, I_MD, I_FNG };

typedef const float* CFP;
struct Ctx {
    const __attribute__((address_space(4))) CFP* in; float* out; unsigned char* ws; LAS unsigned char* lds; gu32* ctl;
    int tid, lane, wave, vcu, G;
};
#define WSP(T_, off) ((T_*)(C.ws + (off)))
__device__ __forceinline__ size_t wout_off(int l) { return (l & 1) ? WS_WOUT2 : WS_WOUT; }
__device__ __forceinline__ size_t moe1_off(int l) { return WS_MOE1 + (size_t)(l & 1) * 16 * MiB; }
__device__ __forceinline__ size_t moe2_off(int l) { return WS_MOE2 + (size_t)(l & 1) * 8 * MiB; }

__device__ __forceinline__ bf16* xs_row(const Ctx& C, int m) { return WSP(bf16, WS_XS) + (size_t)m * D; }
__device__ __forceinline__ const float* in_row(const Ctx& C, int m) { const int b = m / LB, j = m - b * LB; return j < CTX ? C.in[I_CTX] + (size_t)(b * CTX + j) * D : C.in[I_X] + (size_t)(b * SEQ + j - CTX) * D; }
__device__ __forceinline__ int cond_of(int m) { const int b = m / LB, j = m - b * LB; return j < CTX ? 4 : b; }

__device__ __forceinline__ void transpose_item(const float* W, int N, int Kp, bf16* WT, int k0, int n0, int drow0, LAS float* scr, int lane) {
    const float* src = W + (size_t)k0 * N + n0 + lane;
    float tv[64];
#pragma unroll
    for (int i = 0; i < 64; ++i) tv[i] = src[(size_t)i * N];
#pragma unroll
    for (int i = 0; i < 64; ++i) scr[i * 65 + lane] = tv[i];
    LDS_WAIT(); asm volatile("" ::: "memory");
    const int c = lane & 7;
#pragma unroll
    for (int j = 0; j < 8; ++j) { const int n = (lane >> 3) + 8 * j; const LAS float* s = scr + (8 * c) * 65 + n;
        v4u o; o.x = pk2(s[0 * 65], s[1 * 65]); o.y = pk2(s[2 * 65], s[3 * 65]); o.z = pk2(s[4 * 65], s[5 * 65]); o.w = pk2(s[6 * 65], s[7 * 65]);
        *(GAS v4u*)(WT + (size_t)(drow0 + n) * Kp + k0 + 8 * c) = o; }
    LDS_WAIT(); asm volatile("" ::: "memory");
}
__device__ __forceinline__ void transpose_item8(const float* W, int N, int Kp, unsigned char* WT, int k0, int n0, int drow0, float scale, LAS float* scr, int lane) {
    const float* src = W + (size_t)k0 * N + n0 + lane;
    float tv[64];
#pragma unroll
    for (int i = 0; i < 64; ++i) tv[i] = src[(size_t)i * N];
#pragma unroll
    for (int i = 0; i < 64; ++i) scr[i * 65 + lane] = tv[i] * scale;
    LDS_WAIT(); asm volatile("" ::: "memory");
    const int c = lane & 3;
#pragma unroll
    for (int j = 0; j < 4; ++j) { const int n = (lane >> 2) + 16 * j; const LAS float* s = scr + (16 * c) * 65 + n;
        v4u o; o.x = pk4_fp8(s[0 * 65], s[1 * 65], s[2 * 65], s[3 * 65]); o.y = pk4_fp8(s[4 * 65], s[5 * 65], s[6 * 65], s[7 * 65]); o.z = pk4_fp8(s[8 * 65], s[9 * 65], s[10 * 65], s[11 * 65]); o.w = pk4_fp8(s[12 * 65], s[13 * 65], s[14 * 65], s[15 * 65]);
        *(GAS v4u*)(WT + (size_t)(drow0 + n) * Kp + k0 + 16 * c) = o; }
    LDS_WAIT(); asm volatile("" ::: "memory");
}
__device__ __forceinline__ void phase_weights(const Ctx& C, int l, int widx, int nwork, int part) {
    if (widx < 0) return;
    LAS float* scr = (LAS float*)(C.lds + C.wave * 16640);
    const int gw = widx * NWAVES + C.wave, NGW = nwork * NWAVES;
    constexpr int I0 = 16 * 92, I1 = 8 * 8, I2 = 3 * 8 * 16, I3 = 16 * 16, I4 = 16 * 16 * 8, I5 = I4, I6 = 16 * 8 * 16;
    constexpr int MLO = I0 + I1 + I2 + I3, MLEN = I4 + I5, ALL = MLO + MLEN + I6;
    constexpr int N2A = 1300, N1B = 3720, M2LO = MLO + MLEN;
    const int cnt = part == 0 ? ALL : (part == 3 ? I0 + N2A : (part == 1 ? N1B : ALL - I0 - N2A - N1B));
    for (int it = gw; it < cnt; it += NGW) {
        int r = it;
        if (part == 3) { if (it >= I0) r = M2LO + (it - I0); }
        else if (part == 1) r = MLO + it;
        else if (part == 2) { r = I0 + it;
            if (r >= MLO) { r += N1B; if (r >= M2LO) r += N2A; } }
        if (r < I0) { const int kb = r / 92, nb = r % 92; if (W8_ALL) transpose_item8(C.in[I_WIN] + (size_t)l * 1024 * INW, INW, 1024, WSP(unsigned char, WS_WIN), 64 * kb, 64 * nb, 64 * nb, 64.f, scr, C.lane);
            else if (nb < 44 || GATE_BF16) transpose_item(C.in[I_WIN] + (size_t)l * 1024 * INW, INW, 1024, WSP(bf16, WS_WIN), 64 * kb, 64 * nb, 64 * nb, scr, C.lane);
            else transpose_item8(C.in[I_WIN] + (size_t)l * 1024 * INW, INW, 1024, WSP(unsigned char, WS_WIN8), 64 * kb, 64 * nb, 64 * nb - 2816, 64.f, scr, C.lane); continue; } r -= I0;
        if (r < I1) { const int kb = r / 8, nb = r % 8; transpose_item(C.in[I_WGLU] + (size_t)l * 512 * 512, 512, 512, WSP(bf16, WS_WGLU), 64 * kb, 64 * nb, 64 * nb, scr, C.lane); continue; } r -= I1;
        if (r < I2) { const int i = r / 128, q = r % 128, kb = q / 16, nb = q % 16; transpose_item(C.in[I_WBR] + (size_t)(l * 3 + i) * 512 * 1024, 1024, 512, WSP(bf16, WS_WBR) + (size_t)i * 1024 * 512, 64 * kb, 64 * nb, 64 * nb, scr, C.lane); continue; } r -= I2;
        if (r < I3) { const int kb = r / 16, nb = r % 16; transpose_item(C.in[I_WOUT] + (size_t)l * 1024 * 1024, 1024, 1024, (bf16*)(C.ws + wout_off(l)), 64 * kb, 64 * nb, 64 * nb, scr, C.lane); continue; } r -= I3;
        if (r < I4 + I5) { const int up = r >= I4; if (up) r -= I4; const int e = r / 128, q = r % 128, kb = q / 8, nb = q % 8, n0 = 64 * nb;
            if (FP8_MOE) transpose_item8((up ? C.in[I_MU] : C.in[I_MG]) + (size_t)(l * 16 + e) * 1024 * 512, 512, 1024, (unsigned char*)(C.ws + moe1_off(l)) + (size_t)e * 1024 * 1024, 64 * kb, n0, (n0 / 128) * 256 + (n0 % 128) + (up ? 128 : 0), 64.f, scr, C.lane);
            else transpose_item((up ? C.in[I_MU] : C.in[I_MG]) + (size_t)(l * 16 + e) * 1024 * 512, 512, 1024, WSP(bf16, WS_MOE1) + (size_t)e * 1024 * 1024, 64 * kb, n0, (n0 / 128) * 256 + (n0 % 128) + (up ? 128 : 0), scr, C.lane); continue; } r -= I4 + I5;
        { const int e = r / 128, q = r % 128, kb = q / 16, nb = q % 16; if (FP8_MOE) transpose_item8(C.in[I_MD] + (size_t)(l * 16 + e) * 512 * 1024, 1024, 512, (unsigned char*)(C.ws + moe2_off(l)) + (size_t)e * 1024 * 512, 64 * kb, 64 * nb, 64 * nb, 32.f, scr, C.lane);
            else transpose_item(C.in[I_MD] + (size_t)(l * 16 + e) * 512 * 1024, 1024, 512, WSP(bf16, WS_MOE2) + (size_t)e * 1024 * 512, 64 * kb, 64 * nb, 64 * nb, scr, C.lane); }
    }
}

__device__ __forceinline__ void phase_mod(const Ctx& C) {
    LAS float* sc = (LAS float*)(C.lds);
    LAS float* red = (LAS float*)(C.lds + 20480);
    for (int i = C.tid; i < 5 * 1024; i += 512) { const int c = i >> 10, k = i & 1023; const float v = c < 4 ? C.in[I_C][c * 1024 + k] : C.in[I_CCTX][k]; sc[i] = v * fsigmoid(v); }
    __syncthreads();
    for (int it = C.vcu; it < NLAYER * 96; it += C.G) {
        const int l = it / 96, col = (it % 96) * 64 + C.lane, k0 = C.wave * 128;
        const float* W = C.in[I_WMOD] + (size_t)l * 1024 * 6144 + (size_t)k0 * 6144 + col;
        float a0 = 0.f, a1 = 0.f, a2 = 0.f, a3 = 0.f, a4 = 0.f;
#pragma unroll 16
        for (int k = 0; k < 128; ++k) { const float w = W[(size_t)k * 6144]; a0 += sc[k0 + k] * w; a1 += sc[1024 + k0 + k] * w; a2 += sc[2048 + k0 + k] * w; a3 += sc[3072 + k0 + k] * w; a4 += sc[4096 + k0 + k] * w; }
        LAS float* r = red + C.wave * 320 + C.lane; r[0] = a0; r[64] = a1; r[128] = a2; r[192] = a3; r[256] = a4;
        __syncthreads();
        if (C.tid < 320) { const int c = C.tid >> 6; float s = C.in[I_BMOD][l * 6144 + col];
#pragma unroll
            for (int w = 0; w < 8; ++w) s += red[w * 320 + C.tid];
            WSP(float, WS_MOD)[(size_t)(l * 5 + c) * 6144 + col] = s; }
        __syncthreads();
    }
}

__device__ __forceinline__ void phase_s5mats(const Ctx& C, int l, int w) {
    if (w < 0 || w >= 128) return;
    const int g = w >> 2, part = w & 3, tid = C.tid;
    LAS f32x2* POW = (LAS f32x2*)(C.lds);
    LAS f32x2* CC = (LAS f32x2*)(C.lds + 33792);
    LAS f32x2* BB = (LAS f32x2*)(C.lds + 50176);
    LAS f32x2* COEF = (LAS f32x2*)(C.lds + 66560);
    LAS bf16* KT = (LAS bf16*)(C.lds + 67584);
    LAS float* WT = (LAS float*)(C.lds + 101376);
    __syncthreads();
    if (tid < 128) {
        const int d = tid >> 6, p = tid & 63; const int li = ((l * 2 + d) * 32 + g) * 64 + p;
        const float re = C.in[I_LRE][li], im = C.in[I_LIM][li], dt = __expf(C.in[I_LDT][(l * 2 + d) * 32 + g]);
        for (int tau = 0; tau <= 32; ++tau) { const float mag = __expf(re * dt * (float)tau), rev = im * dt * (float)tau * 0.15915494309189535f;
            const float wr = mag * cos_rev(rev), wi = mag * sin_rev(rev);
            POW[(d * 33 + tau) * 64 + p] = (f32x2){wr, wi}; if (tau < 32) { WT[((d * 64 + p) * 2) * 32 + tau] = wr; WT[((d * 64 + p) * 2 + 1) * 32 + tau] = wi; } }
        const float mag = __expf(re * dt), rev = im * dt * 0.15915494309189535f; const float lr = mag * cos_rev(rev) - 1.f, lim = mag * sin_rev(rev);
        const float den = 1.f / (re * re + im * im);
        COEF[tid] = (f32x2){(lr * re + lim * im) * den, (lim * re - lr * im) * den};
    }
    __syncthreads();
    for (int i = tid; i < 2048; i += 512) {
        const int d = i >> 10, p = (i >> 4) & 63, h = i & 15; const size_t bi = (((size_t)(l * 2 + d) * 32 + g) * 64 + p) * 16 + h;
        const float br = C.in[I_BRE][bi], bi_ = C.in[I_BIM][bi]; const f32x2 cf = COEF[d * 64 + p];
        BB[i] = (f32x2){cf.x * br - cf.y * bi_, cf.x * bi_ + cf.y * br};
        const int h2 = (i >> 6) & 15, p2 = i & 63; const size_t ci = (((size_t)(l * 2 + d) * 32 + g) * 16 + h2) * 64 + p2;
        CC[i] = (f32x2){C.in[I_CRE][ci], C.in[I_CIM][ci]};
    }
    __syncthreads();
    {
        const int wv = tid >> 6, ln = tid & 63, hi = ln >> 5, i = ln & 31, h = 2 * wv + (i >> 4), hp = i & 15;
        f32x16 a0 = f32x16{}, a1 = f32x16{};
#pragma unroll 4
        for (int p = 0; p < 64; ++p) {
            const f32x2 c0 = CC[h * 64 + p], b0 = BB[p * 16 + hp], c1 = CC[1024 + h * 64 + p], b1 = BB[1024 + p * 16 + hp];
            const float x0 = hi == 0 ? (c0.x * b0.x - c0.y * b0.y) : -(c0.x * b0.y + c0.y * b0.x);
            const float x1 = hi == 0 ? (c1.x * b1.x - c1.y * b1.y) : -(c1.x * b1.y + c1.y * b1.x);
            a0 = __builtin_amdgcn_mfma_f32_32x32x2f32(x0, WT[(p * 2 + hi) * 32 + i], a0, 0, 0, 0);
            a1 = __builtin_amdgcn_mfma_f32_32x32x2f32(x1, WT[((64 + p) * 2 + hi) * 32 + i], a1, 0, 0, 0);
        }
        const float* sd = C.in[I_SSMD] + l * 512 + g * 16;
#pragma unroll
        for (int r = 0; r < 16; ++r) { const int rl = (r & 3) + 8 * (r >> 2) + 4 * hi, hh = 2 * wv + (rl >> 4), hq = rl & 15;
            float f = a0[r]; if (i == 0) f += a1[r] + (hh == hq ? sd[hh] : 0.f);
            KT[((31 + i) * 16 + hh) * 16 + hq] = (bf16)f2bf(f);
            if (i > 0) KT[((31 - i) * 16 + hh) * 16 + hq] = (bf16)f2bf(a1[r]); }
    }
    __syncthreads();
    bf16* B1 = WSP(bf16, WS_BT1) + (size_t)g * 768 * 512; bf16* B2 = WSP(bf16, WS_BT2) + (size_t)g * 512 * 256;
    for (int i = tid; i < 128 * 64; i += 512) {
        const int n = part * 128 + (i >> 6), ch = i & 63, t = n >> 4, h = n & 15, s = ch >> 1, hp0 = (ch & 1) * 8;
        *(GAS v4u*)(B1 + (size_t)n * 512 + ch * 8) = *(const LAS v4u*)(KT + ((t - s + 31) * 16 + h) * 16 + hp0);
    }
    for (int i = tid; i < 64 * 64; i += 512) {
        const int nn = part * 64 + (i >> 6), ch = i & 63, d = nn >> 7, p = (nn & 127) >> 1, ri = nn & 1, s = ch >> 1, hp0 = (ch & 1) * 8;
        const f32x2 w = POW[(d * 33 + (d == 0 ? 31 - s : s)) * 64 + p]; float v[8];
#pragma unroll
        for (int j = 0; j < 8; ++j) { const f32x2 b = BB[d * 1024 + p * 16 + hp0 + j]; v[j] = ri == 0 ? (w.x * b.x - w.y * b.y) : (w.x * b.y + w.y * b.x); }
        v4u o; o.x = pk2(v[0], v[1]); o.y = pk2(v[2], v[3]); o.z = pk2(v[4], v[5]); o.w = pk2(v[6], v[7]);
        *(GAS v4u*)(B1 + (size_t)(512 + nn) * 512 + ch * 8) = o;
    }
    for (int i = tid; i < 128 * 32; i += 512) {
        const int n = part * 128 + (i >> 5), ch = i & 31, t = n >> 4, h = n & 15, d = ch >> 4, p0 = (ch & 15) * 4; float v[8];
#pragma unroll
        for (int j = 0; j < 4; ++j) { const f32x2 c = CC[d * 1024 + h * 64 + p0 + j], w = POW[(d * 33 + (d == 0 ? t + 1 : 32 - t)) * 64 + p0 + j];
            v[2 * j] = c.x * w.x - c.y * w.y; v[2 * j + 1] = -(c.x * w.y + c.y * w.x); }
        v4u o; o.x = pk2(v[0], v[1]); o.y = pk2(v[2], v[3]); o.z = pk2(v[4], v[5]); o.w = pk2(v[6], v[7]);
        *(GAS v4u*)(B2 + (size_t)n * 256 + ch * 8) = o;
    }
    __syncthreads();
}

template <int MODE>
__device__ __forceinline__ void phase_rows(const Ctx& C, int l) {
    const int gw = C.vcu * NWAVES + C.wave, NGW = C.G * NWAVES, lane = C.lane;
    const float* MODl = WSP(float, WS_MOD) + (size_t)(MODE == 2 ? 0 : l) * 5 * 6144;
    const float* MODp = WSP(float, WS_MOD) + (size_t)(l > 0 ? l - 1 : 0) * 5 * 6144;
    const bf16* YS = WSP(bf16, WS_YSLOT);
    LAS float* GT = (LAS float*)C.lds;
    LAS float* GM = GT + 5120;
    LAS float* SH = GT + 10240;
    __syncthreads();
    for (int i = C.tid; i < 5120; i += 512) { const int cond = i >> 10, k = i & 1023;
        if (MODE != 0) GT[i] = MODp[cond * 6144 + 5 * 1024 + k];
        if (MODE != 2) { GM[i] = C.in[I_N1G][l * D + k] * (MODl[cond * 6144 + 1024 + k] + 1.f); SH[i] = MODl[cond * 6144 + k]; }
        else if (i < 1024) GM[i] = C.in[I_FNG][k]; }
    __syncthreads();
    f32x4 nx[4]; v2u nb[4], na[4], nc[4];
#define ROWS_LOAD(mm) do { const int m_ = (mm); \
        if (MODE == 0) { const GAS f32x4* xr = (const GAS f32x4*)in_row(C, m_) + lane; _Pragma("unroll") for (int q = 0; q < 4; ++q) nx[q] = xr[64 * q]; } \
        else { const GAS v2u* xr = (const GAS v2u*)xs_row(C, m_) + lane; const GAS v2u* y0 = (const GAS v2u*)(YS + (size_t)(2 * m_) * D) + lane; const GAS v2u* y1 = (const GAS v2u*)(YS + (size_t)(2 * m_ + 1) * D) + lane; \
            _Pragma("unroll") for (int q = 0; q < 4; ++q) { nb[q] = xr[64 * q]; na[q] = y0[64 * q]; nc[q] = y1[64 * q]; } } } while (0)
    int m = gw; if (MODE == 2) { while (m < T && (m % LB) < CTX) m += NGW; }
    if (m < T) ROWS_LOAD(m);
    while (m < T) {
        const int b = m / LB, j = m - b * LB, cond = j < CTX ? 4 : b;
        f32x4 v[4];
        if (MODE == 0) {
#pragma unroll
            for (int q = 0; q < 4; ++q) v[q] = nx[q]; }
        else { const LAS f32x4* g2 = (const LAS f32x4*)(GT + cond * 1024) + lane;
#pragma unroll
            for (int q = 0; q < 4; ++q) { const f32x4 g = g2[64 * q]; const v2u a = na[q], c = nc[q], xb_ = nb[q];
                v[q] = (f32x4){bflo(xb_.x), bfhi(xb_.x), bflo(xb_.y), bfhi(xb_.y)} + g * (f32x4){bflo(a.x) + bflo(c.x), bfhi(a.x) + bfhi(c.x), bflo(a.y) + bflo(c.y), bfhi(a.y) + bfhi(c.y)}; } }
        int mn = m + NGW; if (MODE == 2) { while (mn < T && (mn % LB) < CTX) mn += NGW; }
        if (mn < T) ROWS_LOAD(mn);
        float ss = 0.f;
#pragma unroll
        for (int q = 0; q < 4; ++q) ss += (v[q].x * v[q].x + v[q].y * v[q].y) + (v[q].z * v[q].z + v[q].w * v[q].w);
        const float rstd = 1.f / sqrtf(wave_sum(ss, lane) * (1.f / D) + EPS);
        if (MODE == 2) { GAS f32x4* o = (GAS f32x4*)(C.out + (size_t)(b * SEQ + j - CTX) * D) + lane; const LAS f32x4* fg = (const LAS f32x4*)GM + lane;
#pragma unroll
            for (int q = 0; q < 4; ++q) o[64 * q] = v[q] * rstd * fg[64 * q]; }
        else { GAS v2u* xo = (GAS v2u*)xs_row(C, m) + lane; GAS v2u* ho = (GAS v2u*)(WSP(bf16, WS_HB) + (size_t)m * D) + lane; GAS unsigned* h8 = (GAS unsigned*)(WSP(unsigned char, WS_HB8) + (size_t)m * D) + lane;
            const LAS f32x4* gm = (const LAS f32x4*)(GM + cond * 1024) + lane; const LAS f32x4* sh = (const LAS f32x4*)(SH + cond * 1024) + lane;
#pragma unroll
            for (int q = 0; q < 4; ++q) { xo[64 * q] = (v2u){pk2(v[q].x, v[q].y), pk2(v[q].z, v[q].w)}; const f32x4 h = v[q] * rstd * gm[64 * q] + sh[64 * q]; if (!W8_ALL) ho[64 * q] = (v2u){pk2(h.x, h.y), pk2(h.z, h.w)}; if (H8_WRITE) h8[64 * q] = pk4_fp8(h.x, h.y, h.z, h.w); } }
        m = mn;
    }
#undef ROWS_LOAD
}

__device__ __forceinline__ v4u qk_prep8(const v4u w, const float (&g)[8], const float (&cs)[8], const float (&sn)[8], float sc, int s8) {
    float x[8] = {bflo(w.x), bfhi(w.x), bflo(w.y), bfhi(w.y), bflo(w.z), bfhi(w.z), bflo(w.w), bfhi(w.w)};
    float ss = 0.f;
#pragma unroll
    for (int i = 0; i < 8; ++i) ss += x[i] * x[i];
    ss += dpp_mov<0xB1, 0xF>(ss); ss += dpp_mov<0x4E, 0xF>(ss); ss += dpp_mov<0x141, 0xF>(ss);
    const float rstd = 1.f / sqrtf(ss * (1.f / 64.f) + EPS);
    float y[8];
#pragma unroll
    for (int i = 0; i < 8; ++i) { const float xn = x[i] * rstd * g[i]; const float other = dpp_mov<0x4E, 0xF>(xn);
        y[i] = (s8 & 2) ? (xn * cs[i] + other * sn[i]) : (xn * cs[i] - other * sn[i]); }
    v4u o; o.x = pk2(y[0] * sc, y[1] * sc); o.y = pk2(y[2] * sc, y[3] * sc); o.z = pk2(y[4] * sc, y[5] * sc); o.w = pk2(y[6] * sc, y[7] * sc);
    return o;
}
__device__ __forceinline__ void phase_qkprep(const Ctx& C, int l) {
    const int gw = C.vcu * NWAVES + C.wave, NGW = C.G * NWAVES, lane = C.lane, s8 = lane & 7;
    const float* qg = C.in[I_QNG] + l * 64 + 8 * s8; const float* kg = C.in[I_KNG] + l * 64 + 8 * s8;
    float gq[8], gk[8];
#pragma unroll
    for (int i = 0; i < 8; ++i) { gq[i] = qg[i]; gk[i] = kg[i]; }
    const int ax = s8 >> 2, f0 = 8 * (s8 & 1);
    float inv[8];
#pragma unroll
    for (int i = 0; i < 8; ++i) inv[i] = exp2f(-(float)(f0 + i) * 0.8304820237218406f) * 0.15915494309189535f;
    const int kl = lane & 15, rs = lane >> 4;
    { float one[8], zero[8];
#pragma unroll
      for (int i = 0; i < 8; ++i) { one[i] = 1.f; zero[i] = 0.f; }
      for (int r = gw; r < NB * CTX; r += NGW) { const int m = (r / CTX) * LB + (r % CTX);
        const v4u wq = *((const GAS v4u*)(WSP(bf16, WS_QA) + (size_t)m * 512) + lane), wk = *((const GAS v4u*)(WSP(bf16, WS_KA) + (size_t)m * 128) + kl);
        *((GAS v4u*)(WSP(bf16, WS_QA) + (size_t)m * 512) + lane) = qk_prep8(wq, gq, one, zero, C2, s8);
        const v4u ok = qk_prep8(wk, gk, one, zero, 1.f, s8);
        if (lane < 16) *((GAS v4u*)(WSP(bf16, WS_KA) + (size_t)m * 128) + lane) = ok; } }
    constexpr int NG4 = NB * SEQ / 4;
    v4u wk = (v4u){0u, 0u, 0u, 0u};
    if (gw < NG4) { const int lt = gw * 4 + rs, m = (lt / SEQ) * LB + CTX + (lt % SEQ); wk = *((const GAS v4u*)(WSP(bf16, WS_KA) + (size_t)m * 128) + kl); }
    for (int g4 = gw; g4 < NG4; g4 += NGW) {
        const int lt = g4 * 4 + rs, tt = lt % SEQ, m = (lt / SEQ) * LB + CTX + tt; const float pos = (float)(ax == 0 ? (tt >> 6) : (tt & 63));
        const v4u ck = wk;
        if (g4 + NGW < NG4) { const int lt2 = (g4 + NGW) * 4 + rs, m2 = (lt2 / SEQ) * LB + CTX + (lt2 % SEQ); wk = *((const GAS v4u*)(WSP(bf16, WS_KA) + (size_t)m2 * 128) + kl); }
        float cs[8], sn[8];
#pragma unroll
        for (int i = 0; i < 8; ++i) { cs[i] = cos_rev(pos * inv[i]); sn[i] = sin_rev(pos * inv[i]); }
        *((GAS v4u*)(WSP(bf16, WS_KA) + (size_t)m * 128) + kl) = qk_prep8(ck, gk, cs, sn, 1.f, s8);
    }
}

__device__ __forceinline__ void phase_carry(const Ctx& C, int l) {
    static_assert(NCH == 264, "11 batches of 24 chunks");
    LAS f32x2* SL = (LAS f32x2*)C.lds;
    for (int t = (int)blockIdx.x; t < NB * 64; t += C.G) {
        const int b = t >> 6, g = (t >> 1) & 31, d = t & 1;
        const GAS char* Sb = (const GAS char*)(WSP(float, WS_SST) + (size_t)(b * NCH) * 8192 + g * 256 + d * 128);
        GAS char* Xb = (GAS char*)(WSP(bf16, WS_XST) + (size_t)(b * NCH) * 8192 + g * 256 + d * 128);
        __syncthreads();
        v4u pc[17];
#pragma unroll
        for (int j = 0; j < 17; ++j) { const int q = C.tid + 512 * j; if (q < NCH * 32) pc[j] = *(const GAS v4u*)(Sb + (size_t)(q >> 5) * 32768 + (q & 31) * 16); }
#pragma unroll
        for (int j = 0; j < 17; ++j) { const int q = C.tid + 512 * j; if (q < NCH * 32) *(LAS v4u*)((LAS char*)SL + q * 16) = pc[j]; }
        __syncthreads();
        if (C.wave == 0) {
            const int p = C.lane, li = ((l * 2 + d) * 32 + g) * 64 + p;
            const float re = C.in[I_LRE][li], im = C.in[I_LIM][li], dt = __expf(C.in[I_LDT][(l * 2 + d) * 32 + g]);
            const float mag = __expf(re * dt * 32.f), rev = im * dt * 32.f * 0.15915494309189535f; const float Lr = mag * cos_rev(rev), Li = mag * sin_rev(rev);
            const unsigned lx = (unsigned)p * 4u;
            float sr = 0.f, si = 0.f;
#define CARRY_CH(k_) (d == 0 ? (k_) : ((k_) < 8 ? 7 - (k_) : 271 - (k_)))
            for (int bt = 0; bt < 11; ++bt) { f32x2 cur[24];
#pragma unroll
                for (int k = 0; k < 24; ++k) cur[k] = SL[CARRY_CH(bt * 24 + k) * 64 + p];
#pragma unroll
                for (int k = 0; k < 24; ++k) { *(GAS unsigned*)(Xb + (size_t)CARRY_CH(bt * 24 + k) * 16384 + lx) = cvt_pk_bf16(sr, si);
                    const float nr = __builtin_fmaf(Lr, sr, __builtin_fmaf(-Li, si, cur[k].x)), ni = __builtin_fmaf(Lr, si, __builtin_fmaf(Li, sr, cur[k].y)); sr = nr; si = ni; } }
#undef CARRY_CH
        }
        asm volatile("s_waitcnt vmcnt(0)" ::: "memory");
        __syncthreads();
        if (C.tid == 0) { __builtin_amdgcn_fence(__ATOMIC_RELEASE, "agent"); asm volatile("s_waitcnt vmcnt(0)" ::: "memory"); (void)xb_add((unsigned*)(C.ctl + CW_NAQ + 64 * l + 32), 1u); }
    }
    __syncthreads();
}

__device__ __forceinline__ void phase_norm2(const Ctx& C, int l) {
    LAS float* TILE = (LAS float*)C.lds;
    LAS float* PART = (LAS float*)(C.lds + 65792);
    LAS unsigned* REC = (LAS unsigned*)(C.lds + 73984);
    LAS float* LG = (LAS float*)(C.lds + 78080);
    LAS unsigned* LCNT = (LAS unsigned*)(C.lds + 94464);
    LAS float* GAM = (LAS float*)(C.lds + 94720);
    LAS float* SHF = (LAS float*)(C.lds + 115200);
    const int lane = C.lane, tid = C.tid;
    if (tid < 32) LCNT[tid] = 0u;
    const float* MODl = WSP(float, WS_MOD) + (size_t)l * 5 * 6144;
    for (int i = tid; i < 5 * 1024; i += 512) { const int cond = i >> 10, k = i & 1023; GAM[i] = C.in[I_N2G][l * D + k] * (MODl[cond * 6144 + 4096 + k] + 1.f); SHF[i] = MODl[cond * 6144 + 3072 + k]; }
    int nrows = 0; for (int m = C.vcu; m < T; m += C.G) ++nrows;
    __syncthreads();
    const int fn = lane & 15, kq = lane >> 4;
    float bw[32];
#pragma unroll
    for (int j = 0; j < 32; ++j) bw[j] = C.in[I_RW][(128 * C.wave + 32 * kq + j) * 16 + fn];
    v2u nxa[2][4], nxb[2][4];
#define N2_LOAD(NX, ii) do { _Pragma("unroll") for (int rr = 0; rr < 2; ++rr) { const int i_ = (ii) + rr * NWAVES; const int m_ = C.vcu + C.G * (i_ < nrows ? i_ : (ii)); const GAS v2u* xr = (const GAS v2u*)xs_row(C, m_) + lane; \
        _Pragma("unroll") for (int q = 0; q < 4; ++q) NX[rr][q] = xr[64 * q]; } } while (0)
#define N2_STEP(NX, I0) do { const int i0 = (I0); \
        const int i = i0 + C.wave; const bool has0 = i < nrows, has1 = i + NWAVES < nrows; \
        if (has0) { \
            _Pragma("unroll") for (int rr = 0; rr < 2; ++rr) { const int ir = (rr && has1) ? i + NWAVES : i; const int m = C.vcu + C.G * ir, cond = cond_of(m); \
                GAS unsigned* h8 = (GAS unsigned*)(WSP(unsigned char, WS_HB8) + (size_t)m * D) + lane; \
                const LAS f32x4* gm = (const LAS f32x4*)(GAM + cond * 1024) + lane; const LAS f32x4* sh = (const LAS f32x4*)(SHF + cond * 1024) + lane; \
                float ss = 0.f; f32x4 xf[4]; \
                _Pragma("unroll") for (int q = 0; q < 4; ++q) { const v2u w_ = NX[rr][q]; const f32x4 v = (f32x4){bflo(w_.x), bfhi(w_.x), bflo(w_.y), bfhi(w_.y)}; xf[q] = v; ss += (v.x * v.x + v.y * v.y) + (v.z * v.z + v.w * v.w); } \
                const float rstd = 1.f / sqrtf(wave_sum(ss, lane) * (1.f / D) + EPS); \
                _Pragma("unroll") for (int q = 0; q < 4; ++q) { const f32x4 h = xf[q] * rstd * gm[64 * q] + sh[64 * q]; \
                    *(LAS f32x4*)(TILE + (C.wave + NWAVES * rr) * 1028 + 256 * q + 4 * lane) = h; \
                    if (rr == 0 || has1) h8[64 * q] = pk4_fp8(h.x, h.y, h.z, h.w); } } \
            if (i + 4 * NWAVES < nrows) N2_LOAD(NX, i + 4 * NWAVES); \
        } else { \
            _Pragma("unroll") for (int rr = 0; rr < 2; ++rr) \
                _Pragma("unroll") for (int q = 0; q < 4; ++q) *(LAS f32x4*)(TILE + (C.wave + NWAVES * rr) * 1028 + 256 * q + 4 * lane) = (f32x4){0.f, 0.f, 0.f, 0.f}; \
        } \
        __syncthreads(); \
        f32x4 dacc = (f32x4){0.f, 0.f, 0.f, 0.f}; \
        _Pragma("unroll") for (int j = 0; j < 8; ++j) { const f32x4 a = *(const LAS f32x4*)(TILE + fn * 1028 + 128 * C.wave + 32 * kq + 4 * j); \
            _Pragma("unroll") for (int e = 0; e < 4; ++e) dacc = __builtin_amdgcn_mfma_f32_16x16x4f32(a[e], bw[4 * j + e], dacc, 0, 0, 0); } \
        _Pragma("unroll") for (int r = 0; r < 4; ++r) PART[C.wave * 256 + (4 * kq + r) * 16 + fn] = dacc[r]; \
        __syncthreads(); \
        if (tid < 256) { float sum = 0.f; \
            _Pragma("unroll") for (int w = 0; w < NWAVES; ++w) sum += PART[w * 256 + tid]; \
            const int ri = i0 + (tid >> 4); if (ri < nrows) LG[ri * 16 + (tid & 15)] = sum; } } while (0)
    if (C.wave < nrows) N2_LOAD(nxa, C.wave);
    if (C.wave + 2 * NWAVES < nrows) N2_LOAD(nxb, C.wave + 2 * NWAVES);
    for (int ii = 0; ii < nrows; ii += 4 * NWAVES) {
        N2_STEP(nxa, ii);
        if (ii + 2 * NWAVES < nrows) N2_STEP(nxb, ii + 2 * NWAVES);
    }
#undef N2_STEP
#undef N2_LOAD
    __syncthreads();
    float rb[16];
#pragma unroll
    for (int e = 0; e < 16; ++e) rb[e] = C.in[I_RB][e];
    for (int i = tid; i < nrows; i += 512) {
        float lg[16];
#pragma unroll
        for (int q = 0; q < 4; ++q) { const f32x4 t = *(const LAS f32x4*)(LG + i * 16 + 4 * q); lg[4 * q] = t.x; lg[4 * q + 1] = t.y; lg[4 * q + 2] = t.z; lg[4 * q + 3] = t.w; }
        float mx = lg[0];
#pragma unroll
        for (int e = 1; e < 16; ++e) mx = fmaxf(mx, lg[e]);
        float pr[16], sel[16], sum = 0.f;
#pragma unroll
        for (int e = 0; e < 16; ++e) { pr[e] = __expf(lg[e] - mx); sum += pr[e]; }
        const float rs = 1.f / sum;
#pragma unroll
        for (int e = 0; e < 16; ++e) { pr[e] *= rs; sel[e] = pr[e] + rb[e]; }
        float bestv = -1e30f; int best = 0;
#pragma unroll
        for (int gq = 0; gq < 4; ++gq) { float m1 = -1e30f, m2 = -1e30f;
#pragma unroll
            for (int k = 0; k < 4; ++k) { const float s_ = sel[4 * gq + k]; if (s_ > m1) { m2 = m1; m1 = s_; } else if (s_ > m2) m2 = s_; }
            const float gs = m1 + m2; if (gs > bestv) { bestv = gs; best = gq; } }
        float s4[4], p4[4];
#pragma unroll
        for (int k = 0; k < 4; ++k) { s4[k] = best == 0 ? sel[k] : best == 1 ? sel[4 + k] : best == 2 ? sel[8 + k] : sel[12 + k]; p4[k] = best == 0 ? pr[k] : best == 1 ? pr[4 + k] : best == 2 ? pr[8 + k] : pr[12 + k]; }
        int i0 = 0; float v0 = s4[0], q0 = p4[0];
#pragma unroll
        for (int k = 1; k < 4; ++k) if (s4[k] > v0) { v0 = s4[k]; i0 = k; q0 = p4[k]; }
        int i1 = i0 == 0 ? 1 : 0; float v1 = -1e30f, q1 = p4[i0 == 0 ? 1 : 0];
#pragma unroll
        for (int k = 0; k < 4; ++k) if (k != i0 && s4[k] > v1) { v1 = s4[k]; i1 = k; q1 = p4[k]; }
        const int e0 = 4 * best + i0, e1 = 4 * best + i1; const float wn = 1.f / (q0 + q1);
        const unsigned lp0 = atomicAdd((unsigned*)(LCNT + e0), 1u), lp1 = atomicAdd((unsigned*)(LCNT + e1), 1u);
        REC[i * 4 + 0] = (unsigned)e0 | ((unsigned)e1 << 8) | (lp0 << 16); REC[i * 4 + 1] = lp1; REC[i * 4 + 2] = __float_as_uint(q0 * wn); REC[i * 4 + 3] = __float_as_uint(q1 * wn);
    }
    __syncthreads();
    if (tid < 16) LCNT[16 + tid] = __hip_atomic_fetch_add((unsigned*)(C.ctl + CW_CNT + l * 1024 + 64 * tid), LCNT[tid], RLX_AGENT);
    __syncthreads();
    int* LIST = WSP(int, WS_LIST); float* LWG = WSP(float, WS_LW);
    for (int i = tid; i < nrows; i += 512) { const int m = C.vcu + C.G * i; const unsigned r0 = REC[i * 4], r1 = REC[i * 4 + 1];
        const int e0 = r0 & 255, e1 = (r0 >> 8) & 255; const unsigned lp0 = r0 >> 16, lp1 = r1;
        const size_t p0 = (size_t)e0 * T + LCNT[16 + e0] + lp0, p1 = (size_t)e1 * T + LCNT[16 + e1] + lp1;
        LIST[p0] = 2 * m; LIST[p1] = 2 * m + 1; LWG[p0] = __uint_as_float(REC[i * 4 + 2]); LWG[p1] = __uint_as_float(REC[i * 4 + 3]); }
    __syncthreads();
}
using pg8::Unit;
typedef f32x4 Acc[2][2][4][2];
__device__ __forceinline__ v4u pack8(const f32x4& a, const f32x4& b) { v4u w; w.x = cvt_pk_bf16(a[0], a[1]); w.y = cvt_pk_bf16(a[2], a[3]); w.z = cvt_pk_bf16(b[0], b[1]); w.w = cvt_pk_bf16(b[2], b[3]); return w; }
__device__ __forceinline__ void unpack8(const v4u& w, f32x4& a, f32x4& b) { a = (f32x4){bflo(w.x), bfhi(w.x), bflo(w.y), bfhi(w.y)}; b = (f32x4){bflo(w.z), bfhi(w.z), bflo(w.w), bfhi(w.w)}; }
#ifndef WT_MODE
#define WT_MODE 0
#endif
__device__ __forceinline__ void st16(void* p, const v4u& v) {
#if WT_MODE == 1
    asm volatile("global_store_dwordx4 %0, %1, off sc0 sc1" :: "v"(p), "v"(v) : "memory");
#elif WT_MODE == 2
    asm volatile("global_store_dwordx4 %0, %1, off nt" :: "v"(p), "v"(v) : "memory");
#else
    *(GAS v4u*)p = v;
#endif
}
__device__ __forceinline__ int chunk_m0(int cr) { return (cr / NCH) * LB + (cr % NCH) * 32; }

struct PWin {
    static constexpr bool EARLY_AOFF = false, FP8 = false; unsigned char* ws; int G, c; int K; unsigned kstepA;
    __device__ __forceinline__ bool next(int i, Unit& u) const { const long L = (long)i * G + c; if (L >= NPAN * 11) return false; pg8::static_decode((int)L, NPAN, 11, u.pm, u.pn); u.z = 0; return true; }
    __device__ __forceinline__ const char* a_base(const Unit& u) const { return (const char*)(ws + WS_HB) + (size_t)u.pm * 256 * 1024 * 2; }
    __device__ __forceinline__ unsigned a_off(const Unit&, int h, int R, int Cc) const { return (unsigned)((h * 128 + R) * 1024 + Cc) * 2u; }
    __device__ __forceinline__ const char* b_base(const Unit& u) const { return (const char*)(ws + WS_WIN) + (size_t)u.pn * 256 * 1024 * 2; }
    __device__ __forceinline__ void epi(const Acc& acc, const Unit& u, int wr, int wc, int fr, int fq) const {
        const int row0 = u.pm * 256 + wr * 64 + fr;
#pragma unroll
        for (int bj = 0; bj < 2; ++bj) {
            const int cb = u.pn * 256 + bj * 128; bf16* dst; int ld, col, mode = 0; float sc = 1.f;
            if (cb < 512) { dst = (bf16*)(ws + WS_U) + ((size_t)((cb + wc * 32 + 8 * fq) >> 4) * T) * 16 + ((8 * fq) & 15) - (wc * 32 + 8 * fq); ld = 16; col = 0; }
            else if (cb < 1024) { dst = (bf16*)(ws + WS_QA); ld = 512; col = cb - 512; }
            else if (cb == 1024) { dst = (bf16*)(ws + WS_KA); ld = 128; col = 0; }
            else if (cb == 1152) { dst = (bf16*)(ws + WS_VA); ld = 128; col = 0; }
            else if (cb < 1792) { dst = (bf16*)(ws + WS_QN); ld = 512; col = cb - 1280; sc = C2; }
            else if (cb < 2304) { dst = (bf16*)(ws + WS_KN); ld = 512; col = cb - 1792; }
            else { dst = (bf16*)(ws + WS_VN); ld = 512; col = cb - 2304; }
            const int c0 = col + wc * 32 + 8 * fq;
#pragma unroll
            for (int ai = 0; ai < 2; ++ai)
#pragma unroll
                for (int m = 0; m < 4; ++m) { f32x4 v0 = acc[ai][bj][m][0], v1 = acc[ai][bj][m][1];
                    if (mode) { v0 = (f32x4){fsigmoid(v0[0]), fsigmoid(v0[1]), fsigmoid(v0[2]), fsigmoid(v0[3])}; v1 = (f32x4){fsigmoid(v1[0]), fsigmoid(v1[1]), fsigmoid(v1[2]), fsigmoid(v1[3])}; }
                    else { v0 = v0 * sc; v1 = v1 * sc; }
                    st16(dst + (size_t)(row0 + ai * 128 + m * 16) * ld + c0, pack8(v0, v1)); __builtin_amdgcn_sched_barrier(0); }
        }
    }
};

struct PWin8 {
    static constexpr bool EARLY_AOFF = false, FP8 = true; unsigned char* ws; int G, c; int K; unsigned kstepA;
    __device__ __forceinline__ bool next(int i, Unit& u) const { const long L = (long)i * G + c; if (L >= 2 * NPAN * 23) return false; pg8::static_decode((int)L, 2 * NPAN, 23, u.pm, u.pn); u.z = 0; return true; }
    __device__ __forceinline__ const char* a_base(const Unit& u) const { return (const char*)(ws + WS_HB8) + (size_t)u.pm * 128 * 1024; }
    __device__ __forceinline__ unsigned a_off(const Unit&, int R, int Cc) const { return (unsigned)(R * 1024 + Cc * 2); }
    __device__ __forceinline__ const char* b_base(const Unit& u) const { return (const char*)(ws + WS_WIN) + (size_t)u.pn * 256 * 1024; }
    __device__ __forceinline__ void epi(const f32x4 (&acc)[2][4][2], f32x4 (&)[2][4][2], const Unit& u, int wr, int wc, int fr, int fq) const {
        const int row0 = u.pm * 128 + wr * 64 + fr;
#pragma unroll
        for (int bj = 0; bj < 2; ++bj) {
            const int cb = u.pn * 256 + bj * 128;
            if (cb >= 2816) { const int c0 = cb - 2816 + wc * 32 + 8 * fq;
#pragma unroll
                for (int m = 0; m < 4; ++m) { constexpr float NS = -LOG2E / 64.f; f32x4 v0 = acc[bj][m][0], v1 = acc[bj][m][1];
                    v0 = (f32x4){fsigmoid_s(v0[0], NS), fsigmoid_s(v0[1], NS), fsigmoid_s(v0[2], NS), fsigmoid_s(v0[3], NS)}; v1 = (f32x4){fsigmoid_s(v1[0], NS), fsigmoid_s(v1[1], NS), fsigmoid_s(v1[2], NS), fsigmoid_s(v1[3], NS)};
                    *(GAS v2u*)((unsigned char*)(ws + WS_GATES) + (size_t)(row0 + m * 16) * 3072 + c0) = (v2u){pk4_fp8_nc(v0[0], v0[1], v0[2], v0[3]), pk4_fp8_nc(v1[0], v1[1], v1[2], v1[3])}; }
            } else {
                bf16* dst; int ld, col; float sc = 1.f / 64.f;
                if (cb < 512) { dst = (bf16*)(ws + WS_U) + ((size_t)((cb + wc * 32 + 8 * fq) >> 4) * T) * 16 + ((8 * fq) & 15) - (wc * 32 + 8 * fq); ld = 16; col = 0; }
                else if (cb < 1024) { dst = (bf16*)(ws + WS_QA); ld = 512; col = cb - 512; }
                else if (cb == 1024) { dst = (bf16*)(ws + WS_KA); ld = 128; col = 0; }
                else if (cb == 1152) { dst = (bf16*)(ws + WS_VA); ld = 128; col = 0; }
                else if (cb < 1792) { dst = (bf16*)(ws + WS_QN); ld = 512; col = cb - 1280; sc = C2 / 64.f; }
                else if (cb < 2304) { dst = (bf16*)(ws + WS_KN); ld = 512; col = cb - 1792; }
                else { dst = (bf16*)(ws + WS_VN); ld = 512; col = cb - 2304; }
                const int c0 = col + wc * 32 + 8 * fq;
#pragma unroll
                for (int m = 0; m < 4; ++m) *(GAS v4u*)(dst + (size_t)(row0 + m * 16) * ld + c0) = pack8(acc[bj][m][0] * sc, acc[bj][m][1] * sc);
            }
        }
    }
};

struct PWin8M {
    static constexpr bool EARLY_AOFF = false, FP8 = true; unsigned char* ws; int G, c; int K; unsigned kstepA;
    __device__ __forceinline__ bool next(int i, Unit& u) const { const long L = (long)i * G + c; if (L >= (T / 192) * 23) return false; pg8::static_decode((int)L, T / 192, 23, u.pm, u.pn); u.z = 0; return true; }
    __device__ __forceinline__ const char* a_base(const Unit& u) const { return (const char*)(ws + WS_HB8) + (size_t)u.pm * 192 * 1024; }
    __device__ __forceinline__ unsigned a_off(const Unit&, int R, int Cc) const { return (unsigned)(R * 1024 + Cc * 2); }
    __device__ __forceinline__ const char* b_base(const Unit& u) const { return (const char*)(ws + WS_WIN) + (size_t)u.pn * 256 * 1024; }
    __device__ __forceinline__ void epi6(const f32x4 (&acc)[2][6][2], const Unit& u, int wr, int wc, int fr, int fq) const {
        const int row0 = u.pm * 192 + wr * 96 + fr;
#pragma unroll
        for (int bj = 0; bj < 2; ++bj) {
            const int cb = u.pn * 256 + bj * 128;
            if (cb >= 2816) { const int c0 = cb - 2816 + wc * 32 + 8 * fq;
#pragma unroll
                for (int m = 0; m < 6; ++m) { constexpr float NS = -LOG2E / 64.f; f32x4 v0 = acc[bj][m][0], v1 = acc[bj][m][1];
                    v0 = (f32x4){fsigmoid_s(v0[0], NS), fsigmoid_s(v0[1], NS), fsigmoid_s(v0[2], NS), fsigmoid_s(v0[3], NS)}; v1 = (f32x4){fsigmoid_s(v1[0], NS), fsigmoid_s(v1[1], NS), fsigmoid_s(v1[2], NS), fsigmoid_s(v1[3], NS)};
                    *(GAS v2u*)((unsigned char*)(ws + WS_GATES) + (size_t)(row0 + m * 16) * 3072 + c0) = (v2u){pk4_fp8_nc(v0[0], v0[1], v0[2], v0[3]), pk4_fp8_nc(v1[0], v1[1], v1[2], v1[3])}; }
            } else {
                bf16* dst; int ld, col; float sc = 1.f / 64.f;
                if (cb < 512) { dst = (bf16*)(ws + WS_U) + ((size_t)((cb + wc * 32 + 8 * fq) >> 4) * T) * 16 + ((8 * fq) & 15) - (wc * 32 + 8 * fq); ld = 16; col = 0; }
                else if (cb < 1024) { dst = (bf16*)(ws + WS_QA); ld = 512; col = cb - 512; }
                else if (cb == 1024) { dst = (bf16*)(ws + WS_KA); ld = 128; col = 0; }
                else if (cb == 1152) { dst = (bf16*)(ws + WS_VA); ld = 128; col = 0; }
                else if (cb < 1792) { dst = (bf16*)(ws + WS_QN); ld = 512; col = cb - 1280; sc = C2 / 64.f; }
                else if (cb < 2304) { dst = (bf16*)(ws + WS_KN); ld = 512; col = cb - 1792; }
                else { dst = (bf16*)(ws + WS_VN); ld = 512; col = cb - 2304; }
                const int c0 = col + wc * 32 + 8 * fq;
#pragma unroll
                for (int m = 0; m < 6; ++m) *(GAS v4u*)(dst + (size_t)(row0 + m * 16) * ld + c0) = pack8(acc[bj][m][0] * sc, acc[bj][m][1] * sc);
            }
        }
    }
};

struct PGate {
    static constexpr bool EARLY_AOFF = false, FP8 = !GATE_BF16; unsigned char* ws; int G, c; int K; unsigned kstepA;
    __device__ __forceinline__ bool next(int i, Unit& u) const { const long L = (long)i * G + c; if (L >= 2 * NPAN * 12) return false; pg8::static_decode((int)L, 2 * NPAN, 12, u.pm, u.pn); u.z = 0; return true; }
    __device__ __forceinline__ const char* a_base(const Unit& u) const { return GATE_BF16 ? (const char*)(ws + WS_HB) + (size_t)u.pm * 128 * 2048 : (const char*)(ws + WS_HB8) + (size_t)u.pm * 128 * 1024; }
    __device__ __forceinline__ unsigned a_off(const Unit&, int R, int Cc) const { return GATE_BF16 ? (unsigned)(R * 2048 + Cc * 2) : (unsigned)(R * 1024 + Cc * 2); }
    __device__ __forceinline__ const char* b_base(const Unit& u) const { return GATE_BF16 ? (const char*)(ws + WS_WIN) + (size_t)(2816 + u.pn * 256) * 2048 : (const char*)(ws + WS_WIN8) + (size_t)u.pn * 256 * 1024; }
    __device__ __forceinline__ void epi(const f32x4 (&acc)[2][4][2], f32x4 (&)[2][4][2], const Unit& u, int wr, int wc, int fr, int fq) const {
#pragma unroll
        for (int m = 0; m < 4; ++m) { const size_t r = (size_t)(u.pm * 128 + wr * 64 + m * 16 + fr);
#pragma unroll
            for (int bj = 0; bj < 2; ++bj) { const int c0 = u.pn * 256 + bj * 128 + wc * 32 + 8 * fq; f32x4 v0 = acc[bj][m][0] * (GATE_BF16 ? 1.f : 1.f / 64.f), v1 = acc[bj][m][1] * (GATE_BF16 ? 1.f : 1.f / 64.f);
                v0 = (f32x4){fsigmoid(v0[0]), fsigmoid(v0[1]), fsigmoid(v0[2]), fsigmoid(v0[3])}; v1 = (f32x4){fsigmoid(v1[0]), fsigmoid(v1[1]), fsigmoid(v1[2]), fsigmoid(v1[3])};
                if (GATE_BF16) *(GAS v4u*)((bf16*)(ws + WS_GATES) + r * 3072 + c0) = pack8(v0, v1);
                else *(GAS v2u*)((unsigned char*)(ws + WS_GATES) + r * 3072 + c0) = (v2u){pk4_fp8(v0[0], v0[1], v0[2], v0[3]), pk4_fp8(v1[0], v1[1], v1[2], v1[3])}; }
            __builtin_amdgcn_sched_barrier(0); }
    }
};

struct PS5A {
    static constexpr bool EARLY_AOFF = false, FP8 = false; unsigned char* ws; int G, c; int K; unsigned kstepA;
    __device__ __forceinline__ bool next(int i, Unit& u) const { const long L = (long)i * G + c; if (L >= 32 * 15) return false; const int l = (int)L; u.z = l / 15; const int r = l % 15; u.pm = r / 3; u.pn = r % 3; return true; }
    __device__ __forceinline__ const char* a_base(const Unit& u) const { return (const char*)(ws + WS_U) + (size_t)u.z * T * 32; }
    __device__ __forceinline__ unsigned a_off(const Unit& u, int h, int R, int Cc) const { int cr = u.pm * 256 + h * 128 + R; cr = cr < NCR ? cr : NCR - 1; return (unsigned)(cr * 512 + Cc) * 2u; }
    __device__ __forceinline__ const char* b_base(const Unit& u) const { return (const char*)(ws + WS_BT1) + ((size_t)u.z * 768 + u.pn * 256) * 512 * 2; }
    __device__ __forceinline__ void epi(const Acc& acc, const Unit& u, int wr, int wc, int fr, int fq) const {
#pragma unroll
        for (int ai = 0; ai < 2; ++ai)
#pragma unroll
            for (int m = 0; m < 4; ++m) { const int cr = u.pm * 256 + ai * 128 + wr * 64 + m * 16 + fr; if (cr >= NCR) continue;
#pragma unroll
                for (int bj = 0; bj < 2; ++bj) { const int n = bj * 128 + wc * 32 + 8 * fq;
                    if (u.pn < 2) *(GAS v4u*)((bf16*)(ws + WS_YG) + (size_t)u.z * T * 16 + (size_t)cr * 512 + u.pn * 256 + n) = pack8(acc[ai][bj][m][0], acc[ai][bj][m][1]);
                    else { GAS f32x4* o = (GAS f32x4*)((float*)(ws + WS_SST) + (size_t)cr * 8192 + u.z * 256 + n); o[0] = acc[ai][bj][m][0]; o[1] = acc[ai][bj][m][1]; } }
                __builtin_amdgcn_sched_barrier(0); }
    }
};

struct PS5B {
    static constexpr bool EARLY_AOFF = false, FP8 = false; unsigned char* ws; int tk; int K; unsigned kstepA;
    __device__ __forceinline__ bool next(int i, Unit& u) const { if (i != 0) return false; u.z = tk / 18; const int r = tk % 18; u.pm = r / 2; u.pn = r % 2; return true; }
    __device__ __forceinline__ const char* a_base(const Unit& u) const { return (const char*)(ws + WS_XST) + (size_t)u.z * 512; }
    __device__ __forceinline__ unsigned a_off(const Unit& u, int R, int Cc) const { int cr = u.pm * 128 + R; cr = cr < NCR ? cr : NCR - 1; return (unsigned)(cr * 8192 + Cc) * 2u; }
    __device__ __forceinline__ const char* b_base(const Unit& u) const { return (const char*)(ws + WS_BT2) + ((size_t)u.z * 512 + u.pn * 256) * 256 * 2; }
    __device__ __forceinline__ void epi(const f32x4 (&acc)[2][4][2], f32x4 (&)[2][4][2], const Unit& u, int wr, int wc, int fr, int fq) const {
        v4u yw[4][2];
#pragma unroll
        for (int m = 0; m < 4; ++m) { int cr = u.pm * 128 + wr * 64 + m * 16 + fr; cr = cr < NCR ? cr : NCR - 1;
#pragma unroll
            for (int bj = 0; bj < 2; ++bj) yw[m][bj] = *(const GAS v4u*)((const bf16*)(ws + WS_YG) + (size_t)u.z * T * 16 + (size_t)cr * 512 + u.pn * 256 + bj * 128 + wc * 32 + 8 * fq); }
#pragma unroll
        for (int m = 0; m < 4; ++m) { const int cr = u.pm * 128 + wr * 64 + m * 16 + fr; if (cr >= NCR) continue;
#pragma unroll
            for (int bj = 0; bj < 2; ++bj) { const int nn = u.pn * 256 + bj * 128 + wc * 32 + 8 * fq, t = nn >> 4, h0 = nn & 15;
                GAS v4u* p = (GAS v4u*)((bf16*)(ws + WS_YS) + (size_t)(chunk_m0(cr) + t) * 512 + u.z * 16 + h0);
                f32x4 y0, y1; { const v4u w_ = yw[m][bj]; unpack8(w_, y0, y1); } y0 += acc[bj][m][0]; y1 += acc[bj][m][1];
                y0 = (f32x4){gelu_tanh(y0[0]), gelu_tanh(y0[1]), gelu_tanh(y0[2]), gelu_tanh(y0[3])}; y1 = (f32x4){gelu_tanh(y1[0]), gelu_tanh(y1[1]), gelu_tanh(y1[2]), gelu_tanh(y1[3])};
                *p = pack8(y0, y1); } }
    }
};

__device__ __forceinline__ int half_panel(int hl, bool lat_only) { if (!lat_only) return hl; const int pl = hl >> 1; return 2 * (pl + (pl >> 5) + 1) + (hl & 1); }
struct PGlu {
    static constexpr bool EARLY_AOFF = false, FP8 = false; unsigned char* ws; int G, c; int K; unsigned kstepA; bool lat_only;
    __device__ __forceinline__ bool next(int i, Unit& u) const { const int nH = lat_only ? 256 : 2 * NPAN; const long L = (long)i * G + c; if (L >= nH * 2) return false; pg8::static_decode((int)L, nH, 2, u.pm, u.pn); u.pm = half_panel(u.pm, lat_only); u.z = 0; return true; }
    __device__ __forceinline__ const char* a_base(const Unit& u) const { return (const char*)(ws + WS_YS) + (size_t)u.pm * 128 * 512 * 2; }
    __device__ __forceinline__ unsigned a_off(const Unit&, int R, int Cc) const { return (unsigned)(R * 512 + Cc) * 2u; }
    __device__ __forceinline__ const char* b_base(const Unit& u) const { return (const char*)(ws + WS_WGLU) + (size_t)u.pn * 256 * 512 * 2; }
    __device__ __forceinline__ void epi(const f32x4 (&acc)[2][4][2], f32x4 (&)[2][4][2], const Unit& u, int wr, int wc, int fr, int fq) const {
        v4u zw[4][2];
#pragma unroll
        for (int m = 0; m < 4; ++m)
#pragma unroll
            for (int bj = 0; bj < 2; ++bj) zw[m][bj] = *(const GAS v4u*)((const bf16*)(ws + WS_YS) + (size_t)(u.pm * 128 + wr * 64 + m * 16 + fr) * 512 + u.pn * 256 + bj * 128 + wc * 32 + 8 * fq);
#pragma unroll
        for (int m = 0; m < 4; ++m) { const size_t r = (size_t)(u.pm * 128 + wr * 64 + m * 16 + fr);
#pragma unroll
            for (int bj = 0; bj < 2; ++bj) { const int cc = u.pn * 256 + bj * 128 + wc * 32 + 8 * fq;
                f32x4 z0, z1; { const v4u w_ = zw[m][bj]; unpack8(w_, z0, z1); } const f32x4 a0 = acc[bj][m][0], a1 = acc[bj][m][1];
                z0 = z0 * (f32x4){fsigmoid(a0[0]), fsigmoid(a0[1]), fsigmoid(a0[2]), fsigmoid(a0[3])}; z1 = z1 * (f32x4){fsigmoid(a1[0]), fsigmoid(a1[1]), fsigmoid(a1[2]), fsigmoid(a1[3])};
                *(GAS v4u*)((bf16*)(ws + WS_U) + r * 512 + cc) = pack8(z0, z1); } }
    }
};

typedef f32x4 Acc128[2][4][2];
struct PMerge {
    static constexpr bool EARLY_AOFF = false, FP8 = false; unsigned char* ws; int G, c; int K; unsigned kstepA; bool lat_only;
    __device__ __forceinline__ bool next(int i, Unit& u) const { const int nH = lat_only ? 256 : 2 * NPAN; const long tile = (long)(i / 3) * G + c; if (tile >= nH * 4) return false; pg8::static_decode((int)tile, nH, 4, u.pm, u.pn); u.pm = half_panel(u.pm, lat_only); u.z = i % 3; return true; }
    __device__ __forceinline__ const char* a_base(const Unit& u) const { const size_t off = u.z == 0 ? WS_U : (u.z == 1 ? WS_AO : WS_NO); return (const char*)(ws + off) + (size_t)u.pm * 128 * 512 * 2; }
    __device__ __forceinline__ unsigned a_off(const Unit&, int R, int Cc) const { return (unsigned)(R * 512 + Cc) * 2u; }
    __device__ __forceinline__ const char* b_base(const Unit& u) const { return (const char*)(ws + WS_WBR) + ((size_t)u.z * 1024 + u.pn * 256) * 512 * 2; }
    __device__ __forceinline__ void epi(const Acc128& acc, Acc128& mrg, const Unit& u, int wr, int wc, int fr, int fq) const {
        v2u gw[4][2];
#pragma unroll
        for (int m = 0; m < 4; ++m)
#pragma unroll
            for (int bj = 0; bj < 2; ++bj) gw[m][bj] = *(const GAS v2u*)((const unsigned char*)(ws + WS_GATES) + (size_t)(u.pm * 128 + wr * 64 + m * 16 + fr) * 3072 + u.z * 1024 + u.pn * 256 + bj * 128 + wc * 32 + 8 * fq);
#pragma unroll
        for (int m = 0; m < 4; ++m) { const size_t r = (size_t)(u.pm * 128 + wr * 64 + m * 16 + fr);
#pragma unroll
            for (int bj = 0; bj < 2; ++bj) { const int cc = u.pn * 256 + bj * 128 + wc * 32 + 8 * fq; const v2u w_ = gw[m][bj];
                const f32x4 g0 = (f32x4){__builtin_amdgcn_cvt_f32_fp8((int)w_.x, 0), __builtin_amdgcn_cvt_f32_fp8((int)w_.x, 1), __builtin_amdgcn_cvt_f32_fp8((int)w_.x, 2), __builtin_amdgcn_cvt_f32_fp8((int)w_.x, 3)};
                const f32x4 g1 = (f32x4){__builtin_amdgcn_cvt_f32_fp8((int)w_.y, 0), __builtin_amdgcn_cvt_f32_fp8((int)w_.y, 1), __builtin_amdgcn_cvt_f32_fp8((int)w_.y, 2), __builtin_amdgcn_cvt_f32_fp8((int)w_.y, 3)};
                if (u.z == 0) { mrg[bj][m][0] = g0 * acc[bj][m][0]; mrg[bj][m][1] = g1 * acc[bj][m][1]; }
                else { mrg[bj][m][0] += g0 * acc[bj][m][0]; mrg[bj][m][1] += g1 * acc[bj][m][1]; }
                if (u.z == 2) *(GAS v4u*)((bf16*)(ws + WS_HB) + r * 1024 + cc) = pack8(mrg[bj][m][0], mrg[bj][m][1]); } }
    }
};

struct PWout {
    static constexpr bool EARLY_AOFF = false, FP8 = false; unsigned char* ws; float* out; const float* mod; int G, c; int K; unsigned kstepA; bool lat_only; size_t wofs;
    __device__ __forceinline__ bool next(int i, Unit& u) const { const int nH = lat_only ? 256 : 2 * NPAN; const long L = (long)i * G + c; if (L >= nH * 4) return false; pg8::static_decode((int)L, nH, 4, u.pm, u.pn); u.pm = half_panel(u.pm, lat_only); u.z = 0; return true; }
    __device__ __forceinline__ const char* a_base(const Unit& u) const { return (const char*)(ws + WS_HB) + (size_t)u.pm * 128 * 1024 * 2; }
    __device__ __forceinline__ unsigned a_off(const Unit&, int R, int Cc) const { return (unsigned)(R * 1024 + Cc) * 2u; }
    __device__ __forceinline__ const char* b_base(const Unit& u) const { return (const char*)(ws + wofs) + (size_t)u.pn * 256 * 1024 * 2; }
    __device__ __forceinline__ void epi(const f32x4 (&acc)[2][4][2], f32x4 (&)[2][4][2], const Unit& u, int wr, int wc, int fr, int fq) const {
        const int pm = u.pm >> 1, b = pm / 33, pr = pm % 33, cond = pr == 0 ? 4 : b;
        bf16* xb = (bf16*)(ws + WS_XS) + (size_t)u.pm * 128 * D;
        const float* g1 = mod + cond * 6144 + 2048;
        v4u xv[2][4];
#pragma unroll
        for (int bj = 0; bj < 2; ++bj)
#pragma unroll
            for (int m = 0; m < 4; ++m) xv[bj][m] = *(const GAS v4u*)(xb + (size_t)(wr * 64 + m * 16 + fr) * D + u.pn * 256 + bj * 128 + wc * 32 + 8 * fq);
#pragma unroll
        for (int bj = 0; bj < 2; ++bj) { const int cc = u.pn * 256 + bj * 128 + wc * 32 + 8 * fq; const f32x4 ga = *(const GAS f32x4*)(g1 + cc), gb = *(const GAS f32x4*)(g1 + cc + 4);
#pragma unroll
            for (int m = 0; m < 4; ++m) { f32x4 x0, x1; { const v4u w_ = xv[bj][m]; unpack8(w_, x0, x1); }
                *(GAS v4u*)(xb + (size_t)(wr * 64 + m * 16 + fr) * D + cc) = pack8(x0 + ga * acc[bj][m][0], x1 + gb * acc[bj][m][1]); } }
    }
};

struct PWoutM {
    static constexpr bool EARLY_AOFF = false, FP8 = false; unsigned char* ws; const float* mod; int G, c; int K; unsigned kstepA; size_t wofs;
    __device__ __forceinline__ bool next(int i, Unit& u) const { const long L = (long)i * G + c; if (L >= (T / 192) * 4) return false; pg8::static_decode((int)L, T / 192, 4, u.pm, u.pn); u.z = 0; return true; }
    __device__ __forceinline__ const char* a_base(const Unit& u) const { return (const char*)(ws + WS_HB) + (size_t)u.pm * 192 * 1024 * 2; }
    __device__ __forceinline__ unsigned a_off(const Unit&, int R, int Cc) const { return (unsigned)(R * 1024 + Cc) * 2u; }
    __device__ __forceinline__ const char* b_base(const Unit& u) const { return (const char*)(ws + wofs) + (size_t)u.pn * 256 * 1024 * 2; }
    __device__ __forceinline__ void epi6(const f32x4 (&acc)[2][6][2], const Unit& u, int wr, int wc, int fr, int fq) const {
        bf16* xb = (bf16*)(ws + WS_XS) + (size_t)u.pm * 192 * D;
        const int base_ = u.pm * 192 + wr * 96, b0 = base_ / LB, j0 = base_ - b0 * LB;
#pragma unroll
        for (int mh = 0; mh < 6; mh += 3) {
            v4u xv[2][3];
#pragma unroll
            for (int bj = 0; bj < 2; ++bj)
#pragma unroll
                for (int m = 0; m < 3; ++m) xv[bj][m] = *(const GAS v4u*)(xb + (size_t)(wr * 96 + (mh + m) * 16 + fr) * D + u.pn * 256 + bj * 128 + wc * 32 + 8 * fq);
#pragma unroll
            for (int m = 0; m < 3; ++m) { int jj = j0 + (mh + m) * 16, bb = b0; if (jj >= LB) { jj -= LB; ++bb; } const int cond = jj < CTX ? 4 : bb; const float* g1 = mod + cond * 6144 + 2048;
#pragma unroll
                for (int bj = 0; bj < 2; ++bj) { const int cc = u.pn * 256 + bj * 128 + wc * 32 + 8 * fq; const f32x4 ga = *(const GAS f32x4*)(g1 + cc), gb = *(const GAS f32x4*)(g1 + cc + 4);
                    f32x4 x0, x1; { const v4u w_ = xv[bj][m]; unpack8(w_, x0, x1); }
                    *(GAS v4u*)(xb + (size_t)(wr * 96 + (mh + m) * 16 + fr) * D + cc) = pack8(x0 + ga * acc[bj][mh + m][0], x1 + gb * acc[bj][mh + m][1]); } }
        }
    }
};

struct ExpTab { int cnt[16], tile0[17]; };
__device__ __forceinline__ int exp_find(const int (&tile0)[17], int q) { int e = 0;
#pragma unroll
    for (int k = 1; k < 16; ++k) e += (q >= tile0[k]) ? 1 : 0;
    return e; }

struct PMoe1 {
    static constexpr bool EARLY_AOFF = true, FP8 = true; unsigned char* ws; const LAS int* tab; int G, c; int K; unsigned kstepA; size_t wofs;
    __device__ __forceinline__ bool next(int i, Unit& u) const { const long L = (long)i * G + c; const int total = __builtin_amdgcn_readfirstlane(tab[32]) * 4; if (L >= total) return false; const int q = (int)L >> 2; u.pn = (int)L & 3;
        int e = 0;
#pragma unroll
        for (int k = 1; k < 16; ++k) e += (q >= __builtin_amdgcn_readfirstlane(tab[16 + k])) ? 1 : 0;
        u.z = e; u.pm = q - __builtin_amdgcn_readfirstlane(tab[16 + e]); return true; }
    __device__ __forceinline__ const char* a_base(const Unit&) const { return (const char*)(ws + WS_HB8); }
    __device__ __forceinline__ unsigned a_off(const Unit& u, int R, int Cc) const { int r = u.pm * 128 + R; const int n = __builtin_amdgcn_readfirstlane(tab[u.z]); r = r < n ? r : n - 1;
        const int ent = ((const int*)(ws + WS_LIST))[(size_t)u.z * T + r]; return (unsigned)((ent >> 1) * 1024 + Cc * 2); }
    __device__ __forceinline__ const char* b_base(const Unit& u) const { return (const char*)(ws + wofs) + ((size_t)u.z * 1024 + u.pn * 256) * 1024; }
    __device__ __forceinline__ void epi(const f32x4 (&acc)[2][4][2], f32x4 (&)[2][4][2], const Unit& u, int wr, int wc, int fr, int fq) const {
        const size_t arow0 = (size_t)(__builtin_amdgcn_readfirstlane(tab[16 + u.z]) + u.pm) * 128;
#pragma unroll
        for (int m = 0; m < 4; ++m) { const f32x4 g0 = acc[0][m][0] * (1.f / 64.f), g1 = acc[0][m][1] * (1.f / 64.f), u0 = acc[1][m][0] * (8.f / 64.f), u1 = acc[1][m][1] * (8.f / 64.f);
            const f32x4 v0 = (f32x4){g0[0] * fsigmoid(g0[0]), g0[1] * fsigmoid(g0[1]), g0[2] * fsigmoid(g0[2]), g0[3] * fsigmoid(g0[3])} * u0;
            const f32x4 v1 = (f32x4){g1[0] * fsigmoid(g1[0]), g1[1] * fsigmoid(g1[1]), g1[2] * fsigmoid(g1[2]), g1[3] * fsigmoid(g1[3])} * u1;
            *(GAS v2u*)((unsigned char*)(ws + WS_ACT) + (arow0 + wr * 64 + m * 16 + fr) * 512 + u.pn * 128 + wc * 32 + 8 * fq) = (v2u){pk4_fp8(v0[0], v0[1], v0[2], v0[3]), pk4_fp8(v1[0], v1[1], v1[2], v1[3])}; }
    }
};
struct PMoe2 {
    static constexpr bool EARLY_AOFF = false, FP8 = true; unsigned char* ws; const LAS int* tab; int G, c; int K; unsigned kstepA; size_t wofs;
    __device__ __forceinline__ bool next(int i, Unit& u) const { const long L = (long)i * G + c; const int total = __builtin_amdgcn_readfirstlane(tab[32]) * 4; if (L >= total) return false; const int q = (int)L >> 2; u.pn = (int)L & 3;
        int e = 0;
#pragma unroll
        for (int k = 1; k < 16; ++k) e += (q >= __builtin_amdgcn_readfirstlane(tab[16 + k])) ? 1 : 0;
        u.z = e; u.pm = q - __builtin_amdgcn_readfirstlane(tab[16 + e]); return true; }
    __device__ __forceinline__ const char* a_base(const Unit& u) const { return (const char*)(ws + WS_ACT) + (size_t)(__builtin_amdgcn_readfirstlane(tab[16 + u.z]) + u.pm) * 128 * 512; }
    __device__ __forceinline__ unsigned a_off(const Unit&, int R, int Cc) const { return (unsigned)(R * 512 + Cc * 2); }
    __device__ __forceinline__ const char* b_base(const Unit& u) const { return (const char*)(ws + wofs) + ((size_t)u.z * 1024 + u.pn * 256) * 512; }
    __device__ __forceinline__ void epi(const f32x4 (&acc)[2][4][2], f32x4 (&)[2][4][2], const Unit& u, int wr, int wc, int fr, int fq) const {
        const int n = __builtin_amdgcn_readfirstlane(tab[u.z]);
        int entv[4]; float wv[4];
#pragma unroll
        for (int m = 0; m < 4; ++m) { int r = u.pm * 128 + wr * 64 + m * 16 + fr; r = r < n ? r : n - 1; entv[m] = ((const int*)(ws + WS_LIST))[(size_t)u.z * T + r]; wv[m] = ((const float*)(ws + WS_LW))[(size_t)u.z * T + r] * (1.f / 256.f); }
#pragma unroll
        for (int m = 0; m < 4; ++m) { const int r = u.pm * 128 + wr * 64 + m * 16 + fr; if (r >= n) continue;
            const int ent = entv[m]; const float w = wv[m];
#pragma unroll
            for (int bj = 0; bj < 2; ++bj)
                *(GAS v4u*)((bf16*)(ws + WS_YSLOT) + (size_t)ent * 1024 + u.pn * 256 + bj * 128 + wc * 32 + 8 * fq) = pack8(acc[bj][m][0] * w, acc[bj][m][1] * w); }
    }
};
struct PMoe1M {
    static constexpr bool EARLY_AOFF = true, FP8 = true; unsigned char* ws; const LAS int* tab; int G, c; int K; unsigned kstepA; size_t wofs;
    __device__ __forceinline__ bool next(int i, Unit& u) const { const long L = (long)i * G + c; const int total = __builtin_amdgcn_readfirstlane(tab[32]) * 4; if (L >= total) return false; const int q = (int)L >> 2; u.pn = (int)L & 3;
        int e = 0;
#pragma unroll
        for (int st_ = 8; st_ >= 1; st_ >>= 1) { if (q >= __builtin_amdgcn_readfirstlane(tab[16 + e + st_])) e += st_; }
        u.z = e; u.pm = q - __builtin_amdgcn_readfirstlane(tab[16 + e]); return true; }
    __device__ __forceinline__ const char* a_base(const Unit&) const { return (const char*)(ws + WS_HB8); }
    __device__ __forceinline__ unsigned a_off(const Unit& u, int R, int Cc) const { int r = u.pm * 192 + R; const int n = __builtin_amdgcn_readfirstlane(tab[u.z]); r = r < n ? r : n - 1;
        const int ent = ((const int*)(ws + WS_LIST))[(size_t)u.z * T + r]; return (unsigned)((ent >> 1) * 1024 + Cc * 2); }
    __device__ __forceinline__ const char* b_base(const Unit& u) const { return (const char*)(ws + wofs) + ((size_t)u.z * 1024 + u.pn * 256) * 1024; }
    __device__ __forceinline__ void epi6(const f32x4 (&acc)[2][6][2], const Unit& u, int wr, int wc, int fr, int fq) const {
        const size_t arow0 = (size_t)(__builtin_amdgcn_readfirstlane(tab[16 + u.z]) + u.pm) * 192;
#pragma unroll
        for (int m = 0; m < 6; ++m) { const f32x4 g0 = acc[0][m][0] * (1.f / 64.f), g1 = acc[0][m][1] * (1.f / 64.f), u0 = acc[1][m][0] * (8.f / 64.f), u1 = acc[1][m][1] * (8.f / 64.f);
            const f32x4 v0 = (f32x4){g0[0] * fsigmoid(g0[0]), g0[1] * fsigmoid(g0[1]), g0[2] * fsigmoid(g0[2]), g0[3] * fsigmoid(g0[3])} * u0;
            const f32x4 v1 = (f32x4){g1[0] * fsigmoid(g1[0]), g1[1] * fsigmoid(g1[1]), g1[2] * fsigmoid(g1[2]), g1[3] * fsigmoid(g1[3])} * u1;
            *(GAS v2u*)((unsigned char*)(ws + WS_ACT) + (arow0 + wr * 96 + m * 16 + fr) * 512 + u.pn * 128 + wc * 32 + 8 * fq) = (v2u){pk4_fp8(v0[0], v0[1], v0[2], v0[3]), pk4_fp8(v1[0], v1[1], v1[2], v1[3])}; }
    }
};
struct PMoe2M {
    static constexpr bool EARLY_AOFF = false, FP8 = true; unsigned char* ws; const LAS int* tab; int G, c; int K; unsigned kstepA; size_t wofs;
    __device__ __forceinline__ bool next(int i, Unit& u) const { const long L = (long)i * G + c; const int total = __builtin_amdgcn_readfirstlane(tab[32]) * 4; if (L >= total) return false; const int q = (int)L >> 2; u.pn = (int)L & 3;
        int e = 0;
#pragma unroll
        for (int st_ = 8; st_ >= 1; st_ >>= 1) { if (q >= __builtin_amdgcn_readfirstlane(tab[16 + e + st_])) e += st_; }
        u.z = e; u.pm = q - __builtin_amdgcn_readfirstlane(tab[16 + e]); return true; }
    __device__ __forceinline__ const char* a_base(const Unit& u) const { return (const char*)(ws + WS_ACT) + (size_t)(__builtin_amdgcn_readfirstlane(tab[16 + u.z]) + u.pm) * 192 * 512; }
    __device__ __forceinline__ unsigned a_off(const Unit&, int R, int Cc) const { return (unsigned)(R * 512 + Cc * 2); }
    __device__ __forceinline__ const char* b_base(const Unit& u) const { return (const char*)(ws + wofs) + ((size_t)u.z * 1024 + u.pn * 256) * 512; }
    __device__ __forceinline__ void epi6(const f32x4 (&acc)[2][6][2], const Unit& u, int wr, int wc, int fr, int fq) const {
        const int n = __builtin_amdgcn_readfirstlane(tab[u.z]);
        int entv[6]; float wv[6];
#pragma unroll
        for (int m = 0; m < 6; ++m) { int r = u.pm * 192 + wr * 96 + m * 16 + fr; r = r < n ? r : n - 1; entv[m] = ((const int*)(ws + WS_LIST))[(size_t)u.z * T + r]; wv[m] = ((const float*)(ws + WS_LW))[(size_t)u.z * T + r] * (1.f / 256.f); }
#pragma unroll
        for (int m = 0; m < 6; ++m) { const int r = u.pm * 192 + wr * 96 + m * 16 + fr; if (r >= n) continue;
            const int ent = entv[m]; const float w = wv[m];
#pragma unroll
            for (int bj = 0; bj < 2; ++bj)
                *(GAS v4u*)((bf16*)(ws + WS_YSLOT) + (size_t)ent * 1024 + u.pn * 256 + bj * 128 + wc * 32 + 8 * fq) = pack8(acc[bj][m][0] * w, acc[bj][m][1] * w); }
    }
};
struct PMoe1B {
    static constexpr bool EARLY_AOFF = true, FP8 = false; unsigned char* ws; const LAS int* tab; int G, c; int K; unsigned kstepA;
    __device__ __forceinline__ bool next(int i, Unit& u) const { const long L = (long)i * G + c; const int total = tab[32] * 4; if (L >= total) return false; const int q = (int)L >> 2; u.pn = (int)L & 3;
        int e = 0;
#pragma unroll
        for (int k = 1; k < 16; ++k) e += (q >= tab[16 + k]) ? 1 : 0;
        u.z = e; u.pm = q - tab[16 + e]; return true; }
    __device__ __forceinline__ const char* a_base(const Unit&) const { return (const char*)(ws + WS_HB); }
    __device__ __forceinline__ unsigned a_off(const Unit& u, int h, int R, int Cc) const { int r = u.pm * 256 + h * 128 + R; const int n = tab[u.z]; r = r < n ? r : n - 1;
        const int ent = ((const int*)(ws + WS_LIST))[(size_t)u.z * T + r]; return (unsigned)((ent >> 1) * 1024 + Cc) * 2u; }
    __device__ __forceinline__ const char* b_base(const Unit& u) const { return (const char*)(ws + WS_MOE1) + ((size_t)u.z * 1024 + u.pn * 256) * 1024 * 2; }
    __device__ __forceinline__ void epi(const Acc& acc, const Unit& u, int wr, int wc, int fr, int fq) const {
        const size_t arow0 = (size_t)(tab[16 + u.z] + u.pm) * 256;
#pragma unroll
        for (int ai = 0; ai < 2; ++ai)
#pragma unroll
            for (int m = 0; m < 4; ++m) { const f32x4 g0 = acc[ai][0][m][0], g1 = acc[ai][0][m][1], u0 = acc[ai][1][m][0], u1 = acc[ai][1][m][1];
                const f32x4 v0 = (f32x4){g0[0] * fsigmoid(g0[0]), g0[1] * fsigmoid(g0[1]), g0[2] * fsigmoid(g0[2]), g0[3] * fsigmoid(g0[3])} * u0;
                const f32x4 v1 = (f32x4){g1[0] * fsigmoid(g1[0]), g1[1] * fsigmoid(g1[1]), g1[2] * fsigmoid(g1[2]), g1[3] * fsigmoid(g1[3])} * u1;
                *(GAS v4u*)((bf16*)(ws + WS_ACTB) + (arow0 + ai * 128 + wr * 64 + m * 16 + fr) * 512 + u.pn * 128 + wc * 32 + 8 * fq) = pack8(v0, v1); }
    }
};
struct PMoe2B {
    static constexpr bool EARLY_AOFF = false, FP8 = false; unsigned char* ws; const LAS int* tab; int G, c; int K; unsigned kstepA;
    __device__ __forceinline__ bool next(int i, Unit& u) const { const long L = (long)i * G + c; const int total = tab[32] * 4; if (L >= total) return false; const int q = (int)L >> 2; u.pn = (int)L & 3;
        int e = 0;
#pragma unroll
        for (int k = 1; k < 16; ++k) e += (q >= tab[16 + k]) ? 1 : 0;
        u.z = e; u.pm = q - tab[16 + e]; return true; }
    __device__ __forceinline__ const char* a_base(const Unit& u) const { return (const char*)(ws + WS_ACTB) + (size_t)(tab[16 + u.z] + u.pm) * 256 * 512 * 2; }
    __device__ __forceinline__ unsigned a_off(const Unit&, int h, int R, int Cc) const { return (unsigned)((h * 128 + R) * 512 + Cc) * 2u; }
    __device__ __forceinline__ const char* b_base(const Unit& u) const { return (const char*)(ws + WS_MOE2) + ((size_t)u.z * 1024 + u.pn * 256) * 512 * 2; }
    __device__ __forceinline__ void epi(const Acc& acc, const Unit& u, int wr, int wc, int fr, int fq) const {
        const int n = tab[u.z];
#pragma unroll
        for (int ai = 0; ai < 2; ++ai)
#pragma unroll
            for (int m = 0; m < 4; ++m) { const int r = u.pm * 256 + ai * 128 + wr * 64 + m * 16 + fr; if (r >= n) continue;
                const int ent = ((const int*)(ws + WS_LIST))[(size_t)u.z * T + r]; const float w = ((const float*)(ws + WS_LW))[(size_t)u.z * T + r];
#pragma unroll
                for (int bj = 0; bj < 2; ++bj)
                    *(GAS v4u*)((bf16*)(ws + WS_YSLOT) + (size_t)ent * 1024 + u.pn * 256 + bj * 128 + wc * 32 + 8 * fq) = pack8(acc[ai][bj][m][0] * w, acc[ai][bj][m][1] * w); }
    }
};
__device__ __forceinline__ void build_exptab_rows(const Ctx& C, LAS int* tab, int l, int rows) {
    __syncthreads();
    if (threadIdx.x == 0) { int t0 = 0;
        for (int e = 0; e < 16; ++e) { const int n = (int)__hip_atomic_load((unsigned*)(C.ctl + CW_CNT + l * 1024 + 64 * e), RLX_AGENT); tab[e] = n; tab[16 + e] = t0; t0 += (n + rows - 1) / rows; }
        tab[32] = t0; }
    __syncthreads();
}
__device__ __forceinline__ void build_exptab(const Ctx& C, LAS int* tab, int l, int tsh = 7) {
    __syncthreads();
    if (threadIdx.x == 0) { int t0 = 0;
        for (int e = 0; e < 16; ++e) { const int n = (int)__hip_atomic_load((unsigned*)(C.ctl + CW_CNT + l * 1024 + 64 * e), RLX_AGENT); tab[e] = n; tab[16 + e] = t0; t0 += (n + (1 << tsh) - 1) >> tsh; }
        tab[32] = t0; }
    __syncthreads();
}
__device__ __forceinline__ void phase_attn(const Ctx& C, int l, unsigned char* lds_gen) {
    phase_carry(C, l);
    char* shm = (char*)lds_gen;
    bf16* QA = WSP(bf16, WS_QA); bf16* KA = WSP(bf16, WS_KA); bf16* VA = WSP(bf16, WS_VA); bf16* QN = WSP(bf16, WS_QN); bf16* KN = WSP(bf16, WS_KN); bf16* VN = WSP(bf16, WS_VN);
#ifndef ATTN_SEL
#define ATTN_SEL 3
#endif
#ifdef REPMASK
#define REPMASK_ REPMASK
#else
#define REPMASK_ 0
#endif
    const int per = (1024 + C.G - 1) / C.G;
    bool nomax; { float gq = 0.f, gk = 0.f; for (int i = 0; i < 64; ++i) { gq = fmaxf(gq, fabsf(C.in[I_QNG][l * 64 + i])); gk = fmaxf(gk, fabsf(C.in[I_KNG][l * 64 + i])); } nomax = 64.f * gq * gk * C2 <= 60.f; }
    if (ATTN_SEL & 1) for (int i = 0; i < per * (1 + ((REPMASK_ >> 13) & 1)); ++i) { const int id = C.vcu * per + (i % per); if (id >= 1024) continue; const int bh = id >> 5, b = bh >> 3, h = bh & 7, qb = id & 31;
        const bf16* Qu = QA + (size_t)(b * LB + CTX + qb * 256) * 512 + h * 64;
        if (nomax) attn_body::attn_unit<8, false, 512, 128, true, true>(Qu, 512, KA + (size_t)(b * LB) * 128 + (h >> 2) * 64, VA + (size_t)(b * LB) * 128 + (h >> 2) * 64, 128, WSP(bf16, WS_AO) + (Qu - QA), LB / 64, 0, 0, shm, C.in[I_QNG] + l * 64, qb * 256);
        else attn_body::attn_unit<8, false, 512, 128, false, true>(Qu, 512, KA + (size_t)(b * LB) * 128 + (h >> 2) * 64, VA + (size_t)(b * LB) * 128 + (h >> 2) * 64, 128, WSP(bf16, WS_AO) + (Qu - QA), LB / 64, 0, 0, shm, C.in[I_QNG] + l * 64, qb * 256);
    }
    LAS float* bt = (LAS float*)(C.lds + attn_body::LDS_BT);
    if (ATTN_SEL & 2) {
        gu32* naq = C.ctl + CW_NAQ + 64 * l; LAS int* tk = (LAS int*)(C.lds + LDSCTL_OFF + 136);
        unsigned nxt = 0; if (C.tid == 0) nxt = __hip_atomic_fetch_add((unsigned*)naq, 1u, RLX_AGENT);
        for (;;) {
            if (C.tid == 0) *tk = (int)nxt;
            __syncthreads();
            const int id = __builtin_amdgcn_readfirstlane(*tk);
            if (id >= 1024 + 64) break;
            if (C.tid == 0) nxt = __hip_atomic_fetch_add((unsigned*)naq, 1u, RLX_AGENT);
            const bf16 *Qu, *Kh, *Vh; bf16* Ou; int kvp = 512, NT = 4, r0 = 0, rlo = 0; const float* btsrc = nullptr;
            if (id < 1024) { const int bh = id >> 5, b = bh >> 3, h = bh & 7; r0 = (id & 31) * 4;
                const float* rp = C.in[I_RPB] + (size_t)(l * 8 + h) * 465;
                btsrc = rp;
                rlo = r0 - 4 < 0 ? 0 : (r0 - 4 > 120 ? 120 : r0 - 4); const int rh_ = r0 - 1 < 0 ? 0 : (r0 - 1 > 120 ? 120 : r0 - 1), nloc = rh_ + 8 - rlo; NT = (4 + nloc + 1) & ~1;
                Qu = QN + (size_t)(b * LB + CTX + r0 * 64) * 512 + h * 64; Ou = WSP(bf16, WS_NO) + (Qu - QN); Kh = KN + (size_t)(b * LB) * 512 + h * 64; Vh = VN + (size_t)(b * LB) * 512 + h * 64; }
            else { int j = id - 1024; if (j < 32) { const int b = j >> 3, h = j & 7; Qu = QA + (size_t)(b * LB) * 512 + h * 64; Ou = WSP(bf16, WS_AO) + (Qu - QA); Kh = KA + (size_t)(b * LB) * 128 + (h >> 2) * 64; Vh = VA + (size_t)(b * LB) * 128 + (h >> 2) * 64; kvp = 128; }
                else { j -= 32; const int b = j >> 3, h = j & 7; Qu = QN + (size_t)(b * LB) * 512 + h * 64; Ou = WSP(bf16, WS_NO) + (Qu - QN); Kh = KN + (size_t)(b * LB) * 512 + h * 64; Vh = VN + (size_t)(b * LB) * 512 + h * 64; } }
            attn_body::attn_unit<8, true, 512, 0>(Qu, 512, Kh, Vh, kvp, Ou, NT, r0, rlo, shm, btsrc);
        }
    }
    {
        gu32* s5q = C.ctl + CW_NAQ + 64 * l + 16; gu32* cdone = C.ctl + CW_NAQ + 64 * l + 32; LAS int* tk = (LAS int*)(C.lds + LDSCTL_OFF + 136);
        unsigned nxt = 0;
        if (C.tid == 0) { nxt = __hip_atomic_fetch_add((unsigned*)s5q, 1u, RLX_AGENT);
            unsigned sp = 0; while (xb_ld((unsigned*)cdone) < (unsigned)(NB * 64)) { __builtin_amdgcn_s_sleep(1); if (++sp > XB_SPIN_CAP) break; }
            __builtin_amdgcn_fence(__ATOMIC_ACQUIRE, "agent"); }
        for (;;) {
            __syncthreads();
            if (C.tid == 0) *tk = (int)nxt;
            __syncthreads();
            const int id = __builtin_amdgcn_readfirstlane(*tk);
            if (id >= 32 * 18) break;
            if (C.tid == 0) nxt = __hip_atomic_fetch_add((unsigned*)s5q, 1u, RLX_AGENT);
            PS5B P{C.ws, id, 256, 128u}; pg8::gemm_phase_m128(C.lds, P);
        }
    }
}

constexpr int NPH = 46;
__global__ void __launch_bounds__(NWAVES * 64, 2) fwd(Args args) {
    extern __shared__ __attribute__((aligned(16))) unsigned char lds[];
    Ctx C; C.in = (const __attribute__((address_space(4))) CFP*)__builtin_amdgcn_kernarg_segment_ptr(); C.out = args.out; C.ws = args.ws; C.lds = (LAS unsigned char*)lds; C.ctl = (gu32*)(args.ws + WS_CTL);
    C.tid = 0; C.lane = 0; C.wave = __builtin_amdgcn_readfirstlane((int)threadIdx.x >> 6);
    C.G = gridDim.x; { const int bx = blockIdx.x; C.vcu = (C.G % 8 == 0) ? (bx % 8) * (C.G / 8) + bx / 8 : bx; }
    for (int u = threadIdx.x; u < (LDS_BYTES - LDSCTL_OFF) / 4; u += NWAVES * 64) ((LAS unsigned*)(C.lds + LDSCTL_OFF))[u] = 0u;
    __syncthreads();
    const int lo = args.ph_lo, hi = args.ph_hi;
    XcdBarrier bar; bar.bar = (unsigned*)(C.ctl + CW_BAR); bar.x = 0; bar.st = nullptr;
    if (hi - lo > 1) bar = xcd_barrier_post((unsigned*)(C.ctl + CW_BAR), (volatile LAS unsigned*)(C.lds + MISC_OFF) + 8);
    LAS int* tab = (LAS int*)(C.lds + LDSCTL_OFF);
    const int cg = (int)blockIdx.x;
#ifndef PHMASK
#define PHMASK 0xFFFF
#endif
#define IN(k) (lo <= (k) && (k) < hi)
#define EN(b) ((PHMASK >> (b)) & 1)
#ifndef REPMASK
#define REPMASK 0
#endif
#define RUN(b, stmt) do { stmt; if ((REPMASK >> (b)) & 1) { stmt; } } while (0)
#define SEAM(k) do { if (IN(k) && IN((k) + 1)) xcd_barrier(bar); } while (0)
#define LWS() ({ const __attribute__((address_space(4))) CFP* k_ = C.in; asm volatile("" : "+s"(k_)); (unsigned char*)k_[30]; })
#define LC() ({ Ctx c_ = C; c_.tid = threadIdx.x; asm volatile("" : "+v"(c_.tid)); c_.lane = c_.tid & 63; asm volatile("" : "+s"(c_.in)); c_.ws = (unsigned char*)c_.in[30]; c_.out = (float*)c_.in[29]; c_.ctl = (gu32*)(c_.ws + WS_CTL); c_; })
    if (EN(11) && IN(0)) { const Ctx Cl = LC(); phase_mod(Cl); RUN(11, phase_s5mats(Cl, 0, Cl.vcu); phase_weights(Cl, 0, Cl.vcu, Cl.G, 0)); }
    SEAM(0);
    for (int l = 0; l < NLAYER; ++l) {
        const int pb = 1 + 11 * l;
        if (EN(0) && IN(pb)) { const Ctx Cl = LC(); if (l == 0) phase_rows<0>(Cl, 0); else phase_rows<1>(Cl, l); }
        SEAM(pb);
        if (EN(1) && IN(pb + 1)) { if (W8_ALL) { static_assert(T % 192 == 0, "192-row tiles"); PWin8M P{LWS(), C.G, cg, 1024, 128u}; pg8::gemm_phase_m192(C.lds, P); } else { { PWin P{LWS(), C.G, cg, 1024, 128u}; pg8::gemm_phase(C.lds, P); } { PGate P{LWS(), C.G, cg, 1024, 128u}; pg8::gemm_phase_m128(C.lds, P); } } }
        SEAM(pb + 1);
        if (EN(2) && IN(pb + 2)) { { const Ctx Cl = LC(); phase_qkprep(Cl, l); } PS5A P{LWS(), C.G, cg, 512, 128u}; RUN(2, pg8::gemm_phase(C.lds, P)); }
        SEAM(pb + 2);
        if (EN(3) && IN(pb + 3)) { const Ctx Cl = LC(); RUN(3, phase_attn(Cl, l, lds)); }
        SEAM(pb + 3);
        if (EN(5) && IN(pb + 5)) { { PGlu P{LWS(), C.G, cg, 512, 128u, l == NLAYER - 1}; pg8::gemm_phase_m128(C.lds, P); }
            if (l < NLAYER - 1 && C.G >= 224) { const Ctx Cl = LC(); phase_weights(Cl, l + 1, cg - 16, C.G - 16, 3); } }
        SEAM(pb + 5);
        if (EN(6) && IN(pb + 6)) { { PMerge P{LWS(), C.G, cg, 512, 128u, l == NLAYER - 1}; pg8::gemm_phase_m128(C.lds, P); }
            if (l < NLAYER - 1) { const Ctx Cl = LC(); phase_s5mats(Cl, l + 1, C.G >= 160 ? cg - 32 : cg); if (C.G >= 224) phase_weights(Cl, l + 1, cg - 160, C.G - 160, 1); } }
        SEAM(pb + 6);
        if (EN(7) && IN(pb + 7)) { unsigned char* wl_ = LWS(); { PWoutM P{wl_, (const float*)(wl_ + WS_MOD) + (size_t)l * 5 * 6144, C.G, cg, 1024, 128u, wout_off(l)}; pg8::gemm_phase_m192(C.lds, P); }
            if (l < NLAYER - 1) { const Ctx Cl = LC(); if (C.G >= 224) phase_weights(Cl, l + 1, cg - 192, C.G - 192, 2); else phase_weights(Cl, l + 1, cg, C.G, 0); } }
        SEAM(pb + 7);
        if (EN(8) && IN(pb + 8)) { const Ctx Cl = LC(); phase_norm2(Cl, l); }
        SEAM(pb + 8);
        if (EN(9) && IN(pb + 9)) { if (FP8_MOE) { build_exptab_rows(C, tab, l, 192); PMoe1M P{LWS(), tab, C.G, cg, 1024, 128u, moe1_off(l)}; pg8::gemm_phase_m192(C.lds, P); } else { build_exptab(C, tab, l, 8); PMoe1B P{LWS(), tab, C.G, cg, 1024, 128u}; pg8::gemm_phase(C.lds, P); } }
        SEAM(pb + 9);
        if (EN(10) && IN(pb + 10)) { if (FP8_MOE) { build_exptab_rows(C, tab, l, 192); PMoe2M P{LWS(), tab, C.G, cg, 512, 128u, moe2_off(l)}; pg8::gemm_phase_m192(C.lds, P); } else { build_exptab(C, tab, l, 8); PMoe2B P{LWS(), tab, C.G, cg, 512, 128u}; pg8::gemm_phase(C.lds, P); } }
        SEAM(pb + 10);
    }
    if (EN(12) && IN(NPH - 1)) { const Ctx Cl = LC(); phase_rows<2>(Cl, NLAYER); }
#undef IN
#undef SEAM
}

#ifndef MK_PER_PHASE
#define MK_PER_PHASE 0
#endif
extern "C" void kernel_launch(void* const* d_in, const int* in_sizes, int n_in, void* d_out, int out_size, void* d_ws, size_t ws_size, hipStream_t stream) {
    static int grid = 0;
    if (grid == 0) {
        if (n_in != 29 || out_size != NB * SEQ * D || ws_size < WS_END) { fprintf(stderr, "kernel_launch: unexpected shapes (n_in %d out %d ws %zu)\n", n_in, out_size, ws_size); grid = -1; return; }
        int dev = 0, cus = 0, per_cu = 0;
        if (hipGetDevice(&dev) != hipSuccess || hipDeviceGetAttribute(&cus, hipDeviceAttributeMultiprocessorCount, dev) != hipSuccess) { grid = -1; return; }
        if (hipFuncSetAttribute((const void*)fwd, hipFuncAttributeMaxDynamicSharedMemorySize, LDS_BYTES) != hipSuccess) { grid = -1; return; }
        if (hipOccupancyMaxActiveBlocksPerMultiprocessor(&per_cu, (const void*)fwd, NWAVES * 64, LDS_BYTES) != hipSuccess || per_cu < 1) fprintf(stderr, "kernel_launch: occupancy query says %d\n", per_cu);
        (void)hipGetLastError();
        grid = cus;
    }
    if (grid < 0) return;
    (void)hipMemsetAsync((char*)d_ws + WS_CTL, 0, CTL_ZERO_BYTES, stream);
    Args a{};
    for (int i = 0; i < 29; ++i) a.in[i] = (const float*)d_in[i];
    a.out = (float*)d_out; a.ws = (unsigned char*)d_ws;
#if MK_PER_PHASE
    for (int p = 0; p < NPH; ++p) { a.ph_lo = p; a.ph_hi = p + 1; hipLaunchKernelGGL(fwd, dim3(grid), dim3(NWAVES * 64), LDS_BYTES, stream, a); }
#else
    a.ph_lo = 0; a.ph_hi = NPH; hipLaunchKernelGGL(fwd, dim3(grid), dim3(NWAVES * 64), LDS_BYTES, stream, a);
#endif
}
```
